# Optimizing an MI355X kernel written in HIP

```python
import math
import jax, jax.numpy as jnp
from jax import lax
import numpy as np

D_MODEL = 1024
BATCH = 8
SEQ = 4096
DEPTH = 2

N_EVEN = (DEPTH + 1) // 2
N_ODD = DEPTH // 2

A_WIDTH = D_MODEL // 2
A_GROUPS = 4
A_GROUP_DIM = A_WIDTH // A_GROUPS
A_CHUNK = 128
B_WIDTH = D_MODEL // 2
B_HEADS = 4
B_HEAD_DIM = B_WIDTH // B_HEADS
B_CHUNK = 128
B_CONV = 4
EVEN_IN = 2 * A_WIDTH + 2 * B_WIDTH
EVEN_MIX = A_WIDTH + B_WIDTH
C_HEAD_DIM = 64
C_HEADS = D_MODEL // C_HEAD_DIM
C_KV_HEADS = 4
C_WINDOW = 128
C_BLOCK = 128
C_Q = C_HEADS * C_HEAD_DIM
C_KV = C_KV_HEADS * C_HEAD_DIM
ROPE_THETA = 10000.0
MEM_LEN = 256
X_HEADS = 4
X_HEAD_DIM = D_MODEL // X_HEADS
N_GROUPS = 4
EXPERTS_PER_GROUP = 8
N_EXPERTS = N_GROUPS * EXPERTS_PER_GROUP
TOP_K = 2
D_EXPERT = D_MODEL // 2
MOE_BLOCK = 128
DN_ALPHA = (2 * DEPTH) ** 0.25
DN_BETA = (8 * DEPTH) ** -0.25
LN_EPS = 1e-5

kernel_name = 'hybrid_gmlp_mlstm_swa_hmoe'


def layer_norm(x, g, b):
    xf = x.astype(jnp.float32)
    xc = xf - xf.mean(-1, keepdims=True)
    var = (xc * xc).mean(-1, keepdims=True)
    return xc * lax.rsqrt(var + LN_EPS) * g + b


def rotary_tables(seq):
    inv = ROPE_THETA ** (-jnp.arange(0, C_HEAD_DIM, 2, dtype=jnp.float32) / C_HEAD_DIM)
    ang = jnp.arange(seq, dtype=jnp.float32)[:, None] * inv[None, :]
    return jnp.cos(ang), jnp.sin(ang)


def apply_rotary(t, cos, sin):
    t = t.astype(jnp.float32)
    t1, t2 = jnp.split(t, 2, axis=-1)
    c = cos[None, :, None, :]
    s = sin[None, :, None, :]
    return jnp.concatenate([t1 * c - t2 * s, t2 * c + t1 * s], axis=-1)


def causal_depthwise_conv(x, w):
    return lax.conv_general_dilated(
        x, w.astype(x.dtype)[:, None, :], window_strides=(1,),
        padding=[(w.shape[0] - 1, 0)], dimension_numbers=('NWC', 'WIO', 'NWC'),
        feature_group_count=x.shape[-1])


def chunked_gmlp(u, v, ln_g, ln_b, w_s, b_s):
    bsz, seq, _ = u.shape
    nc = seq // A_CHUNK
    vn = layer_norm(v, ln_g, ln_b).reshape(bsz, nc, A_CHUNK, A_GROUPS, A_GROUP_DIM)
    causal = jnp.tril(jnp.ones((A_CHUNK, A_CHUNK), dtype=bool))
    w = jnp.where(causal[None], w_s, 0.0)
    mixed = jnp.einsum('gts,bcsgd->bctgd', w, vn) + b_s.T[None, None, :, :, None]
    return u * mixed.reshape(bsz, seq, A_WIDTH)


def mlstm_chunkwise(q, k, v, ig, lf):
    bsz, nh, seq, dh = q.shape
    L = B_CHUNK
    nc = seq // L

    def to_chunks(t):
        return jnp.moveaxis(t.reshape(bsz, nh, nc, L, *t.shape[3:]), 2, 0)

    causal = jnp.tril(jnp.ones((L, L), dtype=bool))

    def step(carry, inp):
        C, n, m = carry
        qc, kc, vc, igc, lfc = inp
        b = jnp.cumsum(lfc, axis=-1)
        dmat = jnp.where(causal, b[..., :, None] - b[..., None, :] + igc[..., None, :], -jnp.inf)
        inter = b + m[..., None]
        mt = jnp.maximum(dmat.max(-1), inter)
        w_intra = jnp.exp(dmat - mt[..., None])
        w_state = jnp.exp(inter - mt)
        s = jnp.einsum('bhtd,bhsd->bhts', qc, kc) * w_intra
        num = jnp.einsum('bhts,bhsd->bhtd', s, vc) + w_state[..., None] * jnp.einsum('bhvk,bhtk->bhtv', C, qc)
        nq = s.sum(-1) + w_state * jnp.einsum('bhk,bhtk->bht', n, qc)
        h = num / jnp.maximum(jnp.abs(nq), jnp.exp(-mt))[..., None]
        bl = b[..., -1]
        g = bl[..., None] - b + igc
        m_new = jnp.maximum(bl + m, g.max(-1))
        decay = jnp.exp(bl + m - m_new)
        wg = jnp.exp(g - m_new[..., None])
        C_new = decay[..., None, None] * C + jnp.einsum('bhs,bhsv,bhsk->bhvk', wg, vc, kc)
        n_new = decay[..., None] * n + jnp.einsum('bhs,bhsk->bhk', wg, kc)
        return (C_new, n_new, m_new), h

    init = (jnp.zeros((bsz, nh, dh, dh), jnp.float32),
            jnp.zeros((bsz, nh, dh), jnp.float32),
            jnp.zeros((bsz, nh), jnp.float32))
    _, hs = lax.scan(step, init, (to_chunks(q), to_chunks(k), to_chunks(v), to_chunks(ig), to_chunks(lf)))
    return jnp.moveaxis(hs, 0, 2).reshape(bsz, nh, seq, dh)


def mlstm_mixer(xm, z, conv_w, conv_b, wq, wk, wv, w_if, b_if, norm_w, skip):
    bsz, seq, _ = xm.shape
    H, dh = B_HEADS, B_HEAD_DIM
    xc = jax.nn.silu(causal_depthwise_conv(xm, conv_w) + conv_b)
    xc_h = xc.reshape(bsz, seq, H, dh)
    xm_h = xm.reshape(bsz, seq, H, dh)
    q = jnp.einsum('bshd,hde->bshe', xc_h, wq)
    k = jnp.einsum('bshd,hde->bshe', xc_h, wk)
    v = jnp.einsum('bshd,hde->bshe', xm_h, wv)
    gate_in = jnp.concatenate([q.reshape(bsz, seq, B_WIDTH), k.reshape(bsz, seq, B_WIDTH),
                               v.reshape(bsz, seq, B_WIDTH)], axis=-1)
    gates = (gate_in @ w_if + b_if).astype(jnp.float32)
    ig = jnp.transpose(gates[..., :H], (0, 2, 1))
    lf = jnp.transpose(jax.nn.log_sigmoid(gates[..., H:]), (0, 2, 1))

    def to_bhsd(t):
        return jnp.transpose(t, (0, 2, 1, 3)).astype(jnp.float32)

    h = mlstm_chunkwise(to_bhsd(q), to_bhsd(k) * dh ** -0.5, to_bhsd(v), ig, lf)
    h = jnp.transpose(h, (0, 2, 1, 3))
    hc = h - h.mean(-1, keepdims=True)
    hn = hc * lax.rsqrt((hc * hc).mean(-1, keepdims=True) + LN_EPS) * norm_w.reshape(H, dh)
    return (hn.reshape(bsz, seq, B_WIDTH) + skip * xc) * jax.nn.silu(z)


def even_mixer(x, w_in, gm_ln_g, gm_ln_b, gm_ws, gm_bs, conv_w, conv_b, wq, wk, wv, w_if, b_if,
               norm_w, skip, w_out):
    proj = x @ w_in
    a_u = jax.nn.gelu(proj[..., :A_WIDTH])
    a_v = jax.nn.gelu(proj[..., A_WIDTH:2 * A_WIDTH])
    b_x = proj[..., 2 * A_WIDTH:2 * A_WIDTH + B_WIDTH]
    b_z = proj[..., 2 * A_WIDTH + B_WIDTH:]
    y_a = chunked_gmlp(a_u, a_v, gm_ln_g, gm_ln_b, gm_ws, gm_bs)
    y_b = mlstm_mixer(b_x, b_z, conv_w, conv_b, wq, wk, wv, w_if, b_if, norm_w, skip)
    return jnp.concatenate([y_a, y_b], axis=-1) @ w_out


def sliding_window_gqa(q, k, v, sinks):
    bsz, seq = q.shape[0], q.shape[1]
    L = C_BLOCK
    nb = seq // L
    G = C_HEADS // C_KV_HEADS
    qb = q.reshape(bsz, nb, L, C_KV_HEADS, G, C_HEAD_DIM)

    def band(t):
        tb = t.reshape(bsz, nb, L, C_KV_HEADS, C_HEAD_DIM)
        prev = jnp.pad(tb, ((0, 0), (1, 0), (0, 0), (0, 0), (0, 0)))[:, :-1]
        return jnp.concatenate([prev, tb], axis=2)

    kb, vb = band(k), band(v)
    s = jnp.einsum('bnqhgd,bnkhd->bnhgqk', qb, kb).astype(jnp.float32) * C_HEAD_DIM ** -0.5
    qi = jnp.arange(L)[:, None] + L
    kj = jnp.arange(2 * L)[None, :]
    blk = jnp.arange(nb)[:, None, None]
    valid = (kj <= qi) & (qi - kj < C_WINDOW) & (blk * L - L + kj >= 0)
    s = jnp.where(valid[None, :, None, None], s, -jnp.inf)
    sink = sinks.astype(jnp.float32).reshape(1, 1, C_KV_HEADS, G, 1, 1)
    m = jnp.maximum(s.max(-1, keepdims=True), sink)
    p = jnp.exp(s - m)
    p = p / (p.sum(-1, keepdims=True) + jnp.exp(sink - m))
    o = jnp.einsum('bnhgqk,bnkhd->bnqhgd', p, vb)
    return o.reshape(bsz, seq, C_Q)


def swa_mixer(x, w_qkv, b_qkv, sinks, w_o, cos, sin):
    bsz, seq, _ = x.shape
    qkv = x @ w_qkv + b_qkv
    q = qkv[..., :C_Q].reshape(bsz, seq, C_HEADS, C_HEAD_DIM)
    k = qkv[..., C_Q:C_Q + C_KV].reshape(bsz, seq, C_KV_HEADS, C_HEAD_DIM)
    v = qkv[..., C_Q + C_KV:].reshape(bsz, seq, C_KV_HEADS, C_HEAD_DIM)
    q = apply_rotary(q, cos, sin)
    k = apply_rotary(k, cos, sin)
    return sliding_window_gqa(q, k, v, sinks) @ w_o


def memory_cross_attention(x, mem, wq, wkv, wo):
    bsz, seq, _ = x.shape
    m_len = mem.shape[1]
    q = (x @ wq).reshape(bsz, seq, X_HEADS, X_HEAD_DIM)
    kv = mem @ wkv
    k = kv[..., :D_MODEL].reshape(bsz, m_len, X_HEADS, X_HEAD_DIM)
    v = kv[..., D_MODEL:].reshape(bsz, m_len, X_HEADS, X_HEAD_DIM)
    s = jnp.einsum('bshd,bmhd->bhsm', q, k).astype(jnp.float32) * X_HEAD_DIM ** -0.5
    p = jax.nn.softmax(s, axis=-1)
    o = jnp.einsum('bhsm,bmhd->bshd', p, v).reshape(bsz, seq, D_MODEL)
    return o @ wo


def hierarchical_moe(x, w_rg, b_rg, w_re, b_re, w1, w3, w2):
    bsz, seq, d = x.shape
    n_tok = bsz * seq
    xf = x.reshape(n_tok, d)
    lg = (xf @ w_rg + b_rg).astype(jnp.float32)
    pg = jax.nn.softmax(lg, axis=-1)
    gi = jnp.argmax(lg, axis=-1)
    gate_g = jnp.take_along_axis(pg, gi[:, None], axis=-1)[:, 0]
    le = (xf @ w_re + b_re).astype(jnp.float32).reshape(n_tok, N_GROUPS, EXPERTS_PER_GROUP)
    le_sel = jnp.take_along_axis(le, gi[:, None, None], axis=1)[:, 0]
    top_v, top_i = lax.top_k(le_sel, TOP_K)
    pe = jax.nn.softmax(top_v, axis=-1)
    eid = (gi[:, None] * EXPERTS_PER_GROUP + top_i).reshape(-1)
    wts = (gate_g[:, None] * pe).reshape(-1)
    tok = jnp.repeat(jnp.arange(n_tok, dtype=jnp.int32), TOP_K)
    n_asg = n_tok * TOP_K
    order = jnp.argsort(eid)
    se, stok, sw = eid[order], tok[order], wts[order]
    counts = jnp.bincount(eid, length=N_EXPERTS)
    starts = jnp.cumsum(counts) - counts
    pcounts = (counts + MOE_BLOCK - 1) // MOE_BLOCK * MOE_BLOCK
    pends = jnp.cumsum(pcounts)
    pstarts = pends - pcounts
    dest = pstarts[se] + jnp.arange(n_asg, dtype=jnp.int32) - starts[se]
    n_pad = n_asg + N_EXPERTS * MOE_BLOCK
    n_blk = n_pad // MOE_BLOCK
    buf_tok = jnp.full((n_pad,), n_tok, jnp.int32).at[dest].set(stok)
    buf_w = jnp.zeros((n_pad,), jnp.float32).at[dest].set(sw)
    blk_exp = jnp.minimum(jnp.searchsorted(pends, jnp.arange(n_blk, dtype=jnp.int32) * MOE_BLOCK, side='right'),
                          N_EXPERTS - 1)
    xpad = jnp.concatenate([xf, jnp.zeros((1, d), xf.dtype)], axis=0)
    xb = xpad[buf_tok].reshape(n_blk, MOE_BLOCK, d)

    def expert_block(args):
        xblk, e = args
        h = jax.nn.silu(xblk @ w1[e]) * (xblk @ w3[e])
        return h @ w2[e]

    yb = lax.map(expert_block, (xb, blk_exp)).reshape(n_pad, d)
    out = jnp.zeros((n_tok + 1, d), yb.dtype).at[buf_tok].add(yb * buf_w[:, None].astype(yb.dtype))
    return out[:n_tok].reshape(bsz, seq, d)


def setup_inputs(seed: int = 0) -> dict:
    key = jax.random.key(seed)
    keys = jax.random.split(key, 64)
    cnt = [0]

    def nrm(shape, scale):
        k = keys[cnt[0]]
        cnt[0] += 1
        return jax.random.normal(k, shape, jnp.float32) * scale

    NE, NO, D, H = N_EVEN, N_ODD, D_MODEL, B_HEADS
    f_bias = jnp.linspace(3.0, 6.0, H, dtype=jnp.float32)[None, :] + nrm((NE, H), 0.1)
    i_bias = nrm((NE, H), 0.1)
    return {
        'x': nrm((BATCH, SEQ, D), 1.0),
        'mem': nrm((BATCH, MEM_LEN, D), 1.0),
        'ln_g': 1.0 + nrm((DEPTH, 3, D), 0.02),
        'ln_b': nrm((DEPTH, 3, D), 0.02),
        'ev_w_in': nrm((NE, D, EVEN_IN), D ** -0.5),
        'ev_gm_ln_g': 1.0 + nrm((NE, A_WIDTH), 0.02),
        'ev_gm_ln_b': nrm((NE, A_WIDTH), 0.02),
        'ev_gm_ws': nrm((NE, A_GROUPS, A_CHUNK, A_CHUNK), A_CHUNK ** -0.5),
        'ev_gm_bs': 1.0 + nrm((NE, A_GROUPS, A_CHUNK), 0.1),
        'ev_conv_w': nrm((NE, B_CONV, B_WIDTH), B_CONV ** -0.5),
        'ev_conv_b': nrm((NE, B_WIDTH), 0.02),
        'ev_wq': nrm((NE, H, B_HEAD_DIM, B_HEAD_DIM), B_HEAD_DIM ** -0.5),
        'ev_wk': nrm((NE, H, B_HEAD_DIM, B_HEAD_DIM), B_HEAD_DIM ** -0.5),
        'ev_wv': nrm((NE, H, B_HEAD_DIM, B_HEAD_DIM), B_HEAD_DIM ** -0.5),
        'ev_w_if': nrm((NE, 3 * B_WIDTH, 2 * H), (3 * B_WIDTH) ** -0.5),
        'ev_b_if': jnp.concatenate([i_bias, f_bias], axis=-1),
        'ev_norm_w': 1.0 + nrm((NE, B_WIDTH), 0.02),
        'ev_skip': 1.0 + nrm((NE, B_WIDTH), 0.02),
        'ev_w_out': nrm((NE, EVEN_MIX, D), DN_BETA * EVEN_MIX ** -0.5),
        'od_w_qkv': nrm((NO, D, C_Q + 2 * C_KV), D ** -0.5),
        'od_b_qkv': nrm((NO, C_Q + 2 * C_KV), 0.02),
        'od_sinks': nrm((NO, C_HEADS), 0.5),
        'od_w_o': nrm((NO, C_Q, D), DN_BETA * C_Q ** -0.5),
        'xa_wq': nrm((DEPTH, D, D), D ** -0.5),
        'xa_wkv': nrm((DEPTH, D, 2 * D), D ** -0.5),
        'xa_wo': nrm((DEPTH, D, D), DN_BETA * D ** -0.5),
        'moe_w_rg': nrm((DEPTH, D, N_GROUPS), D ** -0.5),
        'moe_b_rg': nrm((DEPTH, N_GROUPS), 0.01),
        'moe_w_re': nrm((DEPTH, D, N_EXPERTS), D ** -0.5),
        'moe_b_re': nrm((DEPTH, N_EXPERTS), 0.01),
        'moe_w1': nrm((DEPTH, N_EXPERTS, D, D_EXPERT), D ** -0.5),
        'moe_w3': nrm((DEPTH, N_EXPERTS, D, D_EXPERT), D ** -0.5),
        'moe_w2': nrm((DEPTH, N_EXPERTS, D_EXPERT, D), DN_BETA * D_EXPERT ** -0.5),
    }


def reference(x, mem, ln_g, ln_b,
              ev_w_in, ev_gm_ln_g, ev_gm_ln_b, ev_gm_ws, ev_gm_bs,
              ev_conv_w, ev_conv_b, ev_wq, ev_wk, ev_wv, ev_w_if, ev_b_if,
              ev_norm_w, ev_skip, ev_w_out,
              od_w_qkv, od_b_qkv, od_sinks, od_w_o,
              xa_wq, xa_wkv, xa_wo,
              moe_w_rg, moe_b_rg, moe_w_re, moe_b_re, moe_w1, moe_w3, moe_w2):
    cos, sin = rotary_tables(x.shape[1])
    for l in range(DEPTH):
        if l % 2 == 0:
            e = l // 2
            y = even_mixer(x, ev_w_in[e], ev_gm_ln_g[e], ev_gm_ln_b[e], ev_gm_ws[e], ev_gm_bs[e],
                           ev_conv_w[e], ev_conv_b[e], ev_wq[e], ev_wk[e], ev_wv[e], ev_w_if[e],
                           ev_b_if[e], ev_norm_w[e], ev_skip[e], ev_w_out[e])
        else:
            o = l // 2
            y = swa_mixer(x, od_w_qkv[o], od_b_qkv[o], od_sinks[o], od_w_o[o], cos, sin)
        x = layer_norm(DN_ALPHA * x + y, ln_g[l, 0], ln_b[l, 0])
        y = memory_cross_attention(x, mem, xa_wq[l], xa_wkv[l], xa_wo[l])
        x = layer_norm(DN_ALPHA * x + y, ln_g[l, 1], ln_b[l, 1])
        y = hierarchical_moe(x, moe_w_rg[l], moe_b_rg[l], moe_w_re[l], moe_b_re[l],
                             moe_w1[l], moe_w3[l], moe_w2[l])
        x = layer_norm(DN_ALPHA * x + y, ln_g[l, 2], ln_b[l, 2])
    return x
```

```cpp
#include <hip/hip_runtime.h>
#include <hip/hip_cooperative_groups.h>
#include <cstdio>
#include <cstdint>
#include <cmath>
namespace fk {
#define LAS __attribute__((address_space(3)))
typedef unsigned short bf16_t;
typedef short bf16x8 __attribute__((ext_vector_type(8)));
typedef short s16x4 __attribute__((ext_vector_type(4)));
typedef float f32x4 __attribute__((ext_vector_type(4)));
typedef float f32x16 __attribute__((ext_vector_type(16)));
typedef float f32x2 __attribute__((ext_vector_type(2)));
typedef unsigned u32x4 __attribute__((ext_vector_type(4)));
typedef unsigned u32x2 __attribute__((ext_vector_type(2)));
typedef __bf16 bf16x2_t __attribute__((ext_vector_type(2)));

constexpr int NT = 32768, DM = 1024, SEQ = 4096;
constexpr int NTHR = 512, NWAVE = 8;
constexpr float ALPHA = 1.4142135623730951f, LN_EPS = 1e-5f, LOG2E = 1.4426950408889634f;

__device__ __forceinline__ unsigned pk2(float lo, float hi) { f32x2 v = {lo, hi}; bf16x2_t b = __builtin_convertvector(v, bf16x2_t); return __builtin_bit_cast(unsigned, b); }
__device__ __forceinline__ float bf_lo(unsigned w) { return __uint_as_float(w << 16); }
__device__ __forceinline__ float bf_hi(unsigned w) { return __uint_as_float(w & 0xffff0000u); }
__device__ __forceinline__ float bf2f(bf16_t b) { return __uint_as_float(((unsigned)b) << 16); }
__device__ __forceinline__ bf16_t f2bf(float f) { return (bf16_t)(pk2(f, 0.f) & 0xffffu); }
__device__ __forceinline__ float fast_exp(float x) { return __builtin_amdgcn_exp2f(x * LOG2E); }
__device__ __forceinline__ float sigmoid_f(float x) { return __builtin_amdgcn_rcpf(1.f + fast_exp(-x)); }
__device__ __forceinline__ float silu_f(float x) { return x * sigmoid_f(x); }
__device__ __forceinline__ float gelu_tanh_f(float x) { const float u = 1.5957691216057308f * (x + 0.044715f * x * x * x); return x * sigmoid_f(u); }
__device__ __forceinline__ int crow(int r, int hi) { return (r & 3) + 8 * (r >> 2) + 4 * hi; }
__device__ __forceinline__ float xhalf_sum(float v) { auto rr = __builtin_amdgcn_permlane32_swap(__float_as_uint(v), __float_as_uint(v), false, false); return __uint_as_float(rr[0]) + __uint_as_float(rr[1]); }
__device__ __forceinline__ float xhalf_max(float v) { auto rr = __builtin_amdgcn_permlane32_swap(__float_as_uint(v), __float_as_uint(v), false, false); return fmaxf(__uint_as_float(rr[0]), __uint_as_float(rr[1])); }
__device__ __forceinline__ float wave_sum(float v) {
#pragma unroll
    for (int o = 1; o < 64; o <<= 1) v += __shfl_xor(v, o);
    return v;
}
__device__ __forceinline__ s16x4 lds_tr(const LAS void* p) { return __builtin_bit_cast(s16x4, __builtin_amdgcn_ds_read_tr16_b64_v4i16((LAS s16x4*)p)); }
#define MFMA32(a, b, c) __builtin_amdgcn_mfma_f32_32x32x16_bf16((a), (b), (c), 0, 0, 0)

namespace pg8 {
constexpr int BM = 256, BK = 64, HALF = 128, HTB = HALF * BK * 2, STAGE_BYTES = 8 * HTB, NXCD = 8, WGM = 8;
__host__ __device__ __forceinline__ int lds_byte(int r, int c) { const int st = (r >> 4) * 2 + (c >> 5), rr = r & 15, cc = c & 31, ob = rr * 64 + cc * 2; return st * 1024 + (ob ^ (((ob >> 9) & 1) << 5)); }
__host__ __device__ __forceinline__ void stage_rc(int b, int& R, int& C) { const int st = b / 1024, sb = b % 1024, swz = sb ^ (((sb >> 9) & 1) << 5); R = (st >> 1) * 16 + swz / 64; C = (st & 1) * 32 + (swz % 64) / 2; }
__host__ __device__ __forceinline__ int perm32(int rho) { const int n = rho >> 4, i = rho & 15; return 8 * (i >> 2) + 4 * n + (i & 3); }

struct Unit { const char* A; const char* B; int pm, pn, job; };

__device__ __forceinline__ void tile_order(int l, int nM, int nN, int& pm, int& pn) {
    const int nwg = nM * nN; int wgid = l;
    { const int q = nwg / NXCD, r = nwg % NXCD, xcd = wgid % NXCD, off = wgid / NXCD; wgid = (xcd < r ? xcd * (q + 1) : r * (q + 1) + (xcd - r) * q) + off; }
    const int nig = WGM * nN, gid = wgid / nig, fm = gid * WGM, gsz = (nM - fm) < WGM ? (nM - fm) : WGM;
    pm = fm + ((wgid % nig) % gsz); pn = (wgid % nig) / gsz;
}
struct JobDesc { unsigned long long A, B, out, bias, rot, out2; int nM, nN, ldc, mode; };
__device__ __forceinline__ unsigned long long rfl64(unsigned long long v) { const unsigned lo = __builtin_amdgcn_readfirstlane((unsigned)v), hi = __builtin_amdgcn_readfirstlane((unsigned)(v >> 32)); return ((unsigned long long)hi << 32) | lo; }
constexpr int JT_OFF = STAGE_BYTES;
struct Jobs3 {
    const LAS JobDesc* jt; int n0, n1, n2; int K, G, c;
    __device__ __forceinline__ bool next(int i, Unit& u) const {
        long L = (long)i * G + c;
        if (L >= (long)n0 + n1 + n2) return false;
        int l = (int)L; int jb = 0;
        if (l >= n0) { l -= n0; jb = 1; if (l >= n1) { l -= n1; jb = 2; } }
        const int jM = __builtin_amdgcn_readfirstlane(jt[jb].nM), jN = __builtin_amdgcn_readfirstlane(jt[jb].nN);
        int pm, pn; tile_order(l, jM, jN, pm, pn);
        const size_t tstep = (size_t)BM * K * 2;
        u.A = (const char*)rfl64(jt[jb].A) + (size_t)pm * tstep; u.B = (const char*)rfl64(jt[jb].B) + (size_t)pn * tstep; u.pm = pm; u.pn = pn; u.job = jb; return true;
    }
};

template <class Epi, class Sched, bool ALIGN_EPI, bool SP2>
__device__ __forceinline__ void gemm_phase(LAS unsigned char* lds, const int K, const Sched& S, const Epi& E) {
    int tid_ = threadIdx.x; asm volatile("" : "+v"(tid_)); const int tid = tid_, wid = __builtin_amdgcn_readfirstlane(tid >> 6), lane = tid & 63, wr = wid >> 2, wc = wid & 3, fr = lane & 15, fq = lane >> 4;
    const int nt = K / BK;
    unsigned voffA[2], voffB[2];
#pragma unroll
    for (int i = 0; i < 2; ++i) { int R, C; stage_rc(tid * 16 + i * 8192, R, C); const int Rb = Epi::PERM ? ((R & ~31) + perm32(R & 31)) : R;
        voffA[i] = (unsigned)(R * K + C) * 2u; voffB[i] = (unsigned)(Rb * K + C) * 2u; }
    const size_t kstep = (size_t)(BK * 2);
    const size_t hstep = (size_t)HALF * K * 2;
    const unsigned ldsw = (unsigned)wid * 1024u;
    const int aoff = lds_byte(wr * 64 + fr, fq * 8), boff = lds_byte(wc * 32 + fr, fq * 8);
#define PG8_SA(b, h) (((b) * 2 + (h)) * HTB)
#define PG8_SB(b, h) ((4 + (b) * 2 + (h)) * HTB)
#define PG8_STAGE(bufoff, gbase, voff) do { _Pragma("unroll") for (int _i = 0; _i < 2; ++_i) \
        __builtin_amdgcn_global_load_lds((const unsigned*)((const char*)(gbase) + (voff)[_i]), (LAS unsigned*)(lds + (bufoff) + ldsw + _i * 8192), 16, 0, 0); } while (0)
#define PG8_LDA(dst, b, h) do { _Pragma("unroll") for (int m = 0; m < 4; ++m) _Pragma("unroll") for (int k = 0; k < 2; ++k) dst[m][k] = *(const LAS bf16x8*)(lds + PG8_SA(b, h) + aoff + m * 2048 + k * 1024); } while (0)
#define PG8_LDB(dst, b, h) do { _Pragma("unroll") for (int n = 0; n < 2; ++n) _Pragma("unroll") for (int k = 0; k < 2; ++k) dst[n][k] = *(const LAS bf16x8*)(lds + PG8_SB(b, h) + boff + n * 2048 + k * 1024); } while (0)
#define PG8_MMA(ai, bj, At, Bt) do { __builtin_amdgcn_s_setprio(1); _Pragma("unroll") for (int m = 0; m < 4; ++m) _Pragma("unroll") for (int n = 0; n < 2; ++n) _Pragma("unroll") for (int k = 0; k < 2; ++k) \
        acc[ai][bj][m][n] = __builtin_amdgcn_mfma_f32_16x16x32_bf16(Bt[n][k], At[m][k], acc[ai][bj][m][n], 0, 0, 0); __builtin_amdgcn_s_setprio(0); } while (0)
#define PG8_WAIT_V(n) asm volatile("s_waitcnt vmcnt(" #n ")" ::: "memory")
#define PG8_WAIT_L(n) asm volatile("s_waitcnt lgkmcnt(" #n ")" ::: "memory")
#define PG8_BAR __builtin_amdgcn_s_barrier()
#define PG8_SCHED __builtin_amdgcn_sched_barrier(0)
    Unit cur, nxt; int ui = 0;
    if (!S.next(0, cur)) return;
    f32x4 acc[2][2][4][2];
#pragma unroll
    for (int a = 0; a < 2; ++a)
#pragma unroll
        for (int b = 0; b < 2; ++b)
#pragma unroll
            for (int m = 0; m < 4; ++m)
#pragma unroll
                for (int n = 0; n < 2; ++n) acc[a][b][m][n] = (f32x4){0.f, 0.f, 0.f, 0.f};
    bf16x8 At[4][2], B0[2][2], B1[2][2];
    const char* cA = cur.A; const char* cB = cur.B;
    if constexpr (SP2) {
        PG8_STAGE(PG8_SB(0, 0), cB, voffB); PG8_STAGE(PG8_SB(0, 1), cB + hstep, voffB); PG8_STAGE(PG8_SA(0, 0), cA, voffA); PG8_STAGE(PG8_SA(0, 1), cA + hstep, voffA);
        if (wr == 1) PG8_BAR;
        PG8_WAIT_V(2); PG8_BAR;
        PG8_STAGE(PG8_SB(1, 0), cB + kstep, voffB); PG8_STAGE(PG8_SA(1, 0), cA + kstep, voffA); PG8_STAGE(PG8_SB(1, 1), cB + hstep + kstep, voffB);
        PG8_WAIT_V(6); PG8_BAR;
    } else {
        PG8_STAGE(PG8_SB(0, 0), cB, voffB); PG8_STAGE(PG8_SA(0, 0), cA, voffA); PG8_STAGE(PG8_SB(0, 1), cB + hstep, voffB); PG8_STAGE(PG8_SA(0, 1), cA + hstep, voffA);
        if (wr == 1) PG8_BAR;
        PG8_WAIT_V(4); PG8_BAR;
        PG8_STAGE(PG8_SB(1, 0), cB + kstep, voffB); PG8_STAGE(PG8_SA(1, 0), cA + kstep, voffA); PG8_STAGE(PG8_SB(1, 1), cB + hstep + kstep, voffB);
        PG8_WAIT_V(6); PG8_BAR;
    }
    for (;;) {
        const bool has_next = S.next(ui + 1, nxt);
        const char* nA = has_next ? nxt.A : cA; const char* nB = has_next ? nxt.B : cB;
        for (int t = 0; t < nt; t += 2) {
            const bool last = (t == nt - 2);
            const char* a1 = cA + (size_t)(t + 1) * kstep;
            const char* a2 = last ? nA : cA + (size_t)(t + 2) * kstep; const char* b2 = last ? nB : cB + (size_t)(t + 2) * kstep;
            const char* a3 = a2 + kstep; const char* b3 = b2 + kstep;
            if constexpr (SP2) {
            PG8_LDB(B0, 0, 0); PG8_LDB(B1, 0, 1); PG8_SCHED; PG8_LDA(At, 0, 0); PG8_STAGE(PG8_SA(1, 1), a1 + hstep, voffA);
            PG8_WAIT_V(8); PG8_WAIT_L(0); PG8_BAR; PG8_MMA(0, 0, At, B0); PG8_MMA(0, 1, At, B1); PG8_BAR; PG8_SCHED;
            PG8_LDA(At, 0, 1); PG8_STAGE(PG8_SB(0, 0), b2, voffB); PG8_STAGE(PG8_SB(0, 1), b2 + hstep, voffB); PG8_STAGE(PG8_SA(0, 0), a2, voffA);
            PG8_WAIT_V(8); PG8_WAIT_L(0); PG8_BAR; PG8_MMA(1, 0, At, B0); PG8_MMA(1, 1, At, B1); PG8_BAR; PG8_SCHED;
            PG8_LDB(B0, 1, 0); PG8_LDB(B1, 1, 1); PG8_SCHED; PG8_LDA(At, 1, 0); PG8_STAGE(PG8_SA(0, 1), a2 + hstep, voffA);
            PG8_WAIT_V(8); PG8_WAIT_L(0); PG8_BAR; PG8_MMA(0, 0, At, B0); PG8_MMA(0, 1, At, B1); PG8_BAR; PG8_SCHED;
            PG8_LDA(At, 1, 1); PG8_STAGE(PG8_SB(1, 0), b3, voffB); PG8_STAGE(PG8_SB(1, 1), b3 + hstep, voffB); PG8_STAGE(PG8_SA(1, 0), a3, voffA);
            PG8_WAIT_V(8); PG8_WAIT_L(0); PG8_BAR; PG8_MMA(1, 0, At, B0); PG8_MMA(1, 1, At, B1); PG8_BAR; PG8_SCHED;
            } else {
            PG8_LDB(B0, 0, 0); PG8_SCHED; PG8_LDA(At, 0, 0); PG8_STAGE(PG8_SA(1, 1), a1 + hstep, voffA);
            PG8_WAIT_L(8); PG8_BAR; PG8_WAIT_L(0); PG8_MMA(0, 0, At, B0); PG8_BAR; PG8_SCHED;
            PG8_LDB(B1, 0, 1); PG8_STAGE(PG8_SB(0, 0), b2, voffB);
            PG8_BAR; PG8_WAIT_L(0); PG8_MMA(0, 1, At, B1); PG8_BAR;
            PG8_LDA(At, 0, 1); PG8_STAGE(PG8_SA(0, 0), a2, voffA);
            PG8_BAR; PG8_WAIT_L(0); PG8_MMA(1, 0, At, B0); PG8_BAR; PG8_SCHED;
            PG8_STAGE(PG8_SB(0, 1), b2 + hstep, voffB);
            PG8_WAIT_V(6); PG8_BAR; PG8_MMA(1, 1, At, B1); PG8_BAR;
            PG8_LDB(B0, 1, 0); PG8_SCHED; PG8_LDA(At, 1, 0); PG8_STAGE(PG8_SA(0, 1), a2 + hstep, voffA);
            PG8_WAIT_L(8); PG8_BAR; PG8_WAIT_L(0); PG8_MMA(0, 0, At, B0); PG8_BAR; PG8_SCHED;
            PG8_LDB(B1, 1, 1); PG8_STAGE(PG8_SB(1, 0), b3, voffB);
            PG8_BAR; PG8_WAIT_L(0); PG8_MMA(0, 1, At, B1); PG8_BAR;
            PG8_LDA(At, 1, 1); PG8_STAGE(PG8_SA(1, 0), a3, voffA);
            PG8_BAR; PG8_WAIT_L(0); PG8_MMA(1, 0, At, B0); PG8_BAR; PG8_SCHED;
            PG8_STAGE(PG8_SB(1, 1), b3 + hstep, voffB);
            PG8_WAIT_V(6); PG8_BAR; PG8_MMA(1, 1, At, B1); PG8_BAR;
            }
        }
        if constexpr (ALIGN_EPI) { if (wr == 0) PG8_BAR; }
        E(acc, cur, wr, wc, fr, fq);
        if (!has_next) break;
#pragma unroll
        for (int a = 0; a < 2; ++a)
#pragma unroll
            for (int b = 0; b < 2; ++b)
#pragma unroll
                for (int m = 0; m < 4; ++m)
#pragma unroll
                    for (int n = 0; n < 2; ++n) acc[a][b][m][n] = (f32x4){0.f, 0.f, 0.f, 0.f};
        cur = nxt; cA = nA; cB = nB; ++ui;
        if constexpr (ALIGN_EPI) { if (wr == 1) PG8_BAR; }
    }
    PG8_WAIT_V(0);
    if constexpr (!ALIGN_EPI) { if (wr == 0) PG8_BAR; }
    PG8_BAR;
#undef PG8_SA
#undef PG8_SB
#undef PG8_STAGE
#undef PG8_LDA
#undef PG8_LDB
#undef PG8_MMA
#undef PG8_WAIT_V
#undef PG8_WAIT_L
#undef PG8_BAR
#undef PG8_SCHED
}
}
enum { EM_PLAIN = 0, EM_GELU4 = 1, EM_SWIGLU = 2, EM_ROTARY = 3, EM_ROWBIAS = 4 };
struct EpiMulti {
    static constexpr bool PERM = true;
    const LAS pg8::JobDesc* jt;
    __device__ __forceinline__ void operator()(const f32x4 (&acc)[2][2][4][2], const pg8::Unit& u, int wr, int wc, int fr, int fq) const {
        const LAS pg8::JobDesc* jd = jt + u.job;
        bf16_t* out = (bf16_t*)pg8::rfl64(jd->out);
        const int ldc = __builtin_amdgcn_readfirstlane(jd->ldc);
        const int mode = __builtin_amdgcn_readfirstlane(jd->mode);
        const float* bias = (const float*)pg8::rfl64(jd->bias);
        const int row0 = u.pm * 256 + wr * 64 + fr;
        const int colt = u.pn * 256 + wc * 32 + 8 * fq;
        if (mode == EM_PLAIN || mode == EM_ROWBIAS) {
#pragma unroll
            for (int ai = 0; ai < 2; ++ai)
#pragma unroll
                for (int m = 0; m < 4; ++m) { const int row = row0 + ai * 128 + m * 16; const float rb = (mode == EM_ROWBIAS && bias) ? bias[row] : 0.f;
                    bf16_t* rowp = out + (size_t)row * ldc + colt;
#pragma unroll
                    for (int bj = 0; bj < 2; ++bj) { const f32x4 v0 = acc[ai][bj][m][0] + rb, v1 = acc[ai][bj][m][1] + rb;
                        u32x4 w; w.x = pk2(v0[0], v0[1]); w.y = pk2(v0[2], v0[3]); w.z = pk2(v1[0], v1[1]); w.w = pk2(v1[2], v1[3]);
                        *(u32x4*)(rowp + bj * 128) = w; } }
        } else if (mode == EM_GELU4) {
            const int arr = u.pn >> 1; bf16_t* base = out + (size_t)arr * NT * 512; const int col = colt - arr * 512; const bool act = arr < 2;
#pragma unroll
            for (int ai = 0; ai < 2; ++ai)
#pragma unroll
                for (int m = 0; m < 4; ++m) { bf16_t* rowp = base + (size_t)(row0 + ai * 128 + m * 16) * 512 + col;
#pragma unroll
                    for (int bj = 0; bj < 2; ++bj) { f32x4 v0 = acc[ai][bj][m][0], v1 = acc[ai][bj][m][1];
                        if (act) {
#pragma unroll
                            for (int e = 0; e < 4; ++e) { v0[e] = gelu_tanh_f(v0[e]); v1[e] = gelu_tanh_f(v1[e]); } }
                        u32x4 w; w.x = pk2(v0[0], v0[1]); w.y = pk2(v0[2], v0[3]); w.z = pk2(v1[0], v1[1]); w.w = pk2(v1[2], v1[3]);
                        *(u32x4*)(rowp + bj * 128) = w; } }
        } else if (mode == EM_SWIGLU) {
#pragma unroll
            for (int ai = 0; ai < 2; ++ai)
#pragma unroll
                for (int m = 0; m < 4; ++m) { bf16_t* rowp = out + (size_t)(row0 + ai * 128 + m * 16) * ldc + (colt >> 1);
#pragma unroll
                    for (int bj = 0; bj < 2; ++bj) { const f32x4 v0 = acc[ai][bj][m][0], v1 = acc[ai][bj][m][1];
                        u32x2 w; w.x = pk2(silu_f(v0[0]) * v0[1], silu_f(v0[2]) * v0[3]); w.y = pk2(silu_f(v1[0]) * v1[1], silu_f(v1[2]) * v1[3]);
                        *(u32x2*)(rowp + bj * 64) = w; } }
        } else {
            const float* rot = (const float*)pg8::rfl64(jd->rot);
            bf16_t* out2 = (bf16_t*)pg8::rfl64(jd->out2);
            const bool isk = u.pn >= 4; bf16_t* base = isk ? out2 : out; const int ld = isk ? 256 : 1024; const int colo = isk ? colt - 1024 : colt;
            float bv[2][8];
#pragma unroll
            for (int bj = 0; bj < 2; ++bj)
#pragma unroll
                for (int e = 0; e < 8; ++e) bv[bj][e] = bias ? bias[colt + bj * 128 + e] : 0.f;
            const int i0 = (colt & 63) >> 1;
#pragma unroll
            for (int ai = 0; ai < 2; ++ai)
#pragma unroll
                for (int m = 0; m < 4; ++m) { const int row = row0 + ai * 128 + m * 16; const int pos = row & (SEQ - 1);
                    const f32x4 cs0 = *(const f32x4*)(rot + ((size_t)pos * 32 + i0) * 2), cs1 = *(const f32x4*)(rot + ((size_t)pos * 32 + i0 + 2) * 2);
                    bf16_t* rowp = base + (size_t)row * ld + colo;
#pragma unroll
                    for (int bj = 0; bj < 2; ++bj) { f32x4 v0 = acc[ai][bj][m][0], v1 = acc[ai][bj][m][1];
#pragma unroll
                        for (int e = 0; e < 4; ++e) { v0[e] += bv[bj][e]; v1[e] += bv[bj][4 + e]; }
                        const float a0 = v0[0] * cs0[0] - v0[1] * cs0[1], b0 = v0[1] * cs0[0] + v0[0] * cs0[1];
                        const float a1 = v0[2] * cs0[2] - v0[3] * cs0[3], b1 = v0[3] * cs0[2] + v0[2] * cs0[3];
                        const float a2 = v1[0] * cs1[0] - v1[1] * cs1[1], b2 = v1[1] * cs1[0] + v1[0] * cs1[1];
                        const float a3 = v1[2] * cs1[2] - v1[3] * cs1[3], b3 = v1[3] * cs1[2] + v1[2] * cs1[3];
                        u32x4 w; w.x = pk2(a0, b0); w.y = pk2(a1, b1); w.z = pk2(a2, b2); w.w = pk2(a3, b3);
                        *(u32x4*)(rowp + bj * 128) = w; } }
        }
    }
};
enum { RM_IDENT = 0, RM_ROT = 1, RM_PAIR0 = 2, RM_PAIR1 = 3 };
__device__ __forceinline__ int rowmap(int kind, int n) {
    if (kind == RM_ROT) { if (n >= 1280) return n; const int d = n & 63; return (n & ~63) + 2 * (d & 31) + (d >> 5); }
    if (kind == RM_PAIR0) return 2 * n;
    if (kind == RM_PAIR1) return 2 * n + 1;
    return n;
}
__device__ __forceinline__ void transpose_item(const float* __restrict__ W, int ldw, int K, bf16_t* __restrict__ WT, LAS float* scr, int kb, int nb, int lane, int kind, float scale, int nscale) {
    const int k0 = 64 * kb, n0 = 32 * nb;
#pragma unroll 8
    for (int i = 0; i < 32; ++i) { const int kk = 2 * i + (lane >> 5); scr[kk * 33 + (lane & 31)] = W[(size_t)(k0 + kk) * ldw + n0 + (lane & 31)]; }
    __builtin_amdgcn_s_waitcnt(0xc07f); asm volatile("" ::: "memory");
    const int c = lane & 7;
#pragma unroll
    for (int j = 0; j < 4; ++j) { const int n = (lane >> 3) + 8 * j; const LAS float* s = scr + (8 * c) * 33 + n; const float sc = (n0 + n) < nscale ? scale : 1.f;
        u32x4 o; o.x = pk2(s[0 * 33] * sc, s[1 * 33] * sc); o.y = pk2(s[2 * 33] * sc, s[3 * 33] * sc); o.z = pk2(s[4 * 33] * sc, s[5 * 33] * sc); o.w = pk2(s[6 * 33] * sc, s[7 * 33] * sc);
        *(u32x4*)(WT + (size_t)rowmap(kind, n0 + n) * K + k0 + 8 * c) = o; }
    __builtin_amdgcn_s_waitcnt(0xc07f); asm volatile("" ::: "memory");
}
__device__ __forceinline__ void convert_mats(const float* W, int K, int N, int nbat, size_t sstr, bf16_t* WT, size_t dstr, int kind, float scale, int nscale, LAS float* scr, int gw, int ngw, int lane) {
    const int nblk = N / 32, per = (K / 64) * nblk, total = per * nbat;
    for (int it = gw; it < total; it += ngw) { const int bt = it / per, r = it - bt * per; transpose_item(W + (size_t)bt * sstr, N, K, WT + (size_t)bt * dstr, scr, r / nblk, r % nblk, lane, kind, scale, nscale); }
}
__device__ __forceinline__ void convert_rows(const float* __restrict__ src, bf16_t* __restrict__ dst, size_t n, int gt, int ngt) {
    for (size_t i = (size_t)gt * 8; i < n; i += (size_t)ngt * 8) { const f32x4 a = *(const f32x4*)(src + i), b = *(const f32x4*)(src + i + 4);
        u32x4 o; o.x = pk2(a[0], a[1]); o.y = pk2(a[2], a[3]); o.z = pk2(b[0], b[1]); o.w = pk2(b[2], b[3]); *(u32x4*)(dst + i) = o; }
}

struct LnArgs { const float* xin; float* xout; bf16_t* xbf; const bf16_t* y; const float* g; const float* b; const int* dest; const float* wts; int mode; int pad; };
__device__ __forceinline__ void ln_row(const LnArgs& a, int row, int lane) {
    const f32x4* xr = (const f32x4*)(a.xin + (size_t)row * DM) + lane;
    f32x4 v[4]; float s = 0.f;
    if (a.mode == 0) {
        const u32x2* yr = (const u32x2*)(a.y + (size_t)row * DM) + lane;
#pragma unroll
        for (int j = 0; j < 4; ++j) { const f32x4 x = xr[64 * j]; const u32x2 y = yr[64 * j];
            v[j] = (f32x4){ALPHA * x[0] + bf_lo(y.x), ALPHA * x[1] + bf_hi(y.x), ALPHA * x[2] + bf_lo(y.y), ALPHA * x[3] + bf_hi(y.y)}; }
    } else {
        const int d0 = a.dest[row * 2], d1 = a.dest[row * 2 + 1]; const float w0 = a.wts[row * 2], w1 = a.wts[row * 2 + 1];
        const u32x2* y0 = (const u32x2*)(a.y + (size_t)d0 * DM) + lane; const u32x2* y1 = (const u32x2*)(a.y + (size_t)d1 * DM) + lane;
#pragma unroll
        for (int j = 0; j < 4; ++j) { const f32x4 x = xr[64 * j]; const u32x2 p = y0[64 * j], q = y1[64 * j];
            v[j] = (f32x4){ALPHA * x[0] + w0 * bf_lo(p.x) + w1 * bf_lo(q.x), ALPHA * x[1] + w0 * bf_hi(p.x) + w1 * bf_hi(q.x),
                           ALPHA * x[2] + w0 * bf_lo(p.y) + w1 * bf_lo(q.y), ALPHA * x[3] + w0 * bf_hi(p.y) + w1 * bf_hi(q.y)}; }
    }
#pragma unroll
    for (int j = 0; j < 4; ++j) s += (v[j][0] + v[j][1]) + (v[j][2] + v[j][3]);
    const float mean = wave_sum(s) * (1.f / DM); float q = 0.f;
#pragma unroll
    for (int j = 0; j < 4; ++j) { v[j] = v[j] - mean; q += (v[j][0] * v[j][0] + v[j][1] * v[j][1]) + (v[j][2] * v[j][2] + v[j][3] * v[j][3]); }
    const float rstd = rsqrtf(wave_sum(q) * (1.f / DM) + LN_EPS);
    f32x4* xo = (f32x4*)(a.xout + (size_t)row * DM) + lane; u32x2* bo = (u32x2*)(a.xbf + (size_t)row * DM) + lane;
    const f32x4* gp = (const f32x4*)a.g + lane; const f32x4* bp = (const f32x4*)a.b + lane;
#pragma unroll
    for (int j = 0; j < 4; ++j) { const f32x4 o = v[j] * rstd * gp[64 * j] + bp[64 * j]; xo[64 * j] = o; u32x2 w; w.x = pk2(o[0], o[1]); w.y = pk2(o[2], o[3]); bo[64 * j] = w; }
}
__device__ __forceinline__ void ln_phase(const LnArgs& a, int blk, int G, int wave, int lane) {
    const int per = NT / G, r0 = blk * per;
    for (int r = wave; r < per; r += NWAVE) ln_row(a, r0 + r, lane);
}
__device__ __forceinline__ void xattn_phase(LAS unsigned char* lds, const bf16_t* __restrict__ Q, const bf16_t* __restrict__ KC, const bf16_t* __restrict__ VT, bf16_t* __restrict__ O, int blk, int G) {
    int tid_ = threadIdx.x; asm volatile("" : "+v"(tid_)); const int tid = tid_, lane = tid & 63, wave = __builtin_amdgcn_readfirstlane(tid >> 6), r32 = lane & 31, hh = lane >> 5;
    for (int u = blk; u < 512; u += G) {
        const int qb = u & 15, h = (u >> 4) & 3, b = u >> 6;
        const size_t qrow = (size_t)b * SEQ + qb * 256 + wave * 32 + r32;
        __syncthreads();
#pragma unroll
        for (int bt = 0; bt < 2; ++bt) {
            u32x4 t[8];
#pragma unroll
            for (int i = 0; i < 8; ++i) { const int ch = tid + 512 * (bt * 8 + i), row = ch >> 5, c = ch & 31; t[i] = *(const u32x4*)(KC + (size_t)(b * 256 + row) * 1024 + h * 256 + c * 8); }
#pragma unroll
            for (int i = 0; i < 8; ++i) { const int ch = tid + 512 * (bt * 8 + i), row = ch >> 5, c = ch & 31; *(LAS u32x4*)(lds + row * 528 + c * 16) = t[i]; }
        }
        __syncthreads();
        f32x16 s[8];
#pragma unroll
        for (int mt = 0; mt < 8; ++mt)
#pragma unroll
            for (int r = 0; r < 16; ++r) s[mt][r] = 0.f;
#pragma unroll 1
        for (int kq = 0; kq < 4; ++kq) {
            bf16x8 qf[4];
#pragma unroll
            for (int ks = 0; ks < 4; ++ks) qf[ks] = *(const bf16x8*)(Q + qrow * 1024 + h * 256 + (kq * 4 + ks) * 16 + hh * 8);
            const LAS unsigned char* kbp = lds + r32 * 528 + (kq * 64 + hh * 8) * 2;
#pragma unroll
            for (int ks = 0; ks < 4; ++ks)
#pragma unroll
                for (int mt = 0; mt < 8; ++mt) { const bf16x8 a = *(const LAS bf16x8*)(kbp + mt * 32 * 528 + ks * 32); s[mt] = MFMA32(a, qf[ks], s[mt]); }
        }
        float mx = -INFINITY;
#pragma unroll
        for (int mt = 0; mt < 8; ++mt)
#pragma unroll
            for (int r = 0; r < 16; ++r) mx = fmaxf(mx, s[mt][r]);
        mx = xhalf_max(mx);
        float sm = 0.f; const float mxl = mx * LOG2E;
        u32x4 pf[8][2];
#pragma unroll
        for (int mt = 0; mt < 8; ++mt) {
#pragma unroll
            for (int r = 0; r < 16; ++r) { const float p = __builtin_amdgcn_exp2f(s[mt][r] * LOG2E - mxl); s[mt][r] = p; sm += p; }
#pragma unroll
            for (int sx = 0; sx < 2; ++sx) pf[mt][sx] = (u32x4){pk2(s[mt][8 * sx], s[mt][8 * sx + 1]), pk2(s[mt][8 * sx + 2], s[mt][8 * sx + 3]), pk2(s[mt][8 * sx + 4], s[mt][8 * sx + 5]), pk2(s[mt][8 * sx + 6], s[mt][8 * sx + 7])};
        }
        sm = xhalf_sum(sm);
        __syncthreads();
#pragma unroll
        for (int bt = 0; bt < 4; ++bt) {
            u32x4 t[4];
#pragma unroll
            for (int i = 0; i < 4; ++i) { const int ch = tid + 512 * (bt * 4 + i), row = ch >> 5, c = ch & 31; t[i] = *(const u32x4*)(VT + (size_t)(h * 256 + row) * 2048 + b * 256 + c * 8); }
#pragma unroll
            for (int i = 0; i < 4; ++i) { const int ch = tid + 512 * (bt * 4 + i), row = ch >> 5, c = ch & 31; LAS u32x2* d = (LAS u32x2*)(lds + row * 520 + c * 16); d[0] = (u32x2){t[i].x, t[i].y}; d[1] = (u32x2){t[i].z, t[i].w}; }
        }
        __syncthreads();
        const float inv = 1.f / sm;
        bf16_t* orow = O + qrow * 1024 + h * 256 + 4 * hh;
#pragma unroll 1
        for (int dh = 0; dh < 2; ++dh) {
            f32x16 o[4];
#pragma unroll
            for (int dt = 0; dt < 4; ++dt)
#pragma unroll
                for (int r = 0; r < 16; ++r) o[dt][r] = 0.f;
            const LAS unsigned char* vb = lds + (dh * 128 + r32) * 520 + 8 * hh;
#pragma unroll
            for (int mt = 0; mt < 8; ++mt)
#pragma unroll
                for (int sx = 0; sx < 2; ++sx) { const int kb = mt * 32 + 16 * sx; const bf16x8 pb = __builtin_bit_cast(bf16x8, pf[mt][sx]);
#pragma unroll
                    for (int dt = 0; dt < 4; ++dt) { const LAS unsigned char* q = vb + dt * 32 * 520 + kb * 2;
                        const s16x4 lo = *(const LAS s16x4*)q, hi = *(const LAS s16x4*)(q + 16);
                        const bf16x8 a = (bf16x8){lo[0], lo[1], lo[2], lo[3], hi[0], hi[1], hi[2], hi[3]}; o[dt] = MFMA32(a, pb, o[dt]); } }
#pragma unroll
            for (int dt = 0; dt < 4; ++dt)
#pragma unroll
                for (int g = 0; g < 4; ++g) { u32x2 w; w.x = pk2(o[dt][4 * g] * inv, o[dt][4 * g + 1] * inv); w.y = pk2(o[dt][4 * g + 2] * inv, o[dt][4 * g + 3] * inv); *(u32x2*)(orow + dh * 128 + dt * 32 + 8 * g) = w; }
        }
    }
}

struct RouteBufs { int* e; float* w; int* rank; int* dest; int* hist; int* tstart; };
__device__ __forceinline__ void moe_router_phase(LAS unsigned char* lds, const bf16_t* __restrict__ XBF, const bf16_t* __restrict__ WRT, const float* __restrict__ brg, const float* __restrict__ bre, const RouteBufs rb, int blk) {
    int tid_ = threadIdx.x; asm volatile("" : "+v"(tid_)); const int tid = tid_, lane = tid & 63, wave = __builtin_amdgcn_readfirstlane(tid >> 6), r32 = lane & 31, hh = lane >> 5;
    LAS float* LG = (LAS float*)lds;
    LAS int* hist = (LAS int*)(lds + 128 * 65 * 4);
    __syncthreads();
    if (tid < 32) hist[tid] = 0;
    const int rbk = wave & 3, ct = wave >> 2;
    const size_t row = (size_t)blk * 128 + rbk * 32 + r32;
    f32x16 acc;
#pragma unroll
    for (int r = 0; r < 16; ++r) acc[r] = 0.f;
    const bf16_t* ap = XBF + row * 1024 + hh * 8; const bf16_t* bh = WRT + (size_t)(ct * 32 + r32) * 1024 + hh * 8; const bf16_t* bl = bh + 64 * 1024;
#pragma unroll 8
    for (int ks = 0; ks < 64; ++ks) { const bf16x8 a = *(const bf16x8*)(ap + ks * 16), b0 = *(const bf16x8*)(bh + ks * 16), b1 = *(const bf16x8*)(bl + ks * 16);
        acc = MFMA32(a, b0, acc); acc = MFMA32(a, b1, acc); }
#pragma unroll
    for (int r = 0; r < 16; ++r) LG[(rbk * 32 + crow(r, hh)) * 65 + ct * 32 + r32] = acc[r];
    __syncthreads();
    if (tid < 128) {
        const LAS float* lg = LG + tid * 65; const int tok = blk * 128 + tid;
        float g4[4];
#pragma unroll
        for (int g = 0; g < 4; ++g) g4[g] = lg[32 + g] + brg[g];
        int gi = 0; float gm = g4[0];
#pragma unroll
        for (int g = 1; g < 4; ++g) if (g4[g] > gm) { gm = g4[g]; gi = g; }
        float gs = 0.f;
#pragma unroll
        for (int g = 0; g < 4; ++g) gs += fast_exp(g4[g] - gm);
        const float gate_g = 1.f / gs;
        float le[8];
#pragma unroll
        for (int e = 0; e < 8; ++e) le[e] = lg[gi * 8 + e] + bre[gi * 8 + e];
        int i0 = 0; float v0 = le[0];
#pragma unroll
        for (int e = 1; e < 8; ++e) if (le[e] > v0) { v0 = le[e]; i0 = e; }
        int i1 = 0; float v1 = -INFINITY;
#pragma unroll
        for (int e = 0; e < 8; ++e) if (e != i0 && le[e] > v1) { v1 = le[e]; i1 = e; }
        const float e1 = fast_exp(v1 - v0), p0 = 1.f / (1.f + e1), p1 = e1 * p0;
        const int ex0 = gi * 8 + i0, ex1 = gi * 8 + i1;
        rb.e[tok * 2] = ex0; rb.e[tok * 2 + 1] = ex1; rb.w[tok * 2] = gate_g * p0; rb.w[tok * 2 + 1] = gate_g * p1;
        rb.rank[tok * 2] = atomicAdd((int*)&hist[ex0], 1); rb.rank[tok * 2 + 1] = atomicAdd((int*)&hist[ex1], 1);
    }
    __syncthreads();
    if (tid < 32) rb.hist[blk * 32 + tid] = hist[tid];
}
__device__ __forceinline__ void moe_scatter_phase(LAS unsigned char* lds, const bf16_t* __restrict__ XBF, bf16_t* __restrict__ XG, const RouteBufs rb, int blk, int G) {
    int tid_ = threadIdx.x; asm volatile("" : "+v"(tid_)); const int tid = tid_, lane = tid & 63, wave = __builtin_amdgcn_readfirstlane(tid >> 6);
    LAS int* sb = (LAS int*)lds;
    __syncthreads();
    if (tid < 32) { int tot = 0, base = 0; for (int b = 0; b < G; ++b) { const int c = rb.hist[b * 32 + tid]; tot += c; if (b < blk) base += c; } sb[tid] = base; sb[32 + tid] = tot; }
    __syncthreads();
    if (tid == 0) { int acc = 0; for (int e = 0; e < 32; ++e) { sb[64 + e] = acc; if (blk == 0) rb.tstart[e] = acc >> 8; acc += (sb[32 + e] + 255) & ~255; } sb[96] = acc; if (blk == 0) rb.tstart[32] = acc >> 8; }
    __syncthreads();
    for (int a = wave; a < 256; a += NWAVE) {
        const int idx = blk * 256 + a; const int e = rb.e[idx]; const int d = sb[64 + e] + sb[e] + rb.rank[idx];
        if (lane == 0) rb.dest[idx] = d;
        const u32x4* src = (const u32x4*)(XBF + (size_t)(idx >> 1) * 1024) + lane; u32x4* dst = (u32x4*)(XG + (size_t)d * 1024) + lane;
        const u32x4 v0 = src[0], v1 = src[64]; dst[0] = v0; dst[64] = v1;
    }
}
struct MoeSched {
    const char* A; const char* B; const int* tstart; int K, nN, G, c; size_t bexp;
    __device__ __forceinline__ bool next(int i, pg8::Unit& u) const {
        const int vc = (c & 7) * (G >> 3) + (c >> 3);
        const long L = (long)i * G + vc; const int ntile = tstart[32];
        if (L >= (long)ntile * nN) return false;
        const int mt = (int)(L / nN), nt = (int)(L % nN);
        int e = 0;
        for (int k = 1; k < 32; ++k) if (tstart[k] <= mt) e = k;
        u.A = A + (size_t)mt * 256 * K * 2; u.B = B + (size_t)e * bexp + (size_t)nt * 256 * K * 2; u.pm = mt; u.pn = nt; u.job = 0; return true;
    }
};
__device__ __forceinline__ void swa_phase(LAS unsigned char* lds, const bf16_t* __restrict__ Q1, const bf16_t* __restrict__ K1, const bf16_t* __restrict__ VT1, const float* __restrict__ sinks, bf16_t* __restrict__ O, int blk, int G) {
    int tid_ = threadIdx.x; asm volatile("" : "+v"(tid_)); const int tid = tid_, lane = tid & 63, wave = __builtin_amdgcn_readfirstlane(tid >> 6), r32 = lane & 31, hh = lane >> 5;
    LAS unsigned char* KL = lds;
    LAS unsigned char* VL = lds + 36864;
    for (int u = blk; u < 1024; u += G) {
        const int n = u & 31, kvh = (u >> 5) & 3, b = u >> 7;
        const int tokb = b * SEQ + (n - 1) * 128;
        __syncthreads();
#pragma unroll
        for (int i = 0; i < 4; ++i) { const int ch = tid + 512 * i; const int key = ch >> 3, c = ch & 7;
            u32x4 v = (u32x4){0u, 0u, 0u, 0u}; if (n > 0 || key >= 128) v = *(const u32x4*)(K1 + (size_t)(tokb + key) * 256 + kvh * 64 + c * 8);
            *(LAS u32x4*)(KL + key * 144 + c * 16) = v; }
#pragma unroll
        for (int i = 0; i < 4; ++i) { const int ch = tid + 512 * i; const int d = ch >> 5, c = ch & 31;
            u32x4 v = (u32x4){0u, 0u, 0u, 0u}; if (n > 0 || c >= 16) v = *(const u32x4*)(VT1 + (size_t)(kvh * 64 + d) * NT + tokb + c * 8);
            LAS u32x2* dp = (LAS u32x2*)(VL + d * 520 + c * 16); dp[0] = (u32x2){v.x, v.y}; dp[1] = (u32x2){v.z, v.w}; }
        __syncthreads();
        const int g = wave >> 1, hq = kvh * 4 + g; const float sink = sinks[hq];
#pragma unroll 1
        for (int sb = 0; sb < 2; ++sb) {
            const int i0 = (wave & 1) * 64 + sb * 32, jt0 = i0 >> 5;
            const size_t qtok = (size_t)b * SEQ + n * 128 + i0 + r32;
            bf16x8 qf[4];
#pragma unroll
            for (int ks = 0; ks < 4; ++ks) qf[ks] = *(const bf16x8*)(Q1 + qtok * 1024 + hq * 64 + ks * 16 + hh * 8);
            f32x16 s[5];
#pragma unroll
            for (int t = 0; t < 5; ++t) {
#pragma unroll
                for (int r = 0; r < 16; ++r) s[t][r] = 0.f;
                const LAS unsigned char* kp = KL + ((jt0 + t) * 32 + r32) * 144 + hh * 16;
#pragma unroll
                for (int ks = 0; ks < 4; ++ks) { const bf16x8 a = *(const LAS bf16x8*)(kp + ks * 32); s[t] = MFMA32(a, qf[ks], s[t]); }
            }
            const int qi = i0 + r32;
            float mx = sink;
#pragma unroll
            for (int t = 0; t < 5; ++t)
#pragma unroll
                for (int r = 0; r < 16; ++r) { const int kj = (jt0 + t) * 32 + crow(r, hh); const bool valid = (kj > qi) && (kj <= qi + 128) && (n > 0 || kj >= 128);
                    s[t][r] = valid ? s[t][r] : -INFINITY; mx = fmaxf(mx, s[t][r]); }
            mx = xhalf_max(mx);
            float sm = 0.f; const float mxl = mx * LOG2E;
            u32x4 pf[5][2];
#pragma unroll
            for (int t = 0; t < 5; ++t) {
#pragma unroll
                for (int r = 0; r < 16; ++r) { const float pv = __builtin_amdgcn_exp2f(s[t][r] * LOG2E - mxl); s[t][r] = pv; sm += pv; }
#pragma unroll
                for (int sx = 0; sx < 2; ++sx) pf[t][sx] = (u32x4){pk2(s[t][8 * sx], s[t][8 * sx + 1]), pk2(s[t][8 * sx + 2], s[t][8 * sx + 3]), pk2(s[t][8 * sx + 4], s[t][8 * sx + 5]), pk2(s[t][8 * sx + 6], s[t][8 * sx + 7])};
            }
            sm = xhalf_sum(sm) + __builtin_amdgcn_exp2f(sink * LOG2E - mxl);
            f32x16 o[2];
#pragma unroll
            for (int dt = 0; dt < 2; ++dt)
#pragma unroll
                for (int r = 0; r < 16; ++r) o[dt][r] = 0.f;
#pragma unroll
            for (int t = 0; t < 5; ++t)
#pragma unroll
                for (int sx = 0; sx < 2; ++sx) { const bf16x8 pb = __builtin_bit_cast(bf16x8, pf[t][sx]);
#pragma unroll
                    for (int dt = 0; dt < 2; ++dt) { const LAS unsigned char* q = VL + (dt * 32 + r32) * 520 + ((jt0 + t) * 32 + 16 * sx + 4 * hh) * 2;
                        const s16x4 lo = *(const LAS s16x4*)q, hi = *(const LAS s16x4*)(q + 16);
                        const bf16x8 a = (bf16x8){lo[0], lo[1], lo[2], lo[3], hi[0], hi[1], hi[2], hi[3]}; o[dt] = MFMA32(a, pb, o[dt]); } }
            const float inv = 1.f / sm;
            bf16_t* orow = O + qtok * 1024 + hq * 64 + 4 * hh;
#pragma unroll
            for (int dt = 0; dt < 2; ++dt)
#pragma unroll
                for (int gq = 0; gq < 4; ++gq) { u32x2 w; w.x = pk2(o[dt][4 * gq] * inv, o[dt][4 * gq + 1] * inv); w.y = pk2(o[dt][4 * gq + 2] * inv, o[dt][4 * gq + 3] * inv); *(u32x2*)(orow + dt * 32 + 8 * gq) = w; }
        }
    }
}
constexpr int TS = 272;
__device__ __forceinline__ bf16x8 tr_frag(const LAS unsigned char* T, int k0, int c0, int lane, bool permuted) {
    const int hh = lane >> 5, blk = (lane >> 4) & 1, q = (lane & 15) >> 2, pp = lane & 3;
    const int r0 = k0 + (permuted ? 4 * hh : 8 * hh) + q, r1 = r0 + (permuted ? 8 : 4);
    const int cb = (c0 + 16 * blk + 4 * pp) * 2;
    const s16x4 lo = lds_tr(T + r0 * TS + cb), hi = lds_tr(T + r1 * TS + cb);
    return (bf16x8){lo[0], lo[1], lo[2], lo[3], hi[0], hi[1], hi[2], hi[3]};
}
__device__ __forceinline__ bf16x8 row_frag(const LAS unsigned char* T, int row, int k0, int hh) { return *(const LAS bf16x8*)(T + row * TS + (k0 + 8 * hh) * 2); }
__device__ __forceinline__ void load_tile128(LAS unsigned char* T, const bf16_t* __restrict__ g, int ld, int tid) {
#pragma unroll
    for (int i = 0; i < 4; ++i) { const int ch = tid + 512 * i, row = ch >> 4, c = ch & 15; *(LAS u32x4*)(T + row * TS + c * 16) = *(const u32x4*)(g + (size_t)row * ld + c * 8); }
}
struct L0Bufs {
    bf16_t *AU, *AV, *BX, *BZ, *V, *XC, *YM, *CS; float *U, *GT, *UN, *NS, *SC;
    const bf16_t *WQT, *GMW, *WIFT; const float *gm_g, *gm_b, *gm_bs, *cw, *cb, *bif, *nw, *skip;
};

__device__ __forceinline__ void l0_mixA(LAS unsigned char* lds, const L0Bufs& B, int blk, int G) {
    int tid_ = threadIdx.x; asm volatile("" : "+v"(tid_)); const int tid = tid_, lane = tid & 63, wave = __builtin_amdgcn_readfirstlane(tid >> 6), r32 = lane & 31, hh = lane >> 5;
    LAS unsigned char* T0 = lds; LAS unsigned char* T1 = lds + 34816; LAS unsigned char* T2 = lds + 2 * 34816; LAS unsigned char* T3 = lds + 3 * 34816;
    LAS float* SF = (LAS float*)T2;
    LAS float* SG = (LAS float*)(lds + 3 * 34816 + 35632);
    for (int u = blk; u < 256; u += G) {
        const int tok0 = u * 128; const bool first = (u & 31) == 0;
        const int trow = tid >> 2, q4 = tid & 3;
        float mean, rstd;
        {   const bf16_t* vr = B.AV + (size_t)(tok0 + trow) * 512 + q4 * 128; float s = 0.f, s2 = 0.f;
#pragma unroll
            for (int i = 0; i < 16; ++i) { const u32x4 w = *(const u32x4*)(vr + i * 8);
                const float f[8] = {bf_lo(w.x), bf_hi(w.x), bf_lo(w.y), bf_hi(w.y), bf_lo(w.z), bf_hi(w.z), bf_lo(w.w), bf_hi(w.w)};
#pragma unroll
                for (int e = 0; e < 8; ++e) { s += f[e]; s2 += f[e] * f[e]; } }
            s += __shfl_xor(s, 1); s += __shfl_xor(s, 2); s2 += __shfl_xor(s2, 1); s2 += __shfl_xor(s2, 2);
            mean = s * (1.f / 512.f); rstd = rsqrtf(fmaxf(s2 * (1.f / 512.f) - mean * mean, 0.f) + LN_EPS); }
#pragma unroll 1
        for (int g = 0; g < 4; ++g) {
            __syncthreads();
            load_tile128(T0, B.GMW + (size_t)g * 128 * 128, 128, tid);
            {   const int cbase = g * 128 + q4 * 32; const bf16_t* vr = B.AV + (size_t)(tok0 + trow) * 512 + cbase;
#pragma unroll
                for (int i = 0; i < 4; ++i) { const u32x4 w = *(const u32x4*)(vr + i * 8); const f32x4 g0 = *(const f32x4*)(B.gm_g + cbase + i * 8), g1 = *(const f32x4*)(B.gm_g + cbase + i * 8 + 4), b0 = *(const f32x4*)(B.gm_b + cbase + i * 8), b1 = *(const f32x4*)(B.gm_b + cbase + i * 8 + 4);
                    u32x4 o; o.x = pk2((bf_lo(w.x) - mean) * rstd * g0[0] + b0[0], (bf_hi(w.x) - mean) * rstd * g0[1] + b0[1]); o.y = pk2((bf_lo(w.y) - mean) * rstd * g0[2] + b0[2], (bf_hi(w.y) - mean) * rstd * g0[3] + b0[3]);
                    o.z = pk2((bf_lo(w.z) - mean) * rstd * g1[0] + b1[0], (bf_hi(w.z) - mean) * rstd * g1[1] + b1[1]); o.w = pk2((bf_lo(w.w) - mean) * rstd * g1[2] + b1[2], (bf_hi(w.w) - mean) * rstd * g1[3] + b1[3]);
                    *(LAS u32x4*)(T1 + trow * TS + (q4 * 32 + i * 8) * 2) = o; } }
            __syncthreads();
            const int tb = wave & 3, dhf = wave >> 2;
            f32x16 acc[2];
#pragma unroll
            for (int dt = 0; dt < 2; ++dt)
#pragma unroll
                for (int r = 0; r < 16; ++r) acc[dt][r] = 0.f;
            for (int ks = 0; ks <= 2 * tb + 1; ++ks) { const bf16x8 bw = row_frag(T0, 32 * tb + r32, 16 * ks, hh);
#pragma unroll
                for (int dt = 0; dt < 2; ++dt) { const bf16x8 a = tr_frag(T1, 16 * ks, 64 * dhf + 32 * dt, lane, false); acc[dt] = MFMA32(a, bw, acc[dt]); } }
            const int t = 32 * tb + r32; const float bsv = B.gm_bs[g * 128 + t];
            const size_t tok = (size_t)tok0 + t;
#pragma unroll
            for (int dt = 0; dt < 2; ++dt)
#pragma unroll
                for (int gq = 0; gq < 4; ++gq) { const int col = g * 128 + 64 * dhf + 32 * dt + 8 * gq + 4 * hh; const u32x2 au = *(const u32x2*)(B.AU + tok * 512 + col);
                    u32x2 w; w.x = pk2(bf_lo(au.x) * (acc[dt][4 * gq] + bsv), bf_hi(au.x) * (acc[dt][4 * gq + 1] + bsv)); w.y = pk2(bf_lo(au.y) * (acc[dt][4 * gq + 2] + bsv), bf_hi(au.y) * (acc[dt][4 * gq + 3] + bsv));
                    *(u32x2*)(B.YM + tok * 1024 + col) = w; }
        }
#pragma unroll 1
        for (int h = 0; h < 4; ++h) {
            __syncthreads();
            for (int ch = tid; ch < 131 * 16; ch += 512) { const int row = ch >> 4, c = ch & 15; u32x4 v = (u32x4){0u, 0u, 0u, 0u};
                if (!(first && row < 3)) v = *(const u32x4*)(B.BX + (size_t)(tok0 - 3 + row) * 512 + h * 128 + c * 8);
                *(LAS u32x4*)(T3 + row * TS + c * 16) = v; }
            __syncthreads();
            {   const int dc = tid & 15, chn = h * 128 + dc * 8; float w[4][8], cbv[8];
#pragma unroll
                for (int j = 0; j < 4; ++j)
#pragma unroll
                    for (int e = 0; e < 8; ++e) w[j][e] = B.cw[j * 512 + chn + e];
#pragma unroll
                for (int e = 0; e < 8; ++e) cbv[e] = B.cb[chn + e];
#pragma unroll 1
                for (int ps = 0; ps < 4; ++ps) { const int t = ps * 32 + (tid >> 4); float a[8];
#pragma unroll
                    for (int e = 0; e < 8; ++e) a[e] = cbv[e];
#pragma unroll
                    for (int j = 0; j < 4; ++j) { const u32x4 x = *(const LAS u32x4*)(T3 + (t + j) * TS + dc * 16);
                        a[0] += w[j][0] * bf_lo(x.x); a[1] += w[j][1] * bf_hi(x.x); a[2] += w[j][2] * bf_lo(x.y); a[3] += w[j][3] * bf_hi(x.y);
                        a[4] += w[j][4] * bf_lo(x.z); a[5] += w[j][5] * bf_hi(x.z); a[6] += w[j][6] * bf_lo(x.w); a[7] += w[j][7] * bf_hi(x.w); }
                    u32x4 o; o.x = pk2(silu_f(a[0]), silu_f(a[1])); o.y = pk2(silu_f(a[2]), silu_f(a[3])); o.z = pk2(silu_f(a[4]), silu_f(a[5])); o.w = pk2(silu_f(a[6]), silu_f(a[7]));
                    *(LAS u32x4*)(T2 + t * TS + dc * 16) = o; *(u32x4*)(B.XC + (size_t)(tok0 + t) * 512 + chn) = o; } }
#pragma unroll 1
            for (int mtx = 0; mtx < 3; ++mtx) {
                __syncthreads();
                load_tile128(T0, B.WQT + ((size_t)mtx * 4 + h) * 128 * 128, 128, tid);
                __syncthreads();
                const int tb = wave & 3, ehf = wave >> 2; const LAS unsigned char* act = mtx == 2 ? T3 + 3 * TS : T2;
                f32x16 acc[2];
#pragma unroll
                for (int et = 0; et < 2; ++et)
#pragma unroll
                    for (int r = 0; r < 16; ++r) acc[et][r] = 0.f;
#pragma unroll
                for (int ks = 0; ks < 8; ++ks) { const bf16x8 bx = row_frag(act, 32 * tb + r32, 16 * ks, hh);
#pragma unroll
                    for (int et = 0; et < 2; ++et) { const bf16x8 a = row_frag(T0, 64 * ehf + 32 * et + r32, 16 * ks, hh); acc[et] = MFMA32(a, bx, acc[et]); } }
                bf16_t* dst = (mtx == 0 ? B.AU : (mtx == 1 ? B.AV : B.V)) + (size_t)(tok0 + 32 * tb + r32) * 512 + h * 128 + 64 * ehf + 4 * hh;
#pragma unroll
                for (int et = 0; et < 2; ++et)
#pragma unroll
                    for (int gq = 0; gq < 4; ++gq) { u32x2 w; w.x = pk2(acc[et][4 * gq], acc[et][4 * gq + 1]); w.y = pk2(acc[et][4 * gq + 2], acc[et][4 * gq + 3]); *(u32x2*)(dst + 32 * et + 8 * gq) = w; }
            }
        }
        __threadfence(); __syncthreads();
        {
            const int tb = wave & 3, kh = wave >> 2; f32x16 acc;
#pragma unroll
            for (int r = 0; r < 16; ++r) acc[r] = 0.f;
            const size_t tok = (size_t)tok0 + 32 * tb + r32;
#pragma unroll 4
            for (int ks = 0; ks < 48; ++ks) { const int i0 = kh * 768 + ks * 16 + 8 * hh;
                const bf16_t* src = i0 < 512 ? B.AU + tok * 512 + i0 : (i0 < 1024 ? B.AV + tok * 512 + (i0 - 512) : B.V + tok * 512 + (i0 - 1024));
                const bf16x8 bx = *(const bf16x8*)src; const bf16x8 a = *(const bf16x8*)(B.WIFT + (size_t)r32 * 1536 + i0); acc = MFMA32(a, bx, acc); }
#pragma unroll
            for (int r = 0; r < 4; ++r) SF[(kh * 8 + r + 4 * hh) * 128 + 32 * tb + r32] = acc[r];
        }
        __syncthreads();
        LAS float* IG = SG; LAS float* BC = SG + 512; LAS float* WG = SG + 1024;
        if (wave < 4) {
            const int h = wave; float lf[2], ig[2];
#pragma unroll
            for (int e = 0; e < 2; ++e) { const int t = 2 * lane + e; ig[e] = SF[h * 128 + t] + SF[(8 + h) * 128 + t] + B.bif[h];
                const float fx = SF[(4 + h) * 128 + t] + SF[(12 + h) * 128 + t] + B.bif[4 + h]; lf[e] = fminf(fx, 0.f) - log1pf(expf(-fabsf(fx))); }
            float run = lf[0] + lf[1];
#pragma unroll
            for (int o = 1; o < 64; o <<= 1) { const float v = __shfl_up(run, o); if (lane >= o) run += v; }
            const float b1 = run, b0 = run - lf[1];
            IG[h * 128 + 2 * lane] = ig[0]; IG[h * 128 + 2 * lane + 1] = ig[1]; BC[h * 128 + 2 * lane] = b0; BC[h * 128 + 2 * lane + 1] = b1;
            float* gt = B.GT + ((size_t)u * 4 + h) * 256;
            gt[2 * lane] = ig[0]; gt[2 * lane + 1] = ig[1]; gt[128 + 2 * lane] = b0; gt[128 + 2 * lane + 1] = b1;
            const float bl = __shfl(b1, 63);
            float g0 = bl - b0 + ig[0], g1 = bl - b1 + ig[1]; float mloc = fmaxf(g0, g1);
#pragma unroll
            for (int o = 1; o < 64; o <<= 1) mloc = fmaxf(mloc, __shfl_xor(mloc, o));
            WG[h * 128 + 2 * lane] = expf(g0 - mloc); WG[h * 128 + 2 * lane + 1] = expf(g1 - mloc);
            if (lane == 0) { B.SC[u * 4 + h] = bl; B.SC[1024 + u * 4 + h] = mloc; }
        }
#pragma unroll 1
        for (int h = 0; h < 4; ++h) {
            __syncthreads();
#pragma unroll
            for (int i = 0; i < 4; ++i) { const int ch = tid + 512 * i, row = ch >> 4, c = ch & 15; const float wg = WG[h * 128 + row];
                const u32x4 v = *(const u32x4*)(B.V + (size_t)(tok0 + row) * 512 + h * 128 + c * 8), k = *(const u32x4*)(B.AV + (size_t)(tok0 + row) * 512 + h * 128 + c * 8);
                u32x4 ov, ok; const float ksc = 0.08838834764831845f;
                ov.x = pk2(bf_lo(v.x) * wg, bf_hi(v.x) * wg); ov.y = pk2(bf_lo(v.y) * wg, bf_hi(v.y) * wg); ov.z = pk2(bf_lo(v.z) * wg, bf_hi(v.z) * wg); ov.w = pk2(bf_lo(v.w) * wg, bf_hi(v.w) * wg);
                ok.x = pk2(bf_lo(k.x) * ksc, bf_hi(k.x) * ksc); ok.y = pk2(bf_lo(k.y) * ksc, bf_hi(k.y) * ksc); ok.z = pk2(bf_lo(k.z) * ksc, bf_hi(k.z) * ksc); ok.w = pk2(bf_lo(k.w) * ksc, bf_hi(k.w) * ksc);
                *(LAS u32x4*)(T0 + row * TS + c * 16) = ov; *(LAS u32x4*)(T1 + row * TS + c * 16) = ok; }
            __syncthreads();
            const int vb = wave & 3, khf = wave >> 2;
            f32x16 acc[2];
#pragma unroll
            for (int kt = 0; kt < 2; ++kt)
#pragma unroll
                for (int r = 0; r < 16; ++r) acc[kt][r] = 0.f;
#pragma unroll
            for (int ks = 0; ks < 8; ++ks) { const bf16x8 a = tr_frag(T0, 16 * ks, 32 * vb, lane, false);
#pragma unroll
                for (int kt = 0; kt < 2; ++kt) { const bf16x8 bk = tr_frag(T1, 16 * ks, 64 * khf + 32 * kt, lane, false); acc[kt] = MFMA32(a, bk, acc[kt]); } }
            float* Uo = B.U + ((size_t)u * 4 + h) * 16384;
#pragma unroll
            for (int kt = 0; kt < 2; ++kt)
#pragma unroll
                for (int r = 0; r < 16; ++r) Uo[(32 * vb + crow(r, hh)) * 128 + 64 * khf + 32 * kt + r32] = acc[kt][r];
            {   const int kk = tid & 127, sq = tid >> 7; float a = 0.f;
                for (int s = sq * 32; s < sq * 32 + 32; ++s) a += WG[h * 128 + s] * bf2f(*(const LAS bf16_t*)(T1 + s * TS + kk * 2));
                SF[2048 + sq * 128 + kk] = a; }
            __syncthreads();
            if (tid < 128) B.UN[((size_t)u * 4 + h) * 128 + tid] = (SF[2048 + tid] + SF[2048 + 128 + tid]) + (SF[2048 + 256 + tid] + SF[2048 + 384 + tid]);
        }
    }
}
__device__ __forceinline__ void l0_scan(const L0Bufs& B, int blk) {
    int tid_ = threadIdx.x; asm volatile("" : "+v"(tid_)); const int tid = tid_, bh = blk >> 3, part = blk & 7, b = bh >> 2, h = bh & 3;
    const int e0 = part * 2048 + tid * 4;
    f32x4 C = (f32x4){0.f, 0.f, 0.f, 0.f}; float nst = 0.f; float m = 0.f;
    for (int c = 0; c < 32; ++c) {
        const int unit = (b * 32 + c) * 4 + h;
        const float bl = B.SC[unit], mloc = B.SC[1024 + unit];
        u32x2 w; w.x = pk2(C[0], C[1]); w.y = pk2(C[2], C[3]); *(u32x2*)(B.CS + (size_t)unit * 16384 + e0) = w;
        if (part == 0 && tid < 128) B.NS[(size_t)unit * 128 + tid] = nst;
        if (part == 0 && tid == 0) B.SC[2048 + unit] = m;
        const float mn = fmaxf(bl + m, mloc), dec = expf(bl + m - mn), wu = expf(mloc - mn); m = mn;
        const f32x4 U = *(const f32x4*)(B.U + (size_t)unit * 16384 + e0);
        C = C * dec + U * wu;
        if (part == 0 && tid < 128) nst = nst * dec + wu * B.UN[(size_t)unit * 128 + tid];
    }
}
__device__ __forceinline__ void l0_mixC(LAS unsigned char* lds, const L0Bufs& B, int blk, int G) {
    const int tid0 = threadIdx.x, wave = __builtin_amdgcn_readfirstlane(tid0 >> 6);
    LAS unsigned char* TQ = lds; LAS unsigned char* TK = lds + 34816; LAS unsigned char* TV = lds + 2 * 34816; LAS unsigned char* TC = lds + 3 * 34816;
    LAS float* SF = (LAS float*)(lds + 4 * 34816);
    LAS float* AS = SF; LAS float* PM = SF + 128; LAS float* NP = SF + 256; LAS float* PS = SF + 384; LAS float* PQ = SF + 640;
    for (int uu = blk; uu < 256; uu += G) {
        const int tok0 = uu * 128;
#pragma unroll 1
        for (int h = 0; h < 4; ++h) {
            const int unit = uu * 4 + h;
            int tid = tid0; asm volatile("" : "+v"(tid));
            const int lane = tid & 63, r32 = lane & 31, hh = lane >> 5;
            __syncthreads();
            load_tile128(TQ, B.AU + (size_t)tok0 * 512 + h * 128, 512, tid);
            load_tile128(TV, B.V + (size_t)tok0 * 512 + h * 128, 512, tid);
            load_tile128(TC, B.CS + (size_t)unit * 16384, 128, tid);
#pragma unroll
            for (int i = 0; i < 4; ++i) { const int ch = tid + 512 * i, row = ch >> 4, c = ch & 15; const u32x4 k = *(const u32x4*)(B.AV + (size_t)(tok0 + row) * 512 + h * 128 + c * 8); const float ksc = 0.08838834764831845f;
                u32x4 ok; ok.x = pk2(bf_lo(k.x) * ksc, bf_hi(k.x) * ksc); ok.y = pk2(bf_lo(k.y) * ksc, bf_hi(k.y) * ksc); ok.z = pk2(bf_lo(k.z) * ksc, bf_hi(k.z) * ksc); ok.w = pk2(bf_lo(k.w) * ksc, bf_hi(k.w) * ksc);
                *(LAS u32x4*)(TK + row * TS + c * 16) = ok; }
            const float mprev = B.SC[2048 + unit];
            if (wave == 0) {
                const float* gt = B.GT + (size_t)unit * 256;
                const float a0 = gt[2 * lane] - gt[128 + 2 * lane], a1 = gt[2 * lane + 1] - gt[128 + 2 * lane + 1];
                float run = fmaxf(a0, a1);
#pragma unroll
                for (int o = 1; o < 64; o <<= 1) { const float v = __shfl_up(run, o); if (lane >= o) run = fmaxf(run, v); }
                const float prev = __shfl_up(run, 1); const float p0 = fmaxf(lane > 0 ? fmaxf(prev, a0) : a0, mprev), p1 = fmaxf(run, mprev);
                AS[2 * lane] = a0; AS[2 * lane + 1] = a1; PM[2 * lane] = p0; PM[2 * lane + 1] = p1;
            }
            if (wave == 1) { NP[lane] = B.NS[(size_t)unit * 128 + lane]; NP[64 + lane] = B.NS[(size_t)unit * 128 + 64 + lane]; }
            __syncthreads();
            const int tb = wave & 3, vh = wave >> 2, t = 32 * tb + r32;
            const float pm = PM[t], bt = B.GT[(size_t)unit * 256 + 128 + t];
            f32x16 s[4];
#pragma unroll
            for (int st = 0; st < 4; ++st)
#pragma unroll
                for (int r = 0; r < 16; ++r) s[st][r] = 0.f;
            {   int lv = lane; asm volatile("" : "+v"(lv));
                const LAS unsigned char* qp = TQ + (32 * tb + (lv & 31)) * TS + (lv >> 5) * 16; const LAS unsigned char* kp = TK + (lv & 31) * TS + (lv >> 5) * 16;
#pragma unroll 2
                for (int ks = 0; ks < 8; ++ks) { const bf16x8 bq = *(const LAS bf16x8*)(qp + ks * 32);
#pragma unroll
                    for (int st = 0; st < 4; ++st) if (st <= tb) { const bf16x8 a = *(const LAS bf16x8*)(kp + st * 32 * TS + ks * 32); s[st] = MFMA32(a, bq, s[st]); } } }
            float nq = 0.f; u32x4 pf[4][2];
#pragma unroll
            for (int st = 0; st < 4; ++st) {
#pragma unroll
                for (int r = 0; r < 16; ++r) { const int sidx = 32 * st + crow(r, hh); const float wv = (sidx <= t) ? __builtin_amdgcn_exp2f((AS[sidx] - pm) * LOG2E) : 0.f; const float pv = s[st][r] * wv; s[st][r] = pv; nq += pv; }
#pragma unroll
                for (int sx = 0; sx < 2; ++sx) pf[st][sx] = (u32x4){pk2(s[st][8 * sx], s[st][8 * sx + 1]), pk2(s[st][8 * sx + 2], s[st][8 * sx + 3]), pk2(s[st][8 * sx + 4], s[st][8 * sx + 5]), pk2(s[st][8 * sx + 6], s[st][8 * sx + 7])};
            }
            nq = xhalf_sum(nq);
            float nqi = 0.f;
#pragma unroll
            for (int i = 0; i < 8; ++i) { const u32x4 qv = *(const LAS u32x4*)(TQ + t * TS + (64 * hh + 8 * i) * 2); const LAS float* np = NP + 64 * hh + 8 * i;
                nqi += bf_lo(qv.x) * np[0] + bf_hi(qv.x) * np[1] + bf_lo(qv.y) * np[2] + bf_hi(qv.y) * np[3] + bf_lo(qv.z) * np[4] + bf_hi(qv.z) * np[5] + bf_lo(qv.w) * np[6] + bf_hi(qv.w) * np[7]; }
            nqi = xhalf_sum(nqi);
            const float wst = __builtin_amdgcn_exp2f((mprev - pm) * LOG2E);
            const float den = fmaxf(fabsf(nq + wst * nqi), __builtin_amdgcn_exp2f(-(bt + pm) * LOG2E)), rden = 1.f / den;
            f32x16 ni[2], nx[2];
#pragma unroll
            for (int vt = 0; vt < 2; ++vt)
#pragma unroll
                for (int r = 0; r < 16; ++r) { ni[vt][r] = 0.f; nx[vt][r] = 0.f; }
            {   int lv = lane; asm volatile("" : "+v"(lv));
#pragma unroll
                for (int st = 0; st < 4; ++st) {
                    if (st <= tb) {
#pragma unroll
                        for (int sx = 0; sx < 2; ++sx) { const bf16x8 pb = __builtin_bit_cast(bf16x8, pf[st][sx]);
#pragma unroll
                            for (int vt = 0; vt < 2; ++vt) { const bf16x8 a = tr_frag(TV, 32 * st + 16 * sx, 64 * vh + 32 * vt, lv, true); ni[vt] = MFMA32(a, pb, ni[vt]); } }
                    }
                } }
            {   int lv = lane; asm volatile("" : "+v"(lv));
                const LAS unsigned char* qp = TQ + (32 * tb + (lv & 31)) * TS + (lv >> 5) * 16; const LAS unsigned char* cp = TC + (64 * vh + (lv & 31)) * TS + (lv >> 5) * 16;
#pragma unroll 2
                for (int ks = 0; ks < 8; ++ks) { const bf16x8 bq = *(const LAS bf16x8*)(qp + ks * 32);
#pragma unroll
                    for (int vt = 0; vt < 2; ++vt) { const bf16x8 a = *(const LAS bf16x8*)(cp + vt * 32 * TS + ks * 32); nx[vt] = MFMA32(a, bq, nx[vt]); } } }
            float hs = 0.f;
#pragma unroll
            for (int vt = 0; vt < 2; ++vt)
#pragma unroll
                for (int r = 0; r < 16; ++r) { const float hv = (ni[vt][r] + wst * nx[vt][r]) * rden; ni[vt][r] = hv; hs += hv; }
            hs = xhalf_sum(hs);
            if (hh == 0) PS[vh * 128 + t] = hs;
            __syncthreads();
            const float mean = (PS[t] + PS[128 + t]) * (1.f / 128.f);
            float hq = 0.f;
#pragma unroll
            for (int vt = 0; vt < 2; ++vt)
#pragma unroll
                for (int r = 0; r < 16; ++r) { const float d = ni[vt][r] - mean; ni[vt][r] = d; hq += d * d; }
            hq = xhalf_sum(hq);
            if (hh == 0) PQ[vh * 128 + t] = hq;
            __syncthreads();
            const float rstd = rsqrtf((PQ[t] + PQ[128 + t]) * (1.f / 128.f) + LN_EPS);
            const size_t tok = (size_t)tok0 + t;
#pragma unroll
            for (int vt = 0; vt < 2; ++vt)
#pragma unroll
                for (int gq = 0; gq < 4; ++gq) { const int chn = h * 128 + 64 * vh + 32 * vt + 8 * gq + 4 * hh;
                    const f32x4 nw = *(const f32x4*)(B.nw + chn), sk = *(const f32x4*)(B.skip + chn); const u32x2 xc = *(const u32x2*)(B.XC + tok * 512 + chn), z = *(const u32x2*)(B.BZ + tok * 512 + chn);
                    const float y0 = (ni[vt][4 * gq] * rstd * nw[0] + sk[0] * bf_lo(xc.x)) * silu_f(bf_lo(z.x)), y1 = (ni[vt][4 * gq + 1] * rstd * nw[1] + sk[1] * bf_hi(xc.x)) * silu_f(bf_hi(z.x));
                    const float y2 = (ni[vt][4 * gq + 2] * rstd * nw[2] + sk[2] * bf_lo(xc.y)) * silu_f(bf_lo(z.y)), y3 = (ni[vt][4 * gq + 3] * rstd * nw[3] + sk[3] * bf_hi(xc.y)) * silu_f(bf_hi(z.y));
                    u32x2 w; w.x = pk2(y0, y1); w.y = pk2(y2, y3); *(u32x2*)(B.YM + tok * 1024 + 512 + chn) = w; asm volatile("" ::: "memory"); }
        }
    }
}
constexpr size_t MB = 1048576ull;
constexpr size_t P_WIN_T = 0, P_WOUT_T = P_WIN_T + 4 * MB, P_WQKV_T = P_WOUT_T + 2 * MB, P_WO_T = P_WQKV_T + 3 * MB, P_XWQ_T = P_WO_T + 2 * MB, P_XWKV_T = P_XWQ_T + 4 * MB, P_XWO_T = P_XWKV_T + 8 * MB,
                 P_MLW_T = P_XWO_T + 4 * MB, P_WIFT = P_MLW_T + MB / 2, P_WRT = P_WIFT + MB / 8, P_ROT = P_WRT + MB / 2, P_BQK = P_ROT + MB, P_MEMB = P_BQK + MB / 8, P_KC = P_MEMB + 4 * MB, P_VT = P_KC + 8 * MB,
                 P_W13T = P_VT + 8 * MB, P_W2T = P_W13T + 64 * MB, P_XBF = P_W2T + 32 * MB, P_RT = P_XBF + 64 * MB, P_TMP = P_RT + 2 * MB;
constexpr size_t RT_E = 0, RT_W = 262144, RT_RANK = 2 * 262144, RT_DEST = 3 * 262144, RT_HIST = 4 * 262144, RT_TSTART = RT_HIST + 32768;
constexpr size_t T_QX = 0, T_OB = 64 * MB, T_YB = 128 * MB;
constexpr size_t T_K1 = 192 * MB, T_VT1 = 208 * MB;
constexpr size_t T_AU = 0, T_AV = 32 * MB, T_BX = 64 * MB, T_BZ = 96 * MB, T_V = 128 * MB, T_XC = 160 * MB, T_YM = 192 * MB, T_U = 256 * MB, T_CS = 320 * MB,
                 T_GT = 352 * MB, T_UN = 353 * MB, T_NS = 353 * MB + MB / 2, T_SC = 354 * MB, T_YB0 = 0;
constexpr size_t T_XG = 0, T_HM = 152 * MB, T_YG = 0;
constexpr size_t FAST_END = P_TMP + 360 * MB;
constexpr int LDS_BYTES = 147456;

struct FP {
    const float* in[33]; float* X;
    unsigned char* ws;
};
#define WSP(T, off) ((T*)(p.ws + (off)))

__device__ __forceinline__ RouteBufs route_bufs(const FP& p) {
    RouteBufs r; r.e = WSP(int, P_RT + RT_E); r.w = WSP(float, P_RT + RT_W); r.rank = WSP(int, P_RT + RT_RANK); r.dest = WSP(int, P_RT + RT_DEST); r.hist = WSP(int, P_RT + RT_HIST); r.tstart = WSP(int, P_RT + RT_TSTART); return r;
}
#define PH_ARGS const FP& p, LAS unsigned char* lds, int blk, int G
#define PH_IDS int tid_ = threadIdx.x; asm volatile("" : "+v"(tid_)); const int tid = tid_, lane = tid & 63, wave = __builtin_amdgcn_readfirstlane(tid >> 6); (void)lane; (void)wave;

__device__ __forceinline__ void ph_conv_xattn(PH_ARGS, int l) {
    PH_IDS; LAS float* scr = (LAS float*)(lds + wave * 8448); const int gw = blk * NWAVE + wave, ngw = G * NWAVE;
    convert_mats(p.in[23] + (size_t)l * 1024 * 1024, 1024, 1024, 1, 0, WSP(bf16_t, P_XWQ_T) + (size_t)l * 1024 * 1024, 0, RM_IDENT, 0.0625f, 1024, scr, gw, ngw, lane);
    convert_mats(p.in[24] + (size_t)l * 1024 * 2048, 1024, 2048, 1, 0, WSP(bf16_t, P_XWKV_T) + (size_t)l * 2048 * 1024, 0, RM_IDENT, 1.f, 0, scr, gw, ngw, lane);
    convert_mats(p.in[25] + (size_t)l * 1024 * 1024, 1024, 1024, 1, 0, WSP(bf16_t, P_XWO_T) + (size_t)l * 1024 * 1024, 0, RM_IDENT, 1.f, 0, scr, gw, ngw, lane);
    convert_rows(p.in[1], WSP(bf16_t, P_MEMB), (size_t)2048 * 1024, blk * NTHR + tid, G * NTHR);
}
__device__ __forceinline__ void ph_conv_moe(PH_ARGS, int l) {
    PH_IDS; LAS float* scr = (LAS float*)(lds + wave * 8448); const int gw = blk * NWAVE + wave, ngw = G * NWAVE;
    const size_t wl = (size_t)l * 32 * 1024 * 512;
    convert_mats(p.in[30] + wl, 1024, 512, 32, (size_t)1024 * 512, WSP(bf16_t, P_W13T), (size_t)1024 * 1024, RM_PAIR0, 1.f, 0, scr, gw, ngw, lane);
    convert_mats(p.in[31] + wl, 1024, 512, 32, (size_t)1024 * 512, WSP(bf16_t, P_W13T), (size_t)1024 * 1024, RM_PAIR1, 1.f, 0, scr, gw, ngw, lane);
    convert_mats(p.in[32] + wl, 512, 1024, 32, (size_t)512 * 1024, WSP(bf16_t, P_W2T), (size_t)1024 * 512, RM_IDENT, 1.f, 0, scr, gw, ngw, lane);
    bf16_t* wrt = WSP(bf16_t, P_WRT) + (size_t)l * 2 * 64 * 1024; const float* wre = p.in[28] + (size_t)l * 1024 * 32; const float* wrg = p.in[26] + (size_t)l * 1024 * 4;
    for (int i = blk * NTHR + tid; i < 64 * 1024; i += G * NTHR) { const int r = i >> 10, k = i & 1023;
        const float v = r < 32 ? wre[k * 32 + r] : (r < 36 ? wrg[k * 4 + (r - 32)] : 0.f);
        const bf16_t h = f2bf(v); wrt[i] = h; wrt[64 * 1024 + i] = f2bf(v - bf2f(h)); }
}
__device__ __forceinline__ void ph_x_to_bf(PH_ARGS) { PH_IDS; convert_rows(p.X, WSP(bf16_t, P_XBF), (size_t)NT * 1024, blk * NTHR + tid, G * NTHR); }

__device__ __forceinline__ void set_job(LAS pg8::JobDesc* jt, int j, const void* A, const void* B, int nM, int nN, void* out, int ldc, int mode, const void* bias = nullptr, const void* rot = nullptr, void* out2 = nullptr) {
    unsigned long long a = (unsigned long long)A, b = (unsigned long long)B, o = (unsigned long long)out, bi = (unsigned long long)bias, ro = (unsigned long long)rot, o2 = (unsigned long long)out2;
    asm volatile("" : "+s"(a), "+s"(b), "+s"(o), "+s"(bi), "+s"(ro), "+s"(o2), "+s"(nM), "+s"(nN), "+s"(ldc), "+s"(mode));
    LAS pg8::JobDesc* d = jt + j; d->A = a; d->B = b; d->out = o; d->bias = bi; d->rot = ro; d->out2 = o2;
    d->nM = nM; d->nN = nN; d->ldc = ldc; d->mode = mode;
}
#define JT_PTR ((LAS pg8::JobDesc*)(lds + pg8::JT_OFF))
__device__ __forceinline__ void run_jobs(LAS unsigned char* lds, int K, int n0, int n1, int n2, int blk, int G) {
    __syncthreads();
    pg8::Jobs3 S; S.jt = JT_PTR; S.n0 = n0; S.n1 = n1; S.n2 = n2; S.K = K; S.G = G; S.c = blk;
    EpiMulti E; E.jt = JT_PTR;
    pg8::gemm_phase<EpiMulti, pg8::Jobs3, true, true>(lds, K, S, E);
}
__device__ __forceinline__ void ph_xattn_g1(PH_ARGS, int l) {
    const bf16_t* wkv = WSP(bf16_t, P_XWKV_T) + (size_t)l * 2048 * 1024;
    __syncthreads();
    if (threadIdx.x == 0) {
        set_job(JT_PTR, 0, WSP(bf16_t, P_MEMB), wkv, 8, 4, WSP(bf16_t, P_KC) + (size_t)l * 2048 * 1024, 1024, EM_PLAIN);
        set_job(JT_PTR, 1, wkv + (size_t)1024 * 1024, WSP(bf16_t, P_MEMB), 4, 8, WSP(bf16_t, P_VT) + (size_t)l * 1024 * 2048, 2048, EM_PLAIN);
        set_job(JT_PTR, 2, WSP(bf16_t, P_XBF), WSP(bf16_t, P_XWQ_T) + (size_t)l * 1024 * 1024, 128, 4, WSP(bf16_t, P_TMP + T_QX), 1024, EM_PLAIN);
    }
    run_jobs(lds, 1024, 32, 32, 512, blk, G);
}
__device__ __forceinline__ void ph_xattn_attn(PH_ARGS, int l) {
    xattn_phase(lds, WSP(bf16_t, P_TMP + T_QX), WSP(bf16_t, P_KC) + (size_t)l * 2048 * 1024, WSP(bf16_t, P_VT) + (size_t)l * 1024 * 2048, WSP(bf16_t, P_TMP + T_OB), blk, G);
}
__device__ __forceinline__ void ph_gemm_plain(PH_ARGS, const bf16_t* A, const bf16_t* Bt, bf16_t* out) {
    __syncthreads();
    if (threadIdx.x == 0) set_job(JT_PTR, 0, A, Bt, 128, 4, out, 1024, EM_PLAIN);
    run_jobs(lds, 1024, 512, 0, 0, blk, G);
}
__device__ __forceinline__ void ph_ln(PH_ARGS, const float* xin, const bf16_t* y, int lnidx, int mode) {
    PH_IDS; LnArgs a; a.xin = xin; a.xout = p.X; a.xbf = WSP(bf16_t, P_XBF); a.y = y; a.g = p.in[2] + lnidx * 1024; a.b = p.in[3] + lnidx * 1024;
    a.dest = WSP(int, P_RT + RT_DEST); a.wts = WSP(float, P_RT + RT_W); a.mode = mode; a.pad = 0;
    ln_phase(a, blk, G, wave, lane);
}
__device__ __forceinline__ void ph_moe_route(PH_ARGS, int l) {
    moe_router_phase(lds, WSP(bf16_t, P_XBF), WSP(bf16_t, P_WRT) + (size_t)l * 2 * 64 * 1024, p.in[27] + l * 4, p.in[29] + l * 32, route_bufs(p), blk);
}
__device__ __forceinline__ void ph_moe_scatter(PH_ARGS) { moe_scatter_phase(lds, WSP(bf16_t, P_XBF), WSP(bf16_t, P_TMP + T_XG), route_bufs(p), blk, G); }
__device__ __forceinline__ void ph_moe_g1(PH_ARGS) {
    __syncthreads();
    if (threadIdx.x == 0) set_job(JT_PTR, 0, nullptr, nullptr, 0, 0, WSP(bf16_t, P_TMP + T_HM), 512, EM_SWIGLU);
    __syncthreads();
    MoeSched S; S.A = (const char*)WSP(bf16_t, P_TMP + T_XG); S.B = (const char*)WSP(bf16_t, P_W13T); S.tstart = WSP(int, P_RT + RT_TSTART); S.K = 1024; S.nN = 4; S.G = G; S.c = blk; S.bexp = (size_t)1024 * 1024 * 2;
    EpiMulti E; E.jt = JT_PTR;
    pg8::gemm_phase<EpiMulti, MoeSched, true, true>(lds, 1024, S, E);
}
__device__ __forceinline__ void ph_moe_g2(PH_ARGS) {
    __syncthreads();
    if (threadIdx.x == 0) set_job(JT_PTR, 0, nullptr, nullptr, 0, 0, WSP(bf16_t, P_TMP + T_YG), 1024, EM_PLAIN);
    __syncthreads();
    MoeSched S; S.A = (const char*)WSP(bf16_t, P_TMP + T_HM); S.B = (const char*)WSP(bf16_t, P_W2T); S.tstart = WSP(int, P_RT + RT_TSTART); S.K = 512; S.nN = 4; S.G = G; S.c = blk; S.bexp = (size_t)1024 * 512 * 2;
    EpiMulti E; E.jt = JT_PTR;
    pg8::gemm_phase<EpiMulti, MoeSched, true, true>(lds, 512, S, E);
}

__device__ __forceinline__ void ph_conv_l1(PH_ARGS) {
    PH_IDS; LAS float* scr = (LAS float*)(lds + wave * 8448); const int gw = blk * NWAVE + wave, ngw = G * NWAVE;
    convert_mats(p.in[19], 1024, 1536, 1, 0, WSP(bf16_t, P_WQKV_T), 0, RM_ROT, 0.125f, 1024, scr, gw, ngw, lane);
    convert_mats(p.in[22], 1024, 1024, 1, 0, WSP(bf16_t, P_WO_T), 0, RM_IDENT, 1.f, 0, scr, gw, ngw, lane);
    const int gt = blk * NTHR + tid, ngt = G * NTHR;
    float* bqk = WSP(float, P_BQK);
    for (int n = gt; n < 1280; n += ngt) bqk[rowmap(RM_ROT, n)] = p.in[20][n] * (n < 1024 ? 0.125f : 1.f);
    float* rot = WSP(float, P_ROT);
    for (int i = gt; i < 4096 * 32; i += ngt) { const int pos = i >> 5, k = i & 31; const float inv = powf(10000.f, -(float)(2 * k) / 64.f); const float ang = (float)pos * inv; rot[2 * i] = cosf(ang); rot[2 * i + 1] = sinf(ang); }
}
__device__ __forceinline__ void ph_l1_g1(PH_ARGS) {
    __syncthreads();
    if (threadIdx.x == 0) {
        set_job(JT_PTR, 0, WSP(bf16_t, P_XBF), WSP(bf16_t, P_WQKV_T), 128, 5, WSP(bf16_t, P_TMP + T_QX), 1024, EM_ROTARY, WSP(float, P_BQK), WSP(float, P_ROT), WSP(bf16_t, P_TMP + T_K1));
        set_job(JT_PTR, 1, WSP(bf16_t, P_WQKV_T) + (size_t)1280 * 1024, WSP(bf16_t, P_XBF), 1, 128, WSP(bf16_t, P_TMP + T_VT1), NT, EM_ROWBIAS, p.in[20] + 1280);
    }
    run_jobs(lds, 1024, 640, 128, 0, blk, G);
}
__device__ __forceinline__ void ph_l1_swa(PH_ARGS) {
    swa_phase(lds, WSP(bf16_t, P_TMP + T_QX), WSP(bf16_t, P_TMP + T_K1), WSP(bf16_t, P_TMP + T_VT1), p.in[21], WSP(bf16_t, P_TMP + T_OB), blk, G);
}

__device__ __forceinline__ L0Bufs l0_bufs(const FP& p) {
    L0Bufs B; B.AU = WSP(bf16_t, P_TMP + T_AU); B.AV = WSP(bf16_t, P_TMP + T_AV); B.BX = WSP(bf16_t, P_TMP + T_BX); B.BZ = WSP(bf16_t, P_TMP + T_BZ); B.V = WSP(bf16_t, P_TMP + T_V); B.XC = WSP(bf16_t, P_TMP + T_XC);
    B.YM = WSP(bf16_t, P_TMP + T_YM); B.CS = WSP(bf16_t, P_TMP + T_CS); B.U = WSP(float, P_TMP + T_U); B.GT = WSP(float, P_TMP + T_GT); B.UN = WSP(float, P_TMP + T_UN); B.NS = WSP(float, P_TMP + T_NS); B.SC = WSP(float, P_TMP + T_SC);
    B.WQT = WSP(bf16_t, P_MLW_T); B.GMW = WSP(bf16_t, P_MLW_T) + 12 * 16384; B.WIFT = WSP(bf16_t, P_WIFT);
    B.gm_g = p.in[5]; B.gm_b = p.in[6]; B.gm_bs = p.in[8]; B.cw = p.in[9]; B.cb = p.in[10]; B.bif = p.in[15]; B.nw = p.in[16]; B.skip = p.in[17]; return B;
}
__device__ __forceinline__ void ph_conv_l0(PH_ARGS) {
    PH_IDS; LAS float* scr = (LAS float*)(lds + wave * 8448); const int gw = blk * NWAVE + wave, ngw = G * NWAVE;
    convert_mats(p.in[4], 1024, 2048, 1, 0, WSP(bf16_t, P_WIN_T), 0, RM_IDENT, 1.f, 0, scr, gw, ngw, lane);
    convert_mats(p.in[18], 1024, 1024, 1, 0, WSP(bf16_t, P_WOUT_T), 0, RM_IDENT, 1.f, 0, scr, gw, ngw, lane);
    convert_mats(p.in[11], 128, 128, 4, 16384, WSP(bf16_t, P_MLW_T), 16384, RM_IDENT, 1.f, 0, scr, gw, ngw, lane);
    convert_mats(p.in[12], 128, 128, 4, 16384, WSP(bf16_t, P_MLW_T) + 4 * 16384, 16384, RM_IDENT, 1.f, 0, scr, gw, ngw, lane);
    convert_mats(p.in[13], 128, 128, 4, 16384, WSP(bf16_t, P_MLW_T) + 8 * 16384, 16384, RM_IDENT, 1.f, 0, scr, gw, ngw, lane);
    const int gt = blk * NTHR + tid, ngt = G * NTHR;
    bf16_t* gmw = WSP(bf16_t, P_MLW_T) + 12 * 16384;
    for (int i = gt; i < 4 * 16384; i += ngt) { const int t = (i >> 7) & 127, sidx = i & 127; gmw[i] = f2bf(sidx <= t ? p.in[7][i] : 0.f); }
    bf16_t* wift = WSP(bf16_t, P_WIFT);
    for (int i = gt; i < 32 * 1536; i += ngt) { const int r = i / 1536, k = i - r * 1536; wift[i] = f2bf(r < 8 ? p.in[14][k * 8 + r] : 0.f); }
}
__device__ __forceinline__ void ph_xin_to_bf(PH_ARGS) { PH_IDS; convert_rows(p.in[0], WSP(bf16_t, P_XBF), (size_t)NT * 1024, blk * NTHR + tid, G * NTHR); }
__device__ __forceinline__ void ph_l0_g1(PH_ARGS) {
    __syncthreads();
    if (threadIdx.x == 0) set_job(JT_PTR, 0, WSP(bf16_t, P_XBF), WSP(bf16_t, P_WIN_T), 128, 8, WSP(bf16_t, P_TMP + T_AU), 512, EM_GELU4);
    run_jobs(lds, 1024, 1024, 0, 0, blk, G);
}

enum { K_CONV_XATTN = 0, K_CONV_MOE, K_X2BF, K_XATTN_G1, K_XATTN_ATTN, K_XATTN_G2, K_LN_Y, K_MOE_ROUTE, K_MOE_SCATTER, K_MOE_G1, K_MOE_G2, K_LN_MOE, K_CONV_L1, K_L1_G1, K_L1_SWA, K_L1_G2, K_CONV_L0, K_XIN2BF, K_L0_G1, K_L0_MIXA, K_L0_SCAN, K_L0_MIXC, K_L0_G2, K_LN_Y0 };
template <int PH>
__global__ void __launch_bounds__(NTHR, 2) k_phase(FP p, int l, int lnidx) {
    extern __shared__ __attribute__((aligned(16))) unsigned char smem[];
    LAS unsigned char* lds = (LAS unsigned char*)smem;
    const int blk = blockIdx.x, G = gridDim.x;
    if constexpr (PH == K_CONV_XATTN) ph_conv_xattn(p, lds, blk, G, l);
    if constexpr (PH == K_CONV_MOE) ph_conv_moe(p, lds, blk, G, l);
    if constexpr (PH == K_X2BF) ph_x_to_bf(p, lds, blk, G);
    if constexpr (PH == K_XATTN_G1) ph_xattn_g1(p, lds, blk, G, l);
    if constexpr (PH == K_XATTN_ATTN) ph_xattn_attn(p, lds, blk, G, l);
    if constexpr (PH == K_XATTN_G2) ph_gemm_plain(p, lds, blk, G, WSP(bf16_t, P_TMP + T_OB), WSP(bf16_t, P_XWO_T) + (size_t)l * 1024 * 1024, WSP(bf16_t, P_TMP + T_YB));
    if constexpr (PH == K_LN_Y) ph_ln(p, lds, blk, G, p.X, WSP(bf16_t, P_TMP + T_YB), lnidx, 0);
    if constexpr (PH == K_MOE_ROUTE) ph_moe_route(p, lds, blk, G, l);
    if constexpr (PH == K_MOE_SCATTER) ph_moe_scatter(p, lds, blk, G);
    if constexpr (PH == K_MOE_G1) ph_moe_g1(p, lds, blk, G);
    if constexpr (PH == K_MOE_G2) ph_moe_g2(p, lds, blk, G);
    if constexpr (PH == K_LN_MOE) ph_ln(p, lds, blk, G, p.X, WSP(bf16_t, P_TMP + T_YG), lnidx, 1);
    if constexpr (PH == K_CONV_L0) ph_conv_l0(p, lds, blk, G);
    if constexpr (PH == K_XIN2BF) ph_xin_to_bf(p, lds, blk, G);
    if constexpr (PH == K_L0_G1) ph_l0_g1(p, lds, blk, G);
    if constexpr (PH == K_L0_MIXA) l0_mixA(lds, l0_bufs(p), blk, G);
    if constexpr (PH == K_L0_SCAN) l0_scan(l0_bufs(p), blk);
    if constexpr (PH == K_L0_MIXC) l0_mixC(lds, l0_bufs(p), blk, G);
    if constexpr (PH == K_L0_G2) ph_gemm_plain(p, lds, blk, G, WSP(bf16_t, P_TMP + T_YM), WSP(bf16_t, P_WOUT_T), WSP(bf16_t, P_TMP + T_YB0));
    if constexpr (PH == K_LN_Y0) ph_ln(p, lds, blk, G, p.in[0], WSP(bf16_t, P_TMP + T_YB0), 0, 0);
    if constexpr (PH == K_CONV_L1) ph_conv_l1(p, lds, blk, G);
    if constexpr (PH == K_L1_G1) ph_l1_g1(p, lds, blk, G);
    if constexpr (PH == K_L1_SWA) ph_l1_swa(p, lds, blk, G);
    if constexpr (PH == K_L1_G2) ph_gemm_plain(p, lds, blk, G, WSP(bf16_t, P_TMP + T_OB), WSP(bf16_t, P_WO_T), WSP(bf16_t, P_TMP + T_YB));
}

struct SchedAll {
    const LAS pg8::JobDesc* jt; int n0, n1, n2; int K, G, c; int moe; const char* A; const char* B; const int* tstart; int nN; size_t bexp;
    __device__ __forceinline__ bool next(int i, pg8::Unit& u) const {
        if (moe) {
            const int vc = (c & 7) * (G >> 3) + (c >> 3);
            const long L = (long)i * G + vc; const int ntile = tstart[32];
            if (L >= (long)ntile * nN) return false;
            const int mt = (int)(L / nN), nt = (int)(L % nN);
            int e = 0;
            for (int k = 1; k < 32; ++k) if (tstart[k] <= mt) e = k;
            u.A = A + (size_t)mt * 256 * K * 2; u.B = B + (size_t)e * bexp + (size_t)nt * 256 * K * 2; u.pm = mt; u.pn = nt; u.job = 0; return true;
        }
        long L = (long)i * G + c;
        if (L >= (long)n0 + n1 + n2) return false;
        int l = (int)L; int jb = 0;
        if (l >= n0) { l -= n0; jb = 1; if (l >= n1) { l -= n1; jb = 2; } }
        const int jM = __builtin_amdgcn_readfirstlane(jt[jb].nM), jN = __builtin_amdgcn_readfirstlane(jt[jb].nN);
        int pm, pn; pg8::tile_order(l, jM, jN, pm, pn);
        const size_t tstep = (size_t)pg8::BM * K * 2;
        u.A = (const char*)pg8::rfl64(jt[jb].A) + (size_t)pm * tstep; u.B = (const char*)pg8::rfl64(jt[jb].B) + (size_t)pn * tstep; u.pm = pm; u.pn = pn; u.job = jb; return true;
    }
};
enum { MP_CONV = 0, MP_L0_G1, MP_L0_MIXA, MP_L0_SCAN, MP_L0_MIXC, MP_L0_G2, MP_LN0, MP_XA_G1, MP_XA_ATTN, MP_XA_G2, MP_LN_ROUTE, MP_SCATTER, MP_MOE_G1, MP_MOE_G2, MP_LN_MOE, MP_L1_G1, MP_L1_SWA, MP_L1_G2, MP_LN3 };
__device__ __forceinline__ int prog_kind(int i) {
    switch (i) { case 0: return MP_CONV; case 1: return MP_L0_G1; case 2: return MP_L0_MIXA; case 3: return MP_L0_SCAN; case 4: return MP_L0_MIXC; case 5: return MP_L0_G2; case 6: return MP_LN0;
        case 7: case 19: return MP_XA_G1; case 8: case 20: return MP_XA_ATTN; case 9: case 21: return MP_XA_G2; case 10: case 22: return MP_LN_ROUTE; case 11: case 23: return MP_SCATTER;
        case 12: case 24: return MP_MOE_G1; case 13: case 25: return MP_MOE_G2; case 14: case 26: return MP_LN_MOE; case 15: return MP_L1_G1; case 16: return MP_L1_SWA; case 17: return MP_L1_G2; default: return MP_LN3; }
}
constexpr int N_PROG = 27;
__global__ void __launch_bounds__(NTHR, 2) mega(FP p0) {
    extern __shared__ __attribute__((aligned(16))) unsigned char smem[];
    LAS unsigned char* lds = (LAS unsigned char*)smem;
    cooperative_groups::grid_group grid = cooperative_groups::this_grid();
    const int blk = blockIdx.x, G = gridDim.x;
#pragma unroll 1
    for (int pi = 0; pi < N_PROG; ++pi) {
        FP p = p0; asm volatile("" : "+s"(p.ws));
        const int kind = prog_kind(pi), l = pi >= 15 ? 1 : 0;
        const bool is_gemm = kind == MP_L0_G1 || kind == MP_L0_G2 || kind == MP_XA_G1 || kind == MP_XA_G2 || kind == MP_MOE_G1 || kind == MP_MOE_G2 || kind == MP_L1_G1 || kind == MP_L1_G2;
        if (is_gemm) {
            SchedAll S; S.jt = JT_PTR; S.n0 = S.n1 = S.n2 = 0; S.K = 1024; S.G = G; S.c = blk; S.moe = 0; S.A = S.B = nullptr; S.tstart = WSP(int, P_RT + RT_TSTART); S.nN = 4; S.bexp = 0;
            __syncthreads();
            if (threadIdx.x == 0) {
                if (kind == MP_L0_G1) set_job(JT_PTR, 0, WSP(bf16_t, P_XBF), WSP(bf16_t, P_WIN_T), 128, 8, WSP(bf16_t, P_TMP + T_AU), 512, EM_GELU4);
                if (kind == MP_L0_G2) set_job(JT_PTR, 0, WSP(bf16_t, P_TMP + T_YM), WSP(bf16_t, P_WOUT_T), 128, 4, WSP(bf16_t, P_TMP + T_YB0), 1024, EM_PLAIN);
                if (kind == MP_XA_G1) { const bf16_t* wkv = WSP(bf16_t, P_XWKV_T) + (size_t)l * 2048 * 1024;
                    set_job(JT_PTR, 0, WSP(bf16_t, P_MEMB), wkv, 8, 4, WSP(bf16_t, P_KC) + (size_t)l * 2048 * 1024, 1024, EM_PLAIN);
                    set_job(JT_PTR, 1, wkv + (size_t)1024 * 1024, WSP(bf16_t, P_MEMB), 4, 8, WSP(bf16_t, P_VT) + (size_t)l * 1024 * 2048, 2048, EM_PLAIN);
                    set_job(JT_PTR, 2, WSP(bf16_t, P_XBF), WSP(bf16_t, P_XWQ_T) + (size_t)l * 1024 * 1024, 128, 4, WSP(bf16_t, P_TMP + T_QX), 1024, EM_PLAIN); }
                if (kind == MP_XA_G2) set_job(JT_PTR, 0, WSP(bf16_t, P_TMP + T_OB), WSP(bf16_t, P_XWO_T) + (size_t)l * 1024 * 1024, 128, 4, WSP(bf16_t, P_TMP + T_YB), 1024, EM_PLAIN);
                if (kind == MP_MOE_G1) set_job(JT_PTR, 0, nullptr, nullptr, 0, 0, WSP(bf16_t, P_TMP + T_HM), 512, EM_SWIGLU);
                if (kind == MP_MOE_G2) set_job(JT_PTR, 0, nullptr, nullptr, 0, 0, WSP(bf16_t, P_TMP + T_YG), 1024, EM_PLAIN);
                if (kind == MP_L1_G1) { set_job(JT_PTR, 0, WSP(bf16_t, P_XBF), WSP(bf16_t, P_WQKV_T), 128, 5, WSP(bf16_t, P_TMP + T_QX), 1024, EM_ROTARY, WSP(float, P_BQK), WSP(float, P_ROT), WSP(bf16_t, P_TMP + T_K1));
                    set_job(JT_PTR, 1, WSP(bf16_t, P_WQKV_T) + (size_t)1280 * 1024, WSP(bf16_t, P_XBF), 1, 128, WSP(bf16_t, P_TMP + T_VT1), NT, EM_ROWBIAS, p.in[20] + 1280); }
                if (kind == MP_L1_G2) set_job(JT_PTR, 0, WSP(bf16_t, P_TMP + T_OB), WSP(bf16_t, P_WO_T), 128, 4, WSP(bf16_t, P_TMP + T_YB), 1024, EM_PLAIN);
            }
            if (kind == MP_L0_G1) S.n0 = 1024;
            if (kind == MP_L0_G2 || kind == MP_XA_G2 || kind == MP_L1_G2) S.n0 = 512;
            if (kind == MP_XA_G1) { S.n0 = 32; S.n1 = 32; S.n2 = 512; }
            if (kind == MP_L1_G1) { S.n0 = 640; S.n1 = 128; }
            if (kind == MP_MOE_G1) { S.moe = 1; S.A = (const char*)WSP(bf16_t, P_TMP + T_XG); S.B = (const char*)WSP(bf16_t, P_W13T); S.bexp = (size_t)1024 * 1024 * 2; }
            if (kind == MP_MOE_G2) { S.moe = 1; S.K = 512; S.A = (const char*)WSP(bf16_t, P_TMP + T_HM); S.B = (const char*)WSP(bf16_t, P_W2T); S.bexp = (size_t)1024 * 512 * 2; }
            __syncthreads();
            EpiMulti E; E.jt = JT_PTR;
            pg8::gemm_phase<EpiMulti, SchedAll, true, true>(lds, S.K, S, E);
        } else {
            switch (kind) {
                case MP_CONV: ph_conv_l0(p, lds, blk, G); ph_conv_l1(p, lds, blk, G); ph_conv_xattn(p, lds, blk, G, 0); ph_conv_xattn(p, lds, blk, G, 1); ph_conv_moe(p, lds, blk, G, 0); ph_xin_to_bf(p, lds, blk, G); break;
                case MP_L0_MIXA: l0_mixA(lds, l0_bufs(p), blk, G); break;
                case MP_L0_SCAN: l0_scan(l0_bufs(p), blk); break;
                case MP_L0_MIXC: l0_mixC(lds, l0_bufs(p), blk, G); break;
                case MP_LN0: ph_ln(p, lds, blk, G, p.in[0], WSP(bf16_t, P_TMP + T_YB0), 0, 0); break;
                case MP_XA_ATTN: ph_xattn_attn(p, lds, blk, G, l); break;
                case MP_LN_ROUTE: ph_ln(p, lds, blk, G, p.X, WSP(bf16_t, P_TMP + T_YB), l * 3 + 1, 0); __threadfence(); __syncthreads(); ph_moe_route(p, lds, blk, G, l); break;
                case MP_SCATTER: ph_moe_scatter(p, lds, blk, G); break;
                case MP_LN_MOE: ph_ln(p, lds, blk, G, p.X, WSP(bf16_t, P_TMP + T_YG), l * 3 + 2, 1); if (l == 0) ph_conv_moe(p, lds, blk, G, 1); break;
                case MP_L1_SWA: ph_l1_swa(p, lds, blk, G); break;
                default: ph_ln(p, lds, blk, G, p.X, WSP(bf16_t, P_TMP + T_YB), 3, 0); break;
            }
        }
        if (pi + 1 < N_PROG) grid.sync();
    }
}
}
extern "C" void kernel_launch(void* const* d_in, const int* in_sizes, int n_in, void* d_out, int out_size, void* d_ws, size_t ws_size, hipStream_t stream) {
    static int ok = 0;
    if (ok == 0) {
        ok = -1;
        if (n_in != 33 || out_size != 32768 * 1024 || ws_size < fk::FAST_END) { fprintf(stderr, "kernel_launch: unexpected shapes/ws (%d, %d, %zu)\n", n_in, out_size, ws_size); return; }
        int dev = 0, cus = 0, per_cu = 0;
        if (hipGetDevice(&dev) != hipSuccess || hipDeviceGetAttribute(&cus, hipDeviceAttributeMultiprocessorCount, dev) != hipSuccess) return;
        if (hipFuncSetAttribute((const void*)fk::mega, hipFuncAttributeMaxDynamicSharedMemorySize, fk::LDS_BYTES) != hipSuccess) return;
        if (hipOccupancyMaxActiveBlocksPerMultiprocessor(&per_cu, (const void*)fk::mega, fk::NTHR, fk::LDS_BYTES) != hipSuccess || per_cu < 1 || cus * per_cu < 256) { fprintf(stderr, "kernel_launch: cannot co-reside 256 workgroups (%d CUs x %d)\n", cus, per_cu); return; }
        ok = 1;
    }
    if (ok < 0) return;
    fk::FP p{}; for (int i = 0; i < 33; ++i) p.in[i] = (const float*)d_in[i]; p.X = (float*)d_out; p.ws = (unsigned char*)d_ws;
    void* args[] = {&p};
    hipError_t e = hipLaunchCooperativeKernel((const void*)fk::mega, dim3(256), dim3(fk::NTHR), args, fk::LDS_BYTES, stream);
    if (e != hipSuccess) fprintf(stderr, "cooperative launch failed: %s\n", hipGetErrorString(e));
}
```

```cpp
#include <hip/hip_runtime.h>
#include <hip/hip_cooperative_groups.h>
#include <cstdio>
#include <cstdint>
#include <cmath>
namespace fk {
#define LAS __attribute__((address_space(3)))
typedef unsigned short bf16_t;
typedef short bf16x8 __attribute__((ext_vector_type(8)));
typedef short s16x4 __attribute__((ext_vector_type(4)));
typedef float f32x4 __attribute__((ext_vector_type(4)));
typedef float f32x16 __attribute__((ext_vector_type(16)));
typedef float f32x2 __attribute__((ext_vector_type(2)));
typedef unsigned u32x4 __attribute__((ext_vector_type(4)));
typedef unsigned u32x2 __attribute__((ext_vector_type(2)));
typedef __bf16 bf16x2_t __attribute__((ext_vector_type(2)));

constexpr int NT = 32768, DM = 1024, SEQ = 4096;
constexpr int NTHR = 512, NWAVE = 8;
constexpr float ALPHA = 1.4142135623730951f, LN_EPS = 1e-5f, LOG2E = 1.4426950408889634f;

__device__ __forceinline__ unsigned pk2(float lo, float hi) { f32x2 v = {lo, hi}; bf16x2_t b = __builtin_convertvector(v, bf16x2_t); return __builtin_bit_cast(unsigned, b); }
__device__ __forceinline__ float bf_lo(unsigned w) { return __uint_as_float(w << 16); }
__device__ __forceinline__ float bf_hi(unsigned w) { return __uint_as_float(w & 0xffff0000u); }
__device__ __forceinline__ float bf2f(bf16_t b) { return __uint_as_float(((unsigned)b) << 16); }
__device__ __forceinline__ bf16_t f2bf(float f) { return (bf16_t)(pk2(f, 0.f) & 0xffffu); }
__device__ __forceinline__ float fast_exp(float x) { return __builtin_amdgcn_exp2f(x * LOG2E); }
__device__ __forceinline__ float sigmoid_f(float x) { return __builtin_amdgcn_rcpf(1.f + fast_exp(-x)); }
__device__ __forceinline__ float silu_f(float x) { return x * sigmoid_f(x); }
__device__ __forceinline__ float gelu_tanh_f(float x) { const float u = 1.5957691216057308f * (x + 0.044715f * x * x * x); return x * sigmoid_f(u); }
__device__ __forceinline__ int crow(int r, int hi) { return (r & 3) + 8 * (r >> 2) + 4 * hi; }
__device__ __forceinline__ float xhalf_sum(float v) { auto rr = __builtin_amdgcn_permlane32_swap(__float_as_uint(v), __float_as_uint(v), false, false); return __uint_as_float(rr[0]) + __uint_as_float(rr[1]); }
__device__ __forceinline__ float xhalf_max(float v) { auto rr = __builtin_amdgcn_permlane32_swap(__float_as_uint(v), __float_as_uint(v), false, false); return fmaxf(__uint_as_float(rr[0]), __uint_as_float(rr[1])); }
__device__ __forceinline__ float wave_sum(float v) {
#pragma unroll
    for (int o = 1; o < 64; o <<= 1) v += __shfl_xor(v, o);
    return v;
}
__device__ __forceinline__ s16x4 lds_tr(const LAS void* p) { return __builtin_bit_cast(s16x4, __builtin_amdgcn_ds_read_tr16_b64_v4i16((LAS s16x4*)p)); }
#define MFMA32(a, b, c) __builtin_amdgcn_mfma_f32_32x32x16_bf16((a), (b), (c), 0, 0, 0)

namespace pg8 {
constexpr int BM = 256, BK = 64, HALF = 128, HTB = HALF * BK * 2, STAGE_BYTES = 8 * HTB, NXCD = 8, WGM = 8;
__host__ __device__ __forceinline__ int lds_byte(int r, int c) { const int st = (r >> 4) * 2 + (c >> 5), rr = r & 15, cc = c & 31, ob = rr * 64 + cc * 2; return st * 1024 + (ob ^ (((ob >> 9) & 1) << 5)); }
__host__ __device__ __forceinline__ void stage_rc(int b, int& R, int& C) { const int st = b / 1024, sb = b % 1024, swz = sb ^ (((sb >> 9) & 1) << 5); R = (st >> 1) * 16 + swz / 64; C = (st & 1) * 32 + (swz % 64) / 2; }
__host__ __device__ __forceinline__ int perm32(int rho) { const int n = rho >> 4, i = rho & 15; return 8 * (i >> 2) + 4 * n + (i & 3); }

struct Unit { const char* A; const char* B; int pm, pn, job; };

__device__ __forceinline__ void tile_order(int l, int nM, int nN, int& pm, int& pn) {
    const int nwg = nM * nN; int wgid = l;
    { const int q = nwg / NXCD, r = nwg % NXCD, xcd = wgid % NXCD, off = wgid / NXCD; wgid = (xcd < r ? xcd * (q + 1) : r * (q + 1) + (xcd - r) * q) + off; }
    const int nig = WGM * nN, gid = wgid / nig, fm = gid * WGM, gsz = (nM - fm) < WGM ? (nM - fm) : WGM;
    pm = fm + ((wgid % nig) % gsz); pn = (wgid % nig) / gsz;
}
struct JobDesc { unsigned long long A, B, out, bias, rot, out2; int nM, nN, ldc, mode; };
__device__ __forceinline__ unsigned long long rfl64(unsigned long long v) { const unsigned lo = __builtin_amdgcn_readfirstlane((unsigned)v), hi = __builtin_amdgcn_readfirstlane((unsigned)(v >> 32)); return ((unsigned long long)hi << 32) | lo; }
constexpr int JT_OFF = STAGE_BYTES;
struct Jobs3 {
    const LAS JobDesc* jt; int n0, n1, n2; int K, G, c;
    __device__ __forceinline__ bool next(int i, Unit& u) const {
        long L = (long)i * G + c;
        if (L >= (long)n0 + n1 + n2) return false;
        int l = (int)L; int jb = 0;
        if (l >= n0) { l -= n0; jb = 1; if (l >= n1) { l -= n1; jb = 2; } }
        const int jM = __builtin_amdgcn_readfirstlane(jt[jb].nM), jN = __builtin_amdgcn_readfirstlane(jt[jb].nN);
        int pm, pn; tile_order(l, jM, jN, pm, pn);
        const size_t tstep = (size_t)BM * K * 2;
        u.A = (const char*)rfl64(jt[jb].A) + (size_t)pm * tstep; u.B = (const char*)rfl64(jt[jb].B) + (size_t)pn * tstep; u.pm = pm; u.pn = pn; u.job = jb; return true;
    }
};

template <class Epi, class Sched, bool ALIGN_EPI, bool SP2>
__device__ __forceinline__ void gemm_phase(LAS unsigned char* lds, const int K, const Sched& S, const Epi& E) {
    int tid_ = threadIdx.x; asm volatile("" : "+v"(tid_)); const int tid = tid_, wid = __builtin_amdgcn_readfirstlane(tid >> 6), lane = tid & 63, wr = wid >> 2, wc = wid & 3, fr = lane & 15, fq = lane >> 4;
    const int nt = K / BK;
    unsigned voffA[2], voffB[2];
#pragma unroll
    for (int i = 0; i < 2; ++i) { int R, C; stage_rc(tid * 16 + i * 8192, R, C); const int Rb = Epi::PERM ? ((R & ~31) + perm32(R & 31)) : R;
        voffA[i] = (unsigned)(R * K + C) * 2u; voffB[i] = (unsigned)(Rb * K + C) * 2u; }
    const size_t kstep = (size_t)(BK * 2);
    const size_t hstep = (size_t)HALF * K * 2;
    const unsigned ldsw = (unsigned)wid * 1024u;
    const int aoff = lds_byte(wr * 64 + fr, fq * 8), boff = lds_byte(wc * 32 + fr, fq * 8);
#define PG8_SA(b, h) (((b) * 2 + (h)) * HTB)
#define PG8_SB(b, h) ((4 + (b) * 2 + (h)) * HTB)
#define PG8_STAGE(bufoff, gbase, voff) do { _Pragma("unroll") for (int _i = 0; _i < 2; ++_i) \
        __builtin_amdgcn_global_load_lds((const unsigned*)((const char*)(gbase) + (voff)[_i]), (LAS unsigned*)(lds + (bufoff) + ldsw + _i * 8192), 16, 0, 0); } while (0)
#define PG8_LDA(dst, b, h) do { _Pragma("unroll") for (int m = 0; m < 4; ++m) _Pragma("unroll") for (int k = 0; k < 2; ++k) dst[m][k] = *(const LAS bf16x8*)(lds + PG8_SA(b, h) + aoff + m * 2048 + k * 1024); } while (0)
#define PG8_LDB(dst, b, h) do { _Pragma("unroll") for (int n = 0; n < 2; ++n) _Pragma("unroll") for (int k = 0; k < 2; ++k) dst[n][k] = *(const LAS bf16x8*)(lds + PG8_SB(b, h) + boff + n * 2048 + k * 1024); } while (0)
#define PG8_MMA(ai, bj, At, Bt) do { __builtin_amdgcn_s_setprio(1); _Pragma("unroll") for (int m = 0; m < 4; ++m) _Pragma("unroll") for (int n = 0; n < 2; ++n) _Pragma("unroll") for (int k = 0; k < 2; ++k) \
        acc[ai][bj][m][n] = __builtin_amdgcn_mfma_f32_16x16x32_bf16(Bt[n][k], At[m][k], acc[ai][bj][m][n], 0, 0, 0); __builtin_amdgcn_s_setprio(0); } while (0)
#define PG8_WAIT_V(n) asm volatile("s_waitcnt vmcnt(" #n ")" ::: "memory")
#define PG8_WAIT_L(n) asm volatile("s_waitcnt lgkmcnt(" #n ")" ::: "memory")
#define PG8_BAR __builtin_amdgcn_s_barrier()
#define PG8_SCHED __builtin_amdgcn_sched_barrier(0)
    Unit cur, nxt; int ui = 0;
    if (!S.next(0, cur)) return;
    f32x4 acc[2][2][4][2];
#pragma unroll
    for (int a = 0; a < 2; ++a)
#pragma unroll
        for (int b = 0; b < 2; ++b)
#pragma unroll
            for (int m = 0; m < 4; ++m)
#pragma unroll
                for (int n = 0; n < 2; ++n) acc[a][b][m][n] = (f32x4){0.f, 0.f, 0.f, 0.f};
    bf16x8 At[4][2], B0[2][2], B1[2][2];
    const char* cA = cur.A; const char* cB = cur.B;
    if constexpr (SP2) {
        PG8_STAGE(PG8_SB(0, 0), cB, voffB); PG8_STAGE(PG8_SB(0, 1), cB + hstep, voffB); PG8_STAGE(PG8_SA(0, 0), cA, voffA); PG8_STAGE(PG8_SA(0, 1), cA + hstep, voffA);
        if (wr == 1) PG8_BAR;
        PG8_WAIT_V(2); PG8_BAR;
        PG8_STAGE(PG8_SB(1, 0), cB + kstep, voffB); PG8_STAGE(PG8_SA(1, 0), cA + kstep, voffA); PG8_STAGE(PG8_SB(1, 1), cB + hstep + kstep, voffB);
        PG8_WAIT_V(6); PG8_BAR;
    } else {
        PG8_STAGE(PG8_SB(0, 0), cB, voffB); PG8_STAGE(PG8_SA(0, 0), cA, voffA); PG8_STAGE(PG8_SB(0, 1), cB + hstep, voffB); PG8_STAGE(PG8_SA(0, 1), cA + hstep, voffA);
        if (wr == 1) PG8_BAR;
        PG8_WAIT_V(4); PG8_BAR;
        PG8_STAGE(PG8_SB(1, 0), cB + kstep, voffB); PG8_STAGE(PG8_SA(1, 0), cA + kstep, voffA); PG8_STAGE(PG8_SB(1, 1), cB + hstep + kstep, voffB);
        PG8_WAIT_V(6); PG8_BAR;
    }
    for (;;) {
        const bool has_next = S.next(ui + 1, nxt);
        const char* nA = has_next ? nxt.A : cA; const char* nB = has_next ? nxt.B : cB;
        for (int t = 0; t < nt; t += 2) {
            const bool last = (t == nt - 2);
            const char* a1 = cA + (size_t)(t + 1) * kstep;
            const char* a2 = last ? nA : cA + (size_t)(t + 2) * kstep; const char* b2 = last ? nB : cB + (size_t)(t + 2) * kstep;
            const char* a3 = a2 + kstep; const char* b3 = b2 + kstep;
            if constexpr (SP2) {
            PG8_LDB(B0, 0, 0); PG8_LDB(B1, 0, 1); PG8_SCHED; PG8_LDA(At, 0, 0); PG8_STAGE(PG8_SA(1, 1), a1 + hstep, voffA);
            PG8_WAIT_V(8); PG8_WAIT_L(0); PG8_BAR; PG8_MMA(0, 0, At, B0); PG8_MMA(0, 1, At, B1); PG8_BAR; PG8_SCHED;
            PG8_LDA(At, 0, 1); PG8_STAGE(PG8_SB(0, 0), b2, voffB); PG8_STAGE(PG8_SB(0, 1), b2 + hstep, voffB); PG8_STAGE(PG8_SA(0, 0), a2, voffA);
            PG8_WAIT_V(8); PG8_WAIT_L(0); PG8_BAR; PG8_MMA(1, 0, At, B0); PG8_MMA(1, 1, At, B1); PG8_BAR; PG8_SCHED;
            PG8_LDB(B0, 1, 0); PG8_LDB(B1, 1, 1); PG8_SCHED; PG8_LDA(At, 1, 0); PG8_STAGE(PG8_SA(0, 1), a2 + hstep, voffA);
            PG8_WAIT_V(8); PG8_WAIT_L(0); PG8_BAR; PG8_MMA(0, 0, At, B0); PG8_MMA(0, 1, At, B1); PG8_BAR; PG8_SCHED;
            PG8_LDA(At, 1, 1); PG8_STAGE(PG8_SB(1, 0), b3, voffB); PG8_STAGE(PG8_SB(1, 1), b3 + hstep, voffB); PG8_STAGE(PG8_SA(1, 0), a3, voffA);
            PG8_WAIT_V(8); PG8_WAIT_L(0); PG8_BAR; PG8_MMA(1, 0, At, B0); PG8_MMA(1, 1, At, B1); PG8_BAR; PG8_SCHED;
            } else {
            PG8_LDB(B0, 0, 0); PG8_SCHED; PG8_LDA(At, 0, 0); PG8_STAGE(PG8_SA(1, 1), a1 + hstep, voffA);
            PG8_WAIT_L(8); PG8_BAR; PG8_WAIT_L(0); PG8_MMA(0, 0, At, B0); PG8_BAR; PG8_SCHED;
            PG8_LDB(B1, 0, 1); PG8_STAGE(PG8_SB(0, 0), b2, voffB);
            PG8_BAR; PG8_WAIT_L(0); PG8_MMA(0, 1, At, B1); PG8_BAR;
            PG8_LDA(At, 0, 1); PG8_STAGE(PG8_SA(0, 0), a2, voffA);
            PG8_BAR; PG8_WAIT_L(0); PG8_MMA(1, 0, At, B0); PG8_BAR; PG8_SCHED;
            PG8_STAGE(PG8_SB(0, 1), b2 + hstep, voffB);
            PG8_WAIT_V(6); PG8_BAR; PG8_MMA(1, 1, At, B1); PG8_BAR;
            PG8_LDB(B0, 1, 0); PG8_SCHED; PG8_LDA(At, 1, 0); PG8_STAGE(PG8_SA(0, 1), a2 + hstep, voffA);
            PG8_WAIT_L(8); PG8_BAR; PG8_WAIT_L(0); PG8_MMA(0, 0, At, B0); PG8_BAR; PG8_SCHED;
            PG8_LDB(B1, 1, 1); PG8_STAGE(PG8_SB(1, 0), b3, voffB);
            PG8_BAR; PG8_WAIT_L(0); PG8_MMA(0, 1, At, B1); PG8_BAR;
            PG8_LDA(At, 1, 1); PG8_STAGE(PG8_SA(1, 0), a3, voffA);
            PG8_BAR; PG8_WAIT_L(0); PG8_MMA(1, 0, At, B0); PG8_BAR; PG8_SCHED;
            PG8_STAGE(PG8_SB(1, 1), b3 + hstep, voffB);
            PG8_WAIT_V(6); PG8_BAR; PG8_MMA(1, 1, At, B1); PG8_BAR;
            }
        }
        if constexpr (ALIGN_EPI) { if (wr == 0) PG8_BAR; }
        E(acc, cur, wr, wc, fr, fq);
        if (!has_next) break;
#pragma unroll
        for (int a = 0; a < 2; ++a)
#pragma unroll
            for (int b = 0; b < 2; ++b)
#pragma unroll
                for (int m = 0; m < 4; ++m)
#pragma unroll
                    for (int n = 0; n < 2; ++n) acc[a][b][m][n] = (f32x4){0.f, 0.f, 0.f, 0.f};
        cur = nxt; cA = nA; cB = nB; ++ui;
        if constexpr (ALIGN_EPI) { if (wr == 1) PG8_BAR; }
    }
    PG8_WAIT_V(0);
    if constexpr (!ALIGN_EPI) { if (wr == 0) PG8_BAR; }
    PG8_BAR;
#undef PG8_SA
#undef PG8_SB
#undef PG8_STAGE
#undef PG8_LDA
#undef PG8_LDB
#undef PG8_MMA
#undef PG8_WAIT_V
#undef PG8_WAIT_L
#undef PG8_BAR
#undef PG8_SCHED
}
}
enum { EM_PLAIN = 0, EM_GELU4 = 1, EM_SWIGLU = 2, EM_ROTARY = 3, EM_ROWBIAS = 4 };
struct EpiMulti {
    static constexpr bool PERM = true;
    const LAS pg8::JobDesc* jt;
    __device__ __forceinline__ void operator()(const f32x4 (&acc)[2][2][4][2], const pg8::Unit& u, int wr, int wc, int fr, int fq) const {
        const LAS pg8::JobDesc* jd = jt + u.job;
        bf16_t* out = (bf16_t*)pg8::rfl64(jd->out);
        const int ldc = __builtin_amdgcn_readfirstlane(jd->ldc);
        const int mode = __builtin_amdgcn_readfirstlane(jd->mode);
        const float* bias = (const float*)pg8::rfl64(jd->bias);
        const int row0 = u.pm * 256 + wr * 64 + fr;
        const int colt = u.pn * 256 + wc * 32 + 8 * fq;
        if (mode == EM_PLAIN || mode == EM_ROWBIAS) {
#pragma unroll
            for (int ai = 0; ai < 2; ++ai)
#pragma unroll
                for (int m = 0; m < 4; ++m) { const int row = row0 + ai * 128 + m * 16; const float rb = (mode == EM_ROWBIAS && bias) ? bias[row] : 0.f;
                    bf16_t* rowp = out + (size_t)row * ldc + colt;
#pragma unroll
                    for (int bj = 0; bj < 2; ++bj) { const f32x4 v0 = acc[ai][bj][m][0] + rb, v1 = acc[ai][bj][m][1] + rb;
                        u32x4 w; w.x = pk2(v0[0], v0[1]); w.y = pk2(v0[2], v0[3]); w.z = pk2(v1[0], v1[1]); w.w = pk2(v1[2], v1[3]);
                        *(u32x4*)(rowp + bj * 128) = w; } }
        } else if (mode == EM_GELU4) {
            const int arr = u.pn >> 1; bf16_t* base = out + (size_t)arr * NT * 512; const int col = colt - arr * 512; const bool act = arr < 2;
#pragma unroll
            for (int ai = 0; ai < 2; ++ai)
#pragma unroll
                for (int m = 0; m < 4; ++m) { bf16_t* rowp = base + (size_t)(row0 + ai * 128 + m * 16) * 512 + col;
#pragma unroll
                    for (int bj = 0; bj < 2; ++bj) { f32x4 v0 = acc[ai][bj][m][0], v1 = acc[ai][bj][m][1];
                        if (act) {
#pragma unroll
                            for (int e = 0; e < 4; ++e) { v0[e] = gelu_tanh_f(v0[e]); v1[e] = gelu_tanh_f(v1[e]); } }
                        u32x4 w; w.x = pk2(v0[0], v0[1]); w.y = pk2(v0[2], v0[3]); w.z = pk2(v1[0], v1[1]); w.w = pk2(v1[2], v1[3]);
                        *(u32x4*)(rowp + bj * 128) = w; } }
        } else if (mode == EM_SWIGLU) {
#pragma unroll
            for (int ai = 0; ai < 2; ++ai)
#pragma unroll
                for (int m = 0; m < 4; ++m) { bf16_t* rowp = out + (size_t)(row0 + ai * 128 + m * 16) * ldc + (colt >> 1);
#pragma unroll
                    for (int bj = 0; bj < 2; ++bj) { const f32x4 v0 = acc[ai][bj][m][0], v1 = acc[ai][bj][m][1];
                        u32x2 w; w.x = pk2(silu_f(v0[0]) * v0[1], silu_f(v0[2]) * v0[3]); w.y = pk2(silu_f(v1[0]) * v1[1], silu_f(v1[2]) * v1[3]);
                        *(u32x2*)(rowp + bj * 64) = w; } }
        } else {
            const float* rot = (const float*)pg8::rfl64(jd->rot);
            bf16_t* out2 = (bf16_t*)pg8::rfl64(jd->out2);
            const bool isk = u.pn >= 4; bf16_t* base = isk ? out2 : out; const int ld = isk ? 256 : 1024; const int colo = isk ? colt - 1024 : colt;
            float bv[2][8];
#pragma unroll
            for (int bj = 0; bj < 2; ++bj)
#pragma unroll
                for (int e = 0; e < 8; ++e) bv[bj][e] = bias ? bias[colt + bj * 128 + e] : 0.f;
            const int i0 = (colt & 63) >> 1;
#pragma unroll
            for (int ai = 0; ai < 2; ++ai)
#pragma unroll
                for (int m = 0; m < 4; ++m) { const int row = row0 + ai * 128 + m * 16; const int pos = row & (SEQ - 1);
                    const f32x4 cs0 = *(const f32x4*)(rot + ((size_t)pos * 32 + i0) * 2), cs1 = *(const f32x4*)(rot + ((size_t)pos * 32 + i0 + 2) * 2);
                    bf16_t* rowp = base + (size_t)row * ld + colo;
#pragma unroll
                    for (int bj = 0; bj < 2; ++bj) { f32x4 v0 = acc[ai][bj][m][0], v1 = acc[ai][bj][m][1];
#pragma unroll
                        for (int e = 0; e < 4; ++e) { v0[e] += bv[bj][e]; v1[e] += bv[bj][4 + e]; }
                        const float a0 = v0[0] * cs0[0] - v0[1] * cs0[1], b0 = v0[1] * cs0[0] + v0[0] * cs0[1];
                        const float a1 = v0[2] * cs0[2] - v0[3] * cs0[3], b1 = v0[3] * cs0[2] + v0[2] * cs0[3];
                        const float a2 = v1[0] * cs1[0] - v1[1] * cs1[1], b2 = v1[1] * cs1[0] + v1[0] * cs1[1];
                        const float a3 = v1[2] * cs1[2] - v1[3] * cs1[3], b3 = v1[3] * cs1[2] + v1[2] * cs1[3];
                        u32x4 w; w.x = pk2(a0, b0); w.y = pk2(a1, b1); w.z = pk2(a2, b2); w.w = pk2(a3, b3);
                        *(u32x4*)(rowp + bj * 128) = w; } }
        }
    }
};
enum { RM_IDENT = 0, RM_ROT = 1, RM_PAIR0 = 2, RM_PAIR1 = 3 };
__device__ __forceinline__ int rowmap(int kind, int n) {
    if (kind == RM_ROT) { if (n >= 1280) return n; const int d = n & 63; return (n & ~63) + 2 * (d & 31) + (d >> 5); }
    if (kind == RM_PAIR0) return 2 * n;
    if (kind == RM_PAIR1) return 2 * n + 1;
    return n;
}
__device__ __forceinline__ void transpose_item(const float* __restrict__ W, int ldw, int K, bf16_t* __restrict__ WT, LAS float* scr, int kb, int nb, int lane, int kind, float scale, int nscale) {
    const int k0 = 64 * kb, n0 = 32 * nb;
    float tv[32];
#pragma unroll
    for (int i = 0; i < 32; ++i) { const int kk = 2 * i + (lane >> 5); tv[i] = W[(size_t)(k0 + kk) * ldw + n0 + (lane & 31)]; }
#pragma unroll
    for (int i = 0; i < 32; ++i) { const int kk = 2 * i + (lane >> 5); scr[kk * 33 + (lane & 31)] = tv[i]; }
    __builtin_amdgcn_s_waitcnt(0xc07f); asm volatile("" ::: "memory");
    const int c = lane & 7;
#pragma unroll
    for (int j = 0; j < 4; ++j) { const int n = (lane >> 3) + 8 * j; const LAS float* s = scr + (8 * c) * 33 + n; const float sc = (n0 + n) < nscale ? scale : 1.f;
        u32x4 o; o.x = pk2(s[0 * 33] * sc, s[1 * 33] * sc); o.y = pk2(s[2 * 33] * sc, s[3 * 33] * sc); o.z = pk2(s[4 * 33] * sc, s[5 * 33] * sc); o.w = pk2(s[6 * 33] * sc, s[7 * 33] * sc);
        *(u32x4*)(WT + (size_t)rowmap(kind, n0 + n) * K + k0 + 8 * c) = o; }
    __builtin_amdgcn_s_waitcnt(0xc07f); asm volatile("" ::: "memory");
}
__device__ __forceinline__ void convert_mats(const float* W, int K, int N, int nbat, size_t sstr, bf16_t* WT, size_t dstr, int kind, float scale, int nscale, LAS float* scr, int gw, int ngw, int lane) {
    const int nblk = N / 32, per = (K / 64) * nblk, total = per * nbat;
    for (int it = gw; it < total; it += ngw) { const int bt = it / per, r = it - bt * per; transpose_item(W + (size_t)bt * sstr, N, K, WT + (size_t)bt * dstr, scr, r / nblk, r % nblk, lane, kind, scale, nscale); }
}
__device__ __forceinline__ void convert_rows(const float* __restrict__ src, bf16_t* __restrict__ dst, size_t n, int gt, int ngt) {
    const size_t step = (size_t)ngt * 8; size_t i = (size_t)gt * 8;
    for (; i + 3 * step < n; i += 4 * step) { f32x4 a[4], b[4];
#pragma unroll
        for (int j = 0; j < 4; ++j) { a[j] = *(const f32x4*)(src + i + j * step); b[j] = *(const f32x4*)(src + i + j * step + 4); }
#pragma unroll
        for (int j = 0; j < 4; ++j) { u32x4 o; o.x = pk2(a[j][0], a[j][1]); o.y = pk2(a[j][2], a[j][3]); o.z = pk2(b[j][0], b[j][1]); o.w = pk2(b[j][2], b[j][3]); *(u32x4*)(dst + i + j * step) = o; } }
    for (; i < n; i += step) { const f32x4 a = *(const f32x4*)(src + i), b = *(const f32x4*)(src + i + 4);
        u32x4 o; o.x = pk2(a[0], a[1]); o.y = pk2(a[2], a[3]); o.z = pk2(b[0], b[1]); o.w = pk2(b[2], b[3]); *(u32x4*)(dst + i) = o; }
}

struct LnArgs { const float* xin32; const bf16_t* xin; float* xout32; bf16_t* xbf; const bf16_t* y; const float* g; const float* b; const int* dest; const float* wts; };
template <int NR, bool XF32, bool OUTF32, bool MOE>
__device__ __forceinline__ void ln_rows(const LnArgs& a, int row0, int lane) {
    f32x4 v[NR][4];
    {
        int d0[NR], d1[NR]; float w0[NR], w1[NR];
        if (MOE) {
#pragma unroll
            for (int i = 0; i < NR; ++i) { d0[i] = a.dest[(row0 + i) * 2]; d1[i] = a.dest[(row0 + i) * 2 + 1]; w0[i] = a.wts[(row0 + i) * 2]; w1[i] = a.wts[(row0 + i) * 2 + 1]; }
        }
        f32x4 x[NR][4]; u32x2 p[NR][4], q[NR][4];
#pragma unroll
        for (int i = 0; i < NR; ++i) {
            const u32x2* y0 = (const u32x2*)(a.y + (size_t)(MOE ? d0[i] : row0 + i) * DM) + lane; const u32x2* y1 = (const u32x2*)(a.y + (size_t)(MOE ? d1[i] : 0) * DM) + lane;
#pragma unroll
            for (int j = 0; j < 4; ++j) {
                if (XF32) x[i][j] = ((const f32x4*)(a.xin32 + (size_t)(row0 + i) * DM) + lane)[64 * j];
                else { const u32x2 xb = ((const u32x2*)(a.xin + (size_t)(row0 + i) * DM) + lane)[64 * j]; x[i][j] = (f32x4){bf_lo(xb.x), bf_hi(xb.x), bf_lo(xb.y), bf_hi(xb.y)}; }
                p[i][j] = y0[64 * j]; if (MOE) q[i][j] = y1[64 * j]; } }
#pragma unroll
        for (int i = 0; i < NR; ++i)
#pragma unroll
            for (int j = 0; j < 4; ++j) {
                if (MOE) v[i][j] = (f32x4){ALPHA * x[i][j][0] + w0[i] * bf_lo(p[i][j].x) + w1[i] * bf_lo(q[i][j].x), ALPHA * x[i][j][1] + w0[i] * bf_hi(p[i][j].x) + w1[i] * bf_hi(q[i][j].x),
                                           ALPHA * x[i][j][2] + w0[i] * bf_lo(p[i][j].y) + w1[i] * bf_lo(q[i][j].y), ALPHA * x[i][j][3] + w0[i] * bf_hi(p[i][j].y) + w1[i] * bf_hi(q[i][j].y)};
                else v[i][j] = (f32x4){ALPHA * x[i][j][0] + bf_lo(p[i][j].x), ALPHA * x[i][j][1] + bf_hi(p[i][j].x), ALPHA * x[i][j][2] + bf_lo(p[i][j].y), ALPHA * x[i][j][3] + bf_hi(p[i][j].y)}; }
    }
    float s[NR];
#pragma unroll
    for (int i = 0; i < NR; ++i) { s[i] = 0.f;
#pragma unroll
        for (int j = 0; j < 4; ++j) s[i] += (v[i][j][0] + v[i][j][1]) + (v[i][j][2] + v[i][j][3]); }
#pragma unroll
    for (int o = 1; o < 64; o <<= 1)
#pragma unroll
        for (int i = 0; i < NR; ++i) s[i] += __shfl_xor(s[i], o);
    float q2[NR];
#pragma unroll
    for (int i = 0; i < NR; ++i) { const float mean = s[i] * (1.f / DM); q2[i] = 0.f;
#pragma unroll
        for (int j = 0; j < 4; ++j) { v[i][j] = v[i][j] - mean; q2[i] += (v[i][j][0] * v[i][j][0] + v[i][j][1] * v[i][j][1]) + (v[i][j][2] * v[i][j][2] + v[i][j][3] * v[i][j][3]); } }
#pragma unroll
    for (int o = 1; o < 64; o <<= 1)
#pragma unroll
        for (int i = 0; i < NR; ++i) q2[i] += __shfl_xor(q2[i], o);
    const f32x4* gp = (const f32x4*)a.g + lane; const f32x4* bp = (const f32x4*)a.b + lane;
    f32x4 gv[4], bv[4];
#pragma unroll
    for (int j = 0; j < 4; ++j) { gv[j] = gp[64 * j]; bv[j] = bp[64 * j]; }
#pragma unroll
    for (int i = 0; i < NR; ++i) { const float rstd = rsqrtf(q2[i] * (1.f / DM) + LN_EPS);
#pragma unroll
        for (int j = 0; j < 4; ++j) { const f32x4 o = v[i][j] * rstd * gv[j] + bv[j];
            if (OUTF32) ((f32x4*)(a.xout32 + (size_t)(row0 + i) * DM) + lane)[64 * j] = o;
            else { u32x2 w; w.x = pk2(o[0], o[1]); w.y = pk2(o[2], o[3]); ((u32x2*)(a.xbf + (size_t)(row0 + i) * DM) + lane)[64 * j] = w; } } }
}
template <bool XF32, bool OUTF32, bool MOE>
__device__ __forceinline__ void ln_phase(const LnArgs& a, int blk, int G, int wave, int lane) {
    const int per = NT / G, r0 = blk * per, pw = per / NWAVE;
    for (int r = 0; r < pw; r += 4) ln_rows<4, XF32, OUTF32, MOE>(a, r0 + wave * pw + r, lane);
}
__device__ __forceinline__ void xattn_phase(LAS unsigned char* lds, const bf16_t* __restrict__ Q, const bf16_t* __restrict__ KC, const bf16_t* __restrict__ VT, bf16_t* __restrict__ O, int blk, int G) {
    int tid_ = threadIdx.x; asm volatile("" : "+v"(tid_)); const int tid = tid_, lane = tid & 63, wave = __builtin_amdgcn_readfirstlane(tid >> 6), r32 = lane & 31, hh = lane >> 5;
    for (int u = blk; u < 512; u += G) {
        const int qb = u & 15, h = (u >> 4) & 3, b = u >> 6;
        const size_t qrow = (size_t)b * SEQ + qb * 256 + wave * 32 + r32;
        __syncthreads();
#pragma unroll
        for (int bt = 0; bt < 2; ++bt) {
            u32x4 t[8];
#pragma unroll
            for (int i = 0; i < 8; ++i) { const int ch = tid + 512 * (bt * 8 + i), row = ch >> 5, c = ch & 31; t[i] = *(const u32x4*)(KC + (size_t)(b * 256 + row) * 1024 + h * 256 + c * 8); }
#pragma unroll
            for (int i = 0; i < 8; ++i) { const int ch = tid + 512 * (bt * 8 + i), row = ch >> 5, c = ch & 31; *(LAS u32x4*)(lds + row * 528 + c * 16) = t[i]; }
        }
        __syncthreads();
        f32x16 s[8];
#pragma unroll
        for (int mt = 0; mt < 8; ++mt)
#pragma unroll
            for (int r = 0; r < 16; ++r) s[mt][r] = 0.f;
#pragma unroll 1
        for (int kq = 0; kq < 4; ++kq) {
            bf16x8 qf[4];
#pragma unroll
            for (int ks = 0; ks < 4; ++ks) qf[ks] = *(const bf16x8*)(Q + qrow * 1024 + h * 256 + (kq * 4 + ks) * 16 + hh * 8);
            const LAS unsigned char* kbp = lds + r32 * 528 + (kq * 64 + hh * 8) * 2;
#pragma unroll
            for (int ks = 0; ks < 4; ++ks)
#pragma unroll
                for (int mt = 0; mt < 8; ++mt) { const bf16x8 a = *(const LAS bf16x8*)(kbp + mt * 32 * 528 + ks * 32); s[mt] = MFMA32(a, qf[ks], s[mt]); }
        }
        float mx = -INFINITY;
#pragma unroll
        for (int mt = 0; mt < 8; ++mt)
#pragma unroll
            for (int r = 0; r < 16; ++r) mx = fmaxf(mx, s[mt][r]);
        mx = xhalf_max(mx);
        float sm = 0.f; const float mxl = mx * LOG2E;
        u32x4 pf[8][2];
#pragma unroll
        for (int mt = 0; mt < 8; ++mt) {
#pragma unroll
            for (int r = 0; r < 16; ++r) { const float p = __builtin_amdgcn_exp2f(s[mt][r] * LOG2E - mxl); s[mt][r] = p; sm += p; }
#pragma unroll
            for (int sx = 0; sx < 2; ++sx) pf[mt][sx] = (u32x4){pk2(s[mt][8 * sx], s[mt][8 * sx + 1]), pk2(s[mt][8 * sx + 2], s[mt][8 * sx + 3]), pk2(s[mt][8 * sx + 4], s[mt][8 * sx + 5]), pk2(s[mt][8 * sx + 6], s[mt][8 * sx + 7])};
        }
        sm = xhalf_sum(sm);
        __syncthreads();
#pragma unroll
        for (int bt = 0; bt < 4; ++bt) {
            u32x4 t[4];
#pragma unroll
            for (int i = 0; i < 4; ++i) { const int ch = tid + 512 * (bt * 4 + i), row = ch >> 5, c = ch & 31; t[i] = *(const u32x4*)(VT + (size_t)(h * 256 + row) * 2048 + b * 256 + c * 8); }
#pragma unroll
            for (int i = 0; i < 4; ++i) { const int ch = tid + 512 * (bt * 4 + i), row = ch >> 5, c = ch & 31; LAS u32x2* d = (LAS u32x2*)(lds + row * 520 + c * 16); d[0] = (u32x2){t[i].x, t[i].y}; d[1] = (u32x2){t[i].z, t[i].w}; }
        }
        __syncthreads();
        const float inv = 1.f / sm;
        bf16_t* orow = O + qrow * 1024 + h * 256 + 4 * hh;
#pragma unroll 1
        for (int dh = 0; dh < 2; ++dh) {
            f32x16 o[4];
#pragma unroll
            for (int dt = 0; dt < 4; ++dt)
#pragma unroll
                for (int r = 0; r < 16; ++r) o[dt][r] = 0.f;
            const LAS unsigned char* vb = lds + (dh * 128 + r32) * 520 + 8 * hh;
#pragma unroll
            for (int mt = 0; mt < 8; ++mt)
#pragma unroll
                for (int sx = 0; sx < 2; ++sx) { const int kb = mt * 32 + 16 * sx; const bf16x8 pb = __builtin_bit_cast(bf16x8, pf[mt][sx]);
#pragma unroll
                    for (int dt = 0; dt < 4; ++dt) { const LAS unsigned char* q = vb + dt * 32 * 520 + kb * 2;
                        const s16x4 lo = *(const LAS s16x4*)q, hi = *(const LAS s16x4*)(q + 16);
                        const bf16x8 a = (bf16x8){lo[0], lo[1], lo[2], lo[3], hi[0], hi[1], hi[2], hi[3]}; o[dt] = MFMA32(a, pb, o[dt]); } }
#pragma unroll
            for (int dt = 0; dt < 4; ++dt)
#pragma unroll
                for (int g = 0; g < 4; ++g) { u32x2 w; w.x = pk2(o[dt][4 * g] * inv, o[dt][4 * g + 1] * inv); w.y = pk2(o[dt][4 * g + 2] * inv, o[dt][4 * g + 3] * inv); *(u32x2*)(orow + dh * 128 + dt * 32 + 8 * g) = w; }
        }
    }
}

struct RouteBufs { int* e; float* w; int* rank; int* dest; int* hist; int* tstart; };
__device__ __forceinline__ void moe_router_phase(LAS unsigned char* lds, const bf16_t* __restrict__ XBF, const bf16_t* __restrict__ WRT, const float* __restrict__ brg, const float* __restrict__ bre, const RouteBufs rb, int blk) {
    int tid_ = threadIdx.x; asm volatile("" : "+v"(tid_)); const int tid = tid_, lane = tid & 63, wave = __builtin_amdgcn_readfirstlane(tid >> 6), r32 = lane & 31, hh = lane >> 5;
    LAS unsigned char* XT = lds; LAS unsigned char* WT = lds + 128 * 528;
    LAS float* LG = (LAS float*)lds;
    LAS int* hist = (LAS int*)(lds + 128 * 65 * 4);
    const int rbk = wave & 3, ct = wave >> 2;
    f32x16 acc;
#pragma unroll
    for (int r = 0; r < 16; ++r) acc[r] = 0.f;
#pragma unroll 1
    for (int kc = 0; kc < 4; ++kc) {
        __syncthreads();
        {   u32x4 tx[8], tw[8];
#pragma unroll
            for (int i = 0; i < 8; ++i) { const int ch = tid + 512 * i, row = ch >> 5, c = ch & 31; tx[i] = *(const u32x4*)(XBF + (size_t)(blk * 128 + row) * 1024 + kc * 256 + c * 8); tw[i] = *(const u32x4*)(WRT + (size_t)row * 1024 + kc * 256 + c * 8); }
#pragma unroll
            for (int i = 0; i < 8; ++i) { const int ch = tid + 512 * i, row = ch >> 5, c = ch & 31; *(LAS u32x4*)(XT + row * 528 + c * 16) = tx[i]; *(LAS u32x4*)(WT + row * 528 + c * 16) = tw[i]; } }
        __syncthreads();
        const LAS unsigned char* ap = XT + (rbk * 32 + r32) * 528 + hh * 16; const LAS unsigned char* bp = WT + (ct * 32 + r32) * 528 + hh * 16;
#pragma unroll
        for (int ks = 0; ks < 16; ++ks) { const bf16x8 a = *(const LAS bf16x8*)(ap + ks * 32), b0 = *(const LAS bf16x8*)(bp + ks * 32), b1 = *(const LAS bf16x8*)(bp + 64 * 528 + ks * 32);
            acc = MFMA32(a, b0, acc); acc = MFMA32(a, b1, acc); }
    }
    __syncthreads();
    if (tid < 32) hist[tid] = 0;
#pragma unroll
    for (int r = 0; r < 16; ++r) LG[(rbk * 32 + crow(r, hh)) * 65 + ct * 32 + r32] = acc[r];
    __syncthreads();
    if (tid < 128) {
        const LAS float* lg = LG + tid * 65; const int tok = blk * 128 + tid;
        float g4[4];
#pragma unroll
        for (int g = 0; g < 4; ++g) g4[g] = lg[32 + g] + brg[g];
        int gi = 0; float gm = g4[0];
#pragma unroll
        for (int g = 1; g < 4; ++g) if (g4[g] > gm) { gm = g4[g]; gi = g; }
        float gs = 0.f;
#pragma unroll
        for (int g = 0; g < 4; ++g) gs += fast_exp(g4[g] - gm);
        const float gate_g = 1.f / gs;
        float le[8];
#pragma unroll
        for (int e = 0; e < 8; ++e) le[e] = lg[gi * 8 + e] + bre[gi * 8 + e];
        int i0 = 0; float v0 = le[0];
#pragma unroll
        for (int e = 1; e < 8; ++e) if (le[e] > v0) { v0 = le[e]; i0 = e; }
        int i1 = 0; float v1 = -INFINITY;
#pragma unroll
        for (int e = 0; e < 8; ++e) if (e != i0 && le[e] > v1) { v1 = le[e]; i1 = e; }
        const float e1 = fast_exp(v1 - v0), p0 = 1.f / (1.f + e1), p1 = e1 * p0;
        const int ex0 = gi * 8 + i0, ex1 = gi * 8 + i1;
        rb.e[tok * 2] = ex0; rb.e[tok * 2 + 1] = ex1; rb.w[tok * 2] = gate_g * p0; rb.w[tok * 2 + 1] = gate_g * p1;
        rb.rank[tok * 2] = atomicAdd((int*)&hist[ex0], 1); rb.rank[tok * 2 + 1] = atomicAdd((int*)&hist[ex1], 1);
    }
    __syncthreads();
    if (tid < 32) rb.hist[blk * 32 + tid] = hist[tid];
}
__device__ __forceinline__ void moe_scatter_phase(LAS unsigned char* lds, const bf16_t* __restrict__ XBF, bf16_t* __restrict__ XG, const RouteBufs rb, int blk, int G) {
    int tid_ = threadIdx.x; asm volatile("" : "+v"(tid_)); const int tid = tid_, lane = tid & 63, wave = __builtin_amdgcn_readfirstlane(tid >> 6);
    LAS int* sb = (LAS int*)lds;
    __syncthreads();
    if (tid < 32) { int tot = 0, base = 0; for (int b = 0; b < G; ++b) { const int c = rb.hist[b * 32 + tid]; tot += c; if (b < blk) base += c; } sb[tid] = base; sb[32 + tid] = tot; }
    __syncthreads();
    if (tid == 0) { int acc = 0; for (int e = 0; e < 32; ++e) { sb[64 + e] = acc; if (blk == 0) rb.tstart[e] = acc >> 8; acc += (sb[32 + e] + 255) & ~255; } sb[96] = acc; if (blk == 0) rb.tstart[32] = acc >> 8; }
    __syncthreads();
    for (int a0 = wave * 4; a0 < 256; a0 += NWAVE * 4) {
        int d[4]; u32x4 v0[4], v1[4];
#pragma unroll
        for (int i = 0; i < 4; ++i) { const int idx = blk * 256 + a0 + i; const int e = rb.e[idx]; d[i] = sb[64 + e] + sb[e] + rb.rank[idx]; }
#pragma unroll
        for (int i = 0; i < 4; ++i) { const int idx = blk * 256 + a0 + i; const u32x4* src = (const u32x4*)(XBF + (size_t)(idx >> 1) * 1024) + lane; v0[i] = src[0]; v1[i] = src[64]; }
#pragma unroll
        for (int i = 0; i < 4; ++i) { const int idx = blk * 256 + a0 + i; if (lane == 0) rb.dest[idx] = d[i]; u32x4* dst = (u32x4*)(XG + (size_t)d[i] * 1024) + lane; dst[0] = v0[i]; dst[64] = v1[i]; }
    }
}
struct MoeSched {
    const char* A; const char* B; const int* tstart; int K, nN, G, c; size_t bexp;
    __device__ __forceinline__ bool next(int i, pg8::Unit& u) const {
        const int vc = (c & 7) * (G >> 3) + (c >> 3);
        const long L = (long)i * G + vc; const int ntile = tstart[32];
        if (L >= (long)ntile * nN) return false;
        const int mt = (int)(L / nN), nt = (int)(L % nN);
        int e = 0;
        for (int k = 1; k < 32; ++k) if (tstart[k] <= mt) e = k;
        u.A = A + (size_t)mt * 256 * K * 2; u.B = B + (size_t)e * bexp + (size_t)nt * 256 * K * 2; u.pm = mt; u.pn = nt; u.job = 0; return true;
    }
};
__device__ __forceinline__ void swa_phase(LAS unsigned char* lds, const bf16_t* __restrict__ Q1, const bf16_t* __restrict__ K1, const bf16_t* __restrict__ VT1, const float* __restrict__ sinks, bf16_t* __restrict__ O, int blk, int G) {
    int tid_ = threadIdx.x; asm volatile("" : "+v"(tid_)); const int tid = tid_, lane = tid & 63, wave = __builtin_amdgcn_readfirstlane(tid >> 6), r32 = lane & 31, hh = lane >> 5;
    LAS unsigned char* KL = lds;
    LAS unsigned char* VL = lds + 36864;
    for (int u = blk; u < 1024; u += G) {
        const int n = u & 31, kvh = (u >> 5) & 3, b = u >> 7;
        const int tokb = b * SEQ + (n - 1) * 128;
        __syncthreads();
#pragma unroll
        for (int i = 0; i < 4; ++i) { const int ch = tid + 512 * i; const int key = ch >> 3, c = ch & 7;
            u32x4 v = (u32x4){0u, 0u, 0u, 0u}; if (n > 0 || key >= 128) v = *(const u32x4*)(K1 + (size_t)(tokb + key) * 256 + kvh * 64 + c * 8);
            *(LAS u32x4*)(KL + key * 144 + c * 16) = v; }
#pragma unroll
        for (int i = 0; i < 4; ++i) { const int ch = tid + 512 * i; const int d = ch >> 5, c = ch & 31;
            u32x4 v = (u32x4){0u, 0u, 0u, 0u}; if (n > 0 || c >= 16) v = *(const u32x4*)(VT1 + (size_t)(kvh * 64 + d) * NT + tokb + c * 8);
            LAS u32x2* dp = (LAS u32x2*)(VL + d * 520 + c * 16); dp[0] = (u32x2){v.x, v.y}; dp[1] = (u32x2){v.z, v.w}; }
        __syncthreads();
        const int g = wave >> 1, hq = kvh * 4 + g; const float sink = sinks[hq];
#pragma unroll 1
        for (int sb = 0; sb < 2; ++sb) {
            const int i0 = (wave & 1) * 64 + sb * 32, jt0 = i0 >> 5;
            const size_t qtok = (size_t)b * SEQ + n * 128 + i0 + r32;
            bf16x8 qf[4];
#pragma unroll
            for (int ks = 0; ks < 4; ++ks) qf[ks] = *(const bf16x8*)(Q1 + qtok * 1024 + hq * 64 + ks * 16 + hh * 8);
            f32x16 s[5];
#pragma unroll
            for (int t = 0; t < 5; ++t) {
#pragma unroll
                for (int r = 0; r < 16; ++r) s[t][r] = 0.f;
                const LAS unsigned char* kp = KL + ((jt0 + t) * 32 + r32) * 144 + hh * 16;
#pragma unroll
                for (int ks = 0; ks < 4; ++ks) { const bf16x8 a = *(const LAS bf16x8*)(kp + ks * 32); s[t] = MFMA32(a, qf[ks], s[t]); }
            }
            const int qi = i0 + r32;
            float mx = sink;
#pragma unroll
            for (int t = 0; t < 5; ++t)
#pragma unroll
                for (int r = 0; r < 16; ++r) { const int kj = (jt0 + t) * 32 + crow(r, hh); const bool valid = (kj > qi) && (kj <= qi + 128) && (n > 0 || kj >= 128);
                    s[t][r] = valid ? s[t][r] : -INFINITY; mx = fmaxf(mx, s[t][r]); }
            mx = xhalf_max(mx);
            float sm = 0.f; const float mxl = mx * LOG2E;
            u32x4 pf[5][2];
#pragma unroll
            for (int t = 0; t < 5; ++t) {
#pragma unroll
                for (int r = 0; r < 16; ++r) { const float pv = __builtin_amdgcn_exp2f(s[t][r] * LOG2E - mxl); s[t][r] = pv; sm += pv; }
#pragma unroll
                for (int sx = 0; sx < 2; ++sx) pf[t][sx] = (u32x4){pk2(s[t][8 * sx], s[t][8 * sx + 1]), pk2(s[t][8 * sx + 2], s[t][8 * sx + 3]), pk2(s[t][8 * sx + 4], s[t][8 * sx + 5]), pk2(s[t][8 * sx + 6], s[t][8 * sx + 7])};
            }
            sm = xhalf_sum(sm) + __builtin_amdgcn_exp2f(sink * LOG2E - mxl);
            f32x16 o[2];
#pragma unroll
            for (int dt = 0; dt < 2; ++dt)
#pragma unroll
                for (int r = 0; r < 16; ++r) o[dt][r] = 0.f;
#pragma unroll
            for (int t = 0; t < 5; ++t)
#pragma unroll
                for (int sx = 0; sx < 2; ++sx) { const bf16x8 pb = __builtin_bit_cast(bf16x8, pf[t][sx]);
#pragma unroll
                    for (int dt = 0; dt < 2; ++dt) { const LAS unsigned char* q = VL + (dt * 32 + r32) * 520 + ((jt0 + t) * 32 + 16 * sx + 4 * hh) * 2;
                        const s16x4 lo = *(const LAS s16x4*)q, hi = *(const LAS s16x4*)(q + 16);
                        const bf16x8 a = (bf16x8){lo[0], lo[1], lo[2], lo[3], hi[0], hi[1], hi[2], hi[3]}; o[dt] = MFMA32(a, pb, o[dt]); } }
            const float inv = 1.f / sm;
            bf16_t* orow = O + qtok * 1024 + hq * 64 + 4 * hh;
#pragma unroll
            for (int dt = 0; dt < 2; ++dt)
#pragma unroll
                for (int gq = 0; gq < 4; ++gq) { u32x2 w; w.x = pk2(o[dt][4 * gq] * inv, o[dt][4 * gq + 1] * inv); w.y = pk2(o[dt][4 * gq + 2] * inv, o[dt][4 * gq + 3] * inv); *(u32x2*)(orow + dt * 32 + 8 * gq) = w; }
        }
    }
}
constexpr int TS = 272;
template <int STRIDE = TS>
__device__ __forceinline__ bf16x8 tr_frag(const LAS unsigned char* T, int k0, int c0, int lane, bool permuted) {
    const int hh = lane >> 5, blk = (lane >> 4) & 1, q = (lane & 15) >> 2, pp = lane & 3;
    const int r0 = k0 + (permuted ? 4 * hh : 8 * hh) + q, r1 = r0 + (permuted ? 8 : 4);
    const int cb = (c0 + 16 * blk + 4 * pp) * 2;
    const s16x4 lo = lds_tr(T + r0 * STRIDE + cb), hi = lds_tr(T + r1 * STRIDE + cb);
    return (bf16x8){lo[0], lo[1], lo[2], lo[3], hi[0], hi[1], hi[2], hi[3]};
}
__device__ __forceinline__ bf16x8 row_frag(const LAS unsigned char* T, int row, int k0, int hh) { return *(const LAS bf16x8*)(T + row * TS + (k0 + 8 * hh) * 2); }
__device__ __forceinline__ void load_tile128(LAS unsigned char* T, const bf16_t* __restrict__ g, int ld, int tid) {
#pragma unroll
    for (int i = 0; i < 4; ++i) { const int ch = tid + 512 * i, row = ch >> 4, c = ch & 15; *(LAS u32x4*)(T + row * TS + c * 16) = *(const u32x4*)(g + (size_t)row * ld + c * 8); }
}
struct L0Bufs {
    bf16_t *AU, *AV, *BX, *BZ, *V, *XC, *YM, *CS, *Q, *K; float *U, *GT, *UN, *NS, *SC;
    const bf16_t *WQT, *GMW, *WIFT; const float *gm_g, *gm_b, *gm_bs, *cw, *cb, *bif, *nw, *skip;
};

__device__ __forceinline__ void l0_mixA(LAS unsigned char* lds, const L0Bufs& B, int blk, int G) {
    const int tid0 = threadIdx.x, wave = __builtin_amdgcn_readfirstlane(tid0 >> 6);
#define OPQ_IDS int tid = tid0; asm volatile("" : "+v"(tid)); const int lane = tid & 63, r32 = lane & 31, hh = lane >> 5; (void)lane; (void)r32; (void)hh;
    LAS unsigned char* T0 = lds; LAS unsigned char* T1 = lds + 34816; LAS unsigned char* T2 = lds + 2 * 34816; LAS unsigned char* T3 = lds + 3 * 34816;
    LAS float* SF = (LAS float*)T2;
    LAS float* SG = (LAS float*)(lds + 3 * 34816 + 35632);
    for (int u = blk; u < 256; u += G) {
        const int tok0 = u * 128; const bool first = (u & 31) == 0;
        constexpr int VS = 1040;
        {   OPQ_IDS; const int trow = tid >> 2, q4 = tid & 3;
            const bf16_t* vr = B.AV + (size_t)(tok0 + trow) * 512 + q4 * 128; float s = 0.f, s2 = 0.f; u32x4 w[16];
#pragma unroll
            for (int i = 0; i < 16; ++i) w[i] = *(const u32x4*)(vr + i * 8);
#pragma unroll
            for (int i = 0; i < 16; ++i) { const float f[8] = {bf_lo(w[i].x), bf_hi(w[i].x), bf_lo(w[i].y), bf_hi(w[i].y), bf_lo(w[i].z), bf_hi(w[i].z), bf_lo(w[i].w), bf_hi(w[i].w)};
#pragma unroll
                for (int e = 0; e < 8; ++e) { s += f[e]; s2 += f[e] * f[e]; } }
            s += __shfl_xor(s, 1); s += __shfl_xor(s, 2); s2 += __shfl_xor(s2, 1); s2 += __shfl_xor(s2, 2);
            const float mean = s * (1.f / 512.f), rstd = rsqrtf(fmaxf(s2 * (1.f / 512.f) - mean * mean, 0.f) + LN_EPS);
            __syncthreads();
#pragma unroll
            for (int i = 0; i < 16; ++i) { const int cbase = q4 * 128 + i * 8; const f32x4 g0 = *(const f32x4*)(B.gm_g + cbase), g1 = *(const f32x4*)(B.gm_g + cbase + 4), b0 = *(const f32x4*)(B.gm_b + cbase), b1 = *(const f32x4*)(B.gm_b + cbase + 4);
                u32x4 o; o.x = pk2((bf_lo(w[i].x) - mean) * rstd * g0[0] + b0[0], (bf_hi(w[i].x) - mean) * rstd * g0[1] + b0[1]); o.y = pk2((bf_lo(w[i].y) - mean) * rstd * g0[2] + b0[2], (bf_hi(w[i].y) - mean) * rstd * g0[3] + b0[3]);
                o.z = pk2((bf_lo(w[i].z) - mean) * rstd * g1[0] + b1[0], (bf_hi(w[i].z) - mean) * rstd * g1[1] + b1[1]); o.w = pk2((bf_lo(w[i].w) - mean) * rstd * g1[2] + b1[2], (bf_hi(w[i].w) - mean) * rstd * g1[3] + b1[3]);
                *(LAS u32x4*)(lds + trow * VS + cbase * 2) = o; asm volatile("" ::: "memory"); }
            __syncthreads();
        }
        {   const int tb = wave & 3, dhf = wave >> 2;
#pragma unroll 1
            for (int g = 0; g < 4; ++g) {
                OPQ_IDS; const int t = 32 * tb + r32; const size_t tok = (size_t)tok0 + t;
                f32x16 acc[2];
#pragma unroll
                for (int dt = 0; dt < 2; ++dt)
#pragma unroll
                    for (int r = 0; r < 16; ++r) acc[dt][r] = 0.f;
                const bf16_t* wrow = B.GMW + ((size_t)g * 128 + t) * 128 + 8 * hh;
                bf16x8 bw[8];
#pragma unroll
                for (int ks = 0; ks < 8; ++ks) bw[ks] = *(const bf16x8*)(wrow + 16 * ks);
#pragma unroll
                for (int ks = 0; ks < 8; ++ks) if (ks <= 2 * tb + 1) {
#pragma unroll
                    for (int dt = 0; dt < 2; ++dt) { const bf16x8 a = tr_frag<VS>(lds, 16 * ks, g * 128 + 64 * dhf + 32 * dt, lane, false); acc[dt] = MFMA32(a, bw[ks], acc[dt]); } }
                const float bsv = B.gm_bs[g * 128 + t];
#pragma unroll
                for (int dt = 0; dt < 2; ++dt)
#pragma unroll
                    for (int gq = 0; gq < 4; ++gq) { const int col = g * 128 + 64 * dhf + 32 * dt + 8 * gq + 4 * hh; const u32x2 au = *(const u32x2*)(B.AU + tok * 512 + col);
                        u32x2 w; w.x = pk2(bf_lo(au.x) * (acc[dt][4 * gq] + bsv), bf_hi(au.x) * (acc[dt][4 * gq + 1] + bsv)); w.y = pk2(bf_lo(au.y) * (acc[dt][4 * gq + 2] + bsv), bf_hi(au.y) * (acc[dt][4 * gq + 3] + bsv));
                        *(u32x2*)(B.YM + tok * 1024 + col) = w; }
            }
        }
#pragma unroll 1
        for (int h = 0; h < 4; ++h) {
            OPQ_IDS;
            __syncthreads();
            for (int ch = tid; ch < 131 * 16; ch += 512) { const int row = ch >> 4, c = ch & 15; u32x4 v = (u32x4){0u, 0u, 0u, 0u};
                if (!(first && row < 3)) v = *(const u32x4*)(B.BX + (size_t)(tok0 - 3 + row) * 512 + h * 128 + c * 8);
                *(LAS u32x4*)(T3 + row * TS + c * 16) = v; }
            __syncthreads();
            {   const int dc = tid & 15, chn = h * 128 + dc * 8; float w[4][8], cbv[8];
#pragma unroll
                for (int j = 0; j < 4; ++j)
#pragma unroll
                    for (int e = 0; e < 8; ++e) w[j][e] = B.cw[j * 512 + chn + e];
#pragma unroll
                for (int e = 0; e < 8; ++e) cbv[e] = B.cb[chn + e];
#pragma unroll 1
                for (int ps = 0; ps < 4; ++ps) { const int t = ps * 32 + (tid >> 4); float a[8];
#pragma unroll
                    for (int e = 0; e < 8; ++e) a[e] = cbv[e];
#pragma unroll
                    for (int j = 0; j < 4; ++j) { const u32x4 x = *(const LAS u32x4*)(T3 + (t + j) * TS + dc * 16);
                        a[0] += w[j][0] * bf_lo(x.x); a[1] += w[j][1] * bf_hi(x.x); a[2] += w[j][2] * bf_lo(x.y); a[3] += w[j][3] * bf_hi(x.y);
                        a[4] += w[j][4] * bf_lo(x.z); a[5] += w[j][5] * bf_hi(x.z); a[6] += w[j][6] * bf_lo(x.w); a[7] += w[j][7] * bf_hi(x.w); }
                    u32x4 o; o.x = pk2(silu_f(a[0]), silu_f(a[1])); o.y = pk2(silu_f(a[2]), silu_f(a[3])); o.z = pk2(silu_f(a[4]), silu_f(a[5])); o.w = pk2(silu_f(a[6]), silu_f(a[7]));
                    *(LAS u32x4*)(T2 + t * TS + dc * 16) = o; *(u32x4*)(B.XC + (size_t)(tok0 + t) * 512 + chn) = o; } }
            __syncthreads();
            {   const int tb = wave & 3, ehf = wave >> 2;
#pragma unroll 1
                for (int mtx = 0; mtx < 3; ++mtx) {
                    OPQ_IDS;
                    const LAS unsigned char* act = mtx == 2 ? T3 + 3 * TS : T2;
                    const bf16_t* wbase = B.WQT + (((size_t)mtx * 4 + h) * 128 + 64 * ehf + r32) * 128 + 8 * hh;
                    f32x16 acc[2];
#pragma unroll
                    for (int et = 0; et < 2; ++et)
#pragma unroll
                        for (int r = 0; r < 16; ++r) acc[et][r] = 0.f;
#pragma unroll
                    for (int ks = 0; ks < 8; ++ks) { const bf16x8 bx = row_frag(act, 32 * tb + r32, 16 * ks, hh);
#pragma unroll
                        for (int et = 0; et < 2; ++et) { const bf16x8 a = *(const bf16x8*)(wbase + (size_t)et * 32 * 128 + 16 * ks); acc[et] = MFMA32(a, bx, acc[et]); } }
                    bf16_t* dst = (mtx == 0 ? B.Q : (mtx == 1 ? B.K : B.V)) + (size_t)(tok0 + 32 * tb + r32) * 512 + h * 128 + 64 * ehf + 4 * hh;
#pragma unroll
                    for (int et = 0; et < 2; ++et)
#pragma unroll
                        for (int gq = 0; gq < 4; ++gq) { u32x2 w; w.x = pk2(acc[et][4 * gq], acc[et][4 * gq + 1]); w.y = pk2(acc[et][4 * gq + 2], acc[et][4 * gq + 3]); *(u32x2*)(dst + 32 * et + 8 * gq) = w; }
                }
            }
        }
        __syncthreads();
        {
            OPQ_IDS; const int tb = wave & 3, kh = wave >> 2; f32x16 acc;
#pragma unroll
            for (int r = 0; r < 16; ++r) acc[r] = 0.f;
            const size_t tok = (size_t)tok0 + 32 * tb + r32;
#pragma unroll 4
            for (int ks = 0; ks < 48; ++ks) { const int i0 = kh * 768 + ks * 16 + 8 * hh;
                const bf16_t* src = i0 < 512 ? B.Q + tok * 512 + i0 : (i0 < 1024 ? B.K + tok * 512 + (i0 - 512) : B.V + tok * 512 + (i0 - 1024));
                const bf16x8 bx = *(const bf16x8*)src; const bf16x8 a = *(const bf16x8*)(B.WIFT + (size_t)r32 * 1536 + i0); acc = MFMA32(a, bx, acc); }
#pragma unroll
            for (int r = 0; r < 4; ++r) SF[(kh * 8 + r + 4 * hh) * 128 + 32 * tb + r32] = acc[r];
        }
        __syncthreads();
        LAS float* IG = SG; LAS float* BC = SG + 512; LAS float* WG = SG + 1024;
        if (wave < 4) {
            OPQ_IDS; const int h = wave; float lf[2], ig[2];
#pragma unroll
            for (int e = 0; e < 2; ++e) { const int t = 2 * lane + e; ig[e] = SF[h * 128 + t] + SF[(8 + h) * 128 + t] + B.bif[h];
                const float fx = SF[(4 + h) * 128 + t] + SF[(12 + h) * 128 + t] + B.bif[4 + h]; lf[e] = fminf(fx, 0.f) - log1pf(expf(-fabsf(fx))); }
            float run = lf[0] + lf[1];
#pragma unroll
            for (int o = 1; o < 64; o <<= 1) { const float v = __shfl_up(run, o); if (lane >= o) run += v; }
            const float b1 = run, b0 = run - lf[1];
            IG[h * 128 + 2 * lane] = ig[0]; IG[h * 128 + 2 * lane + 1] = ig[1]; BC[h * 128 + 2 * lane] = b0; BC[h * 128 + 2 * lane + 1] = b1;
            float* gt = B.GT + ((size_t)u * 4 + h) * 256;
            gt[2 * lane] = ig[0]; gt[2 * lane + 1] = ig[1]; gt[128 + 2 * lane] = b0; gt[128 + 2 * lane + 1] = b1;
            const float bl = __shfl(b1, 63);
            float g0 = bl - b0 + ig[0], g1 = bl - b1 + ig[1]; float mloc = fmaxf(g0, g1);
#pragma unroll
            for (int o = 1; o < 64; o <<= 1) mloc = fmaxf(mloc, __shfl_xor(mloc, o));
            WG[h * 128 + 2 * lane] = expf(g0 - mloc); WG[h * 128 + 2 * lane + 1] = expf(g1 - mloc);
            if (lane == 0) { B.SC[u * 4 + h] = bl; B.SC[1024 + u * 4 + h] = mloc; }
        }
#pragma unroll 1
        for (int h = 0; h < 4; ++h) {
            OPQ_IDS;
            __syncthreads();
#pragma unroll
            for (int i = 0; i < 4; ++i) { const int ch = tid + 512 * i, row = ch >> 4, c = ch & 15; const float wg = WG[h * 128 + row];
                const u32x4 v = *(const u32x4*)(B.V + (size_t)(tok0 + row) * 512 + h * 128 + c * 8), k = *(const u32x4*)(B.K + (size_t)(tok0 + row) * 512 + h * 128 + c * 8);
                u32x4 ov, ok; const float ksc = 0.08838834764831845f;
                ov.x = pk2(bf_lo(v.x) * wg, bf_hi(v.x) * wg); ov.y = pk2(bf_lo(v.y) * wg, bf_hi(v.y) * wg); ov.z = pk2(bf_lo(v.z) * wg, bf_hi(v.z) * wg); ov.w = pk2(bf_lo(v.w) * wg, bf_hi(v.w) * wg);
                ok.x = pk2(bf_lo(k.x) * ksc, bf_hi(k.x) * ksc); ok.y = pk2(bf_lo(k.y) * ksc, bf_hi(k.y) * ksc); ok.z = pk2(bf_lo(k.z) * ksc, bf_hi(k.z) * ksc); ok.w = pk2(bf_lo(k.w) * ksc, bf_hi(k.w) * ksc);
                *(LAS u32x4*)(T0 + row * TS + c * 16) = ov; *(LAS u32x4*)(T1 + row * TS + c * 16) = ok; }
            __syncthreads();
            const int vb = wave & 3, khf = wave >> 2;
            f32x16 acc[2];
#pragma unroll
            for (int kt = 0; kt < 2; ++kt)
#pragma unroll
                for (int r = 0; r < 16; ++r) acc[kt][r] = 0.f;
#pragma unroll
            for (int ks = 0; ks < 8; ++ks) { const bf16x8 a = tr_frag(T0, 16 * ks, 32 * vb, lane, false);
#pragma unroll
                for (int kt = 0; kt < 2; ++kt) { const bf16x8 bk = tr_frag(T1, 16 * ks, 64 * khf + 32 * kt, lane, false); acc[kt] = MFMA32(a, bk, acc[kt]); } }
            float* Uo = B.U + ((size_t)u * 4 + h) * 16384;
#pragma unroll
            for (int kt = 0; kt < 2; ++kt)
#pragma unroll
                for (int r = 0; r < 16; ++r) Uo[(32 * vb + crow(r, hh)) * 128 + 64 * khf + 32 * kt + r32] = acc[kt][r];
            {   const int kk = tid & 127, sq = tid >> 7; float a = 0.f;
                for (int s = sq * 32; s < sq * 32 + 32; ++s) a += WG[h * 128 + s] * bf2f(*(const LAS bf16_t*)(T1 + s * TS + kk * 2));
                SF[2048 + sq * 128 + kk] = a; }
            __syncthreads();
            if (tid < 128) B.UN[((size_t)u * 4 + h) * 128 + tid] = (SF[2048 + tid] + SF[2048 + 128 + tid]) + (SF[2048 + 256 + tid] + SF[2048 + 384 + tid]);
        }
    }
}
#undef OPQ_IDS
__device__ __forceinline__ void l0_scan(const L0Bufs& B, int blk) {
    int tid_ = threadIdx.x; asm volatile("" : "+v"(tid_)); const int tid = tid_, bh = blk >> 3, part = blk & 7, b = bh >> 2, h = bh & 3;
    const int e0 = part * 2048 + tid * 4;
    f32x4 C = (f32x4){0.f, 0.f, 0.f, 0.f}; float nst = 0.f; float m = 0.f;
    const int unit0 = (b * 32) * 4 + h;
    f32x4 Un = *(const f32x4*)(B.U + (size_t)unit0 * 16384 + e0); float bln = B.SC[unit0], mln = B.SC[1024 + unit0];
    float unn = (part == 0 && tid < 128) ? B.UN[(size_t)unit0 * 128 + tid] : 0.f;
    for (int c = 0; c < 32; ++c) {
        const int unit = unit0 + 4 * c;
        const f32x4 U = Un; const float bl = bln, mloc = mln, un = unn;
        if (c < 31) { const int un1 = unit + 4; Un = *(const f32x4*)(B.U + (size_t)un1 * 16384 + e0); bln = B.SC[un1]; mln = B.SC[1024 + un1]; if (part == 0 && tid < 128) unn = B.UN[(size_t)un1 * 128 + tid]; }
        u32x2 w; w.x = pk2(C[0], C[1]); w.y = pk2(C[2], C[3]); *(u32x2*)(B.CS + (size_t)unit * 16384 + e0) = w;
        if (part == 0 && tid < 128) B.NS[(size_t)unit * 128 + tid] = nst;
        if (part == 0 && tid == 0) B.SC[2048 + unit] = m;
        const float mn = fmaxf(bl + m, mloc), dec = expf(bl + m - mn), wu = expf(mloc - mn); m = mn;
        C = C * dec + U * wu;
        nst = nst * dec + wu * un;
    }
}
__device__ __forceinline__ void l0_mixC(LAS unsigned char* lds, const L0Bufs& B, int blk, int G) {
    const int tid0 = threadIdx.x, wave = __builtin_amdgcn_readfirstlane(tid0 >> 6);
    LAS unsigned char* TQ = lds; LAS unsigned char* TK = lds + 34816; LAS unsigned char* TV = lds + 2 * 34816; LAS unsigned char* TC = lds + 3 * 34816;
    LAS float* SF = (LAS float*)(lds + 4 * 34816);
    LAS float* AS = SF; LAS float* PM = SF + 128; LAS float* NP = SF + 256; LAS float* PS = SF + 384; LAS float* PQ = SF + 640;
    for (int uu = blk; uu < 256; uu += G) {
        const int tok0 = uu * 128;
#pragma unroll 1
        for (int h = 0; h < 4; ++h) {
            const int unit = uu * 4 + h;
            int tid = tid0; asm volatile("" : "+v"(tid));
            const int lane = tid & 63, r32 = lane & 31, hh = lane >> 5;
            __syncthreads();
            load_tile128(TQ, B.Q + (size_t)tok0 * 512 + h * 128, 512, tid);
            load_tile128(TV, B.V + (size_t)tok0 * 512 + h * 128, 512, tid);
            load_tile128(TC, B.CS + (size_t)unit * 16384, 128, tid);
#pragma unroll
            for (int i = 0; i < 4; ++i) { const int ch = tid + 512 * i, row = ch >> 4, c = ch & 15; const u32x4 k = *(const u32x4*)(B.K + (size_t)(tok0 + row) * 512 + h * 128 + c * 8); const float ksc = 0.08838834764831845f;
                u32x4 ok; ok.x = pk2(bf_lo(k.x) * ksc, bf_hi(k.x) * ksc); ok.y = pk2(bf_lo(k.y) * ksc, bf_hi(k.y) * ksc); ok.z = pk2(bf_lo(k.z) * ksc, bf_hi(k.z) * ksc); ok.w = pk2(bf_lo(k.w) * ksc, bf_hi(k.w) * ksc);
                *(LAS u32x4*)(TK + row * TS + c * 16) = ok; }
            const float mprev = B.SC[2048 + unit];
            if (wave == 0) {
                const float* gt = B.GT + (size_t)unit * 256;
                const float a0 = gt[2 * lane] - gt[128 + 2 * lane], a1 = gt[2 * lane + 1] - gt[128 + 2 * lane + 1];
                float run = fmaxf(a0, a1);
#pragma unroll
                for (int o = 1; o < 64; o <<= 1) { const float v = __shfl_up(run, o); if (lane >= o) run = fmaxf(run, v); }
                const float prev = __shfl_up(run, 1); const float p0 = fmaxf(lane > 0 ? fmaxf(prev, a0) : a0, mprev), p1 = fmaxf(run, mprev);
                AS[2 * lane] = a0; AS[2 * lane + 1] = a1; PM[2 * lane] = p0; PM[2 * lane + 1] = p1;
            }
            if (wave == 1) { NP[lane] = B.NS[(size_t)unit * 128 + lane]; NP[64 + lane] = B.NS[(size_t)unit * 128 + 64 + lane]; }
            __syncthreads();
            const int tb = wave & 3, vh = wave >> 2, t = 32 * tb + r32;
            const float pm = PM[t], bt = B.GT[(size_t)unit * 256 + 128 + t];
            f32x16 s[4];
#pragma unroll
            for (int st = 0; st < 4; ++st)
#pragma unroll
                for (int r = 0; r < 16; ++r) s[st][r] = 0.f;
            {   int lv = lane; asm volatile("" : "+v"(lv));
                const LAS unsigned char* qp = TQ + (32 * tb + (lv & 31)) * TS + (lv >> 5) * 16; const LAS unsigned char* kp = TK + (lv & 31) * TS + (lv >> 5) * 16;
#pragma unroll 2
                for (int ks = 0; ks < 8; ++ks) { const bf16x8 bq = *(const LAS bf16x8*)(qp + ks * 32);
#pragma unroll
                    for (int st = 0; st < 4; ++st) if (st <= tb) { const bf16x8 a = *(const LAS bf16x8*)(kp + st * 32 * TS + ks * 32); s[st] = MFMA32(a, bq, s[st]); } } }
            float nq = 0.f; u32x4 pf[4][2];
#pragma unroll
            for (int st = 0; st < 4; ++st) {
#pragma unroll
                for (int r = 0; r < 16; ++r) { const int sidx = 32 * st + crow(r, hh); const float wv = (sidx <= t) ? __builtin_amdgcn_exp2f((AS[sidx] - pm) * LOG2E) : 0.f; const float pv = s[st][r] * wv; s[st][r] = pv; nq += pv; }
#pragma unroll
                for (int sx = 0; sx < 2; ++sx) pf[st][sx] = (u32x4){pk2(s[st][8 * sx], s[st][8 * sx + 1]), pk2(s[st][8 * sx + 2], s[st][8 * sx + 3]), pk2(s[st][8 * sx + 4], s[st][8 * sx + 5]), pk2(s[st][8 * sx + 6], s[st][8 * sx + 7])};
            }
            nq = xhalf_sum(nq);
            float nqi = 0.f;
#pragma unroll
            for (int i = 0; i < 8; ++i) { const u32x4 qv = *(const LAS u32x4*)(TQ + t * TS + (64 * hh + 8 * i) * 2); const LAS float* np = NP + 64 * hh + 8 * i;
                nqi += bf_lo(qv.x) * np[0] + bf_hi(qv.x) * np[1] + bf_lo(qv.y) * np[2] + bf_hi(qv.y) * np[3] + bf_lo(qv.z) * np[4] + bf_hi(qv.z) * np[5] + bf_lo(qv.w) * np[6] + bf_hi(qv.w) * np[7]; }
            nqi = xhalf_sum(nqi);
            const float wst = __builtin_amdgcn_exp2f((mprev - pm) * LOG2E);
            const float den = fmaxf(fabsf(nq + wst * nqi), __builtin_amdgcn_exp2f(-(bt + pm) * LOG2E)), rden = 1.f / den;
            f32x16 ni[2], nx[2];
#pragma unroll
            for (int vt = 0; vt < 2; ++vt)
#pragma unroll
                for (int r = 0; r < 16; ++r) { ni[vt][r] = 0.f; nx[vt][r] = 0.f; }
            {   int lv = lane; asm volatile("" : "+v"(lv));
#pragma unroll
                for (int st = 0; st < 4; ++st) {
                    if (st <= tb) {
#pragma unroll
                        for (int sx = 0; sx < 2; ++sx) { const bf16x8 pb = __builtin_bit_cast(bf16x8, pf[st][sx]);
#pragma unroll
                            for (int vt = 0; vt < 2; ++vt) { const bf16x8 a = tr_frag(TV, 32 * st + 16 * sx, 64 * vh + 32 * vt, lv, true); ni[vt] = MFMA32(a, pb, ni[vt]); } }
                    }
                } }
            {   int lv = lane; asm volatile("" : "+v"(lv));
                const LAS unsigned char* qp = TQ + (32 * tb + (lv & 31)) * TS + (lv >> 5) * 16; const LAS unsigned char* cp = TC + (64 * vh + (lv & 31)) * TS + (lv >> 5) * 16;
#pragma unroll 2
                for (int ks = 0; ks < 8; ++ks) { const bf16x8 bq = *(const LAS bf16x8*)(qp + ks * 32);
#pragma unroll
                    for (int vt = 0; vt < 2; ++vt) { const bf16x8 a = *(const LAS bf16x8*)(cp + vt * 32 * TS + ks * 32); nx[vt] = MFMA32(a, bq, nx[vt]); } } }
            float hs = 0.f;
#pragma unroll
            for (int vt = 0; vt < 2; ++vt)
#pragma unroll
                for (int r = 0; r < 16; ++r) { const float hv = (ni[vt][r] + wst * nx[vt][r]) * rden; ni[vt][r] = hv; hs += hv; }
            hs = xhalf_sum(hs);
            if (hh == 0) PS[vh * 128 + t] = hs;
            __syncthreads();
            const float mean = (PS[t] + PS[128 + t]) * (1.f / 128.f);
            float hq = 0.f;
#pragma unroll
            for (int vt = 0; vt < 2; ++vt)
#pragma unroll
                for (int r = 0; r < 16; ++r) { const float d = ni[vt][r] - mean; ni[vt][r] = d; hq += d * d; }
            hq = xhalf_sum(hq);
            if (hh == 0) PQ[vh * 128 + t] = hq;
            __syncthreads();
            const float rstd = rsqrtf((PQ[t] + PQ[128 + t]) * (1.f / 128.f) + LN_EPS);
            const size_t tok = (size_t)tok0 + t;
#pragma unroll
            for (int vt = 0; vt < 2; ++vt)
#pragma unroll
                for (int gq = 0; gq < 4; ++gq) { const int chn = h * 128 + 64 * vh + 32 * vt + 8 * gq + 4 * hh;
                    const f32x4 nw = *(const f32x4*)(B.nw + chn), sk = *(const f32x4*)(B.skip + chn); const u32x2 xc = *(const u32x2*)(B.XC + tok * 512 + chn), z = *(const u32x2*)(B.BZ + tok * 512 + chn);
                    const float y0 = (ni[vt][4 * gq] * rstd * nw[0] + sk[0] * bf_lo(xc.x)) * silu_f(bf_lo(z.x)), y1 = (ni[vt][4 * gq + 1] * rstd * nw[1] + sk[1] * bf_hi(xc.x)) * silu_f(bf_hi(z.x));
                    const float y2 = (ni[vt][4 * gq + 2] * rstd * nw[2] + sk[2] * bf_lo(xc.y)) * silu_f(bf_lo(z.y)), y3 = (ni[vt][4 * gq + 3] * rstd * nw[3] + sk[3] * bf_hi(xc.y)) * silu_f(bf_hi(z.y));
                    u32x2 w; w.x = pk2(y0, y1); w.y = pk2(y2, y3); *(u32x2*)(B.YM + tok * 1024 + 512 + chn) = w; asm volatile("" ::: "memory"); }
        }
    }
}
constexpr size_t MB = 1048576ull;
constexpr size_t P_WIN_T = 0, P_WOUT_T = P_WIN_T + 4 * MB, P_WQKV_T = P_WOUT_T + 2 * MB, P_WO_T = P_WQKV_T + 3 * MB, P_XWQ_T = P_WO_T + 2 * MB, P_XWKV_T = P_XWQ_T + 4 * MB, P_XWO_T = P_XWKV_T + 8 * MB,
                 P_MLW_T = P_XWO_T + 4 * MB, P_WIFT = P_MLW_T + MB / 2, P_WRT = P_WIFT + MB / 8, P_ROT = P_WRT + MB / 2, P_BQK = P_ROT + MB, P_MEMB = P_BQK + MB / 8, P_KC = P_MEMB + 4 * MB, P_VT = P_KC + 8 * MB,
                 P_W13T = P_VT + 8 * MB, P_W2T = P_W13T + 64 * MB, P_XBF = P_W2T + 32 * MB, P_RT = P_XBF + 64 * MB, P_TMP = P_RT + 2 * MB;
constexpr size_t RT_E = 0, RT_W = 262144, RT_RANK = 2 * 262144, RT_DEST = 3 * 262144, RT_HIST = 4 * 262144, RT_TSTART = RT_HIST + 32768;
constexpr size_t T_QX = 0, T_OB = 64 * MB, T_YB = 128 * MB;
constexpr size_t T_K1 = 192 * MB, T_VT1 = 208 * MB;
constexpr size_t T_AU = 0, T_AV = 32 * MB, T_BX = 64 * MB, T_BZ = 96 * MB, T_V = 128 * MB, T_XC = 160 * MB, T_YM = 192 * MB, T_U = 256 * MB, T_CS = 320 * MB,
                 T_GT = 352 * MB, T_UN = 353 * MB, T_NS = 353 * MB + MB / 2, T_SC = 354 * MB, T_YB0 = 0;
constexpr size_t T_XG = 0, T_HM = 152 * MB, T_YG = 0;
constexpr size_t FAST_END = P_TMP + 360 * MB;
constexpr int LDS_BYTES = 147456;

struct FP {
    const float* in[33]; float* X;
    unsigned char* ws;
};
#define WSP(T, off) ((T*)(p.ws + (off)))

__device__ __forceinline__ RouteBufs route_bufs(const FP& p) {
    RouteBufs r; r.e = WSP(int, P_RT + RT_E); r.w = WSP(float, P_RT + RT_W); r.rank = WSP(int, P_RT + RT_RANK); r.dest = WSP(int, P_RT + RT_DEST); r.hist = WSP(int, P_RT + RT_HIST); r.tstart = WSP(int, P_RT + RT_TSTART); return r;
}
#define PH_ARGS const FP& p, LAS unsigned char* lds, int blk, int G
#define PH_IDS int tid_ = threadIdx.x; asm volatile("" : "+v"(tid_)); const int tid = tid_, lane = tid & 63, wave = __builtin_amdgcn_readfirstlane(tid >> 6); (void)lane; (void)wave;

__device__ __forceinline__ void ph_conv_xattn(PH_ARGS, int l) {
    PH_IDS; LAS float* scr = (LAS float*)(lds + wave * 8448); const int gw = blk * NWAVE + wave, ngw = G * NWAVE;
    convert_mats(p.in[23] + (size_t)l * 1024 * 1024, 1024, 1024, 1, 0, WSP(bf16_t, P_XWQ_T) + (size_t)l * 1024 * 1024, 0, RM_IDENT, 0.0625f, 1024, scr, gw, ngw, lane);
    convert_mats(p.in[24] + (size_t)l * 1024 * 2048, 1024, 2048, 1, 0, WSP(bf16_t, P_XWKV_T) + (size_t)l * 2048 * 1024, 0, RM_IDENT, 1.f, 0, scr, gw, ngw, lane);
    convert_mats(p.in[25] + (size_t)l * 1024 * 1024, 1024, 1024, 1, 0, WSP(bf16_t, P_XWO_T) + (size_t)l * 1024 * 1024, 0, RM_IDENT, 1.f, 0, scr, gw, ngw, lane);
    convert_rows(p.in[1], WSP(bf16_t, P_MEMB), (size_t)2048 * 1024, blk * NTHR + tid, G * NTHR);
}
__device__ __forceinline__ void ph_conv_moe(PH_ARGS, int l) {
    PH_IDS; LAS float* scr = (LAS float*)(lds + wave * 8448); const int gw = blk * NWAVE + wave, ngw = G * NWAVE;
    const size_t wl = (size_t)l * 32 * 1024 * 512;
    convert_mats(p.in[30] + wl, 1024, 512, 32, (size_t)1024 * 512, WSP(bf16_t, P_W13T), (size_t)1024 * 1024, RM_PAIR0, 1.f, 0, scr, gw, ngw, lane);
    convert_mats(p.in[31] + wl, 1024, 512, 32, (size_t)1024 * 512, WSP(bf16_t, P_W13T), (size_t)1024 * 1024, RM_PAIR1, 1.f, 0, scr, gw, ngw, lane);
    convert_mats(p.in[32] + wl, 512, 1024, 32, (size_t)512 * 1024, WSP(bf16_t, P_W2T), (size_t)1024 * 512, RM_IDENT, 1.f, 0, scr, gw, ngw, lane);
    bf16_t* wrt = WSP(bf16_t, P_WRT) + (size_t)l * 2 * 64 * 1024; const float* wre = p.in[28] + (size_t)l * 1024 * 32; const float* wrg = p.in[26] + (size_t)l * 1024 * 4;
    for (int i = blk * NTHR + tid; i < 64 * 1024; i += G * NTHR) { const int r = i >> 10, k = i & 1023;
        const float v = r < 32 ? wre[k * 32 + r] : (r < 36 ? wrg[k * 4 + (r - 32)] : 0.f);
        const bf16_t h = f2bf(v); wrt[i] = h; wrt[64 * 1024 + i] = f2bf(v - bf2f(h)); }
}
__device__ __forceinline__ void ph_x_to_bf(PH_ARGS) { PH_IDS; convert_rows(p.X, WSP(bf16_t, P_XBF), (size_t)NT * 1024, blk * NTHR + tid, G * NTHR); }

__device__ __forceinline__ void set_job(LAS pg8::JobDesc* jt, int j, const void* A, const void* B, int nM, int nN, void* out, int ldc, int mode, const void* bias = nullptr, const void* rot = nullptr, void* out2 = nullptr) {
    unsigned long long a = (unsigned long long)A, b = (unsigned long long)B, o = (unsigned long long)out, bi = (unsigned long long)bias, ro = (unsigned long long)rot, o2 = (unsigned long long)out2;
    asm volatile("" : "+s"(a), "+s"(b), "+s"(o), "+s"(bi), "+s"(ro), "+s"(o2), "+s"(nM), "+s"(nN), "+s"(ldc), "+s"(mode));
    LAS pg8::JobDesc* d = jt + j; d->A = a; d->B = b; d->out = o; d->bias = bi; d->rot = ro; d->out2 = o2;
    d->nM = nM; d->nN = nN; d->ldc = ldc; d->mode = mode;
}
#define JT_PTR ((LAS pg8::JobDesc*)(lds + pg8::JT_OFF))
__device__ __forceinline__ void run_jobs(LAS unsigned char* lds, int K, int n0, int n1, int n2, int blk, int G) {
    __syncthreads();
    pg8::Jobs3 S; S.jt = JT_PTR; S.n0 = n0; S.n1 = n1; S.n2 = n2; S.K = K; S.G = G; S.c = blk;
    EpiMulti E; E.jt = JT_PTR;
    pg8::gemm_phase<EpiMulti, pg8::Jobs3, true, true>(lds, K, S, E);
}
__device__ __forceinline__ void ph_xattn_g1(PH_ARGS, int l) {
    const bf16_t* wkv = WSP(bf16_t, P_XWKV_T) + (size_t)l * 2048 * 1024;
    __syncthreads();
    if (threadIdx.x == 0) {
        set_job(JT_PTR, 0, WSP(bf16_t, P_MEMB), wkv, 8, 4, WSP(bf16_t, P_KC) + (size_t)l * 2048 * 1024, 1024, EM_PLAIN);
        set_job(JT_PTR, 1, wkv + (size_t)1024 * 1024, WSP(bf16_t, P_MEMB), 4, 8, WSP(bf16_t, P_VT) + (size_t)l * 1024 * 2048, 2048, EM_PLAIN);
        set_job(JT_PTR, 2, WSP(bf16_t, P_XBF), WSP(bf16_t, P_XWQ_T) + (size_t)l * 1024 * 1024, 128, 4, WSP(bf16_t, P_TMP + T_QX), 1024, EM_PLAIN);
    }
    run_jobs(lds, 1024, 32, 32, 512, blk, G);
}
__device__ __forceinline__ void ph_xattn_attn(PH_ARGS, int l) {
    xattn_phase(lds, WSP(bf16_t, P_TMP + T_QX), WSP(bf16_t, P_KC) + (size_t)l * 2048 * 1024, WSP(bf16_t, P_VT) + (size_t)l * 1024 * 2048, WSP(bf16_t, P_TMP + T_OB), blk, G);
}
__device__ __forceinline__ void ph_gemm_plain(PH_ARGS, const bf16_t* A, const bf16_t* Bt, bf16_t* out) {
    __syncthreads();
    if (threadIdx.x == 0) set_job(JT_PTR, 0, A, Bt, 128, 4, out, 1024, EM_PLAIN);
    run_jobs(lds, 1024, 512, 0, 0, blk, G);
}
template <bool XF32, bool OUTF32, bool MOE>
__device__ __forceinline__ void ph_ln(PH_ARGS, const bf16_t* y, int lnidx, bool dry = false) {
    PH_IDS; LnArgs a; a.xin32 = p.in[0]; a.xin = WSP(bf16_t, P_XBF); a.xout32 = dry ? WSP(float, P_TMP + 200 * MB) : p.X; a.xbf = dry ? WSP(bf16_t, P_TMP + 288 * MB) : WSP(bf16_t, P_XBF); a.y = y; a.g = p.in[2] + lnidx * 1024; a.b = p.in[3] + lnidx * 1024;
    a.dest = WSP(int, P_RT + RT_DEST); a.wts = WSP(float, P_RT + RT_W);
    ln_phase<XF32, OUTF32, MOE>(a, blk, G, wave, lane);
}
__device__ __forceinline__ void ph_moe_route(PH_ARGS, int l) {
    moe_router_phase(lds, WSP(bf16_t, P_XBF), WSP(bf16_t, P_WRT) + (size_t)l * 2 * 64 * 1024, p.in[27] + l * 4, p.in[29] + l * 32, route_bufs(p), blk);
}
__device__ __forceinline__ void ph_moe_scatter(PH_ARGS) { moe_scatter_phase(lds, WSP(bf16_t, P_XBF), WSP(bf16_t, P_TMP + T_XG), route_bufs(p), blk, G); }
__device__ __forceinline__ void ph_moe_g1(PH_ARGS) {
    __syncthreads();
    if (threadIdx.x == 0) set_job(JT_PTR, 0, nullptr, nullptr, 0, 0, WSP(bf16_t, P_TMP + T_HM), 512, EM_SWIGLU);
    __syncthreads();
    MoeSched S; S.A = (const char*)WSP(bf16_t, P_TMP + T_XG); S.B = (const char*)WSP(bf16_t, P_W13T); S.tstart = WSP(int, P_RT + RT_TSTART); S.K = 1024; S.nN = 4; S.G = G; S.c = blk; S.bexp = (size_t)1024 * 1024 * 2;
    EpiMulti E; E.jt = JT_PTR;
    pg8::gemm_phase<EpiMulti, MoeSched, true, true>(lds, 1024, S, E);
}
__device__ __forceinline__ void ph_moe_g2(PH_ARGS) {
    __syncthreads();
    if (threadIdx.x == 0) set_job(JT_PTR, 0, nullptr, nullptr, 0, 0, WSP(bf16_t, P_TMP + T_YG), 1024, EM_PLAIN);
    __syncthreads();
    MoeSched S; S.A = (const char*)WSP(bf16_t, P_TMP + T_HM); S.B = (const char*)WSP(bf16_t, P_W2T); S.tstart = WSP(int, P_RT + RT_TSTART); S.K = 512; S.nN = 4; S.G = G; S.c = blk; S.bexp = (size_t)1024 * 512 * 2;
    EpiMulti E; E.jt = JT_PTR;
    pg8::gemm_phase<EpiMulti, MoeSched, true, true>(lds, 512, S, E);
}

__device__ __forceinline__ void ph_conv_l1(PH_ARGS) {
    PH_IDS; LAS float* scr = (LAS float*)(lds + wave * 8448); const int gw = blk * NWAVE + wave, ngw = G * NWAVE;
    convert_mats(p.in[19], 1024, 1536, 1, 0, WSP(bf16_t, P_WQKV_T), 0, RM_ROT, 0.125f, 1024, scr, gw, ngw, lane);
    convert_mats(p.in[22], 1024, 1024, 1, 0, WSP(bf16_t, P_WO_T), 0, RM_IDENT, 1.f, 0, scr, gw, ngw, lane);
    const int gt = blk * NTHR + tid, ngt = G * NTHR;
    float* bqk = WSP(float, P_BQK);
    for (int n = gt; n < 1280; n += ngt) bqk[rowmap(RM_ROT, n)] = p.in[20][n] * (n < 1024 ? 0.125f : 1.f);
    float* rot = WSP(float, P_ROT);
    for (int i = gt; i < 4096 * 32; i += ngt) { const int pos = i >> 5, k = i & 31; const float inv = powf(10000.f, -(float)(2 * k) / 64.f); const float ang = (float)pos * inv; rot[2 * i] = cosf(ang); rot[2 * i + 1] = sinf(ang); }
}
__device__ __forceinline__ void ph_l1_g1(PH_ARGS) {
    __syncthreads();
    if (threadIdx.x == 0) {
        set_job(JT_PTR, 0, WSP(bf16_t, P_XBF), WSP(bf16_t, P_WQKV_T), 128, 5, WSP(bf16_t, P_TMP + T_QX), 1024, EM_ROTARY, WSP(float, P_BQK), WSP(float, P_ROT), WSP(bf16_t, P_TMP + T_K1));
        set_job(JT_PTR, 1, WSP(bf16_t, P_WQKV_T) + (size_t)1280 * 1024, WSP(bf16_t, P_XBF), 1, 128, WSP(bf16_t, P_TMP + T_VT1), NT, EM_ROWBIAS, p.in[20] + 1280);
    }
    run_jobs(lds, 1024, 640, 128, 0, blk, G);
}
__device__ __forceinline__ void ph_l1_swa(PH_ARGS) {
    swa_phase(lds, WSP(bf16_t, P_TMP + T_QX), WSP(bf16_t, P_TMP + T_K1), WSP(bf16_t, P_TMP + T_VT1), p.in[21], WSP(bf16_t, P_TMP + T_OB), blk, G);
}

__device__ __forceinline__ L0Bufs l0_bufs(const FP& p) {
    L0Bufs B; B.AU = WSP(bf16_t, P_TMP + T_AU); B.AV = WSP(bf16_t, P_TMP + T_AV); B.BX = WSP(bf16_t, P_TMP + T_BX); B.BZ = WSP(bf16_t, P_TMP + T_BZ); B.V = WSP(bf16_t, P_TMP + T_V); B.XC = WSP(bf16_t, P_TMP + T_XC);
    B.YM = WSP(bf16_t, P_TMP + T_YM); B.CS = WSP(bf16_t, P_TMP + T_CS); B.U = WSP(float, P_TMP + T_U); B.GT = WSP(float, P_TMP + T_GT); B.UN = WSP(float, P_TMP + T_UN); B.NS = WSP(float, P_TMP + T_NS); B.SC = WSP(float, P_TMP + T_SC);
    B.Q = WSP(bf16_t, P_XBF); B.K = WSP(bf16_t, P_XBF) + (size_t)NT * 512;
    B.WQT = WSP(bf16_t, P_MLW_T); B.GMW = WSP(bf16_t, P_MLW_T) + 12 * 16384; B.WIFT = WSP(bf16_t, P_WIFT);
    B.gm_g = p.in[5]; B.gm_b = p.in[6]; B.gm_bs = p.in[8]; B.cw = p.in[9]; B.cb = p.in[10]; B.bif = p.in[15]; B.nw = p.in[16]; B.skip = p.in[17]; return B;
}
__device__ __forceinline__ void ph_conv_l0(PH_ARGS) {
    PH_IDS; LAS float* scr = (LAS float*)(lds + wave * 8448); const int gw = blk * NWAVE + wave, ngw = G * NWAVE;
    convert_mats(p.in[4], 1024, 2048, 1, 0, WSP(bf16_t, P_WIN_T), 0, RM_IDENT, 1.f, 0, scr, gw, ngw, lane);
    convert_mats(p.in[18], 1024, 1024, 1, 0, WSP(bf16_t, P_WOUT_T), 0, RM_IDENT, 1.f, 0, scr, gw, ngw, lane);
    convert_mats(p.in[11], 128, 128, 4, 16384, WSP(bf16_t, P_MLW_T), 16384, RM_IDENT, 1.f, 0, scr, gw, ngw, lane);
    convert_mats(p.in[12], 128, 128, 4, 16384, WSP(bf16_t, P_MLW_T) + 4 * 16384, 16384, RM_IDENT, 1.f, 0, scr, gw, ngw, lane);
    convert_mats(p.in[13], 128, 128, 4, 16384, WSP(bf16_t, P_MLW_T) + 8 * 16384, 16384, RM_IDENT, 1.f, 0, scr, gw, ngw, lane);
    const int gt = blk * NTHR + tid, ngt = G * NTHR;
    bf16_t* gmw = WSP(bf16_t, P_MLW_T) + 12 * 16384;
    for (int i = gt; i < 4 * 16384; i += ngt) { const int t = (i >> 7) & 127, sidx = i & 127; gmw[i] = f2bf(sidx <= t ? p.in[7][i] : 0.f); }
    bf16_t* wift = WSP(bf16_t, P_WIFT);
    for (int i = gt; i < 32 * 1536; i += ngt) { const int r = i / 1536, k = i - r * 1536; wift[i] = f2bf(r < 8 ? p.in[14][k * 8 + r] : 0.f); }
}
__device__ __forceinline__ void ph_xin_to_bf(PH_ARGS) { PH_IDS; convert_rows(p.in[0], WSP(bf16_t, P_XBF), (size_t)NT * 1024, blk * NTHR + tid, G * NTHR); }
__device__ __forceinline__ void ph_l0_g1(PH_ARGS) {
    __syncthreads();
    if (threadIdx.x == 0) set_job(JT_PTR, 0, WSP(bf16_t, P_XBF), WSP(bf16_t, P_WIN_T), 128, 8, WSP(bf16_t, P_TMP + T_AU), 512, EM_GELU4);
    run_jobs(lds, 1024, 1024, 0, 0, blk, G);
}

enum { K_CONV_XATTN = 0, K_CONV_MOE, K_X2BF, K_XATTN_G1, K_XATTN_ATTN, K_XATTN_G2, K_LN_Y, K_MOE_ROUTE, K_MOE_SCATTER, K_MOE_G1, K_MOE_G2, K_LN_MOE, K_CONV_L1, K_L1_G1, K_L1_SWA, K_L1_G2, K_CONV_L0, K_XIN2BF, K_L0_G1, K_L0_MIXA, K_L0_SCAN, K_L0_MIXC, K_L0_G2, K_LN_Y0 };
template <int PH>
__global__ void __launch_bounds__(NTHR, 2) k_phase(FP p, int l, int lnidx) {
    extern __shared__ __attribute__((aligned(16))) unsigned char smem[];
    LAS unsigned char* lds = (LAS unsigned char*)smem;
    const int blk = blockIdx.x, G = gridDim.x;
    if constexpr (PH == K_CONV_XATTN) ph_conv_xattn(p, lds, blk, G, l);
    if constexpr (PH == K_CONV_MOE) ph_conv_moe(p, lds, blk, G, l);
    if constexpr (PH == K_X2BF) ph_x_to_bf(p, lds, blk, G);
    if constexpr (PH == K_XATTN_G1) ph_xattn_g1(p, lds, blk, G, l);
    if constexpr (PH == K_XATTN_ATTN) ph_xattn_attn(p, lds, blk, G, l);
    if constexpr (PH == K_XATTN_G2) ph_gemm_plain(p, lds, blk, G, WSP(bf16_t, P_TMP + T_OB), WSP(bf16_t, P_XWO_T) + (size_t)l * 1024 * 1024, WSP(bf16_t, P_TMP + T_YB));
    if constexpr (PH == K_LN_Y) ph_ln<false, false, false>(p, lds, blk, G, WSP(bf16_t, P_TMP + T_YB), lnidx);
    if constexpr (PH == K_MOE_ROUTE) ph_moe_route(p, lds, blk, G, l);
    if constexpr (PH == K_MOE_SCATTER) ph_moe_scatter(p, lds, blk, G);
    if constexpr (PH == K_MOE_G1) ph_moe_g1(p, lds, blk, G);
    if constexpr (PH == K_MOE_G2) ph_moe_g2(p, lds, blk, G);
    if constexpr (PH == K_LN_MOE) ph_ln<false, false, true>(p, lds, blk, G, WSP(bf16_t, P_TMP + T_YG), lnidx);
    if constexpr (PH == K_CONV_L0) ph_conv_l0(p, lds, blk, G);
    if constexpr (PH == K_XIN2BF) ph_xin_to_bf(p, lds, blk, G);
    if constexpr (PH == K_L0_G1) ph_l0_g1(p, lds, blk, G);
    if constexpr (PH == K_L0_MIXA) l0_mixA(lds, l0_bufs(p), blk, G);
    if constexpr (PH == K_L0_SCAN) l0_scan(l0_bufs(p), blk);
    if constexpr (PH == K_L0_MIXC) l0_mixC(lds, l0_bufs(p), blk, G);
    if constexpr (PH == K_L0_G2) ph_gemm_plain(p, lds, blk, G, WSP(bf16_t, P_TMP + T_YM), WSP(bf16_t, P_WOUT_T), WSP(bf16_t, P_TMP + T_YB0));
    if constexpr (PH == K_LN_Y0) ph_ln<true, false, false>(p, lds, blk, G, WSP(bf16_t, P_TMP + T_YB0), 0);
    if constexpr (PH == K_CONV_L1) ph_conv_l1(p, lds, blk, G);
    if constexpr (PH == K_L1_G1) ph_l1_g1(p, lds, blk, G);
    if constexpr (PH == K_L1_SWA) ph_l1_swa(p, lds, blk, G);
    if constexpr (PH == K_L1_G2) ph_gemm_plain(p, lds, blk, G, WSP(bf16_t, P_TMP + T_OB), WSP(bf16_t, P_WO_T), WSP(bf16_t, P_TMP + T_YB));
}

#define XB_TMO      128
#define XB_XCNT(j)  (256  + 64 * (j))
#define XB_XSUB(j)  (1280 + 64 * (j))
#define XB_XGEN(j)  (2304 + 64 * (j))
#define XB_TOP      3328
#define XB_TOPGEN   3392
#define XCD_BAR_WORDS 3456
#define XB_SPIN_CAP (1u << 22)
__device__ __forceinline__ unsigned xb_ld(unsigned* p)              { return __hip_atomic_load(p, __ATOMIC_RELAXED, __HIP_MEMORY_SCOPE_AGENT); }
__device__ __forceinline__ unsigned xb_add(unsigned* p, unsigned v) { return __hip_atomic_fetch_add(p, v, __ATOMIC_RELAXED, __HIP_MEMORY_SCOPE_AGENT); }
__device__ __forceinline__ unsigned xb_xcc_id() { return (unsigned)__builtin_amdgcn_s_getreg((3 << 11) | 20) & 0xFu; }
#define XB_SPIN(cond, bar) do { unsigned _sp = 0; while (cond) { __builtin_amdgcn_s_sleep(1); \
    if ((++_sp & 255u) == 0u) { if (xb_ld(&(bar)[XB_TMO])) break; if (_sp > XB_SPIN_CAP) { atomicAdd(&(bar)[XB_TMO], 1u); break; } } } } while (0)
struct XcdBarrier { unsigned* bar; unsigned x; volatile LAS unsigned* st; };
__device__ __forceinline__ XcdBarrier xcd_barrier_post(unsigned* bar, volatile LAS unsigned* st) {
    XcdBarrier b; b.bar = bar; b.x = xb_xcc_id(); b.st = st;
    if (threadIdx.x == 0) (void)xb_add(&bar[XB_XCNT(b.x)], 1u);
    return b;
}
__device__ __forceinline__ void xcd_barrier_complete(unsigned* bar, unsigned x, unsigned& nloc, unsigned& nx) {
    const unsigned G = gridDim.x * gridDim.y * gridDim.z;
    unsigned sum, cnt, mine, sp = 0u;
    for (;;) {
        sum = 0u; cnt = 0u; mine = 0u;
#pragma unroll
        for (unsigned j = 0; j < 16; ++j) { const unsigned c = xb_ld(&bar[XB_XCNT(j)]); sum += c; cnt += (c > 0u) ? 1u : 0u; mine = (j == x) ? c : mine; }
        if (sum == G) break;
        __builtin_amdgcn_s_sleep(1);
        if ((++sp & 255u) == 0u) { if (xb_ld(&bar[XB_TMO])) break; if (sp > XB_SPIN_CAP) { atomicAdd(&bar[XB_TMO], 1u); break; } }
    }
    nloc = mine > 0u ? mine : 1u; nx = cnt > 0u ? cnt : 1u;
}
__device__ __forceinline__ void xcd_barrier(const XcdBarrier& b) {
    asm volatile("s_waitcnt vmcnt(0)" ::: "memory");
    __syncthreads();
    if (threadIdx.x == 0) {
        unsigned* bar = b.bar;
        __builtin_amdgcn_s_waitcnt(0);
        unsigned nloc = b.st[0], nx = b.st[1];
        if (nloc == 0u) { xcd_barrier_complete(bar, b.x, nloc, nx); b.st[0] = nloc; b.st[1] = nx; }
        const unsigned old = xb_add(&bar[XB_XSUB(b.x)], 1u);
        const unsigned gen = old / nloc;
        if (old + 1u == (gen + 1u) * nloc) {
            __builtin_amdgcn_fence(__ATOMIC_RELEASE, "agent");
            asm volatile("s_waitcnt vmcnt(0)" ::: "memory");
            const unsigned og = xb_add(&bar[XB_TOP], 1u);
            const unsigned tg = og / nx;
            if (og + 1u == (tg + 1u) * nx) xb_add(&bar[XB_TOPGEN], 1u);
            else XB_SPIN(xb_ld(&bar[XB_TOPGEN]) == tg, bar);
            __builtin_amdgcn_fence(__ATOMIC_ACQUIRE, "agent");
            xb_add(&bar[XB_XGEN(b.x)], 1u);
            asm volatile("s_waitcnt vmcnt(0)" ::: "memory");
        } else {
            XB_SPIN(xb_ld(&bar[XB_XGEN(b.x)]) == gen, bar);
            __builtin_amdgcn_fence(__ATOMIC_ACQUIRE, "agent");
            asm volatile("s_waitcnt vmcnt(0)" ::: "memory");
        }
    }
    __syncthreads();
}
constexpr size_t P_BAR = P_RT + 1572864;
constexpr int LDS_BARW = LDS_BYTES - 16;

struct SchedAll {
    const LAS pg8::JobDesc* jt; int n0, n1, n2; int K, G, c; int moe; const char* A; const char* B; const int* tstart; int nN; size_t bexp;
    __device__ __forceinline__ bool next(int i, pg8::Unit& u) const {
        if (moe) {
            const int vc = (c & 7) * (G >> 3) + (c >> 3);
            const long L = (long)i * G + vc; const int ntile = tstart[32];
            if (L >= (long)ntile * nN) return false;
            const int mt = (int)(L / nN), nt = (int)(L % nN);
            int e = 0;
            for (int k = 1; k < 32; ++k) if (tstart[k] <= mt) e = k;
            u.A = A + (size_t)mt * 256 * K * 2; u.B = B + (size_t)e * bexp + (size_t)nt * 256 * K * 2; u.pm = mt; u.pn = nt; u.job = 0; return true;
        }
        long L = (long)i * G + c;
        if (L >= (long)n0 + n1 + n2) return false;
        int l = (int)L; int jb = 0;
        if (l >= n0) { l -= n0; jb = 1; if (l >= n1) { l -= n1; jb = 2; } }
        const int jM = __builtin_amdgcn_readfirstlane(jt[jb].nM), jN = __builtin_amdgcn_readfirstlane(jt[jb].nN);
        int pm, pn; pg8::tile_order(l, jM, jN, pm, pn);
        const size_t tstep = (size_t)pg8::BM * K * 2;
        u.A = (const char*)pg8::rfl64(jt[jb].A) + (size_t)pm * tstep; u.B = (const char*)pg8::rfl64(jt[jb].B) + (size_t)pn * tstep; u.pm = pm; u.pn = pn; u.job = jb; return true;
    }
};
enum { MP_CONV = 0, MP_L0_G1, MP_L0_MIXA, MP_L0_SCAN, MP_L0_MIXC, MP_L0_G2, MP_LN0, MP_XA_G1, MP_XA_ATTN, MP_XA_G2, MP_LN_ROUTE, MP_SCATTER, MP_MOE_G1, MP_MOE_G2, MP_LN_MOE, MP_L1_G1, MP_L1_SWA, MP_L1_G2, MP_LN3 };
__device__ __forceinline__ int prog_kind(int i) {
    switch (i) { case 0: return MP_CONV; case 1: return MP_L0_G1; case 2: return MP_L0_MIXA; case 3: return MP_L0_SCAN; case 4: return MP_L0_MIXC; case 5: return MP_L0_G2; case 6: return MP_LN0;
        case 7: case 19: return MP_XA_G1; case 8: case 20: return MP_XA_ATTN; case 9: case 21: return MP_XA_G2; case 10: case 22: return MP_LN_ROUTE; case 11: case 23: return MP_SCATTER;
        case 12: case 24: return MP_MOE_G1; case 13: case 25: return MP_MOE_G2; case 14: case 26: return MP_LN_MOE; case 15: return MP_L1_G1; case 16: return MP_L1_SWA; case 17: return MP_L1_G2; default: return MP_LN3; }
}
constexpr int N_PROG = 27;
__global__ void __launch_bounds__(NTHR, 2) mega(FP p0) {
    extern __shared__ __attribute__((aligned(16))) unsigned char smem[];
    LAS unsigned char* lds = (LAS unsigned char*)smem;
    cooperative_groups::grid_group grid = cooperative_groups::this_grid();
    const int blk = blockIdx.x, G = gridDim.x;
    volatile LAS unsigned* bst = (volatile LAS unsigned*)(lds + LDS_BARW);
    if (threadIdx.x == 0) { bst[0] = 0u; bst[1] = 0u; }
    __syncthreads();
    const XcdBarrier xbar = xcd_barrier_post((unsigned*)(p0.ws + P_BAR), bst);
    int dup = 0; (void)dup;
#pragma unroll 1
    for (int pi = 0; pi < N_PROG; ++pi) {
        FP p = p0; asm volatile("" : "+s"(p.ws));
        const int kind = prog_kind(pi), l = pi >= 15 ? 1 : 0;
        const bool is_gemm = kind == MP_L0_G1 || kind == MP_L0_G2 || kind == MP_XA_G1 || kind == MP_XA_G2 || kind == MP_MOE_G1 || kind == MP_MOE_G2 || kind == MP_L1_G1 || kind == MP_L1_G2;
        if (is_gemm) {
            SchedAll S; S.jt = JT_PTR; S.n0 = S.n1 = S.n2 = 0; S.K = 1024; S.G = G; S.c = blk; S.moe = 0; S.A = S.B = nullptr; S.tstart = WSP(int, P_RT + RT_TSTART); S.nN = 4; S.bexp = 0;
            __syncthreads();
            if (threadIdx.x == 0) {
                if (kind == MP_L0_G1) set_job(JT_PTR, 0, WSP(bf16_t, P_XBF), WSP(bf16_t, P_WIN_T), 128, 8, WSP(bf16_t, P_TMP + T_AU), 512, EM_GELU4);
                if (kind == MP_L0_G2) set_job(JT_PTR, 0, WSP(bf16_t, P_TMP + T_YM), WSP(bf16_t, P_WOUT_T), 128, 4, WSP(bf16_t, P_TMP + T_YB0), 1024, EM_PLAIN);
                if (kind == MP_XA_G1) { const bf16_t* wkv = WSP(bf16_t, P_XWKV_T) + (size_t)l * 2048 * 1024;
                    set_job(JT_PTR, 0, WSP(bf16_t, P_MEMB), wkv, 8, 4, WSP(bf16_t, P_KC) + (size_t)l * 2048 * 1024, 1024, EM_PLAIN);
                    set_job(JT_PTR, 1, wkv + (size_t)1024 * 1024, WSP(bf16_t, P_MEMB), 4, 8, WSP(bf16_t, P_VT) + (size_t)l * 1024 * 2048, 2048, EM_PLAIN);
                    set_job(JT_PTR, 2, WSP(bf16_t, P_XBF), WSP(bf16_t, P_XWQ_T) + (size_t)l * 1024 * 1024, 128, 4, WSP(bf16_t, P_TMP + T_QX), 1024, EM_PLAIN); }
                if (kind == MP_XA_G2) set_job(JT_PTR, 0, WSP(bf16_t, P_TMP + T_OB), WSP(bf16_t, P_XWO_T) + (size_t)l * 1024 * 1024, 128, 4, WSP(bf16_t, P_TMP + T_YB), 1024, EM_PLAIN);
                if (kind == MP_MOE_G1) set_job(JT_PTR, 0, nullptr, nullptr, 0, 0, WSP(bf16_t, P_TMP + T_HM), 512, EM_SWIGLU);
                if (kind == MP_MOE_G2) set_job(JT_PTR, 0, nullptr, nullptr, 0, 0, WSP(bf16_t, P_TMP + T_YG), 1024, EM_PLAIN);
                if (kind == MP_L1_G1) { set_job(JT_PTR, 0, WSP(bf16_t, P_XBF), WSP(bf16_t, P_WQKV_T), 128, 5, WSP(bf16_t, P_TMP + T_QX), 1024, EM_ROTARY, WSP(float, P_BQK), WSP(float, P_ROT), WSP(bf16_t, P_TMP + T_K1));
                    set_job(JT_PTR, 1, WSP(bf16_t, P_WQKV_T) + (size_t)1280 * 1024, WSP(bf16_t, P_XBF), 1, 128, WSP(bf16_t, P_TMP + T_VT1), NT, EM_ROWBIAS, p.in[20] + 1280); }
                if (kind == MP_L1_G2) set_job(JT_PTR, 0, WSP(bf16_t, P_TMP + T_OB), WSP(bf16_t, P_WO_T), 128, 4, WSP(bf16_t, P_TMP + T_YB), 1024, EM_PLAIN);
            }
            if (kind == MP_L0_G1) S.n0 = 1024;
            if (kind == MP_L0_G2 || kind == MP_XA_G2 || kind == MP_L1_G2) S.n0 = 512;
            if (kind == MP_XA_G1) { S.n0 = 32; S.n1 = 32; S.n2 = 512; }
            if (kind == MP_L1_G1) { S.n0 = 640; S.n1 = 128; }
            if (kind == MP_MOE_G1) { S.moe = 1; S.A = (const char*)WSP(bf16_t, P_TMP + T_XG); S.B = (const char*)WSP(bf16_t, P_W13T); S.bexp = (size_t)1024 * 1024 * 2; }
            if (kind == MP_MOE_G2) { S.moe = 1; S.K = 512; S.A = (const char*)WSP(bf16_t, P_TMP + T_HM); S.B = (const char*)WSP(bf16_t, P_W2T); S.bexp = (size_t)1024 * 512 * 2; }
            __syncthreads();
            EpiMulti E; E.jt = JT_PTR;
#ifdef PROBE_GEMM2
#pragma unroll 1
            for (int rep = 0; rep < 2; ++rep)
#endif
            pg8::gemm_phase<EpiMulti, SchedAll, true, true>(lds, S.K, S, E);
        } else {
#ifdef PROBE_MASK
#define DRY (dup == 0 && (((PROBE_MASK) >> kind) & 1))
#else
#define DRY false
#endif
            switch (kind) {
                case MP_CONV: ph_conv_l0(p, lds, blk, G); ph_conv_l1(p, lds, blk, G); ph_conv_xattn(p, lds, blk, G, 0); ph_conv_xattn(p, lds, blk, G, 1); ph_conv_moe(p, lds, blk, G, 0); ph_xin_to_bf(p, lds, blk, G); break;
                case MP_L0_MIXA: l0_mixA(lds, l0_bufs(p), blk, G); break;
                case MP_L0_SCAN: l0_scan(l0_bufs(p), blk); break;
                case MP_L0_MIXC: l0_mixC(lds, l0_bufs(p), blk, G); break;
                case MP_LN0: ph_ln<true, false, false>(p, lds, blk, G, WSP(bf16_t, P_TMP + T_YB0), 0, DRY); break;
                case MP_XA_ATTN: ph_xattn_attn(p, lds, blk, G, l); break;
                case MP_LN_ROUTE: ph_ln<false, false, false>(p, lds, blk, G, WSP(bf16_t, P_TMP + T_YB), l * 3 + 1, DRY); __syncthreads(); ph_moe_route(p, lds, blk, G, l); break;
                case MP_SCATTER: ph_moe_scatter(p, lds, blk, G); break;
                case MP_LN_MOE: if (l == 0) { ph_ln<false, false, true>(p, lds, blk, G, WSP(bf16_t, P_TMP + T_YG), 2, DRY); if (!(DRY)) ph_conv_moe(p, lds, blk, G, 1); } else ph_ln<false, true, true>(p, lds, blk, G, WSP(bf16_t, P_TMP + T_YG), 5, DRY); break;
                case MP_L1_SWA: ph_l1_swa(p, lds, blk, G); break;
                default: ph_ln<false, false, false>(p, lds, blk, G, WSP(bf16_t, P_TMP + T_YB), 3, DRY); break;
            }
        }
#ifdef PROBE_MASK
        if (((PROBE_MASK) >> kind) & 1) { if (dup == 0) { dup = 1; xcd_barrier(xbar); --pi; continue; } dup = 0; }
#endif
        if (pi + 1 < N_PROG) { if (pi == 0) grid.sync(); else { xcd_barrier(xbar);
#ifdef PROBE_BAR2
            xcd_barrier(xbar);
#endif
        } }
    }
}
}
extern "C" void kernel_launch(void* const* d_in, const int* in_sizes, int n_in, void* d_out, int out_size, void* d_ws, size_t ws_size, hipStream_t stream) {
    static int ok = 0;
    if (ok == 0) {
        ok = -1;
        if (n_in != 33 || out_size != 32768 * 1024 || ws_size < fk::FAST_END) { fprintf(stderr, "kernel_launch: unexpected shapes/ws (%d, %d, %zu)\n", n_in, out_size, ws_size); return; }
        int dev = 0, cus = 0, per_cu = 0;
        if (hipGetDevice(&dev) != hipSuccess || hipDeviceGetAttribute(&cus, hipDeviceAttributeMultiprocessorCount, dev) != hipSuccess) return;
        if (hipFuncSetAttribute((const void*)fk::mega, hipFuncAttributeMaxDynamicSharedMemorySize, fk::LDS_BYTES) != hipSuccess) return;
        if (hipOccupancyMaxActiveBlocksPerMultiprocessor(&per_cu, (const void*)fk::mega, fk::NTHR, fk::LDS_BYTES) != hipSuccess || per_cu < 1 || cus * per_cu < 256) { fprintf(stderr, "kernel_launch: cannot co-reside 256 workgroups (%d CUs x %d)\n", cus, per_cu); return; }
        ok = 1;
    }
    if (ok < 0) return;
    fk::FP p{}; for (int i = 0; i < 33; ++i) p.in[i] = (const float*)d_in[i]; p.X = (float*)d_out; p.ws = (unsigned char*)d_ws;
    if (hipMemsetAsync((char*)d_ws + fk::P_BAR, 0, 16384, stream) != hipSuccess) return;
    void* args[] = {&p};
    hipError_t e = hipLaunchCooperativeKernel((const void*)fk::mega, dim3(256), dim3(fk::NTHR), args, fk::LDS_BYTES, stream);
    if (e != hipSuccess) fprintf(stderr, "cooperative launch failed: %s\n", hipGetErrorString(e));
}
```

```cpp
#include <hip/hip_runtime.h>
#include <hip/hip_cooperative_groups.h>
#include <cstdio>
#include <cstdint>
#include <cmath>
namespace fk {
#define LAS __attribute__((address_space(3)))
typedef unsigned short bf16_t;
typedef short bf16x8 __attribute__((ext_vector_type(8)));
typedef short s16x4 __attribute__((ext_vector_type(4)));
typedef float f32x4 __attribute__((ext_vector_type(4)));
typedef float f32x16 __attribute__((ext_vector_type(16)));
typedef float f32x2 __attribute__((ext_vector_type(2)));
typedef unsigned u32x4 __attribute__((ext_vector_type(4)));
typedef unsigned u32x2 __attribute__((ext_vector_type(2)));
typedef __bf16 bf16x2_t __attribute__((ext_vector_type(2)));

constexpr int NT = 32768, DM = 1024, SEQ = 4096;
constexpr int NTHR = 512, NWAVE = 8;
constexpr float ALPHA = 1.4142135623730951f, LN_EPS = 1e-5f, LOG2E = 1.4426950408889634f;

__device__ __forceinline__ unsigned pk2(float lo, float hi) { f32x2 v = {lo, hi}; bf16x2_t b = __builtin_convertvector(v, bf16x2_t); return __builtin_bit_cast(unsigned, b); }
__device__ __forceinline__ float bf_lo(unsigned w) { return __uint_as_float(w << 16); }
__device__ __forceinline__ float bf_hi(unsigned w) { return __uint_as_float(w & 0xffff0000u); }
__device__ __forceinline__ float bf2f(bf16_t b) { return __uint_as_float(((unsigned)b) << 16); }
__device__ __forceinline__ bf16_t f2bf(float f) { return (bf16_t)(pk2(f, 0.f) & 0xffffu); }
__device__ __forceinline__ float fast_exp(float x) { return __builtin_amdgcn_exp2f(x * LOG2E); }
__device__ __forceinline__ float sigmoid_f(float x) { return __builtin_amdgcn_rcpf(1.f + fast_exp(-x)); }
__device__ __forceinline__ float silu_f(float x) { return x * sigmoid_f(x); }
__device__ __forceinline__ float gelu_tanh_f(float x) { const float u = 1.5957691216057308f * (x + 0.044715f * x * x * x); return x * sigmoid_f(u); }
__device__ __forceinline__ int crow(int r, int hi) { return (r & 3) + 8 * (r >> 2) + 4 * hi; }
__device__ __forceinline__ float xhalf_sum(float v) { auto rr = __builtin_amdgcn_permlane32_swap(__float_as_uint(v), __float_as_uint(v), false, false); return __uint_as_float(rr[0]) + __uint_as_float(rr[1]); }
__device__ __forceinline__ float xhalf_max(float v) { auto rr = __builtin_amdgcn_permlane32_swap(__float_as_uint(v), __float_as_uint(v), false, false); return fmaxf(__uint_as_float(rr[0]), __uint_as_float(rr[1])); }
__device__ __forceinline__ float shx(float v, int o, int lane) { return __int_as_float(__builtin_amdgcn_ds_bpermute((lane ^ o) << 2, __float_as_int(v))); }
__device__ __forceinline__ float shup(float v, int o, int lane) { return __int_as_float(__builtin_amdgcn_ds_bpermute(((lane - o) & 63) << 2, __float_as_int(v))); }
__device__ __forceinline__ float shidx(float v, int idx) { return __int_as_float(__builtin_amdgcn_ds_bpermute(idx << 2, __float_as_int(v))); }
__device__ __forceinline__ s16x4 lds_tr(const LAS void* p) { return __builtin_bit_cast(s16x4, __builtin_amdgcn_ds_read_tr16_b64_v4i16((LAS s16x4*)p)); }
#define MFMA32(a, b, c) __builtin_amdgcn_mfma_f32_32x32x16_bf16((a), (b), (c), 0, 0, 0)

namespace pg8 {
constexpr int BM = 256, BK = 64, HALF = 128, HTB = HALF * BK * 2, STAGE_BYTES = 8 * HTB, NXCD = 8, WGM = 8;
__host__ __device__ __forceinline__ int lds_byte(int r, int c) { const int st = (r >> 4) * 2 + (c >> 5), rr = r & 15, cc = c & 31, ob = rr * 64 + cc * 2; return st * 1024 + (ob ^ (((ob >> 9) & 1) << 5)); }
__host__ __device__ __forceinline__ void stage_rc(int b, int& R, int& C) { const int st = b / 1024, sb = b % 1024, swz = sb ^ (((sb >> 9) & 1) << 5); R = (st >> 1) * 16 + swz / 64; C = (st & 1) * 32 + (swz % 64) / 2; }
__host__ __device__ __forceinline__ int perm32(int rho) { const int n = rho >> 4, i = rho & 15; return 8 * (i >> 2) + 4 * n + (i & 3); }

struct Unit { const char* A; const char* B; const int* src; int pm, pn, job; };

__device__ __forceinline__ void tile_order(int l, int nM, int nN, int& pm, int& pn) {
    const int nwg = nM * nN; int wgid = l;
    { const int q = nwg / NXCD, r = nwg % NXCD, xcd = wgid % NXCD, off = wgid / NXCD; wgid = (xcd < r ? xcd * (q + 1) : r * (q + 1) + (xcd - r) * q) + off; }
    const int nig = WGM * nN, gid = wgid / nig, fm = gid * WGM, gsz = (nM - fm) < WGM ? (nM - fm) : WGM;
    pm = fm + ((wgid % nig) % gsz); pn = (wgid % nig) / gsz;
}
struct JobDesc { unsigned long long A, B, out, bias, rot, out2; int nM, nN, ldc, mode; };
__device__ __forceinline__ unsigned long long rfl64(unsigned long long v) { const unsigned lo = __builtin_amdgcn_readfirstlane((unsigned)v), hi = __builtin_amdgcn_readfirstlane((unsigned)(v >> 32)); return ((unsigned long long)hi << 32) | lo; }
constexpr int JT_OFF = STAGE_BYTES;
struct Jobs3 {
    const LAS JobDesc* jt; int n0, n1, n2; int K, G, c;
    __device__ __forceinline__ Unit get(int i, bool& ok) const { Unit u; u.A = nullptr; u.B = nullptr; u.src = nullptr; u.pm = 0; u.pn = 0; u.job = 0; ok = next(i, u); return u; }
    __device__ __forceinline__ bool next(int i, Unit& u) const {
        long L = (long)i * G + c;
        if (L >= (long)n0 + n1 + n2) return false;
        int l = (int)L; int jb = 0;
        if (l >= n0) { l -= n0; jb = 1; if (l >= n1) { l -= n1; jb = 2; } }
        const int jM = __builtin_amdgcn_readfirstlane(jt[jb].nM), jN = __builtin_amdgcn_readfirstlane(jt[jb].nN);
        int pm, pn; tile_order(l, jM, jN, pm, pn);
        const size_t tstep = (size_t)BM * K * 2;
        u.A = (const char*)rfl64(jt[jb].A) + (size_t)pm * tstep; u.B = (const char*)rfl64(jt[jb].B) + (size_t)pn * tstep; u.src = nullptr; u.pm = pm; u.pn = pn; u.job = jb; return true;
    }
};

template <class Epi, class Sched, bool ALIGN_EPI, bool SP2>
__device__ __forceinline__ void gemm_phase(LAS unsigned char* lds, const int K, const Sched& S, const Epi& E) {
    int tid_ = threadIdx.x; asm volatile("" : "+v"(tid_)); const int tid = tid_, wid = __builtin_amdgcn_readfirstlane(tid >> 6), lane = tid & 63, wr = wid >> 2, wc = wid & 3, fr = lane & 15, fq = lane >> 4;
    const int nt = K / BK;
    static_assert(SP2, "only the two-super-phase form is kept");
    unsigned vA0[2], vA1[2], vB0[2], vB1[2];
#pragma unroll
    for (int i = 0; i < 2; ++i) { int R, C; stage_rc(tid * 16 + i * 8192, R, C); const int Rb = 64 * (R >> 5) + perm32(R & 31); vB0[i] = (unsigned)(Rb * K + C) * 2u; vB1[i] = (unsigned)((Rb + 32) * K + C) * 2u; }
    auto a_rows = [&](const int* src, unsigned (&o0)[2], unsigned (&o1)[2]) {
        int tq = tid; asm volatile("" : "+v"(tq));
#pragma unroll
        for (int i = 0; i < 2; ++i) { int R, C; stage_rc(tq * 16 + i * 8192, R, C); int r0 = R, r1 = R + HALF; if (src) { r0 = src[R]; r1 = src[R + HALF]; }
            o0[i] = (unsigned)(r0 * K + C) * 2u; o1[i] = (unsigned)(r1 * K + C) * 2u; }
    };
    const size_t kstep = (size_t)(BK * 2);
    const size_t hstep = (size_t)HALF * K * 2;
    const unsigned ldsw = (unsigned)wid * 1024u;
    const int aoff = lds_byte(wr * 64 + fr, fq * 8), boff = lds_byte(wc * 32 + fr, fq * 8);
#define PG8_SA(b, h) (((b) * 2 + (h)) * HTB)
#define PG8_SB(b, h) ((4 + (b) * 2 + (h)) * HTB)
#define PG8_STAGE(bufoff, gbase, voff) do { _Pragma("unroll") for (int _i = 0; _i < 2; ++_i) \
        __builtin_amdgcn_global_load_lds((const unsigned*)((const char*)(gbase) + (voff)[_i]), (LAS unsigned*)(lds + (bufoff) + ldsw + _i * 8192), 16, 0, 0); } while (0)
#define PG8_LDA(dst, b, h) do { _Pragma("unroll") for (int m = 0; m < 4; ++m) _Pragma("unroll") for (int k = 0; k < 2; ++k) dst[m][k] = *(const LAS bf16x8*)(lds + PG8_SA(b, h) + aoff + m * 2048 + k * 1024); } while (0)
#define PG8_LDB(dst, b, h) do { _Pragma("unroll") for (int n = 0; n < 2; ++n) _Pragma("unroll") for (int k = 0; k < 2; ++k) dst[n][k] = *(const LAS bf16x8*)(lds + PG8_SB(b, h) + boff + n * 2048 + k * 1024); } while (0)
#define PG8_MMA(ai, bj, At, Bt) do { __builtin_amdgcn_s_setprio(1); _Pragma("unroll") for (int m = 0; m < 4; ++m) _Pragma("unroll") for (int n = 0; n < 2; ++n) _Pragma("unroll") for (int k = 0; k < 2; ++k) \
        acc[ai][bj][m][n] = __builtin_amdgcn_mfma_f32_16x16x32_bf16(Bt[n][k], At[m][k], acc[ai][bj][m][n], 0, 0, 0); __builtin_amdgcn_s_setprio(0); } while (0)
#define PG8_WAIT_V(n) asm volatile("s_waitcnt vmcnt(" #n ")" ::: "memory")
#define PG8_WAIT_L(n) asm volatile("s_waitcnt lgkmcnt(" #n ")" ::: "memory")
#define PG8_BAR __builtin_amdgcn_s_barrier()
#define PG8_SCHED __builtin_amdgcn_sched_barrier(0)
    auto unif = [](Unit u) { Unit r; r.A = (const char*)rfl64((unsigned long long)u.A); r.B = (const char*)rfl64((unsigned long long)u.B); r.src = (const int*)rfl64((unsigned long long)u.src);
        r.pm = __builtin_amdgcn_readfirstlane(u.pm); r.pn = __builtin_amdgcn_readfirstlane(u.pn); r.job = __builtin_amdgcn_readfirstlane(u.job); return r; };
    int ui = 0; bool ok0; Unit cur = unif(S.get(0, ok0));
    if (!ok0) return;
    f32x4 acc[2][2][4][2];
#pragma unroll
    for (int a = 0; a < 2; ++a)
#pragma unroll
        for (int b = 0; b < 2; ++b)
#pragma unroll
            for (int m = 0; m < 4; ++m)
#pragma unroll
                for (int n = 0; n < 2; ++n) acc[a][b][m][n] = (f32x4){0.f, 0.f, 0.f, 0.f};
    bf16x8 At[4][2], B0[2][2], B1[2][2];
    const char* cA = cur.A; const char* cB = cur.B;
    a_rows(cur.src, vA0, vA1);
    {
        PG8_STAGE(PG8_SB(0, 0), cB, vB0); PG8_STAGE(PG8_SB(0, 1), cB, vB1); PG8_STAGE(PG8_SA(0, 0), cA, vA0); PG8_STAGE(PG8_SA(0, 1), cA, vA1);
        if (wr == 1) PG8_BAR;
        PG8_WAIT_V(2); PG8_BAR;
        PG8_STAGE(PG8_SB(1, 0), cB + kstep, vB0); PG8_STAGE(PG8_SA(1, 0), cA + kstep, vA0); PG8_STAGE(PG8_SB(1, 1), cB + kstep, vB1);
        PG8_WAIT_V(6); PG8_BAR;
    }
    for (;;) {
        bool has_next; const Unit nxt = unif(S.get(ui + 1, has_next)); bool early_done = false;
        const char* nA = has_next ? nxt.A : cA; const char* nB = has_next ? nxt.B : cB;
        for (int t = 0; t < nt; t += 2) {
            const bool last = (t == nt - 2);
            const char* a1 = cA + (size_t)(t + 1) * kstep;
            const char* a2 = last ? nA : cA + (size_t)(t + 2) * kstep; const char* b2 = last ? nB : cB + (size_t)(t + 2) * kstep;
            const char* a3 = a2 + kstep; const char* b3 = b2 + kstep;
            PG8_LDB(B0, 0, 0); PG8_LDB(B1, 0, 1); PG8_SCHED; PG8_LDA(At, 0, 0); PG8_STAGE(PG8_SA(1, 1), a1, vA1);
            if (last && has_next) a_rows(nxt.src, vA0, vA1);
            PG8_WAIT_V(8); PG8_WAIT_L(0); PG8_BAR; PG8_MMA(0, 0, At, B0); PG8_MMA(0, 1, At, B1); PG8_BAR; PG8_SCHED;
            PG8_LDA(At, 0, 1); PG8_STAGE(PG8_SB(0, 0), b2, vB0); PG8_STAGE(PG8_SB(0, 1), b2, vB1); PG8_STAGE(PG8_SA(0, 0), a2, vA0);
            PG8_WAIT_V(8); PG8_WAIT_L(0); PG8_BAR; PG8_MMA(1, 0, At, B0); PG8_MMA(1, 1, At, B1); PG8_BAR; PG8_SCHED;
            PG8_LDB(B0, 1, 0); PG8_LDB(B1, 1, 1); PG8_SCHED; PG8_LDA(At, 1, 0); PG8_STAGE(PG8_SA(0, 1), a2, vA1);
            PG8_WAIT_V(8); PG8_WAIT_L(0); PG8_BAR; PG8_MMA(0, 0, At, B0); PG8_MMA(0, 1, At, B1); PG8_BAR; PG8_SCHED;
            if (last) { early_done = E.early(acc, cur, wr, wc, fr, fq); PG8_SCHED; }
            PG8_LDA(At, 1, 1); PG8_STAGE(PG8_SB(1, 0), b3, vB0); PG8_STAGE(PG8_SB(1, 1), b3, vB1); PG8_STAGE(PG8_SA(1, 0), a3, vA0);
            PG8_WAIT_V(8); PG8_WAIT_L(0); PG8_BAR; PG8_MMA(1, 0, At, B0); PG8_MMA(1, 1, At, B1); PG8_BAR; PG8_SCHED;
        }
        if constexpr (ALIGN_EPI) { if (wr == 0) PG8_BAR; }
        if (!early_done) E.template half<0>(acc, cur, wr, wc, fr, fq);
        E.template half<1>(acc, cur, wr, wc, fr, fq);
        if (!has_next) break;
#pragma unroll
        for (int a = 0; a < 2; ++a)
#pragma unroll
            for (int b = 0; b < 2; ++b)
#pragma unroll
                for (int m = 0; m < 4; ++m)
#pragma unroll
                    for (int n = 0; n < 2; ++n) acc[a][b][m][n] = (f32x4){0.f, 0.f, 0.f, 0.f};
        cur = nxt; cA = nA; cB = nB; ++ui;
        if constexpr (ALIGN_EPI) { if (wr == 1) PG8_BAR; }
    }
    PG8_WAIT_V(0);
    if constexpr (!ALIGN_EPI) { if (wr == 0) PG8_BAR; }
    PG8_BAR;
#undef PG8_SA
#undef PG8_SB
#undef PG8_STAGE
#undef PG8_LDA
#undef PG8_LDB
#undef PG8_MMA
#undef PG8_WAIT_V
#undef PG8_WAIT_L
#undef PG8_BAR
#undef PG8_SCHED
}
}
enum { EM_PLAIN = 0, EM_GELU4 = 1, EM_SWIGLU = 2, EM_ROTARY = 3, EM_ROWBIAS = 4 };
struct EpiMulti {
    static constexpr bool PERM = true;
    const LAS pg8::JobDesc* jt;
    __device__ __forceinline__ bool early(const f32x4 (&acc)[2][2][4][2], const pg8::Unit& u, int wr, int wc, int fr, int fq) const {
        const LAS pg8::JobDesc* jd = jt + u.job;
        if (__builtin_amdgcn_readfirstlane(jd->mode) != EM_PLAIN) return false;
        bf16_t* out = (bf16_t*)pg8::rfl64(jd->out); const int ldc = __builtin_amdgcn_readfirstlane(jd->ldc);
        bf16_t* rowp = out + (size_t)(u.pm * 256 + wr * 64 + fr) * ldc + u.pn * 256 + wc * 64 + 8 * fq;
#pragma unroll
        for (int m = 0; m < 4; ++m)
#pragma unroll
            for (int bj = 0; bj < 2; ++bj) { const f32x4 v0 = acc[0][bj][m][0], v1 = acc[0][bj][m][1];
                u32x4 w; w.x = pk2(v0[0], v0[1]); w.y = pk2(v0[2], v0[3]); w.z = pk2(v1[0], v1[1]); w.w = pk2(v1[2], v1[3]);
                *(u32x4*)(rowp + (size_t)m * 16 * ldc + bj * 32) = w; }
        return true;
    }
    template <int AI>
    __device__ __forceinline__ void half(const f32x4 (&acc)[2][2][4][2], const pg8::Unit& u, int wr, int wc, int fr, int fq) const {
        const LAS pg8::JobDesc* jd = jt + u.job;
        bf16_t* out = (bf16_t*)pg8::rfl64(jd->out);
        const int ldc = __builtin_amdgcn_readfirstlane(jd->ldc);
        const int mode = __builtin_amdgcn_readfirstlane(jd->mode);
        const float* bias = (const float*)pg8::rfl64(jd->bias);
        const int row0 = u.pm * 256 + wr * 64 + fr;
        const int colt = u.pn * 256 + wc * 64 + 8 * fq;
        if (mode == EM_PLAIN || mode == EM_ROWBIAS) {
#pragma unroll
            for (int ai = AI; ai < AI + 1; ++ai)
#pragma unroll
                for (int m = 0; m < 4; ++m) { const int row = row0 + ai * 128 + m * 16; const float rb = (mode == EM_ROWBIAS && bias) ? bias[row] : 0.f;
                    bf16_t* rowp = out + (size_t)row * ldc + colt;
#pragma unroll
                    for (int bj = 0; bj < 2; ++bj) { const f32x4 v0 = acc[ai][bj][m][0] + rb, v1 = acc[ai][bj][m][1] + rb;
                        u32x4 w; w.x = pk2(v0[0], v0[1]); w.y = pk2(v0[2], v0[3]); w.z = pk2(v1[0], v1[1]); w.w = pk2(v1[2], v1[3]);
                        *(u32x4*)(rowp + bj * 32) = w; } }
        } else if (mode == EM_GELU4) {
            const int arr = u.pn >> 1; bf16_t* base = out + (size_t)arr * NT * 512; const int col = colt - arr * 512; const bool act = arr < 2;
#pragma unroll
            for (int ai = AI; ai < AI + 1; ++ai)
#pragma unroll
                for (int m = 0; m < 4; ++m) { bf16_t* rowp = base + (size_t)(row0 + ai * 128 + m * 16) * 512 + col;
#pragma unroll
                    for (int bj = 0; bj < 2; ++bj) { f32x4 v0 = acc[ai][bj][m][0], v1 = acc[ai][bj][m][1];
                        if (act) {
#pragma unroll
                            for (int e = 0; e < 4; ++e) { v0[e] = gelu_tanh_f(v0[e]); v1[e] = gelu_tanh_f(v1[e]); } }
                        u32x4 w; w.x = pk2(v0[0], v0[1]); w.y = pk2(v0[2], v0[3]); w.z = pk2(v1[0], v1[1]); w.w = pk2(v1[2], v1[3]);
                        *(u32x4*)(rowp + bj * 32) = w; } }
        } else if (mode == EM_SWIGLU) {
#pragma unroll
            for (int ai = AI; ai < AI + 1; ++ai)
#pragma unroll
                for (int m = 0; m < 4; ++m) { bf16_t* rowp = out + (size_t)(row0 + ai * 128 + m * 16) * ldc + (colt >> 1);
#pragma unroll
                    for (int bj = 0; bj < 2; ++bj) { const f32x4 v0 = acc[ai][bj][m][0], v1 = acc[ai][bj][m][1];
                        u32x2 w; w.x = pk2(silu_f(v0[0]) * v0[1], silu_f(v0[2]) * v0[3]); w.y = pk2(silu_f(v1[0]) * v1[1], silu_f(v1[2]) * v1[3]);
                        *(u32x2*)(rowp + bj * 16) = w; } }
        } else {
            const float* rot = (const float*)pg8::rfl64(jd->rot);
            bf16_t* out2 = (bf16_t*)pg8::rfl64(jd->out2);
            const bool isk = u.pn >= 4; bf16_t* base = isk ? out2 : out; const int ld = isk ? 256 : 1024; const int colo = isk ? colt - 1024 : colt;
            float bv[2][8];
#pragma unroll
            for (int bj = 0; bj < 2; ++bj)
#pragma unroll
                for (int e = 0; e < 8; ++e) bv[bj][e] = bias ? bias[colt + bj * 32 + e] : 0.f;
            const int i0 = (colt & 63) >> 1;
#pragma unroll
            for (int ai = AI; ai < AI + 1; ++ai)
#pragma unroll
                for (int m = 0; m < 4; ++m) { const int row = row0 + ai * 128 + m * 16; const int pos = row & (SEQ - 1);
                    bf16_t* rowp = base + (size_t)row * ld + colo;
#pragma unroll
                    for (int bj = 0; bj < 2; ++bj) { f32x4 v0 = acc[ai][bj][m][0], v1 = acc[ai][bj][m][1];
                        const f32x4 cs0 = *(const f32x4*)(rot + ((size_t)pos * 32 + i0 + 16 * bj) * 2), cs1 = *(const f32x4*)(rot + ((size_t)pos * 32 + i0 + 16 * bj + 2) * 2);
#pragma unroll
                        for (int e = 0; e < 4; ++e) { v0[e] += bv[bj][e]; v1[e] += bv[bj][4 + e]; }
                        const float a0 = v0[0] * cs0[0] - v0[1] * cs0[1], b0 = v0[1] * cs0[0] + v0[0] * cs0[1];
                        const float a1 = v0[2] * cs0[2] - v0[3] * cs0[3], b1 = v0[3] * cs0[2] + v0[2] * cs0[3];
                        const float a2 = v1[0] * cs1[0] - v1[1] * cs1[1], b2 = v1[1] * cs1[0] + v1[0] * cs1[1];
                        const float a3 = v1[2] * cs1[2] - v1[3] * cs1[3], b3 = v1[3] * cs1[2] + v1[2] * cs1[3];
                        u32x4 w; w.x = pk2(a0, b0); w.y = pk2(a1, b1); w.z = pk2(a2, b2); w.w = pk2(a3, b3);
                        *(u32x4*)(rowp + bj * 32) = w; } }
        }
    }
};
enum { RM_IDENT = 0, RM_ROT = 1, RM_PAIR0 = 2, RM_PAIR1 = 3 };
__device__ __forceinline__ int rowmap(int kind, int n) {
    if (kind == RM_ROT) { if (n >= 1280) return n; const int d = n & 63; return (n & ~63) + 2 * (d & 31) + (d >> 5); }
    if (kind == RM_PAIR0) return 2 * n;
    if (kind == RM_PAIR1) return 2 * n + 1;
    return n;
}
__device__ __forceinline__ void transpose_item(const float* __restrict__ W, int ldw, int K, bf16_t* __restrict__ WT, LAS float* scr, int kb, int nb, int lane, int kind, float scale, int nscale) {
    const int k0 = 64 * kb, n0 = 32 * nb;
    float tv[32];
#pragma unroll
    for (int i = 0; i < 32; ++i) { const int kk = 2 * i + (lane >> 5); tv[i] = W[(size_t)(k0 + kk) * ldw + n0 + (lane & 31)]; }
#pragma unroll
    for (int i = 0; i < 32; ++i) { const int kk = 2 * i + (lane >> 5); scr[kk * 33 + (lane & 31)] = tv[i]; }
    __builtin_amdgcn_s_waitcnt(0xc07f); asm volatile("" ::: "memory");
    const int c = lane & 7;
#pragma unroll
    for (int j = 0; j < 4; ++j) { const int n = (lane >> 3) + 8 * j; const LAS float* s = scr + (8 * c) * 33 + n; const float sc = (n0 + n) < nscale ? scale : 1.f;
        u32x4 o; o.x = pk2(s[0 * 33] * sc, s[1 * 33] * sc); o.y = pk2(s[2 * 33] * sc, s[3 * 33] * sc); o.z = pk2(s[4 * 33] * sc, s[5 * 33] * sc); o.w = pk2(s[6 * 33] * sc, s[7 * 33] * sc);
        *(u32x4*)(WT + (size_t)rowmap(kind, n0 + n) * K + k0 + 8 * c) = o; }
    __builtin_amdgcn_s_waitcnt(0xc07f); asm volatile("" ::: "memory");
}
__device__ __forceinline__ void convert_mats(const float* W, int K, int N, int nbat, size_t sstr, bf16_t* WT, size_t dstr, int kind, float scale, int nscale, LAS float* scr, int gw, int ngw, int lane) {
    const int nblk = N / 32, per = (K / 64) * nblk, total = per * nbat;
    for (int it = gw; it < total; it += ngw) { const int bt = it / per, r = it - bt * per; transpose_item(W + (size_t)bt * sstr, N, K, WT + (size_t)bt * dstr, scr, r / nblk, r % nblk, lane, kind, scale, nscale); }
}
__device__ __forceinline__ void convert_rows(const float* __restrict__ src, bf16_t* __restrict__ dst, size_t n, int gt, int ngt) {
    const size_t step = (size_t)ngt * 8; size_t i = (size_t)gt * 8;
    for (; i + 3 * step < n; i += 4 * step) { f32x4 a[4], b[4];
#pragma unroll
        for (int j = 0; j < 4; ++j) { a[j] = *(const f32x4*)(src + i + j * step); b[j] = *(const f32x4*)(src + i + j * step + 4); }
#pragma unroll
        for (int j = 0; j < 4; ++j) { u32x4 o; o.x = pk2(a[j][0], a[j][1]); o.y = pk2(a[j][2], a[j][3]); o.z = pk2(b[j][0], b[j][1]); o.w = pk2(b[j][2], b[j][3]); *(u32x4*)(dst + i + j * step) = o; } }
    for (; i < n; i += step) { const f32x4 a = *(const f32x4*)(src + i), b = *(const f32x4*)(src + i + 4);
        u32x4 o; o.x = pk2(a[0], a[1]); o.y = pk2(a[2], a[3]); o.z = pk2(b[0], b[1]); o.w = pk2(b[2], b[3]); *(u32x4*)(dst + i) = o; }
}

struct LnArgs { const float* xin32; const bf16_t* xin; float* xout32; bf16_t* xbf; const bf16_t* y; const float* g; const float* b; const int* dest; const float* wts; };
template <int NR, bool XF32, bool OUTF32, bool MOE>
__device__ __forceinline__ void ln_rows(const LnArgs& a, int row0, int lane) {
    float v[NR][2][8];
    {
        int d0[NR], d1[NR]; float w0[NR], w1[NR];
        if (MOE) {
#pragma unroll
            for (int i = 0; i < NR; ++i) { d0[i] = a.dest[(row0 + i) * 2]; d1[i] = a.dest[(row0 + i) * 2 + 1]; w0[i] = a.wts[(row0 + i) * 2]; w1[i] = a.wts[(row0 + i) * 2 + 1]; }
        }
        f32x4 xf[XF32 ? NR : 1][2][2]; u32x4 xb[XF32 ? 1 : NR][2]; u32x4 p[NR][2], q[MOE ? NR : 1][2];
#pragma unroll
        for (int i = 0; i < NR; ++i) {
            const u32x4* y0 = (const u32x4*)(a.y + (size_t)(MOE ? d0[i] : row0 + i) * DM) + lane; const u32x4* y1 = (const u32x4*)(a.y + (size_t)(MOE ? d1[i] : 0) * DM) + lane;
#pragma unroll
            for (int j = 0; j < 2; ++j) {
                if (XF32) { const f32x4* xr = (const f32x4*)(a.xin32 + (size_t)(row0 + i) * DM) + 2 * lane + 128 * j; xf[XF32 ? i : 0][j][0] = xr[0]; xf[XF32 ? i : 0][j][1] = xr[1]; }
                else xb[XF32 ? 0 : i][j] = ((const u32x4*)(a.xin + (size_t)(row0 + i) * DM) + lane)[64 * j];
                p[i][j] = y0[64 * j]; if (MOE) q[MOE ? i : 0][j] = y1[64 * j]; } }
#pragma unroll
        for (int i = 0; i < NR; ++i)
#pragma unroll
            for (int j = 0; j < 2; ++j) {
                float x[8];
                if (XF32) {
#pragma unroll
                    for (int e = 0; e < 4; ++e) { x[e] = xf[XF32 ? i : 0][j][0][e]; x[4 + e] = xf[XF32 ? i : 0][j][1][e]; } }
                else { const u32x4 w = xb[XF32 ? 0 : i][j]; x[0] = bf_lo(w.x); x[1] = bf_hi(w.x); x[2] = bf_lo(w.y); x[3] = bf_hi(w.y); x[4] = bf_lo(w.z); x[5] = bf_hi(w.z); x[6] = bf_lo(w.w); x[7] = bf_hi(w.w); }
                const u32x4 pw = p[i][j]; const float py[8] = {bf_lo(pw.x), bf_hi(pw.x), bf_lo(pw.y), bf_hi(pw.y), bf_lo(pw.z), bf_hi(pw.z), bf_lo(pw.w), bf_hi(pw.w)};
                if (MOE) { const u32x4 qw = q[MOE ? i : 0][j]; const float qy[8] = {bf_lo(qw.x), bf_hi(qw.x), bf_lo(qw.y), bf_hi(qw.y), bf_lo(qw.z), bf_hi(qw.z), bf_lo(qw.w), bf_hi(qw.w)};
#pragma unroll
                    for (int e = 0; e < 8; ++e) v[i][j][e] = ALPHA * x[e] + w0[i] * py[e] + w1[i] * qy[e]; }
                else {
#pragma unroll
                    for (int e = 0; e < 8; ++e) v[i][j][e] = ALPHA * x[e] + py[e]; }
            }
    }
    float s[NR];
#pragma unroll
    for (int i = 0; i < NR; ++i) { s[i] = 0.f;
#pragma unroll
        for (int j = 0; j < 2; ++j)
#pragma unroll
            for (int e = 0; e < 8; ++e) s[i] += v[i][j][e]; }
#pragma unroll
    for (int o = 1; o < 64; o <<= 1)
#pragma unroll
        for (int i = 0; i < NR; ++i) s[i] += shx(s[i], o, lane);
    float q2[NR];
#pragma unroll
    for (int i = 0; i < NR; ++i) { const float mean = s[i] * (1.f / DM); q2[i] = 0.f;
#pragma unroll
        for (int j = 0; j < 2; ++j)
#pragma unroll
            for (int e = 0; e < 8; ++e) { v[i][j][e] -= mean; q2[i] += v[i][j][e] * v[i][j][e]; } }
#pragma unroll
    for (int o = 1; o < 64; o <<= 1)
#pragma unroll
        for (int i = 0; i < NR; ++i) q2[i] += shx(q2[i], o, lane);
    f32x4 gv[2][2], bv[2][2];
#pragma unroll
    for (int j = 0; j < 2; ++j) { const f32x4* gp = (const f32x4*)a.g + 2 * lane + 128 * j; const f32x4* bp = (const f32x4*)a.b + 2 * lane + 128 * j; gv[j][0] = gp[0]; gv[j][1] = gp[1]; bv[j][0] = bp[0]; bv[j][1] = bp[1]; }
#pragma unroll
    for (int i = 0; i < NR; ++i) { const float rstd = rsqrtf(q2[i] * (1.f / DM) + LN_EPS);
#pragma unroll
        for (int j = 0; j < 2; ++j) { float o[8];
#pragma unroll
            for (int e = 0; e < 8; ++e) o[e] = v[i][j][e] * rstd * gv[j][e >> 2][e & 3] + bv[j][e >> 2][e & 3];
            if (OUTF32) { f32x4* xo = (f32x4*)(a.xout32 + (size_t)(row0 + i) * DM) + 2 * lane + 128 * j; xo[0] = (f32x4){o[0], o[1], o[2], o[3]}; xo[1] = (f32x4){o[4], o[5], o[6], o[7]}; }
            else { u32x4 w; w.x = pk2(o[0], o[1]); w.y = pk2(o[2], o[3]); w.z = pk2(o[4], o[5]); w.w = pk2(o[6], o[7]); ((u32x4*)(a.xbf + (size_t)(row0 + i) * DM) + lane)[64 * j] = w; } } }
}
template <bool XF32, bool OUTF32, bool MOE>
__device__ __forceinline__ void ln_phase(const LnArgs& a, int blk, int G, int wave, int lane) {
    const int per = NT / G, r0 = blk * per, pw = per / NWAVE;
    for (int r = 0; r < pw; r += 4) ln_rows<4, XF32, OUTF32, MOE>(a, r0 + wave * pw + r, lane);
}
__device__ __forceinline__ void xattn_phase(LAS unsigned char* lds, const bf16_t* __restrict__ Q, const bf16_t* __restrict__ KC, const bf16_t* __restrict__ VT, bf16_t* __restrict__ O, int blk, int G) {
    const int tid0 = threadIdx.x, wave = __builtin_amdgcn_readfirstlane(tid0 >> 6);
#define XA_IDS int tid = tid0; asm volatile("" : "+v"(tid)); const int lane = tid & 63, r32 = lane & 31, hh = lane >> 5; const size_t qrow = (size_t)b * SEQ + qb * 256 + wave * 32 + r32; (void)lane; (void)hh; (void)qrow;
    for (int u = blk; u < 512; u += G) {
        const int qb = u & 15, h = (u >> 4) & 3, b = u >> 6;
        XA_IDS;
        bf16x8 qf[16];
#pragma unroll
        for (int ks = 0; ks < 16; ++ks) qf[ks] = *(const bf16x8*)(Q + qrow * 1024 + h * 256 + ks * 16 + hh * 8);
        __syncthreads();
#pragma unroll
        for (int bt = 0; bt < 2; ++bt) {
            u32x4 t[8];
#pragma unroll
            for (int i = 0; i < 8; ++i) { const int ch = tid + 512 * (bt * 8 + i), row = ch >> 5, c = ch & 31; t[i] = *(const u32x4*)(KC + (size_t)(b * 256 + row) * 1024 + h * 256 + c * 8); }
#pragma unroll
            for (int i = 0; i < 8; ++i) { const int ch = tid + 512 * (bt * 8 + i), row = ch >> 5, c = ch & 31; *(LAS u32x4*)(lds + row * 528 + c * 16) = t[i]; }
        }
        __syncthreads();
        f32x16 s[8];
#pragma unroll
        for (int mt = 0; mt < 8; ++mt)
#pragma unroll
            for (int r = 0; r < 16; ++r) s[mt][r] = 0.f;
        {   const LAS unsigned char* kbp = lds + r32 * 528 + hh * 16;
#pragma unroll
            for (int ks = 0; ks < 16; ++ks)
#pragma unroll
                for (int mt = 0; mt < 8; ++mt) { const bf16x8 a = *(const LAS bf16x8*)(kbp + mt * 32 * 528 + ks * 32); s[mt] = MFMA32(a, qf[ks], s[mt]); }
        }
        float mx = -INFINITY;
#pragma unroll
        for (int mt = 0; mt < 8; ++mt)
#pragma unroll
            for (int r = 0; r < 16; ++r) mx = fmaxf(mx, s[mt][r]);
        mx = xhalf_max(mx);
        float sm = 0.f; const float mxl = mx * LOG2E;
        u32x4 pf[8][2];
#pragma unroll
        for (int mt = 0; mt < 8; ++mt) {
#pragma unroll
            for (int r = 0; r < 16; ++r) { const float p = __builtin_amdgcn_exp2f(s[mt][r] * LOG2E - mxl); s[mt][r] = p; sm += p; }
#pragma unroll
            for (int sx = 0; sx < 2; ++sx) pf[mt][sx] = (u32x4){pk2(s[mt][8 * sx], s[mt][8 * sx + 1]), pk2(s[mt][8 * sx + 2], s[mt][8 * sx + 3]), pk2(s[mt][8 * sx + 4], s[mt][8 * sx + 5]), pk2(s[mt][8 * sx + 6], s[mt][8 * sx + 7])};
        }
        sm = xhalf_sum(sm);
        __syncthreads();
        {   XA_IDS;
#pragma unroll
        for (int bt = 0; bt < 4; ++bt) {
            u32x4 t[4];
#pragma unroll
            for (int i = 0; i < 4; ++i) { const int ch = tid + 512 * (bt * 4 + i), row = ch >> 5, c = ch & 31; t[i] = *(const u32x4*)(VT + (size_t)(h * 256 + row) * 2048 + b * 256 + c * 8); }
#pragma unroll
            for (int i = 0; i < 4; ++i) { const int ch = tid + 512 * (bt * 4 + i), row = ch >> 5, c = ch & 31; LAS u32x2* d = (LAS u32x2*)(lds + row * 520 + c * 16); d[0] = (u32x2){t[i].x, t[i].y}; d[1] = (u32x2){t[i].z, t[i].w}; }
        }
        }
        __syncthreads();
        {   XA_IDS;
        const float inv = 1.f / sm;
        bf16_t* orow = O + qrow * 1024 + h * 256 + 4 * hh;
#pragma unroll 1
        for (int dh = 0; dh < 2; ++dh) {
            f32x16 o[4];
#pragma unroll
            for (int dt = 0; dt < 4; ++dt)
#pragma unroll
                for (int r = 0; r < 16; ++r) o[dt][r] = 0.f;
            const LAS unsigned char* vb = lds + (dh * 128 + r32) * 520 + 8 * hh;
#pragma unroll
            for (int mt = 0; mt < 8; ++mt)
#pragma unroll
                for (int sx = 0; sx < 2; ++sx) { const int kb = mt * 32 + 16 * sx; const bf16x8 pb = __builtin_bit_cast(bf16x8, pf[mt][sx]);
#pragma unroll
                    for (int dt = 0; dt < 4; ++dt) { const LAS unsigned char* q = vb + dt * 32 * 520 + kb * 2;
                        const s16x4 lo = *(const LAS s16x4*)q, hi = *(const LAS s16x4*)(q + 16);
                        const bf16x8 a = (bf16x8){lo[0], lo[1], lo[2], lo[3], hi[0], hi[1], hi[2], hi[3]}; o[dt] = MFMA32(a, pb, o[dt]); } }
#pragma unroll
            for (int dt = 0; dt < 4; ++dt)
#pragma unroll
                for (int g = 0; g < 4; ++g) { u32x2 w; w.x = pk2(o[dt][4 * g] * inv, o[dt][4 * g + 1] * inv); w.y = pk2(o[dt][4 * g + 2] * inv, o[dt][4 * g + 3] * inv); *(u32x2*)(orow + dh * 128 + dt * 32 + 8 * g) = w; }
        }
        }
    }
#undef XA_IDS
}

struct RouteBufs { int* e; float* w; int* rank; int* dest; int* hist; int* tstart; int* src; };
__device__ __forceinline__ void moe_router_phase(LAS unsigned char* lds, const bf16_t* __restrict__ XBF, const bf16_t* __restrict__ WRT, const float* __restrict__ brg, const float* __restrict__ bre, const RouteBufs rb, int blk) {
    int tid_ = threadIdx.x; asm volatile("" : "+v"(tid_)); const int tid = tid_, lane = tid & 63, wave = __builtin_amdgcn_readfirstlane(tid >> 6), r32 = lane & 31, hh = lane >> 5;
    LAS unsigned char* XT = lds; LAS unsigned char* WT = lds + 128 * 528;
    LAS float* LG = (LAS float*)lds;
    LAS int* hist = (LAS int*)(lds + 128 * 65 * 4);
    const int rbk = wave & 3, ct = wave >> 2;
    f32x16 acc;
#pragma unroll
    for (int r = 0; r < 16; ++r) acc[r] = 0.f;
#pragma unroll 1
    for (int kc = 0; kc < 4; ++kc) {
        __syncthreads();
        {   u32x4 tx[8], tw[8];
#pragma unroll
            for (int i = 0; i < 8; ++i) { const int ch = tid + 512 * i, row = ch >> 5, c = ch & 31; tx[i] = *(const u32x4*)(XBF + (size_t)(blk * 128 + row) * 1024 + kc * 256 + c * 8); tw[i] = *(const u32x4*)(WRT + (size_t)row * 1024 + kc * 256 + c * 8); }
#pragma unroll
            for (int i = 0; i < 8; ++i) { const int ch = tid + 512 * i, row = ch >> 5, c = ch & 31; *(LAS u32x4*)(XT + row * 528 + c * 16) = tx[i]; *(LAS u32x4*)(WT + row * 528 + c * 16) = tw[i]; } }
        __syncthreads();
        const LAS unsigned char* ap = XT + (rbk * 32 + r32) * 528 + hh * 16; const LAS unsigned char* bp = WT + (ct * 32 + r32) * 528 + hh * 16;
#pragma unroll
        for (int ks = 0; ks < 16; ++ks) { const bf16x8 a = *(const LAS bf16x8*)(ap + ks * 32), b0 = *(const LAS bf16x8*)(bp + ks * 32), b1 = *(const LAS bf16x8*)(bp + 64 * 528 + ks * 32);
            acc = MFMA32(a, b0, acc); acc = MFMA32(a, b1, acc); }
    }
    __syncthreads();
    if (tid < 32) hist[tid] = 0;
#pragma unroll
    for (int r = 0; r < 16; ++r) LG[(rbk * 32 + crow(r, hh)) * 65 + ct * 32 + r32] = acc[r];
    __syncthreads();
    if (tid < 128) {
        const LAS float* lg = LG + tid * 65; const int tok = blk * 128 + tid;
        float g4[4];
#pragma unroll
        for (int g = 0; g < 4; ++g) g4[g] = lg[32 + g] + brg[g];
        int gi = 0; float gm = g4[0];
#pragma unroll
        for (int g = 1; g < 4; ++g) if (g4[g] > gm) { gm = g4[g]; gi = g; }
        float gs = 0.f;
#pragma unroll
        for (int g = 0; g < 4; ++g) gs += fast_exp(g4[g] - gm);
        const float gate_g = 1.f / gs;
        float le[8];
#pragma unroll
        for (int e = 0; e < 8; ++e) le[e] = lg[gi * 8 + e] + bre[gi * 8 + e];
        int i0 = 0; float v0 = le[0];
#pragma unroll
        for (int e = 1; e < 8; ++e) if (le[e] > v0) { v0 = le[e]; i0 = e; }
        int i1 = 0; float v1 = -INFINITY;
#pragma unroll
        for (int e = 0; e < 8; ++e) if (e != i0 && le[e] > v1) { v1 = le[e]; i1 = e; }
        const float e1 = fast_exp(v1 - v0), p0 = 1.f / (1.f + e1), p1 = e1 * p0;
        const int ex0 = gi * 8 + i0, ex1 = gi * 8 + i1;
        rb.e[tok * 2] = ex0; rb.e[tok * 2 + 1] = ex1; rb.w[tok * 2] = gate_g * p0; rb.w[tok * 2 + 1] = gate_g * p1;
        rb.rank[tok * 2] = atomicAdd((int*)&hist[ex0], 1); rb.rank[tok * 2 + 1] = atomicAdd((int*)&hist[ex1], 1);
    }
    __syncthreads();
    if (tid < 32) rb.hist[blk * 32 + tid] = hist[tid];
}
__device__ __forceinline__ void moe_scatter_phase(LAS unsigned char* lds, const RouteBufs rb, int blk, int G) {
    int tid_ = threadIdx.x; asm volatile("" : "+v"(tid_)); const int tid = tid_, lane = tid & 63, wave = __builtin_amdgcn_readfirstlane(tid >> 6);
    LAS int* sb = (LAS int*)lds;
    __syncthreads();
    {
        const int e = tid & 31, part = tid >> 5; int c[16];
#pragma unroll
        for (int i = 0; i < 16; ++i) c[i] = rb.hist[(part * 16 + i) * 32 + e];
        int tot = 0, base = 0;
#pragma unroll
        for (int i = 0; i < 16; ++i) { tot += c[i]; if (part * 16 + i < blk) base += c[i]; }
        sb[128 + part * 32 + e] = base; sb[128 + 512 + part * 32 + e] = tot; }
    __syncthreads();
    if (tid < 32) { int tot = 0, base = 0;
#pragma unroll
        for (int i = 0; i < 16; ++i) { base += sb[128 + i * 32 + tid]; tot += sb[128 + 512 + i * 32 + tid]; }
        sb[tid] = base; sb[32 + tid] = tot; }
    __syncthreads();
    if (tid == 0) { int acc = 0; for (int e = 0; e < 32; ++e) { sb[64 + e] = acc; if (blk == 0) rb.tstart[e] = acc >> 8; acc += (sb[32 + e] + 255) & ~255; } sb[96] = acc; if (blk == 0) rb.tstart[32] = acc >> 8; }
    __syncthreads();
    if (tid < 256) { const int idx = blk * 256 + tid; const int e = rb.e[idx]; const int d = sb[64 + e] + sb[e] + rb.rank[idx]; rb.dest[idx] = d; rb.src[d] = idx >> 1; }
    if (blk < 32) { const int e = blk; const int lo = sb[64 + e] + sb[32 + e], hi = sb[64 + e] + ((sb[32 + e] + 255) & ~255); for (int r = lo + tid; r < hi; r += NTHR) rb.src[r] = 0; }
}
struct MoeSched {
    const char* A; const char* B; const int* tstart; int K, nN, G, c; size_t bexp;
    __device__ __forceinline__ pg8::Unit get(int i, bool& ok) const { pg8::Unit u; u.A = nullptr; u.B = nullptr; u.src = nullptr; u.pm = 0; u.pn = 0; u.job = 0; ok = next(i, u); return u; }
    __device__ __forceinline__ bool next(int i, pg8::Unit& u) const {
        const int vc = (c & 7) * (G >> 3) + (c >> 3);
        const long L = (long)i * G + vc; const int ntile = tstart[32];
        if (L >= (long)ntile * nN) return false;
        const int mt = (int)(L / nN), nt = (int)(L % nN);
        int e = 0;
        for (int k = 1; k < 32; ++k) if (tstart[k] <= mt) e = k;
        u.A = A + (size_t)mt * 256 * K * 2; u.B = B + (size_t)e * bexp + (size_t)nt * 256 * K * 2; u.src = nullptr; u.pm = mt; u.pn = nt; u.job = 0; return true;
    }
};
__device__ __forceinline__ void swa_phase(LAS unsigned char* lds, const bf16_t* __restrict__ Q1, const bf16_t* __restrict__ K1, const bf16_t* __restrict__ VT1, const float* __restrict__ sinks, bf16_t* __restrict__ O, int blk, int G) {
    int tid_ = threadIdx.x; asm volatile("" : "+v"(tid_)); const int tid = tid_, lane = tid & 63, wave = __builtin_amdgcn_readfirstlane(tid >> 6), r32 = lane & 31, hh = lane >> 5;
    LAS unsigned char* KL = lds;
    LAS unsigned char* VL = lds + 36864;
    for (int u = blk; u < 1024; u += G) {
        const int n = u & 31, kvh = (u >> 5) & 3, b = u >> 7;
        const int tokb = b * SEQ + (n - 1) * 128;
        bf16x8 qfa[2][4];
        {   const int g0 = wave >> 1, hq0 = kvh * 4 + g0;
#pragma unroll
            for (int sb = 0; sb < 2; ++sb)
#pragma unroll
                for (int ks = 0; ks < 4; ++ks) qfa[sb][ks] = *(const bf16x8*)(Q1 + ((size_t)b * SEQ + n * 128 + (wave & 1) * 64 + sb * 32 + r32) * 1024 + hq0 * 64 + ks * 16 + hh * 8); }
        __syncthreads();
#pragma unroll
        for (int i = 0; i < 4; ++i) { const int ch = tid + 512 * i; const int key = ch >> 3, c = ch & 7;
            u32x4 v = (u32x4){0u, 0u, 0u, 0u}; if (n > 0 || key >= 128) v = *(const u32x4*)(K1 + (size_t)(tokb + key) * 256 + kvh * 64 + c * 8);
            *(LAS u32x4*)(KL + key * 144 + c * 16) = v; }
#pragma unroll
        for (int i = 0; i < 4; ++i) { const int ch = tid + 512 * i; const int d = ch >> 5, c = ch & 31;
            u32x4 v = (u32x4){0u, 0u, 0u, 0u}; if (n > 0 || c >= 16) v = *(const u32x4*)(VT1 + (size_t)(kvh * 64 + d) * NT + tokb + c * 8);
            LAS u32x2* dp = (LAS u32x2*)(VL + d * 520 + c * 16); dp[0] = (u32x2){v.x, v.y}; dp[1] = (u32x2){v.z, v.w}; }
        __syncthreads();
        const int g = wave >> 1, hq = kvh * 4 + g; const float sink = sinks[hq];
#pragma unroll 1
        for (int sb = 0; sb < 2; ++sb) {
            bf16x8 qf[4];
#pragma unroll
            for (int ks = 0; ks < 4; ++ks) qf[ks] = sb ? qfa[1][ks] : qfa[0][ks];
            const int i0 = (wave & 1) * 64 + sb * 32, jt0 = i0 >> 5;
            const size_t qtok = (size_t)b * SEQ + n * 128 + i0 + r32;
            f32x16 s[5];
#pragma unroll
            for (int t = 0; t < 5; ++t) {
#pragma unroll
                for (int r = 0; r < 16; ++r) s[t][r] = 0.f;
                const LAS unsigned char* kp = KL + ((jt0 + t) * 32 + r32) * 144 + hh * 16;
#pragma unroll
                for (int ks = 0; ks < 4; ++ks) { const bf16x8 a = *(const LAS bf16x8*)(kp + ks * 32); s[t] = MFMA32(a, qf[ks], s[t]); }
            }
            const int qi = i0 + r32;
            float mx = sink;
#pragma unroll
            for (int t = 0; t < 5; ++t)
#pragma unroll
                for (int r = 0; r < 16; ++r) { const int kj = (jt0 + t) * 32 + crow(r, hh); const bool valid = (kj > qi) && (kj <= qi + 128) && (n > 0 || kj >= 128);
                    s[t][r] = valid ? s[t][r] : -INFINITY; mx = fmaxf(mx, s[t][r]); }
            mx = xhalf_max(mx);
            float sm = 0.f; const float mxl = mx * LOG2E;
            u32x4 pf[5][2];
#pragma unroll
            for (int t = 0; t < 5; ++t) {
#pragma unroll
                for (int r = 0; r < 16; ++r) { const float pv = __builtin_amdgcn_exp2f(s[t][r] * LOG2E - mxl); s[t][r] = pv; sm += pv; }
#pragma unroll
                for (int sx = 0; sx < 2; ++sx) pf[t][sx] = (u32x4){pk2(s[t][8 * sx], s[t][8 * sx + 1]), pk2(s[t][8 * sx + 2], s[t][8 * sx + 3]), pk2(s[t][8 * sx + 4], s[t][8 * sx + 5]), pk2(s[t][8 * sx + 6], s[t][8 * sx + 7])};
            }
            sm = xhalf_sum(sm) + __builtin_amdgcn_exp2f(sink * LOG2E - mxl);
            f32x16 o[2];
#pragma unroll
            for (int dt = 0; dt < 2; ++dt)
#pragma unroll
                for (int r = 0; r < 16; ++r) o[dt][r] = 0.f;
#pragma unroll
            for (int t = 0; t < 5; ++t)
#pragma unroll
                for (int sx = 0; sx < 2; ++sx) { const bf16x8 pb = __builtin_bit_cast(bf16x8, pf[t][sx]);
#pragma unroll
                    for (int dt = 0; dt < 2; ++dt) { const LAS unsigned char* q = VL + (dt * 32 + r32) * 520 + ((jt0 + t) * 32 + 16 * sx + 4 * hh) * 2;
                        const s16x4 lo = *(const LAS s16x4*)q, hi = *(const LAS s16x4*)(q + 16);
                        const bf16x8 a = (bf16x8){lo[0], lo[1], lo[2], lo[3], hi[0], hi[1], hi[2], hi[3]}; o[dt] = MFMA32(a, pb, o[dt]); } }
            const float inv = 1.f / sm;
            bf16_t* orow = O + qtok * 1024 + hq * 64 + 4 * hh;
#pragma unroll
            for (int dt = 0; dt < 2; ++dt)
#pragma unroll
                for (int gq = 0; gq < 4; ++gq) { u32x2 w; w.x = pk2(o[dt][4 * gq] * inv, o[dt][4 * gq + 1] * inv); w.y = pk2(o[dt][4 * gq + 2] * inv, o[dt][4 * gq + 3] * inv); *(u32x2*)(orow + dt * 32 + 8 * gq) = w; }
        }
    }
}
constexpr int TS = 272;
template <int STRIDE = TS>
__device__ __forceinline__ bf16x8 tr_frag(const LAS unsigned char* T, int k0, int c0, int lane, bool permuted) {
    const int hh = lane >> 5, blk = (lane >> 4) & 1, q = (lane & 15) >> 2, pp = lane & 3;
    const int r0 = k0 + (permuted ? 4 * hh : 8 * hh) + q, r1 = r0 + (permuted ? 8 : 4);
    const int cb = (c0 + 16 * blk + 4 * pp) * 2;
    const s16x4 lo = lds_tr(T + r0 * STRIDE + cb), hi = lds_tr(T + r1 * STRIDE + cb);
    return (bf16x8){lo[0], lo[1], lo[2], lo[3], hi[0], hi[1], hi[2], hi[3]};
}
__device__ __forceinline__ bf16x8 row_frag(const LAS unsigned char* T, int row, int k0, int hh) { return *(const LAS bf16x8*)(T + row * TS + (k0 + 8 * hh) * 2); }
__device__ __forceinline__ void load_tile128(LAS unsigned char* T, const bf16_t* __restrict__ g, int ld, int tid) {
#pragma unroll
    for (int i = 0; i < 4; ++i) { const int ch = tid + 512 * i, row = ch >> 4, c = ch & 15; *(LAS u32x4*)(T + row * TS + c * 16) = *(const u32x4*)(g + (size_t)row * ld + c * 8); }
}
struct L0Bufs {
    bf16_t *AU, *AV, *BX, *BZ, *V, *XC, *YM, *CS, *Q, *K; float *U, *GT, *UN, *NS, *SC;
    const bf16_t *WQT, *GMW, *MT; const float *gm_g, *gm_b, *gm_bs, *cw, *cb, *bif, *nw, *skip;
};

__device__ __forceinline__ void l0_mixA(LAS unsigned char* lds, const L0Bufs& B, int blk, int G) {
    const int tid0 = threadIdx.x, wave = __builtin_amdgcn_readfirstlane(tid0 >> 6);
#define OPQ_IDS int tid = tid0; asm volatile("" : "+v"(tid)); const int lane = tid & 63, r32 = lane & 31, hh = lane >> 5; (void)lane; (void)r32; (void)hh;
    LAS unsigned char* T0 = lds; LAS unsigned char* T1 = lds + 34816; LAS unsigned char* T2 = lds + 2 * 34816; LAS unsigned char* T3 = lds + 3 * 34816;
    LAS float* SF = (LAS float*)T2;
    LAS float* SG = (LAS float*)(lds + 3 * 34816 + 35632);
    for (int u = blk; u < 256; u += G) {
        const int tok0 = u * 128; const bool first = (u & 31) == 0;
        constexpr int VS = 1040;
        {   OPQ_IDS; const int trow = tid >> 2, q4 = tid & 3;
            const bf16_t* vr = B.AV + (size_t)(tok0 + trow) * 512 + q4 * 128; float s = 0.f, s2 = 0.f; u32x4 w[16];
#pragma unroll
            for (int i = 0; i < 16; ++i) w[i] = *(const u32x4*)(vr + i * 8);
#pragma unroll
            for (int i = 0; i < 16; ++i) { const float f[8] = {bf_lo(w[i].x), bf_hi(w[i].x), bf_lo(w[i].y), bf_hi(w[i].y), bf_lo(w[i].z), bf_hi(w[i].z), bf_lo(w[i].w), bf_hi(w[i].w)};
#pragma unroll
                for (int e = 0; e < 8; ++e) { s += f[e]; s2 += f[e] * f[e]; } }
            s += shx(s, 1, lane); s += shx(s, 2, lane); s2 += shx(s2, 1, lane); s2 += shx(s2, 2, lane);
            const float mean = s * (1.f / 512.f), rstd = rsqrtf(fmaxf(s2 * (1.f / 512.f) - mean * mean, 0.f) + LN_EPS);
            __syncthreads();
#pragma unroll
            for (int i = 0; i < 16; ++i) { const int cbase = q4 * 128 + i * 8; const f32x4 g0 = *(const f32x4*)(B.gm_g + cbase), g1 = *(const f32x4*)(B.gm_g + cbase + 4), b0 = *(const f32x4*)(B.gm_b + cbase), b1 = *(const f32x4*)(B.gm_b + cbase + 4);
                u32x4 o; o.x = pk2((bf_lo(w[i].x) - mean) * rstd * g0[0] + b0[0], (bf_hi(w[i].x) - mean) * rstd * g0[1] + b0[1]); o.y = pk2((bf_lo(w[i].y) - mean) * rstd * g0[2] + b0[2], (bf_hi(w[i].y) - mean) * rstd * g0[3] + b0[3]);
                o.z = pk2((bf_lo(w[i].z) - mean) * rstd * g1[0] + b1[0], (bf_hi(w[i].z) - mean) * rstd * g1[1] + b1[1]); o.w = pk2((bf_lo(w[i].w) - mean) * rstd * g1[2] + b1[2], (bf_hi(w[i].w) - mean) * rstd * g1[3] + b1[3]);
                *(LAS u32x4*)(lds + trow * VS + cbase * 2) = o; asm volatile("" ::: "memory"); }
            __syncthreads();
        }
        {   const int tb = wave & 3, dhf = wave >> 2;
#pragma unroll 1
            for (int g = 0; g < 4; ++g) {
                OPQ_IDS; const int t = 32 * tb + r32; const size_t tok = (size_t)tok0 + t;
                f32x16 acc[2];
#pragma unroll
                for (int dt = 0; dt < 2; ++dt)
#pragma unroll
                    for (int r = 0; r < 16; ++r) acc[dt][r] = 0.f;
                const bf16_t* wrow = B.GMW + ((size_t)g * 128 + t) * 128 + 8 * hh;
                bf16x8 bw[8];
#pragma unroll
                for (int ks = 0; ks < 8; ++ks) bw[ks] = *(const bf16x8*)(wrow + 16 * ks);
#pragma unroll
                for (int ks = 0; ks < 8; ++ks) if (ks <= 2 * tb + 1) {
#pragma unroll
                    for (int dt = 0; dt < 2; ++dt) { const bf16x8 a = tr_frag<VS>(lds, 16 * ks, g * 128 + 64 * dhf + 32 * dt, lane, false); acc[dt] = MFMA32(a, bw[ks], acc[dt]); } }
                const float bsv = B.gm_bs[g * 128 + t];
#pragma unroll
                for (int dt = 0; dt < 2; ++dt)
#pragma unroll
                    for (int gq = 0; gq < 4; ++gq) { const int col = g * 128 + 64 * dhf + 32 * dt + 8 * gq + 4 * hh; const u32x2 au = *(const u32x2*)(B.AU + tok * 512 + col);
                        u32x2 w; w.x = pk2(bf_lo(au.x) * (acc[dt][4 * gq] + bsv), bf_hi(au.x) * (acc[dt][4 * gq + 1] + bsv)); w.y = pk2(bf_lo(au.y) * (acc[dt][4 * gq + 2] + bsv), bf_hi(au.y) * (acc[dt][4 * gq + 3] + bsv));
                        *(u32x2*)(B.YM + tok * 1024 + col) = w; }
            }
        }
        f32x16 accg;
#pragma unroll
        for (int r = 0; r < 16; ++r) accg[r] = 0.f;
        LAS unsigned char* MTL = (LAS unsigned char*)SG;
#pragma unroll 1
        for (int h = 0; h < 4; ++h) {
            OPQ_IDS;
            __syncthreads();
            for (int ch = tid; ch < 131 * 16; ch += 512) { const int row = ch >> 4, c = ch & 15; u32x4 v = (u32x4){0u, 0u, 0u, 0u};
                if (!(first && row < 3)) v = *(const u32x4*)(B.BX + (size_t)(tok0 - 3 + row) * 512 + h * 128 + c * 8);
                *(LAS u32x4*)(T3 + row * TS + c * 16) = v; }
            load_tile128(T0, B.WQT + ((size_t)0 * 4 + h) * 128 * 128, 128, tid);
            load_tile128(T1, B.WQT + ((size_t)1 * 4 + h) * 128 * 128, 128, tid);
            if (tid < 256) { const int row = tid >> 5, c = tid & 31; *(LAS u32x4*)(MTL + row * 528 + c * 16) = *(const u32x4*)(B.MT + ((size_t)h * 8 + row) * 256 + c * 8); }
            __syncthreads();
            {   const int dc = tid & 15, chn = h * 128 + dc * 8; float w[4][8], cbv[8];
#pragma unroll
                for (int j = 0; j < 4; ++j)
#pragma unroll
                    for (int e = 0; e < 8; ++e) w[j][e] = B.cw[j * 512 + chn + e];
#pragma unroll
                for (int e = 0; e < 8; ++e) cbv[e] = B.cb[chn + e];
#pragma unroll 1
                for (int ps = 0; ps < 4; ++ps) { const int t = ps * 32 + (tid >> 4); float a[8];
#pragma unroll
                    for (int e = 0; e < 8; ++e) a[e] = cbv[e];
#pragma unroll
                    for (int j = 0; j < 4; ++j) { const u32x4 x = *(const LAS u32x4*)(T3 + (t + j) * TS + dc * 16);
                        a[0] += w[j][0] * bf_lo(x.x); a[1] += w[j][1] * bf_hi(x.x); a[2] += w[j][2] * bf_lo(x.y); a[3] += w[j][3] * bf_hi(x.y);
                        a[4] += w[j][4] * bf_lo(x.z); a[5] += w[j][5] * bf_hi(x.z); a[6] += w[j][6] * bf_lo(x.w); a[7] += w[j][7] * bf_hi(x.w); }
                    u32x4 o; o.x = pk2(silu_f(a[0]), silu_f(a[1])); o.y = pk2(silu_f(a[2]), silu_f(a[3])); o.z = pk2(silu_f(a[4]), silu_f(a[5])); o.w = pk2(silu_f(a[6]), silu_f(a[7]));
                    *(LAS u32x4*)(T2 + t * TS + dc * 16) = o; *(u32x4*)(B.XC + (size_t)(tok0 + t) * 512 + chn) = o; } }
            __syncthreads();
            {   const int tb = wave & 3, ehf = wave >> 2;
                {
                    OPQ_IDS; const LAS unsigned char* act = ehf ? T3 + 3 * TS : T2;
#pragma unroll
                    for (int ks = 0; ks < 8; ++ks) { const bf16x8 a = *(const LAS bf16x8*)(MTL + (r32 & 7) * 528 + (ehf * 128 + 16 * ks + 8 * hh) * 2); const bf16x8 bx = row_frag(act, 32 * tb + r32, 16 * ks, hh); accg = MFMA32(a, bx, accg); } }
#pragma unroll 1
                for (int mtx = 0; mtx < 2; ++mtx) {
                    OPQ_IDS;
                    const LAS unsigned char* wt = mtx ? T1 : T0;
                    f32x16 acc[2];
#pragma unroll
                    for (int et = 0; et < 2; ++et)
#pragma unroll
                        for (int r = 0; r < 16; ++r) acc[et][r] = 0.f;
#pragma unroll
                    for (int ks = 0; ks < 8; ++ks) { const bf16x8 bx = row_frag(T2, 32 * tb + r32, 16 * ks, hh);
#pragma unroll
                        for (int et = 0; et < 2; ++et) { const bf16x8 a = row_frag(wt, 64 * ehf + 32 * et + r32, 16 * ks, hh); acc[et] = MFMA32(a, bx, acc[et]); } }
                    bf16_t* dst = (mtx == 0 ? B.Q : B.K) + (size_t)(tok0 + 32 * tb + r32) * 512 + h * 128 + 64 * ehf + 4 * hh;
#pragma unroll
                    for (int et = 0; et < 2; ++et)
#pragma unroll
                        for (int gq = 0; gq < 4; ++gq) { u32x2 w; w.x = pk2(acc[et][4 * gq], acc[et][4 * gq + 1]); w.y = pk2(acc[et][4 * gq + 2], acc[et][4 * gq + 3]); *(u32x2*)(dst + 32 * et + 8 * gq) = w; }
                }
            }
            __syncthreads();
            load_tile128(T0, B.WQT + ((size_t)2 * 4 + h) * 128 * 128, 128, tid);
            __syncthreads();
            {   OPQ_IDS; const int tb = wave & 3, ehf = wave >> 2;
                f32x16 acc[2];
#pragma unroll
                for (int et = 0; et < 2; ++et)
#pragma unroll
                    for (int r = 0; r < 16; ++r) acc[et][r] = 0.f;
#pragma unroll
                for (int ks = 0; ks < 8; ++ks) { const bf16x8 bx = row_frag(T3 + 3 * TS, 32 * tb + r32, 16 * ks, hh);
#pragma unroll
                    for (int et = 0; et < 2; ++et) { const bf16x8 a = row_frag(T0, 64 * ehf + 32 * et + r32, 16 * ks, hh); acc[et] = MFMA32(a, bx, acc[et]); } }
                bf16_t* dst = B.V + (size_t)(tok0 + 32 * tb + r32) * 512 + h * 128 + 64 * ehf + 4 * hh;
#pragma unroll
                for (int et = 0; et < 2; ++et)
#pragma unroll
                    for (int gq = 0; gq < 4; ++gq) { u32x2 w; w.x = pk2(acc[et][4 * gq], acc[et][4 * gq + 1]); w.y = pk2(acc[et][4 * gq + 2], acc[et][4 * gq + 3]); *(u32x2*)(dst + 32 * et + 8 * gq) = w; }
            }
        }
        __syncthreads();
        {   OPQ_IDS; const int tb = wave & 3, kh = wave >> 2;
#pragma unroll
            for (int r = 0; r < 4; ++r) SF[(kh * 8 + r + 4 * hh) * 128 + 32 * tb + r32] = accg[r];
        }
        __syncthreads();
        LAS float* IG = SG; LAS float* BC = SG + 512; LAS float* WG = SG + 1024;
        if (wave < 4) {
            OPQ_IDS; const int h = wave; float lf[2], ig[2];
#pragma unroll
            for (int e = 0; e < 2; ++e) { const int t = 2 * lane + e; ig[e] = SF[h * 128 + t] + SF[(8 + h) * 128 + t] + B.bif[h];
                const float fx = SF[(4 + h) * 128 + t] + SF[(12 + h) * 128 + t] + B.bif[4 + h]; lf[e] = fminf(fx, 0.f) - log1pf(expf(-fabsf(fx))); }
            float run = lf[0] + lf[1];
#pragma unroll
            for (int o = 1; o < 64; o <<= 1) { const float v = shup(run, o, lane); if (lane >= o) run += v; }
            const float b1 = run, b0 = run - lf[1];
            IG[h * 128 + 2 * lane] = ig[0]; IG[h * 128 + 2 * lane + 1] = ig[1]; BC[h * 128 + 2 * lane] = b0; BC[h * 128 + 2 * lane + 1] = b1;
            float* gt = B.GT + ((size_t)u * 4 + h) * 256;
            gt[2 * lane] = ig[0]; gt[2 * lane + 1] = ig[1]; gt[128 + 2 * lane] = b0; gt[128 + 2 * lane + 1] = b1;
            const float bl = shidx(b1, 63);
            float g0 = bl - b0 + ig[0], g1 = bl - b1 + ig[1]; float mloc = fmaxf(g0, g1);
#pragma unroll
            for (int o = 1; o < 64; o <<= 1) mloc = fmaxf(mloc, shx(mloc, o, lane));
            WG[h * 128 + 2 * lane] = expf(g0 - mloc); WG[h * 128 + 2 * lane + 1] = expf(g1 - mloc);
            if (lane == 0) { B.SC[u * 4 + h] = bl; B.SC[1024 + u * 4 + h] = mloc; }
        }
#pragma unroll 1
        for (int h = 0; h < 4; ++h) {
            OPQ_IDS;
            __syncthreads();
#pragma unroll
            for (int i = 0; i < 4; ++i) { const int ch = tid + 512 * i, row = ch >> 4, c = ch & 15; const float wg = WG[h * 128 + row];
                const u32x4 v = *(const u32x4*)(B.V + (size_t)(tok0 + row) * 512 + h * 128 + c * 8), k = *(const u32x4*)(B.K + (size_t)(tok0 + row) * 512 + h * 128 + c * 8);
                u32x4 ov, ok; const float ksc = 0.08838834764831845f;
                ov.x = pk2(bf_lo(v.x) * wg, bf_hi(v.x) * wg); ov.y = pk2(bf_lo(v.y) * wg, bf_hi(v.y) * wg); ov.z = pk2(bf_lo(v.z) * wg, bf_hi(v.z) * wg); ov.w = pk2(bf_lo(v.w) * wg, bf_hi(v.w) * wg);
                ok.x = pk2(bf_lo(k.x) * ksc, bf_hi(k.x) * ksc); ok.y = pk2(bf_lo(k.y) * ksc, bf_hi(k.y) * ksc); ok.z = pk2(bf_lo(k.z) * ksc, bf_hi(k.z) * ksc); ok.w = pk2(bf_lo(k.w) * ksc, bf_hi(k.w) * ksc);
                *(LAS u32x4*)(T0 + row * TS + c * 16) = ov; *(LAS u32x4*)(T1 + row * TS + c * 16) = ok; }
            __syncthreads();
            const int vb = wave & 3, khf = wave >> 2;
            f32x16 acc[2];
#pragma unroll
            for (int kt = 0; kt < 2; ++kt)
#pragma unroll
                for (int r = 0; r < 16; ++r) acc[kt][r] = 0.f;
#pragma unroll
            for (int ks = 0; ks < 8; ++ks) { const bf16x8 a = tr_frag(T0, 16 * ks, 32 * vb, lane, false);
#pragma unroll
                for (int kt = 0; kt < 2; ++kt) { const bf16x8 bk = tr_frag(T1, 16 * ks, 64 * khf + 32 * kt, lane, false); acc[kt] = MFMA32(a, bk, acc[kt]); } }
            float* Uo = B.U + ((size_t)u * 4 + h) * 16384;
#pragma unroll
            for (int kt = 0; kt < 2; ++kt)
#pragma unroll
                for (int r = 0; r < 16; ++r) Uo[(32 * vb + crow(r, hh)) * 128 + 64 * khf + 32 * kt + r32] = acc[kt][r];
            {   const int kk = tid & 127, sq = tid >> 7; float a = 0.f;
                for (int s = sq * 32; s < sq * 32 + 32; ++s) a += WG[h * 128 + s] * bf2f(*(const LAS bf16_t*)(T1 + s * TS + kk * 2));
                SF[2048 + sq * 128 + kk] = a; }
            __syncthreads();
            if (tid < 128) B.UN[((size_t)u * 4 + h) * 128 + tid] = (SF[2048 + tid] + SF[2048 + 128 + tid]) + (SF[2048 + 256 + tid] + SF[2048 + 384 + tid]);
        }
    }
}
#undef OPQ_IDS
__device__ __forceinline__ void l0_scan(const L0Bufs& B, int blk, int tid) {
    const int bh = blk >> 3, part = blk & 7, b = bh >> 2, h = bh & 3;
    const int e0 = part * 2048 + tid * 8;
    f32x4 C0 = (f32x4){0.f, 0.f, 0.f, 0.f}, C1 = C0; float nst = 0.f; float m = 0.f;
    const int unit0 = (b * 32) * 4 + h;
    f32x4 Un0 = *(const f32x4*)(B.U + (size_t)unit0 * 16384 + e0), Un1 = *(const f32x4*)(B.U + (size_t)unit0 * 16384 + e0 + 4); float bln = B.SC[unit0], mln = B.SC[1024 + unit0];
    float unn = (part == 0 && tid < 128) ? B.UN[(size_t)unit0 * 128 + tid] : 0.f;
    for (int c = 0; c < 32; ++c) {
        const int unit = unit0 + 4 * c;
        const f32x4 U0 = Un0, U1 = Un1; const float bl = bln, mloc = mln, un = unn;
        if (c < 31) { const int un1 = unit + 4; Un0 = *(const f32x4*)(B.U + (size_t)un1 * 16384 + e0); Un1 = *(const f32x4*)(B.U + (size_t)un1 * 16384 + e0 + 4); bln = B.SC[un1]; mln = B.SC[1024 + un1]; if (part == 0 && tid < 128) unn = B.UN[(size_t)un1 * 128 + tid]; }
        u32x4 w; w.x = pk2(C0[0], C0[1]); w.y = pk2(C0[2], C0[3]); w.z = pk2(C1[0], C1[1]); w.w = pk2(C1[2], C1[3]); *(u32x4*)(B.CS + (size_t)unit * 16384 + e0) = w;
        if (part == 0 && tid < 128) B.NS[(size_t)unit * 128 + tid] = nst;
        if (part == 0 && tid == 0) B.SC[2048 + unit] = m;
        const float mn = fmaxf(bl + m, mloc), dec = expf(bl + m - mn), wu = expf(mloc - mn); m = mn;
        C0 = C0 * dec + U0 * wu; C1 = C1 * dec + U1 * wu;
        nst = nst * dec + wu * un;
    }
}
__device__ __forceinline__ void l0_mixC(LAS unsigned char* lds, const L0Bufs& B, int blk, int G) {
    const int tid0 = threadIdx.x, wave = __builtin_amdgcn_readfirstlane(tid0 >> 6);
    LAS unsigned char* TQ = lds; LAS unsigned char* TK = lds + 34816; LAS unsigned char* TV = lds + 2 * 34816; LAS unsigned char* TC = lds + 3 * 34816;
    LAS float* SF = (LAS float*)(lds + 4 * 34816);
    LAS float* AS = SF; LAS float* PM = SF + 128; LAS float* NP = SF + 256; LAS float* PS = SF + 384; LAS float* PQ = SF + 640; LAS float* NW = SF + 896;
    __syncthreads();
    { int tq = tid0; asm volatile("" : "+v"(tq)); if (tq < 256) ((LAS f32x4*)NW)[tq] = tq < 128 ? ((const f32x4*)B.nw)[tq] : ((const f32x4*)B.skip)[tq - 128]; }
    for (int uu = blk; uu < 256; uu += G) {
        const int tok0 = uu * 128;
#pragma unroll 1
        for (int h = 0; h < 4; ++h) {
            const int unit = uu * 4 + h;
            int tid = tid0; asm volatile("" : "+v"(tid));
            const int lane = tid & 63, r32 = lane & 31, hh = lane >> 5;
            __syncthreads();
            load_tile128(TQ, B.Q + (size_t)tok0 * 512 + h * 128, 512, tid);
            load_tile128(TV, B.V + (size_t)tok0 * 512 + h * 128, 512, tid);
            load_tile128(TC, B.CS + (size_t)unit * 16384, 128, tid);
#pragma unroll
            for (int i = 0; i < 4; ++i) { const int ch = tid + 512 * i, row = ch >> 4, c = ch & 15; const u32x4 k = *(const u32x4*)(B.K + (size_t)(tok0 + row) * 512 + h * 128 + c * 8); const float ksc = 0.08838834764831845f;
                u32x4 ok; ok.x = pk2(bf_lo(k.x) * ksc, bf_hi(k.x) * ksc); ok.y = pk2(bf_lo(k.y) * ksc, bf_hi(k.y) * ksc); ok.z = pk2(bf_lo(k.z) * ksc, bf_hi(k.z) * ksc); ok.w = pk2(bf_lo(k.w) * ksc, bf_hi(k.w) * ksc);
                *(LAS u32x4*)(TK + row * TS + c * 16) = ok; }
            const float mprev = B.SC[2048 + unit];
            if (wave == 0) {
                const float* gt = B.GT + (size_t)unit * 256;
                const float a0 = gt[2 * lane] - gt[128 + 2 * lane], a1 = gt[2 * lane + 1] - gt[128 + 2 * lane + 1];
                float run = fmaxf(a0, a1);
#pragma unroll
                for (int o = 1; o < 64; o <<= 1) { const float v = shup(run, o, lane); if (lane >= o) run = fmaxf(run, v); }
                const float prev = shup(run, 1, lane); const float p0 = fmaxf(lane > 0 ? fmaxf(prev, a0) : a0, mprev), p1 = fmaxf(run, mprev);
                AS[2 * lane] = a0; AS[2 * lane + 1] = a1; PM[2 * lane] = p0; PM[2 * lane + 1] = p1;
            }
            if (wave == 1) { NP[lane] = B.NS[(size_t)unit * 128 + lane]; NP[64 + lane] = B.NS[(size_t)unit * 128 + 64 + lane]; }
            __syncthreads();
            const int tb = wave & 3, vh = wave >> 2, t = 32 * tb + r32;
            const float pm = PM[t], bt = B.GT[(size_t)unit * 256 + 128 + t];
            f32x16 s[4];
#pragma unroll
            for (int st = 0; st < 4; ++st)
#pragma unroll
                for (int r = 0; r < 16; ++r) s[st][r] = 0.f;
            {   int lv = lane; asm volatile("" : "+v"(lv));
                const LAS unsigned char* qp = TQ + (32 * tb + (lv & 31)) * TS + (lv >> 5) * 16; const LAS unsigned char* kp = TK + (lv & 31) * TS + (lv >> 5) * 16;
#pragma unroll 2
                for (int ks = 0; ks < 8; ++ks) { const bf16x8 bq = *(const LAS bf16x8*)(qp + ks * 32);
#pragma unroll
                    for (int st = 0; st < 4; ++st) if (st <= tb) { const bf16x8 a = *(const LAS bf16x8*)(kp + st * 32 * TS + ks * 32); s[st] = MFMA32(a, bq, s[st]); } } }
            float nq = 0.f; u32x4 pf[4][2];
#pragma unroll
            for (int st = 0; st < 4; ++st) {
#pragma unroll
                for (int r = 0; r < 16; ++r) { const int sidx = 32 * st + crow(r, hh); const float wv = (sidx <= t) ? __builtin_amdgcn_exp2f((AS[sidx] - pm) * LOG2E) : 0.f; const float pv = s[st][r] * wv; s[st][r] = pv; nq += pv; }
#pragma unroll
                for (int sx = 0; sx < 2; ++sx) pf[st][sx] = (u32x4){pk2(s[st][8 * sx], s[st][8 * sx + 1]), pk2(s[st][8 * sx + 2], s[st][8 * sx + 3]), pk2(s[st][8 * sx + 4], s[st][8 * sx + 5]), pk2(s[st][8 * sx + 6], s[st][8 * sx + 7])};
            }
            nq = xhalf_sum(nq);
            float nqi = 0.f;
#pragma unroll
            for (int i = 0; i < 8; ++i) { const u32x4 qv = *(const LAS u32x4*)(TQ + t * TS + (64 * hh + 8 * i) * 2); const LAS float* np = NP + 64 * hh + 8 * i;
                nqi += bf_lo(qv.x) * np[0] + bf_hi(qv.x) * np[1] + bf_lo(qv.y) * np[2] + bf_hi(qv.y) * np[3] + bf_lo(qv.z) * np[4] + bf_hi(qv.z) * np[5] + bf_lo(qv.w) * np[6] + bf_hi(qv.w) * np[7]; }
            nqi = xhalf_sum(nqi);
            const float wst = __builtin_amdgcn_exp2f((mprev - pm) * LOG2E);
            const float den = fmaxf(fabsf(nq + wst * nqi), __builtin_amdgcn_exp2f(-(bt + pm) * LOG2E)), rden = 1.f / den;
            f32x16 ni[2], nx[2];
#pragma unroll
            for (int vt = 0; vt < 2; ++vt)
#pragma unroll
                for (int r = 0; r < 16; ++r) { ni[vt][r] = 0.f; nx[vt][r] = 0.f; }
            {   int lv = lane; asm volatile("" : "+v"(lv));
#pragma unroll
                for (int st = 0; st < 4; ++st) {
                    if (st <= tb) {
#pragma unroll
                        for (int sx = 0; sx < 2; ++sx) { const bf16x8 pb = __builtin_bit_cast(bf16x8, pf[st][sx]);
#pragma unroll
                            for (int vt = 0; vt < 2; ++vt) { const bf16x8 a = tr_frag(TV, 32 * st + 16 * sx, 64 * vh + 32 * vt, lv, true); ni[vt] = MFMA32(a, pb, ni[vt]); } }
                    }
                } }
            {   int lv = lane; asm volatile("" : "+v"(lv));
                const LAS unsigned char* qp = TQ + (32 * tb + (lv & 31)) * TS + (lv >> 5) * 16; const LAS unsigned char* cp = TC + (64 * vh + (lv & 31)) * TS + (lv >> 5) * 16;
#pragma unroll 2
                for (int ks = 0; ks < 8; ++ks) { const bf16x8 bq = *(const LAS bf16x8*)(qp + ks * 32);
#pragma unroll
                    for (int vt = 0; vt < 2; ++vt) { const bf16x8 a = *(const LAS bf16x8*)(cp + vt * 32 * TS + ks * 32); nx[vt] = MFMA32(a, bq, nx[vt]); } } }
            const size_t tok = (size_t)tok0 + t;
            u32x2 xcv[2][4], zv[2][4];
#pragma unroll
            for (int vt = 0; vt < 2; ++vt)
#pragma unroll
                for (int gq = 0; gq < 4; ++gq) { const int chn = h * 128 + 64 * vh + 32 * vt + 8 * gq + 4 * hh; xcv[vt][gq] = *(const u32x2*)(B.XC + tok * 512 + chn); zv[vt][gq] = *(const u32x2*)(B.BZ + tok * 512 + chn); }
            float hs = 0.f, hq = 0.f;
#pragma unroll
            for (int vt = 0; vt < 2; ++vt)
#pragma unroll
                for (int r = 0; r < 16; ++r) { const float hv = (ni[vt][r] + wst * nx[vt][r]) * rden; ni[vt][r] = hv; hs += hv; hq += hv * hv; }
            hs = xhalf_sum(hs); hq = xhalf_sum(hq);
            if (hh == 0) { PS[vh * 128 + t] = hs; PQ[vh * 128 + t] = hq; }
            __syncthreads();
            const float mean = (PS[t] + PS[128 + t]) * (1.f / 128.f);
            const float rstd = rsqrtf(fmaxf((PQ[t] + PQ[128 + t]) * (1.f / 128.f) - mean * mean, 0.f) + LN_EPS);
#pragma unroll
            for (int vt = 0; vt < 2; ++vt)
#pragma unroll
                for (int gq = 0; gq < 4; ++gq) { const int cl = 64 * vh + 32 * vt + 8 * gq + 4 * hh, chn = h * 128 + cl;
                    const f32x4 nw = *(const LAS f32x4*)(NW + chn), sk = *(const LAS f32x4*)(NW + 512 + chn); const u32x2 xc = xcv[vt][gq], z = zv[vt][gq];
                    const float y0 = ((ni[vt][4 * gq] - mean) * rstd * nw[0] + sk[0] * bf_lo(xc.x)) * silu_f(bf_lo(z.x)), y1 = ((ni[vt][4 * gq + 1] - mean) * rstd * nw[1] + sk[1] * bf_hi(xc.x)) * silu_f(bf_hi(z.x));
                    const float y2 = ((ni[vt][4 * gq + 2] - mean) * rstd * nw[2] + sk[2] * bf_lo(xc.y)) * silu_f(bf_lo(z.y)), y3 = ((ni[vt][4 * gq + 3] - mean) * rstd * nw[3] + sk[3] * bf_hi(xc.y)) * silu_f(bf_hi(z.y));
                    u32x2 w; w.x = pk2(y0, y1); w.y = pk2(y2, y3); *(u32x2*)(B.YM + tok * 1024 + 512 + chn) = w; }
        }
    }
}
constexpr size_t MB = 1048576ull;
constexpr size_t P_WIN_T = 0, P_WOUT_T = P_WIN_T + 4 * MB, P_WQKV_T = P_WOUT_T + 2 * MB, P_WO_T = P_WQKV_T + 3 * MB, P_XWQ_T = P_WO_T + 2 * MB, P_XWKV_T = P_XWQ_T + 4 * MB, P_XWO_T = P_XWKV_T + 8 * MB,
                 P_MLW_T = P_XWO_T + 4 * MB, P_WIFT = P_MLW_T + MB / 2, P_WRT = P_WIFT + MB / 8, P_ROT = P_WRT + MB / 2, P_BQK = P_ROT + MB, P_MEMB = P_BQK + MB / 8, P_KC = P_MEMB + 4 * MB, P_VT = P_KC + 8 * MB,
                 P_W13T = P_VT + 8 * MB, P_W2T = P_W13T + 64 * MB, P_XBF = P_W2T + 32 * MB, P_RT = P_XBF + 64 * MB, P_TMP = P_RT + 2 * MB;
constexpr size_t RT_SRC = 1638400;
constexpr size_t RT_E = 0, RT_W = 262144, RT_RANK = 2 * 262144, RT_DEST = 3 * 262144, RT_HIST = 4 * 262144, RT_TSTART = RT_HIST + 32768;
constexpr size_t T_QX = 0, T_OB = 64 * MB, T_YB = 128 * MB;
constexpr size_t T_K1 = 192 * MB, T_VT1 = 208 * MB;
constexpr size_t T_AU = 0, T_AV = 32 * MB, T_BX = 64 * MB, T_BZ = 96 * MB, T_V = 128 * MB, T_XC = 160 * MB, T_YM = 192 * MB, T_U = 256 * MB, T_CS = 320 * MB,
                 T_GT = 352 * MB, T_UN = 353 * MB, T_NS = 353 * MB + MB / 2, T_SC = 354 * MB, T_YB0 = 0;
constexpr size_t T_XG = 0, T_HM = 152 * MB, T_YG = 0;
constexpr size_t FAST_END = P_TMP + 360 * MB;
constexpr int LDS_BYTES = 147456;

struct FP {
    const float* in[33]; float* X;
    unsigned char* ws;
};
typedef const float* const __attribute__((address_space(4)))* InTab;
struct PV { InTab in; float* X; unsigned char* ws; };
__device__ __forceinline__ PV make_pv(const FP& p0) {
    PV p; InTab kp = (InTab)__builtin_amdgcn_kernarg_segment_ptr(); asm volatile("" : "+s"(kp)); p.in = kp;
    p.X = p0.X; p.ws = p0.ws; asm volatile("" : "+s"(p.ws)); return p;
}
#define WSP(T, off) ((T*)(p.ws + (off)))

__device__ __forceinline__ RouteBufs route_bufs(const PV& p) {
    RouteBufs r; r.e = WSP(int, P_RT + RT_E); r.w = WSP(float, P_RT + RT_W); r.rank = WSP(int, P_RT + RT_RANK); r.dest = WSP(int, P_RT + RT_DEST); r.hist = WSP(int, P_RT + RT_HIST); r.tstart = WSP(int, P_RT + RT_TSTART); r.src = WSP(int, P_RT + RT_SRC); return r;
}
#define PH_ARGS const PV& p, LAS unsigned char* lds, int blk, int G
#define PH_IDS int tid_ = threadIdx.x; asm volatile("" : "+v"(tid_)); const int tid = tid_, lane = tid & 63, wave = __builtin_amdgcn_readfirstlane(tid >> 6); (void)lane; (void)wave;

__device__ __forceinline__ void ph_conv_xattn(PH_ARGS, int l) {
    PH_IDS; LAS float* scr = (LAS float*)(lds + wave * 8448); const int gw = blk * NWAVE + wave, ngw = G * NWAVE;
    convert_mats(p.in[23] + (size_t)l * 1024 * 1024, 1024, 1024, 1, 0, WSP(bf16_t, P_XWQ_T) + (size_t)l * 1024 * 1024, 0, RM_IDENT, 0.0625f, 1024, scr, gw, ngw, lane);
    convert_mats(p.in[24] + (size_t)l * 1024 * 2048, 1024, 2048, 1, 0, WSP(bf16_t, P_XWKV_T) + (size_t)l * 2048 * 1024, 0, RM_IDENT, 1.f, 0, scr, gw, ngw, lane);
    convert_mats(p.in[25] + (size_t)l * 1024 * 1024, 1024, 1024, 1, 0, WSP(bf16_t, P_XWO_T) + (size_t)l * 1024 * 1024, 0, RM_IDENT, 1.f, 0, scr, gw, ngw, lane);
    convert_rows(p.in[1], WSP(bf16_t, P_MEMB), (size_t)2048 * 1024, blk * NTHR + tid, G * NTHR);
}
__device__ __forceinline__ void conv_moe_waves(const PV& p, int l, LAS float* scr, int gw, int ngw, int gt, int ngt, int lane) {
    const size_t wl = (size_t)l * 32 * 1024 * 512;
    convert_mats(p.in[30] + wl, 1024, 512, 32, (size_t)1024 * 512, WSP(bf16_t, P_W13T), (size_t)1024 * 1024, RM_PAIR0, 1.f, 0, scr, gw, ngw, lane);
    convert_mats(p.in[31] + wl, 1024, 512, 32, (size_t)1024 * 512, WSP(bf16_t, P_W13T), (size_t)1024 * 1024, RM_PAIR1, 1.f, 0, scr, gw, ngw, lane);
    convert_mats(p.in[32] + wl, 512, 1024, 32, (size_t)512 * 1024, WSP(bf16_t, P_W2T), (size_t)1024 * 512, RM_IDENT, 1.f, 0, scr, gw, ngw, lane);
    bf16_t* wrt = WSP(bf16_t, P_WRT) + (size_t)l * 2 * 64 * 1024; const float* wre = p.in[28] + (size_t)l * 1024 * 32; const float* wrg = p.in[26] + (size_t)l * 1024 * 4;
    for (int i = gt; i < 64 * 1024; i += ngt) { const int r = i >> 10, k = i & 1023;
        const float v = r < 32 ? wre[k * 32 + r] : (r < 36 ? wrg[k * 4 + (r - 32)] : 0.f);
        const bf16_t h = f2bf(v); wrt[i] = h; wrt[64 * 1024 + i] = f2bf(v - bf2f(h)); }
}
__device__ __forceinline__ void ph_conv_moe(PH_ARGS, int l) {
    PH_IDS; conv_moe_waves(p, l, (LAS float*)(lds + wave * 8448), blk * NWAVE + wave, G * NWAVE, blk * NTHR + tid, G * NTHR, lane);
}
__device__ __forceinline__ void ph_x_to_bf(PH_ARGS) { PH_IDS; convert_rows(p.X, WSP(bf16_t, P_XBF), (size_t)NT * 1024, blk * NTHR + tid, G * NTHR); }

__device__ __forceinline__ void set_job(LAS pg8::JobDesc* jt, int j, const void* A, const void* B, int nM, int nN, void* out, int ldc, int mode, const void* bias = nullptr, const void* rot = nullptr, void* out2 = nullptr) {
    unsigned long long a = (unsigned long long)A, b = (unsigned long long)B, o = (unsigned long long)out, bi = (unsigned long long)bias, ro = (unsigned long long)rot, o2 = (unsigned long long)out2;
    asm volatile("" : "+s"(a), "+s"(b), "+s"(o), "+s"(bi), "+s"(ro), "+s"(o2), "+s"(nM), "+s"(nN), "+s"(ldc), "+s"(mode));
    LAS pg8::JobDesc* d = jt + j; d->A = a; d->B = b; d->out = o; d->bias = bi; d->rot = ro; d->out2 = o2;
    d->nM = nM; d->nN = nN; d->ldc = ldc; d->mode = mode;
}
#define JT_PTR ((LAS pg8::JobDesc*)(lds + pg8::JT_OFF))
__device__ __forceinline__ void run_jobs(LAS unsigned char* lds, int K, int n0, int n1, int n2, int blk, int G) {
    __syncthreads();
    pg8::Jobs3 S; S.jt = JT_PTR; S.n0 = n0; S.n1 = n1; S.n2 = n2; S.K = K; S.G = G; S.c = blk;
    EpiMulti E; E.jt = JT_PTR;
    pg8::gemm_phase<EpiMulti, pg8::Jobs3, true, true>(lds, K, S, E);
}
__device__ __forceinline__ void ph_xattn_g1(PH_ARGS, int l) {
    const bf16_t* wkv = WSP(bf16_t, P_XWKV_T) + (size_t)l * 2048 * 1024;
    __syncthreads();
    if (threadIdx.x == 0) {
        set_job(JT_PTR, 0, WSP(bf16_t, P_MEMB), wkv, 8, 4, WSP(bf16_t, P_KC) + (size_t)l * 2048 * 1024, 1024, EM_PLAIN);
        set_job(JT_PTR, 1, wkv + (size_t)1024 * 1024, WSP(bf16_t, P_MEMB), 4, 8, WSP(bf16_t, P_VT) + (size_t)l * 1024 * 2048, 2048, EM_PLAIN);
        set_job(JT_PTR, 2, WSP(bf16_t, P_XBF), WSP(bf16_t, P_XWQ_T) + (size_t)l * 1024 * 1024, 128, 4, WSP(bf16_t, P_TMP + T_QX), 1024, EM_PLAIN);
    }
    run_jobs(lds, 1024, 32, 32, 512, blk, G);
}
__device__ __forceinline__ void ph_xattn_attn(PH_ARGS, int l) {
    xattn_phase(lds, WSP(bf16_t, P_TMP + T_QX), WSP(bf16_t, P_KC) + (size_t)l * 2048 * 1024, WSP(bf16_t, P_VT) + (size_t)l * 1024 * 2048, WSP(bf16_t, P_TMP + T_OB), blk, G);
}
__device__ __forceinline__ void ph_gemm_plain(PH_ARGS, const bf16_t* A, const bf16_t* Bt, bf16_t* out) {
    __syncthreads();
    if (threadIdx.x == 0) set_job(JT_PTR, 0, A, Bt, 128, 4, out, 1024, EM_PLAIN);
    run_jobs(lds, 1024, 512, 0, 0, blk, G);
}
template <bool XF32, bool OUTF32, bool MOE>
__device__ __forceinline__ void ph_ln(PH_ARGS, const bf16_t* y, int lnidx, bool dry = false) {
    PH_IDS; LnArgs a; a.xin32 = p.in[0]; a.xin = WSP(bf16_t, P_XBF); a.xout32 = dry ? WSP(float, P_TMP + 200 * MB) : p.X; a.xbf = dry ? WSP(bf16_t, P_TMP + 288 * MB) : WSP(bf16_t, P_XBF); a.y = y; a.g = p.in[2] + lnidx * 1024; a.b = p.in[3] + lnidx * 1024;
    a.dest = WSP(int, P_RT + RT_DEST); a.wts = WSP(float, P_RT + RT_W);
    ln_phase<XF32, OUTF32, MOE>(a, blk, G, wave, lane);
}
__device__ __forceinline__ void ph_moe_route(PH_ARGS, int l) {
    moe_router_phase(lds, WSP(bf16_t, P_XBF), WSP(bf16_t, P_WRT) + (size_t)l * 2 * 64 * 1024, p.in[27] + l * 4, p.in[29] + l * 32, route_bufs(p), blk);
}
__device__ __forceinline__ void ph_moe_scatter(PH_ARGS) { moe_scatter_phase(lds, route_bufs(p), blk, G); }
__device__ __forceinline__ void ph_moe_g1(PH_ARGS) {
    __syncthreads();
    if (threadIdx.x == 0) set_job(JT_PTR, 0, nullptr, nullptr, 0, 0, WSP(bf16_t, P_TMP + T_HM), 512, EM_SWIGLU);
    __syncthreads();
    MoeSched S; S.A = (const char*)WSP(bf16_t, P_TMP + T_XG); S.B = (const char*)WSP(bf16_t, P_W13T); S.tstart = WSP(int, P_RT + RT_TSTART); S.K = 1024; S.nN = 4; S.G = G; S.c = blk; S.bexp = (size_t)1024 * 1024 * 2;
    EpiMulti E; E.jt = JT_PTR;
    pg8::gemm_phase<EpiMulti, MoeSched, true, true>(lds, 1024, S, E);
}
__device__ __forceinline__ void ph_moe_g2(PH_ARGS) {
    __syncthreads();
    if (threadIdx.x == 0) set_job(JT_PTR, 0, nullptr, nullptr, 0, 0, WSP(bf16_t, P_TMP + T_YG), 1024, EM_PLAIN);
    __syncthreads();
    MoeSched S; S.A = (const char*)WSP(bf16_t, P_TMP + T_HM); S.B = (const char*)WSP(bf16_t, P_W2T); S.tstart = WSP(int, P_RT + RT_TSTART); S.K = 512; S.nN = 4; S.G = G; S.c = blk; S.bexp = (size_t)1024 * 512 * 2;
    EpiMulti E; E.jt = JT_PTR;
    pg8::gemm_phase<EpiMulti, MoeSched, true, true>(lds, 512, S, E);
}

__device__ __forceinline__ void ph_conv_l1(PH_ARGS) {
    PH_IDS; LAS float* scr = (LAS float*)(lds + wave * 8448); const int gw = blk * NWAVE + wave, ngw = G * NWAVE;
    convert_mats(p.in[19], 1024, 1536, 1, 0, WSP(bf16_t, P_WQKV_T), 0, RM_ROT, 0.125f, 1024, scr, gw, ngw, lane);
    convert_mats(p.in[22], 1024, 1024, 1, 0, WSP(bf16_t, P_WO_T), 0, RM_IDENT, 1.f, 0, scr, gw, ngw, lane);
    const int gt = blk * NTHR + tid, ngt = G * NTHR;
    float* bqk = WSP(float, P_BQK);
    for (int n = gt; n < 1280; n += ngt) bqk[rowmap(RM_ROT, n)] = p.in[20][n] * (n < 1024 ? 0.125f : 1.f);
    float* rot = WSP(float, P_ROT);
    for (int i = gt; i < 4096 * 32; i += ngt) { const int pos = i >> 5, k = i & 31; const float inv = powf(10000.f, -(float)(2 * k) / 64.f); const float ang = (float)pos * inv; rot[2 * i] = cosf(ang); rot[2 * i + 1] = sinf(ang); }
}
__device__ __forceinline__ void ph_l1_g1(PH_ARGS) {
    __syncthreads();
    if (threadIdx.x == 0) {
        set_job(JT_PTR, 0, WSP(bf16_t, P_XBF), WSP(bf16_t, P_WQKV_T), 128, 5, WSP(bf16_t, P_TMP + T_QX), 1024, EM_ROTARY, WSP(float, P_BQK), WSP(float, P_ROT), WSP(bf16_t, P_TMP + T_K1));
        set_job(JT_PTR, 1, WSP(bf16_t, P_WQKV_T) + (size_t)1280 * 1024, WSP(bf16_t, P_XBF), 1, 128, WSP(bf16_t, P_TMP + T_VT1), NT, EM_ROWBIAS, p.in[20] + 1280);
    }
    run_jobs(lds, 1024, 640, 128, 0, blk, G);
}
__device__ __forceinline__ void ph_l1_swa(PH_ARGS) {
    swa_phase(lds, WSP(bf16_t, P_TMP + T_QX), WSP(bf16_t, P_TMP + T_K1), WSP(bf16_t, P_TMP + T_VT1), p.in[21], WSP(bf16_t, P_TMP + T_OB), blk, G);
}

__device__ __forceinline__ L0Bufs l0_bufs(const PV& p) {
    L0Bufs B; B.AU = WSP(bf16_t, P_TMP + T_AU); B.AV = WSP(bf16_t, P_TMP + T_AV); B.BX = WSP(bf16_t, P_TMP + T_BX); B.BZ = WSP(bf16_t, P_TMP + T_BZ); B.V = WSP(bf16_t, P_TMP + T_V); B.XC = WSP(bf16_t, P_TMP + T_XC);
    B.YM = WSP(bf16_t, P_TMP + T_YM); B.CS = WSP(bf16_t, P_TMP + T_CS); B.U = WSP(float, P_TMP + T_U); B.GT = WSP(float, P_TMP + T_GT); B.UN = WSP(float, P_TMP + T_UN); B.NS = WSP(float, P_TMP + T_NS); B.SC = WSP(float, P_TMP + T_SC);
    B.Q = WSP(bf16_t, P_XBF); B.K = WSP(bf16_t, P_XBF) + (size_t)NT * 512;
    B.WQT = WSP(bf16_t, P_MLW_T); B.GMW = WSP(bf16_t, P_MLW_T) + 12 * 16384; B.MT = WSP(bf16_t, P_WIFT);
    B.gm_g = p.in[5]; B.gm_b = p.in[6]; B.gm_bs = p.in[8]; B.cw = p.in[9]; B.cb = p.in[10]; B.bif = p.in[15]; B.nw = p.in[16]; B.skip = p.in[17]; return B;
}
__device__ __forceinline__ void ph_scan_conv(PH_ARGS) {
    PH_IDS;
    if (wave < 4) l0_scan(l0_bufs(p), blk, tid);
}
__device__ __forceinline__ void ph_conv_l0(PH_ARGS) {
    PH_IDS; LAS float* scr = (LAS float*)(lds + wave * 8448); const int gw = blk * NWAVE + wave, ngw = G * NWAVE;
    convert_mats(p.in[4], 1024, 2048, 1, 0, WSP(bf16_t, P_WIN_T), 0, RM_IDENT, 1.f, 0, scr, gw, ngw, lane);
    convert_mats(p.in[18], 1024, 1024, 1, 0, WSP(bf16_t, P_WOUT_T), 0, RM_IDENT, 1.f, 0, scr, gw, ngw, lane);
    convert_mats(p.in[11], 128, 128, 4, 16384, WSP(bf16_t, P_MLW_T), 16384, RM_IDENT, 1.f, 0, scr, gw, ngw, lane);
    convert_mats(p.in[12], 128, 128, 4, 16384, WSP(bf16_t, P_MLW_T) + 4 * 16384, 16384, RM_IDENT, 1.f, 0, scr, gw, ngw, lane);
    convert_mats(p.in[13], 128, 128, 4, 16384, WSP(bf16_t, P_MLW_T) + 8 * 16384, 16384, RM_IDENT, 1.f, 0, scr, gw, ngw, lane);
    const int gt = blk * NTHR + tid, ngt = G * NTHR;
    bf16_t* gmw = WSP(bf16_t, P_MLW_T) + 12 * 16384;
    for (int i = gt; i < 4 * 16384; i += ngt) { const int t = (i >> 7) & 127, sidx = i & 127; gmw[i] = f2bf(sidx <= t ? p.in[7][i] : 0.f); }
    bf16_t* mt = WSP(bf16_t, P_WIFT);
    for (int i = gt; i < 4 * 8 * 256; i += ngt) { const int h = i >> 11, g = (i >> 8) & 7, j = i & 255, d = j & 127; float a = 0.f;
        if (j < 128) { for (int e = 0; e < 128; ++e) a += p.in[11][((size_t)h * 128 + d) * 128 + e] * p.in[14][(h * 128 + e) * 8 + g] + p.in[12][((size_t)h * 128 + d) * 128 + e] * p.in[14][(512 + h * 128 + e) * 8 + g]; }
        else { for (int e = 0; e < 128; ++e) a += p.in[13][((size_t)h * 128 + d) * 128 + e] * p.in[14][(1024 + h * 128 + e) * 8 + g]; }
        mt[i] = f2bf(a); }
}
__device__ __forceinline__ void ph_xin_to_bf(PH_ARGS) { PH_IDS; convert_rows(p.in[0], WSP(bf16_t, P_XBF), (size_t)NT * 1024, blk * NTHR + tid, G * NTHR); }
__device__ __forceinline__ void ph_l0_g1(PH_ARGS) {
    __syncthreads();
    if (threadIdx.x == 0) set_job(JT_PTR, 0, WSP(bf16_t, P_XBF), WSP(bf16_t, P_WIN_T), 128, 8, WSP(bf16_t, P_TMP + T_AU), 512, EM_GELU4);
    run_jobs(lds, 1024, 1024, 0, 0, blk, G);
}

enum { K_CONV_XATTN = 0, K_CONV_MOE, K_X2BF, K_XATTN_G1, K_XATTN_ATTN, K_XATTN_G2, K_LN_Y, K_MOE_ROUTE, K_MOE_SCATTER, K_MOE_G1, K_MOE_G2, K_LN_MOE, K_CONV_L1, K_L1_G1, K_L1_SWA, K_L1_G2, K_CONV_L0, K_XIN2BF, K_L0_G1, K_L0_MIXA, K_L0_SCAN, K_L0_MIXC, K_L0_G2, K_LN_Y0 };
template <int PH>
__global__ void __launch_bounds__(NTHR, 2) k_phase(FP p0, int l, int lnidx) {
    const PV p = make_pv(p0);
    extern __shared__ __attribute__((aligned(16))) unsigned char smem[];
    LAS unsigned char* lds = (LAS unsigned char*)smem;
    const int blk = blockIdx.x, G = gridDim.x;
    if constexpr (PH == K_CONV_XATTN) ph_conv_xattn(p, lds, blk, G, l);
    if constexpr (PH == K_CONV_MOE) ph_conv_moe(p, lds, blk, G, l);
    if constexpr (PH == K_X2BF) ph_x_to_bf(p, lds, blk, G);
    if constexpr (PH == K_XATTN_G1) ph_xattn_g1(p, lds, blk, G, l);
    if constexpr (PH == K_XATTN_ATTN) ph_xattn_attn(p, lds, blk, G, l);
    if constexpr (PH == K_XATTN_G2) ph_gemm_plain(p, lds, blk, G, WSP(bf16_t, P_TMP + T_OB), WSP(bf16_t, P_XWO_T) + (size_t)l * 1024 * 1024, WSP(bf16_t, P_TMP + T_YB));
    if constexpr (PH == K_LN_Y) ph_ln<false, false, false>(p, lds, blk, G, WSP(bf16_t, P_TMP + T_YB), lnidx);
    if constexpr (PH == K_MOE_ROUTE) ph_moe_route(p, lds, blk, G, l);
    if constexpr (PH == K_MOE_SCATTER) ph_moe_scatter(p, lds, blk, G);
    if constexpr (PH == K_MOE_G1) ph_moe_g1(p, lds, blk, G);
    if constexpr (PH == K_MOE_G2) ph_moe_g2(p, lds, blk, G);
    if constexpr (PH == K_LN_MOE) ph_ln<false, false, true>(p, lds, blk, G, WSP(bf16_t, P_TMP + T_YG), lnidx);
    if constexpr (PH == K_CONV_L0) ph_conv_l0(p, lds, blk, G);
    if constexpr (PH == K_XIN2BF) ph_xin_to_bf(p, lds, blk, G);
    if constexpr (PH == K_L0_G1) ph_l0_g1(p, lds, blk, G);
    if constexpr (PH == K_L0_MIXA) l0_mixA(lds, l0_bufs(p), blk, G);
    if constexpr (PH == K_L0_SCAN) ph_scan_conv(p, lds, blk, G);
    if constexpr (PH == K_L0_MIXC) l0_mixC(lds, l0_bufs(p), blk, G);
    if constexpr (PH == K_L0_G2) ph_gemm_plain(p, lds, blk, G, WSP(bf16_t, P_TMP + T_YM), WSP(bf16_t, P_WOUT_T), WSP(bf16_t, P_TMP + T_YB0));
    if constexpr (PH == K_LN_Y0) ph_ln<true, false, false>(p, lds, blk, G, WSP(bf16_t, P_TMP + T_YB0), 0);
    if constexpr (PH == K_CONV_L1) ph_conv_l1(p, lds, blk, G);
    if constexpr (PH == K_L1_G1) ph_l1_g1(p, lds, blk, G);
    if constexpr (PH == K_L1_SWA) ph_l1_swa(p, lds, blk, G);
    if constexpr (PH == K_L1_G2) ph_gemm_plain(p, lds, blk, G, WSP(bf16_t, P_TMP + T_OB), WSP(bf16_t, P_WO_T), WSP(bf16_t, P_TMP + T_YB));
}

#define XB_TMO      128
#define XB_XCNT(j)  (256  + 64 * (j))
#define XB_XSUB(j)  (1280 + 64 * (j))
#define XB_XGEN(j)  (2304 + 64 * (j))
#define XB_TOP      3328
#define XB_TOPGEN   3392
#define XCD_BAR_WORDS 3456
#define XB_SPIN_CAP (1u << 22)
__device__ __forceinline__ unsigned xb_ld(unsigned* p)              { return __hip_atomic_load(p, __ATOMIC_RELAXED, __HIP_MEMORY_SCOPE_AGENT); }
__device__ __forceinline__ unsigned xb_add(unsigned* p, unsigned v) { return __hip_atomic_fetch_add(p, v, __ATOMIC_RELAXED, __HIP_MEMORY_SCOPE_AGENT); }
__device__ __forceinline__ unsigned xb_xcc_id() { return (unsigned)__builtin_amdgcn_s_getreg((3 << 11) | 20) & 0xFu; }
#define XB_SPIN(cond, bar) do { unsigned _sp = 0; while (cond) { __builtin_amdgcn_s_sleep(1); \
    if ((++_sp & 255u) == 0u) { if (xb_ld(&(bar)[XB_TMO])) break; if (_sp > XB_SPIN_CAP) { atomicAdd(&(bar)[XB_TMO], 1u); break; } } } } while (0)
struct XcdBarrier { unsigned* bar; unsigned x; volatile LAS unsigned* st; };
__device__ __forceinline__ XcdBarrier xcd_barrier_post(unsigned* bar, volatile LAS unsigned* st) {
    XcdBarrier b; b.bar = bar; b.x = xb_xcc_id(); b.st = st;
    if (threadIdx.x == 0) (void)xb_add(&bar[XB_XCNT(b.x)], 1u);
    return b;
}
__device__ __forceinline__ void xcd_barrier_complete(unsigned* bar, unsigned x, unsigned& nloc, unsigned& nx) {
    const unsigned G = gridDim.x * gridDim.y * gridDim.z;
    unsigned sum, cnt, mine, sp = 0u;
    for (;;) {
        sum = 0u; cnt = 0u; mine = 0u;
#pragma unroll
        for (unsigned j = 0; j < 16; ++j) { const unsigned c = xb_ld(&bar[XB_XCNT(j)]); sum += c; cnt += (c > 0u) ? 1u : 0u; mine = (j == x) ? c : mine; }
        if (sum == G) break;
        __builtin_amdgcn_s_sleep(1);
        if ((++sp & 255u) == 0u) { if (xb_ld(&bar[XB_TMO])) break; if (sp > XB_SPIN_CAP) { atomicAdd(&bar[XB_TMO], 1u); break; } }
    }
    nloc = mine > 0u ? mine : 1u; nx = cnt > 0u ? cnt : 1u;
}
__device__ __forceinline__ void xcd_barrier(const XcdBarrier& b) {
    asm volatile("s_waitcnt vmcnt(0)" ::: "memory");
    __syncthreads();
    if (threadIdx.x == 0) {
        unsigned* bar = b.bar; asm volatile("" : "+s"(bar));
        __builtin_amdgcn_s_waitcnt(0);
        unsigned nloc = b.st[0], nx = b.st[1];
        if (nloc == 0u) { xcd_barrier_complete(bar, b.x, nloc, nx); b.st[0] = nloc; b.st[1] = nx; }
        const unsigned old = xb_add(&bar[XB_XSUB(b.x)], 1u);
        const unsigned gen = old / nloc;
        if (old + 1u == (gen + 1u) * nloc) {
            __builtin_amdgcn_fence(__ATOMIC_RELEASE, "agent");
            asm volatile("s_waitcnt vmcnt(0)" ::: "memory");
            const unsigned og = xb_add(&bar[XB_TOP], 1u);
            const unsigned tg = og / nx;
            if (og + 1u == (tg + 1u) * nx) xb_add(&bar[XB_TOPGEN], 1u);
            else XB_SPIN(xb_ld(&bar[XB_TOPGEN]) == tg, bar);
            __builtin_amdgcn_fence(__ATOMIC_ACQUIRE, "agent");
            xb_add(&bar[XB_XGEN(b.x)], 1u);
            asm volatile("s_waitcnt vmcnt(0)" ::: "memory");
        } else {
            XB_SPIN(xb_ld(&bar[XB_XGEN(b.x)]) == gen, bar);
            __builtin_amdgcn_fence(__ATOMIC_ACQUIRE, "agent");
            asm volatile("s_waitcnt vmcnt(0)" ::: "memory");
        }
    }
    __syncthreads();
}
constexpr size_t P_BAR = P_RT + 1572864;
constexpr int LDS_BARW = LDS_BYTES - 16;

struct SchedAll {
    const LAS pg8::JobDesc* jt; int n0, n1, n2, n3, n4; int K, G, c; int moe; const char* A; const char* B; const int* tstart; const int* src; int nN; size_t bexp;
    __device__ __forceinline__ pg8::Unit get(int i, bool& ok) const {
        const char* ua = nullptr; const char* ub = nullptr; const int* us = nullptr; int upm = 0, upn = 0, ujob = 0; bool good = false;
        if (moe) {
            const int vc = (c & 7) * (G >> 3) + (c >> 3);
            const long L = (long)i * G + vc; const int ntile = tstart[32];
            if (L < (long)ntile * nN) {
                const int mt = (int)(L / nN), nt = (int)(L % nN);
                int e = 0;
                for (int k = 1; k < 32; ++k) if (tstart[k] <= mt) e = k;
                ua = src ? A : A + (size_t)mt * 256 * K * 2; us = src ? src + mt * 256 : nullptr; ub = B + (size_t)e * bexp + (size_t)nt * 256 * K * 2; upm = mt; upn = nt; good = true;
            }
        } else {
            long L = (long)i * G + c;
            if (L < (long)n0 + n1 + n2 + n3 + n4) {
                int l = (int)L; int jb = 0;
                if (l >= n0) { l -= n0; jb = 1; if (l >= n1) { l -= n1; jb = 2; if (l >= n2) { l -= n2; jb = 3; if (l >= n3) { l -= n3; jb = 4; } } } }
                const int jM = __builtin_amdgcn_readfirstlane(jt[jb].nM), jN = __builtin_amdgcn_readfirstlane(jt[jb].nN);
                int pm, pn; pg8::tile_order(l, jM, jN, pm, pn);
                const size_t tstep = (size_t)pg8::BM * K * 2;
                ua = (const char*)pg8::rfl64(jt[jb].A) + (size_t)pm * tstep; ub = (const char*)pg8::rfl64(jt[jb].B) + (size_t)pn * tstep; upm = pm; upn = pn; ujob = jb; good = true;
            }
        }
        pg8::Unit u; u.A = ua; u.B = ub; u.src = us; u.pm = upm; u.pn = upn; u.job = ujob; ok = good; return u;
    }
};
enum { MP_CONV = 0, MP_L0_G1, MP_L0_MIXA, MP_L0_SCAN, MP_L0_MIXC, MP_L0_G2, MP_LN0, MP_XA_G1, MP_XA_ATTN, MP_XA_G2, MP_LN_ROUTE, MP_SCATTER, MP_MOE_G1, MP_MOE_G2, MP_LN_MOE, MP_L1_G1, MP_L1_SWA, MP_L1_G2, MP_LN3 };
__device__ __forceinline__ int prog_kind(int i) {
    switch (i) { case 0: return MP_CONV; case 1: return MP_L0_G1; case 2: return MP_L0_MIXA; case 3: return MP_L0_SCAN; case 4: return MP_L0_MIXC; case 5: return MP_L0_G2; case 6: return MP_LN0;
        case 7: case 19: return MP_XA_G1; case 8: case 20: return MP_XA_ATTN; case 9: case 21: return MP_XA_G2; case 10: case 22: return MP_LN_ROUTE; case 11: case 23: return MP_SCATTER;
        case 12: case 24: return MP_MOE_G1; case 13: case 25: return MP_MOE_G2; case 14: case 26: return MP_LN_MOE; case 15: return MP_L1_G1; case 16: return MP_L1_SWA; case 17: return MP_L1_G2; default: return MP_LN3; }
}
constexpr int N_PROG = 27;
__global__ void __launch_bounds__(NTHR, 2) mega(FP p0) {
    extern __shared__ __attribute__((aligned(16))) unsigned char smem[];
    LAS unsigned char* lds = (LAS unsigned char*)smem;
    cooperative_groups::grid_group grid = cooperative_groups::this_grid();
    const int blk0 = blockIdx.x, G0 = gridDim.x;
    volatile LAS unsigned* bst = (volatile LAS unsigned*)(lds + LDS_BARW);
    if (threadIdx.x == 0) { bst[0] = 0u; bst[1] = 0u; }
    __syncthreads();
    const XcdBarrier xbar = xcd_barrier_post((unsigned*)(p0.ws + P_BAR), bst);
    int dup = 0; (void)dup;
#pragma unroll 1
    for (int pi = 0; pi < N_PROG; ++pi) {
        int blk = blk0, G = G0; asm volatile("" : "+s"(blk), "+s"(G));
        const PV p = make_pv(p0);
        const int kind = prog_kind(pi), l = pi >= 15 ? 1 : 0;
        const bool is_gemm = kind == MP_L0_G1 || kind == MP_L0_G2 || kind == MP_XA_G1 || kind == MP_XA_G2 || kind == MP_MOE_G1 || kind == MP_MOE_G2 || kind == MP_L1_G1 || kind == MP_L1_G2;
        if (is_gemm) {
            SchedAll S; S.jt = JT_PTR; S.n0 = S.n1 = S.n2 = S.n3 = S.n4 = 0; S.K = 1024; S.G = G; S.c = blk; S.moe = 0; S.A = S.B = nullptr; S.tstart = WSP(int, P_RT + RT_TSTART); S.src = nullptr; S.nN = 4; S.bexp = 0;
            __syncthreads();
            if (threadIdx.x == 0) {
                if (kind == MP_L0_G1) set_job(JT_PTR, 0, WSP(bf16_t, P_XBF), WSP(bf16_t, P_WIN_T), 128, 8, WSP(bf16_t, P_TMP + T_AU), 512, EM_GELU4);
                if (kind == MP_L0_G2) set_job(JT_PTR, 0, WSP(bf16_t, P_TMP + T_YM), WSP(bf16_t, P_WOUT_T), 128, 4, WSP(bf16_t, P_TMP + T_YB0), 1024, EM_PLAIN);
                if (kind == MP_XA_G1) {
                    set_job(JT_PTR, 0, WSP(bf16_t, P_XBF), WSP(bf16_t, P_XWQ_T) + (size_t)l * 1024 * 1024, 128, 4, WSP(bf16_t, P_TMP + T_QX), 1024, EM_PLAIN);
                    if (l == 0) { for (int ll = 0; ll < 2; ++ll) { const bf16_t* wkv = WSP(bf16_t, P_XWKV_T) + (size_t)ll * 2048 * 1024;
                        set_job(JT_PTR, 1 + 2 * ll, WSP(bf16_t, P_MEMB), wkv, 8, 4, WSP(bf16_t, P_KC) + (size_t)ll * 2048 * 1024, 1024, EM_PLAIN);
                        set_job(JT_PTR, 2 + 2 * ll, wkv + (size_t)1024 * 1024, WSP(bf16_t, P_MEMB), 4, 8, WSP(bf16_t, P_VT) + (size_t)ll * 1024 * 2048, 2048, EM_PLAIN); } } }
                if (kind == MP_XA_G2) set_job(JT_PTR, 0, WSP(bf16_t, P_TMP + T_OB), WSP(bf16_t, P_XWO_T) + (size_t)l * 1024 * 1024, 128, 4, WSP(bf16_t, P_TMP + T_YB), 1024, EM_PLAIN);
                if (kind == MP_MOE_G1) set_job(JT_PTR, 0, nullptr, nullptr, 0, 0, WSP(bf16_t, P_TMP + T_HM), 512, EM_SWIGLU);
                if (kind == MP_MOE_G2) set_job(JT_PTR, 0, nullptr, nullptr, 0, 0, WSP(bf16_t, P_TMP + T_YG), 1024, EM_PLAIN);
                if (kind == MP_L1_G1) { set_job(JT_PTR, 0, WSP(bf16_t, P_XBF), WSP(bf16_t, P_WQKV_T), 128, 5, WSP(bf16_t, P_TMP + T_QX), 1024, EM_ROTARY, WSP(float, P_BQK), WSP(float, P_ROT), WSP(bf16_t, P_TMP + T_K1));
                    set_job(JT_PTR, 1, WSP(bf16_t, P_WQKV_T) + (size_t)1280 * 1024, WSP(bf16_t, P_XBF), 1, 128, WSP(bf16_t, P_TMP + T_VT1), NT, EM_ROWBIAS, p.in[20] + 1280); }
                if (kind == MP_L1_G2) set_job(JT_PTR, 0, WSP(bf16_t, P_TMP + T_OB), WSP(bf16_t, P_WO_T), 128, 4, WSP(bf16_t, P_TMP + T_YB), 1024, EM_PLAIN);
            }
            if (kind == MP_L0_G1) S.n0 = 1024;
            if (kind == MP_L0_G2 || kind == MP_XA_G2 || kind == MP_L1_G2) S.n0 = 512;
            if (kind == MP_XA_G1) { S.n0 = 512; if (l == 0) { S.n1 = 32; S.n2 = 32; S.n3 = 32; S.n4 = 32; } }
            if (kind == MP_L1_G1) { S.n0 = 640; S.n1 = 128; }
            if (kind == MP_MOE_G1) { S.moe = 1; S.A = (const char*)WSP(bf16_t, P_XBF); S.src = WSP(int, P_RT + RT_SRC); S.B = (const char*)WSP(bf16_t, P_W13T); S.bexp = (size_t)1024 * 1024 * 2; }
            if (kind == MP_MOE_G2) { S.moe = 1; S.K = 512; S.A = (const char*)WSP(bf16_t, P_TMP + T_HM); S.B = (const char*)WSP(bf16_t, P_W2T); S.bexp = (size_t)1024 * 512 * 2; }
            __syncthreads();
            EpiMulti E; E.jt = JT_PTR;
#ifdef PROBE_GEMM2
#pragma unroll 1
            for (int rep = 0; rep < 2; ++rep)
#endif
            pg8::gemm_phase<EpiMulti, SchedAll, true, true>(lds, S.K, S, E);
        } else {
#ifdef PROBE_MASK
#define DRY (dup == 0 && (((PROBE_MASK) >> kind) & 1))
#else
#define DRY false
#endif
            switch (kind) {
                case MP_CONV: ph_conv_l0(p, lds, blk, G); ph_conv_l1(p, lds, blk, G); ph_conv_xattn(p, lds, blk, G, 0); ph_conv_xattn(p, lds, blk, G, 1); ph_conv_moe(p, lds, blk, G, 0); ph_xin_to_bf(p, lds, blk, G); break;
                case MP_L0_MIXA: l0_mixA(lds, l0_bufs(p), blk, G); break;
                case MP_L0_SCAN: ph_scan_conv(p, lds, blk, G); break;
                case MP_L0_MIXC: l0_mixC(lds, l0_bufs(p), blk, G); break;
                case MP_LN0: ph_ln<true, false, false>(p, lds, blk, G, WSP(bf16_t, P_TMP + T_YB0), 0, DRY); break;
                case MP_XA_ATTN: ph_xattn_attn(p, lds, blk, G, l); break;
                case MP_LN_ROUTE: ph_ln<false, false, false>(p, lds, blk, G, WSP(bf16_t, P_TMP + T_YB), l * 3 + 1, DRY); __syncthreads(); ph_moe_route(p, lds, blk, G, l); break;
                case MP_SCATTER: ph_moe_scatter(p, lds, blk, G); break;
                case MP_LN_MOE: if (l == 0) { ph_ln<false, false, true>(p, lds, blk, G, WSP(bf16_t, P_TMP + T_YG), 2, DRY); if (!(DRY)) ph_conv_moe(p, lds, blk, G, 1); } else ph_ln<false, true, true>(p, lds, blk, G, WSP(bf16_t, P_TMP + T_YG), 5, DRY); break;
                case MP_L1_SWA: ph_l1_swa(p, lds, blk, G); break;
                default: ph_ln<false, false, false>(p, lds, blk, G, WSP(bf16_t, P_TMP + T_YB), 3, DRY); break;
            }
        }
#ifdef PROBE_MASK
        if (((PROBE_MASK) >> kind) & 1) { if (dup == 0) { dup = 1; xcd_barrier(xbar); --pi; continue; } dup = 0; }
#endif
        if (pi + 1 < N_PROG) { if (pi == 0) grid.sync(); else { xcd_barrier(xbar);
#ifdef PROBE_BAR2
            xcd_barrier(xbar);
#endif
        } }
    }
}
}
extern "C" void kernel_launch(void* const* d_in, const int* in_sizes, int n_in, void* d_out, int out_size, void* d_ws, size_t ws_size, hipStream_t stream) {
    static int ok = 0;
    if (ok == 0) {
        ok = -1;
        if (n_in != 33 || out_size != 32768 * 1024 || ws_size < fk::FAST_END) { fprintf(stderr, "kernel_launch: unexpected shapes/ws (%d, %d, %zu)\n", n_in, out_size, ws_size); return; }
        int dev = 0, cus = 0, per_cu = 0;
        if (hipGetDevice(&dev) != hipSuccess || hipDeviceGetAttribute(&cus, hipDeviceAttributeMultiprocessorCount, dev) != hipSuccess) return;
        if (hipFuncSetAttribute((const void*)fk::mega, hipFuncAttributeMaxDynamicSharedMemorySize, fk::LDS_BYTES) != hipSuccess) return;
        if (hipOccupancyMaxActiveBlocksPerMultiprocessor(&per_cu, (const void*)fk::mega, fk::NTHR, fk::LDS_BYTES) != hipSuccess || per_cu < 1 || cus * per_cu < 256) { fprintf(stderr, "kernel_launch: cannot co-reside 256 workgroups (%d CUs x %d)\n", cus, per_cu); return; }
        ok = 1;
    }
    if (ok < 0) return;
    fk::FP p{}; for (int i = 0; i < 33; ++i) p.in[i] = (const float*)d_in[i]; p.X = (float*)d_out; p.ws = (unsigned char*)d_ws;
    if (hipMemsetAsync((char*)d_ws + fk::P_BAR, 0, 16384, stream) != hipSuccess) return;
    void* args[] = {&p};
    hipError_t e = hipLaunchCooperativeKernel((const void*)fk::mega, dim3(256), dim3(fk::NTHR), args, fk::LDS_BYTES, stream);
    if (e != hipSuccess) fprintf(stderr, "cooperative launch failed: %s\n", hipGetErrorString(e));
}
```

```cpp
#include <hip/hip_runtime.h>
#include <hip/hip_cooperative_groups.h>
#include <cstdio>
#include <cstdint>
#include <cmath>
namespace fk {
#define LAS __attribute__((address_space(3)))
typedef unsigned short bf16_t;
typedef short bf16x8 __attribute__((ext_vector_type(8)));
typedef short s16x4 __attribute__((ext_vector_type(4)));
typedef float f32x4 __attribute__((ext_vector_type(4)));
typedef float f32x16 __attribute__((ext_vector_type(16)));
typedef float f32x2 __attribute__((ext_vector_type(2)));
typedef unsigned u32x4 __attribute__((ext_vector_type(4)));
typedef unsigned u32x2 __attribute__((ext_vector_type(2)));
typedef __bf16 bf16x2_t __attribute__((ext_vector_type(2)));

constexpr int NT = 32768, DM = 1024, SEQ = 4096;
constexpr int NTHR = 512, NWAVE = 8;
constexpr float ALPHA = 1.4142135623730951f, LN_EPS = 1e-5f, LOG2E = 1.4426950408889634f;

__device__ __forceinline__ unsigned pk2(float lo, float hi) { f32x2 v = {lo, hi}; bf16x2_t b = __builtin_convertvector(v, bf16x2_t); return __builtin_bit_cast(unsigned, b); }
__device__ __forceinline__ float bf_lo(unsigned w) { return __uint_as_float(w << 16); }
__device__ __forceinline__ float bf_hi(unsigned w) { return __uint_as_float(w & 0xffff0000u); }
__device__ __forceinline__ float bf2f(bf16_t b) { return __uint_as_float(((unsigned)b) << 16); }
__device__ __forceinline__ bf16_t f2bf(float f) { return (bf16_t)(pk2(f, 0.f) & 0xffffu); }
__device__ __forceinline__ float fast_exp(float x) { return __builtin_amdgcn_exp2f(x * LOG2E); }
__device__ __forceinline__ float sigmoid_f(float x) { return __builtin_amdgcn_rcpf(1.f + fast_exp(-x)); }
__device__ __forceinline__ float silu_f(float x) { return x * sigmoid_f(x); }
__device__ __forceinline__ float gelu_tanh_f(float x) { const float u = 1.5957691216057308f * (x + 0.044715f * x * x * x); return x * sigmoid_f(u); }
__device__ __forceinline__ int crow(int r, int hi) { return (r & 3) + 8 * (r >> 2) + 4 * hi; }
__device__ __forceinline__ float xhalf_sum(float v) { auto rr = __builtin_amdgcn_permlane32_swap(__float_as_uint(v), __float_as_uint(v), false, false); return __uint_as_float(rr[0]) + __uint_as_float(rr[1]); }
__device__ __forceinline__ float xhalf_max(float v) { auto rr = __builtin_amdgcn_permlane32_swap(__float_as_uint(v), __float_as_uint(v), false, false); return fmaxf(__uint_as_float(rr[0]), __uint_as_float(rr[1])); }
__device__ __forceinline__ float shx(float v, int o, int lane) { return __int_as_float(__builtin_amdgcn_ds_bpermute((lane ^ o) << 2, __float_as_int(v))); }
__device__ __forceinline__ float shup(float v, int o, int lane) { return __int_as_float(__builtin_amdgcn_ds_bpermute(((lane - o) & 63) << 2, __float_as_int(v))); }
__device__ __forceinline__ float shidx(float v, int idx) { return __int_as_float(__builtin_amdgcn_ds_bpermute(idx << 2, __float_as_int(v))); }
__device__ __forceinline__ s16x4 lds_tr(const LAS void* p) { return __builtin_bit_cast(s16x4, __builtin_amdgcn_ds_read_tr16_b64_v4i16((LAS s16x4*)p)); }
#define MFMA32(a, b, c) __builtin_amdgcn_mfma_f32_32x32x16_bf16((a), (b), (c), 0, 0, 0)

namespace pg8 {
constexpr int BM = 256, BK = 64, HALF = 128, HTB = HALF * BK * 2, STAGE_BYTES = 8 * HTB, NXCD = 8, WGM = 8;
__host__ __device__ __forceinline__ int lds_byte(int r, int c) { const int st = (r >> 4) * 2 + (c >> 5), rr = r & 15, cc = c & 31, ob = rr * 64 + cc * 2; return st * 1024 + (ob ^ (((ob >> 9) & 1) << 5)); }
__host__ __device__ __forceinline__ void stage_rc(int b, int& R, int& C) { const int st = b / 1024, sb = b % 1024, swz = sb ^ (((sb >> 9) & 1) << 5); R = (st >> 1) * 16 + swz / 64; C = (st & 1) * 32 + (swz % 64) / 2; }
__host__ __device__ __forceinline__ int perm32(int rho) { const int n = rho >> 4, i = rho & 15; return 8 * (i >> 2) + 4 * n + (i & 3); }

struct Unit { const char* A; const char* B; const int* src; int pm, pn, job; };

__device__ __forceinline__ void tile_order(int l, int nM, int nN, int& pm, int& pn) {
    const int nwg = nM * nN; int wgid = l;
    { const int q = nwg / NXCD, r = nwg % NXCD, xcd = wgid % NXCD, off = wgid / NXCD; wgid = (xcd < r ? xcd * (q + 1) : r * (q + 1) + (xcd - r) * q) + off; }
    const int nig = WGM * nN, gid = wgid / nig, fm = gid * WGM, gsz = (nM - fm) < WGM ? (nM - fm) : WGM;
    pm = fm + ((wgid % nig) % gsz); pn = (wgid % nig) / gsz;
}
struct JobDesc { unsigned long long A, B, out, bias, rot, out2; int nM, nN, ldc, mode; };
__device__ __forceinline__ unsigned long long rfl64(unsigned long long v) { const unsigned lo = __builtin_amdgcn_readfirstlane((unsigned)v), hi = __builtin_amdgcn_readfirstlane((unsigned)(v >> 32)); return ((unsigned long long)hi << 32) | lo; }
constexpr int JT_OFF = STAGE_BYTES;
struct Jobs3 {
    const LAS JobDesc* jt; int n0, n1, n2; int K, G, c;
    __device__ __forceinline__ Unit get(int i, bool& ok) const { Unit u; u.A = nullptr; u.B = nullptr; u.src = nullptr; u.pm = 0; u.pn = 0; u.job = 0; ok = next(i, u); return u; }
    __device__ __forceinline__ bool next(int i, Unit& u) const {
        long L = (long)i * G + c;
        if (L >= (long)n0 + n1 + n2) return false;
        int l = (int)L; int jb = 0;
        if (l >= n0) { l -= n0; jb = 1; if (l >= n1) { l -= n1; jb = 2; } }
        const int jM = __builtin_amdgcn_readfirstlane(jt[jb].nM), jN = __builtin_amdgcn_readfirstlane(jt[jb].nN);
        int pm, pn; tile_order(l, jM, jN, pm, pn);
        const size_t tstep = (size_t)BM * K * 2;
        u.A = (const char*)rfl64(jt[jb].A) + (size_t)pm * tstep; u.B = (const char*)rfl64(jt[jb].B) + (size_t)pn * tstep; u.src = nullptr; u.pm = pm; u.pn = pn; u.job = jb; return true;
    }
};

template <class Epi, class Sched, bool ALIGN_EPI, bool SP2>
__device__ __forceinline__ void gemm_phase(LAS unsigned char* lds, const int K, const Sched& S, const Epi& E) {
    int tid_ = threadIdx.x; asm volatile("" : "+v"(tid_)); const int tid = tid_, wid = __builtin_amdgcn_readfirstlane(tid >> 6), lane = tid & 63, wr = wid >> 2, wc = wid & 3, fr = lane & 15, fq = lane >> 4;
    const int nt = K / BK;
    static_assert(SP2, "only the two-super-phase form is kept");
    unsigned vA0[2], vA1[2], vB0[2], vB1[2];
#pragma unroll
    for (int i = 0; i < 2; ++i) { int R, C; stage_rc(tid * 16 + i * 8192, R, C); const int Rb = 64 * (R >> 5) + perm32(R & 31); vB0[i] = (unsigned)(Rb * K + C) * 2u; vB1[i] = (unsigned)((Rb + 32) * K + C) * 2u; }
    auto a_rows = [&](const int* src, unsigned (&o0)[2], unsigned (&o1)[2]) {
        int tq = tid; asm volatile("" : "+v"(tq));
#pragma unroll
        for (int i = 0; i < 2; ++i) { int R, C; stage_rc(tq * 16 + i * 8192, R, C); int r0 = R, r1 = R + HALF; if (src) { r0 = src[R]; r1 = src[R + HALF]; }
            o0[i] = (unsigned)(r0 * K + C) * 2u; o1[i] = (unsigned)(r1 * K + C) * 2u; }
    };
    const size_t kstep = (size_t)(BK * 2);
    const size_t hstep = (size_t)HALF * K * 2;
    const unsigned ldsw = (unsigned)wid * 1024u;
    const int aoff = lds_byte(wr * 64 + fr, fq * 8), boff = lds_byte(wc * 32 + fr, fq * 8);
#define PG8_SA(b, h) (((b) * 2 + (h)) * HTB)
#define PG8_SB(b, h) ((4 + (b) * 2 + (h)) * HTB)
#define PG8_STAGE(bufoff, gbase, voff) do { _Pragma("unroll") for (int _i = 0; _i < 2; ++_i) \
        __builtin_amdgcn_global_load_lds((const unsigned*)((const char*)(gbase) + (voff)[_i]), (LAS unsigned*)(lds + (bufoff) + ldsw + _i * 8192), 16, 0, 0); } while (0)
#define PG8_LDA(dst, b, h) do { _Pragma("unroll") for (int m = 0; m < 4; ++m) _Pragma("unroll") for (int k = 0; k < 2; ++k) dst[m][k] = *(const LAS bf16x8*)(lds + PG8_SA(b, h) + aoff + m * 2048 + k * 1024); } while (0)
#define PG8_LDB(dst, b, h) do { _Pragma("unroll") for (int n = 0; n < 2; ++n) _Pragma("unroll") for (int k = 0; k < 2; ++k) dst[n][k] = *(const LAS bf16x8*)(lds + PG8_SB(b, h) + boff + n * 2048 + k * 1024); } while (0)
#define PG8_MMA(ai, bj, At, Bt) do { __builtin_amdgcn_s_setprio(1); _Pragma("unroll") for (int m = 0; m < 4; ++m) _Pragma("unroll") for (int n = 0; n < 2; ++n) _Pragma("unroll") for (int k = 0; k < 2; ++k) \
        acc[ai][bj][m][n] = __builtin_amdgcn_mfma_f32_16x16x32_bf16(Bt[n][k], At[m][k], acc[ai][bj][m][n], 0, 0, 0); __builtin_amdgcn_s_setprio(0); } while (0)
#define PG8_WAIT_V(n) asm volatile("s_waitcnt vmcnt(" #n ")" ::: "memory")
#define PG8_WAIT_L(n) asm volatile("s_waitcnt lgkmcnt(" #n ")" ::: "memory")
#define PG8_BAR __builtin_amdgcn_s_barrier()
#define PG8_SCHED __builtin_amdgcn_sched_barrier(0)
    auto unif = [](Unit u) { Unit r; r.A = (const char*)rfl64((unsigned long long)u.A); r.B = (const char*)rfl64((unsigned long long)u.B); r.src = (const int*)rfl64((unsigned long long)u.src);
        r.pm = __builtin_amdgcn_readfirstlane(u.pm); r.pn = __builtin_amdgcn_readfirstlane(u.pn); r.job = __builtin_amdgcn_readfirstlane(u.job); return r; };
    int ui = 0; bool ok0; Unit cur = unif(S.get(0, ok0));
    if (!ok0) return;
    f32x4 acc[2][2][4][2];
#pragma unroll
    for (int a = 0; a < 2; ++a)
#pragma unroll
        for (int b = 0; b < 2; ++b)
#pragma unroll
            for (int m = 0; m < 4; ++m)
#pragma unroll
                for (int n = 0; n < 2; ++n) acc[a][b][m][n] = (f32x4){0.f, 0.f, 0.f, 0.f};
    bf16x8 At[4][2], B0[2][2], B1[2][2];
    const char* cA = cur.A; const char* cB = cur.B;
    a_rows(cur.src, vA0, vA1);
    {
        PG8_STAGE(PG8_SB(0, 0), cB, vB0); PG8_STAGE(PG8_SB(0, 1), cB, vB1); PG8_STAGE(PG8_SA(0, 0), cA, vA0); PG8_STAGE(PG8_SA(0, 1), cA, vA1);
        if (wr == 1) PG8_BAR;
        PG8_WAIT_V(2); PG8_BAR;
        PG8_STAGE(PG8_SB(1, 0), cB + kstep, vB0); PG8_STAGE(PG8_SA(1, 0), cA + kstep, vA0); PG8_STAGE(PG8_SB(1, 1), cB + kstep, vB1);
        PG8_WAIT_V(6); PG8_BAR;
    }
    for (;;) {
        bool has_next; const Unit nxt = unif(S.get(ui + 1, has_next)); bool early_done = false;
        const char* nA = has_next ? nxt.A : cA; const char* nB = has_next ? nxt.B : cB;
        for (int t = 0; t < nt; t += 2) {
            const bool last = (t == nt - 2);
            const char* a1 = cA + (size_t)(t + 1) * kstep;
            const char* a2 = last ? nA : cA + (size_t)(t + 2) * kstep; const char* b2 = last ? nB : cB + (size_t)(t + 2) * kstep;
            const char* a3 = a2 + kstep; const char* b3 = b2 + kstep;
            PG8_LDB(B0, 0, 0); PG8_LDB(B1, 0, 1); PG8_SCHED; PG8_LDA(At, 0, 0); PG8_STAGE(PG8_SA(1, 1), a1, vA1);
            if (last && has_next) a_rows(nxt.src, vA0, vA1);
            PG8_WAIT_V(8); PG8_WAIT_L(0); PG8_BAR; PG8_MMA(0, 0, At, B0); PG8_MMA(0, 1, At, B1); PG8_BAR; PG8_SCHED;
            PG8_LDA(At, 0, 1); PG8_STAGE(PG8_SB(0, 0), b2, vB0); PG8_STAGE(PG8_SB(0, 1), b2, vB1); PG8_STAGE(PG8_SA(0, 0), a2, vA0);
            PG8_WAIT_V(8); PG8_WAIT_L(0); PG8_BAR; PG8_MMA(1, 0, At, B0); PG8_MMA(1, 1, At, B1); PG8_BAR; PG8_SCHED;
            PG8_LDB(B0, 1, 0); PG8_LDB(B1, 1, 1); PG8_SCHED; PG8_LDA(At, 1, 0); PG8_STAGE(PG8_SA(0, 1), a2, vA1);
            PG8_WAIT_V(8); PG8_WAIT_L(0); PG8_BAR; PG8_MMA(0, 0, At, B0); PG8_MMA(0, 1, At, B1); PG8_BAR; PG8_SCHED;
            if (last) { early_done = E.early(acc, cur, wr, wc, fr, fq); PG8_SCHED; }
            PG8_LDA(At, 1, 1); PG8_STAGE(PG8_SB(1, 0), b3, vB0); PG8_STAGE(PG8_SB(1, 1), b3, vB1); PG8_STAGE(PG8_SA(1, 0), a3, vA0);
            PG8_WAIT_V(8); PG8_WAIT_L(0); PG8_BAR; PG8_MMA(1, 0, At, B0); PG8_MMA(1, 1, At, B1); PG8_BAR; PG8_SCHED;
        }
        if constexpr (ALIGN_EPI) { if (wr == 0) PG8_BAR; }
        if (!early_done) E.template half<0>(acc, cur, wr, wc, fr, fq);
        E.template half<1>(acc, cur, wr, wc, fr, fq);
        if (!has_next) break;
#pragma unroll
        for (int a = 0; a < 2; ++a)
#pragma unroll
            for (int b = 0; b < 2; ++b)
#pragma unroll
                for (int m = 0; m < 4; ++m)
#pragma unroll
                    for (int n = 0; n < 2; ++n) acc[a][b][m][n] = (f32x4){0.f, 0.f, 0.f, 0.f};
        cur = nxt; cA = nA; cB = nB; ++ui;
        if constexpr (ALIGN_EPI) { if (wr == 1) PG8_BAR; }
    }
    PG8_WAIT_V(0);
    if constexpr (!ALIGN_EPI) { if (wr == 0) PG8_BAR; }
    PG8_BAR;
#undef PG8_SA
#undef PG8_SB
#undef PG8_STAGE
#undef PG8_LDA
#undef PG8_LDB
#undef PG8_MMA
#undef PG8_WAIT_V
#undef PG8_WAIT_L
#undef PG8_BAR
#undef PG8_SCHED
}
}
enum { EM_PLAIN = 0, EM_GELU4 = 1, EM_SWIGLU = 2, EM_ROTARY = 3, EM_ROWBIAS = 4 };
struct EpiMulti {
    static constexpr bool PERM = true;
    const LAS pg8::JobDesc* jt;
    __device__ __forceinline__ bool early(const f32x4 (&acc)[2][2][4][2], const pg8::Unit& u, int wr, int wc, int fr, int fq) const {
        const LAS pg8::JobDesc* jd = jt + u.job;
        if (__builtin_amdgcn_readfirstlane(jd->mode) != EM_PLAIN) return false;
        bf16_t* out = (bf16_t*)pg8::rfl64(jd->out); const int ldc = __builtin_amdgcn_readfirstlane(jd->ldc);
        bf16_t* rowp = out + (size_t)(u.pm * 256 + wr * 64 + fr) * ldc + u.pn * 256 + wc * 64 + 8 * fq;
#pragma unroll
        for (int m = 0; m < 4; ++m)
#pragma unroll
            for (int bj = 0; bj < 2; ++bj) { const f32x4 v0 = acc[0][bj][m][0], v1 = acc[0][bj][m][1];
                u32x4 w; w.x = pk2(v0[0], v0[1]); w.y = pk2(v0[2], v0[3]); w.z = pk2(v1[0], v1[1]); w.w = pk2(v1[2], v1[3]);
                *(u32x4*)(rowp + (size_t)m * 16 * ldc + bj * 32) = w; }
        return true;
    }
    template <int AI>
    __device__ __forceinline__ void half(const f32x4 (&acc)[2][2][4][2], const pg8::Unit& u, int wr, int wc, int fr, int fq) const {
        const LAS pg8::JobDesc* jd = jt + u.job;
        bf16_t* out = (bf16_t*)pg8::rfl64(jd->out);
        const int ldc = __builtin_amdgcn_readfirstlane(jd->ldc);
        const int mode = __builtin_amdgcn_readfirstlane(jd->mode);
        const float* bias = (const float*)pg8::rfl64(jd->bias);
        const int row0 = u.pm * 256 + wr * 64 + fr;
        const int colt = u.pn * 256 + wc * 64 + 8 * fq;
        if (mode == EM_PLAIN || mode == EM_ROWBIAS) {
#pragma unroll
            for (int ai = AI; ai < AI + 1; ++ai)
#pragma unroll
                for (int m = 0; m < 4; ++m) { const int row = row0 + ai * 128 + m * 16; const float rb = (mode == EM_ROWBIAS && bias) ? bias[row] : 0.f;
                    bf16_t* rowp = out + (size_t)row * ldc + colt;
#pragma unroll
                    for (int bj = 0; bj < 2; ++bj) { const f32x4 v0 = acc[ai][bj][m][0] + rb, v1 = acc[ai][bj][m][1] + rb;
                        u32x4 w; w.x = pk2(v0[0], v0[1]); w.y = pk2(v0[2], v0[3]); w.z = pk2(v1[0], v1[1]); w.w = pk2(v1[2], v1[3]);
                        *(u32x4*)(rowp + bj * 32) = w; } }
        } else if (mode == EM_GELU4) {
            const int arr = u.pn >> 1; bf16_t* base = out + (size_t)arr * NT * 512; const int col = colt - arr * 512; const bool act = arr < 2;
#pragma unroll
            for (int ai = AI; ai < AI + 1; ++ai)
#pragma unroll
                for (int m = 0; m < 4; ++m) { bf16_t* rowp = base + (size_t)(row0 + ai * 128 + m * 16) * 512 + col;
#pragma unroll
                    for (int bj = 0; bj < 2; ++bj) { f32x4 v0 = acc[ai][bj][m][0], v1 = acc[ai][bj][m][1];
                        if (act) {
#pragma unroll
                            for (int e = 0; e < 4; ++e) { v0[e] = gelu_tanh_f(v0[e]); v1[e] = gelu_tanh_f(v1[e]); } }
                        u32x4 w; w.x = pk2(v0[0], v0[1]); w.y = pk2(v0[2], v0[3]); w.z = pk2(v1[0], v1[1]); w.w = pk2(v1[2], v1[3]);
                        *(u32x4*)(rowp + bj * 32) = w; } }
        } else if (mode == EM_SWIGLU) {
#pragma unroll
            for (int ai = AI; ai < AI + 1; ++ai)
#pragma unroll
                for (int m = 0; m < 4; ++m) { bf16_t* rowp = out + (size_t)(row0 + ai * 128 + m * 16) * ldc + (colt >> 1);
#pragma unroll
                    for (int bj = 0; bj < 2; ++bj) { const f32x4 v0 = acc[ai][bj][m][0], v1 = acc[ai][bj][m][1];
                        u32x2 w; w.x = pk2(silu_f(v0[0]) * v0[1], silu_f(v0[2]) * v0[3]); w.y = pk2(silu_f(v1[0]) * v1[1], silu_f(v1[2]) * v1[3]);
                        *(u32x2*)(rowp + bj * 16) = w; } }
        } else {
            const float* rot = (const float*)pg8::rfl64(jd->rot);
            bf16_t* out2 = (bf16_t*)pg8::rfl64(jd->out2);
            const bool isk = u.pn >= 4; bf16_t* base = isk ? out2 : out; const int ld = isk ? 256 : 1024; const int colo = isk ? colt - 1024 : colt;
            float bv[2][8];
#pragma unroll
            for (int bj = 0; bj < 2; ++bj)
#pragma unroll
                for (int e = 0; e < 8; ++e) bv[bj][e] = bias ? bias[colt + bj * 32 + e] : 0.f;
            const int i0 = (colt & 63) >> 1;
#pragma unroll
            for (int ai = AI; ai < AI + 1; ++ai)
#pragma unroll
                for (int m = 0; m < 4; ++m) { const int row = row0 + ai * 128 + m * 16; const int pos = row & (SEQ - 1);
                    bf16_t* rowp = base + (size_t)row * ld + colo;
#pragma unroll
                    for (int bj = 0; bj < 2; ++bj) { f32x4 v0 = acc[ai][bj][m][0], v1 = acc[ai][bj][m][1];
                        const f32x4 cs0 = *(const f32x4*)(rot + ((size_t)pos * 32 + i0 + 16 * bj) * 2), cs1 = *(const f32x4*)(rot + ((size_t)pos * 32 + i0 + 16 * bj + 2) * 2);
#pragma unroll
                        for (int e = 0; e < 4; ++e) { v0[e] += bv[bj][e]; v1[e] += bv[bj][4 + e]; }
                        const float a0 = v0[0] * cs0[0] - v0[1] * cs0[1], b0 = v0[1] * cs0[0] + v0[0] * cs0[1];
                        const float a1 = v0[2] * cs0[2] - v0[3] * cs0[3], b1 = v0[3] * cs0[2] + v0[2] * cs0[3];
                        const float a2 = v1[0] * cs1[0] - v1[1] * cs1[1], b2 = v1[1] * cs1[0] + v1[0] * cs1[1];
                        const float a3 = v1[2] * cs1[2] - v1[3] * cs1[3], b3 = v1[3] * cs1[2] + v1[2] * cs1[3];
                        u32x4 w; w.x = pk2(a0, b0); w.y = pk2(a1, b1); w.z = pk2(a2, b2); w.w = pk2(a3, b3);
                        *(u32x4*)(rowp + bj * 32) = w; } }
        }
    }
};
enum { RM_IDENT = 0, RM_ROT = 1, RM_PAIR0 = 2, RM_PAIR1 = 3 };
__device__ __forceinline__ int rowmap(int kind, int n) {
    if (kind == RM_ROT) { if (n >= 1280) return n; const int d = n & 63; return (n & ~63) + 2 * (d & 31) + (d >> 5); }
    if (kind == RM_PAIR0) return 2 * n;
    if (kind == RM_PAIR1) return 2 * n + 1;
    return n;
}
__device__ __forceinline__ void ti_load(const float* __restrict__ W, int ldw, int kb, int nb, int lane, f32x4 (&tv)[8]) {
    const int k0 = 64 * kb, n0 = 32 * nb;
#pragma unroll
    for (int i = 0; i < 8; ++i) { const int kk = 8 * i + (lane >> 3); tv[i] = *(const f32x4*)(W + (size_t)(k0 + kk) * ldw + n0 + 4 * (lane & 7)); }
}
__device__ __forceinline__ void ti_store(const f32x4 (&tv)[8], int K, bf16_t* __restrict__ WT, LAS float* scr, int kb, int nb, int lane, int kind, float scale, int nscale) {
    const int k0 = 64 * kb, n0 = 32 * nb;
#pragma unroll
    for (int i = 0; i < 8; ++i) { const int kk = 8 * i + (lane >> 3); LAS float* d = scr + kk * 33 + 4 * (lane & 7); d[0] = tv[i][0]; d[1] = tv[i][1]; d[2] = tv[i][2]; d[3] = tv[i][3]; }
    __builtin_amdgcn_s_waitcnt(0xc07f); asm volatile("" ::: "memory");
    const int c = lane & 7;
#pragma unroll
    for (int j = 0; j < 4; ++j) { const int n = (lane >> 3) + 8 * j; const LAS float* s = scr + (8 * c) * 33 + n; const float sc = (n0 + n) < nscale ? scale : 1.f;
        u32x4 o; o.x = pk2(s[0 * 33] * sc, s[1 * 33] * sc); o.y = pk2(s[2 * 33] * sc, s[3 * 33] * sc); o.z = pk2(s[4 * 33] * sc, s[5 * 33] * sc); o.w = pk2(s[6 * 33] * sc, s[7 * 33] * sc);
        *(u32x4*)(WT + (size_t)rowmap(kind, n0 + n) * K + k0 + 8 * c) = o; }
    __builtin_amdgcn_s_waitcnt(0xc07f); asm volatile("" ::: "memory");
}
__device__ __forceinline__ void convert_mats(const float* W, int K, int N, int nbat, size_t sstr, bf16_t* WT, size_t dstr, int kind, float scale, int nscale, LAS float* scr, int gw, int ngw, int lane) {
    const int nblk = N / 32, per = (K / 64) * nblk, total = per * nbat;
    if (gw >= total) return;
    f32x4 cur[8], nxt[8];
    { const int bt = gw / per, r = gw - bt * per; ti_load(W + (size_t)bt * sstr, N, r / nblk, r % nblk, lane, cur); }
    for (int it = gw; it < total; it += ngw) {
        const int in = it + ngw; const bool more = in < total;
        if (more) { const int bt = in / per, r = in - bt * per; ti_load(W + (size_t)bt * sstr, N, r / nblk, r % nblk, lane, nxt); }
        { const int bt = it / per, r = it - bt * per; ti_store(cur, K, WT + (size_t)bt * dstr, scr, r / nblk, r % nblk, lane, kind, scale, nscale); }
#pragma unroll
        for (int i = 0; i < 8; ++i) cur[i] = nxt[i];
    }
}
__device__ __forceinline__ void convert_rows(const float* __restrict__ src, bf16_t* __restrict__ dst, size_t n, int gt, int ngt) {
    const size_t step = (size_t)ngt * 8; size_t i = (size_t)gt * 8;
    for (; i + 3 * step < n; i += 4 * step) { f32x4 a[4], b[4];
#pragma unroll
        for (int j = 0; j < 4; ++j) { a[j] = *(const f32x4*)(src + i + j * step); b[j] = *(const f32x4*)(src + i + j * step + 4); }
#pragma unroll
        for (int j = 0; j < 4; ++j) { u32x4 o; o.x = pk2(a[j][0], a[j][1]); o.y = pk2(a[j][2], a[j][3]); o.z = pk2(b[j][0], b[j][1]); o.w = pk2(b[j][2], b[j][3]); *(u32x4*)(dst + i + j * step) = o; } }
    for (; i < n; i += step) { const f32x4 a = *(const f32x4*)(src + i), b = *(const f32x4*)(src + i + 4);
        u32x4 o; o.x = pk2(a[0], a[1]); o.y = pk2(a[2], a[3]); o.z = pk2(b[0], b[1]); o.w = pk2(b[2], b[3]); *(u32x4*)(dst + i) = o; }
}

struct LnArgs { const float* xin32; const bf16_t* xin; float* xout32; bf16_t* xbf; const bf16_t* y; const float* g; const float* b; const int* dest; const float* wts; };
template <int NR, bool XF32, bool OUTF32, bool MOE>
__device__ __forceinline__ void ln_rows(const LnArgs& a, int row0, int lane) {
    float v[NR][2][8];
    {
        int d0[NR], d1[NR]; float w0[NR], w1[NR];
        if (MOE) {
#pragma unroll
            for (int i = 0; i < NR; ++i) { d0[i] = a.dest[(row0 + i) * 2]; d1[i] = a.dest[(row0 + i) * 2 + 1]; w0[i] = a.wts[(row0 + i) * 2]; w1[i] = a.wts[(row0 + i) * 2 + 1]; }
        }
        f32x4 xf[XF32 ? NR : 1][2][2]; u32x4 xb[XF32 ? 1 : NR][2]; u32x4 p[NR][2], q[MOE ? NR : 1][2];
#pragma unroll
        for (int i = 0; i < NR; ++i) {
            const u32x4* y0 = (const u32x4*)(a.y + (size_t)(MOE ? d0[i] : row0 + i) * DM) + lane; const u32x4* y1 = (const u32x4*)(a.y + (size_t)(MOE ? d1[i] : 0) * DM) + lane;
#pragma unroll
            for (int j = 0; j < 2; ++j) {
                if (XF32) { const f32x4* xr = (const f32x4*)(a.xin32 + (size_t)(row0 + i) * DM) + 2 * lane + 128 * j; xf[XF32 ? i : 0][j][0] = xr[0]; xf[XF32 ? i : 0][j][1] = xr[1]; }
                else xb[XF32 ? 0 : i][j] = ((const u32x4*)(a.xin + (size_t)(row0 + i) * DM) + lane)[64 * j];
                p[i][j] = y0[64 * j]; if (MOE) q[MOE ? i : 0][j] = y1[64 * j]; } }
#pragma unroll
        for (int i = 0; i < NR; ++i)
#pragma unroll
            for (int j = 0; j < 2; ++j) {
                float x[8];
                if (XF32) {
#pragma unroll
                    for (int e = 0; e < 4; ++e) { x[e] = xf[XF32 ? i : 0][j][0][e]; x[4 + e] = xf[XF32 ? i : 0][j][1][e]; } }
                else { const u32x4 w = xb[XF32 ? 0 : i][j]; x[0] = bf_lo(w.x); x[1] = bf_hi(w.x); x[2] = bf_lo(w.y); x[3] = bf_hi(w.y); x[4] = bf_lo(w.z); x[5] = bf_hi(w.z); x[6] = bf_lo(w.w); x[7] = bf_hi(w.w); }
                const u32x4 pw = p[i][j]; const float py[8] = {bf_lo(pw.x), bf_hi(pw.x), bf_lo(pw.y), bf_hi(pw.y), bf_lo(pw.z), bf_hi(pw.z), bf_lo(pw.w), bf_hi(pw.w)};
                if (MOE) { const u32x4 qw = q[MOE ? i : 0][j]; const float qy[8] = {bf_lo(qw.x), bf_hi(qw.x), bf_lo(qw.y), bf_hi(qw.y), bf_lo(qw.z), bf_hi(qw.z), bf_lo(qw.w), bf_hi(qw.w)};
#pragma unroll
                    for (int e = 0; e < 8; ++e) v[i][j][e] = ALPHA * x[e] + w0[i] * py[e] + w1[i] * qy[e]; }
                else {
#pragma unroll
                    for (int e = 0; e < 8; ++e) v[i][j][e] = ALPHA * x[e] + py[e]; }
            }
    }
    float s[NR];
#pragma unroll
    for (int i = 0; i < NR; ++i) { s[i] = 0.f;
#pragma unroll
        for (int j = 0; j < 2; ++j)
#pragma unroll
            for (int e = 0; e < 8; ++e) s[i] += v[i][j][e]; }
#pragma unroll
    for (int o = 1; o < 64; o <<= 1)
#pragma unroll
        for (int i = 0; i < NR; ++i) s[i] += shx(s[i], o, lane);
    float q2[NR];
#pragma unroll
    for (int i = 0; i < NR; ++i) { const float mean = s[i] * (1.f / DM); q2[i] = 0.f;
#pragma unroll
        for (int j = 0; j < 2; ++j)
#pragma unroll
            for (int e = 0; e < 8; ++e) { v[i][j][e] -= mean; q2[i] += v[i][j][e] * v[i][j][e]; } }
#pragma unroll
    for (int o = 1; o < 64; o <<= 1)
#pragma unroll
        for (int i = 0; i < NR; ++i) q2[i] += shx(q2[i], o, lane);
    f32x4 gv[2][2], bv[2][2];
#pragma unroll
    for (int j = 0; j < 2; ++j) { const f32x4* gp = (const f32x4*)a.g + 2 * lane + 128 * j; const f32x4* bp = (const f32x4*)a.b + 2 * lane + 128 * j; gv[j][0] = gp[0]; gv[j][1] = gp[1]; bv[j][0] = bp[0]; bv[j][1] = bp[1]; }
#pragma unroll
    for (int i = 0; i < NR; ++i) { const float rstd = rsqrtf(q2[i] * (1.f / DM) + LN_EPS);
#pragma unroll
        for (int j = 0; j < 2; ++j) { float o[8];
#pragma unroll
            for (int e = 0; e < 8; ++e) o[e] = v[i][j][e] * rstd * gv[j][e >> 2][e & 3] + bv[j][e >> 2][e & 3];
            if (OUTF32) { f32x4* xo = (f32x4*)(a.xout32 + (size_t)(row0 + i) * DM) + 2 * lane + 128 * j; xo[0] = (f32x4){o[0], o[1], o[2], o[3]}; xo[1] = (f32x4){o[4], o[5], o[6], o[7]}; }
            else { u32x4 w; w.x = pk2(o[0], o[1]); w.y = pk2(o[2], o[3]); w.z = pk2(o[4], o[5]); w.w = pk2(o[6], o[7]); ((u32x4*)(a.xbf + (size_t)(row0 + i) * DM) + lane)[64 * j] = w; } } }
}
template <bool XF32, bool OUTF32, bool MOE>
__device__ __forceinline__ void ln_phase(const LnArgs& a, int blk, int G, int wave, int lane) {
    const int per = NT / G, r0 = blk * per, pw = per / NWAVE;
    for (int r = 0; r < pw; r += 4) ln_rows<4, XF32, OUTF32, MOE>(a, r0 + wave * pw + r, lane);
}
__device__ __forceinline__ void xattn_phase(LAS unsigned char* lds, const bf16_t* __restrict__ Q, const bf16_t* __restrict__ KC, const bf16_t* __restrict__ VT, bf16_t* __restrict__ O, int blk, int G) {
    const int tid0 = threadIdx.x, wave = __builtin_amdgcn_readfirstlane(tid0 >> 6);
#define XA_IDS int tid = tid0; asm volatile("" : "+v"(tid)); const int lane = tid & 63, r32 = lane & 31, hh = lane >> 5; const size_t qrow = (size_t)b * SEQ + qb * 256 + wave * 32 + r32; (void)lane; (void)hh; (void)qrow;
    for (int u = blk; u < 512; u += G) {
        const int qb = u & 15, h = (u >> 4) & 3, b = u >> 6;
        XA_IDS;
        bf16x8 qf[16];
#pragma unroll
        for (int ks = 0; ks < 16; ++ks) qf[ks] = *(const bf16x8*)(Q + qrow * 1024 + h * 256 + ks * 16 + hh * 8);
        __syncthreads();
#pragma unroll
        for (int bt = 0; bt < 2; ++bt) {
            u32x4 t[8];
#pragma unroll
            for (int i = 0; i < 8; ++i) { const int ch = tid + 512 * (bt * 8 + i), row = ch >> 5, c = ch & 31; t[i] = *(const u32x4*)(KC + (size_t)(b * 256 + row) * 1024 + h * 256 + c * 8); }
#pragma unroll
            for (int i = 0; i < 8; ++i) { const int ch = tid + 512 * (bt * 8 + i), row = ch >> 5, c = ch & 31; *(LAS u32x4*)(lds + row * 528 + c * 16) = t[i]; }
        }
        __syncthreads();
        f32x16 s[8];
#pragma unroll
        for (int mt = 0; mt < 8; ++mt)
#pragma unroll
            for (int r = 0; r < 16; ++r) s[mt][r] = 0.f;
        {   const LAS unsigned char* kbp = lds + r32 * 528 + hh * 16;
#pragma unroll
            for (int ks = 0; ks < 16; ++ks)
#pragma unroll
                for (int mt = 0; mt < 8; ++mt) { const bf16x8 a = *(const LAS bf16x8*)(kbp + mt * 32 * 528 + ks * 32); s[mt] = MFMA32(a, qf[ks], s[mt]); }
        }
        float mx = -INFINITY;
#pragma unroll
        for (int mt = 0; mt < 8; ++mt)
#pragma unroll
            for (int r = 0; r < 16; ++r) mx = fmaxf(mx, s[mt][r]);
        mx = xhalf_max(mx);
        float sm = 0.f; const float mxl = mx * LOG2E;
        u32x4 pf[8][2];
#pragma unroll
        for (int mt = 0; mt < 8; ++mt) {
#pragma unroll
            for (int r = 0; r < 16; ++r) { const float p = __builtin_amdgcn_exp2f(s[mt][r] * LOG2E - mxl); s[mt][r] = p; sm += p; }
#pragma unroll
            for (int sx = 0; sx < 2; ++sx) pf[mt][sx] = (u32x4){pk2(s[mt][8 * sx], s[mt][8 * sx + 1]), pk2(s[mt][8 * sx + 2], s[mt][8 * sx + 3]), pk2(s[mt][8 * sx + 4], s[mt][8 * sx + 5]), pk2(s[mt][8 * sx + 6], s[mt][8 * sx + 7])};
        }
        sm = xhalf_sum(sm);
        __syncthreads();
        {   XA_IDS;
#pragma unroll
        for (int bt = 0; bt < 4; ++bt) {
            u32x4 t[4];
#pragma unroll
            for (int i = 0; i < 4; ++i) { const int ch = tid + 512 * (bt * 4 + i), row = ch >> 5, c = ch & 31; t[i] = *(const u32x4*)(VT + (size_t)(h * 256 + row) * 2048 + b * 256 + c * 8); }
#pragma unroll
            for (int i = 0; i < 4; ++i) { const int ch = tid + 512 * (bt * 4 + i), row = ch >> 5, c = ch & 31; LAS u32x2* d = (LAS u32x2*)(lds + row * 520 + c * 16); d[0] = (u32x2){t[i].x, t[i].y}; d[1] = (u32x2){t[i].z, t[i].w}; }
        }
        }
        __syncthreads();
        {   XA_IDS;
        const float inv = 1.f / sm;
        bf16_t* orow = O + qrow * 1024 + h * 256 + 4 * hh;
#pragma unroll 1
        for (int dh = 0; dh < 2; ++dh) {
            f32x16 o[4];
#pragma unroll
            for (int dt = 0; dt < 4; ++dt)
#pragma unroll
                for (int r = 0; r < 16; ++r) o[dt][r] = 0.f;
            const LAS unsigned char* vb = lds + (dh * 128 + r32) * 520 + 8 * hh;
#pragma unroll
            for (int mt = 0; mt < 8; ++mt)
#pragma unroll
                for (int sx = 0; sx < 2; ++sx) { const int kb = mt * 32 + 16 * sx; const bf16x8 pb = __builtin_bit_cast(bf16x8, pf[mt][sx]);
#pragma unroll
                    for (int dt = 0; dt < 4; ++dt) { const LAS unsigned char* q = vb + dt * 32 * 520 + kb * 2;
                        const s16x4 lo = *(const LAS s16x4*)q, hi = *(const LAS s16x4*)(q + 16);
                        const bf16x8 a = (bf16x8){lo[0], lo[1], lo[2], lo[3], hi[0], hi[1], hi[2], hi[3]}; o[dt] = MFMA32(a, pb, o[dt]); } }
#pragma unroll
            for (int dt = 0; dt < 4; ++dt)
#pragma unroll
                for (int g = 0; g < 4; ++g) { u32x2 w; w.x = pk2(o[dt][4 * g] * inv, o[dt][4 * g + 1] * inv); w.y = pk2(o[dt][4 * g + 2] * inv, o[dt][4 * g + 3] * inv); *(u32x2*)(orow + dh * 128 + dt * 32 + 8 * g) = w; }
        }
        }
    }
#undef XA_IDS
}

struct RouteBufs { int* e; float* w; int* rank; int* dest; int* hist; int* tstart; int* src; };
__device__ __forceinline__ void moe_router_phase(LAS unsigned char* lds, const bf16_t* __restrict__ XBF, const bf16_t* __restrict__ WRT, const float* __restrict__ brg, const float* __restrict__ bre, const RouteBufs rb, int blk) {
    int tid_ = threadIdx.x; asm volatile("" : "+v"(tid_)); const int tid = tid_, lane = tid & 63, wave = __builtin_amdgcn_readfirstlane(tid >> 6), r32 = lane & 31, hh = lane >> 5;
    LAS unsigned char* XT = lds; LAS unsigned char* WT = lds + 128 * 528;
    LAS float* LG = (LAS float*)lds;
    LAS int* hist = (LAS int*)(lds + 128 * 65 * 4);
    const int rbk = wave & 3, ct = wave >> 2;
    f32x16 acc;
#pragma unroll
    for (int r = 0; r < 16; ++r) acc[r] = 0.f;
#pragma unroll 1
    for (int kc = 0; kc < 4; ++kc) {
        __syncthreads();
        {   u32x4 tx[8], tw[8];
#pragma unroll
            for (int i = 0; i < 8; ++i) { const int ch = tid + 512 * i, row = ch >> 5, c = ch & 31; tx[i] = *(const u32x4*)(XBF + (size_t)(blk * 128 + row) * 1024 + kc * 256 + c * 8); tw[i] = *(const u32x4*)(WRT + (size_t)row * 1024 + kc * 256 + c * 8); }
#pragma unroll
            for (int i = 0; i < 8; ++i) { const int ch = tid + 512 * i, row = ch >> 5, c = ch & 31; *(LAS u32x4*)(XT + row * 528 + c * 16) = tx[i]; *(LAS u32x4*)(WT + row * 528 + c * 16) = tw[i]; } }
        __syncthreads();
        const LAS unsigned char* ap = XT + (rbk * 32 + r32) * 528 + hh * 16; const LAS unsigned char* bp = WT + (ct * 32 + r32) * 528 + hh * 16;
#pragma unroll
        for (int ks = 0; ks < 16; ++ks) { const bf16x8 a = *(const LAS bf16x8*)(ap + ks * 32), b0 = *(const LAS bf16x8*)(bp + ks * 32), b1 = *(const LAS bf16x8*)(bp + 64 * 528 + ks * 32);
            acc = MFMA32(a, b0, acc); acc = MFMA32(a, b1, acc); }
    }
    __syncthreads();
    if (tid < 32) hist[tid] = 0;
#pragma unroll
    for (int r = 0; r < 16; ++r) LG[(rbk * 32 + crow(r, hh)) * 65 + ct * 32 + r32] = acc[r];
    __syncthreads();
    if (tid < 128) {
        const LAS float* lg = LG + tid * 65; const int tok = blk * 128 + tid;
        float g4[4];
#pragma unroll
        for (int g = 0; g < 4; ++g) g4[g] = lg[32 + g] + brg[g];
        int gi = 0; float gm = g4[0];
#pragma unroll
        for (int g = 1; g < 4; ++g) if (g4[g] > gm) { gm = g4[g]; gi = g; }
        float gs = 0.f;
#pragma unroll
        for (int g = 0; g < 4; ++g) gs += fast_exp(g4[g] - gm);
        const float gate_g = 1.f / gs;
        float le[8];
#pragma unroll
        for (int e = 0; e < 8; ++e) le[e] = lg[gi * 8 + e] + bre[gi * 8 + e];
        int i0 = 0; float v0 = le[0];
#pragma unroll
        for (int e = 1; e < 8; ++e) if (le[e] > v0) { v0 = le[e]; i0 = e; }
        int i1 = 0; float v1 = -INFINITY;
#pragma unroll
        for (int e = 0; e < 8; ++e) if (e != i0 && le[e] > v1) { v1 = le[e]; i1 = e; }
        const float e1 = fast_exp(v1 - v0), p0 = 1.f / (1.f + e1), p1 = e1 * p0;
        const int ex0 = gi * 8 + i0, ex1 = gi * 8 + i1;
        rb.e[tok * 2] = ex0; rb.e[tok * 2 + 1] = ex1; rb.w[tok * 2] = gate_g * p0; rb.w[tok * 2 + 1] = gate_g * p1;
        rb.rank[tok * 2] = atomicAdd((int*)&hist[ex0], 1); rb.rank[tok * 2 + 1] = atomicAdd((int*)&hist[ex1], 1);
    }
    __syncthreads();
    if (tid < 32) rb.hist[blk * 32 + tid] = hist[tid];
}
__device__ __forceinline__ void moe_scatter_phase(LAS unsigned char* lds, const RouteBufs rb, int blk, int G) {
    int tid_ = threadIdx.x; asm volatile("" : "+v"(tid_)); const int tid = tid_, lane = tid & 63, wave = __builtin_amdgcn_readfirstlane(tid >> 6);
    LAS int* sb = (LAS int*)lds;
    __syncthreads();
    {
        const int e = tid & 31, part = tid >> 5; int c[16];
#pragma unroll
        for (int i = 0; i < 16; ++i) c[i] = rb.hist[(part * 16 + i) * 32 + e];
        int tot = 0, base = 0;
#pragma unroll
        for (int i = 0; i < 16; ++i) { tot += c[i]; if (part * 16 + i < blk) base += c[i]; }
        sb[128 + part * 32 + e] = base; sb[128 + 512 + part * 32 + e] = tot; }
    __syncthreads();
    if (tid < 32) { int tot = 0, base = 0;
#pragma unroll
        for (int i = 0; i < 16; ++i) { base += sb[128 + i * 32 + tid]; tot += sb[128 + 512 + i * 32 + tid]; }
        sb[tid] = base; sb[32 + tid] = tot; }
    __syncthreads();
    if (tid == 0) { int acc = 0; for (int e = 0; e < 32; ++e) { sb[64 + e] = acc; if (blk == 0) rb.tstart[e] = acc >> 8; acc += (sb[32 + e] + 255) & ~255; } sb[96] = acc; if (blk == 0) rb.tstart[32] = acc >> 8; }
    __syncthreads();
    if (tid < 256) { const int idx = blk * 256 + tid; const int e = rb.e[idx]; const int d = sb[64 + e] + sb[e] + rb.rank[idx]; rb.dest[idx] = d; rb.src[d] = idx >> 1; }
    if (blk < 32) { const int e = blk; const int lo = sb[64 + e] + sb[32 + e], hi = sb[64 + e] + ((sb[32 + e] + 255) & ~255); for (int r = lo + tid; r < hi; r += NTHR) rb.src[r] = 0; }
}
struct MoeSched {
    const char* A; const char* B; const int* tstart; int K, nN, G, c; size_t bexp;
    __device__ __forceinline__ pg8::Unit get(int i, bool& ok) const { pg8::Unit u; u.A = nullptr; u.B = nullptr; u.src = nullptr; u.pm = 0; u.pn = 0; u.job = 0; ok = next(i, u); return u; }
    __device__ __forceinline__ bool next(int i, pg8::Unit& u) const {
        const int vc = (c & 7) * (G >> 3) + (c >> 3);
        const long L = (long)i * G + vc; const int ntile = tstart[32];
        if (L >= (long)ntile * nN) return false;
        const int mt = (int)(L / nN), nt = (int)(L % nN);
        int e = 0;
        for (int k = 1; k < 32; ++k) if (tstart[k] <= mt) e = k;
        u.A = A + (size_t)mt * 256 * K * 2; u.B = B + (size_t)e * bexp + (size_t)nt * 256 * K * 2; u.src = nullptr; u.pm = mt; u.pn = nt; u.job = 0; return true;
    }
};
__device__ __forceinline__ void swa_phase(LAS unsigned char* lds, const bf16_t* __restrict__ Q1, const bf16_t* __restrict__ K1, const bf16_t* __restrict__ VT1, const float* __restrict__ sinks, bf16_t* __restrict__ O, int blk, int G) {
    int tid_ = threadIdx.x; asm volatile("" : "+v"(tid_)); const int tid = tid_, lane = tid & 63, wave = __builtin_amdgcn_readfirstlane(tid >> 6), r32 = lane & 31, hh = lane >> 5;
    LAS unsigned char* KL = lds;
    LAS unsigned char* VL = lds + 36864;
    for (int u = blk; u < 1024; u += G) {
        const int n = u & 31, kvh = (u >> 5) & 3, b = u >> 7;
        const int tokb = b * SEQ + (n - 1) * 128;
        bf16x8 qfa[2][4];
        {   const int g0 = wave >> 1, hq0 = kvh * 4 + g0;
#pragma unroll
            for (int sb = 0; sb < 2; ++sb)
#pragma unroll
                for (int ks = 0; ks < 4; ++ks) qfa[sb][ks] = *(const bf16x8*)(Q1 + ((size_t)b * SEQ + n * 128 + (wave & 1) * 64 + sb * 32 + r32) * 1024 + hq0 * 64 + ks * 16 + hh * 8); }
        __syncthreads();
#pragma unroll
        for (int i = 0; i < 4; ++i) { const int ch = tid + 512 * i; const int key = ch >> 3, c = ch & 7;
            u32x4 v = (u32x4){0u, 0u, 0u, 0u}; if (n > 0 || key >= 128) v = *(const u32x4*)(K1 + (size_t)(tokb + key) * 256 + kvh * 64 + c * 8);
            *(LAS u32x4*)(KL + key * 144 + c * 16) = v; }
#pragma unroll
        for (int i = 0; i < 4; ++i) { const int ch = tid + 512 * i; const int d = ch >> 5, c = ch & 31;
            u32x4 v = (u32x4){0u, 0u, 0u, 0u}; if (n > 0 || c >= 16) v = *(const u32x4*)(VT1 + (size_t)(kvh * 64 + d) * NT + tokb + c * 8);
            LAS u32x2* dp = (LAS u32x2*)(VL + d * 520 + c * 16); dp[0] = (u32x2){v.x, v.y}; dp[1] = (u32x2){v.z, v.w}; }
        __syncthreads();
        const int g = wave >> 1, hq = kvh * 4 + g; const float sink = sinks[hq];
#pragma unroll 1
        for (int sb = 0; sb < 2; ++sb) {
            bf16x8 qf[4];
#pragma unroll
            for (int ks = 0; ks < 4; ++ks) qf[ks] = sb ? qfa[1][ks] : qfa[0][ks];
            const int i0 = (wave & 1) * 64 + sb * 32, jt0 = i0 >> 5;
            const size_t qtok = (size_t)b * SEQ + n * 128 + i0 + r32;
            f32x16 s[5];
#pragma unroll
            for (int t = 0; t < 5; ++t) {
#pragma unroll
                for (int r = 0; r < 16; ++r) s[t][r] = 0.f;
                const LAS unsigned char* kp = KL + ((jt0 + t) * 32 + r32) * 144 + hh * 16;
#pragma unroll
                for (int ks = 0; ks < 4; ++ks) { const bf16x8 a = *(const LAS bf16x8*)(kp + ks * 32); s[t] = MFMA32(a, qf[ks], s[t]); }
            }
            const int qi = i0 + r32;
            float mx = sink;
#pragma unroll
            for (int t = 0; t < 5; ++t)
#pragma unroll
                for (int r = 0; r < 16; ++r) { const int kj = (jt0 + t) * 32 + crow(r, hh); const bool valid = (kj > qi) && (kj <= qi + 128) && (n > 0 || kj >= 128);
                    s[t][r] = valid ? s[t][r] : -INFINITY; mx = fmaxf(mx, s[t][r]); }
            mx = xhalf_max(mx);
            float sm = 0.f; const float mxl = mx * LOG2E;
            u32x4 pf[5][2];
#pragma unroll
            for (int t = 0; t < 5; ++t) {
#pragma unroll
                for (int r = 0; r < 16; ++r) { const float pv = __builtin_amdgcn_exp2f(s[t][r] * LOG2E - mxl); s[t][r] = pv; sm += pv; }
#pragma unroll
                for (int sx = 0; sx < 2; ++sx) pf[t][sx] = (u32x4){pk2(s[t][8 * sx], s[t][8 * sx + 1]), pk2(s[t][8 * sx + 2], s[t][8 * sx + 3]), pk2(s[t][8 * sx + 4], s[t][8 * sx + 5]), pk2(s[t][8 * sx + 6], s[t][8 * sx + 7])};
            }
            sm = xhalf_sum(sm) + __builtin_amdgcn_exp2f(sink * LOG2E - mxl);
            f32x16 o[2];
#pragma unroll
            for (int dt = 0; dt < 2; ++dt)
#pragma unroll
                for (int r = 0; r < 16; ++r) o[dt][r] = 0.f;
#pragma unroll
            for (int t = 0; t < 5; ++t)
#pragma unroll
                for (int sx = 0; sx < 2; ++sx) { const bf16x8 pb = __builtin_bit_cast(bf16x8, pf[t][sx]);
#pragma unroll
                    for (int dt = 0; dt < 2; ++dt) { const LAS unsigned char* q = VL + (dt * 32 + r32) * 520 + ((jt0 + t) * 32 + 16 * sx + 4 * hh) * 2;
                        const s16x4 lo = *(const LAS s16x4*)q, hi = *(const LAS s16x4*)(q + 16);
                        const bf16x8 a = (bf16x8){lo[0], lo[1], lo[2], lo[3], hi[0], hi[1], hi[2], hi[3]}; o[dt] = MFMA32(a, pb, o[dt]); } }
            const float inv = 1.f / sm;
            bf16_t* orow = O + qtok * 1024 + hq * 64 + 4 * hh;
#pragma unroll
            for (int dt = 0; dt < 2; ++dt)
#pragma unroll
                for (int gq = 0; gq < 4; ++gq) { u32x2 w; w.x = pk2(o[dt][4 * gq] * inv, o[dt][4 * gq + 1] * inv); w.y = pk2(o[dt][4 * gq + 2] * inv, o[dt][4 * gq + 3] * inv); *(u32x2*)(orow + dt * 32 + 8 * gq) = w; }
        }
    }
}
constexpr int TS = 272;
template <int STRIDE = TS>
__device__ __forceinline__ bf16x8 tr_frag(const LAS unsigned char* T, int k0, int c0, int lane, bool permuted) {
    const int hh = lane >> 5, blk = (lane >> 4) & 1, q = (lane & 15) >> 2, pp = lane & 3;
    const int r0 = k0 + (permuted ? 4 * hh : 8 * hh) + q, r1 = r0 + (permuted ? 8 : 4);
    const int cb = (c0 + 16 * blk + 4 * pp) * 2;
    const s16x4 lo = lds_tr(T + r0 * STRIDE + cb), hi = lds_tr(T + r1 * STRIDE + cb);
    return (bf16x8){lo[0], lo[1], lo[2], lo[3], hi[0], hi[1], hi[2], hi[3]};
}
__device__ __forceinline__ bf16x8 row_frag(const LAS unsigned char* T, int row, int k0, int hh) { return *(const LAS bf16x8*)(T + row * TS + (k0 + 8 * hh) * 2); }
__device__ __forceinline__ void load_tile128(LAS unsigned char* T, const bf16_t* __restrict__ g, int ld, int tid) {
#pragma unroll
    for (int i = 0; i < 4; ++i) { const int ch = tid + 512 * i, row = ch >> 4, c = ch & 15; *(LAS u32x4*)(T + row * TS + c * 16) = *(const u32x4*)(g + (size_t)row * ld + c * 8); }
}
struct L0Bufs {
    bf16_t *AU, *AV, *BX, *BZ, *V, *XC, *YM, *CS, *Q, *K; float *U, *GT, *UN, *NS, *SC;
    const bf16_t *WQT, *GMW, *MT; const float *gm_g, *gm_b, *gm_bs, *cw, *cb, *bif, *nw, *skip;
};

__device__ __forceinline__ void l0_mixA(LAS unsigned char* lds, const L0Bufs& B, int blk, int G) {
    const int tid0 = threadIdx.x, wave = __builtin_amdgcn_readfirstlane(tid0 >> 6);
#define OPQ_IDS int tid = tid0; asm volatile("" : "+v"(tid)); const int lane = tid & 63, r32 = lane & 31, hh = lane >> 5; (void)lane; (void)r32; (void)hh;
    LAS unsigned char* T0 = lds; LAS unsigned char* T1 = lds + 34816; LAS unsigned char* T2 = lds + 2 * 34816; LAS unsigned char* T3 = lds + 3 * 34816;
    LAS float* SF = (LAS float*)T2;
    LAS float* SG = (LAS float*)(lds + 3 * 34816 + 35632);
    for (int u = blk; u < 256; u += G) {
        const int tok0 = u * 128; const bool first = (u & 31) == 0;
        constexpr int VS = 1040;
        {   OPQ_IDS; const int trow = tid >> 2, q4 = tid & 3;
            const bf16_t* vr = B.AV + (size_t)(tok0 + trow) * 512 + q4 * 128; float s = 0.f, s2 = 0.f; u32x4 w[16];
#pragma unroll
            for (int i = 0; i < 16; ++i) w[i] = *(const u32x4*)(vr + i * 8);
#pragma unroll
            for (int i = 0; i < 16; ++i) { const float f[8] = {bf_lo(w[i].x), bf_hi(w[i].x), bf_lo(w[i].y), bf_hi(w[i].y), bf_lo(w[i].z), bf_hi(w[i].z), bf_lo(w[i].w), bf_hi(w[i].w)};
#pragma unroll
                for (int e = 0; e < 8; ++e) { s += f[e]; s2 += f[e] * f[e]; } }
            s += shx(s, 1, lane); s += shx(s, 2, lane); s2 += shx(s2, 1, lane); s2 += shx(s2, 2, lane);
            const float mean = s * (1.f / 512.f), rstd = rsqrtf(fmaxf(s2 * (1.f / 512.f) - mean * mean, 0.f) + LN_EPS);
            __syncthreads();
#pragma unroll
            for (int i = 0; i < 16; ++i) { const int cbase = q4 * 128 + i * 8; const f32x4 g0 = *(const f32x4*)(B.gm_g + cbase), g1 = *(const f32x4*)(B.gm_g + cbase + 4), b0 = *(const f32x4*)(B.gm_b + cbase), b1 = *(const f32x4*)(B.gm_b + cbase + 4);
                u32x4 o; o.x = pk2((bf_lo(w[i].x) - mean) * rstd * g0[0] + b0[0], (bf_hi(w[i].x) - mean) * rstd * g0[1] + b0[1]); o.y = pk2((bf_lo(w[i].y) - mean) * rstd * g0[2] + b0[2], (bf_hi(w[i].y) - mean) * rstd * g0[3] + b0[3]);
                o.z = pk2((bf_lo(w[i].z) - mean) * rstd * g1[0] + b1[0], (bf_hi(w[i].z) - mean) * rstd * g1[1] + b1[1]); o.w = pk2((bf_lo(w[i].w) - mean) * rstd * g1[2] + b1[2], (bf_hi(w[i].w) - mean) * rstd * g1[3] + b1[3]);
                *(LAS u32x4*)(lds + trow * VS + cbase * 2) = o; asm volatile("" ::: "memory"); }
            __syncthreads();
        }
        {   const int tb = wave & 3, dhf = wave >> 2;
#pragma unroll 1
            for (int g = 0; g < 4; ++g) {
                OPQ_IDS; const int t = 32 * tb + r32; const size_t tok = (size_t)tok0 + t;
                f32x16 acc[2];
#pragma unroll
                for (int dt = 0; dt < 2; ++dt)
#pragma unroll
                    for (int r = 0; r < 16; ++r) acc[dt][r] = 0.f;
                const bf16_t* wrow = B.GMW + ((size_t)g * 128 + t) * 128 + 8 * hh;
                bf16x8 bw[8];
#pragma unroll
                for (int ks = 0; ks < 8; ++ks) bw[ks] = *(const bf16x8*)(wrow + 16 * ks);
#pragma unroll
                for (int ks = 0; ks < 8; ++ks) if (ks <= 2 * tb + 1) {
#pragma unroll
                    for (int dt = 0; dt < 2; ++dt) { const bf16x8 a = tr_frag<VS>(lds, 16 * ks, g * 128 + 64 * dhf + 32 * dt, lane, false); acc[dt] = MFMA32(a, bw[ks], acc[dt]); } }
                const float bsv = B.gm_bs[g * 128 + t];
#pragma unroll
                for (int dt = 0; dt < 2; ++dt)
#pragma unroll
                    for (int gq = 0; gq < 4; ++gq) { const int col = g * 128 + 64 * dhf + 32 * dt + 8 * gq + 4 * hh; const u32x2 au = *(const u32x2*)(B.AU + tok * 512 + col);
                        u32x2 w; w.x = pk2(bf_lo(au.x) * (acc[dt][4 * gq] + bsv), bf_hi(au.x) * (acc[dt][4 * gq + 1] + bsv)); w.y = pk2(bf_lo(au.y) * (acc[dt][4 * gq + 2] + bsv), bf_hi(au.y) * (acc[dt][4 * gq + 3] + bsv));
                        *(u32x2*)(B.YM + tok * 1024 + col) = w; }
            }
        }
        f32x16 accg;
#pragma unroll
        for (int r = 0; r < 16; ++r) accg[r] = 0.f;
        LAS unsigned char* MTL = (LAS unsigned char*)SG;
#pragma unroll 1
        for (int h = 0; h < 4; ++h) {
            OPQ_IDS;
            __syncthreads();
            for (int ch = tid; ch < 131 * 16; ch += 512) { const int row = ch >> 4, c = ch & 15; u32x4 v = (u32x4){0u, 0u, 0u, 0u};
                if (!(first && row < 3)) v = *(const u32x4*)(B.BX + (size_t)(tok0 - 3 + row) * 512 + h * 128 + c * 8);
                *(LAS u32x4*)(T3 + row * TS + c * 16) = v; }
            load_tile128(T0, B.WQT + ((size_t)0 * 4 + h) * 128 * 128, 128, tid);
            load_tile128(T1, B.WQT + ((size_t)1 * 4 + h) * 128 * 128, 128, tid);
            if (tid < 256) { const int row = tid >> 5, c = tid & 31; *(LAS u32x4*)(MTL + row * 528 + c * 16) = *(const u32x4*)(B.MT + ((size_t)h * 8 + row) * 256 + c * 8); }
            __syncthreads();
            {   const int dc = tid & 15, chn = h * 128 + dc * 8; float w[4][8], cbv[8];
#pragma unroll
                for (int j = 0; j < 4; ++j)
#pragma unroll
                    for (int e = 0; e < 8; ++e) w[j][e] = B.cw[j * 512 + chn + e];
#pragma unroll
                for (int e = 0; e < 8; ++e) cbv[e] = B.cb[chn + e];
#pragma unroll 1
                for (int ps = 0; ps < 4; ++ps) { const int t = ps * 32 + (tid >> 4); float a[8];
#pragma unroll
                    for (int e = 0; e < 8; ++e) a[e] = cbv[e];
#pragma unroll
                    for (int j = 0; j < 4; ++j) { const u32x4 x = *(const LAS u32x4*)(T3 + (t + j) * TS + dc * 16);
                        a[0] += w[j][0] * bf_lo(x.x); a[1] += w[j][1] * bf_hi(x.x); a[2] += w[j][2] * bf_lo(x.y); a[3] += w[j][3] * bf_hi(x.y);
                        a[4] += w[j][4] * bf_lo(x.z); a[5] += w[j][5] * bf_hi(x.z); a[6] += w[j][6] * bf_lo(x.w); a[7] += w[j][7] * bf_hi(x.w); }
                    u32x4 o; o.x = pk2(silu_f(a[0]), silu_f(a[1])); o.y = pk2(silu_f(a[2]), silu_f(a[3])); o.z = pk2(silu_f(a[4]), silu_f(a[5])); o.w = pk2(silu_f(a[6]), silu_f(a[7]));
                    *(LAS u32x4*)(T2 + t * TS + dc * 16) = o; *(u32x4*)(B.XC + (size_t)(tok0 + t) * 512 + chn) = o; } }
            __syncthreads();
            {   const int tb = wave & 3, ehf = wave >> 2;
                {
                    OPQ_IDS; const LAS unsigned char* act = ehf ? T3 + 3 * TS : T2;
#pragma unroll
                    for (int ks = 0; ks < 8; ++ks) { const bf16x8 a = *(const LAS bf16x8*)(MTL + (r32 & 7) * 528 + (ehf * 128 + 16 * ks + 8 * hh) * 2); const bf16x8 bx = row_frag(act, 32 * tb + r32, 16 * ks, hh); accg = MFMA32(a, bx, accg); } }
#pragma unroll 1
                for (int mtx = 0; mtx < 2; ++mtx) {
                    OPQ_IDS;
                    const LAS unsigned char* wt = mtx ? T1 : T0;
                    f32x16 acc[2];
#pragma unroll
                    for (int et = 0; et < 2; ++et)
#pragma unroll
                        for (int r = 0; r < 16; ++r) acc[et][r] = 0.f;
#pragma unroll
                    for (int ks = 0; ks < 8; ++ks) { const bf16x8 bx = row_frag(T2, 32 * tb + r32, 16 * ks, hh);
#pragma unroll
                        for (int et = 0; et < 2; ++et) { const bf16x8 a = row_frag(wt, 64 * ehf + 32 * et + r32, 16 * ks, hh); acc[et] = MFMA32(a, bx, acc[et]); } }
                    bf16_t* dst = (mtx == 0 ? B.Q : B.K) + (size_t)(tok0 + 32 * tb + r32) * 512 + h * 128 + 64 * ehf + 4 * hh;
#pragma unroll
                    for (int et = 0; et < 2; ++et)
#pragma unroll
                        for (int gq = 0; gq < 4; ++gq) { u32x2 w; w.x = pk2(acc[et][4 * gq], acc[et][4 * gq + 1]); w.y = pk2(acc[et][4 * gq + 2], acc[et][4 * gq + 3]); *(u32x2*)(dst + 32 * et + 8 * gq) = w; }
                }
            }
            __syncthreads();
            load_tile128(T0, B.WQT + ((size_t)2 * 4 + h) * 128 * 128, 128, tid);
            __syncthreads();
            {   OPQ_IDS; const int tb = wave & 3, ehf = wave >> 2;
                f32x16 acc[2];
#pragma unroll
                for (int et = 0; et < 2; ++et)
#pragma unroll
                    for (int r = 0; r < 16; ++r) acc[et][r] = 0.f;
#pragma unroll
                for (int ks = 0; ks < 8; ++ks) { const bf16x8 bx = row_frag(T3 + 3 * TS, 32 * tb + r32, 16 * ks, hh);
#pragma unroll
                    for (int et = 0; et < 2; ++et) { const bf16x8 a = row_frag(T0, 64 * ehf + 32 * et + r32, 16 * ks, hh); acc[et] = MFMA32(a, bx, acc[et]); } }
                bf16_t* dst = B.V + (size_t)(tok0 + 32 * tb + r32) * 512 + h * 128 + 64 * ehf + 4 * hh;
#pragma unroll
                for (int et = 0; et < 2; ++et)
#pragma unroll
                    for (int gq = 0; gq < 4; ++gq) { u32x2 w; w.x = pk2(acc[et][4 * gq], acc[et][4 * gq + 1]); w.y = pk2(acc[et][4 * gq + 2], acc[et][4 * gq + 3]); *(u32x2*)(dst + 32 * et + 8 * gq) = w; }
            }
        }
        __syncthreads();
        {   OPQ_IDS; const int tb = wave & 3, kh = wave >> 2;
#pragma unroll
            for (int r = 0; r < 4; ++r) SF[(kh * 8 + r + 4 * hh) * 128 + 32 * tb + r32] = accg[r];
        }
        __syncthreads();
        LAS float* IG = SG; LAS float* BC = SG + 512; LAS float* WG = SG + 1024;
        if (wave < 4) {
            OPQ_IDS; const int h = wave; float lf[2], ig[2];
#pragma unroll
            for (int e = 0; e < 2; ++e) { const int t = 2 * lane + e; ig[e] = SF[h * 128 + t] + SF[(8 + h) * 128 + t] + B.bif[h];
                const float fx = SF[(4 + h) * 128 + t] + SF[(12 + h) * 128 + t] + B.bif[4 + h]; lf[e] = fminf(fx, 0.f) - log1pf(expf(-fabsf(fx))); }
            float run = lf[0] + lf[1];
#pragma unroll
            for (int o = 1; o < 64; o <<= 1) { const float v = shup(run, o, lane); if (lane >= o) run += v; }
            const float b1 = run, b0 = run - lf[1];
            IG[h * 128 + 2 * lane] = ig[0]; IG[h * 128 + 2 * lane + 1] = ig[1]; BC[h * 128 + 2 * lane] = b0; BC[h * 128 + 2 * lane + 1] = b1;
            float* gt = B.GT + ((size_t)u * 4 + h) * 256;
            gt[2 * lane] = ig[0]; gt[2 * lane + 1] = ig[1]; gt[128 + 2 * lane] = b0; gt[128 + 2 * lane + 1] = b1;
            const float bl = shidx(b1, 63);
            float g0 = bl - b0 + ig[0], g1 = bl - b1 + ig[1]; float mloc = fmaxf(g0, g1);
#pragma unroll
            for (int o = 1; o < 64; o <<= 1) mloc = fmaxf(mloc, shx(mloc, o, lane));
            WG[h * 128 + 2 * lane] = expf(g0 - mloc); WG[h * 128 + 2 * lane + 1] = expf(g1 - mloc);
            if (lane == 0) { B.SC[u * 4 + h] = bl; B.SC[1024 + u * 4 + h] = mloc; }
        }
#pragma unroll 1
        for (int h = 0; h < 4; ++h) {
            OPQ_IDS;
            __syncthreads();
#pragma unroll
            for (int i = 0; i < 4; ++i) { const int ch = tid + 512 * i, row = ch >> 4, c = ch & 15; const float wg = WG[h * 128 + row];
                const u32x4 v = *(const u32x4*)(B.V + (size_t)(tok0 + row) * 512 + h * 128 + c * 8), k = *(const u32x4*)(B.K + (size_t)(tok0 + row) * 512 + h * 128 + c * 8);
                u32x4 ov, ok; const float ksc = 0.08838834764831845f;
                ov.x = pk2(bf_lo(v.x) * wg, bf_hi(v.x) * wg); ov.y = pk2(bf_lo(v.y) * wg, bf_hi(v.y) * wg); ov.z = pk2(bf_lo(v.z) * wg, bf_hi(v.z) * wg); ov.w = pk2(bf_lo(v.w) * wg, bf_hi(v.w) * wg);
                ok.x = pk2(bf_lo(k.x) * ksc, bf_hi(k.x) * ksc); ok.y = pk2(bf_lo(k.y) * ksc, bf_hi(k.y) * ksc); ok.z = pk2(bf_lo(k.z) * ksc, bf_hi(k.z) * ksc); ok.w = pk2(bf_lo(k.w) * ksc, bf_hi(k.w) * ksc);
                *(LAS u32x4*)(T0 + row * TS + c * 16) = ov; *(LAS u32x4*)(T1 + row * TS + c * 16) = ok; }
            __syncthreads();
            const int vb = wave & 3, khf = wave >> 2;
            f32x16 acc[2];
#pragma unroll
            for (int kt = 0; kt < 2; ++kt)
#pragma unroll
                for (int r = 0; r < 16; ++r) acc[kt][r] = 0.f;
#pragma unroll
            for (int ks = 0; ks < 8; ++ks) { const bf16x8 a = tr_frag(T0, 16 * ks, 32 * vb, lane, false);
#pragma unroll
                for (int kt = 0; kt < 2; ++kt) { const bf16x8 bk = tr_frag(T1, 16 * ks, 64 * khf + 32 * kt, lane, false); acc[kt] = MFMA32(a, bk, acc[kt]); } }
            float* Uo = B.U + ((size_t)u * 4 + h) * 16384;
#pragma unroll
            for (int kt = 0; kt < 2; ++kt)
#pragma unroll
                for (int r = 0; r < 16; ++r) Uo[(32 * vb + crow(r, hh)) * 128 + 64 * khf + 32 * kt + r32] = acc[kt][r];
            {   const int kk = tid & 127, sq = tid >> 7; float a = 0.f;
                for (int s = sq * 32; s < sq * 32 + 32; ++s) a += WG[h * 128 + s] * bf2f(*(const LAS bf16_t*)(T1 + s * TS + kk * 2));
                SF[2048 + sq * 128 + kk] = a; }
            __syncthreads();
            if (tid < 128) B.UN[((size_t)u * 4 + h) * 128 + tid] = (SF[2048 + tid] + SF[2048 + 128 + tid]) + (SF[2048 + 256 + tid] + SF[2048 + 384 + tid]);
        }
    }
}
#undef OPQ_IDS
__device__ __forceinline__ void l0_scan(const L0Bufs& B, int blk, int tid) {
    const int bh = blk >> 3, part = blk & 7, b = bh >> 2, h = bh & 3;
    const int e0 = part * 2048 + tid * 8;
    f32x4 C0 = (f32x4){0.f, 0.f, 0.f, 0.f}, C1 = C0; float nst = 0.f; float m = 0.f;
    const int unit0 = (b * 32) * 4 + h;
    f32x4 Un0 = *(const f32x4*)(B.U + (size_t)unit0 * 16384 + e0), Un1 = *(const f32x4*)(B.U + (size_t)unit0 * 16384 + e0 + 4); float bln = B.SC[unit0], mln = B.SC[1024 + unit0];
    float unn = (part == 0 && tid < 128) ? B.UN[(size_t)unit0 * 128 + tid] : 0.f;
    for (int c = 0; c < 32; ++c) {
        const int unit = unit0 + 4 * c;
        const f32x4 U0 = Un0, U1 = Un1; const float bl = bln, mloc = mln, un = unn;
        if (c < 31) { const int un1 = unit + 4; Un0 = *(const f32x4*)(B.U + (size_t)un1 * 16384 + e0); Un1 = *(const f32x4*)(B.U + (size_t)un1 * 16384 + e0 + 4); bln = B.SC[un1]; mln = B.SC[1024 + un1]; if (part == 0 && tid < 128) unn = B.UN[(size_t)un1 * 128 + tid]; }
        u32x4 w; w.x = pk2(C0[0], C0[1]); w.y = pk2(C0[2], C0[3]); w.z = pk2(C1[0], C1[1]); w.w = pk2(C1[2], C1[3]); *(u32x4*)(B.CS + (size_t)unit * 16384 + e0) = w;
        if (part == 0 && tid < 128) B.NS[(size_t)unit * 128 + tid] = nst;
        if (part == 0 && tid == 0) B.SC[2048 + unit] = m;
        const float mn = fmaxf(bl + m, mloc), dec = expf(bl + m - mn), wu = expf(mloc - mn); m = mn;
        C0 = C0 * dec + U0 * wu; C1 = C1 * dec + U1 * wu;
        nst = nst * dec + wu * un;
    }
}
__device__ __forceinline__ void l0_mixC(LAS unsigned char* lds, const L0Bufs& B, int blk, int G) {
    const int tid0 = threadIdx.x, wave = __builtin_amdgcn_readfirstlane(tid0 >> 6);
    LAS unsigned char* TQ = lds; LAS unsigned char* TK = lds + 34816; LAS unsigned char* TV = lds + 2 * 34816; LAS unsigned char* TC = lds + 3 * 34816;
    LAS float* SF = (LAS float*)(lds + 4 * 34816);
    LAS float* AS = SF; LAS float* PM = SF + 128; LAS float* NP = SF + 256; LAS float* PS = SF + 384; LAS float* PQ = SF + 640; LAS float* NW = SF + 896;
    __syncthreads();
    { int tq = tid0; asm volatile("" : "+v"(tq)); if (tq < 256) ((LAS f32x4*)NW)[tq] = tq < 128 ? ((const f32x4*)B.nw)[tq] : ((const f32x4*)B.skip)[tq - 128]; }
    for (int uu = blk; uu < 256; uu += G) {
        const int tok0 = uu * 128;
#pragma unroll 1
        for (int h = 0; h < 4; ++h) {
            const int unit = uu * 4 + h;
            int tid = tid0; asm volatile("" : "+v"(tid));
            const int lane = tid & 63, r32 = lane & 31, hh = lane >> 5;
            __syncthreads();
            load_tile128(TQ, B.Q + (size_t)tok0 * 512 + h * 128, 512, tid);
            load_tile128(TV, B.V + (size_t)tok0 * 512 + h * 128, 512, tid);
            load_tile128(TC, B.CS + (size_t)unit * 16384, 128, tid);
#pragma unroll
            for (int i = 0; i < 4; ++i) { const int ch = tid + 512 * i, row = ch >> 4, c = ch & 15; const u32x4 k = *(const u32x4*)(B.K + (size_t)(tok0 + row) * 512 + h * 128 + c * 8); const float ksc = 0.08838834764831845f;
                u32x4 ok; ok.x = pk2(bf_lo(k.x) * ksc, bf_hi(k.x) * ksc); ok.y = pk2(bf_lo(k.y) * ksc, bf_hi(k.y) * ksc); ok.z = pk2(bf_lo(k.z) * ksc, bf_hi(k.z) * ksc); ok.w = pk2(bf_lo(k.w) * ksc, bf_hi(k.w) * ksc);
                *(LAS u32x4*)(TK + row * TS + c * 16) = ok; }
            const float mprev = B.SC[2048 + unit];
            if (wave == 0) {
                const float* gt = B.GT + (size_t)unit * 256;
                const float a0 = gt[2 * lane] - gt[128 + 2 * lane], a1 = gt[2 * lane + 1] - gt[128 + 2 * lane + 1];
                float run = fmaxf(a0, a1);
#pragma unroll
                for (int o = 1; o < 64; o <<= 1) { const float v = shup(run, o, lane); if (lane >= o) run = fmaxf(run, v); }
                const float prev = shup(run, 1, lane); const float p0 = fmaxf(lane > 0 ? fmaxf(prev, a0) : a0, mprev), p1 = fmaxf(run, mprev);
                AS[2 * lane] = a0; AS[2 * lane + 1] = a1; PM[2 * lane] = p0; PM[2 * lane + 1] = p1;
            }
            if (wave == 1) { NP[lane] = B.NS[(size_t)unit * 128 + lane]; NP[64 + lane] = B.NS[(size_t)unit * 128 + 64 + lane]; }
            __syncthreads();
            const int tb = wave & 3, vh = wave >> 2, t = 32 * tb + r32;
            const float pm = PM[t], bt = B.GT[(size_t)unit * 256 + 128 + t];
            f32x16 s[4];
#pragma unroll
            for (int st = 0; st < 4; ++st)
#pragma unroll
                for (int r = 0; r < 16; ++r) s[st][r] = 0.f;
            {   int lv = lane; asm volatile("" : "+v"(lv));
                const LAS unsigned char* qp = TQ + (32 * tb + (lv & 31)) * TS + (lv >> 5) * 16; const LAS unsigned char* kp = TK + (lv & 31) * TS + (lv >> 5) * 16;
#pragma unroll 2
                for (int ks = 0; ks < 8; ++ks) { const bf16x8 bq = *(const LAS bf16x8*)(qp + ks * 32);
#pragma unroll
                    for (int st = 0; st < 4; ++st) if (st <= tb) { const bf16x8 a = *(const LAS bf16x8*)(kp + st * 32 * TS + ks * 32); s[st] = MFMA32(a, bq, s[st]); } } }
            float nq = 0.f; u32x4 pf[4][2];
#pragma unroll
            for (int st = 0; st < 4; ++st) {
#pragma unroll
                for (int r = 0; r < 16; ++r) { const int sidx = 32 * st + crow(r, hh); const float wv = (sidx <= t) ? __builtin_amdgcn_exp2f((AS[sidx] - pm) * LOG2E) : 0.f; const float pv = s[st][r] * wv; s[st][r] = pv; nq += pv; }
#pragma unroll
                for (int sx = 0; sx < 2; ++sx) pf[st][sx] = (u32x4){pk2(s[st][8 * sx], s[st][8 * sx + 1]), pk2(s[st][8 * sx + 2], s[st][8 * sx + 3]), pk2(s[st][8 * sx + 4], s[st][8 * sx + 5]), pk2(s[st][8 * sx + 6], s[st][8 * sx + 7])};
            }
            nq = xhalf_sum(nq);
            float nqi = 0.f;
#pragma unroll
            for (int i = 0; i < 8; ++i) { const u32x4 qv = *(const LAS u32x4*)(TQ + t * TS + (64 * hh + 8 * i) * 2); const LAS float* np = NP + 64 * hh + 8 * i;
                nqi += bf_lo(qv.x) * np[0] + bf_hi(qv.x) * np[1] + bf_lo(qv.y) * np[2] + bf_hi(qv.y) * np[3] + bf_lo(qv.z) * np[4] + bf_hi(qv.z) * np[5] + bf_lo(qv.w) * np[6] + bf_hi(qv.w) * np[7]; }
            nqi = xhalf_sum(nqi);
            const float wst = __builtin_amdgcn_exp2f((mprev - pm) * LOG2E);
            const float den = fmaxf(fabsf(nq + wst * nqi), __builtin_amdgcn_exp2f(-(bt + pm) * LOG2E)), rden = 1.f / den;
            f32x16 ni[2], nx[2];
#pragma unroll
            for (int vt = 0; vt < 2; ++vt)
#pragma unroll
                for (int r = 0; r < 16; ++r) { ni[vt][r] = 0.f; nx[vt][r] = 0.f; }
            {   int lv = lane; asm volatile("" : "+v"(lv));
#pragma unroll
                for (int st = 0; st < 4; ++st) {
                    if (st <= tb) {
#pragma unroll
                        for (int sx = 0; sx < 2; ++sx) { const bf16x8 pb = __builtin_bit_cast(bf16x8, pf[st][sx]);
#pragma unroll
                            for (int vt = 0; vt < 2; ++vt) { const bf16x8 a = tr_frag(TV, 32 * st + 16 * sx, 64 * vh + 32 * vt, lv, true); ni[vt] = MFMA32(a, pb, ni[vt]); } }
                    }
                } }
            {   int lv = lane; asm volatile("" : "+v"(lv));
                const LAS unsigned char* qp = TQ + (32 * tb + (lv & 31)) * TS + (lv >> 5) * 16; const LAS unsigned char* cp = TC + (64 * vh + (lv & 31)) * TS + (lv >> 5) * 16;
#pragma unroll 2
                for (int ks = 0; ks < 8; ++ks) { const bf16x8 bq = *(const LAS bf16x8*)(qp + ks * 32);
#pragma unroll
                    for (int vt = 0; vt < 2; ++vt) { const bf16x8 a = *(const LAS bf16x8*)(cp + vt * 32 * TS + ks * 32); nx[vt] = MFMA32(a, bq, nx[vt]); } } }
            const size_t tok = (size_t)tok0 + t;
            u32x2 xcv[2][4], zv[2][4];
#pragma unroll
            for (int vt = 0; vt < 2; ++vt)
#pragma unroll
                for (int gq = 0; gq < 4; ++gq) { const int chn = h * 128 + 64 * vh + 32 * vt + 8 * gq + 4 * hh; xcv[vt][gq] = *(const u32x2*)(B.XC + tok * 512 + chn); zv[vt][gq] = *(const u32x2*)(B.BZ + tok * 512 + chn); }
            float hs = 0.f, hq = 0.f;
#pragma unroll
            for (int vt = 0; vt < 2; ++vt)
#pragma unroll
                for (int r = 0; r < 16; ++r) { const float hv = (ni[vt][r] + wst * nx[vt][r]) * rden; ni[vt][r] = hv; hs += hv; hq += hv * hv; }
            hs = xhalf_sum(hs); hq = xhalf_sum(hq);
            if (hh == 0) { PS[vh * 128 + t] = hs; PQ[vh * 128 + t] = hq; }
            __syncthreads();
            const float mean = (PS[t] + PS[128 + t]) * (1.f / 128.f);
            const float rstd = rsqrtf(fmaxf((PQ[t] + PQ[128 + t]) * (1.f / 128.f) - mean * mean, 0.f) + LN_EPS);
#pragma unroll
            for (int vt = 0; vt < 2; ++vt)
#pragma unroll
                for (int gq = 0; gq < 4; ++gq) { const int cl = 64 * vh + 32 * vt + 8 * gq + 4 * hh, chn = h * 128 + cl;
                    const f32x4 nw = *(const LAS f32x4*)(NW + chn), sk = *(const LAS f32x4*)(NW + 512 + chn); const u32x2 xc = xcv[vt][gq], z = zv[vt][gq];
                    const float y0 = ((ni[vt][4 * gq] - mean) * rstd * nw[0] + sk[0] * bf_lo(xc.x)) * silu_f(bf_lo(z.x)), y1 = ((ni[vt][4 * gq + 1] - mean) * rstd * nw[1] + sk[1] * bf_hi(xc.x)) * silu_f(bf_hi(z.x));
                    const float y2 = ((ni[vt][4 * gq + 2] - mean) * rstd * nw[2] + sk[2] * bf_lo(xc.y)) * silu_f(bf_lo(z.y)), y3 = ((ni[vt][4 * gq + 3] - mean) * rstd * nw[3] + sk[3] * bf_hi(xc.y)) * silu_f(bf_hi(z.y));
                    u32x2 w; w.x = pk2(y0, y1); w.y = pk2(y2, y3); *(u32x2*)(B.YM + tok * 1024 + 512 + chn) = w; }
        }
    }
}
constexpr size_t MB = 1048576ull;
constexpr size_t P_WIN_T = 0, P_WOUT_T = P_WIN_T + 4 * MB, P_WQKV_T = P_WOUT_T + 2 * MB, P_WO_T = P_WQKV_T + 3 * MB, P_XWQ_T = P_WO_T + 2 * MB, P_XWKV_T = P_XWQ_T + 4 * MB, P_XWO_T = P_XWKV_T + 8 * MB,
                 P_MLW_T = P_XWO_T + 4 * MB, P_WIFT = P_MLW_T + MB / 2, P_WRT = P_WIFT + MB / 8, P_ROT = P_WRT + MB / 2, P_BQK = P_ROT + MB, P_MEMB = P_BQK + MB / 8, P_KC = P_MEMB + 4 * MB, P_VT = P_KC + 8 * MB,
                 P_W13T = P_VT + 8 * MB, P_W2T = P_W13T + 64 * MB, P_XBF = P_W2T + 32 * MB, P_RT = P_XBF + 64 * MB, P_TMP = P_RT + 2 * MB;
constexpr size_t RT_SRC = 1638400;
constexpr size_t RT_E = 0, RT_W = 262144, RT_RANK = 2 * 262144, RT_DEST = 3 * 262144, RT_HIST = 4 * 262144, RT_TSTART = RT_HIST + 32768;
constexpr size_t T_QX = 0, T_OB = 64 * MB, T_YB = 128 * MB;
constexpr size_t T_K1 = 192 * MB, T_VT1 = 208 * MB;
constexpr size_t T_AU = 0, T_AV = 32 * MB, T_BX = 64 * MB, T_BZ = 96 * MB, T_V = 128 * MB, T_XC = 160 * MB, T_YM = 192 * MB, T_U = 256 * MB, T_CS = 320 * MB,
                 T_GT = 352 * MB, T_UN = 353 * MB, T_NS = 353 * MB + MB / 2, T_SC = 354 * MB, T_YB0 = 0;
constexpr size_t T_XG = 0, T_HM = 152 * MB, T_YG = 0;
constexpr size_t FAST_END = P_TMP + 360 * MB;
constexpr int LDS_BYTES = 147456;

struct FP {
    const float* in[33]; float* X;
    unsigned char* ws;
};
typedef const float* const __attribute__((address_space(4)))* InTab;
struct PV { InTab in; float* X; unsigned char* ws; };
__device__ __forceinline__ PV make_pv(const FP& p0) {
    PV p; InTab kp = (InTab)__builtin_amdgcn_kernarg_segment_ptr(); asm volatile("" : "+s"(kp)); p.in = kp;
    p.X = p0.X; p.ws = p0.ws; asm volatile("" : "+s"(p.ws)); return p;
}
#define WSP(T, off) ((T*)(p.ws + (off)))

__device__ __forceinline__ RouteBufs route_bufs(const PV& p) {
    RouteBufs r; r.e = WSP(int, P_RT + RT_E); r.w = WSP(float, P_RT + RT_W); r.rank = WSP(int, P_RT + RT_RANK); r.dest = WSP(int, P_RT + RT_DEST); r.hist = WSP(int, P_RT + RT_HIST); r.tstart = WSP(int, P_RT + RT_TSTART); r.src = WSP(int, P_RT + RT_SRC); return r;
}
#define PH_ARGS const PV& p, LAS unsigned char* lds, int blk, int G
#define PH_IDS int tid_ = threadIdx.x; asm volatile("" : "+v"(tid_)); const int tid = tid_, lane = tid & 63, wave = __builtin_amdgcn_readfirstlane(tid >> 6); (void)lane; (void)wave;

__device__ __forceinline__ void ph_conv_xattn(PH_ARGS, int l) {
    PH_IDS; LAS float* scr = (LAS float*)(lds + wave * 8448); const int gw = blk * NWAVE + wave, ngw = G * NWAVE;
    convert_mats(p.in[23] + (size_t)l * 1024 * 1024, 1024, 1024, 1, 0, WSP(bf16_t, P_XWQ_T) + (size_t)l * 1024 * 1024, 0, RM_IDENT, 0.0625f, 1024, scr, gw, ngw, lane);
    convert_mats(p.in[24] + (size_t)l * 1024 * 2048, 1024, 2048, 1, 0, WSP(bf16_t, P_XWKV_T) + (size_t)l * 2048 * 1024, 0, RM_IDENT, 1.f, 0, scr, gw, ngw, lane);
    convert_mats(p.in[25] + (size_t)l * 1024 * 1024, 1024, 1024, 1, 0, WSP(bf16_t, P_XWO_T) + (size_t)l * 1024 * 1024, 0, RM_IDENT, 1.f, 0, scr, gw, ngw, lane);
    convert_rows(p.in[1], WSP(bf16_t, P_MEMB), (size_t)2048 * 1024, blk * NTHR + tid, G * NTHR);
}
__device__ __forceinline__ void conv_moe_waves(const PV& p, int l, LAS float* scr, int gw, int ngw, int gt, int ngt, int lane) {
    const size_t wl = (size_t)l * 32 * 1024 * 512;
    convert_mats(p.in[30] + wl, 1024, 512, 32, (size_t)1024 * 512, WSP(bf16_t, P_W13T), (size_t)1024 * 1024, RM_PAIR0, 1.f, 0, scr, gw, ngw, lane);
    convert_mats(p.in[31] + wl, 1024, 512, 32, (size_t)1024 * 512, WSP(bf16_t, P_W13T), (size_t)1024 * 1024, RM_PAIR1, 1.f, 0, scr, gw, ngw, lane);
    convert_mats(p.in[32] + wl, 512, 1024, 32, (size_t)512 * 1024, WSP(bf16_t, P_W2T), (size_t)1024 * 512, RM_IDENT, 1.f, 0, scr, gw, ngw, lane);
    bf16_t* wrt = WSP(bf16_t, P_WRT) + (size_t)l * 2 * 64 * 1024; const float* wre = p.in[28] + (size_t)l * 1024 * 32; const float* wrg = p.in[26] + (size_t)l * 1024 * 4;
    for (int i = gt; i < 64 * 1024; i += ngt) { const int r = i >> 10, k = i & 1023;
        const float v = r < 32 ? wre[k * 32 + r] : (r < 36 ? wrg[k * 4 + (r - 32)] : 0.f);
        const bf16_t h = f2bf(v); wrt[i] = h; wrt[64 * 1024 + i] = f2bf(v - bf2f(h)); }
}
__device__ __forceinline__ void ph_conv_moe(PH_ARGS, int l) {
    PH_IDS; conv_moe_waves(p, l, (LAS float*)(lds + wave * 8448), blk * NWAVE + wave, G * NWAVE, blk * NTHR + tid, G * NTHR, lane);
}
__device__ __forceinline__ void ph_x_to_bf(PH_ARGS) { PH_IDS; convert_rows(p.X, WSP(bf16_t, P_XBF), (size_t)NT * 1024, blk * NTHR + tid, G * NTHR); }

__device__ __forceinline__ void set_job(LAS pg8::JobDesc* jt, int j, const void* A, const void* B, int nM, int nN, void* out, int ldc, int mode, const void* bias = nullptr, const void* rot = nullptr, void* out2 = nullptr) {
    unsigned long long a = (unsigned long long)A, b = (unsigned long long)B, o = (unsigned long long)out, bi = (unsigned long long)bias, ro = (unsigned long long)rot, o2 = (unsigned long long)out2;
    asm volatile("" : "+s"(a), "+s"(b), "+s"(o), "+s"(bi), "+s"(ro), "+s"(o2), "+s"(nM), "+s"(nN), "+s"(ldc), "+s"(mode));
    LAS pg8::JobDesc* d = jt + j; d->A = a; d->B = b; d->out = o; d->bias = bi; d->rot = ro; d->out2 = o2;
    d->nM = nM; d->nN = nN; d->ldc = ldc; d->mode = mode;
}
#define JT_PTR ((LAS pg8::JobDesc*)(lds + pg8::JT_OFF))
__device__ __forceinline__ void run_jobs(LAS unsigned char* lds, int K, int n0, int n1, int n2, int blk, int G) {
    __syncthreads();
    pg8::Jobs3 S; S.jt = JT_PTR; S.n0 = n0; S.n1 = n1; S.n2 = n2; S.K = K; S.G = G; S.c = blk;
    EpiMulti E; E.jt = JT_PTR;
    pg8::gemm_phase<EpiMulti, pg8::Jobs3, true, true>(lds, K, S, E);
}
__device__ __forceinline__ void ph_xattn_g1(PH_ARGS, int l) {
    const bf16_t* wkv = WSP(bf16_t, P_XWKV_T) + (size_t)l * 2048 * 1024;
    __syncthreads();
    if (threadIdx.x == 0) {
        set_job(JT_PTR, 0, WSP(bf16_t, P_MEMB), wkv, 8, 4, WSP(bf16_t, P_KC) + (size_t)l * 2048 * 1024, 1024, EM_PLAIN);
        set_job(JT_PTR, 1, wkv + (size_t)1024 * 1024, WSP(bf16_t, P_MEMB), 4, 8, WSP(bf16_t, P_VT) + (size_t)l * 1024 * 2048, 2048, EM_PLAIN);
        set_job(JT_PTR, 2, WSP(bf16_t, P_XBF), WSP(bf16_t, P_XWQ_T) + (size_t)l * 1024 * 1024, 128, 4, WSP(bf16_t, P_TMP + T_QX), 1024, EM_PLAIN);
    }
    run_jobs(lds, 1024, 32, 32, 512, blk, G);
}
__device__ __forceinline__ void ph_xattn_attn(PH_ARGS, int l) {
    xattn_phase(lds, WSP(bf16_t, P_TMP + T_QX), WSP(bf16_t, P_KC) + (size_t)l * 2048 * 1024, WSP(bf16_t, P_VT) + (size_t)l * 1024 * 2048, WSP(bf16_t, P_TMP + T_OB), blk, G);
}
__device__ __forceinline__ void ph_gemm_plain(PH_ARGS, const bf16_t* A, const bf16_t* Bt, bf16_t* out) {
    __syncthreads();
    if (threadIdx.x == 0) set_job(JT_PTR, 0, A, Bt, 128, 4, out, 1024, EM_PLAIN);
    run_jobs(lds, 1024, 512, 0, 0, blk, G);
}
template <bool XF32, bool OUTF32, bool MOE>
__device__ __forceinline__ void ph_ln(PH_ARGS, const bf16_t* y, int lnidx, bool dry = false) {
    PH_IDS; LnArgs a; a.xin32 = p.in[0]; a.xin = WSP(bf16_t, P_XBF); a.xout32 = dry ? WSP(float, P_TMP + 200 * MB) : p.X; a.xbf = dry ? WSP(bf16_t, P_TMP + 288 * MB) : WSP(bf16_t, P_XBF); a.y = y; a.g = p.in[2] + lnidx * 1024; a.b = p.in[3] + lnidx * 1024;
    a.dest = WSP(int, P_RT + RT_DEST); a.wts = WSP(float, P_RT + RT_W);
    ln_phase<XF32, OUTF32, MOE>(a, blk, G, wave, lane);
}
__device__ __forceinline__ void ph_moe_route(PH_ARGS, int l) {
    moe_router_phase(lds, WSP(bf16_t, P_XBF), WSP(bf16_t, P_WRT) + (size_t)l * 2 * 64 * 1024, p.in[27] + l * 4, p.in[29] + l * 32, route_bufs(p), blk);
}
__device__ __forceinline__ void ph_moe_scatter(PH_ARGS) { moe_scatter_phase(lds, route_bufs(p), blk, G); }
__device__ __forceinline__ void ph_moe_g1(PH_ARGS) {
    __syncthreads();
    if (threadIdx.x == 0) set_job(JT_PTR, 0, nullptr, nullptr, 0, 0, WSP(bf16_t, P_TMP + T_HM), 512, EM_SWIGLU);
    __syncthreads();
    MoeSched S; S.A = (const char*)WSP(bf16_t, P_TMP + T_XG); S.B = (const char*)WSP(bf16_t, P_W13T); S.tstart = WSP(int, P_RT + RT_TSTART); S.K = 1024; S.nN = 4; S.G = G; S.c = blk; S.bexp = (size_t)1024 * 1024 * 2;
    EpiMulti E; E.jt = JT_PTR;
    pg8::gemm_phase<EpiMulti, MoeSched, true, true>(lds, 1024, S, E);
}
__device__ __forceinline__ void ph_moe_g2(PH_ARGS) {
    __syncthreads();
    if (threadIdx.x == 0) set_job(JT_PTR, 0, nullptr, nullptr, 0, 0, WSP(bf16_t, P_TMP + T_YG), 1024, EM_PLAIN);
    __syncthreads();
    MoeSched S; S.A = (const char*)WSP(bf16_t, P_TMP + T_HM); S.B = (const char*)WSP(bf16_t, P_W2T); S.tstart = WSP(int, P_RT + RT_TSTART); S.K = 512; S.nN = 4; S.G = G; S.c = blk; S.bexp = (size_t)1024 * 512 * 2;
    EpiMulti E; E.jt = JT_PTR;
    pg8::gemm_phase<EpiMulti, MoeSched, true, true>(lds, 512, S, E);
}

__device__ __forceinline__ void ph_conv_l1(PH_ARGS) {
    PH_IDS; LAS float* scr = (LAS float*)(lds + wave * 8448); const int gw = blk * NWAVE + wave, ngw = G * NWAVE;
    convert_mats(p.in[19], 1024, 1536, 1, 0, WSP(bf16_t, P_WQKV_T), 0, RM_ROT, 0.125f, 1024, scr, gw, ngw, lane);
    convert_mats(p.in[22], 1024, 1024, 1, 0, WSP(bf16_t, P_WO_T), 0, RM_IDENT, 1.f, 0, scr, gw, ngw, lane);
    const int gt = blk * NTHR + tid, ngt = G * NTHR;
    float* bqk = WSP(float, P_BQK);
    for (int n = gt; n < 1280; n += ngt) bqk[rowmap(RM_ROT, n)] = p.in[20][n] * (n < 1024 ? 0.125f : 1.f);
    float* rot = WSP(float, P_ROT);
    for (int i = gt; i < 4096 * 32; i += ngt) { const int pos = i >> 5, k = i & 31; const float inv = powf(10000.f, -(float)(2 * k) / 64.f); const float ang = (float)pos * inv; rot[2 * i] = cosf(ang); rot[2 * i + 1] = sinf(ang); }
}
__device__ __forceinline__ void ph_l1_g1(PH_ARGS) {
    __syncthreads();
    if (threadIdx.x == 0) {
        set_job(JT_PTR, 0, WSP(bf16_t, P_XBF), WSP(bf16_t, P_WQKV_T), 128, 5, WSP(bf16_t, P_TMP + T_QX), 1024, EM_ROTARY, WSP(float, P_BQK), WSP(float, P_ROT), WSP(bf16_t, P_TMP + T_K1));
        set_job(JT_PTR, 1, WSP(bf16_t, P_WQKV_T) + (size_t)1280 * 1024, WSP(bf16_t, P_XBF), 1, 128, WSP(bf16_t, P_TMP + T_VT1), NT, EM_ROWBIAS, p.in[20] + 1280);
    }
    run_jobs(lds, 1024, 640, 128, 0, blk, G);
}
__device__ __forceinline__ void ph_l1_swa(PH_ARGS) {
    swa_phase(lds, WSP(bf16_t, P_TMP + T_QX), WSP(bf16_t, P_TMP + T_K1), WSP(bf16_t, P_TMP + T_VT1), p.in[21], WSP(bf16_t, P_TMP + T_OB), blk, G);
}

__device__ __forceinline__ L0Bufs l0_bufs(const PV& p) {
    L0Bufs B; B.AU = WSP(bf16_t, P_TMP + T_AU); B.AV = WSP(bf16_t, P_TMP + T_AV); B.BX = WSP(bf16_t, P_TMP + T_BX); B.BZ = WSP(bf16_t, P_TMP + T_BZ); B.V = WSP(bf16_t, P_TMP + T_V); B.XC = WSP(bf16_t, P_TMP + T_XC);
    B.YM = WSP(bf16_t, P_TMP + T_YM); B.CS = WSP(bf16_t, P_TMP + T_CS); B.U = WSP(float, P_TMP + T_U); B.GT = WSP(float, P_TMP + T_GT); B.UN = WSP(float, P_TMP + T_UN); B.NS = WSP(float, P_TMP + T_NS); B.SC = WSP(float, P_TMP + T_SC);
    B.Q = WSP(bf16_t, P_XBF); B.K = WSP(bf16_t, P_XBF) + (size_t)NT * 512;
    B.WQT = WSP(bf16_t, P_MLW_T); B.GMW = WSP(bf16_t, P_MLW_T) + 12 * 16384; B.MT = WSP(bf16_t, P_WIFT);
    B.gm_g = p.in[5]; B.gm_b = p.in[6]; B.gm_bs = p.in[8]; B.cw = p.in[9]; B.cb = p.in[10]; B.bif = p.in[15]; B.nw = p.in[16]; B.skip = p.in[17]; return B;
}
__device__ __forceinline__ void ph_scan_conv(PH_ARGS) {
    PH_IDS;
    if (wave < 4) l0_scan(l0_bufs(p), blk, tid);
}
__device__ __forceinline__ void ph_conv_l0(PH_ARGS) {
    PH_IDS; LAS float* scr = (LAS float*)(lds + wave * 8448); const int gw = blk * NWAVE + wave, ngw = G * NWAVE;
    convert_mats(p.in[4], 1024, 2048, 1, 0, WSP(bf16_t, P_WIN_T), 0, RM_IDENT, 1.f, 0, scr, gw, ngw, lane);
    convert_mats(p.in[18], 1024, 1024, 1, 0, WSP(bf16_t, P_WOUT_T), 0, RM_IDENT, 1.f, 0, scr, gw, ngw, lane);
    convert_mats(p.in[11], 128, 128, 4, 16384, WSP(bf16_t, P_MLW_T), 16384, RM_IDENT, 1.f, 0, scr, gw, ngw, lane);
    convert_mats(p.in[12], 128, 128, 4, 16384, WSP(bf16_t, P_MLW_T) + 4 * 16384, 16384, RM_IDENT, 1.f, 0, scr, gw, ngw, lane);
    convert_mats(p.in[13], 128, 128, 4, 16384, WSP(bf16_t, P_MLW_T) + 8 * 16384, 16384, RM_IDENT, 1.f, 0, scr, gw, ngw, lane);
    const int gt = blk * NTHR + tid, ngt = G * NTHR;
    bf16_t* gmw = WSP(bf16_t, P_MLW_T) + 12 * 16384;
    for (int i = gt; i < 4 * 16384; i += ngt) { const int t = (i >> 7) & 127, sidx = i & 127; gmw[i] = f2bf(sidx <= t ? p.in[7][i] : 0.f); }
    bf16_t* mt = WSP(bf16_t, P_WIFT);
    for (int i = gt; i < 4 * 8 * 256; i += ngt) { const int h = i >> 11, g = (i >> 8) & 7, j = i & 255, d = j & 127; float a = 0.f;
        if (j < 128) { for (int e = 0; e < 128; ++e) a += p.in[11][((size_t)h * 128 + d) * 128 + e] * p.in[14][(h * 128 + e) * 8 + g] + p.in[12][((size_t)h * 128 + d) * 128 + e] * p.in[14][(512 + h * 128 + e) * 8 + g]; }
        else { for (int e = 0; e < 128; ++e) a += p.in[13][((size_t)h * 128 + d) * 128 + e] * p.in[14][(1024 + h * 128 + e) * 8 + g]; }
        mt[i] = f2bf(a); }
}
__device__ __forceinline__ void ph_xin_to_bf(PH_ARGS) { PH_IDS; convert_rows(p.in[0], WSP(bf16_t, P_XBF), (size_t)NT * 1024, blk * NTHR + tid, G * NTHR); }
__device__ __forceinline__ void ph_l0_g1(PH_ARGS) {
    __syncthreads();
    if (threadIdx.x == 0) set_job(JT_PTR, 0, WSP(bf16_t, P_XBF), WSP(bf16_t, P_WIN_T), 128, 8, WSP(bf16_t, P_TMP + T_AU), 512, EM_GELU4);
    run_jobs(lds, 1024, 1024, 0, 0, blk, G);
}

enum { K_CONV_XATTN = 0, K_CONV_MOE, K_X2BF, K_XATTN_G1, K_XATTN_ATTN, K_XATTN_G2, K_LN_Y, K_MOE_ROUTE, K_MOE_SCATTER, K_MOE_G1, K_MOE_G2, K_LN_MOE, K_CONV_L1, K_L1_G1, K_L1_SWA, K_L1_G2, K_CONV_L0, K_XIN2BF, K_L0_G1, K_L0_MIXA, K_L0_SCAN, K_L0_MIXC, K_L0_G2, K_LN_Y0 };
template <int PH>
__global__ void __launch_bounds__(NTHR, 2) k_phase(FP p0, int l, int lnidx) {
    const PV p = make_pv(p0);
    extern __shared__ __attribute__((aligned(16))) unsigned char smem[];
    LAS unsigned char* lds = (LAS unsigned char*)smem;
    const int blk = blockIdx.x, G = gridDim.x;
    if constexpr (PH == K_CONV_XATTN) ph_conv_xattn(p, lds, blk, G, l);
    if constexpr (PH == K_CONV_MOE) ph_conv_moe(p, lds, blk, G, l);
    if constexpr (PH == K_X2BF) ph_x_to_bf(p, lds, blk, G);
    if constexpr (PH == K_XATTN_G1) ph_xattn_g1(p, lds, blk, G, l);
    if constexpr (PH == K_XATTN_ATTN) ph_xattn_attn(p, lds, blk, G, l);
    if constexpr (PH == K_XATTN_G2) ph_gemm_plain(p, lds, blk, G, WSP(bf16_t, P_TMP + T_OB), WSP(bf16_t, P_XWO_T) + (size_t)l * 1024 * 1024, WSP(bf16_t, P_TMP + T_YB));
    if constexpr (PH == K_LN_Y) ph_ln<false, false, false>(p, lds, blk, G, WSP(bf16_t, P_TMP + T_YB), lnidx);
    if constexpr (PH == K_MOE_ROUTE) ph_moe_route(p, lds, blk, G, l);
    if constexpr (PH == K_MOE_SCATTER) ph_moe_scatter(p, lds, blk, G);
    if constexpr (PH == K_MOE_G1) ph_moe_g1(p, lds, blk, G);
    if constexpr (PH == K_MOE_G2) ph_moe_g2(p, lds, blk, G);
    if constexpr (PH == K_LN_MOE) ph_ln<false, false, true>(p, lds, blk, G, WSP(bf16_t, P_TMP + T_YG), lnidx);
    if constexpr (PH == K_CONV_L0) ph_conv_l0(p, lds, blk, G);
    if constexpr (PH == K_XIN2BF) ph_xin_to_bf(p, lds, blk, G);
    if constexpr (PH == K_L0_G1) ph_l0_g1(p, lds, blk, G);
    if constexpr (PH == K_L0_MIXA) l0_mixA(lds, l0_bufs(p), blk, G);
    if constexpr (PH == K_L0_SCAN) ph_scan_conv(p, lds, blk, G);
    if constexpr (PH == K_L0_MIXC) l0_mixC(lds, l0_bufs(p), blk, G);
    if constexpr (PH == K_L0_G2) ph_gemm_plain(p, lds, blk, G, WSP(bf16_t, P_TMP + T_YM), WSP(bf16_t, P_WOUT_T), WSP(bf16_t, P_TMP + T_YB0));
    if constexpr (PH == K_LN_Y0) ph_ln<true, false, false>(p, lds, blk, G, WSP(bf16_t, P_TMP + T_YB0), 0);
    if constexpr (PH == K_CONV_L1) ph_conv_l1(p, lds, blk, G);
    if constexpr (PH == K_L1_G1) ph_l1_g1(p, lds, blk, G);
    if constexpr (PH == K_L1_SWA) ph_l1_swa(p, lds, blk, G);
    if constexpr (PH == K_L1_G2) ph_gemm_plain(p, lds, blk, G, WSP(bf16_t, P_TMP + T_OB), WSP(bf16_t, P_WO_T), WSP(bf16_t, P_TMP + T_YB));
}

#define XB_TMO      128
#define XB_XCNT(j)  (256  + 64 * (j))
#define XB_XSUB(j)  (1280 + 64 * (j))
#define XB_XGEN(j)  (2304 + 64 * (j))
#define XB_TOP      3328
#define XB_TOPGEN   3392
#define XCD_BAR_WORDS 3456
#define XB_SPIN_CAP (1u << 22)
__device__ __forceinline__ unsigned xb_ld(unsigned* p)              { return __hip_atomic_load(p, __ATOMIC_RELAXED, __HIP_MEMORY_SCOPE_AGENT); }
__device__ __forceinline__ unsigned xb_add(unsigned* p, unsigned v) { return __hip_atomic_fetch_add(p, v, __ATOMIC_RELAXED, __HIP_MEMORY_SCOPE_AGENT); }
__device__ __forceinline__ unsigned xb_xcc_id() { return (unsigned)__builtin_amdgcn_s_getreg((3 << 11) | 20) & 0xFu; }
#define XB_SPIN(cond, bar) do { unsigned _sp = 0; while (cond) { __builtin_amdgcn_s_sleep(1); \
    if ((++_sp & 255u) == 0u) { if (xb_ld(&(bar)[XB_TMO])) break; if (_sp > XB_SPIN_CAP) { atomicAdd(&(bar)[XB_TMO], 1u); break; } } } } while (0)
struct XcdBarrier { unsigned* bar; unsigned x; volatile LAS unsigned* st; };
__device__ __forceinline__ XcdBarrier xcd_barrier_post(unsigned* bar, volatile LAS unsigned* st) {
    XcdBarrier b; b.bar = bar; b.x = xb_xcc_id(); b.st = st;
    if (threadIdx.x == 0) (void)xb_add(&bar[XB_XCNT(b.x)], 1u);
    return b;
}
__device__ __forceinline__ void xcd_barrier_complete(unsigned* bar, unsigned x, unsigned& nloc, unsigned& nx) {
    const unsigned G = gridDim.x * gridDim.y * gridDim.z;
    unsigned sum, cnt, mine, sp = 0u;
    for (;;) {
        sum = 0u; cnt = 0u; mine = 0u;
#pragma unroll
        for (unsigned j = 0; j < 16; ++j) { const unsigned c = xb_ld(&bar[XB_XCNT(j)]); sum += c; cnt += (c > 0u) ? 1u : 0u; mine = (j == x) ? c : mine; }
        if (sum == G) break;
        __builtin_amdgcn_s_sleep(1);
        if ((++sp & 255u) == 0u) { if (xb_ld(&bar[XB_TMO])) break; if (sp > XB_SPIN_CAP) { atomicAdd(&bar[XB_TMO], 1u); break; } }
    }
    nloc = mine > 0u ? mine : 1u; nx = cnt > 0u ? cnt : 1u;
}
__device__ __forceinline__ void xcd_barrier(const XcdBarrier& b) {
    asm volatile("s_waitcnt vmcnt(0)" ::: "memory");
    __syncthreads();
    if (threadIdx.x == 0) {
        unsigned* bar = b.bar; asm volatile("" : "+s"(bar));
        __builtin_amdgcn_s_waitcnt(0);
        unsigned nloc = b.st[0], nx = b.st[1];
        if (nloc == 0u) { xcd_barrier_complete(bar, b.x, nloc, nx); b.st[0] = nloc; b.st[1] = nx; }
        const unsigned old = xb_add(&bar[XB_XSUB(b.x)], 1u);
        const unsigned gen = old / nloc;
        if (old + 1u == (gen + 1u) * nloc) {
            __builtin_amdgcn_fence(__ATOMIC_RELEASE, "agent");
            asm volatile("s_waitcnt vmcnt(0)" ::: "memory");
            const unsigned og = xb_add(&bar[XB_TOP], 1u);
            const unsigned tg = og / nx;
            if (og + 1u == (tg + 1u) * nx) xb_add(&bar[XB_TOPGEN], 1u);
            else XB_SPIN(xb_ld(&bar[XB_TOPGEN]) == tg, bar);
            __builtin_amdgcn_fence(__ATOMIC_ACQUIRE, "agent");
            xb_add(&bar[XB_XGEN(b.x)], 1u);
            asm volatile("s_waitcnt vmcnt(0)" ::: "memory");
        } else {
            XB_SPIN(xb_ld(&bar[XB_XGEN(b.x)]) == gen, bar);
            __builtin_amdgcn_fence(__ATOMIC_ACQUIRE, "agent");
            asm volatile("s_waitcnt vmcnt(0)" ::: "memory");
        }
    }
    __syncthreads();
}
constexpr size_t P_BAR = P_RT + 1572864;
constexpr int LDS_BARW = LDS_BYTES - 16;

struct SchedAll {
    const LAS pg8::JobDesc* jt; int n0, n1, n2, n3, n4; int K, G, c; int moe; const char* A; const char* B; const int* tstart; const int* src; int nN; size_t bexp;
    __device__ __forceinline__ pg8::Unit get(int i, bool& ok) const {
        const char* ua = nullptr; const char* ub = nullptr; const int* us = nullptr; int upm = 0, upn = 0, ujob = 0; bool good = false;
        if (moe) {
            const int vc = (c & 7) * (G >> 3) + (c >> 3);
            const long L = (long)i * G + vc; const int ntile = tstart[32];
            if (L < (long)ntile * nN) {
                const int mt = (int)(L / nN), nt = (int)(L % nN);
                int e = 0;
                for (int k = 1; k < 32; ++k) if (tstart[k] <= mt) e = k;
                ua = src ? A : A + (size_t)mt * 256 * K * 2; us = src ? src + mt * 256 : nullptr; ub = B + (size_t)e * bexp + (size_t)nt * 256 * K * 2; upm = mt; upn = nt; good = true;
            }
        } else {
            long L = (long)i * G + c;
            if (L < (long)n0 + n1 + n2 + n3 + n4) {
                int l = (int)L; int jb = 0;
                if (l >= n0) { l -= n0; jb = 1; if (l >= n1) { l -= n1; jb = 2; if (l >= n2) { l -= n2; jb = 3; if (l >= n3) { l -= n3; jb = 4; } } } }
                const int jM = __builtin_amdgcn_readfirstlane(jt[jb].nM), jN = __builtin_amdgcn_readfirstlane(jt[jb].nN);
                int pm, pn; pg8::tile_order(l, jM, jN, pm, pn);
                const size_t tstep = (size_t)pg8::BM * K * 2;
                ua = (const char*)pg8::rfl64(jt[jb].A) + (size_t)pm * tstep; ub = (const char*)pg8::rfl64(jt[jb].B) + (size_t)pn * tstep; upm = pm; upn = pn; ujob = jb; good = true;
            }
        }
        pg8::Unit u; u.A = ua; u.B = ub; u.src = us; u.pm = upm; u.pn = upn; u.job = ujob; ok = good; return u;
    }
};
enum { MP_CONV = 0, MP_L0_G1, MP_L0_MIXA, MP_L0_SCAN, MP_L0_MIXC, MP_L0_G2, MP_LN0, MP_XA_G1, MP_XA_ATTN, MP_XA_G2, MP_LN_ROUTE, MP_SCATTER, MP_MOE_G1, MP_MOE_G2, MP_LN_MOE, MP_L1_G1, MP_L1_SWA, MP_L1_G2, MP_LN3 };
__device__ __forceinline__ int prog_kind(int i) {
    switch (i) { case 0: return MP_CONV; case 1: return MP_L0_G1; case 2: return MP_L0_MIXA; case 3: return MP_L0_SCAN; case 4: return MP_L0_MIXC; case 5: return MP_L0_G2; case 6: return MP_LN0;
        case 7: case 19: return MP_XA_G1; case 8: case 20: return MP_XA_ATTN; case 9: case 21: return MP_XA_G2; case 10: case 22: return MP_LN_ROUTE; case 11: case 23: return MP_SCATTER;
        case 12: case 24: return MP_MOE_G1; case 13: case 25: return MP_MOE_G2; case 14: case 26: return MP_LN_MOE; case 15: return MP_L1_G1; case 16: return MP_L1_SWA; case 17: return MP_L1_G2; default: return MP_LN3; }
}
constexpr int N_PROG = 27;
__global__ void __launch_bounds__(NTHR, 2) mega(FP p0) {
    extern __shared__ __attribute__((aligned(16))) unsigned char smem[];
    LAS unsigned char* lds = (LAS unsigned char*)smem;
    cooperative_groups::grid_group grid = cooperative_groups::this_grid();
    const int blk0 = blockIdx.x, G0 = gridDim.x;
    volatile LAS unsigned* bst = (volatile LAS unsigned*)(lds + LDS_BARW);
    if (threadIdx.x == 0) { bst[0] = 0u; bst[1] = 0u; }
    __syncthreads();
    const XcdBarrier xbar = xcd_barrier_post((unsigned*)(p0.ws + P_BAR), bst);
    int dup = 0; (void)dup;
#pragma unroll 1
    for (int pi = 0; pi < N_PROG; ++pi) {
        int blk = blk0, G = G0; asm volatile("" : "+s"(blk), "+s"(G));
        const PV p = make_pv(p0);
        const int kind = prog_kind(pi), l = pi >= 15 ? 1 : 0;
        const bool is_gemm = kind == MP_L0_G1 || kind == MP_L0_G2 || kind == MP_XA_G1 || kind == MP_XA_G2 || kind == MP_MOE_G1 || kind == MP_MOE_G2 || kind == MP_L1_G1 || kind == MP_L1_G2;
        if (is_gemm) {
            SchedAll S; S.jt = JT_PTR; S.n0 = S.n1 = S.n2 = S.n3 = S.n4 = 0; S.K = 1024; S.G = G; S.c = blk; S.moe = 0; S.A = S.B = nullptr; S.tstart = WSP(int, P_RT + RT_TSTART); S.src = nullptr; S.nN = 4; S.bexp = 0;
            __syncthreads();
            if (threadIdx.x == 0) {
                if (kind == MP_L0_G1) set_job(JT_PTR, 0, WSP(bf16_t, P_XBF), WSP(bf16_t, P_WIN_T), 128, 8, WSP(bf16_t, P_TMP + T_AU), 512, EM_GELU4);
                if (kind == MP_L0_G2) set_job(JT_PTR, 0, WSP(bf16_t, P_TMP + T_YM), WSP(bf16_t, P_WOUT_T), 128, 4, WSP(bf16_t, P_TMP + T_YB0), 1024, EM_PLAIN);
                if (kind == MP_XA_G1) {
                    set_job(JT_PTR, 0, WSP(bf16_t, P_XBF), WSP(bf16_t, P_XWQ_T) + (size_t)l * 1024 * 1024, 128, 4, WSP(bf16_t, P_TMP + T_QX), 1024, EM_PLAIN);
                    if (l == 0) { for (int ll = 0; ll < 2; ++ll) { const bf16_t* wkv = WSP(bf16_t, P_XWKV_T) + (size_t)ll * 2048 * 1024;
                        set_job(JT_PTR, 1 + 2 * ll, WSP(bf16_t, P_MEMB), wkv, 8, 4, WSP(bf16_t, P_KC) + (size_t)ll * 2048 * 1024, 1024, EM_PLAIN);
                        set_job(JT_PTR, 2 + 2 * ll, wkv + (size_t)1024 * 1024, WSP(bf16_t, P_MEMB), 4, 8, WSP(bf16_t, P_VT) + (size_t)ll * 1024 * 2048, 2048, EM_PLAIN); } } }
                if (kind == MP_XA_G2) set_job(JT_PTR, 0, WSP(bf16_t, P_TMP + T_OB), WSP(bf16_t, P_XWO_T) + (size_t)l * 1024 * 1024, 128, 4, WSP(bf16_t, P_TMP + T_YB), 1024, EM_PLAIN);
                if (kind == MP_MOE_G1) set_job(JT_PTR, 0, nullptr, nullptr, 0, 0, WSP(bf16_t, P_TMP + T_HM), 512, EM_SWIGLU);
                if (kind == MP_MOE_G2) set_job(JT_PTR, 0, nullptr, nullptr, 0, 0, WSP(bf16_t, P_TMP + T_YG), 1024, EM_PLAIN);
                if (kind == MP_L1_G1) { set_job(JT_PTR, 0, WSP(bf16_t, P_XBF), WSP(bf16_t, P_WQKV_T), 128, 5, WSP(bf16_t, P_TMP + T_QX), 1024, EM_ROTARY, WSP(float, P_BQK), WSP(float, P_ROT), WSP(bf16_t, P_TMP + T_K1));
                    set_job(JT_PTR, 1, WSP(bf16_t, P_WQKV_T) + (size_t)1280 * 1024, WSP(bf16_t, P_XBF), 1, 128, WSP(bf16_t, P_TMP + T_VT1), NT, EM_ROWBIAS, p.in[20] + 1280); }
                if (kind == MP_L1_G2) set_job(JT_PTR, 0, WSP(bf16_t, P_TMP + T_OB), WSP(bf16_t, P_WO_T), 128, 4, WSP(bf16_t, P_TMP + T_YB), 1024, EM_PLAIN);
            }
            if (kind == MP_L0_G1) S.n0 = 1024;
            if (kind == MP_L0_G2 || kind == MP_XA_G2 || kind == MP_L1_G2) S.n0 = 512;
            if (kind == MP_XA_G1) { S.n0 = 512; if (l == 0) { S.n1 = 32; S.n2 = 32; S.n3 = 32; S.n4 = 32; } }
            if (kind == MP_L1_G1) { S.n0 = 640; S.n1 = 128; }
            if (kind == MP_MOE_G1) { S.moe = 1; S.A = (const char*)WSP(bf16_t, P_XBF); S.src = WSP(int, P_RT + RT_SRC); S.B = (const char*)WSP(bf16_t, P_W13T); S.bexp = (size_t)1024 * 1024 * 2; }
            if (kind == MP_MOE_G2) { S.moe = 1; S.K = 512; S.A = (const char*)WSP(bf16_t, P_TMP + T_HM); S.B = (const char*)WSP(bf16_t, P_W2T); S.bexp = (size_t)1024 * 512 * 2; }
            __syncthreads();
            EpiMulti E; E.jt = JT_PTR;
#ifdef PROBE_GEMM2
#pragma unroll 1
            for (int rep = 0; rep < 2; ++rep)
#endif
            pg8::gemm_phase<EpiMulti, SchedAll, true, true>(lds, S.K, S, E);
        } else {
#ifdef PROBE_MASK
#define DRY (dup == 0 && (((PROBE_MASK) >> kind) & 1))
#else
#define DRY false
#endif
            switch (kind) {
                case MP_CONV: ph_conv_l0(p, lds, blk, G); ph_conv_l1(p, lds, blk, G); ph_conv_xattn(p, lds, blk, G, 0); ph_conv_xattn(p, lds, blk, G, 1); ph_conv_moe(p, lds, blk, G, 0); ph_xin_to_bf(p, lds, blk, G); break;
                case MP_L0_MIXA: l0_mixA(lds, l0_bufs(p), blk, G); break;
                case MP_L0_SCAN: ph_scan_conv(p, lds, blk, G); break;
                case MP_L0_MIXC: l0_mixC(lds, l0_bufs(p), blk, G); break;
                case MP_LN0: ph_ln<true, false, false>(p, lds, blk, G, WSP(bf16_t, P_TMP + T_YB0), 0, DRY); break;
                case MP_XA_ATTN: ph_xattn_attn(p, lds, blk, G, l); break;
                case MP_LN_ROUTE: ph_ln<false, false, false>(p, lds, blk, G, WSP(bf16_t, P_TMP + T_YB), l * 3 + 1, DRY); __syncthreads(); ph_moe_route(p, lds, blk, G, l); break;
                case MP_SCATTER: ph_moe_scatter(p, lds, blk, G); break;
                case MP_LN_MOE: if (l == 0) { ph_ln<false, false, true>(p, lds, blk, G, WSP(bf16_t, P_TMP + T_YG), 2, DRY); if (!(DRY)) ph_conv_moe(p, lds, blk, G, 1); } else ph_ln<false, true, true>(p, lds, blk, G, WSP(bf16_t, P_TMP + T_YG), 5, DRY); break;
                case MP_L1_SWA: ph_l1_swa(p, lds, blk, G); break;
                default: ph_ln<false, false, false>(p, lds, blk, G, WSP(bf16_t, P_TMP + T_YB), 3, DRY); break;
            }
        }
#ifdef PROBE_MASK
        if (((PROBE_MASK) >> kind) & 1) { if (dup == 0) { dup = 1; xcd_barrier(xbar); --pi; continue; } dup = 0; }
#endif
        if (pi + 1 < N_PROG) { if (p0.ws == nullptr) grid.sync(); else { xcd_barrier(xbar);
#ifdef PROBE_BAR2
            xcd_barrier(xbar);
#endif
        } }
    }
}
}
extern "C" void kernel_launch(void* const* d_in, const int* in_sizes, int n_in, void* d_out, int out_size, void* d_ws, size_t ws_size, hipStream_t stream) {
    static int ok = 0;
    if (ok == 0) {
        ok = -1;
        if (n_in != 33 || out_size != 32768 * 1024 || ws_size < fk::FAST_END) { fprintf(stderr, "kernel_launch: unexpected shapes/ws (%d, %d, %zu)\n", n_in, out_size, ws_size); return; }
        int dev = 0, cus = 0, per_cu = 0;
        if (hipGetDevice(&dev) != hipSuccess || hipDeviceGetAttribute(&cus, hipDeviceAttributeMultiprocessorCount, dev) != hipSuccess) return;
        if (hipFuncSetAttribute((const void*)fk::mega, hipFuncAttributeMaxDynamicSharedMemorySize, fk::LDS_BYTES) != hipSuccess) return;
        if (hipOccupancyMaxActiveBlocksPerMultiprocessor(&per_cu, (const void*)fk::mega, fk::NTHR, fk::LDS_BYTES) != hipSuccess || per_cu < 1 || cus * per_cu < 256) { fprintf(stderr, "kernel_launch: cannot co-reside 256 workgroups (%d CUs x %d)\n", cus, per_cu); return; }
        ok = 1;
    }
    if (ok < 0) return;
    fk::FP p{}; for (int i = 0; i < 33; ++i) p.in[i] = (const float*)d_in[i]; p.X = (float*)d_out; p.ws = (unsigned char*)d_ws;
    if (hipMemsetAsync((char*)d_ws + fk::P_BAR, 0, 16384, stream) != hipSuccess) return;
    void* args[] = {&p};
    hipError_t e = hipLaunchCooperativeKernel((const void*)fk::mega, dim3(256), dim3(fk::NTHR), args, fk::LDS_BYTES, stream);
    if (e != hipSuccess) fprintf(stderr, "cooperative launch failed: %s\n", hipGetErrorString(e));
}
```

```cpp
#include <hip/hip_runtime.h>
#include <hip/hip_cooperative_groups.h>
#include <cstdio>
#include <cstdint>
#include <cmath>
namespace fk {
#define LAS __attribute__((address_space(3)))
typedef unsigned short bf16_t;
typedef short bf16x8 __attribute__((ext_vector_type(8)));
typedef short s16x4 __attribute__((ext_vector_type(4)));
typedef float f32x4 __attribute__((ext_vector_type(4)));
typedef float f32x16 __attribute__((ext_vector_type(16)));
typedef float f32x2 __attribute__((ext_vector_type(2)));
typedef unsigned u32x4 __attribute__((ext_vector_type(4)));
typedef unsigned u32x2 __attribute__((ext_vector_type(2)));
typedef __bf16 bf16x2_t __attribute__((ext_vector_type(2)));

constexpr int NT = 32768, DM = 1024, SEQ = 4096;
constexpr int NTHR = 512, NWAVE = 8;
constexpr float ALPHA = 1.4142135623730951f, LN_EPS = 1e-5f, LOG2E = 1.4426950408889634f;

__device__ __forceinline__ unsigned pk2(float lo, float hi) { f32x2 v = {lo, hi}; bf16x2_t b = __builtin_convertvector(v, bf16x2_t); return __builtin_bit_cast(unsigned, b); }
__device__ __forceinline__ float bf_lo(unsigned w) { return __uint_as_float(w << 16); }
__device__ __forceinline__ float bf_hi(unsigned w) { return __uint_as_float(w & 0xffff0000u); }
__device__ __forceinline__ float bf2f(bf16_t b) { return __uint_as_float(((unsigned)b) << 16); }
__device__ __forceinline__ bf16_t f2bf(float f) { return (bf16_t)(pk2(f, 0.f) & 0xffffu); }
__device__ __forceinline__ float fast_exp(float x) { return __builtin_amdgcn_exp2f(x * LOG2E); }
__device__ __forceinline__ float sigmoid_f(float x) { return __builtin_amdgcn_rcpf(1.f + fast_exp(-x)); }
__device__ __forceinline__ float silu_f(float x) { return x * sigmoid_f(x); }
__device__ __forceinline__ float gelu_tanh_f(float x) { const float u = 1.5957691216057308f * (x + 0.044715f * x * x * x); return x * sigmoid_f(u); }
__device__ __forceinline__ int crow(int r, int hi) { return (r & 3) + 8 * (r >> 2) + 4 * hi; }
__device__ __forceinline__ float xhalf_sum(float v) { auto rr = __builtin_amdgcn_permlane32_swap(__float_as_uint(v), __float_as_uint(v), false, false); return __uint_as_float(rr[0]) + __uint_as_float(rr[1]); }
__device__ __forceinline__ float xhalf_max(float v) { auto rr = __builtin_amdgcn_permlane32_swap(__float_as_uint(v), __float_as_uint(v), false, false); return fmaxf(__uint_as_float(rr[0]), __uint_as_float(rr[1])); }
__device__ __forceinline__ float shx(float v, int o, int lane) { return __int_as_float(__builtin_amdgcn_ds_bpermute((lane ^ o) << 2, __float_as_int(v))); }
__device__ __forceinline__ float shup(float v, int o, int lane) { return __int_as_float(__builtin_amdgcn_ds_bpermute(((lane - o) & 63) << 2, __float_as_int(v))); }
__device__ __forceinline__ float shidx(float v, int idx) { return __int_as_float(__builtin_amdgcn_ds_bpermute(idx << 2, __float_as_int(v))); }
__device__ __forceinline__ s16x4 lds_tr(const LAS void* p) { return __builtin_bit_cast(s16x4, __builtin_amdgcn_ds_read_tr16_b64_v4i16((LAS s16x4*)p)); }
#define MFMA32(a, b, c) __builtin_amdgcn_mfma_f32_32x32x16_bf16((a), (b), (c), 0, 0, 0)

namespace pg8 {
constexpr int BM = 256, BK = 64, HALF = 128, HTB = HALF * BK * 2, STAGE_BYTES = 8 * HTB, NXCD = 8, WGM = 8;
__host__ __device__ __forceinline__ int lds_byte(int r, int c) { const int st = (r >> 4) * 2 + (c >> 5), rr = r & 15, cc = c & 31, ob = rr * 64 + cc * 2; return st * 1024 + (ob ^ (((ob >> 9) & 1) << 5)); }
__host__ __device__ __forceinline__ void stage_rc(int b, int& R, int& C) { const int st = b / 1024, sb = b % 1024, swz = sb ^ (((sb >> 9) & 1) << 5); R = (st >> 1) * 16 + swz / 64; C = (st & 1) * 32 + (swz % 64) / 2; }
__host__ __device__ __forceinline__ int perm32(int rho) { const int n = rho >> 4, i = rho & 15; return 8 * (i >> 2) + 4 * n + (i & 3); }

struct Unit { const char* A; const char* B; const int* src; int pm, pn, job; };

__device__ __forceinline__ void tile_order(int l, int nM, int nN, int& pm, int& pn) {
    const int nwg = nM * nN; int wgid = l;
    { const int q = nwg / NXCD, r = nwg % NXCD, xcd = wgid % NXCD, off = wgid / NXCD; wgid = (xcd < r ? xcd * (q + 1) : r * (q + 1) + (xcd - r) * q) + off; }
    const int nig = WGM * nN, gid = wgid / nig, fm = gid * WGM, gsz = (nM - fm) < WGM ? (nM - fm) : WGM;
    pm = fm + ((wgid % nig) % gsz); pn = (wgid % nig) / gsz;
}
struct JobDesc { unsigned long long A, B, out, bias, rot, out2; int nM, nN, ldc, mode; };
__device__ __forceinline__ unsigned long long rfl64(unsigned long long v) { const unsigned lo = __builtin_amdgcn_readfirstlane((unsigned)v), hi = __builtin_amdgcn_readfirstlane((unsigned)(v >> 32)); return ((unsigned long long)hi << 32) | lo; }
constexpr int JT_OFF = STAGE_BYTES;
struct Jobs3 {
    const LAS JobDesc* jt; int n0, n1, n2; int K, G, c;
    __device__ __forceinline__ Unit get(int i, bool& ok) const { Unit u; u.A = nullptr; u.B = nullptr; u.src = nullptr; u.pm = 0; u.pn = 0; u.job = 0; ok = next(i, u); return u; }
    __device__ __forceinline__ bool next(int i, Unit& u) const {
        long L = (long)i * G + c;
        if (L >= (long)n0 + n1 + n2) return false;
        int l = (int)L; int jb = 0;
        if (l >= n0) { l -= n0; jb = 1; if (l >= n1) { l -= n1; jb = 2; } }
        const int jM = __builtin_amdgcn_readfirstlane(jt[jb].nM), jN = __builtin_amdgcn_readfirstlane(jt[jb].nN);
        int pm, pn; tile_order(l, jM, jN, pm, pn);
        const size_t tstep = (size_t)BM * K * 2;
        u.A = (const char*)rfl64(jt[jb].A) + (size_t)pm * tstep; u.B = (const char*)rfl64(jt[jb].B) + (size_t)pn * tstep; u.src = nullptr; u.pm = pm; u.pn = pn; u.job = jb; return true;
    }
};

template <class Epi, class Sched, bool ALIGN_EPI, bool SP2>
__device__ __forceinline__ void gemm_phase(LAS unsigned char* lds, const int K, const Sched& S, const Epi& E) {
    int tid_ = threadIdx.x; asm volatile("" : "+v"(tid_)); const int tid = tid_, wid = __builtin_amdgcn_readfirstlane(tid >> 6), lane = tid & 63, wr = wid >> 2, wc = wid & 3, fr = lane & 15, fq = lane >> 4;
    const int nt = K / BK;
    static_assert(SP2, "only the two-super-phase form is kept");
    unsigned vA0[2], vA1[2], vB0[2], vB1[2];
#pragma unroll
    for (int i = 0; i < 2; ++i) { int R, C; stage_rc(tid * 16 + i * 8192, R, C); const int Rb = 64 * (R >> 5) + perm32(R & 31); vB0[i] = (unsigned)(Rb * K + C) * 2u; vB1[i] = (unsigned)((Rb + 32) * K + C) * 2u; }
    auto a_rows = [&](const int* src, unsigned (&o0)[2], unsigned (&o1)[2]) {
        int tq = tid; asm volatile("" : "+v"(tq));
#pragma unroll
        for (int i = 0; i < 2; ++i) { int R, C; stage_rc(tq * 16 + i * 8192, R, C); int r0 = R, r1 = R + HALF; if (src) { r0 = src[R]; r1 = src[R + HALF]; }
            o0[i] = (unsigned)(r0 * K + C) * 2u; o1[i] = (unsigned)(r1 * K + C) * 2u; }
    };
    const size_t kstep = (size_t)(BK * 2);
    const size_t hstep = (size_t)HALF * K * 2;
    const unsigned ldsw = (unsigned)wid * 1024u;
    const int aoff = lds_byte(wr * 64 + fr, fq * 8), boff = lds_byte(wc * 32 + fr, fq * 8);
#define PG8_SA(b, h) (((b) * 2 + (h)) * HTB)
#define PG8_SB(b, h) ((4 + (b) * 2 + (h)) * HTB)
#define PG8_STAGE(bufoff, gbase, voff) do { _Pragma("unroll") for (int _i = 0; _i < 2; ++_i) \
        __builtin_amdgcn_global_load_lds((const unsigned*)((const char*)(gbase) + (voff)[_i]), (LAS unsigned*)(lds + (bufoff) + ldsw + _i * 8192), 16, 0, 0); } while (0)
#define PG8_LDA(dst, b, h) do { _Pragma("unroll") for (int m = 0; m < 4; ++m) _Pragma("unroll") for (int k = 0; k < 2; ++k) dst[m][k] = *(const LAS bf16x8*)(lds + PG8_SA(b, h) + aoff + m * 2048 + k * 1024); } while (0)
#define PG8_LDB(dst, b, h) do { _Pragma("unroll") for (int n = 0; n < 2; ++n) _Pragma("unroll") for (int k = 0; k < 2; ++k) dst[n][k] = *(const LAS bf16x8*)(lds + PG8_SB(b, h) + boff + n * 2048 + k * 1024); } while (0)
#define PG8_MMA(ai, bj, At, Bt) do { __builtin_amdgcn_s_setprio(1); _Pragma("unroll") for (int m = 0; m < 4; ++m) _Pragma("unroll") for (int n = 0; n < 2; ++n) _Pragma("unroll") for (int k = 0; k < 2; ++k) \
        acc[ai][bj][m][n] = __builtin_amdgcn_mfma_f32_16x16x32_bf16(Bt[n][k], At[m][k], acc[ai][bj][m][n], 0, 0, 0); __builtin_amdgcn_s_setprio(0); } while (0)
#define PG8_WAIT_V(n) asm volatile("s_waitcnt vmcnt(" #n ")" ::: "memory")
#define PG8_WAIT_L(n) asm volatile("s_waitcnt lgkmcnt(" #n ")" ::: "memory")
#define PG8_BAR __builtin_amdgcn_s_barrier()
#define PG8_SCHED __builtin_amdgcn_sched_barrier(0)
    auto unif = [](Unit u) { Unit r; r.A = (const char*)rfl64((unsigned long long)u.A); r.B = (const char*)rfl64((unsigned long long)u.B); r.src = (const int*)rfl64((unsigned long long)u.src);
        r.pm = __builtin_amdgcn_readfirstlane(u.pm); r.pn = __builtin_amdgcn_readfirstlane(u.pn); r.job = __builtin_amdgcn_readfirstlane(u.job); return r; };
    int ui = 0; bool ok0; Unit cur = unif(S.get(0, ok0));
    if (!ok0) return;
    f32x4 acc[2][2][4][2];
#pragma unroll
    for (int a = 0; a < 2; ++a)
#pragma unroll
        for (int b = 0; b < 2; ++b)
#pragma unroll
            for (int m = 0; m < 4; ++m)
#pragma unroll
                for (int n = 0; n < 2; ++n) acc[a][b][m][n] = (f32x4){0.f, 0.f, 0.f, 0.f};
    bf16x8 At[4][2], B0[2][2], B1[2][2];
    const char* cA = cur.A; const char* cB = cur.B;
    a_rows(cur.src, vA0, vA1);
    {
        PG8_STAGE(PG8_SB(0, 0), cB, vB0); PG8_STAGE(PG8_SB(0, 1), cB, vB1); PG8_STAGE(PG8_SA(0, 0), cA, vA0); PG8_STAGE(PG8_SA(0, 1), cA, vA1);
        if (wr == 1) PG8_BAR;
        PG8_WAIT_V(2); PG8_BAR;
        PG8_STAGE(PG8_SB(1, 0), cB + kstep, vB0); PG8_STAGE(PG8_SA(1, 0), cA + kstep, vA0); PG8_STAGE(PG8_SB(1, 1), cB + kstep, vB1);
        PG8_WAIT_V(6); PG8_BAR;
    }
    for (;;) {
        bool has_next; const Unit nxt = unif(S.get(ui + 1, has_next)); bool early_done = false;
        const char* nA = has_next ? nxt.A : cA; const char* nB = has_next ? nxt.B : cB;
        for (int t = 0; t < nt; t += 2) {
            const bool last = (t == nt - 2);
            const char* a1 = cA + (size_t)(t + 1) * kstep;
            const char* a2 = last ? nA : cA + (size_t)(t + 2) * kstep; const char* b2 = last ? nB : cB + (size_t)(t + 2) * kstep;
            const char* a3 = a2 + kstep; const char* b3 = b2 + kstep;
            PG8_LDB(B0, 0, 0); PG8_LDB(B1, 0, 1); PG8_SCHED; PG8_LDA(At, 0, 0); PG8_STAGE(PG8_SA(1, 1), a1, vA1);
            if (last && has_next) a_rows(nxt.src, vA0, vA1);
            PG8_WAIT_V(8); PG8_WAIT_L(0); PG8_BAR; PG8_MMA(0, 0, At, B0); PG8_MMA(0, 1, At, B1); PG8_BAR; PG8_SCHED;
            PG8_LDA(At, 0, 1); PG8_STAGE(PG8_SB(0, 0), b2, vB0); PG8_STAGE(PG8_SB(0, 1), b2, vB1); PG8_STAGE(PG8_SA(0, 0), a2, vA0);
            PG8_WAIT_V(8); PG8_WAIT_L(0); PG8_BAR; PG8_MMA(1, 0, At, B0); PG8_MMA(1, 1, At, B1); PG8_BAR; PG8_SCHED;
            PG8_LDB(B0, 1, 0); PG8_LDB(B1, 1, 1); PG8_SCHED; PG8_LDA(At, 1, 0); PG8_STAGE(PG8_SA(0, 1), a2, vA1);
            PG8_WAIT_V(8); PG8_WAIT_L(0); PG8_BAR; PG8_MMA(0, 0, At, B0); PG8_MMA(0, 1, At, B1); PG8_BAR; PG8_SCHED;
            if (last) { early_done = E.early(acc, cur, wr, wc, fr, fq); PG8_SCHED; }
            PG8_LDA(At, 1, 1); PG8_STAGE(PG8_SB(1, 0), b3, vB0); PG8_STAGE(PG8_SB(1, 1), b3, vB1); PG8_STAGE(PG8_SA(1, 0), a3, vA0);
            PG8_WAIT_V(8); PG8_WAIT_L(0); PG8_BAR; PG8_MMA(1, 0, At, B0); PG8_MMA(1, 1, At, B1); PG8_BAR; PG8_SCHED;
        }
        if constexpr (ALIGN_EPI) { if (wr == 0) PG8_BAR; }
        if (!early_done) E.template half<0>(acc, cur, wr, wc, fr, fq);
        E.template half<1>(acc, cur, wr, wc, fr, fq);
        if (!has_next) break;
#pragma unroll
        for (int a = 0; a < 2; ++a)
#pragma unroll
            for (int b = 0; b < 2; ++b)
#pragma unroll
                for (int m = 0; m < 4; ++m)
#pragma unroll
                    for (int n = 0; n < 2; ++n) acc[a][b][m][n] = (f32x4){0.f, 0.f, 0.f, 0.f};
        cur = nxt; cA = nA; cB = nB; ++ui;
        if constexpr (ALIGN_EPI) { if (wr == 1) PG8_BAR; }
    }
    PG8_WAIT_V(0);
    if constexpr (!ALIGN_EPI) { if (wr == 0) PG8_BAR; }
    PG8_BAR;
#undef PG8_SA
#undef PG8_SB
#undef PG8_STAGE
#undef PG8_LDA
#undef PG8_LDB
#undef PG8_MMA
#undef PG8_WAIT_V
#undef PG8_WAIT_L
#undef PG8_BAR
#undef PG8_SCHED
}
}
enum { EM_PLAIN = 0, EM_GELU4 = 1, EM_SWIGLU = 2, EM_ROTARY = 3, EM_ROWBIAS = 4 };
struct EpiMulti {
    static constexpr bool PERM = true;
    const LAS pg8::JobDesc* jt;
    __device__ __forceinline__ bool early(const f32x4 (&acc)[2][2][4][2], const pg8::Unit& u, int wr, int wc, int fr, int fq) const {
        const LAS pg8::JobDesc* jd = jt + u.job;
        if (__builtin_amdgcn_readfirstlane(jd->mode) != EM_PLAIN) return false;
        bf16_t* out = (bf16_t*)pg8::rfl64(jd->out); const int ldc = __builtin_amdgcn_readfirstlane(jd->ldc);
        bf16_t* rowp = out + (size_t)(u.pm * 256 + wr * 64 + fr) * ldc + u.pn * 256 + wc * 64 + 8 * fq;
#pragma unroll
        for (int m = 0; m < 4; ++m)
#pragma unroll
            for (int bj = 0; bj < 2; ++bj) { const f32x4 v0 = acc[0][bj][m][0], v1 = acc[0][bj][m][1];
                u32x4 w; w.x = pk2(v0[0], v0[1]); w.y = pk2(v0[2], v0[3]); w.z = pk2(v1[0], v1[1]); w.w = pk2(v1[2], v1[3]);
                *(u32x4*)(rowp + (size_t)m * 16 * ldc + bj * 32) = w; }
        return true;
    }
    template <int AI>
    __device__ __forceinline__ void half(const f32x4 (&acc)[2][2][4][2], const pg8::Unit& u, int wr, int wc, int fr, int fq) const {
        const LAS pg8::JobDesc* jd = jt + u.job;
        bf16_t* out = (bf16_t*)pg8::rfl64(jd->out);
        const int ldc = __builtin_amdgcn_readfirstlane(jd->ldc);
        const int mode = __builtin_amdgcn_readfirstlane(jd->mode);
        const float* bias = (const float*)pg8::rfl64(jd->bias);
        const int row0 = u.pm * 256 + wr * 64 + fr;
        const int colt = u.pn * 256 + wc * 64 + 8 * fq;
        if (mode == EM_PLAIN || mode == EM_ROWBIAS) {
#pragma unroll
            for (int ai = AI; ai < AI + 1; ++ai)
#pragma unroll
                for (int m = 0; m < 4; ++m) { const int row = row0 + ai * 128 + m * 16; const float rb = (mode == EM_ROWBIAS && bias) ? bias[row] : 0.f;
                    bf16_t* rowp = out + (size_t)row * ldc + colt;
#pragma unroll
                    for (int bj = 0; bj < 2; ++bj) { const f32x4 v0 = acc[ai][bj][m][0] + rb, v1 = acc[ai][bj][m][1] + rb;
                        u32x4 w; w.x = pk2(v0[0], v0[1]); w.y = pk2(v0[2], v0[3]); w.z = pk2(v1[0], v1[1]); w.w = pk2(v1[2], v1[3]);
                        *(u32x4*)(rowp + bj * 32) = w; } }
        } else if (mode == EM_GELU4) {
            const int arr = u.pn >> 1; bf16_t* base = out + (size_t)arr * NT * 512; const int col = colt - arr * 512; const bool act = arr < 2;
#pragma unroll
            for (int ai = AI; ai < AI + 1; ++ai)
#pragma unroll
                for (int m = 0; m < 4; ++m) { bf16_t* rowp = base + (size_t)(row0 + ai * 128 + m * 16) * 512 + col;
#pragma unroll
                    for (int bj = 0; bj < 2; ++bj) { f32x4 v0 = acc[ai][bj][m][0], v1 = acc[ai][bj][m][1];
                        if (act) {
#pragma unroll
                            for (int e = 0; e < 4; ++e) { v0[e] = gelu_tanh_f(v0[e]); v1[e] = gelu_tanh_f(v1[e]); } }
                        u32x4 w; w.x = pk2(v0[0], v0[1]); w.y = pk2(v0[2], v0[3]); w.z = pk2(v1[0], v1[1]); w.w = pk2(v1[2], v1[3]);
                        *(u32x4*)(rowp + bj * 32) = w; } }
        } else if (mode == EM_SWIGLU) {
#pragma unroll
            for (int ai = AI; ai < AI + 1; ++ai)
#pragma unroll
                for (int m = 0; m < 4; ++m) { bf16_t* rowp = out + (size_t)(row0 + ai * 128 + m * 16) * ldc + (colt >> 1);
#pragma unroll
                    for (int bj = 0; bj < 2; ++bj) { const f32x4 v0 = acc[ai][bj][m][0], v1 = acc[ai][bj][m][1];
                        u32x2 w; w.x = pk2(silu_f(v0[0]) * v0[1], silu_f(v0[2]) * v0[3]); w.y = pk2(silu_f(v1[0]) * v1[1], silu_f(v1[2]) * v1[3]);
                        *(u32x2*)(rowp + bj * 16) = w; } }
        } else {
            const float* rot = (const float*)pg8::rfl64(jd->rot);
            bf16_t* out2 = (bf16_t*)pg8::rfl64(jd->out2);
            const bool isk = u.pn >= 4; bf16_t* base = isk ? out2 : out; const int ld = isk ? 256 : 1024; const int colo = isk ? colt - 1024 : colt;
            float bv[2][8];
#pragma unroll
            for (int bj = 0; bj < 2; ++bj)
#pragma unroll
                for (int e = 0; e < 8; ++e) bv[bj][e] = bias ? bias[colt + bj * 32 + e] : 0.f;
            const int i0 = (colt & 63) >> 1;
#pragma unroll
            for (int ai = AI; ai < AI + 1; ++ai)
#pragma unroll
                for (int m = 0; m < 4; ++m) { const int row = row0 + ai * 128 + m * 16; const int pos = row & (SEQ - 1);
                    bf16_t* rowp = base + (size_t)row * ld + colo;
#pragma unroll
                    for (int bj = 0; bj < 2; ++bj) { f32x4 v0 = acc[ai][bj][m][0], v1 = acc[ai][bj][m][1];
                        const f32x4 cs0 = *(const f32x4*)(rot + ((size_t)pos * 32 + i0 + 16 * bj) * 2), cs1 = *(const f32x4*)(rot + ((size_t)pos * 32 + i0 + 16 * bj + 2) * 2);
#pragma unroll
                        for (int e = 0; e < 4; ++e) { v0[e] += bv[bj][e]; v1[e] += bv[bj][4 + e]; }
                        const float a0 = v0[0] * cs0[0] - v0[1] * cs0[1], b0 = v0[1] * cs0[0] + v0[0] * cs0[1];
                        const float a1 = v0[2] * cs0[2] - v0[3] * cs0[3], b1 = v0[3] * cs0[2] + v0[2] * cs0[3];
                        const float a2 = v1[0] * cs1[0] - v1[1] * cs1[1], b2 = v1[1] * cs1[0] + v1[0] * cs1[1];
                        const float a3 = v1[2] * cs1[2] - v1[3] * cs1[3], b3 = v1[3] * cs1[2] + v1[2] * cs1[3];
                        u32x4 w; w.x = pk2(a0, b0); w.y = pk2(a1, b1); w.z = pk2(a2, b2); w.w = pk2(a3, b3);
                        *(u32x4*)(rowp + bj * 32) = w; } }
        }
    }
};
enum { RM_IDENT = 0, RM_ROT = 1, RM_PAIR0 = 2, RM_PAIR1 = 3 };
__device__ __forceinline__ int rowmap(int kind, int n) {
    if (kind == RM_ROT) { if (n >= 1280) return n; const int d = n & 63; return (n & ~63) + 2 * (d & 31) + (d >> 5); }
    if (kind == RM_PAIR0) return 2 * n;
    if (kind == RM_PAIR1) return 2 * n + 1;
    return n;
}
__device__ __forceinline__ void ti_load(const float* __restrict__ W, int ldw, int kb, int nb, int lane, f32x4 (&tv)[8]) {
    const int k0 = 64 * kb, n0 = 32 * nb;
#pragma unroll
    for (int i = 0; i < 8; ++i) { const int kk = 8 * i + (lane >> 3); tv[i] = *(const f32x4*)(W + (size_t)(k0 + kk) * ldw + n0 + 4 * (lane & 7)); }
}
__device__ __forceinline__ void ti_store(const f32x4 (&tv)[8], int K, bf16_t* __restrict__ WT, LAS float* scr, int kb, int nb, int lane, int kind, float scale, int nscale) {
    const int k0 = 64 * kb, n0 = 32 * nb;
#pragma unroll
    for (int i = 0; i < 8; ++i) { const int kk = 8 * i + (lane >> 3); LAS float* d = scr + kk * 33 + 4 * (lane & 7); d[0] = tv[i][0]; d[1] = tv[i][1]; d[2] = tv[i][2]; d[3] = tv[i][3]; }
    __builtin_amdgcn_s_waitcnt(0xc07f); asm volatile("" ::: "memory");
    const int c = lane & 7;
#pragma unroll
    for (int j = 0; j < 4; ++j) { const int n = (lane >> 3) + 8 * j; const LAS float* s = scr + (8 * c) * 33 + n; const float sc = (n0 + n) < nscale ? scale : 1.f;
        u32x4 o; o.x = pk2(s[0 * 33] * sc, s[1 * 33] * sc); o.y = pk2(s[2 * 33] * sc, s[3 * 33] * sc); o.z = pk2(s[4 * 33] * sc, s[5 * 33] * sc); o.w = pk2(s[6 * 33] * sc, s[7 * 33] * sc);
        *(u32x4*)(WT + (size_t)rowmap(kind, n0 + n) * K + k0 + 8 * c) = o; }
    __builtin_amdgcn_s_waitcnt(0xc07f); asm volatile("" ::: "memory");
}
__device__ __forceinline__ void convert_mats(const float* W, int K, int N, int nbat, size_t sstr, bf16_t* WT, size_t dstr, int kind, float scale, int nscale, LAS float* scr, int gw, int ngw, int lane) {
    const int nblk = N / 32, per = (K / 64) * nblk, total = per * nbat;
    if (gw >= total) return;
    f32x4 cur[8], nxt[8];
    { const int bt = gw / per, r = gw - bt * per; ti_load(W + (size_t)bt * sstr, N, r / nblk, r % nblk, lane, cur); }
    for (int it = gw; it < total; it += ngw) {
        const int in = it + ngw; const bool more = in < total;
        if (more) { const int bt = in / per, r = in - bt * per; ti_load(W + (size_t)bt * sstr, N, r / nblk, r % nblk, lane, nxt); }
        { const int bt = it / per, r = it - bt * per; ti_store(cur, K, WT + (size_t)bt * dstr, scr, r / nblk, r % nblk, lane, kind, scale, nscale); }
#pragma unroll
        for (int i = 0; i < 8; ++i) cur[i] = nxt[i];
    }
}
__device__ __forceinline__ void convert_rows(const float* __restrict__ src, bf16_t* __restrict__ dst, size_t n, int gt, int ngt) {
    const size_t step = (size_t)ngt * 8; size_t i = (size_t)gt * 8;
    for (; i + 3 * step < n; i += 4 * step) { f32x4 a[4], b[4];
#pragma unroll
        for (int j = 0; j < 4; ++j) { a[j] = *(const f32x4*)(src + i + j * step); b[j] = *(const f32x4*)(src + i + j * step + 4); }
#pragma unroll
        for (int j = 0; j < 4; ++j) { u32x4 o; o.x = pk2(a[j][0], a[j][1]); o.y = pk2(a[j][2], a[j][3]); o.z = pk2(b[j][0], b[j][1]); o.w = pk2(b[j][2], b[j][3]); *(u32x4*)(dst + i + j * step) = o; } }
    for (; i < n; i += step) { const f32x4 a = *(const f32x4*)(src + i), b = *(const f32x4*)(src + i + 4);
        u32x4 o; o.x = pk2(a[0], a[1]); o.y = pk2(a[2], a[3]); o.z = pk2(b[0], b[1]); o.w = pk2(b[2], b[3]); *(u32x4*)(dst + i) = o; }
}

struct LnArgs { const float* xin32; const bf16_t* xin; float* xout32; bf16_t* xbf; const bf16_t* y; const float* g; const float* b; const int* dest; const float* wts; };
template <int NR, bool XF32, bool OUTF32, bool MOE>
__device__ __forceinline__ void ln_rows(const LnArgs& a, int row0, int lane) {
    float v[NR][2][8];
    {
        int d0[NR], d1[NR]; float w0[NR], w1[NR];
        if (MOE) {
#pragma unroll
            for (int i = 0; i < NR; ++i) { d0[i] = a.dest[(row0 + i) * 2]; d1[i] = a.dest[(row0 + i) * 2 + 1]; w0[i] = a.wts[(row0 + i) * 2]; w1[i] = a.wts[(row0 + i) * 2 + 1]; }
        }
        f32x4 xf[XF32 ? NR : 1][2][2]; u32x4 xb[XF32 ? 1 : NR][2]; u32x4 p[NR][2], q[MOE ? NR : 1][2];
#pragma unroll
        for (int i = 0; i < NR; ++i) {
            const u32x4* y0 = (const u32x4*)(a.y + (size_t)(MOE ? d0[i] : row0 + i) * DM) + lane; const u32x4* y1 = (const u32x4*)(a.y + (size_t)(MOE ? d1[i] : 0) * DM) + lane;
#pragma unroll
            for (int j = 0; j < 2; ++j) {
                if (XF32) { const f32x4* xr = (const f32x4*)(a.xin32 + (size_t)(row0 + i) * DM) + 2 * lane + 128 * j; xf[XF32 ? i : 0][j][0] = xr[0]; xf[XF32 ? i : 0][j][1] = xr[1]; }
                else xb[XF32 ? 0 : i][j] = ((const u32x4*)(a.xin + (size_t)(row0 + i) * DM) + lane)[64 * j];
                p[i][j] = y0[64 * j]; if (MOE) q[MOE ? i : 0][j] = y1[64 * j]; } }
#pragma unroll
        for (int i = 0; i < NR; ++i)
#pragma unroll
            for (int j = 0; j < 2; ++j) {
                float x[8];
                if (XF32) {
#pragma unroll
                    for (int e = 0; e < 4; ++e) { x[e] = xf[XF32 ? i : 0][j][0][e]; x[4 + e] = xf[XF32 ? i : 0][j][1][e]; } }
                else { const u32x4 w = xb[XF32 ? 0 : i][j]; x[0] = bf_lo(w.x); x[1] = bf_hi(w.x); x[2] = bf_lo(w.y); x[3] = bf_hi(w.y); x[4] = bf_lo(w.z); x[5] = bf_hi(w.z); x[6] = bf_lo(w.w); x[7] = bf_hi(w.w); }
                const u32x4 pw = p[i][j]; const float py[8] = {bf_lo(pw.x), bf_hi(pw.x), bf_lo(pw.y), bf_hi(pw.y), bf_lo(pw.z), bf_hi(pw.z), bf_lo(pw.w), bf_hi(pw.w)};
                if (MOE) { const u32x4 qw = q[MOE ? i : 0][j]; const float qy[8] = {bf_lo(qw.x), bf_hi(qw.x), bf_lo(qw.y), bf_hi(qw.y), bf_lo(qw.z), bf_hi(qw.z), bf_lo(qw.w), bf_hi(qw.w)};
#pragma unroll
                    for (int e = 0; e < 8; ++e) v[i][j][e] = ALPHA * x[e] + w0[i] * py[e] + w1[i] * qy[e]; }
                else {
#pragma unroll
                    for (int e = 0; e < 8; ++e) v[i][j][e] = ALPHA * x[e] + py[e]; }
            }
    }
    float s[NR];
#pragma unroll
    for (int i = 0; i < NR; ++i) { s[i] = 0.f;
#pragma unroll
        for (int j = 0; j < 2; ++j)
#pragma unroll
            for (int e = 0; e < 8; ++e) s[i] += v[i][j][e]; }
#pragma unroll
    for (int o = 1; o < 64; o <<= 1)
#pragma unroll
        for (int i = 0; i < NR; ++i) s[i] += shx(s[i], o, lane);
    float q2[NR];
#pragma unroll
    for (int i = 0; i < NR; ++i) { const float mean = s[i] * (1.f / DM); q2[i] = 0.f;
#pragma unroll
        for (int j = 0; j < 2; ++j)
#pragma unroll
            for (int e = 0; e < 8; ++e) { v[i][j][e] -= mean; q2[i] += v[i][j][e] * v[i][j][e]; } }
#pragma unroll
    for (int o = 1; o < 64; o <<= 1)
#pragma unroll
        for (int i = 0; i < NR; ++i) q2[i] += shx(q2[i], o, lane);
    f32x4 gv[2][2], bv[2][2];
#pragma unroll
    for (int j = 0; j < 2; ++j) { const f32x4* gp = (const f32x4*)a.g + 2 * lane + 128 * j; const f32x4* bp = (const f32x4*)a.b + 2 * lane + 128 * j; gv[j][0] = gp[0]; gv[j][1] = gp[1]; bv[j][0] = bp[0]; bv[j][1] = bp[1]; }
#pragma unroll
    for (int i = 0; i < NR; ++i) { const float rstd = rsqrtf(q2[i] * (1.f / DM) + LN_EPS);
#pragma unroll
        for (int j = 0; j < 2; ++j) { float o[8];
#pragma unroll
            for (int e = 0; e < 8; ++e) o[e] = v[i][j][e] * rstd * gv[j][e >> 2][e & 3] + bv[j][e >> 2][e & 3];
            if (OUTF32) { f32x4* xo = (f32x4*)(a.xout32 + (size_t)(row0 + i) * DM) + 2 * lane + 128 * j; xo[0] = (f32x4){o[0], o[1], o[2], o[3]}; xo[1] = (f32x4){o[4], o[5], o[6], o[7]}; }
            else { u32x4 w; w.x = pk2(o[0], o[1]); w.y = pk2(o[2], o[3]); w.z = pk2(o[4], o[5]); w.w = pk2(o[6], o[7]); ((u32x4*)(a.xbf + (size_t)(row0 + i) * DM) + lane)[64 * j] = w; } } }
}
template <bool XF32, bool OUTF32, bool MOE>
__device__ __forceinline__ void ln_phase(const LnArgs& a, int blk, int G, int wave, int lane) {
    const int per = NT / G, r0 = blk * per, pw = per / NWAVE;
    for (int r = 0; r < pw; r += 4) ln_rows<4, XF32, OUTF32, MOE>(a, r0 + wave * pw + r, lane);
}
__device__ __forceinline__ void xattn_phase(LAS unsigned char* lds, const bf16_t* __restrict__ Q, const bf16_t* __restrict__ KC, const bf16_t* __restrict__ VT, bf16_t* __restrict__ O, int blk, int G) {
    const int tid0 = threadIdx.x, wave = __builtin_amdgcn_readfirstlane(tid0 >> 6);
#define XA_IDS int tid = tid0; asm volatile("" : "+v"(tid)); const int lane = tid & 63, r32 = lane & 31, hh = lane >> 5; const size_t qrow = (size_t)b * SEQ + qb * 256 + wave * 32 + r32; (void)lane; (void)hh; (void)qrow;
    for (int u = blk; u < 512; u += G) {
        const int qb = u & 15, h = (u >> 4) & 3, b = u >> 6;
        XA_IDS;
        bf16x8 qf[16];
#pragma unroll
        for (int ks = 0; ks < 16; ++ks) qf[ks] = *(const bf16x8*)(Q + qrow * 1024 + h * 256 + ks * 16 + hh * 8);
        __syncthreads();
#pragma unroll
        for (int bt = 0; bt < 2; ++bt) {
            u32x4 t[8];
#pragma unroll
            for (int i = 0; i < 8; ++i) { const int ch = tid + 512 * (bt * 8 + i), row = ch >> 5, c = ch & 31; t[i] = *(const u32x4*)(KC + (size_t)(b * 256 + row) * 1024 + h * 256 + c * 8); }
#pragma unroll
            for (int i = 0; i < 8; ++i) { const int ch = tid + 512 * (bt * 8 + i), row = ch >> 5, c = ch & 31; *(LAS u32x4*)(lds + row * 528 + c * 16) = t[i]; }
        }
        __syncthreads();
        f32x16 s[8];
#pragma unroll
        for (int mt = 0; mt < 8; ++mt)
#pragma unroll
            for (int r = 0; r < 16; ++r) s[mt][r] = 0.f;
        {   const LAS unsigned char* kbp = lds + r32 * 528 + hh * 16;
#pragma unroll
            for (int ks = 0; ks < 16; ++ks)
#pragma unroll
                for (int mt = 0; mt < 8; ++mt) { const bf16x8 a = *(const LAS bf16x8*)(kbp + mt * 32 * 528 + ks * 32); s[mt] = MFMA32(a, qf[ks], s[mt]); }
        }
        float mx = -INFINITY;
#pragma unroll
        for (int mt = 0; mt < 8; ++mt)
#pragma unroll
            for (int r = 0; r < 16; ++r) mx = fmaxf(mx, s[mt][r]);
        mx = xhalf_max(mx);
        float sm = 0.f; const float mxl = mx * LOG2E;
        u32x4 pf[8][2];
#pragma unroll
        for (int mt = 0; mt < 8; ++mt) {
#pragma unroll
            for (int r = 0; r < 16; ++r) { const float p = __builtin_amdgcn_exp2f(s[mt][r] * LOG2E - mxl); s[mt][r] = p; sm += p; }
#pragma unroll
            for (int sx = 0; sx < 2; ++sx) pf[mt][sx] = (u32x4){pk2(s[mt][8 * sx], s[mt][8 * sx + 1]), pk2(s[mt][8 * sx + 2], s[mt][8 * sx + 3]), pk2(s[mt][8 * sx + 4], s[mt][8 * sx + 5]), pk2(s[mt][8 * sx + 6], s[mt][8 * sx + 7])};
        }
        sm = xhalf_sum(sm);
        __syncthreads();
        {   XA_IDS;
#pragma unroll
        for (int bt = 0; bt < 4; ++bt) {
            u32x4 t[4];
#pragma unroll
            for (int i = 0; i < 4; ++i) { const int ch = tid + 512 * (bt * 4 + i), row = ch >> 5, c = ch & 31; t[i] = *(const u32x4*)(VT + (size_t)(h * 256 + row) * 2048 + b * 256 + c * 8); }
#pragma unroll
            for (int i = 0; i < 4; ++i) { const int ch = tid + 512 * (bt * 4 + i), row = ch >> 5, c = ch & 31; LAS u32x2* d = (LAS u32x2*)(lds + row * 520 + c * 16); d[0] = (u32x2){t[i].x, t[i].y}; d[1] = (u32x2){t[i].z, t[i].w}; }
        }
        }
        __syncthreads();
        {   XA_IDS;
        const float inv = 1.f / sm;
        bf16_t* orow = O + qrow * 1024 + h * 256 + 4 * hh;
#pragma unroll 1
        for (int dh = 0; dh < 2; ++dh) {
            f32x16 o[4];
#pragma unroll
            for (int dt = 0; dt < 4; ++dt)
#pragma unroll
                for (int r = 0; r < 16; ++r) o[dt][r] = 0.f;
            const LAS unsigned char* vb = lds + (dh * 128 + r32) * 520 + 8 * hh;
#pragma unroll
            for (int mt = 0; mt < 8; ++mt)
#pragma unroll
                for (int sx = 0; sx < 2; ++sx) { const int kb = mt * 32 + 16 * sx; const bf16x8 pb = __builtin_bit_cast(bf16x8, pf[mt][sx]);
#pragma unroll
                    for (int dt = 0; dt < 4; ++dt) { const LAS unsigned char* q = vb + dt * 32 * 520 + kb * 2;
                        const s16x4 lo = *(const LAS s16x4*)q, hi = *(const LAS s16x4*)(q + 16);
                        const bf16x8 a = (bf16x8){lo[0], lo[1], lo[2], lo[3], hi[0], hi[1], hi[2], hi[3]}; o[dt] = MFMA32(a, pb, o[dt]); } }
#pragma unroll
            for (int dt = 0; dt < 4; ++dt)
#pragma unroll
                for (int g = 0; g < 4; ++g) { u32x2 w; w.x = pk2(o[dt][4 * g] * inv, o[dt][4 * g + 1] * inv); w.y = pk2(o[dt][4 * g + 2] * inv, o[dt][4 * g + 3] * inv); *(u32x2*)(orow + dh * 128 + dt * 32 + 8 * g) = w; }
        }
        }
    }
#undef XA_IDS
}

struct RouteBufs { int* e; float* w; int* rank; int* dest; int* hist; int* tstart; int* src; };
__device__ __forceinline__ void moe_router_phase(LAS unsigned char* lds, const bf16_t* __restrict__ XBF, const bf16_t* __restrict__ WRT, const float* __restrict__ brg, const float* __restrict__ bre, const RouteBufs rb, int blk) {
    int tid_ = threadIdx.x; asm volatile("" : "+v"(tid_)); const int tid = tid_, lane = tid & 63, wave = __builtin_amdgcn_readfirstlane(tid >> 6), r32 = lane & 31, hh = lane >> 5;
    LAS unsigned char* XT = lds; LAS unsigned char* WT = lds + 128 * 528;
    LAS float* LG = (LAS float*)lds;
    LAS int* hist = (LAS int*)(lds + 128 * 65 * 4);
    const int rbk = wave & 3, ct = wave >> 2;
    f32x16 acc;
#pragma unroll
    for (int r = 0; r < 16; ++r) acc[r] = 0.f;
#pragma unroll 1
    for (int kc = 0; kc < 4; ++kc) {
        __syncthreads();
        {   u32x4 tx[8], tw[8];
#pragma unroll
            for (int i = 0; i < 8; ++i) { const int ch = tid + 512 * i, row = ch >> 5, c = ch & 31; tx[i] = *(const u32x4*)(XBF + (size_t)(blk * 128 + row) * 1024 + kc * 256 + c * 8); tw[i] = *(const u32x4*)(WRT + (size_t)row * 1024 + kc * 256 + c * 8); }
#pragma unroll
            for (int i = 0; i < 8; ++i) { const int ch = tid + 512 * i, row = ch >> 5, c = ch & 31; *(LAS u32x4*)(XT + row * 528 + c * 16) = tx[i]; *(LAS u32x4*)(WT + row * 528 + c * 16) = tw[i]; } }
        __syncthreads();
        const LAS unsigned char* ap = XT + (rbk * 32 + r32) * 528 + hh * 16; const LAS unsigned char* bp = WT + (ct * 32 + r32) * 528 + hh * 16;
#pragma unroll
        for (int ks = 0; ks < 16; ++ks) { const bf16x8 a = *(const LAS bf16x8*)(ap + ks * 32), b0 = *(const LAS bf16x8*)(bp + ks * 32), b1 = *(const LAS bf16x8*)(bp + 64 * 528 + ks * 32);
            acc = MFMA32(a, b0, acc); acc = MFMA32(a, b1, acc); }
    }
    __syncthreads();
    if (tid < 32) hist[tid] = 0;
#pragma unroll
    for (int r = 0; r < 16; ++r) LG[(rbk * 32 + crow(r, hh)) * 65 + ct * 32 + r32] = acc[r];
    __syncthreads();
    if (tid < 128) {
        const LAS float* lg = LG + tid * 65; const int tok = blk * 128 + tid;
        float g4[4];
#pragma unroll
        for (int g = 0; g < 4; ++g) g4[g] = lg[32 + g] + brg[g];
        int gi = 0; float gm = g4[0];
#pragma unroll
        for (int g = 1; g < 4; ++g) if (g4[g] > gm) { gm = g4[g]; gi = g; }
        float gs = 0.f;
#pragma unroll
        for (int g = 0; g < 4; ++g) gs += fast_exp(g4[g] - gm);
        const float gate_g = 1.f / gs;
        float le[8];
#pragma unroll
        for (int e = 0; e < 8; ++e) le[e] = lg[gi * 8 + e] + bre[gi * 8 + e];
        int i0 = 0; float v0 = le[0];
#pragma unroll
        for (int e = 1; e < 8; ++e) if (le[e] > v0) { v0 = le[e]; i0 = e; }
        int i1 = 0; float v1 = -INFINITY;
#pragma unroll
        for (int e = 0; e < 8; ++e) if (e != i0 && le[e] > v1) { v1 = le[e]; i1 = e; }
        const float e1 = fast_exp(v1 - v0), p0 = 1.f / (1.f + e1), p1 = e1 * p0;
        const int ex0 = gi * 8 + i0, ex1 = gi * 8 + i1;
        rb.e[tok * 2] = ex0; rb.e[tok * 2 + 1] = ex1; rb.w[tok * 2] = gate_g * p0; rb.w[tok * 2 + 1] = gate_g * p1;
        rb.rank[tok * 2] = atomicAdd((int*)&hist[ex0], 1); rb.rank[tok * 2 + 1] = atomicAdd((int*)&hist[ex1], 1);
    }
    __syncthreads();
    if (tid < 32) rb.hist[blk * 32 + tid] = hist[tid];
}
__device__ __forceinline__ void moe_scatter_phase(LAS unsigned char* lds, const RouteBufs rb, int blk, int G) {
    int tid_ = threadIdx.x; asm volatile("" : "+v"(tid_)); const int tid = tid_, lane = tid & 63, wave = __builtin_amdgcn_readfirstlane(tid >> 6);
    LAS int* sb = (LAS int*)lds;
    __syncthreads();
    {
        const int e = tid & 31, part = tid >> 5; int c[16];
#pragma unroll
        for (int i = 0; i < 16; ++i) c[i] = rb.hist[(part * 16 + i) * 32 + e];
        int tot = 0, base = 0;
#pragma unroll
        for (int i = 0; i < 16; ++i) { tot += c[i]; if (part * 16 + i < blk) base += c[i]; }
        sb[128 + part * 32 + e] = base; sb[128 + 512 + part * 32 + e] = tot; }
    __syncthreads();
    if (tid < 32) { int tot = 0, base = 0;
#pragma unroll
        for (int i = 0; i < 16; ++i) { base += sb[128 + i * 32 + tid]; tot += sb[128 + 512 + i * 32 + tid]; }
        sb[tid] = base; sb[32 + tid] = tot; }
    __syncthreads();
    if (tid == 0) { int acc = 0; for (int e = 0; e < 32; ++e) { sb[64 + e] = acc; if (blk == 0) rb.tstart[e] = acc >> 8; acc += (sb[32 + e] + 255) & ~255; } sb[96] = acc; if (blk == 0) rb.tstart[32] = acc >> 8; }
    __syncthreads();
    if (tid < 256) { const int idx = blk * 256 + tid; const int e = rb.e[idx]; const int d = sb[64 + e] + sb[e] + rb.rank[idx]; rb.dest[idx] = d; rb.src[d] = idx >> 1; }
    if (blk < 32) { const int e = blk; const int lo = sb[64 + e] + sb[32 + e], hi = sb[64 + e] + ((sb[32 + e] + 255) & ~255); for (int r = lo + tid; r < hi; r += NTHR) rb.src[r] = 0; }
}
struct MoeSched {
    const char* A; const char* B; const int* tstart; int K, nN, G, c; size_t bexp;
    __device__ __forceinline__ pg8::Unit get(int i, bool& ok) const { pg8::Unit u; u.A = nullptr; u.B = nullptr; u.src = nullptr; u.pm = 0; u.pn = 0; u.job = 0; ok = next(i, u); return u; }
    __device__ __forceinline__ bool next(int i, pg8::Unit& u) const {
        const int vc = (c & 7) * (G >> 3) + (c >> 3);
        const long L = (long)i * G + vc; const int ntile = tstart[32];
        if (L >= (long)ntile * nN) return false;
        const int mt = (int)(L / nN), nt = (int)(L % nN);
        int e = 0;
        for (int k = 1; k < 32; ++k) if (tstart[k] <= mt) e = k;
        u.A = A + (size_t)mt * 256 * K * 2; u.B = B + (size_t)e * bexp + (size_t)nt * 256 * K * 2; u.src = nullptr; u.pm = mt; u.pn = nt; u.job = 0; return true;
    }
};
__device__ __forceinline__ void swa_phase(LAS unsigned char* lds, const bf16_t* __restrict__ Q1, const bf16_t* __restrict__ K1, const bf16_t* __restrict__ VT1, const float* __restrict__ sinks, bf16_t* __restrict__ O, int blk, int G) {
    int tid_ = threadIdx.x; asm volatile("" : "+v"(tid_)); const int tid = tid_, lane = tid & 63, wave = __builtin_amdgcn_readfirstlane(tid >> 6), r32 = lane & 31, hh = lane >> 5;
    LAS unsigned char* KL = lds;
    LAS unsigned char* VL = lds + 36864;
    for (int u = blk; u < 1024; u += G) {
        const int n = u & 31, kvh = (u >> 5) & 3, b = u >> 7;
        const int tokb = b * SEQ + (n - 1) * 128;
        bf16x8 qfa[2][4];
        {   const int g0 = wave >> 1, hq0 = kvh * 4 + g0;
#pragma unroll
            for (int sb = 0; sb < 2; ++sb)
#pragma unroll
                for (int ks = 0; ks < 4; ++ks) qfa[sb][ks] = *(const bf16x8*)(Q1 + ((size_t)b * SEQ + n * 128 + (wave & 1) * 64 + sb * 32 + r32) * 1024 + hq0 * 64 + ks * 16 + hh * 8); }
        __syncthreads();
#pragma unroll
        for (int i = 0; i < 4; ++i) { const int ch = tid + 512 * i; const int key = ch >> 3, c = ch & 7;
            u32x4 v = (u32x4){0u, 0u, 0u, 0u}; if (n > 0 || key >= 128) v = *(const u32x4*)(K1 + (size_t)(tokb + key) * 256 + kvh * 64 + c * 8);
            *(LAS u32x4*)(KL + key * 144 + c * 16) = v; }
#pragma unroll
        for (int i = 0; i < 4; ++i) { const int ch = tid + 512 * i; const int d = ch >> 5, c = ch & 31;
            u32x4 v = (u32x4){0u, 0u, 0u, 0u}; if (n > 0 || c >= 16) v = *(const u32x4*)(VT1 + (size_t)(kvh * 64 + d) * NT + tokb + c * 8);
            LAS u32x2* dp = (LAS u32x2*)(VL + d * 520 + c * 16); dp[0] = (u32x2){v.x, v.y}; dp[1] = (u32x2){v.z, v.w}; }
        __syncthreads();
        const int g = wave >> 1, hq = kvh * 4 + g; const float sink = sinks[hq];
#pragma unroll 1
        for (int sb = 0; sb < 2; ++sb) {
            bf16x8 qf[4];
#pragma unroll
            for (int ks = 0; ks < 4; ++ks) qf[ks] = sb ? qfa[1][ks] : qfa[0][ks];
            const int i0 = (wave & 1) * 64 + sb * 32, jt0 = i0 >> 5;
            const size_t qtok = (size_t)b * SEQ + n * 128 + i0 + r32;
            f32x16 s[5];
#pragma unroll
            for (int t = 0; t < 5; ++t) {
#pragma unroll
                for (int r = 0; r < 16; ++r) s[t][r] = 0.f;
                const LAS unsigned char* kp = KL + ((jt0 + t) * 32 + r32) * 144 + hh * 16;
#pragma unroll
                for (int ks = 0; ks < 4; ++ks) { const bf16x8 a = *(const LAS bf16x8*)(kp + ks * 32); s[t] = MFMA32(a, qf[ks], s[t]); }
            }
            const int qi = i0 + r32;
            float mx = sink;
#pragma unroll
            for (int t = 0; t < 5; ++t)
#pragma unroll
                for (int r = 0; r < 16; ++r) { const int kj = (jt0 + t) * 32 + crow(r, hh); const bool valid = (kj > qi) && (kj <= qi + 128) && (n > 0 || kj >= 128);
                    s[t][r] = valid ? s[t][r] : -INFINITY; mx = fmaxf(mx, s[t][r]); }
            mx = xhalf_max(mx);
            float sm = 0.f; const float mxl = mx * LOG2E;
            u32x4 pf[5][2];
#pragma unroll
            for (int t = 0; t < 5; ++t) {
#pragma unroll
                for (int r = 0; r < 16; ++r) { const float pv = __builtin_amdgcn_exp2f(s[t][r] * LOG2E - mxl); s[t][r] = pv; sm += pv; }
#pragma unroll
                for (int sx = 0; sx < 2; ++sx) pf[t][sx] = (u32x4){pk2(s[t][8 * sx], s[t][8 * sx + 1]), pk2(s[t][8 * sx + 2], s[t][8 * sx + 3]), pk2(s[t][8 * sx + 4], s[t][8 * sx + 5]), pk2(s[t][8 * sx + 6], s[t][8 * sx + 7])};
            }
            sm = xhalf_sum(sm) + __builtin_amdgcn_exp2f(sink * LOG2E - mxl);
            f32x16 o[2];
#pragma unroll
            for (int dt = 0; dt < 2; ++dt)
#pragma unroll
                for (int r = 0; r < 16; ++r) o[dt][r] = 0.f;
#pragma unroll
            for (int t = 0; t < 5; ++t)
#pragma unroll
                for (int sx = 0; sx < 2; ++sx) { const bf16x8 pb = __builtin_bit_cast(bf16x8, pf[t][sx]);
#pragma unroll
                    for (int dt = 0; dt < 2; ++dt) { const LAS unsigned char* q = VL + (dt * 32 + r32) * 520 + ((jt0 + t) * 32 + 16 * sx + 4 * hh) * 2;
                        const s16x4 lo = *(const LAS s16x4*)q, hi = *(const LAS s16x4*)(q + 16);
                        const bf16x8 a = (bf16x8){lo[0], lo[1], lo[2], lo[3], hi[0], hi[1], hi[2], hi[3]}; o[dt] = MFMA32(a, pb, o[dt]); } }
            const float inv = 1.f / sm;
            bf16_t* orow = O + qtok * 1024 + hq * 64 + 4 * hh;
#pragma unroll
            for (int dt = 0; dt < 2; ++dt)
#pragma unroll
                for (int gq = 0; gq < 4; ++gq) { u32x2 w; w.x = pk2(o[dt][4 * gq] * inv, o[dt][4 * gq + 1] * inv); w.y = pk2(o[dt][4 * gq + 2] * inv, o[dt][4 * gq + 3] * inv); *(u32x2*)(orow + dt * 32 + 8 * gq) = w; }
        }
    }
}
constexpr int TS = 272;
template <int STRIDE = TS>
__device__ __forceinline__ bf16x8 tr_frag(const LAS unsigned char* T, int k0, int c0, int lane, bool permuted) {
    const int hh = lane >> 5, blk = (lane >> 4) & 1, q = (lane & 15) >> 2, pp = lane & 3;
    const int r0 = k0 + (permuted ? 4 * hh : 8 * hh) + q, r1 = r0 + (permuted ? 8 : 4);
    const int cb = (c0 + 16 * blk + 4 * pp) * 2;
    const s16x4 lo = lds_tr(T + r0 * STRIDE + cb), hi = lds_tr(T + r1 * STRIDE + cb);
    return (bf16x8){lo[0], lo[1], lo[2], lo[3], hi[0], hi[1], hi[2], hi[3]};
}
__device__ __forceinline__ bf16x8 row_frag(const LAS unsigned char* T, int row, int k0, int hh) { return *(const LAS bf16x8*)(T + row * TS + (k0 + 8 * hh) * 2); }
__device__ __forceinline__ void load_tile128(LAS unsigned char* T, const bf16_t* __restrict__ g, int ld, int tid) {
#pragma unroll
    for (int i = 0; i < 4; ++i) { const int ch = tid + 512 * i, row = ch >> 4, c = ch & 15; *(LAS u32x4*)(T + row * TS + c * 16) = *(const u32x4*)(g + (size_t)row * ld + c * 8); }
}
struct L0Bufs {
    bf16_t *AU, *AV, *BX, *BZ, *V, *XC, *YM, *CS, *Q, *K, *U; float *GT, *UN, *NS, *SC;
    const bf16_t *WQT, *GMW, *MT; const float *gm_g, *gm_b, *gm_bs, *cw, *cb, *bif, *nw, *skip;
};

__device__ __forceinline__ void l0_mixA(LAS unsigned char* lds, const L0Bufs& B, int blk, int G) {
    const int tid0 = threadIdx.x, wave = __builtin_amdgcn_readfirstlane(tid0 >> 6);
#define OPQ_IDS int tid = tid0; asm volatile("" : "+v"(tid)); const int lane = tid & 63, r32 = lane & 31, hh = lane >> 5; (void)lane; (void)r32; (void)hh;
    LAS unsigned char* T0 = lds; LAS unsigned char* T1 = lds + 34816; LAS unsigned char* T2 = lds + 2 * 34816; LAS unsigned char* T3 = lds + 3 * 34816;
    LAS float* SF = (LAS float*)T2;
    LAS float* SG = (LAS float*)(lds + 3 * 34816 + 35632);
    for (int u = blk; u < 256; u += G) {
        const int tok0 = u * 128; const bool first = (u & 31) == 0;
        constexpr int VS = 1040;
        {   OPQ_IDS; const int trow = tid >> 2, q4 = tid & 3;
            const bf16_t* vr = B.AV + (size_t)(tok0 + trow) * 512 + q4 * 128; float s = 0.f, s2 = 0.f; u32x4 w[16];
#pragma unroll
            for (int i = 0; i < 16; ++i) w[i] = *(const u32x4*)(vr + i * 8);
#pragma unroll
            for (int i = 0; i < 16; ++i) { const float f[8] = {bf_lo(w[i].x), bf_hi(w[i].x), bf_lo(w[i].y), bf_hi(w[i].y), bf_lo(w[i].z), bf_hi(w[i].z), bf_lo(w[i].w), bf_hi(w[i].w)};
#pragma unroll
                for (int e = 0; e < 8; ++e) { s += f[e]; s2 += f[e] * f[e]; } }
            s += shx(s, 1, lane); s += shx(s, 2, lane); s2 += shx(s2, 1, lane); s2 += shx(s2, 2, lane);
            const float mean = s * (1.f / 512.f), rstd = rsqrtf(fmaxf(s2 * (1.f / 512.f) - mean * mean, 0.f) + LN_EPS);
            __syncthreads();
#pragma unroll
            for (int i = 0; i < 16; ++i) { const int cbase = q4 * 128 + i * 8; const f32x4 g0 = *(const f32x4*)(B.gm_g + cbase), g1 = *(const f32x4*)(B.gm_g + cbase + 4), b0 = *(const f32x4*)(B.gm_b + cbase), b1 = *(const f32x4*)(B.gm_b + cbase + 4);
                u32x4 o; o.x = pk2((bf_lo(w[i].x) - mean) * rstd * g0[0] + b0[0], (bf_hi(w[i].x) - mean) * rstd * g0[1] + b0[1]); o.y = pk2((bf_lo(w[i].y) - mean) * rstd * g0[2] + b0[2], (bf_hi(w[i].y) - mean) * rstd * g0[3] + b0[3]);
                o.z = pk2((bf_lo(w[i].z) - mean) * rstd * g1[0] + b1[0], (bf_hi(w[i].z) - mean) * rstd * g1[1] + b1[1]); o.w = pk2((bf_lo(w[i].w) - mean) * rstd * g1[2] + b1[2], (bf_hi(w[i].w) - mean) * rstd * g1[3] + b1[3]);
                *(LAS u32x4*)(lds + trow * VS + cbase * 2) = o; asm volatile("" ::: "memory"); }
            __syncthreads();
        }
        {   const int tb = wave & 3, dhf = wave >> 2;
#pragma unroll 1
            for (int g = 0; g < 4; ++g) {
                OPQ_IDS; const int t = 32 * tb + r32; const size_t tok = (size_t)tok0 + t;
                f32x16 acc[2];
#pragma unroll
                for (int dt = 0; dt < 2; ++dt)
#pragma unroll
                    for (int r = 0; r < 16; ++r) acc[dt][r] = 0.f;
                const bf16_t* wrow = B.GMW + ((size_t)g * 128 + t) * 128 + 8 * hh;
                bf16x8 bw[8];
#pragma unroll
                for (int ks = 0; ks < 8; ++ks) bw[ks] = *(const bf16x8*)(wrow + 16 * ks);
#pragma unroll
                for (int ks = 0; ks < 8; ++ks) if (ks <= 2 * tb + 1) {
#pragma unroll
                    for (int dt = 0; dt < 2; ++dt) { const bf16x8 a = tr_frag<VS>(lds, 16 * ks, g * 128 + 64 * dhf + 32 * dt, lane, false); acc[dt] = MFMA32(a, bw[ks], acc[dt]); } }
                const float bsv = B.gm_bs[g * 128 + t];
#pragma unroll
                for (int dt = 0; dt < 2; ++dt)
#pragma unroll
                    for (int gq = 0; gq < 4; ++gq) { const int col = g * 128 + 64 * dhf + 32 * dt + 8 * gq + 4 * hh; const u32x2 au = *(const u32x2*)(B.AU + tok * 512 + col);
                        u32x2 w; w.x = pk2(bf_lo(au.x) * (acc[dt][4 * gq] + bsv), bf_hi(au.x) * (acc[dt][4 * gq + 1] + bsv)); w.y = pk2(bf_lo(au.y) * (acc[dt][4 * gq + 2] + bsv), bf_hi(au.y) * (acc[dt][4 * gq + 3] + bsv));
                        *(u32x2*)(B.YM + tok * 1024 + col) = w; }
            }
        }
        f32x16 accg;
#pragma unroll
        for (int r = 0; r < 16; ++r) accg[r] = 0.f;
        LAS unsigned char* MTL = (LAS unsigned char*)SG;
#pragma unroll 1
        for (int h = 0; h < 4; ++h) {
            OPQ_IDS;
            __syncthreads();
            for (int ch = tid; ch < 131 * 16; ch += 512) { const int row = ch >> 4, c = ch & 15; u32x4 v = (u32x4){0u, 0u, 0u, 0u};
                if (!(first && row < 3)) v = *(const u32x4*)(B.BX + (size_t)(tok0 - 3 + row) * 512 + h * 128 + c * 8);
                *(LAS u32x4*)(T3 + row * TS + c * 16) = v; }
            load_tile128(T0, B.WQT + ((size_t)0 * 4 + h) * 128 * 128, 128, tid);
            load_tile128(T1, B.WQT + ((size_t)1 * 4 + h) * 128 * 128, 128, tid);
            if (tid < 256) { const int row = tid >> 5, c = tid & 31; *(LAS u32x4*)(MTL + row * 528 + c * 16) = *(const u32x4*)(B.MT + ((size_t)h * 8 + row) * 256 + c * 8); }
            __syncthreads();
            {   const int dc = tid & 15, chn = h * 128 + dc * 8; float w[4][8], cbv[8];
#pragma unroll
                for (int j = 0; j < 4; ++j)
#pragma unroll
                    for (int e = 0; e < 8; ++e) w[j][e] = B.cw[j * 512 + chn + e];
#pragma unroll
                for (int e = 0; e < 8; ++e) cbv[e] = B.cb[chn + e];
#pragma unroll 1
                for (int ps = 0; ps < 4; ++ps) { const int t = ps * 32 + (tid >> 4); float a[8];
#pragma unroll
                    for (int e = 0; e < 8; ++e) a[e] = cbv[e];
#pragma unroll
                    for (int j = 0; j < 4; ++j) { const u32x4 x = *(const LAS u32x4*)(T3 + (t + j) * TS + dc * 16);
                        a[0] += w[j][0] * bf_lo(x.x); a[1] += w[j][1] * bf_hi(x.x); a[2] += w[j][2] * bf_lo(x.y); a[3] += w[j][3] * bf_hi(x.y);
                        a[4] += w[j][4] * bf_lo(x.z); a[5] += w[j][5] * bf_hi(x.z); a[6] += w[j][6] * bf_lo(x.w); a[7] += w[j][7] * bf_hi(x.w); }
                    u32x4 o; o.x = pk2(silu_f(a[0]), silu_f(a[1])); o.y = pk2(silu_f(a[2]), silu_f(a[3])); o.z = pk2(silu_f(a[4]), silu_f(a[5])); o.w = pk2(silu_f(a[6]), silu_f(a[7]));
                    *(LAS u32x4*)(T2 + t * TS + dc * 16) = o; *(u32x4*)(B.XC + (size_t)(tok0 + t) * 512 + chn) = o; } }
            __syncthreads();
            {   const int tb = wave & 3, ehf = wave >> 2;
                {
                    OPQ_IDS; const LAS unsigned char* act = ehf ? T3 + 3 * TS : T2;
#pragma unroll
                    for (int ks = 0; ks < 8; ++ks) { const bf16x8 a = *(const LAS bf16x8*)(MTL + (r32 & 7) * 528 + (ehf * 128 + 16 * ks + 8 * hh) * 2); const bf16x8 bx = row_frag(act, 32 * tb + r32, 16 * ks, hh); accg = MFMA32(a, bx, accg); } }
#pragma unroll 1
                for (int mtx = 0; mtx < 2; ++mtx) {
                    OPQ_IDS;
                    const LAS unsigned char* wt = mtx ? T1 : T0;
                    f32x16 acc[2];
#pragma unroll
                    for (int et = 0; et < 2; ++et)
#pragma unroll
                        for (int r = 0; r < 16; ++r) acc[et][r] = 0.f;
#pragma unroll
                    for (int ks = 0; ks < 8; ++ks) { const bf16x8 bx = row_frag(T2, 32 * tb + r32, 16 * ks, hh);
#pragma unroll
                        for (int et = 0; et < 2; ++et) { const bf16x8 a = row_frag(wt, 64 * ehf + 32 * et + r32, 16 * ks, hh); acc[et] = MFMA32(a, bx, acc[et]); } }
                    bf16_t* dst = (mtx == 0 ? B.Q : B.K) + (size_t)(tok0 + 32 * tb + r32) * 512 + h * 128 + 64 * ehf + 4 * hh;
#pragma unroll
                    for (int et = 0; et < 2; ++et)
#pragma unroll
                        for (int gq = 0; gq < 4; ++gq) { u32x2 w; w.x = pk2(acc[et][4 * gq], acc[et][4 * gq + 1]); w.y = pk2(acc[et][4 * gq + 2], acc[et][4 * gq + 3]); *(u32x2*)(dst + 32 * et + 8 * gq) = w; }
                }
            }
            __syncthreads();
            load_tile128(T0, B.WQT + ((size_t)2 * 4 + h) * 128 * 128, 128, tid);
            __syncthreads();
            {   OPQ_IDS; const int tb = wave & 3, ehf = wave >> 2;
                f32x16 acc[2];
#pragma unroll
                for (int et = 0; et < 2; ++et)
#pragma unroll
                    for (int r = 0; r < 16; ++r) acc[et][r] = 0.f;
#pragma unroll
                for (int ks = 0; ks < 8; ++ks) { const bf16x8 bx = row_frag(T3 + 3 * TS, 32 * tb + r32, 16 * ks, hh);
#pragma unroll
                    for (int et = 0; et < 2; ++et) { const bf16x8 a = row_frag(T0, 64 * ehf + 32 * et + r32, 16 * ks, hh); acc[et] = MFMA32(a, bx, acc[et]); } }
                bf16_t* dst = B.V + (size_t)(tok0 + 32 * tb + r32) * 512 + h * 128 + 64 * ehf + 4 * hh;
#pragma unroll
                for (int et = 0; et < 2; ++et)
#pragma unroll
                    for (int gq = 0; gq < 4; ++gq) { u32x2 w; w.x = pk2(acc[et][4 * gq], acc[et][4 * gq + 1]); w.y = pk2(acc[et][4 * gq + 2], acc[et][4 * gq + 3]); *(u32x2*)(dst + 32 * et + 8 * gq) = w; }
            }
        }
        __syncthreads();
        {   OPQ_IDS; const int tb = wave & 3, kh = wave >> 2;
#pragma unroll
            for (int r = 0; r < 4; ++r) SF[(kh * 8 + r + 4 * hh) * 128 + 32 * tb + r32] = accg[r];
        }
        __syncthreads();
        LAS float* IG = SG; LAS float* BC = SG + 512; LAS float* WG = SG + 1024;
        if (wave < 4) {
            OPQ_IDS; const int h = wave; float lf[2], ig[2];
#pragma unroll
            for (int e = 0; e < 2; ++e) { const int t = 2 * lane + e; ig[e] = SF[h * 128 + t] + SF[(8 + h) * 128 + t] + B.bif[h];
                const float fx = SF[(4 + h) * 128 + t] + SF[(12 + h) * 128 + t] + B.bif[4 + h]; lf[e] = fminf(fx, 0.f) - log1pf(expf(-fabsf(fx))); }
            float run = lf[0] + lf[1];
#pragma unroll
            for (int o = 1; o < 64; o <<= 1) { const float v = shup(run, o, lane); if (lane >= o) run += v; }
            const float b1 = run, b0 = run - lf[1];
            IG[h * 128 + 2 * lane] = ig[0]; IG[h * 128 + 2 * lane + 1] = ig[1]; BC[h * 128 + 2 * lane] = b0; BC[h * 128 + 2 * lane + 1] = b1;
            float* gt = B.GT + ((size_t)u * 4 + h) * 256;
            gt[2 * lane] = ig[0]; gt[2 * lane + 1] = ig[1]; gt[128 + 2 * lane] = b0; gt[128 + 2 * lane + 1] = b1;
            const float bl = shidx(b1, 63);
            float g0 = bl - b0 + ig[0], g1 = bl - b1 + ig[1]; float mloc = fmaxf(g0, g1);
#pragma unroll
            for (int o = 1; o < 64; o <<= 1) mloc = fmaxf(mloc, shx(mloc, o, lane));
            WG[h * 128 + 2 * lane] = expf(g0 - mloc); WG[h * 128 + 2 * lane + 1] = expf(g1 - mloc);
            if (lane == 0) { B.SC[u * 4 + h] = bl; B.SC[1024 + u * 4 + h] = mloc; }
        }
#pragma unroll 1
        for (int h = 0; h < 4; ++h) {
            OPQ_IDS;
            __syncthreads();
#pragma unroll
            for (int i = 0; i < 4; ++i) { const int ch = tid + 512 * i, row = ch >> 4, c = ch & 15; const float wg = WG[h * 128 + row];
                const u32x4 v = *(const u32x4*)(B.V + (size_t)(tok0 + row) * 512 + h * 128 + c * 8), k = *(const u32x4*)(B.K + (size_t)(tok0 + row) * 512 + h * 128 + c * 8);
                u32x4 ov, ok; const float ksc = 0.08838834764831845f;
                ov.x = pk2(bf_lo(v.x) * wg, bf_hi(v.x) * wg); ov.y = pk2(bf_lo(v.y) * wg, bf_hi(v.y) * wg); ov.z = pk2(bf_lo(v.z) * wg, bf_hi(v.z) * wg); ov.w = pk2(bf_lo(v.w) * wg, bf_hi(v.w) * wg);
                ok.x = pk2(bf_lo(k.x) * ksc, bf_hi(k.x) * ksc); ok.y = pk2(bf_lo(k.y) * ksc, bf_hi(k.y) * ksc); ok.z = pk2(bf_lo(k.z) * ksc, bf_hi(k.z) * ksc); ok.w = pk2(bf_lo(k.w) * ksc, bf_hi(k.w) * ksc);
                *(LAS u32x4*)(T0 + row * TS + c * 16) = ov; *(LAS u32x4*)(T1 + row * TS + c * 16) = ok; }
            __syncthreads();
            const int vb = wave & 3, khf = wave >> 2;
            f32x16 acc[2];
#pragma unroll
            for (int kt = 0; kt < 2; ++kt)
#pragma unroll
                for (int r = 0; r < 16; ++r) acc[kt][r] = 0.f;
#pragma unroll
            for (int ks = 0; ks < 8; ++ks) { const bf16x8 a = tr_frag(T0, 16 * ks, 32 * vb, lane, false);
#pragma unroll
                for (int kt = 0; kt < 2; ++kt) { const bf16x8 bk = tr_frag(T1, 16 * ks, 64 * khf + 32 * kt, lane, false); acc[kt] = MFMA32(a, bk, acc[kt]); } }
            bf16_t* Uo = B.U + ((size_t)u * 4 + h) * 16384;
#pragma unroll
            for (int kt = 0; kt < 2; ++kt)
#pragma unroll
                for (int r = 0; r < 16; ++r) Uo[(32 * vb + crow(r, hh)) * 128 + 64 * khf + 32 * kt + r32] = f2bf(acc[kt][r]);
            {   const int kk = tid & 127, sq = tid >> 7; float a = 0.f;
                for (int s = sq * 32; s < sq * 32 + 32; ++s) a += WG[h * 128 + s] * bf2f(*(const LAS bf16_t*)(T1 + s * TS + kk * 2));
                SF[2048 + sq * 128 + kk] = a; }
            __syncthreads();
            if (tid < 128) B.UN[((size_t)u * 4 + h) * 128 + tid] = (SF[2048 + tid] + SF[2048 + 128 + tid]) + (SF[2048 + 256 + tid] + SF[2048 + 384 + tid]);
        }
    }
}
#undef OPQ_IDS
__device__ __forceinline__ void l0_scan(const L0Bufs& B, int blk, int tid) {
    const int bh = blk >> 3, part = blk & 7, b = bh >> 2, h = bh & 3;
    const int e0 = part * 2048 + tid * 8;
    f32x4 C0 = (f32x4){0.f, 0.f, 0.f, 0.f}, C1 = C0; float nst = 0.f; float m = 0.f;
    const int unit0 = (b * 32) * 4 + h;
    u32x4 Unw = *(const u32x4*)(B.U + (size_t)unit0 * 16384 + e0); float bln = B.SC[unit0], mln = B.SC[1024 + unit0];
    float unn = (part == 0 && tid < 128) ? B.UN[(size_t)unit0 * 128 + tid] : 0.f;
    for (int c = 0; c < 32; ++c) {
        const int unit = unit0 + 4 * c;
        const f32x4 U0 = (f32x4){bf_lo(Unw.x), bf_hi(Unw.x), bf_lo(Unw.y), bf_hi(Unw.y)}, U1 = (f32x4){bf_lo(Unw.z), bf_hi(Unw.z), bf_lo(Unw.w), bf_hi(Unw.w)}; const float bl = bln, mloc = mln, un = unn;
        if (c < 31) { const int un1 = unit + 4; Unw = *(const u32x4*)(B.U + (size_t)un1 * 16384 + e0); bln = B.SC[un1]; mln = B.SC[1024 + un1]; if (part == 0 && tid < 128) unn = B.UN[(size_t)un1 * 128 + tid]; }
        u32x4 w; w.x = pk2(C0[0], C0[1]); w.y = pk2(C0[2], C0[3]); w.z = pk2(C1[0], C1[1]); w.w = pk2(C1[2], C1[3]); *(u32x4*)(B.CS + (size_t)unit * 16384 + e0) = w;
        if (part == 0 && tid < 128) B.NS[(size_t)unit * 128 + tid] = nst;
        if (part == 0 && tid == 0) B.SC[2048 + unit] = m;
        const float mn = fmaxf(bl + m, mloc), dec = expf(bl + m - mn), wu = expf(mloc - mn); m = mn;
        C0 = C0 * dec + U0 * wu; C1 = C1 * dec + U1 * wu;
        nst = nst * dec + wu * un;
    }
}
__device__ __forceinline__ void l0_mixC(LAS unsigned char* lds, const L0Bufs& B, int blk, int G) {
    const int tid0 = threadIdx.x, wave = __builtin_amdgcn_readfirstlane(tid0 >> 6);
    LAS unsigned char* TQ = lds; LAS unsigned char* TK = lds + 34816; LAS unsigned char* TV = lds + 2 * 34816; LAS unsigned char* TC = lds + 3 * 34816;
    LAS float* SF = (LAS float*)(lds + 4 * 34816);
    LAS float* AS = SF; LAS float* PM = SF + 128; LAS float* NP = SF + 256; LAS float* PS = SF + 384; LAS float* PQ = SF + 640; LAS float* NW = SF + 896;
    __syncthreads();
    { int tq = tid0; asm volatile("" : "+v"(tq)); if (tq < 256) ((LAS f32x4*)NW)[tq] = tq < 128 ? ((const f32x4*)B.nw)[tq] : ((const f32x4*)B.skip)[tq - 128]; }
    for (int uu = blk; uu < 256; uu += G) {
        const int tok0 = uu * 128;
#pragma unroll 1
        for (int h = 0; h < 4; ++h) {
            const int unit = uu * 4 + h;
            int tid = tid0; asm volatile("" : "+v"(tid));
            const int lane = tid & 63, r32 = lane & 31, hh = lane >> 5;
            __syncthreads();
            load_tile128(TQ, B.Q + (size_t)tok0 * 512 + h * 128, 512, tid);
            load_tile128(TV, B.V + (size_t)tok0 * 512 + h * 128, 512, tid);
            load_tile128(TC, B.CS + (size_t)unit * 16384, 128, tid);
#pragma unroll
            for (int i = 0; i < 4; ++i) { const int ch = tid + 512 * i, row = ch >> 4, c = ch & 15; const u32x4 k = *(const u32x4*)(B.K + (size_t)(tok0 + row) * 512 + h * 128 + c * 8); const float ksc = 0.08838834764831845f;
                u32x4 ok; ok.x = pk2(bf_lo(k.x) * ksc, bf_hi(k.x) * ksc); ok.y = pk2(bf_lo(k.y) * ksc, bf_hi(k.y) * ksc); ok.z = pk2(bf_lo(k.z) * ksc, bf_hi(k.z) * ksc); ok.w = pk2(bf_lo(k.w) * ksc, bf_hi(k.w) * ksc);
                *(LAS u32x4*)(TK + row * TS + c * 16) = ok; }
            const float mprev = B.SC[2048 + unit];
            if (wave == 0) {
                const float* gt = B.GT + (size_t)unit * 256;
                const float a0 = gt[2 * lane] - gt[128 + 2 * lane], a1 = gt[2 * lane + 1] - gt[128 + 2 * lane + 1];
                float run = fmaxf(a0, a1);
#pragma unroll
                for (int o = 1; o < 64; o <<= 1) { const float v = shup(run, o, lane); if (lane >= o) run = fmaxf(run, v); }
                const float prev = shup(run, 1, lane); const float p0 = fmaxf(lane > 0 ? fmaxf(prev, a0) : a0, mprev), p1 = fmaxf(run, mprev);
                AS[2 * lane] = a0; AS[2 * lane + 1] = a1; PM[2 * lane] = p0; PM[2 * lane + 1] = p1;
            }
            if (wave == 1) { NP[lane] = B.NS[(size_t)unit * 128 + lane]; NP[64 + lane] = B.NS[(size_t)unit * 128 + 64 + lane]; }
            __syncthreads();
            const int tb = wave & 3, vh = wave >> 2, t = 32 * tb + r32;
            const float pm = PM[t], bt = B.GT[(size_t)unit * 256 + 128 + t];
            f32x16 s[4];
#pragma unroll
            for (int st = 0; st < 4; ++st)
#pragma unroll
                for (int r = 0; r < 16; ++r) s[st][r] = 0.f;
            {   int lv = lane; asm volatile("" : "+v"(lv));
                const LAS unsigned char* qp = TQ + (32 * tb + (lv & 31)) * TS + (lv >> 5) * 16; const LAS unsigned char* kp = TK + (lv & 31) * TS + (lv >> 5) * 16;
#pragma unroll 2
                for (int ks = 0; ks < 8; ++ks) { const bf16x8 bq = *(const LAS bf16x8*)(qp + ks * 32);
#pragma unroll
                    for (int st = 0; st < 4; ++st) if (st <= tb) { const bf16x8 a = *(const LAS bf16x8*)(kp + st * 32 * TS + ks * 32); s[st] = MFMA32(a, bq, s[st]); } } }
            float nq = 0.f; u32x4 pf[4][2];
#pragma unroll
            for (int st = 0; st < 4; ++st) {
#pragma unroll
                for (int r = 0; r < 16; ++r) { const int sidx = 32 * st + crow(r, hh); const float wv = (sidx <= t) ? __builtin_amdgcn_exp2f((AS[sidx] - pm) * LOG2E) : 0.f; const float pv = s[st][r] * wv; s[st][r] = pv; nq += pv; }
#pragma unroll
                for (int sx = 0; sx < 2; ++sx) pf[st][sx] = (u32x4){pk2(s[st][8 * sx], s[st][8 * sx + 1]), pk2(s[st][8 * sx + 2], s[st][8 * sx + 3]), pk2(s[st][8 * sx + 4], s[st][8 * sx + 5]), pk2(s[st][8 * sx + 6], s[st][8 * sx + 7])};
            }
            nq = xhalf_sum(nq);
            float nqi = 0.f;
#pragma unroll
            for (int i = 0; i < 8; ++i) { const u32x4 qv = *(const LAS u32x4*)(TQ + t * TS + (64 * hh + 8 * i) * 2); const LAS float* np = NP + 64 * hh + 8 * i;
                nqi += bf_lo(qv.x) * np[0] + bf_hi(qv.x) * np[1] + bf_lo(qv.y) * np[2] + bf_hi(qv.y) * np[3] + bf_lo(qv.z) * np[4] + bf_hi(qv.z) * np[5] + bf_lo(qv.w) * np[6] + bf_hi(qv.w) * np[7]; }
            nqi = xhalf_sum(nqi);
            const float wst = __builtin_amdgcn_exp2f((mprev - pm) * LOG2E);
            const float den = fmaxf(fabsf(nq + wst * nqi), __builtin_amdgcn_exp2f(-(bt + pm) * LOG2E)), rden = 1.f / den;
            f32x16 ni[2], nx[2];
#pragma unroll
            for (int vt = 0; vt < 2; ++vt)
#pragma unroll
                for (int r = 0; r < 16; ++r) { ni[vt][r] = 0.f; nx[vt][r] = 0.f; }
            {   int lv = lane; asm volatile("" : "+v"(lv));
#pragma unroll
                for (int st = 0; st < 4; ++st) {
                    if (st <= tb) {
#pragma unroll
                        for (int sx = 0; sx < 2; ++sx) { const bf16x8 pb = __builtin_bit_cast(bf16x8, pf[st][sx]);
#pragma unroll
                            for (int vt = 0; vt < 2; ++vt) { const bf16x8 a = tr_frag(TV, 32 * st + 16 * sx, 64 * vh + 32 * vt, lv, true); ni[vt] = MFMA32(a, pb, ni[vt]); } }
                    }
                } }
            {   int lv = lane; asm volatile("" : "+v"(lv));
                const LAS unsigned char* qp = TQ + (32 * tb + (lv & 31)) * TS + (lv >> 5) * 16; const LAS unsigned char* cp = TC + (64 * vh + (lv & 31)) * TS + (lv >> 5) * 16;
#pragma unroll 2
                for (int ks = 0; ks < 8; ++ks) { const bf16x8 bq = *(const LAS bf16x8*)(qp + ks * 32);
#pragma unroll
                    for (int vt = 0; vt < 2; ++vt) { const bf16x8 a = *(const LAS bf16x8*)(cp + vt * 32 * TS + ks * 32); nx[vt] = MFMA32(a, bq, nx[vt]); } } }
            const size_t tok = (size_t)tok0 + t;
            u32x2 xcv[2][4], zv[2][4];
#pragma unroll
            for (int vt = 0; vt < 2; ++vt)
#pragma unroll
                for (int gq = 0; gq < 4; ++gq) { const int chn = h * 128 + 64 * vh + 32 * vt + 8 * gq + 4 * hh; xcv[vt][gq] = *(const u32x2*)(B.XC + tok * 512 + chn); zv[vt][gq] = *(const u32x2*)(B.BZ + tok * 512 + chn); }
            float hs = 0.f, hq = 0.f;
#pragma unroll
            for (int vt = 0; vt < 2; ++vt)
#pragma unroll
                for (int r = 0; r < 16; ++r) { const float hv = (ni[vt][r] + wst * nx[vt][r]) * rden; ni[vt][r] = hv; hs += hv; hq += hv * hv; }
            hs = xhalf_sum(hs); hq = xhalf_sum(hq);
            if (hh == 0) { PS[vh * 128 + t] = hs; PQ[vh * 128 + t] = hq; }
            __syncthreads();
            const float mean = (PS[t] + PS[128 + t]) * (1.f / 128.f);
            const float rstd = rsqrtf(fmaxf((PQ[t] + PQ[128 + t]) * (1.f / 128.f) - mean * mean, 0.f) + LN_EPS);
#pragma unroll
            for (int vt = 0; vt < 2; ++vt)
#pragma unroll
                for (int gq = 0; gq < 4; ++gq) { const int cl = 64 * vh + 32 * vt + 8 * gq + 4 * hh, chn = h * 128 + cl;
                    const f32x4 nw = *(const LAS f32x4*)(NW + chn), sk = *(const LAS f32x4*)(NW + 512 + chn); const u32x2 xc = xcv[vt][gq], z = zv[vt][gq];
                    const float y0 = ((ni[vt][4 * gq] - mean) * rstd * nw[0] + sk[0] * bf_lo(xc.x)) * silu_f(bf_lo(z.x)), y1 = ((ni[vt][4 * gq + 1] - mean) * rstd * nw[1] + sk[1] * bf_hi(xc.x)) * silu_f(bf_hi(z.x));
                    const float y2 = ((ni[vt][4 * gq + 2] - mean) * rstd * nw[2] + sk[2] * bf_lo(xc.y)) * silu_f(bf_lo(z.y)), y3 = ((ni[vt][4 * gq + 3] - mean) * rstd * nw[3] + sk[3] * bf_hi(xc.y)) * silu_f(bf_hi(z.y));
                    u32x2 w; w.x = pk2(y0, y1); w.y = pk2(y2, y3); *(u32x2*)(B.YM + tok * 1024 + 512 + chn) = w; }
        }
    }
}
constexpr size_t MB = 1048576ull;
constexpr size_t P_WIN_T = 0, P_WOUT_T = P_WIN_T + 4 * MB, P_WQKV_T = P_WOUT_T + 2 * MB, P_WO_T = P_WQKV_T + 3 * MB, P_XWQ_T = P_WO_T + 2 * MB, P_XWKV_T = P_XWQ_T + 4 * MB, P_XWO_T = P_XWKV_T + 8 * MB,
                 P_MLW_T = P_XWO_T + 4 * MB, P_WIFT = P_MLW_T + MB / 2, P_WRT = P_WIFT + MB / 8, P_ROT = P_WRT + MB / 2, P_BQK = P_ROT + MB, P_MEMB = P_BQK + MB / 8, P_KC = P_MEMB + 4 * MB, P_VT = P_KC + 8 * MB,
                 P_W13T = P_VT + 8 * MB, P_W2T = P_W13T + 64 * MB, P_XBF = P_W2T + 32 * MB, P_RT = P_XBF + 64 * MB, P_TMP = P_RT + 2 * MB;
constexpr size_t RT_SRC = 1638400;
constexpr size_t RT_E = 0, RT_W = 262144, RT_RANK = 2 * 262144, RT_DEST = 3 * 262144, RT_HIST = 4 * 262144, RT_TSTART = RT_HIST + 32768;
constexpr size_t T_QX = 0, T_OB = 64 * MB, T_YB = 128 * MB;
constexpr size_t T_K1 = 192 * MB, T_VT1 = 208 * MB;
constexpr size_t T_AU = 0, T_AV = 32 * MB, T_BX = 64 * MB, T_BZ = 96 * MB, T_V = 128 * MB, T_XC = 160 * MB, T_YM = 192 * MB, T_U = 256 * MB, T_CS = 320 * MB,
                 T_GT = 352 * MB, T_UN = 353 * MB, T_NS = 353 * MB + MB / 2, T_SC = 354 * MB, T_YB0 = 0;
constexpr size_t T_XG = 0, T_HM = 152 * MB, T_YG = 0;
constexpr size_t FAST_END = P_TMP + 360 * MB;
constexpr int LDS_BYTES = 147456;

struct FP {
    const float* in[33]; float* X;
    unsigned char* ws;
};
typedef const float* const __attribute__((address_space(4)))* InTab;
struct PV { InTab in; float* X; unsigned char* ws; };
__device__ __forceinline__ PV make_pv(const FP& p0) {
    PV p; InTab kp = (InTab)__builtin_amdgcn_kernarg_segment_ptr(); asm volatile("" : "+s"(kp)); p.in = kp;
    p.X = p0.X; p.ws = p0.ws; asm volatile("" : "+s"(p.ws)); return p;
}
#define WSP(T, off) ((T*)(p.ws + (off)))

__device__ __forceinline__ RouteBufs route_bufs(const PV& p) {
    RouteBufs r; r.e = WSP(int, P_RT + RT_E); r.w = WSP(float, P_RT + RT_W); r.rank = WSP(int, P_RT + RT_RANK); r.dest = WSP(int, P_RT + RT_DEST); r.hist = WSP(int, P_RT + RT_HIST); r.tstart = WSP(int, P_RT + RT_TSTART); r.src = WSP(int, P_RT + RT_SRC); return r;
}
#define PH_ARGS const PV& p, LAS unsigned char* lds, int blk, int G
#define PH_IDS int tid_ = threadIdx.x; asm volatile("" : "+v"(tid_)); const int tid = tid_, lane = tid & 63, wave = __builtin_amdgcn_readfirstlane(tid >> 6); (void)lane; (void)wave;

__device__ __forceinline__ void ph_conv_xattn(PH_ARGS, int l) {
    PH_IDS; LAS float* scr = (LAS float*)(lds + wave * 8448); const int gw = blk * NWAVE + wave, ngw = G * NWAVE;
    convert_mats(p.in[23] + (size_t)l * 1024 * 1024, 1024, 1024, 1, 0, WSP(bf16_t, P_XWQ_T) + (size_t)l * 1024 * 1024, 0, RM_IDENT, 0.0625f, 1024, scr, gw, ngw, lane);
    convert_mats(p.in[24] + (size_t)l * 1024 * 2048, 1024, 2048, 1, 0, WSP(bf16_t, P_XWKV_T) + (size_t)l * 2048 * 1024, 0, RM_IDENT, 1.f, 0, scr, gw, ngw, lane);
    convert_mats(p.in[25] + (size_t)l * 1024 * 1024, 1024, 1024, 1, 0, WSP(bf16_t, P_XWO_T) + (size_t)l * 1024 * 1024, 0, RM_IDENT, 1.f, 0, scr, gw, ngw, lane);
    convert_rows(p.in[1], WSP(bf16_t, P_MEMB), (size_t)2048 * 1024, blk * NTHR + tid, G * NTHR);
}
__device__ __forceinline__ void conv_moe_waves(const PV& p, int l, LAS float* scr, int gw, int ngw, int gt, int ngt, int lane) {
    const size_t wl = (size_t)l * 32 * 1024 * 512;
    convert_mats(p.in[30] + wl, 1024, 512, 32, (size_t)1024 * 512, WSP(bf16_t, P_W13T), (size_t)1024 * 1024, RM_PAIR0, 1.f, 0, scr, gw, ngw, lane);
    convert_mats(p.in[31] + wl, 1024, 512, 32, (size_t)1024 * 512, WSP(bf16_t, P_W13T), (size_t)1024 * 1024, RM_PAIR1, 1.f, 0, scr, gw, ngw, lane);
    convert_mats(p.in[32] + wl, 512, 1024, 32, (size_t)512 * 1024, WSP(bf16_t, P_W2T), (size_t)1024 * 512, RM_IDENT, 1.f, 0, scr, gw, ngw, lane);
    bf16_t* wrt = WSP(bf16_t, P_WRT) + (size_t)l * 2 * 64 * 1024; const float* wre = p.in[28] + (size_t)l * 1024 * 32; const float* wrg = p.in[26] + (size_t)l * 1024 * 4;
    for (int i = gt; i < 64 * 1024; i += ngt) { const int r = i >> 10, k = i & 1023;
        const float v = r < 32 ? wre[k * 32 + r] : (r < 36 ? wrg[k * 4 + (r - 32)] : 0.f);
        const bf16_t h = f2bf(v); wrt[i] = h; wrt[64 * 1024 + i] = f2bf(v - bf2f(h)); }
}
__device__ __forceinline__ void ph_conv_moe(PH_ARGS, int l) {
    PH_IDS; conv_moe_waves(p, l, (LAS float*)(lds + wave * 8448), blk * NWAVE + wave, G * NWAVE, blk * NTHR + tid, G * NTHR, lane);
}
__device__ __forceinline__ void ph_x_to_bf(PH_ARGS) { PH_IDS; convert_rows(p.X, WSP(bf16_t, P_XBF), (size_t)NT * 1024, blk * NTHR + tid, G * NTHR); }

__device__ __forceinline__ void set_job(LAS pg8::JobDesc* jt, int j, const void* A, const void* B, int nM, int nN, void* out, int ldc, int mode, const void* bias = nullptr, const void* rot = nullptr, void* out2 = nullptr) {
    unsigned long long a = (unsigned long long)A, b = (unsigned long long)B, o = (unsigned long long)out, bi = (unsigned long long)bias, ro = (unsigned long long)rot, o2 = (unsigned long long)out2;
    asm volatile("" : "+s"(a), "+s"(b), "+s"(o), "+s"(bi), "+s"(ro), "+s"(o2), "+s"(nM), "+s"(nN), "+s"(ldc), "+s"(mode));
    LAS pg8::JobDesc* d = jt + j; d->A = a; d->B = b; d->out = o; d->bias = bi; d->rot = ro; d->out2 = o2;
    d->nM = nM; d->nN = nN; d->ldc = ldc; d->mode = mode;
}
#define JT_PTR ((LAS pg8::JobDesc*)(lds + pg8::JT_OFF))
__device__ __forceinline__ void run_jobs(LAS unsigned char* lds, int K, int n0, int n1, int n2, int blk, int G) {
    __syncthreads();
    pg8::Jobs3 S; S.jt = JT_PTR; S.n0 = n0; S.n1 = n1; S.n2 = n2; S.K = K; S.G = G; S.c = blk;
    EpiMulti E; E.jt = JT_PTR;
    pg8::gemm_phase<EpiMulti, pg8::Jobs3, true, true>(lds, K, S, E);
}
__device__ __forceinline__ void ph_xattn_g1(PH_ARGS, int l) {
    const bf16_t* wkv = WSP(bf16_t, P_XWKV_T) + (size_t)l * 2048 * 1024;
    __syncthreads();
    if (threadIdx.x == 0) {
        set_job(JT_PTR, 0, WSP(bf16_t, P_MEMB), wkv, 8, 4, WSP(bf16_t, P_KC) + (size_t)l * 2048 * 1024, 1024, EM_PLAIN);
        set_job(JT_PTR, 1, wkv + (size_t)1024 * 1024, WSP(bf16_t, P_MEMB), 4, 8, WSP(bf16_t, P_VT) + (size_t)l * 1024 * 2048, 2048, EM_PLAIN);
        set_job(JT_PTR, 2, WSP(bf16_t, P_XBF), WSP(bf16_t, P_XWQ_T) + (size_t)l * 1024 * 1024, 128, 4, WSP(bf16_t, P_TMP + T_QX), 1024, EM_PLAIN);
    }
    run_jobs(lds, 1024, 32, 32, 512, blk, G);
}
__device__ __forceinline__ void ph_xattn_attn(PH_ARGS, int l) {
    xattn_phase(lds, WSP(bf16_t, P_TMP + T_QX), WSP(bf16_t, P_KC) + (size_t)l * 2048 * 1024, WSP(bf16_t, P_VT) + (size_t)l * 1024 * 2048, WSP(bf16_t, P_TMP + T_OB), blk, G);
}
__device__ __forceinline__ void ph_gemm_plain(PH_ARGS, const bf16_t* A, const bf16_t* Bt, bf16_t* out) {
    __syncthreads();
    if (threadIdx.x == 0) set_job(JT_PTR, 0, A, Bt, 128, 4, out, 1024, EM_PLAIN);
    run_jobs(lds, 1024, 512, 0, 0, blk, G);
}
template <bool XF32, bool OUTF32, bool MOE>
__device__ __forceinline__ void ph_ln(PH_ARGS, const bf16_t* y, int lnidx, bool dry = false) {
    PH_IDS; LnArgs a; a.xin32 = p.in[0]; a.xin = WSP(bf16_t, P_XBF); a.xout32 = dry ? WSP(float, P_TMP + 200 * MB) : p.X; a.xbf = dry ? WSP(bf16_t, P_TMP + 288 * MB) : WSP(bf16_t, P_XBF); a.y = y; a.g = p.in[2] + lnidx * 1024; a.b = p.in[3] + lnidx * 1024;
    a.dest = WSP(int, P_RT + RT_DEST); a.wts = WSP(float, P_RT + RT_W);
    ln_phase<XF32, OUTF32, MOE>(a, blk, G, wave, lane);
}
__device__ __forceinline__ void ph_moe_route(PH_ARGS, int l) {
    moe_router_phase(lds, WSP(bf16_t, P_XBF), WSP(bf16_t, P_WRT) + (size_t)l * 2 * 64 * 1024, p.in[27] + l * 4, p.in[29] + l * 32, route_bufs(p), blk);
}
__device__ __forceinline__ void ph_moe_scatter(PH_ARGS) { moe_scatter_phase(lds, route_bufs(p), blk, G); }
__device__ __forceinline__ void ph_moe_g1(PH_ARGS) {
    __syncthreads();
    if (threadIdx.x == 0) set_job(JT_PTR, 0, nullptr, nullptr, 0, 0, WSP(bf16_t, P_TMP + T_HM), 512, EM_SWIGLU);
    __syncthreads();
    MoeSched S; S.A = (const char*)WSP(bf16_t, P_TMP + T_XG); S.B = (const char*)WSP(bf16_t, P_W13T); S.tstart = WSP(int, P_RT + RT_TSTART); S.K = 1024; S.nN = 4; S.G = G; S.c = blk; S.bexp = (size_t)1024 * 1024 * 2;
    EpiMulti E; E.jt = JT_PTR;
    pg8::gemm_phase<EpiMulti, MoeSched, true, true>(lds, 1024, S, E);
}
__device__ __forceinline__ void ph_moe_g2(PH_ARGS) {
    __syncthreads();
    if (threadIdx.x == 0) set_job(JT_PTR, 0, nullptr, nullptr, 0, 0, WSP(bf16_t, P_TMP + T_YG), 1024, EM_PLAIN);
    __syncthreads();
    MoeSched S; S.A = (const char*)WSP(bf16_t, P_TMP + T_HM); S.B = (const char*)WSP(bf16_t, P_W2T); S.tstart = WSP(int, P_RT + RT_TSTART); S.K = 512; S.nN = 4; S.G = G; S.c = blk; S.bexp = (size_t)1024 * 512 * 2;
    EpiMulti E; E.jt = JT_PTR;
    pg8::gemm_phase<EpiMulti, MoeSched, true, true>(lds, 512, S, E);
}

__device__ __forceinline__ void ph_conv_l1(PH_ARGS) {
    PH_IDS; LAS float* scr = (LAS float*)(lds + wave * 8448); const int gw = blk * NWAVE + wave, ngw = G * NWAVE;
    convert_mats(p.in[19], 1024, 1536, 1, 0, WSP(bf16_t, P_WQKV_T), 0, RM_ROT, 0.125f, 1024, scr, gw, ngw, lane);
    convert_mats(p.in[22], 1024, 1024, 1, 0, WSP(bf16_t, P_WO_T), 0, RM_IDENT, 1.f, 0, scr, gw, ngw, lane);
    const int gt = blk * NTHR + tid, ngt = G * NTHR;
    float* bqk = WSP(float, P_BQK);
    for (int n = gt; n < 1280; n += ngt) bqk[rowmap(RM_ROT, n)] = p.in[20][n] * (n < 1024 ? 0.125f : 1.f);
    float* rot = WSP(float, P_ROT);
    for (int i = gt; i < 4096 * 32; i += ngt) { const int pos = i >> 5, k = i & 31; const float inv = powf(10000.f, -(float)(2 * k) / 64.f); const float ang = (float)pos * inv; rot[2 * i] = cosf(ang); rot[2 * i + 1] = sinf(ang); }
}
__device__ __forceinline__ void ph_l1_g1(PH_ARGS) {
    __syncthreads();
    if (threadIdx.x == 0) {
        set_job(JT_PTR, 0, WSP(bf16_t, P_XBF), WSP(bf16_t, P_WQKV_T), 128, 5, WSP(bf16_t, P_TMP + T_QX), 1024, EM_ROTARY, WSP(float, P_BQK), WSP(float, P_ROT), WSP(bf16_t, P_TMP + T_K1));
        set_job(JT_PTR, 1, WSP(bf16_t, P_WQKV_T) + (size_t)1280 * 1024, WSP(bf16_t, P_XBF), 1, 128, WSP(bf16_t, P_TMP + T_VT1), NT, EM_ROWBIAS, p.in[20] + 1280);
    }
    run_jobs(lds, 1024, 640, 128, 0, blk, G);
}
__device__ __forceinline__ void ph_l1_swa(PH_ARGS) {
    swa_phase(lds, WSP(bf16_t, P_TMP + T_QX), WSP(bf16_t, P_TMP + T_K1), WSP(bf16_t, P_TMP + T_VT1), p.in[21], WSP(bf16_t, P_TMP + T_OB), blk, G);
}

__device__ __forceinline__ L0Bufs l0_bufs(const PV& p) {
    L0Bufs B; B.AU = WSP(bf16_t, P_TMP + T_AU); B.AV = WSP(bf16_t, P_TMP + T_AV); B.BX = WSP(bf16_t, P_TMP + T_BX); B.BZ = WSP(bf16_t, P_TMP + T_BZ); B.V = WSP(bf16_t, P_TMP + T_V); B.XC = WSP(bf16_t, P_TMP + T_XC);
    B.YM = WSP(bf16_t, P_TMP + T_YM); B.CS = WSP(bf16_t, P_TMP + T_CS); B.U = WSP(bf16_t, P_TMP + T_U); B.GT = WSP(float, P_TMP + T_GT); B.UN = WSP(float, P_TMP + T_UN); B.NS = WSP(float, P_TMP + T_NS); B.SC = WSP(float, P_TMP + T_SC);
    B.Q = B.AU; B.K = B.AV;
    B.WQT = WSP(bf16_t, P_MLW_T); B.GMW = WSP(bf16_t, P_MLW_T) + 12 * 16384; B.MT = WSP(bf16_t, P_WIFT);
    B.gm_g = p.in[5]; B.gm_b = p.in[6]; B.gm_bs = p.in[8]; B.cw = p.in[9]; B.cb = p.in[10]; B.bif = p.in[15]; B.nw = p.in[16]; B.skip = p.in[17]; return B;
}
__device__ __forceinline__ void ph_scan_conv(PH_ARGS) {
    PH_IDS;
    if (wave < 4) l0_scan(l0_bufs(p), blk, tid);
}
__device__ __forceinline__ void ph_conv_l0(PH_ARGS) {
    PH_IDS; LAS float* scr = (LAS float*)(lds + wave * 8448); const int gw = blk * NWAVE + wave, ngw = G * NWAVE;
    convert_mats(p.in[4], 1024, 2048, 1, 0, WSP(bf16_t, P_WIN_T), 0, RM_IDENT, 1.f, 0, scr, gw, ngw, lane);
    convert_mats(p.in[18], 1024, 1024, 1, 0, WSP(bf16_t, P_WOUT_T), 0, RM_IDENT, 1.f, 0, scr, gw, ngw, lane);
    convert_mats(p.in[11], 128, 128, 4, 16384, WSP(bf16_t, P_MLW_T), 16384, RM_IDENT, 1.f, 0, scr, gw, ngw, lane);
    convert_mats(p.in[12], 128, 128, 4, 16384, WSP(bf16_t, P_MLW_T) + 4 * 16384, 16384, RM_IDENT, 1.f, 0, scr, gw, ngw, lane);
    convert_mats(p.in[13], 128, 128, 4, 16384, WSP(bf16_t, P_MLW_T) + 8 * 16384, 16384, RM_IDENT, 1.f, 0, scr, gw, ngw, lane);
    const int gt = blk * NTHR + tid, ngt = G * NTHR;
    bf16_t* gmw = WSP(bf16_t, P_MLW_T) + 12 * 16384;
    for (int i = gt; i < 4 * 16384; i += ngt) { const int t = (i >> 7) & 127, sidx = i & 127; gmw[i] = f2bf(sidx <= t ? p.in[7][i] : 0.f); }
    bf16_t* mt = WSP(bf16_t, P_WIFT);
    for (int i = gt; i < 4 * 8 * 256; i += ngt) { const int h = i >> 11, g = (i >> 8) & 7, j = i & 255, d = j & 127; float a = 0.f;
        if (j < 128) { for (int e = 0; e < 128; ++e) a += p.in[11][((size_t)h * 128 + d) * 128 + e] * p.in[14][(h * 128 + e) * 8 + g] + p.in[12][((size_t)h * 128 + d) * 128 + e] * p.in[14][(512 + h * 128 + e) * 8 + g]; }
        else { for (int e = 0; e < 128; ++e) a += p.in[13][((size_t)h * 128 + d) * 128 + e] * p.in[14][(1024 + h * 128 + e) * 8 + g]; }
        mt[i] = f2bf(a); }
}
__device__ __forceinline__ void ph_xin_to_bf(PH_ARGS) { PH_IDS; convert_rows(p.in[0], WSP(bf16_t, P_XBF), (size_t)NT * 1024, blk * NTHR + tid, G * NTHR); }
__device__ __forceinline__ void ph_l0_g1(PH_ARGS) {
    __syncthreads();
    if (threadIdx.x == 0) set_job(JT_PTR, 0, WSP(bf16_t, P_XBF), WSP(bf16_t, P_WIN_T), 128, 8, WSP(bf16_t, P_TMP + T_AU), 512, EM_GELU4);
    run_jobs(lds, 1024, 1024, 0, 0, blk, G);
}

enum { K_CONV_XATTN = 0, K_CONV_MOE, K_X2BF, K_XATTN_G1, K_XATTN_ATTN, K_XATTN_G2, K_LN_Y, K_MOE_ROUTE, K_MOE_SCATTER, K_MOE_G1, K_MOE_G2, K_LN_MOE, K_CONV_L1, K_L1_G1, K_L1_SWA, K_L1_G2, K_CONV_L0, K_XIN2BF, K_L0_G1, K_L0_MIXA, K_L0_SCAN, K_L0_MIXC, K_L0_G2, K_LN_Y0 };
template <int PH>
__global__ void __launch_bounds__(NTHR, 2) k_phase(FP p0, int l, int lnidx) {
    const PV p = make_pv(p0);
    extern __shared__ __attribute__((aligned(16))) unsigned char smem[];
    LAS unsigned char* lds = (LAS unsigned char*)smem;
    const int blk = blockIdx.x, G = gridDim.x;
    if constexpr (PH == K_CONV_XATTN) ph_conv_xattn(p, lds, blk, G, l);
    if constexpr (PH == K_CONV_MOE) ph_conv_moe(p, lds, blk, G, l);
    if constexpr (PH == K_X2BF) ph_x_to_bf(p, lds, blk, G);
    if constexpr (PH == K_XATTN_G1) ph_xattn_g1(p, lds, blk, G, l);
    if constexpr (PH == K_XATTN_ATTN) ph_xattn_attn(p, lds, blk, G, l);
    if constexpr (PH == K_XATTN_G2) ph_gemm_plain(p, lds, blk, G, WSP(bf16_t, P_TMP + T_OB), WSP(bf16_t, P_XWO_T) + (size_t)l * 1024 * 1024, WSP(bf16_t, P_TMP + T_YB));
    if constexpr (PH == K_LN_Y) ph_ln<false, false, false>(p, lds, blk, G, WSP(bf16_t, P_TMP + T_YB), lnidx);
    if constexpr (PH == K_MOE_ROUTE) ph_moe_route(p, lds, blk, G, l);
    if constexpr (PH == K_MOE_SCATTER) ph_moe_scatter(p, lds, blk, G);
    if constexpr (PH == K_MOE_G1) ph_moe_g1(p, lds, blk, G);
    if constexpr (PH == K_MOE_G2) ph_moe_g2(p, lds, blk, G);
    if constexpr (PH == K_LN_MOE) ph_ln<false, false, true>(p, lds, blk, G, WSP(bf16_t, P_TMP + T_YG), lnidx);
    if constexpr (PH == K_CONV_L0) ph_conv_l0(p, lds, blk, G);
    if constexpr (PH == K_XIN2BF) ph_xin_to_bf(p, lds, blk, G);
    if constexpr (PH == K_L0_G1) ph_l0_g1(p, lds, blk, G);
    if constexpr (PH == K_L0_MIXA) l0_mixA(lds, l0_bufs(p), blk, G);
    if constexpr (PH == K_L0_SCAN) ph_scan_conv(p, lds, blk, G);
    if constexpr (PH == K_L0_MIXC) l0_mixC(lds, l0_bufs(p), blk, G);
    if constexpr (PH == K_L0_G2) ph_gemm_plain(p, lds, blk, G, WSP(bf16_t, P_TMP + T_YM), WSP(bf16_t, P_WOUT_T), WSP(bf16_t, P_TMP + T_YB0));
    if constexpr (PH == K_LN_Y0) ph_ln<true, false, false>(p, lds, blk, G, WSP(bf16_t, P_TMP + T_YB0), 0);
    if constexpr (PH == K_CONV_L1) ph_conv_l1(p, lds, blk, G);
    if constexpr (PH == K_L1_G1) ph_l1_g1(p, lds, blk, G);
    if constexpr (PH == K_L1_SWA) ph_l1_swa(p, lds, blk, G);
    if constexpr (PH == K_L1_G2) ph_gemm_plain(p, lds, blk, G, WSP(bf16_t, P_TMP + T_OB), WSP(bf16_t, P_WO_T), WSP(bf16_t, P_TMP + T_YB));
}

#define XB_TMO      128
#define XB_XCNT(j)  (256  + 64 * (j))
#define XB_XSUB(j)  (1280 + 64 * (j))
#define XB_XGEN(j)  (2304 + 64 * (j))
#define XB_TOP      3328
#define XB_TOPGEN   3392
#define XCD_BAR_WORDS 3456
#define XB_SPIN_CAP (1u << 22)
__device__ __forceinline__ unsigned xb_ld(unsigned* p)              { return __hip_atomic_load(p, __ATOMIC_RELAXED, __HIP_MEMORY_SCOPE_AGENT); }
__device__ __forceinline__ unsigned xb_add(unsigned* p, unsigned v) { return __hip_atomic_fetch_add(p, v, __ATOMIC_RELAXED, __HIP_MEMORY_SCOPE_AGENT); }
__device__ __forceinline__ unsigned xb_xcc_id() { return (unsigned)__builtin_amdgcn_s_getreg((3 << 11) | 20) & 0xFu; }
#define XB_SPIN(cond, bar) do { unsigned _sp = 0; while (cond) { __builtin_amdgcn_s_sleep(1); \
    if ((++_sp & 255u) == 0u) { if (xb_ld(&(bar)[XB_TMO])) break; if (_sp > XB_SPIN_CAP) { atomicAdd(&(bar)[XB_TMO], 1u); break; } } } } while (0)
struct XcdBarrier { unsigned* bar; unsigned x; volatile LAS unsigned* st; };
__device__ __forceinline__ XcdBarrier xcd_barrier_post(unsigned* bar, volatile LAS unsigned* st) {
    XcdBarrier b; b.bar = bar; b.x = xb_xcc_id(); b.st = st;
    if (threadIdx.x == 0) (void)xb_add(&bar[XB_XCNT(b.x)], 1u);
    return b;
}
__device__ __forceinline__ void xcd_barrier_complete(unsigned* bar, unsigned x, unsigned& nloc, unsigned& nx) {
    const unsigned G = gridDim.x * gridDim.y * gridDim.z;
    unsigned sum, cnt, mine, sp = 0u;
    for (;;) {
        sum = 0u; cnt = 0u; mine = 0u;
#pragma unroll
        for (unsigned j = 0; j < 16; ++j) { const unsigned c = xb_ld(&bar[XB_XCNT(j)]); sum += c; cnt += (c > 0u) ? 1u : 0u; mine = (j == x) ? c : mine; }
        if (sum == G) break;
        __builtin_amdgcn_s_sleep(1);
        if ((++sp & 255u) == 0u) { if (xb_ld(&bar[XB_TMO])) break; if (sp > XB_SPIN_CAP) { atomicAdd(&bar[XB_TMO], 1u); break; } }
    }
    nloc = mine > 0u ? mine : 1u; nx = cnt > 0u ? cnt : 1u;
}
__device__ __forceinline__ void xcd_barrier(const XcdBarrier& b) {
    asm volatile("s_waitcnt vmcnt(0)" ::: "memory");
    __syncthreads();
    if (threadIdx.x == 0) {
        unsigned* bar = b.bar; asm volatile("" : "+s"(bar));
        __builtin_amdgcn_s_waitcnt(0);
        unsigned nloc = b.st[0], nx = b.st[1];
        if (nloc == 0u) { xcd_barrier_complete(bar, b.x, nloc, nx); b.st[0] = nloc; b.st[1] = nx; }
        const unsigned old = xb_add(&bar[XB_XSUB(b.x)], 1u);
        const unsigned gen = old / nloc;
        if (old + 1u == (gen + 1u) * nloc) {
            __builtin_amdgcn_fence(__ATOMIC_RELEASE, "agent");
            asm volatile("s_waitcnt vmcnt(0)" ::: "memory");
            const unsigned og = xb_add(&bar[XB_TOP], 1u);
            const unsigned tg = og / nx;
            if (og + 1u == (tg + 1u) * nx) xb_add(&bar[XB_TOPGEN], 1u);
            else XB_SPIN(xb_ld(&bar[XB_TOPGEN]) == tg, bar);
            __builtin_amdgcn_fence(__ATOMIC_ACQUIRE, "agent");
            xb_add(&bar[XB_XGEN(b.x)], 1u);
            asm volatile("s_waitcnt vmcnt(0)" ::: "memory");
        } else {
            XB_SPIN(xb_ld(&bar[XB_XGEN(b.x)]) == gen, bar);
            __builtin_amdgcn_fence(__ATOMIC_ACQUIRE, "agent");
            asm volatile("s_waitcnt vmcnt(0)" ::: "memory");
        }
    }
    __syncthreads();
}
constexpr size_t P_BAR = P_RT + 1572864;
constexpr int LDS_BARW = LDS_BYTES - 16;

struct SchedAll {
    const LAS pg8::JobDesc* jt; int n0, n1, n2, n3, n4; int K, G, c; int moe; const char* A; const char* B; const int* tstart; const int* src; int nN; size_t bexp;
    __device__ __forceinline__ pg8::Unit get(int i, bool& ok) const {
        const char* ua = nullptr; const char* ub = nullptr; const int* us = nullptr; int upm = 0, upn = 0, ujob = 0; bool good = false;
        if (moe) {
            const int vc = (c & 7) * (G >> 3) + (c >> 3);
            const long L = (long)i * G + vc; const int ntile = tstart[32];
            if (L < (long)ntile * nN) {
                const int mt = (int)(L / nN), nt = (int)(L % nN);
                int e = 0;
                for (int k = 1; k < 32; ++k) if (tstart[k] <= mt) e = k;
                ua = src ? A : A + (size_t)mt * 256 * K * 2; us = src ? src + mt * 256 : nullptr; ub = B + (size_t)e * bexp + (size_t)nt * 256 * K * 2; upm = mt; upn = nt; good = true;
            }
        } else {
            long L = (long)i * G + c;
            if (L < (long)n0 + n1 + n2 + n3 + n4) {
                int l = (int)L; int jb = 0;
                if (l >= n0) { l -= n0; jb = 1; if (l >= n1) { l -= n1; jb = 2; if (l >= n2) { l -= n2; jb = 3; if (l >= n3) { l -= n3; jb = 4; } } } }
                const int jM = __builtin_amdgcn_readfirstlane(jt[jb].nM), jN = __builtin_amdgcn_readfirstlane(jt[jb].nN);
                int pm, pn; pg8::tile_order(l, jM, jN, pm, pn);
                const size_t tstep = (size_t)pg8::BM * K * 2;
                ua = (const char*)pg8::rfl64(jt[jb].A) + (size_t)pm * tstep; ub = (const char*)pg8::rfl64(jt[jb].B) + (size_t)pn * tstep; upm = pm; upn = pn; ujob = jb; good = true;
            }
        }
        pg8::Unit u; u.A = ua; u.B = ub; u.src = us; u.pm = upm; u.pn = upn; u.job = ujob; ok = good; return u;
    }
};
enum { MP_CONV = 0, MP_L0_G1, MP_L0_MIXA, MP_L0_SCAN, MP_L0_MIXC, MP_L0_G2, MP_LN0, MP_XA_G1, MP_XA_ATTN, MP_XA_G2, MP_LN_ROUTE, MP_SCATTER, MP_MOE_G1, MP_MOE_G2, MP_LN_MOE, MP_L1_G1, MP_L1_SWA, MP_L1_G2, MP_LN3 };
__device__ __forceinline__ int prog_kind(int i) {
    switch (i) { case 0: return MP_CONV; case 1: return MP_L0_G1; case 2: return MP_L0_MIXA; case 3: return MP_L0_SCAN; case 4: return MP_L0_MIXC; case 5: return MP_L0_G2; case 6: return MP_LN0;
        case 7: case 19: return MP_XA_G1; case 8: case 20: return MP_XA_ATTN; case 9: case 21: return MP_XA_G2; case 10: case 22: return MP_LN_ROUTE; case 11: case 23: return MP_SCATTER;
        case 12: case 24: return MP_MOE_G1; case 13: case 25: return MP_MOE_G2; case 14: case 26: return MP_LN_MOE; case 15: return MP_L1_G1; case 16: return MP_L1_SWA; case 17: return MP_L1_G2; default: return MP_LN3; }
}
constexpr int N_PROG = 27;
__global__ void __launch_bounds__(NTHR, 2) mega(FP p0) {
    extern __shared__ __attribute__((aligned(16))) unsigned char smem[];
    LAS unsigned char* lds = (LAS unsigned char*)smem;
    cooperative_groups::grid_group grid = cooperative_groups::this_grid();
    const int blk0 = blockIdx.x, G0 = gridDim.x;
    volatile LAS unsigned* bst = (volatile LAS unsigned*)(lds + LDS_BARW);
    if (threadIdx.x == 0) { bst[0] = 0u; bst[1] = 0u; }
    __syncthreads();
    const XcdBarrier xbar = xcd_barrier_post((unsigned*)(p0.ws + P_BAR), bst);
    int dup = 0; (void)dup;
#pragma unroll 1
    for (int pi = 0; pi < N_PROG; ++pi) {
        int blk = blk0, G = G0; asm volatile("" : "+s"(blk), "+s"(G));
        const PV p = make_pv(p0);
        const int kind = prog_kind(pi), l = pi >= 15 ? 1 : 0;
        const bool is_gemm = kind == MP_L0_G1 || kind == MP_L0_G2 || kind == MP_XA_G1 || kind == MP_XA_G2 || kind == MP_MOE_G1 || kind == MP_MOE_G2 || kind == MP_L1_G1 || kind == MP_L1_G2;
        if (is_gemm) {
            SchedAll S; S.jt = JT_PTR; S.n0 = S.n1 = S.n2 = S.n3 = S.n4 = 0; S.K = 1024; S.G = G; S.c = blk; S.moe = 0; S.A = S.B = nullptr; S.tstart = WSP(int, P_RT + RT_TSTART); S.src = nullptr; S.nN = 4; S.bexp = 0;
            __syncthreads();
            if (threadIdx.x == 0) {
                if (kind == MP_L0_G1) set_job(JT_PTR, 0, WSP(bf16_t, P_XBF), WSP(bf16_t, P_WIN_T), 128, 8, WSP(bf16_t, P_TMP + T_AU), 512, EM_GELU4);
                if (kind == MP_L0_G2) set_job(JT_PTR, 0, WSP(bf16_t, P_TMP + T_YM), WSP(bf16_t, P_WOUT_T), 128, 4, WSP(bf16_t, P_TMP + T_YB0), 1024, EM_PLAIN);
                if (kind == MP_XA_G1) {
                    set_job(JT_PTR, 0, WSP(bf16_t, P_XBF), WSP(bf16_t, P_XWQ_T) + (size_t)l * 1024 * 1024, 128, 4, WSP(bf16_t, P_TMP + T_QX), 1024, EM_PLAIN);
                    if (l == 0) { for (int ll = 0; ll < 2; ++ll) { const bf16_t* wkv = WSP(bf16_t, P_XWKV_T) + (size_t)ll * 2048 * 1024;
                        set_job(JT_PTR, 1 + 2 * ll, WSP(bf16_t, P_MEMB), wkv, 8, 4, WSP(bf16_t, P_KC) + (size_t)ll * 2048 * 1024, 1024, EM_PLAIN);
                        set_job(JT_PTR, 2 + 2 * ll, wkv + (size_t)1024 * 1024, WSP(bf16_t, P_MEMB), 4, 8, WSP(bf16_t, P_VT) + (size_t)ll * 1024 * 2048, 2048, EM_PLAIN); } } }
                if (kind == MP_XA_G2) set_job(JT_PTR, 0, WSP(bf16_t, P_TMP + T_OB), WSP(bf16_t, P_XWO_T) + (size_t)l * 1024 * 1024, 128, 4, WSP(bf16_t, P_TMP + T_YB), 1024, EM_PLAIN);
                if (kind == MP_MOE_G1) set_job(JT_PTR, 0, nullptr, nullptr, 0, 0, WSP(bf16_t, P_TMP + T_HM), 512, EM_SWIGLU);
                if (kind == MP_MOE_G2) set_job(JT_PTR, 0, nullptr, nullptr, 0, 0, WSP(bf16_t, P_TMP + T_YG), 1024, EM_PLAIN);
                if (kind == MP_L1_G1) { set_job(JT_PTR, 0, WSP(bf16_t, P_XBF), WSP(bf16_t, P_WQKV_T), 128, 5, WSP(bf16_t, P_TMP + T_QX), 1024, EM_ROTARY, WSP(float, P_BQK), WSP(float, P_ROT), WSP(bf16_t, P_TMP + T_K1));
                    set_job(JT_PTR, 1, WSP(bf16_t, P_WQKV_T) + (size_t)1280 * 1024, WSP(bf16_t, P_XBF), 1, 128, WSP(bf16_t, P_TMP + T_VT1), NT, EM_ROWBIAS, p.in[20] + 1280); }
                if (kind == MP_L1_G2) set_job(JT_PTR, 0, WSP(bf16_t, P_TMP + T_OB), WSP(bf16_t, P_WO_T), 128, 4, WSP(bf16_t, P_TMP + T_YB), 1024, EM_PLAIN);
            }
            if (kind == MP_L0_G1) S.n0 = 1024;
            if (kind == MP_L0_G2 || kind == MP_XA_G2 || kind == MP_L1_G2) S.n0 = 512;
            if (kind == MP_XA_G1) { S.n0 = 512; if (l == 0) { S.n1 = 32; S.n2 = 32; S.n3 = 32; S.n4 = 32; } }
            if (kind == MP_L1_G1) { S.n0 = 640; S.n1 = 128; }
            if (kind == MP_MOE_G1) { S.moe = 1; S.A = (const char*)WSP(bf16_t, P_XBF); S.src = WSP(int, P_RT + RT_SRC); S.B = (const char*)WSP(bf16_t, P_W13T); S.bexp = (size_t)1024 * 1024 * 2; }
            if (kind == MP_MOE_G2) { S.moe = 1; S.K = 512; S.A = (const char*)WSP(bf16_t, P_TMP + T_HM); S.B = (const char*)WSP(bf16_t, P_W2T); S.bexp = (size_t)1024 * 512 * 2; }
            __syncthreads();
            EpiMulti E; E.jt = JT_PTR;
#ifdef PROBE_GEMM2
#pragma unroll 1
            for (int rep = 0; rep < 2; ++rep)
#endif
            pg8::gemm_phase<EpiMulti, SchedAll, true, true>(lds, S.K, S, E);
        } else {
#ifdef PROBE_MASK
#define DRY (dup == 0 && (((PROBE_MASK) >> kind) & 1))
#else
#define DRY false
#endif
            switch (kind) {
                case MP_CONV: ph_conv_l0(p, lds, blk, G); ph_conv_l1(p, lds, blk, G); ph_conv_xattn(p, lds, blk, G, 0); ph_conv_xattn(p, lds, blk, G, 1); ph_conv_moe(p, lds, blk, G, 0); ph_xin_to_bf(p, lds, blk, G); break;
                case MP_L0_MIXA: l0_mixA(lds, l0_bufs(p), blk, G); break;
                case MP_L0_SCAN: ph_scan_conv(p, lds, blk, G); break;
                case MP_L0_MIXC: l0_mixC(lds, l0_bufs(p), blk, G); break;
                case MP_LN0: ph_ln<false, false, false>(p, lds, blk, G, WSP(bf16_t, P_TMP + T_YB0), 0, DRY); break;
                case MP_XA_ATTN: ph_xattn_attn(p, lds, blk, G, l); break;
                case MP_LN_ROUTE: ph_ln<false, false, false>(p, lds, blk, G, WSP(bf16_t, P_TMP + T_YB), l * 3 + 1, DRY); __syncthreads(); ph_moe_route(p, lds, blk, G, l); break;
                case MP_SCATTER: ph_moe_scatter(p, lds, blk, G); break;
                case MP_LN_MOE: if (l == 0) { ph_ln<false, false, true>(p, lds, blk, G, WSP(bf16_t, P_TMP + T_YG), 2, DRY); if (!(DRY)) ph_conv_moe(p, lds, blk, G, 1); } else ph_ln<false, true, true>(p, lds, blk, G, WSP(bf16_t, P_TMP + T_YG), 5, DRY); break;
                case MP_L1_SWA: ph_l1_swa(p, lds, blk, G); break;
                default: ph_ln<false, false, false>(p, lds, blk, G, WSP(bf16_t, P_TMP + T_YB), 3, DRY); break;
            }
        }
#ifdef PROBE_MASK
        if (((PROBE_MASK) >> kind) & 1) { if (dup == 0) { dup = 1; xcd_barrier(xbar); --pi; continue; } dup = 0; }
#endif
        if (pi + 1 < N_PROG) { if (p0.ws == nullptr) grid.sync(); else { xcd_barrier(xbar);
#ifdef PROBE_BAR2
            xcd_barrier(xbar);
#endif
        } }
    }
}
}
extern "C" void kernel_launch(void* const* d_in, const int* in_sizes, int n_in, void* d_out, int out_size, void* d_ws, size_t ws_size, hipStream_t stream) {
    static int ok = 0;
    if (ok == 0) {
        ok = -1;
        if (n_in != 33 || out_size != 32768 * 1024 || ws_size < fk::FAST_END) { fprintf(stderr, "kernel_launch: unexpected shapes/ws (%d, %d, %zu)\n", n_in, out_size, ws_size); return; }
        int dev = 0, cus = 0, per_cu = 0;
        if (hipGetDevice(&dev) != hipSuccess || hipDeviceGetAttribute(&cus, hipDeviceAttributeMultiprocessorCount, dev) != hipSuccess) return;
        if (hipFuncSetAttribute((const void*)fk::mega, hipFuncAttributeMaxDynamicSharedMemorySize, fk::LDS_BYTES) != hipSuccess) return;
        if (hipOccupancyMaxActiveBlocksPerMultiprocessor(&per_cu, (const void*)fk::mega, fk::NTHR, fk::LDS_BYTES) != hipSuccess || per_cu < 1 || cus * per_cu < 256) { fprintf(stderr, "kernel_launch: cannot co-reside 256 workgroups (%d CUs x %d)\n", cus, per_cu); return; }
        ok = 1;
    }
    if (ok < 0) return;
    fk::FP p{}; for (int i = 0; i < 33; ++i) p.in[i] = (const float*)d_in[i]; p.X = (float*)d_out; p.ws = (unsigned char*)d_ws;
    if (hipMemsetAsync((char*)d_ws + fk::P_BAR, 0, 16384, stream) != hipSuccess) return;
    void* args[] = {&p};
    hipError_t e = hipLaunchCooperativeKernel((const void*)fk::mega, dim3(256), dim3(fk::NTHR), args, fk::LDS_BYTES, stream);
    if (e != hipSuccess) fprintf(stderr, "cooperative launch failed: %s\n", hipGetErrorString(e));
}
```

```cpp
#include <hip/hip_runtime.h>
#include <hip/hip_cooperative_groups.h>
#include <cstdio>
#include <cstdint>
#include <cmath>
namespace fk {
#define LAS __attribute__((address_space(3)))
typedef unsigned short bf16_t;
typedef short bf16x8 __attribute__((ext_vector_type(8)));
typedef short s16x4 __attribute__((ext_vector_type(4)));
typedef float f32x4 __attribute__((ext_vector_type(4)));
typedef float f32x16 __attribute__((ext_vector_type(16)));
typedef float f32x2 __attribute__((ext_vector_type(2)));
typedef unsigned u32x4 __attribute__((ext_vector_type(4)));
typedef unsigned u32x2 __attribute__((ext_vector_type(2)));
typedef __bf16 bf16x2_t __attribute__((ext_vector_type(2)));

constexpr int NT = 32768, DM = 1024, SEQ = 4096;
constexpr int NTHR = 512, NWAVE = 8;
constexpr float ALPHA = 1.4142135623730951f, LN_EPS = 1e-5f, LOG2E = 1.4426950408889634f;

__device__ __forceinline__ unsigned pk2(float lo, float hi) { f32x2 v = {lo, hi}; bf16x2_t b = __builtin_convertvector(v, bf16x2_t); return __builtin_bit_cast(unsigned, b); }
__device__ __forceinline__ float bf_lo(unsigned w) { return __uint_as_float(w << 16); }
__device__ __forceinline__ float bf_hi(unsigned w) { return __uint_as_float(w & 0xffff0000u); }
__device__ __forceinline__ float bf2f(bf16_t b) { return __uint_as_float(((unsigned)b) << 16); }
__device__ __forceinline__ bf16_t f2bf(float f) { return (bf16_t)(pk2(f, 0.f) & 0xffffu); }
__device__ __forceinline__ float fast_exp(float x) { return __builtin_amdgcn_exp2f(x * LOG2E); }
__device__ __forceinline__ float sigmoid_f(float x) { return __builtin_amdgcn_rcpf(1.f + fast_exp(-x)); }
__device__ __forceinline__ float silu_f(float x) { return x * sigmoid_f(x); }
__device__ __forceinline__ float gelu_tanh_f(float x) { const float u = 1.5957691216057308f * (x + 0.044715f * x * x * x); return x * sigmoid_f(u); }
__device__ __forceinline__ int crow(int r, int hi) { return (r & 3) + 8 * (r >> 2) + 4 * hi; }
__device__ __forceinline__ float xhalf_sum(float v) { auto rr = __builtin_amdgcn_permlane32_swap(__float_as_uint(v), __float_as_uint(v), false, false); return __uint_as_float(rr[0]) + __uint_as_float(rr[1]); }
__device__ __forceinline__ float xhalf_max(float v) { auto rr = __builtin_amdgcn_permlane32_swap(__float_as_uint(v), __float_as_uint(v), false, false); return fmaxf(__uint_as_float(rr[0]), __uint_as_float(rr[1])); }
__device__ __forceinline__ float shx(float v, int o, int lane) { return __int_as_float(__builtin_amdgcn_ds_bpermute((lane ^ o) << 2, __float_as_int(v))); }
__device__ __forceinline__ float shup(float v, int o, int lane) { return __int_as_float(__builtin_amdgcn_ds_bpermute(((lane - o) & 63) << 2, __float_as_int(v))); }
__device__ __forceinline__ float shidx(float v, int idx) { return __int_as_float(__builtin_amdgcn_ds_bpermute(idx << 2, __float_as_int(v))); }
__device__ __forceinline__ s16x4 lds_tr(const LAS void* p) { return __builtin_bit_cast(s16x4, __builtin_amdgcn_ds_read_tr16_b64_v4i16((LAS s16x4*)p)); }
#define MFMA32(a, b, c) __builtin_amdgcn_mfma_f32_32x32x16_bf16((a), (b), (c), 0, 0, 0)

namespace pg8 {
constexpr int BM = 256, BK = 64, HALF = 128, HTB = HALF * BK * 2, STAGE_BYTES = 8 * HTB, NXCD = 8, WGM = 8;
__host__ __device__ __forceinline__ int lds_byte(int r, int c) { const int st = (r >> 4) * 2 + (c >> 5), rr = r & 15, cc = c & 31, ob = rr * 64 + cc * 2; return st * 1024 + (ob ^ (((ob >> 9) & 1) << 5)); }
__host__ __device__ __forceinline__ void stage_rc(int b, int& R, int& C) { const int st = b / 1024, sb = b % 1024, swz = sb ^ (((sb >> 9) & 1) << 5); R = (st >> 1) * 16 + swz / 64; C = (st & 1) * 32 + (swz % 64) / 2; }
__host__ __device__ __forceinline__ int perm32(int rho) { const int n = rho >> 4, i = rho & 15; return 8 * (i >> 2) + 4 * n + (i & 3); }

struct Unit { const char* A; const char* B; const int* src; int pm, pn, job; };

__device__ __forceinline__ void tile_order(int l, int nM, int nN, int& pm, int& pn) {
    const int nwg = nM * nN; int wgid = l;
    { const int q = nwg / NXCD, r = nwg % NXCD, xcd = wgid % NXCD, off = wgid / NXCD; wgid = (xcd < r ? xcd * (q + 1) : r * (q + 1) + (xcd - r) * q) + off; }
    const int nig = WGM * nN, gid = wgid / nig, fm = gid * WGM, gsz = (nM - fm) < WGM ? (nM - fm) : WGM;
    pm = fm + ((wgid % nig) % gsz); pn = (wgid % nig) / gsz;
}
struct JobDesc { unsigned long long A, B, out, bias, rot, out2; int nM, nN, ldc, mode; };
__device__ __forceinline__ unsigned long long rfl64(unsigned long long v) { const unsigned lo = __builtin_amdgcn_readfirstlane((unsigned)v), hi = __builtin_amdgcn_readfirstlane((unsigned)(v >> 32)); return ((unsigned long long)hi << 32) | lo; }
constexpr int JT_OFF = STAGE_BYTES;
struct Jobs3 {
    const LAS JobDesc* jt; int n0, n1, n2; int K, G, c;
    __device__ __forceinline__ Unit get(int i, bool& ok) const { Unit u; u.A = nullptr; u.B = nullptr; u.src = nullptr; u.pm = 0; u.pn = 0; u.job = 0; ok = next(i, u); return u; }
    __device__ __forceinline__ bool next(int i, Unit& u) const {
        long L = (long)i * G + c;
        if (L >= (long)n0 + n1 + n2) return false;
        int l = (int)L; int jb = 0;
        if (l >= n0) { l -= n0; jb = 1; if (l >= n1) { l -= n1; jb = 2; } }
        const int jM = __builtin_amdgcn_readfirstlane(jt[jb].nM), jN = __builtin_amdgcn_readfirstlane(jt[jb].nN);
        int pm, pn; tile_order(l, jM, jN, pm, pn);
        const size_t tstep = (size_t)BM * K * 2;
        u.A = (const char*)rfl64(jt[jb].A) + (size_t)pm * tstep; u.B = (const char*)rfl64(jt[jb].B) + (size_t)pn * tstep; u.src = nullptr; u.pm = pm; u.pn = pn; u.job = jb; return true;
    }
};

template <class Epi, class Sched, bool ALIGN_EPI, bool SP2>
__device__ __forceinline__ void gemm_phase(LAS unsigned char* lds, const int K, const Sched& S, const Epi& E) {
    int tid_ = threadIdx.x; asm volatile("" : "+v"(tid_)); const int tid = tid_, wid = __builtin_amdgcn_readfirstlane(tid >> 6), lane = tid & 63, wr = wid >> 2, wc = wid & 3, fr = lane & 15, fq = lane >> 4;
    const int nt = K / BK;
    static_assert(SP2, "only the two-super-phase form is kept");
    unsigned vA0[2], vA1[2], vB0[2], vB1[2];
#pragma unroll
    for (int i = 0; i < 2; ++i) { int R, C; stage_rc(tid * 16 + i * 8192, R, C); const int Rb = 64 * (R >> 5) + perm32(R & 31); vB0[i] = (unsigned)(Rb * K + C) * 2u; vB1[i] = (unsigned)((Rb + 32) * K + C) * 2u; }
    auto a_rows = [&](const int* src, unsigned (&o0)[2], unsigned (&o1)[2]) {
        int tq = tid; asm volatile("" : "+v"(tq));
#pragma unroll
        for (int i = 0; i < 2; ++i) { int R, C; stage_rc(tq * 16 + i * 8192, R, C); int r0 = R, r1 = R + HALF; if (src) { r0 = src[R]; r1 = src[R + HALF]; }
            o0[i] = (unsigned)(r0 * K + C) * 2u; o1[i] = (unsigned)(r1 * K + C) * 2u; }
    };
    const size_t kstep = (size_t)(BK * 2);
    const size_t hstep = (size_t)HALF * K * 2;
    const unsigned ldsw = (unsigned)wid * 1024u;
    const int aoff = lds_byte(wr * 64 + fr, fq * 8), boff = lds_byte(wc * 32 + fr, fq * 8);
#define PG8_SA(b, h) (((b) * 2 + (h)) * HTB)
#define PG8_SB(b, h) ((4 + (b) * 2 + (h)) * HTB)
#define PG8_STAGE(bufoff, gbase, voff) do { _Pragma("unroll") for (int _i = 0; _i < 2; ++_i) \
        __builtin_amdgcn_global_load_lds((const unsigned*)((const char*)(gbase) + (voff)[_i]), (LAS unsigned*)(lds + (bufoff) + ldsw + _i * 8192), 16, 0, 0); } while (0)
#define PG8_LDA(dst, b, h) do { _Pragma("unroll") for (int m = 0; m < 4; ++m) _Pragma("unroll") for (int k = 0; k < 2; ++k) dst[m][k] = *(const LAS bf16x8*)(lds + PG8_SA(b, h) + aoff + m * 2048 + k * 1024); } while (0)
#define PG8_LDB(dst, b, h) do { _Pragma("unroll") for (int n = 0; n < 2; ++n) _Pragma("unroll") for (int k = 0; k < 2; ++k) dst[n][k] = *(const LAS bf16x8*)(lds + PG8_SB(b, h) + boff + n * 2048 + k * 1024); } while (0)
#define PG8_MMA(ai, bj, At, Bt) do { __builtin_amdgcn_s_setprio(1); _Pragma("unroll") for (int m = 0; m < 4; ++m) _Pragma("unroll") for (int n = 0; n < 2; ++n) _Pragma("unroll") for (int k = 0; k < 2; ++k) \
        acc[ai][bj][m][n] = __builtin_amdgcn_mfma_f32_16x16x32_bf16(Bt[n][k], At[m][k], acc[ai][bj][m][n], 0, 0, 0); __builtin_amdgcn_s_setprio(0); } while (0)
#define PG8_WAIT_V(n) asm volatile("s_waitcnt vmcnt(" #n ")" ::: "memory")
#define PG8_WAIT_L(n) asm volatile("s_waitcnt lgkmcnt(" #n ")" ::: "memory")
#define PG8_BAR __builtin_amdgcn_s_barrier()
#define PG8_SCHED __builtin_amdgcn_sched_barrier(0)
    auto unif = [](Unit u) { Unit r; r.A = (const char*)rfl64((unsigned long long)u.A); r.B = (const char*)rfl64((unsigned long long)u.B); r.src = (const int*)rfl64((unsigned long long)u.src);
        r.pm = __builtin_amdgcn_readfirstlane(u.pm); r.pn = __builtin_amdgcn_readfirstlane(u.pn); r.job = __builtin_amdgcn_readfirstlane(u.job); return r; };
    int ui = 0; bool ok0; Unit cur = unif(S.get(0, ok0));
    if (!ok0) return;
    f32x4 acc[2][2][4][2];
#pragma unroll
    for (int a = 0; a < 2; ++a)
#pragma unroll
        for (int b = 0; b < 2; ++b)
#pragma unroll
            for (int m = 0; m < 4; ++m)
#pragma unroll
                for (int n = 0; n < 2; ++n) acc[a][b][m][n] = (f32x4){0.f, 0.f, 0.f, 0.f};
    bf16x8 At[4][2], B0[2][2], B1[2][2];
    const char* cA = cur.A; const char* cB = cur.B;
    a_rows(cur.src, vA0, vA1);
    {
        PG8_STAGE(PG8_SB(0, 0), cB, vB0); PG8_STAGE(PG8_SB(0, 1), cB, vB1); PG8_STAGE(PG8_SA(0, 0), cA, vA0); PG8_STAGE(PG8_SA(0, 1), cA, vA1);
        if (wr == 1) PG8_BAR;
        PG8_WAIT_V(2); PG8_BAR;
        PG8_STAGE(PG8_SB(1, 0), cB + kstep, vB0); PG8_STAGE(PG8_SA(1, 0), cA + kstep, vA0); PG8_STAGE(PG8_SB(1, 1), cB + kstep, vB1);
        PG8_WAIT_V(6); PG8_BAR;
    }
    for (;;) {
        bool has_next; const Unit nxt = unif(S.get(ui + 1, has_next)); bool early_done = false;
        const char* nA = has_next ? nxt.A : cA; const char* nB = has_next ? nxt.B : cB;
        for (int t = 0; t < nt; t += 2) {
            const bool last = (t == nt - 2);
            const char* a1 = cA + (size_t)(t + 1) * kstep;
            const char* a2 = last ? nA : cA + (size_t)(t + 2) * kstep; const char* b2 = last ? nB : cB + (size_t)(t + 2) * kstep;
            const char* a3 = a2 + kstep; const char* b3 = b2 + kstep;
            PG8_LDB(B0, 0, 0); PG8_LDB(B1, 0, 1); PG8_SCHED; PG8_LDA(At, 0, 0); PG8_STAGE(PG8_SA(1, 1), a1, vA1);
            if (last && has_next) a_rows(nxt.src, vA0, vA1);
            PG8_WAIT_V(8); PG8_WAIT_L(0); PG8_BAR; PG8_MMA(0, 0, At, B0); PG8_MMA(0, 1, At, B1); PG8_BAR; PG8_SCHED;
            PG8_LDA(At, 0, 1); PG8_STAGE(PG8_SB(0, 0), b2, vB0); PG8_STAGE(PG8_SB(0, 1), b2, vB1); PG8_STAGE(PG8_SA(0, 0), a2, vA0);
            PG8_WAIT_V(8); PG8_WAIT_L(0); PG8_BAR; PG8_MMA(1, 0, At, B0); PG8_MMA(1, 1, At, B1); PG8_BAR; PG8_SCHED;
            PG8_LDB(B0, 1, 0); PG8_LDB(B1, 1, 1); PG8_SCHED; PG8_LDA(At, 1, 0); PG8_STAGE(PG8_SA(0, 1), a2, vA1);
            PG8_WAIT_V(8); PG8_WAIT_L(0); PG8_BAR; PG8_MMA(0, 0, At, B0); PG8_MMA(0, 1, At, B1); PG8_BAR; PG8_SCHED;
            if (last) { early_done = E.early(acc, cur, wr, wc, fr, fq); PG8_SCHED; }
            PG8_LDA(At, 1, 1); PG8_STAGE(PG8_SB(1, 0), b3, vB0); PG8_STAGE(PG8_SB(1, 1), b3, vB1); PG8_STAGE(PG8_SA(1, 0), a3, vA0);
            PG8_WAIT_V(8); PG8_WAIT_L(0); PG8_BAR; PG8_MMA(1, 0, At, B0); PG8_MMA(1, 1, At, B1); PG8_BAR; PG8_SCHED;
        }
        if constexpr (ALIGN_EPI) { if (wr == 0) PG8_BAR; }
        if (!early_done) E.template half<0>(acc, cur, wr, wc, fr, fq);
        E.template half<1>(acc, cur, wr, wc, fr, fq);
        if (!has_next) break;
#pragma unroll
        for (int a = 0; a < 2; ++a)
#pragma unroll
            for (int b = 0; b < 2; ++b)
#pragma unroll
                for (int m = 0; m < 4; ++m)
#pragma unroll
                    for (int n = 0; n < 2; ++n) acc[a][b][m][n] = (f32x4){0.f, 0.f, 0.f, 0.f};
        cur = nxt; cA = nA; cB = nB; ++ui;
        if constexpr (ALIGN_EPI) { if (wr == 1) PG8_BAR; }
    }
    PG8_WAIT_V(0);
    if constexpr (!ALIGN_EPI) { if (wr == 0) PG8_BAR; }
    PG8_BAR;
#undef PG8_SA
#undef PG8_SB
#undef PG8_STAGE
#undef PG8_LDA
#undef PG8_LDB
#undef PG8_MMA
#undef PG8_WAIT_V
#undef PG8_WAIT_L
#undef PG8_BAR
#undef PG8_SCHED
}
}
enum { EM_PLAIN = 0, EM_GELU4 = 1, EM_SWIGLU = 2, EM_ROTARY = 3, EM_ROWBIAS = 4 };
struct EpiMulti {
    static constexpr bool PERM = true;
    const LAS pg8::JobDesc* jt;
    __device__ __forceinline__ bool early(const f32x4 (&acc)[2][2][4][2], const pg8::Unit& u, int wr, int wc, int fr, int fq) const {
        const LAS pg8::JobDesc* jd = jt + u.job;
        if (__builtin_amdgcn_readfirstlane(jd->mode) != EM_PLAIN) return false;
        bf16_t* out = (bf16_t*)pg8::rfl64(jd->out); const int ldc = __builtin_amdgcn_readfirstlane(jd->ldc);
        bf16_t* rowp = out + (size_t)(u.pm * 256 + wr * 64 + fr) * ldc + u.pn * 256 + wc * 64 + 8 * fq;
#pragma unroll
        for (int m = 0; m < 4; ++m)
#pragma unroll
            for (int bj = 0; bj < 2; ++bj) { const f32x4 v0 = acc[0][bj][m][0], v1 = acc[0][bj][m][1];
                u32x4 w; w.x = pk2(v0[0], v0[1]); w.y = pk2(v0[2], v0[3]); w.z = pk2(v1[0], v1[1]); w.w = pk2(v1[2], v1[3]);
                *(u32x4*)(rowp + (size_t)m * 16 * ldc + bj * 32) = w; }
        return true;
    }
    template <int AI>
    __device__ __forceinline__ void half(const f32x4 (&acc)[2][2][4][2], const pg8::Unit& u, int wr, int wc, int fr, int fq) const {
        const LAS pg8::JobDesc* jd = jt + u.job;
        bf16_t* out = (bf16_t*)pg8::rfl64(jd->out);
        const int ldc = __builtin_amdgcn_readfirstlane(jd->ldc);
        const int mode = __builtin_amdgcn_readfirstlane(jd->mode);
        const float* bias = (const float*)pg8::rfl64(jd->bias);
        const int row0 = u.pm * 256 + wr * 64 + fr;
        const int colt = u.pn * 256 + wc * 64 + 8 * fq;
        if (mode == EM_PLAIN || mode == EM_ROWBIAS) {
#pragma unroll
            for (int ai = AI; ai < AI + 1; ++ai)
#pragma unroll
                for (int m = 0; m < 4; ++m) { const int row = row0 + ai * 128 + m * 16; const float rb = (mode == EM_ROWBIAS && bias) ? bias[row] : 0.f;
                    bf16_t* rowp = out + (size_t)row * ldc + colt;
#pragma unroll
                    for (int bj = 0; bj < 2; ++bj) { const f32x4 v0 = acc[ai][bj][m][0] + rb, v1 = acc[ai][bj][m][1] + rb;
                        u32x4 w; w.x = pk2(v0[0], v0[1]); w.y = pk2(v0[2], v0[3]); w.z = pk2(v1[0], v1[1]); w.w = pk2(v1[2], v1[3]);
                        *(u32x4*)(rowp + bj * 32) = w; } }
        } else if (mode == EM_GELU4) {
            const int arr = u.pn >> 1; bf16_t* base = out + (size_t)arr * NT * 512; const int col = colt - arr * 512; const bool act = arr < 2;
#pragma unroll
            for (int ai = AI; ai < AI + 1; ++ai)
#pragma unroll
                for (int m = 0; m < 4; ++m) { bf16_t* rowp = base + (size_t)(row0 + ai * 128 + m * 16) * 512 + col;
#pragma unroll
                    for (int bj = 0; bj < 2; ++bj) { f32x4 v0 = acc[ai][bj][m][0], v1 = acc[ai][bj][m][1];
                        if (act) {
#pragma unroll
                            for (int e = 0; e < 4; ++e) { v0[e] = gelu_tanh_f(v0[e]); v1[e] = gelu_tanh_f(v1[e]); } }
                        u32x4 w; w.x = pk2(v0[0], v0[1]); w.y = pk2(v0[2], v0[3]); w.z = pk2(v1[0], v1[1]); w.w = pk2(v1[2], v1[3]);
                        *(u32x4*)(rowp + bj * 32) = w; } }
        } else if (mode == EM_SWIGLU) {
#pragma unroll
            for (int ai = AI; ai < AI + 1; ++ai)
#pragma unroll
                for (int m = 0; m < 4; ++m) { bf16_t* rowp = out + (size_t)(row0 + ai * 128 + m * 16) * ldc + (colt >> 1);
#pragma unroll
                    for (int bj = 0; bj < 2; ++bj) { const f32x4 v0 = acc[ai][bj][m][0], v1 = acc[ai][bj][m][1];
                        u32x2 w; w.x = pk2(silu_f(v0[0]) * v0[1], silu_f(v0[2]) * v0[3]); w.y = pk2(silu_f(v1[0]) * v1[1], silu_f(v1[2]) * v1[3]);
                        *(u32x2*)(rowp + bj * 16) = w; } }
        } else {
            const float* rot = (const float*)pg8::rfl64(jd->rot);
            bf16_t* out2 = (bf16_t*)pg8::rfl64(jd->out2);
            const bool isk = u.pn >= 4; bf16_t* base = isk ? out2 : out; const int ld = isk ? 256 : 1024; const int colo = isk ? colt - 1024 : colt;
            float bv[2][8];
#pragma unroll
            for (int bj = 0; bj < 2; ++bj)
#pragma unroll
                for (int e = 0; e < 8; ++e) bv[bj][e] = bias ? bias[colt + bj * 32 + e] : 0.f;
            const int i0 = (colt & 63) >> 1;
#pragma unroll
            for (int ai = AI; ai < AI + 1; ++ai)
#pragma unroll
                for (int m = 0; m < 4; ++m) { const int row = row0 + ai * 128 + m * 16; const int pos = row & (SEQ - 1);
                    bf16_t* rowp = base + (size_t)row * ld + colo;
#pragma unroll
                    for (int bj = 0; bj < 2; ++bj) { f32x4 v0 = acc[ai][bj][m][0], v1 = acc[ai][bj][m][1];
                        const f32x4 cs0 = *(const f32x4*)(rot + ((size_t)pos * 32 + i0 + 16 * bj) * 2), cs1 = *(const f32x4*)(rot + ((size_t)pos * 32 + i0 + 16 * bj + 2) * 2);
#pragma unroll
                        for (int e = 0; e < 4; ++e) { v0[e] += bv[bj][e]; v1[e] += bv[bj][4 + e]; }
                        const float a0 = v0[0] * cs0[0] - v0[1] * cs0[1], b0 = v0[1] * cs0[0] + v0[0] * cs0[1];
                        const float a1 = v0[2] * cs0[2] - v0[3] * cs0[3], b1 = v0[3] * cs0[2] + v0[2] * cs0[3];
                        const float a2 = v1[0] * cs1[0] - v1[1] * cs1[1], b2 = v1[1] * cs1[0] + v1[0] * cs1[1];
                        const float a3 = v1[2] * cs1[2] - v1[3] * cs1[3], b3 = v1[3] * cs1[2] + v1[2] * cs1[3];
                        u32x4 w; w.x = pk2(a0, b0); w.y = pk2(a1, b1); w.z = pk2(a2, b2); w.w = pk2(a3, b3);
                        *(u32x4*)(rowp + bj * 32) = w; } }
        }
    }
};

constexpr int LNF_PART = pg8::JT_OFF + 1024;
constexpr int LNF_STAT = LNF_PART + 8192;
struct EpiLN {
    static constexpr bool PERM = true;
    bf16_t* xio; const float* g; const float* b; unsigned long long* slots; LAS unsigned char* lds;
    __device__ __forceinline__ bool early(const f32x4 (&)[2][2][4][2], const pg8::Unit&, int, int, int, int) const { return false; }
    template <int AI>
    __device__ __forceinline__ void half(f32x4 (&acc)[2][2][4][2], const pg8::Unit& u, int wr, int wc, int fr, int fq) const {
        int tid_ = threadIdx.x; asm volatile("" : "+v"(tid_)); const int tid = tid_, lane = tid & 63;
        const int colt = u.pn * 256 + wc * 64 + 8 * fq;
        LAS f32x2* part = (LAS f32x2*)(lds + LNF_PART);
        LAS f32x2* stat = (LAS f32x2*)(lds + LNF_STAT);
#pragma unroll
        for (int m = 0; m < 4; ++m) { const int rl = AI * 128 + wr * 64 + m * 16 + fr;
            const bf16_t* rowp = xio + (size_t)(u.pm * 256 + rl) * 1024 + colt;
            float s1 = 0.f, s2 = 0.f;
#pragma unroll
            for (int bj = 0; bj < 2; ++bj) { const u32x4 w = *(const u32x4*)(rowp + bj * 32);
                f32x4 v0 = acc[AI][bj][m][0], v1 = acc[AI][bj][m][1];
                v0[0] += ALPHA * bf_lo(w.x); v0[1] += ALPHA * bf_hi(w.x); v0[2] += ALPHA * bf_lo(w.y); v0[3] += ALPHA * bf_hi(w.y);
                v1[0] += ALPHA * bf_lo(w.z); v1[1] += ALPHA * bf_hi(w.z); v1[2] += ALPHA * bf_lo(w.w); v1[3] += ALPHA * bf_hi(w.w);
#pragma unroll
                for (int e = 0; e < 4; ++e) { s1 += v0[e] + v1[e]; s2 += v0[e] * v0[e] + v1[e] * v1[e]; }
                acc[AI][bj][m][0] = v0; acc[AI][bj][m][1] = v1; }
            s1 += shx(s1, 16, lane); s2 += shx(s2, 16, lane); s1 += shx(s1, 32, lane); s2 += shx(s2, 32, lane);
            if (fq == 0) part[rl * 4 + wc] = (f32x2){s1, s2}; }
        if constexpr (AI == 1) {
            __syncthreads();
            if (tid < 256) {
                const f32x2 p0 = part[tid * 4], p1 = part[tid * 4 + 1], p2 = part[tid * 4 + 2], p3 = part[tid * 4 + 3];
                const float t1 = (p0[0] + p1[0]) + (p2[0] + p3[0]), t2 = (p0[1] + p1[1]) + (p2[1] + p3[1]);
                unsigned long long* sl = slots + (size_t)u.pm * 1024 + tid;
                __hip_atomic_store(sl + u.pn * 256, ((unsigned long long)__float_as_uint(t2) << 32) | __float_as_uint(t1), __ATOMIC_RELAXED, __HIP_MEMORY_SCOPE_AGENT);
                float S1 = 0.f, S2 = 0.f;
#pragma unroll 1
                for (int q = 0; q < 4; ++q) { unsigned long long x; unsigned sp = 0;
                    for (;;) { x = __hip_atomic_load(sl + q * 256, __ATOMIC_RELAXED, __HIP_MEMORY_SCOPE_AGENT); if (x != ~0ull || ++sp > (1u << 22)) break; __builtin_amdgcn_s_sleep(1); }
                    S1 += __uint_as_float((unsigned)x); S2 += __uint_as_float((unsigned)(x >> 32)); }
                const float mean = S1 * (1.f / 1024.f); const float var = fmaxf(S2 * (1.f / 1024.f) - mean * mean, 0.f);
                stat[tid] = (f32x2){mean, __builtin_amdgcn_rsqf(var + LN_EPS)};
            }
            __syncthreads();
#pragma unroll
            for (int bj = 0; bj < 2; ++bj) {
                const f32x4 g0 = *(const f32x4*)(g + colt + bj * 32), g1 = *(const f32x4*)(g + colt + bj * 32 + 4), b0 = *(const f32x4*)(b + colt + bj * 32), b1 = *(const f32x4*)(b + colt + bj * 32 + 4);
#pragma unroll
                for (int ai = 0; ai < 2; ++ai)
#pragma unroll
                    for (int m = 0; m < 4; ++m) { const int rl = ai * 128 + wr * 64 + m * 16 + fr; const f32x2 st = stat[rl];
                        const f32x4 v0 = (acc[ai][bj][m][0] - st[0]) * st[1] * g0 + b0, v1 = (acc[ai][bj][m][1] - st[0]) * st[1] * g1 + b1;
                        u32x4 w; w.x = pk2(v0[0], v0[1]); w.y = pk2(v0[2], v0[3]); w.z = pk2(v1[0], v1[1]); w.w = pk2(v1[2], v1[3]);
                        *(u32x4*)(xio + (size_t)(u.pm * 256 + rl) * 1024 + colt + bj * 32) = w; }
            }
        }
    }
};
enum { RM_IDENT = 0, RM_ROT = 1, RM_PAIR0 = 2, RM_PAIR1 = 3 };
__device__ __forceinline__ int rowmap(int kind, int n) {
    if (kind == RM_ROT) { if (n >= 1280) return n; const int d = n & 63; return (n & ~63) + 2 * (d & 31) + (d >> 5); }
    if (kind == RM_PAIR0) return 2 * n;
    if (kind == RM_PAIR1) return 2 * n + 1;
    return n;
}
__device__ __forceinline__ void ti_load(const float* __restrict__ W, int ldw, int kb, int nb, int lane, f32x4 (&tv)[8]) {
    const int k0 = 64 * kb, n0 = 32 * nb;
#pragma unroll
    for (int i = 0; i < 8; ++i) { const int kk = 8 * i + (lane >> 3); tv[i] = *(const f32x4*)(W + (size_t)(k0 + kk) * ldw + n0 + 4 * (lane & 7)); }
}
__device__ __forceinline__ void ti_store(const f32x4 (&tv)[8], int K, bf16_t* __restrict__ WT, LAS float* scr, int kb, int nb, int lane, int kind, float scale, int nscale) {
    const int k0 = 64 * kb, n0 = 32 * nb;
#pragma unroll
    for (int i = 0; i < 8; ++i) { const int kk = 8 * i + (lane >> 3); LAS float* d = scr + kk * 33 + 4 * (lane & 7); d[0] = tv[i][0]; d[1] = tv[i][1]; d[2] = tv[i][2]; d[3] = tv[i][3]; }
    __builtin_amdgcn_s_waitcnt(0xc07f); asm volatile("" ::: "memory");
    const int c = lane & 7;
#pragma unroll
    for (int j = 0; j < 4; ++j) { const int n = (lane >> 3) + 8 * j; const LAS float* s = scr + (8 * c) * 33 + n; const float sc = (n0 + n) < nscale ? scale : 1.f;
        u32x4 o; o.x = pk2(s[0 * 33] * sc, s[1 * 33] * sc); o.y = pk2(s[2 * 33] * sc, s[3 * 33] * sc); o.z = pk2(s[4 * 33] * sc, s[5 * 33] * sc); o.w = pk2(s[6 * 33] * sc, s[7 * 33] * sc);
        *(u32x4*)(WT + (size_t)rowmap(kind, n0 + n) * K + k0 + 8 * c) = o; }
    __builtin_amdgcn_s_waitcnt(0xc07f); asm volatile("" ::: "memory");
}
__device__ __forceinline__ void convert_mats(const float* W, int K, int N, int nbat, size_t sstr, bf16_t* WT, size_t dstr, int kind, float scale, int nscale, LAS float* scr, int gw, int ngw, int lane) {
    const int nblk = N / 32, per = (K / 64) * nblk, total = per * nbat;
    if (gw >= total) return;
    f32x4 cur[8], nxt[8];
    { const int bt = gw / per, r = gw - bt * per; ti_load(W + (size_t)bt * sstr, N, r / nblk, r % nblk, lane, cur); }
    for (int it = gw; it < total; it += ngw) {
        const int in = it + ngw; const bool more = in < total;
        if (more) { const int bt = in / per, r = in - bt * per; ti_load(W + (size_t)bt * sstr, N, r / nblk, r % nblk, lane, nxt); }
        { const int bt = it / per, r = it - bt * per; ti_store(cur, K, WT + (size_t)bt * dstr, scr, r / nblk, r % nblk, lane, kind, scale, nscale); }
#pragma unroll
        for (int i = 0; i < 8; ++i) cur[i] = nxt[i];
    }
}
__device__ __forceinline__ void convert_rows(const float* __restrict__ src, bf16_t* __restrict__ dst, size_t n, int gt, int ngt) {
    const size_t step = (size_t)ngt * 8; size_t i = (size_t)gt * 8;
    for (; i + 3 * step < n; i += 4 * step) { f32x4 a[4], b[4];
#pragma unroll
        for (int j = 0; j < 4; ++j) { a[j] = *(const f32x4*)(src + i + j * step); b[j] = *(const f32x4*)(src + i + j * step + 4); }
#pragma unroll
        for (int j = 0; j < 4; ++j) { u32x4 o; o.x = pk2(a[j][0], a[j][1]); o.y = pk2(a[j][2], a[j][3]); o.z = pk2(b[j][0], b[j][1]); o.w = pk2(b[j][2], b[j][3]); *(u32x4*)(dst + i + j * step) = o; } }
    for (; i < n; i += step) { const f32x4 a = *(const f32x4*)(src + i), b = *(const f32x4*)(src + i + 4);
        u32x4 o; o.x = pk2(a[0], a[1]); o.y = pk2(a[2], a[3]); o.z = pk2(b[0], b[1]); o.w = pk2(b[2], b[3]); *(u32x4*)(dst + i) = o; }
}

struct LnArgs { const float* xin32; const bf16_t* xin; float* xout32; bf16_t* xbf; const bf16_t* y; const float* g; const float* b; const int* dest; const float* wts; };
template <int NR, bool XF32, bool OUTF32, bool MOE>
__device__ __forceinline__ void ln_rows(const LnArgs& a, int row0, int lane) {
    float v[NR][2][8];
    {
        int d0[NR], d1[NR]; float w0[NR], w1[NR];
        if (MOE) {
#pragma unroll
            for (int i = 0; i < NR; ++i) { d0[i] = a.dest[(row0 + i) * 2]; d1[i] = a.dest[(row0 + i) * 2 + 1]; w0[i] = a.wts[(row0 + i) * 2]; w1[i] = a.wts[(row0 + i) * 2 + 1]; }
        }
        f32x4 xf[XF32 ? NR : 1][2][2]; u32x4 xb[XF32 ? 1 : NR][2]; u32x4 p[NR][2], q[MOE ? NR : 1][2];
#pragma unroll
        for (int i = 0; i < NR; ++i) {
            const u32x4* y0 = (const u32x4*)(a.y + (size_t)(MOE ? d0[i] : row0 + i) * DM) + lane; const u32x4* y1 = (const u32x4*)(a.y + (size_t)(MOE ? d1[i] : 0) * DM) + lane;
#pragma unroll
            for (int j = 0; j < 2; ++j) {
                if (XF32) { const f32x4* xr = (const f32x4*)(a.xin32 + (size_t)(row0 + i) * DM) + 2 * lane + 128 * j; xf[XF32 ? i : 0][j][0] = xr[0]; xf[XF32 ? i : 0][j][1] = xr[1]; }
                else xb[XF32 ? 0 : i][j] = ((const u32x4*)(a.xin + (size_t)(row0 + i) * DM) + lane)[64 * j];
                p[i][j] = y0[64 * j]; if (MOE) q[MOE ? i : 0][j] = y1[64 * j]; } }
#pragma unroll
        for (int i = 0; i < NR; ++i)
#pragma unroll
            for (int j = 0; j < 2; ++j) {
                float x[8];
                if (XF32) {
#pragma unroll
                    for (int e = 0; e < 4; ++e) { x[e] = xf[XF32 ? i : 0][j][0][e]; x[4 + e] = xf[XF32 ? i : 0][j][1][e]; } }
                else { const u32x4 w = xb[XF32 ? 0 : i][j]; x[0] = bf_lo(w.x); x[1] = bf_hi(w.x); x[2] = bf_lo(w.y); x[3] = bf_hi(w.y); x[4] = bf_lo(w.z); x[5] = bf_hi(w.z); x[6] = bf_lo(w.w); x[7] = bf_hi(w.w); }
                const u32x4 pw = p[i][j]; const float py[8] = {bf_lo(pw.x), bf_hi(pw.x), bf_lo(pw.y), bf_hi(pw.y), bf_lo(pw.z), bf_hi(pw.z), bf_lo(pw.w), bf_hi(pw.w)};
                if (MOE) { const u32x4 qw = q[MOE ? i : 0][j]; const float qy[8] = {bf_lo(qw.x), bf_hi(qw.x), bf_lo(qw.y), bf_hi(qw.y), bf_lo(qw.z), bf_hi(qw.z), bf_lo(qw.w), bf_hi(qw.w)};
#pragma unroll
                    for (int e = 0; e < 8; ++e) v[i][j][e] = ALPHA * x[e] + w0[i] * py[e] + w1[i] * qy[e]; }
                else {
#pragma unroll
                    for (int e = 0; e < 8; ++e) v[i][j][e] = ALPHA * x[e] + py[e]; }
            }
    }
    float s[NR];
#pragma unroll
    for (int i = 0; i < NR; ++i) { s[i] = 0.f;
#pragma unroll
        for (int j = 0; j < 2; ++j)
#pragma unroll
            for (int e = 0; e < 8; ++e) s[i] += v[i][j][e]; }
#pragma unroll
    for (int o = 1; o < 64; o <<= 1)
#pragma unroll
        for (int i = 0; i < NR; ++i) s[i] += shx(s[i], o, lane);
    float q2[NR];
#pragma unroll
    for (int i = 0; i < NR; ++i) { const float mean = s[i] * (1.f / DM); q2[i] = 0.f;
#pragma unroll
        for (int j = 0; j < 2; ++j)
#pragma unroll
            for (int e = 0; e < 8; ++e) { v[i][j][e] -= mean; q2[i] += v[i][j][e] * v[i][j][e]; } }
#pragma unroll
    for (int o = 1; o < 64; o <<= 1)
#pragma unroll
        for (int i = 0; i < NR; ++i) q2[i] += shx(q2[i], o, lane);
    f32x4 gv[2][2], bv[2][2];
#pragma unroll
    for (int j = 0; j < 2; ++j) { const f32x4* gp = (const f32x4*)a.g + 2 * lane + 128 * j; const f32x4* bp = (const f32x4*)a.b + 2 * lane + 128 * j; gv[j][0] = gp[0]; gv[j][1] = gp[1]; bv[j][0] = bp[0]; bv[j][1] = bp[1]; }
#pragma unroll
    for (int i = 0; i < NR; ++i) { const float rstd = rsqrtf(q2[i] * (1.f / DM) + LN_EPS);
#pragma unroll
        for (int j = 0; j < 2; ++j) { float o[8];
#pragma unroll
            for (int e = 0; e < 8; ++e) o[e] = v[i][j][e] * rstd * gv[j][e >> 2][e & 3] + bv[j][e >> 2][e & 3];
            if (OUTF32) { f32x4* xo = (f32x4*)(a.xout32 + (size_t)(row0 + i) * DM) + 2 * lane + 128 * j; xo[0] = (f32x4){o[0], o[1], o[2], o[3]}; xo[1] = (f32x4){o[4], o[5], o[6], o[7]}; }
            else { u32x4 w; w.x = pk2(o[0], o[1]); w.y = pk2(o[2], o[3]); w.z = pk2(o[4], o[5]); w.w = pk2(o[6], o[7]); ((u32x4*)(a.xbf + (size_t)(row0 + i) * DM) + lane)[64 * j] = w; } } }
}
template <bool XF32, bool OUTF32, bool MOE>
__device__ __forceinline__ void ln_phase(const LnArgs& a, int blk, int G, int wave, int lane) {
    const int per = NT / G, r0 = blk * per, pw = per / NWAVE;
    for (int r = 0; r < pw; r += 4) ln_rows<4, XF32, OUTF32, MOE>(a, r0 + wave * pw + r, lane);
}
__device__ __forceinline__ void xattn_phase(LAS unsigned char* lds, const bf16_t* __restrict__ Q, const bf16_t* __restrict__ KC, const bf16_t* __restrict__ VT, bf16_t* __restrict__ O, int blk, int G) {
    const int tid0 = threadIdx.x, wave = __builtin_amdgcn_readfirstlane(tid0 >> 6);
#define XA_IDS int tid = tid0; asm volatile("" : "+v"(tid)); const int lane = tid & 63, r32 = lane & 31, hh = lane >> 5; const size_t qrow = (size_t)b * SEQ + qb * 256 + wave * 32 + r32; (void)lane; (void)hh; (void)qrow;
    for (int u = blk; u < 512; u += G) {
        const int qb = u & 15, h = (u >> 4) & 3, b = u >> 6;
        XA_IDS;
        bf16x8 qf[16];
#pragma unroll
        for (int ks = 0; ks < 16; ++ks) qf[ks] = *(const bf16x8*)(Q + qrow * 1024 + h * 256 + ks * 16 + hh * 8);
        __syncthreads();
#pragma unroll
        for (int bt = 0; bt < 2; ++bt) {
            u32x4 t[8];
#pragma unroll
            for (int i = 0; i < 8; ++i) { const int ch = tid + 512 * (bt * 8 + i), row = ch >> 5, c = ch & 31; t[i] = *(const u32x4*)(KC + (size_t)(b * 256 + row) * 1024 + h * 256 + c * 8); }
#pragma unroll
            for (int i = 0; i < 8; ++i) { const int ch = tid + 512 * (bt * 8 + i), row = ch >> 5, c = ch & 31; *(LAS u32x4*)(lds + row * 528 + c * 16) = t[i]; }
        }
        __syncthreads();
        f32x16 s[8];
#pragma unroll
        for (int mt = 0; mt < 8; ++mt)
#pragma unroll
            for (int r = 0; r < 16; ++r) s[mt][r] = 0.f;
        {   const LAS unsigned char* kbp = lds + r32 * 528 + hh * 16;
#pragma unroll
            for (int ks = 0; ks < 16; ++ks)
#pragma unroll
                for (int mt = 0; mt < 8; ++mt) { const bf16x8 a = *(const LAS bf16x8*)(kbp + mt * 32 * 528 + ks * 32); s[mt] = MFMA32(a, qf[ks], s[mt]); }
        }
        float mx = -INFINITY;
#pragma unroll
        for (int mt = 0; mt < 8; ++mt)
#pragma unroll
            for (int r = 0; r < 16; ++r) mx = fmaxf(mx, s[mt][r]);
        mx = xhalf_max(mx);
        float sm = 0.f; const float mxl = mx * LOG2E;
        u32x4 pf[8][2];
#pragma unroll
        for (int mt = 0; mt < 8; ++mt) {
#pragma unroll
            for (int r = 0; r < 16; ++r) { const float p = __builtin_amdgcn_exp2f(s[mt][r] * LOG2E - mxl); s[mt][r] = p; sm += p; }
#pragma unroll
            for (int sx = 0; sx < 2; ++sx) pf[mt][sx] = (u32x4){pk2(s[mt][8 * sx], s[mt][8 * sx + 1]), pk2(s[mt][8 * sx + 2], s[mt][8 * sx + 3]), pk2(s[mt][8 * sx + 4], s[mt][8 * sx + 5]), pk2(s[mt][8 * sx + 6], s[mt][8 * sx + 7])};
        }
        sm = xhalf_sum(sm);
        __syncthreads();
        {   XA_IDS;
#pragma unroll
        for (int bt = 0; bt < 4; ++bt) {
            u32x4 t[4];
#pragma unroll
            for (int i = 0; i < 4; ++i) { const int ch = tid + 512 * (bt * 4 + i), row = ch >> 5, c = ch & 31; t[i] = *(const u32x4*)(VT + (size_t)(h * 256 + row) * 2048 + b * 256 + c * 8); }
#pragma unroll
            for (int i = 0; i < 4; ++i) { const int ch = tid + 512 * (bt * 4 + i), row = ch >> 5, c = ch & 31; LAS u32x2* d = (LAS u32x2*)(lds + row * 520 + c * 16); d[0] = (u32x2){t[i].x, t[i].y}; d[1] = (u32x2){t[i].z, t[i].w}; }
        }
        }
        __syncthreads();
        {   XA_IDS;
        const float inv = 1.f / sm;
        bf16_t* orow = O + qrow * 1024 + h * 256 + 4 * hh;
#pragma unroll 1
        for (int dh = 0; dh < 2; ++dh) {
            f32x16 o[4];
#pragma unroll
            for (int dt = 0; dt < 4; ++dt)
#pragma unroll
                for (int r = 0; r < 16; ++r) o[dt][r] = 0.f;
            const LAS unsigned char* vb = lds + (dh * 128 + r32) * 520 + 8 * hh;
#pragma unroll
            for (int mt = 0; mt < 8; ++mt)
#pragma unroll
                for (int sx = 0; sx < 2; ++sx) { const int kb = mt * 32 + 16 * sx; const bf16x8 pb = __builtin_bit_cast(bf16x8, pf[mt][sx]);
#pragma unroll
                    for (int dt = 0; dt < 4; ++dt) { const LAS unsigned char* q = vb + dt * 32 * 520 + kb * 2;
                        const s16x4 lo = *(const LAS s16x4*)q, hi = *(const LAS s16x4*)(q + 16);
                        const bf16x8 a = (bf16x8){lo[0], lo[1], lo[2], lo[3], hi[0], hi[1], hi[2], hi[3]}; o[dt] = MFMA32(a, pb, o[dt]); } }
#pragma unroll
            for (int dt = 0; dt < 4; ++dt)
#pragma unroll
                for (int g = 0; g < 4; ++g) { u32x2 w; w.x = pk2(o[dt][4 * g] * inv, o[dt][4 * g + 1] * inv); w.y = pk2(o[dt][4 * g + 2] * inv, o[dt][4 * g + 3] * inv); *(u32x2*)(orow + dh * 128 + dt * 32 + 8 * g) = w; }
        }
        }
    }
#undef XA_IDS
}

struct RouteBufs { int* e; float* w; int* rank; int* dest; int* hist; int* tstart; int* src; };
__device__ __forceinline__ void moe_router_phase(LAS unsigned char* lds, const bf16_t* __restrict__ XBF, const bf16_t* __restrict__ WRT, const float* __restrict__ brg, const float* __restrict__ bre, const RouteBufs rb, int blk) {
    int tid_ = threadIdx.x; asm volatile("" : "+v"(tid_)); const int tid = tid_, lane = tid & 63, wave = __builtin_amdgcn_readfirstlane(tid >> 6), r32 = lane & 31, hh = lane >> 5;
    LAS unsigned char* XT = lds; LAS unsigned char* WT = lds + 128 * 528;
    LAS float* LG = (LAS float*)lds;
    LAS int* hist = (LAS int*)(lds + 128 * 65 * 4);
    const int rbk = wave & 3, ct = wave >> 2;
    f32x16 acc;
#pragma unroll
    for (int r = 0; r < 16; ++r) acc[r] = 0.f;
#pragma unroll 1
    for (int kc = 0; kc < 4; ++kc) {
        __syncthreads();
        {   u32x4 tx[8], tw[8];
#pragma unroll
            for (int i = 0; i < 8; ++i) { const int ch = tid + 512 * i, row = ch >> 5, c = ch & 31; tx[i] = *(const u32x4*)(XBF + (size_t)(blk * 128 + row) * 1024 + kc * 256 + c * 8); tw[i] = *(const u32x4*)(WRT + (size_t)row * 1024 + kc * 256 + c * 8); }
#pragma unroll
            for (int i = 0; i < 8; ++i) { const int ch = tid + 512 * i, row = ch >> 5, c = ch & 31; *(LAS u32x4*)(XT + row * 528 + c * 16) = tx[i]; *(LAS u32x4*)(WT + row * 528 + c * 16) = tw[i]; } }
        __syncthreads();
        const LAS unsigned char* ap = XT + (rbk * 32 + r32) * 528 + hh * 16; const LAS unsigned char* bp = WT + (ct * 32 + r32) * 528 + hh * 16;
#pragma unroll
        for (int ks = 0; ks < 16; ++ks) { const bf16x8 a = *(const LAS bf16x8*)(ap + ks * 32), b0 = *(const LAS bf16x8*)(bp + ks * 32), b1 = *(const LAS bf16x8*)(bp + 64 * 528 + ks * 32);
            acc = MFMA32(a, b0, acc); acc = MFMA32(a, b1, acc); }
    }
    __syncthreads();
    if (tid < 32) hist[tid] = 0;
#pragma unroll
    for (int r = 0; r < 16; ++r) LG[(rbk * 32 + crow(r, hh)) * 65 + ct * 32 + r32] = acc[r];
    __syncthreads();
    if (tid < 128) {
        const LAS float* lg = LG + tid * 65; const int tok = blk * 128 + tid;
        float g4[4];
#pragma unroll
        for (int g = 0; g < 4; ++g) g4[g] = lg[32 + g] + brg[g];
        int gi = 0; float gm = g4[0];
#pragma unroll
        for (int g = 1; g < 4; ++g) if (g4[g] > gm) { gm = g4[g]; gi = g; }
        float gs = 0.f;
#pragma unroll
        for (int g = 0; g < 4; ++g) gs += fast_exp(g4[g] - gm);
        const float gate_g = 1.f / gs;
        float le[8];
#pragma unroll
        for (int e = 0; e < 8; ++e) le[e] = lg[gi * 8 + e] + bre[gi * 8 + e];
        int i0 = 0; float v0 = le[0];
#pragma unroll
        for (int e = 1; e < 8; ++e) if (le[e] > v0) { v0 = le[e]; i0 = e; }
        int i1 = 0; float v1 = -INFINITY;
#pragma unroll
        for (int e = 0; e < 8; ++e) if (e != i0 && le[e] > v1) { v1 = le[e]; i1 = e; }
        const float e1 = fast_exp(v1 - v0), p0 = 1.f / (1.f + e1), p1 = e1 * p0;
        const int ex0 = gi * 8 + i0, ex1 = gi * 8 + i1;
        rb.e[tok * 2] = ex0; rb.e[tok * 2 + 1] = ex1; rb.w[tok * 2] = gate_g * p0; rb.w[tok * 2 + 1] = gate_g * p1;
        rb.rank[tok * 2] = atomicAdd((int*)&hist[ex0], 1); rb.rank[tok * 2 + 1] = atomicAdd((int*)&hist[ex1], 1);
    }
    __syncthreads();
    if (tid < 32) rb.hist[blk * 32 + tid] = hist[tid];
}
__device__ __forceinline__ void moe_scatter_phase(LAS unsigned char* lds, const RouteBufs rb, int blk, int G) {
    int tid_ = threadIdx.x; asm volatile("" : "+v"(tid_)); const int tid = tid_, lane = tid & 63, wave = __builtin_amdgcn_readfirstlane(tid >> 6);
    LAS int* sb = (LAS int*)lds;
    __syncthreads();
    {
        const int e = tid & 31, part = tid >> 5; int c[16];
#pragma unroll
        for (int i = 0; i < 16; ++i) c[i] = rb.hist[(part * 16 + i) * 32 + e];
        int tot = 0, base = 0;
#pragma unroll
        for (int i = 0; i < 16; ++i) { tot += c[i]; if (part * 16 + i < blk) base += c[i]; }
        sb[128 + part * 32 + e] = base; sb[128 + 512 + part * 32 + e] = tot; }
    __syncthreads();
    if (tid < 32) { int tot = 0, base = 0;
#pragma unroll
        for (int i = 0; i < 16; ++i) { base += sb[128 + i * 32 + tid]; tot += sb[128 + 512 + i * 32 + tid]; }
        sb[tid] = base; sb[32 + tid] = tot; }
    __syncthreads();
    if (tid == 0) { int acc = 0; for (int e = 0; e < 32; ++e) { sb[64 + e] = acc; if (blk == 0) rb.tstart[e] = acc >> 8; acc += (sb[32 + e] + 255) & ~255; } sb[96] = acc; if (blk == 0) rb.tstart[32] = acc >> 8; }
    __syncthreads();
    if (tid < 256) { const int idx = blk * 256 + tid; const int e = rb.e[idx]; const int d = sb[64 + e] + sb[e] + rb.rank[idx]; rb.dest[idx] = d; rb.src[d] = idx >> 1; }
    if (blk < 32) { const int e = blk; const int lo = sb[64 + e] + sb[32 + e], hi = sb[64 + e] + ((sb[32 + e] + 255) & ~255); for (int r = lo + tid; r < hi; r += NTHR) rb.src[r] = 0; }
}
struct MoeSched {
    const char* A; const char* B; const int* tstart; int K, nN, G, c; size_t bexp;
    __device__ __forceinline__ pg8::Unit get(int i, bool& ok) const { pg8::Unit u; u.A = nullptr; u.B = nullptr; u.src = nullptr; u.pm = 0; u.pn = 0; u.job = 0; ok = next(i, u); return u; }
    __device__ __forceinline__ bool next(int i, pg8::Unit& u) const {
        const int vc = (c & 7) * (G >> 3) + (c >> 3);
        const long L = (long)i * G + vc; const int ntile = tstart[32];
        if (L >= (long)ntile * nN) return false;
        const int mt = (int)(L / nN), nt = (int)(L % nN);
        int e = 0;
        for (int k = 1; k < 32; ++k) if (tstart[k] <= mt) e = k;
        u.A = A + (size_t)mt * 256 * K * 2; u.B = B + (size_t)e * bexp + (size_t)nt * 256 * K * 2; u.src = nullptr; u.pm = mt; u.pn = nt; u.job = 0; return true;
    }
};
__device__ __forceinline__ void swa_phase(LAS unsigned char* lds, const bf16_t* __restrict__ Q1, const bf16_t* __restrict__ K1, const bf16_t* __restrict__ VT1, const float* __restrict__ sinks, bf16_t* __restrict__ O, int blk, int G) {
    int tid_ = threadIdx.x; asm volatile("" : "+v"(tid_)); const int tid = tid_, lane = tid & 63, wave = __builtin_amdgcn_readfirstlane(tid >> 6), r32 = lane & 31, hh = lane >> 5;
    LAS unsigned char* KL = lds;
    LAS unsigned char* VL = lds + 36864;
    for (int u = blk; u < 1024; u += G) {
        const int n = u & 31, kvh = (u >> 5) & 3, b = u >> 7;
        const int tokb = b * SEQ + (n - 1) * 128;
        bf16x8 qfa[2][4];
        {   const int g0 = wave >> 1, hq0 = kvh * 4 + g0;
#pragma unroll
            for (int sb = 0; sb < 2; ++sb)
#pragma unroll
                for (int ks = 0; ks < 4; ++ks) qfa[sb][ks] = *(const bf16x8*)(Q1 + ((size_t)b * SEQ + n * 128 + (wave & 1) * 64 + sb * 32 + r32) * 1024 + hq0 * 64 + ks * 16 + hh * 8); }
        __syncthreads();
#pragma unroll
        for (int i = 0; i < 4; ++i) { const int ch = tid + 512 * i; const int key = ch >> 3, c = ch & 7;
            u32x4 v = (u32x4){0u, 0u, 0u, 0u}; if (n > 0 || key >= 128) v = *(const u32x4*)(K1 + (size_t)(tokb + key) * 256 + kvh * 64 + c * 8);
            *(LAS u32x4*)(KL + key * 144 + c * 16) = v; }
#pragma unroll
        for (int i = 0; i < 4; ++i) { const int ch = tid + 512 * i; const int d = ch >> 5, c = ch & 31;
            u32x4 v = (u32x4){0u, 0u, 0u, 0u}; if (n > 0 || c >= 16) v = *(const u32x4*)(VT1 + (size_t)(kvh * 64 + d) * NT + tokb + c * 8);
            LAS u32x2* dp = (LAS u32x2*)(VL + d * 520 + c * 16); dp[0] = (u32x2){v.x, v.y}; dp[1] = (u32x2){v.z, v.w}; }
        __syncthreads();
        const int g = wave >> 1, hq = kvh * 4 + g; const float sink = sinks[hq];
#pragma unroll 1
        for (int sb = 0; sb < 2; ++sb) {
            bf16x8 qf[4];
#pragma unroll
            for (int ks = 0; ks < 4; ++ks) qf[ks] = sb ? qfa[1][ks] : qfa[0][ks];
            const int i0 = (wave & 1) * 64 + sb * 32, jt0 = i0 >> 5;
            const size_t qtok = (size_t)b * SEQ + n * 128 + i0 + r32;
            f32x16 s[5];
#pragma unroll
            for (int t = 0; t < 5; ++t) {
#pragma unroll
                for (int r = 0; r < 16; ++r) s[t][r] = 0.f;
                const LAS unsigned char* kp = KL + ((jt0 + t) * 32 + r32) * 144 + hh * 16;
#pragma unroll
                for (int ks = 0; ks < 4; ++ks) { const bf16x8 a = *(const LAS bf16x8*)(kp + ks * 32); s[t] = MFMA32(a, qf[ks], s[t]); }
            }
            const int qi = i0 + r32;
            float mx = sink;
#pragma unroll
            for (int t = 0; t < 5; ++t)
#pragma unroll
                for (int r = 0; r < 16; ++r) { const int kj = (jt0 + t) * 32 + crow(r, hh); const bool valid = (kj > qi) && (kj <= qi + 128) && (n > 0 || kj >= 128);
                    s[t][r] = valid ? s[t][r] : -INFINITY; mx = fmaxf(mx, s[t][r]); }
            mx = xhalf_max(mx);
            float sm = 0.f; const float mxl = mx * LOG2E;
            u32x4 pf[5][2];
#pragma unroll
            for (int t = 0; t < 5; ++t) {
#pragma unroll
                for (int r = 0; r < 16; ++r) { const float pv = __builtin_amdgcn_exp2f(s[t][r] * LOG2E - mxl); s[t][r] = pv; sm += pv; }
#pragma unroll
                for (int sx = 0; sx < 2; ++sx) pf[t][sx] = (u32x4){pk2(s[t][8 * sx], s[t][8 * sx + 1]), pk2(s[t][8 * sx + 2], s[t][8 * sx + 3]), pk2(s[t][8 * sx + 4], s[t][8 * sx + 5]), pk2(s[t][8 * sx + 6], s[t][8 * sx + 7])};
            }
            sm = xhalf_sum(sm) + __builtin_amdgcn_exp2f(sink * LOG2E - mxl);
            f32x16 o[2];
#pragma unroll
            for (int dt = 0; dt < 2; ++dt)
#pragma unroll
                for (int r = 0; r < 16; ++r) o[dt][r] = 0.f;
#pragma unroll
            for (int t = 0; t < 5; ++t)
#pragma unroll
                for (int sx = 0; sx < 2; ++sx) { const bf16x8 pb = __builtin_bit_cast(bf16x8, pf[t][sx]);
#pragma unroll
                    for (int dt = 0; dt < 2; ++dt) { const LAS unsigned char* q = VL + (dt * 32 + r32) * 520 + ((jt0 + t) * 32 + 16 * sx + 4 * hh) * 2;
                        const s16x4 lo = *(const LAS s16x4*)q, hi = *(const LAS s16x4*)(q + 16);
                        const bf16x8 a = (bf16x8){lo[0], lo[1], lo[2], lo[3], hi[0], hi[1], hi[2], hi[3]}; o[dt] = MFMA32(a, pb, o[dt]); } }
            const float inv = 1.f / sm;
            bf16_t* orow = O + qtok * 1024 + hq * 64 + 4 * hh;
#pragma unroll
            for (int dt = 0; dt < 2; ++dt)
#pragma unroll
                for (int gq = 0; gq < 4; ++gq) { u32x2 w; w.x = pk2(o[dt][4 * gq] * inv, o[dt][4 * gq + 1] * inv); w.y = pk2(o[dt][4 * gq + 2] * inv, o[dt][4 * gq + 3] * inv); *(u32x2*)(orow + dt * 32 + 8 * gq) = w; }
        }
    }
}
constexpr int TS = 272;
template <int STRIDE = TS>
__device__ __forceinline__ bf16x8 tr_frag(const LAS unsigned char* T, int k0, int c0, int lane, bool permuted) {
    const int hh = lane >> 5, blk = (lane >> 4) & 1, q = (lane & 15) >> 2, pp = lane & 3;
    const int r0 = k0 + (permuted ? 4 * hh : 8 * hh) + q, r1 = r0 + (permuted ? 8 : 4);
    const int cb = (c0 + 16 * blk + 4 * pp) * 2;
    const s16x4 lo = lds_tr(T + r0 * STRIDE + cb), hi = lds_tr(T + r1 * STRIDE + cb);
    return (bf16x8){lo[0], lo[1], lo[2], lo[3], hi[0], hi[1], hi[2], hi[3]};
}
__device__ __forceinline__ bf16x8 row_frag(const LAS unsigned char* T, int row, int k0, int hh) { return *(const LAS bf16x8*)(T + row * TS + (k0 + 8 * hh) * 2); }
__device__ __forceinline__ void load_tile128(LAS unsigned char* T, const bf16_t* __restrict__ g, int ld, int tid) {
#pragma unroll
    for (int i = 0; i < 4; ++i) { const int ch = tid + 512 * i, row = ch >> 4, c = ch & 15; *(LAS u32x4*)(T + row * TS + c * 16) = *(const u32x4*)(g + (size_t)row * ld + c * 8); }
}
struct L0Bufs {
    bf16_t *AU, *AV, *BX, *BZ, *V, *XC, *YM, *CS, *Q, *K, *U; float *GT, *UN, *NS, *SC;
    const bf16_t *WQT, *GMW, *MT; const float *gm_g, *gm_b, *gm_bs, *cw, *cb, *bif, *nw, *skip;
};

__device__ __forceinline__ void l0_mixA(LAS unsigned char* lds, const L0Bufs& B, int blk, int G) {
    const int tid0 = threadIdx.x, wave = __builtin_amdgcn_readfirstlane(tid0 >> 6);
#define OPQ_IDS int tid = tid0; asm volatile("" : "+v"(tid)); const int lane = tid & 63, r32 = lane & 31, hh = lane >> 5; (void)lane; (void)r32; (void)hh;
    LAS unsigned char* T0 = lds; LAS unsigned char* T1 = lds + 34816; LAS unsigned char* T2 = lds + 2 * 34816; LAS unsigned char* T3 = lds + 3 * 34816;
    LAS float* SF = (LAS float*)T2;
    LAS float* SG = (LAS float*)(lds + 3 * 34816 + 35632);
    for (int u = blk; u < 256; u += G) {
        const int tok0 = u * 128; const bool first = (u & 31) == 0;
        constexpr int VS = 1040;
        {   OPQ_IDS; const int trow = tid >> 2, q4 = tid & 3;
            const bf16_t* vr = B.AV + (size_t)(tok0 + trow) * 512 + q4 * 128; float s = 0.f, s2 = 0.f; u32x4 w[16];
#pragma unroll
            for (int i = 0; i < 16; ++i) w[i] = *(const u32x4*)(vr + i * 8);
#pragma unroll
            for (int i = 0; i < 16; ++i) { const float f[8] = {bf_lo(w[i].x), bf_hi(w[i].x), bf_lo(w[i].y), bf_hi(w[i].y), bf_lo(w[i].z), bf_hi(w[i].z), bf_lo(w[i].w), bf_hi(w[i].w)};
#pragma unroll
                for (int e = 0; e < 8; ++e) { s += f[e]; s2 += f[e] * f[e]; } }
            s += shx(s, 1, lane); s += shx(s, 2, lane); s2 += shx(s2, 1, lane); s2 += shx(s2, 2, lane);
            const float mean = s * (1.f / 512.f), rstd = rsqrtf(fmaxf(s2 * (1.f / 512.f) - mean * mean, 0.f) + LN_EPS);
            __syncthreads();
#pragma unroll
            for (int i = 0; i < 16; ++i) { const int cbase = q4 * 128 + i * 8; const f32x4 g0 = *(const f32x4*)(B.gm_g + cbase), g1 = *(const f32x4*)(B.gm_g + cbase + 4), b0 = *(const f32x4*)(B.gm_b + cbase), b1 = *(const f32x4*)(B.gm_b + cbase + 4);
                u32x4 o; o.x = pk2((bf_lo(w[i].x) - mean) * rstd * g0[0] + b0[0], (bf_hi(w[i].x) - mean) * rstd * g0[1] + b0[1]); o.y = pk2((bf_lo(w[i].y) - mean) * rstd * g0[2] + b0[2], (bf_hi(w[i].y) - mean) * rstd * g0[3] + b0[3]);
                o.z = pk2((bf_lo(w[i].z) - mean) * rstd * g1[0] + b1[0], (bf_hi(w[i].z) - mean) * rstd * g1[1] + b1[1]); o.w = pk2((bf_lo(w[i].w) - mean) * rstd * g1[2] + b1[2], (bf_hi(w[i].w) - mean) * rstd * g1[3] + b1[3]);
                *(LAS u32x4*)(lds + trow * VS + cbase * 2) = o; asm volatile("" ::: "memory"); }
            __syncthreads();
        }
        {   const int tb = wave & 3, dhf = wave >> 2;
#pragma unroll 1
            for (int g = 0; g < 4; ++g) {
                OPQ_IDS; const int t = 32 * tb + r32; const size_t tok = (size_t)tok0 + t;
                f32x16 acc[2];
#pragma unroll
                for (int dt = 0; dt < 2; ++dt)
#pragma unroll
                    for (int r = 0; r < 16; ++r) acc[dt][r] = 0.f;
                const bf16_t* wrow = B.GMW + ((size_t)g * 128 + t) * 128 + 8 * hh;
                bf16x8 bw[8];
#pragma unroll
                for (int ks = 0; ks < 8; ++ks) bw[ks] = *(const bf16x8*)(wrow + 16 * ks);
#pragma unroll
                for (int ks = 0; ks < 8; ++ks) if (ks <= 2 * tb + 1) {
#pragma unroll
                    for (int dt = 0; dt < 2; ++dt) { const bf16x8 a = tr_frag<VS>(lds, 16 * ks, g * 128 + 64 * dhf + 32 * dt, lane, false); acc[dt] = MFMA32(a, bw[ks], acc[dt]); } }
                const float bsv = B.gm_bs[g * 128 + t];
#pragma unroll
                for (int dt = 0; dt < 2; ++dt)
#pragma unroll
                    for (int gq = 0; gq < 4; ++gq) { const int col = g * 128 + 64 * dhf + 32 * dt + 8 * gq + 4 * hh; const u32x2 au = *(const u32x2*)(B.AU + tok * 512 + col);
                        u32x2 w; w.x = pk2(bf_lo(au.x) * (acc[dt][4 * gq] + bsv), bf_hi(au.x) * (acc[dt][4 * gq + 1] + bsv)); w.y = pk2(bf_lo(au.y) * (acc[dt][4 * gq + 2] + bsv), bf_hi(au.y) * (acc[dt][4 * gq + 3] + bsv));
                        *(u32x2*)(B.YM + tok * 1024 + col) = w; }
            }
        }
        f32x16 accg;
#pragma unroll
        for (int r = 0; r < 16; ++r) accg[r] = 0.f;
        LAS unsigned char* MTL = (LAS unsigned char*)SG;
#pragma unroll 1
        for (int h = 0; h < 4; ++h) {
            OPQ_IDS;
            __syncthreads();
            for (int ch = tid; ch < 131 * 16; ch += 512) { const int row = ch >> 4, c = ch & 15; u32x4 v = (u32x4){0u, 0u, 0u, 0u};
                if (!(first && row < 3)) v = *(const u32x4*)(B.BX + (size_t)(tok0 - 3 + row) * 512 + h * 128 + c * 8);
                *(LAS u32x4*)(T3 + row * TS + c * 16) = v; }
            load_tile128(T0, B.WQT + ((size_t)0 * 4 + h) * 128 * 128, 128, tid);
            load_tile128(T1, B.WQT + ((size_t)1 * 4 + h) * 128 * 128, 128, tid);
            if (tid < 256) { const int row = tid >> 5, c = tid & 31; *(LAS u32x4*)(MTL + row * 528 + c * 16) = *(const u32x4*)(B.MT + ((size_t)h * 8 + row) * 256 + c * 8); }
            __syncthreads();
            {   const int dc = tid & 15, chn = h * 128 + dc * 8; float w[4][8], cbv[8];
#pragma unroll
                for (int j = 0; j < 4; ++j)
#pragma unroll
                    for (int e = 0; e < 8; ++e) w[j][e] = B.cw[j * 512 + chn + e];
#pragma unroll
                for (int e = 0; e < 8; ++e) cbv[e] = B.cb[chn + e];
#pragma unroll 1
                for (int ps = 0; ps < 4; ++ps) { const int t = ps * 32 + (tid >> 4); float a[8];
#pragma unroll
                    for (int e = 0; e < 8; ++e) a[e] = cbv[e];
#pragma unroll
                    for (int j = 0; j < 4; ++j) { const u32x4 x = *(const LAS u32x4*)(T3 + (t + j) * TS + dc * 16);
                        a[0] += w[j][0] * bf_lo(x.x); a[1] += w[j][1] * bf_hi(x.x); a[2] += w[j][2] * bf_lo(x.y); a[3] += w[j][3] * bf_hi(x.y);
                        a[4] += w[j][4] * bf_lo(x.z); a[5] += w[j][5] * bf_hi(x.z); a[6] += w[j][6] * bf_lo(x.w); a[7] += w[j][7] * bf_hi(x.w); }
                    u32x4 o; o.x = pk2(silu_f(a[0]), silu_f(a[1])); o.y = pk2(silu_f(a[2]), silu_f(a[3])); o.z = pk2(silu_f(a[4]), silu_f(a[5])); o.w = pk2(silu_f(a[6]), silu_f(a[7]));
                    *(LAS u32x4*)(T2 + t * TS + dc * 16) = o; *(u32x4*)(B.XC + (size_t)(tok0 + t) * 512 + chn) = o; } }
            __syncthreads();
            {   const int tb = wave & 3, ehf = wave >> 2;
                {
                    OPQ_IDS; const LAS unsigned char* act = ehf ? T3 + 3 * TS : T2;
#pragma unroll
                    for (int ks = 0; ks < 8; ++ks) { const bf16x8 a = *(const LAS bf16x8*)(MTL + (r32 & 7) * 528 + (ehf * 128 + 16 * ks + 8 * hh) * 2); const bf16x8 bx = row_frag(act, 32 * tb + r32, 16 * ks, hh); accg = MFMA32(a, bx, accg); } }
#pragma unroll 1
                for (int mtx = 0; mtx < 2; ++mtx) {
                    OPQ_IDS;
                    const LAS unsigned char* wt = mtx ? T1 : T0;
                    f32x16 acc[2];
#pragma unroll
                    for (int et = 0; et < 2; ++et)
#pragma unroll
                        for (int r = 0; r < 16; ++r) acc[et][r] = 0.f;
#pragma unroll
                    for (int ks = 0; ks < 8; ++ks) { const bf16x8 bx = row_frag(T2, 32 * tb + r32, 16 * ks, hh);
#pragma unroll
                        for (int et = 0; et < 2; ++et) { const bf16x8 a = row_frag(wt, 64 * ehf + 32 * et + r32, 16 * ks, hh); acc[et] = MFMA32(a, bx, acc[et]); } }
                    bf16_t* dst = (mtx == 0 ? B.Q : B.K) + (size_t)(tok0 + 32 * tb + r32) * 512 + h * 128 + 64 * ehf + 4 * hh;
#pragma unroll
                    for (int et = 0; et < 2; ++et)
#pragma unroll
                        for (int gq = 0; gq < 4; ++gq) { u32x2 w; w.x = pk2(acc[et][4 * gq], acc[et][4 * gq + 1]); w.y = pk2(acc[et][4 * gq + 2], acc[et][4 * gq + 3]); *(u32x2*)(dst + 32 * et + 8 * gq) = w; }
                }
            }
            __syncthreads();
            load_tile128(T0, B.WQT + ((size_t)2 * 4 + h) * 128 * 128, 128, tid);
            __syncthreads();
            {   OPQ_IDS; const int tb = wave & 3, ehf = wave >> 2;
                f32x16 acc[2];
#pragma unroll
                for (int et = 0; et < 2; ++et)
#pragma unroll
                    for (int r = 0; r < 16; ++r) acc[et][r] = 0.f;
#pragma unroll
                for (int ks = 0; ks < 8; ++ks) { const bf16x8 bx = row_frag(T3 + 3 * TS, 32 * tb + r32, 16 * ks, hh);
#pragma unroll
                    for (int et = 0; et < 2; ++et) { const bf16x8 a = row_frag(T0, 64 * ehf + 32 * et + r32, 16 * ks, hh); acc[et] = MFMA32(a, bx, acc[et]); } }
                bf16_t* dst = B.V + (size_t)(tok0 + 32 * tb + r32) * 512 + h * 128 + 64 * ehf + 4 * hh;
#pragma unroll
                for (int et = 0; et < 2; ++et)
#pragma unroll
                    for (int gq = 0; gq < 4; ++gq) { u32x2 w; w.x = pk2(acc[et][4 * gq], acc[et][4 * gq + 1]); w.y = pk2(acc[et][4 * gq + 2], acc[et][4 * gq + 3]); *(u32x2*)(dst + 32 * et + 8 * gq) = w; }
            }
        }
        __syncthreads();
        {   OPQ_IDS; const int tb = wave & 3, kh = wave >> 2;
#pragma unroll
            for (int r = 0; r < 4; ++r) SF[(kh * 8 + r + 4 * hh) * 128 + 32 * tb + r32] = accg[r];
        }
        __syncthreads();
        LAS float* IG = SG; LAS float* BC = SG + 512; LAS float* WG = SG + 1024;
        if (wave < 4) {
            OPQ_IDS; const int h = wave; float lf[2], ig[2];
#pragma unroll
            for (int e = 0; e < 2; ++e) { const int t = 2 * lane + e; ig[e] = SF[h * 128 + t] + SF[(8 + h) * 128 + t] + B.bif[h];
                const float fx = SF[(4 + h) * 128 + t] + SF[(12 + h) * 128 + t] + B.bif[4 + h]; lf[e] = fminf(fx, 0.f) - log1pf(expf(-fabsf(fx))); }
            float run = lf[0] + lf[1];
#pragma unroll
            for (int o = 1; o < 64; o <<= 1) { const float v = shup(run, o, lane); if (lane >= o) run += v; }
            const float b1 = run, b0 = run - lf[1];
            IG[h * 128 + 2 * lane] = ig[0]; IG[h * 128 + 2 * lane + 1] = ig[1]; BC[h * 128 + 2 * lane] = b0; BC[h * 128 + 2 * lane + 1] = b1;
            float* gt = B.GT + ((size_t)u * 4 + h) * 256;
            gt[2 * lane] = ig[0]; gt[2 * lane + 1] = ig[1]; gt[128 + 2 * lane] = b0; gt[128 + 2 * lane + 1] = b1;
            const float bl = shidx(b1, 63);
            float g0 = bl - b0 + ig[0], g1 = bl - b1 + ig[1]; float mloc = fmaxf(g0, g1);
#pragma unroll
            for (int o = 1; o < 64; o <<= 1) mloc = fmaxf(mloc, shx(mloc, o, lane));
            WG[h * 128 + 2 * lane] = expf(g0 - mloc); WG[h * 128 + 2 * lane + 1] = expf(g1 - mloc);
            if (lane == 0) { B.SC[u * 4 + h] = bl; B.SC[1024 + u * 4 + h] = mloc; }
        }
#pragma unroll 1
        for (int h = 0; h < 4; ++h) {
            OPQ_IDS;
            __syncthreads();
#pragma unroll
            for (int i = 0; i < 4; ++i) { const int ch = tid + 512 * i, row = ch >> 4, c = ch & 15; const float wg = WG[h * 128 + row];
                const u32x4 v = *(const u32x4*)(B.V + (size_t)(tok0 + row) * 512 + h * 128 + c * 8), k = *(const u32x4*)(B.K + (size_t)(tok0 + row) * 512 + h * 128 + c * 8);
                u32x4 ov, ok; const float ksc = 0.08838834764831845f;
                ov.x = pk2(bf_lo(v.x) * wg, bf_hi(v.x) * wg); ov.y = pk2(bf_lo(v.y) * wg, bf_hi(v.y) * wg); ov.z = pk2(bf_lo(v.z) * wg, bf_hi(v.z) * wg); ov.w = pk2(bf_lo(v.w) * wg, bf_hi(v.w) * wg);
                ok.x = pk2(bf_lo(k.x) * ksc, bf_hi(k.x) * ksc); ok.y = pk2(bf_lo(k.y) * ksc, bf_hi(k.y) * ksc); ok.z = pk2(bf_lo(k.z) * ksc, bf_hi(k.z) * ksc); ok.w = pk2(bf_lo(k.w) * ksc, bf_hi(k.w) * ksc);
                *(LAS u32x4*)(T0 + row * TS + c * 16) = ov; *(LAS u32x4*)(T1 + row * TS + c * 16) = ok; }
            __syncthreads();
            const int vb = wave & 3, khf = wave >> 2;
            f32x16 acc[2];
#pragma unroll
            for (int kt = 0; kt < 2; ++kt)
#pragma unroll
                for (int r = 0; r < 16; ++r) acc[kt][r] = 0.f;
#pragma unroll
            for (int ks = 0; ks < 8; ++ks) { const bf16x8 a = tr_frag(T0, 16 * ks, 32 * vb, lane, false);
#pragma unroll
                for (int kt = 0; kt < 2; ++kt) { const bf16x8 bk = tr_frag(T1, 16 * ks, 64 * khf + 32 * kt, lane, false); acc[kt] = MFMA32(a, bk, acc[kt]); } }
            bf16_t* Uo = B.U + ((size_t)u * 4 + h) * 16384;
#pragma unroll
            for (int kt = 0; kt < 2; ++kt)
#pragma unroll
                for (int r = 0; r < 16; ++r) Uo[(32 * vb + crow(r, hh)) * 128 + 64 * khf + 32 * kt + r32] = f2bf(acc[kt][r]);
            {   const int kk = tid & 127, sq = tid >> 7; float a = 0.f;
                for (int s = sq * 32; s < sq * 32 + 32; ++s) a += WG[h * 128 + s] * bf2f(*(const LAS bf16_t*)(T1 + s * TS + kk * 2));
                SF[2048 + sq * 128 + kk] = a; }
            __syncthreads();
            if (tid < 128) B.UN[((size_t)u * 4 + h) * 128 + tid] = (SF[2048 + tid] + SF[2048 + 128 + tid]) + (SF[2048 + 256 + tid] + SF[2048 + 384 + tid]);
        }
    }
}
#undef OPQ_IDS
__device__ __forceinline__ void l0_scan(const L0Bufs& B, int blk, int tid) {
    const int bh = blk >> 3, part = blk & 7, b = bh >> 2, h = bh & 3;
    const int e0 = part * 2048 + tid * 8;
    f32x4 C0 = (f32x4){0.f, 0.f, 0.f, 0.f}, C1 = C0; float nst = 0.f; float m = 0.f;
    const int unit0 = (b * 32) * 4 + h;
    u32x4 Unw = *(const u32x4*)(B.U + (size_t)unit0 * 16384 + e0); float bln = B.SC[unit0], mln = B.SC[1024 + unit0];
    float unn = (part == 0 && tid < 128) ? B.UN[(size_t)unit0 * 128 + tid] : 0.f;
    for (int c = 0; c < 32; ++c) {
        const int unit = unit0 + 4 * c;
        const f32x4 U0 = (f32x4){bf_lo(Unw.x), bf_hi(Unw.x), bf_lo(Unw.y), bf_hi(Unw.y)}, U1 = (f32x4){bf_lo(Unw.z), bf_hi(Unw.z), bf_lo(Unw.w), bf_hi(Unw.w)}; const float bl = bln, mloc = mln, un = unn;
        if (c < 31) { const int un1 = unit + 4; Unw = *(const u32x4*)(B.U + (size_t)un1 * 16384 + e0); bln = B.SC[un1]; mln = B.SC[1024 + un1]; if (part == 0 && tid < 128) unn = B.UN[(size_t)un1 * 128 + tid]; }
        u32x4 w; w.x = pk2(C0[0], C0[1]); w.y = pk2(C0[2], C0[3]); w.z = pk2(C1[0], C1[1]); w.w = pk2(C1[2], C1[3]); *(u32x4*)(B.CS + (size_t)unit * 16384 + e0) = w;
        if (part == 0 && tid < 128) B.NS[(size_t)unit * 128 + tid] = nst;
        if (part == 0 && tid == 0) B.SC[2048 + unit] = m;
        const float mn = fmaxf(bl + m, mloc), dec = expf(bl + m - mn), wu = expf(mloc - mn); m = mn;
        C0 = C0 * dec + U0 * wu; C1 = C1 * dec + U1 * wu;
        nst = nst * dec + wu * un;
    }
}
__device__ __forceinline__ void l0_mixC(LAS unsigned char* lds, const L0Bufs& B, int blk, int G) {
    const int tid0 = threadIdx.x, wave = __builtin_amdgcn_readfirstlane(tid0 >> 6);
    LAS unsigned char* TQ = lds; LAS unsigned char* TK = lds + 34816; LAS unsigned char* TV = lds + 2 * 34816; LAS unsigned char* TC = lds + 3 * 34816;
    LAS float* SF = (LAS float*)(lds + 4 * 34816);
    LAS float* AS = SF; LAS float* PM = SF + 128; LAS float* NP = SF + 256; LAS float* PS = SF + 384; LAS float* PQ = SF + 640; LAS float* NW = SF + 896;
    __syncthreads();
    { int tq = tid0; asm volatile("" : "+v"(tq)); if (tq < 256) ((LAS f32x4*)NW)[tq] = tq < 128 ? ((const f32x4*)B.nw)[tq] : ((const f32x4*)B.skip)[tq - 128]; }
    for (int uu = blk; uu < 256; uu += G) {
        const int tok0 = uu * 128;
#pragma unroll 1
        for (int h = 0; h < 4; ++h) {
            const int unit = uu * 4 + h;
            int tid = tid0; asm volatile("" : "+v"(tid));
            const int lane = tid & 63, r32 = lane & 31, hh = lane >> 5;
            __syncthreads();
            load_tile128(TQ, B.Q + (size_t)tok0 * 512 + h * 128, 512, tid);
            load_tile128(TV, B.V + (size_t)tok0 * 512 + h * 128, 512, tid);
            load_tile128(TC, B.CS + (size_t)unit * 16384, 128, tid);
#pragma unroll
            for (int i = 0; i < 4; ++i) { const int ch = tid + 512 * i, row = ch >> 4, c = ch & 15; const u32x4 k = *(const u32x4*)(B.K + (size_t)(tok0 + row) * 512 + h * 128 + c * 8); const float ksc = 0.08838834764831845f;
                u32x4 ok; ok.x = pk2(bf_lo(k.x) * ksc, bf_hi(k.x) * ksc); ok.y = pk2(bf_lo(k.y) * ksc, bf_hi(k.y) * ksc); ok.z = pk2(bf_lo(k.z) * ksc, bf_hi(k.z) * ksc); ok.w = pk2(bf_lo(k.w) * ksc, bf_hi(k.w) * ksc);
                *(LAS u32x4*)(TK + row * TS + c * 16) = ok; }
            const float mprev = B.SC[2048 + unit];
            if (wave == 0) {
                const float* gt = B.GT + (size_t)unit * 256;
                const float a0 = gt[2 * lane] - gt[128 + 2 * lane], a1 = gt[2 * lane + 1] - gt[128 + 2 * lane + 1];
                float run = fmaxf(a0, a1);
#pragma unroll
                for (int o = 1; o < 64; o <<= 1) { const float v = shup(run, o, lane); if (lane >= o) run = fmaxf(run, v); }
                const float prev = shup(run, 1, lane); const float p0 = fmaxf(lane > 0 ? fmaxf(prev, a0) : a0, mprev), p1 = fmaxf(run, mprev);
                AS[2 * lane] = a0; AS[2 * lane + 1] = a1; PM[2 * lane] = p0; PM[2 * lane + 1] = p1;
            }
            if (wave == 1) { NP[lane] = B.NS[(size_t)unit * 128 + lane]; NP[64 + lane] = B.NS[(size_t)unit * 128 + 64 + lane]; }
            __syncthreads();
            const int tb = wave & 3, vh = wave >> 2, t = 32 * tb + r32;
            const float pm = PM[t], bt = B.GT[(size_t)unit * 256 + 128 + t];
            f32x16 s[4];
#pragma unroll
            for (int st = 0; st < 4; ++st)
#pragma unroll
                for (int r = 0; r < 16; ++r) s[st][r] = 0.f;
            {   int lv = lane; asm volatile("" : "+v"(lv));
                const LAS unsigned char* qp = TQ + (32 * tb + (lv & 31)) * TS + (lv >> 5) * 16; const LAS unsigned char* kp = TK + (lv & 31) * TS + (lv >> 5) * 16;
#pragma unroll 2
                for (int ks = 0; ks < 8; ++ks) { const bf16x8 bq = *(const LAS bf16x8*)(qp + ks * 32);
#pragma unroll
                    for (int st = 0; st < 4; ++st) if (st <= tb) { const bf16x8 a = *(const LAS bf16x8*)(kp + st * 32 * TS + ks * 32); s[st] = MFMA32(a, bq, s[st]); } } }
            float nq = 0.f; u32x4 pf[4][2];
#pragma unroll
            for (int st = 0; st < 4; ++st) {
#pragma unroll
                for (int r = 0; r < 16; ++r) { const int sidx = 32 * st + crow(r, hh); const float wv = (sidx <= t) ? __builtin_amdgcn_exp2f((AS[sidx] - pm) * LOG2E) : 0.f; const float pv = s[st][r] * wv; s[st][r] = pv; nq += pv; }
#pragma unroll
                for (int sx = 0; sx < 2; ++sx) pf[st][sx] = (u32x4){pk2(s[st][8 * sx], s[st][8 * sx + 1]), pk2(s[st][8 * sx + 2], s[st][8 * sx + 3]), pk2(s[st][8 * sx + 4], s[st][8 * sx + 5]), pk2(s[st][8 * sx + 6], s[st][8 * sx + 7])};
            }
            nq = xhalf_sum(nq);
            float nqi = 0.f;
#pragma unroll
            for (int i = 0; i < 8; ++i) { const u32x4 qv = *(const LAS u32x4*)(TQ + t * TS + (64 * hh + 8 * i) * 2); const LAS float* np = NP + 64 * hh + 8 * i;
                nqi += bf_lo(qv.x) * np[0] + bf_hi(qv.x) * np[1] + bf_lo(qv.y) * np[2] + bf_hi(qv.y) * np[3] + bf_lo(qv.z) * np[4] + bf_hi(qv.z) * np[5] + bf_lo(qv.w) * np[6] + bf_hi(qv.w) * np[7]; }
            nqi = xhalf_sum(nqi);
            const float wst = __builtin_amdgcn_exp2f((mprev - pm) * LOG2E);
            const float den = fmaxf(fabsf(nq + wst * nqi), __builtin_amdgcn_exp2f(-(bt + pm) * LOG2E)), rden = 1.f / den;
            f32x16 ni[2], nx[2];
#pragma unroll
            for (int vt = 0; vt < 2; ++vt)
#pragma unroll
                for (int r = 0; r < 16; ++r) { ni[vt][r] = 0.f; nx[vt][r] = 0.f; }
            {   int lv = lane; asm volatile("" : "+v"(lv));
#pragma unroll
                for (int st = 0; st < 4; ++st) {
                    if (st <= tb) {
#pragma unroll
                        for (int sx = 0; sx < 2; ++sx) { const bf16x8 pb = __builtin_bit_cast(bf16x8, pf[st][sx]);
#pragma unroll
                            for (int vt = 0; vt < 2; ++vt) { const bf16x8 a = tr_frag(TV, 32 * st + 16 * sx, 64 * vh + 32 * vt, lv, true); ni[vt] = MFMA32(a, pb, ni[vt]); } }
                    }
                } }
            {   int lv = lane; asm volatile("" : "+v"(lv));
                const LAS unsigned char* qp = TQ + (32 * tb + (lv & 31)) * TS + (lv >> 5) * 16; const LAS unsigned char* cp = TC + (64 * vh + (lv & 31)) * TS + (lv >> 5) * 16;
#pragma unroll 2
                for (int ks = 0; ks < 8; ++ks) { const bf16x8 bq = *(const LAS bf16x8*)(qp + ks * 32);
#pragma unroll
                    for (int vt = 0; vt < 2; ++vt) { const bf16x8 a = *(const LAS bf16x8*)(cp + vt * 32 * TS + ks * 32); nx[vt] = MFMA32(a, bq, nx[vt]); } } }
            const size_t tok = (size_t)tok0 + t;
            u32x2 xcv[2][4], zv[2][4];
#pragma unroll
            for (int vt = 0; vt < 2; ++vt)
#pragma unroll
                for (int gq = 0; gq < 4; ++gq) { const int chn = h * 128 + 64 * vh + 32 * vt + 8 * gq + 4 * hh; xcv[vt][gq] = *(const u32x2*)(B.XC + tok * 512 + chn); zv[vt][gq] = *(const u32x2*)(B.BZ + tok * 512 + chn); }
            float hs = 0.f, hq = 0.f;
#pragma unroll
            for (int vt = 0; vt < 2; ++vt)
#pragma unroll
                for (int r = 0; r < 16; ++r) { const float hv = (ni[vt][r] + wst * nx[vt][r]) * rden; ni[vt][r] = hv; hs += hv; hq += hv * hv; }
            hs = xhalf_sum(hs); hq = xhalf_sum(hq);
            if (hh == 0) { PS[vh * 128 + t] = hs; PQ[vh * 128 + t] = hq; }
            __syncthreads();
            const float mean = (PS[t] + PS[128 + t]) * (1.f / 128.f);
            const float rstd = rsqrtf(fmaxf((PQ[t] + PQ[128 + t]) * (1.f / 128.f) - mean * mean, 0.f) + LN_EPS);
#pragma unroll
            for (int vt = 0; vt < 2; ++vt)
#pragma unroll
                for (int gq = 0; gq < 4; ++gq) { const int cl = 64 * vh + 32 * vt + 8 * gq + 4 * hh, chn = h * 128 + cl;
                    const f32x4 nw = *(const LAS f32x4*)(NW + chn), sk = *(const LAS f32x4*)(NW + 512 + chn); const u32x2 xc = xcv[vt][gq], z = zv[vt][gq];
                    const float y0 = ((ni[vt][4 * gq] - mean) * rstd * nw[0] + sk[0] * bf_lo(xc.x)) * silu_f(bf_lo(z.x)), y1 = ((ni[vt][4 * gq + 1] - mean) * rstd * nw[1] + sk[1] * bf_hi(xc.x)) * silu_f(bf_hi(z.x));
                    const float y2 = ((ni[vt][4 * gq + 2] - mean) * rstd * nw[2] + sk[2] * bf_lo(xc.y)) * silu_f(bf_lo(z.y)), y3 = ((ni[vt][4 * gq + 3] - mean) * rstd * nw[3] + sk[3] * bf_hi(xc.y)) * silu_f(bf_hi(z.y));
                    u32x2 w; w.x = pk2(y0, y1); w.y = pk2(y2, y3); *(u32x2*)(B.YM + tok * 1024 + 512 + chn) = w; }
        }
    }
}
constexpr size_t MB = 1048576ull;
constexpr size_t P_WIN_T = 0, P_WOUT_T = P_WIN_T + 4 * MB, P_WQKV_T = P_WOUT_T + 2 * MB, P_WO_T = P_WQKV_T + 3 * MB, P_XWQ_T = P_WO_T + 2 * MB, P_XWKV_T = P_XWQ_T + 4 * MB, P_XWO_T = P_XWKV_T + 8 * MB,
                 P_MLW_T = P_XWO_T + 4 * MB, P_WIFT = P_MLW_T + MB / 2, P_WRT = P_WIFT + MB / 8, P_ROT = P_WRT + MB / 2, P_BQK = P_ROT + MB, P_MEMB = P_BQK + MB / 8, P_KC = P_MEMB + 4 * MB, P_VT = P_KC + 8 * MB,
                 P_W13T = P_VT + 8 * MB, P_W2T = P_W13T + 64 * MB, P_XBF = P_W2T + 32 * MB, P_RT = P_XBF + 64 * MB, P_TMP = P_RT + 2 * MB;
constexpr size_t RT_SRC = 1638400;
constexpr size_t RT_E = 0, RT_W = 262144, RT_RANK = 2 * 262144, RT_DEST = 3 * 262144, RT_HIST = 4 * 262144, RT_TSTART = RT_HIST + 32768;
constexpr size_t T_QX = 0, T_OB = 64 * MB, T_YB = 128 * MB;
constexpr size_t T_K1 = 192 * MB, T_VT1 = 208 * MB;
constexpr size_t T_AU = 0, T_AV = 32 * MB, T_BX = 64 * MB, T_BZ = 96 * MB, T_V = 128 * MB, T_XC = 160 * MB, T_YM = 192 * MB, T_U = 256 * MB, T_CS = 320 * MB,
                 T_GT = 352 * MB, T_UN = 353 * MB, T_NS = 353 * MB + MB / 2, T_SC = 354 * MB, T_YB0 = 0;
constexpr size_t T_XG = 0, T_HM = 152 * MB, T_YG = 0;
constexpr size_t T_SLOT = 356 * MB;
constexpr size_t FAST_END = P_TMP + 360 * MB;
constexpr int LDS_BYTES = 147456;

struct FP {
    const float* in[33]; float* X;
    unsigned char* ws;
};
typedef const float* const __attribute__((address_space(4)))* InTab;
struct PV { InTab in; float* X; unsigned char* ws; };
__device__ __forceinline__ PV make_pv(const FP& p0) {
    PV p; InTab kp = (InTab)__builtin_amdgcn_kernarg_segment_ptr(); asm volatile("" : "+s"(kp)); p.in = kp;
    p.X = p0.X; p.ws = p0.ws; asm volatile("" : "+s"(p.ws)); return p;
}
#define WSP(T, off) ((T*)(p.ws + (off)))

__device__ __forceinline__ RouteBufs route_bufs(const PV& p) {
    RouteBufs r; r.e = WSP(int, P_RT + RT_E); r.w = WSP(float, P_RT + RT_W); r.rank = WSP(int, P_RT + RT_RANK); r.dest = WSP(int, P_RT + RT_DEST); r.hist = WSP(int, P_RT + RT_HIST); r.tstart = WSP(int, P_RT + RT_TSTART); r.src = WSP(int, P_RT + RT_SRC); return r;
}
#define PH_ARGS const PV& p, LAS unsigned char* lds, int blk, int G
#define PH_IDS int tid_ = threadIdx.x; asm volatile("" : "+v"(tid_)); const int tid = tid_, lane = tid & 63, wave = __builtin_amdgcn_readfirstlane(tid >> 6); (void)lane; (void)wave;

__device__ __forceinline__ void ph_conv_xattn(PH_ARGS, int l) {
    PH_IDS; LAS float* scr = (LAS float*)(lds + wave * 8448); const int gw = blk * NWAVE + wave, ngw = G * NWAVE;
    convert_mats(p.in[23] + (size_t)l * 1024 * 1024, 1024, 1024, 1, 0, WSP(bf16_t, P_XWQ_T) + (size_t)l * 1024 * 1024, 0, RM_IDENT, 0.0625f, 1024, scr, gw, ngw, lane);
    convert_mats(p.in[24] + (size_t)l * 1024 * 2048, 1024, 2048, 1, 0, WSP(bf16_t, P_XWKV_T) + (size_t)l * 2048 * 1024, 0, RM_IDENT, 1.f, 0, scr, gw, ngw, lane);
    convert_mats(p.in[25] + (size_t)l * 1024 * 1024, 1024, 1024, 1, 0, WSP(bf16_t, P_XWO_T) + (size_t)l * 1024 * 1024, 0, RM_IDENT, 1.f, 0, scr, gw, ngw, lane);
    convert_rows(p.in[1], WSP(bf16_t, P_MEMB), (size_t)2048 * 1024, blk * NTHR + tid, G * NTHR);
}
__device__ __forceinline__ void conv_moe_waves(const PV& p, int l, LAS float* scr, int gw, int ngw, int gt, int ngt, int lane) {
    const size_t wl = (size_t)l * 32 * 1024 * 512;
    convert_mats(p.in[30] + wl, 1024, 512, 32, (size_t)1024 * 512, WSP(bf16_t, P_W13T), (size_t)1024 * 1024, RM_PAIR0, 1.f, 0, scr, gw, ngw, lane);
    convert_mats(p.in[31] + wl, 1024, 512, 32, (size_t)1024 * 512, WSP(bf16_t, P_W13T), (size_t)1024 * 1024, RM_PAIR1, 1.f, 0, scr, gw, ngw, lane);
    convert_mats(p.in[32] + wl, 512, 1024, 32, (size_t)512 * 1024, WSP(bf16_t, P_W2T), (size_t)1024 * 512, RM_IDENT, 1.f, 0, scr, gw, ngw, lane);
    bf16_t* wrt = WSP(bf16_t, P_WRT) + (size_t)l * 2 * 64 * 1024; const float* wre = p.in[28] + (size_t)l * 1024 * 32; const float* wrg = p.in[26] + (size_t)l * 1024 * 4;
    for (int i = gt; i < 64 * 1024; i += ngt) { const int r = i >> 10, k = i & 1023;
        const float v = r < 32 ? wre[k * 32 + r] : (r < 36 ? wrg[k * 4 + (r - 32)] : 0.f);
        const bf16_t h = f2bf(v); wrt[i] = h; wrt[64 * 1024 + i] = f2bf(v - bf2f(h)); }
}
__device__ __forceinline__ void ph_conv_moe(PH_ARGS, int l) {
    PH_IDS; conv_moe_waves(p, l, (LAS float*)(lds + wave * 8448), blk * NWAVE + wave, G * NWAVE, blk * NTHR + tid, G * NTHR, lane);
}
__device__ __forceinline__ void ph_x_to_bf(PH_ARGS) { PH_IDS; convert_rows(p.X, WSP(bf16_t, P_XBF), (size_t)NT * 1024, blk * NTHR + tid, G * NTHR); }

__device__ __forceinline__ void set_job(LAS pg8::JobDesc* jt, int j, const void* A, const void* B, int nM, int nN, void* out, int ldc, int mode, const void* bias = nullptr, const void* rot = nullptr, void* out2 = nullptr) {
    unsigned long long a = (unsigned long long)A, b = (unsigned long long)B, o = (unsigned long long)out, bi = (unsigned long long)bias, ro = (unsigned long long)rot, o2 = (unsigned long long)out2;
    asm volatile("" : "+s"(a), "+s"(b), "+s"(o), "+s"(bi), "+s"(ro), "+s"(o2), "+s"(nM), "+s"(nN), "+s"(ldc), "+s"(mode));
    LAS pg8::JobDesc* d = jt + j; d->A = a; d->B = b; d->out = o; d->bias = bi; d->rot = ro; d->out2 = o2;
    d->nM = nM; d->nN = nN; d->ldc = ldc; d->mode = mode;
}
#define JT_PTR ((LAS pg8::JobDesc*)(lds + pg8::JT_OFF))
__device__ __forceinline__ void run_jobs(LAS unsigned char* lds, int K, int n0, int n1, int n2, int blk, int G) {
    __syncthreads();
    pg8::Jobs3 S; S.jt = JT_PTR; S.n0 = n0; S.n1 = n1; S.n2 = n2; S.K = K; S.G = G; S.c = blk;
    EpiMulti E; E.jt = JT_PTR;
    pg8::gemm_phase<EpiMulti, pg8::Jobs3, true, true>(lds, K, S, E);
}
__device__ __forceinline__ void ph_xattn_g1(PH_ARGS, int l) {
    const bf16_t* wkv = WSP(bf16_t, P_XWKV_T) + (size_t)l * 2048 * 1024;
    __syncthreads();
    if (threadIdx.x == 0) {
        set_job(JT_PTR, 0, WSP(bf16_t, P_MEMB), wkv, 8, 4, WSP(bf16_t, P_KC) + (size_t)l * 2048 * 1024, 1024, EM_PLAIN);
        set_job(JT_PTR, 1, wkv + (size_t)1024 * 1024, WSP(bf16_t, P_MEMB), 4, 8, WSP(bf16_t, P_VT) + (size_t)l * 1024 * 2048, 2048, EM_PLAIN);
        set_job(JT_PTR, 2, WSP(bf16_t, P_XBF), WSP(bf16_t, P_XWQ_T) + (size_t)l * 1024 * 1024, 128, 4, WSP(bf16_t, P_TMP + T_QX), 1024, EM_PLAIN);
    }
    run_jobs(lds, 1024, 32, 32, 512, blk, G);
}
__device__ __forceinline__ void ph_xattn_attn(PH_ARGS, int l) {
    xattn_phase(lds, WSP(bf16_t, P_TMP + T_QX), WSP(bf16_t, P_KC) + (size_t)l * 2048 * 1024, WSP(bf16_t, P_VT) + (size_t)l * 1024 * 2048, WSP(bf16_t, P_TMP + T_OB), blk, G);
}
__device__ __forceinline__ void ph_gemm_plain(PH_ARGS, const bf16_t* A, const bf16_t* Bt, bf16_t* out) {
    __syncthreads();
    if (threadIdx.x == 0) set_job(JT_PTR, 0, A, Bt, 128, 4, out, 1024, EM_PLAIN);
    run_jobs(lds, 1024, 512, 0, 0, blk, G);
}
template <bool XF32, bool OUTF32, bool MOE>
__device__ __forceinline__ void ph_ln(PH_ARGS, const bf16_t* y, int lnidx, bool dry = false) {
    PH_IDS; LnArgs a; a.xin32 = p.in[0]; a.xin = WSP(bf16_t, P_XBF); a.xout32 = dry ? WSP(float, P_TMP + 200 * MB) : p.X; a.xbf = dry ? WSP(bf16_t, P_TMP + 288 * MB) : WSP(bf16_t, P_XBF); a.y = y; a.g = p.in[2] + lnidx * 1024; a.b = p.in[3] + lnidx * 1024;
    a.dest = WSP(int, P_RT + RT_DEST); a.wts = WSP(float, P_RT + RT_W);
    ln_phase<XF32, OUTF32, MOE>(a, blk, G, wave, lane);
}
__device__ __forceinline__ void ph_moe_route(PH_ARGS, int l) {
    moe_router_phase(lds, WSP(bf16_t, P_XBF), WSP(bf16_t, P_WRT) + (size_t)l * 2 * 64 * 1024, p.in[27] + l * 4, p.in[29] + l * 32, route_bufs(p), blk);
}
__device__ __forceinline__ void ph_moe_scatter(PH_ARGS) { moe_scatter_phase(lds, route_bufs(p), blk, G); }
__device__ __forceinline__ void ph_moe_g1(PH_ARGS) {
    __syncthreads();
    if (threadIdx.x == 0) set_job(JT_PTR, 0, nullptr, nullptr, 0, 0, WSP(bf16_t, P_TMP + T_HM), 512, EM_SWIGLU);
    __syncthreads();
    MoeSched S; S.A = (const char*)WSP(bf16_t, P_TMP + T_XG); S.B = (const char*)WSP(bf16_t, P_W13T); S.tstart = WSP(int, P_RT + RT_TSTART); S.K = 1024; S.nN = 4; S.G = G; S.c = blk; S.bexp = (size_t)1024 * 1024 * 2;
    EpiMulti E; E.jt = JT_PTR;
    pg8::gemm_phase<EpiMulti, MoeSched, true, true>(lds, 1024, S, E);
}
__device__ __forceinline__ void ph_moe_g2(PH_ARGS) {
    __syncthreads();
    if (threadIdx.x == 0) set_job(JT_PTR, 0, nullptr, nullptr, 0, 0, WSP(bf16_t, P_TMP + T_YG), 1024, EM_PLAIN);
    __syncthreads();
    MoeSched S; S.A = (const char*)WSP(bf16_t, P_TMP + T_HM); S.B = (const char*)WSP(bf16_t, P_W2T); S.tstart = WSP(int, P_RT + RT_TSTART); S.K = 512; S.nN = 4; S.G = G; S.c = blk; S.bexp = (size_t)1024 * 512 * 2;
    EpiMulti E; E.jt = JT_PTR;
    pg8::gemm_phase<EpiMulti, MoeSched, true, true>(lds, 512, S, E);
}

__device__ __forceinline__ void ph_conv_l1(PH_ARGS) {
    PH_IDS; LAS float* scr = (LAS float*)(lds + wave * 8448); const int gw = blk * NWAVE + wave, ngw = G * NWAVE;
    convert_mats(p.in[19], 1024, 1536, 1, 0, WSP(bf16_t, P_WQKV_T), 0, RM_ROT, 0.125f, 1024, scr, gw, ngw, lane);
    convert_mats(p.in[22], 1024, 1024, 1, 0, WSP(bf16_t, P_WO_T), 0, RM_IDENT, 1.f, 0, scr, gw, ngw, lane);
    const int gt = blk * NTHR + tid, ngt = G * NTHR;
    float* bqk = WSP(float, P_BQK);
    for (int n = gt; n < 1280; n += ngt) bqk[rowmap(RM_ROT, n)] = p.in[20][n] * (n < 1024 ? 0.125f : 1.f);
    float* rot = WSP(float, P_ROT);
    for (int i = gt; i < 4096 * 32; i += ngt) { const int pos = i >> 5, k = i & 31; const float inv = powf(10000.f, -(float)(2 * k) / 64.f); const float ang = (float)pos * inv; rot[2 * i] = cosf(ang); rot[2 * i + 1] = sinf(ang); }
}
__device__ __forceinline__ void ph_l1_g1(PH_ARGS) {
    __syncthreads();
    if (threadIdx.x == 0) {
        set_job(JT_PTR, 0, WSP(bf16_t, P_XBF), WSP(bf16_t, P_WQKV_T), 128, 5, WSP(bf16_t, P_TMP + T_QX), 1024, EM_ROTARY, WSP(float, P_BQK), WSP(float, P_ROT), WSP(bf16_t, P_TMP + T_K1));
        set_job(JT_PTR, 1, WSP(bf16_t, P_WQKV_T) + (size_t)1280 * 1024, WSP(bf16_t, P_XBF), 1, 128, WSP(bf16_t, P_TMP + T_VT1), NT, EM_ROWBIAS, p.in[20] + 1280);
    }
    run_jobs(lds, 1024, 640, 128, 0, blk, G);
}
__device__ __forceinline__ void ph_l1_swa(PH_ARGS) {
    swa_phase(lds, WSP(bf16_t, P_TMP + T_QX), WSP(bf16_t, P_TMP + T_K1), WSP(bf16_t, P_TMP + T_VT1), p.in[21], WSP(bf16_t, P_TMP + T_OB), blk, G);
}

__device__ __forceinline__ L0Bufs l0_bufs(const PV& p) {
    L0Bufs B; B.AU = WSP(bf16_t, P_TMP + T_AU); B.AV = WSP(bf16_t, P_TMP + T_AV); B.BX = WSP(bf16_t, P_TMP + T_BX); B.BZ = WSP(bf16_t, P_TMP + T_BZ); B.V = WSP(bf16_t, P_TMP + T_V); B.XC = WSP(bf16_t, P_TMP + T_XC);
    B.YM = WSP(bf16_t, P_TMP + T_YM); B.CS = WSP(bf16_t, P_TMP + T_CS); B.U = WSP(bf16_t, P_TMP + T_U); B.GT = WSP(float, P_TMP + T_GT); B.UN = WSP(float, P_TMP + T_UN); B.NS = WSP(float, P_TMP + T_NS); B.SC = WSP(float, P_TMP + T_SC);
    B.Q = B.AU; B.K = B.AV;
    B.WQT = WSP(bf16_t, P_MLW_T); B.GMW = WSP(bf16_t, P_MLW_T) + 12 * 16384; B.MT = WSP(bf16_t, P_WIFT);
    B.gm_g = p.in[5]; B.gm_b = p.in[6]; B.gm_bs = p.in[8]; B.cw = p.in[9]; B.cb = p.in[10]; B.bif = p.in[15]; B.nw = p.in[16]; B.skip = p.in[17]; return B;
}
__device__ __forceinline__ void ph_scan_conv(PH_ARGS) {
    PH_IDS;
    if (wave < 4) l0_scan(l0_bufs(p), blk, tid);
}
__device__ __forceinline__ void ph_conv_l0(PH_ARGS) {
    PH_IDS; LAS float* scr = (LAS float*)(lds + wave * 8448); const int gw = blk * NWAVE + wave, ngw = G * NWAVE;
    convert_mats(p.in[4], 1024, 2048, 1, 0, WSP(bf16_t, P_WIN_T), 0, RM_IDENT, 1.f, 0, scr, gw, ngw, lane);
    convert_mats(p.in[18], 1024, 1024, 1, 0, WSP(bf16_t, P_WOUT_T), 0, RM_IDENT, 1.f, 0, scr, gw, ngw, lane);
    convert_mats(p.in[11], 128, 128, 4, 16384, WSP(bf16_t, P_MLW_T), 16384, RM_IDENT, 1.f, 0, scr, gw, ngw, lane);
    convert_mats(p.in[12], 128, 128, 4, 16384, WSP(bf16_t, P_MLW_T) + 4 * 16384, 16384, RM_IDENT, 1.f, 0, scr, gw, ngw, lane);
    convert_mats(p.in[13], 128, 128, 4, 16384, WSP(bf16_t, P_MLW_T) + 8 * 16384, 16384, RM_IDENT, 1.f, 0, scr, gw, ngw, lane);
    const int gt = blk * NTHR + tid, ngt = G * NTHR;
    bf16_t* gmw = WSP(bf16_t, P_MLW_T) + 12 * 16384;
    for (int i = gt; i < 4 * 16384; i += ngt) { const int t = (i >> 7) & 127, sidx = i & 127; gmw[i] = f2bf(sidx <= t ? p.in[7][i] : 0.f); }
    bf16_t* mt = WSP(bf16_t, P_WIFT);
    for (int i = gt; i < 4 * 8 * 256; i += ngt) { const int h = i >> 11, g = (i >> 8) & 7, j = i & 255, d = j & 127; float a = 0.f;
        if (j < 128) { for (int e = 0; e < 128; ++e) a += p.in[11][((size_t)h * 128 + d) * 128 + e] * p.in[14][(h * 128 + e) * 8 + g] + p.in[12][((size_t)h * 128 + d) * 128 + e] * p.in[14][(512 + h * 128 + e) * 8 + g]; }
        else { for (int e = 0; e < 128; ++e) a += p.in[13][((size_t)h * 128 + d) * 128 + e] * p.in[14][(1024 + h * 128 + e) * 8 + g]; }
        mt[i] = f2bf(a); }
}
__device__ __forceinline__ void ph_xin_to_bf(PH_ARGS) { PH_IDS; convert_rows(p.in[0], WSP(bf16_t, P_XBF), (size_t)NT * 1024, blk * NTHR + tid, G * NTHR); }
__device__ __forceinline__ void ph_l0_g1(PH_ARGS) {
    __syncthreads();
    if (threadIdx.x == 0) set_job(JT_PTR, 0, WSP(bf16_t, P_XBF), WSP(bf16_t, P_WIN_T), 128, 8, WSP(bf16_t, P_TMP + T_AU), 512, EM_GELU4);
    run_jobs(lds, 1024, 1024, 0, 0, blk, G);
}

enum { K_CONV_XATTN = 0, K_CONV_MOE, K_X2BF, K_XATTN_G1, K_XATTN_ATTN, K_XATTN_G2, K_LN_Y, K_MOE_ROUTE, K_MOE_SCATTER, K_MOE_G1, K_MOE_G2, K_LN_MOE, K_CONV_L1, K_L1_G1, K_L1_SWA, K_L1_G2, K_CONV_L0, K_XIN2BF, K_L0_G1, K_L0_MIXA, K_L0_SCAN, K_L0_MIXC, K_L0_G2, K_LN_Y0 };
template <int PH>
__global__ void __launch_bounds__(NTHR, 2) k_phase(FP p0, int l, int lnidx) {
    const PV p = make_pv(p0);
    extern __shared__ __attribute__((aligned(16))) unsigned char smem[];
    LAS unsigned char* lds = (LAS unsigned char*)smem;
    const int blk = blockIdx.x, G = gridDim.x;
    if constexpr (PH == K_CONV_XATTN) ph_conv_xattn(p, lds, blk, G, l);
    if constexpr (PH == K_CONV_MOE) ph_conv_moe(p, lds, blk, G, l);
    if constexpr (PH == K_X2BF) ph_x_to_bf(p, lds, blk, G);
    if constexpr (PH == K_XATTN_G1) ph_xattn_g1(p, lds, blk, G, l);
    if constexpr (PH == K_XATTN_ATTN) ph_xattn_attn(p, lds, blk, G, l);
    if constexpr (PH == K_XATTN_G2) ph_gemm_plain(p, lds, blk, G, WSP(bf16_t, P_TMP + T_OB), WSP(bf16_t, P_XWO_T) + (size_t)l * 1024 * 1024, WSP(bf16_t, P_TMP + T_YB));
    if constexpr (PH == K_LN_Y) ph_ln<false, false, false>(p, lds, blk, G, WSP(bf16_t, P_TMP + T_YB), lnidx);
    if constexpr (PH == K_MOE_ROUTE) ph_moe_route(p, lds, blk, G, l);
    if constexpr (PH == K_MOE_SCATTER) ph_moe_scatter(p, lds, blk, G);
    if constexpr (PH == K_MOE_G1) ph_moe_g1(p, lds, blk, G);
    if constexpr (PH == K_MOE_G2) ph_moe_g2(p, lds, blk, G);
    if constexpr (PH == K_LN_MOE) ph_ln<false, false, true>(p, lds, blk, G, WSP(bf16_t, P_TMP + T_YG), lnidx);
    if constexpr (PH == K_CONV_L0) ph_conv_l0(p, lds, blk, G);
    if constexpr (PH == K_XIN2BF) ph_xin_to_bf(p, lds, blk, G);
    if constexpr (PH == K_L0_G1) ph_l0_g1(p, lds, blk, G);
    if constexpr (PH == K_L0_MIXA) l0_mixA(lds, l0_bufs(p), blk, G);
    if constexpr (PH == K_L0_SCAN) ph_scan_conv(p, lds, blk, G);
    if constexpr (PH == K_L0_MIXC) l0_mixC(lds, l0_bufs(p), blk, G);
    if constexpr (PH == K_L0_G2) ph_gemm_plain(p, lds, blk, G, WSP(bf16_t, P_TMP + T_YM), WSP(bf16_t, P_WOUT_T), WSP(bf16_t, P_TMP + T_YB0));
    if constexpr (PH == K_LN_Y0) ph_ln<true, false, false>(p, lds, blk, G, WSP(bf16_t, P_TMP + T_YB0), 0);
    if constexpr (PH == K_CONV_L1) ph_conv_l1(p, lds, blk, G);
    if constexpr (PH == K_L1_G1) ph_l1_g1(p, lds, blk, G);
    if constexpr (PH == K_L1_SWA) ph_l1_swa(p, lds, blk, G);
    if constexpr (PH == K_L1_G2) ph_gemm_plain(p, lds, blk, G, WSP(bf16_t, P_TMP + T_OB), WSP(bf16_t, P_WO_T), WSP(bf16_t, P_TMP + T_YB));
}

#define XB_TMO      128
#define XB_XCNT(j)  (256  + 64 * (j))
#define XB_XSUB(j)  (1280 + 64 * (j))
#define XB_XGEN(j)  (2304 + 64 * (j))
#define XB_TOP      3328
#define XB_TOPGEN   3392
#define XCD_BAR_WORDS 3456
#define XB_SPIN_CAP (1u << 22)
__device__ __forceinline__ unsigned xb_ld(unsigned* p)              { return __hip_atomic_load(p, __ATOMIC_RELAXED, __HIP_MEMORY_SCOPE_AGENT); }
__device__ __forceinline__ unsigned xb_add(unsigned* p, unsigned v) { return __hip_atomic_fetch_add(p, v, __ATOMIC_RELAXED, __HIP_MEMORY_SCOPE_AGENT); }
__device__ __forceinline__ unsigned xb_xcc_id() { return (unsigned)__builtin_amdgcn_s_getreg((3 << 11) | 20) & 0xFu; }
#define XB_SPIN(cond, bar) do { unsigned _sp = 0; while (cond) { __builtin_amdgcn_s_sleep(1); \
    if ((++_sp & 255u) == 0u) { if (xb_ld(&(bar)[XB_TMO])) break; if (_sp > XB_SPIN_CAP) { atomicAdd(&(bar)[XB_TMO], 1u); break; } } } } while (0)
struct XcdBarrier { unsigned* bar; unsigned x; volatile LAS unsigned* st; };
__device__ __forceinline__ XcdBarrier xcd_barrier_post(unsigned* bar, volatile LAS unsigned* st) {
    XcdBarrier b; b.bar = bar; b.x = xb_xcc_id(); b.st = st;
    if (threadIdx.x == 0) (void)xb_add(&bar[XB_XCNT(b.x)], 1u);
    return b;
}
__device__ __forceinline__ void xcd_barrier_complete(unsigned* bar, unsigned x, unsigned& nloc, unsigned& nx) {
    const unsigned G = gridDim.x * gridDim.y * gridDim.z;
    unsigned sum, cnt, mine, sp = 0u;
    for (;;) {
        sum = 0u; cnt = 0u; mine = 0u;
#pragma unroll
        for (unsigned j = 0; j < 16; ++j) { const unsigned c = xb_ld(&bar[XB_XCNT(j)]); sum += c; cnt += (c > 0u) ? 1u : 0u; mine = (j == x) ? c : mine; }
        if (sum == G) break;
        __builtin_amdgcn_s_sleep(1);
        if ((++sp & 255u) == 0u) { if (xb_ld(&bar[XB_TMO])) break; if (sp > XB_SPIN_CAP) { atomicAdd(&bar[XB_TMO], 1u); break; } }
    }
    nloc = mine > 0u ? mine : 1u; nx = cnt > 0u ? cnt : 1u;
}
__device__ __forceinline__ void xcd_barrier(const XcdBarrier& b) {
    asm volatile("s_waitcnt vmcnt(0)" ::: "memory");
    __syncthreads();
    if (threadIdx.x == 0) {
        unsigned* bar = b.bar; asm volatile("" : "+s"(bar));
        __builtin_amdgcn_s_waitcnt(0);
        unsigned nloc = b.st[0], nx = b.st[1];
        if (nloc == 0u) { xcd_barrier_complete(bar, b.x, nloc, nx); b.st[0] = nloc; b.st[1] = nx; }
        const unsigned old = xb_add(&bar[XB_XSUB(b.x)], 1u);
        const unsigned gen = old / nloc;
        if (old + 1u == (gen + 1u) * nloc) {
            __builtin_amdgcn_fence(__ATOMIC_RELEASE, "agent");
            asm volatile("s_waitcnt vmcnt(0)" ::: "memory");
            const unsigned og = xb_add(&bar[XB_TOP], 1u);
            const unsigned tg = og / nx;
            if (og + 1u == (tg + 1u) * nx) xb_add(&bar[XB_TOPGEN], 1u);
            else XB_SPIN(xb_ld(&bar[XB_TOPGEN]) == tg, bar);
            __builtin_amdgcn_fence(__ATOMIC_ACQUIRE, "agent");
            xb_add(&bar[XB_XGEN(b.x)], 1u);
            asm volatile("s_waitcnt vmcnt(0)" ::: "memory");
        } else {
            XB_SPIN(xb_ld(&bar[XB_XGEN(b.x)]) == gen, bar);
            __builtin_amdgcn_fence(__ATOMIC_ACQUIRE, "agent");
            asm volatile("s_waitcnt vmcnt(0)" ::: "memory");
        }
    }
    __syncthreads();
}
constexpr size_t P_BAR = P_RT + 1572864;
constexpr int LDS_BARW = LDS_BYTES - 16;

struct SchedAll {
    const LAS pg8::JobDesc* jt; int n0, n1, n2, n3, n4; int K, G, c; int moe; const char* A; const char* B; const int* tstart; const int* src; int nN; size_t bexp;
    __device__ __forceinline__ pg8::Unit get(int i, bool& ok) const {
        const char* ua = nullptr; const char* ub = nullptr; const int* us = nullptr; int upm = 0, upn = 0, ujob = 0; bool good = false;
        if (moe) {
            const int vc = (c & 7) * (G >> 3) + (c >> 3);
            const long L = (long)i * G + vc; const int ntile = tstart[32];
            if (L < (long)ntile * nN) {
                const int mt = (int)(L / nN), nt = (int)(L % nN);
                int e = 0;
                for (int k = 1; k < 32; ++k) if (tstart[k] <= mt) e = k;
                ua = src ? A : A + (size_t)mt * 256 * K * 2; us = src ? src + mt * 256 : nullptr; ub = B + (size_t)e * bexp + (size_t)nt * 256 * K * 2; upm = mt; upn = nt; good = true;
            }
        } else {
            long L = (long)i * G + c;
            if (L < (long)n0 + n1 + n2 + n3 + n4) {
                int l = (int)L; int jb = 0;
                if (l >= n0) { l -= n0; jb = 1; if (l >= n1) { l -= n1; jb = 2; if (l >= n2) { l -= n2; jb = 3; if (l >= n3) { l -= n3; jb = 4; } } } }
                const int jM = __builtin_amdgcn_readfirstlane(jt[jb].nM), jN = __builtin_amdgcn_readfirstlane(jt[jb].nN);
                int pm, pn; pg8::tile_order(l, jM, jN, pm, pn);
                const size_t tstep = (size_t)pg8::BM * K * 2;
                ua = (const char*)pg8::rfl64(jt[jb].A) + (size_t)pm * tstep; ub = (const char*)pg8::rfl64(jt[jb].B) + (size_t)pn * tstep; upm = pm; upn = pn; ujob = jb; good = true;
            }
        }
        pg8::Unit u; u.A = ua; u.B = ub; u.src = us; u.pm = upm; u.pn = upn; u.job = ujob; ok = good; return u;
    }
};
enum { MP_CONV = 0, MP_L0_G1, MP_L0_MIXA, MP_L0_SCAN, MP_L0_MIXC, MP_L0_G2, MP_XA_G1, MP_XA_ATTN, MP_XA_G2, MP_ROUTE, MP_SCATTER, MP_MOE_G1, MP_MOE_G2, MP_LN_MOE, MP_L1_G1, MP_L1_SWA, MP_L1_G2 };
struct SchedLN {
    const char* A; const char* B; int G, c;
    __device__ __forceinline__ pg8::Unit get(int i, bool& ok) const {
        const int L = i * G + c; const bool good = L < 512; int pm = 0, pn = 0; if (good) pg8::tile_order(L, 128, 4, pm, pn);
        const size_t tstep = (size_t)pg8::BM * 1024 * 2;
        pg8::Unit u; u.A = A + (size_t)pm * tstep; u.B = B + (size_t)pn * tstep; u.src = nullptr; u.pm = pm; u.pn = pn; u.job = 0; ok = good; return u;
    }
};
__device__ __forceinline__ int prog_kind(int i) {
    switch (i) { case 0: return MP_CONV; case 1: return MP_L0_G1; case 2: return MP_L0_MIXA; case 3: return MP_L0_SCAN; case 4: return MP_L0_MIXC; case 5: return MP_L0_G2;
        case 6: case 17: return MP_XA_G1; case 7: case 18: return MP_XA_ATTN; case 8: case 19: return MP_XA_G2; case 9: case 20: return MP_ROUTE; case 10: case 21: return MP_SCATTER;
        case 11: case 22: return MP_MOE_G1; case 12: case 23: return MP_MOE_G2; case 13: case 24: return MP_LN_MOE; case 14: return MP_L1_G1; case 15: return MP_L1_SWA; default: return MP_L1_G2; }
}
constexpr int N_PROG = 25;
__global__ void __launch_bounds__(NTHR, 2) mega(FP p0) {
    extern __shared__ __attribute__((aligned(16))) unsigned char smem[];
    LAS unsigned char* lds = (LAS unsigned char*)smem;
    cooperative_groups::grid_group grid = cooperative_groups::this_grid();
    const int blk0 = blockIdx.x, G0 = gridDim.x;
    volatile LAS unsigned* bst = (volatile LAS unsigned*)(lds + LDS_BARW);
    if (threadIdx.x == 0) { bst[0] = 0u; bst[1] = 0u; }
    __syncthreads();
    const XcdBarrier xbar = xcd_barrier_post((unsigned*)(p0.ws + P_BAR), bst);
    int dup = 0; (void)dup;
#pragma unroll 1
    for (int pi = 0; pi < N_PROG; ++pi) {
        int blk = blk0, G = G0; asm volatile("" : "+s"(blk), "+s"(G));
        const PV p = make_pv(p0);
        const int kind = prog_kind(pi), l = pi >= 14 ? 1 : 0;
        const bool is_gemm = kind == MP_L0_G1 || kind == MP_XA_G1 || kind == MP_MOE_G1 || kind == MP_MOE_G2 || kind == MP_L1_G1;
        const bool is_lnf = kind == MP_L0_G2 || kind == MP_XA_G2 || kind == MP_L1_G2;
        if (is_lnf) {
            const int site = kind == MP_L0_G2 ? 0 : (kind == MP_L1_G2 ? 2 : 1 + 2 * l), lnidx = kind == MP_L0_G2 ? 0 : (kind == MP_L1_G2 ? 3 : 1 + 3 * l);
            SchedLN S; S.G = G; S.c = blk;
            S.A = (const char*)(kind == MP_L0_G2 ? WSP(bf16_t, P_TMP + T_YM) : WSP(bf16_t, P_TMP + T_OB));
            S.B = (const char*)(kind == MP_L0_G2 ? WSP(bf16_t, P_WOUT_T) : (kind == MP_L1_G2 ? WSP(bf16_t, P_WO_T) : WSP(bf16_t, P_XWO_T) + (size_t)l * 1024 * 1024));
            EpiLN E; E.xio = WSP(bf16_t, P_XBF); E.g = p.in[2] + lnidx * 1024; E.b = p.in[3] + lnidx * 1024; E.slots = WSP(unsigned long long, P_TMP + T_SLOT) + (size_t)site * 131072; E.lds = lds;
            __syncthreads();
            pg8::gemm_phase<EpiLN, SchedLN, true, true>(lds, 1024, S, E);
        } else if (is_gemm) {
            SchedAll S; S.jt = JT_PTR; S.n0 = S.n1 = S.n2 = S.n3 = S.n4 = 0; S.K = 1024; S.G = G; S.c = blk; S.moe = 0; S.A = S.B = nullptr; S.tstart = WSP(int, P_RT + RT_TSTART); S.src = nullptr; S.nN = 4; S.bexp = 0;
            __syncthreads();
            if (threadIdx.x == 0) {
                if (kind == MP_L0_G1) set_job(JT_PTR, 0, WSP(bf16_t, P_XBF), WSP(bf16_t, P_WIN_T), 128, 8, WSP(bf16_t, P_TMP + T_AU), 512, EM_GELU4);
                if (kind == MP_XA_G1) {
                    set_job(JT_PTR, 0, WSP(bf16_t, P_XBF), WSP(bf16_t, P_XWQ_T) + (size_t)l * 1024 * 1024, 128, 4, WSP(bf16_t, P_TMP + T_QX), 1024, EM_PLAIN);
                    if (l == 0) { for (int ll = 0; ll < 2; ++ll) { const bf16_t* wkv = WSP(bf16_t, P_XWKV_T) + (size_t)ll * 2048 * 1024;
                        set_job(JT_PTR, 1 + 2 * ll, WSP(bf16_t, P_MEMB), wkv, 8, 4, WSP(bf16_t, P_KC) + (size_t)ll * 2048 * 1024, 1024, EM_PLAIN);
                        set_job(JT_PTR, 2 + 2 * ll, wkv + (size_t)1024 * 1024, WSP(bf16_t, P_MEMB), 4, 8, WSP(bf16_t, P_VT) + (size_t)ll * 1024 * 2048, 2048, EM_PLAIN); } } }
                if (kind == MP_MOE_G1) set_job(JT_PTR, 0, nullptr, nullptr, 0, 0, WSP(bf16_t, P_TMP + T_HM), 512, EM_SWIGLU);
                if (kind == MP_MOE_G2) set_job(JT_PTR, 0, nullptr, nullptr, 0, 0, WSP(bf16_t, P_TMP + T_YG), 1024, EM_PLAIN);
                if (kind == MP_L1_G1) { set_job(JT_PTR, 0, WSP(bf16_t, P_XBF), WSP(bf16_t, P_WQKV_T), 128, 5, WSP(bf16_t, P_TMP + T_QX), 1024, EM_ROTARY, WSP(float, P_BQK), WSP(float, P_ROT), WSP(bf16_t, P_TMP + T_K1));
                    set_job(JT_PTR, 1, WSP(bf16_t, P_WQKV_T) + (size_t)1280 * 1024, WSP(bf16_t, P_XBF), 1, 128, WSP(bf16_t, P_TMP + T_VT1), NT, EM_ROWBIAS, p.in[20] + 1280); }
            }
            if (kind == MP_L0_G1) S.n0 = 1024;
            if (kind == MP_XA_G1) { S.n0 = 512; if (l == 0) { S.n1 = 32; S.n2 = 32; S.n3 = 32; S.n4 = 32; } }
            if (kind == MP_L1_G1) { S.n0 = 640; S.n1 = 128; }
            if (kind == MP_MOE_G1) { S.moe = 1; S.A = (const char*)WSP(bf16_t, P_XBF); S.src = WSP(int, P_RT + RT_SRC); S.B = (const char*)WSP(bf16_t, P_W13T); S.bexp = (size_t)1024 * 1024 * 2; }
            if (kind == MP_MOE_G2) { S.moe = 1; S.K = 512; S.A = (const char*)WSP(bf16_t, P_TMP + T_HM); S.B = (const char*)WSP(bf16_t, P_W2T); S.bexp = (size_t)1024 * 512 * 2; }
            __syncthreads();
            EpiMulti E; E.jt = JT_PTR;
#ifdef PROBE_GEMM2
#pragma unroll 1
            for (int rep = 0; rep < 2; ++rep)
#endif
            pg8::gemm_phase<EpiMulti, SchedAll, true, true>(lds, S.K, S, E);
        } else {
#ifdef PROBE_MASK
#define DRY (dup == 0 && (((PROBE_MASK) >> kind) & 1))
#else
#define DRY false
#endif
            switch (kind) {
                case MP_CONV: ph_conv_l0(p, lds, blk, G); ph_conv_l1(p, lds, blk, G); ph_conv_xattn(p, lds, blk, G, 0); ph_conv_xattn(p, lds, blk, G, 1); ph_conv_moe(p, lds, blk, G, 0); ph_xin_to_bf(p, lds, blk, G); break;
                case MP_L0_MIXA: l0_mixA(lds, l0_bufs(p), blk, G); break;
                case MP_L0_SCAN: ph_scan_conv(p, lds, blk, G); break;
                case MP_L0_MIXC: l0_mixC(lds, l0_bufs(p), blk, G); break;
                case MP_XA_ATTN: ph_xattn_attn(p, lds, blk, G, l); break;
                case MP_ROUTE: ph_moe_route(p, lds, blk, G, l); break;
                case MP_SCATTER: ph_moe_scatter(p, lds, blk, G); break;
                case MP_LN_MOE: if (l == 0) { ph_ln<false, false, true>(p, lds, blk, G, WSP(bf16_t, P_TMP + T_YG), 2, DRY); if (!(DRY)) ph_conv_moe(p, lds, blk, G, 1); } else ph_ln<false, true, true>(p, lds, blk, G, WSP(bf16_t, P_TMP + T_YG), 5, DRY); break;
                default: ph_l1_swa(p, lds, blk, G); break;
            }
        }
#ifdef PROBE_MASK
        if (((PROBE_MASK) >> kind) & 1) { if (dup == 0) { dup = 1; xcd_barrier(xbar); --pi; continue; } dup = 0; }
#endif
        if (pi + 1 < N_PROG) { if (p0.ws == nullptr) grid.sync(); else { xcd_barrier(xbar);
#ifdef PROBE_BAR2
            xcd_barrier(xbar);
#endif
        } }
    }
}
}
extern "C" void kernel_launch(void* const* d_in, const int* in_sizes, int n_in, void* d_out, int out_size, void* d_ws, size_t ws_size, hipStream_t stream) {
    static int ok = 0;
    if (ok == 0) {
        ok = -1;
        if (n_in != 33 || out_size != 32768 * 1024 || ws_size < fk::FAST_END) { fprintf(stderr, "kernel_launch: unexpected shapes/ws (%d, %d, %zu)\n", n_in, out_size, ws_size); return; }
        int dev = 0, cus = 0, per_cu = 0;
        if (hipGetDevice(&dev) != hipSuccess || hipDeviceGetAttribute(&cus, hipDeviceAttributeMultiprocessorCount, dev) != hipSuccess) return;
        if (hipFuncSetAttribute((const void*)fk::mega, hipFuncAttributeMaxDynamicSharedMemorySize, fk::LDS_BYTES) != hipSuccess) return;
        if (hipOccupancyMaxActiveBlocksPerMultiprocessor(&per_cu, (const void*)fk::mega, fk::NTHR, fk::LDS_BYTES) != hipSuccess || per_cu < 1 || cus * per_cu < 256) { fprintf(stderr, "kernel_launch: cannot co-reside 256 workgroups (%d CUs x %d)\n", cus, per_cu); return; }
        ok = 1;
    }
    if (ok < 0) return;
    fk::FP p{}; for (int i = 0; i < 33; ++i) p.in[i] = (const float*)d_in[i]; p.X = (float*)d_out; p.ws = (unsigned char*)d_ws;
    if (hipMemsetAsync((char*)d_ws + fk::P_BAR, 0, 16384, stream) != hipSuccess) return;
    if (hipMemsetAsync((char*)d_ws + fk::P_TMP + fk::T_SLOT, 0xFF, 4 * fk::MB, stream) != hipSuccess) return;
    void* args[] = {&p};
    hipError_t e = hipLaunchCooperativeKernel((const void*)fk::mega, dim3(256), dim3(fk::NTHR), args, fk::LDS_BYTES, stream);
    if (e != hipSuccess) fprintf(stderr, "cooperative launch failed: %s\n", hipGetErrorString(e));
}
```

```cpp
#include <hip/hip_runtime.h>
#include <hip/hip_cooperative_groups.h>
#include <cstdio>
#include <cstdint>
#include <cmath>
namespace fk {
#define LAS __attribute__((address_space(3)))
typedef unsigned short bf16_t;
typedef short bf16x8 __attribute__((ext_vector_type(8)));
typedef short s16x4 __attribute__((ext_vector_type(4)));
typedef float f32x4 __attribute__((ext_vector_type(4)));
typedef float f32x16 __attribute__((ext_vector_type(16)));
typedef float f32x2 __attribute__((ext_vector_type(2)));
typedef unsigned u32x4 __attribute__((ext_vector_type(4)));
typedef unsigned u32x2 __attribute__((ext_vector_type(2)));
typedef __bf16 bf16x2_t __attribute__((ext_vector_type(2)));

constexpr int NT = 32768, DM = 1024, SEQ = 4096;
constexpr int NTHR = 512, NWAVE = 8;
constexpr float ALPHA = 1.4142135623730951f, LN_EPS = 1e-5f, LOG2E = 1.4426950408889634f;

__device__ __forceinline__ unsigned pk2(float lo, float hi) { f32x2 v = {lo, hi}; bf16x2_t b = __builtin_convertvector(v, bf16x2_t); return __builtin_bit_cast(unsigned, b); }
__device__ __forceinline__ float bf_lo(unsigned w) { return __uint_as_float(w << 16); }
__device__ __forceinline__ float bf_hi(unsigned w) { return __uint_as_float(w & 0xffff0000u); }
__device__ __forceinline__ float bf2f(bf16_t b) { return __uint_as_float(((unsigned)b) << 16); }
__device__ __forceinline__ bf16_t f2bf(float f) { return (bf16_t)(pk2(f, 0.f) & 0xffffu); }
__device__ __forceinline__ float fast_exp(float x) { return __builtin_amdgcn_exp2f(x * LOG2E); }
__device__ __forceinline__ float sigmoid_f(float x) { return __builtin_amdgcn_rcpf(1.f + fast_exp(-x)); }
__device__ __forceinline__ float silu_f(float x) { return x * sigmoid_f(x); }
__device__ __forceinline__ float gelu_tanh_f(float x) { const float u = 1.5957691216057308f * (x + 0.044715f * x * x * x); return x * sigmoid_f(u); }
__device__ __forceinline__ int crow(int r, int hi) { return (r & 3) + 8 * (r >> 2) + 4 * hi; }
__device__ __forceinline__ float xhalf_sum(float v) { auto rr = __builtin_amdgcn_permlane32_swap(__float_as_uint(v), __float_as_uint(v), false, false); return __uint_as_float(rr[0]) + __uint_as_float(rr[1]); }
__device__ __forceinline__ float xhalf_max(float v) { auto rr = __builtin_amdgcn_permlane32_swap(__float_as_uint(v), __float_as_uint(v), false, false); return fmaxf(__uint_as_float(rr[0]), __uint_as_float(rr[1])); }
__device__ __forceinline__ float shx(float v, int o, int lane) { return __int_as_float(__builtin_amdgcn_ds_bpermute((lane ^ o) << 2, __float_as_int(v))); }
__device__ __forceinline__ float shup(float v, int o, int lane) { return __int_as_float(__builtin_amdgcn_ds_bpermute(((lane - o) & 63) << 2, __float_as_int(v))); }
__device__ __forceinline__ float shidx(float v, int idx) { return __int_as_float(__builtin_amdgcn_ds_bpermute(idx << 2, __float_as_int(v))); }
__device__ __forceinline__ s16x4 lds_tr(const LAS void* p) { return __builtin_bit_cast(s16x4, __builtin_amdgcn_ds_read_tr16_b64_v4i16((LAS s16x4*)p)); }
#define MFMA32(a, b, c) __builtin_amdgcn_mfma_f32_32x32x16_bf16((a), (b), (c), 0, 0, 0)

namespace pg8 {
constexpr int BM = 256, BK = 64, HALF = 128, HTB = HALF * BK * 2, STAGE_BYTES = 8 * HTB, NXCD = 8, WGM = 8;
__host__ __device__ __forceinline__ int lds_byte(int r, int c) { const int st = (r >> 4) * 2 + (c >> 5), rr = r & 15, cc = c & 31, ob = rr * 64 + cc * 2; return st * 1024 + (ob ^ (((ob >> 9) & 1) << 5)); }
__host__ __device__ __forceinline__ void stage_rc(int b, int& R, int& C) { const int st = b / 1024, sb = b % 1024, swz = sb ^ (((sb >> 9) & 1) << 5); R = (st >> 1) * 16 + swz / 64; C = (st & 1) * 32 + (swz % 64) / 2; }
__host__ __device__ __forceinline__ int perm32(int rho) { const int n = rho >> 4, i = rho & 15; return 8 * (i >> 2) + 4 * n + (i & 3); }

struct Unit { const char* A; const char* B; const int* src; int pm, pn, job; };

__device__ __forceinline__ void tile_order(int l, int nM, int nN, int& pm, int& pn) {
    const int nwg = nM * nN; int wgid = l;
    { const int q = nwg / NXCD, r = nwg % NXCD, xcd = wgid % NXCD, off = wgid / NXCD; wgid = (xcd < r ? xcd * (q + 1) : r * (q + 1) + (xcd - r) * q) + off; }
    const int nig = WGM * nN, gid = wgid / nig, fm = gid * WGM, gsz = (nM - fm) < WGM ? (nM - fm) : WGM;
    pm = fm + ((wgid % nig) % gsz); pn = (wgid % nig) / gsz;
}
struct JobDesc { unsigned long long A, B, out, bias, rot, out2; int nM, nN, ldc, mode; };
__device__ __forceinline__ unsigned long long rfl64(unsigned long long v) { const unsigned lo = __builtin_amdgcn_readfirstlane((unsigned)v), hi = __builtin_amdgcn_readfirstlane((unsigned)(v >> 32)); return ((unsigned long long)hi << 32) | lo; }
constexpr int JT_OFF = STAGE_BYTES;
struct Jobs3 {
    const LAS JobDesc* jt; int n0, n1, n2; int K, G, c;
    __device__ __forceinline__ Unit get(int i, bool& ok) const { Unit u; u.A = nullptr; u.B = nullptr; u.src = nullptr; u.pm = 0; u.pn = 0; u.job = 0; ok = next(i, u); return u; }
    __device__ __forceinline__ bool next(int i, Unit& u) const {
        long L = (long)i * G + c;
        if (L >= (long)n0 + n1 + n2) return false;
        int l = (int)L; int jb = 0;
        if (l >= n0) { l -= n0; jb = 1; if (l >= n1) { l -= n1; jb = 2; } }
        const int jM = __builtin_amdgcn_readfirstlane(jt[jb].nM), jN = __builtin_amdgcn_readfirstlane(jt[jb].nN);
        int pm, pn; tile_order(l, jM, jN, pm, pn);
        const size_t tstep = (size_t)BM * K * 2;
        u.A = (const char*)rfl64(jt[jb].A) + (size_t)pm * tstep; u.B = (const char*)rfl64(jt[jb].B) + (size_t)pn * tstep; u.src = nullptr; u.pm = pm; u.pn = pn; u.job = jb; return true;
    }
};

template <class Epi, class Sched, bool ALIGN_EPI, bool SP2>
__device__ __forceinline__ void gemm_phase(LAS unsigned char* lds, const int K, const Sched& S, const Epi& E) {
    int tid_ = threadIdx.x; asm volatile("" : "+v"(tid_)); const int tid = tid_, wid = __builtin_amdgcn_readfirstlane(tid >> 6), lane = tid & 63, wr = wid >> 2, wc = wid & 3, fr = lane & 15, fq = lane >> 4;
    const int nt = K / BK;
    static_assert(SP2, "only the two-super-phase form is kept");
    unsigned vA0[2], vA1[2], vB0[2];
#pragma unroll
    for (int i = 0; i < 2; ++i) { int R, C; stage_rc(tid * 16 + i * 8192, R, C); const int Rb = 64 * (R >> 5) + perm32(R & 31); vB0[i] = (unsigned)(Rb * K + C) * 2u; }
    const size_t bhalf = (size_t)32 * K * 2;
    auto a_rows = [&](const int* src, unsigned (&o0)[2], unsigned (&o1)[2]) {
        int tq = threadIdx.x; asm volatile("" : "+v"(tq));
#pragma unroll
        for (int i = 0; i < 2; ++i) { int R, C; stage_rc(tq * 16 + i * 8192, R, C); int r0 = R, r1 = R + HALF; if (src) { r0 = src[R]; r1 = src[R + HALF]; }
            o0[i] = (unsigned)(r0 * K + C) * 2u; o1[i] = (unsigned)(r1 * K + C) * 2u; }
    };
    const size_t kstep = (size_t)(BK * 2);
    const size_t hstep = (size_t)HALF * K * 2;
    const unsigned ldsw = (unsigned)wid * 1024u;
    const int aoff = lds_byte(wr * 64 + fr, fq * 8), boff = lds_byte(wc * 32 + fr, fq * 8);
#define PG8_SA(b, h) (((b) * 2 + (h)) * HTB)
#define PG8_SB(b, h) ((4 + (b) * 2 + (h)) * HTB)
#define PG8_STAGE(bufoff, gbase, voff) do { _Pragma("unroll") for (int _i = 0; _i < 2; ++_i) \
        __builtin_amdgcn_global_load_lds((const unsigned*)((const char*)(gbase) + (voff)[_i]), (LAS unsigned*)(lds + (bufoff) + ldsw + _i * 8192), 16, 0, 0); } while (0)
#define PG8_LDA(dst, b, h) do { _Pragma("unroll") for (int m = 0; m < 4; ++m) _Pragma("unroll") for (int k = 0; k < 2; ++k) dst[m][k] = *(const LAS bf16x8*)(lds + PG8_SA(b, h) + aoff + m * 2048 + k * 1024); } while (0)
#define PG8_LDB(dst, b, h) do { _Pragma("unroll") for (int n = 0; n < 2; ++n) _Pragma("unroll") for (int k = 0; k < 2; ++k) dst[n][k] = *(const LAS bf16x8*)(lds + PG8_SB(b, h) + boff + n * 2048 + k * 1024); } while (0)
#define PG8_MMA(ai, bj, At, Bt) do { __builtin_amdgcn_s_setprio(1); _Pragma("unroll") for (int m = 0; m < 4; ++m) _Pragma("unroll") for (int n = 0; n < 2; ++n) _Pragma("unroll") for (int k = 0; k < 2; ++k) \
        acc[ai][bj][m][n] = __builtin_amdgcn_mfma_f32_16x16x32_bf16(Bt[n][k], At[m][k], acc[ai][bj][m][n], 0, 0, 0); __builtin_amdgcn_s_setprio(0); } while (0)
#define PG8_WAIT_V(n) asm volatile("s_waitcnt vmcnt(" #n ")" ::: "memory")
#define PG8_WAIT_L(n) asm volatile("s_waitcnt lgkmcnt(" #n ")" ::: "memory")
#define PG8_BAR __builtin_amdgcn_s_barrier()
#define PG8_SCHED __builtin_amdgcn_sched_barrier(0)
    auto unif = [](Unit u) { Unit r; r.A = (const char*)rfl64((unsigned long long)u.A); r.B = (const char*)rfl64((unsigned long long)u.B); r.src = (const int*)rfl64((unsigned long long)u.src);
        r.pm = __builtin_amdgcn_readfirstlane(u.pm); r.pn = __builtin_amdgcn_readfirstlane(u.pn); r.job = __builtin_amdgcn_readfirstlane(u.job); return r; };
    int ui = 0; bool ok0; Unit cur = unif(S.get(0, ok0));
    if (!ok0) return;
    f32x4 acc[2][2][4][2];
    E.prefetch(cur, wr, wc, fr, fq);
    bf16x8 At[4][2], B0[2][2], B1[2][2];
    const char* cA = cur.A; const char* cB = cur.B;
    a_rows(cur.src, vA0, vA1);
    {
        PG8_STAGE(PG8_SB(0, 0), cB, vB0); PG8_STAGE(PG8_SB(0, 1), cB + bhalf, vB0); PG8_STAGE(PG8_SA(0, 0), cA, vA0); PG8_STAGE(PG8_SA(0, 1), cA, vA1);
        if (wr == 1) PG8_BAR;
        PG8_WAIT_V(2); PG8_BAR;
        PG8_STAGE(PG8_SB(1, 0), cB + kstep, vB0); PG8_STAGE(PG8_SA(1, 0), cA + kstep, vA0); PG8_STAGE(PG8_SB(1, 1), cB + kstep + bhalf, vB0);
        PG8_WAIT_V(6); PG8_BAR;
    }
    for (;;) {
        E.init(acc);
        bool has_next; const Unit nxt = unif(S.get(ui + 1, has_next)); bool early_done = false;
        const char* nA = has_next ? nxt.A : cA; const char* nB = has_next ? nxt.B : cB;
        for (int t = 0; t < nt; t += 2) {
            const bool last = (t == nt - 2);
            const char* a1 = cA + (size_t)(t + 1) * kstep;
            const char* a2 = last ? nA : cA + (size_t)(t + 2) * kstep; const char* b2 = last ? nB : cB + (size_t)(t + 2) * kstep;
            const char* a3 = a2 + kstep; const char* b3 = b2 + kstep;
            PG8_LDB(B0, 0, 0); PG8_LDB(B1, 0, 1); PG8_SCHED; PG8_LDA(At, 0, 0); PG8_STAGE(PG8_SA(1, 1), a1, vA1);
            if (last && has_next) a_rows(nxt.src, vA0, vA1);
            PG8_WAIT_V(8); PG8_WAIT_L(0); PG8_BAR; PG8_MMA(0, 0, At, B0); PG8_MMA(0, 1, At, B1); PG8_BAR; PG8_SCHED;
            PG8_LDA(At, 0, 1); PG8_STAGE(PG8_SB(0, 0), b2, vB0); PG8_STAGE(PG8_SB(0, 1), b2 + bhalf, vB0); PG8_STAGE(PG8_SA(0, 0), a2, vA0);
            PG8_WAIT_V(8); PG8_WAIT_L(0); PG8_BAR; PG8_MMA(1, 0, At, B0); PG8_MMA(1, 1, At, B1); PG8_BAR; PG8_SCHED;
            PG8_LDB(B0, 1, 0); PG8_LDB(B1, 1, 1); PG8_SCHED; PG8_LDA(At, 1, 0); PG8_STAGE(PG8_SA(0, 1), a2, vA1);
            PG8_WAIT_V(8); PG8_WAIT_L(0); PG8_BAR; PG8_MMA(0, 0, At, B0); PG8_MMA(0, 1, At, B1); PG8_BAR; PG8_SCHED;
            if (last) { early_done = E.early(acc, cur, wr, wc, fr, fq); PG8_SCHED; }
            PG8_LDA(At, 1, 1); PG8_STAGE(PG8_SB(1, 0), b3, vB0); PG8_STAGE(PG8_SB(1, 1), b3 + bhalf, vB0); PG8_STAGE(PG8_SA(1, 0), a3, vA0);
            PG8_WAIT_V(8); PG8_WAIT_L(0); PG8_BAR; PG8_MMA(1, 0, At, B0); PG8_MMA(1, 1, At, B1); PG8_BAR; PG8_SCHED;
        }
        if constexpr (ALIGN_EPI) { if (wr == 0) PG8_BAR; }
        E.prefetch(nxt, wr, wc, fr, fq);
        if (!early_done) E.template half<0>(acc, cur, wr, wc, fr, fq);
        E.template half<1>(acc, cur, wr, wc, fr, fq);
        if (!has_next) break;
        cur = nxt; cA = nA; cB = nB; ++ui;
        if constexpr (ALIGN_EPI) { if (wr == 1) PG8_BAR; }
    }
    PG8_WAIT_V(0);
    if constexpr (!ALIGN_EPI) { if (wr == 0) PG8_BAR; }
    PG8_BAR;
#undef PG8_SA
#undef PG8_SB
#undef PG8_STAGE
#undef PG8_LDA
#undef PG8_LDB
#undef PG8_MMA
#undef PG8_WAIT_V
#undef PG8_WAIT_L
#undef PG8_BAR
#undef PG8_SCHED
}
}
enum { EM_PLAIN = 0, EM_GELU4 = 1, EM_SWIGLU = 2, EM_ROTARY = 3, EM_ROWBIAS = 4 };
struct EpiMulti {
    static constexpr bool PERM = true;
    const LAS pg8::JobDesc* jt;
    __device__ __forceinline__ void prefetch(const pg8::Unit&, int, int, int, int) const {}
    __device__ __forceinline__ void init(f32x4 (&acc)[2][2][4][2]) const {
#pragma unroll
        for (int a = 0; a < 2; ++a)
#pragma unroll
            for (int b = 0; b < 2; ++b)
#pragma unroll
                for (int m = 0; m < 4; ++m)
#pragma unroll
                    for (int n = 0; n < 2; ++n) acc[a][b][m][n] = (f32x4){0.f, 0.f, 0.f, 0.f};
    }
    __device__ __forceinline__ bool early(const f32x4 (&acc)[2][2][4][2], const pg8::Unit& u, int wr, int wc, int fr, int fq) const {
        const LAS pg8::JobDesc* jd = jt + u.job;
        if (__builtin_amdgcn_readfirstlane(jd->mode) != EM_PLAIN) return false;
        bf16_t* out = (bf16_t*)pg8::rfl64(jd->out); const int ldc = __builtin_amdgcn_readfirstlane(jd->ldc);
        bf16_t* rowp = out + (size_t)(u.pm * 256 + wr * 64 + fr) * ldc + u.pn * 256 + wc * 64 + 8 * fq;
#pragma unroll
        for (int m = 0; m < 4; ++m)
#pragma unroll
            for (int bj = 0; bj < 2; ++bj) { const f32x4 v0 = acc[0][bj][m][0], v1 = acc[0][bj][m][1];
                u32x4 w; w.x = pk2(v0[0], v0[1]); w.y = pk2(v0[2], v0[3]); w.z = pk2(v1[0], v1[1]); w.w = pk2(v1[2], v1[3]);
                *(u32x4*)(rowp + (size_t)m * 16 * ldc + bj * 32) = w; }
        return true;
    }
    template <int AI>
    __device__ __forceinline__ void half(const f32x4 (&acc)[2][2][4][2], const pg8::Unit& u, int wr, int wc, int fr, int fq) const {
        const LAS pg8::JobDesc* jd = jt + u.job;
        bf16_t* out = (bf16_t*)pg8::rfl64(jd->out);
        const int ldc = __builtin_amdgcn_readfirstlane(jd->ldc);
        const int mode = __builtin_amdgcn_readfirstlane(jd->mode);
        const float* bias = (const float*)pg8::rfl64(jd->bias);
        const int row0 = u.pm * 256 + wr * 64 + fr;
        const int colt = u.pn * 256 + wc * 64 + 8 * fq;
        if (mode == EM_PLAIN || mode == EM_ROWBIAS) {
#pragma unroll
            for (int ai = AI; ai < AI + 1; ++ai)
#pragma unroll
                for (int m = 0; m < 4; ++m) { const int row = row0 + ai * 128 + m * 16; const float rb = (mode == EM_ROWBIAS && bias) ? bias[row] : 0.f;
                    bf16_t* rowp = out + (size_t)row * ldc + colt;
#pragma unroll
                    for (int bj = 0; bj < 2; ++bj) { const f32x4 v0 = acc[ai][bj][m][0] + rb, v1 = acc[ai][bj][m][1] + rb;
                        u32x4 w; w.x = pk2(v0[0], v0[1]); w.y = pk2(v0[2], v0[3]); w.z = pk2(v1[0], v1[1]); w.w = pk2(v1[2], v1[3]);
                        *(u32x4*)(rowp + bj * 32) = w; } }
        } else if (mode == EM_GELU4) {
            const int arr = u.pn >> 1; bf16_t* base = out + (size_t)arr * NT * 512; const int col = colt - arr * 512; const bool act = arr < 2;
#pragma unroll
            for (int ai = AI; ai < AI + 1; ++ai)
#pragma unroll
                for (int m = 0; m < 4; ++m) { bf16_t* rowp = base + (size_t)(row0 + ai * 128 + m * 16) * 512 + col;
#pragma unroll
                    for (int bj = 0; bj < 2; ++bj) { f32x4 v0 = acc[ai][bj][m][0], v1 = acc[ai][bj][m][1];
                        if (act) {
#pragma unroll
                            for (int e = 0; e < 4; ++e) { v0[e] = gelu_tanh_f(v0[e]); v1[e] = gelu_tanh_f(v1[e]); } }
                        u32x4 w; w.x = pk2(v0[0], v0[1]); w.y = pk2(v0[2], v0[3]); w.z = pk2(v1[0], v1[1]); w.w = pk2(v1[2], v1[3]);
                        *(u32x4*)(rowp + bj * 32) = w; } }
        } else if (mode == EM_SWIGLU) {
#pragma unroll
            for (int ai = AI; ai < AI + 1; ++ai)
#pragma unroll
                for (int m = 0; m < 4; ++m) { bf16_t* rowp = out + (size_t)(row0 + ai * 128 + m * 16) * ldc + (colt >> 1);
#pragma unroll
                    for (int bj = 0; bj < 2; ++bj) { const f32x4 v0 = acc[ai][bj][m][0], v1 = acc[ai][bj][m][1];
                        u32x2 w; w.x = pk2(silu_f(v0[0]) * v0[1], silu_f(v0[2]) * v0[3]); w.y = pk2(silu_f(v1[0]) * v1[1], silu_f(v1[2]) * v1[3]);
                        *(u32x2*)(rowp + bj * 16) = w; } }
        } else {
            const float* rot = (const float*)pg8::rfl64(jd->rot);
            bf16_t* out2 = (bf16_t*)pg8::rfl64(jd->out2);
            const bool isk = u.pn >= 4; bf16_t* base = isk ? out2 : out; const int ld = isk ? 256 : 1024; const int colo = isk ? colt - 1024 : colt;
            float bv[2][8];
#pragma unroll
            for (int bj = 0; bj < 2; ++bj)
#pragma unroll
                for (int e = 0; e < 8; ++e) bv[bj][e] = bias ? bias[colt + bj * 32 + e] : 0.f;
            const int i0 = (colt & 63) >> 1;
#pragma unroll
            for (int ai = AI; ai < AI + 1; ++ai)
#pragma unroll
                for (int m = 0; m < 4; ++m) { const int row = row0 + ai * 128 + m * 16; const int pos = row & (SEQ - 1);
                    bf16_t* rowp = base + (size_t)row * ld + colo;
#pragma unroll
                    for (int bj = 0; bj < 2; ++bj) { f32x4 v0 = acc[ai][bj][m][0], v1 = acc[ai][bj][m][1];
                        const f32x4 cs0 = *(const f32x4*)(rot + ((size_t)pos * 32 + i0 + 16 * bj) * 2), cs1 = *(const f32x4*)(rot + ((size_t)pos * 32 + i0 + 16 * bj + 2) * 2);
#pragma unroll
                        for (int e = 0; e < 4; ++e) { v0[e] += bv[bj][e]; v1[e] += bv[bj][4 + e]; }
                        const float a0 = v0[0] * cs0[0] - v0[1] * cs0[1], b0 = v0[1] * cs0[0] + v0[0] * cs0[1];
                        const float a1 = v0[2] * cs0[2] - v0[3] * cs0[3], b1 = v0[3] * cs0[2] + v0[2] * cs0[3];
                        const float a2 = v1[0] * cs1[0] - v1[1] * cs1[1], b2 = v1[1] * cs1[0] + v1[0] * cs1[1];
                        const float a3 = v1[2] * cs1[2] - v1[3] * cs1[3], b3 = v1[3] * cs1[2] + v1[2] * cs1[3];
                        u32x4 w; w.x = pk2(a0, b0); w.y = pk2(a1, b1); w.z = pk2(a2, b2); w.w = pk2(a3, b3);
                        *(u32x4*)(rowp + bj * 32) = w; } }
        }
    }
};

#define GAS __attribute__((address_space(1)))
#define P_TMP_PROBE (194ull * 1048576ull)
constexpr int LNF_PART = pg8::JT_OFF + 1024;
constexpr int LNF_STAT = LNF_PART + 8192;
struct EpiLN {
    static constexpr bool PERM = true;
    LAS unsigned char* lds;
    mutable u32x4 pre[2][4][2];
    __device__ __forceinline__ void prefetch(const pg8::Unit& u, int, int, int, int) const {
        int tq = threadIdx.x; asm volatile("" : "+v"(tq)); const int wq = __builtin_amdgcn_readfirstlane(tq >> 6), wr = wq >> 2, wc = wq & 3, fr = tq & 15, fq = (tq & 63) >> 4;
        const unsigned long long xio = pg8::rfl64(((const LAS pg8::JobDesc*)(lds + pg8::JT_OFF))->out);
        const GAS unsigned char* tb = (const GAS unsigned char*)(xio + ((size_t)u.pm * 256 * 1024 + u.pn * 256) * 2);
        const unsigned loff = (unsigned)((wr * 64 + fr) * 1024 + wc * 64 + 8 * fq) * 2u;
#pragma unroll
        for (int ai = 0; ai < 2; ++ai)
#pragma unroll
            for (int m = 0; m < 4; ++m)
#pragma unroll
                for (int bj = 0; bj < 2; ++bj) pre[ai][m][bj] = *(const GAS u32x4*)(tb + (ai * 128 + m * 16) * 2048 + bj * 64 + loff);
    }
    __device__ __forceinline__ void init(f32x4 (&acc)[2][2][4][2]) const {
#pragma unroll
        for (int ai = 0; ai < 2; ++ai)
#pragma unroll
            for (int m = 0; m < 4; ++m)
#pragma unroll
                for (int bj = 0; bj < 2; ++bj) { const u32x4 w = pre[ai][m][bj];
                    acc[ai][bj][m][0] = (f32x4){ALPHA * bf_lo(w.x), ALPHA * bf_hi(w.x), ALPHA * bf_lo(w.y), ALPHA * bf_hi(w.y)};
                    acc[ai][bj][m][1] = (f32x4){ALPHA * bf_lo(w.z), ALPHA * bf_hi(w.z), ALPHA * bf_lo(w.w), ALPHA * bf_hi(w.w)};
                    __builtin_amdgcn_sched_barrier(0); }
    }
    __device__ __forceinline__ bool early(const f32x4 (&)[2][2][4][2], const pg8::Unit&, int, int, int, int) const { return false; }
    template <int AI>
    __device__ __forceinline__ void half(f32x4 (&acc)[2][2][4][2], const pg8::Unit& u, int, int, int, int) const {
        int tid_ = threadIdx.x; asm volatile("" : "+v"(tid_)); const int tid = tid_, lane = tid & 63;
        const int wq = __builtin_amdgcn_readfirstlane(tid >> 6), wr = wq >> 2, wc = wq & 3, fr = lane & 15, fq = lane >> 4;
        const int colt = u.pn * 256 + wc * 64 + 8 * fq;
        LAS f32x2* part = (LAS f32x2*)(lds + LNF_PART);
        LAS f32x2* stat = (LAS f32x2*)(lds + LNF_STAT);
#pragma unroll
        for (int m = 0; m < 4; ++m) { const int rl = AI * 128 + wr * 64 + m * 16 + fr;
            float s1 = 0.f, s2 = 0.f;
#pragma unroll
            for (int bj = 0; bj < 2; ++bj) { const f32x4 v0 = acc[AI][bj][m][0], v1 = acc[AI][bj][m][1];
#pragma unroll
                for (int e = 0; e < 4; ++e) { s1 += v0[e] + v1[e]; s2 += v0[e] * v0[e] + v1[e] * v1[e]; } }
            s1 += shx(s1, 16, lane); s2 += shx(s2, 16, lane); s1 += shx(s1, 32, lane); s2 += shx(s2, 32, lane);
            if (fq == 0) part[rl * 4 + wc] = (f32x2){s1, s2}; }
        if constexpr (AI == 1) {
            __syncthreads();
            if (tid < 256) {
                const f32x2 p0 = part[tid * 4], p1 = part[tid * 4 + 1], p2 = part[tid * 4 + 2], p3 = part[tid * 4 + 3];
                const float t1 = (p0[0] + p1[0]) + (p2[0] + p3[0]), t2 = (p0[1] + p1[1]) + (p2[1] + p3[1]);
                unsigned long long* sl = (unsigned long long*)pg8::rfl64(((const LAS pg8::JobDesc*)(lds + pg8::JT_OFF))->out2) + (size_t)u.pm * 1024 + tid;
                __hip_atomic_store(sl + u.pn * 256, ((unsigned long long)__float_as_uint(t2) << 32) | __float_as_uint(t1), __ATOMIC_RELAXED, __HIP_MEMORY_SCOPE_AGENT);
                unsigned long long x0, x1, x2, x3; unsigned sp = 0;
                for (;;) {
                    x0 = __hip_atomic_load(sl, __ATOMIC_RELAXED, __HIP_MEMORY_SCOPE_AGENT); x1 = __hip_atomic_load(sl + 256, __ATOMIC_RELAXED, __HIP_MEMORY_SCOPE_AGENT);
                    x2 = __hip_atomic_load(sl + 512, __ATOMIC_RELAXED, __HIP_MEMORY_SCOPE_AGENT); x3 = __hip_atomic_load(sl + 768, __ATOMIC_RELAXED, __HIP_MEMORY_SCOPE_AGENT);
                    if ((x0 != ~0ull && x1 != ~0ull && x2 != ~0ull && x3 != ~0ull) || ++sp > (1u << 22)) break;
                    __builtin_amdgcn_s_sleep(1); }
#ifdef PROBE_LNX
                {   unsigned long long* sl2 = sl + 4 * 131072;
                    __hip_atomic_store(sl2 + u.pn * 256, ((unsigned long long)__float_as_uint(t2) << 32) | __float_as_uint(t1), __ATOMIC_RELAXED, __HIP_MEMORY_SCOPE_AGENT);
                    unsigned long long y0, y1, y2, y3; unsigned sq = 0;
                    for (;;) { y0 = __hip_atomic_load(sl2, __ATOMIC_RELAXED, __HIP_MEMORY_SCOPE_AGENT); y1 = __hip_atomic_load(sl2 + 256, __ATOMIC_RELAXED, __HIP_MEMORY_SCOPE_AGENT);
                        y2 = __hip_atomic_load(sl2 + 512, __ATOMIC_RELAXED, __HIP_MEMORY_SCOPE_AGENT); y3 = __hip_atomic_load(sl2 + 768, __ATOMIC_RELAXED, __HIP_MEMORY_SCOPE_AGENT);
                        if ((y0 != ~0ull && y1 != ~0ull && y2 != ~0ull && y3 != ~0ull) || ++sq > (1u << 22)) break;
                        __builtin_amdgcn_s_sleep(1); }
                    if (y0 == 0x123456789ull) x0 = y1; }
#endif
                const float S1 = (__uint_as_float((unsigned)x0) + __uint_as_float((unsigned)x1)) + (__uint_as_float((unsigned)x2) + __uint_as_float((unsigned)x3));
                const float S2 = (__uint_as_float((unsigned)(x0 >> 32)) + __uint_as_float((unsigned)(x1 >> 32))) + (__uint_as_float((unsigned)(x2 >> 32)) + __uint_as_float((unsigned)(x3 >> 32)));
                const float mean = S1 * (1.f / 1024.f); const float var = fmaxf(S2 * (1.f / 1024.f) - mean * mean, 0.f);
                stat[tid] = (f32x2){mean, __builtin_amdgcn_rsqf(var + LN_EPS)};
            }
            __syncthreads();
            const LAS pg8::JobDesc* jd = (const LAS pg8::JobDesc*)(lds + pg8::JT_OFF);
            const unsigned long long xio = pg8::rfl64(jd->out); const float* g = (const float*)pg8::rfl64(jd->bias); const float* b = (const float*)pg8::rfl64(jd->rot);
            GAS unsigned char* tb = (GAS unsigned char*)(xio + ((size_t)u.pm * 256 * 1024 + u.pn * 256) * 2); const unsigned loff = (unsigned)((wr * 64 + fr) * 1024 + wc * 64 + 8 * fq) * 2u;
#pragma unroll
            for (int bj = 0; bj < 2; ++bj) {
                __builtin_amdgcn_sched_barrier(0);
                const f32x4 g0 = *(const GAS f32x4*)((const GAS float*)g + colt + bj * 32), g1 = *(const GAS f32x4*)((const GAS float*)g + colt + bj * 32 + 4), b0 = *(const GAS f32x4*)((const GAS float*)b + colt + bj * 32), b1 = *(const GAS f32x4*)((const GAS float*)b + colt + bj * 32 + 4);
                f32x2 stn = stat[wr * 64 + fr];
#pragma unroll
                for (int am = 0; am < 8; ++am) { const int ai = am >> 2, m = am & 3; const int rl = ai * 128 + wr * 64 + m * 16 + fr; const f32x2 st = stn;
                    if (am < 7) stn = stat[((am + 1) >> 2) * 128 + wr * 64 + ((am + 1) & 3) * 16 + fr];
                    const float sc = st[1], sh = -st[0] * st[1];
                    const f32x4 v0 = (acc[ai][bj][m][0] * sc + sh) * g0 + b0, v1 = (acc[ai][bj][m][1] * sc + sh) * g1 + b1;
                    u32x4 w; w.x = pk2(v0[0], v0[1]); w.y = pk2(v0[2], v0[3]); w.z = pk2(v1[0], v1[1]); w.w = pk2(v1[2], v1[3]);
                    *(GAS u32x4*)(tb + (ai * 128 + m * 16) * 2048 + bj * 64 + loff) = w;
#ifdef PROBE_LNS
                    *(GAS u32x4*)(tb + ((size_t)P_TMP_PROBE) + (ai * 128 + m * 16) * 2048 + bj * 64 + loff) = w;
#endif
                    __builtin_amdgcn_sched_barrier(0); }
            }
        }
    }
};
enum { RM_IDENT = 0, RM_ROT = 1, RM_PAIR0 = 2, RM_PAIR1 = 3 };
__device__ __forceinline__ int rowmap(int kind, int n) {
    if (kind == RM_ROT) { if (n >= 1280) return n; const int d = n & 63; return (n & ~63) + 2 * (d & 31) + (d >> 5); }
    if (kind == RM_PAIR0) return 2 * n;
    if (kind == RM_PAIR1) return 2 * n + 1;
    return n;
}
__device__ __forceinline__ void ti_load(const float* __restrict__ W, int ldw, int kb, int nb, int lane, f32x4 (&tv)[8]) {
    const int k0 = 64 * kb, n0 = 32 * nb;
#pragma unroll
    for (int i = 0; i < 8; ++i) { const int kk = 8 * i + (lane >> 3); tv[i] = *(const f32x4*)(W + (size_t)(k0 + kk) * ldw + n0 + 4 * (lane & 7)); }
}
__device__ __forceinline__ void ti_store(const f32x4 (&tv)[8], int K, bf16_t* __restrict__ WT, LAS float* scr, int kb, int nb, int lane, int kind, float scale, int nscale) {
    const int k0 = 64 * kb, n0 = 32 * nb;
#pragma unroll
    for (int i = 0; i < 8; ++i) { const int kk = 8 * i + (lane >> 3); LAS float* d = scr + kk * 33 + 4 * (lane & 7); d[0] = tv[i][0]; d[1] = tv[i][1]; d[2] = tv[i][2]; d[3] = tv[i][3]; }
    __builtin_amdgcn_s_waitcnt(0xc07f); asm volatile("" ::: "memory");
    const int c = lane & 7;
#pragma unroll
    for (int j = 0; j < 4; ++j) { const int n = (lane >> 3) + 8 * j; const LAS float* s = scr + (8 * c) * 33 + n; const float sc = (n0 + n) < nscale ? scale : 1.f;
        u32x4 o; o.x = pk2(s[0 * 33] * sc, s[1 * 33] * sc); o.y = pk2(s[2 * 33] * sc, s[3 * 33] * sc); o.z = pk2(s[4 * 33] * sc, s[5 * 33] * sc); o.w = pk2(s[6 * 33] * sc, s[7 * 33] * sc);
        *(u32x4*)(WT + (size_t)rowmap(kind, n0 + n) * K + k0 + 8 * c) = o; }
    __builtin_amdgcn_s_waitcnt(0xc07f); asm volatile("" ::: "memory");
}
__device__ __forceinline__ void convert_mats(const float* W, int K, int N, int nbat, size_t sstr, bf16_t* WT, size_t dstr, int kind, float scale, int nscale, LAS float* scr, int gw, int ngw, int lane) {
    const int nblk = N / 32, per = (K / 64) * nblk, total = per * nbat;
    if (gw >= total) return;
    f32x4 cur[8], nxt[8];
    { const int bt = gw / per, r = gw - bt * per; ti_load(W + (size_t)bt * sstr, N, r / nblk, r % nblk, lane, cur); }
    for (int it = gw; it < total; it += ngw) {
        const int in = it + ngw; const bool more = in < total;
        if (more) { const int bt = in / per, r = in - bt * per; ti_load(W + (size_t)bt * sstr, N, r / nblk, r % nblk, lane, nxt); }
        { const int bt = it / per, r = it - bt * per; ti_store(cur, K, WT + (size_t)bt * dstr, scr, r / nblk, r % nblk, lane, kind, scale, nscale); }
#pragma unroll
        for (int i = 0; i < 8; ++i) cur[i] = nxt[i];
    }
}
__device__ __forceinline__ void convert_rows(const float* __restrict__ src, bf16_t* __restrict__ dst, size_t n, int gt, int ngt) {
    const size_t step = (size_t)ngt * 8; size_t i = (size_t)gt * 8;
    for (; i + 3 * step < n; i += 4 * step) { f32x4 a[4], b[4];
#pragma unroll
        for (int j = 0; j < 4; ++j) { a[j] = *(const f32x4*)(src + i + j * step); b[j] = *(const f32x4*)(src + i + j * step + 4); }
#pragma unroll
        for (int j = 0; j < 4; ++j) { u32x4 o; o.x = pk2(a[j][0], a[j][1]); o.y = pk2(a[j][2], a[j][3]); o.z = pk2(b[j][0], b[j][1]); o.w = pk2(b[j][2], b[j][3]); *(u32x4*)(dst + i + j * step) = o; } }
    for (; i < n; i += step) { const f32x4 a = *(const f32x4*)(src + i), b = *(const f32x4*)(src + i + 4);
        u32x4 o; o.x = pk2(a[0], a[1]); o.y = pk2(a[2], a[3]); o.z = pk2(b[0], b[1]); o.w = pk2(b[2], b[3]); *(u32x4*)(dst + i) = o; }
}

struct LnArgs { const float* xin32; const bf16_t* xin; float* xout32; bf16_t* xbf; const bf16_t* y; const float* g; const float* b; const int* dest; const float* wts; };
template <int NR, bool XF32, bool OUTF32, bool MOE>
__device__ __forceinline__ void ln_rows(const LnArgs& a, int row0, int lane) {
    float v[NR][2][8];
    {
        int d0[NR], d1[NR]; float w0[NR], w1[NR];
        if (MOE) {
#pragma unroll
            for (int i = 0; i < NR; ++i) { d0[i] = a.dest[(row0 + i) * 2]; d1[i] = a.dest[(row0 + i) * 2 + 1]; w0[i] = a.wts[(row0 + i) * 2]; w1[i] = a.wts[(row0 + i) * 2 + 1]; }
        }
        f32x4 xf[XF32 ? NR : 1][2][2]; u32x4 xb[XF32 ? 1 : NR][2]; u32x4 p[NR][2], q[MOE ? NR : 1][2];
#pragma unroll
        for (int i = 0; i < NR; ++i) {
            const u32x4* y0 = (const u32x4*)(a.y + (size_t)(MOE ? d0[i] : row0 + i) * DM) + lane; const u32x4* y1 = (const u32x4*)(a.y + (size_t)(MOE ? d1[i] : 0) * DM) + lane;
#pragma unroll
            for (int j = 0; j < 2; ++j) {
                if (XF32) { const f32x4* xr = (const f32x4*)(a.xin32 + (size_t)(row0 + i) * DM) + 2 * lane + 128 * j; xf[XF32 ? i : 0][j][0] = xr[0]; xf[XF32 ? i : 0][j][1] = xr[1]; }
                else xb[XF32 ? 0 : i][j] = ((const u32x4*)(a.xin + (size_t)(row0 + i) * DM) + lane)[64 * j];
                p[i][j] = y0[64 * j]; if (MOE) q[MOE ? i : 0][j] = y1[64 * j]; } }
#pragma unroll
        for (int i = 0; i < NR; ++i)
#pragma unroll
            for (int j = 0; j < 2; ++j) {
                float x[8];
                if (XF32) {
#pragma unroll
                    for (int e = 0; e < 4; ++e) { x[e] = xf[XF32 ? i : 0][j][0][e]; x[4 + e] = xf[XF32 ? i : 0][j][1][e]; } }
                else { const u32x4 w = xb[XF32 ? 0 : i][j]; x[0] = bf_lo(w.x); x[1] = bf_hi(w.x); x[2] = bf_lo(w.y); x[3] = bf_hi(w.y); x[4] = bf_lo(w.z); x[5] = bf_hi(w.z); x[6] = bf_lo(w.w); x[7] = bf_hi(w.w); }
                const u32x4 pw = p[i][j]; const float py[8] = {bf_lo(pw.x), bf_hi(pw.x), bf_lo(pw.y), bf_hi(pw.y), bf_lo(pw.z), bf_hi(pw.z), bf_lo(pw.w), bf_hi(pw.w)};
                if (MOE) { const u32x4 qw = q[MOE ? i : 0][j]; const float qy[8] = {bf_lo(qw.x), bf_hi(qw.x), bf_lo(qw.y), bf_hi(qw.y), bf_lo(qw.z), bf_hi(qw.z), bf_lo(qw.w), bf_hi(qw.w)};
#pragma unroll
                    for (int e = 0; e < 8; ++e) v[i][j][e] = ALPHA * x[e] + w0[i] * py[e] + w1[i] * qy[e]; }
                else {
#pragma unroll
                    for (int e = 0; e < 8; ++e) v[i][j][e] = ALPHA * x[e] + py[e]; }
            }
    }
    float s[NR];
#pragma unroll
    for (int i = 0; i < NR; ++i) { s[i] = 0.f;
#pragma unroll
        for (int j = 0; j < 2; ++j)
#pragma unroll
            for (int e = 0; e < 8; ++e) s[i] += v[i][j][e]; }
#pragma unroll
    for (int o = 1; o < 64; o <<= 1)
#pragma unroll
        for (int i = 0; i < NR; ++i) s[i] += shx(s[i], o, lane);
    float q2[NR];
#pragma unroll
    for (int i = 0; i < NR; ++i) { const float mean = s[i] * (1.f / DM); q2[i] = 0.f;
#pragma unroll
        for (int j = 0; j < 2; ++j)
#pragma unroll
            for (int e = 0; e < 8; ++e) { v[i][j][e] -= mean; q2[i] += v[i][j][e] * v[i][j][e]; } }
#pragma unroll
    for (int o = 1; o < 64; o <<= 1)
#pragma unroll
        for (int i = 0; i < NR; ++i) q2[i] += shx(q2[i], o, lane);
    f32x4 gv[2][2], bv[2][2];
#pragma unroll
    for (int j = 0; j < 2; ++j) { const f32x4* gp = (const f32x4*)a.g + 2 * lane + 128 * j; const f32x4* bp = (const f32x4*)a.b + 2 * lane + 128 * j; gv[j][0] = gp[0]; gv[j][1] = gp[1]; bv[j][0] = bp[0]; bv[j][1] = bp[1]; }
#pragma unroll
    for (int i = 0; i < NR; ++i) { const float rstd = rsqrtf(q2[i] * (1.f / DM) + LN_EPS);
#pragma unroll
        for (int j = 0; j < 2; ++j) { float o[8];
#pragma unroll
            for (int e = 0; e < 8; ++e) o[e] = v[i][j][e] * rstd * gv[j][e >> 2][e & 3] + bv[j][e >> 2][e & 3];
            if (OUTF32) { f32x4* xo = (f32x4*)(a.xout32 + (size_t)(row0 + i) * DM) + 2 * lane + 128 * j; xo[0] = (f32x4){o[0], o[1], o[2], o[3]}; xo[1] = (f32x4){o[4], o[5], o[6], o[7]}; }
            else { u32x4 w; w.x = pk2(o[0], o[1]); w.y = pk2(o[2], o[3]); w.z = pk2(o[4], o[5]); w.w = pk2(o[6], o[7]); ((u32x4*)(a.xbf + (size_t)(row0 + i) * DM) + lane)[64 * j] = w; } } }
}
template <bool XF32, bool OUTF32, bool MOE>
__device__ __forceinline__ void ln_phase(const LnArgs& a, int blk, int G, int wave, int lane) {
    const int per = NT / G, r0 = blk * per, pw = per / NWAVE;
    for (int r = 0; r < pw; r += 4) ln_rows<4, XF32, OUTF32, MOE>(a, r0 + wave * pw + r, lane);
}
__device__ __forceinline__ void xattn_phase(LAS unsigned char* lds, const bf16_t* __restrict__ Q, const bf16_t* __restrict__ KC, const bf16_t* __restrict__ VT, bf16_t* __restrict__ O, int blk, int G) {
    const int tid0 = threadIdx.x, wave = __builtin_amdgcn_readfirstlane(tid0 >> 6);
#define XA_IDS int tid = tid0; asm volatile("" : "+v"(tid)); const int lane = tid & 63, r32 = lane & 31, hh = lane >> 5; const size_t qrow = (size_t)b * SEQ + qb * 256 + wave * 32 + r32; (void)lane; (void)hh; (void)qrow;
    for (int u = blk; u < 512; u += G) {
        int qb = u & 15, h = (u >> 4) & 3, b = u >> 6;
        if (G == 256) { const int x = blk & 7, j = blk >> 3, grp = x * 4 + (u >> 8) * 2 + (j >> 4); qb = j & 15; h = grp & 3; b = grp >> 2; }
        XA_IDS;
        bf16x8 qf[16];
#pragma unroll
        for (int ks = 0; ks < 16; ++ks) qf[ks] = *(const bf16x8*)(Q + qrow * 1024 + h * 256 + ks * 16 + hh * 8);
        __syncthreads();
#pragma unroll
        for (int bt = 0; bt < 2; ++bt) {
            u32x4 t[8];
#pragma unroll
            for (int i = 0; i < 8; ++i) { const int ch = tid + 512 * (bt * 8 + i), row = ch >> 5, c = ch & 31; t[i] = *(const u32x4*)(KC + (size_t)(b * 256 + row) * 1024 + h * 256 + c * 8); }
#pragma unroll
            for (int i = 0; i < 8; ++i) { const int ch = tid + 512 * (bt * 8 + i), row = ch >> 5, c = ch & 31; *(LAS u32x4*)(lds + row * 528 + c * 16) = t[i]; }
        }
        __syncthreads();
        f32x16 s[8];
#pragma unroll
        for (int mt = 0; mt < 8; ++mt)
#pragma unroll
            for (int r = 0; r < 16; ++r) s[mt][r] = 0.f;
        {   const LAS unsigned char* kbp = lds + r32 * 528 + hh * 16;
#pragma unroll
            for (int ks = 0; ks < 16; ++ks)
#pragma unroll
                for (int mt = 0; mt < 8; ++mt) { const bf16x8 a = *(const LAS bf16x8*)(kbp + mt * 32 * 528 + ks * 32); s[mt] = MFMA32(a, qf[ks], s[mt]); }
        }
        float mx = -INFINITY;
#pragma unroll
        for (int mt = 0; mt < 8; ++mt)
#pragma unroll
            for (int r = 0; r < 16; ++r) mx = fmaxf(mx, s[mt][r]);
        mx = xhalf_max(mx);
        float sm = 0.f; const float mxl = mx * LOG2E;
        u32x4 pf[8][2];
#pragma unroll
        for (int mt = 0; mt < 8; ++mt) {
#pragma unroll
            for (int r = 0; r < 16; ++r) { const float p = __builtin_amdgcn_exp2f(s[mt][r] * LOG2E - mxl); s[mt][r] = p; sm += p; }
#pragma unroll
            for (int sx = 0; sx < 2; ++sx) pf[mt][sx] = (u32x4){pk2(s[mt][8 * sx], s[mt][8 * sx + 1]), pk2(s[mt][8 * sx + 2], s[mt][8 * sx + 3]), pk2(s[mt][8 * sx + 4], s[mt][8 * sx + 5]), pk2(s[mt][8 * sx + 6], s[mt][8 * sx + 7])};
        }
        sm = xhalf_sum(sm);
        __syncthreads();
        {   XA_IDS;
#pragma unroll
        for (int bt = 0; bt < 4; ++bt) {
            u32x4 t[4];
#pragma unroll
            for (int i = 0; i < 4; ++i) { const int ch = tid + 512 * (bt * 4 + i), row = ch >> 5, c = ch & 31; t[i] = *(const u32x4*)(VT + (size_t)(h * 256 + row) * 2048 + b * 256 + c * 8); }
#pragma unroll
            for (int i = 0; i < 4; ++i) { const int ch = tid + 512 * (bt * 4 + i), row = ch >> 5, c = ch & 31; LAS u32x2* d = (LAS u32x2*)(lds + row * 520 + c * 16); d[0] = (u32x2){t[i].x, t[i].y}; d[1] = (u32x2){t[i].z, t[i].w}; }
        }
        }
        __syncthreads();
        {   XA_IDS;
        const float inv = 1.f / sm;
        bf16_t* orow = O + qrow * 1024 + h * 256 + 4 * hh;
#pragma unroll 1
        for (int dh = 0; dh < 2; ++dh) {
            f32x16 o[4];
#pragma unroll
            for (int dt = 0; dt < 4; ++dt)
#pragma unroll
                for (int r = 0; r < 16; ++r) o[dt][r] = 0.f;
            const LAS unsigned char* vb = lds + (dh * 128 + r32) * 520 + 8 * hh;
#pragma unroll
            for (int mt = 0; mt < 8; ++mt)
#pragma unroll
                for (int sx = 0; sx < 2; ++sx) { const int kb = mt * 32 + 16 * sx; const bf16x8 pb = __builtin_bit_cast(bf16x8, pf[mt][sx]);
#pragma unroll
                    for (int dt = 0; dt < 4; ++dt) { const LAS unsigned char* q = vb + dt * 32 * 520 + kb * 2;
                        const s16x4 lo = *(const LAS s16x4*)q, hi = *(const LAS s16x4*)(q + 16);
                        const bf16x8 a = (bf16x8){lo[0], lo[1], lo[2], lo[3], hi[0], hi[1], hi[2], hi[3]}; o[dt] = MFMA32(a, pb, o[dt]); } }
#pragma unroll
            for (int dt = 0; dt < 4; ++dt)
#pragma unroll
                for (int g = 0; g < 4; ++g) { u32x2 w; w.x = pk2(o[dt][4 * g] * inv, o[dt][4 * g + 1] * inv); w.y = pk2(o[dt][4 * g + 2] * inv, o[dt][4 * g + 3] * inv); *(u32x2*)(orow + dh * 128 + dt * 32 + 8 * g) = w; }
        }
        }
    }
#undef XA_IDS
}

struct RouteBufs { int* e; float* w; int* rank; int* dest; int* hist; int* tstart; int* src; };
__device__ __forceinline__ void moe_router_phase(LAS unsigned char* lds, const bf16_t* __restrict__ XBF, const bf16_t* __restrict__ WRT, const float* __restrict__ brg, const float* __restrict__ bre, const RouteBufs rb, int blk) {
    int tid_ = threadIdx.x; asm volatile("" : "+v"(tid_)); const int tid = tid_, lane = tid & 63, wave = __builtin_amdgcn_readfirstlane(tid >> 6), r32 = lane & 31, hh = lane >> 5;
    LAS unsigned char* XT = lds; LAS unsigned char* WT = lds + 128 * 528;
    LAS float* LG = (LAS float*)lds;
    LAS int* hist = (LAS int*)(lds + 128 * 65 * 4);
    const int rbk = wave & 3, ct = wave >> 2;
    f32x16 acc;
#pragma unroll
    for (int r = 0; r < 16; ++r) acc[r] = 0.f;
#pragma unroll 1
    for (int kc = 0; kc < 4; ++kc) {
        __syncthreads();
        {   u32x4 tx[8], tw[8];
#pragma unroll
            for (int i = 0; i < 8; ++i) { const int ch = tid + 512 * i, row = ch >> 5, c = ch & 31; tx[i] = *(const u32x4*)(XBF + (size_t)(blk * 128 + row) * 1024 + kc * 256 + c * 8); tw[i] = *(const u32x4*)(WRT + (size_t)row * 1024 + kc * 256 + c * 8); }
#pragma unroll
            for (int i = 0; i < 8; ++i) { const int ch = tid + 512 * i, row = ch >> 5, c = ch & 31; *(LAS u32x4*)(XT + row * 528 + c * 16) = tx[i]; *(LAS u32x4*)(WT + row * 528 + c * 16) = tw[i]; } }
        __syncthreads();
        const LAS unsigned char* ap = XT + (rbk * 32 + r32) * 528 + hh * 16; const LAS unsigned char* bp = WT + (ct * 32 + r32) * 528 + hh * 16;
#pragma unroll
        for (int ks = 0; ks < 16; ++ks) { const bf16x8 a = *(const LAS bf16x8*)(ap + ks * 32), b0 = *(const LAS bf16x8*)(bp + ks * 32), b1 = *(const LAS bf16x8*)(bp + 64 * 528 + ks * 32);
            acc = MFMA32(a, b0, acc); acc = MFMA32(a, b1, acc); }
    }
    __syncthreads();
    if (tid < 32) hist[tid] = 0;
#pragma unroll
    for (int r = 0; r < 16; ++r) LG[(rbk * 32 + crow(r, hh)) * 65 + ct * 32 + r32] = acc[r];
    __syncthreads();
    if (tid < 128) {
        const LAS float* lg = LG + tid * 65; const int tok = blk * 128 + tid;
        float g4[4];
#pragma unroll
        for (int g = 0; g < 4; ++g) g4[g] = lg[32 + g] + brg[g];
        int gi = 0; float gm = g4[0];
#pragma unroll
        for (int g = 1; g < 4; ++g) if (g4[g] > gm) { gm = g4[g]; gi = g; }
        float gs = 0.f;
#pragma unroll
        for (int g = 0; g < 4; ++g) gs += fast_exp(g4[g] - gm);
        const float gate_g = 1.f / gs;
        float le[8];
#pragma unroll
        for (int e = 0; e < 8; ++e) le[e] = lg[gi * 8 + e] + bre[gi * 8 + e];
        int i0 = 0; float v0 = le[0];
#pragma unroll
        for (int e = 1; e < 8; ++e) if (le[e] > v0) { v0 = le[e]; i0 = e; }
        int i1 = 0; float v1 = -INFINITY;
#pragma unroll
        for (int e = 0; e < 8; ++e) if (e != i0 && le[e] > v1) { v1 = le[e]; i1 = e; }
        const float e1 = fast_exp(v1 - v0), p0 = 1.f / (1.f + e1), p1 = e1 * p0;
        const int ex0 = gi * 8 + i0, ex1 = gi * 8 + i1;
        rb.e[tok * 2] = ex0; rb.e[tok * 2 + 1] = ex1; rb.w[tok * 2] = gate_g * p0; rb.w[tok * 2 + 1] = gate_g * p1;
        rb.rank[tok * 2] = atomicAdd((int*)&hist[ex0], 1); rb.rank[tok * 2 + 1] = atomicAdd((int*)&hist[ex1], 1);
    }
    __syncthreads();
    if (tid < 32) rb.hist[blk * 32 + tid] = hist[tid];
}
__device__ __forceinline__ void moe_scatter_phase(LAS unsigned char* lds, const RouteBufs rb, int blk, int G) {
    int tid_ = threadIdx.x; asm volatile("" : "+v"(tid_)); const int tid = tid_, lane = tid & 63, wave = __builtin_amdgcn_readfirstlane(tid >> 6);
    LAS int* sb = (LAS int*)lds;
    __syncthreads();
    {
        const int e = tid & 31, part = tid >> 5; int c[16];
#pragma unroll
        for (int i = 0; i < 16; ++i) c[i] = rb.hist[(part * 16 + i) * 32 + e];
        int tot = 0, base = 0;
#pragma unroll
        for (int i = 0; i < 16; ++i) { tot += c[i]; if (part * 16 + i < blk) base += c[i]; }
        sb[128 + part * 32 + e] = base; sb[128 + 512 + part * 32 + e] = tot; }
    __syncthreads();
    if (tid < 32) { int tot = 0, base = 0;
#pragma unroll
        for (int i = 0; i < 16; ++i) { base += sb[128 + i * 32 + tid]; tot += sb[128 + 512 + i * 32 + tid]; }
        sb[tid] = base; sb[32 + tid] = tot; }
    __syncthreads();
    if (tid == 0) { int acc = 0; for (int e = 0; e < 32; ++e) { sb[64 + e] = acc; if (blk == 0) rb.tstart[e] = acc >> 8; acc += (sb[32 + e] + 255) & ~255; } sb[96] = acc; if (blk == 0) rb.tstart[32] = acc >> 8; }
    __syncthreads();
    if (tid < 256) { const int idx = blk * 256 + tid; const int e = rb.e[idx]; const int d = sb[64 + e] + sb[e] + rb.rank[idx]; rb.dest[idx] = d; rb.src[d] = idx >> 1; }
    if (blk < 32) { const int e = blk; const int lo = sb[64 + e] + sb[32 + e], hi = sb[64 + e] + ((sb[32 + e] + 255) & ~255); for (int r = lo + tid; r < hi; r += NTHR) rb.src[r] = 0; }
}
struct MoeSched {
    const char* A; const char* B; const int* tstart; int K, nN, G, c; size_t bexp;
    __device__ __forceinline__ pg8::Unit get(int i, bool& ok) const { pg8::Unit u; u.A = nullptr; u.B = nullptr; u.src = nullptr; u.pm = 0; u.pn = 0; u.job = 0; ok = next(i, u); return u; }
    __device__ __forceinline__ bool next(int i, pg8::Unit& u) const {
        const int vc = (c & 7) * (G >> 3) + (c >> 3);
        const long L = (long)i * G + vc; const int ntile = tstart[32];
        if (L >= (long)ntile * nN) return false;
        const int mt = (int)(L / nN), nt = (int)(L % nN);
        int e = 0;
        for (int k = 1; k < 32; ++k) if (tstart[k] <= mt) e = k;
        u.A = A + (size_t)mt * 256 * K * 2; u.B = B + (size_t)e * bexp + (size_t)nt * 256 * K * 2; u.src = nullptr; u.pm = mt; u.pn = nt; u.job = 0; return true;
    }
};
__device__ __forceinline__ void swa_phase(LAS unsigned char* lds, const bf16_t* __restrict__ Q1, const bf16_t* __restrict__ K1, const bf16_t* __restrict__ VT1, const float* __restrict__ sinks, bf16_t* __restrict__ O, int blk, int G) {
    int tid_ = threadIdx.x; asm volatile("" : "+v"(tid_)); const int tid = tid_, lane = tid & 63, wave = __builtin_amdgcn_readfirstlane(tid >> 6), r32 = lane & 31, hh = lane >> 5;
    LAS unsigned char* KL = lds;
    LAS unsigned char* VL = lds + 36864;
    for (int u = blk; u < 1024; u += G) {
        int n = u & 31, kvh = (u >> 5) & 3, b = u >> 7;
        if (G == 256) { const int grp = (u >> 8) * 8 + (blk & 7); n = blk >> 3; kvh = grp & 3; b = grp >> 2; }
        const int tokb = b * SEQ + (n - 1) * 128;
        bf16x8 qfa[2][4];
        {   const int g0 = wave >> 1, hq0 = kvh * 4 + g0;
#pragma unroll
            for (int sb = 0; sb < 2; ++sb)
#pragma unroll
                for (int ks = 0; ks < 4; ++ks) qfa[sb][ks] = *(const bf16x8*)(Q1 + ((size_t)b * SEQ + n * 128 + (wave & 1) * 64 + sb * 32 + r32) * 1024 + hq0 * 64 + ks * 16 + hh * 8); }
        __syncthreads();
#pragma unroll
        for (int i = 0; i < 4; ++i) { const int ch = tid + 512 * i; const int key = ch >> 3, c = ch & 7;
            u32x4 v = (u32x4){0u, 0u, 0u, 0u}; if (n > 0 || key >= 128) v = *(const u32x4*)(K1 + (size_t)(tokb + key) * 256 + kvh * 64 + c * 8);
            *(LAS u32x4*)(KL + key * 144 + c * 16) = v; }
#pragma unroll
        for (int i = 0; i < 4; ++i) { const int ch = tid + 512 * i; const int d = ch >> 5, c = ch & 31;
            u32x4 v = (u32x4){0u, 0u, 0u, 0u}; if (n > 0 || c >= 16) v = *(const u32x4*)(VT1 + (size_t)(kvh * 64 + d) * NT + tokb + c * 8);
            LAS u32x2* dp = (LAS u32x2*)(VL + d * 520 + c * 16); dp[0] = (u32x2){v.x, v.y}; dp[1] = (u32x2){v.z, v.w}; }
        __syncthreads();
        const int g = wave >> 1, hq = kvh * 4 + g; const float sink = sinks[hq];
#pragma unroll 1
        for (int sb = 0; sb < 2; ++sb) {
            bf16x8 qf[4];
#pragma unroll
            for (int ks = 0; ks < 4; ++ks) qf[ks] = sb ? qfa[1][ks] : qfa[0][ks];
            const int i0 = (wave & 1) * 64 + sb * 32, jt0 = i0 >> 5;
            const size_t qtok = (size_t)b * SEQ + n * 128 + i0 + r32;
            f32x16 s[5];
#pragma unroll
            for (int t = 0; t < 5; ++t) {
#pragma unroll
                for (int r = 0; r < 16; ++r) s[t][r] = 0.f;
                const LAS unsigned char* kp = KL + ((jt0 + t) * 32 + r32) * 144 + hh * 16;
#pragma unroll
                for (int ks = 0; ks < 4; ++ks) { const bf16x8 a = *(const LAS bf16x8*)(kp + ks * 32); s[t] = MFMA32(a, qf[ks], s[t]); }
            }
            const int qi = i0 + r32;
            float mx = sink;
#pragma unroll
            for (int t = 0; t < 5; ++t)
#pragma unroll
                for (int r = 0; r < 16; ++r) { const int kj = (jt0 + t) * 32 + crow(r, hh); const bool valid = (kj > qi) && (kj <= qi + 128) && (n > 0 || kj >= 128);
                    s[t][r] = valid ? s[t][r] : -INFINITY; mx = fmaxf(mx, s[t][r]); }
            mx = xhalf_max(mx);
            float sm = 0.f; const float mxl = mx * LOG2E;
            u32x4 pf[5][2];
#pragma unroll
            for (int t = 0; t < 5; ++t) {
#pragma unroll
                for (int r = 0; r < 16; ++r) { const float pv = __builtin_amdgcn_exp2f(s[t][r] * LOG2E - mxl); s[t][r] = pv; sm += pv; }
#pragma unroll
                for (int sx = 0; sx < 2; ++sx) pf[t][sx] = (u32x4){pk2(s[t][8 * sx], s[t][8 * sx + 1]), pk2(s[t][8 * sx + 2], s[t][8 * sx + 3]), pk2(s[t][8 * sx + 4], s[t][8 * sx + 5]), pk2(s[t][8 * sx + 6], s[t][8 * sx + 7])};
            }
            sm = xhalf_sum(sm) + __builtin_amdgcn_exp2f(sink * LOG2E - mxl);
            f32x16 o[2];
#pragma unroll
            for (int dt = 0; dt < 2; ++dt)
#pragma unroll
                for (int r = 0; r < 16; ++r) o[dt][r] = 0.f;
#pragma unroll
            for (int t = 0; t < 5; ++t)
#pragma unroll
                for (int sx = 0; sx < 2; ++sx) { const bf16x8 pb = __builtin_bit_cast(bf16x8, pf[t][sx]);
#pragma unroll
                    for (int dt = 0; dt < 2; ++dt) { const LAS unsigned char* q = VL + (dt * 32 + r32) * 520 + ((jt0 + t) * 32 + 16 * sx + 4 * hh) * 2;
                        const s16x4 lo = *(const LAS s16x4*)q, hi = *(const LAS s16x4*)(q + 16);
                        const bf16x8 a = (bf16x8){lo[0], lo[1], lo[2], lo[3], hi[0], hi[1], hi[2], hi[3]}; o[dt] = MFMA32(a, pb, o[dt]); } }
            const float inv = 1.f / sm;
            bf16_t* orow = O + qtok * 1024 + hq * 64 + 4 * hh;
#pragma unroll
            for (int dt = 0; dt < 2; ++dt)
#pragma unroll
                for (int gq = 0; gq < 4; ++gq) { u32x2 w; w.x = pk2(o[dt][4 * gq] * inv, o[dt][4 * gq + 1] * inv); w.y = pk2(o[dt][4 * gq + 2] * inv, o[dt][4 * gq + 3] * inv); *(u32x2*)(orow + dt * 32 + 8 * gq) = w; }
        }
    }
}
constexpr int TS = 272;
template <int STRIDE = TS>
__device__ __forceinline__ bf16x8 tr_frag(const LAS unsigned char* T, int k0, int c0, int lane, bool permuted) {
    const int hh = lane >> 5, blk = (lane >> 4) & 1, q = (lane & 15) >> 2, pp = lane & 3;
    const int r0 = k0 + (permuted ? 4 * hh : 8 * hh) + q, r1 = r0 + (permuted ? 8 : 4);
    const int cb = (c0 + 16 * blk + 4 * pp) * 2;
    const s16x4 lo = lds_tr(T + r0 * STRIDE + cb), hi = lds_tr(T + r1 * STRIDE + cb);
    return (bf16x8){lo[0], lo[1], lo[2], lo[3], hi[0], hi[1], hi[2], hi[3]};
}
__device__ __forceinline__ bf16x8 row_frag(const LAS unsigned char* T, int row, int k0, int hh) { return *(const LAS bf16x8*)(T + row * TS + (k0 + 8 * hh) * 2); }
__device__ __forceinline__ void load_tile128(LAS unsigned char* T, const bf16_t* __restrict__ g, int ld, int tid) {
#pragma unroll
    for (int i = 0; i < 4; ++i) { const int ch = tid + 512 * i, row = ch >> 4, c = ch & 15; *(LAS u32x4*)(T + row * TS + c * 16) = *(const u32x4*)(g + (size_t)row * ld + c * 8); }
}
struct L0Bufs {
    bf16_t *AU, *AV, *BX, *BZ, *V, *XC, *YM, *CS, *Q, *K, *U; float *GT, *UN, *NS, *SC;
    const bf16_t *WQT, *GMW, *MT; const float *gm_g, *gm_b, *gm_bs, *cw, *cb, *bif, *nw, *skip;
};

__device__ __forceinline__ void l0_mixA(LAS unsigned char* lds, const L0Bufs& B, int blk, int G) {
    const int tid0 = threadIdx.x, wave = __builtin_amdgcn_readfirstlane(tid0 >> 6);
#define OPQ_IDS int tid = tid0; asm volatile("" : "+v"(tid)); const int lane = tid & 63, r32 = lane & 31, hh = lane >> 5; (void)lane; (void)r32; (void)hh;
    LAS unsigned char* T0 = lds; LAS unsigned char* T1 = lds + 34816; LAS unsigned char* T2 = lds + 2 * 34816; LAS unsigned char* T3 = lds + 3 * 34816;
    LAS float* SF = (LAS float*)T2;
    LAS float* SG = (LAS float*)(lds + 3 * 34816 + 35632);
    for (int u = blk; u < 256; u += G) {
        const int tok0 = u * 128; const bool first = (u & 31) == 0;
        constexpr int VS = 1040;
        {   OPQ_IDS; const int trow = tid >> 2, q4 = tid & 3;
            const bf16_t* vr = B.AV + (size_t)(tok0 + trow) * 512 + q4 * 128; float s = 0.f, s2 = 0.f; u32x4 w[16];
#pragma unroll
            for (int i = 0; i < 16; ++i) w[i] = *(const u32x4*)(vr + i * 8);
#pragma unroll
            for (int i = 0; i < 16; ++i) { const float f[8] = {bf_lo(w[i].x), bf_hi(w[i].x), bf_lo(w[i].y), bf_hi(w[i].y), bf_lo(w[i].z), bf_hi(w[i].z), bf_lo(w[i].w), bf_hi(w[i].w)};
#pragma unroll
                for (int e = 0; e < 8; ++e) { s += f[e]; s2 += f[e] * f[e]; } }
            s += shx(s, 1, lane); s += shx(s, 2, lane); s2 += shx(s2, 1, lane); s2 += shx(s2, 2, lane);
            const float mean = s * (1.f / 512.f), rstd = rsqrtf(fmaxf(s2 * (1.f / 512.f) - mean * mean, 0.f) + LN_EPS);
            __syncthreads();
#pragma unroll
            for (int i = 0; i < 16; ++i) { const int cbase = q4 * 128 + i * 8; const f32x4 g0 = *(const f32x4*)(B.gm_g + cbase), g1 = *(const f32x4*)(B.gm_g + cbase + 4), b0 = *(const f32x4*)(B.gm_b + cbase), b1 = *(const f32x4*)(B.gm_b + cbase + 4);
                u32x4 o; o.x = pk2((bf_lo(w[i].x) - mean) * rstd * g0[0] + b0[0], (bf_hi(w[i].x) - mean) * rstd * g0[1] + b0[1]); o.y = pk2((bf_lo(w[i].y) - mean) * rstd * g0[2] + b0[2], (bf_hi(w[i].y) - mean) * rstd * g0[3] + b0[3]);
                o.z = pk2((bf_lo(w[i].z) - mean) * rstd * g1[0] + b1[0], (bf_hi(w[i].z) - mean) * rstd * g1[1] + b1[1]); o.w = pk2((bf_lo(w[i].w) - mean) * rstd * g1[2] + b1[2], (bf_hi(w[i].w) - mean) * rstd * g1[3] + b1[3]);
                *(LAS u32x4*)(lds + trow * VS + cbase * 2) = o; asm volatile("" ::: "memory"); }
            __syncthreads();
        }
        {   const int tb = wave & 3, dhf = wave >> 2;
#pragma unroll 1
            for (int g = 0; g < 4; ++g) {
                OPQ_IDS; const int t = 32 * tb + r32; const size_t tok = (size_t)tok0 + t;
                f32x16 acc[2];
#pragma unroll
                for (int dt = 0; dt < 2; ++dt)
#pragma unroll
                    for (int r = 0; r < 16; ++r) acc[dt][r] = 0.f;
                const bf16_t* wrow = B.GMW + ((size_t)g * 128 + t) * 128 + 8 * hh;
                bf16x8 bw[8];
#pragma unroll
                for (int ks = 0; ks < 8; ++ks) bw[ks] = *(const bf16x8*)(wrow + 16 * ks);
#pragma unroll
                for (int ks = 0; ks < 8; ++ks) if (ks <= 2 * tb + 1) {
#pragma unroll
                    for (int dt = 0; dt < 2; ++dt) { const bf16x8 a = tr_frag<VS>(lds, 16 * ks, g * 128 + 64 * dhf + 32 * dt, lane, false); acc[dt] = MFMA32(a, bw[ks], acc[dt]); } }
                const float bsv = B.gm_bs[g * 128 + t];
#pragma unroll
                for (int dt = 0; dt < 2; ++dt)
#pragma unroll
                    for (int gq = 0; gq < 4; ++gq) { const int col = g * 128 + 64 * dhf + 32 * dt + 8 * gq + 4 * hh; const u32x2 au = *(const u32x2*)(B.AU + tok * 512 + col);
                        u32x2 w; w.x = pk2(bf_lo(au.x) * (acc[dt][4 * gq] + bsv), bf_hi(au.x) * (acc[dt][4 * gq + 1] + bsv)); w.y = pk2(bf_lo(au.y) * (acc[dt][4 * gq + 2] + bsv), bf_hi(au.y) * (acc[dt][4 * gq + 3] + bsv));
                        *(u32x2*)(B.YM + tok * 1024 + col) = w; }
            }
        }
        f32x16 accg;
#pragma unroll
        for (int r = 0; r < 16; ++r) accg[r] = 0.f;
        LAS unsigned char* MTL = (LAS unsigned char*)SG;
#pragma unroll 1
        for (int h = 0; h < 4; ++h) {
            OPQ_IDS;
            __syncthreads();
            for (int ch = tid; ch < 131 * 16; ch += 512) { const int row = ch >> 4, c = ch & 15; u32x4 v = (u32x4){0u, 0u, 0u, 0u};
                if (!(first && row < 3)) v = *(const u32x4*)(B.BX + (size_t)(tok0 - 3 + row) * 512 + h * 128 + c * 8);
                *(LAS u32x4*)(T3 + row * TS + c * 16) = v; }
            load_tile128(T0, B.WQT + ((size_t)0 * 4 + h) * 128 * 128, 128, tid);
            load_tile128(T1, B.WQT + ((size_t)1 * 4 + h) * 128 * 128, 128, tid);
            if (tid < 256) { const int row = tid >> 5, c = tid & 31; *(LAS u32x4*)(MTL + row * 528 + c * 16) = *(const u32x4*)(B.MT + ((size_t)h * 8 + row) * 256 + c * 8); }
            __syncthreads();
            {   const int dc = tid & 15, chn = h * 128 + dc * 8; float w[4][8], cbv[8];
#pragma unroll
                for (int j = 0; j < 4; ++j)
#pragma unroll
                    for (int e = 0; e < 8; ++e) w[j][e] = B.cw[j * 512 + chn + e];
#pragma unroll
                for (int e = 0; e < 8; ++e) cbv[e] = B.cb[chn + e];
#pragma unroll 1
                for (int ps = 0; ps < 4; ++ps) { const int t = ps * 32 + (tid >> 4); float a[8];
#pragma unroll
                    for (int e = 0; e < 8; ++e) a[e] = cbv[e];
#pragma unroll
                    for (int j = 0; j < 4; ++j) { const u32x4 x = *(const LAS u32x4*)(T3 + (t + j) * TS + dc * 16);
                        a[0] += w[j][0] * bf_lo(x.x); a[1] += w[j][1] * bf_hi(x.x); a[2] += w[j][2] * bf_lo(x.y); a[3] += w[j][3] * bf_hi(x.y);
                        a[4] += w[j][4] * bf_lo(x.z); a[5] += w[j][5] * bf_hi(x.z); a[6] += w[j][6] * bf_lo(x.w); a[7] += w[j][7] * bf_hi(x.w); }
                    u32x4 o; o.x = pk2(silu_f(a[0]), silu_f(a[1])); o.y = pk2(silu_f(a[2]), silu_f(a[3])); o.z = pk2(silu_f(a[4]), silu_f(a[5])); o.w = pk2(silu_f(a[6]), silu_f(a[7]));
                    *(LAS u32x4*)(T2 + t * TS + dc * 16) = o; *(u32x4*)(B.XC + (size_t)(tok0 + t) * 512 + chn) = o; } }
            __syncthreads();
            {   const int tb = wave & 3, ehf = wave >> 2;
                {
                    OPQ_IDS; const LAS unsigned char* act = ehf ? T3 + 3 * TS : T2;
#pragma unroll
                    for (int ks = 0; ks < 8; ++ks) { const bf16x8 a = *(const LAS bf16x8*)(MTL + (r32 & 7) * 528 + (ehf * 128 + 16 * ks + 8 * hh) * 2); const bf16x8 bx = row_frag(act, 32 * tb + r32, 16 * ks, hh); accg = MFMA32(a, bx, accg); } }
#pragma unroll 1
                for (int mtx = 0; mtx < 2; ++mtx) {
                    OPQ_IDS;
                    const LAS unsigned char* wt = mtx ? T1 : T0;
                    f32x16 acc[2];
#pragma unroll
                    for (int et = 0; et < 2; ++et)
#pragma unroll
                        for (int r = 0; r < 16; ++r) acc[et][r] = 0.f;
#pragma unroll
                    for (int ks = 0; ks < 8; ++ks) { const bf16x8 bx = row_frag(T2, 32 * tb + r32, 16 * ks, hh);
#pragma unroll
                        for (int et = 0; et < 2; ++et) { const bf16x8 a = row_frag(wt, 64 * ehf + 32 * et + r32, 16 * ks, hh); acc[et] = MFMA32(a, bx, acc[et]); } }
                    bf16_t* dst = (mtx == 0 ? B.Q : B.K) + (size_t)(tok0 + 32 * tb + r32) * 512 + h * 128 + 64 * ehf + 4 * hh;
#pragma unroll
                    for (int et = 0; et < 2; ++et)
#pragma unroll
                        for (int gq = 0; gq < 4; ++gq) { u32x2 w; w.x = pk2(acc[et][4 * gq], acc[et][4 * gq + 1]); w.y = pk2(acc[et][4 * gq + 2], acc[et][4 * gq + 3]); *(u32x2*)(dst + 32 * et + 8 * gq) = w; }
                }
            }
            __syncthreads();
            load_tile128(T0, B.WQT + ((size_t)2 * 4 + h) * 128 * 128, 128, tid);
            __syncthreads();
            {   OPQ_IDS; const int tb = wave & 3, ehf = wave >> 2;
                f32x16 acc[2];
#pragma unroll
                for (int et = 0; et < 2; ++et)
#pragma unroll
                    for (int r = 0; r < 16; ++r) acc[et][r] = 0.f;
#pragma unroll
                for (int ks = 0; ks < 8; ++ks) { const bf16x8 bx = row_frag(T3 + 3 * TS, 32 * tb + r32, 16 * ks, hh);
#pragma unroll
                    for (int et = 0; et < 2; ++et) { const bf16x8 a = row_frag(T0, 64 * ehf + 32 * et + r32, 16 * ks, hh); acc[et] = MFMA32(a, bx, acc[et]); } }
                bf16_t* dst = B.V + (size_t)(tok0 + 32 * tb + r32) * 512 + h * 128 + 64 * ehf + 4 * hh;
#pragma unroll
                for (int et = 0; et < 2; ++et)
#pragma unroll
                    for (int gq = 0; gq < 4; ++gq) { u32x2 w; w.x = pk2(acc[et][4 * gq], acc[et][4 * gq + 1]); w.y = pk2(acc[et][4 * gq + 2], acc[et][4 * gq + 3]); *(u32x2*)(dst + 32 * et + 8 * gq) = w; }
            }
        }
        __syncthreads();
        {   OPQ_IDS; const int tb = wave & 3, kh = wave >> 2;
#pragma unroll
            for (int r = 0; r < 4; ++r) SF[(kh * 8 + r + 4 * hh) * 128 + 32 * tb + r32] = accg[r];
        }
        __syncthreads();
        LAS float* IG = SG; LAS float* BC = SG + 512; LAS float* WG = SG + 1024;
        if (wave < 4) {
            OPQ_IDS; const int h = wave; float lf[2], ig[2];
#pragma unroll
            for (int e = 0; e < 2; ++e) { const int t = 2 * lane + e; ig[e] = SF[h * 128 + t] + SF[(8 + h) * 128 + t] + B.bif[h];
                const float fx = SF[(4 + h) * 128 + t] + SF[(12 + h) * 128 + t] + B.bif[4 + h]; lf[e] = fminf(fx, 0.f) - log1pf(expf(-fabsf(fx))); }
            float run = lf[0] + lf[1];
#pragma unroll
            for (int o = 1; o < 64; o <<= 1) { const float v = shup(run, o, lane); if (lane >= o) run += v; }
            const float b1 = run, b0 = run - lf[1];
            IG[h * 128 + 2 * lane] = ig[0]; IG[h * 128 + 2 * lane + 1] = ig[1]; BC[h * 128 + 2 * lane] = b0; BC[h * 128 + 2 * lane + 1] = b1;
            float* gt = B.GT + ((size_t)u * 4 + h) * 256;
            gt[2 * lane] = ig[0]; gt[2 * lane + 1] = ig[1]; gt[128 + 2 * lane] = b0; gt[128 + 2 * lane + 1] = b1;
            const float bl = shidx(b1, 63);
            float g0 = bl - b0 + ig[0], g1 = bl - b1 + ig[1]; float mloc = fmaxf(g0, g1);
#pragma unroll
            for (int o = 1; o < 64; o <<= 1) mloc = fmaxf(mloc, shx(mloc, o, lane));
            WG[h * 128 + 2 * lane] = expf(g0 - mloc); WG[h * 128 + 2 * lane + 1] = expf(g1 - mloc);
            if (lane == 0) { B.SC[u * 4 + h] = bl; B.SC[1024 + u * 4 + h] = mloc; }
        }
#pragma unroll 1
        for (int h = 0; h < 4; ++h) {
            OPQ_IDS;
            __syncthreads();
#pragma unroll
            for (int i = 0; i < 4; ++i) { const int ch = tid + 512 * i, row = ch >> 4, c = ch & 15; const float wg = WG[h * 128 + row];
                const u32x4 v = *(const u32x4*)(B.V + (size_t)(tok0 + row) * 512 + h * 128 + c * 8), k = *(const u32x4*)(B.K + (size_t)(tok0 + row) * 512 + h * 128 + c * 8);
                u32x4 ov, ok; const float ksc = 0.08838834764831845f;
                ov.x = pk2(bf_lo(v.x) * wg, bf_hi(v.x) * wg); ov.y = pk2(bf_lo(v.y) * wg, bf_hi(v.y) * wg); ov.z = pk2(bf_lo(v.z) * wg, bf_hi(v.z) * wg); ov.w = pk2(bf_lo(v.w) * wg, bf_hi(v.w) * wg);
                ok.x = pk2(bf_lo(k.x) * ksc, bf_hi(k.x) * ksc); ok.y = pk2(bf_lo(k.y) * ksc, bf_hi(k.y) * ksc); ok.z = pk2(bf_lo(k.z) * ksc, bf_hi(k.z) * ksc); ok.w = pk2(bf_lo(k.w) * ksc, bf_hi(k.w) * ksc);
                *(LAS u32x4*)(T0 + row * TS + c * 16) = ov; *(LAS u32x4*)(T1 + row * TS + c * 16) = ok; }
            __syncthreads();
            const int vb = wave & 3, khf = wave >> 2;
            f32x16 acc[2];
#pragma unroll
            for (int kt = 0; kt < 2; ++kt)
#pragma unroll
                for (int r = 0; r < 16; ++r) acc[kt][r] = 0.f;
#pragma unroll
            for (int ks = 0; ks < 8; ++ks) { const bf16x8 a = tr_frag(T0, 16 * ks, 32 * vb, lane, false);
#pragma unroll
                for (int kt = 0; kt < 2; ++kt) { const bf16x8 bk = tr_frag(T1, 16 * ks, 64 * khf + 32 * kt, lane, false); acc[kt] = MFMA32(a, bk, acc[kt]); } }
            bf16_t* Uo = B.U + ((size_t)u * 4 + h) * 16384;
#pragma unroll
            for (int kt = 0; kt < 2; ++kt)
#pragma unroll
                for (int r = 0; r < 16; ++r) Uo[(32 * vb + crow(r, hh)) * 128 + 64 * khf + 32 * kt + r32] = f2bf(acc[kt][r]);
            {   const int kk = tid & 127, sq = tid >> 7; float a = 0.f;
                for (int s = sq * 32; s < sq * 32 + 32; ++s) a += WG[h * 128 + s] * bf2f(*(const LAS bf16_t*)(T1 + s * TS + kk * 2));
                SF[2048 + sq * 128 + kk] = a; }
            __syncthreads();
            if (tid < 128) B.UN[((size_t)u * 4 + h) * 128 + tid] = (SF[2048 + tid] + SF[2048 + 128 + tid]) + (SF[2048 + 256 + tid] + SF[2048 + 384 + tid]);
        }
    }
}
#undef OPQ_IDS
__device__ __forceinline__ void l0_scan(const L0Bufs& B, int blk, int tid) {
    const int bh = blk >> 3, part = blk & 7, b = bh >> 2, h = bh & 3;
    const int e0 = part * 2048 + tid * 8;
    f32x4 C0 = (f32x4){0.f, 0.f, 0.f, 0.f}, C1 = C0; float nst = 0.f; float m = 0.f;
    const int unit0 = (b * 32) * 4 + h;
    u32x4 Unw = *(const u32x4*)(B.U + (size_t)unit0 * 16384 + e0); float bln = B.SC[unit0], mln = B.SC[1024 + unit0];
    float unn = (part == 0 && tid < 128) ? B.UN[(size_t)unit0 * 128 + tid] : 0.f;
    for (int c = 0; c < 32; ++c) {
        const int unit = unit0 + 4 * c;
        const f32x4 U0 = (f32x4){bf_lo(Unw.x), bf_hi(Unw.x), bf_lo(Unw.y), bf_hi(Unw.y)}, U1 = (f32x4){bf_lo(Unw.z), bf_hi(Unw.z), bf_lo(Unw.w), bf_hi(Unw.w)}; const float bl = bln, mloc = mln, un = unn;
        if (c < 31) { const int un1 = unit + 4; Unw = *(const u32x4*)(B.U + (size_t)un1 * 16384 + e0); bln = B.SC[un1]; mln = B.SC[1024 + un1]; if (part == 0 && tid < 128) unn = B.UN[(size_t)un1 * 128 + tid]; }
        u32x4 w; w.x = pk2(C0[0], C0[1]); w.y = pk2(C0[2], C0[3]); w.z = pk2(C1[0], C1[1]); w.w = pk2(C1[2], C1[3]); *(u32x4*)(B.CS + (size_t)unit * 16384 + e0) = w;
        if (part == 0 && tid < 128) B.NS[(size_t)unit * 128 + tid] = nst;
        if (part == 0 && tid == 0) B.SC[2048 + unit] = m;
        const float mn = fmaxf(bl + m, mloc), dec = expf(bl + m - mn), wu = expf(mloc - mn); m = mn;
        C0 = C0 * dec + U0 * wu; C1 = C1 * dec + U1 * wu;
        nst = nst * dec + wu * un;
    }
}
__device__ __forceinline__ void l0_mixC(LAS unsigned char* lds, const L0Bufs& B, int blk, int G) {
    const int tid0 = threadIdx.x, wave = __builtin_amdgcn_readfirstlane(tid0 >> 6);
    LAS unsigned char* TQ = lds; LAS unsigned char* TK = lds + 34816; LAS unsigned char* TV = lds + 2 * 34816; LAS unsigned char* TC = lds + 3 * 34816;
    LAS float* SF = (LAS float*)(lds + 4 * 34816);
    LAS float* AS = SF; LAS float* PM = SF + 128; LAS float* NP = SF + 256; LAS float* PS = SF + 384; LAS float* PQ = SF + 640; LAS float* NW = SF + 896;
    __syncthreads();
    { int tq = tid0; asm volatile("" : "+v"(tq)); if (tq < 256) ((LAS f32x4*)NW)[tq] = tq < 128 ? ((const f32x4*)B.nw)[tq] : ((const f32x4*)B.skip)[tq - 128]; }
    for (int uu = blk; uu < 256; uu += G) {
        const int tok0 = uu * 128;
#pragma unroll 1
        for (int h = 0; h < 4; ++h) {
            const int unit = uu * 4 + h;
            int tid = tid0; asm volatile("" : "+v"(tid));
            const int lane = tid & 63, r32 = lane & 31, hh = lane >> 5;
            __syncthreads();
            load_tile128(TQ, B.Q + (size_t)tok0 * 512 + h * 128, 512, tid);
            load_tile128(TV, B.V + (size_t)tok0 * 512 + h * 128, 512, tid);
            load_tile128(TC, B.CS + (size_t)unit * 16384, 128, tid);
#pragma unroll
            for (int i = 0; i < 4; ++i) { const int ch = tid + 512 * i, row = ch >> 4, c = ch & 15; const u32x4 k = *(const u32x4*)(B.K + (size_t)(tok0 + row) * 512 + h * 128 + c * 8); const float ksc = 0.08838834764831845f;
                u32x4 ok; ok.x = pk2(bf_lo(k.x) * ksc, bf_hi(k.x) * ksc); ok.y = pk2(bf_lo(k.y) * ksc, bf_hi(k.y) * ksc); ok.z = pk2(bf_lo(k.z) * ksc, bf_hi(k.z) * ksc); ok.w = pk2(bf_lo(k.w) * ksc, bf_hi(k.w) * ksc);
                *(LAS u32x4*)(TK + row * TS + c * 16) = ok; }
            const float mprev = B.SC[2048 + unit];
            if (wave == 0) {
                const float* gt = B.GT + (size_t)unit * 256;
                const float a0 = gt[2 * lane] - gt[128 + 2 * lane], a1 = gt[2 * lane + 1] - gt[128 + 2 * lane + 1];
                float run = fmaxf(a0, a1);
#pragma unroll
                for (int o = 1; o < 64; o <<= 1) { const float v = shup(run, o, lane); if (lane >= o) run = fmaxf(run, v); }
                const float prev = shup(run, 1, lane); const float p0 = fmaxf(lane > 0 ? fmaxf(prev, a0) : a0, mprev), p1 = fmaxf(run, mprev);
                AS[2 * lane] = a0; AS[2 * lane + 1] = a1; PM[2 * lane] = p0; PM[2 * lane + 1] = p1;
            }
            if (wave == 1) { NP[lane] = B.NS[(size_t)unit * 128 + lane]; NP[64 + lane] = B.NS[(size_t)unit * 128 + 64 + lane]; }
            __syncthreads();
            const int tb = wave & 3, vh = wave >> 2, t = 32 * tb + r32;
            const float pm = PM[t], bt = B.GT[(size_t)unit * 256 + 128 + t];
            f32x16 s[4];
#pragma unroll
            for (int st = 0; st < 4; ++st)
#pragma unroll
                for (int r = 0; r < 16; ++r) s[st][r] = 0.f;
            {   int lv = lane; asm volatile("" : "+v"(lv));
                const LAS unsigned char* qp = TQ + (32 * tb + (lv & 31)) * TS + (lv >> 5) * 16; const LAS unsigned char* kp = TK + (lv & 31) * TS + (lv >> 5) * 16;
#pragma unroll 2
                for (int ks = 0; ks < 8; ++ks) { const bf16x8 bq = *(const LAS bf16x8*)(qp + ks * 32);
#pragma unroll
                    for (int st = 0; st < 4; ++st) if (st <= tb) { const bf16x8 a = *(const LAS bf16x8*)(kp + st * 32 * TS + ks * 32); s[st] = MFMA32(a, bq, s[st]); } } }
            float nq = 0.f; u32x4 pf[4][2];
#pragma unroll
            for (int st = 0; st < 4; ++st) {
#pragma unroll
                for (int r = 0; r < 16; ++r) { const int sidx = 32 * st + crow(r, hh); const float wv = (sidx <= t) ? __builtin_amdgcn_exp2f((AS[sidx] - pm) * LOG2E) : 0.f; const float pv = s[st][r] * wv; s[st][r] = pv; nq += pv; }
#pragma unroll
                for (int sx = 0; sx < 2; ++sx) pf[st][sx] = (u32x4){pk2(s[st][8 * sx], s[st][8 * sx + 1]), pk2(s[st][8 * sx + 2], s[st][8 * sx + 3]), pk2(s[st][8 * sx + 4], s[st][8 * sx + 5]), pk2(s[st][8 * sx + 6], s[st][8 * sx + 7])};
            }
            nq = xhalf_sum(nq);
            float nqi = 0.f;
#pragma unroll
            for (int i = 0; i < 8; ++i) { const u32x4 qv = *(const LAS u32x4*)(TQ + t * TS + (64 * hh + 8 * i) * 2); const LAS float* np = NP + 64 * hh + 8 * i;
                nqi += bf_lo(qv.x) * np[0] + bf_hi(qv.x) * np[1] + bf_lo(qv.y) * np[2] + bf_hi(qv.y) * np[3] + bf_lo(qv.z) * np[4] + bf_hi(qv.z) * np[5] + bf_lo(qv.w) * np[6] + bf_hi(qv.w) * np[7]; }
            nqi = xhalf_sum(nqi);
            const float wst = __builtin_amdgcn_exp2f((mprev - pm) * LOG2E);
            const float den = fmaxf(fabsf(nq + wst * nqi), __builtin_amdgcn_exp2f(-(bt + pm) * LOG2E)), rden = 1.f / den;
            f32x16 ni[2], nx[2];
#pragma unroll
            for (int vt = 0; vt < 2; ++vt)
#pragma unroll
                for (int r = 0; r < 16; ++r) { ni[vt][r] = 0.f; nx[vt][r] = 0.f; }
            {   int lv = lane; asm volatile("" : "+v"(lv));
#pragma unroll
                for (int st = 0; st < 4; ++st) {
                    if (st <= tb) {
#pragma unroll
                        for (int sx = 0; sx < 2; ++sx) { const bf16x8 pb = __builtin_bit_cast(bf16x8, pf[st][sx]);
#pragma unroll
                            for (int vt = 0; vt < 2; ++vt) { const bf16x8 a = tr_frag(TV, 32 * st + 16 * sx, 64 * vh + 32 * vt, lv, true); ni[vt] = MFMA32(a, pb, ni[vt]); } }
                    }
                } }
            {   int lv = lane; asm volatile("" : "+v"(lv));
                const LAS unsigned char* qp = TQ + (32 * tb + (lv & 31)) * TS + (lv >> 5) * 16; const LAS unsigned char* cp = TC + (64 * vh + (lv & 31)) * TS + (lv >> 5) * 16;
#pragma unroll 2
                for (int ks = 0; ks < 8; ++ks) { const bf16x8 bq = *(const LAS bf16x8*)(qp + ks * 32);
#pragma unroll
                    for (int vt = 0; vt < 2; ++vt) { const bf16x8 a = *(const LAS bf16x8*)(cp + vt * 32 * TS + ks * 32); nx[vt] = MFMA32(a, bq, nx[vt]); } } }
            const size_t tok = (size_t)tok0 + t;
            u32x2 xcv[2][4], zv[2][4];
#pragma unroll
            for (int vt = 0; vt < 2; ++vt)
#pragma unroll
                for (int gq = 0; gq < 4; ++gq) { const int chn = h * 128 + 64 * vh + 32 * vt + 8 * gq + 4 * hh; xcv[vt][gq] = *(const u32x2*)(B.XC + tok * 512 + chn); zv[vt][gq] = *(const u32x2*)(B.BZ + tok * 512 + chn); }
            float hs = 0.f, hq = 0.f;
#pragma unroll
            for (int vt = 0; vt < 2; ++vt)
#pragma unroll
                for (int r = 0; r < 16; ++r) { const float hv = (ni[vt][r] + wst * nx[vt][r]) * rden; ni[vt][r] = hv; hs += hv; hq += hv * hv; }
            hs = xhalf_sum(hs); hq = xhalf_sum(hq);
            if (hh == 0) { PS[vh * 128 + t] = hs; PQ[vh * 128 + t] = hq; }
            __syncthreads();
            const float mean = (PS[t] + PS[128 + t]) * (1.f / 128.f);
            const float rstd = rsqrtf(fmaxf((PQ[t] + PQ[128 + t]) * (1.f / 128.f) - mean * mean, 0.f) + LN_EPS);
#pragma unroll
            for (int vt = 0; vt < 2; ++vt)
#pragma unroll
                for (int gq = 0; gq < 4; ++gq) { const int cl = 64 * vh + 32 * vt + 8 * gq + 4 * hh, chn = h * 128 + cl;
                    const f32x4 nw = *(const LAS f32x4*)(NW + chn), sk = *(const LAS f32x4*)(NW + 512 + chn); const u32x2 xc = xcv[vt][gq], z = zv[vt][gq];
                    const float y0 = ((ni[vt][4 * gq] - mean) * rstd * nw[0] + sk[0] * bf_lo(xc.x)) * silu_f(bf_lo(z.x)), y1 = ((ni[vt][4 * gq + 1] - mean) * rstd * nw[1] + sk[1] * bf_hi(xc.x)) * silu_f(bf_hi(z.x));
                    const float y2 = ((ni[vt][4 * gq + 2] - mean) * rstd * nw[2] + sk[2] * bf_lo(xc.y)) * silu_f(bf_lo(z.y)), y3 = ((ni[vt][4 * gq + 3] - mean) * rstd * nw[3] + sk[3] * bf_hi(xc.y)) * silu_f(bf_hi(z.y));
                    u32x2 w; w.x = pk2(y0, y1); w.y = pk2(y2, y3); *(u32x2*)(B.YM + tok * 1024 + 512 + chn) = w; }
        }
    }
}
constexpr size_t MB = 1048576ull;
constexpr size_t P_WIN_T = 0, P_WOUT_T = P_WIN_T + 4 * MB, P_WQKV_T = P_WOUT_T + 2 * MB, P_WO_T = P_WQKV_T + 3 * MB, P_XWQ_T = P_WO_T + 2 * MB, P_XWKV_T = P_XWQ_T + 4 * MB, P_XWO_T = P_XWKV_T + 8 * MB,
                 P_MLW_T = P_XWO_T + 4 * MB, P_WIFT = P_MLW_T + MB / 2, P_WRT = P_WIFT + MB / 8, P_ROT = P_WRT + MB / 2, P_BQK = P_ROT + MB, P_MEMB = P_BQK + MB / 8, P_KC = P_MEMB + 4 * MB, P_VT = P_KC + 8 * MB,
                 P_W13T = P_VT + 8 * MB, P_W2T = P_W13T + 64 * MB, P_XBF = P_W2T + 32 * MB, P_RT = P_XBF + 64 * MB, P_TMP = P_RT + 2 * MB;
constexpr size_t RT_SRC = 1638400;
constexpr size_t RT_E = 0, RT_W = 262144, RT_RANK = 2 * 262144, RT_DEST = 3 * 262144, RT_HIST = 4 * 262144, RT_TSTART = RT_HIST + 32768;
constexpr size_t T_QX = 0, T_OB = 64 * MB, T_YB = 128 * MB;
constexpr size_t T_K1 = 192 * MB, T_VT1 = 208 * MB;
constexpr size_t T_AU = 0, T_AV = 32 * MB, T_BX = 64 * MB, T_BZ = 96 * MB, T_V = 128 * MB, T_XC = 160 * MB, T_YM = 192 * MB, T_U = 256 * MB, T_CS = 320 * MB,
                 T_GT = 352 * MB, T_UN = 353 * MB, T_NS = 353 * MB + MB / 2, T_SC = 354 * MB, T_YB0 = 0;
constexpr size_t T_XG = 0, T_HM = 152 * MB, T_YG = 0;
constexpr size_t T_SLOT = 356 * MB;
constexpr size_t FAST_END = P_TMP + 360 * MB;
#ifdef PROBE_LNX
constexpr size_t SLOT_MB = 8;
#else
constexpr size_t SLOT_MB = 4;
#endif
constexpr int LDS_BYTES = 147456;

struct FP {
    const float* in[33]; float* X;
    unsigned char* ws;
};
typedef const float* const __attribute__((address_space(4)))* InTab;
struct PV { InTab in; float* X; unsigned char* ws; };
__device__ __forceinline__ PV make_pv(const FP& p0) {
    PV p; InTab kp = (InTab)__builtin_amdgcn_kernarg_segment_ptr(); asm volatile("" : "+s"(kp)); p.in = kp;
    p.X = p0.X; p.ws = p0.ws; asm volatile("" : "+s"(p.ws)); return p;
}
#define WSP(T, off) ((T*)(p.ws + (off)))

__device__ __forceinline__ RouteBufs route_bufs(const PV& p) {
    RouteBufs r; r.e = WSP(int, P_RT + RT_E); r.w = WSP(float, P_RT + RT_W); r.rank = WSP(int, P_RT + RT_RANK); r.dest = WSP(int, P_RT + RT_DEST); r.hist = WSP(int, P_RT + RT_HIST); r.tstart = WSP(int, P_RT + RT_TSTART); r.src = WSP(int, P_RT + RT_SRC); return r;
}
#define PH_ARGS const PV& p, LAS unsigned char* lds, int blk, int G
#define PH_IDS int tid_ = threadIdx.x; asm volatile("" : "+v"(tid_)); const int tid = tid_, lane = tid & 63, wave = __builtin_amdgcn_readfirstlane(tid >> 6); (void)lane; (void)wave;

__device__ __forceinline__ void ph_conv_xattn(PH_ARGS, int l) {
    PH_IDS; LAS float* scr = (LAS float*)(lds + wave * 8448); const int gw = blk * NWAVE + wave, ngw = G * NWAVE;
    convert_mats(p.in[23] + (size_t)l * 1024 * 1024, 1024, 1024, 1, 0, WSP(bf16_t, P_XWQ_T) + (size_t)l * 1024 * 1024, 0, RM_IDENT, 0.0625f, 1024, scr, gw, ngw, lane);
    convert_mats(p.in[24] + (size_t)l * 1024 * 2048, 1024, 2048, 1, 0, WSP(bf16_t, P_XWKV_T) + (size_t)l * 2048 * 1024, 0, RM_IDENT, 1.f, 0, scr, gw, ngw, lane);
    convert_mats(p.in[25] + (size_t)l * 1024 * 1024, 1024, 1024, 1, 0, WSP(bf16_t, P_XWO_T) + (size_t)l * 1024 * 1024, 0, RM_IDENT, 1.f, 0, scr, gw, ngw, lane);
    convert_rows(p.in[1], WSP(bf16_t, P_MEMB), (size_t)2048 * 1024, blk * NTHR + tid, G * NTHR);
}
__device__ __forceinline__ void conv_moe_waves(const PV& p, int l, LAS float* scr, int gw, int ngw, int gt, int ngt, int lane) {
    const size_t wl = (size_t)l * 32 * 1024 * 512;
    convert_mats(p.in[30] + wl, 1024, 512, 32, (size_t)1024 * 512, WSP(bf16_t, P_W13T), (size_t)1024 * 1024, RM_PAIR0, 1.f, 0, scr, gw, ngw, lane);
    convert_mats(p.in[31] + wl, 1024, 512, 32, (size_t)1024 * 512, WSP(bf16_t, P_W13T), (size_t)1024 * 1024, RM_PAIR1, 1.f, 0, scr, gw, ngw, lane);
    convert_mats(p.in[32] + wl, 512, 1024, 32, (size_t)512 * 1024, WSP(bf16_t, P_W2T), (size_t)1024 * 512, RM_IDENT, 1.f, 0, scr, gw, ngw, lane);
    bf16_t* wrt = WSP(bf16_t, P_WRT) + (size_t)l * 2 * 64 * 1024; const float* wre = p.in[28] + (size_t)l * 1024 * 32; const float* wrg = p.in[26] + (size_t)l * 1024 * 4;
    for (int i = gt; i < 64 * 1024; i += ngt) { const int r = i >> 10, k = i & 1023;
        const float v = r < 32 ? wre[k * 32 + r] : (r < 36 ? wrg[k * 4 + (r - 32)] : 0.f);
        const bf16_t h = f2bf(v); wrt[i] = h; wrt[64 * 1024 + i] = f2bf(v - bf2f(h)); }
}
__device__ __forceinline__ void ph_conv_moe(PH_ARGS, int l) {
    PH_IDS; conv_moe_waves(p, l, (LAS float*)(lds + wave * 8448), blk * NWAVE + wave, G * NWAVE, blk * NTHR + tid, G * NTHR, lane);
}
__device__ __forceinline__ void ph_x_to_bf(PH_ARGS) { PH_IDS; convert_rows(p.X, WSP(bf16_t, P_XBF), (size_t)NT * 1024, blk * NTHR + tid, G * NTHR); }

__device__ __forceinline__ void set_job(LAS pg8::JobDesc* jt, int j, const void* A, const void* B, int nM, int nN, void* out, int ldc, int mode, const void* bias = nullptr, const void* rot = nullptr, void* out2 = nullptr) {
    unsigned long long a = (unsigned long long)A, b = (unsigned long long)B, o = (unsigned long long)out, bi = (unsigned long long)bias, ro = (unsigned long long)rot, o2 = (unsigned long long)out2;
    asm volatile("" : "+s"(a), "+s"(b), "+s"(o), "+s"(bi), "+s"(ro), "+s"(o2), "+s"(nM), "+s"(nN), "+s"(ldc), "+s"(mode));
    LAS pg8::JobDesc* d = jt + j; d->A = a; d->B = b; d->out = o; d->bias = bi; d->rot = ro; d->out2 = o2;
    d->nM = nM; d->nN = nN; d->ldc = ldc; d->mode = mode;
}
#define JT_PTR ((LAS pg8::JobDesc*)(lds + pg8::JT_OFF))
__device__ __forceinline__ void run_jobs(LAS unsigned char* lds, int K, int n0, int n1, int n2, int blk, int G) {
    __syncthreads();
    pg8::Jobs3 S; S.jt = JT_PTR; S.n0 = n0; S.n1 = n1; S.n2 = n2; S.K = K; S.G = G; S.c = blk;
    EpiMulti E; E.jt = JT_PTR;
    pg8::gemm_phase<EpiMulti, pg8::Jobs3, true, true>(lds, K, S, E);
}
__device__ __forceinline__ void ph_xattn_g1(PH_ARGS, int l) {
    const bf16_t* wkv = WSP(bf16_t, P_XWKV_T) + (size_t)l * 2048 * 1024;
    __syncthreads();
    if (threadIdx.x == 0) {
        set_job(JT_PTR, 0, WSP(bf16_t, P_MEMB), wkv, 8, 4, WSP(bf16_t, P_KC) + (size_t)l * 2048 * 1024, 1024, EM_PLAIN);
        set_job(JT_PTR, 1, wkv + (size_t)1024 * 1024, WSP(bf16_t, P_MEMB), 4, 8, WSP(bf16_t, P_VT) + (size_t)l * 1024 * 2048, 2048, EM_PLAIN);
        set_job(JT_PTR, 2, WSP(bf16_t, P_XBF), WSP(bf16_t, P_XWQ_T) + (size_t)l * 1024 * 1024, 128, 4, WSP(bf16_t, P_TMP + T_QX), 1024, EM_PLAIN);
    }
    run_jobs(lds, 1024, 32, 32, 512, blk, G);
}
__device__ __forceinline__ void ph_xattn_attn(PH_ARGS, int l) {
    xattn_phase(lds, WSP(bf16_t, P_TMP + T_QX), WSP(bf16_t, P_KC) + (size_t)l * 2048 * 1024, WSP(bf16_t, P_VT) + (size_t)l * 1024 * 2048, WSP(bf16_t, P_TMP + T_OB), blk, G);
}
__device__ __forceinline__ void ph_gemm_plain(PH_ARGS, const bf16_t* A, const bf16_t* Bt, bf16_t* out) {
    __syncthreads();
    if (threadIdx.x == 0) set_job(JT_PTR, 0, A, Bt, 128, 4, out, 1024, EM_PLAIN);
    run_jobs(lds, 1024, 512, 0, 0, blk, G);
}
template <bool XF32, bool OUTF32, bool MOE>
__device__ __forceinline__ void ph_ln(PH_ARGS, const bf16_t* y, int lnidx, bool dry = false) {
    PH_IDS; LnArgs a; a.xin32 = p.in[0]; a.xin = WSP(bf16_t, P_XBF); a.xout32 = dry ? WSP(float, P_TMP + 200 * MB) : p.X; a.xbf = dry ? WSP(bf16_t, P_TMP + 288 * MB) : WSP(bf16_t, P_XBF); a.y = y; a.g = p.in[2] + lnidx * 1024; a.b = p.in[3] + lnidx * 1024;
    a.dest = WSP(int, P_RT + RT_DEST); a.wts = WSP(float, P_RT + RT_W);
    ln_phase<XF32, OUTF32, MOE>(a, blk, G, wave, lane);
}
__device__ __forceinline__ void ph_moe_route(PH_ARGS, int l) {
    moe_router_phase(lds, WSP(bf16_t, P_XBF), WSP(bf16_t, P_WRT) + (size_t)l * 2 * 64 * 1024, p.in[27] + l * 4, p.in[29] + l * 32, route_bufs(p), blk);
}
__device__ __forceinline__ void ph_moe_scatter(PH_ARGS) { moe_scatter_phase(lds, route_bufs(p), blk, G); }
__device__ __forceinline__ void ph_moe_g1(PH_ARGS) {
    __syncthreads();
    if (threadIdx.x == 0) set_job(JT_PTR, 0, nullptr, nullptr, 0, 0, WSP(bf16_t, P_TMP + T_HM), 512, EM_SWIGLU);
    __syncthreads();
    MoeSched S; S.A = (const char*)WSP(bf16_t, P_TMP + T_XG); S.B = (const char*)WSP(bf16_t, P_W13T); S.tstart = WSP(int, P_RT + RT_TSTART); S.K = 1024; S.nN = 4; S.G = G; S.c = blk; S.bexp = (size_t)1024 * 1024 * 2;
    EpiMulti E; E.jt = JT_PTR;
    pg8::gemm_phase<EpiMulti, MoeSched, true, true>(lds, 1024, S, E);
}
__device__ __forceinline__ void ph_moe_g2(PH_ARGS) {
    __syncthreads();
    if (threadIdx.x == 0) set_job(JT_PTR, 0, nullptr, nullptr, 0, 0, WSP(bf16_t, P_TMP + T_YG), 1024, EM_PLAIN);
    __syncthreads();
    MoeSched S; S.A = (const char*)WSP(bf16_t, P_TMP + T_HM); S.B = (const char*)WSP(bf16_t, P_W2T); S.tstart = WSP(int, P_RT + RT_TSTART); S.K = 512; S.nN = 4; S.G = G; S.c = blk; S.bexp = (size_t)1024 * 512 * 2;
    EpiMulti E; E.jt = JT_PTR;
    pg8::gemm_phase<EpiMulti, MoeSched, true, true>(lds, 512, S, E);
}

__device__ __forceinline__ void ph_conv_l1(PH_ARGS) {
    PH_IDS; LAS float* scr = (LAS float*)(lds + wave * 8448); const int gw = blk * NWAVE + wave, ngw = G * NWAVE;
    convert_mats(p.in[19], 1024, 1536, 1, 0, WSP(bf16_t, P_WQKV_T), 0, RM_ROT, 0.125f, 1024, scr, gw, ngw, lane);
    convert_mats(p.in[22], 1024, 1024, 1, 0, WSP(bf16_t, P_WO_T), 0, RM_IDENT, 1.f, 0, scr, gw, ngw, lane);
    const int gt = blk * NTHR + tid, ngt = G * NTHR;
    float* bqk = WSP(float, P_BQK);
    for (int n = gt; n < 1280; n += ngt) bqk[rowmap(RM_ROT, n)] = p.in[20][n] * (n < 1024 ? 0.125f : 1.f);
    float* rot = WSP(float, P_ROT);
    for (int i = gt; i < 4096 * 32; i += ngt) { const int pos = i >> 5, k = i & 31; const float inv = powf(10000.f, -(float)(2 * k) / 64.f); const float ang = (float)pos * inv; rot[2 * i] = cosf(ang); rot[2 * i + 1] = sinf(ang); }
}
__device__ __forceinline__ void ph_l1_g1(PH_ARGS) {
    __syncthreads();
    if (threadIdx.x == 0) {
        set_job(JT_PTR, 0, WSP(bf16_t, P_XBF), WSP(bf16_t, P_WQKV_T), 128, 5, WSP(bf16_t, P_TMP + T_QX), 1024, EM_ROTARY, WSP(float, P_BQK), WSP(float, P_ROT), WSP(bf16_t, P_TMP + T_K1));
        set_job(JT_PTR, 1, WSP(bf16_t, P_WQKV_T) + (size_t)1280 * 1024, WSP(bf16_t, P_XBF), 1, 128, WSP(bf16_t, P_TMP + T_VT1), NT, EM_ROWBIAS, p.in[20] + 1280);
    }
    run_jobs(lds, 1024, 640, 128, 0, blk, G);
}
__device__ __forceinline__ void ph_l1_swa(PH_ARGS) {
    swa_phase(lds, WSP(bf16_t, P_TMP + T_QX), WSP(bf16_t, P_TMP + T_K1), WSP(bf16_t, P_TMP + T_VT1), p.in[21], WSP(bf16_t, P_TMP + T_OB), blk, G);
}

__device__ __forceinline__ L0Bufs l0_bufs(const PV& p) {
    L0Bufs B; B.AU = WSP(bf16_t, P_TMP + T_AU); B.AV = WSP(bf16_t, P_TMP + T_AV); B.BX = WSP(bf16_t, P_TMP + T_BX); B.BZ = WSP(bf16_t, P_TMP + T_BZ); B.V = WSP(bf16_t, P_TMP + T_V); B.XC = WSP(bf16_t, P_TMP + T_XC);
    B.YM = WSP(bf16_t, P_TMP + T_YM); B.CS = WSP(bf16_t, P_TMP + T_CS); B.U = WSP(bf16_t, P_TMP + T_U); B.GT = WSP(float, P_TMP + T_GT); B.UN = WSP(float, P_TMP + T_UN); B.NS = WSP(float, P_TMP + T_NS); B.SC = WSP(float, P_TMP + T_SC);
    B.Q = B.AU; B.K = B.AV;
    B.WQT = WSP(bf16_t, P_MLW_T); B.GMW = WSP(bf16_t, P_MLW_T) + 12 * 16384; B.MT = WSP(bf16_t, P_WIFT);
    B.gm_g = p.in[5]; B.gm_b = p.in[6]; B.gm_bs = p.in[8]; B.cw = p.in[9]; B.cb = p.in[10]; B.bif = p.in[15]; B.nw = p.in[16]; B.skip = p.in[17]; return B;
}
__device__ __forceinline__ void ph_scan_conv(PH_ARGS) {
    PH_IDS;
    if (wave < 4) l0_scan(l0_bufs(p), blk, tid);
}
__device__ __forceinline__ void ph_conv_l0(PH_ARGS) {
    PH_IDS; LAS float* scr = (LAS float*)(lds + wave * 8448); const int gw = blk * NWAVE + wave, ngw = G * NWAVE;
    convert_mats(p.in[4], 1024, 2048, 1, 0, WSP(bf16_t, P_WIN_T), 0, RM_IDENT, 1.f, 0, scr, gw, ngw, lane);
    convert_mats(p.in[18], 1024, 1024, 1, 0, WSP(bf16_t, P_WOUT_T), 0, RM_IDENT, 1.f, 0, scr, gw, ngw, lane);
    convert_mats(p.in[11], 128, 128, 4, 16384, WSP(bf16_t, P_MLW_T), 16384, RM_IDENT, 1.f, 0, scr, gw, ngw, lane);
    convert_mats(p.in[12], 128, 128, 4, 16384, WSP(bf16_t, P_MLW_T) + 4 * 16384, 16384, RM_IDENT, 1.f, 0, scr, gw, ngw, lane);
    convert_mats(p.in[13], 128, 128, 4, 16384, WSP(bf16_t, P_MLW_T) + 8 * 16384, 16384, RM_IDENT, 1.f, 0, scr, gw, ngw, lane);
    const int gt = blk * NTHR + tid, ngt = G * NTHR;
    bf16_t* gmw = WSP(bf16_t, P_MLW_T) + 12 * 16384;
    for (int i = gt; i < 4 * 16384; i += ngt) { const int t = (i >> 7) & 127, sidx = i & 127; gmw[i] = f2bf(sidx <= t ? p.in[7][i] : 0.f); }
    bf16_t* mt = WSP(bf16_t, P_WIFT);
    for (int i = gt; i < 4 * 8 * 256; i += ngt) { const int h = i >> 11, g = (i >> 8) & 7, j = i & 255, d = j & 127; float a = 0.f;
        if (j < 128) { for (int e = 0; e < 128; ++e) a += p.in[11][((size_t)h * 128 + d) * 128 + e] * p.in[14][(h * 128 + e) * 8 + g] + p.in[12][((size_t)h * 128 + d) * 128 + e] * p.in[14][(512 + h * 128 + e) * 8 + g]; }
        else { for (int e = 0; e < 128; ++e) a += p.in[13][((size_t)h * 128 + d) * 128 + e] * p.in[14][(1024 + h * 128 + e) * 8 + g]; }
        mt[i] = f2bf(a); }
}
__device__ __forceinline__ void ph_xin_to_bf(PH_ARGS) { PH_IDS; convert_rows(p.in[0], WSP(bf16_t, P_XBF), (size_t)NT * 1024, blk * NTHR + tid, G * NTHR); }
__device__ __forceinline__ void ph_l0_g1(PH_ARGS) {
    __syncthreads();
    if (threadIdx.x == 0) set_job(JT_PTR, 0, WSP(bf16_t, P_XBF), WSP(bf16_t, P_WIN_T), 128, 8, WSP(bf16_t, P_TMP + T_AU), 512, EM_GELU4);
    run_jobs(lds, 1024, 1024, 0, 0, blk, G);
}

enum { K_CONV_XATTN = 0, K_CONV_MOE, K_X2BF, K_XATTN_G1, K_XATTN_ATTN, K_XATTN_G2, K_LN_Y, K_MOE_ROUTE, K_MOE_SCATTER, K_MOE_G1, K_MOE_G2, K_LN_MOE, K_CONV_L1, K_L1_G1, K_L1_SWA, K_L1_G2, K_CONV_L0, K_XIN2BF, K_L0_G1, K_L0_MIXA, K_L0_SCAN, K_L0_MIXC, K_L0_G2, K_LN_Y0 };
template <int PH>
__global__ void __launch_bounds__(NTHR, 2) k_phase(FP p0, int l, int lnidx) {
    const PV p = make_pv(p0);
    extern __shared__ __attribute__((aligned(16))) unsigned char smem[];
    LAS unsigned char* lds = (LAS unsigned char*)smem;
    const int blk = blockIdx.x, G = gridDim.x;
    if constexpr (PH == K_CONV_XATTN) ph_conv_xattn(p, lds, blk, G, l);
    if constexpr (PH == K_CONV_MOE) ph_conv_moe(p, lds, blk, G, l);
    if constexpr (PH == K_X2BF) ph_x_to_bf(p, lds, blk, G);
    if constexpr (PH == K_XATTN_G1) ph_xattn_g1(p, lds, blk, G, l);
    if constexpr (PH == K_XATTN_ATTN) ph_xattn_attn(p, lds, blk, G, l);
    if constexpr (PH == K_XATTN_G2) ph_gemm_plain(p, lds, blk, G, WSP(bf16_t, P_TMP + T_OB), WSP(bf16_t, P_XWO_T) + (size_t)l * 1024 * 1024, WSP(bf16_t, P_TMP + T_YB));
    if constexpr (PH == K_LN_Y) ph_ln<false, false, false>(p, lds, blk, G, WSP(bf16_t, P_TMP + T_YB), lnidx);
    if constexpr (PH == K_MOE_ROUTE) ph_moe_route(p, lds, blk, G, l);
    if constexpr (PH == K_MOE_SCATTER) ph_moe_scatter(p, lds, blk, G);
    if constexpr (PH == K_MOE_G1) ph_moe_g1(p, lds, blk, G);
    if constexpr (PH == K_MOE_G2) ph_moe_g2(p, lds, blk, G);
    if constexpr (PH == K_LN_MOE) ph_ln<false, false, true>(p, lds, blk, G, WSP(bf16_t, P_TMP + T_YG), lnidx);
    if constexpr (PH == K_CONV_L0) ph_conv_l0(p, lds, blk, G);
    if constexpr (PH == K_XIN2BF) ph_xin_to_bf(p, lds, blk, G);
    if constexpr (PH == K_L0_G1) ph_l0_g1(p, lds, blk, G);
    if constexpr (PH == K_L0_MIXA) l0_mixA(lds, l0_bufs(p), blk, G);
    if constexpr (PH == K_L0_SCAN) ph_scan_conv(p, lds, blk, G);
    if constexpr (PH == K_L0_MIXC) l0_mixC(lds, l0_bufs(p), blk, G);
    if constexpr (PH == K_L0_G2) ph_gemm_plain(p, lds, blk, G, WSP(bf16_t, P_TMP + T_YM), WSP(bf16_t, P_WOUT_T), WSP(bf16_t, P_TMP + T_YB0));
    if constexpr (PH == K_LN_Y0) ph_ln<true, false, false>(p, lds, blk, G, WSP(bf16_t, P_TMP + T_YB0), 0);
    if constexpr (PH == K_CONV_L1) ph_conv_l1(p, lds, blk, G);
    if constexpr (PH == K_L1_G1) ph_l1_g1(p, lds, blk, G);
    if constexpr (PH == K_L1_SWA) ph_l1_swa(p, lds, blk, G);
    if constexpr (PH == K_L1_G2) ph_gemm_plain(p, lds, blk, G, WSP(bf16_t, P_TMP + T_OB), WSP(bf16_t, P_WO_T), WSP(bf16_t, P_TMP + T_YB));
}

#define XB_TMO      128
#define XB_XCNT(j)  (256  + 64 * (j))
#define XB_XSUB(j)  (1280 + 64 * (j))
#define XB_XGEN(j)  (2304 + 64 * (j))
#define XB_TOP      3328
#define XB_TOPGEN   3392
#define XCD_BAR_WORDS 3456
#define XB_SPIN_CAP (1u << 22)
__device__ __forceinline__ unsigned xb_ld(unsigned* p)              { return __hip_atomic_load(p, __ATOMIC_RELAXED, __HIP_MEMORY_SCOPE_AGENT); }
__device__ __forceinline__ unsigned xb_add(unsigned* p, unsigned v) { return __hip_atomic_fetch_add(p, v, __ATOMIC_RELAXED, __HIP_MEMORY_SCOPE_AGENT); }
__device__ __forceinline__ unsigned xb_xcc_id() { return (unsigned)__builtin_amdgcn_s_getreg((3 << 11) | 20) & 0xFu; }
#define XB_SPIN(cond, bar) do { unsigned _sp = 0; while (cond) { __builtin_amdgcn_s_sleep(1); \
    if ((++_sp & 255u) == 0u) { if (xb_ld(&(bar)[XB_TMO])) break; if (_sp > XB_SPIN_CAP) { atomicAdd(&(bar)[XB_TMO], 1u); break; } } } } while (0)
struct XcdBarrier { unsigned* bar; unsigned x; volatile LAS unsigned* st; };
__device__ __forceinline__ XcdBarrier xcd_barrier_post(unsigned* bar, volatile LAS unsigned* st) {
    XcdBarrier b; b.bar = bar; b.x = xb_xcc_id(); b.st = st;
    if (threadIdx.x == 0) (void)xb_add(&bar[XB_XCNT(b.x)], 1u);
    return b;
}
__device__ __forceinline__ void xcd_barrier_complete(unsigned* bar, unsigned x, unsigned& nloc, unsigned& nx) {
    const unsigned G = gridDim.x * gridDim.y * gridDim.z;
    unsigned sum, cnt, mine, sp = 0u;
    for (;;) {
        sum = 0u; cnt = 0u; mine = 0u;
#pragma unroll
        for (unsigned j = 0; j < 16; ++j) { const unsigned c = xb_ld(&bar[XB_XCNT(j)]); sum += c; cnt += (c > 0u) ? 1u : 0u; mine = (j == x) ? c : mine; }
        if (sum == G) break;
        __builtin_amdgcn_s_sleep(1);
        if ((++sp & 255u) == 0u) { if (xb_ld(&bar[XB_TMO])) break; if (sp > XB_SPIN_CAP) { atomicAdd(&bar[XB_TMO], 1u); break; } }
    }
    nloc = mine > 0u ? mine : 1u; nx = cnt > 0u ? cnt : 1u;
}
__device__ __forceinline__ void xcd_barrier(const XcdBarrier& b) {
    asm volatile("s_waitcnt vmcnt(0)" ::: "memory");
    __syncthreads();
    if (threadIdx.x == 0) {
        unsigned* bar = b.bar; asm volatile("" : "+s"(bar));
        __builtin_amdgcn_s_waitcnt(0);
        unsigned nloc = b.st[0], nx = b.st[1];
        if (nloc == 0u) { xcd_barrier_complete(bar, b.x, nloc, nx); b.st[0] = nloc; b.st[1] = nx; }
        const unsigned old = xb_add(&bar[XB_XSUB(b.x)], 1u);
        const unsigned gen = old / nloc;
        if (old + 1u == (gen + 1u) * nloc) {
            __builtin_amdgcn_fence(__ATOMIC_RELEASE, "agent");
            asm volatile("s_waitcnt vmcnt(0)" ::: "memory");
            const unsigned og = xb_add(&bar[XB_TOP], 1u);
            const unsigned tg = og / nx;
            if (og + 1u == (tg + 1u) * nx) xb_add(&bar[XB_TOPGEN], 1u);
            else XB_SPIN(xb_ld(&bar[XB_TOPGEN]) == tg, bar);
            __builtin_amdgcn_fence(__ATOMIC_ACQUIRE, "agent");
            xb_add(&bar[XB_XGEN(b.x)], 1u);
            asm volatile("s_waitcnt vmcnt(0)" ::: "memory");
        } else {
            XB_SPIN(xb_ld(&bar[XB_XGEN(b.x)]) == gen, bar);
            __builtin_amdgcn_fence(__ATOMIC_ACQUIRE, "agent");
            asm volatile("s_waitcnt vmcnt(0)" ::: "memory");
        }
    }
    __syncthreads();
}
constexpr size_t P_BAR = P_RT + 1572864;
constexpr int LDS_BARW = LDS_BYTES - 16;

struct SchedAll {
    const LAS pg8::JobDesc* jt; int n0, n1, n2, n3, n4; int K, G, c; int moe; const char* A; const char* B; const int* tstart; const int* src; int nN; size_t bexp;
    __device__ __forceinline__ pg8::Unit get(int i, bool& ok) const {
        const char* ua = nullptr; const char* ub = nullptr; const int* us = nullptr; int upm = 0, upn = 0, ujob = 0; bool good = false;
        if (moe) {
            const int vc = (c & 7) * (G >> 3) + (c >> 3);
            const long L = (long)i * G + vc; const int ntile = tstart[32];
            if (L < (long)ntile * nN) {
                const int mt = (int)(L / nN), nt = (int)(L % nN);
                int e = 0;
                for (int k = 1; k < 32; ++k) if (tstart[k] <= mt) e = k;
                ua = src ? A : A + (size_t)mt * 256 * K * 2; us = src ? src + mt * 256 : nullptr; ub = B + (size_t)e * bexp + (size_t)nt * 256 * K * 2; upm = mt; upn = nt; good = true;
            }
        } else {
            long L = (long)i * G + c;
            if (L < (long)n0 + n1 + n2 + n3 + n4) {
                int l = (int)L; int jb = 0;
                if (l >= n0) { l -= n0; jb = 1; if (l >= n1) { l -= n1; jb = 2; if (l >= n2) { l -= n2; jb = 3; if (l >= n3) { l -= n3; jb = 4; } } } }
                const int jM = __builtin_amdgcn_readfirstlane(jt[jb].nM), jN = __builtin_amdgcn_readfirstlane(jt[jb].nN);
                int pm, pn; pg8::tile_order(l, jM, jN, pm, pn);
                const size_t tstep = (size_t)pg8::BM * K * 2;
                ua = (const char*)pg8::rfl64(jt[jb].A) + (size_t)pm * tstep; ub = (const char*)pg8::rfl64(jt[jb].B) + (size_t)pn * tstep; upm = pm; upn = pn; ujob = jb; good = true;
            }
        }
        pg8::Unit u; u.A = ua; u.B = ub; u.src = us; u.pm = upm; u.pn = upn; u.job = ujob; ok = good; return u;
    }
};
enum { MP_CONV = 0, MP_L0_G1, MP_L0_MIXA, MP_L0_SCAN, MP_L0_MIXC, MP_L0_G2, MP_XA_G1, MP_XA_ATTN, MP_XA_G2, MP_ROUTE, MP_SCATTER, MP_MOE_G1, MP_MOE_G2, MP_LN_MOE, MP_L1_G1, MP_L1_SWA, MP_L1_G2 };
struct SchedLN {
    const char* A; const char* B; int G, c;
    __device__ __forceinline__ pg8::Unit get(int i, bool& ok) const {
        const int L = i * G + c; const bool good = L < 512; int pm = 0, pn = 0; if (good) pg8::tile_order(L, 128, 4, pm, pn);
        const size_t tstep = (size_t)pg8::BM * 1024 * 2;
        pg8::Unit u; u.A = A + (size_t)pm * tstep; u.B = B + (size_t)pn * tstep; u.src = nullptr; u.pm = pm; u.pn = pn; u.job = 0; ok = good; return u;
    }
};
__device__ __forceinline__ int prog_kind(int i) {
    switch (i) { case 0: return MP_CONV; case 1: return MP_L0_G1; case 2: return MP_L0_MIXA; case 3: return MP_L0_SCAN; case 4: return MP_L0_MIXC; case 5: return MP_L0_G2;
        case 6: case 17: return MP_XA_G1; case 7: case 18: return MP_XA_ATTN; case 8: case 19: return MP_XA_G2; case 9: case 20: return MP_ROUTE; case 10: case 21: return MP_SCATTER;
        case 11: case 22: return MP_MOE_G1; case 12: case 23: return MP_MOE_G2; case 13: case 24: return MP_LN_MOE; case 14: return MP_L1_G1; case 15: return MP_L1_SWA; default: return MP_L1_G2; }
}
constexpr int N_PROG = 25;
__global__ void __launch_bounds__(NTHR, 2) mega(FP p0) {
    extern __shared__ __attribute__((aligned(16))) unsigned char smem[];
    LAS unsigned char* lds = (LAS unsigned char*)smem;
    cooperative_groups::grid_group grid = cooperative_groups::this_grid();
    const int blk0 = blockIdx.x, G0 = gridDim.x;
    volatile LAS unsigned* bst = (volatile LAS unsigned*)(lds + LDS_BARW);
    if (threadIdx.x == 0) { bst[0] = 0u; bst[1] = 0u; }
    __syncthreads();
    const XcdBarrier xbar = xcd_barrier_post((unsigned*)(p0.ws + P_BAR), bst);
    int dup = 0; (void)dup;
#pragma unroll 1
    for (int pi = 0; pi < N_PROG; ++pi) {
        int blk = blk0, G = G0; asm volatile("" : "+s"(blk), "+s"(G));
        const PV p = make_pv(p0);
        const int kind = prog_kind(pi), l = pi >= 14 ? 1 : 0;
        const bool is_gemm = kind == MP_L0_G1 || kind == MP_XA_G1 || kind == MP_MOE_G1 || kind == MP_MOE_G2 || kind == MP_L1_G1;
        const bool is_lnf = kind == MP_L0_G2 || kind == MP_XA_G2 || kind == MP_L1_G2;
        if (is_lnf) {
            const int site = kind == MP_L0_G2 ? 0 : (kind == MP_L1_G2 ? 2 : 1 + 2 * l), lnidx = kind == MP_L0_G2 ? 0 : (kind == MP_L1_G2 ? 3 : 1 + 3 * l);
            SchedLN S; S.G = G; S.c = blk;
            S.A = (const char*)(kind == MP_L0_G2 ? WSP(bf16_t, P_TMP + T_YM) : WSP(bf16_t, P_TMP + T_OB));
            S.B = (const char*)(kind == MP_L0_G2 ? WSP(bf16_t, P_WOUT_T) : (kind == MP_L1_G2 ? WSP(bf16_t, P_WO_T) : WSP(bf16_t, P_XWO_T) + (size_t)l * 1024 * 1024));
            __syncthreads();
            if (threadIdx.x == 0) set_job(JT_PTR, 0, nullptr, nullptr, 128, 4, WSP(bf16_t, P_XBF), 1024, 0, p.in[2] + lnidx * 1024, p.in[3] + lnidx * 1024, WSP(unsigned long long, P_TMP + T_SLOT) + (size_t)site * 131072);
            EpiLN E; E.lds = lds;
            __syncthreads();
            pg8::gemm_phase<EpiLN, SchedLN, true, true>(lds, 1024, S, E);
        } else if (is_gemm) {
            SchedAll S; S.jt = JT_PTR; S.n0 = S.n1 = S.n2 = S.n3 = S.n4 = 0; S.K = 1024; S.G = G; S.c = blk; S.moe = 0; S.A = S.B = nullptr; S.tstart = WSP(int, P_RT + RT_TSTART); S.src = nullptr; S.nN = 4; S.bexp = 0;
            __syncthreads();
            if (threadIdx.x == 0) {
                if (kind == MP_L0_G1) set_job(JT_PTR, 0, WSP(bf16_t, P_XBF), WSP(bf16_t, P_WIN_T), 128, 8, WSP(bf16_t, P_TMP + T_AU), 512, EM_GELU4);
                if (kind == MP_XA_G1) {
                    set_job(JT_PTR, 0, WSP(bf16_t, P_XBF), WSP(bf16_t, P_XWQ_T) + (size_t)l * 1024 * 1024, 128, 4, WSP(bf16_t, P_TMP + T_QX), 1024, EM_PLAIN);
                    if (l == 0) { for (int ll = 0; ll < 2; ++ll) { const bf16_t* wkv = WSP(bf16_t, P_XWKV_T) + (size_t)ll * 2048 * 1024;
                        set_job(JT_PTR, 1 + 2 * ll, WSP(bf16_t, P_MEMB), wkv, 8, 4, WSP(bf16_t, P_KC) + (size_t)ll * 2048 * 1024, 1024, EM_PLAIN);
                        set_job(JT_PTR, 2 + 2 * ll, wkv + (size_t)1024 * 1024, WSP(bf16_t, P_MEMB), 4, 8, WSP(bf16_t, P_VT) + (size_t)ll * 1024 * 2048, 2048, EM_PLAIN); } } }
                if (kind == MP_MOE_G1) set_job(JT_PTR, 0, nullptr, nullptr, 0, 0, WSP(bf16_t, P_TMP + T_HM), 512, EM_SWIGLU);
                if (kind == MP_MOE_G2) set_job(JT_PTR, 0, nullptr, nullptr, 0, 0, WSP(bf16_t, P_TMP + T_YG), 1024, EM_PLAIN);
                if (kind == MP_L1_G1) { set_job(JT_PTR, 0, WSP(bf16_t, P_XBF), WSP(bf16_t, P_WQKV_T), 128, 5, WSP(bf16_t, P_TMP + T_QX), 1024, EM_ROTARY, WSP(float, P_BQK), WSP(float, P_ROT), WSP(bf16_t, P_TMP + T_K1));
                    set_job(JT_PTR, 1, WSP(bf16_t, P_WQKV_T) + (size_t)1280 * 1024, WSP(bf16_t, P_XBF), 1, 128, WSP(bf16_t, P_TMP + T_VT1), NT, EM_ROWBIAS, p.in[20] + 1280); }
            }
            if (kind == MP_L0_G1) S.n0 = 1024;
            if (kind == MP_XA_G1) { S.n0 = 512; if (l == 0) { S.n1 = 32; S.n2 = 32; S.n3 = 32; S.n4 = 32; } }
            if (kind == MP_L1_G1) { S.n0 = 640; S.n1 = 128; }
            if (kind == MP_MOE_G1) { S.moe = 1; S.A = (const char*)WSP(bf16_t, P_XBF); S.src = WSP(int, P_RT + RT_SRC); S.B = (const char*)WSP(bf16_t, P_W13T); S.bexp = (size_t)1024 * 1024 * 2; }
            if (kind == MP_MOE_G2) { S.moe = 1; S.K = 512; S.A = (const char*)WSP(bf16_t, P_TMP + T_HM); S.B = (const char*)WSP(bf16_t, P_W2T); S.bexp = (size_t)1024 * 512 * 2; }
            __syncthreads();
            EpiMulti E; E.jt = JT_PTR;
#ifdef PROBE_GEMM2
#pragma unroll 1
            for (int rep = 0; rep < 2; ++rep)
#endif
            pg8::gemm_phase<EpiMulti, SchedAll, true, true>(lds, S.K, S, E);
        } else {
#ifdef PROBE_MASK
#define DRY (dup == 0 && (((PROBE_MASK) >> kind) & 1))
#else
#define DRY false
#endif
            switch (kind) {
                case MP_CONV: ph_conv_l0(p, lds, blk, G); ph_conv_l1(p, lds, blk, G); ph_conv_xattn(p, lds, blk, G, 0); ph_conv_xattn(p, lds, blk, G, 1); ph_conv_moe(p, lds, blk, G, 0); ph_xin_to_bf(p, lds, blk, G); break;
                case MP_L0_MIXA: l0_mixA(lds, l0_bufs(p), blk, G); break;
                case MP_L0_SCAN: ph_scan_conv(p, lds, blk, G); break;
                case MP_L0_MIXC: l0_mixC(lds, l0_bufs(p), blk, G); break;
                case MP_XA_ATTN: ph_xattn_attn(p, lds, blk, G, l); break;
                case MP_ROUTE: ph_moe_route(p, lds, blk, G, l); break;
                case MP_SCATTER: ph_moe_scatter(p, lds, blk, G); break;
                case MP_LN_MOE: if (l == 0) { ph_ln<false, false, true>(p, lds, blk, G, WSP(bf16_t, P_TMP + T_YG), 2, DRY); if (!(DRY)) ph_conv_moe(p, lds, blk, G, 1); } else ph_ln<false, true, true>(p, lds, blk, G, WSP(bf16_t, P_TMP + T_YG), 5, DRY); break;
                default: ph_l1_swa(p, lds, blk, G); break;
            }
        }
#ifdef PROBE_MASK
        if (((PROBE_MASK) >> kind) & 1) { if (dup == 0) { dup = 1; xcd_barrier(xbar); --pi; continue; } dup = 0; }
#endif
        if (pi + 1 < N_PROG) { if (p0.ws == nullptr) grid.sync(); else { xcd_barrier(xbar);
#ifdef PROBE_BAR2
            xcd_barrier(xbar);
#endif
        } }
    }
}
}
extern "C" void kernel_launch(void* const* d_in, const int* in_sizes, int n_in, void* d_out, int out_size, void* d_ws, size_t ws_size, hipStream_t stream) {
    static int ok = 0;
    if (ok == 0) {
        ok = -1;
        if (n_in != 33 || out_size != 32768 * 1024 || ws_size < fk::FAST_END + (fk::SLOT_MB - 4) * fk::MB) { fprintf(stderr, "kernel_launch: unexpected shapes/ws (%d, %d, %zu)\n", n_in, out_size, ws_size); return; }
        int dev = 0, cus = 0, per_cu = 0;
        if (hipGetDevice(&dev) != hipSuccess || hipDeviceGetAttribute(&cus, hipDeviceAttributeMultiprocessorCount, dev) != hipSuccess) return;
        if (hipFuncSetAttribute((const void*)fk::mega, hipFuncAttributeMaxDynamicSharedMemorySize, fk::LDS_BYTES) != hipSuccess) return;
        if (hipOccupancyMaxActiveBlocksPerMultiprocessor(&per_cu, (const void*)fk::mega, fk::NTHR, fk::LDS_BYTES) != hipSuccess || per_cu < 1 || cus * per_cu < 256) { fprintf(stderr, "kernel_launch: cannot co-reside 256 workgroups (%d CUs x %d)\n", cus, per_cu); return; }
        ok = 1;
    }
    if (ok < 0) return;
    fk::FP p{}; for (int i = 0; i < 33; ++i) p.in[i] = (const float*)d_in[i]; p.X = (float*)d_out; p.ws = (unsigned char*)d_ws;
    if (hipMemsetAsync((char*)d_ws + fk::P_BAR, 0, 16384, stream) != hipSuccess) return;
    if (hipMemsetAsync((char*)d_ws + fk::P_TMP + fk::T_SLOT, 0xFF, fk::SLOT_MB * fk::MB, stream) != hipSuccess) return;
    void* args[] = {&p};
    hipError_t e = hipLaunchCooperativeKernel((const void*)fk::mega, dim3(256), dim3(fk::NTHR), args, fk::LDS_BYTES, stream);
    if (e != hipSuccess) fprintf(stderr, "cooperative launch failed: %s\n", hipGetErrorString(e));
}
```

```cpp
#include <hip/hip_runtime.h>
#include <hip/hip_cooperative_groups.h>
#include <cstdio>
#include <cstdint>
#include <cmath>
namespace fk {
#define LAS __attribute__((address_space(3)))
typedef unsigned short bf16_t;
typedef short bf16x8 __attribute__((ext_vector_type(8)));
typedef short s16x4 __attribute__((ext_vector_type(4)));
typedef float f32x4 __attribute__((ext_vector_type(4)));
typedef float f32x16 __attribute__((ext_vector_type(16)));
typedef float f32x2 __attribute__((ext_vector_type(2)));
typedef unsigned u32x4 __attribute__((ext_vector_type(4)));
typedef unsigned u32x2 __attribute__((ext_vector_type(2)));
typedef __bf16 bf16x2_t __attribute__((ext_vector_type(2)));

constexpr int NT = 32768, DM = 1024, SEQ = 4096;
constexpr int NTHR = 512, NWAVE = 8;
constexpr float ALPHA = 1.4142135623730951f, LN_EPS = 1e-5f, LOG2E = 1.4426950408889634f;

__device__ __forceinline__ unsigned pk2(float lo, float hi) { f32x2 v = {lo, hi}; bf16x2_t b = __builtin_convertvector(v, bf16x2_t); return __builtin_bit_cast(unsigned, b); }
__device__ __forceinline__ float bf_lo(unsigned w) { return __uint_as_float(w << 16); }
__device__ __forceinline__ float bf_hi(unsigned w) { return __uint_as_float(w & 0xffff0000u); }
__device__ __forceinline__ float bf2f(bf16_t b) { return __uint_as_float(((unsigned)b) << 16); }
__device__ __forceinline__ bf16_t f2bf(float f) { return (bf16_t)(pk2(f, 0.f) & 0xffffu); }
__device__ __forceinline__ float fast_exp(float x) { return __builtin_amdgcn_exp2f(x * LOG2E); }
__device__ __forceinline__ float sigmoid_f(float x) { return __builtin_amdgcn_rcpf(1.f + fast_exp(-x)); }
__device__ __forceinline__ float silu_f(float x) { return x * sigmoid_f(x); }
__device__ __forceinline__ float gelu_tanh_f(float x) { const float u = 1.5957691216057308f * (x + 0.044715f * x * x * x); return x * sigmoid_f(u); }
__device__ __forceinline__ int crow(int r, int hi) { return (r & 3) + 8 * (r >> 2) + 4 * hi; }
__device__ __forceinline__ float xhalf_sum(float v) { auto rr = __builtin_amdgcn_permlane32_swap(__float_as_uint(v), __float_as_uint(v), false, false); return __uint_as_float(rr[0]) + __uint_as_float(rr[1]); }
__device__ __forceinline__ float xhalf_max(float v) { auto rr = __builtin_amdgcn_permlane32_swap(__float_as_uint(v), __float_as_uint(v), false, false); return fmaxf(__uint_as_float(rr[0]), __uint_as_float(rr[1])); }
__device__ __forceinline__ float shx(float v, int o, int lane) { return __int_as_float(__builtin_amdgcn_ds_bpermute((lane ^ o) << 2, __float_as_int(v))); }
__device__ __forceinline__ float shup(float v, int o, int lane) { return __int_as_float(__builtin_amdgcn_ds_bpermute(((lane - o) & 63) << 2, __float_as_int(v))); }
__device__ __forceinline__ float shidx(float v, int idx) { return __int_as_float(__builtin_amdgcn_ds_bpermute(idx << 2, __float_as_int(v))); }
__device__ __forceinline__ s16x4 lds_tr(const LAS void* p) { return __builtin_bit_cast(s16x4, __builtin_amdgcn_ds_read_tr16_b64_v4i16((LAS s16x4*)p)); }
#define MFMA32(a, b, c) __builtin_amdgcn_mfma_f32_32x32x16_bf16((a), (b), (c), 0, 0, 0)

namespace pg8 {
constexpr int BM = 256, BK = 64, HALF = 128, HTB = HALF * BK * 2, STAGE_BYTES = 8 * HTB, NXCD = 8, WGM = 8;
__host__ __device__ __forceinline__ int lds_byte(int r, int c) { const int st = (r >> 4) * 2 + (c >> 5), rr = r & 15, cc = c & 31, ob = rr * 64 + cc * 2; return st * 1024 + (ob ^ (((ob >> 9) & 1) << 5)); }
__host__ __device__ __forceinline__ void stage_rc(int b, int& R, int& C) { const int st = b / 1024, sb = b % 1024, swz = sb ^ (((sb >> 9) & 1) << 5); R = (st >> 1) * 16 + swz / 64; C = (st & 1) * 32 + (swz % 64) / 2; }
__host__ __device__ __forceinline__ int perm32(int rho) { const int n = rho >> 4, i = rho & 15; return 8 * (i >> 2) + 4 * n + (i & 3); }

struct Unit { const char* A; const char* B; const int* src; int pm, pn, job; };

__device__ __forceinline__ void tile_order(int l, int nM, int nN, int& pm, int& pn) {
    const int nwg = nM * nN; int wgid = l;
    { const int q = nwg / NXCD, r = nwg % NXCD, xcd = wgid % NXCD, off = wgid / NXCD; wgid = (xcd < r ? xcd * (q + 1) : r * (q + 1) + (xcd - r) * q) + off; }
    const int nig = WGM * nN, gid = wgid / nig, fm = gid * WGM, gsz = (nM - fm) < WGM ? (nM - fm) : WGM;
    pm = fm + ((wgid % nig) % gsz); pn = (wgid % nig) / gsz;
}
struct JobDesc { unsigned long long A, B, out, bias, rot, out2; int nM, nN, ldc, mode; };
__device__ __forceinline__ unsigned long long rfl64(unsigned long long v) { const unsigned lo = __builtin_amdgcn_readfirstlane((unsigned)v), hi = __builtin_amdgcn_readfirstlane((unsigned)(v >> 32)); return ((unsigned long long)hi << 32) | lo; }
constexpr int JT_OFF = STAGE_BYTES;
struct Jobs3 {
    const LAS JobDesc* jt; int n0, n1, n2; int K, G, c;
    __device__ __forceinline__ Unit get(int i, bool& ok) const { Unit u; u.A = nullptr; u.B = nullptr; u.src = nullptr; u.pm = 0; u.pn = 0; u.job = 0; ok = next(i, u); return u; }
    __device__ __forceinline__ bool next(int i, Unit& u) const {
        long L = (long)i * G + c;
        if (L >= (long)n0 + n1 + n2) return false;
        int l = (int)L; int jb = 0;
        if (l >= n0) { l -= n0; jb = 1; if (l >= n1) { l -= n1; jb = 2; } }
        const int jM = __builtin_amdgcn_readfirstlane(jt[jb].nM), jN = __builtin_amdgcn_readfirstlane(jt[jb].nN);
        int pm, pn; tile_order(l, jM, jN, pm, pn);
        const size_t tstep = (size_t)BM * K * 2;
        u.A = (const char*)rfl64(jt[jb].A) + (size_t)pm * tstep; u.B = (const char*)rfl64(jt[jb].B) + (size_t)pn * tstep; u.src = nullptr; u.pm = pm; u.pn = pn; u.job = jb; return true;
    }
};

template <class Epi, class Sched, bool ALIGN_EPI, bool SP2>
__device__ __forceinline__ void gemm_phase(LAS unsigned char* lds, const int K, const Sched& S, const Epi& E) {
    int tid_ = threadIdx.x; asm volatile("" : "+v"(tid_)); const int tid = tid_, wid = __builtin_amdgcn_readfirstlane(tid >> 6), lane = tid & 63, wr = wid >> 2, wc = wid & 3, fr = lane & 15, fq = lane >> 4;
    const int nt = K / BK;
    static_assert(SP2, "only the two-super-phase form is kept");
    unsigned vA0[2], vA1[2], vB0[2];
#pragma unroll
    for (int i = 0; i < 2; ++i) { int R, C; stage_rc(tid * 16 + i * 8192, R, C); const int Rb = 64 * (R >> 5) + perm32(R & 31); vB0[i] = (unsigned)(Rb * K + C) * 2u; }
    const size_t bhalf = (size_t)32 * K * 2;
    auto a_rows = [&](const int* src, unsigned (&o0)[2], unsigned (&o1)[2]) {
        int tq = threadIdx.x; asm volatile("" : "+v"(tq));
#pragma unroll
        for (int i = 0; i < 2; ++i) { int R, C; stage_rc(tq * 16 + i * 8192, R, C); int r0 = R, r1 = R + HALF; if (src) { r0 = src[R]; r1 = src[R + HALF]; }
            o0[i] = (unsigned)(r0 * K + C) * 2u; o1[i] = (unsigned)(r1 * K + C) * 2u; }
    };
    const size_t kstep = (size_t)(BK * 2);
    const size_t hstep = (size_t)HALF * K * 2;
    const unsigned ldsw = (unsigned)wid * 1024u;
    const int aoff = lds_byte(wr * 64 + fr, fq * 8), boff = lds_byte(wc * 32 + fr, fq * 8);
#define PG8_SA(b, h) (((b) * 2 + (h)) * HTB)
#define PG8_SB(b, h) ((4 + (b) * 2 + (h)) * HTB)
#define PG8_STAGE(bufoff, gbase, voff) do { _Pragma("unroll") for (int _i = 0; _i < 2; ++_i) \
        __builtin_amdgcn_global_load_lds((const unsigned*)((const char*)(gbase) + (voff)[_i]), (LAS unsigned*)(lds + (bufoff) + ldsw + _i * 8192), 16, 0, 0); } while (0)
#define PG8_LDA(dst, b, h) do { _Pragma("unroll") for (int m = 0; m < 4; ++m) _Pragma("unroll") for (int k = 0; k < 2; ++k) dst[m][k] = *(const LAS bf16x8*)(lds + PG8_SA(b, h) + aoff + m * 2048 + k * 1024); } while (0)
#define PG8_LDB(dst, b, h) do { _Pragma("unroll") for (int n = 0; n < 2; ++n) _Pragma("unroll") for (int k = 0; k < 2; ++k) dst[n][k] = *(const LAS bf16x8*)(lds + PG8_SB(b, h) + boff + n * 2048 + k * 1024); } while (0)
#define PG8_MMA(ai, bj, At, Bt) do { __builtin_amdgcn_s_setprio(1); _Pragma("unroll") for (int m = 0; m < 4; ++m) _Pragma("unroll") for (int n = 0; n < 2; ++n) _Pragma("unroll") for (int k = 0; k < 2; ++k) \
        acc[ai][bj][m][n] = __builtin_amdgcn_mfma_f32_16x16x32_bf16(Bt[n][k], At[m][k], acc[ai][bj][m][n], 0, 0, 0); __builtin_amdgcn_s_setprio(0); } while (0)
#define PG8_WAIT_V(n) asm volatile("s_waitcnt vmcnt(" #n ")" ::: "memory")
#define PG8_WAIT_L(n) asm volatile("s_waitcnt lgkmcnt(" #n ")" ::: "memory")
#define PG8_BAR __builtin_amdgcn_s_barrier()
#define PG8_SCHED __builtin_amdgcn_sched_barrier(0)
    auto unif = [](Unit u) { Unit r; r.A = (const char*)rfl64((unsigned long long)u.A); r.B = (const char*)rfl64((unsigned long long)u.B); r.src = (const int*)rfl64((unsigned long long)u.src);
        r.pm = __builtin_amdgcn_readfirstlane(u.pm); r.pn = __builtin_amdgcn_readfirstlane(u.pn); r.job = __builtin_amdgcn_readfirstlane(u.job); return r; };
    int ui = 0; bool ok0; Unit cur = unif(S.get(0, ok0));
    if (!ok0) return;
    f32x4 acc[2][2][4][2];
    E.prefetch(cur, wr, wc, fr, fq);
    bf16x8 At[4][2], B0[2][2], B1[2][2];
    const char* cA = cur.A; const char* cB = cur.B;
    a_rows(cur.src, vA0, vA1);
    {
        PG8_STAGE(PG8_SB(0, 0), cB, vB0); PG8_STAGE(PG8_SB(0, 1), cB + bhalf, vB0); PG8_STAGE(PG8_SA(0, 0), cA, vA0); PG8_STAGE(PG8_SA(0, 1), cA, vA1);
        if (wr == 1) PG8_BAR;
        PG8_WAIT_V(2); PG8_BAR;
        PG8_STAGE(PG8_SB(1, 0), cB + kstep, vB0); PG8_STAGE(PG8_SA(1, 0), cA + kstep, vA0); PG8_STAGE(PG8_SB(1, 1), cB + kstep + bhalf, vB0);
        PG8_WAIT_V(6); PG8_BAR;
    }
    for (;;) {
        E.init(acc);
        bool has_next; const Unit nxt = unif(S.get(ui + 1, has_next)); bool early_done = false;
        const char* nA = has_next ? nxt.A : cA; const char* nB = has_next ? nxt.B : cB;
        for (int t = 0; t < nt; t += 2) {
            const bool last = (t == nt - 2);
            const char* a1 = cA + (size_t)(t + 1) * kstep;
            const char* a2 = last ? nA : cA + (size_t)(t + 2) * kstep; const char* b2 = last ? nB : cB + (size_t)(t + 2) * kstep;
            const char* a3 = a2 + kstep; const char* b3 = b2 + kstep;
            PG8_LDB(B0, 0, 0); PG8_LDB(B1, 0, 1); PG8_SCHED; PG8_LDA(At, 0, 0); PG8_STAGE(PG8_SA(1, 1), a1, vA1);
            if (last && has_next) a_rows(nxt.src, vA0, vA1);
            PG8_WAIT_V(8); PG8_WAIT_L(0); PG8_BAR; PG8_MMA(0, 0, At, B0); PG8_MMA(0, 1, At, B1); PG8_BAR; PG8_SCHED;
            PG8_LDA(At, 0, 1); PG8_STAGE(PG8_SB(0, 0), b2, vB0); PG8_STAGE(PG8_SB(0, 1), b2 + bhalf, vB0); PG8_STAGE(PG8_SA(0, 0), a2, vA0);
            PG8_WAIT_V(8); PG8_WAIT_L(0); PG8_BAR; PG8_MMA(1, 0, At, B0); PG8_MMA(1, 1, At, B1); PG8_BAR; PG8_SCHED;
            PG8_LDB(B0, 1, 0); PG8_LDB(B1, 1, 1); PG8_SCHED; PG8_LDA(At, 1, 0); PG8_STAGE(PG8_SA(0, 1), a2, vA1);
            PG8_WAIT_V(8); PG8_WAIT_L(0); PG8_BAR; PG8_MMA(0, 0, At, B0); PG8_MMA(0, 1, At, B1); PG8_BAR; PG8_SCHED;
            if (last) { early_done = E.early(acc, cur, wr, wc, fr, fq); PG8_SCHED; }
            PG8_LDA(At, 1, 1); PG8_STAGE(PG8_SB(1, 0), b3, vB0); PG8_STAGE(PG8_SB(1, 1), b3 + bhalf, vB0); PG8_STAGE(PG8_SA(1, 0), a3, vA0);
            PG8_WAIT_V(8); PG8_WAIT_L(0); PG8_BAR; PG8_MMA(1, 0, At, B0); PG8_MMA(1, 1, At, B1); PG8_BAR; PG8_SCHED;
        }
        if constexpr (ALIGN_EPI) { if (wr == 0) PG8_BAR; }
        E.prefetch(nxt, wr, wc, fr, fq);
        if (!early_done) E.template half<0>(acc, cur, wr, wc, fr, fq);
        E.template half<1>(acc, cur, wr, wc, fr, fq);
        if (!has_next) break;
        cur = nxt; cA = nA; cB = nB; ++ui;
        if constexpr (ALIGN_EPI) { if (wr == 1) PG8_BAR; }
    }
    PG8_WAIT_V(0);
    if constexpr (!ALIGN_EPI) { if (wr == 0) PG8_BAR; }
    PG8_BAR;
#undef PG8_SA
#undef PG8_SB
#undef PG8_STAGE
#undef PG8_LDA
#undef PG8_LDB
#undef PG8_MMA
#undef PG8_WAIT_V
#undef PG8_WAIT_L
#undef PG8_BAR
#undef PG8_SCHED
}
}
enum { EM_PLAIN = 0, EM_GELU4 = 1, EM_SWIGLU = 2, EM_ROTARY = 3, EM_ROWBIAS = 4 };
struct EpiMulti {
    static constexpr bool PERM = true;
    const LAS pg8::JobDesc* jt;
    __device__ __forceinline__ void prefetch(const pg8::Unit&, int, int, int, int) const {}
    __device__ __forceinline__ void init(f32x4 (&acc)[2][2][4][2]) const {
#pragma unroll
        for (int a = 0; a < 2; ++a)
#pragma unroll
            for (int b = 0; b < 2; ++b)
#pragma unroll
                for (int m = 0; m < 4; ++m)
#pragma unroll
                    for (int n = 0; n < 2; ++n) acc[a][b][m][n] = (f32x4){0.f, 0.f, 0.f, 0.f};
    }
    __device__ __forceinline__ bool early(const f32x4 (&acc)[2][2][4][2], const pg8::Unit& u, int wr, int wc, int fr, int fq) const {
        const LAS pg8::JobDesc* jd = jt + u.job;
        if (__builtin_amdgcn_readfirstlane(jd->mode) != EM_PLAIN) return false;
        bf16_t* out = (bf16_t*)pg8::rfl64(jd->out); const int ldc = __builtin_amdgcn_readfirstlane(jd->ldc);
        bf16_t* rowp = out + (size_t)(u.pm * 256 + wr * 64 + fr) * ldc + u.pn * 256 + wc * 64 + 8 * fq;
#pragma unroll
        for (int m = 0; m < 4; ++m)
#pragma unroll
            for (int bj = 0; bj < 2; ++bj) { const f32x4 v0 = acc[0][bj][m][0], v1 = acc[0][bj][m][1];
                u32x4 w; w.x = pk2(v0[0], v0[1]); w.y = pk2(v0[2], v0[3]); w.z = pk2(v1[0], v1[1]); w.w = pk2(v1[2], v1[3]);
                *(u32x4*)(rowp + (size_t)m * 16 * ldc + bj * 32) = w; }
        return true;
    }
    template <int AI>
    __device__ __forceinline__ void half(const f32x4 (&acc)[2][2][4][2], const pg8::Unit& u, int wr, int wc, int fr, int fq) const {
        const LAS pg8::JobDesc* jd = jt + u.job;
        bf16_t* out = (bf16_t*)pg8::rfl64(jd->out);
        const int ldc = __builtin_amdgcn_readfirstlane(jd->ldc);
        const int mode = __builtin_amdgcn_readfirstlane(jd->mode);
        const float* bias = (const float*)pg8::rfl64(jd->bias);
        const int row0 = u.pm * 256 + wr * 64 + fr;
        const int colt = u.pn * 256 + wc * 64 + 8 * fq;
        if (mode == EM_PLAIN || mode == EM_ROWBIAS) {
#pragma unroll
            for (int ai = AI; ai < AI + 1; ++ai)
#pragma unroll
                for (int m = 0; m < 4; ++m) { const int row = row0 + ai * 128 + m * 16; const float rb = (mode == EM_ROWBIAS && bias) ? bias[row] : 0.f;
                    bf16_t* rowp = out + (size_t)row * ldc + colt;
#pragma unroll
                    for (int bj = 0; bj < 2; ++bj) { const f32x4 v0 = acc[ai][bj][m][0] + rb, v1 = acc[ai][bj][m][1] + rb;
                        u32x4 w; w.x = pk2(v0[0], v0[1]); w.y = pk2(v0[2], v0[3]); w.z = pk2(v1[0], v1[1]); w.w = pk2(v1[2], v1[3]);
                        *(u32x4*)(rowp + bj * 32) = w; } }
        } else if (mode == EM_GELU4) {
            const int arr = u.pn >> 1; bf16_t* base = out + (size_t)arr * NT * 512; const int col = colt - arr * 512; const bool act = arr < 2;
#pragma unroll
            for (int ai = AI; ai < AI + 1; ++ai)
#pragma unroll
                for (int m = 0; m < 4; ++m) { bf16_t* rowp = base + (size_t)(row0 + ai * 128 + m * 16) * 512 + col;
#pragma unroll
                    for (int bj = 0; bj < 2; ++bj) { f32x4 v0 = acc[ai][bj][m][0], v1 = acc[ai][bj][m][1];
                        if (act) {
#pragma unroll
                            for (int e = 0; e < 4; ++e) { v0[e] = gelu_tanh_f(v0[e]); v1[e] = gelu_tanh_f(v1[e]); } }
                        u32x4 w; w.x = pk2(v0[0], v0[1]); w.y = pk2(v0[2], v0[3]); w.z = pk2(v1[0], v1[1]); w.w = pk2(v1[2], v1[3]);
                        *(u32x4*)(rowp + bj * 32) = w; } }
        } else if (mode == EM_SWIGLU) {
#pragma unroll
            for (int ai = AI; ai < AI + 1; ++ai)
#pragma unroll
                for (int m = 0; m < 4; ++m) { bf16_t* rowp = out + (size_t)(row0 + ai * 128 + m * 16) * ldc + (colt >> 1);
#pragma unroll
                    for (int bj = 0; bj < 2; ++bj) { const f32x4 v0 = acc[ai][bj][m][0], v1 = acc[ai][bj][m][1];
                        u32x2 w; w.x = pk2(silu_f(v0[0]) * v0[1], silu_f(v0[2]) * v0[3]); w.y = pk2(silu_f(v1[0]) * v1[1], silu_f(v1[2]) * v1[3]);
                        *(u32x2*)(rowp + bj * 16) = w; } }
        } else {
            const float* rot = (const float*)pg8::rfl64(jd->rot);
            bf16_t* out2 = (bf16_t*)pg8::rfl64(jd->out2);
            const bool isk = u.pn >= 4; bf16_t* base = isk ? out2 : out; const int ld = isk ? 256 : 1024; const int colo = isk ? colt - 1024 : colt;
            float bv[2][8];
#pragma unroll
            for (int bj = 0; bj < 2; ++bj)
#pragma unroll
                for (int e = 0; e < 8; ++e) bv[bj][e] = bias ? bias[colt + bj * 32 + e] : 0.f;
            const int i0 = (colt & 63) >> 1;
#pragma unroll
            for (int ai = AI; ai < AI + 1; ++ai)
#pragma unroll
                for (int m = 0; m < 4; ++m) { const int row = row0 + ai * 128 + m * 16; const int pos = row & (SEQ - 1);
                    bf16_t* rowp = base + (size_t)row * ld + colo;
#pragma unroll
                    for (int bj = 0; bj < 2; ++bj) { f32x4 v0 = acc[ai][bj][m][0], v1 = acc[ai][bj][m][1];
                        const f32x4 cs0 = *(const f32x4*)(rot + ((size_t)pos * 32 + i0 + 16 * bj) * 2), cs1 = *(const f32x4*)(rot + ((size_t)pos * 32 + i0 + 16 * bj + 2) * 2);
#pragma unroll
                        for (int e = 0; e < 4; ++e) { v0[e] += bv[bj][e]; v1[e] += bv[bj][4 + e]; }
                        const float a0 = v0[0] * cs0[0] - v0[1] * cs0[1], b0 = v0[1] * cs0[0] + v0[0] * cs0[1];
                        const float a1 = v0[2] * cs0[2] - v0[3] * cs0[3], b1 = v0[3] * cs0[2] + v0[2] * cs0[3];
                        const float a2 = v1[0] * cs1[0] - v1[1] * cs1[1], b2 = v1[1] * cs1[0] + v1[0] * cs1[1];
                        const float a3 = v1[2] * cs1[2] - v1[3] * cs1[3], b3 = v1[3] * cs1[2] + v1[2] * cs1[3];
                        u32x4 w; w.x = pk2(a0, b0); w.y = pk2(a1, b1); w.z = pk2(a2, b2); w.w = pk2(a3, b3);
                        *(u32x4*)(rowp + bj * 32) = w; } }
        }
    }
};

#define GAS __attribute__((address_space(1)))
#define P_TMP_PROBE (194ull * 1048576ull)
constexpr int LNF_PART = pg8::JT_OFF + 1024;
constexpr int LNF_STAT = LNF_PART + 8192;
struct EpiLN {
    static constexpr bool PERM = true;
    LAS unsigned char* lds;
    mutable u32x4 pre[2][4][2];
    __device__ __forceinline__ void prefetch(const pg8::Unit& u, int, int, int, int) const {
        int tq = threadIdx.x; asm volatile("" : "+v"(tq)); const int wq = __builtin_amdgcn_readfirstlane(tq >> 6), wr = wq >> 2, wc = wq & 3, fr = tq & 15, fq = (tq & 63) >> 4;
        const unsigned long long xio = pg8::rfl64(((const LAS pg8::JobDesc*)(lds + pg8::JT_OFF))->out);
        const GAS unsigned char* tb = (const GAS unsigned char*)(xio + ((size_t)u.pm * 256 * 1024 + u.pn * 256) * 2);
        const unsigned loff = (unsigned)((wr * 64 + fr) * 1024 + wc * 64 + 8 * fq) * 2u;
#pragma unroll
        for (int ai = 0; ai < 2; ++ai)
#pragma unroll
            for (int m = 0; m < 4; ++m)
#pragma unroll
                for (int bj = 0; bj < 2; ++bj) pre[ai][m][bj] = *(const GAS u32x4*)(tb + (ai * 128 + m * 16) * 2048 + bj * 64 + loff);
    }
    __device__ __forceinline__ void init(f32x4 (&acc)[2][2][4][2]) const {
#pragma unroll
        for (int ai = 0; ai < 2; ++ai)
#pragma unroll
            for (int m = 0; m < 4; ++m)
#pragma unroll
                for (int bj = 0; bj < 2; ++bj) { const u32x4 w = pre[ai][m][bj];
                    acc[ai][bj][m][0] = (f32x4){ALPHA * bf_lo(w.x), ALPHA * bf_hi(w.x), ALPHA * bf_lo(w.y), ALPHA * bf_hi(w.y)};
                    acc[ai][bj][m][1] = (f32x4){ALPHA * bf_lo(w.z), ALPHA * bf_hi(w.z), ALPHA * bf_lo(w.w), ALPHA * bf_hi(w.w)};
                    __builtin_amdgcn_sched_barrier(0); }
    }
    __device__ __forceinline__ bool early(const f32x4 (&)[2][2][4][2], const pg8::Unit&, int, int, int, int) const { return false; }
    template <int AI>
    __device__ __forceinline__ void half(f32x4 (&acc)[2][2][4][2], const pg8::Unit& u, int, int, int, int) const {
        int tid_ = threadIdx.x; asm volatile("" : "+v"(tid_)); const int tid = tid_, lane = tid & 63;
        const int wq = __builtin_amdgcn_readfirstlane(tid >> 6), wr = wq >> 2, wc = wq & 3, fr = lane & 15, fq = lane >> 4;
        const int colt = u.pn * 256 + wc * 64 + 8 * fq;
        LAS f32x2* part = (LAS f32x2*)(lds + LNF_PART);
        LAS f32x2* stat = (LAS f32x2*)(lds + LNF_STAT);
#pragma unroll
        for (int m = 0; m < 4; ++m) { const int rl = AI * 128 + wr * 64 + m * 16 + fr;
            float s1 = 0.f, s2 = 0.f;
#pragma unroll
            for (int bj = 0; bj < 2; ++bj) { const f32x4 v0 = acc[AI][bj][m][0], v1 = acc[AI][bj][m][1];
#pragma unroll
                for (int e = 0; e < 4; ++e) { s1 += v0[e] + v1[e]; s2 += v0[e] * v0[e] + v1[e] * v1[e]; } }
            s1 += shx(s1, 16, lane); s2 += shx(s2, 16, lane); s1 += shx(s1, 32, lane); s2 += shx(s2, 32, lane);
            if (fq == 0) part[rl * 4 + wc] = (f32x2){s1, s2}; }
        if constexpr (AI == 1) {
            __syncthreads();
            if (tid < 256) {
                const f32x2 p0 = part[tid * 4], p1 = part[tid * 4 + 1], p2 = part[tid * 4 + 2], p3 = part[tid * 4 + 3];
                const float t1 = (p0[0] + p1[0]) + (p2[0] + p3[0]), t2 = (p0[1] + p1[1]) + (p2[1] + p3[1]);
                unsigned long long* sl = (unsigned long long*)pg8::rfl64(((const LAS pg8::JobDesc*)(lds + pg8::JT_OFF))->out2) + (size_t)u.pm * 1024 + tid;
                __hip_atomic_store(sl + u.pn * 256, ((unsigned long long)__float_as_uint(t2) << 32) | __float_as_uint(t1), __ATOMIC_RELAXED, __HIP_MEMORY_SCOPE_AGENT);
                unsigned long long x0, x1, x2, x3; unsigned sp = 0;
                for (;;) {
                    x0 = __hip_atomic_load(sl, __ATOMIC_RELAXED, __HIP_MEMORY_SCOPE_AGENT); x1 = __hip_atomic_load(sl + 256, __ATOMIC_RELAXED, __HIP_MEMORY_SCOPE_AGENT);
                    x2 = __hip_atomic_load(sl + 512, __ATOMIC_RELAXED, __HIP_MEMORY_SCOPE_AGENT); x3 = __hip_atomic_load(sl + 768, __ATOMIC_RELAXED, __HIP_MEMORY_SCOPE_AGENT);
                    if ((x0 != ~0ull && x1 != ~0ull && x2 != ~0ull && x3 != ~0ull) || ++sp > (1u << 22)) break;
                    __builtin_amdgcn_s_sleep(1); }
#ifdef PROBE_LNX
                {   unsigned long long* sl2 = sl + 4 * 131072;
                    __hip_atomic_store(sl2 + u.pn * 256, ((unsigned long long)__float_as_uint(t2) << 32) | __float_as_uint(t1), __ATOMIC_RELAXED, __HIP_MEMORY_SCOPE_AGENT);
                    unsigned long long y0, y1, y2, y3; unsigned sq = 0;
                    for (;;) { y0 = __hip_atomic_load(sl2, __ATOMIC_RELAXED, __HIP_MEMORY_SCOPE_AGENT); y1 = __hip_atomic_load(sl2 + 256, __ATOMIC_RELAXED, __HIP_MEMORY_SCOPE_AGENT);
                        y2 = __hip_atomic_load(sl2 + 512, __ATOMIC_RELAXED, __HIP_MEMORY_SCOPE_AGENT); y3 = __hip_atomic_load(sl2 + 768, __ATOMIC_RELAXED, __HIP_MEMORY_SCOPE_AGENT);
                        if ((y0 != ~0ull && y1 != ~0ull && y2 != ~0ull && y3 != ~0ull) || ++sq > (1u << 22)) break;
                        __builtin_amdgcn_s_sleep(1); }
                    if (y0 == 0x123456789ull) x0 = y1; }
#endif
                const float S1 = (__uint_as_float((unsigned)x0) + __uint_as_float((unsigned)x1)) + (__uint_as_float((unsigned)x2) + __uint_as_float((unsigned)x3));
                const float S2 = (__uint_as_float((unsigned)(x0 >> 32)) + __uint_as_float((unsigned)(x1 >> 32))) + (__uint_as_float((unsigned)(x2 >> 32)) + __uint_as_float((unsigned)(x3 >> 32)));
                const float mean = S1 * (1.f / 1024.f); const float var = fmaxf(S2 * (1.f / 1024.f) - mean * mean, 0.f);
                stat[tid] = (f32x2){mean, __builtin_amdgcn_rsqf(var + LN_EPS)};
            }
            __syncthreads();
            const LAS pg8::JobDesc* jd = (const LAS pg8::JobDesc*)(lds + pg8::JT_OFF);
            const unsigned long long xio = pg8::rfl64(jd->out); const float* g = (const float*)pg8::rfl64(jd->bias); const float* b = (const float*)pg8::rfl64(jd->rot);
            GAS unsigned char* tb = (GAS unsigned char*)(xio + ((size_t)u.pm * 256 * 1024 + u.pn * 256) * 2); const unsigned loff = (unsigned)((wr * 64 + fr) * 1024 + wc * 64 + 8 * fq) * 2u;
#pragma unroll
            for (int bj = 0; bj < 2; ++bj) {
                __builtin_amdgcn_sched_barrier(0);
                const f32x4 g0 = *(const GAS f32x4*)((const GAS float*)g + colt + bj * 32), g1 = *(const GAS f32x4*)((const GAS float*)g + colt + bj * 32 + 4), b0 = *(const GAS f32x4*)((const GAS float*)b + colt + bj * 32), b1 = *(const GAS f32x4*)((const GAS float*)b + colt + bj * 32 + 4);
                f32x2 stn = stat[wr * 64 + fr];
#pragma unroll
                for (int am = 0; am < 8; ++am) { const int ai = am >> 2, m = am & 3; const int rl = ai * 128 + wr * 64 + m * 16 + fr; const f32x2 st = stn;
                    if (am < 7) stn = stat[((am + 1) >> 2) * 128 + wr * 64 + ((am + 1) & 3) * 16 + fr];
                    const float sc = st[1], sh = -st[0] * st[1];
                    const f32x4 v0 = (acc[ai][bj][m][0] * sc + sh) * g0 + b0, v1 = (acc[ai][bj][m][1] * sc + sh) * g1 + b1;
                    u32x4 w; w.x = pk2(v0[0], v0[1]); w.y = pk2(v0[2], v0[3]); w.z = pk2(v1[0], v1[1]); w.w = pk2(v1[2], v1[3]);
                    *(GAS u32x4*)(tb + (ai * 128 + m * 16) * 2048 + bj * 64 + loff) = w;
#ifdef PROBE_LNS
                    *(GAS u32x4*)(tb + ((size_t)P_TMP_PROBE) + (ai * 128 + m * 16) * 2048 + bj * 64 + loff) = w;
#endif
                    __builtin_amdgcn_sched_barrier(0); }
            }
        }
    }
};
enum { RM_IDENT = 0, RM_ROT = 1, RM_PAIR0 = 2, RM_PAIR1 = 3 };
__device__ __forceinline__ int rowmap(int kind, int n) {
    if (kind == RM_ROT) { if (n >= 1280) return n; const int d = n & 63; return (n & ~63) + 2 * (d & 31) + (d >> 5); }
    if (kind == RM_PAIR0) return 2 * n;
    if (kind == RM_PAIR1) return 2 * n + 1;
    return n;
}
__device__ __forceinline__ void ti_load(const float* __restrict__ W, int ldw, int kb, int nb, int lane, f32x4 (&tv)[8]) {
    const int k0 = 64 * kb, n0 = 32 * nb;
#pragma unroll
    for (int i = 0; i < 8; ++i) { const int kk = 8 * i + (lane >> 3); tv[i] = *(const f32x4*)(W + (size_t)(k0 + kk) * ldw + n0 + 4 * (lane & 7)); }
}
__device__ __forceinline__ void ti_store(const f32x4 (&tv)[8], int K, bf16_t* __restrict__ WT, LAS float* scr, int kb, int nb, int lane, int kind, float scale, int nscale) {
    const int k0 = 64 * kb, n0 = 32 * nb;
#pragma unroll
    for (int i = 0; i < 8; ++i) { const int kk = 8 * i + (lane >> 3); LAS float* d = scr + kk * 33 + 4 * (lane & 7); d[0] = tv[i][0]; d[1] = tv[i][1]; d[2] = tv[i][2]; d[3] = tv[i][3]; }
    __builtin_amdgcn_s_waitcnt(0xc07f); asm volatile("" ::: "memory");
    const int c = lane & 7;
#pragma unroll
    for (int j = 0; j < 4; ++j) { const int n = (lane >> 3) + 8 * j; const LAS float* s = scr + (8 * c) * 33 + n; const float sc = (n0 + n) < nscale ? scale : 1.f;
        u32x4 o; o.x = pk2(s[0 * 33] * sc, s[1 * 33] * sc); o.y = pk2(s[2 * 33] * sc, s[3 * 33] * sc); o.z = pk2(s[4 * 33] * sc, s[5 * 33] * sc); o.w = pk2(s[6 * 33] * sc, s[7 * 33] * sc);
        *(u32x4*)(WT + (size_t)rowmap(kind, n0 + n) * K + k0 + 8 * c) = o; }
    __builtin_amdgcn_s_waitcnt(0xc07f); asm volatile("" ::: "memory");
}
__device__ __forceinline__ void convert_mats(const float* W, int K, int N, int nbat, size_t sstr, bf16_t* WT, size_t dstr, int kind, float scale, int nscale, LAS float* scr, int& gwr, int ngw, int lane) {
    const int nblk = N / 32, per = (K / 64) * nblk, total = per * nbat;
    const int gw = gwr; gwr = (gw + ngw - total % ngw) % ngw;
    if (gw >= total) return;
    f32x4 cur[8], nxt[8];
    { const int bt = gw / per, r = gw - bt * per; ti_load(W + (size_t)bt * sstr, N, r / nblk, r % nblk, lane, cur); }
    for (int it = gw; it < total; it += ngw) {
        const int in = it + ngw; const bool more = in < total;
        if (more) { const int bt = in / per, r = in - bt * per; ti_load(W + (size_t)bt * sstr, N, r / nblk, r % nblk, lane, nxt); }
        { const int bt = it / per, r = it - bt * per; ti_store(cur, K, WT + (size_t)bt * dstr, scr, r / nblk, r % nblk, lane, kind, scale, nscale); }
#pragma unroll
        for (int i = 0; i < 8; ++i) cur[i] = nxt[i];
    }
}
__device__ __forceinline__ void convert_rows(const float* __restrict__ src, bf16_t* __restrict__ dst, size_t n, int gt, int ngt) {
    const size_t step = (size_t)ngt * 8; size_t i = (size_t)gt * 8;
    for (; i + 3 * step < n; i += 4 * step) { f32x4 a[4], b[4];
#pragma unroll
        for (int j = 0; j < 4; ++j) { a[j] = *(const f32x4*)(src + i + j * step); b[j] = *(const f32x4*)(src + i + j * step + 4); }
#pragma unroll
        for (int j = 0; j < 4; ++j) { u32x4 o; o.x = pk2(a[j][0], a[j][1]); o.y = pk2(a[j][2], a[j][3]); o.z = pk2(b[j][0], b[j][1]); o.w = pk2(b[j][2], b[j][3]); *(u32x4*)(dst + i + j * step) = o; } }
    for (; i < n; i += step) { const f32x4 a = *(const f32x4*)(src + i), b = *(const f32x4*)(src + i + 4);
        u32x4 o; o.x = pk2(a[0], a[1]); o.y = pk2(a[2], a[3]); o.z = pk2(b[0], b[1]); o.w = pk2(b[2], b[3]); *(u32x4*)(dst + i) = o; }
}

struct LnArgs { const float* xin32; const bf16_t* xin; float* xout32; bf16_t* xbf; const bf16_t* y; const float* g; const float* b; const int* dest; const float* wts; };
template <int NR, bool XF32, bool OUTF32, bool MOE>
__device__ __forceinline__ void ln_rows(const LnArgs& a, int row0, int lane) {
    float v[NR][2][8];
    {
        int d0[NR], d1[NR]; float w0[NR], w1[NR];
        if (MOE) {
#pragma unroll
            for (int i = 0; i < NR; ++i) { d0[i] = a.dest[(row0 + i) * 2]; d1[i] = a.dest[(row0 + i) * 2 + 1]; w0[i] = a.wts[(row0 + i) * 2]; w1[i] = a.wts[(row0 + i) * 2 + 1]; }
        }
        f32x4 xf[XF32 ? NR : 1][2][2]; u32x4 xb[XF32 ? 1 : NR][2]; u32x4 p[NR][2], q[MOE ? NR : 1][2];
#pragma unroll
        for (int i = 0; i < NR; ++i) {
            const u32x4* y0 = (const u32x4*)(a.y + (size_t)(MOE ? d0[i] : row0 + i) * DM) + lane; const u32x4* y1 = (const u32x4*)(a.y + (size_t)(MOE ? d1[i] : 0) * DM) + lane;
#pragma unroll
            for (int j = 0; j < 2; ++j) {
                if (XF32) { const f32x4* xr = (const f32x4*)(a.xin32 + (size_t)(row0 + i) * DM) + 2 * lane + 128 * j; xf[XF32 ? i : 0][j][0] = xr[0]; xf[XF32 ? i : 0][j][1] = xr[1]; }
                else xb[XF32 ? 0 : i][j] = ((const u32x4*)(a.xin + (size_t)(row0 + i) * DM) + lane)[64 * j];
                p[i][j] = y0[64 * j]; if (MOE) q[MOE ? i : 0][j] = y1[64 * j]; } }
#pragma unroll
        for (int i = 0; i < NR; ++i)
#pragma unroll
            for (int j = 0; j < 2; ++j) {
                float x[8];
                if (XF32) {
#pragma unroll
                    for (int e = 0; e < 4; ++e) { x[e] = xf[XF32 ? i : 0][j][0][e]; x[4 + e] = xf[XF32 ? i : 0][j][1][e]; } }
                else { const u32x4 w = xb[XF32 ? 0 : i][j]; x[0] = bf_lo(w.x); x[1] = bf_hi(w.x); x[2] = bf_lo(w.y); x[3] = bf_hi(w.y); x[4] = bf_lo(w.z); x[5] = bf_hi(w.z); x[6] = bf_lo(w.w); x[7] = bf_hi(w.w); }
                const u32x4 pw = p[i][j]; const float py[8] = {bf_lo(pw.x), bf_hi(pw.x), bf_lo(pw.y), bf_hi(pw.y), bf_lo(pw.z), bf_hi(pw.z), bf_lo(pw.w), bf_hi(pw.w)};
                if (MOE) { const u32x4 qw = q[MOE ? i : 0][j]; const float qy[8] = {bf_lo(qw.x), bf_hi(qw.x), bf_lo(qw.y), bf_hi(qw.y), bf_lo(qw.z), bf_hi(qw.z), bf_lo(qw.w), bf_hi(qw.w)};
#pragma unroll
                    for (int e = 0; e < 8; ++e) v[i][j][e] = ALPHA * x[e] + w0[i] * py[e] + w1[i] * qy[e]; }
                else {
#pragma unroll
                    for (int e = 0; e < 8; ++e) v[i][j][e] = ALPHA * x[e] + py[e]; }
            }
    }
    float s[NR];
#pragma unroll
    for (int i = 0; i < NR; ++i) { s[i] = 0.f;
#pragma unroll
        for (int j = 0; j < 2; ++j)
#pragma unroll
            for (int e = 0; e < 8; ++e) s[i] += v[i][j][e]; }
#pragma unroll
    for (int o = 1; o < 64; o <<= 1)
#pragma unroll
        for (int i = 0; i < NR; ++i) s[i] += shx(s[i], o, lane);
    float q2[NR];
#pragma unroll
    for (int i = 0; i < NR; ++i) { const float mean = s[i] * (1.f / DM); q2[i] = 0.f;
#pragma unroll
        for (int j = 0; j < 2; ++j)
#pragma unroll
            for (int e = 0; e < 8; ++e) { v[i][j][e] -= mean; q2[i] += v[i][j][e] * v[i][j][e]; } }
#pragma unroll
    for (int o = 1; o < 64; o <<= 1)
#pragma unroll
        for (int i = 0; i < NR; ++i) q2[i] += shx(q2[i], o, lane);
    f32x4 gv[2][2], bv[2][2];
#pragma unroll
    for (int j = 0; j < 2; ++j) { const f32x4* gp = (const f32x4*)a.g + 2 * lane + 128 * j; const f32x4* bp = (const f32x4*)a.b + 2 * lane + 128 * j; gv[j][0] = gp[0]; gv[j][1] = gp[1]; bv[j][0] = bp[0]; bv[j][1] = bp[1]; }
#pragma unroll
    for (int i = 0; i < NR; ++i) { const float rstd = rsqrtf(q2[i] * (1.f / DM) + LN_EPS);
#pragma unroll
        for (int j = 0; j < 2; ++j) { float o[8];
#pragma unroll
            for (int e = 0; e < 8; ++e) o[e] = v[i][j][e] * rstd * gv[j][e >> 2][e & 3] + bv[j][e >> 2][e & 3];
            if (OUTF32) { f32x4* xo = (f32x4*)(a.xout32 + (size_t)(row0 + i) * DM) + 2 * lane + 128 * j; xo[0] = (f32x4){o[0], o[1], o[2], o[3]}; xo[1] = (f32x4){o[4], o[5], o[6], o[7]}; }
            else { u32x4 w; w.x = pk2(o[0], o[1]); w.y = pk2(o[2], o[3]); w.z = pk2(o[4], o[5]); w.w = pk2(o[6], o[7]); ((u32x4*)(a.xbf + (size_t)(row0 + i) * DM) + lane)[64 * j] = w; } } }
}
template <bool XF32, bool OUTF32, bool MOE>
__device__ __forceinline__ void ln_phase(const LnArgs& a, int blk, int G, int wave, int lane) {
    const int per = NT / G, r0 = blk * per, pw = per / NWAVE;
    for (int r = 0; r < pw; r += 4) ln_rows<4, XF32, OUTF32, MOE>(a, r0 + wave * pw + r, lane);
}
__device__ __forceinline__ void xattn_phase(LAS unsigned char* lds, const bf16_t* __restrict__ Q, const bf16_t* __restrict__ KC, const bf16_t* __restrict__ VT, bf16_t* __restrict__ O, int blk, int G) {
    const int tid0 = threadIdx.x, wave = __builtin_amdgcn_readfirstlane(tid0 >> 6);
#define XA_IDS int tid = tid0; asm volatile("" : "+v"(tid)); const int lane = tid & 63, r32 = lane & 31, hh = lane >> 5; const size_t qrow = (size_t)b * SEQ + qb * 256 + wave * 32 + r32; (void)lane; (void)hh; (void)qrow;
    for (int u = blk; u < 512; u += G) {
        int qb = u & 15, h = (u >> 4) & 3, b = u >> 6;
        if (G == 256) { const int x = blk & 7, j = blk >> 3, grp = x * 4 + (u >> 8) * 2 + (j >> 4); qb = j & 15; h = grp & 3; b = grp >> 2; }
        XA_IDS;
        bf16x8 qf[16];
#pragma unroll
        for (int ks = 0; ks < 16; ++ks) qf[ks] = *(const bf16x8*)(Q + qrow * 1024 + h * 256 + ks * 16 + hh * 8);
        __syncthreads();
#pragma unroll
        for (int bt = 0; bt < 2; ++bt) {
            u32x4 t[8];
#pragma unroll
            for (int i = 0; i < 8; ++i) { const int ch = tid + 512 * (bt * 8 + i), row = ch >> 5, c = ch & 31; t[i] = *(const u32x4*)(KC + (size_t)(b * 256 + row) * 1024 + h * 256 + c * 8); }
#pragma unroll
            for (int i = 0; i < 8; ++i) { const int ch = tid + 512 * (bt * 8 + i), row = ch >> 5, c = ch & 31; *(LAS u32x4*)(lds + row * 528 + c * 16) = t[i]; }
        }
        __syncthreads();
        f32x16 s[8];
#pragma unroll
        for (int mt = 0; mt < 8; ++mt)
#pragma unroll
            for (int r = 0; r < 16; ++r) s[mt][r] = 0.f;
        {   const LAS unsigned char* kbp = lds + r32 * 528 + hh * 16;
#pragma unroll
            for (int ks = 0; ks < 16; ++ks)
#pragma unroll
                for (int mt = 0; mt < 8; ++mt) { const bf16x8 a = *(const LAS bf16x8*)(kbp + mt * 32 * 528 + ks * 32); s[mt] = MFMA32(a, qf[ks], s[mt]); }
        }
        float mx = -INFINITY;
#pragma unroll
        for (int mt = 0; mt < 8; ++mt)
#pragma unroll
            for (int r = 0; r < 16; ++r) mx = fmaxf(mx, s[mt][r]);
        mx = xhalf_max(mx);
        float sm = 0.f; const float mxl = mx * LOG2E;
        u32x4 pf[8][2];
#pragma unroll
        for (int mt = 0; mt < 8; ++mt) {
#pragma unroll
            for (int r = 0; r < 16; ++r) { const float p = __builtin_amdgcn_exp2f(s[mt][r] * LOG2E - mxl); s[mt][r] = p; sm += p; }
#pragma unroll
            for (int sx = 0; sx < 2; ++sx) pf[mt][sx] = (u32x4){pk2(s[mt][8 * sx], s[mt][8 * sx + 1]), pk2(s[mt][8 * sx + 2], s[mt][8 * sx + 3]), pk2(s[mt][8 * sx + 4], s[mt][8 * sx + 5]), pk2(s[mt][8 * sx + 6], s[mt][8 * sx + 7])};
        }
        sm = xhalf_sum(sm);
        __syncthreads();
        {   XA_IDS;
#pragma unroll
        for (int bt = 0; bt < 4; ++bt) {
            u32x4 t[4];
#pragma unroll
            for (int i = 0; i < 4; ++i) { const int ch = tid + 512 * (bt * 4 + i), row = ch >> 5, c = ch & 31; t[i] = *(const u32x4*)(VT + (size_t)(h * 256 + row) * 2048 + b * 256 + c * 8); }
#pragma unroll
            for (int i = 0; i < 4; ++i) { const int ch = tid + 512 * (bt * 4 + i), row = ch >> 5, c = ch & 31; LAS u32x2* d = (LAS u32x2*)(lds + row * 520 + c * 16); d[0] = (u32x2){t[i].x, t[i].y}; d[1] = (u32x2){t[i].z, t[i].w}; }
        }
        }
        __syncthreads();
        {   XA_IDS;
        const float inv = 1.f / sm;
        bf16_t* orow = O + qrow * 1024 + h * 256 + 4 * hh;
#pragma unroll 1
        for (int dh = 0; dh < 2; ++dh) {
            f32x16 o[4];
#pragma unroll
            for (int dt = 0; dt < 4; ++dt)
#pragma unroll
                for (int r = 0; r < 16; ++r) o[dt][r] = 0.f;
            const LAS unsigned char* vb = lds + (dh * 128 + r32) * 520 + 8 * hh;
#pragma unroll
            for (int mt = 0; mt < 8; ++mt)
#pragma unroll
                for (int sx = 0; sx < 2; ++sx) { const int kb = mt * 32 + 16 * sx; const bf16x8 pb = __builtin_bit_cast(bf16x8, pf[mt][sx]);
#pragma unroll
                    for (int dt = 0; dt < 4; ++dt) { const LAS unsigned char* q = vb + dt * 32 * 520 + kb * 2;
                        const s16x4 lo = *(const LAS s16x4*)q, hi = *(const LAS s16x4*)(q + 16);
                        const bf16x8 a = (bf16x8){lo[0], lo[1], lo[2], lo[3], hi[0], hi[1], hi[2], hi[3]}; o[dt] = MFMA32(a, pb, o[dt]); } }
#pragma unroll
            for (int dt = 0; dt < 4; ++dt)
#pragma unroll
                for (int g = 0; g < 4; ++g) { u32x2 w; w.x = pk2(o[dt][4 * g] * inv, o[dt][4 * g + 1] * inv); w.y = pk2(o[dt][4 * g + 2] * inv, o[dt][4 * g + 3] * inv); *(u32x2*)(orow + dh * 128 + dt * 32 + 8 * g) = w; }
        }
        }
    }
#undef XA_IDS
}

struct RouteBufs { int* e; float* w; int* rank; int* dest; int* hist; int* tstart; int* src; };
__device__ __forceinline__ void moe_router_phase(LAS unsigned char* lds, const bf16_t* __restrict__ XBF, const bf16_t* __restrict__ WRT, const float* __restrict__ brg, const float* __restrict__ bre, const RouteBufs rb, int blk) {
    int tid_ = threadIdx.x; asm volatile("" : "+v"(tid_)); const int tid = tid_, lane = tid & 63, wave = __builtin_amdgcn_readfirstlane(tid >> 6), r32 = lane & 31, hh = lane >> 5;
    LAS unsigned char* XT = lds; LAS unsigned char* WT = lds + 128 * 528;
    LAS float* LG = (LAS float*)lds;
    LAS int* hist = (LAS int*)(lds + 128 * 65 * 4);
    const int rbk = wave & 3, ct = wave >> 2;
    f32x16 acc;
#pragma unroll
    for (int r = 0; r < 16; ++r) acc[r] = 0.f;
#pragma unroll 1
    for (int kc = 0; kc < 4; ++kc) {
        __syncthreads();
        {   u32x4 tx[8], tw[8];
#pragma unroll
            for (int i = 0; i < 8; ++i) { const int ch = tid + 512 * i, row = ch >> 5, c = ch & 31; tx[i] = *(const u32x4*)(XBF + (size_t)(blk * 128 + row) * 1024 + kc * 256 + c * 8); tw[i] = *(const u32x4*)(WRT + (size_t)row * 1024 + kc * 256 + c * 8); }
#pragma unroll
            for (int i = 0; i < 8; ++i) { const int ch = tid + 512 * i, row = ch >> 5, c = ch & 31; *(LAS u32x4*)(XT + row * 528 + c * 16) = tx[i]; *(LAS u32x4*)(WT + row * 528 + c * 16) = tw[i]; } }
        __syncthreads();
        const LAS unsigned char* ap = XT + (rbk * 32 + r32) * 528 + hh * 16; const LAS unsigned char* bp = WT + (ct * 32 + r32) * 528 + hh * 16;
#pragma unroll
        for (int ks = 0; ks < 16; ++ks) { const bf16x8 a = *(const LAS bf16x8*)(ap + ks * 32), b0 = *(const LAS bf16x8*)(bp + ks * 32), b1 = *(const LAS bf16x8*)(bp + 64 * 528 + ks * 32);
            acc = MFMA32(a, b0, acc); acc = MFMA32(a, b1, acc); }
    }
    __syncthreads();
    if (tid < 32) hist[tid] = 0;
#pragma unroll
    for (int r = 0; r < 16; ++r) LG[(rbk * 32 + crow(r, hh)) * 65 + ct * 32 + r32] = acc[r];
    __syncthreads();
    if (tid < 128) {
        const LAS float* lg = LG + tid * 65; const int tok = blk * 128 + tid;
        float g4[4];
#pragma unroll
        for (int g = 0; g < 4; ++g) g4[g] = lg[32 + g] + brg[g];
        int gi = 0; float gm = g4[0];
#pragma unroll
        for (int g = 1; g < 4; ++g) if (g4[g] > gm) { gm = g4[g]; gi = g; }
        float gs = 0.f;
#pragma unroll
        for (int g = 0; g < 4; ++g) gs += fast_exp(g4[g] - gm);
        const float gate_g = 1.f / gs;
        float le[8];
#pragma unroll
        for (int e = 0; e < 8; ++e) le[e] = lg[gi * 8 + e] + bre[gi * 8 + e];
        int i0 = 0; float v0 = le[0];
#pragma unroll
        for (int e = 1; e < 8; ++e) if (le[e] > v0) { v0 = le[e]; i0 = e; }
        int i1 = 0; float v1 = -INFINITY;
#pragma unroll
        for (int e = 0; e < 8; ++e) if (e != i0 && le[e] > v1) { v1 = le[e]; i1 = e; }
        const float e1 = fast_exp(v1 - v0), p0 = 1.f / (1.f + e1), p1 = e1 * p0;
        const int ex0 = gi * 8 + i0, ex1 = gi * 8 + i1;
        rb.e[tok * 2] = ex0; rb.e[tok * 2 + 1] = ex1; rb.w[tok * 2] = gate_g * p0; rb.w[tok * 2 + 1] = gate_g * p1;
        rb.rank[tok * 2] = atomicAdd((int*)&hist[ex0], 1); rb.rank[tok * 2 + 1] = atomicAdd((int*)&hist[ex1], 1);
    }
    __syncthreads();
    if (tid < 32) rb.hist[blk * 32 + tid] = hist[tid];
}
__device__ __forceinline__ void moe_scatter_phase(LAS unsigned char* lds, const RouteBufs rb, int blk, int G) {
    int tid_ = threadIdx.x; asm volatile("" : "+v"(tid_)); const int tid = tid_, lane = tid & 63, wave = __builtin_amdgcn_readfirstlane(tid >> 6);
    LAS int* sb = (LAS int*)lds;
    __syncthreads();
    {
        const int e = tid & 31, part = tid >> 5; int c[16];
#pragma unroll
        for (int i = 0; i < 16; ++i) c[i] = rb.hist[(part * 16 + i) * 32 + e];
        int tot = 0, base = 0;
#pragma unroll
        for (int i = 0; i < 16; ++i) { tot += c[i]; if (part * 16 + i < blk) base += c[i]; }
        sb[128 + part * 32 + e] = base; sb[128 + 512 + part * 32 + e] = tot; }
    __syncthreads();
    if (tid < 32) { int tot = 0, base = 0;
#pragma unroll
        for (int i = 0; i < 16; ++i) { base += sb[128 + i * 32 + tid]; tot += sb[128 + 512 + i * 32 + tid]; }
        sb[tid] = base; sb[32 + tid] = tot; }
    __syncthreads();
    if (tid == 0) { int acc = 0; for (int e = 0; e < 32; ++e) { sb[64 + e] = acc; if (blk == 0) rb.tstart[e] = acc >> 8; acc += (sb[32 + e] + 255) & ~255; } sb[96] = acc; if (blk == 0) rb.tstart[32] = acc >> 8; }
    __syncthreads();
    if (tid < 256) { const int idx = blk * 256 + tid; const int e = rb.e[idx]; const int d = sb[64 + e] + sb[e] + rb.rank[idx]; rb.dest[idx] = d; rb.src[d] = idx >> 1; }
    if (blk < 32) { const int e = blk; const int lo = sb[64 + e] + sb[32 + e], hi = sb[64 + e] + ((sb[32 + e] + 255) & ~255); for (int r = lo + tid; r < hi; r += NTHR) rb.src[r] = 0; }
}
struct MoeSched {
    const char* A; const char* B; const int* tstart; int K, nN, G, c; size_t bexp;
    __device__ __forceinline__ pg8::Unit get(int i, bool& ok) const { pg8::Unit u; u.A = nullptr; u.B = nullptr; u.src = nullptr; u.pm = 0; u.pn = 0; u.job = 0; ok = next(i, u); return u; }
    __device__ __forceinline__ bool next(int i, pg8::Unit& u) const {
        const int vc = (c & 7) * (G >> 3) + (c >> 3);
        const long L = (long)i * G + vc; const int ntile = tstart[32];
        if (L >= (long)ntile * nN) return false;
        const int mt = (int)(L / nN), nt = (int)(L % nN);
        int e = 0;
        for (int k = 1; k < 32; ++k) if (tstart[k] <= mt) e = k;
        u.A = A + (size_t)mt * 256 * K * 2; u.B = B + (size_t)e * bexp + (size_t)nt * 256 * K * 2; u.src = nullptr; u.pm = mt; u.pn = nt; u.job = 0; return true;
    }
};
__device__ __forceinline__ void swa_phase(LAS unsigned char* lds, const bf16_t* __restrict__ Q1, const bf16_t* __restrict__ K1, const bf16_t* __restrict__ VT1, const float* __restrict__ sinks, bf16_t* __restrict__ O, int blk, int G) {
    int tid_ = threadIdx.x; asm volatile("" : "+v"(tid_)); const int tid = tid_, lane = tid & 63, wave = __builtin_amdgcn_readfirstlane(tid >> 6), r32 = lane & 31, hh = lane >> 5;
    LAS unsigned char* KL = lds;
    LAS unsigned char* VL = lds + 36864;
    for (int u = blk; u < 1024; u += G) {
        int n = u & 31, kvh = (u >> 5) & 3, b = u >> 7;
        if (G == 256) { const int grp = (u >> 8) * 8 + (blk & 7); n = blk >> 3; kvh = grp & 3; b = grp >> 2; }
        const int tokb = b * SEQ + (n - 1) * 128;
        bf16x8 qfa[2][4];
        {   const int g0 = wave >> 1, hq0 = kvh * 4 + g0;
#pragma unroll
            for (int sb = 0; sb < 2; ++sb)
#pragma unroll
                for (int ks = 0; ks < 4; ++ks) qfa[sb][ks] = *(const bf16x8*)(Q1 + ((size_t)b * SEQ + n * 128 + (wave & 1) * 64 + sb * 32 + r32) * 1024 + hq0 * 64 + ks * 16 + hh * 8); }
        __syncthreads();
#pragma unroll
        for (int i = 0; i < 4; ++i) { const int ch = tid + 512 * i; const int key = ch >> 3, c = ch & 7;
            u32x4 v = (u32x4){0u, 0u, 0u, 0u}; if (n > 0 || key >= 128) v = *(const u32x4*)(K1 + (size_t)(tokb + key) * 256 + kvh * 64 + c * 8);
            *(LAS u32x4*)(KL + key * 144 + c * 16) = v; }
#pragma unroll
        for (int i = 0; i < 4; ++i) { const int ch = tid + 512 * i; const int d = ch >> 5, c = ch & 31;
            u32x4 v = (u32x4){0u, 0u, 0u, 0u}; if (n > 0 || c >= 16) v = *(const u32x4*)(VT1 + (size_t)(kvh * 64 + d) * NT + tokb + c * 8);
            LAS u32x2* dp = (LAS u32x2*)(VL + d * 520 + c * 16); dp[0] = (u32x2){v.x, v.y}; dp[1] = (u32x2){v.z, v.w}; }
        __syncthreads();
        const int g = wave >> 1, hq = kvh * 4 + g; const float sink = sinks[hq];
#pragma unroll 1
        for (int sb = 0; sb < 2; ++sb) {
            bf16x8 qf[4];
#pragma unroll
            for (int ks = 0; ks < 4; ++ks) qf[ks] = sb ? qfa[1][ks] : qfa[0][ks];
            const int i0 = (wave & 1) * 64 + sb * 32, jt0 = i0 >> 5;
            const size_t qtok = (size_t)b * SEQ + n * 128 + i0 + r32;
            f32x16 s[5];
#pragma unroll
            for (int t = 0; t < 5; ++t) {
#pragma unroll
                for (int r = 0; r < 16; ++r) s[t][r] = 0.f;
                const LAS unsigned char* kp = KL + ((jt0 + t) * 32 + r32) * 144 + hh * 16;
#pragma unroll
                for (int ks = 0; ks < 4; ++ks) { const bf16x8 a = *(const LAS bf16x8*)(kp + ks * 32); s[t] = MFMA32(a, qf[ks], s[t]); }
            }
            const int qi = i0 + r32;
            float mx = sink;
#pragma unroll
            for (int t = 0; t < 5; ++t)
#pragma unroll
                for (int r = 0; r < 16; ++r) { const int kj = (jt0 + t) * 32 + crow(r, hh); const bool valid = (kj > qi) && (kj <= qi + 128) && (n > 0 || kj >= 128);
                    s[t][r] = valid ? s[t][r] : -INFINITY; mx = fmaxf(mx, s[t][r]); }
            mx = xhalf_max(mx);
            float sm = 0.f; const float mxl = mx * LOG2E;
            u32x4 pf[5][2];
#pragma unroll
            for (int t = 0; t < 5; ++t) {
#pragma unroll
                for (int r = 0; r < 16; ++r) { const float pv = __builtin_amdgcn_exp2f(s[t][r] * LOG2E - mxl); s[t][r] = pv; sm += pv; }
#pragma unroll
                for (int sx = 0; sx < 2; ++sx) pf[t][sx] = (u32x4){pk2(s[t][8 * sx], s[t][8 * sx + 1]), pk2(s[t][8 * sx + 2], s[t][8 * sx + 3]), pk2(s[t][8 * sx + 4], s[t][8 * sx + 5]), pk2(s[t][8 * sx + 6], s[t][8 * sx + 7])};
            }
            sm = xhalf_sum(sm) + __builtin_amdgcn_exp2f(sink * LOG2E - mxl);
            f32x16 o[2];
#pragma unroll
            for (int dt = 0; dt < 2; ++dt)
#pragma unroll
                for (int r = 0; r < 16; ++r) o[dt][r] = 0.f;
#pragma unroll
            for (int t = 0; t < 5; ++t)
#pragma unroll
                for (int sx = 0; sx < 2; ++sx) { const bf16x8 pb = __builtin_bit_cast(bf16x8, pf[t][sx]);
#pragma unroll
                    for (int dt = 0; dt < 2; ++dt) { const LAS unsigned char* q = VL + (dt * 32 + r32) * 520 + ((jt0 + t) * 32 + 16 * sx + 4 * hh) * 2;
                        const s16x4 lo = *(const LAS s16x4*)q, hi = *(const LAS s16x4*)(q + 16);
                        const bf16x8 a = (bf16x8){lo[0], lo[1], lo[2], lo[3], hi[0], hi[1], hi[2], hi[3]}; o[dt] = MFMA32(a, pb, o[dt]); } }
            const float inv = 1.f / sm;
            bf16_t* orow = O + qtok * 1024 + hq * 64 + 4 * hh;
#pragma unroll
            for (int dt = 0; dt < 2; ++dt)
#pragma unroll
                for (int gq = 0; gq < 4; ++gq) { u32x2 w; w.x = pk2(o[dt][4 * gq] * inv, o[dt][4 * gq + 1] * inv); w.y = pk2(o[dt][4 * gq + 2] * inv, o[dt][4 * gq + 3] * inv); *(u32x2*)(orow + dt * 32 + 8 * gq) = w; }
        }
    }
}
constexpr int TS = 272;
template <int STRIDE = TS>
__device__ __forceinline__ bf16x8 tr_frag(const LAS unsigned char* T, int k0, int c0, int lane, bool permuted) {
    const int hh = lane >> 5, blk = (lane >> 4) & 1, q = (lane & 15) >> 2, pp = lane & 3;
    const int r0 = k0 + (permuted ? 4 * hh : 8 * hh) + q, r1 = r0 + (permuted ? 8 : 4);
    const int cb = (c0 + 16 * blk + 4 * pp) * 2;
    const s16x4 lo = lds_tr(T + r0 * STRIDE + cb), hi = lds_tr(T + r1 * STRIDE + cb);
    return (bf16x8){lo[0], lo[1], lo[2], lo[3], hi[0], hi[1], hi[2], hi[3]};
}
__device__ __forceinline__ bf16x8 row_frag(const LAS unsigned char* T, int row, int k0, int hh) { return *(const LAS bf16x8*)(T + row * TS + (k0 + 8 * hh) * 2); }
__device__ __forceinline__ void load_tile128(LAS unsigned char* T, const bf16_t* __restrict__ g, int ld, int tid) {
#pragma unroll
    for (int i = 0; i < 4; ++i) { const int ch = tid + 512 * i, row = ch >> 4, c = ch & 15; *(LAS u32x4*)(T + row * TS + c * 16) = *(const u32x4*)(g + (size_t)row * ld + c * 8); }
}
struct L0Bufs {
    bf16_t *AU, *AV, *BX, *BZ, *V, *XC, *YM, *CS, *Q, *K, *U; float *GT, *UN, *NS, *SC;
    const bf16_t *WQT, *GMW, *MT; const float *gm_g, *gm_b, *gm_bs, *cw, *cb, *bif, *nw, *skip;
};

__device__ __forceinline__ void l0_mixA(LAS unsigned char* lds, const L0Bufs& B, int blk, int G) {
    const int tid0 = threadIdx.x, wave = __builtin_amdgcn_readfirstlane(tid0 >> 6);
#define OPQ_IDS int tid = tid0; asm volatile("" : "+v"(tid)); const int lane = tid & 63, r32 = lane & 31, hh = lane >> 5; (void)lane; (void)r32; (void)hh;
    LAS unsigned char* T0 = lds; LAS unsigned char* T1 = lds + 34816; LAS unsigned char* T2 = lds + 2 * 34816; LAS unsigned char* T3 = lds + 3 * 34816;
    LAS float* SF = (LAS float*)T2;
    LAS float* SG = (LAS float*)(lds + 3 * 34816 + 35632);
    for (int u = blk; u < 256; u += G) {
        const int tok0 = u * 128; const bool first = (u & 31) == 0;
        constexpr int VS = 1040;
        {   OPQ_IDS; const int trow = tid >> 2, q4 = tid & 3;
            const bf16_t* vr = B.AV + (size_t)(tok0 + trow) * 512 + q4 * 128; float s = 0.f, s2 = 0.f; u32x4 w[16];
#pragma unroll
            for (int i = 0; i < 16; ++i) w[i] = *(const u32x4*)(vr + i * 8);
#pragma unroll
            for (int i = 0; i < 16; ++i) { const float f[8] = {bf_lo(w[i].x), bf_hi(w[i].x), bf_lo(w[i].y), bf_hi(w[i].y), bf_lo(w[i].z), bf_hi(w[i].z), bf_lo(w[i].w), bf_hi(w[i].w)};
#pragma unroll
                for (int e = 0; e < 8; ++e) { s += f[e]; s2 += f[e] * f[e]; } }
            s += shx(s, 1, lane); s += shx(s, 2, lane); s2 += shx(s2, 1, lane); s2 += shx(s2, 2, lane);
            const float mean = s * (1.f / 512.f), rstd = rsqrtf(fmaxf(s2 * (1.f / 512.f) - mean * mean, 0.f) + LN_EPS);
            __syncthreads();
#pragma unroll
            for (int i = 0; i < 16; ++i) { const int cbase = q4 * 128 + i * 8; const f32x4 g0 = *(const f32x4*)(B.gm_g + cbase), g1 = *(const f32x4*)(B.gm_g + cbase + 4), b0 = *(const f32x4*)(B.gm_b + cbase), b1 = *(const f32x4*)(B.gm_b + cbase + 4);
                u32x4 o; o.x = pk2((bf_lo(w[i].x) - mean) * rstd * g0[0] + b0[0], (bf_hi(w[i].x) - mean) * rstd * g0[1] + b0[1]); o.y = pk2((bf_lo(w[i].y) - mean) * rstd * g0[2] + b0[2], (bf_hi(w[i].y) - mean) * rstd * g0[3] + b0[3]);
                o.z = pk2((bf_lo(w[i].z) - mean) * rstd * g1[0] + b1[0], (bf_hi(w[i].z) - mean) * rstd * g1[1] + b1[1]); o.w = pk2((bf_lo(w[i].w) - mean) * rstd * g1[2] + b1[2], (bf_hi(w[i].w) - mean) * rstd * g1[3] + b1[3]);
                *(LAS u32x4*)(lds + trow * VS + cbase * 2) = o; asm volatile("" ::: "memory"); }
            __syncthreads();
        }
        {   const int tb = wave & 3, dhf = wave >> 2;
#pragma unroll 1
            for (int g = 0; g < 4; ++g) {
                OPQ_IDS; const int t = 32 * tb + r32; const size_t tok = (size_t)tok0 + t;
                f32x16 acc[2];
#pragma unroll
                for (int dt = 0; dt < 2; ++dt)
#pragma unroll
                    for (int r = 0; r < 16; ++r) acc[dt][r] = 0.f;
                const bf16_t* wrow = B.GMW + ((size_t)g * 128 + t) * 128 + 8 * hh;
                bf16x8 bw[8];
#pragma unroll
                for (int ks = 0; ks < 8; ++ks) bw[ks] = *(const bf16x8*)(wrow + 16 * ks);
#pragma unroll
                for (int ks = 0; ks < 8; ++ks) if (ks <= 2 * tb + 1) {
#pragma unroll
                    for (int dt = 0; dt < 2; ++dt) { const bf16x8 a = tr_frag<VS>(lds, 16 * ks, g * 128 + 64 * dhf + 32 * dt, lane, false); acc[dt] = MFMA32(a, bw[ks], acc[dt]); } }
                const float bsv = B.gm_bs[g * 128 + t];
#pragma unroll
                for (int dt = 0; dt < 2; ++dt)
#pragma unroll
                    for (int gq = 0; gq < 4; ++gq) { const int col = g * 128 + 64 * dhf + 32 * dt + 8 * gq + 4 * hh; const u32x2 au = *(const u32x2*)(B.AU + tok * 512 + col);
                        u32x2 w; w.x = pk2(bf_lo(au.x) * (acc[dt][4 * gq] + bsv), bf_hi(au.x) * (acc[dt][4 * gq + 1] + bsv)); w.y = pk2(bf_lo(au.y) * (acc[dt][4 * gq + 2] + bsv), bf_hi(au.y) * (acc[dt][4 * gq + 3] + bsv));
                        *(u32x2*)(B.YM + tok * 1024 + col) = w; }
            }
        }
        f32x16 accg;
#pragma unroll
        for (int r = 0; r < 16; ++r) accg[r] = 0.f;
        LAS unsigned char* MTL = (LAS unsigned char*)SG;
#pragma unroll 1
        for (int h = 0; h < 4; ++h) {
            OPQ_IDS;
            __syncthreads();
            for (int ch = tid; ch < 131 * 16; ch += 512) { const int row = ch >> 4, c = ch & 15; u32x4 v = (u32x4){0u, 0u, 0u, 0u};
                if (!(first && row < 3)) v = *(const u32x4*)(B.BX + (size_t)(tok0 - 3 + row) * 512 + h * 128 + c * 8);
                *(LAS u32x4*)(T3 + row * TS + c * 16) = v; }
            load_tile128(T0, B.WQT + ((size_t)0 * 4 + h) * 128 * 128, 128, tid);
            load_tile128(T1, B.WQT + ((size_t)1 * 4 + h) * 128 * 128, 128, tid);
            if (tid < 256) { const int row = tid >> 5, c = tid & 31; *(LAS u32x4*)(MTL + row * 528 + c * 16) = *(const u32x4*)(B.MT + ((size_t)h * 8 + row) * 256 + c * 8); }
            __syncthreads();
            {   const int dc = tid & 15, chn = h * 128 + dc * 8; float w[4][8], cbv[8];
#pragma unroll
                for (int j = 0; j < 4; ++j)
#pragma unroll
                    for (int e = 0; e < 8; ++e) w[j][e] = B.cw[j * 512 + chn + e];
#pragma unroll
                for (int e = 0; e < 8; ++e) cbv[e] = B.cb[chn + e];
#pragma unroll 1
                for (int ps = 0; ps < 4; ++ps) { const int t = ps * 32 + (tid >> 4); float a[8];
#pragma unroll
                    for (int e = 0; e < 8; ++e) a[e] = cbv[e];
#pragma unroll
                    for (int j = 0; j < 4; ++j) { const u32x4 x = *(const LAS u32x4*)(T3 + (t + j) * TS + dc * 16);
                        a[0] += w[j][0] * bf_lo(x.x); a[1] += w[j][1] * bf_hi(x.x); a[2] += w[j][2] * bf_lo(x.y); a[3] += w[j][3] * bf_hi(x.y);
                        a[4] += w[j][4] * bf_lo(x.z); a[5] += w[j][5] * bf_hi(x.z); a[6] += w[j][6] * bf_lo(x.w); a[7] += w[j][7] * bf_hi(x.w); }
                    u32x4 o; o.x = pk2(silu_f(a[0]), silu_f(a[1])); o.y = pk2(silu_f(a[2]), silu_f(a[3])); o.z = pk2(silu_f(a[4]), silu_f(a[5])); o.w = pk2(silu_f(a[6]), silu_f(a[7]));
                    *(LAS u32x4*)(T2 + t * TS + dc * 16) = o; *(u32x4*)(B.XC + (size_t)(tok0 + t) * 512 + chn) = o; } }
            __syncthreads();
            {   const int tb = wave & 3, ehf = wave >> 2;
                {
                    OPQ_IDS; const LAS unsigned char* act = ehf ? T3 + 3 * TS : T2;
#pragma unroll
                    for (int ks = 0; ks < 8; ++ks) { const bf16x8 a = *(const LAS bf16x8*)(MTL + (r32 & 7) * 528 + (ehf * 128 + 16 * ks + 8 * hh) * 2); const bf16x8 bx = row_frag(act, 32 * tb + r32, 16 * ks, hh); accg = MFMA32(a, bx, accg); } }
#pragma unroll 1
                for (int mtx = 0; mtx < 2; ++mtx) {
                    OPQ_IDS;
                    const LAS unsigned char* wt = mtx ? T1 : T0;
                    f32x16 acc[2];
#pragma unroll
                    for (int et = 0; et < 2; ++et)
#pragma unroll
                        for (int r = 0; r < 16; ++r) acc[et][r] = 0.f;
#pragma unroll
                    for (int ks = 0; ks < 8; ++ks) { const bf16x8 bx = row_frag(T2, 32 * tb + r32, 16 * ks, hh);
#pragma unroll
                        for (int et = 0; et < 2; ++et) { const bf16x8 a = row_frag(wt, 64 * ehf + 32 * et + r32, 16 * ks, hh); acc[et] = MFMA32(a, bx, acc[et]); } }
                    bf16_t* dst = (mtx == 0 ? B.Q : B.K) + (size_t)(tok0 + 32 * tb + r32) * 512 + h * 128 + 64 * ehf + 4 * hh;
#pragma unroll
                    for (int et = 0; et < 2; ++et)
#pragma unroll
                        for (int gq = 0; gq < 4; ++gq) { u32x2 w; w.x = pk2(acc[et][4 * gq], acc[et][4 * gq + 1]); w.y = pk2(acc[et][4 * gq + 2], acc[et][4 * gq + 3]); *(u32x2*)(dst + 32 * et + 8 * gq) = w; }
                }
            }
            __syncthreads();
            load_tile128(T0, B.WQT + ((size_t)2 * 4 + h) * 128 * 128, 128, tid);
            __syncthreads();
            {   OPQ_IDS; const int tb = wave & 3, ehf = wave >> 2;
                f32x16 acc[2];
#pragma unroll
                for (int et = 0; et < 2; ++et)
#pragma unroll
                    for (int r = 0; r < 16; ++r) acc[et][r] = 0.f;
#pragma unroll
                for (int ks = 0; ks < 8; ++ks) { const bf16x8 bx = row_frag(T3 + 3 * TS, 32 * tb + r32, 16 * ks, hh);
#pragma unroll
                    for (int et = 0; et < 2; ++et) { const bf16x8 a = row_frag(T0, 64 * ehf + 32 * et + r32, 16 * ks, hh); acc[et] = MFMA32(a, bx, acc[et]); } }
                bf16_t* dst = B.V + (size_t)(tok0 + 32 * tb + r32) * 512 + h * 128 + 64 * ehf + 4 * hh;
#pragma unroll
                for (int et = 0; et < 2; ++et)
#pragma unroll
                    for (int gq = 0; gq < 4; ++gq) { u32x2 w; w.x = pk2(acc[et][4 * gq], acc[et][4 * gq + 1]); w.y = pk2(acc[et][4 * gq + 2], acc[et][4 * gq + 3]); *(u32x2*)(dst + 32 * et + 8 * gq) = w; }
            }
        }
        __syncthreads();
        {   OPQ_IDS; const int tb = wave & 3, kh = wave >> 2;
#pragma unroll
            for (int r = 0; r < 4; ++r) SF[(kh * 8 + r + 4 * hh) * 128 + 32 * tb + r32] = accg[r];
        }
        __syncthreads();
        LAS float* IG = SG; LAS float* BC = SG + 512; LAS float* WG = SG + 1024;
        if (wave < 4) {
            OPQ_IDS; const int h = wave; float lf[2], ig[2];
#pragma unroll
            for (int e = 0; e < 2; ++e) { const int t = 2 * lane + e; ig[e] = SF[h * 128 + t] + SF[(8 + h) * 128 + t] + B.bif[h];
                const float fx = SF[(4 + h) * 128 + t] + SF[(12 + h) * 128 + t] + B.bif[4 + h]; lf[e] = fminf(fx, 0.f) - log1pf(expf(-fabsf(fx))); }
            float run = lf[0] + lf[1];
#pragma unroll
            for (int o = 1; o < 64; o <<= 1) { const float v = shup(run, o, lane); if (lane >= o) run += v; }
            const float b1 = run, b0 = run - lf[1];
            IG[h * 128 + 2 * lane] = ig[0]; IG[h * 128 + 2 * lane + 1] = ig[1]; BC[h * 128 + 2 * lane] = b0; BC[h * 128 + 2 * lane + 1] = b1;
            float* gt = B.GT + ((size_t)u * 4 + h) * 256;
            gt[2 * lane] = ig[0]; gt[2 * lane + 1] = ig[1]; gt[128 + 2 * lane] = b0; gt[128 + 2 * lane + 1] = b1;
            const float bl = shidx(b1, 63);
            float g0 = bl - b0 + ig[0], g1 = bl - b1 + ig[1]; float mloc = fmaxf(g0, g1);
#pragma unroll
            for (int o = 1; o < 64; o <<= 1) mloc = fmaxf(mloc, shx(mloc, o, lane));
            WG[h * 128 + 2 * lane] = expf(g0 - mloc); WG[h * 128 + 2 * lane + 1] = expf(g1 - mloc);
            if (lane == 0) { B.SC[u * 4 + h] = bl; B.SC[1024 + u * 4 + h] = mloc; }
        }
#pragma unroll 1
        for (int h = 0; h < 4; ++h) {
            OPQ_IDS;
            __syncthreads();
#pragma unroll
            for (int i = 0; i < 4; ++i) { const int ch = tid + 512 * i, row = ch >> 4, c = ch & 15; const float wg = WG[h * 128 + row];
                const u32x4 v = *(const u32x4*)(B.V + (size_t)(tok0 + row) * 512 + h * 128 + c * 8), k = *(const u32x4*)(B.K + (size_t)(tok0 + row) * 512 + h * 128 + c * 8);
                u32x4 ov, ok; const float ksc = 0.08838834764831845f;
                ov.x = pk2(bf_lo(v.x) * wg, bf_hi(v.x) * wg); ov.y = pk2(bf_lo(v.y) * wg, bf_hi(v.y) * wg); ov.z = pk2(bf_lo(v.z) * wg, bf_hi(v.z) * wg); ov.w = pk2(bf_lo(v.w) * wg, bf_hi(v.w) * wg);
                ok.x = pk2(bf_lo(k.x) * ksc, bf_hi(k.x) * ksc); ok.y = pk2(bf_lo(k.y) * ksc, bf_hi(k.y) * ksc); ok.z = pk2(bf_lo(k.z) * ksc, bf_hi(k.z) * ksc); ok.w = pk2(bf_lo(k.w) * ksc, bf_hi(k.w) * ksc);
                *(LAS u32x4*)(T0 + row * TS + c * 16) = ov; *(LAS u32x4*)(T1 + row * TS + c * 16) = ok; }
            __syncthreads();
            const int vb = wave & 3, khf = wave >> 2;
            f32x16 acc[2];
#pragma unroll
            for (int kt = 0; kt < 2; ++kt)
#pragma unroll
                for (int r = 0; r < 16; ++r) acc[kt][r] = 0.f;
#pragma unroll
            for (int ks = 0; ks < 8; ++ks) { const bf16x8 a = tr_frag(T0, 16 * ks, 32 * vb, lane, false);
#pragma unroll
                for (int kt = 0; kt < 2; ++kt) { const bf16x8 bk = tr_frag(T1, 16 * ks, 64 * khf + 32 * kt, lane, false); acc[kt] = MFMA32(a, bk, acc[kt]); } }
            bf16_t* Uo = B.U + ((size_t)u * 4 + h) * 16384;
#pragma unroll
            for (int kt = 0; kt < 2; ++kt)
#pragma unroll
                for (int r = 0; r < 16; ++r) Uo[(32 * vb + crow(r, hh)) * 128 + 64 * khf + 32 * kt + r32] = f2bf(acc[kt][r]);
            {   const int kk = tid & 127, sq = tid >> 7; float a = 0.f;
                for (int s = sq * 32; s < sq * 32 + 32; ++s) a += WG[h * 128 + s] * bf2f(*(const LAS bf16_t*)(T1 + s * TS + kk * 2));
                SF[2048 + sq * 128 + kk] = a; }
            __syncthreads();
            if (tid < 128) B.UN[((size_t)u * 4 + h) * 128 + tid] = (SF[2048 + tid] + SF[2048 + 128 + tid]) + (SF[2048 + 256 + tid] + SF[2048 + 384 + tid]);
        }
    }
}
#undef OPQ_IDS
__device__ __forceinline__ void l0_scan(const L0Bufs& B, int blk, int tid) {
    const int bh = blk >> 3, part = blk & 7, b = bh >> 2, h = bh & 3, lane = tid & 63;
    const int e0 = part * 2048 + tid * 8;
    float zz = 0.f; asm volatile("" : "+v"(zz));
    f32x4 C0 = (f32x4){zz, zz, zz, zz}, C1 = C0; float nst = 0.f; float m = 0.f;
    const int unit0 = (b * 32) * 4 + h;
    const bool nrm = part == 0 && tid < 128;
    const float blv = lane < 32 ? B.SC[unit0 + 4 * lane] : 0.f, mlv = lane < 32 ? B.SC[1024 + unit0 + 4 * lane] : 0.f;
    u32x4 ub[8]; float un8[8];
#pragma unroll
    for (int j = 0; j < 8; ++j) { ub[j] = *(const u32x4*)(B.U + (size_t)(unit0 + 4 * j) * 16384 + e0); un8[j] = B.UN[(size_t)(unit0 + 4 * j) * 128 + (tid & 127)]; }
#pragma unroll
    for (int g = 0; g < 4; ++g) {
        u32x4 nb[8]; float nn[8];
#pragma unroll
        for (int j = 0; j < 8; ++j) { const int un1 = unit0 + 4 * (8 * (g < 3 ? g + 1 : 3) + j); nb[j] = *(const u32x4*)(B.U + (size_t)un1 * 16384 + e0); nn[j] = B.UN[(size_t)un1 * 128 + (tid & 127)]; }
#pragma unroll
        for (int j = 0; j < 8; ++j) { const int c = 8 * g + j, unit = unit0 + 4 * c; const u32x4 Unw = ub[j];
            const f32x4 U0 = (f32x4){bf_lo(Unw.x), bf_hi(Unw.x), bf_lo(Unw.y), bf_hi(Unw.y)}, U1 = (f32x4){bf_lo(Unw.z), bf_hi(Unw.z), bf_lo(Unw.w), bf_hi(Unw.w)};
            const float bl = __int_as_float(__builtin_amdgcn_readlane(__float_as_int(blv), c)), mloc = __int_as_float(__builtin_amdgcn_readlane(__float_as_int(mlv), c)), un = un8[j];
            u32x4 w; w.x = pk2(C0[0], C0[1]); w.y = pk2(C0[2], C0[3]); w.z = pk2(C1[0], C1[1]); w.w = pk2(C1[2], C1[3]); *(u32x4*)(B.CS + (size_t)unit * 16384 + e0) = w;
            if (nrm) B.NS[(size_t)unit * 128 + tid] = nst;
            if (part == 0 && tid == 0) B.SC[2048 + unit] = m;
            const float mn = fmaxf(bl + m, mloc), dec = expf(bl + m - mn), wu = expf(mloc - mn); m = mn;
            C0 = C0 * dec + U0 * wu; C1 = C1 * dec + U1 * wu;
            nst = nst * dec + wu * un; }
#pragma unroll
        for (int j = 0; j < 8; ++j) { ub[j] = nb[j]; un8[j] = nn[j]; }
    }
}
__device__ __forceinline__ void l0_mixC(LAS unsigned char* lds, const L0Bufs& B, int blk, int G) {
    const int tid0 = threadIdx.x, wave = __builtin_amdgcn_readfirstlane(tid0 >> 6);
    LAS unsigned char* TQ = lds; LAS unsigned char* TK = lds + 34816; LAS unsigned char* TV = lds + 2 * 34816; LAS unsigned char* TC = lds + 3 * 34816;
    LAS float* SF = (LAS float*)(lds + 4 * 34816);
    LAS float* AS = SF; LAS float* PM = SF + 128; LAS float* NP = SF + 256; LAS float* PS = SF + 384; LAS float* PQ = SF + 640; LAS float* NW = SF + 896;
    __syncthreads();
    { int tq = tid0; asm volatile("" : "+v"(tq)); if (tq < 256) ((LAS f32x4*)NW)[tq] = tq < 128 ? ((const f32x4*)B.nw)[tq] : ((const f32x4*)B.skip)[tq - 128]; }
    for (int uu = blk; uu < 256; uu += G) {
        const int tok0 = uu * 128;
#pragma unroll 1
        for (int h = 0; h < 4; ++h) {
            const int unit = uu * 4 + h;
            int tid = tid0; asm volatile("" : "+v"(tid));
            const int lane = tid & 63, r32 = lane & 31, hh = lane >> 5;
            __syncthreads();
            load_tile128(TQ, B.Q + (size_t)tok0 * 512 + h * 128, 512, tid);
            load_tile128(TV, B.V + (size_t)tok0 * 512 + h * 128, 512, tid);
            load_tile128(TC, B.CS + (size_t)unit * 16384, 128, tid);
#pragma unroll
            for (int i = 0; i < 4; ++i) { const int ch = tid + 512 * i, row = ch >> 4, c = ch & 15; const u32x4 k = *(const u32x4*)(B.K + (size_t)(tok0 + row) * 512 + h * 128 + c * 8); const float ksc = 0.08838834764831845f;
                u32x4 ok; ok.x = pk2(bf_lo(k.x) * ksc, bf_hi(k.x) * ksc); ok.y = pk2(bf_lo(k.y) * ksc, bf_hi(k.y) * ksc); ok.z = pk2(bf_lo(k.z) * ksc, bf_hi(k.z) * ksc); ok.w = pk2(bf_lo(k.w) * ksc, bf_hi(k.w) * ksc);
                *(LAS u32x4*)(TK + row * TS + c * 16) = ok; }
            const float mprev = B.SC[2048 + unit];
            if (wave == 0) {
                const float* gt = B.GT + (size_t)unit * 256;
                const float a0 = gt[2 * lane] - gt[128 + 2 * lane], a1 = gt[2 * lane + 1] - gt[128 + 2 * lane + 1];
                float run = fmaxf(a0, a1);
#pragma unroll
                for (int o = 1; o < 64; o <<= 1) { const float v = shup(run, o, lane); if (lane >= o) run = fmaxf(run, v); }
                const float prev = shup(run, 1, lane); const float p0 = fmaxf(lane > 0 ? fmaxf(prev, a0) : a0, mprev), p1 = fmaxf(run, mprev);
                AS[2 * lane] = a0; AS[2 * lane + 1] = a1; PM[2 * lane] = p0; PM[2 * lane + 1] = p1;
            }
            if (wave == 1) { NP[lane] = B.NS[(size_t)unit * 128 + lane]; NP[64 + lane] = B.NS[(size_t)unit * 128 + 64 + lane]; }
            __syncthreads();
            const int tb = wave & 3, vh = wave >> 2, t = 32 * tb + r32;
            const float pm = PM[t], bt = B.GT[(size_t)unit * 256 + 128 + t];
            f32x16 s[4];
#pragma unroll
            for (int st = 0; st < 4; ++st)
#pragma unroll
                for (int r = 0; r < 16; ++r) s[st][r] = 0.f;
            {   int lv = lane; asm volatile("" : "+v"(lv));
                const LAS unsigned char* qp = TQ + (32 * tb + (lv & 31)) * TS + (lv >> 5) * 16; const LAS unsigned char* kp = TK + (lv & 31) * TS + (lv >> 5) * 16;
#pragma unroll 2
                for (int ks = 0; ks < 8; ++ks) { const bf16x8 bq = *(const LAS bf16x8*)(qp + ks * 32);
#pragma unroll
                    for (int st = 0; st < 4; ++st) if (st <= tb) { const bf16x8 a = *(const LAS bf16x8*)(kp + st * 32 * TS + ks * 32); s[st] = MFMA32(a, bq, s[st]); } } }
            float nq = 0.f; u32x4 pf[4][2];
#pragma unroll
            for (int st = 0; st < 4; ++st) {
#pragma unroll
                for (int r = 0; r < 16; ++r) { const int sidx = 32 * st + crow(r, hh); const float wv = (sidx <= t) ? __builtin_amdgcn_exp2f((AS[sidx] - pm) * LOG2E) : 0.f; const float pv = s[st][r] * wv; s[st][r] = pv; nq += pv; }
#pragma unroll
                for (int sx = 0; sx < 2; ++sx) pf[st][sx] = (u32x4){pk2(s[st][8 * sx], s[st][8 * sx + 1]), pk2(s[st][8 * sx + 2], s[st][8 * sx + 3]), pk2(s[st][8 * sx + 4], s[st][8 * sx + 5]), pk2(s[st][8 * sx + 6], s[st][8 * sx + 7])};
            }
            nq = xhalf_sum(nq);
            float nqi = 0.f;
#pragma unroll
            for (int i = 0; i < 8; ++i) { const u32x4 qv = *(const LAS u32x4*)(TQ + t * TS + (64 * hh + 8 * i) * 2); const LAS float* np = NP + 64 * hh + 8 * i;
                nqi += bf_lo(qv.x) * np[0] + bf_hi(qv.x) * np[1] + bf_lo(qv.y) * np[2] + bf_hi(qv.y) * np[3] + bf_lo(qv.z) * np[4] + bf_hi(qv.z) * np[5] + bf_lo(qv.w) * np[6] + bf_hi(qv.w) * np[7]; }
            nqi = xhalf_sum(nqi);
            const float wst = __builtin_amdgcn_exp2f((mprev - pm) * LOG2E);
            const float den = fmaxf(fabsf(nq + wst * nqi), __builtin_amdgcn_exp2f(-(bt + pm) * LOG2E)), rden = 1.f / den;
            f32x16 ni[2], nx[2];
#pragma unroll
            for (int vt = 0; vt < 2; ++vt)
#pragma unroll
                for (int r = 0; r < 16; ++r) { ni[vt][r] = 0.f; nx[vt][r] = 0.f; }
            {   int lv = lane; asm volatile("" : "+v"(lv));
#pragma unroll
                for (int st = 0; st < 4; ++st) {
                    if (st <= tb) {
#pragma unroll
                        for (int sx = 0; sx < 2; ++sx) { const bf16x8 pb = __builtin_bit_cast(bf16x8, pf[st][sx]);
#pragma unroll
                            for (int vt = 0; vt < 2; ++vt) { const bf16x8 a = tr_frag(TV, 32 * st + 16 * sx, 64 * vh + 32 * vt, lv, true); ni[vt] = MFMA32(a, pb, ni[vt]); } }
                    }
                } }
            {   int lv = lane; asm volatile("" : "+v"(lv));
                const LAS unsigned char* qp = TQ + (32 * tb + (lv & 31)) * TS + (lv >> 5) * 16; const LAS unsigned char* cp = TC + (64 * vh + (lv & 31)) * TS + (lv >> 5) * 16;
#pragma unroll 2
                for (int ks = 0; ks < 8; ++ks) { const bf16x8 bq = *(const LAS bf16x8*)(qp + ks * 32);
#pragma unroll
                    for (int vt = 0; vt < 2; ++vt) { const bf16x8 a = *(const LAS bf16x8*)(cp + vt * 32 * TS + ks * 32); nx[vt] = MFMA32(a, bq, nx[vt]); } } }
            const size_t tok = (size_t)tok0 + t;
            u32x2 xcv[2][4], zv[2][4];
#pragma unroll
            for (int vt = 0; vt < 2; ++vt)
#pragma unroll
                for (int gq = 0; gq < 4; ++gq) { const int chn = h * 128 + 64 * vh + 32 * vt + 8 * gq + 4 * hh; xcv[vt][gq] = *(const u32x2*)(B.XC + tok * 512 + chn); zv[vt][gq] = *(const u32x2*)(B.BZ + tok * 512 + chn); }
            float hs = 0.f, hq = 0.f;
#pragma unroll
            for (int vt = 0; vt < 2; ++vt)
#pragma unroll
                for (int r = 0; r < 16; ++r) { const float hv = (ni[vt][r] + wst * nx[vt][r]) * rden; ni[vt][r] = hv; hs += hv; hq += hv * hv; }
            hs = xhalf_sum(hs); hq = xhalf_sum(hq);
            if (hh == 0) { PS[vh * 128 + t] = hs; PQ[vh * 128 + t] = hq; }
            __syncthreads();
            const float mean = (PS[t] + PS[128 + t]) * (1.f / 128.f);
            const float rstd = rsqrtf(fmaxf((PQ[t] + PQ[128 + t]) * (1.f / 128.f) - mean * mean, 0.f) + LN_EPS);
#pragma unroll
            for (int vt = 0; vt < 2; ++vt)
#pragma unroll
                for (int gq = 0; gq < 4; ++gq) { const int cl = 64 * vh + 32 * vt + 8 * gq + 4 * hh, chn = h * 128 + cl;
                    const f32x4 nw = *(const LAS f32x4*)(NW + chn), sk = *(const LAS f32x4*)(NW + 512 + chn); const u32x2 xc = xcv[vt][gq], z = zv[vt][gq];
                    const float y0 = ((ni[vt][4 * gq] - mean) * rstd * nw[0] + sk[0] * bf_lo(xc.x)) * silu_f(bf_lo(z.x)), y1 = ((ni[vt][4 * gq + 1] - mean) * rstd * nw[1] + sk[1] * bf_hi(xc.x)) * silu_f(bf_hi(z.x));
                    const float y2 = ((ni[vt][4 * gq + 2] - mean) * rstd * nw[2] + sk[2] * bf_lo(xc.y)) * silu_f(bf_lo(z.y)), y3 = ((ni[vt][4 * gq + 3] - mean) * rstd * nw[3] + sk[3] * bf_hi(xc.y)) * silu_f(bf_hi(z.y));
                    u32x2 w; w.x = pk2(y0, y1); w.y = pk2(y2, y3); *(u32x2*)(B.YM + tok * 1024 + 512 + chn) = w; }
        }
    }
}
constexpr size_t MB = 1048576ull;
constexpr size_t P_WIN_T = 0, P_WOUT_T = P_WIN_T + 4 * MB, P_WQKV_T = P_WOUT_T + 2 * MB, P_WO_T = P_WQKV_T + 3 * MB, P_XWQ_T = P_WO_T + 2 * MB, P_XWKV_T = P_XWQ_T + 4 * MB, P_XWO_T = P_XWKV_T + 8 * MB,
                 P_MLW_T = P_XWO_T + 4 * MB, P_WIFT = P_MLW_T + MB / 2, P_WRT = P_WIFT + MB / 8, P_ROT = P_WRT + MB / 2, P_BQK = P_ROT + MB, P_MEMB = P_BQK + MB / 8, P_KC = P_MEMB + 4 * MB, P_VT = P_KC + 8 * MB,
                 P_W13T = P_VT + 8 * MB, P_W2T = P_W13T + 64 * MB, P_XBF = P_W2T + 32 * MB, P_RT = P_XBF + 64 * MB, P_TMP = P_RT + 2 * MB;
constexpr size_t RT_SRC = 1638400;
constexpr size_t RT_E = 0, RT_W = 262144, RT_RANK = 2 * 262144, RT_DEST = 3 * 262144, RT_HIST = 4 * 262144, RT_TSTART = RT_HIST + 32768;
constexpr size_t T_QX = 0, T_OB = 64 * MB, T_YB = 128 * MB;
constexpr size_t T_K1 = 192 * MB, T_VT1 = 208 * MB;
constexpr size_t T_AU = 0, T_AV = 32 * MB, T_BX = 64 * MB, T_BZ = 96 * MB, T_V = 128 * MB, T_XC = 160 * MB, T_YM = 192 * MB, T_U = 256 * MB, T_CS = 320 * MB,
                 T_GT = 352 * MB, T_UN = 353 * MB, T_NS = 353 * MB + MB / 2, T_SC = 354 * MB, T_YB0 = 0;
constexpr size_t T_XG = 0, T_HM = 152 * MB, T_YG = 0;
constexpr size_t T_SLOT = 356 * MB;
constexpr size_t FAST_END = P_TMP + 360 * MB;
#ifdef PROBE_LNX
constexpr size_t SLOT_MB = 8;
#else
constexpr size_t SLOT_MB = 4;
#endif
constexpr int LDS_BYTES = 147456;

struct FP {
    const float* in[33]; float* X;
    unsigned char* ws;
};
typedef const float* const __attribute__((address_space(4)))* InTab;
struct PV { InTab in; float* X; unsigned char* ws; };
__device__ __forceinline__ PV make_pv(const FP& p0) {
    PV p; InTab kp = (InTab)__builtin_amdgcn_kernarg_segment_ptr(); asm volatile("" : "+s"(kp)); p.in = kp;
    p.X = p0.X; p.ws = p0.ws; asm volatile("" : "+s"(p.ws)); return p;
}
#define WSP(T, off) ((T*)(p.ws + (off)))

__device__ __forceinline__ RouteBufs route_bufs(const PV& p) {
    RouteBufs r; r.e = WSP(int, P_RT + RT_E); r.w = WSP(float, P_RT + RT_W); r.rank = WSP(int, P_RT + RT_RANK); r.dest = WSP(int, P_RT + RT_DEST); r.hist = WSP(int, P_RT + RT_HIST); r.tstart = WSP(int, P_RT + RT_TSTART); r.src = WSP(int, P_RT + RT_SRC); return r;
}
#define PH_ARGS const PV& p, LAS unsigned char* lds, int blk, int G
#define PH_IDS int tid_ = threadIdx.x; asm volatile("" : "+v"(tid_)); const int tid = tid_, lane = tid & 63, wave = __builtin_amdgcn_readfirstlane(tid >> 6); (void)lane; (void)wave;

__device__ __forceinline__ void ph_conv_xattn(PH_ARGS, int l, int& gw) {
    PH_IDS; LAS float* scr = (LAS float*)(lds + wave * 8448); const int ngw = G * NWAVE;
    convert_mats(p.in[23] + (size_t)l * 1024 * 1024, 1024, 1024, 1, 0, WSP(bf16_t, P_XWQ_T) + (size_t)l * 1024 * 1024, 0, RM_IDENT, 0.0625f, 1024, scr, gw, ngw, lane);
    convert_mats(p.in[24] + (size_t)l * 1024 * 2048, 1024, 2048, 1, 0, WSP(bf16_t, P_XWKV_T) + (size_t)l * 2048 * 1024, 0, RM_IDENT, 1.f, 0, scr, gw, ngw, lane);
    convert_mats(p.in[25] + (size_t)l * 1024 * 1024, 1024, 1024, 1, 0, WSP(bf16_t, P_XWO_T) + (size_t)l * 1024 * 1024, 0, RM_IDENT, 1.f, 0, scr, gw, ngw, lane);
    convert_rows(p.in[1], WSP(bf16_t, P_MEMB), (size_t)2048 * 1024, blk * NTHR + tid, G * NTHR);
}
__device__ __forceinline__ void conv_moe_waves(const PV& p, int l, LAS float* scr, int& gw, int ngw, int gt, int ngt, int lane) {
    const size_t wl = (size_t)l * 32 * 1024 * 512;
    convert_mats(p.in[30] + wl, 1024, 512, 32, (size_t)1024 * 512, WSP(bf16_t, P_W13T), (size_t)1024 * 1024, RM_PAIR0, 1.f, 0, scr, gw, ngw, lane);
    convert_mats(p.in[31] + wl, 1024, 512, 32, (size_t)1024 * 512, WSP(bf16_t, P_W13T), (size_t)1024 * 1024, RM_PAIR1, 1.f, 0, scr, gw, ngw, lane);
    convert_mats(p.in[32] + wl, 512, 1024, 32, (size_t)512 * 1024, WSP(bf16_t, P_W2T), (size_t)1024 * 512, RM_IDENT, 1.f, 0, scr, gw, ngw, lane);
    bf16_t* wrt = WSP(bf16_t, P_WRT) + (size_t)l * 2 * 64 * 1024; const float* wre = p.in[28] + (size_t)l * 1024 * 32; const float* wrg = p.in[26] + (size_t)l * 1024 * 4;
    for (int i = gt; i < 64 * 1024; i += ngt) { const int r = i >> 10, k = i & 1023;
        const float v = r < 32 ? wre[k * 32 + r] : (r < 36 ? wrg[k * 4 + (r - 32)] : 0.f);
        const bf16_t h = f2bf(v); wrt[i] = h; wrt[64 * 1024 + i] = f2bf(v - bf2f(h)); }
}
__device__ __forceinline__ void ph_conv_moe(PH_ARGS, int l, int& gw) {
    PH_IDS; conv_moe_waves(p, l, (LAS float*)(lds + wave * 8448), gw, G * NWAVE, blk * NTHR + tid, G * NTHR, lane);
}
__device__ __forceinline__ void ph_x_to_bf(PH_ARGS) { PH_IDS; convert_rows(p.X, WSP(bf16_t, P_XBF), (size_t)NT * 1024, blk * NTHR + tid, G * NTHR); }

__device__ __forceinline__ void set_job(LAS pg8::JobDesc* jt, int j, const void* A, const void* B, int nM, int nN, void* out, int ldc, int mode, const void* bias = nullptr, const void* rot = nullptr, void* out2 = nullptr) {
    unsigned long long a = (unsigned long long)A, b = (unsigned long long)B, o = (unsigned long long)out, bi = (unsigned long long)bias, ro = (unsigned long long)rot, o2 = (unsigned long long)out2;
    asm volatile("" : "+s"(a), "+s"(b), "+s"(o), "+s"(bi), "+s"(ro), "+s"(o2), "+s"(nM), "+s"(nN), "+s"(ldc), "+s"(mode));
    LAS pg8::JobDesc* d = jt + j; d->A = a; d->B = b; d->out = o; d->bias = bi; d->rot = ro; d->out2 = o2;
    d->nM = nM; d->nN = nN; d->ldc = ldc; d->mode = mode;
}
#define JT_PTR ((LAS pg8::JobDesc*)(lds + pg8::JT_OFF))
__device__ __forceinline__ void run_jobs(LAS unsigned char* lds, int K, int n0, int n1, int n2, int blk, int G) {
    __syncthreads();
    pg8::Jobs3 S; S.jt = JT_PTR; S.n0 = n0; S.n1 = n1; S.n2 = n2; S.K = K; S.G = G; S.c = blk;
    EpiMulti E; E.jt = JT_PTR;
    pg8::gemm_phase<EpiMulti, pg8::Jobs3, true, true>(lds, K, S, E);
}
__device__ __forceinline__ void ph_xattn_g1(PH_ARGS, int l) {
    const bf16_t* wkv = WSP(bf16_t, P_XWKV_T) + (size_t)l * 2048 * 1024;
    __syncthreads();
    if (threadIdx.x == 0) {
        set_job(JT_PTR, 0, WSP(bf16_t, P_MEMB), wkv, 8, 4, WSP(bf16_t, P_KC) + (size_t)l * 2048 * 1024, 1024, EM_PLAIN);
        set_job(JT_PTR, 1, wkv + (size_t)1024 * 1024, WSP(bf16_t, P_MEMB), 4, 8, WSP(bf16_t, P_VT) + (size_t)l * 1024 * 2048, 2048, EM_PLAIN);
        set_job(JT_PTR, 2, WSP(bf16_t, P_XBF), WSP(bf16_t, P_XWQ_T) + (size_t)l * 1024 * 1024, 128, 4, WSP(bf16_t, P_TMP + T_QX), 1024, EM_PLAIN);
    }
    run_jobs(lds, 1024, 32, 32, 512, blk, G);
}
__device__ __forceinline__ void ph_xattn_attn(PH_ARGS, int l) {
    xattn_phase(lds, WSP(bf16_t, P_TMP + T_QX), WSP(bf16_t, P_KC) + (size_t)l * 2048 * 1024, WSP(bf16_t, P_VT) + (size_t)l * 1024 * 2048, WSP(bf16_t, P_TMP + T_OB), blk, G);
}
__device__ __forceinline__ void ph_gemm_plain(PH_ARGS, const bf16_t* A, const bf16_t* Bt, bf16_t* out) {
    __syncthreads();
    if (threadIdx.x == 0) set_job(JT_PTR, 0, A, Bt, 128, 4, out, 1024, EM_PLAIN);
    run_jobs(lds, 1024, 512, 0, 0, blk, G);
}
template <bool XF32, bool OUTF32, bool MOE>
__device__ __forceinline__ void ph_ln(PH_ARGS, const bf16_t* y, int lnidx, bool dry = false) {
    PH_IDS; LnArgs a; a.xin32 = p.in[0]; a.xin = WSP(bf16_t, P_XBF); a.xout32 = dry ? WSP(float, P_TMP + 200 * MB) : p.X; a.xbf = dry ? WSP(bf16_t, P_TMP + 288 * MB) : WSP(bf16_t, P_XBF); a.y = y; a.g = p.in[2] + lnidx * 1024; a.b = p.in[3] + lnidx * 1024;
    a.dest = WSP(int, P_RT + RT_DEST); a.wts = WSP(float, P_RT + RT_W);
    ln_phase<XF32, OUTF32, MOE>(a, blk, G, wave, lane);
}
__device__ __forceinline__ void ph_moe_route(PH_ARGS, int l) {
    moe_router_phase(lds, WSP(bf16_t, P_XBF), WSP(bf16_t, P_WRT) + (size_t)l * 2 * 64 * 1024, p.in[27] + l * 4, p.in[29] + l * 32, route_bufs(p), blk);
}
__device__ __forceinline__ void ph_moe_scatter(PH_ARGS) { moe_scatter_phase(lds, route_bufs(p), blk, G); }
__device__ __forceinline__ void ph_moe_g1(PH_ARGS) {
    __syncthreads();
    if (threadIdx.x == 0) set_job(JT_PTR, 0, nullptr, nullptr, 0, 0, WSP(bf16_t, P_TMP + T_HM), 512, EM_SWIGLU);
    __syncthreads();
    MoeSched S; S.A = (const char*)WSP(bf16_t, P_TMP + T_XG); S.B = (const char*)WSP(bf16_t, P_W13T); S.tstart = WSP(int, P_RT + RT_TSTART); S.K = 1024; S.nN = 4; S.G = G; S.c = blk; S.bexp = (size_t)1024 * 1024 * 2;
    EpiMulti E; E.jt = JT_PTR;
    pg8::gemm_phase<EpiMulti, MoeSched, true, true>(lds, 1024, S, E);
}
__device__ __forceinline__ void ph_moe_g2(PH_ARGS) {
    __syncthreads();
    if (threadIdx.x == 0) set_job(JT_PTR, 0, nullptr, nullptr, 0, 0, WSP(bf16_t, P_TMP + T_YG), 1024, EM_PLAIN);
    __syncthreads();
    MoeSched S; S.A = (const char*)WSP(bf16_t, P_TMP + T_HM); S.B = (const char*)WSP(bf16_t, P_W2T); S.tstart = WSP(int, P_RT + RT_TSTART); S.K = 512; S.nN = 4; S.G = G; S.c = blk; S.bexp = (size_t)1024 * 512 * 2;
    EpiMulti E; E.jt = JT_PTR;
    pg8::gemm_phase<EpiMulti, MoeSched, true, true>(lds, 512, S, E);
}

__device__ __forceinline__ void ph_conv_l1(PH_ARGS, int& gw) {
    PH_IDS; LAS float* scr = (LAS float*)(lds + wave * 8448); const int ngw = G * NWAVE;
    convert_mats(p.in[19], 1024, 1536, 1, 0, WSP(bf16_t, P_WQKV_T), 0, RM_ROT, 0.125f, 1024, scr, gw, ngw, lane);
    convert_mats(p.in[22], 1024, 1024, 1, 0, WSP(bf16_t, P_WO_T), 0, RM_IDENT, 1.f, 0, scr, gw, ngw, lane);
    const int gt = blk * NTHR + tid, ngt = G * NTHR;
    float* bqk = WSP(float, P_BQK);
    for (int n = gt; n < 1280; n += ngt) bqk[rowmap(RM_ROT, n)] = p.in[20][n] * (n < 1024 ? 0.125f : 1.f);
    float* rot = WSP(float, P_ROT);
    for (int i = gt; i < 4096 * 32; i += ngt) { const int pos = i >> 5, k = i & 31; const float inv = powf(10000.f, -(float)(2 * k) / 64.f); const float ang = (float)pos * inv; rot[2 * i] = cosf(ang); rot[2 * i + 1] = sinf(ang); }
}
__device__ __forceinline__ void ph_l1_g1(PH_ARGS) {
    __syncthreads();
    if (threadIdx.x == 0) {
        set_job(JT_PTR, 0, WSP(bf16_t, P_XBF), WSP(bf16_t, P_WQKV_T), 128, 5, WSP(bf16_t, P_TMP + T_QX), 1024, EM_ROTARY, WSP(float, P_BQK), WSP(float, P_ROT), WSP(bf16_t, P_TMP + T_K1));
        set_job(JT_PTR, 1, WSP(bf16_t, P_WQKV_T) + (size_t)1280 * 1024, WSP(bf16_t, P_XBF), 1, 128, WSP(bf16_t, P_TMP + T_VT1), NT, EM_ROWBIAS, p.in[20] + 1280);
    }
    run_jobs(lds, 1024, 640, 128, 0, blk, G);
}
__device__ __forceinline__ void ph_l1_swa(PH_ARGS) {
    swa_phase(lds, WSP(bf16_t, P_TMP + T_QX), WSP(bf16_t, P_TMP + T_K1), WSP(bf16_t, P_TMP + T_VT1), p.in[21], WSP(bf16_t, P_TMP + T_OB), blk, G);
}

__device__ __forceinline__ L0Bufs l0_bufs(const PV& p) {
    L0Bufs B; B.AU = WSP(bf16_t, P_TMP + T_AU); B.AV = WSP(bf16_t, P_TMP + T_AV); B.BX = WSP(bf16_t, P_TMP + T_BX); B.BZ = WSP(bf16_t, P_TMP + T_BZ); B.V = WSP(bf16_t, P_TMP + T_V); B.XC = WSP(bf16_t, P_TMP + T_XC);
    B.YM = WSP(bf16_t, P_TMP + T_YM); B.CS = WSP(bf16_t, P_TMP + T_CS); B.U = WSP(bf16_t, P_TMP + T_U); B.GT = WSP(float, P_TMP + T_GT); B.UN = WSP(float, P_TMP + T_UN); B.NS = WSP(float, P_TMP + T_NS); B.SC = WSP(float, P_TMP + T_SC);
    B.Q = B.AU; B.K = B.AV;
    B.WQT = WSP(bf16_t, P_MLW_T); B.GMW = WSP(bf16_t, P_MLW_T) + 12 * 16384; B.MT = WSP(bf16_t, P_WIFT);
    B.gm_g = p.in[5]; B.gm_b = p.in[6]; B.gm_bs = p.in[8]; B.cw = p.in[9]; B.cb = p.in[10]; B.bif = p.in[15]; B.nw = p.in[16]; B.skip = p.in[17]; return B;
}
__device__ __forceinline__ void ph_scan_conv(PH_ARGS) {
    PH_IDS;
    if (wave < 4) l0_scan(l0_bufs(p), blk, tid);
}
__device__ __forceinline__ void ph_conv_l0(PH_ARGS, int& gwr) {
    PH_IDS; LAS float* scr = (LAS float*)(lds + wave * 8448); const int gw = blk * NWAVE + wave, ngw = G * NWAVE;
    convert_mats(p.in[4], 1024, 2048, 1, 0, WSP(bf16_t, P_WIN_T), 0, RM_IDENT, 1.f, 0, scr, gwr, ngw, lane);
    convert_mats(p.in[18], 1024, 1024, 1, 0, WSP(bf16_t, P_WOUT_T), 0, RM_IDENT, 1.f, 0, scr, gwr, ngw, lane);
    convert_mats(p.in[11], 128, 128, 4, 16384, WSP(bf16_t, P_MLW_T), 16384, RM_IDENT, 1.f, 0, scr, gwr, ngw, lane);
    convert_mats(p.in[12], 128, 128, 4, 16384, WSP(bf16_t, P_MLW_T) + 4 * 16384, 16384, RM_IDENT, 1.f, 0, scr, gwr, ngw, lane);
    convert_mats(p.in[13], 128, 128, 4, 16384, WSP(bf16_t, P_MLW_T) + 8 * 16384, 16384, RM_IDENT, 1.f, 0, scr, gwr, ngw, lane);
    const int gt = blk * NTHR + tid, ngt = G * NTHR;
    bf16_t* gmw = WSP(bf16_t, P_MLW_T) + 12 * 16384;
    for (int i = gt; i < 4 * 16384; i += ngt) { const int t = (i >> 7) & 127, sidx = i & 127; gmw[i] = f2bf(sidx <= t ? p.in[7][i] : 0.f); }
    bf16_t* mt = WSP(bf16_t, P_WIFT);
    for (int i = gw; i < 4 * 8 * 256; i += ngw) { const int h = i >> 11, g = (i >> 8) & 7, j = i & 255, d = j & 127; float a = 0.f;
        for (int e = lane; e < 128; e += 64) {
            if (j < 128) a += p.in[11][((size_t)h * 128 + d) * 128 + e] * p.in[14][(h * 128 + e) * 8 + g] + p.in[12][((size_t)h * 128 + d) * 128 + e] * p.in[14][(512 + h * 128 + e) * 8 + g];
            else a += p.in[13][((size_t)h * 128 + d) * 128 + e] * p.in[14][(1024 + h * 128 + e) * 8 + g]; }
        a += shx(a, 32, lane); a += shx(a, 16, lane); a += shx(a, 8, lane); a += shx(a, 4, lane); a += shx(a, 2, lane); a += shx(a, 1, lane);
        if (lane == 0) mt[i] = f2bf(a); }
}
__device__ __forceinline__ void ph_xin_to_bf(PH_ARGS) { PH_IDS; convert_rows(p.in[0], WSP(bf16_t, P_XBF), (size_t)NT * 1024, blk * NTHR + tid, G * NTHR); }
__device__ __forceinline__ void ph_l0_g1(PH_ARGS) {
    __syncthreads();
    if (threadIdx.x == 0) set_job(JT_PTR, 0, WSP(bf16_t, P_XBF), WSP(bf16_t, P_WIN_T), 128, 8, WSP(bf16_t, P_TMP + T_AU), 512, EM_GELU4);
    run_jobs(lds, 1024, 1024, 0, 0, blk, G);
}

enum { K_CONV_XATTN = 0, K_CONV_MOE, K_X2BF, K_XATTN_G1, K_XATTN_ATTN, K_XATTN_G2, K_LN_Y, K_MOE_ROUTE, K_MOE_SCATTER, K_MOE_G1, K_MOE_G2, K_LN_MOE, K_CONV_L1, K_L1_G1, K_L1_SWA, K_L1_G2, K_CONV_L0, K_XIN2BF, K_L0_G1, K_L0_MIXA, K_L0_SCAN, K_L0_MIXC, K_L0_G2, K_LN_Y0 };
template <int PH>
__global__ void __launch_bounds__(NTHR, 2) k_phase(FP p0, int l, int lnidx) {
    const PV p = make_pv(p0);
    extern __shared__ __attribute__((aligned(16))) unsigned char smem[];
    LAS unsigned char* lds = (LAS unsigned char*)smem;
    const int blk = blockIdx.x, G = gridDim.x;
    if constexpr (PH == K_CONV_XATTN) { int gwr = blk * NWAVE + (threadIdx.x >> 6); ph_conv_xattn(p, lds, blk, G, l, gwr); }
    if constexpr (PH == K_CONV_MOE) { int gwr = blk * NWAVE + (threadIdx.x >> 6); ph_conv_moe(p, lds, blk, G, l, gwr); }
    if constexpr (PH == K_X2BF) ph_x_to_bf(p, lds, blk, G);
    if constexpr (PH == K_XATTN_G1) ph_xattn_g1(p, lds, blk, G, l);
    if constexpr (PH == K_XATTN_ATTN) ph_xattn_attn(p, lds, blk, G, l);
    if constexpr (PH == K_XATTN_G2) ph_gemm_plain(p, lds, blk, G, WSP(bf16_t, P_TMP + T_OB), WSP(bf16_t, P_XWO_T) + (size_t)l * 1024 * 1024, WSP(bf16_t, P_TMP + T_YB));
    if constexpr (PH == K_LN_Y) ph_ln<false, false, false>(p, lds, blk, G, WSP(bf16_t, P_TMP + T_YB), lnidx);
    if constexpr (PH == K_MOE_ROUTE) ph_moe_route(p, lds, blk, G, l);
    if constexpr (PH == K_MOE_SCATTER) ph_moe_scatter(p, lds, blk, G);
    if constexpr (PH == K_MOE_G1) ph_moe_g1(p, lds, blk, G);
    if constexpr (PH == K_MOE_G2) ph_moe_g2(p, lds, blk, G);
    if constexpr (PH == K_LN_MOE) ph_ln<false, false, true>(p, lds, blk, G, WSP(bf16_t, P_TMP + T_YG), lnidx);
    if constexpr (PH == K_CONV_L0) { int gwr = blk * NWAVE + (threadIdx.x >> 6); ph_conv_l0(p, lds, blk, G, gwr); }
    if constexpr (PH == K_XIN2BF) ph_xin_to_bf(p, lds, blk, G);
    if constexpr (PH == K_L0_G1) ph_l0_g1(p, lds, blk, G);
    if constexpr (PH == K_L0_MIXA) l0_mixA(lds, l0_bufs(p), blk, G);
    if constexpr (PH == K_L0_SCAN) ph_scan_conv(p, lds, blk, G);
    if constexpr (PH == K_L0_MIXC) l0_mixC(lds, l0_bufs(p), blk, G);
    if constexpr (PH == K_L0_G2) ph_gemm_plain(p, lds, blk, G, WSP(bf16_t, P_TMP + T_YM), WSP(bf16_t, P_WOUT_T), WSP(bf16_t, P_TMP + T_YB0));
    if constexpr (PH == K_LN_Y0) ph_ln<true, false, false>(p, lds, blk, G, WSP(bf16_t, P_TMP + T_YB0), 0);
    if constexpr (PH == K_CONV_L1) { int gwr = blk * NWAVE + (threadIdx.x >> 6); ph_conv_l1(p, lds, blk, G, gwr); }
    if constexpr (PH == K_L1_G1) ph_l1_g1(p, lds, blk, G);
    if constexpr (PH == K_L1_SWA) ph_l1_swa(p, lds, blk, G);
    if constexpr (PH == K_L1_G2) ph_gemm_plain(p, lds, blk, G, WSP(bf16_t, P_TMP + T_OB), WSP(bf16_t, P_WO_T), WSP(bf16_t, P_TMP + T_YB));
}

#define XB_TMO      128
#define XB_XCNT(j)  (256  + 64 * (j))
#define XB_XSUB(j)  (1280 + 64 * (j))
#define XB_XGEN(j)  (2304 + 64 * (j))
#define XB_TOP      3328
#define XB_TOPGEN   3392
#define XCD_BAR_WORDS 3456
#define XB_SPIN_CAP (1u << 22)
__device__ __forceinline__ unsigned xb_ld(unsigned* p)              { return __hip_atomic_load(p, __ATOMIC_RELAXED, __HIP_MEMORY_SCOPE_AGENT); }
__device__ __forceinline__ unsigned xb_add(unsigned* p, unsigned v) { return __hip_atomic_fetch_add(p, v, __ATOMIC_RELAXED, __HIP_MEMORY_SCOPE_AGENT); }
__device__ __forceinline__ unsigned xb_xcc_id() { return (unsigned)__builtin_amdgcn_s_getreg((3 << 11) | 20) & 0xFu; }
#define XB_SPIN(cond, bar) do { unsigned _sp = 0; while (cond) { __builtin_amdgcn_s_sleep(1); \
    if ((++_sp & 255u) == 0u) { if (xb_ld(&(bar)[XB_TMO])) break; if (_sp > XB_SPIN_CAP) { atomicAdd(&(bar)[XB_TMO], 1u); break; } } } } while (0)
struct XcdBarrier { unsigned* bar; unsigned x; volatile LAS unsigned* st; };
__device__ __forceinline__ XcdBarrier xcd_barrier_post(unsigned* bar, volatile LAS unsigned* st) {
    XcdBarrier b; b.bar = bar; b.x = xb_xcc_id(); b.st = st;
    if (threadIdx.x == 0) (void)xb_add(&bar[XB_XCNT(b.x)], 1u);
    return b;
}
__device__ __forceinline__ void xcd_barrier_complete(unsigned* bar, unsigned x, unsigned& nloc, unsigned& nx) {
    const unsigned G = gridDim.x * gridDim.y * gridDim.z;
    unsigned sum, cnt, mine, sp = 0u;
    for (;;) {
        sum = 0u; cnt = 0u; mine = 0u;
#pragma unroll
        for (unsigned j = 0; j < 16; ++j) { const unsigned c = xb_ld(&bar[XB_XCNT(j)]); sum += c; cnt += (c > 0u) ? 1u : 0u; mine = (j == x) ? c : mine; }
        if (sum == G) break;
        __builtin_amdgcn_s_sleep(1);
        if ((++sp & 255u) == 0u) { if (xb_ld(&bar[XB_TMO])) break; if (sp > XB_SPIN_CAP) { atomicAdd(&bar[XB_TMO], 1u); break; } }
    }
    nloc = mine > 0u ? mine : 1u; nx = cnt > 0u ? cnt : 1u;
}
__device__ __forceinline__ void xcd_barrier(const XcdBarrier& b) {
    asm volatile("s_waitcnt vmcnt(0)" ::: "memory");
    __syncthreads();
    if (threadIdx.x == 0) {
        unsigned* bar = b.bar; asm volatile("" : "+s"(bar));
        __builtin_amdgcn_s_waitcnt(0);
        unsigned nloc = b.st[0], nx = b.st[1];
        if (nloc == 0u) { xcd_barrier_complete(bar, b.x, nloc, nx); b.st[0] = nloc; b.st[1] = nx; }
        const unsigned old = xb_add(&bar[XB_XSUB(b.x)], 1u);
        const unsigned gen = old / nloc;
        if (old + 1u == (gen + 1u) * nloc) {
            __builtin_amdgcn_fence(__ATOMIC_RELEASE, "agent");
            asm volatile("s_waitcnt vmcnt(0)" ::: "memory");
            const unsigned og = xb_add(&bar[XB_TOP], 1u);
            const unsigned tg = og / nx;
            if (og + 1u == (tg + 1u) * nx) xb_add(&bar[XB_TOPGEN], 1u);
            else XB_SPIN(xb_ld(&bar[XB_TOPGEN]) == tg, bar);
            __builtin_amdgcn_fence(__ATOMIC_ACQUIRE, "agent");
            xb_add(&bar[XB_XGEN(b.x)], 1u);
            asm volatile("s_waitcnt vmcnt(0)" ::: "memory");
        } else {
            XB_SPIN(xb_ld(&bar[XB_XGEN(b.x)]) == gen, bar);
            __builtin_amdgcn_fence(__ATOMIC_ACQUIRE, "agent");
            asm volatile("s_waitcnt vmcnt(0)" ::: "memory");
        }
    }
    __syncthreads();
}
constexpr size_t P_BAR = P_RT + 1572864;
constexpr int LDS_BARW = LDS_BYTES - 16;

struct SchedAll {
    const LAS pg8::JobDesc* jt; int n0, n1, n2, n3, n4; int K, G, c; int moe; const char* A; const char* B; const int* tstart; const int* src; int nN; size_t bexp;
    __device__ __forceinline__ pg8::Unit get(int i, bool& ok) const {
        const char* ua = nullptr; const char* ub = nullptr; const int* us = nullptr; int upm = 0, upn = 0, ujob = 0; bool good = false;
        if (moe) {
            const int vc = (c & 7) * (G >> 3) + (c >> 3);
            const long L = (long)i * G + vc; const int ntile = tstart[32];
            if (L < (long)ntile * nN) {
                const int mt = (int)(L / nN), nt = (int)(L % nN);
                int e = 0;
                for (int k = 1; k < 32; ++k) if (tstart[k] <= mt) e = k;
                ua = src ? A : A + (size_t)mt * 256 * K * 2; us = src ? src + mt * 256 : nullptr; ub = B + (size_t)e * bexp + (size_t)nt * 256 * K * 2; upm = mt; upn = nt; good = true;
            }
        } else {
            long L = (long)i * G + c;
            if (L < (long)n0 + n1 + n2 + n3 + n4) {
                int l = (int)L; int jb = 0;
                if (l >= n0) { l -= n0; jb = 1; if (l >= n1) { l -= n1; jb = 2; if (l >= n2) { l -= n2; jb = 3; if (l >= n3) { l -= n3; jb = 4; } } } }
                const int jM = __builtin_amdgcn_readfirstlane(jt[jb].nM), jN = __builtin_amdgcn_readfirstlane(jt[jb].nN);
                int pm, pn; pg8::tile_order(l, jM, jN, pm, pn);
                const size_t tstep = (size_t)pg8::BM * K * 2;
                ua = (const char*)pg8::rfl64(jt[jb].A) + (size_t)pm * tstep; ub = (const char*)pg8::rfl64(jt[jb].B) + (size_t)pn * tstep; upm = pm; upn = pn; ujob = jb; good = true;
            }
        }
        pg8::Unit u; u.A = ua; u.B = ub; u.src = us; u.pm = upm; u.pn = upn; u.job = ujob; ok = good; return u;
    }
};
enum { MP_CONV = 0, MP_L0_G1, MP_L0_MIXA, MP_L0_SCAN, MP_L0_MIXC, MP_L0_G2, MP_XA_G1, MP_XA_ATTN, MP_XA_G2, MP_ROUTE, MP_SCATTER, MP_MOE_G1, MP_MOE_G2, MP_LN_MOE, MP_L1_G1, MP_L1_SWA, MP_L1_G2 };
struct SchedLN {
    const char* A; const char* B; int G, c;
    __device__ __forceinline__ pg8::Unit get(int i, bool& ok) const {
        const int L = i * G + c; const bool good = L < 512; int pm = 0, pn = 0; if (good) pg8::tile_order(L, 128, 4, pm, pn);
        const size_t tstep = (size_t)pg8::BM * 1024 * 2;
        pg8::Unit u; u.A = A + (size_t)pm * tstep; u.B = B + (size_t)pn * tstep; u.src = nullptr; u.pm = pm; u.pn = pn; u.job = 0; ok = good; return u;
    }
};
__device__ __forceinline__ int prog_kind(int i) {
    switch (i) { case 0: return MP_CONV; case 1: return MP_L0_G1; case 2: return MP_L0_MIXA; case 3: return MP_L0_SCAN; case 4: return MP_L0_MIXC; case 5: return MP_L0_G2;
        case 6: case 17: return MP_XA_G1; case 7: case 18: return MP_XA_ATTN; case 8: case 19: return MP_XA_G2; case 9: case 20: return MP_ROUTE; case 10: case 21: return MP_SCATTER;
        case 11: case 22: return MP_MOE_G1; case 12: case 23: return MP_MOE_G2; case 13: case 24: return MP_LN_MOE; case 14: return MP_L1_G1; case 15: return MP_L1_SWA; default: return MP_L1_G2; }
}
constexpr int N_PROG = 25;
__global__ void __launch_bounds__(NTHR, 2) mega(FP p0) {
    extern __shared__ __attribute__((aligned(16))) unsigned char smem[];
    LAS unsigned char* lds = (LAS unsigned char*)smem;
    cooperative_groups::grid_group grid = cooperative_groups::this_grid();
    const int blk0 = blockIdx.x, G0 = gridDim.x;
    volatile LAS unsigned* bst = (volatile LAS unsigned*)(lds + LDS_BARW);
    if (threadIdx.x == 0) { bst[0] = 0u; bst[1] = 0u; }
    __syncthreads();
    const XcdBarrier xbar = xcd_barrier_post((unsigned*)(p0.ws + P_BAR), bst);
    int dup = 0; (void)dup;
#pragma unroll 1
    for (int pi = 0; pi < N_PROG; ++pi) {
        int blk = blk0, G = G0; asm volatile("" : "+s"(blk), "+s"(G));
        const PV p = make_pv(p0);
        const int kind = prog_kind(pi), l = pi >= 14 ? 1 : 0;
        const bool is_gemm = kind == MP_L0_G1 || kind == MP_XA_G1 || kind == MP_MOE_G1 || kind == MP_MOE_G2 || kind == MP_L1_G1;
        const bool is_lnf = kind == MP_L0_G2 || kind == MP_XA_G2 || kind == MP_L1_G2;
        if (is_lnf) {
            const int site = kind == MP_L0_G2 ? 0 : (kind == MP_L1_G2 ? 2 : 1 + 2 * l), lnidx = kind == MP_L0_G2 ? 0 : (kind == MP_L1_G2 ? 3 : 1 + 3 * l);
            SchedLN S; S.G = G; S.c = blk;
            S.A = (const char*)(kind == MP_L0_G2 ? WSP(bf16_t, P_TMP + T_YM) : WSP(bf16_t, P_TMP + T_OB));
            S.B = (const char*)(kind == MP_L0_G2 ? WSP(bf16_t, P_WOUT_T) : (kind == MP_L1_G2 ? WSP(bf16_t, P_WO_T) : WSP(bf16_t, P_XWO_T) + (size_t)l * 1024 * 1024));
            __syncthreads();
            if (threadIdx.x == 0) set_job(JT_PTR, 0, nullptr, nullptr, 128, 4, WSP(bf16_t, P_XBF), 1024, 0, p.in[2] + lnidx * 1024, p.in[3] + lnidx * 1024, WSP(unsigned long long, P_TMP + T_SLOT) + (size_t)site * 131072);
            EpiLN E; E.lds = lds;
            __syncthreads();
            pg8::gemm_phase<EpiLN, SchedLN, true, true>(lds, 1024, S, E);
        } else if (is_gemm) {
            SchedAll S; S.jt = JT_PTR; S.n0 = S.n1 = S.n2 = S.n3 = S.n4 = 0; S.K = 1024; S.G = G; S.c = blk; S.moe = 0; S.A = S.B = nullptr; S.tstart = WSP(int, P_RT + RT_TSTART); S.src = nullptr; S.nN = 4; S.bexp = 0;
            __syncthreads();
            if (threadIdx.x == 0) {
                if (kind == MP_L0_G1) set_job(JT_PTR, 0, WSP(bf16_t, P_XBF), WSP(bf16_t, P_WIN_T), 128, 8, WSP(bf16_t, P_TMP + T_AU), 512, EM_GELU4);
                if (kind == MP_XA_G1) {
                    set_job(JT_PTR, 0, WSP(bf16_t, P_XBF), WSP(bf16_t, P_XWQ_T) + (size_t)l * 1024 * 1024, 128, 4, WSP(bf16_t, P_TMP + T_QX), 1024, EM_PLAIN);
                    if (l == 0) { for (int ll = 0; ll < 2; ++ll) { const bf16_t* wkv = WSP(bf16_t, P_XWKV_T) + (size_t)ll * 2048 * 1024;
                        set_job(JT_PTR, 1 + 2 * ll, WSP(bf16_t, P_MEMB), wkv, 8, 4, WSP(bf16_t, P_KC) + (size_t)ll * 2048 * 1024, 1024, EM_PLAIN);
                        set_job(JT_PTR, 2 + 2 * ll, wkv + (size_t)1024 * 1024, WSP(bf16_t, P_MEMB), 4, 8, WSP(bf16_t, P_VT) + (size_t)ll * 1024 * 2048, 2048, EM_PLAIN); } } }
                if (kind == MP_MOE_G1) set_job(JT_PTR, 0, nullptr, nullptr, 0, 0, WSP(bf16_t, P_TMP + T_HM), 512, EM_SWIGLU);
                if (kind == MP_MOE_G2) set_job(JT_PTR, 0, nullptr, nullptr, 0, 0, WSP(bf16_t, P_TMP + T_YG), 1024, EM_PLAIN);
                if (kind == MP_L1_G1) { set_job(JT_PTR, 0, WSP(bf16_t, P_XBF), WSP(bf16_t, P_WQKV_T), 128, 5, WSP(bf16_t, P_TMP + T_QX), 1024, EM_ROTARY, WSP(float, P_BQK), WSP(float, P_ROT), WSP(bf16_t, P_TMP + T_K1));
                    set_job(JT_PTR, 1, WSP(bf16_t, P_WQKV_T) + (size_t)1280 * 1024, WSP(bf16_t, P_XBF), 1, 128, WSP(bf16_t, P_TMP + T_VT1), NT, EM_ROWBIAS, p.in[20] + 1280); }
            }
            if (kind == MP_L0_G1) S.n0 = 1024;
            if (kind == MP_XA_G1) { S.n0 = 512; if (l == 0) { S.n1 = 32; S.n2 = 32; S.n3 = 32; S.n4 = 32; } }
            if (kind == MP_L1_G1) { S.n0 = 640; S.n1 = 128; }
            if (kind == MP_MOE_G1) { S.moe = 1; S.A = (const char*)WSP(bf16_t, P_XBF); S.src = WSP(int, P_RT + RT_SRC); S.B = (const char*)WSP(bf16_t, P_W13T); S.bexp = (size_t)1024 * 1024 * 2; }
            if (kind == MP_MOE_G2) { S.moe = 1; S.K = 512; S.A = (const char*)WSP(bf16_t, P_TMP + T_HM); S.B = (const char*)WSP(bf16_t, P_W2T); S.bexp = (size_t)1024 * 512 * 2; }
            __syncthreads();
            EpiMulti E; E.jt = JT_PTR;
#ifdef PROBE_GEMM2
#pragma unroll 1
            for (int rep = 0; rep < 2; ++rep)
#endif
            pg8::gemm_phase<EpiMulti, SchedAll, true, true>(lds, S.K, S, E);
        } else {
#ifdef PROBE_MASK
#define DRY (dup == 0 && (((PROBE_MASK) >> kind) & 1))
#else
#define DRY false
#endif
            switch (kind) {
                case MP_CONV: { int gwr = blk * NWAVE + __builtin_amdgcn_readfirstlane((int)threadIdx.x >> 6);
                    ph_conv_l0(p, lds, blk, G, gwr); ph_conv_l1(p, lds, blk, G, gwr); ph_conv_xattn(p, lds, blk, G, 0, gwr); ph_conv_xattn(p, lds, blk, G, 1, gwr); ph_conv_moe(p, lds, blk, G, 0, gwr); ph_xin_to_bf(p, lds, blk, G); } break;
                case MP_L0_MIXA: l0_mixA(lds, l0_bufs(p), blk, G); break;
                case MP_L0_SCAN: ph_scan_conv(p, lds, blk, G); break;
                case MP_L0_MIXC: l0_mixC(lds, l0_bufs(p), blk, G); break;
                case MP_XA_ATTN: ph_xattn_attn(p, lds, blk, G, l); break;
                case MP_ROUTE: ph_moe_route(p, lds, blk, G, l); break;
                case MP_SCATTER: ph_moe_scatter(p, lds, blk, G); break;
                case MP_LN_MOE: if (l == 0) { ph_ln<false, false, true>(p, lds, blk, G, WSP(bf16_t, P_TMP + T_YG), 2, DRY); if (!(DRY)) { int gwr = blk * NWAVE + __builtin_amdgcn_readfirstlane((int)threadIdx.x >> 6); ph_conv_moe(p, lds, blk, G, 1, gwr); } } else ph_ln<false, true, true>(p, lds, blk, G, WSP(bf16_t, P_TMP + T_YG), 5, DRY); break;
                default: ph_l1_swa(p, lds, blk, G); break;
            }
        }
#ifdef PROBE_MASK
        if (((PROBE_MASK) >> kind) & 1) { if (dup == 0) { dup = 1; xcd_barrier(xbar); --pi; continue; } dup = 0; }
#endif
        if (pi + 1 < N_PROG) { if (p0.ws == nullptr) grid.sync(); else { xcd_barrier(xbar);
#ifdef PROBE_BAR2
            xcd_barrier(xbar);
#endif
        } }
    }
}
}
extern "C" void kernel_launch(void* const* d_in, const int* in_sizes, int n_in, void* d_out, int out_size, void* d_ws, size_t ws_size, hipStream_t stream) {
    static int ok = 0;
    if (ok == 0) {
        ok = -1;
        if (n_in != 33 || out_size != 32768 * 1024 || ws_size < fk::FAST_END + (fk::SLOT_MB - 4) * fk::MB) { fprintf(stderr, "kernel_launch: unexpected shapes/ws (%d, %d, %zu)\n", n_in, out_size, ws_size); return; }
        int dev = 0, cus = 0, per_cu = 0;
        if (hipGetDevice(&dev) != hipSuccess || hipDeviceGetAttribute(&cus, hipDeviceAttributeMultiprocessorCount, dev) != hipSuccess) return;
        if (hipFuncSetAttribute((const void*)fk::mega, hipFuncAttributeMaxDynamicSharedMemorySize, fk::LDS_BYTES) != hipSuccess) return;
        if (hipOccupancyMaxActiveBlocksPerMultiprocessor(&per_cu, (const void*)fk::mega, fk::NTHR, fk::LDS_BYTES) != hipSuccess || per_cu < 1 || cus * per_cu < 256) { fprintf(stderr, "kernel_launch: cannot co-reside 256 workgroups (%d CUs x %d)\n", cus, per_cu); return; }
        ok = 1;
    }
    if (ok < 0) return;
    fk::FP p{}; for (int i = 0; i < 33; ++i) p.in[i] = (const float*)d_in[i]; p.X = (float*)d_out; p.ws = (unsigned char*)d_ws;
    if (hipMemsetAsync((char*)d_ws + fk::P_BAR, 0, 16384, stream) != hipSuccess) return;
    if (hipMemsetAsync((char*)d_ws + fk::P_TMP + fk::T_SLOT, 0xFF, fk::SLOT_MB * fk::MB, stream) != hipSuccess) return;
    void* args[] = {&p};
    hipError_t e = hipLaunchCooperativeKernel((const void*)fk::mega, dim3(256), dim3(fk::NTHR), args, fk::LDS_BYTES, stream);
    if (e != hipSuccess) fprintf(stderr, "cooperative launch failed: %s\n", hipGetErrorString(e));
}
```

```cpp
#include <hip/hip_runtime.h>
#include <hip/hip_cooperative_groups.h>
#include <cstdio>
#include <cstdint>
#include <cmath>
namespace fk {
#define LAS __attribute__((address_space(3)))
typedef unsigned short bf16_t;
typedef short bf16x8 __attribute__((ext_vector_type(8)));
typedef short s16x4 __attribute__((ext_vector_type(4)));
typedef float f32x4 __attribute__((ext_vector_type(4)));
typedef float f32x16 __attribute__((ext_vector_type(16)));
typedef float f32x2 __attribute__((ext_vector_type(2)));
typedef unsigned u32x4 __attribute__((ext_vector_type(4)));
typedef unsigned u32x2 __attribute__((ext_vector_type(2)));
typedef __bf16 bf16x2_t __attribute__((ext_vector_type(2)));

constexpr int NT = 32768, DM = 1024, SEQ = 4096;
constexpr int NTHR = 512, NWAVE = 8;
constexpr float ALPHA = 1.4142135623730951f, LN_EPS = 1e-5f, LOG2E = 1.4426950408889634f;

__device__ __forceinline__ unsigned pk2(float lo, float hi) { f32x2 v = {lo, hi}; bf16x2_t b = __builtin_convertvector(v, bf16x2_t); return __builtin_bit_cast(unsigned, b); }
__device__ __forceinline__ float bf_lo(unsigned w) { return __uint_as_float(w << 16); }
__device__ __forceinline__ float bf_hi(unsigned w) { return __uint_as_float(w & 0xffff0000u); }
__device__ __forceinline__ float bf2f(bf16_t b) { return __uint_as_float(((unsigned)b) << 16); }
__device__ __forceinline__ bf16_t f2bf(float f) { return (bf16_t)(pk2(f, 0.f) & 0xffffu); }
__device__ __forceinline__ float fast_exp(float x) { return __builtin_amdgcn_exp2f(x * LOG2E); }
__device__ __forceinline__ float sigmoid_f(float x) { return __builtin_amdgcn_rcpf(1.f + fast_exp(-x)); }
__device__ __forceinline__ float silu_f(float x) { return x * sigmoid_f(x); }
__device__ __forceinline__ float gelu_tanh_f(float x) { const float u = 1.5957691216057308f * (x + 0.044715f * x * x * x); return x * sigmoid_f(u); }
__device__ __forceinline__ int crow(int r, int hi) { return (r & 3) + 8 * (r >> 2) + 4 * hi; }
__device__ __forceinline__ float xhalf_sum(float v) { auto rr = __builtin_amdgcn_permlane32_swap(__float_as_uint(v), __float_as_uint(v), false, false); return __uint_as_float(rr[0]) + __uint_as_float(rr[1]); }
__device__ __forceinline__ float xhalf_max(float v) { auto rr = __builtin_amdgcn_permlane32_swap(__float_as_uint(v), __float_as_uint(v), false, false); return fmaxf(__uint_as_float(rr[0]), __uint_as_float(rr[1])); }
__device__ __forceinline__ float shx(float v, int o, int lane) { return __int_as_float(__builtin_amdgcn_ds_bpermute((lane ^ o) << 2, __float_as_int(v))); }
__device__ __forceinline__ float shup(float v, int o, int lane) { return __int_as_float(__builtin_amdgcn_ds_bpermute(((lane - o) & 63) << 2, __float_as_int(v))); }
__device__ __forceinline__ float shidx(float v, int idx) { return __int_as_float(__builtin_amdgcn_ds_bpermute(idx << 2, __float_as_int(v))); }
__device__ __forceinline__ s16x4 lds_tr(const LAS void* p) { return __builtin_bit_cast(s16x4, __builtin_amdgcn_ds_read_tr16_b64_v4i16((LAS s16x4*)p)); }
#define MFMA32(a, b, c) __builtin_amdgcn_mfma_f32_32x32x16_bf16((a), (b), (c), 0, 0, 0)

namespace pg8 {
constexpr int BM = 256, BK = 64, HALF = 128, HTB = HALF * BK * 2, STAGE_BYTES = 8 * HTB, NXCD = 8, WGM = 8;
__host__ __device__ __forceinline__ int lds_byte(int r, int c) { const int st = (r >> 4) * 2 + (c >> 5), rr = r & 15, cc = c & 31, ob = rr * 64 + cc * 2; return st * 1024 + (ob ^ (((ob >> 9) & 1) << 5)); }
__host__ __device__ __forceinline__ void stage_rc(int b, int& R, int& C) { const int st = b / 1024, sb = b % 1024, swz = sb ^ (((sb >> 9) & 1) << 5); R = (st >> 1) * 16 + swz / 64; C = (st & 1) * 32 + (swz % 64) / 2; }
__host__ __device__ __forceinline__ int perm32(int rho) { const int n = rho >> 4, i = rho & 15; return 8 * (i >> 2) + 4 * n + (i & 3); }

struct Unit { const char* A; const char* B; const int* src; int pm, pn, job; };

__device__ __forceinline__ void tile_order(int l, int nM, int nN, int& pm, int& pn) {
    const int nwg = nM * nN; int wgid = l;
    { const int q = nwg / NXCD, r = nwg % NXCD, xcd = wgid % NXCD, off = wgid / NXCD; wgid = (xcd < r ? xcd * (q + 1) : r * (q + 1) + (xcd - r) * q) + off; }
    const int nig = WGM * nN, gid = wgid / nig, fm = gid * WGM, gsz = (nM - fm) < WGM ? (nM - fm) : WGM;
    pm = fm + ((wgid % nig) % gsz); pn = (wgid % nig) / gsz;
}
struct JobDesc { unsigned long long A, B, out, bias, rot, out2; int nM, nN, ldc, mode; };
__device__ __forceinline__ unsigned long long rfl64(unsigned long long v) { const unsigned lo = __builtin_amdgcn_readfirstlane((unsigned)v), hi = __builtin_amdgcn_readfirstlane((unsigned)(v >> 32)); return ((unsigned long long)hi << 32) | lo; }
constexpr int JT_OFF = STAGE_BYTES;
struct Jobs3 {
    const LAS JobDesc* jt; int n0, n1, n2; int K, G, c;
    __device__ __forceinline__ Unit get(int i, bool& ok) const { Unit u; u.A = nullptr; u.B = nullptr; u.src = nullptr; u.pm = 0; u.pn = 0; u.job = 0; ok = next(i, u); return u; }
    __device__ __forceinline__ bool next(int i, Unit& u) const {
        long L = (long)i * G + c;
        if (L >= (long)n0 + n1 + n2) return false;
        int l = (int)L; int jb = 0;
        if (l >= n0) { l -= n0; jb = 1; if (l >= n1) { l -= n1; jb = 2; } }
        const int jM = __builtin_amdgcn_readfirstlane(jt[jb].nM), jN = __builtin_amdgcn_readfirstlane(jt[jb].nN);
        int pm, pn; tile_order(l, jM, jN, pm, pn);
        const size_t tstep = (size_t)BM * K * 2;
        u.A = (const char*)rfl64(jt[jb].A) + (size_t)pm * tstep; u.B = (const char*)rfl64(jt[jb].B) + (size_t)pn * tstep; u.src = nullptr; u.pm = pm; u.pn = pn; u.job = jb; return true;
    }
};

template <class Epi, class Sched, bool ALIGN_EPI, bool SP2>
__device__ __forceinline__ void gemm_phase(LAS unsigned char* lds, const int K, const Sched& S, const Epi& E) {
    int tid_ = threadIdx.x; asm volatile("" : "+v"(tid_)); const int tid = tid_, wid = __builtin_amdgcn_readfirstlane(tid >> 6), lane = tid & 63, wr = wid >> 2, wc = wid & 3, fr = lane & 15, fq = lane >> 4;
    const int nt = K / BK;
    static_assert(SP2, "only the two-super-phase form is kept");
    unsigned vA0[2], vA1[2], vB0[2];
#pragma unroll
    for (int i = 0; i < 2; ++i) { int R, C; stage_rc(tid * 16 + i * 8192, R, C); const int Rb = 64 * (R >> 5) + perm32(R & 31); vB0[i] = (unsigned)(Rb * K + C) * 2u; }
    const size_t bhalf = (size_t)32 * K * 2;
    auto a_rows = [&](const int* src, unsigned (&o0)[2], unsigned (&o1)[2]) {
        int tq = threadIdx.x; asm volatile("" : "+v"(tq));
#pragma unroll
        for (int i = 0; i < 2; ++i) { int R, C; stage_rc(tq * 16 + i * 8192, R, C); int r0 = R, r1 = R + HALF; if (src) { r0 = src[R]; r1 = src[R + HALF]; }
            o0[i] = (unsigned)(r0 * K + C) * 2u; o1[i] = (unsigned)(r1 * K + C) * 2u; }
    };
    const size_t kstep = (size_t)(BK * 2);
    const size_t hstep = (size_t)HALF * K * 2;
    const unsigned ldsw = (unsigned)wid * 1024u;
    const int aoff = lds_byte(wr * 64 + fr, fq * 8), boff = lds_byte(wc * 32 + fr, fq * 8);
#define PG8_SA(b, h) (((b) * 2 + (h)) * HTB)
#define PG8_SB(b, h) ((4 + (b) * 2 + (h)) * HTB)
#define PG8_STAGE(bufoff, gbase, voff) do { _Pragma("unroll") for (int _i = 0; _i < 2; ++_i) \
        __builtin_amdgcn_global_load_lds((const unsigned*)((const char*)(gbase) + (voff)[_i]), (LAS unsigned*)(lds + (bufoff) + ldsw + _i * 8192), 16, 0, 0); } while (0)
#define PG8_LDA(dst, b, h) do { _Pragma("unroll") for (int m = 0; m < 4; ++m) _Pragma("unroll") for (int k = 0; k < 2; ++k) dst[m][k] = *(const LAS bf16x8*)(lds + PG8_SA(b, h) + aoff + m * 2048 + k * 1024); } while (0)
#define PG8_LDB(dst, b, h) do { _Pragma("unroll") for (int n = 0; n < 2; ++n) _Pragma("unroll") for (int k = 0; k < 2; ++k) dst[n][k] = *(const LAS bf16x8*)(lds + PG8_SB(b, h) + boff + n * 2048 + k * 1024); } while (0)
#define PG8_MMA(ai, bj, At, Bt) do { __builtin_amdgcn_s_setprio(1); _Pragma("unroll") for (int m = 0; m < 4; ++m) _Pragma("unroll") for (int n = 0; n < 2; ++n) _Pragma("unroll") for (int k = 0; k < 2; ++k) \
        acc[ai][bj][m][n] = __builtin_amdgcn_mfma_f32_16x16x32_bf16(Bt[n][k], At[m][k], acc[ai][bj][m][n], 0, 0, 0); __builtin_amdgcn_s_setprio(0); } while (0)
#define PG8_WAIT_V(n) asm volatile("s_waitcnt vmcnt(" #n ")" ::: "memory")
#define PG8_WAIT_L(n) asm volatile("s_waitcnt lgkmcnt(" #n ")" ::: "memory")
#define PG8_BAR __builtin_amdgcn_s_barrier()
#define PG8_SCHED __builtin_amdgcn_sched_barrier(0)
    auto unif = [](Unit u) { Unit r; r.A = (const char*)rfl64((unsigned long long)u.A); r.B = (const char*)rfl64((unsigned long long)u.B); r.src = (const int*)rfl64((unsigned long long)u.src);
        r.pm = __builtin_amdgcn_readfirstlane(u.pm); r.pn = __builtin_amdgcn_readfirstlane(u.pn); r.job = __builtin_amdgcn_readfirstlane(u.job); return r; };
    int ui = 0; bool ok0; Unit cur = unif(S.get(0, ok0));
    if (!ok0) return;
    f32x4 acc[2][2][4][2];
    E.prefetch(cur, wr, wc, fr, fq);
    bf16x8 At[4][2], B0[2][2], B1[2][2];
    const char* cA = cur.A; const char* cB = cur.B;
    a_rows(cur.src, vA0, vA1);
    {
        PG8_STAGE(PG8_SB(0, 0), cB, vB0); PG8_STAGE(PG8_SB(0, 1), cB + bhalf, vB0); PG8_STAGE(PG8_SA(0, 0), cA, vA0); PG8_STAGE(PG8_SA(0, 1), cA, vA1);
        if (wr == 1) PG8_BAR;
        PG8_WAIT_V(2); PG8_BAR;
        PG8_STAGE(PG8_SB(1, 0), cB + kstep, vB0); PG8_STAGE(PG8_SA(1, 0), cA + kstep, vA0); PG8_STAGE(PG8_SB(1, 1), cB + kstep + bhalf, vB0);
        PG8_WAIT_V(6); PG8_BAR;
    }
    for (;;) {
        E.init(acc);
        bool has_next; const Unit nxt = unif(S.get(ui + 1, has_next)); bool early_done = false;
        const char* nA = has_next ? nxt.A : cA; const char* nB = has_next ? nxt.B : cB;
        for (int t = 0; t < nt; t += 2) {
            const bool last = (t == nt - 2);
            const char* a1 = cA + (size_t)(t + 1) * kstep;
            const char* a2 = last ? nA : cA + (size_t)(t + 2) * kstep; const char* b2 = last ? nB : cB + (size_t)(t + 2) * kstep;
            const char* a3 = a2 + kstep; const char* b3 = b2 + kstep;
            PG8_LDB(B0, 0, 0); PG8_LDB(B1, 0, 1); PG8_SCHED; PG8_LDA(At, 0, 0); PG8_STAGE(PG8_SA(1, 1), a1, vA1);
            if (last && has_next) a_rows(nxt.src, vA0, vA1);
            PG8_WAIT_V(8); PG8_WAIT_L(0); PG8_BAR; PG8_MMA(0, 0, At, B0); PG8_MMA(0, 1, At, B1); PG8_BAR; PG8_SCHED;
            PG8_LDA(At, 0, 1); PG8_STAGE(PG8_SB(0, 0), b2, vB0); PG8_STAGE(PG8_SB(0, 1), b2 + bhalf, vB0); PG8_STAGE(PG8_SA(0, 0), a2, vA0);
            PG8_WAIT_V(8); PG8_WAIT_L(0); PG8_BAR; PG8_MMA(1, 0, At, B0); PG8_MMA(1, 1, At, B1); PG8_BAR; PG8_SCHED;
            PG8_LDB(B0, 1, 0); PG8_LDB(B1, 1, 1); PG8_SCHED; PG8_LDA(At, 1, 0); PG8_STAGE(PG8_SA(0, 1), a2, vA1);
            PG8_WAIT_V(8); PG8_WAIT_L(0); PG8_BAR; PG8_MMA(0, 0, At, B0); PG8_MMA(0, 1, At, B1); PG8_BAR; PG8_SCHED;
            if (last) { early_done = E.early(acc, cur, wr, wc, fr, fq); PG8_SCHED; }
            PG8_LDA(At, 1, 1); PG8_STAGE(PG8_SB(1, 0), b3, vB0); PG8_STAGE(PG8_SB(1, 1), b3 + bhalf, vB0); PG8_STAGE(PG8_SA(1, 0), a3, vA0);
            PG8_WAIT_V(8); PG8_WAIT_L(0); PG8_BAR; PG8_MMA(1, 0, At, B0); PG8_MMA(1, 1, At, B1); PG8_BAR; PG8_SCHED;
        }
        if constexpr (ALIGN_EPI) { if (wr == 0) PG8_BAR; }
        E.prefetch(nxt, wr, wc, fr, fq);
        if (!early_done) E.template half<0>(acc, cur, wr, wc, fr, fq);
        E.template half<1>(acc, cur, wr, wc, fr, fq);
        if (!has_next) break;
        cur = nxt; cA = nA; cB = nB; ++ui;
        if constexpr (ALIGN_EPI) { if (wr == 1) PG8_BAR; }
    }
    PG8_WAIT_V(0);
    if constexpr (!ALIGN_EPI) { if (wr == 0) PG8_BAR; }
    PG8_BAR;
#undef PG8_SA
#undef PG8_SB
#undef PG8_STAGE
#undef PG8_LDA
#undef PG8_LDB
#undef PG8_MMA
#undef PG8_WAIT_V
#undef PG8_WAIT_L
#undef PG8_BAR
#undef PG8_SCHED
}
}
enum { EM_PLAIN = 0, EM_GELU4 = 1, EM_SWIGLU = 2, EM_ROTARY = 3, EM_ROWBIAS = 4 };
struct EpiMulti {
    static constexpr bool PERM = true;
    const LAS pg8::JobDesc* jt;
    __device__ __forceinline__ void prefetch(const pg8::Unit&, int, int, int, int) const {}
    __device__ __forceinline__ void init(f32x4 (&acc)[2][2][4][2]) const {
#pragma unroll
        for (int a = 0; a < 2; ++a)
#pragma unroll
            for (int b = 0; b < 2; ++b)
#pragma unroll
                for (int m = 0; m < 4; ++m)
#pragma unroll
                    for (int n = 0; n < 2; ++n) acc[a][b][m][n] = (f32x4){0.f, 0.f, 0.f, 0.f};
    }
    __device__ __forceinline__ bool early(const f32x4 (&acc)[2][2][4][2], const pg8::Unit& u, int wr, int wc, int fr, int fq) const {
        const LAS pg8::JobDesc* jd = jt + u.job;
        if (__builtin_amdgcn_readfirstlane(jd->mode) != EM_PLAIN) return false;
        bf16_t* out = (bf16_t*)pg8::rfl64(jd->out); const int ldc = __builtin_amdgcn_readfirstlane(jd->ldc);
        bf16_t* rowp = out + (size_t)(u.pm * 256 + wr * 64 + fr) * ldc + u.pn * 256 + wc * 64 + 8 * fq;
#pragma unroll
        for (int m = 0; m < 4; ++m)
#pragma unroll
            for (int bj = 0; bj < 2; ++bj) { const f32x4 v0 = acc[0][bj][m][0], v1 = acc[0][bj][m][1];
                u32x4 w; w.x = pk2(v0[0], v0[1]); w.y = pk2(v0[2], v0[3]); w.z = pk2(v1[0], v1[1]); w.w = pk2(v1[2], v1[3]);
                *(u32x4*)(rowp + (size_t)m * 16 * ldc + bj * 32) = w; }
        return true;
    }
    template <int AI>
    __device__ __forceinline__ void half(const f32x4 (&acc)[2][2][4][2], const pg8::Unit& u, int wr, int wc, int fr, int fq) const {
        const LAS pg8::JobDesc* jd = jt + u.job;
        bf16_t* out = (bf16_t*)pg8::rfl64(jd->out);
        const int ldc = __builtin_amdgcn_readfirstlane(jd->ldc);
        const int mode = __builtin_amdgcn_readfirstlane(jd->mode);
        const float* bias = (const float*)pg8::rfl64(jd->bias);
        const int row0 = u.pm * 256 + wr * 64 + fr;
        const int colt = u.pn * 256 + wc * 64 + 8 * fq;
        if (mode == EM_PLAIN || mode == EM_ROWBIAS) {
#pragma unroll
            for (int ai = AI; ai < AI + 1; ++ai)
#pragma unroll
                for (int m = 0; m < 4; ++m) { const int row = row0 + ai * 128 + m * 16; const float rb = (mode == EM_ROWBIAS && bias) ? bias[row] : 0.f;
                    bf16_t* rowp = out + (size_t)row * ldc + colt;
#pragma unroll
                    for (int bj = 0; bj < 2; ++bj) { const f32x4 v0 = acc[ai][bj][m][0] + rb, v1 = acc[ai][bj][m][1] + rb;
                        u32x4 w; w.x = pk2(v0[0], v0[1]); w.y = pk2(v0[2], v0[3]); w.z = pk2(v1[0], v1[1]); w.w = pk2(v1[2], v1[3]);
                        *(u32x4*)(rowp + bj * 32) = w; } }
        } else if (mode == EM_GELU4) {
            const int arr = u.pn >> 1; bf16_t* base = out + (size_t)arr * NT * 512; const int col = colt - arr * 512; const bool act = arr < 2;
#pragma unroll
            for (int ai = AI; ai < AI + 1; ++ai)
#pragma unroll
                for (int m = 0; m < 4; ++m) { bf16_t* rowp = base + (size_t)(row0 + ai * 128 + m * 16) * 512 + col;
#pragma unroll
                    for (int bj = 0; bj < 2; ++bj) { f32x4 v0 = acc[ai][bj][m][0], v1 = acc[ai][bj][m][1];
                        if (act) {
#pragma unroll
                            for (int e = 0; e < 4; ++e) { v0[e] = gelu_tanh_f(v0[e]); v1[e] = gelu_tanh_f(v1[e]); } }
                        u32x4 w; w.x = pk2(v0[0], v0[1]); w.y = pk2(v0[2], v0[3]); w.z = pk2(v1[0], v1[1]); w.w = pk2(v1[2], v1[3]);
                        *(u32x4*)(rowp + bj * 32) = w; } }
        } else if (mode == EM_SWIGLU) {
#pragma unroll
            for (int ai = AI; ai < AI + 1; ++ai)
#pragma unroll
                for (int m = 0; m < 4; ++m) { bf16_t* rowp = out + (size_t)(row0 + ai * 128 + m * 16) * ldc + (colt >> 1);
#pragma unroll
                    for (int bj = 0; bj < 2; ++bj) { const f32x4 v0 = acc[ai][bj][m][0], v1 = acc[ai][bj][m][1];
                        u32x2 w; w.x = pk2(silu_f(v0[0]) * v0[1], silu_f(v0[2]) * v0[3]); w.y = pk2(silu_f(v1[0]) * v1[1], silu_f(v1[2]) * v1[3]);
                        *(u32x2*)(rowp + bj * 16) = w; } }
        } else {
            const float* rot = (const float*)pg8::rfl64(jd->rot);
            bf16_t* out2 = (bf16_t*)pg8::rfl64(jd->out2);
            const bool isk = u.pn >= 4; bf16_t* base = isk ? out2 : out; const int ld = isk ? 256 : 1024; const int colo = isk ? colt - 1024 : colt;
            float bv[2][8];
#pragma unroll
            for (int bj = 0; bj < 2; ++bj) { f32x4 b0 = (f32x4){0.f, 0.f, 0.f, 0.f}, b1 = b0; if (bias) { b0 = *(const f32x4*)(bias + colt + bj * 32); b1 = *(const f32x4*)(bias + colt + bj * 32 + 4); }
#pragma unroll
                for (int e = 0; e < 4; ++e) { bv[bj][e] = b0[e]; bv[bj][4 + e] = b1[e]; } }
            const int i0 = (colt & 63) >> 1;
#pragma unroll
            for (int ai = AI; ai < AI + 1; ++ai)
#pragma unroll
                for (int m = 0; m < 4; ++m) { const int row = row0 + ai * 128 + m * 16; const int pos = row & (SEQ - 1);
                    bf16_t* rowp = base + (size_t)row * ld + colo;
#pragma unroll
                    for (int bj = 0; bj < 2; ++bj) { f32x4 v0 = acc[ai][bj][m][0], v1 = acc[ai][bj][m][1];
                        const f32x4 cs0 = *(const f32x4*)(rot + ((size_t)pos * 32 + i0 + 16 * bj) * 2), cs1 = *(const f32x4*)(rot + ((size_t)pos * 32 + i0 + 16 * bj + 2) * 2);
#pragma unroll
                        for (int e = 0; e < 4; ++e) { v0[e] += bv[bj][e]; v1[e] += bv[bj][4 + e]; }
                        const float a0 = v0[0] * cs0[0] - v0[1] * cs0[1], b0 = v0[1] * cs0[0] + v0[0] * cs0[1];
                        const float a1 = v0[2] * cs0[2] - v0[3] * cs0[3], b1 = v0[3] * cs0[2] + v0[2] * cs0[3];
                        const float a2 = v1[0] * cs1[0] - v1[1] * cs1[1], b2 = v1[1] * cs1[0] + v1[0] * cs1[1];
                        const float a3 = v1[2] * cs1[2] - v1[3] * cs1[3], b3 = v1[3] * cs1[2] + v1[2] * cs1[3];
                        u32x4 w; w.x = pk2(a0, b0); w.y = pk2(a1, b1); w.z = pk2(a2, b2); w.w = pk2(a3, b3);
                        *(u32x4*)(rowp + bj * 32) = w; } }
        }
    }
};

#define GAS __attribute__((address_space(1)))
#define P_TMP_PROBE (194ull * 1048576ull)
constexpr int LNF_PART = pg8::JT_OFF + 1024;
constexpr int LNF_STAT = LNF_PART + 8192;
struct EpiLN {
    static constexpr bool PERM = true;
    LAS unsigned char* lds;
    mutable u32x4 pre[2][4][2];
    __device__ __forceinline__ void prefetch(const pg8::Unit& u, int, int, int, int) const {
        int tq = threadIdx.x; asm volatile("" : "+v"(tq)); const int wq = __builtin_amdgcn_readfirstlane(tq >> 6), wr = wq >> 2, wc = wq & 3, fr = tq & 15, fq = (tq & 63) >> 4;
        const unsigned long long xio = pg8::rfl64(((const LAS pg8::JobDesc*)(lds + pg8::JT_OFF))->out);
        const GAS unsigned char* tb = (const GAS unsigned char*)(xio + ((size_t)u.pm * 256 * 1024 + u.pn * 256) * 2);
        const unsigned loff = (unsigned)((wr * 64 + fr) * 1024 + wc * 64 + 8 * fq) * 2u;
#pragma unroll
        for (int ai = 0; ai < 2; ++ai)
#pragma unroll
            for (int m = 0; m < 4; ++m)
#pragma unroll
                for (int bj = 0; bj < 2; ++bj) pre[ai][m][bj] = *(const GAS u32x4*)(tb + (ai * 128 + m * 16) * 2048 + bj * 64 + loff);
    }
    __device__ __forceinline__ void init(f32x4 (&acc)[2][2][4][2]) const {
#pragma unroll
        for (int ai = 0; ai < 2; ++ai)
#pragma unroll
            for (int m = 0; m < 4; ++m)
#pragma unroll
                for (int bj = 0; bj < 2; ++bj) { const u32x4 w = pre[ai][m][bj];
                    acc[ai][bj][m][0] = (f32x4){ALPHA * bf_lo(w.x), ALPHA * bf_hi(w.x), ALPHA * bf_lo(w.y), ALPHA * bf_hi(w.y)};
                    acc[ai][bj][m][1] = (f32x4){ALPHA * bf_lo(w.z), ALPHA * bf_hi(w.z), ALPHA * bf_lo(w.w), ALPHA * bf_hi(w.w)};
                    __builtin_amdgcn_sched_barrier(0); }
    }
    __device__ __forceinline__ bool early(const f32x4 (&)[2][2][4][2], const pg8::Unit&, int, int, int, int) const { return false; }
    template <int AI>
    __device__ __forceinline__ void half(f32x4 (&acc)[2][2][4][2], const pg8::Unit& u, int, int, int, int) const {
        int tid_ = threadIdx.x; asm volatile("" : "+v"(tid_)); const int tid = tid_, lane = tid & 63;
        const int wq = __builtin_amdgcn_readfirstlane(tid >> 6), wr = wq >> 2, wc = wq & 3, fr = lane & 15, fq = lane >> 4;
        const int colt = u.pn * 256 + wc * 64 + 8 * fq;
        LAS f32x2* part = (LAS f32x2*)(lds + LNF_PART);
        LAS f32x2* stat = (LAS f32x2*)(lds + LNF_STAT);
#pragma unroll
        for (int m = 0; m < 4; ++m) { const int rl = AI * 128 + wr * 64 + m * 16 + fr;
            float s1 = 0.f, s2 = 0.f;
#pragma unroll
            for (int bj = 0; bj < 2; ++bj) { const f32x4 v0 = acc[AI][bj][m][0], v1 = acc[AI][bj][m][1];
#pragma unroll
                for (int e = 0; e < 4; ++e) { s1 += v0[e] + v1[e]; s2 += v0[e] * v0[e] + v1[e] * v1[e]; } }
            s1 += shx(s1, 16, lane); s2 += shx(s2, 16, lane); s1 += shx(s1, 32, lane); s2 += shx(s2, 32, lane);
            if (fq == 0) part[rl * 4 + wc] = (f32x2){s1, s2}; }
        if constexpr (AI == 1) {
            __syncthreads();
            if (tid < 256) {
                const f32x2 p0 = part[tid * 4], p1 = part[tid * 4 + 1], p2 = part[tid * 4 + 2], p3 = part[tid * 4 + 3];
                const float t1 = (p0[0] + p1[0]) + (p2[0] + p3[0]), t2 = (p0[1] + p1[1]) + (p2[1] + p3[1]);
                unsigned long long* sl = (unsigned long long*)pg8::rfl64(((const LAS pg8::JobDesc*)(lds + pg8::JT_OFF))->out2) + (size_t)u.pm * 1024 + tid;
#ifdef PROBE_LNV
                const bool dryp = __builtin_amdgcn_readfirstlane(((const LAS pg8::JobDesc*)(lds + pg8::JT_OFF))->mode) != 0;
#endif
                __hip_atomic_store(sl + u.pn * 256, ((unsigned long long)__float_as_uint(t2) << 32) | __float_as_uint(t1), __ATOMIC_RELAXED, __HIP_MEMORY_SCOPE_AGENT);
                unsigned long long x0, x1, x2, x3; unsigned sp = 0;
                for (;;) {
                    x0 = __hip_atomic_load(sl, __ATOMIC_RELAXED, __HIP_MEMORY_SCOPE_AGENT); x1 = __hip_atomic_load(sl + 256, __ATOMIC_RELAXED, __HIP_MEMORY_SCOPE_AGENT);
                    x2 = __hip_atomic_load(sl + 512, __ATOMIC_RELAXED, __HIP_MEMORY_SCOPE_AGENT); x3 = __hip_atomic_load(sl + 768, __ATOMIC_RELAXED, __HIP_MEMORY_SCOPE_AGENT);
                    if ((x0 != ~0ull && x1 != ~0ull && x2 != ~0ull && x3 != ~0ull) || ++sp > (1u << 22)) break;
#ifdef PROBE_LNV
                    if (dryp && ((PROBE_LNV) & 1)) break;
#endif
                    __builtin_amdgcn_s_sleep(1); }
#ifdef PROBE_LNX
                {   unsigned long long* sl2 = sl + 4 * 131072;
                    __hip_atomic_store(sl2 + u.pn * 256, ((unsigned long long)__float_as_uint(t2) << 32) | __float_as_uint(t1), __ATOMIC_RELAXED, __HIP_MEMORY_SCOPE_AGENT);
                    unsigned long long y0, y1, y2, y3; unsigned sq = 0;
                    for (;;) { y0 = __hip_atomic_load(sl2, __ATOMIC_RELAXED, __HIP_MEMORY_SCOPE_AGENT); y1 = __hip_atomic_load(sl2 + 256, __ATOMIC_RELAXED, __HIP_MEMORY_SCOPE_AGENT);
                        y2 = __hip_atomic_load(sl2 + 512, __ATOMIC_RELAXED, __HIP_MEMORY_SCOPE_AGENT); y3 = __hip_atomic_load(sl2 + 768, __ATOMIC_RELAXED, __HIP_MEMORY_SCOPE_AGENT);
                        if ((y0 != ~0ull && y1 != ~0ull && y2 != ~0ull && y3 != ~0ull) || ++sq > (1u << 22)) break;
                        __builtin_amdgcn_s_sleep(1); }
                    if (y0 == 0x123456789ull) x0 = y1; }
#endif
                const float S1 = (__uint_as_float((unsigned)x0) + __uint_as_float((unsigned)x1)) + (__uint_as_float((unsigned)x2) + __uint_as_float((unsigned)x3));
                const float S2 = (__uint_as_float((unsigned)(x0 >> 32)) + __uint_as_float((unsigned)(x1 >> 32))) + (__uint_as_float((unsigned)(x2 >> 32)) + __uint_as_float((unsigned)(x3 >> 32)));
                const float mean = S1 * (1.f / 1024.f); const float var = fmaxf(S2 * (1.f / 1024.f) - mean * mean, 0.f);
                stat[tid] = (f32x2){mean, __builtin_amdgcn_rsqf(var + LN_EPS)};
            }
            __syncthreads();
            const LAS pg8::JobDesc* jd = (const LAS pg8::JobDesc*)(lds + pg8::JT_OFF);
#ifdef PROBE_LNV
            const bool dryp2 = __builtin_amdgcn_readfirstlane(jd->mode) != 0;
#endif
            const unsigned long long xio = pg8::rfl64(jd->out); const float* g = (const float*)pg8::rfl64(jd->bias); const float* b = (const float*)pg8::rfl64(jd->rot);
            GAS unsigned char* tb = (GAS unsigned char*)(xio + ((size_t)u.pm * 256 * 1024 + u.pn * 256) * 2); const unsigned loff = (unsigned)((wr * 64 + fr) * 1024 + wc * 64 + 8 * fq) * 2u;
#pragma unroll
            for (int bj = 0; bj < 2; ++bj) {
                __builtin_amdgcn_sched_barrier(0);
                const f32x4 g0 = *(const GAS f32x4*)((const GAS float*)g + colt + bj * 32), g1 = *(const GAS f32x4*)((const GAS float*)g + colt + bj * 32 + 4), b0 = *(const GAS f32x4*)((const GAS float*)b + colt + bj * 32), b1 = *(const GAS f32x4*)((const GAS float*)b + colt + bj * 32 + 4);
                f32x2 stn = stat[wr * 64 + fr];
#pragma unroll
                for (int am = 0; am < 8; ++am) { const int ai = am >> 2, m = am & 3; const int rl = ai * 128 + wr * 64 + m * 16 + fr; const f32x2 st = stn;
                    if (am < 7) stn = stat[((am + 1) >> 2) * 128 + wr * 64 + ((am + 1) & 3) * 16 + fr];
                    const float sc = st[1], sh = -st[0] * st[1];
                    const f32x4 v0 = (acc[ai][bj][m][0] * sc + sh) * g0 + b0, v1 = (acc[ai][bj][m][1] * sc + sh) * g1 + b1;
                    u32x4 w; w.x = pk2(v0[0], v0[1]); w.y = pk2(v0[2], v0[3]); w.z = pk2(v1[0], v1[1]); w.w = pk2(v1[2], v1[3]);
#ifdef PROBE_LNV
                    if (!(dryp2 && ((PROBE_LNV) & 2)))
                    *(GAS u32x4*)(tb + (dryp2 ? (size_t)P_TMP_PROBE : (size_t)0) + (ai * 128 + m * 16) * 2048 + bj * 64 + loff) = w;
#else
                    *(GAS u32x4*)(tb + (ai * 128 + m * 16) * 2048 + bj * 64 + loff) = w;
#endif
#ifdef PROBE_LNS
                    *(GAS u32x4*)(tb + ((size_t)P_TMP_PROBE) + (ai * 128 + m * 16) * 2048 + bj * 64 + loff) = w;
#endif
                    __builtin_amdgcn_sched_barrier(0); }
            }
        }
    }
};
enum { RM_IDENT = 0, RM_ROT = 1, RM_PAIR0 = 2, RM_PAIR1 = 3 };
__device__ __forceinline__ int rowmap(int kind, int n) {
    if (kind == RM_ROT) { if (n >= 1280) return n; const int d = n & 63; return (n & ~63) + 2 * (d & 31) + (d >> 5); }
    if (kind == RM_PAIR0) return 2 * n;
    if (kind == RM_PAIR1) return 2 * n + 1;
    return n;
}
__device__ __forceinline__ void ti_load(const float* __restrict__ W, int ldw, int kb, int nb, int lane, f32x4 (&tv)[8]) {
    const int k0 = 64 * kb, n0 = 32 * nb;
#pragma unroll
    for (int i = 0; i < 8; ++i) { const int kk = 8 * i + (lane >> 3); tv[i] = *(const f32x4*)(W + (size_t)(k0 + kk) * ldw + n0 + 4 * (lane & 7)); }
}
__device__ __forceinline__ void ti_store(const f32x4 (&tv)[8], int K, bf16_t* __restrict__ WT, LAS float* scr, int kb, int nb, int lane, int kind, float scale, int nscale) {
    const int k0 = 64 * kb, n0 = 32 * nb;
#pragma unroll
    for (int i = 0; i < 8; ++i) { const int kk = 8 * i + (lane >> 3); LAS float* d = scr + kk * 33 + 4 * (lane & 7); d[0] = tv[i][0]; d[1] = tv[i][1]; d[2] = tv[i][2]; d[3] = tv[i][3]; }
    __builtin_amdgcn_s_waitcnt(0xc07f); asm volatile("" ::: "memory");
    const int c = lane & 7;
#pragma unroll
    for (int j = 0; j < 4; ++j) { const int n = (lane >> 3) + 8 * j; const LAS float* s = scr + (8 * c) * 33 + n; const float sc = (n0 + n) < nscale ? scale : 1.f;
        u32x4 o; o.x = pk2(s[0 * 33] * sc, s[1 * 33] * sc); o.y = pk2(s[2 * 33] * sc, s[3 * 33] * sc); o.z = pk2(s[4 * 33] * sc, s[5 * 33] * sc); o.w = pk2(s[6 * 33] * sc, s[7 * 33] * sc);
        *(u32x4*)(WT + (size_t)rowmap(kind, n0 + n) * K + k0 + 8 * c) = o; }
    __builtin_amdgcn_s_waitcnt(0xc07f); asm volatile("" ::: "memory");
}
__device__ __forceinline__ void convert_mats(const float* W, int K, int N, int nbat, size_t sstr, bf16_t* WT, size_t dstr, int kind, float scale, int nscale, LAS float* scr, int& gwr, int ngw, int lane) {
    const int nblk = N / 32, per = (K / 64) * nblk, total = per * nbat;
    const int gw = gwr; gwr = (gw + ngw - total % ngw) % ngw;
    if (gw >= total) return;
    f32x4 cur[8], nxt[8];
    { const int bt = gw / per, r = gw - bt * per; ti_load(W + (size_t)bt * sstr, N, r / nblk, r % nblk, lane, cur); }
    for (int it = gw; it < total; it += ngw) {
        const int in = it + ngw; const bool more = in < total;
        if (more) { const int bt = in / per, r = in - bt * per; ti_load(W + (size_t)bt * sstr, N, r / nblk, r % nblk, lane, nxt); }
        { const int bt = it / per, r = it - bt * per; ti_store(cur, K, WT + (size_t)bt * dstr, scr, r / nblk, r % nblk, lane, kind, scale, nscale); }
#pragma unroll
        for (int i = 0; i < 8; ++i) cur[i] = nxt[i];
    }
}
__device__ __forceinline__ void convert_rows(const float* __restrict__ src, bf16_t* __restrict__ dst, size_t n, int gt, int ngt) {
    const size_t step = (size_t)ngt * 8; size_t i = (size_t)gt * 8;
    for (; i + 3 * step < n; i += 4 * step) { f32x4 a[4], b[4];
#pragma unroll
        for (int j = 0; j < 4; ++j) { a[j] = *(const f32x4*)(src + i + j * step); b[j] = *(const f32x4*)(src + i + j * step + 4); }
#pragma unroll
        for (int j = 0; j < 4; ++j) { u32x4 o; o.x = pk2(a[j][0], a[j][1]); o.y = pk2(a[j][2], a[j][3]); o.z = pk2(b[j][0], b[j][1]); o.w = pk2(b[j][2], b[j][3]); *(u32x4*)(dst + i + j * step) = o; } }
    for (; i < n; i += step) { const f32x4 a = *(const f32x4*)(src + i), b = *(const f32x4*)(src + i + 4);
        u32x4 o; o.x = pk2(a[0], a[1]); o.y = pk2(a[2], a[3]); o.z = pk2(b[0], b[1]); o.w = pk2(b[2], b[3]); *(u32x4*)(dst + i) = o; }
}

struct LnArgs { const float* xin32; const bf16_t* xin; float* xout32; bf16_t* xbf; const bf16_t* y; const float* g; const float* b; const int* dest; const float* wts; };
template <int NR, bool XF32, bool OUTF32, bool MOE>
__device__ __forceinline__ void ln_rows(const LnArgs& a, int row0, int lane) {
    float v[NR][2][8];
    {
        int d0[NR], d1[NR]; float w0[NR], w1[NR];
        if (MOE) {
#pragma unroll
            for (int i = 0; i < NR; ++i) { d0[i] = a.dest[(row0 + i) * 2]; d1[i] = a.dest[(row0 + i) * 2 + 1]; w0[i] = a.wts[(row0 + i) * 2]; w1[i] = a.wts[(row0 + i) * 2 + 1]; }
        }
        f32x4 xf[XF32 ? NR : 1][2][2]; u32x4 xb[XF32 ? 1 : NR][2]; u32x4 p[NR][2], q[MOE ? NR : 1][2];
#pragma unroll
        for (int i = 0; i < NR; ++i) {
            const u32x4* y0 = (const u32x4*)(a.y + (size_t)(MOE ? d0[i] : row0 + i) * DM) + lane; const u32x4* y1 = (const u32x4*)(a.y + (size_t)(MOE ? d1[i] : 0) * DM) + lane;
#pragma unroll
            for (int j = 0; j < 2; ++j) {
                if (XF32) { const f32x4* xr = (const f32x4*)(a.xin32 + (size_t)(row0 + i) * DM) + 2 * lane + 128 * j; xf[XF32 ? i : 0][j][0] = xr[0]; xf[XF32 ? i : 0][j][1] = xr[1]; }
                else xb[XF32 ? 0 : i][j] = ((const u32x4*)(a.xin + (size_t)(row0 + i) * DM) + lane)[64 * j];
                p[i][j] = y0[64 * j]; if (MOE) q[MOE ? i : 0][j] = y1[64 * j]; } }
#pragma unroll
        for (int i = 0; i < NR; ++i)
#pragma unroll
            for (int j = 0; j < 2; ++j) {
                float x[8];
                if (XF32) {
#pragma unroll
                    for (int e = 0; e < 4; ++e) { x[e] = xf[XF32 ? i : 0][j][0][e]; x[4 + e] = xf[XF32 ? i : 0][j][1][e]; } }
                else { const u32x4 w = xb[XF32 ? 0 : i][j]; x[0] = bf_lo(w.x); x[1] = bf_hi(w.x); x[2] = bf_lo(w.y); x[3] = bf_hi(w.y); x[4] = bf_lo(w.z); x[5] = bf_hi(w.z); x[6] = bf_lo(w.w); x[7] = bf_hi(w.w); }
                const u32x4 pw = p[i][j]; const float py[8] = {bf_lo(pw.x), bf_hi(pw.x), bf_lo(pw.y), bf_hi(pw.y), bf_lo(pw.z), bf_hi(pw.z), bf_lo(pw.w), bf_hi(pw.w)};
                if (MOE) { const u32x4 qw = q[MOE ? i : 0][j]; const float qy[8] = {bf_lo(qw.x), bf_hi(qw.x), bf_lo(qw.y), bf_hi(qw.y), bf_lo(qw.z), bf_hi(qw.z), bf_lo(qw.w), bf_hi(qw.w)};
#pragma unroll
                    for (int e = 0; e < 8; ++e) v[i][j][e] = ALPHA * x[e] + w0[i] * py[e] + w1[i] * qy[e]; }
                else {
#pragma unroll
                    for (int e = 0; e < 8; ++e) v[i][j][e] = ALPHA * x[e] + py[e]; }
            }
    }
    float s[NR];
#pragma unroll
    for (int i = 0; i < NR; ++i) { s[i] = 0.f;
#pragma unroll
        for (int j = 0; j < 2; ++j)
#pragma unroll
            for (int e = 0; e < 8; ++e) s[i] += v[i][j][e]; }
#pragma unroll
    for (int o = 1; o < 64; o <<= 1)
#pragma unroll
        for (int i = 0; i < NR; ++i) s[i] += shx(s[i], o, lane);
    float q2[NR];
#pragma unroll
    for (int i = 0; i < NR; ++i) { const float mean = s[i] * (1.f / DM); q2[i] = 0.f;
#pragma unroll
        for (int j = 0; j < 2; ++j)
#pragma unroll
            for (int e = 0; e < 8; ++e) { v[i][j][e] -= mean; q2[i] += v[i][j][e] * v[i][j][e]; } }
#pragma unroll
    for (int o = 1; o < 64; o <<= 1)
#pragma unroll
        for (int i = 0; i < NR; ++i) q2[i] += shx(q2[i], o, lane);
    f32x4 gv[2][2], bv[2][2];
#pragma unroll
    for (int j = 0; j < 2; ++j) { const f32x4* gp = (const f32x4*)a.g + 2 * lane + 128 * j; const f32x4* bp = (const f32x4*)a.b + 2 * lane + 128 * j; gv[j][0] = gp[0]; gv[j][1] = gp[1]; bv[j][0] = bp[0]; bv[j][1] = bp[1]; }
#pragma unroll
    for (int i = 0; i < NR; ++i) { const float rstd = rsqrtf(q2[i] * (1.f / DM) + LN_EPS);
#pragma unroll
        for (int j = 0; j < 2; ++j) { float o[8];
#pragma unroll
            for (int e = 0; e < 8; ++e) o[e] = v[i][j][e] * rstd * gv[j][e >> 2][e & 3] + bv[j][e >> 2][e & 3];
            if (OUTF32) { f32x4* xo = (f32x4*)(a.xout32 + (size_t)(row0 + i) * DM) + 2 * lane + 128 * j; xo[0] = (f32x4){o[0], o[1], o[2], o[3]}; xo[1] = (f32x4){o[4], o[5], o[6], o[7]}; }
            else { u32x4 w; w.x = pk2(o[0], o[1]); w.y = pk2(o[2], o[3]); w.z = pk2(o[4], o[5]); w.w = pk2(o[6], o[7]); ((u32x4*)(a.xbf + (size_t)(row0 + i) * DM) + lane)[64 * j] = w; } } }
}
template <bool XF32, bool OUTF32, bool MOE>
__device__ __forceinline__ void ln_phase(const LnArgs& a, int blk, int G, int wave, int lane) {
    const int per = NT / G, r0 = blk * per, pw = per / NWAVE;
    for (int r = 0; r < pw; r += 4) ln_rows<4, XF32, OUTF32, MOE>(a, r0 + wave * pw + r, lane);
}
__device__ __forceinline__ void xattn_phase(LAS unsigned char* lds, const bf16_t* __restrict__ Q, const bf16_t* __restrict__ KC, const bf16_t* __restrict__ VT, bf16_t* __restrict__ O, int blk, int G) {
    const int tid0 = threadIdx.x, wave = __builtin_amdgcn_readfirstlane(tid0 >> 6);
#define XA_IDS int tid = tid0; asm volatile("" : "+v"(tid)); const int lane = tid & 63, r32 = lane & 31, hh = lane >> 5; const size_t qrow = (size_t)b * SEQ + qb * 256 + wave * 32 + r32; (void)lane; (void)hh; (void)qrow;
    for (int u = blk; u < 512; u += G) {
        int qb = u & 15, h = (u >> 4) & 3, b = u >> 6;
        if (G == 256) { const int x = blk & 7, j = blk >> 3, grp = x * 4 + (u >> 8) * 2 + (j >> 4); qb = j & 15; h = grp & 3; b = grp >> 2; }
        XA_IDS;
        bf16x8 qf[16];
#pragma unroll
        for (int ks = 0; ks < 16; ++ks) qf[ks] = *(const bf16x8*)(Q + qrow * 1024 + h * 256 + ks * 16 + hh * 8);
        __syncthreads();
#pragma unroll
        for (int bt = 0; bt < 2; ++bt) {
            u32x4 t[8];
#pragma unroll
            for (int i = 0; i < 8; ++i) { const int ch = tid + 512 * (bt * 8 + i), row = ch >> 5, c = ch & 31; t[i] = *(const u32x4*)(KC + (size_t)(b * 256 + row) * 1024 + h * 256 + c * 8); }
#pragma unroll
            for (int i = 0; i < 8; ++i) { const int ch = tid + 512 * (bt * 8 + i), row = ch >> 5, c = ch & 31; *(LAS u32x4*)(lds + row * 528 + c * 16) = t[i]; }
        }
        __syncthreads();
        f32x16 s[8];
#pragma unroll
        for (int mt = 0; mt < 8; ++mt)
#pragma unroll
            for (int r = 0; r < 16; ++r) s[mt][r] = 0.f;
        {   const LAS unsigned char* kbp = lds + r32 * 528 + hh * 16;
#pragma unroll
            for (int ks = 0; ks < 16; ++ks)
#pragma unroll
                for (int mt = 0; mt < 8; ++mt) { const bf16x8 a = *(const LAS bf16x8*)(kbp + mt * 32 * 528 + ks * 32); s[mt] = MFMA32(a, qf[ks], s[mt]); }
        }
        float mx = -INFINITY;
#pragma unroll
        for (int mt = 0; mt < 8; ++mt)
#pragma unroll
            for (int r = 0; r < 16; ++r) mx = fmaxf(mx, s[mt][r]);
        mx = xhalf_max(mx);
        float sm = 0.f; const float mxl = mx * LOG2E;
        u32x4 pf[8][2];
#pragma unroll
        for (int mt = 0; mt < 8; ++mt) {
#pragma unroll
            for (int r = 0; r < 16; ++r) { const float p = __builtin_amdgcn_exp2f(s[mt][r] * LOG2E - mxl); s[mt][r] = p; sm += p; }
#pragma unroll
            for (int sx = 0; sx < 2; ++sx) pf[mt][sx] = (u32x4){pk2(s[mt][8 * sx], s[mt][8 * sx + 1]), pk2(s[mt][8 * sx + 2], s[mt][8 * sx + 3]), pk2(s[mt][8 * sx + 4], s[mt][8 * sx + 5]), pk2(s[mt][8 * sx + 6], s[mt][8 * sx + 7])};
        }
        sm = xhalf_sum(sm);
        __syncthreads();
        {   XA_IDS;
#pragma unroll
        for (int bt = 0; bt < 4; ++bt) {
            u32x4 t[4];
#pragma unroll
            for (int i = 0; i < 4; ++i) { const int ch = tid + 512 * (bt * 4 + i), row = ch >> 5, c = ch & 31; t[i] = *(const u32x4*)(VT + (size_t)(h * 256 + row) * 2048 + b * 256 + c * 8); }
#pragma unroll
            for (int i = 0; i < 4; ++i) { const int ch = tid + 512 * (bt * 4 + i), row = ch >> 5, c = ch & 31; LAS u32x2* d = (LAS u32x2*)(lds + row * 520 + c * 16); d[0] = (u32x2){t[i].x, t[i].y}; d[1] = (u32x2){t[i].z, t[i].w}; }
        }
        }
        __syncthreads();
        {   XA_IDS;
        const float inv = 1.f / sm;
        bf16_t* orow = O + qrow * 1024 + h * 256 + 4 * hh;
#pragma unroll 1
        for (int dh = 0; dh < 2; ++dh) {
            f32x16 o[4];
#pragma unroll
            for (int dt = 0; dt < 4; ++dt)
#pragma unroll
                for (int r = 0; r < 16; ++r) o[dt][r] = 0.f;
            const LAS unsigned char* vb = lds + (dh * 128 + r32) * 520 + 8 * hh;
#pragma unroll
            for (int mt = 0; mt < 8; ++mt)
#pragma unroll
                for (int sx = 0; sx < 2; ++sx) { const int kb = mt * 32 + 16 * sx; const bf16x8 pb = __builtin_bit_cast(bf16x8, pf[mt][sx]);
#pragma unroll
                    for (int dt = 0; dt < 4; ++dt) { const LAS unsigned char* q = vb + dt * 32 * 520 + kb * 2;
                        const s16x4 lo = *(const LAS s16x4*)q, hi = *(const LAS s16x4*)(q + 16);
                        const bf16x8 a = (bf16x8){lo[0], lo[1], lo[2], lo[3], hi[0], hi[1], hi[2], hi[3]}; o[dt] = MFMA32(a, pb, o[dt]); } }
#pragma unroll
            for (int dt = 0; dt < 4; ++dt)
#pragma unroll
                for (int g = 0; g < 4; ++g) { u32x2 w; w.x = pk2(o[dt][4 * g] * inv, o[dt][4 * g + 1] * inv); w.y = pk2(o[dt][4 * g + 2] * inv, o[dt][4 * g + 3] * inv); *(u32x2*)(orow + dh * 128 + dt * 32 + 8 * g) = w; }
        }
        }
    }
#undef XA_IDS
}

struct RouteBufs { int* e; float* w; int* rank; int* dest; int* hist; int* tstart; int* src; };
__device__ __forceinline__ void moe_router_phase(LAS unsigned char* lds, const bf16_t* __restrict__ XBF, const bf16_t* __restrict__ WRT, const float* __restrict__ brg, const float* __restrict__ bre, const RouteBufs rb, int blk) {
    int tid_ = threadIdx.x; asm volatile("" : "+v"(tid_)); const int tid = tid_, lane = tid & 63, wave = __builtin_amdgcn_readfirstlane(tid >> 6), r32 = lane & 31, hh = lane >> 5;
    LAS unsigned char* XT = lds; LAS unsigned char* WT = lds + 128 * 528;
    LAS float* LG = (LAS float*)lds;
    LAS int* hist = (LAS int*)(lds + 128 * 65 * 4);
    const int rbk = wave & 3, ct = wave >> 2;
    f32x16 acc;
#pragma unroll
    for (int r = 0; r < 16; ++r) acc[r] = 0.f;
#pragma unroll 1
    for (int kc = 0; kc < 4; ++kc) {
        __syncthreads();
        {   u32x4 tx[8], tw[8];
#pragma unroll
            for (int i = 0; i < 8; ++i) { const int ch = tid + 512 * i, row = ch >> 5, c = ch & 31; tx[i] = *(const u32x4*)(XBF + (size_t)(blk * 128 + row) * 1024 + kc * 256 + c * 8); tw[i] = *(const u32x4*)(WRT + (size_t)row * 1024 + kc * 256 + c * 8); }
#pragma unroll
            for (int i = 0; i < 8; ++i) { const int ch = tid + 512 * i, row = ch >> 5, c = ch & 31; *(LAS u32x4*)(XT + row * 528 + c * 16) = tx[i]; *(LAS u32x4*)(WT + row * 528 + c * 16) = tw[i]; } }
        __syncthreads();
        const LAS unsigned char* ap = XT + (rbk * 32 + r32) * 528 + hh * 16; const LAS unsigned char* bp = WT + (ct * 32 + r32) * 528 + hh * 16;
#pragma unroll
        for (int ks = 0; ks < 16; ++ks) { const bf16x8 a = *(const LAS bf16x8*)(ap + ks * 32), b0 = *(const LAS bf16x8*)(bp + ks * 32), b1 = *(const LAS bf16x8*)(bp + 64 * 528 + ks * 32);
            acc = MFMA32(a, b0, acc); acc = MFMA32(a, b1, acc); }
    }
    __syncthreads();
    if (tid < 32) hist[tid] = 0;
#pragma unroll
    for (int r = 0; r < 16; ++r) LG[(rbk * 32 + crow(r, hh)) * 65 + ct * 32 + r32] = acc[r];
    __syncthreads();
    if (tid < 128) {
        const LAS float* lg = LG + tid * 65; const int tok = blk * 128 + tid;
        float g4[4];
#pragma unroll
        for (int g = 0; g < 4; ++g) g4[g] = lg[32 + g] + brg[g];
        int gi = 0; float gm = g4[0];
#pragma unroll
        for (int g = 1; g < 4; ++g) if (g4[g] > gm) { gm = g4[g]; gi = g; }
        float gs = 0.f;
#pragma unroll
        for (int g = 0; g < 4; ++g) gs += fast_exp(g4[g] - gm);
        const float gate_g = 1.f / gs;
        float le[8];
#pragma unroll
        for (int e = 0; e < 8; ++e) le[e] = lg[gi * 8 + e] + bre[gi * 8 + e];
        int i0 = 0; float v0 = le[0];
#pragma unroll
        for (int e = 1; e < 8; ++e) if (le[e] > v0) { v0 = le[e]; i0 = e; }
        int i1 = 0; float v1 = -INFINITY;
#pragma unroll
        for (int e = 0; e < 8; ++e) if (e != i0 && le[e] > v1) { v1 = le[e]; i1 = e; }
        const float e1 = fast_exp(v1 - v0), p0 = 1.f / (1.f + e1), p1 = e1 * p0;
        const int ex0 = gi * 8 + i0, ex1 = gi * 8 + i1;
        rb.e[tok * 2] = ex0; rb.e[tok * 2 + 1] = ex1; rb.w[tok * 2] = gate_g * p0; rb.w[tok * 2 + 1] = gate_g * p1;
        rb.rank[tok * 2] = atomicAdd((int*)&hist[ex0], 1); rb.rank[tok * 2 + 1] = atomicAdd((int*)&hist[ex1], 1);
    }
    __syncthreads();
    if (tid < 32) rb.hist[blk * 32 + tid] = hist[tid];
}
__device__ __forceinline__ void moe_scatter_phase(LAS unsigned char* lds, const RouteBufs rb, int blk, int G) {
    int tid_ = threadIdx.x; asm volatile("" : "+v"(tid_)); const int tid = tid_, lane = tid & 63, wave = __builtin_amdgcn_readfirstlane(tid >> 6);
    LAS int* sb = (LAS int*)lds;
    __syncthreads();
    {
        const int e = tid & 31, part = tid >> 5; int c[16];
#pragma unroll
        for (int i = 0; i < 16; ++i) c[i] = rb.hist[(part * 16 + i) * 32 + e];
        int tot = 0, base = 0;
#pragma unroll
        for (int i = 0; i < 16; ++i) { tot += c[i]; if (part * 16 + i < blk) base += c[i]; }
        sb[128 + part * 32 + e] = base; sb[128 + 512 + part * 32 + e] = tot; }
    __syncthreads();
    if (tid < 32) { int tot = 0, base = 0;
#pragma unroll
        for (int i = 0; i < 16; ++i) { base += sb[128 + i * 32 + tid]; tot += sb[128 + 512 + i * 32 + tid]; }
        sb[tid] = base; sb[32 + tid] = tot; }
    __syncthreads();
    if (tid == 0) { int acc = 0; for (int e = 0; e < 32; ++e) { sb[64 + e] = acc; if (blk == 0) rb.tstart[e] = acc >> 8; acc += (sb[32 + e] + 255) & ~255; } sb[96] = acc; if (blk == 0) rb.tstart[32] = acc >> 8; }
    __syncthreads();
    if (tid < 256) { const int idx = blk * 256 + tid; const int e = rb.e[idx]; const int d = sb[64 + e] + sb[e] + rb.rank[idx]; rb.dest[idx] = d; rb.src[d] = idx >> 1; }
    if (blk < 32) { const int e = blk; const int lo = sb[64 + e] + sb[32 + e], hi = sb[64 + e] + ((sb[32 + e] + 255) & ~255); for (int r = lo + tid; r < hi; r += NTHR) rb.src[r] = 0; }
}
struct MoeSched {
    const char* A; const char* B; const int* tstart; int K, nN, G, c; size_t bexp;
    __device__ __forceinline__ pg8::Unit get(int i, bool& ok) const { pg8::Unit u; u.A = nullptr; u.B = nullptr; u.src = nullptr; u.pm = 0; u.pn = 0; u.job = 0; ok = next(i, u); return u; }
    __device__ __forceinline__ bool next(int i, pg8::Unit& u) const {
        const int vc = (c & 7) * (G >> 3) + (c >> 3);
        const long L = (long)i * G + vc; const int ntile = tstart[32];
        if (L >= (long)ntile * nN) return false;
        const int mt = (int)(L / nN), nt = (int)(L % nN);
        int e = 0;
        for (int k = 1; k < 32; ++k) if (tstart[k] <= mt) e = k;
        u.A = A + (size_t)mt * 256 * K * 2; u.B = B + (size_t)e * bexp + (size_t)nt * 256 * K * 2; u.src = nullptr; u.pm = mt; u.pn = nt; u.job = 0; return true;
    }
};
__device__ __forceinline__ void swa_phase(LAS unsigned char* lds, const bf16_t* __restrict__ Q1, const bf16_t* __restrict__ K1, const bf16_t* __restrict__ VT1, const float* __restrict__ sinks, bf16_t* __restrict__ O, int blk, int G) {
    int tid_ = threadIdx.x; asm volatile("" : "+v"(tid_)); const int tid = tid_, lane = tid & 63, wave = __builtin_amdgcn_readfirstlane(tid >> 6), r32 = lane & 31, hh = lane >> 5;
    LAS unsigned char* KL = lds;
    LAS unsigned char* VL = lds + 36864;
    for (int u = blk; u < 1024; u += G) {
        int n = u & 31, kvh = (u >> 5) & 3, b = u >> 7;
        if (G == 256) { const int grp = (u >> 8) * 8 + (blk & 7); n = blk >> 3; kvh = grp & 3; b = grp >> 2; }
        const int tokb = b * SEQ + (n - 1) * 128;
        bf16x8 qfa[2][4];
        {   const int g0 = wave >> 1, hq0 = kvh * 4 + g0;
#pragma unroll
            for (int sb = 0; sb < 2; ++sb)
#pragma unroll
                for (int ks = 0; ks < 4; ++ks) qfa[sb][ks] = *(const bf16x8*)(Q1 + ((size_t)b * SEQ + n * 128 + (wave & 1) * 64 + sb * 32 + r32) * 1024 + hq0 * 64 + ks * 16 + hh * 8); }
        __syncthreads();
#pragma unroll
        for (int i = 0; i < 4; ++i) { const int ch = tid + 512 * i; const int key = ch >> 3, c = ch & 7;
            u32x4 v = (u32x4){0u, 0u, 0u, 0u}; if (n > 0 || key >= 128) v = *(const u32x4*)(K1 + (size_t)(tokb + key) * 256 + kvh * 64 + c * 8);
            *(LAS u32x4*)(KL + key * 144 + c * 16) = v; }
#pragma unroll
        for (int i = 0; i < 4; ++i) { const int ch = tid + 512 * i; const int d = ch >> 5, c = ch & 31;
            u32x4 v = (u32x4){0u, 0u, 0u, 0u}; if (n > 0 || c >= 16) v = *(const u32x4*)(VT1 + (size_t)(kvh * 64 + d) * NT + tokb + c * 8);
            LAS u32x2* dp = (LAS u32x2*)(VL + d * 520 + c * 16); dp[0] = (u32x2){v.x, v.y}; dp[1] = (u32x2){v.z, v.w}; }
        __syncthreads();
        const int g = wave >> 1, hq = kvh * 4 + g; const float sink = sinks[hq];
#pragma unroll 1
        for (int sb = 0; sb < 2; ++sb) {
            bf16x8 qf[4];
#pragma unroll
            for (int ks = 0; ks < 4; ++ks) qf[ks] = sb ? qfa[1][ks] : qfa[0][ks];
            const int i0 = (wave & 1) * 64 + sb * 32, jt0 = i0 >> 5;
            const size_t qtok = (size_t)b * SEQ + n * 128 + i0 + r32;
            f32x16 s[5];
#pragma unroll
            for (int t = 0; t < 5; ++t) {
#pragma unroll
                for (int r = 0; r < 16; ++r) s[t][r] = 0.f;
                const LAS unsigned char* kp = KL + ((jt0 + t) * 32 + r32) * 144 + hh * 16;
#pragma unroll
                for (int ks = 0; ks < 4; ++ks) { const bf16x8 a = *(const LAS bf16x8*)(kp + ks * 32); s[t] = MFMA32(a, qf[ks], s[t]); }
            }
            const int qi = i0 + r32;
            float mx = sink;
#pragma unroll
            for (int t = 0; t < 5; ++t)
#pragma unroll
                for (int r = 0; r < 16; ++r) { const int kj = (jt0 + t) * 32 + crow(r, hh); const bool valid = (kj > qi) && (kj <= qi + 128) && (n > 0 || kj >= 128);
                    s[t][r] = valid ? s[t][r] : -INFINITY; mx = fmaxf(mx, s[t][r]); }
            mx = xhalf_max(mx);
            float sm = 0.f; const float mxl = mx * LOG2E;
            u32x4 pf[5][2];
#pragma unroll
            for (int t = 0; t < 5; ++t) {
#pragma unroll
                for (int r = 0; r < 16; ++r) { const float pv = __builtin_amdgcn_exp2f(s[t][r] * LOG2E - mxl); s[t][r] = pv; sm += pv; }
#pragma unroll
                for (int sx = 0; sx < 2; ++sx) pf[t][sx] = (u32x4){pk2(s[t][8 * sx], s[t][8 * sx + 1]), pk2(s[t][8 * sx + 2], s[t][8 * sx + 3]), pk2(s[t][8 * sx + 4], s[t][8 * sx + 5]), pk2(s[t][8 * sx + 6], s[t][8 * sx + 7])};
            }
            sm = xhalf_sum(sm) + __builtin_amdgcn_exp2f(sink * LOG2E - mxl);
            f32x16 o[2];
#pragma unroll
            for (int dt = 0; dt < 2; ++dt)
#pragma unroll
                for (int r = 0; r < 16; ++r) o[dt][r] = 0.f;
#pragma unroll
            for (int t = 0; t < 5; ++t)
#pragma unroll
                for (int sx = 0; sx < 2; ++sx) { const bf16x8 pb = __builtin_bit_cast(bf16x8, pf[t][sx]);
#pragma unroll
                    for (int dt = 0; dt < 2; ++dt) { const LAS unsigned char* q = VL + (dt * 32 + r32) * 520 + ((jt0 + t) * 32 + 16 * sx + 4 * hh) * 2;
                        const s16x4 lo = *(const LAS s16x4*)q, hi = *(const LAS s16x4*)(q + 16);
                        const bf16x8 a = (bf16x8){lo[0], lo[1], lo[2], lo[3], hi[0], hi[1], hi[2], hi[3]}; o[dt] = MFMA32(a, pb, o[dt]); } }
            const float inv = 1.f / sm;
            bf16_t* orow = O + qtok * 1024 + hq * 64 + 4 * hh;
#pragma unroll
            for (int dt = 0; dt < 2; ++dt)
#pragma unroll
                for (int gq = 0; gq < 4; ++gq) { u32x2 w; w.x = pk2(o[dt][4 * gq] * inv, o[dt][4 * gq + 1] * inv); w.y = pk2(o[dt][4 * gq + 2] * inv, o[dt][4 * gq + 3] * inv); *(u32x2*)(orow + dt * 32 + 8 * gq) = w; }
        }
    }
}
constexpr int TS = 272;
template <int STRIDE = TS>
__device__ __forceinline__ bf16x8 tr_frag(const LAS unsigned char* T, int k0, int c0, int lane, bool permuted) {
    const int hh = lane >> 5, blk = (lane >> 4) & 1, q = (lane & 15) >> 2, pp = lane & 3;
    const int r0 = k0 + (permuted ? 4 * hh : 8 * hh) + q, r1 = r0 + (permuted ? 8 : 4);
    const int cb = (c0 + 16 * blk + 4 * pp) * 2;
    const s16x4 lo = lds_tr(T + r0 * STRIDE + cb), hi = lds_tr(T + r1 * STRIDE + cb);
    return (bf16x8){lo[0], lo[1], lo[2], lo[3], hi[0], hi[1], hi[2], hi[3]};
}
__device__ __forceinline__ bf16x8 row_frag(const LAS unsigned char* T, int row, int k0, int hh) { return *(const LAS bf16x8*)(T + row * TS + (k0 + 8 * hh) * 2); }
__device__ __forceinline__ void load_tile128(LAS unsigned char* T, const bf16_t* __restrict__ g, int ld, int tid) {
#pragma unroll
    for (int i = 0; i < 4; ++i) { const int ch = tid + 512 * i, row = ch >> 4, c = ch & 15; *(LAS u32x4*)(T + row * TS + c * 16) = *(const u32x4*)(g + (size_t)row * ld + c * 8); }
}
struct L0Bufs {
    bf16_t *AU, *AV, *BX, *BZ, *V, *XC, *YM, *CS, *Q, *K, *U; float *GT, *UN, *NS, *SC;
    const bf16_t *WQT, *GMW, *MT; const float *gm_g, *gm_b, *gm_bs, *cw, *cb, *bif, *nw, *skip;
};

__device__ __forceinline__ void l0_mixA(LAS unsigned char* lds, const L0Bufs& B, int blk, int G) {
    const int tid0 = threadIdx.x, wave = __builtin_amdgcn_readfirstlane(tid0 >> 6);
#define OPQ_IDS int tid = tid0; asm volatile("" : "+v"(tid)); const int lane = tid & 63, r32 = lane & 31, hh = lane >> 5; (void)lane; (void)r32; (void)hh;
    LAS unsigned char* T0 = lds; LAS unsigned char* T1 = lds + 34816; LAS unsigned char* T2 = lds + 2 * 34816; LAS unsigned char* T3 = lds + 3 * 34816;
    LAS float* SF = (LAS float*)T2;
    LAS float* SG = (LAS float*)(lds + 3 * 34816 + 35632);
    for (int u = blk; u < 256; u += G) {
        const int tok0 = u * 128; const bool first = (u & 31) == 0;
        constexpr int VS = 1040;
        {   OPQ_IDS; const int trow = tid >> 2, q4 = tid & 3;
            const bf16_t* vr = B.AV + (size_t)(tok0 + trow) * 512 + q4 * 128; float s = 0.f, s2 = 0.f; u32x4 w[16];
#pragma unroll
            for (int i = 0; i < 16; ++i) w[i] = *(const u32x4*)(vr + i * 8);
#pragma unroll
            for (int i = 0; i < 16; ++i) { const float f[8] = {bf_lo(w[i].x), bf_hi(w[i].x), bf_lo(w[i].y), bf_hi(w[i].y), bf_lo(w[i].z), bf_hi(w[i].z), bf_lo(w[i].w), bf_hi(w[i].w)};
#pragma unroll
                for (int e = 0; e < 8; ++e) { s += f[e]; s2 += f[e] * f[e]; } }
            s += shx(s, 1, lane); s += shx(s, 2, lane); s2 += shx(s2, 1, lane); s2 += shx(s2, 2, lane);
            const float mean = s * (1.f / 512.f), rstd = rsqrtf(fmaxf(s2 * (1.f / 512.f) - mean * mean, 0.f) + LN_EPS);
            __syncthreads();
#pragma unroll
            for (int i = 0; i < 16; ++i) { const int cbase = q4 * 128 + i * 8; const f32x4 g0 = *(const f32x4*)(B.gm_g + cbase), g1 = *(const f32x4*)(B.gm_g + cbase + 4), b0 = *(const f32x4*)(B.gm_b + cbase), b1 = *(const f32x4*)(B.gm_b + cbase + 4);
                u32x4 o; o.x = pk2((bf_lo(w[i].x) - mean) * rstd * g0[0] + b0[0], (bf_hi(w[i].x) - mean) * rstd * g0[1] + b0[1]); o.y = pk2((bf_lo(w[i].y) - mean) * rstd * g0[2] + b0[2], (bf_hi(w[i].y) - mean) * rstd * g0[3] + b0[3]);
                o.z = pk2((bf_lo(w[i].z) - mean) * rstd * g1[0] + b1[0], (bf_hi(w[i].z) - mean) * rstd * g1[1] + b1[1]); o.w = pk2((bf_lo(w[i].w) - mean) * rstd * g1[2] + b1[2], (bf_hi(w[i].w) - mean) * rstd * g1[3] + b1[3]);
                *(LAS u32x4*)(lds + trow * VS + cbase * 2) = o; asm volatile("" ::: "memory"); }
            __syncthreads();
        }
        {   const int tb = wave & 3, dhf = wave >> 2;
#pragma unroll 1
            for (int g = 0; g < 4; ++g) {
                OPQ_IDS; const int t = 32 * tb + r32; const size_t tok = (size_t)tok0 + t;
                f32x16 acc[2];
#pragma unroll
                for (int dt = 0; dt < 2; ++dt)
#pragma unroll
                    for (int r = 0; r < 16; ++r) acc[dt][r] = 0.f;
                const bf16_t* wrow = B.GMW + ((size_t)g * 128 + t) * 128 + 8 * hh;
                bf16x8 bw[8];
#pragma unroll
                for (int ks = 0; ks < 8; ++ks) bw[ks] = *(const bf16x8*)(wrow + 16 * ks);
#pragma unroll
                for (int ks = 0; ks < 8; ++ks) if (ks <= 2 * tb + 1) {
#pragma unroll
                    for (int dt = 0; dt < 2; ++dt) { const bf16x8 a = tr_frag<VS>(lds, 16 * ks, g * 128 + 64 * dhf + 32 * dt, lane, false); acc[dt] = MFMA32(a, bw[ks], acc[dt]); } }
                const float bsv = B.gm_bs[g * 128 + t];
#pragma unroll
                for (int dt = 0; dt < 2; ++dt)
#pragma unroll
                    for (int gq = 0; gq < 4; ++gq) { const int col = g * 128 + 64 * dhf + 32 * dt + 8 * gq + 4 * hh; const u32x2 au = *(const u32x2*)(B.AU + tok * 512 + col);
                        u32x2 w; w.x = pk2(bf_lo(au.x) * (acc[dt][4 * gq] + bsv), bf_hi(au.x) * (acc[dt][4 * gq + 1] + bsv)); w.y = pk2(bf_lo(au.y) * (acc[dt][4 * gq + 2] + bsv), bf_hi(au.y) * (acc[dt][4 * gq + 3] + bsv));
                        *(u32x2*)(B.YM + tok * 1024 + col) = w; }
            }
        }
        f32x16 accg;
#pragma unroll
        for (int r = 0; r < 16; ++r) accg[r] = 0.f;
        LAS unsigned char* MTL = (LAS unsigned char*)SG;
#pragma unroll 1
        for (int h = 0; h < 4; ++h) {
            OPQ_IDS;
            __syncthreads();
            for (int ch = tid; ch < 131 * 16; ch += 512) { const int row = ch >> 4, c = ch & 15; u32x4 v = (u32x4){0u, 0u, 0u, 0u};
                if (!(first && row < 3)) v = *(const u32x4*)(B.BX + (size_t)(tok0 - 3 + row) * 512 + h * 128 + c * 8);
                *(LAS u32x4*)(T3 + row * TS + c * 16) = v; }
            load_tile128(T0, B.WQT + ((size_t)0 * 4 + h) * 128 * 128, 128, tid);
            load_tile128(T1, B.WQT + ((size_t)1 * 4 + h) * 128 * 128, 128, tid);
            if (tid < 256) { const int row = tid >> 5, c = tid & 31; *(LAS u32x4*)(MTL + row * 528 + c * 16) = *(const u32x4*)(B.MT + ((size_t)h * 8 + row) * 256 + c * 8); }
            __syncthreads();
            {   const int dc = tid & 15, chn = h * 128 + dc * 8; float w[4][8], cbv[8];
#pragma unroll
                for (int j = 0; j < 4; ++j)
#pragma unroll
                    for (int e = 0; e < 8; ++e) w[j][e] = B.cw[j * 512 + chn + e];
#pragma unroll
                for (int e = 0; e < 8; ++e) cbv[e] = B.cb[chn + e];
#pragma unroll 1
                for (int ps = 0; ps < 4; ++ps) { const int t = ps * 32 + (tid >> 4); float a[8];
#pragma unroll
                    for (int e = 0; e < 8; ++e) a[e] = cbv[e];
#pragma unroll
                    for (int j = 0; j < 4; ++j) { const u32x4 x = *(const LAS u32x4*)(T3 + (t + j) * TS + dc * 16);
                        a[0] += w[j][0] * bf_lo(x.x); a[1] += w[j][1] * bf_hi(x.x); a[2] += w[j][2] * bf_lo(x.y); a[3] += w[j][3] * bf_hi(x.y);
                        a[4] += w[j][4] * bf_lo(x.z); a[5] += w[j][5] * bf_hi(x.z); a[6] += w[j][6] * bf_lo(x.w); a[7] += w[j][7] * bf_hi(x.w); }
                    u32x4 o; o.x = pk2(silu_f(a[0]), silu_f(a[1])); o.y = pk2(silu_f(a[2]), silu_f(a[3])); o.z = pk2(silu_f(a[4]), silu_f(a[5])); o.w = pk2(silu_f(a[6]), silu_f(a[7]));
                    *(LAS u32x4*)(T2 + t * TS + dc * 16) = o; *(u32x4*)(B.XC + (size_t)(tok0 + t) * 512 + chn) = o; } }
            __syncthreads();
            {   const int tb = wave & 3, ehf = wave >> 2;
                {
                    OPQ_IDS; const LAS unsigned char* act = ehf ? T3 + 3 * TS : T2;
#pragma unroll
                    for (int ks = 0; ks < 8; ++ks) { const bf16x8 a = *(const LAS bf16x8*)(MTL + (r32 & 7) * 528 + (ehf * 128 + 16 * ks + 8 * hh) * 2); const bf16x8 bx = row_frag(act, 32 * tb + r32, 16 * ks, hh); accg = MFMA32(a, bx, accg); } }
#pragma unroll 1
                for (int mtx = 0; mtx < 2; ++mtx) {
                    OPQ_IDS;
                    const LAS unsigned char* wt = mtx ? T1 : T0;
                    f32x16 acc[2];
#pragma unroll
                    for (int et = 0; et < 2; ++et)
#pragma unroll
                        for (int r = 0; r < 16; ++r) acc[et][r] = 0.f;
#pragma unroll
                    for (int ks = 0; ks < 8; ++ks) { const bf16x8 bx = row_frag(T2, 32 * tb + r32, 16 * ks, hh);
#pragma unroll
                        for (int et = 0; et < 2; ++et) { const bf16x8 a = row_frag(wt, 64 * ehf + 32 * et + r32, 16 * ks, hh); acc[et] = MFMA32(a, bx, acc[et]); } }
                    bf16_t* dst = (mtx == 0 ? B.Q : B.K) + (size_t)(tok0 + 32 * tb + r32) * 512 + h * 128 + 64 * ehf + 4 * hh;
#pragma unroll
                    for (int et = 0; et < 2; ++et)
#pragma unroll
                        for (int gq = 0; gq < 4; ++gq) { u32x2 w; w.x = pk2(acc[et][4 * gq], acc[et][4 * gq + 1]); w.y = pk2(acc[et][4 * gq + 2], acc[et][4 * gq + 3]); *(u32x2*)(dst + 32 * et + 8 * gq) = w; }
                }
            }
            __syncthreads();
            load_tile128(T0, B.WQT + ((size_t)2 * 4 + h) * 128 * 128, 128, tid);
            __syncthreads();
            {   OPQ_IDS; const int tb = wave & 3, ehf = wave >> 2;
                f32x16 acc[2];
#pragma unroll
                for (int et = 0; et < 2; ++et)
#pragma unroll
                    for (int r = 0; r < 16; ++r) acc[et][r] = 0.f;
#pragma unroll
                for (int ks = 0; ks < 8; ++ks) { const bf16x8 bx = row_frag(T3 + 3 * TS, 32 * tb + r32, 16 * ks, hh);
#pragma unroll
                    for (int et = 0; et < 2; ++et) { const bf16x8 a = row_frag(T0, 64 * ehf + 32 * et + r32, 16 * ks, hh); acc[et] = MFMA32(a, bx, acc[et]); } }
                bf16_t* dst = B.V + (size_t)(tok0 + 32 * tb + r32) * 512 + h * 128 + 64 * ehf + 4 * hh;
#pragma unroll
                for (int et = 0; et < 2; ++et)
#pragma unroll
                    for (int gq = 0; gq < 4; ++gq) { u32x2 w; w.x = pk2(acc[et][4 * gq], acc[et][4 * gq + 1]); w.y = pk2(acc[et][4 * gq + 2], acc[et][4 * gq + 3]); *(u32x2*)(dst + 32 * et + 8 * gq) = w; }
            }
        }
        __syncthreads();
        {   OPQ_IDS; const int tb = wave & 3, kh = wave >> 2;
#pragma unroll
            for (int r = 0; r < 4; ++r) SF[(kh * 8 + r + 4 * hh) * 128 + 32 * tb + r32] = accg[r];
        }
        __syncthreads();
        LAS float* IG = SG; LAS float* BC = SG + 512; LAS float* WG = SG + 1024;
        if (wave < 4) {
            OPQ_IDS; const int h = wave; float lf[2], ig[2];
#pragma unroll
            for (int e = 0; e < 2; ++e) { const int t = 2 * lane + e; ig[e] = SF[h * 128 + t] + SF[(8 + h) * 128 + t] + B.bif[h];
                const float fx = SF[(4 + h) * 128 + t] + SF[(12 + h) * 128 + t] + B.bif[4 + h]; lf[e] = fminf(fx, 0.f) - log1pf(expf(-fabsf(fx))); }
            float run = lf[0] + lf[1];
#pragma unroll
            for (int o = 1; o < 64; o <<= 1) { const float v = shup(run, o, lane); if (lane >= o) run += v; }
            const float b1 = run, b0 = run - lf[1];
            IG[h * 128 + 2 * lane] = ig[0]; IG[h * 128 + 2 * lane + 1] = ig[1]; BC[h * 128 + 2 * lane] = b0; BC[h * 128 + 2 * lane + 1] = b1;
            float* gt = B.GT + ((size_t)u * 4 + h) * 256;
            gt[2 * lane] = ig[0]; gt[2 * lane + 1] = ig[1]; gt[128 + 2 * lane] = b0; gt[128 + 2 * lane + 1] = b1;
            const float bl = shidx(b1, 63);
            float g0 = bl - b0 + ig[0], g1 = bl - b1 + ig[1]; float mloc = fmaxf(g0, g1);
#pragma unroll
            for (int o = 1; o < 64; o <<= 1) mloc = fmaxf(mloc, shx(mloc, o, lane));
            WG[h * 128 + 2 * lane] = expf(g0 - mloc); WG[h * 128 + 2 * lane + 1] = expf(g1 - mloc);
            if (lane == 0) { B.SC[u * 4 + h] = bl; B.SC[1024 + u * 4 + h] = mloc; }
        }
#pragma unroll 1
        for (int h = 0; h < 4; ++h) {
            OPQ_IDS;
            __syncthreads();
#pragma unroll
            for (int i = 0; i < 4; ++i) { const int ch = tid + 512 * i, row = ch >> 4, c = ch & 15; const float wg = WG[h * 128 + row];
                const u32x4 v = *(const u32x4*)(B.V + (size_t)(tok0 + row) * 512 + h * 128 + c * 8), k = *(const u32x4*)(B.K + (size_t)(tok0 + row) * 512 + h * 128 + c * 8);
                u32x4 ov, ok; const float ksc = 0.08838834764831845f;
                ov.x = pk2(bf_lo(v.x) * wg, bf_hi(v.x) * wg); ov.y = pk2(bf_lo(v.y) * wg, bf_hi(v.y) * wg); ov.z = pk2(bf_lo(v.z) * wg, bf_hi(v.z) * wg); ov.w = pk2(bf_lo(v.w) * wg, bf_hi(v.w) * wg);
                ok.x = pk2(bf_lo(k.x) * ksc, bf_hi(k.x) * ksc); ok.y = pk2(bf_lo(k.y) * ksc, bf_hi(k.y) * ksc); ok.z = pk2(bf_lo(k.z) * ksc, bf_hi(k.z) * ksc); ok.w = pk2(bf_lo(k.w) * ksc, bf_hi(k.w) * ksc);
                *(LAS u32x4*)(T0 + row * TS + c * 16) = ov; *(LAS u32x4*)(T1 + row * TS + c * 16) = ok; }
            __syncthreads();
            const int vb = wave & 3, khf = wave >> 2;
            f32x16 acc[2];
#pragma unroll
            for (int kt = 0; kt < 2; ++kt)
#pragma unroll
                for (int r = 0; r < 16; ++r) acc[kt][r] = 0.f;
#pragma unroll
            for (int ks = 0; ks < 8; ++ks) { const bf16x8 a = tr_frag(T0, 16 * ks, 32 * vb, lane, false);
#pragma unroll
                for (int kt = 0; kt < 2; ++kt) { const bf16x8 bk = tr_frag(T1, 16 * ks, 64 * khf + 32 * kt, lane, false); acc[kt] = MFMA32(a, bk, acc[kt]); } }
            bf16_t* Uo = B.U + ((size_t)u * 4 + h) * 16384;
#pragma unroll
            for (int kt = 0; kt < 2; ++kt)
#pragma unroll
                for (int r = 0; r < 16; ++r) Uo[(32 * vb + crow(r, hh)) * 128 + 64 * khf + 32 * kt + r32] = f2bf(acc[kt][r]);
            {   const int kk = tid & 127, sq = tid >> 7; float a = 0.f;
                for (int s = sq * 32; s < sq * 32 + 32; ++s) a += WG[h * 128 + s] * bf2f(*(const LAS bf16_t*)(T1 + s * TS + kk * 2));
                SF[2048 + sq * 128 + kk] = a; }
            __syncthreads();
            if (tid < 128) B.UN[((size_t)u * 4 + h) * 128 + tid] = (SF[2048 + tid] + SF[2048 + 128 + tid]) + (SF[2048 + 256 + tid] + SF[2048 + 384 + tid]);
        }
    }
}
#undef OPQ_IDS
__device__ __forceinline__ void l0_scan(const L0Bufs& B, int blk, int tid) {
    const int bh = blk >> 3, part = blk & 7, b = bh >> 2, h = bh & 3, lane = tid & 63;
    const int e0 = part * 2048 + tid * 8;
    float zz = 0.f; asm volatile("" : "+v"(zz));
    f32x4 C0 = (f32x4){zz, zz, zz, zz}, C1 = C0; float nst = 0.f; float m = 0.f;
    const int unit0 = (b * 32) * 4 + h;
    const bool nrm = part == 0 && tid < 128;
    const float blv = lane < 32 ? B.SC[unit0 + 4 * lane] : 0.f, mlv = lane < 32 ? B.SC[1024 + unit0 + 4 * lane] : 0.f;
    u32x4 ub[8]; float un8[8];
#pragma unroll
    for (int j = 0; j < 8; ++j) { ub[j] = *(const u32x4*)(B.U + (size_t)(unit0 + 4 * j) * 16384 + e0); un8[j] = B.UN[(size_t)(unit0 + 4 * j) * 128 + (tid & 127)]; }
#pragma unroll
    for (int g = 0; g < 4; ++g) {
        u32x4 nb[8]; float nn[8];
#pragma unroll
        for (int j = 0; j < 8; ++j) { const int un1 = unit0 + 4 * (8 * (g < 3 ? g + 1 : 3) + j); nb[j] = *(const u32x4*)(B.U + (size_t)un1 * 16384 + e0); nn[j] = B.UN[(size_t)un1 * 128 + (tid & 127)]; }
#pragma unroll
        for (int j = 0; j < 8; ++j) { const int c = 8 * g + j, unit = unit0 + 4 * c; const u32x4 Unw = ub[j];
            const f32x4 U0 = (f32x4){bf_lo(Unw.x), bf_hi(Unw.x), bf_lo(Unw.y), bf_hi(Unw.y)}, U1 = (f32x4){bf_lo(Unw.z), bf_hi(Unw.z), bf_lo(Unw.w), bf_hi(Unw.w)};
            const float bl = __int_as_float(__builtin_amdgcn_readlane(__float_as_int(blv), c)), mloc = __int_as_float(__builtin_amdgcn_readlane(__float_as_int(mlv), c)), un = un8[j];
            u32x4 w; w.x = pk2(C0[0], C0[1]); w.y = pk2(C0[2], C0[3]); w.z = pk2(C1[0], C1[1]); w.w = pk2(C1[2], C1[3]); *(u32x4*)(B.CS + (size_t)unit * 16384 + e0) = w;
            if (nrm) B.NS[(size_t)unit * 128 + tid] = nst;
            if (part == 0 && tid == 0) B.SC[2048 + unit] = m;
            const float mn = fmaxf(bl + m, mloc), dec = expf(bl + m - mn), wu = expf(mloc - mn); m = mn;
            C0 = C0 * dec + U0 * wu; C1 = C1 * dec + U1 * wu;
            nst = nst * dec + wu * un; }
#pragma unroll
        for (int j = 0; j < 8; ++j) { ub[j] = nb[j]; un8[j] = nn[j]; }
    }
}
__device__ __forceinline__ void l0_mixC(LAS unsigned char* lds, const L0Bufs& B, int blk, int G) {
    const int tid0 = threadIdx.x, wave = __builtin_amdgcn_readfirstlane(tid0 >> 6);
    LAS unsigned char* TQ = lds; LAS unsigned char* TK = lds + 34816; LAS unsigned char* TV = lds + 2 * 34816; LAS unsigned char* TC = lds + 3 * 34816;
    LAS float* SF = (LAS float*)(lds + 4 * 34816);
    LAS float* AS = SF; LAS float* PM = SF + 128; LAS float* NP = SF + 256; LAS float* PS = SF + 384; LAS float* PQ = SF + 640; LAS float* NW = SF + 896;
    __syncthreads();
    { int tq = tid0; asm volatile("" : "+v"(tq)); if (tq < 256) ((LAS f32x4*)NW)[tq] = tq < 128 ? ((const f32x4*)B.nw)[tq] : ((const f32x4*)B.skip)[tq - 128]; }
    for (int uu = blk; uu < 256; uu += G) {
        const int tok0 = uu * 128;
#pragma unroll 1
        for (int h = 0; h < 4; ++h) {
            const int unit = uu * 4 + h;
            int tid = tid0; asm volatile("" : "+v"(tid));
            const int lane = tid & 63, r32 = lane & 31, hh = lane >> 5;
            __syncthreads();
            load_tile128(TQ, B.Q + (size_t)tok0 * 512 + h * 128, 512, tid);
            load_tile128(TV, B.V + (size_t)tok0 * 512 + h * 128, 512, tid);
            load_tile128(TC, B.CS + (size_t)unit * 16384, 128, tid);
#pragma unroll
            for (int i = 0; i < 4; ++i) { const int ch = tid + 512 * i, row = ch >> 4, c = ch & 15; const u32x4 k = *(const u32x4*)(B.K + (size_t)(tok0 + row) * 512 + h * 128 + c * 8); const float ksc = 0.08838834764831845f;
                u32x4 ok; ok.x = pk2(bf_lo(k.x) * ksc, bf_hi(k.x) * ksc); ok.y = pk2(bf_lo(k.y) * ksc, bf_hi(k.y) * ksc); ok.z = pk2(bf_lo(k.z) * ksc, bf_hi(k.z) * ksc); ok.w = pk2(bf_lo(k.w) * ksc, bf_hi(k.w) * ksc);
                *(LAS u32x4*)(TK + row * TS + c * 16) = ok; }
            const float mprev = B.SC[2048 + unit];
            if (wave == 0) {
                const float* gt = B.GT + (size_t)unit * 256;
                const float a0 = gt[2 * lane] - gt[128 + 2 * lane], a1 = gt[2 * lane + 1] - gt[128 + 2 * lane + 1];
                float run = fmaxf(a0, a1);
#pragma unroll
                for (int o = 1; o < 64; o <<= 1) { const float v = shup(run, o, lane); if (lane >= o) run = fmaxf(run, v); }
                const float prev = shup(run, 1, lane); const float p0 = fmaxf(lane > 0 ? fmaxf(prev, a0) : a0, mprev), p1 = fmaxf(run, mprev);
                AS[2 * lane] = a0; AS[2 * lane + 1] = a1; PM[2 * lane] = p0; PM[2 * lane + 1] = p1;
            }
            if (wave == 1) { NP[lane] = B.NS[(size_t)unit * 128 + lane]; NP[64 + lane] = B.NS[(size_t)unit * 128 + 64 + lane]; }
            __syncthreads();
            const int tb = wave & 3, vh = wave >> 2, t = 32 * tb + r32;
            const float pm = PM[t], bt = B.GT[(size_t)unit * 256 + 128 + t];
            f32x16 s[4];
#pragma unroll
            for (int st = 0; st < 4; ++st)
#pragma unroll
                for (int r = 0; r < 16; ++r) s[st][r] = 0.f;
            {   int lv = lane; asm volatile("" : "+v"(lv));
                const LAS unsigned char* qp = TQ + (32 * tb + (lv & 31)) * TS + (lv >> 5) * 16; const LAS unsigned char* kp = TK + (lv & 31) * TS + (lv >> 5) * 16;
#pragma unroll 2
                for (int ks = 0; ks < 8; ++ks) { const bf16x8 bq = *(const LAS bf16x8*)(qp + ks * 32);
#pragma unroll
                    for (int st = 0; st < 4; ++st) if (st <= tb) { const bf16x8 a = *(const LAS bf16x8*)(kp + st * 32 * TS + ks * 32); s[st] = MFMA32(a, bq, s[st]); } } }
            float nq = 0.f; u32x4 pf[4][2];
#pragma unroll
            for (int st = 0; st < 4; ++st) {
#pragma unroll
                for (int r = 0; r < 16; ++r) { const int sidx = 32 * st + crow(r, hh); const float wv = (sidx <= t) ? __builtin_amdgcn_exp2f((AS[sidx] - pm) * LOG2E) : 0.f; const float pv = s[st][r] * wv; s[st][r] = pv; nq += pv; }
#pragma unroll
                for (int sx = 0; sx < 2; ++sx) pf[st][sx] = (u32x4){pk2(s[st][8 * sx], s[st][8 * sx + 1]), pk2(s[st][8 * sx + 2], s[st][8 * sx + 3]), pk2(s[st][8 * sx + 4], s[st][8 * sx + 5]), pk2(s[st][8 * sx + 6], s[st][8 * sx + 7])};
            }
            nq = xhalf_sum(nq);
            float nqi = 0.f;
#pragma unroll
            for (int i = 0; i < 8; ++i) { const u32x4 qv = *(const LAS u32x4*)(TQ + t * TS + (64 * hh + 8 * i) * 2); const LAS float* np = NP + 64 * hh + 8 * i;
                nqi += bf_lo(qv.x) * np[0] + bf_hi(qv.x) * np[1] + bf_lo(qv.y) * np[2] + bf_hi(qv.y) * np[3] + bf_lo(qv.z) * np[4] + bf_hi(qv.z) * np[5] + bf_lo(qv.w) * np[6] + bf_hi(qv.w) * np[7]; }
            nqi = xhalf_sum(nqi);
            const float wst = __builtin_amdgcn_exp2f((mprev - pm) * LOG2E);
            const float den = fmaxf(fabsf(nq + wst * nqi), __builtin_amdgcn_exp2f(-(bt + pm) * LOG2E)), rden = 1.f / den;
            f32x16 ni[2], nx[2];
#pragma unroll
            for (int vt = 0; vt < 2; ++vt)
#pragma unroll
                for (int r = 0; r < 16; ++r) { ni[vt][r] = 0.f; nx[vt][r] = 0.f; }
            {   int lv = lane; asm volatile("" : "+v"(lv));
#pragma unroll
                for (int st = 0; st < 4; ++st) {
                    if (st <= tb) {
#pragma unroll
                        for (int sx = 0; sx < 2; ++sx) { const bf16x8 pb = __builtin_bit_cast(bf16x8, pf[st][sx]);
#pragma unroll
                            for (int vt = 0; vt < 2; ++vt) { const bf16x8 a = tr_frag(TV, 32 * st + 16 * sx, 64 * vh + 32 * vt, lv, true); ni[vt] = MFMA32(a, pb, ni[vt]); } }
                    }
                } }
            {   int lv = lane; asm volatile("" : "+v"(lv));
                const LAS unsigned char* qp = TQ + (32 * tb + (lv & 31)) * TS + (lv >> 5) * 16; const LAS unsigned char* cp = TC + (64 * vh + (lv & 31)) * TS + (lv >> 5) * 16;
#pragma unroll 2
                for (int ks = 0; ks < 8; ++ks) { const bf16x8 bq = *(const LAS bf16x8*)(qp + ks * 32);
#pragma unroll
                    for (int vt = 0; vt < 2; ++vt) { const bf16x8 a = *(const LAS bf16x8*)(cp + vt * 32 * TS + ks * 32); nx[vt] = MFMA32(a, bq, nx[vt]); } } }
            const size_t tok = (size_t)tok0 + t;
            u32x2 xcv[2][4], zv[2][4];
#pragma unroll
            for (int vt = 0; vt < 2; ++vt)
#pragma unroll
                for (int gq = 0; gq < 4; ++gq) { const int chn = h * 128 + 64 * vh + 32 * vt + 8 * gq + 4 * hh; xcv[vt][gq] = *(const u32x2*)(B.XC + tok * 512 + chn); zv[vt][gq] = *(const u32x2*)(B.BZ + tok * 512 + chn); }
            float hs = 0.f, hq = 0.f;
#pragma unroll
            for (int vt = 0; vt < 2; ++vt)
#pragma unroll
                for (int r = 0; r < 16; ++r) { const float hv = (ni[vt][r] + wst * nx[vt][r]) * rden; ni[vt][r] = hv; hs += hv; hq += hv * hv; }
            hs = xhalf_sum(hs); hq = xhalf_sum(hq);
            if (hh == 0) { PS[vh * 128 + t] = hs; PQ[vh * 128 + t] = hq; }
            __syncthreads();
            const float mean = (PS[t] + PS[128 + t]) * (1.f / 128.f);
            const float rstd = rsqrtf(fmaxf((PQ[t] + PQ[128 + t]) * (1.f / 128.f) - mean * mean, 0.f) + LN_EPS);
#pragma unroll
            for (int vt = 0; vt < 2; ++vt)
#pragma unroll
                for (int gq = 0; gq < 4; ++gq) { const int cl = 64 * vh + 32 * vt + 8 * gq + 4 * hh, chn = h * 128 + cl;
                    const f32x4 nw = *(const LAS f32x4*)(NW + chn), sk = *(const LAS f32x4*)(NW + 512 + chn); const u32x2 xc = xcv[vt][gq], z = zv[vt][gq];
                    const float y0 = ((ni[vt][4 * gq] - mean) * rstd * nw[0] + sk[0] * bf_lo(xc.x)) * silu_f(bf_lo(z.x)), y1 = ((ni[vt][4 * gq + 1] - mean) * rstd * nw[1] + sk[1] * bf_hi(xc.x)) * silu_f(bf_hi(z.x));
                    const float y2 = ((ni[vt][4 * gq + 2] - mean) * rstd * nw[2] + sk[2] * bf_lo(xc.y)) * silu_f(bf_lo(z.y)), y3 = ((ni[vt][4 * gq + 3] - mean) * rstd * nw[3] + sk[3] * bf_hi(xc.y)) * silu_f(bf_hi(z.y));
                    u32x2 w; w.x = pk2(y0, y1); w.y = pk2(y2, y3); *(u32x2*)(B.YM + tok * 1024 + 512 + chn) = w; }
        }
    }
}
constexpr size_t MB = 1048576ull;
constexpr size_t P_WIN_T = 0, P_WOUT_T = P_WIN_T + 4 * MB, P_WQKV_T = P_WOUT_T + 2 * MB, P_WO_T = P_WQKV_T + 3 * MB, P_XWQ_T = P_WO_T + 2 * MB, P_XWKV_T = P_XWQ_T + 4 * MB, P_XWO_T = P_XWKV_T + 8 * MB,
                 P_MLW_T = P_XWO_T + 4 * MB, P_WIFT = P_MLW_T + MB / 2, P_WRT = P_WIFT + MB / 8, P_ROT = P_WRT + MB / 2, P_BQK = P_ROT + MB, P_MEMB = P_BQK + MB / 8, P_KC = P_MEMB + 4 * MB, P_VT = P_KC + 8 * MB,
                 P_W13T = P_VT + 8 * MB, P_W2T = P_W13T + 64 * MB, P_XBF = P_W2T + 32 * MB, P_RT = P_XBF + 64 * MB, P_TMP = P_RT + 2 * MB;
constexpr size_t RT_SRC = 1638400;
constexpr size_t RT_E = 0, RT_W = 262144, RT_RANK = 2 * 262144, RT_DEST = 3 * 262144, RT_HIST = 4 * 262144, RT_TSTART = RT_HIST + 32768;
constexpr size_t T_QX = 0, T_OB = 64 * MB, T_YB = 128 * MB;
constexpr size_t T_K1 = 192 * MB, T_VT1 = 208 * MB;
constexpr size_t T_AU = 0, T_AV = 32 * MB, T_BX = 64 * MB, T_BZ = 96 * MB, T_V = 128 * MB, T_XC = 160 * MB, T_YM = 192 * MB, T_U = 256 * MB, T_CS = 320 * MB,
                 T_GT = 352 * MB, T_UN = 353 * MB, T_NS = 353 * MB + MB / 2, T_SC = 354 * MB, T_YB0 = 0;
constexpr size_t T_XG = 0, T_HM = 152 * MB, T_YG = 0;
constexpr size_t T_SLOT = 356 * MB;
constexpr size_t FAST_END = P_TMP + 360 * MB;
#if defined(PROBE_LNX) || defined(PROBE_LNV)
constexpr size_t SLOT_MB = 8;
#else
constexpr size_t SLOT_MB = 4;
#endif
constexpr int LDS_BYTES = 147456;

struct FP {
    const float* in[33]; float* X;
    unsigned char* ws;
};
typedef const float* const __attribute__((address_space(4)))* InTab;
struct PV { InTab in; float* X; unsigned char* ws; };
__device__ __forceinline__ PV make_pv(const FP& p0) {
    PV p; InTab kp = (InTab)__builtin_amdgcn_kernarg_segment_ptr(); asm volatile("" : "+s"(kp)); p.in = kp;
    p.X = p0.X; p.ws = p0.ws; asm volatile("" : "+s"(p.ws)); return p;
}
#define WSP(T, off) ((T*)(p.ws + (off)))

__device__ __forceinline__ RouteBufs route_bufs(const PV& p) {
    RouteBufs r; r.e = WSP(int, P_RT + RT_E); r.w = WSP(float, P_RT + RT_W); r.rank = WSP(int, P_RT + RT_RANK); r.dest = WSP(int, P_RT + RT_DEST); r.hist = WSP(int, P_RT + RT_HIST); r.tstart = WSP(int, P_RT + RT_TSTART); r.src = WSP(int, P_RT + RT_SRC); return r;
}
#define PH_ARGS const PV& p, LAS unsigned char* lds, int blk, int G
#define PH_IDS int tid_ = threadIdx.x; asm volatile("" : "+v"(tid_)); const int tid = tid_, lane = tid & 63, wave = __builtin_amdgcn_readfirstlane(tid >> 6); (void)lane; (void)wave;

__device__ __forceinline__ void ph_conv_xattn(PH_ARGS, int l, int& gw) {
    PH_IDS; LAS float* scr = (LAS float*)(lds + wave * 8448); const int ngw = G * NWAVE;
    convert_mats(p.in[23] + (size_t)l * 1024 * 1024, 1024, 1024, 1, 0, WSP(bf16_t, P_XWQ_T) + (size_t)l * 1024 * 1024, 0, RM_IDENT, 0.0625f, 1024, scr, gw, ngw, lane);
    convert_mats(p.in[24] + (size_t)l * 1024 * 2048, 1024, 2048, 1, 0, WSP(bf16_t, P_XWKV_T) + (size_t)l * 2048 * 1024, 0, RM_IDENT, 1.f, 0, scr, gw, ngw, lane);
    convert_mats(p.in[25] + (size_t)l * 1024 * 1024, 1024, 1024, 1, 0, WSP(bf16_t, P_XWO_T) + (size_t)l * 1024 * 1024, 0, RM_IDENT, 1.f, 0, scr, gw, ngw, lane);
    convert_rows(p.in[1], WSP(bf16_t, P_MEMB), (size_t)2048 * 1024, blk * NTHR + tid, G * NTHR);
}
__device__ __forceinline__ void conv_moe_waves(const PV& p, int l, LAS float* scr, int& gw, int ngw, int gt, int ngt, int lane) {
    const size_t wl = (size_t)l * 32 * 1024 * 512;
    convert_mats(p.in[30] + wl, 1024, 512, 32, (size_t)1024 * 512, WSP(bf16_t, P_W13T), (size_t)1024 * 1024, RM_PAIR0, 1.f, 0, scr, gw, ngw, lane);
    convert_mats(p.in[31] + wl, 1024, 512, 32, (size_t)1024 * 512, WSP(bf16_t, P_W13T), (size_t)1024 * 1024, RM_PAIR1, 1.f, 0, scr, gw, ngw, lane);
    convert_mats(p.in[32] + wl, 512, 1024, 32, (size_t)512 * 1024, WSP(bf16_t, P_W2T), (size_t)1024 * 512, RM_IDENT, 1.f, 0, scr, gw, ngw, lane);
    bf16_t* wrt = WSP(bf16_t, P_WRT) + (size_t)l * 2 * 64 * 1024; const float* wre = p.in[28] + (size_t)l * 1024 * 32; const float* wrg = p.in[26] + (size_t)l * 1024 * 4;
    for (int i = gt; i < 64 * 1024; i += ngt) { const int r = i >> 10, k = i & 1023;
        const float v = r < 32 ? wre[k * 32 + r] : (r < 36 ? wrg[k * 4 + (r - 32)] : 0.f);
        const bf16_t h = f2bf(v); wrt[i] = h; wrt[64 * 1024 + i] = f2bf(v - bf2f(h)); }
}
__device__ __forceinline__ void ph_conv_moe(PH_ARGS, int l, int& gw) {
    PH_IDS; conv_moe_waves(p, l, (LAS float*)(lds + wave * 8448), gw, G * NWAVE, blk * NTHR + tid, G * NTHR, lane);
}
__device__ __forceinline__ void ph_x_to_bf(PH_ARGS) { PH_IDS; convert_rows(p.X, WSP(bf16_t, P_XBF), (size_t)NT * 1024, blk * NTHR + tid, G * NTHR); }

__device__ __forceinline__ void set_job(LAS pg8::JobDesc* jt, int j, const void* A, const void* B, int nM, int nN, void* out, int ldc, int mode, const void* bias = nullptr, const void* rot = nullptr, void* out2 = nullptr) {
    unsigned long long a = (unsigned long long)A, b = (unsigned long long)B, o = (unsigned long long)out, bi = (unsigned long long)bias, ro = (unsigned long long)rot, o2 = (unsigned long long)out2;
    asm volatile("" : "+s"(a), "+s"(b), "+s"(o), "+s"(bi), "+s"(ro), "+s"(o2), "+s"(nM), "+s"(nN), "+s"(ldc), "+s"(mode));
    LAS pg8::JobDesc* d = jt + j; d->A = a; d->B = b; d->out = o; d->bias = bi; d->rot = ro; d->out2 = o2;
    d->nM = nM; d->nN = nN; d->ldc = ldc; d->mode = mode;
}
#define JT_PTR ((LAS pg8::JobDesc*)(lds + pg8::JT_OFF))
__device__ __forceinline__ void run_jobs(LAS unsigned char* lds, int K, int n0, int n1, int n2, int blk, int G) {
    __syncthreads();
    pg8::Jobs3 S; S.jt = JT_PTR; S.n0 = n0; S.n1 = n1; S.n2 = n2; S.K = K; S.G = G; S.c = blk;
    EpiMulti E; E.jt = JT_PTR;
    pg8::gemm_phase<EpiMulti, pg8::Jobs3, true, true>(lds, K, S, E);
}
__device__ __forceinline__ void ph_xattn_g1(PH_ARGS, int l) {
    const bf16_t* wkv = WSP(bf16_t, P_XWKV_T) + (size_t)l * 2048 * 1024;
    __syncthreads();
    if (threadIdx.x == 0) {
        set_job(JT_PTR, 0, WSP(bf16_t, P_MEMB), wkv, 8, 4, WSP(bf16_t, P_KC) + (size_t)l * 2048 * 1024, 1024, EM_PLAIN);
        set_job(JT_PTR, 1, wkv + (size_t)1024 * 1024, WSP(bf16_t, P_MEMB), 4, 8, WSP(bf16_t, P_VT) + (size_t)l * 1024 * 2048, 2048, EM_PLAIN);
        set_job(JT_PTR, 2, WSP(bf16_t, P_XBF), WSP(bf16_t, P_XWQ_T) + (size_t)l * 1024 * 1024, 128, 4, WSP(bf16_t, P_TMP + T_QX), 1024, EM_PLAIN);
    }
    run_jobs(lds, 1024, 32, 32, 512, blk, G);
}
__device__ __forceinline__ void ph_xattn_attn(PH_ARGS, int l) {
    xattn_phase(lds, WSP(bf16_t, P_TMP + T_QX), WSP(bf16_t, P_KC) + (size_t)l * 2048 * 1024, WSP(bf16_t, P_VT) + (size_t)l * 1024 * 2048, WSP(bf16_t, P_TMP + T_OB), blk, G);
}
__device__ __forceinline__ void ph_gemm_plain(PH_ARGS, const bf16_t* A, const bf16_t* Bt, bf16_t* out) {
    __syncthreads();
    if (threadIdx.x == 0) set_job(JT_PTR, 0, A, Bt, 128, 4, out, 1024, EM_PLAIN);
    run_jobs(lds, 1024, 512, 0, 0, blk, G);
}
template <bool XF32, bool OUTF32, bool MOE>
__device__ __forceinline__ void ph_ln(PH_ARGS, const bf16_t* y, int lnidx, bool dry = false) {
    PH_IDS; LnArgs a; a.xin32 = p.in[0]; a.xin = WSP(bf16_t, P_XBF); a.xout32 = dry ? WSP(float, P_TMP + 200 * MB) : p.X; a.xbf = dry ? WSP(bf16_t, P_TMP + 288 * MB) : WSP(bf16_t, P_XBF); a.y = y; a.g = p.in[2] + lnidx * 1024; a.b = p.in[3] + lnidx * 1024;
    a.dest = WSP(int, P_RT + RT_DEST); a.wts = WSP(float, P_RT + RT_W);
    ln_phase<XF32, OUTF32, MOE>(a, blk, G, wave, lane);
}
__device__ __forceinline__ void ph_moe_route(PH_ARGS, int l) {
    moe_router_phase(lds, WSP(bf16_t, P_XBF), WSP(bf16_t, P_WRT) + (size_t)l * 2 * 64 * 1024, p.in[27] + l * 4, p.in[29] + l * 32, route_bufs(p), blk);
}
__device__ __forceinline__ void ph_moe_scatter(PH_ARGS) { moe_scatter_phase(lds, route_bufs(p), blk, G); }
__device__ __forceinline__ void ph_moe_g1(PH_ARGS) {
    __syncthreads();
    if (threadIdx.x == 0) set_job(JT_PTR, 0, nullptr, nullptr, 0, 0, WSP(bf16_t, P_TMP + T_HM), 512, EM_SWIGLU);
    __syncthreads();
    MoeSched S; S.A = (const char*)WSP(bf16_t, P_TMP + T_XG); S.B = (const char*)WSP(bf16_t, P_W13T); S.tstart = WSP(int, P_RT + RT_TSTART); S.K = 1024; S.nN = 4; S.G = G; S.c = blk; S.bexp = (size_t)1024 * 1024 * 2;
    EpiMulti E; E.jt = JT_PTR;
    pg8::gemm_phase<EpiMulti, MoeSched, true, true>(lds, 1024, S, E);
}
__device__ __forceinline__ void ph_moe_g2(PH_ARGS) {
    __syncthreads();
    if (threadIdx.x == 0) set_job(JT_PTR, 0, nullptr, nullptr, 0, 0, WSP(bf16_t, P_TMP + T_YG), 1024, EM_PLAIN);
    __syncthreads();
    MoeSched S; S.A = (const char*)WSP(bf16_t, P_TMP + T_HM); S.B = (const char*)WSP(bf16_t, P_W2T); S.tstart = WSP(int, P_RT + RT_TSTART); S.K = 512; S.nN = 4; S.G = G; S.c = blk; S.bexp = (size_t)1024 * 512 * 2;
    EpiMulti E; E.jt = JT_PTR;
    pg8::gemm_phase<EpiMulti, MoeSched, true, true>(lds, 512, S, E);
}

__device__ __forceinline__ void ph_conv_l1(PH_ARGS, int& gw) {
    PH_IDS; LAS float* scr = (LAS float*)(lds + wave * 8448); const int ngw = G * NWAVE;
    convert_mats(p.in[19], 1024, 1536, 1, 0, WSP(bf16_t, P_WQKV_T), 0, RM_ROT, 0.125f, 1024, scr, gw, ngw, lane);
    convert_mats(p.in[22], 1024, 1024, 1, 0, WSP(bf16_t, P_WO_T), 0, RM_IDENT, 1.f, 0, scr, gw, ngw, lane);
    const int gt = blk * NTHR + tid, ngt = G * NTHR;
    float* bqk = WSP(float, P_BQK);
    for (int n = gt; n < 1280; n += ngt) bqk[rowmap(RM_ROT, n)] = p.in[20][n] * (n < 1024 ? 0.125f : 1.f);
    float* rot = WSP(float, P_ROT);
    for (int i = gt; i < 4096 * 32; i += ngt) { const int pos = i >> 5, k = i & 31; const float inv = powf(10000.f, -(float)(2 * k) / 64.f); const float ang = (float)pos * inv; rot[2 * i] = cosf(ang); rot[2 * i + 1] = sinf(ang); }
}
__device__ __forceinline__ void ph_l1_g1(PH_ARGS) {
    __syncthreads();
    if (threadIdx.x == 0) {
        set_job(JT_PTR, 0, WSP(bf16_t, P_XBF), WSP(bf16_t, P_WQKV_T), 128, 5, WSP(bf16_t, P_TMP + T_QX), 1024, EM_ROTARY, WSP(float, P_BQK), WSP(float, P_ROT), WSP(bf16_t, P_TMP + T_K1));
        set_job(JT_PTR, 1, WSP(bf16_t, P_WQKV_T) + (size_t)1280 * 1024, WSP(bf16_t, P_XBF), 1, 128, WSP(bf16_t, P_TMP + T_VT1), NT, EM_ROWBIAS, p.in[20] + 1280);
    }
    run_jobs(lds, 1024, 640, 128, 0, blk, G);
}
__device__ __forceinline__ void ph_l1_swa(PH_ARGS) {
    swa_phase(lds, WSP(bf16_t, P_TMP + T_QX), WSP(bf16_t, P_TMP + T_K1), WSP(bf16_t, P_TMP + T_VT1), p.in[21], WSP(bf16_t, P_TMP + T_OB), blk, G);
}

__device__ __forceinline__ L0Bufs l0_bufs(const PV& p) {
    L0Bufs B; B.AU = WSP(bf16_t, P_TMP + T_AU); B.AV = WSP(bf16_t, P_TMP + T_AV); B.BX = WSP(bf16_t, P_TMP + T_BX); B.BZ = WSP(bf16_t, P_TMP + T_BZ); B.V = WSP(bf16_t, P_TMP + T_V); B.XC = WSP(bf16_t, P_TMP + T_XC);
    B.YM = WSP(bf16_t, P_TMP + T_YM); B.CS = WSP(bf16_t, P_TMP + T_CS); B.U = WSP(bf16_t, P_TMP + T_U); B.GT = WSP(float, P_TMP + T_GT); B.UN = WSP(float, P_TMP + T_UN); B.NS = WSP(float, P_TMP + T_NS); B.SC = WSP(float, P_TMP + T_SC);
    B.Q = B.AU; B.K = B.AV;
    B.WQT = WSP(bf16_t, P_MLW_T); B.GMW = WSP(bf16_t, P_MLW_T) + 12 * 16384; B.MT = WSP(bf16_t, P_WIFT);
    B.gm_g = p.in[5]; B.gm_b = p.in[6]; B.gm_bs = p.in[8]; B.cw = p.in[9]; B.cb = p.in[10]; B.bif = p.in[15]; B.nw = p.in[16]; B.skip = p.in[17]; return B;
}
__device__ __forceinline__ void ph_scan_conv(PH_ARGS) {
    PH_IDS;
    if (wave < 4) l0_scan(l0_bufs(p), blk, tid);
}
__device__ __forceinline__ void ph_conv_l0(PH_ARGS, int& gwr) {
    PH_IDS; LAS float* scr = (LAS float*)(lds + wave * 8448); const int gw = blk * NWAVE + wave, ngw = G * NWAVE;
    convert_mats(p.in[4], 1024, 2048, 1, 0, WSP(bf16_t, P_WIN_T), 0, RM_IDENT, 1.f, 0, scr, gwr, ngw, lane);
    convert_mats(p.in[18], 1024, 1024, 1, 0, WSP(bf16_t, P_WOUT_T), 0, RM_IDENT, 1.f, 0, scr, gwr, ngw, lane);
    convert_mats(p.in[11], 128, 128, 4, 16384, WSP(bf16_t, P_MLW_T), 16384, RM_IDENT, 1.f, 0, scr, gwr, ngw, lane);
    convert_mats(p.in[12], 128, 128, 4, 16384, WSP(bf16_t, P_MLW_T) + 4 * 16384, 16384, RM_IDENT, 1.f, 0, scr, gwr, ngw, lane);
    convert_mats(p.in[13], 128, 128, 4, 16384, WSP(bf16_t, P_MLW_T) + 8 * 16384, 16384, RM_IDENT, 1.f, 0, scr, gwr, ngw, lane);
    const int gt = blk * NTHR + tid, ngt = G * NTHR;
    bf16_t* gmw = WSP(bf16_t, P_MLW_T) + 12 * 16384;
    for (int i = gt; i < 4 * 16384; i += ngt) { const int t = (i >> 7) & 127, sidx = i & 127; gmw[i] = f2bf(sidx <= t ? p.in[7][i] : 0.f); }
    bf16_t* mt = WSP(bf16_t, P_WIFT);
    for (int i = gw; i < 4 * 8 * 256; i += ngw) { const int h = i >> 11, g = (i >> 8) & 7, j = i & 255, d = j & 127; float a = 0.f;
        for (int e = lane; e < 128; e += 64) {
            if (j < 128) a += p.in[11][((size_t)h * 128 + d) * 128 + e] * p.in[14][(h * 128 + e) * 8 + g] + p.in[12][((size_t)h * 128 + d) * 128 + e] * p.in[14][(512 + h * 128 + e) * 8 + g];
            else a += p.in[13][((size_t)h * 128 + d) * 128 + e] * p.in[14][(1024 + h * 128 + e) * 8 + g]; }
        a += shx(a, 32, lane); a += shx(a, 16, lane); a += shx(a, 8, lane); a += shx(a, 4, lane); a += shx(a, 2, lane); a += shx(a, 1, lane);
        if (lane == 0) mt[i] = f2bf(a); }
}
__device__ __forceinline__ void ph_xin_to_bf(PH_ARGS) { PH_IDS; convert_rows(p.in[0], WSP(bf16_t, P_XBF), (size_t)NT * 1024, blk * NTHR + tid, G * NTHR); }
__device__ __forceinline__ void ph_l0_g1(PH_ARGS) {
    __syncthreads();
    if (threadIdx.x == 0) set_job(JT_PTR, 0, WSP(bf16_t, P_XBF), WSP(bf16_t, P_WIN_T), 128, 8, WSP(bf16_t, P_TMP + T_AU), 512, EM_GELU4);
    run_jobs(lds, 1024, 1024, 0, 0, blk, G);
}

enum { K_CONV_XATTN = 0, K_CONV_MOE, K_X2BF, K_XATTN_G1, K_XATTN_ATTN, K_XATTN_G2, K_LN_Y, K_MOE_ROUTE, K_MOE_SCATTER, K_MOE_G1, K_MOE_G2, K_LN_MOE, K_CONV_L1, K_L1_G1, K_L1_SWA, K_L1_G2, K_CONV_L0, K_XIN2BF, K_L0_G1, K_L0_MIXA, K_L0_SCAN, K_L0_MIXC, K_L0_G2, K_LN_Y0 };
template <int PH>
__global__ void __launch_bounds__(NTHR, 2) k_phase(FP p0, int l, int lnidx) {
    const PV p = make_pv(p0);
    extern __shared__ __attribute__((aligned(16))) unsigned char smem[];
    LAS unsigned char* lds = (LAS unsigned char*)smem;
    const int blk = blockIdx.x, G = gridDim.x;
    if constexpr (PH == K_CONV_XATTN) { int gwr = blk * NWAVE + (threadIdx.x >> 6); ph_conv_xattn(p, lds, blk, G, l, gwr); }
    if constexpr (PH == K_CONV_MOE) { int gwr = blk * NWAVE + (threadIdx.x >> 6); ph_conv_moe(p, lds, blk, G, l, gwr); }
    if constexpr (PH == K_X2BF) ph_x_to_bf(p, lds, blk, G);
    if constexpr (PH == K_XATTN_G1) ph_xattn_g1(p, lds, blk, G, l);
    if constexpr (PH == K_XATTN_ATTN) ph_xattn_attn(p, lds, blk, G, l);
    if constexpr (PH == K_XATTN_G2) ph_gemm_plain(p, lds, blk, G, WSP(bf16_t, P_TMP + T_OB), WSP(bf16_t, P_XWO_T) + (size_t)l * 1024 * 1024, WSP(bf16_t, P_TMP + T_YB));
    if constexpr (PH == K_LN_Y) ph_ln<false, false, false>(p, lds, blk, G, WSP(bf16_t, P_TMP + T_YB), lnidx);
    if constexpr (PH == K_MOE_ROUTE) ph_moe_route(p, lds, blk, G, l);
    if constexpr (PH == K_MOE_SCATTER) ph_moe_scatter(p, lds, blk, G);
    if constexpr (PH == K_MOE_G1) ph_moe_g1(p, lds, blk, G);
    if constexpr (PH == K_MOE_G2) ph_moe_g2(p, lds, blk, G);
    if constexpr (PH == K_LN_MOE) ph_ln<false, false, true>(p, lds, blk, G, WSP(bf16_t, P_TMP + T_YG), lnidx);
    if constexpr (PH == K_CONV_L0) { int gwr = blk * NWAVE + (threadIdx.x >> 6); ph_conv_l0(p, lds, blk, G, gwr); }
    if constexpr (PH == K_XIN2BF) ph_xin_to_bf(p, lds, blk, G);
    if constexpr (PH == K_L0_G1) ph_l0_g1(p, lds, blk, G);
    if constexpr (PH == K_L0_MIXA) l0_mixA(lds, l0_bufs(p), blk, G);
    if constexpr (PH == K_L0_SCAN) ph_scan_conv(p, lds, blk, G);
    if constexpr (PH == K_L0_MIXC) l0_mixC(lds, l0_bufs(p), blk, G);
    if constexpr (PH == K_L0_G2) ph_gemm_plain(p, lds, blk, G, WSP(bf16_t, P_TMP + T_YM), WSP(bf16_t, P_WOUT_T), WSP(bf16_t, P_TMP + T_YB0));
    if constexpr (PH == K_LN_Y0) ph_ln<true, false, false>(p, lds, blk, G, WSP(bf16_t, P_TMP + T_YB0), 0);
    if constexpr (PH == K_CONV_L1) { int gwr = blk * NWAVE + (threadIdx.x >> 6); ph_conv_l1(p, lds, blk, G, gwr); }
    if constexpr (PH == K_L1_G1) ph_l1_g1(p, lds, blk, G);
    if constexpr (PH == K_L1_SWA) ph_l1_swa(p, lds, blk, G);
    if constexpr (PH == K_L1_G2) ph_gemm_plain(p, lds, blk, G, WSP(bf16_t, P_TMP + T_OB), WSP(bf16_t, P_WO_T), WSP(bf16_t, P_TMP + T_YB));
}

#define XB_TMO      128
#define XB_XCNT(j)  (256  + 64 * (j))
#define XB_XSUB(j)  (1280 + 64 * (j))
#define XB_XGEN(j)  (2304 + 64 * (j))
#define XB_TOP      3328
#define XB_TOPGEN   3392
#define XCD_BAR_WORDS 3456
#define XB_SPIN_CAP (1u << 22)
__device__ __forceinline__ unsigned xb_ld(unsigned* p)              { return __hip_atomic_load(p, __ATOMIC_RELAXED, __HIP_MEMORY_SCOPE_AGENT); }
__device__ __forceinline__ unsigned xb_add(unsigned* p, unsigned v) { return __hip_atomic_fetch_add(p, v, __ATOMIC_RELAXED, __HIP_MEMORY_SCOPE_AGENT); }
__device__ __forceinline__ unsigned xb_xcc_id() { return (unsigned)__builtin_amdgcn_s_getreg((3 << 11) | 20) & 0xFu; }
#define XB_SPIN(cond, bar) do { unsigned _sp = 0; while (cond) { __builtin_amdgcn_s_sleep(1); \
    if ((++_sp & 255u) == 0u) { if (xb_ld(&(bar)[XB_TMO])) break; if (_sp > XB_SPIN_CAP) { atomicAdd(&(bar)[XB_TMO], 1u); break; } } } } while (0)
struct XcdBarrier { unsigned* bar; unsigned x; volatile LAS unsigned* st; };
__device__ __forceinline__ XcdBarrier xcd_barrier_post(unsigned* bar, volatile LAS unsigned* st) {
    XcdBarrier b; b.bar = bar; b.x = xb_xcc_id(); b.st = st;
    if (threadIdx.x == 0) (void)xb_add(&bar[XB_XCNT(b.x)], 1u);
    return b;
}
__device__ __forceinline__ void xcd_barrier_complete(unsigned* bar, unsigned x, unsigned& nloc, unsigned& nx) {
    const unsigned G = gridDim.x * gridDim.y * gridDim.z;
    unsigned sum, cnt, mine, sp = 0u;
    for (;;) {
        sum = 0u; cnt = 0u; mine = 0u;
#pragma unroll
        for (unsigned j = 0; j < 16; ++j) { const unsigned c = xb_ld(&bar[XB_XCNT(j)]); sum += c; cnt += (c > 0u) ? 1u : 0u; mine = (j == x) ? c : mine; }
        if (sum == G) break;
        __builtin_amdgcn_s_sleep(1);
        if ((++sp & 255u) == 0u) { if (xb_ld(&bar[XB_TMO])) break; if (sp > XB_SPIN_CAP) { atomicAdd(&bar[XB_TMO], 1u); break; } }
    }
    nloc = mine > 0u ? mine : 1u; nx = cnt > 0u ? cnt : 1u;
}
__device__ __forceinline__ void xcd_barrier(const XcdBarrier& b) {
    asm volatile("s_waitcnt vmcnt(0)" ::: "memory");
    __syncthreads();
    if (threadIdx.x == 0) {
        unsigned* bar = b.bar; asm volatile("" : "+s"(bar));
        __builtin_amdgcn_s_waitcnt(0);
        unsigned nloc = b.st[0], nx = b.st[1];
        if (nloc == 0u) { xcd_barrier_complete(bar, b.x, nloc, nx); b.st[0] = nloc; b.st[1] = nx; }
        const unsigned old = xb_add(&bar[XB_XSUB(b.x)], 1u);
        const unsigned gen = old / nloc;
        if (old + 1u == (gen + 1u) * nloc) {
            __builtin_amdgcn_fence(__ATOMIC_RELEASE, "agent");
            asm volatile("s_waitcnt vmcnt(0)" ::: "memory");
            const unsigned og = xb_add(&bar[XB_TOP], 1u);
            const unsigned tg = og / nx;
            if (og + 1u == (tg + 1u) * nx) xb_add(&bar[XB_TOPGEN], 1u);
            else XB_SPIN(xb_ld(&bar[XB_TOPGEN]) == tg, bar);
            __builtin_amdgcn_fence(__ATOMIC_ACQUIRE, "agent");
            asm volatile("s_waitcnt vmcnt(0)" ::: "memory");
        } else {
            XB_SPIN(xb_ld(&bar[XB_TOPGEN]) == gen, bar);
            __builtin_amdgcn_fence(__ATOMIC_ACQUIRE, "agent");
            asm volatile("s_waitcnt vmcnt(0)" ::: "memory");
        }
    }
    __syncthreads();
}
constexpr size_t P_BAR = P_RT + 1572864;
constexpr int LDS_BARW = LDS_BYTES - 16;

struct SchedAll {
    const LAS pg8::JobDesc* jt; int n0, n1, n2, n3, n4; int K, G, c; int moe; const char* A; const char* B; const int* tstart; const int* src; int nN; size_t bexp;
    __device__ __forceinline__ pg8::Unit get(int i, bool& ok) const {
        const char* ua = nullptr; const char* ub = nullptr; const int* us = nullptr; int upm = 0, upn = 0, ujob = 0; bool good = false;
        if (moe) {
            const int vc = (c & 7) * (G >> 3) + (c >> 3);
            const long L = (long)i * G + vc; const int ntile = tstart[32];
            if (L < (long)ntile * nN) {
                const int mt = (int)(L / nN), nt = (int)(L % nN);
                int e = 0;
                for (int k = 1; k < 32; ++k) if (tstart[k] <= mt) e = k;
                ua = src ? A : A + (size_t)mt * 256 * K * 2; us = src ? src + mt * 256 : nullptr; ub = B + (size_t)e * bexp + (size_t)nt * 256 * K * 2; upm = mt; upn = nt; good = true;
            }
        } else {
            long L = (long)i * G + c;
            if (L < (long)n0 + n1 + n2 + n3 + n4) {
                int l = (int)L; int jb = 0;
                if (l >= n0) { l -= n0; jb = 1; if (l >= n1) { l -= n1; jb = 2; if (l >= n2) { l -= n2; jb = 3; if (l >= n3) { l -= n3; jb = 4; } } } }
                const int jM = __builtin_amdgcn_readfirstlane(jt[jb].nM), jN = __builtin_amdgcn_readfirstlane(jt[jb].nN);
                int pm, pn; pg8::tile_order(l, jM, jN, pm, pn);
                const size_t tstep = (size_t)pg8::BM * K * 2;
                ua = (const char*)pg8::rfl64(jt[jb].A) + (size_t)pm * tstep; ub = (const char*)pg8::rfl64(jt[jb].B) + (size_t)pn * tstep; upm = pm; upn = pn; ujob = jb; good = true;
            }
        }
        pg8::Unit u; u.A = ua; u.B = ub; u.src = us; u.pm = upm; u.pn = upn; u.job = ujob; ok = good; return u;
    }
};
enum { MP_CONV = 0, MP_L0_G1, MP_L0_MIXA, MP_L0_SCAN, MP_L0_MIXC, MP_L0_G2, MP_XA_G1, MP_XA_ATTN, MP_XA_G2, MP_ROUTE, MP_SCATTER, MP_MOE_G1, MP_MOE_G2, MP_LN_MOE, MP_L1_G1, MP_L1_SWA, MP_L1_G2 };
struct SchedLN {
    const char* A; const char* B; int G, c;
    __device__ __forceinline__ pg8::Unit get(int i, bool& ok) const {
        const int L = i * G + c; const bool good = L < 512; int pm = 0, pn = 0; if (good) pg8::tile_order(L, 128, 4, pm, pn);
        const size_t tstep = (size_t)pg8::BM * 1024 * 2;
        pg8::Unit u; u.A = A + (size_t)pm * tstep; u.B = B + (size_t)pn * tstep; u.src = nullptr; u.pm = pm; u.pn = pn; u.job = 0; ok = good; return u;
    }
};
__device__ __forceinline__ int prog_kind(int i) {
    switch (i) { case 0: return MP_CONV; case 1: return MP_L0_G1; case 2: return MP_L0_MIXA; case 3: return MP_L0_SCAN; case 4: return MP_L0_MIXC; case 5: return MP_L0_G2;
        case 6: case 17: return MP_XA_G1; case 7: case 18: return MP_XA_ATTN; case 8: case 19: return MP_XA_G2; case 9: case 20: return MP_ROUTE; case 10: case 21: return MP_SCATTER;
        case 11: case 22: return MP_MOE_G1; case 12: case 23: return MP_MOE_G2; case 13: case 24: return MP_LN_MOE; case 14: return MP_L1_G1; case 15: return MP_L1_SWA; default: return MP_L1_G2; }
}
constexpr int N_PROG = 25;
__global__ void __launch_bounds__(NTHR, 2) mega(FP p0) {
    extern __shared__ __attribute__((aligned(16))) unsigned char smem[];
    LAS unsigned char* lds = (LAS unsigned char*)smem;
    cooperative_groups::grid_group grid = cooperative_groups::this_grid();
    const int blk0 = blockIdx.x, G0 = gridDim.x;
    volatile LAS unsigned* bst = (volatile LAS unsigned*)(lds + LDS_BARW);
    if (threadIdx.x == 0) { bst[0] = 0u; bst[1] = 0u; }
    __syncthreads();
    const XcdBarrier xbar = xcd_barrier_post((unsigned*)(p0.ws + P_BAR), bst);
    int dup = 0; (void)dup;
#pragma unroll 1
    for (int pi = 0; pi < N_PROG; ++pi) {
        int blk = blk0, G = G0; asm volatile("" : "+s"(blk), "+s"(G));
        const PV p = make_pv(p0);
        const int kind = prog_kind(pi), l = pi >= 14 ? 1 : 0;
        const bool is_gemm = kind == MP_L0_G1 || kind == MP_XA_G1 || kind == MP_MOE_G1 || kind == MP_MOE_G2 || kind == MP_L1_G1;
        const bool is_lnf = kind == MP_L0_G2 || kind == MP_XA_G2 || kind == MP_L1_G2;
        if (is_lnf) {
            const int site = kind == MP_L0_G2 ? 0 : (kind == MP_L1_G2 ? 2 : 1 + 2 * l), lnidx = kind == MP_L0_G2 ? 0 : (kind == MP_L1_G2 ? 3 : 1 + 3 * l);
            SchedLN S; S.G = G; S.c = blk;
            S.A = (const char*)(kind == MP_L0_G2 ? WSP(bf16_t, P_TMP + T_YM) : WSP(bf16_t, P_TMP + T_OB));
            S.B = (const char*)(kind == MP_L0_G2 ? WSP(bf16_t, P_WOUT_T) : (kind == MP_L1_G2 ? WSP(bf16_t, P_WO_T) : WSP(bf16_t, P_XWO_T) + (size_t)l * 1024 * 1024));
            __syncthreads();
            #ifdef PROBE_LNV
            const int drym = __builtin_amdgcn_readfirstlane((dup == 0 && (((PROBE_MASK) >> kind) & 1)) ? 1 : 0);
#else
            const int drym = 0;
#endif
            unsigned long long* slp = WSP(unsigned long long, P_TMP + T_SLOT) + (size_t)(site + 4 * drym) * 131072;
            if (threadIdx.x == 0) set_job(JT_PTR, 0, nullptr, nullptr, 128, 4, WSP(bf16_t, P_XBF), 1024, 0, p.in[2] + lnidx * 1024, p.in[3] + lnidx * 1024, nullptr);
            if (threadIdx.x == 0) { JT_PTR->mode = drym; JT_PTR->out2 = (unsigned long long)slp; }
            EpiLN E; E.lds = lds;
            __syncthreads();
            pg8::gemm_phase<EpiLN, SchedLN, true, true>(lds, 1024, S, E);
        } else if (is_gemm) {
            SchedAll S; S.jt = JT_PTR; S.n0 = S.n1 = S.n2 = S.n3 = S.n4 = 0; S.K = 1024; S.G = G; S.c = blk; S.moe = 0; S.A = S.B = nullptr; S.tstart = WSP(int, P_RT + RT_TSTART); S.src = nullptr; S.nN = 4; S.bexp = 0;
            __syncthreads();
            if (threadIdx.x == 0) {
                if (kind == MP_L0_G1) set_job(JT_PTR, 0, WSP(bf16_t, P_XBF), WSP(bf16_t, P_WIN_T), 128, 8, WSP(bf16_t, P_TMP + T_AU), 512, EM_GELU4);
                if (kind == MP_XA_G1) {
                    set_job(JT_PTR, 0, WSP(bf16_t, P_XBF), WSP(bf16_t, P_XWQ_T) + (size_t)l * 1024 * 1024, 128, 4, WSP(bf16_t, P_TMP + T_QX), 1024, EM_PLAIN);
                    if (l == 0) { for (int ll = 0; ll < 2; ++ll) { const bf16_t* wkv = WSP(bf16_t, P_XWKV_T) + (size_t)ll * 2048 * 1024;
                        set_job(JT_PTR, 1 + 2 * ll, WSP(bf16_t, P_MEMB), wkv, 8, 4, WSP(bf16_t, P_KC) + (size_t)ll * 2048 * 1024, 1024, EM_PLAIN);
                        set_job(JT_PTR, 2 + 2 * ll, wkv + (size_t)1024 * 1024, WSP(bf16_t, P_MEMB), 4, 8, WSP(bf16_t, P_VT) + (size_t)ll * 1024 * 2048, 2048, EM_PLAIN); } } }
                if (kind == MP_MOE_G1) set_job(JT_PTR, 0, nullptr, nullptr, 0, 0, WSP(bf16_t, P_TMP + T_HM), 512, EM_SWIGLU);
                if (kind == MP_MOE_G2) set_job(JT_PTR, 0, nullptr, nullptr, 0, 0, WSP(bf16_t, P_TMP + T_YG), 1024, EM_PLAIN);
                if (kind == MP_L1_G1) { set_job(JT_PTR, 0, WSP(bf16_t, P_XBF), WSP(bf16_t, P_WQKV_T), 128, 5, WSP(bf16_t, P_TMP + T_QX), 1024, EM_ROTARY, WSP(float, P_BQK), WSP(float, P_ROT), WSP(bf16_t, P_TMP + T_K1));
                    set_job(JT_PTR, 1, WSP(bf16_t, P_WQKV_T) + (size_t)1280 * 1024, WSP(bf16_t, P_XBF), 1, 128, WSP(bf16_t, P_TMP + T_VT1), NT, EM_ROWBIAS, p.in[20] + 1280); }
#ifdef PROBE_L1PLAIN
                if (kind == MP_L1_G1 && dup == 0) JT_PTR[0].mode = EM_PLAIN;
#endif
            }
            if (kind == MP_L0_G1) S.n0 = 1024;
            if (kind == MP_XA_G1) { S.n0 = 512; if (l == 0) { S.n1 = 32; S.n2 = 32; S.n3 = 32; S.n4 = 32; } }
            if (kind == MP_L1_G1) { S.n0 = 640; S.n1 = 128; }
            if (kind == MP_MOE_G1) { S.moe = 1; S.A = (const char*)WSP(bf16_t, P_XBF); S.src = WSP(int, P_RT + RT_SRC); S.B = (const char*)WSP(bf16_t, P_W13T); S.bexp = (size_t)1024 * 1024 * 2; }
            if (kind == MP_MOE_G2) { S.moe = 1; S.K = 512; S.A = (const char*)WSP(bf16_t, P_TMP + T_HM); S.B = (const char*)WSP(bf16_t, P_W2T); S.bexp = (size_t)1024 * 512 * 2; }
            __syncthreads();
            EpiMulti E; E.jt = JT_PTR;
#ifdef PROBE_GEMM2
#pragma unroll 1
            for (int rep = 0; rep < 2; ++rep)
#endif
            pg8::gemm_phase<EpiMulti, SchedAll, true, true>(lds, S.K, S, E);
        } else {
#ifdef PROBE_MASK
#define DRY (dup == 0 && (((PROBE_MASK) >> kind) & 1))
#else
#define DRY false
#endif
            switch (kind) {
                case MP_CONV: { int gwr = blk * NWAVE + __builtin_amdgcn_readfirstlane((int)threadIdx.x >> 6);
                    ph_conv_l0(p, lds, blk, G, gwr); ph_conv_l1(p, lds, blk, G, gwr); ph_conv_xattn(p, lds, blk, G, 0, gwr); ph_conv_xattn(p, lds, blk, G, 1, gwr); ph_conv_moe(p, lds, blk, G, 0, gwr); ph_xin_to_bf(p, lds, blk, G); } break;
                case MP_L0_MIXA: { L0Bufs Bx = l0_bufs(p); if (DRY) { Bx.Q = Bx.K = WSP(bf16_t, P_TMP + 288 * MB); } l0_mixA(lds, Bx, blk, G); } break;
                case MP_L0_SCAN: ph_scan_conv(p, lds, blk, G); break;
                case MP_L0_MIXC: l0_mixC(lds, l0_bufs(p), blk, G); break;
                case MP_XA_ATTN: ph_xattn_attn(p, lds, blk, G, l); break;
                case MP_ROUTE: ph_moe_route(p, lds, blk, G, l); break;
                case MP_SCATTER: ph_moe_scatter(p, lds, blk, G); break;
                case MP_LN_MOE: if (l == 0) { ph_ln<false, false, true>(p, lds, blk, G, WSP(bf16_t, P_TMP + T_YG), 2, DRY); if (!(DRY)) { int gwr = blk * NWAVE + __builtin_amdgcn_readfirstlane((int)threadIdx.x >> 6); ph_conv_moe(p, lds, blk, G, 1, gwr); } } else ph_ln<false, true, true>(p, lds, blk, G, WSP(bf16_t, P_TMP + T_YG), 5, DRY); break;
                default: ph_l1_swa(p, lds, blk, G); break;
            }
        }
#ifdef PROBE_MASK
        if (((PROBE_MASK) >> kind) & 1) { if (dup == 0) { dup = 1; xcd_barrier(xbar); --pi; continue; } dup = 0; }
#endif
        if (pi + 1 < N_PROG) { if (p0.ws == nullptr) grid.sync(); else { xcd_barrier(xbar);
#ifdef PROBE_BAR2
            xcd_barrier(xbar);
#endif
        } }
    }
}
}
extern "C" void kernel_launch(void* const* d_in, const int* in_sizes, int n_in, void* d_out, int out_size, void* d_ws, size_t ws_size, hipStream_t stream) {
    static int ok = 0;
    if (ok == 0) {
        ok = -1;
        if (n_in != 33 || out_size != 32768 * 1024 || ws_size < fk::FAST_END + (fk::SLOT_MB - 4) * fk::MB) { fprintf(stderr, "kernel_launch: unexpected shapes/ws (%d, %d, %zu)\n", n_in, out_size, ws_size); return; }
        int dev = 0, cus = 0, per_cu = 0;
        if (hipGetDevice(&dev) != hipSuccess || hipDeviceGetAttribute(&cus, hipDeviceAttributeMultiprocessorCount, dev) != hipSuccess) return;
        if (hipFuncSetAttribute((const void*)fk::mega, hipFuncAttributeMaxDynamicSharedMemorySize, fk::LDS_BYTES) != hipSuccess) return;
        if (hipOccupancyMaxActiveBlocksPerMultiprocessor(&per_cu, (const void*)fk::mega, fk::NTHR, fk::LDS_BYTES) != hipSuccess || per_cu < 1 || cus * per_cu < 256) { fprintf(stderr, "kernel_launch: cannot co-reside 256 workgroups (%d CUs x %d)\n", cus, per_cu); return; }
        ok = 1;
    }
    if (ok < 0) return;
    fk::FP p{}; for (int i = 0; i < 33; ++i) p.in[i] = (const float*)d_in[i]; p.X = (float*)d_out; p.ws = (unsigned char*)d_ws;
    if (hipMemsetAsync((char*)d_ws + fk::P_BAR, 0, 16384, stream) != hipSuccess) return;
    if (hipMemsetAsync((char*)d_ws + fk::P_TMP + fk::T_SLOT, 0xFF, fk::SLOT_MB * fk::MB, stream) != hipSuccess) return;
    void* args[] = {&p};
    hipError_t e = hipLaunchCooperativeKernel((const void*)fk::mega, dim3(256), dim3(fk::NTHR), args, fk::LDS_BYTES, stream);
    if (e != hipSuccess) fprintf(stderr, "cooperative launch failed: %s\n", hipGetErrorString(e));
}
```

```cpp
#include <hip/hip_runtime.h>
#include <hip/hip_cooperative_groups.h>
#include <cstdio>
#include <cstdint>
#include <cmath>
namespace fk {
#define LAS __attribute__((address_space(3)))
typedef unsigned short bf16_t;
typedef short bf16x8 __attribute__((ext_vector_type(8)));
typedef short s16x4 __attribute__((ext_vector_type(4)));
typedef float f32x4 __attribute__((ext_vector_type(4)));
typedef float f32x16 __attribute__((ext_vector_type(16)));
typedef float f32x2 __attribute__((ext_vector_type(2)));
typedef unsigned u32x4 __attribute__((ext_vector_type(4)));
typedef unsigned u32x2 __attribute__((ext_vector_type(2)));
typedef __bf16 bf16x2_t __attribute__((ext_vector_type(2)));

constexpr int NT = 32768, DM = 1024, SEQ = 4096;
constexpr int NTHR = 512, NWAVE = 8;
constexpr float ALPHA = 1.4142135623730951f, LN_EPS = 1e-5f, LOG2E = 1.4426950408889634f;

__device__ __forceinline__ unsigned pk2(float lo, float hi) { f32x2 v = {lo, hi}; bf16x2_t b = __builtin_convertvector(v, bf16x2_t); return __builtin_bit_cast(unsigned, b); }
__device__ __forceinline__ float bf_lo(unsigned w) { return __uint_as_float(w << 16); }
__device__ __forceinline__ float bf_hi(unsigned w) { return __uint_as_float(w & 0xffff0000u); }
__device__ __forceinline__ float bf2f(bf16_t b) { return __uint_as_float(((unsigned)b) << 16); }
__device__ __forceinline__ bf16_t f2bf(float f) { return (bf16_t)(pk2(f, 0.f) & 0xffffu); }
__device__ __forceinline__ float fast_exp(float x) { return __builtin_amdgcn_exp2f(x * LOG2E); }
__device__ __forceinline__ float sigmoid_f(float x) { return __builtin_amdgcn_rcpf(1.f + fast_exp(-x)); }
__device__ __forceinline__ float silu_f(float x) { return x * sigmoid_f(x); }
__device__ __forceinline__ float gelu_tanh_f(float x) { const float u = 1.5957691216057308f * (x + 0.044715f * x * x * x); return x * sigmoid_f(u); }
__device__ __forceinline__ int crow(int r, int hi) { return (r & 3) + 8 * (r >> 2) + 4 * hi; }
__device__ __forceinline__ float xhalf_sum(float v) { auto rr = __builtin_amdgcn_permlane32_swap(__float_as_uint(v), __float_as_uint(v), false, false); return __uint_as_float(rr[0]) + __uint_as_float(rr[1]); }
__device__ __forceinline__ float xhalf_max(float v) { auto rr = __builtin_amdgcn_permlane32_swap(__float_as_uint(v), __float_as_uint(v), false, false); return fmaxf(__uint_as_float(rr[0]), __uint_as_float(rr[1])); }
__device__ __forceinline__ float shx(float v, int o, int lane) { return __int_as_float(__builtin_amdgcn_ds_bpermute((lane ^ o) << 2, __float_as_int(v))); }
__device__ __forceinline__ float shup(float v, int o, int lane) { return __int_as_float(__builtin_amdgcn_ds_bpermute(((lane - o) & 63) << 2, __float_as_int(v))); }
__device__ __forceinline__ float shidx(float v, int idx) { return __int_as_float(__builtin_amdgcn_ds_bpermute(idx << 2, __float_as_int(v))); }
__device__ __forceinline__ s16x4 lds_tr(const LAS void* p) { return __builtin_bit_cast(s16x4, __builtin_amdgcn_ds_read_tr16_b64_v4i16((LAS s16x4*)p)); }
#define MFMA32(a, b, c) __builtin_amdgcn_mfma_f32_32x32x16_bf16((a), (b), (c), 0, 0, 0)

namespace pg8 {
constexpr int BM = 256, BK = 64, HALF = 128, HTB = HALF * BK * 2, STAGE_BYTES = 8 * HTB, NXCD = 8, WGM = 8;
__host__ __device__ __forceinline__ int lds_byte(int r, int c) { const int st = (r >> 4) * 2 + (c >> 5), rr = r & 15, cc = c & 31, ob = rr * 64 + cc * 2; return st * 1024 + (ob ^ (((ob >> 9) & 1) << 5)); }
__host__ __device__ __forceinline__ void stage_rc(int b, int& R, int& C) { const int st = b / 1024, sb = b % 1024, swz = sb ^ (((sb >> 9) & 1) << 5); R = (st >> 1) * 16 + swz / 64; C = (st & 1) * 32 + (swz % 64) / 2; }
__host__ __device__ __forceinline__ int perm32(int rho) { const int n = rho >> 4, i = rho & 15; return 8 * (i >> 2) + 4 * n + (i & 3); }

struct Unit { const char* A; const char* B; const int* src; int pm, pn, job; };

__device__ __forceinline__ void tile_order(int l, int nM, int nN, int& pm, int& pn) {
    const int nwg = nM * nN; int wgid = l;
    { const int q = nwg / NXCD, r = nwg % NXCD, xcd = wgid % NXCD, off = wgid / NXCD; wgid = (xcd < r ? xcd * (q + 1) : r * (q + 1) + (xcd - r) * q) + off; }
    const int nig = WGM * nN, gid = wgid / nig, fm = gid * WGM, gsz = (nM - fm) < WGM ? (nM - fm) : WGM;
    pm = fm + ((wgid % nig) % gsz); pn = (wgid % nig) / gsz;
}
struct JobDesc { unsigned long long A, B, out, bias, rot, out2; int nM, nN, ldc, mode; };
__device__ __forceinline__ unsigned long long rfl64(unsigned long long v) { const unsigned lo = __builtin_amdgcn_readfirstlane((unsigned)v), hi = __builtin_amdgcn_readfirstlane((unsigned)(v >> 32)); return ((unsigned long long)hi << 32) | lo; }
constexpr int JT_OFF = STAGE_BYTES;
struct Jobs3 {
    const LAS JobDesc* jt; int n0, n1, n2; int K, G, c;
    __device__ __forceinline__ Unit get(int i, bool& ok) const { Unit u; u.A = nullptr; u.B = nullptr; u.src = nullptr; u.pm = 0; u.pn = 0; u.job = 0; ok = next(i, u); return u; }
    __device__ __forceinline__ bool next(int i, Unit& u) const {
        long L = (long)i * G + c;
        if (L >= (long)n0 + n1 + n2) return false;
        int l = (int)L; int jb = 0;
        if (l >= n0) { l -= n0; jb = 1; if (l >= n1) { l -= n1; jb = 2; } }
        const int jM = __builtin_amdgcn_readfirstlane(jt[jb].nM), jN = __builtin_amdgcn_readfirstlane(jt[jb].nN);
        int pm, pn; tile_order(l, jM, jN, pm, pn);
        const size_t tstep = (size_t)BM * K * 2;
        u.A = (const char*)rfl64(jt[jb].A) + (size_t)pm * tstep; u.B = (const char*)rfl64(jt[jb].B) + (size_t)pn * tstep; u.src = nullptr; u.pm = pm; u.pn = pn; u.job = jb; return true;
    }
};

template <class Epi, class Sched, bool ALIGN_EPI, bool SP2>
__device__ __forceinline__ void gemm_phase(LAS unsigned char* lds, const int K, const Sched& S, const Epi& E) {
    int tid_ = threadIdx.x; asm volatile("" : "+v"(tid_)); const int tid = tid_, wid = __builtin_amdgcn_readfirstlane(tid >> 6), lane = tid & 63, wr = wid >> 2, wc = wid & 3, fr = lane & 15, fq = lane >> 4;
    const int nt = K / BK;
    static_assert(SP2, "only the two-super-phase form is kept");
    unsigned vA0[2], vA1[2], vB0[2];
#pragma unroll
    for (int i = 0; i < 2; ++i) { int R, C; stage_rc(tid * 16 + i * 8192, R, C); const int Rb = 64 * (R >> 5) + perm32(R & 31); vB0[i] = (unsigned)(Rb * K + C) * 2u; }
    const size_t bhalf = (size_t)32 * K * 2;
    auto a_rows = [&](const int* src, unsigned (&o0)[2], unsigned (&o1)[2]) {
        int tq = threadIdx.x; asm volatile("" : "+v"(tq));
#pragma unroll
        for (int i = 0; i < 2; ++i) { int R, C; stage_rc(tq * 16 + i * 8192, R, C); int r0 = R, r1 = R + HALF; if (src) { r0 = src[R]; r1 = src[R + HALF]; }
            o0[i] = (unsigned)(r0 * K + C) * 2u; o1[i] = (unsigned)(r1 * K + C) * 2u; }
    };
    const size_t kstep = (size_t)(BK * 2);
    const size_t hstep = (size_t)HALF * K * 2;
    const unsigned ldsw = (unsigned)wid * 1024u;
    const int aoff = lds_byte(wr * 64 + fr, fq * 8), boff = lds_byte(wc * 32 + fr, fq * 8);
#define PG8_SA(b, h) (((b) * 2 + (h)) * HTB)
#define PG8_SB(b, h) ((4 + (b) * 2 + (h)) * HTB)
#define PG8_STAGE(bufoff, gbase, voff) do { _Pragma("unroll") for (int _i = 0; _i < 2; ++_i) \
        __builtin_amdgcn_global_load_lds((const unsigned*)((const char*)(gbase) + (voff)[_i]), (LAS unsigned*)(lds + (bufoff) + ldsw + _i * 8192), 16, 0, 0); } while (0)
#define PG8_LDA(dst, b, h) do { _Pragma("unroll") for (int m = 0; m < 4; ++m) _Pragma("unroll") for (int k = 0; k < 2; ++k) dst[m][k] = *(const LAS bf16x8*)(lds + PG8_SA(b, h) + aoff + m * 2048 + k * 1024); } while (0)
#define PG8_LDB(dst, b, h) do { _Pragma("unroll") for (int n = 0; n < 2; ++n) _Pragma("unroll") for (int k = 0; k < 2; ++k) dst[n][k] = *(const LAS bf16x8*)(lds + PG8_SB(b, h) + boff + n * 2048 + k * 1024); } while (0)
#define PG8_MMA(ai, bj, At, Bt) do { __builtin_amdgcn_s_setprio(1); _Pragma("unroll") for (int m = 0; m < 4; ++m) _Pragma("unroll") for (int n = 0; n < 2; ++n) _Pragma("unroll") for (int k = 0; k < 2; ++k) \
        acc[ai][bj][m][n] = __builtin_amdgcn_mfma_f32_16x16x32_bf16(Bt[n][k], At[m][k], acc[ai][bj][m][n], 0, 0, 0); __builtin_amdgcn_s_setprio(0); } while (0)
#define PG8_WAIT_V(n) asm volatile("s_waitcnt vmcnt(" #n ")" ::: "memory")
#define PG8_WAIT_L(n) asm volatile("s_waitcnt lgkmcnt(" #n ")" ::: "memory")
#define PG8_BAR __builtin_amdgcn_s_barrier()
#define PG8_SCHED __builtin_amdgcn_sched_barrier(0)
    auto unif = [](Unit u) { Unit r; r.A = (const char*)rfl64((unsigned long long)u.A); r.B = (const char*)rfl64((unsigned long long)u.B); r.src = (const int*)rfl64((unsigned long long)u.src);
        r.pm = __builtin_amdgcn_readfirstlane(u.pm); r.pn = __builtin_amdgcn_readfirstlane(u.pn); r.job = __builtin_amdgcn_readfirstlane(u.job); return r; };
    int ui = 0; bool ok0; Unit cur = unif(S.get(0, ok0));
    if (!ok0) return;
    f32x4 acc[2][2][4][2];
    E.prefetch(cur, wr, wc, fr, fq);
    bf16x8 At[4][2], B0[2][2], B1[2][2];
    const char* cA = cur.A; const char* cB = cur.B;
    a_rows(cur.src, vA0, vA1);
    {
        PG8_STAGE(PG8_SB(0, 0), cB, vB0); PG8_STAGE(PG8_SB(0, 1), cB + bhalf, vB0); PG8_STAGE(PG8_SA(0, 0), cA, vA0); PG8_STAGE(PG8_SA(0, 1), cA, vA1);
        if (wr == 1) PG8_BAR;
        PG8_WAIT_V(2); PG8_BAR;
        PG8_STAGE(PG8_SB(1, 0), cB + kstep, vB0); PG8_STAGE(PG8_SA(1, 0), cA + kstep, vA0); PG8_STAGE(PG8_SB(1, 1), cB + kstep + bhalf, vB0);
        PG8_WAIT_V(6); PG8_BAR;
    }
    for (;;) {
        E.init(acc);
        bool has_next; const Unit nxt = unif(S.get(ui + 1, has_next)); bool early_done = false;
        const char* nA = has_next ? nxt.A : cA; const char* nB = has_next ? nxt.B : cB;
        for (int t = 0; t < nt; t += 2) {
            const bool last = (t == nt - 2);
            const char* a1 = cA + (size_t)(t + 1) * kstep;
            const char* a2 = last ? nA : cA + (size_t)(t + 2) * kstep; const char* b2 = last ? nB : cB + (size_t)(t + 2) * kstep;
            const char* a3 = a2 + kstep; const char* b3 = b2 + kstep;
            PG8_LDB(B0, 0, 0); PG8_LDB(B1, 0, 1); PG8_SCHED; PG8_LDA(At, 0, 0); PG8_STAGE(PG8_SA(1, 1), a1, vA1);
            if (last && has_next) a_rows(nxt.src, vA0, vA1);
            PG8_WAIT_V(8); PG8_WAIT_L(0); PG8_BAR; PG8_MMA(0, 0, At, B0); PG8_MMA(0, 1, At, B1); PG8_BAR; PG8_SCHED;
            PG8_LDA(At, 0, 1); PG8_STAGE(PG8_SB(0, 0), b2, vB0); PG8_STAGE(PG8_SB(0, 1), b2 + bhalf, vB0); PG8_STAGE(PG8_SA(0, 0), a2, vA0);
            PG8_WAIT_V(8); PG8_WAIT_L(0); PG8_BAR; PG8_MMA(1, 0, At, B0); PG8_MMA(1, 1, At, B1); PG8_BAR; PG8_SCHED;
            PG8_LDB(B0, 1, 0); PG8_LDB(B1, 1, 1); PG8_SCHED; PG8_LDA(At, 1, 0); PG8_STAGE(PG8_SA(0, 1), a2, vA1);
            PG8_WAIT_V(8); PG8_WAIT_L(0); PG8_BAR; PG8_MMA(0, 0, At, B0); PG8_MMA(0, 1, At, B1); PG8_BAR; PG8_SCHED;
            if (last) { early_done = E.early(acc, cur, wr, wc, fr, fq); PG8_SCHED; }
            PG8_LDA(At, 1, 1); PG8_STAGE(PG8_SB(1, 0), b3, vB0); PG8_STAGE(PG8_SB(1, 1), b3 + bhalf, vB0); PG8_STAGE(PG8_SA(1, 0), a3, vA0);
            PG8_WAIT_V(8); PG8_WAIT_L(0); PG8_BAR; PG8_MMA(1, 0, At, B0); PG8_MMA(1, 1, At, B1); PG8_BAR; PG8_SCHED;
        }
        if constexpr (ALIGN_EPI) { if (wr == 0) PG8_BAR; }
        E.prefetch(nxt, wr, wc, fr, fq);
        if (!early_done) E.template half<0>(acc, cur, wr, wc, fr, fq);
        E.template half<1>(acc, cur, wr, wc, fr, fq);
        if (!has_next) break;
        cur = nxt; cA = nA; cB = nB; ++ui;
        if constexpr (ALIGN_EPI) { if (wr == 1) PG8_BAR; }
    }
    PG8_WAIT_V(0);
    if constexpr (!ALIGN_EPI) { if (wr == 0) PG8_BAR; }
    PG8_BAR;
#undef PG8_SA
#undef PG8_SB
#undef PG8_STAGE
#undef PG8_LDA
#undef PG8_LDB
#undef PG8_MMA
#undef PG8_WAIT_V
#undef PG8_WAIT_L
#undef PG8_BAR
#undef PG8_SCHED
}
}
enum { EM_PLAIN = 0, EM_GELU4 = 1, EM_SWIGLU = 2, EM_ROTARY = 3, EM_ROWBIAS = 4 };
struct EpiMulti {
    static constexpr bool PERM = true;
    const LAS pg8::JobDesc* jt;
    __device__ __forceinline__ void prefetch(const pg8::Unit&, int, int, int, int) const {}
    __device__ __forceinline__ void init(f32x4 (&acc)[2][2][4][2]) const {
#pragma unroll
        for (int a = 0; a < 2; ++a)
#pragma unroll
            for (int b = 0; b < 2; ++b)
#pragma unroll
                for (int m = 0; m < 4; ++m)
#pragma unroll
                    for (int n = 0; n < 2; ++n) acc[a][b][m][n] = (f32x4){0.f, 0.f, 0.f, 0.f};
    }
    __device__ __forceinline__ bool early(const f32x4 (&acc)[2][2][4][2], const pg8::Unit& u, int wr, int wc, int fr, int fq) const {
        const LAS pg8::JobDesc* jd = jt + u.job;
        if (__builtin_amdgcn_readfirstlane(jd->mode) != EM_PLAIN) return false;
        bf16_t* out = (bf16_t*)pg8::rfl64(jd->out); const int ldc = __builtin_amdgcn_readfirstlane(jd->ldc);
        bf16_t* rowp = out + (size_t)(u.pm * 256 + wr * 64 + fr) * ldc + u.pn * 256 + wc * 64 + 8 * fq;
#pragma unroll
        for (int m = 0; m < 4; ++m)
#pragma unroll
            for (int bj = 0; bj < 2; ++bj) { const f32x4 v0 = acc[0][bj][m][0], v1 = acc[0][bj][m][1];
                u32x4 w; w.x = pk2(v0[0], v0[1]); w.y = pk2(v0[2], v0[3]); w.z = pk2(v1[0], v1[1]); w.w = pk2(v1[2], v1[3]);
                *(u32x4*)(rowp + (size_t)m * 16 * ldc + bj * 32) = w; }
        return true;
    }
    template <int AI>
    __device__ __forceinline__ void half(const f32x4 (&acc)[2][2][4][2], const pg8::Unit& u, int wr, int wc, int fr, int fq) const {
        const LAS pg8::JobDesc* jd = jt + u.job;
        bf16_t* out = (bf16_t*)pg8::rfl64(jd->out);
        const int ldc = __builtin_amdgcn_readfirstlane(jd->ldc);
        const int mode = __builtin_amdgcn_readfirstlane(jd->mode);
        const float* bias = (const float*)pg8::rfl64(jd->bias);
        const int row0 = u.pm * 256 + wr * 64 + fr;
        const int colt = u.pn * 256 + wc * 64 + 8 * fq;
        if (mode == EM_PLAIN || mode == EM_ROWBIAS) {
#pragma unroll
            for (int ai = AI; ai < AI + 1; ++ai)
#pragma unroll
                for (int m = 0; m < 4; ++m) { const int row = row0 + ai * 128 + m * 16; const float rb = (mode == EM_ROWBIAS && bias) ? bias[row] : 0.f;
                    bf16_t* rowp = out + (size_t)row * ldc + colt;
#pragma unroll
                    for (int bj = 0; bj < 2; ++bj) { const f32x4 v0 = acc[ai][bj][m][0] + rb, v1 = acc[ai][bj][m][1] + rb;
                        u32x4 w; w.x = pk2(v0[0], v0[1]); w.y = pk2(v0[2], v0[3]); w.z = pk2(v1[0], v1[1]); w.w = pk2(v1[2], v1[3]);
                        *(u32x4*)(rowp + bj * 32) = w; } }
        } else if (mode == EM_GELU4) {
            const int arr = u.pn >> 1; bf16_t* base = out + (size_t)arr * NT * 512; const int col = colt - arr * 512; const bool act = arr < 2;
#pragma unroll
            for (int ai = AI; ai < AI + 1; ++ai)
#pragma unroll
                for (int m = 0; m < 4; ++m) { bf16_t* rowp = base + (size_t)(row0 + ai * 128 + m * 16) * 512 + col;
#pragma unroll
                    for (int bj = 0; bj < 2; ++bj) { f32x4 v0 = acc[ai][bj][m][0], v1 = acc[ai][bj][m][1];
                        if (act) {
#pragma unroll
                            for (int e = 0; e < 4; ++e) { v0[e] = gelu_tanh_f(v0[e]); v1[e] = gelu_tanh_f(v1[e]); } }
                        u32x4 w; w.x = pk2(v0[0], v0[1]); w.y = pk2(v0[2], v0[3]); w.z = pk2(v1[0], v1[1]); w.w = pk2(v1[2], v1[3]);
                        *(u32x4*)(rowp + bj * 32) = w; } }
        } else if (mode == EM_SWIGLU) {
#pragma unroll
            for (int ai = AI; ai < AI + 1; ++ai)
#pragma unroll
                for (int m = 0; m < 4; ++m) { bf16_t* rowp = out + (size_t)(row0 + ai * 128 + m * 16) * ldc + (colt >> 1);
#pragma unroll
                    for (int bj = 0; bj < 2; ++bj) { const f32x4 v0 = acc[ai][bj][m][0], v1 = acc[ai][bj][m][1];
                        u32x2 w; w.x = pk2(silu_f(v0[0]) * v0[1], silu_f(v0[2]) * v0[3]); w.y = pk2(silu_f(v1[0]) * v1[1], silu_f(v1[2]) * v1[3]);
                        *(u32x2*)(rowp + bj * 16) = w; } }
        } else {
            const float* rot = (const float*)pg8::rfl64(jd->rot);
            bf16_t* out2 = (bf16_t*)pg8::rfl64(jd->out2);
            const bool isk = u.pn >= 4; bf16_t* base = isk ? out2 : out; const int ld = isk ? 256 : 1024; const int colo = isk ? colt - 1024 : colt;
            float bv[2][8];
#pragma unroll
            for (int bj = 0; bj < 2; ++bj) { f32x4 b0 = (f32x4){0.f, 0.f, 0.f, 0.f}, b1 = b0; if (bias) { b0 = *(const f32x4*)(bias + colt + bj * 32); b1 = *(const f32x4*)(bias + colt + bj * 32 + 4); }
#pragma unroll
                for (int e = 0; e < 4; ++e) { bv[bj][e] = b0[e]; bv[bj][4 + e] = b1[e]; } }
            const int i0 = (colt & 63) >> 1;
#pragma unroll
            for (int ai = AI; ai < AI + 1; ++ai)
#pragma unroll
                for (int m = 0; m < 4; ++m) { const int row = row0 + ai * 128 + m * 16; const int pos = row & (SEQ - 1);
                    bf16_t* rowp = base + (size_t)row * ld + colo;
#pragma unroll
                    for (int bj = 0; bj < 2; ++bj) { f32x4 v0 = acc[ai][bj][m][0], v1 = acc[ai][bj][m][1];
                        const f32x4 cs0 = *(const f32x4*)(rot + ((size_t)pos * 32 + i0 + 16 * bj) * 2), cs1 = *(const f32x4*)(rot + ((size_t)pos * 32 + i0 + 16 * bj + 2) * 2);
#pragma unroll
                        for (int e = 0; e < 4; ++e) { v0[e] += bv[bj][e]; v1[e] += bv[bj][4 + e]; }
                        const float a0 = v0[0] * cs0[0] - v0[1] * cs0[1], b0 = v0[1] * cs0[0] + v0[0] * cs0[1];
                        const float a1 = v0[2] * cs0[2] - v0[3] * cs0[3], b1 = v0[3] * cs0[2] + v0[2] * cs0[3];
                        const float a2 = v1[0] * cs1[0] - v1[1] * cs1[1], b2 = v1[1] * cs1[0] + v1[0] * cs1[1];
                        const float a3 = v1[2] * cs1[2] - v1[3] * cs1[3], b3 = v1[3] * cs1[2] + v1[2] * cs1[3];
                        u32x4 w; w.x = pk2(a0, b0); w.y = pk2(a1, b1); w.z = pk2(a2, b2); w.w = pk2(a3, b3);
                        *(u32x4*)(rowp + bj * 32) = w; } }
        }
    }
};

#define GAS __attribute__((address_space(1)))
#define P_TMP_PROBE (194ull * 1048576ull)
constexpr int LNF_PART = pg8::JT_OFF + 1024;
constexpr int LNF_STAT = LNF_PART + 8192;
struct EpiLN {
    static constexpr bool PERM = true;
    LAS unsigned char* lds;
    mutable u32x4 pre[2][4][2];
    __device__ __forceinline__ void prefetch(const pg8::Unit& u, int, int, int, int) const {
        int tq = threadIdx.x; asm volatile("" : "+v"(tq)); const int wq = __builtin_amdgcn_readfirstlane(tq >> 6), wr = wq >> 2, wc = wq & 3, fr = tq & 15, fq = (tq & 63) >> 4;
        const unsigned long long xio = pg8::rfl64(((const LAS pg8::JobDesc*)(lds + pg8::JT_OFF))->out);
        const GAS unsigned char* tb = (const GAS unsigned char*)(xio + ((size_t)u.pm * 256 * 1024 + u.pn * 256) * 2);
        const unsigned loff = (unsigned)((wr * 64 + fr) * 1024 + wc * 64 + 8 * fq) * 2u;
#pragma unroll
        for (int ai = 0; ai < 2; ++ai)
#pragma unroll
            for (int m = 0; m < 4; ++m)
#pragma unroll
                for (int bj = 0; bj < 2; ++bj) pre[ai][m][bj] = *(const GAS u32x4*)(tb + (ai * 128 + m * 16) * 2048 + bj * 64 + loff);
    }
    __device__ __forceinline__ void init(f32x4 (&acc)[2][2][4][2]) const {
#pragma unroll
        for (int ai = 0; ai < 2; ++ai)
#pragma unroll
            for (int m = 0; m < 4; ++m)
#pragma unroll
                for (int bj = 0; bj < 2; ++bj) { const u32x4 w = pre[ai][m][bj];
                    acc[ai][bj][m][0] = (f32x4){ALPHA * bf_lo(w.x), ALPHA * bf_hi(w.x), ALPHA * bf_lo(w.y), ALPHA * bf_hi(w.y)};
                    acc[ai][bj][m][1] = (f32x4){ALPHA * bf_lo(w.z), ALPHA * bf_hi(w.z), ALPHA * bf_lo(w.w), ALPHA * bf_hi(w.w)};
                    __builtin_amdgcn_sched_barrier(0); }
    }
    __device__ __forceinline__ bool early(const f32x4 (&)[2][2][4][2], const pg8::Unit&, int, int, int, int) const { return false; }
    template <int AI>
    __device__ __forceinline__ void half(f32x4 (&acc)[2][2][4][2], const pg8::Unit& u, int, int, int, int) const {
        int tid_ = threadIdx.x; asm volatile("" : "+v"(tid_)); const int tid = tid_, lane = tid & 63;
        const int wq = __builtin_amdgcn_readfirstlane(tid >> 6), wr = wq >> 2, wc = wq & 3, fr = lane & 15, fq = lane >> 4;
        const int colt = u.pn * 256 + wc * 64 + 8 * fq;
        LAS f32x2* part = (LAS f32x2*)(lds + LNF_PART);
        LAS f32x2* stat = (LAS f32x2*)(lds + LNF_STAT);
#pragma unroll
        for (int m = 0; m < 4; ++m) { const int rl = AI * 128 + wr * 64 + m * 16 + fr;
            float s1 = 0.f, s2 = 0.f;
#pragma unroll
            for (int bj = 0; bj < 2; ++bj) { const f32x4 v0 = acc[AI][bj][m][0], v1 = acc[AI][bj][m][1];
#pragma unroll
                for (int e = 0; e < 4; ++e) { s1 += v0[e] + v1[e]; s2 += v0[e] * v0[e] + v1[e] * v1[e]; } }
            s1 += shx(s1, 16, lane); s2 += shx(s2, 16, lane); s1 += shx(s1, 32, lane); s2 += shx(s2, 32, lane);
            if (fq == 0) part[rl * 4 + wc] = (f32x2){s1, s2}; }
        if constexpr (AI == 1) {
            __syncthreads();
            if (tid < 256) {
                const f32x2 p0 = part[tid * 4], p1 = part[tid * 4 + 1], p2 = part[tid * 4 + 2], p3 = part[tid * 4 + 3];
                const float t1 = (p0[0] + p1[0]) + (p2[0] + p3[0]), t2 = (p0[1] + p1[1]) + (p2[1] + p3[1]);
                unsigned long long* sl = (unsigned long long*)pg8::rfl64(((const LAS pg8::JobDesc*)(lds + pg8::JT_OFF))->out2) + (size_t)u.pm * 1024 + tid;
#ifdef PROBE_LNV
                const bool dryp = __builtin_amdgcn_readfirstlane(((const LAS pg8::JobDesc*)(lds + pg8::JT_OFF))->mode) != 0;
#endif
                __hip_atomic_store(sl + u.pn * 256, ((unsigned long long)__float_as_uint(t2) << 32) | __float_as_uint(t1), __ATOMIC_RELAXED, __HIP_MEMORY_SCOPE_AGENT);
                unsigned long long x0, x1, x2, x3; unsigned sp = 0;
                for (;;) {
                    x0 = __hip_atomic_load(sl, __ATOMIC_RELAXED, __HIP_MEMORY_SCOPE_AGENT); x1 = __hip_atomic_load(sl + 256, __ATOMIC_RELAXED, __HIP_MEMORY_SCOPE_AGENT);
                    x2 = __hip_atomic_load(sl + 512, __ATOMIC_RELAXED, __HIP_MEMORY_SCOPE_AGENT); x3 = __hip_atomic_load(sl + 768, __ATOMIC_RELAXED, __HIP_MEMORY_SCOPE_AGENT);
                    if ((x0 != ~0ull && x1 != ~0ull && x2 != ~0ull && x3 != ~0ull) || ++sp > (1u << 22)) break;
#ifdef PROBE_LNV
                    if (dryp && ((PROBE_LNV) & 1)) break;
#endif
                    __builtin_amdgcn_s_sleep(1); }
#ifdef PROBE_LNX
                {   unsigned long long* sl2 = sl + 4 * 131072;
                    __hip_atomic_store(sl2 + u.pn * 256, ((unsigned long long)__float_as_uint(t2) << 32) | __float_as_uint(t1), __ATOMIC_RELAXED, __HIP_MEMORY_SCOPE_AGENT);
                    unsigned long long y0, y1, y2, y3; unsigned sq = 0;
                    for (;;) { y0 = __hip_atomic_load(sl2, __ATOMIC_RELAXED, __HIP_MEMORY_SCOPE_AGENT); y1 = __hip_atomic_load(sl2 + 256, __ATOMIC_RELAXED, __HIP_MEMORY_SCOPE_AGENT);
                        y2 = __hip_atomic_load(sl2 + 512, __ATOMIC_RELAXED, __HIP_MEMORY_SCOPE_AGENT); y3 = __hip_atomic_load(sl2 + 768, __ATOMIC_RELAXED, __HIP_MEMORY_SCOPE_AGENT);
                        if ((y0 != ~0ull && y1 != ~0ull && y2 != ~0ull && y3 != ~0ull) || ++sq > (1u << 22)) break;
                        __builtin_amdgcn_s_sleep(1); }
                    if (y0 == 0x123456789ull) x0 = y1; }
#endif
                const float S1 = (__uint_as_float((unsigned)x0) + __uint_as_float((unsigned)x1)) + (__uint_as_float((unsigned)x2) + __uint_as_float((unsigned)x3));
                const float S2 = (__uint_as_float((unsigned)(x0 >> 32)) + __uint_as_float((unsigned)(x1 >> 32))) + (__uint_as_float((unsigned)(x2 >> 32)) + __uint_as_float((unsigned)(x3 >> 32)));
                const float mean = S1 * (1.f / 1024.f); const float var = fmaxf(S2 * (1.f / 1024.f) - mean * mean, 0.f);
                stat[tid] = (f32x2){mean, __builtin_amdgcn_rsqf(var + LN_EPS)};
            }
            __syncthreads();
            const LAS pg8::JobDesc* jd = (const LAS pg8::JobDesc*)(lds + pg8::JT_OFF);
#ifdef PROBE_LNV
            const bool dryp2 = __builtin_amdgcn_readfirstlane(jd->mode) != 0;
#endif
            const unsigned long long xio = pg8::rfl64(jd->out); const float* g = (const float*)pg8::rfl64(jd->bias); const float* b = (const float*)pg8::rfl64(jd->rot);
            GAS unsigned char* tb = (GAS unsigned char*)(xio + ((size_t)u.pm * 256 * 1024 + u.pn * 256) * 2); const unsigned loff = (unsigned)((wr * 64 + fr) * 1024 + wc * 64 + 8 * fq) * 2u;
#pragma unroll
            for (int bj = 0; bj < 2; ++bj) {
                __builtin_amdgcn_sched_barrier(0);
                const f32x4 g0 = *(const GAS f32x4*)((const GAS float*)g + colt + bj * 32), g1 = *(const GAS f32x4*)((const GAS float*)g + colt + bj * 32 + 4), b0 = *(const GAS f32x4*)((const GAS float*)b + colt + bj * 32), b1 = *(const GAS f32x4*)((const GAS float*)b + colt + bj * 32 + 4);
                f32x2 stn = stat[wr * 64 + fr];
#pragma unroll
                for (int am = 0; am < 8; ++am) { const int ai = am >> 2, m = am & 3; const int rl = ai * 128 + wr * 64 + m * 16 + fr; const f32x2 st = stn;
                    if (am < 7) stn = stat[((am + 1) >> 2) * 128 + wr * 64 + ((am + 1) & 3) * 16 + fr];
                    const float sc = st[1], sh = -st[0] * st[1];
                    const f32x4 v0 = (acc[ai][bj][m][0] * sc + sh) * g0 + b0, v1 = (acc[ai][bj][m][1] * sc + sh) * g1 + b1;
                    u32x4 w; w.x = pk2(v0[0], v0[1]); w.y = pk2(v0[2], v0[3]); w.z = pk2(v1[0], v1[1]); w.w = pk2(v1[2], v1[3]);
#ifdef PROBE_LNV
                    if (!(dryp2 && ((PROBE_LNV) & 2)))
                    *(GAS u32x4*)(tb + (dryp2 ? (size_t)P_TMP_PROBE : (size_t)0) + (ai * 128 + m * 16) * 2048 + bj * 64 + loff) = w;
#else
                    *(GAS u32x4*)(tb + (ai * 128 + m * 16) * 2048 + bj * 64 + loff) = w;
#endif
#ifdef PROBE_LNS
                    *(GAS u32x4*)(tb + ((size_t)P_TMP_PROBE) + (ai * 128 + m * 16) * 2048 + bj * 64 + loff) = w;
#endif
                    __builtin_amdgcn_sched_barrier(0); }
            }
        }
    }
};
enum { RM_IDENT = 0, RM_ROT = 1, RM_PAIR0 = 2, RM_PAIR1 = 3 };
__device__ __forceinline__ int rowmap(int kind, int n) {
    if (kind == RM_ROT) { if (n >= 1280) return n; const int d = n & 63; return (n & ~63) + 2 * (d & 31) + (d >> 5); }
    if (kind == RM_PAIR0) return 2 * n;
    if (kind == RM_PAIR1) return 2 * n + 1;
    return n;
}
__device__ __forceinline__ void ti_load(const float* __restrict__ W, int ldw, int kb, int nb, int lane, f32x4 (&tv)[8]) {
    const int k0 = 64 * kb, n0 = 32 * nb;
#pragma unroll
    for (int i = 0; i < 8; ++i) { const int kk = 8 * i + (lane >> 3); tv[i] = *(const f32x4*)(W + (size_t)(k0 + kk) * ldw + n0 + 4 * (lane & 7)); }
}
__device__ __forceinline__ void ti_store(const f32x4 (&tv)[8], int K, bf16_t* __restrict__ WT, LAS float* scr, int kb, int nb, int lane, int kind, float scale, int nscale) {
    const int k0 = 64 * kb, n0 = 32 * nb;
#pragma unroll
    for (int i = 0; i < 8; ++i) { const int kk = 8 * i + (lane >> 3); LAS float* d = scr + kk * 33 + 4 * (lane & 7); d[0] = tv[i][0]; d[1] = tv[i][1]; d[2] = tv[i][2]; d[3] = tv[i][3]; }
    __builtin_amdgcn_s_waitcnt(0xc07f); asm volatile("" ::: "memory");
    const int c = lane & 7;
#pragma unroll
    for (int j = 0; j < 4; ++j) { const int n = (lane >> 3) + 8 * j; const LAS float* s = scr + (8 * c) * 33 + n; const float sc = (n0 + n) < nscale ? scale : 1.f;
        u32x4 o; o.x = pk2(s[0 * 33] * sc, s[1 * 33] * sc); o.y = pk2(s[2 * 33] * sc, s[3 * 33] * sc); o.z = pk2(s[4 * 33] * sc, s[5 * 33] * sc); o.w = pk2(s[6 * 33] * sc, s[7 * 33] * sc);
        *(u32x4*)(WT + (size_t)rowmap(kind, n0 + n) * K + k0 + 8 * c) = o; }
    __builtin_amdgcn_s_waitcnt(0xc07f); asm volatile("" ::: "memory");
}
__device__ __forceinline__ void convert_mats(const float* W, int K, int N, int nbat, size_t sstr, bf16_t* WT, size_t dstr, int kind, float scale, int nscale, LAS float* scr, int& gwr, int ngw, int lane) {
    const int nblk = N / 32, per = (K / 64) * nblk, total = per * nbat;
    const int gw = gwr; gwr = (gw + ngw - total % ngw) % ngw;
    if (gw >= total) return;
    f32x4 cur[8], nxt[8];
    { const int bt = gw / per, r = gw - bt * per; ti_load(W + (size_t)bt * sstr, N, r / nblk, r % nblk, lane, cur); }
    for (int it = gw; it < total; it += ngw) {
        const int in = it + ngw; const bool more = in < total;
        if (more) { const int bt = in / per, r = in - bt * per; ti_load(W + (size_t)bt * sstr, N, r / nblk, r % nblk, lane, nxt); }
        { const int bt = it / per, r = it - bt * per; ti_store(cur, K, WT + (size_t)bt * dstr, scr, r / nblk, r % nblk, lane, kind, scale, nscale); }
#pragma unroll
        for (int i = 0; i < 8; ++i) cur[i] = nxt[i];
    }
}
__device__ __forceinline__ void convert_rows(const float* __restrict__ src, bf16_t* __restrict__ dst, size_t n, int gt, int ngt) {
    const size_t step = (size_t)ngt * 8; size_t i = (size_t)gt * 8;
    for (; i + 3 * step < n; i += 4 * step) { f32x4 a[4], b[4];
#pragma unroll
        for (int j = 0; j < 4; ++j) { a[j] = *(const f32x4*)(src + i + j * step); b[j] = *(const f32x4*)(src + i + j * step + 4); }
#pragma unroll
        for (int j = 0; j < 4; ++j) { u32x4 o; o.x = pk2(a[j][0], a[j][1]); o.y = pk2(a[j][2], a[j][3]); o.z = pk2(b[j][0], b[j][1]); o.w = pk2(b[j][2], b[j][3]); *(u32x4*)(dst + i + j * step) = o; } }
    for (; i < n; i += step) { const f32x4 a = *(const f32x4*)(src + i), b = *(const f32x4*)(src + i + 4);
        u32x4 o; o.x = pk2(a[0], a[1]); o.y = pk2(a[2], a[3]); o.z = pk2(b[0], b[1]); o.w = pk2(b[2], b[3]); *(u32x4*)(dst + i) = o; }
}

struct LnArgs { const float* xin32; const bf16_t* xin; float* xout32; bf16_t* xbf; const bf16_t* y; const float* g; const float* b; const int* dest; const float* wts; };
template <int NR, bool XF32, bool OUTF32, bool MOE>
__device__ __forceinline__ void ln_rows(const LnArgs& a, int row0, int lane) {
    float v[NR][2][8];
    {
        int d0[NR], d1[NR]; float w0[NR], w1[NR];
        if (MOE) {
#pragma unroll
            for (int i = 0; i < NR; ++i) { d0[i] = a.dest[(row0 + i) * 2]; d1[i] = a.dest[(row0 + i) * 2 + 1]; w0[i] = a.wts[(row0 + i) * 2]; w1[i] = a.wts[(row0 + i) * 2 + 1]; }
        }
        f32x4 xf[XF32 ? NR : 1][2][2]; u32x4 xb[XF32 ? 1 : NR][2]; u32x4 p[NR][2], q[MOE ? NR : 1][2];
#pragma unroll
        for (int i = 0; i < NR; ++i) {
            const u32x4* y0 = (const u32x4*)(a.y + (size_t)(MOE ? d0[i] : row0 + i) * DM) + lane; const u32x4* y1 = (const u32x4*)(a.y + (size_t)(MOE ? d1[i] : 0) * DM) + lane;
#pragma unroll
            for (int j = 0; j < 2; ++j) {
                if (XF32) { const f32x4* xr = (const f32x4*)(a.xin32 + (size_t)(row0 + i) * DM) + 2 * lane + 128 * j; xf[XF32 ? i : 0][j][0] = xr[0]; xf[XF32 ? i : 0][j][1] = xr[1]; }
                else xb[XF32 ? 0 : i][j] = ((const u32x4*)(a.xin + (size_t)(row0 + i) * DM) + lane)[64 * j];
                p[i][j] = y0[64 * j]; if (MOE) q[MOE ? i : 0][j] = y1[64 * j]; } }
#pragma unroll
        for (int i = 0; i < NR; ++i)
#pragma unroll
            for (int j = 0; j < 2; ++j) {
                float x[8];
                if (XF32) {
#pragma unroll
                    for (int e = 0; e < 4; ++e) { x[e] = xf[XF32 ? i : 0][j][0][e]; x[4 + e] = xf[XF32 ? i : 0][j][1][e]; } }
                else { const u32x4 w = xb[XF32 ? 0 : i][j]; x[0] = bf_lo(w.x); x[1] = bf_hi(w.x); x[2] = bf_lo(w.y); x[3] = bf_hi(w.y); x[4] = bf_lo(w.z); x[5] = bf_hi(w.z); x[6] = bf_lo(w.w); x[7] = bf_hi(w.w); }
                const u32x4 pw = p[i][j]; const float py[8] = {bf_lo(pw.x), bf_hi(pw.x), bf_lo(pw.y), bf_hi(pw.y), bf_lo(pw.z), bf_hi(pw.z), bf_lo(pw.w), bf_hi(pw.w)};
                if (MOE) { const u32x4 qw = q[MOE ? i : 0][j]; const float qy[8] = {bf_lo(qw.x), bf_hi(qw.x), bf_lo(qw.y), bf_hi(qw.y), bf_lo(qw.z), bf_hi(qw.z), bf_lo(qw.w), bf_hi(qw.w)};
#pragma unroll
                    for (int e = 0; e < 8; ++e) v[i][j][e] = ALPHA * x[e] + w0[i] * py[e] + w1[i] * qy[e]; }
                else {
#pragma unroll
                    for (int e = 0; e < 8; ++e) v[i][j][e] = ALPHA * x[e] + py[e]; }
            }
    }
    float s[NR];
#pragma unroll
    for (int i = 0; i < NR; ++i) { s[i] = 0.f;
#pragma unroll
        for (int j = 0; j < 2; ++j)
#pragma unroll
            for (int e = 0; e < 8; ++e) s[i] += v[i][j][e]; }
#pragma unroll
    for (int o = 1; o < 64; o <<= 1)
#pragma unroll
        for (int i = 0; i < NR; ++i) s[i] += shx(s[i], o, lane);
    float q2[NR];
#pragma unroll
    for (int i = 0; i < NR; ++i) { const float mean = s[i] * (1.f / DM); q2[i] = 0.f;
#pragma unroll
        for (int j = 0; j < 2; ++j)
#pragma unroll
            for (int e = 0; e < 8; ++e) { v[i][j][e] -= mean; q2[i] += v[i][j][e] * v[i][j][e]; } }
#pragma unroll
    for (int o = 1; o < 64; o <<= 1)
#pragma unroll
        for (int i = 0; i < NR; ++i) q2[i] += shx(q2[i], o, lane);
    f32x4 gv[2][2], bv[2][2];
#pragma unroll
    for (int j = 0; j < 2; ++j) { const f32x4* gp = (const f32x4*)a.g + 2 * lane + 128 * j; const f32x4* bp = (const f32x4*)a.b + 2 * lane + 128 * j; gv[j][0] = gp[0]; gv[j][1] = gp[1]; bv[j][0] = bp[0]; bv[j][1] = bp[1]; }
#pragma unroll
    for (int i = 0; i < NR; ++i) { const float rstd = rsqrtf(q2[i] * (1.f / DM) + LN_EPS);
#pragma unroll
        for (int j = 0; j < 2; ++j) { float o[8];
#pragma unroll
            for (int e = 0; e < 8; ++e) o[e] = v[i][j][e] * rstd * gv[j][e >> 2][e & 3] + bv[j][e >> 2][e & 3];
            if (OUTF32) { f32x4* xo = (f32x4*)(a.xout32 + (size_t)(row0 + i) * DM) + 2 * lane + 128 * j; xo[0] = (f32x4){o[0], o[1], o[2], o[3]}; xo[1] = (f32x4){o[4], o[5], o[6], o[7]}; }
            else { u32x4 w; w.x = pk2(o[0], o[1]); w.y = pk2(o[2], o[3]); w.z = pk2(o[4], o[5]); w.w = pk2(o[6], o[7]); ((u32x4*)(a.xbf + (size_t)(row0 + i) * DM) + lane)[64 * j] = w; } } }
}
template <bool XF32, bool OUTF32, bool MOE>
__device__ __forceinline__ void ln_phase(const LnArgs& a, int blk, int G, int wave, int lane) {
    const int per = NT / G, r0 = blk * per, pw = per / NWAVE;
    for (int r = 0; r < pw; r += 4) ln_rows<4, XF32, OUTF32, MOE>(a, r0 + wave * pw + r, lane);
}
__device__ __forceinline__ void xattn_phase(LAS unsigned char* lds, const bf16_t* __restrict__ Q, const bf16_t* __restrict__ KC, const bf16_t* __restrict__ VT, bf16_t* __restrict__ O, int blk, int G) {
    const int tid0 = threadIdx.x, wave = __builtin_amdgcn_readfirstlane(tid0 >> 6);
#define XA_IDS int tid = tid0; asm volatile("" : "+v"(tid)); const int lane = tid & 63, r32 = lane & 31, hh = lane >> 5; const size_t qrow = (size_t)b * SEQ + qb * 256 + wave * 32 + r32; (void)lane; (void)hh; (void)qrow;
    for (int u = blk; u < 512; u += G) {
        int qb = u & 15, h = (u >> 4) & 3, b = u >> 6;
        if (G == 256) { const int x = blk & 7, j = blk >> 3, grp = x * 4 + (u >> 8) * 2 + (j >> 4); qb = j & 15; h = grp & 3; b = grp >> 2; }
        XA_IDS;
        bf16x8 qf[16];
#pragma unroll
        for (int ks = 0; ks < 16; ++ks) qf[ks] = *(const bf16x8*)(Q + qrow * 1024 + h * 256 + ks * 16 + hh * 8);
        __syncthreads();
#pragma unroll
        for (int bt = 0; bt < 2; ++bt) {
            u32x4 t[8];
#pragma unroll
            for (int i = 0; i < 8; ++i) { const int ch = tid + 512 * (bt * 8 + i), row = ch >> 5, c = ch & 31; t[i] = *(const u32x4*)(KC + (size_t)(b * 256 + row) * 1024 + h * 256 + c * 8); }
#pragma unroll
            for (int i = 0; i < 8; ++i) { const int ch = tid + 512 * (bt * 8 + i), row = ch >> 5, c = ch & 31; *(LAS u32x4*)(lds + row * 528 + c * 16) = t[i]; }
        }
        __syncthreads();
        f32x16 s[8];
#pragma unroll
        for (int mt = 0; mt < 8; ++mt)
#pragma unroll
            for (int r = 0; r < 16; ++r) s[mt][r] = 0.f;
        {   const LAS unsigned char* kbp = lds + r32 * 528 + hh * 16;
#pragma unroll
            for (int ks = 0; ks < 16; ++ks)
#pragma unroll
                for (int mt = 0; mt < 8; ++mt) { const bf16x8 a = *(const LAS bf16x8*)(kbp + mt * 32 * 528 + ks * 32); s[mt] = MFMA32(a, qf[ks], s[mt]); }
        }
        float mx = -INFINITY;
#pragma unroll
        for (int mt = 0; mt < 8; ++mt)
#pragma unroll
            for (int r = 0; r < 16; ++r) mx = fmaxf(mx, s[mt][r]);
        mx = xhalf_max(mx);
        float sm = 0.f; const float mxl = mx * LOG2E;
        u32x4 pf[8][2];
#pragma unroll
        for (int mt = 0; mt < 8; ++mt) {
#pragma unroll
            for (int r = 0; r < 16; ++r) { const float p = __builtin_amdgcn_exp2f(s[mt][r] * LOG2E - mxl); s[mt][r] = p; sm += p; }
#pragma unroll
            for (int sx = 0; sx < 2; ++sx) pf[mt][sx] = (u32x4){pk2(s[mt][8 * sx], s[mt][8 * sx + 1]), pk2(s[mt][8 * sx + 2], s[mt][8 * sx + 3]), pk2(s[mt][8 * sx + 4], s[mt][8 * sx + 5]), pk2(s[mt][8 * sx + 6], s[mt][8 * sx + 7])};
        }
        sm = xhalf_sum(sm);
        __syncthreads();
        {   XA_IDS;
#pragma unroll
        for (int bt = 0; bt < 4; ++bt) {
            u32x4 t[4];
#pragma unroll
            for (int i = 0; i < 4; ++i) { const int ch = tid + 512 * (bt * 4 + i), row = ch >> 5, c = ch & 31; t[i] = *(const u32x4*)(VT + (size_t)(h * 256 + row) * 2048 + b * 256 + c * 8); }
#pragma unroll
            for (int i = 0; i < 4; ++i) { const int ch = tid + 512 * (bt * 4 + i), row = ch >> 5, c = ch & 31; LAS u32x2* d = (LAS u32x2*)(lds + row * 520 + c * 16); d[0] = (u32x2){t[i].x, t[i].y}; d[1] = (u32x2){t[i].z, t[i].w}; }
        }
        }
        __syncthreads();
        {   XA_IDS;
        const float inv = 1.f / sm;
        bf16_t* orow = O + qrow * 1024 + h * 256 + 4 * hh;
#pragma unroll 1
        for (int dh = 0; dh < 2; ++dh) {
            f32x16 o[4];
#pragma unroll
            for (int dt = 0; dt < 4; ++dt)
#pragma unroll
                for (int r = 0; r < 16; ++r) o[dt][r] = 0.f;
            const LAS unsigned char* vb = lds + (dh * 128 + r32) * 520 + 8 * hh;
#pragma unroll
            for (int mt = 0; mt < 8; ++mt)
#pragma unroll
                for (int sx = 0; sx < 2; ++sx) { const int kb = mt * 32 + 16 * sx; const bf16x8 pb = __builtin_bit_cast(bf16x8, pf[mt][sx]);
#pragma unroll
                    for (int dt = 0; dt < 4; ++dt) { const LAS unsigned char* q = vb + dt * 32 * 520 + kb * 2;
                        const s16x4 lo = *(const LAS s16x4*)q, hi = *(const LAS s16x4*)(q + 16);
                        const bf16x8 a = (bf16x8){lo[0], lo[1], lo[2], lo[3], hi[0], hi[1], hi[2], hi[3]}; o[dt] = MFMA32(a, pb, o[dt]); } }
#pragma unroll
            for (int dt = 0; dt < 4; ++dt)
#pragma unroll
                for (int g = 0; g < 4; ++g) { u32x2 w; w.x = pk2(o[dt][4 * g] * inv, o[dt][4 * g + 1] * inv); w.y = pk2(o[dt][4 * g + 2] * inv, o[dt][4 * g + 3] * inv); *(u32x2*)(orow + dh * 128 + dt * 32 + 8 * g) = w; }
        }
        }
    }
#undef XA_IDS
}

struct RouteBufs { int* e; float* w; int* rank; int* dest; int* hist; int* tstart; int* src; };
__device__ __forceinline__ void moe_router_phase(LAS unsigned char* lds, const bf16_t* __restrict__ XBF, const bf16_t* __restrict__ WRT, const float* __restrict__ brg, const float* __restrict__ bre, const RouteBufs rb, int blk) {
    int tid_ = threadIdx.x; asm volatile("" : "+v"(tid_)); const int tid = tid_, lane = tid & 63, wave = __builtin_amdgcn_readfirstlane(tid >> 6), r32 = lane & 31, hh = lane >> 5;
    LAS unsigned char* XT = lds; LAS unsigned char* WT = lds + 128 * 528;
    LAS float* LG = (LAS float*)lds;
    LAS int* hist = (LAS int*)(lds + 128 * 65 * 4);
    const int rbk = wave & 3, ct = wave >> 2;
    f32x16 acc;
#pragma unroll
    for (int r = 0; r < 16; ++r) acc[r] = 0.f;
#pragma unroll 1
    for (int kc = 0; kc < 4; ++kc) {
        __syncthreads();
        {   u32x4 tx[8], tw[8];
#pragma unroll
            for (int i = 0; i < 8; ++i) { const int ch = tid + 512 * i, row = ch >> 5, c = ch & 31; tx[i] = *(const u32x4*)(XBF + (size_t)(blk * 128 + row) * 1024 + kc * 256 + c * 8); tw[i] = *(const u32x4*)(WRT + (size_t)row * 1024 + kc * 256 + c * 8); }
#pragma unroll
            for (int i = 0; i < 8; ++i) { const int ch = tid + 512 * i, row = ch >> 5, c = ch & 31; *(LAS u32x4*)(XT + row * 528 + c * 16) = tx[i]; *(LAS u32x4*)(WT + row * 528 + c * 16) = tw[i]; } }
        __syncthreads();
        const LAS unsigned char* ap = XT + (rbk * 32 + r32) * 528 + hh * 16; const LAS unsigned char* bp = WT + (ct * 32 + r32) * 528 + hh * 16;
#pragma unroll
        for (int ks = 0; ks < 16; ++ks) { const bf16x8 a = *(const LAS bf16x8*)(ap + ks * 32), b0 = *(const LAS bf16x8*)(bp + ks * 32), b1 = *(const LAS bf16x8*)(bp + 64 * 528 + ks * 32);
            acc = MFMA32(a, b0, acc); acc = MFMA32(a, b1, acc); }
    }
    __syncthreads();
    if (tid < 32) hist[tid] = 0;
#pragma unroll
    for (int r = 0; r < 16; ++r) LG[(rbk * 32 + crow(r, hh)) * 65 + ct * 32 + r32] = acc[r];
    __syncthreads();
    if (tid < 128) {
        const LAS float* lg = LG + tid * 65; const int tok = blk * 128 + tid;
        float g4[4];
#pragma unroll
        for (int g = 0; g < 4; ++g) g4[g] = lg[32 + g] + brg[g];
        int gi = 0; float gm = g4[0];
#pragma unroll
        for (int g = 1; g < 4; ++g) if (g4[g] > gm) { gm = g4[g]; gi = g; }
        float gs = 0.f;
#pragma unroll
        for (int g = 0; g < 4; ++g) gs += fast_exp(g4[g] - gm);
        const float gate_g = 1.f / gs;
        float le[8];
#pragma unroll
        for (int e = 0; e < 8; ++e) le[e] = lg[gi * 8 + e] + bre[gi * 8 + e];
        int i0 = 0; float v0 = le[0];
#pragma unroll
        for (int e = 1; e < 8; ++e) if (le[e] > v0) { v0 = le[e]; i0 = e; }
        int i1 = 0; float v1 = -INFINITY;
#pragma unroll
        for (int e = 0; e < 8; ++e) if (e != i0 && le[e] > v1) { v1 = le[e]; i1 = e; }
        const float e1 = fast_exp(v1 - v0), p0 = 1.f / (1.f + e1), p1 = e1 * p0;
        const int ex0 = gi * 8 + i0, ex1 = gi * 8 + i1;
        rb.e[tok * 2] = ex0; rb.e[tok * 2 + 1] = ex1; rb.w[tok * 2] = gate_g * p0; rb.w[tok * 2 + 1] = gate_g * p1;
        rb.rank[tok * 2] = atomicAdd((int*)&hist[ex0], 1); rb.rank[tok * 2 + 1] = atomicAdd((int*)&hist[ex1], 1);
    }
    __syncthreads();
    if (tid < 32) rb.hist[blk * 32 + tid] = hist[tid];
}
__device__ __forceinline__ void moe_scatter_phase(LAS unsigned char* lds, const RouteBufs rb, int blk, int G) {
    int tid_ = threadIdx.x; asm volatile("" : "+v"(tid_)); const int tid = tid_, lane = tid & 63, wave = __builtin_amdgcn_readfirstlane(tid >> 6);
    LAS int* sb = (LAS int*)lds;
    __syncthreads();
    {
        const int e = tid & 31, part = tid >> 5; int c[16];
#pragma unroll
        for (int i = 0; i < 16; ++i) c[i] = rb.hist[(part * 16 + i) * 32 + e];
        int tot = 0, base = 0;
#pragma unroll
        for (int i = 0; i < 16; ++i) { tot += c[i]; if (part * 16 + i < blk) base += c[i]; }
        sb[128 + part * 32 + e] = base; sb[128 + 512 + part * 32 + e] = tot; }
    __syncthreads();
    if (tid < 32) { int tot = 0, base = 0;
#pragma unroll
        for (int i = 0; i < 16; ++i) { base += sb[128 + i * 32 + tid]; tot += sb[128 + 512 + i * 32 + tid]; }
        sb[tid] = base; sb[32 + tid] = tot; }
    __syncthreads();
    if (tid == 0) { int acc = 0; for (int e = 0; e < 32; ++e) { sb[64 + e] = acc; if (blk == 0) rb.tstart[e] = acc >> 8; acc += (sb[32 + e] + 255) & ~255; } sb[96] = acc; if (blk == 0) rb.tstart[32] = acc >> 8; }
    __syncthreads();
    if (tid < 256) { const int idx = blk * 256 + tid; const int e = rb.e[idx]; const int d = sb[64 + e] + sb[e] + rb.rank[idx]; rb.dest[idx] = d; rb.src[d] = idx >> 1; }
    if (blk < 32) { const int e = blk; const int lo = sb[64 + e] + sb[32 + e], hi = sb[64 + e] + ((sb[32 + e] + 255) & ~255); for (int r = lo + tid; r < hi; r += NTHR) rb.src[r] = 0; }
}
struct MoeSched {
    const char* A; const char* B; const int* tstart; int K, nN, G, c; size_t bexp;
    __device__ __forceinline__ pg8::Unit get(int i, bool& ok) const { pg8::Unit u; u.A = nullptr; u.B = nullptr; u.src = nullptr; u.pm = 0; u.pn = 0; u.job = 0; ok = next(i, u); return u; }
    __device__ __forceinline__ bool next(int i, pg8::Unit& u) const {
        const int vc = (c & 7) * (G >> 3) + (c >> 3);
        const long L = (long)i * G + vc; const int ntile = tstart[32];
        if (L >= (long)ntile * nN) return false;
        const int mt = (int)(L / nN), nt = (int)(L % nN);
        int e = 0;
        for (int k = 1; k < 32; ++k) if (tstart[k] <= mt) e = k;
        u.A = A + (size_t)mt * 256 * K * 2; u.B = B + (size_t)e * bexp + (size_t)nt * 256 * K * 2; u.src = nullptr; u.pm = mt; u.pn = nt; u.job = 0; return true;
    }
};
__device__ __forceinline__ void swa_phase(LAS unsigned char* lds, const bf16_t* __restrict__ Q1, const bf16_t* __restrict__ K1, const bf16_t* __restrict__ VT1, const float* __restrict__ sinks, bf16_t* __restrict__ O, int blk, int G) {
    int tid_ = threadIdx.x; asm volatile("" : "+v"(tid_)); const int tid = tid_, lane = tid & 63, wave = __builtin_amdgcn_readfirstlane(tid >> 6), r32 = lane & 31, hh = lane >> 5;
    LAS unsigned char* KL = lds;
    LAS unsigned char* VL = lds + 36864;
    for (int u = blk; u < 1024; u += G) {
        int n = u & 31, kvh = (u >> 5) & 3, b = u >> 7;
        if (G == 256) { const int grp = (u >> 8) * 8 + (blk & 7); n = blk >> 3; kvh = grp & 3; b = grp >> 2; }
        const int tokb = b * SEQ + (n - 1) * 128;
        bf16x8 qfa[2][4];
        {   const int g0 = wave >> 1, hq0 = kvh * 4 + g0;
#pragma unroll
            for (int sb = 0; sb < 2; ++sb)
#pragma unroll
                for (int ks = 0; ks < 4; ++ks) qfa[sb][ks] = *(const bf16x8*)(Q1 + ((size_t)b * SEQ + n * 128 + (wave & 1) * 64 + sb * 32 + r32) * 1024 + hq0 * 64 + ks * 16 + hh * 8); }
        __syncthreads();
#pragma unroll
        for (int i = 0; i < 4; ++i) { const int ch = tid + 512 * i; const int key = ch >> 3, c = ch & 7;
            u32x4 v = (u32x4){0u, 0u, 0u, 0u}; if (n > 0 || key >= 128) v = *(const u32x4*)(K1 + (size_t)(tokb + key) * 256 + kvh * 64 + c * 8);
            *(LAS u32x4*)(KL + key * 144 + c * 16) = v; }
#pragma unroll
        for (int i = 0; i < 4; ++i) { const int ch = tid + 512 * i; const int d = ch >> 5, c = ch & 31;
            u32x4 v = (u32x4){0u, 0u, 0u, 0u}; if (n > 0 || c >= 16) v = *(const u32x4*)(VT1 + (size_t)(kvh * 64 + d) * NT + tokb + c * 8);
            LAS u32x2* dp = (LAS u32x2*)(VL + d * 520 + c * 16); dp[0] = (u32x2){v.x, v.y}; dp[1] = (u32x2){v.z, v.w}; }
        __syncthreads();
        const int g = wave >> 1, hq = kvh * 4 + g; const float sink = sinks[hq];
#pragma unroll 1
        for (int sb = 0; sb < 2; ++sb) {
            bf16x8 qf[4];
#pragma unroll
            for (int ks = 0; ks < 4; ++ks) qf[ks] = sb ? qfa[1][ks] : qfa[0][ks];
            const int i0 = (wave & 1) * 64 + sb * 32, jt0 = i0 >> 5;
            const size_t qtok = (size_t)b * SEQ + n * 128 + i0 + r32;
            f32x16 s[5];
#pragma unroll
            for (int t = 0; t < 5; ++t) {
#pragma unroll
                for (int r = 0; r < 16; ++r) s[t][r] = 0.f;
                const LAS unsigned char* kp = KL + ((jt0 + t) * 32 + r32) * 144 + hh * 16;
#pragma unroll
                for (int ks = 0; ks < 4; ++ks) { const bf16x8 a = *(const LAS bf16x8*)(kp + ks * 32); s[t] = MFMA32(a, qf[ks], s[t]); }
            }
            const int qi = i0 + r32;
            float mx = sink;
#pragma unroll
            for (int t = 0; t < 5; ++t)
#pragma unroll
                for (int r = 0; r < 16; ++r) { const int kj = (jt0 + t) * 32 + crow(r, hh); const bool valid = (kj > qi) && (kj <= qi + 128) && (n > 0 || kj >= 128);
                    s[t][r] = valid ? s[t][r] : -INFINITY; mx = fmaxf(mx, s[t][r]); }
            mx = xhalf_max(mx);
            float sm = 0.f; const float mxl = mx * LOG2E;
            u32x4 pf[5][2];
#pragma unroll
            for (int t = 0; t < 5; ++t) {
#pragma unroll
                for (int r = 0; r < 16; ++r) { const float pv = __builtin_amdgcn_exp2f(s[t][r] * LOG2E - mxl); s[t][r] = pv; sm += pv; }
#pragma unroll
                for (int sx = 0; sx < 2; ++sx) pf[t][sx] = (u32x4){pk2(s[t][8 * sx], s[t][8 * sx + 1]), pk2(s[t][8 * sx + 2], s[t][8 * sx + 3]), pk2(s[t][8 * sx + 4], s[t][8 * sx + 5]), pk2(s[t][8 * sx + 6], s[t][8 * sx + 7])};
            }
            sm = xhalf_sum(sm) + __builtin_amdgcn_exp2f(sink * LOG2E - mxl);
            f32x16 o[2];
#pragma unroll
            for (int dt = 0; dt < 2; ++dt)
#pragma unroll
                for (int r = 0; r < 16; ++r) o[dt][r] = 0.f;
#pragma unroll
            for (int t = 0; t < 5; ++t)
#pragma unroll
                for (int sx = 0; sx < 2; ++sx) { const bf16x8 pb = __builtin_bit_cast(bf16x8, pf[t][sx]);
#pragma unroll
                    for (int dt = 0; dt < 2; ++dt) { const LAS unsigned char* q = VL + (dt * 32 + r32) * 520 + ((jt0 + t) * 32 + 16 * sx + 4 * hh) * 2;
                        const s16x4 lo = *(const LAS s16x4*)q, hi = *(const LAS s16x4*)(q + 16);
                        const bf16x8 a = (bf16x8){lo[0], lo[1], lo[2], lo[3], hi[0], hi[1], hi[2], hi[3]}; o[dt] = MFMA32(a, pb, o[dt]); } }
            const float inv = 1.f / sm;
            bf16_t* orow = O + qtok * 1024 + hq * 64 + 4 * hh;
#pragma unroll
            for (int dt = 0; dt < 2; ++dt)
#pragma unroll
                for (int gq = 0; gq < 4; ++gq) { u32x2 w; w.x = pk2(o[dt][4 * gq] * inv, o[dt][4 * gq + 1] * inv); w.y = pk2(o[dt][4 * gq + 2] * inv, o[dt][4 * gq + 3] * inv); *(u32x2*)(orow + dt * 32 + 8 * gq) = w; }
        }
    }
}
constexpr int TS = 272;
template <int STRIDE = TS>
__device__ __forceinline__ bf16x8 tr_frag(const LAS unsigned char* T, int k0, int c0, int lane, bool permuted) {
    const int hh = lane >> 5, blk = (lane >> 4) & 1, q = (lane & 15) >> 2, pp = lane & 3;
    const int r0 = k0 + (permuted ? 4 * hh : 8 * hh) + q, r1 = r0 + (permuted ? 8 : 4);
    const int cb = (c0 + 16 * blk + 4 * pp) * 2;
    const s16x4 lo = lds_tr(T + r0 * STRIDE + cb), hi = lds_tr(T + r1 * STRIDE + cb);
    return (bf16x8){lo[0], lo[1], lo[2], lo[3], hi[0], hi[1], hi[2], hi[3]};
}
__device__ __forceinline__ bf16x8 row_frag(const LAS unsigned char* T, int row, int k0, int hh) { return *(const LAS bf16x8*)(T + row * TS + (k0 + 8 * hh) * 2); }
__device__ __forceinline__ void load_tile128(LAS unsigned char* T, const bf16_t* __restrict__ g, int ld, int tid) {
#pragma unroll
    for (int i = 0; i < 4; ++i) { const int ch = tid + 512 * i, row = ch >> 4, c = ch & 15; *(LAS u32x4*)(T + row * TS + c * 16) = *(const u32x4*)(g + (size_t)row * ld + c * 8); }
}
struct L0Bufs {
    bf16_t *AU, *AV, *BX, *BZ, *V, *XC, *YM, *CS, *Q, *K, *U; float *GT, *UN, *NS, *SC;
    const bf16_t *WQT, *GMW, *MT; const float *gm_g, *gm_b, *gm_bs, *cw, *cb, *bif, *nw, *skip;
};

__device__ __forceinline__ void l0_mixA(LAS unsigned char* lds, const L0Bufs& B, int blk, int G) {
    const int tid0 = threadIdx.x, wave = __builtin_amdgcn_readfirstlane(tid0 >> 6);
#define OPQ_IDS int tid = tid0; asm volatile("" : "+v"(tid)); const int lane = tid & 63, r32 = lane & 31, hh = lane >> 5; (void)lane; (void)r32; (void)hh;
    LAS unsigned char* T0 = lds; LAS unsigned char* T1 = lds + 34816; LAS unsigned char* T2 = lds + 2 * 34816; LAS unsigned char* T3 = lds + 3 * 34816;
    LAS float* SF = (LAS float*)T2;
    LAS float* SG = (LAS float*)(lds + 3 * 34816 + 35632);
    for (int u = blk; u < 256; u += G) {
        const int tok0 = u * 128; const bool first = (u & 31) == 0;
        constexpr int VS = 1040;
        {   OPQ_IDS; const int trow = tid >> 2, q4 = tid & 3;
            const bf16_t* vr = B.AV + (size_t)(tok0 + trow) * 512 + q4 * 128; float s = 0.f, s2 = 0.f; u32x4 w[16];
#pragma unroll
            for (int i = 0; i < 16; ++i) w[i] = *(const u32x4*)(vr + i * 8);
#pragma unroll
            for (int i = 0; i < 16; ++i) { const float f[8] = {bf_lo(w[i].x), bf_hi(w[i].x), bf_lo(w[i].y), bf_hi(w[i].y), bf_lo(w[i].z), bf_hi(w[i].z), bf_lo(w[i].w), bf_hi(w[i].w)};
#pragma unroll
                for (int e = 0; e < 8; ++e) { s += f[e]; s2 += f[e] * f[e]; } }
            s += shx(s, 1, lane); s += shx(s, 2, lane); s2 += shx(s2, 1, lane); s2 += shx(s2, 2, lane);
            const float mean = s * (1.f / 512.f), rstd = rsqrtf(fmaxf(s2 * (1.f / 512.f) - mean * mean, 0.f) + LN_EPS);
            __syncthreads();
#pragma unroll
            for (int i = 0; i < 16; ++i) { const int cbase = q4 * 128 + i * 8; const f32x4 g0 = *(const f32x4*)(B.gm_g + cbase), g1 = *(const f32x4*)(B.gm_g + cbase + 4), b0 = *(const f32x4*)(B.gm_b + cbase), b1 = *(const f32x4*)(B.gm_b + cbase + 4);
                u32x4 o; o.x = pk2((bf_lo(w[i].x) - mean) * rstd * g0[0] + b0[0], (bf_hi(w[i].x) - mean) * rstd * g0[1] + b0[1]); o.y = pk2((bf_lo(w[i].y) - mean) * rstd * g0[2] + b0[2], (bf_hi(w[i].y) - mean) * rstd * g0[3] + b0[3]);
                o.z = pk2((bf_lo(w[i].z) - mean) * rstd * g1[0] + b1[0], (bf_hi(w[i].z) - mean) * rstd * g1[1] + b1[1]); o.w = pk2((bf_lo(w[i].w) - mean) * rstd * g1[2] + b1[2], (bf_hi(w[i].w) - mean) * rstd * g1[3] + b1[3]);
                *(LAS u32x4*)(lds + trow * VS + cbase * 2) = o; asm volatile("" ::: "memory"); }
            __syncthreads();
        }
        {   const int tb = wave & 3, dhf = wave >> 2;
#pragma unroll 1
            for (int g = 0; g < 4; ++g) {
                OPQ_IDS; const int t = 32 * tb + r32; const size_t tok = (size_t)tok0 + t;
                f32x16 acc[2];
#pragma unroll
                for (int dt = 0; dt < 2; ++dt)
#pragma unroll
                    for (int r = 0; r < 16; ++r) acc[dt][r] = 0.f;
                const bf16_t* wrow = B.GMW + ((size_t)g * 128 + t) * 128 + 8 * hh;
                bf16x8 bw[8];
#pragma unroll
                for (int ks = 0; ks < 8; ++ks) bw[ks] = *(const bf16x8*)(wrow + 16 * ks);
#pragma unroll
                for (int ks = 0; ks < 8; ++ks) if (ks <= 2 * tb + 1) {
#pragma unroll
                    for (int dt = 0; dt < 2; ++dt) { const bf16x8 a = tr_frag<VS>(lds, 16 * ks, g * 128 + 64 * dhf + 32 * dt, lane, false); acc[dt] = MFMA32(a, bw[ks], acc[dt]); } }
                const float bsv = B.gm_bs[g * 128 + t];
#pragma unroll
                for (int dt = 0; dt < 2; ++dt)
#pragma unroll
                    for (int gq = 0; gq < 4; ++gq) { const int col = g * 128 + 64 * dhf + 32 * dt + 8 * gq + 4 * hh; const u32x2 au = *(const u32x2*)(B.AU + tok * 512 + col);
                        u32x2 w; w.x = pk2(bf_lo(au.x) * (acc[dt][4 * gq] + bsv), bf_hi(au.x) * (acc[dt][4 * gq + 1] + bsv)); w.y = pk2(bf_lo(au.y) * (acc[dt][4 * gq + 2] + bsv), bf_hi(au.y) * (acc[dt][4 * gq + 3] + bsv));
                        *(u32x2*)(B.YM + tok * 1024 + col) = w; }
            }
        }
        f32x16 accg;
#pragma unroll
        for (int r = 0; r < 16; ++r) accg[r] = 0.f;
        LAS unsigned char* MTL = (LAS unsigned char*)SG;
#pragma unroll 1
        for (int h = 0; h < 4; ++h) {
            OPQ_IDS;
            __syncthreads();
            for (int ch = tid; ch < 131 * 16; ch += 512) { const int row = ch >> 4, c = ch & 15; u32x4 v = (u32x4){0u, 0u, 0u, 0u};
                if (!(first && row < 3)) v = *(const u32x4*)(B.BX + (size_t)(tok0 - 3 + row) * 512 + h * 128 + c * 8);
                *(LAS u32x4*)(T3 + row * TS + c * 16) = v; }
            load_tile128(T0, B.WQT + ((size_t)0 * 4 + h) * 128 * 128, 128, tid);
            load_tile128(T1, B.WQT + ((size_t)1 * 4 + h) * 128 * 128, 128, tid);
            if (tid < 256) { const int row = tid >> 5, c = tid & 31; *(LAS u32x4*)(MTL + row * 528 + c * 16) = *(const u32x4*)(B.MT + ((size_t)h * 8 + row) * 256 + c * 8); }
            __syncthreads();
            {   const int dc = tid & 15, chn = h * 128 + dc * 8; float w[4][8], cbv[8];
#pragma unroll
                for (int j = 0; j < 4; ++j)
#pragma unroll
                    for (int e = 0; e < 8; ++e) w[j][e] = B.cw[j * 512 + chn + e];
#pragma unroll
                for (int e = 0; e < 8; ++e) cbv[e] = B.cb[chn + e];
#pragma unroll 1
                for (int ps = 0; ps < 4; ++ps) { const int t = ps * 32 + (tid >> 4); float a[8];
#pragma unroll
                    for (int e = 0; e < 8; ++e) a[e] = cbv[e];
#pragma unroll
                    for (int j = 0; j < 4; ++j) { const u32x4 x = *(const LAS u32x4*)(T3 + (t + j) * TS + dc * 16);
                        a[0] += w[j][0] * bf_lo(x.x); a[1] += w[j][1] * bf_hi(x.x); a[2] += w[j][2] * bf_lo(x.y); a[3] += w[j][3] * bf_hi(x.y);
                        a[4] += w[j][4] * bf_lo(x.z); a[5] += w[j][5] * bf_hi(x.z); a[6] += w[j][6] * bf_lo(x.w); a[7] += w[j][7] * bf_hi(x.w); }
                    u32x4 o; o.x = pk2(silu_f(a[0]), silu_f(a[1])); o.y = pk2(silu_f(a[2]), silu_f(a[3])); o.z = pk2(silu_f(a[4]), silu_f(a[5])); o.w = pk2(silu_f(a[6]), silu_f(a[7]));
                    *(LAS u32x4*)(T2 + t * TS + dc * 16) = o; *(u32x4*)(B.XC + (size_t)(tok0 + t) * 512 + chn) = o; } }
            __syncthreads();
            {   const int tb = wave & 3, ehf = wave >> 2;
                {
                    OPQ_IDS; const LAS unsigned char* act = ehf ? T3 + 3 * TS : T2;
#pragma unroll
                    for (int ks = 0; ks < 8; ++ks) { const bf16x8 a = *(const LAS bf16x8*)(MTL + (r32 & 7) * 528 + (ehf * 128 + 16 * ks + 8 * hh) * 2); const bf16x8 bx = row_frag(act, 32 * tb + r32, 16 * ks, hh); accg = MFMA32(a, bx, accg); } }
#pragma unroll 1
                for (int mtx = 0; mtx < 2; ++mtx) {
                    OPQ_IDS;
                    const LAS unsigned char* wt = mtx ? T1 : T0;
                    f32x16 acc[2];
#pragma unroll
                    for (int et = 0; et < 2; ++et)
#pragma unroll
                        for (int r = 0; r < 16; ++r) acc[et][r] = 0.f;
#pragma unroll
                    for (int ks = 0; ks < 8; ++ks) { const bf16x8 bx = row_frag(T2, 32 * tb + r32, 16 * ks, hh);
#pragma unroll
                        for (int et = 0; et < 2; ++et) { const bf16x8 a = row_frag(wt, 64 * ehf + 32 * et + r32, 16 * ks, hh); acc[et] = MFMA32(a, bx, acc[et]); } }
                    bf16_t* dst = (mtx == 0 ? B.Q : B.K) + (size_t)(tok0 + 32 * tb + r32) * 512 + h * 128 + 64 * ehf + 4 * hh;
#pragma unroll
                    for (int et = 0; et < 2; ++et)
#pragma unroll
                        for (int gq = 0; gq < 4; ++gq) { u32x2 w; w.x = pk2(acc[et][4 * gq], acc[et][4 * gq + 1]); w.y = pk2(acc[et][4 * gq + 2], acc[et][4 * gq + 3]); *(u32x2*)(dst + 32 * et + 8 * gq) = w; }
                }
            }
            __syncthreads();
            load_tile128(T0, B.WQT + ((size_t)2 * 4 + h) * 128 * 128, 128, tid);
            __syncthreads();
            {   OPQ_IDS; const int tb = wave & 3, ehf = wave >> 2;
                f32x16 acc[2];
#pragma unroll
                for (int et = 0; et < 2; ++et)
#pragma unroll
                    for (int r = 0; r < 16; ++r) acc[et][r] = 0.f;
#pragma unroll
                for (int ks = 0; ks < 8; ++ks) { const bf16x8 bx = row_frag(T3 + 3 * TS, 32 * tb + r32, 16 * ks, hh);
#pragma unroll
                    for (int et = 0; et < 2; ++et) { const bf16x8 a = row_frag(T0, 64 * ehf + 32 * et + r32, 16 * ks, hh); acc[et] = MFMA32(a, bx, acc[et]); } }
                bf16_t* dst = B.V + (size_t)(tok0 + 32 * tb + r32) * 512 + h * 128 + 64 * ehf + 4 * hh;
#pragma unroll
                for (int et = 0; et < 2; ++et)
#pragma unroll
                    for (int gq = 0; gq < 4; ++gq) { u32x2 w; w.x = pk2(acc[et][4 * gq], acc[et][4 * gq + 1]); w.y = pk2(acc[et][4 * gq + 2], acc[et][4 * gq + 3]); *(u32x2*)(dst + 32 * et + 8 * gq) = w; }
            }
        }
        __syncthreads();
        {   OPQ_IDS; const int tb = wave & 3, kh = wave >> 2;
#pragma unroll
            for (int r = 0; r < 4; ++r) SF[(kh * 8 + r + 4 * hh) * 128 + 32 * tb + r32] = accg[r];
        }
        __syncthreads();
        LAS float* IG = SG; LAS float* BC = SG + 512; LAS float* WG = SG + 1024;
        if (wave < 4) {
            OPQ_IDS; const int h = wave; float lf[2], ig[2];
#pragma unroll
            for (int e = 0; e < 2; ++e) { const int t = 2 * lane + e; ig[e] = SF[h * 128 + t] + SF[(8 + h) * 128 + t] + B.bif[h];
                const float fx = SF[(4 + h) * 128 + t] + SF[(12 + h) * 128 + t] + B.bif[4 + h]; lf[e] = fminf(fx, 0.f) - log1pf(expf(-fabsf(fx))); }
            float run = lf[0] + lf[1];
#pragma unroll
            for (int o = 1; o < 64; o <<= 1) { const float v = shup(run, o, lane); if (lane >= o) run += v; }
            const float b1 = run, b0 = run - lf[1];
            IG[h * 128 + 2 * lane] = ig[0]; IG[h * 128 + 2 * lane + 1] = ig[1]; BC[h * 128 + 2 * lane] = b0; BC[h * 128 + 2 * lane + 1] = b1;
            float* gt = B.GT + ((size_t)u * 4 + h) * 256;
            gt[2 * lane] = ig[0]; gt[2 * lane + 1] = ig[1]; gt[128 + 2 * lane] = b0; gt[128 + 2 * lane + 1] = b1;
            const float bl = shidx(b1, 63);
            float g0 = bl - b0 + ig[0], g1 = bl - b1 + ig[1]; float mloc = fmaxf(g0, g1);
#pragma unroll
            for (int o = 1; o < 64; o <<= 1) mloc = fmaxf(mloc, shx(mloc, o, lane));
            WG[h * 128 + 2 * lane] = expf(g0 - mloc); WG[h * 128 + 2 * lane + 1] = expf(g1 - mloc);
            if (lane == 0) { B.SC[u * 4 + h] = bl; B.SC[1024 + u * 4 + h] = mloc; }
        }
#pragma unroll 1
        for (int h = 0; h < 4; ++h) {
            OPQ_IDS;
            __syncthreads();
#pragma unroll
            for (int i = 0; i < 4; ++i) { const int ch = tid + 512 * i, row = ch >> 4, c = ch & 15; const float wg = WG[h * 128 + row];
                const u32x4 v = *(const u32x4*)(B.V + (size_t)(tok0 + row) * 512 + h * 128 + c * 8), k = *(const u32x4*)(B.K + (size_t)(tok0 + row) * 512 + h * 128 + c * 8);
                u32x4 ov, ok; const float ksc = 0.08838834764831845f;
                ov.x = pk2(bf_lo(v.x) * wg, bf_hi(v.x) * wg); ov.y = pk2(bf_lo(v.y) * wg, bf_hi(v.y) * wg); ov.z = pk2(bf_lo(v.z) * wg, bf_hi(v.z) * wg); ov.w = pk2(bf_lo(v.w) * wg, bf_hi(v.w) * wg);
                ok.x = pk2(bf_lo(k.x) * ksc, bf_hi(k.x) * ksc); ok.y = pk2(bf_lo(k.y) * ksc, bf_hi(k.y) * ksc); ok.z = pk2(bf_lo(k.z) * ksc, bf_hi(k.z) * ksc); ok.w = pk2(bf_lo(k.w) * ksc, bf_hi(k.w) * ksc);
                *(LAS u32x4*)(T0 + row * TS + c * 16) = ov; *(LAS u32x4*)(T1 + row * TS + c * 16) = ok; }
            __syncthreads();
            const int vb = wave & 3, khf = wave >> 2;
            f32x16 acc[2];
#pragma unroll
            for (int kt = 0; kt < 2; ++kt)
#pragma unroll
                for (int r = 0; r < 16; ++r) acc[kt][r] = 0.f;
#pragma unroll
            for (int ks = 0; ks < 8; ++ks) { const bf16x8 a = tr_frag(T0, 16 * ks, 32 * vb, lane, false);
#pragma unroll
                for (int kt = 0; kt < 2; ++kt) { const bf16x8 bk = tr_frag(T1, 16 * ks, 64 * khf + 32 * kt, lane, false); acc[kt] = MFMA32(a, bk, acc[kt]); } }
            bf16_t* Uo = B.U + ((size_t)u * 4 + h) * 16384;
#pragma unroll
            for (int kt = 0; kt < 2; ++kt)
#pragma unroll
                for (int r = 0; r < 16; ++r) Uo[(32 * vb + crow(r, hh)) * 128 + 64 * khf + 32 * kt + r32] = f2bf(acc[kt][r]);
            {   const int kk = tid & 127, sq = tid >> 7; float a = 0.f;
                for (int s = sq * 32; s < sq * 32 + 32; ++s) a += WG[h * 128 + s] * bf2f(*(const LAS bf16_t*)(T1 + s * TS + kk * 2));
                SF[2048 + sq * 128 + kk] = a; }
            __syncthreads();
            if (tid < 128) B.UN[((size_t)u * 4 + h) * 128 + tid] = (SF[2048 + tid] + SF[2048 + 128 + tid]) + (SF[2048 + 256 + tid] + SF[2048 + 384 + tid]);
        }
    }
}
#undef OPQ_IDS
__device__ __forceinline__ void l0_scan(const L0Bufs& B, int blk, int tid) {
    const int bh = blk >> 3, part = blk & 7, b = bh >> 2, h = bh & 3, lane = tid & 63;
    const int e0 = part * 2048 + tid * 8;
    float zz = 0.f; asm volatile("" : "+v"(zz));
    f32x4 C0 = (f32x4){zz, zz, zz, zz}, C1 = C0; float nst = 0.f; float m = 0.f;
    const int unit0 = (b * 32) * 4 + h;
    const bool nrm = part == 0 && tid < 128;
    const float blv = lane < 32 ? B.SC[unit0 + 4 * lane] : 0.f, mlv = lane < 32 ? B.SC[1024 + unit0 + 4 * lane] : 0.f;
    u32x4 ub[8]; float un8[8];
#pragma unroll
    for (int j = 0; j < 8; ++j) { ub[j] = *(const u32x4*)(B.U + (size_t)(unit0 + 4 * j) * 16384 + e0); un8[j] = B.UN[(size_t)(unit0 + 4 * j) * 128 + (tid & 127)]; }
#pragma unroll
    for (int g = 0; g < 4; ++g) {
        u32x4 nb[8]; float nn[8];
#pragma unroll
        for (int j = 0; j < 8; ++j) { const int un1 = unit0 + 4 * (8 * (g < 3 ? g + 1 : 3) + j); nb[j] = *(const u32x4*)(B.U + (size_t)un1 * 16384 + e0); nn[j] = B.UN[(size_t)un1 * 128 + (tid & 127)]; }
#pragma unroll
        for (int j = 0; j < 8; ++j) { const int c = 8 * g + j, unit = unit0 + 4 * c; const u32x4 Unw = ub[j];
            const f32x4 U0 = (f32x4){bf_lo(Unw.x), bf_hi(Unw.x), bf_lo(Unw.y), bf_hi(Unw.y)}, U1 = (f32x4){bf_lo(Unw.z), bf_hi(Unw.z), bf_lo(Unw.w), bf_hi(Unw.w)};
            const float bl = __int_as_float(__builtin_amdgcn_readlane(__float_as_int(blv), c)), mloc = __int_as_float(__builtin_amdgcn_readlane(__float_as_int(mlv), c)), un = un8[j];
            u32x4 w; w.x = pk2(C0[0], C0[1]); w.y = pk2(C0[2], C0[3]); w.z = pk2(C1[0], C1[1]); w.w = pk2(C1[2], C1[3]); *(u32x4*)(B.CS + (size_t)unit * 16384 + e0) = w;
            if (nrm) B.NS[(size_t)unit * 128 + tid] = nst;
            if (part == 0 && tid == 0) B.SC[2048 + unit] = m;
            const float mn = fmaxf(bl + m, mloc), dec = expf(bl + m - mn), wu = expf(mloc - mn); m = mn;
            C0 = C0 * dec + U0 * wu; C1 = C1 * dec + U1 * wu;
            nst = nst * dec + wu * un; }
#pragma unroll
        for (int j = 0; j < 8; ++j) { ub[j] = nb[j]; un8[j] = nn[j]; }
    }
}
__device__ __forceinline__ void l0_mixC(LAS unsigned char* lds, const L0Bufs& B, int blk, int G) {
    const int tid0 = threadIdx.x, wave = __builtin_amdgcn_readfirstlane(tid0 >> 6);
    LAS unsigned char* TQ = lds; LAS unsigned char* TK = lds + 34816; LAS unsigned char* TV = lds + 2 * 34816; LAS unsigned char* TC = lds + 3 * 34816;
    LAS float* SF = (LAS float*)(lds + 4 * 34816);
    LAS float* AS = SF; LAS float* PM = SF + 128; LAS float* NP = SF + 256; LAS float* PS = SF + 384; LAS float* PQ = SF + 640; LAS float* NW = SF + 896;
    __syncthreads();
    { int tq = tid0; asm volatile("" : "+v"(tq)); if (tq < 256) ((LAS f32x4*)NW)[tq] = tq < 128 ? ((const f32x4*)B.nw)[tq] : ((const f32x4*)B.skip)[tq - 128]; }
    for (int uu = blk; uu < 256; uu += G) {
        const int tok0 = uu * 128;
#pragma unroll 1
        for (int h = 0; h < 4; ++h) {
            const int unit = uu * 4 + h;
            int tid = tid0; asm volatile("" : "+v"(tid));
            const int lane = tid & 63, r32 = lane & 31, hh = lane >> 5;
            __syncthreads();
            load_tile128(TQ, B.Q + (size_t)tok0 * 512 + h * 128, 512, tid);
            load_tile128(TV, B.V + (size_t)tok0 * 512 + h * 128, 512, tid);
            load_tile128(TC, B.CS + (size_t)unit * 16384, 128, tid);
#pragma unroll
            for (int i = 0; i < 4; ++i) { const int ch = tid + 512 * i, row = ch >> 4, c = ch & 15; const u32x4 k = *(const u32x4*)(B.K + (size_t)(tok0 + row) * 512 + h * 128 + c * 8); const float ksc = 0.08838834764831845f;
                u32x4 ok; ok.x = pk2(bf_lo(k.x) * ksc, bf_hi(k.x) * ksc); ok.y = pk2(bf_lo(k.y) * ksc, bf_hi(k.y) * ksc); ok.z = pk2(bf_lo(k.z) * ksc, bf_hi(k.z) * ksc); ok.w = pk2(bf_lo(k.w) * ksc, bf_hi(k.w) * ksc);
                *(LAS u32x4*)(TK + row * TS + c * 16) = ok; }
            const float mprev = B.SC[2048 + unit];
            if (wave == 0) {
                const float* gt = B.GT + (size_t)unit * 256;
                const float a0 = gt[2 * lane] - gt[128 + 2 * lane], a1 = gt[2 * lane + 1] - gt[128 + 2 * lane + 1];
                float run = fmaxf(a0, a1);
#pragma unroll
                for (int o = 1; o < 64; o <<= 1) { const float v = shup(run, o, lane); if (lane >= o) run = fmaxf(run, v); }
                const float prev = shup(run, 1, lane); const float p0 = fmaxf(lane > 0 ? fmaxf(prev, a0) : a0, mprev), p1 = fmaxf(run, mprev);
                AS[2 * lane] = a0; AS[2 * lane + 1] = a1; PM[2 * lane] = p0; PM[2 * lane + 1] = p1;
            }
            if (wave == 1) { NP[lane] = B.NS[(size_t)unit * 128 + lane]; NP[64 + lane] = B.NS[(size_t)unit * 128 + 64 + lane]; }
            __syncthreads();
            const int tb = wave & 3, vh = wave >> 2, t = 32 * tb + r32;
            const float pm = PM[t], bt = B.GT[(size_t)unit * 256 + 128 + t];
            f32x16 s[4];
#pragma unroll
            for (int st = 0; st < 4; ++st)
#pragma unroll
                for (int r = 0; r < 16; ++r) s[st][r] = 0.f;
            {   int lv = lane; asm volatile("" : "+v"(lv));
                const LAS unsigned char* qp = TQ + (32 * tb + (lv & 31)) * TS + (lv >> 5) * 16; const LAS unsigned char* kp = TK + (lv & 31) * TS + (lv >> 5) * 16;
#pragma unroll 2
                for (int ks = 0; ks < 8; ++ks) { const bf16x8 bq = *(const LAS bf16x8*)(qp + ks * 32);
#pragma unroll
                    for (int st = 0; st < 4; ++st) if (st <= tb) { const bf16x8 a = *(const LAS bf16x8*)(kp + st * 32 * TS + ks * 32); s[st] = MFMA32(a, bq, s[st]); } } }
            float nq = 0.f; u32x4 pf[4][2];
#pragma unroll
            for (int st = 0; st < 4; ++st) {
#pragma unroll
                for (int r = 0; r < 16; ++r) { const int sidx = 32 * st + crow(r, hh); const float wv = (sidx <= t) ? __builtin_amdgcn_exp2f((AS[sidx] - pm) * LOG2E) : 0.f; const float pv = s[st][r] * wv; s[st][r] = pv; nq += pv; }
#pragma unroll
                for (int sx = 0; sx < 2; ++sx) pf[st][sx] = (u32x4){pk2(s[st][8 * sx], s[st][8 * sx + 1]), pk2(s[st][8 * sx + 2], s[st][8 * sx + 3]), pk2(s[st][8 * sx + 4], s[st][8 * sx + 5]), pk2(s[st][8 * sx + 6], s[st][8 * sx + 7])};
            }
            nq = xhalf_sum(nq);
            float nqi = 0.f;
#pragma unroll
            for (int i = 0; i < 8; ++i) { const u32x4 qv = *(const LAS u32x4*)(TQ + t * TS + (64 * hh + 8 * i) * 2); const LAS float* np = NP + 64 * hh + 8 * i;
                nqi += bf_lo(qv.x) * np[0] + bf_hi(qv.x) * np[1] + bf_lo(qv.y) * np[2] + bf_hi(qv.y) * np[3] + bf_lo(qv.z) * np[4] + bf_hi(qv.z) * np[5] + bf_lo(qv.w) * np[6] + bf_hi(qv.w) * np[7]; }
            nqi = xhalf_sum(nqi);
            const float wst = __builtin_amdgcn_exp2f((mprev - pm) * LOG2E);
            const float den = fmaxf(fabsf(nq + wst * nqi), __builtin_amdgcn_exp2f(-(bt + pm) * LOG2E)), rden = 1.f / den;
            f32x16 ni[2], nx[2];
#pragma unroll
            for (int vt = 0; vt < 2; ++vt)
#pragma unroll
                for (int r = 0; r < 16; ++r) { ni[vt][r] = 0.f; nx[vt][r] = 0.f; }
            {   int lv = lane; asm volatile("" : "+v"(lv));
#pragma unroll
                for (int st = 0; st < 4; ++st) {
                    if (st <= tb) {
#pragma unroll
                        for (int sx = 0; sx < 2; ++sx) { const bf16x8 pb = __builtin_bit_cast(bf16x8, pf[st][sx]);
#pragma unroll
                            for (int vt = 0; vt < 2; ++vt) { const bf16x8 a = tr_frag(TV, 32 * st + 16 * sx, 64 * vh + 32 * vt, lv, true); ni[vt] = MFMA32(a, pb, ni[vt]); } }
                    }
                } }
            {   int lv = lane; asm volatile("" : "+v"(lv));
                const LAS unsigned char* qp = TQ + (32 * tb + (lv & 31)) * TS + (lv >> 5) * 16; const LAS unsigned char* cp = TC + (64 * vh + (lv & 31)) * TS + (lv >> 5) * 16;
#pragma unroll 2
                for (int ks = 0; ks < 8; ++ks) { const bf16x8 bq = *(const LAS bf16x8*)(qp + ks * 32);
#pragma unroll
                    for (int vt = 0; vt < 2; ++vt) { const bf16x8 a = *(const LAS bf16x8*)(cp + vt * 32 * TS + ks * 32); nx[vt] = MFMA32(a, bq, nx[vt]); } } }
            const size_t tok = (size_t)tok0 + t;
            u32x2 xcv[2][4], zv[2][4];
#pragma unroll
            for (int vt = 0; vt < 2; ++vt)
#pragma unroll
                for (int gq = 0; gq < 4; ++gq) { const int chn = h * 128 + 64 * vh + 32 * vt + 8 * gq + 4 * hh; xcv[vt][gq] = *(const u32x2*)(B.XC + tok * 512 + chn); zv[vt][gq] = *(const u32x2*)(B.BZ + tok * 512 + chn); }
            float hs = 0.f, hq = 0.f;
#pragma unroll
            for (int vt = 0; vt < 2; ++vt)
#pragma unroll
                for (int r = 0; r < 16; ++r) { const float hv = (ni[vt][r] + wst * nx[vt][r]) * rden; ni[vt][r] = hv; hs += hv; hq += hv * hv; }
            hs = xhalf_sum(hs); hq = xhalf_sum(hq);
            if (hh == 0) { PS[vh * 128 + t] = hs; PQ[vh * 128 + t] = hq; }
            __syncthreads();
            const float mean = (PS[t] + PS[128 + t]) * (1.f / 128.f);
            const float rstd = rsqrtf(fmaxf((PQ[t] + PQ[128 + t]) * (1.f / 128.f) - mean * mean, 0.f) + LN_EPS);
#pragma unroll
            for (int vt = 0; vt < 2; ++vt)
#pragma unroll
                for (int gq = 0; gq < 4; ++gq) { const int cl = 64 * vh + 32 * vt + 8 * gq + 4 * hh, chn = h * 128 + cl;
                    const f32x4 nw = *(const LAS f32x4*)(NW + chn), sk = *(const LAS f32x4*)(NW + 512 + chn); const u32x2 xc = xcv[vt][gq], z = zv[vt][gq];
                    const float y0 = ((ni[vt][4 * gq] - mean) * rstd * nw[0] + sk[0] * bf_lo(xc.x)) * silu_f(bf_lo(z.x)), y1 = ((ni[vt][4 * gq + 1] - mean) * rstd * nw[1] + sk[1] * bf_hi(xc.x)) * silu_f(bf_hi(z.x));
                    const float y2 = ((ni[vt][4 * gq + 2] - mean) * rstd * nw[2] + sk[2] * bf_lo(xc.y)) * silu_f(bf_lo(z.y)), y3 = ((ni[vt][4 * gq + 3] - mean) * rstd * nw[3] + sk[3] * bf_hi(xc.y)) * silu_f(bf_hi(z.y));
                    u32x2 w; w.x = pk2(y0, y1); w.y = pk2(y2, y3); *(u32x2*)(B.YM + tok * 1024 + 512 + chn) = w; }
        }
    }
}
constexpr size_t MB = 1048576ull;
constexpr size_t P_WIN_T = 0, P_WOUT_T = P_WIN_T + 4 * MB, P_WQKV_T = P_WOUT_T + 2 * MB, P_WO_T = P_WQKV_T + 3 * MB, P_XWQ_T = P_WO_T + 2 * MB, P_XWKV_T = P_XWQ_T + 4 * MB, P_XWO_T = P_XWKV_T + 8 * MB,
                 P_MLW_T = P_XWO_T + 4 * MB, P_WIFT = P_MLW_T + MB / 2, P_WRT = P_WIFT + MB / 8, P_ROT = P_WRT + MB / 2, P_BQK = P_ROT + MB, P_MEMB = P_BQK + MB / 8, P_KC = P_MEMB + 4 * MB, P_VT = P_KC + 8 * MB,
                 P_W13T = P_VT + 8 * MB, P_W2T = P_W13T + 64 * MB, P_XBF = P_W2T + 32 * MB, P_RT = P_XBF + 64 * MB, P_TMP = P_RT + 2 * MB;
constexpr size_t P_BAR = P_RT + 1572864;
constexpr size_t RT_SRC = 1638400;
constexpr size_t RT_E = 0, RT_W = 262144, RT_RANK = 2 * 262144, RT_DEST = 3 * 262144, RT_HIST = 4 * 262144, RT_TSTART = RT_HIST + 32768;
constexpr size_t T_QX = 0, T_OB = 64 * MB, T_YB = 128 * MB;
constexpr size_t T_K1 = 192 * MB, T_VT1 = 208 * MB;
constexpr size_t T_AU = 0, T_AV = 32 * MB, T_BX = 64 * MB, T_BZ = 96 * MB, T_V = 128 * MB, T_XC = 160 * MB, T_YM = 192 * MB, T_U = 256 * MB, T_CS = 320 * MB,
                 T_GT = 352 * MB, T_UN = 353 * MB, T_NS = 353 * MB + MB / 2, T_SC = 354 * MB, T_YB0 = 0;
constexpr size_t T_XG = 0, T_HM = 152 * MB, T_YG = 0;
constexpr size_t T_W13B = 228 * MB, T_W2B = 292 * MB;
constexpr size_t T_SLOT = 356 * MB;
constexpr size_t FAST_END = P_TMP + 360 * MB;
#if defined(PROBE_LNX) || defined(PROBE_LNV)
constexpr size_t SLOT_MB = 8;
#else
constexpr size_t SLOT_MB = 4;
#endif
constexpr int LDS_BYTES = 147456;

struct FP {
    const float* in[33]; float* X;
    unsigned char* ws;
};
typedef const float* const __attribute__((address_space(4)))* InTab;
struct PV { InTab in; float* X; unsigned char* ws; };
__device__ __forceinline__ PV make_pv(const FP& p0) {
    PV p; InTab kp = (InTab)__builtin_amdgcn_kernarg_segment_ptr(); asm volatile("" : "+s"(kp)); p.in = kp;
    p.X = p0.X; p.ws = p0.ws; asm volatile("" : "+s"(p.ws)); return p;
}
#define WSP(T, off) ((T*)(p.ws + (off)))

__device__ __forceinline__ RouteBufs route_bufs(const PV& p) {
    RouteBufs r; r.e = WSP(int, P_RT + RT_E); r.w = WSP(float, P_RT + RT_W); r.rank = WSP(int, P_RT + RT_RANK); r.dest = WSP(int, P_RT + RT_DEST); r.hist = WSP(int, P_RT + RT_HIST); r.tstart = WSP(int, P_RT + RT_TSTART); r.src = WSP(int, P_RT + RT_SRC); return r;
}
#define PH_ARGS const PV& p, LAS unsigned char* lds, int blk, int G
#define PH_IDS int tid_ = threadIdx.x; asm volatile("" : "+v"(tid_)); const int tid = tid_, lane = tid & 63, wave = __builtin_amdgcn_readfirstlane(tid >> 6); (void)lane; (void)wave;

__device__ __forceinline__ void ph_conv_xattn(PH_ARGS, int l, int& gw) {
    PH_IDS; LAS float* scr = (LAS float*)(lds + wave * 8448); const int ngw = G * NWAVE;
    convert_mats(p.in[23] + (size_t)l * 1024 * 1024, 1024, 1024, 1, 0, WSP(bf16_t, P_XWQ_T) + (size_t)l * 1024 * 1024, 0, RM_IDENT, 0.0625f, 1024, scr, gw, ngw, lane);
    convert_mats(p.in[24] + (size_t)l * 1024 * 2048, 1024, 2048, 1, 0, WSP(bf16_t, P_XWKV_T) + (size_t)l * 2048 * 1024, 0, RM_IDENT, 1.f, 0, scr, gw, ngw, lane);
    convert_mats(p.in[25] + (size_t)l * 1024 * 1024, 1024, 1024, 1, 0, WSP(bf16_t, P_XWO_T) + (size_t)l * 1024 * 1024, 0, RM_IDENT, 1.f, 0, scr, gw, ngw, lane);
    convert_rows(p.in[1], WSP(bf16_t, P_MEMB), (size_t)2048 * 1024, blk * NTHR + tid, G * NTHR);
}
__device__ __forceinline__ void conv_router_w(const PV& p, int l, int gt, int ngt) {
    bf16_t* wrt = WSP(bf16_t, P_WRT) + (size_t)l * 2 * 64 * 1024; const float* wre = p.in[28] + (size_t)l * 1024 * 32; const float* wrg = p.in[26] + (size_t)l * 1024 * 4;
    for (int i = gt; i < 64 * 1024; i += ngt) { const int r = i >> 10, k = i & 1023;
        const float v = r < 32 ? wre[k * 32 + r] : (r < 36 ? wrg[k * 4 + (r - 32)] : 0.f);
        const bf16_t h = f2bf(v); wrt[i] = h; wrt[64 * 1024 + i] = f2bf(v - bf2f(h)); }
}
__device__ __forceinline__ void conv_moe_waves(const PV& p, int l, LAS float* scr, int& gw, int ngw, int gt, int ngt, int lane) {
    const size_t wl = (size_t)l * 32 * 1024 * 512;
    convert_mats(p.in[30] + wl, 1024, 512, 32, (size_t)1024 * 512, WSP(bf16_t, P_W13T), (size_t)1024 * 1024, RM_PAIR0, 1.f, 0, scr, gw, ngw, lane);
    convert_mats(p.in[31] + wl, 1024, 512, 32, (size_t)1024 * 512, WSP(bf16_t, P_W13T), (size_t)1024 * 1024, RM_PAIR1, 1.f, 0, scr, gw, ngw, lane);
    convert_mats(p.in[32] + wl, 512, 1024, 32, (size_t)512 * 1024, WSP(bf16_t, P_W2T), (size_t)1024 * 512, RM_IDENT, 1.f, 0, scr, gw, ngw, lane);
    conv_router_w(p, l, gt, ngt);
}
#ifndef TAILQ_XA
#define TAILQ_XA 3
#endif
#ifndef TAILQ_G1
#define TAILQ_G1 4
#endif
#ifndef TAILQ_G2
#define TAILQ_G2 2
#endif
constexpr size_t P_CURSOR_OFF = 15360;
__device__ __forceinline__ void conv_moe1_item(const PV& p, unsigned it, LAS float* scr, int lane, f32x4 (&tv)[8], bool load) {
    const size_t wl = (size_t)32 * 1024 * 512;
    const int mat = it >> 13, r = it & 8191, bt = r >> 8, rr = r & 255;
    if (mat < 2) { const float* W = (mat == 0 ? p.in[30] : p.in[31]) + wl + (size_t)bt * 1024 * 512;
        if (load) ti_load(W, 512, rr >> 4, rr & 15, lane, tv); else ti_store(tv, 1024, WSP(bf16_t, P_TMP + T_W13B) + (size_t)bt * 1024 * 1024, scr, rr >> 4, rr & 15, lane, mat == 0 ? RM_PAIR0 : RM_PAIR1, 1.f, 0); }
    else { const float* W = p.in[32] + wl + (size_t)bt * 512 * 1024;
        if (load) ti_load(W, 1024, rr >> 5, rr & 31, lane, tv); else ti_store(tv, 512, WSP(bf16_t, P_TMP + T_W2B) + (size_t)bt * 1024 * 512, scr, rr >> 5, rr & 31, lane, RM_IDENT, 1.f, 0); }
}
__device__ __forceinline__ void conv_moe1_range(const PV& p, LAS float* scr, int lane, int first, int stride, int last) {
    if (last > 12288) last = 12288;
    if (first >= last) return;
    f32x4 ta[8], tb[8];
    conv_moe1_item(p, 2 * first, scr, lane, ta, true); conv_moe1_item(p, 2 * first + 1, scr, lane, tb, true);
    for (int it = first; it < last; it += stride) {
        const int nx = it + stride; f32x4 na[8], nb[8];
        const int nl = nx < last ? nx : it;
        conv_moe1_item(p, 2 * nl, scr, lane, na, true);
        conv_moe1_item(p, 2 * it, scr, lane, ta, false);
        conv_moe1_item(p, 2 * nl + 1, scr, lane, nb, true);
        conv_moe1_item(p, 2 * it + 1, scr, lane, tb, false);
#pragma unroll
        for (int i = 0; i < 8; ++i) { ta[i] = na[i]; tb[i] = nb[i]; }
    }
}
struct TailPlan { int t0, t1, t2, nidle, first_idle; };
__device__ __forceinline__ TailPlan tail_plan(int ntile, int G) {
    TailPlan t; const int U = ntile * 4, R = (U + G - 1) / G; t.first_idle = U - (R - 1) * G; t.nidle = G - t.first_idle;
    t.t0 = 128 * NWAVE * TAILQ_XA; t.t1 = t.nidle * NWAVE * TAILQ_G1; t.t2 = t.nidle * NWAVE * TAILQ_G2; return t;
}
__device__ __forceinline__ void ph_conv_moe(PH_ARGS, int l, int& gw) {
    PH_IDS; conv_moe_waves(p, l, (LAS float*)(lds + wave * 8448), gw, G * NWAVE, blk * NTHR + tid, G * NTHR, lane);
}
__device__ __forceinline__ void ph_x_to_bf(PH_ARGS) { PH_IDS; convert_rows(p.X, WSP(bf16_t, P_XBF), (size_t)NT * 1024, blk * NTHR + tid, G * NTHR); }

__device__ __forceinline__ void set_job(LAS pg8::JobDesc* jt, int j, const void* A, const void* B, int nM, int nN, void* out, int ldc, int mode, const void* bias = nullptr, const void* rot = nullptr, void* out2 = nullptr) {
    unsigned long long a = (unsigned long long)A, b = (unsigned long long)B, o = (unsigned long long)out, bi = (unsigned long long)bias, ro = (unsigned long long)rot, o2 = (unsigned long long)out2;
    asm volatile("" : "+s"(a), "+s"(b), "+s"(o), "+s"(bi), "+s"(ro), "+s"(o2), "+s"(nM), "+s"(nN), "+s"(ldc), "+s"(mode));
    LAS pg8::JobDesc* d = jt + j; d->A = a; d->B = b; d->out = o; d->bias = bi; d->rot = ro; d->out2 = o2;
    d->nM = nM; d->nN = nN; d->ldc = ldc; d->mode = mode;
}
#define JT_PTR ((LAS pg8::JobDesc*)(lds + pg8::JT_OFF))
__device__ __forceinline__ void run_jobs(LAS unsigned char* lds, int K, int n0, int n1, int n2, int blk, int G) {
    __syncthreads();
    pg8::Jobs3 S; S.jt = JT_PTR; S.n0 = n0; S.n1 = n1; S.n2 = n2; S.K = K; S.G = G; S.c = blk;
    EpiMulti E; E.jt = JT_PTR;
    pg8::gemm_phase<EpiMulti, pg8::Jobs3, true, true>(lds, K, S, E);
}
__device__ __forceinline__ void ph_xattn_g1(PH_ARGS, int l) {
    const bf16_t* wkv = WSP(bf16_t, P_XWKV_T) + (size_t)l * 2048 * 1024;
    __syncthreads();
    if (threadIdx.x == 0) {
        set_job(JT_PTR, 0, WSP(bf16_t, P_MEMB), wkv, 8, 4, WSP(bf16_t, P_KC) + (size_t)l * 2048 * 1024, 1024, EM_PLAIN);
        set_job(JT_PTR, 1, wkv + (size_t)1024 * 1024, WSP(bf16_t, P_MEMB), 4, 8, WSP(bf16_t, P_VT) + (size_t)l * 1024 * 2048, 2048, EM_PLAIN);
        set_job(JT_PTR, 2, WSP(bf16_t, P_XBF), WSP(bf16_t, P_XWQ_T) + (size_t)l * 1024 * 1024, 128, 4, WSP(bf16_t, P_TMP + T_QX), 1024, EM_PLAIN);
    }
    run_jobs(lds, 1024, 32, 32, 512, blk, G);
}
__device__ __forceinline__ void ph_xattn_attn(PH_ARGS, int l) {
    xattn_phase(lds, WSP(bf16_t, P_TMP + T_QX), WSP(bf16_t, P_KC) + (size_t)l * 2048 * 1024, WSP(bf16_t, P_VT) + (size_t)l * 1024 * 2048, WSP(bf16_t, P_TMP + T_OB), blk, G);
}
__device__ __forceinline__ void ph_gemm_plain(PH_ARGS, const bf16_t* A, const bf16_t* Bt, bf16_t* out) {
    __syncthreads();
    if (threadIdx.x == 0) set_job(JT_PTR, 0, A, Bt, 128, 4, out, 1024, EM_PLAIN);
    run_jobs(lds, 1024, 512, 0, 0, blk, G);
}
template <bool XF32, bool OUTF32, bool MOE>
__device__ __forceinline__ void ph_ln(PH_ARGS, const bf16_t* y, int lnidx, bool dry = false) {
    PH_IDS; LnArgs a; a.xin32 = p.in[0]; a.xin = WSP(bf16_t, P_XBF); a.xout32 = dry ? WSP(float, P_TMP + 200 * MB) : p.X; a.xbf = dry ? WSP(bf16_t, P_TMP + 288 * MB) : WSP(bf16_t, P_XBF); a.y = y; a.g = p.in[2] + lnidx * 1024; a.b = p.in[3] + lnidx * 1024;
    a.dest = WSP(int, P_RT + RT_DEST); a.wts = WSP(float, P_RT + RT_W);
    ln_phase<XF32, OUTF32, MOE>(a, blk, G, wave, lane);
}
__device__ __forceinline__ void ph_moe_route(PH_ARGS, int l) {
    moe_router_phase(lds, WSP(bf16_t, P_XBF), WSP(bf16_t, P_WRT) + (size_t)l * 2 * 64 * 1024, p.in[27] + l * 4, p.in[29] + l * 32, route_bufs(p), blk);
}
__device__ __forceinline__ void ph_moe_scatter(PH_ARGS) { moe_scatter_phase(lds, route_bufs(p), blk, G); }
__device__ __forceinline__ void ph_moe_g1(PH_ARGS) {
    __syncthreads();
    if (threadIdx.x == 0) set_job(JT_PTR, 0, nullptr, nullptr, 0, 0, WSP(bf16_t, P_TMP + T_HM), 512, EM_SWIGLU);
    __syncthreads();
    MoeSched S; S.A = (const char*)WSP(bf16_t, P_TMP + T_XG); S.B = (const char*)WSP(bf16_t, P_W13T); S.tstart = WSP(int, P_RT + RT_TSTART); S.K = 1024; S.nN = 4; S.G = G; S.c = blk; S.bexp = (size_t)1024 * 1024 * 2;
    EpiMulti E; E.jt = JT_PTR;
    pg8::gemm_phase<EpiMulti, MoeSched, true, true>(lds, 1024, S, E);
}
__device__ __forceinline__ void ph_moe_g2(PH_ARGS) {
    __syncthreads();
    if (threadIdx.x == 0) set_job(JT_PTR, 0, nullptr, nullptr, 0, 0, WSP(bf16_t, P_TMP + T_YG), 1024, EM_PLAIN);
    __syncthreads();
    MoeSched S; S.A = (const char*)WSP(bf16_t, P_TMP + T_HM); S.B = (const char*)WSP(bf16_t, P_W2T); S.tstart = WSP(int, P_RT + RT_TSTART); S.K = 512; S.nN = 4; S.G = G; S.c = blk; S.bexp = (size_t)1024 * 512 * 2;
    EpiMulti E; E.jt = JT_PTR;
    pg8::gemm_phase<EpiMulti, MoeSched, true, true>(lds, 512, S, E);
}

__device__ __forceinline__ void ph_conv_l1(PH_ARGS, int& gw) {
    PH_IDS; LAS float* scr = (LAS float*)(lds + wave * 8448); const int ngw = G * NWAVE;
    convert_mats(p.in[19], 1024, 1536, 1, 0, WSP(bf16_t, P_WQKV_T), 0, RM_ROT, 0.125f, 1024, scr, gw, ngw, lane);
    convert_mats(p.in[22], 1024, 1024, 1, 0, WSP(bf16_t, P_WO_T), 0, RM_IDENT, 1.f, 0, scr, gw, ngw, lane);
    const int gt = blk * NTHR + tid, ngt = G * NTHR;
    float* bqk = WSP(float, P_BQK);
    for (int n = gt; n < 1280; n += ngt) bqk[rowmap(RM_ROT, n)] = p.in[20][n] * (n < 1024 ? 0.125f : 1.f);
    float* rot = WSP(float, P_ROT);
    for (int i = gt; i < 4096 * 32; i += ngt) { const int pos = i >> 5, k = i & 31; const float inv = powf(10000.f, -(float)(2 * k) / 64.f); const float ang = (float)pos * inv; rot[2 * i] = cosf(ang); rot[2 * i + 1] = sinf(ang); }
}
__device__ __forceinline__ void ph_l1_g1(PH_ARGS) {
    __syncthreads();
    if (threadIdx.x == 0) {
        set_job(JT_PTR, 0, WSP(bf16_t, P_XBF), WSP(bf16_t, P_WQKV_T), 128, 5, WSP(bf16_t, P_TMP + T_QX), 1024, EM_ROTARY, WSP(float, P_BQK), WSP(float, P_ROT), WSP(bf16_t, P_TMP + T_K1));
        set_job(JT_PTR, 1, WSP(bf16_t, P_WQKV_T) + (size_t)1280 * 1024, WSP(bf16_t, P_XBF), 1, 128, WSP(bf16_t, P_TMP + T_VT1), NT, EM_ROWBIAS, p.in[20] + 1280);
    }
    run_jobs(lds, 1024, 640, 128, 0, blk, G);
}
__device__ __forceinline__ void ph_l1_swa(PH_ARGS) {
    swa_phase(lds, WSP(bf16_t, P_TMP + T_QX), WSP(bf16_t, P_TMP + T_K1), WSP(bf16_t, P_TMP + T_VT1), p.in[21], WSP(bf16_t, P_TMP + T_OB), blk, G);
}

__device__ __forceinline__ L0Bufs l0_bufs(const PV& p) {
    L0Bufs B; B.AU = WSP(bf16_t, P_TMP + T_AU); B.AV = WSP(bf16_t, P_TMP + T_AV); B.BX = WSP(bf16_t, P_TMP + T_BX); B.BZ = WSP(bf16_t, P_TMP + T_BZ); B.V = WSP(bf16_t, P_TMP + T_V); B.XC = WSP(bf16_t, P_TMP + T_XC);
    B.YM = WSP(bf16_t, P_TMP + T_YM); B.CS = WSP(bf16_t, P_TMP + T_CS); B.U = WSP(bf16_t, P_TMP + T_U); B.GT = WSP(float, P_TMP + T_GT); B.UN = WSP(float, P_TMP + T_UN); B.NS = WSP(float, P_TMP + T_NS); B.SC = WSP(float, P_TMP + T_SC);
    B.Q = B.AU; B.K = B.AV;
    B.WQT = WSP(bf16_t, P_MLW_T); B.GMW = WSP(bf16_t, P_MLW_T) + 12 * 16384; B.MT = WSP(bf16_t, P_WIFT);
    B.gm_g = p.in[5]; B.gm_b = p.in[6]; B.gm_bs = p.in[8]; B.cw = p.in[9]; B.cb = p.in[10]; B.bif = p.in[15]; B.nw = p.in[16]; B.skip = p.in[17]; return B;
}
__device__ __forceinline__ void ph_scan_conv(PH_ARGS) {
    PH_IDS;
    if (wave < 4) l0_scan(l0_bufs(p), blk, tid);
}
__device__ __forceinline__ void ph_conv_l0(PH_ARGS, int& gwr) {
    PH_IDS; LAS float* scr = (LAS float*)(lds + wave * 8448); const int gw = blk * NWAVE + wave, ngw = G * NWAVE;
    convert_mats(p.in[4], 1024, 2048, 1, 0, WSP(bf16_t, P_WIN_T), 0, RM_IDENT, 1.f, 0, scr, gwr, ngw, lane);
    convert_mats(p.in[18], 1024, 1024, 1, 0, WSP(bf16_t, P_WOUT_T), 0, RM_IDENT, 1.f, 0, scr, gwr, ngw, lane);
    convert_mats(p.in[11], 128, 128, 4, 16384, WSP(bf16_t, P_MLW_T), 16384, RM_IDENT, 1.f, 0, scr, gwr, ngw, lane);
    convert_mats(p.in[12], 128, 128, 4, 16384, WSP(bf16_t, P_MLW_T) + 4 * 16384, 16384, RM_IDENT, 1.f, 0, scr, gwr, ngw, lane);
    convert_mats(p.in[13], 128, 128, 4, 16384, WSP(bf16_t, P_MLW_T) + 8 * 16384, 16384, RM_IDENT, 1.f, 0, scr, gwr, ngw, lane);
    const int gt = blk * NTHR + tid, ngt = G * NTHR;
    bf16_t* gmw = WSP(bf16_t, P_MLW_T) + 12 * 16384;
    for (int i = gt; i < 4 * 16384; i += ngt) { const int t = (i >> 7) & 127, sidx = i & 127; gmw[i] = f2bf(sidx <= t ? p.in[7][i] : 0.f); }
    bf16_t* mt = WSP(bf16_t, P_WIFT);
    for (int i = gw; i < 4 * 8 * 256; i += ngw) { const int h = i >> 11, g = (i >> 8) & 7, j = i & 255, d = j & 127; float a = 0.f;
        for (int e = lane; e < 128; e += 64) {
            if (j < 128) a += p.in[11][((size_t)h * 128 + d) * 128 + e] * p.in[14][(h * 128 + e) * 8 + g] + p.in[12][((size_t)h * 128 + d) * 128 + e] * p.in[14][(512 + h * 128 + e) * 8 + g];
            else a += p.in[13][((size_t)h * 128 + d) * 128 + e] * p.in[14][(1024 + h * 128 + e) * 8 + g]; }
        a += shx(a, 32, lane); a += shx(a, 16, lane); a += shx(a, 8, lane); a += shx(a, 4, lane); a += shx(a, 2, lane); a += shx(a, 1, lane);
        if (lane == 0) mt[i] = f2bf(a); }
}
__device__ __forceinline__ void ph_xin_to_bf(PH_ARGS) { PH_IDS; convert_rows(p.in[0], WSP(bf16_t, P_XBF), (size_t)NT * 1024, blk * NTHR + tid, G * NTHR); }
__device__ __forceinline__ void ph_l0_g1(PH_ARGS) {
    __syncthreads();
    if (threadIdx.x == 0) set_job(JT_PTR, 0, WSP(bf16_t, P_XBF), WSP(bf16_t, P_WIN_T), 128, 8, WSP(bf16_t, P_TMP + T_AU), 512, EM_GELU4);
    run_jobs(lds, 1024, 1024, 0, 0, blk, G);
}

enum { K_CONV_XATTN = 0, K_CONV_MOE, K_X2BF, K_XATTN_G1, K_XATTN_ATTN, K_XATTN_G2, K_LN_Y, K_MOE_ROUTE, K_MOE_SCATTER, K_MOE_G1, K_MOE_G2, K_LN_MOE, K_CONV_L1, K_L1_G1, K_L1_SWA, K_L1_G2, K_CONV_L0, K_XIN2BF, K_L0_G1, K_L0_MIXA, K_L0_SCAN, K_L0_MIXC, K_L0_G2, K_LN_Y0 };
template <int PH>
__global__ void __launch_bounds__(NTHR, 2) k_phase(FP p0, int l, int lnidx) {
    const PV p = make_pv(p0);
    extern __shared__ __attribute__((aligned(16))) unsigned char smem[];
    LAS unsigned char* lds = (LAS unsigned char*)smem;
    const int blk = blockIdx.x, G = gridDim.x;
    if constexpr (PH == K_CONV_XATTN) { int gwr = blk * NWAVE + (threadIdx.x >> 6); ph_conv_xattn(p, lds, blk, G, l, gwr); }
    if constexpr (PH == K_CONV_MOE) { int gwr = blk * NWAVE + (threadIdx.x >> 6); ph_conv_moe(p, lds, blk, G, l, gwr); }
    if constexpr (PH == K_X2BF) ph_x_to_bf(p, lds, blk, G);
    if constexpr (PH == K_XATTN_G1) ph_xattn_g1(p, lds, blk, G, l);
    if constexpr (PH == K_XATTN_ATTN) ph_xattn_attn(p, lds, blk, G, l);
    if constexpr (PH == K_XATTN_G2) ph_gemm_plain(p, lds, blk, G, WSP(bf16_t, P_TMP + T_OB), WSP(bf16_t, P_XWO_T) + (size_t)l * 1024 * 1024, WSP(bf16_t, P_TMP + T_YB));
    if constexpr (PH == K_LN_Y) ph_ln<false, false, false>(p, lds, blk, G, WSP(bf16_t, P_TMP + T_YB), lnidx);
    if constexpr (PH == K_MOE_ROUTE) ph_moe_route(p, lds, blk, G, l);
    if constexpr (PH == K_MOE_SCATTER) ph_moe_scatter(p, lds, blk, G);
    if constexpr (PH == K_MOE_G1) ph_moe_g1(p, lds, blk, G);
    if constexpr (PH == K_MOE_G2) ph_moe_g2(p, lds, blk, G);
    if constexpr (PH == K_LN_MOE) ph_ln<false, false, true>(p, lds, blk, G, WSP(bf16_t, P_TMP + T_YG), lnidx);
    if constexpr (PH == K_CONV_L0) { int gwr = blk * NWAVE + (threadIdx.x >> 6); ph_conv_l0(p, lds, blk, G, gwr); }
    if constexpr (PH == K_XIN2BF) ph_xin_to_bf(p, lds, blk, G);
    if constexpr (PH == K_L0_G1) ph_l0_g1(p, lds, blk, G);
    if constexpr (PH == K_L0_MIXA) l0_mixA(lds, l0_bufs(p), blk, G);
    if constexpr (PH == K_L0_SCAN) ph_scan_conv(p, lds, blk, G);
    if constexpr (PH == K_L0_MIXC) l0_mixC(lds, l0_bufs(p), blk, G);
    if constexpr (PH == K_L0_G2) ph_gemm_plain(p, lds, blk, G, WSP(bf16_t, P_TMP + T_YM), WSP(bf16_t, P_WOUT_T), WSP(bf16_t, P_TMP + T_YB0));
    if constexpr (PH == K_LN_Y0) ph_ln<true, false, false>(p, lds, blk, G, WSP(bf16_t, P_TMP + T_YB0), 0);
    if constexpr (PH == K_CONV_L1) { int gwr = blk * NWAVE + (threadIdx.x >> 6); ph_conv_l1(p, lds, blk, G, gwr); }
    if constexpr (PH == K_L1_G1) ph_l1_g1(p, lds, blk, G);
    if constexpr (PH == K_L1_SWA) ph_l1_swa(p, lds, blk, G);
    if constexpr (PH == K_L1_G2) ph_gemm_plain(p, lds, blk, G, WSP(bf16_t, P_TMP + T_OB), WSP(bf16_t, P_WO_T), WSP(bf16_t, P_TMP + T_YB));
}

#define XB_TMO      128
#define XB_XCNT(j)  (256  + 64 * (j))
#define XB_XSUB(j)  (1280 + 64 * (j))
#define XB_XGEN(j)  (2304 + 64 * (j))
#define XB_TOP      3328
#define XB_TOPGEN   3392
#define XCD_BAR_WORDS 3456
#define XB_SPIN_CAP (1u << 22)
__device__ __forceinline__ unsigned xb_ld(unsigned* p)              { return __hip_atomic_load(p, __ATOMIC_RELAXED, __HIP_MEMORY_SCOPE_AGENT); }
__device__ __forceinline__ unsigned xb_add(unsigned* p, unsigned v) { return __hip_atomic_fetch_add(p, v, __ATOMIC_RELAXED, __HIP_MEMORY_SCOPE_AGENT); }
__device__ __forceinline__ unsigned xb_xcc_id() { return (unsigned)__builtin_amdgcn_s_getreg((3 << 11) | 20) & 0xFu; }
#define XB_SPIN(cond, bar) do { unsigned _sp = 0; while (cond) { __builtin_amdgcn_s_sleep(1); \
    if ((++_sp & 255u) == 0u) { if (xb_ld(&(bar)[XB_TMO])) break; if (_sp > XB_SPIN_CAP) { atomicAdd(&(bar)[XB_TMO], 1u); break; } } } } while (0)
struct XcdBarrier { unsigned* bar; unsigned x; volatile LAS unsigned* st; };
__device__ __forceinline__ XcdBarrier xcd_barrier_post(unsigned* bar, volatile LAS unsigned* st) {
    XcdBarrier b; b.bar = bar; b.x = xb_xcc_id(); b.st = st;
    if (threadIdx.x == 0) (void)xb_add(&bar[XB_XCNT(b.x)], 1u);
    return b;
}
__device__ __forceinline__ void xcd_barrier_complete(unsigned* bar, unsigned x, unsigned& nloc, unsigned& nx) {
    const unsigned G = gridDim.x * gridDim.y * gridDim.z;
    unsigned sum, cnt, mine, sp = 0u;
    for (;;) {
        sum = 0u; cnt = 0u; mine = 0u;
#pragma unroll
        for (unsigned j = 0; j < 16; ++j) { const unsigned c = xb_ld(&bar[XB_XCNT(j)]); sum += c; cnt += (c > 0u) ? 1u : 0u; mine = (j == x) ? c : mine; }
        if (sum == G) break;
        __builtin_amdgcn_s_sleep(1);
        if ((++sp & 255u) == 0u) { if (xb_ld(&bar[XB_TMO])) break; if (sp > XB_SPIN_CAP) { atomicAdd(&bar[XB_TMO], 1u); break; } }
    }
    nloc = mine > 0u ? mine : 1u; nx = cnt > 0u ? cnt : 1u;
}
__device__ __forceinline__ void xcd_barrier(const XcdBarrier& b) {
    asm volatile("s_waitcnt vmcnt(0)" ::: "memory");
    __syncthreads();
    if (threadIdx.x == 0) {
        unsigned* bar = b.bar; asm volatile("" : "+s"(bar));
        __builtin_amdgcn_s_waitcnt(0);
        unsigned nloc = b.st[0], nx = b.st[1];
        if (nloc == 0u) { xcd_barrier_complete(bar, b.x, nloc, nx); b.st[0] = nloc; b.st[1] = nx; }
        const unsigned old = xb_add(&bar[XB_XSUB(b.x)], 1u);
        const unsigned gen = old / nloc;
        if (old + 1u == (gen + 1u) * nloc) {
            __builtin_amdgcn_fence(__ATOMIC_RELEASE, "agent");
            asm volatile("s_waitcnt vmcnt(0)" ::: "memory");
            const unsigned og = xb_add(&bar[XB_TOP], 1u);
            const unsigned tg = og / nx;
            if (og + 1u == (tg + 1u) * nx) xb_add(&bar[XB_TOPGEN], 1u);
            else XB_SPIN(xb_ld(&bar[XB_TOPGEN]) == tg, bar);
            __builtin_amdgcn_fence(__ATOMIC_ACQUIRE, "agent");
            asm volatile("s_waitcnt vmcnt(0)" ::: "memory");
        } else {
            XB_SPIN(xb_ld(&bar[XB_TOPGEN]) == gen, bar);
            __builtin_amdgcn_fence(__ATOMIC_ACQUIRE, "agent");
            asm volatile("s_waitcnt vmcnt(0)" ::: "memory");
        }
    }
    __syncthreads();
}
constexpr int LDS_BARW = LDS_BYTES - 16;

struct SchedAll {
    const LAS pg8::JobDesc* jt; int n0, n1, n2, n3, n4; int K, G, c; int moe; const char* A; const char* B; const int* tstart; const int* src; int nN; size_t bexp;
    __device__ __forceinline__ pg8::Unit get(int i, bool& ok) const {
        const char* ua = nullptr; const char* ub = nullptr; const int* us = nullptr; int upm = 0, upn = 0, ujob = 0; bool good = false;
        if (moe) {
            const int vc = (c & 7) * (G >> 3) + (c >> 3);
            const long L = (long)i * G + vc; const int ntile = tstart[32];
            if (L < (long)ntile * nN) {
                const int mt = (int)(L / nN), nt = (int)(L % nN);
                int e = 0;
                for (int k = 1; k < 32; ++k) if (tstart[k] <= mt) e = k;
                ua = src ? A : A + (size_t)mt * 256 * K * 2; us = src ? src + mt * 256 : nullptr; ub = B + (size_t)e * bexp + (size_t)nt * 256 * K * 2; upm = mt; upn = nt; good = true;
            }
        } else {
            long L = (long)i * G + c;
            if (L < (long)n0 + n1 + n2 + n3 + n4) {
                int l = (int)L; int jb = 0;
                if (l >= n0) { l -= n0; jb = 1; if (l >= n1) { l -= n1; jb = 2; if (l >= n2) { l -= n2; jb = 3; if (l >= n3) { l -= n3; jb = 4; } } } }
                const int jM = __builtin_amdgcn_readfirstlane(jt[jb].nM), jN = __builtin_amdgcn_readfirstlane(jt[jb].nN);
                int pm, pn; pg8::tile_order(l, jM, jN, pm, pn);
                const size_t tstep = (size_t)pg8::BM * K * 2;
                ua = (const char*)pg8::rfl64(jt[jb].A) + (size_t)pm * tstep; ub = (const char*)pg8::rfl64(jt[jb].B) + (size_t)pn * tstep; upm = pm; upn = pn; ujob = jb; good = true;
            }
        }
        pg8::Unit u; u.A = ua; u.B = ub; u.src = us; u.pm = upm; u.pn = upn; u.job = ujob; ok = good; return u;
    }
};
enum { MP_CONV = 0, MP_L0_G1, MP_L0_MIXA, MP_L0_SCAN, MP_L0_MIXC, MP_L0_G2, MP_XA_G1, MP_XA_ATTN, MP_XA_G2, MP_ROUTE, MP_SCATTER, MP_MOE_G1, MP_MOE_G2, MP_LN_MOE, MP_L1_G1, MP_L1_SWA, MP_L1_G2 };
struct SchedLN {
    const char* A; const char* B; int G, c;
    __device__ __forceinline__ pg8::Unit get(int i, bool& ok) const {
        const int L = i * G + c; const bool good = L < 512; int pm = 0, pn = 0; if (good) pg8::tile_order(L, 128, 4, pm, pn);
        const size_t tstep = (size_t)pg8::BM * 1024 * 2;
        pg8::Unit u; u.A = A + (size_t)pm * tstep; u.B = B + (size_t)pn * tstep; u.src = nullptr; u.pm = pm; u.pn = pn; u.job = 0; ok = good; return u;
    }
};
__device__ __forceinline__ int prog_kind(int i) {
    switch (i) { case 0: return MP_CONV; case 1: return MP_L0_G1; case 2: return MP_L0_MIXA; case 3: return MP_L0_SCAN; case 4: return MP_L0_MIXC; case 5: return MP_L0_G2;
        case 6: case 17: return MP_XA_G1; case 7: case 18: return MP_XA_ATTN; case 8: case 19: return MP_XA_G2; case 9: case 20: return MP_ROUTE; case 10: case 21: return MP_SCATTER;
        case 11: case 22: return MP_MOE_G1; case 12: case 23: return MP_MOE_G2; case 13: case 24: return MP_LN_MOE; case 14: return MP_L1_G1; case 15: return MP_L1_SWA; default: return MP_L1_G2; }
}
constexpr int N_PROG = 25;
__global__ void __launch_bounds__(NTHR, 2) mega(FP p0) {
    extern __shared__ __attribute__((aligned(16))) unsigned char smem[];
    LAS unsigned char* lds = (LAS unsigned char*)smem;
    cooperative_groups::grid_group grid = cooperative_groups::this_grid();
    const int blk0 = blockIdx.x, G0 = gridDim.x;
    volatile LAS unsigned* bst = (volatile LAS unsigned*)(lds + LDS_BARW);
    if (threadIdx.x == 0) { bst[0] = 0u; bst[1] = 0u; }
    __syncthreads();
    const XcdBarrier xbar = xcd_barrier_post((unsigned*)(p0.ws + P_BAR), bst);
    int dup = 0; (void)dup;
#pragma unroll 1
    for (int pi = 0; pi < N_PROG; ++pi) {
        int blk = blk0, G = G0; asm volatile("" : "+s"(blk), "+s"(G));
        const PV p = make_pv(p0);
        const int kind = prog_kind(pi), l = pi >= 14 ? 1 : 0;
        const bool is_gemm = kind == MP_L0_G1 || kind == MP_XA_G1 || kind == MP_MOE_G1 || kind == MP_MOE_G2 || kind == MP_L1_G1;
        const bool is_lnf = kind == MP_L0_G2 || kind == MP_XA_G2 || kind == MP_L1_G2;
        if (is_lnf) {
            const int site = kind == MP_L0_G2 ? 0 : (kind == MP_L1_G2 ? 2 : 1 + 2 * l), lnidx = kind == MP_L0_G2 ? 0 : (kind == MP_L1_G2 ? 3 : 1 + 3 * l);
            SchedLN S; S.G = G; S.c = blk;
            S.A = (const char*)(kind == MP_L0_G2 ? WSP(bf16_t, P_TMP + T_YM) : WSP(bf16_t, P_TMP + T_OB));
            S.B = (const char*)(kind == MP_L0_G2 ? WSP(bf16_t, P_WOUT_T) : (kind == MP_L1_G2 ? WSP(bf16_t, P_WO_T) : WSP(bf16_t, P_XWO_T) + (size_t)l * 1024 * 1024));
            __syncthreads();
            #ifdef PROBE_LNV
            const int drym = __builtin_amdgcn_readfirstlane((dup == 0 && (((PROBE_MASK) >> kind) & 1)) ? 1 : 0);
#else
            const int drym = 0;
#endif
            unsigned long long* slp = WSP(unsigned long long, P_TMP + T_SLOT) + (size_t)(site + 4 * drym) * 131072;
            if (threadIdx.x == 0) set_job(JT_PTR, 0, nullptr, nullptr, 128, 4, WSP(bf16_t, P_XBF), 1024, 0, p.in[2] + lnidx * 1024, p.in[3] + lnidx * 1024, nullptr);
            if (threadIdx.x == 0) { JT_PTR->mode = drym; JT_PTR->out2 = (unsigned long long)slp; }
            EpiLN E; E.lds = lds;
            __syncthreads();
            pg8::gemm_phase<EpiLN, SchedLN, true, true>(lds, 1024, S, E);
        } else if (is_gemm) {
            SchedAll S; S.jt = JT_PTR; S.n0 = S.n1 = S.n2 = S.n3 = S.n4 = 0; S.K = 1024; S.G = G; S.c = blk; S.moe = 0; S.A = S.B = nullptr; S.tstart = WSP(int, P_RT + RT_TSTART); S.src = nullptr; S.nN = 4; S.bexp = 0;
            __syncthreads();
            if (threadIdx.x == 0) {
                if (kind == MP_L0_G1) set_job(JT_PTR, 0, WSP(bf16_t, P_XBF), WSP(bf16_t, P_WIN_T), 128, 8, WSP(bf16_t, P_TMP + T_AU), 512, EM_GELU4);
                if (kind == MP_XA_G1) {
                    set_job(JT_PTR, 0, WSP(bf16_t, P_XBF), WSP(bf16_t, P_XWQ_T) + (size_t)l * 1024 * 1024, 128, 4, WSP(bf16_t, P_TMP + T_QX), 1024, EM_PLAIN);
                    if (l == 0) { for (int ll = 0; ll < 2; ++ll) { const bf16_t* wkv = WSP(bf16_t, P_XWKV_T) + (size_t)ll * 2048 * 1024;
                        set_job(JT_PTR, 1 + 2 * ll, WSP(bf16_t, P_MEMB), wkv, 8, 4, WSP(bf16_t, P_KC) + (size_t)ll * 2048 * 1024, 1024, EM_PLAIN);
                        set_job(JT_PTR, 2 + 2 * ll, wkv + (size_t)1024 * 1024, WSP(bf16_t, P_MEMB), 4, 8, WSP(bf16_t, P_VT) + (size_t)ll * 1024 * 2048, 2048, EM_PLAIN); } } }
                if (kind == MP_MOE_G1) set_job(JT_PTR, 0, nullptr, nullptr, 0, 0, WSP(bf16_t, P_TMP + T_HM), 512, EM_SWIGLU);
                if (kind == MP_MOE_G2) set_job(JT_PTR, 0, nullptr, nullptr, 0, 0, WSP(bf16_t, P_TMP + T_YG), 1024, EM_PLAIN);
                if (kind == MP_L1_G1) { set_job(JT_PTR, 0, WSP(bf16_t, P_XBF), WSP(bf16_t, P_WQKV_T), 128, 5, WSP(bf16_t, P_TMP + T_QX), 1024, EM_ROTARY, WSP(float, P_BQK), WSP(float, P_ROT), WSP(bf16_t, P_TMP + T_K1));
                    set_job(JT_PTR, 1, WSP(bf16_t, P_WQKV_T) + (size_t)1280 * 1024, WSP(bf16_t, P_XBF), 1, 128, WSP(bf16_t, P_TMP + T_VT1), NT, EM_ROWBIAS, p.in[20] + 1280); }
#ifdef PROBE_L1PLAIN
                if (kind == MP_L1_G1 && dup == 0) JT_PTR[0].mode = EM_PLAIN;
#endif
            }
            if (kind == MP_L0_G1) S.n0 = 1024;
            if (kind == MP_XA_G1) { S.n0 = 512; if (l == 0) { S.n1 = 32; S.n2 = 32; S.n3 = 32; S.n4 = 32; } }
            if (kind == MP_L1_G1) { S.n0 = 640; S.n1 = 128; }
            if (kind == MP_MOE_G1) { S.moe = 1; S.A = (const char*)WSP(bf16_t, P_XBF); S.src = WSP(int, P_RT + RT_SRC); S.B = (const char*)(l ? WSP(bf16_t, P_TMP + T_W13B) : WSP(bf16_t, P_W13T)); S.bexp = (size_t)1024 * 1024 * 2; }
            if (kind == MP_MOE_G2) { S.moe = 1; S.K = 512; S.A = (const char*)WSP(bf16_t, P_TMP + T_HM); S.B = (const char*)(l ? WSP(bf16_t, P_TMP + T_W2B) : WSP(bf16_t, P_W2T)); S.bexp = (size_t)1024 * 512 * 2; }
            __syncthreads();
            EpiMulti E; E.jt = JT_PTR;
#ifdef PROBE_GEMM2
#pragma unroll 1
            for (int rep = 0; rep < 2; ++rep)
#endif
            pg8::gemm_phase<EpiMulti, SchedAll, true, true>(lds, S.K, S, E);
            if (l == 0 && (kind == MP_XA_G1 || kind == MP_MOE_G1 || kind == MP_MOE_G2)) {
                const TailPlan tp = tail_plan(S.tstart[32], G);
                const int vc = kind == MP_XA_G1 ? blk : (blk & 7) * (G >> 3) + (blk >> 3);
                const int fi = kind == MP_XA_G1 ? 128 : tp.first_idle, quota = kind == MP_MOE_G2 ? TAILQ_G2 : (kind == MP_XA_G1 ? TAILQ_XA : TAILQ_G1), base = kind == MP_XA_G1 ? 0 : (kind == MP_MOE_G1 ? tp.t0 : tp.t0 + tp.t1);
                if (vc >= fi) { const int wv = __builtin_amdgcn_readfirstlane((int)threadIdx.x >> 6); int lq = threadIdx.x & 63; asm volatile("" : "+v"(lq));
                    const int f0 = base + ((vc - fi) * NWAVE + wv) * quota;
                    conv_moe1_range(p, (LAS float*)(lds + wv * 8448), lq, f0, 1, f0 + quota); }
            }
        } else {
#ifdef PROBE_MASK
#define DRY (dup == 0 && (((PROBE_MASK) >> kind) & 1))
#else
#define DRY false
#endif
            switch (kind) {
                case MP_CONV: { int gwr = blk * NWAVE + __builtin_amdgcn_readfirstlane((int)threadIdx.x >> 6);
                    ph_conv_l0(p, lds, blk, G, gwr); ph_conv_l1(p, lds, blk, G, gwr); ph_conv_xattn(p, lds, blk, G, 0, gwr); ph_conv_xattn(p, lds, blk, G, 1, gwr); ph_conv_moe(p, lds, blk, G, 0, gwr); ph_xin_to_bf(p, lds, blk, G); } break;
                case MP_L0_MIXA: { L0Bufs Bx = l0_bufs(p); if (DRY) { Bx.Q = Bx.K = WSP(bf16_t, P_TMP + 288 * MB); } l0_mixA(lds, Bx, blk, G); } break;
                case MP_L0_SCAN: ph_scan_conv(p, lds, blk, G); break;
                case MP_L0_MIXC: l0_mixC(lds, l0_bufs(p), blk, G); break;
                case MP_XA_ATTN: ph_xattn_attn(p, lds, blk, G, l); break;
                case MP_ROUTE: ph_moe_route(p, lds, blk, G, l); break;
                case MP_SCATTER: ph_moe_scatter(p, lds, blk, G); break;
                case MP_LN_MOE: if (l == 0) { ph_ln<false, false, true>(p, lds, blk, G, WSP(bf16_t, P_TMP + T_YG), 2, DRY); if (!(DRY)) { const int wv = __builtin_amdgcn_readfirstlane((int)threadIdx.x >> 6); int lq = threadIdx.x & 63; asm volatile("" : "+v"(lq)); { const TailPlan tp = tail_plan(WSP(int, P_RT + RT_TSTART)[32], G); conv_moe1_range(p, (LAS float*)(lds + wv * 8448), lq, tp.t0 + tp.t1 + tp.t2 + blk * NWAVE + wv, G * NWAVE, 12288); } conv_router_w(p, 1, blk * NTHR + (int)threadIdx.x, G * NTHR); } } else ph_ln<false, true, true>(p, lds, blk, G, WSP(bf16_t, P_TMP + T_YG), 5, DRY); break;
                default: ph_l1_swa(p, lds, blk, G); break;
            }
        }
#ifdef PROBE_MASK
        if (((PROBE_MASK) >> kind) & 1) { if (dup == 0) { dup = 1; xcd_barrier(xbar); --pi; continue; } dup = 0; }
#endif
        if (pi + 1 < N_PROG) { if (p0.ws == nullptr) grid.sync(); else { xcd_barrier(xbar);
#ifdef PROBE_BAR2
            xcd_barrier(xbar);
#endif
        } }
    }
}
}
extern "C" void kernel_launch(void* const* d_in, const int* in_sizes, int n_in, void* d_out, int out_size, void* d_ws, size_t ws_size, hipStream_t stream) {
    static int ok = 0;
    if (ok == 0) {
        ok = -1;
        if (n_in != 33 || out_size != 32768 * 1024 || ws_size < fk::FAST_END + (fk::SLOT_MB - 4) * fk::MB) { fprintf(stderr, "kernel_launch: unexpected shapes/ws (%d, %d, %zu)\n", n_in, out_size, ws_size); return; }
        int dev = 0, cus = 0, per_cu = 0;
        if (hipGetDevice(&dev) != hipSuccess || hipDeviceGetAttribute(&cus, hipDeviceAttributeMultiprocessorCount, dev) != hipSuccess) return;
        if (hipFuncSetAttribute((const void*)fk::mega, hipFuncAttributeMaxDynamicSharedMemorySize, fk::LDS_BYTES) != hipSuccess) return;
        if (hipOccupancyMaxActiveBlocksPerMultiprocessor(&per_cu, (const void*)fk::mega, fk::NTHR, fk::LDS_BYTES) != hipSuccess || per_cu < 1 || cus * per_cu < 256) { fprintf(stderr, "kernel_launch: cannot co-reside 256 workgroups (%d CUs x %d)\n", cus, per_cu); return; }
        ok = 1;
    }
    if (ok < 0) return;
    fk::FP p{}; for (int i = 0; i < 33; ++i) p.in[i] = (const float*)d_in[i]; p.X = (float*)d_out; p.ws = (unsigned char*)d_ws;
    if (hipMemsetAsync((char*)d_ws + fk::P_BAR, 0, 16384, stream) != hipSuccess) return;
    if (hipMemsetAsync((char*)d_ws + fk::P_TMP + fk::T_SLOT, 0xFF, fk::SLOT_MB * fk::MB, stream) != hipSuccess) return;
    void* args[] = {&p};
    hipError_t e = hipLaunchCooperativeKernel((const void*)fk::mega, dim3(256), dim3(fk::NTHR), args, fk::LDS_BYTES, stream);
    if (e != hipSuccess) fprintf(stderr, "cooperative launch failed: %s\n", hipGetErrorString(e));
}
```

```cpp
#include <hip/hip_runtime.h>
#include <hip/hip_cooperative_groups.h>
#include <cstdio>
#include <cstdint>
#include <cmath>
namespace fk {
#define LAS __attribute__((address_space(3)))
typedef unsigned short bf16_t;
typedef short bf16x8 __attribute__((ext_vector_type(8)));
typedef short s16x4 __attribute__((ext_vector_type(4)));
typedef float f32x4 __attribute__((ext_vector_type(4)));
typedef float f32x16 __attribute__((ext_vector_type(16)));
typedef float f32x2 __attribute__((ext_vector_type(2)));
typedef unsigned u32x4 __attribute__((ext_vector_type(4)));
typedef unsigned u32x2 __attribute__((ext_vector_type(2)));
typedef __bf16 bf16x2_t __attribute__((ext_vector_type(2)));

constexpr int NT = 32768, DM = 1024, SEQ = 4096;
constexpr int NTHR = 512, NWAVE = 8;
constexpr float ALPHA = 1.4142135623730951f, LN_EPS = 1e-5f, LOG2E = 1.4426950408889634f;

__device__ __forceinline__ unsigned pk2(float lo, float hi) { f32x2 v = {lo, hi}; bf16x2_t b = __builtin_convertvector(v, bf16x2_t); return __builtin_bit_cast(unsigned, b); }
__device__ __forceinline__ float bf_lo(unsigned w) { return __uint_as_float(w << 16); }
__device__ __forceinline__ float bf_hi(unsigned w) { return __uint_as_float(w & 0xffff0000u); }
__device__ __forceinline__ float bf2f(bf16_t b) { return __uint_as_float(((unsigned)b) << 16); }
__device__ __forceinline__ bf16_t f2bf(float f) { return (bf16_t)(pk2(f, 0.f) & 0xffffu); }
__device__ __forceinline__ float fast_exp(float x) { return __builtin_amdgcn_exp2f(x * LOG2E); }
__device__ __forceinline__ float sigmoid_f(float x) { return __builtin_amdgcn_rcpf(1.f + fast_exp(-x)); }
__device__ __forceinline__ float silu_f(float x) { return x * sigmoid_f(x); }
__device__ __forceinline__ float gelu_tanh_f(float x) { const float u = 1.5957691216057308f * (x + 0.044715f * x * x * x); return x * sigmoid_f(u); }
__device__ __forceinline__ int crow(int r, int hi) { return (r & 3) + 8 * (r >> 2) + 4 * hi; }
__device__ __forceinline__ float xhalf_sum(float v) { auto rr = __builtin_amdgcn_permlane32_swap(__float_as_uint(v), __float_as_uint(v), false, false); return __uint_as_float(rr[0]) + __uint_as_float(rr[1]); }
__device__ __forceinline__ float xhalf_max(float v) { auto rr = __builtin_amdgcn_permlane32_swap(__float_as_uint(v), __float_as_uint(v), false, false); return fmaxf(__uint_as_float(rr[0]), __uint_as_float(rr[1])); }
__device__ __forceinline__ float shx(float v, int o, int lane) { return __int_as_float(__builtin_amdgcn_ds_bpermute((lane ^ o) << 2, __float_as_int(v))); }
__device__ __forceinline__ float shup(float v, int o, int lane) { return __int_as_float(__builtin_amdgcn_ds_bpermute(((lane - o) & 63) << 2, __float_as_int(v))); }
__device__ __forceinline__ float shidx(float v, int idx) { return __int_as_float(__builtin_amdgcn_ds_bpermute(idx << 2, __float_as_int(v))); }
__device__ __forceinline__ s16x4 lds_tr(const LAS void* p) { return __builtin_bit_cast(s16x4, __builtin_amdgcn_ds_read_tr16_b64_v4i16((LAS s16x4*)p)); }
#define MFMA32(a, b, c) __builtin_amdgcn_mfma_f32_32x32x16_bf16((a), (b), (c), 0, 0, 0)

namespace pg8 {
constexpr int BM = 256, BK = 64, HALF = 128, HTB = HALF * BK * 2, STAGE_BYTES = 8 * HTB, NXCD = 8, WGM = 8;
__host__ __device__ __forceinline__ int lds_byte(int r, int c) { const int st = (r >> 4) * 2 + (c >> 5), rr = r & 15, cc = c & 31, ob = rr * 64 + cc * 2; return st * 1024 + (ob ^ (((ob >> 9) & 1) << 5)); }
__host__ __device__ __forceinline__ void stage_rc(int b, int& R, int& C) { const int st = b / 1024, sb = b % 1024, swz = sb ^ (((sb >> 9) & 1) << 5); R = (st >> 1) * 16 + swz / 64; C = (st & 1) * 32 + (swz % 64) / 2; }
__host__ __device__ __forceinline__ int perm32(int rho) { const int n = rho >> 4, i = rho & 15; return 8 * (i >> 2) + 4 * n + (i & 3); }

struct Unit { const char* A; const char* B; const int* src; int pm, pn, job; };

__device__ __forceinline__ void tile_order(int l, int nM, int nN, int& pm, int& pn) {
    const int nwg = nM * nN; int wgid = l;
    { const int q = nwg / NXCD, r = nwg % NXCD, xcd = wgid % NXCD, off = wgid / NXCD; wgid = (xcd < r ? xcd * (q + 1) : r * (q + 1) + (xcd - r) * q) + off; }
    const int nig = WGM * nN, gid = wgid / nig, fm = gid * WGM, gsz = (nM - fm) < WGM ? (nM - fm) : WGM;
    pm = fm + ((wgid % nig) % gsz); pn = (wgid % nig) / gsz;
}
struct JobDesc { unsigned long long A, B, out, bias, rot, out2; int nM, nN, ldc, mode; };
__device__ __forceinline__ unsigned long long rfl64(unsigned long long v) { const unsigned lo = __builtin_amdgcn_readfirstlane((unsigned)v), hi = __builtin_amdgcn_readfirstlane((unsigned)(v >> 32)); return ((unsigned long long)hi << 32) | lo; }
constexpr int JT_OFF = STAGE_BYTES;
struct Jobs3 {
    const LAS JobDesc* jt; int n0, n1, n2; int K, G, c;
    __device__ __forceinline__ Unit get(int i, bool& ok) const { Unit u; u.A = nullptr; u.B = nullptr; u.src = nullptr; u.pm = 0; u.pn = 0; u.job = 0; ok = next(i, u); return u; }
    __device__ __forceinline__ bool next(int i, Unit& u) const {
        long L = (long)i * G + c;
        if (L >= (long)n0 + n1 + n2) return false;
        int l = (int)L; int jb = 0;
        if (l >= n0) { l -= n0; jb = 1; if (l >= n1) { l -= n1; jb = 2; } }
        const int jM = __builtin_amdgcn_readfirstlane(jt[jb].nM), jN = __builtin_amdgcn_readfirstlane(jt[jb].nN);
        int pm, pn; tile_order(l, jM, jN, pm, pn);
        const size_t tstep = (size_t)BM * K * 2;
        u.A = (const char*)rfl64(jt[jb].A) + (size_t)pm * tstep; u.B = (const char*)rfl64(jt[jb].B) + (size_t)pn * tstep; u.src = nullptr; u.pm = pm; u.pn = pn; u.job = jb; return true;
    }
};

template <class Epi, class Sched, bool ALIGN_EPI, bool SP2>
__device__ __forceinline__ void gemm_phase(LAS unsigned char* lds, const int K, const Sched& S, const Epi& E) {
    int tid_ = threadIdx.x; asm volatile("" : "+v"(tid_)); const int tid = tid_, wid = __builtin_amdgcn_readfirstlane(tid >> 6), lane = tid & 63, wr = wid >> 2, wc = wid & 3, fr = lane & 15, fq = lane >> 4;
    const int nt = K / BK;
    static_assert(SP2, "only the two-super-phase form is kept");
    unsigned vA0[2], vA1[2], vB0[2];
#pragma unroll
    for (int i = 0; i < 2; ++i) { int R, C; stage_rc(tid * 16 + i * 8192, R, C); const int Rb = 64 * (R >> 5) + perm32(R & 31); vB0[i] = (unsigned)(Rb * K + C) * 2u; }
    const size_t bhalf = (size_t)32 * K * 2;
    auto a_rows = [&](const int* src, unsigned (&o0)[2], unsigned (&o1)[2]) {
        int tq = threadIdx.x; asm volatile("" : "+v"(tq));
#pragma unroll
        for (int i = 0; i < 2; ++i) { int R, C; stage_rc(tq * 16 + i * 8192, R, C); int r0 = R, r1 = R + HALF; if (src) { r0 = src[R]; r1 = src[R + HALF]; }
            o0[i] = (unsigned)(r0 * K + C) * 2u; o1[i] = (unsigned)(r1 * K + C) * 2u; }
    };
    const size_t kstep = (size_t)(BK * 2);
    const size_t hstep = (size_t)HALF * K * 2;
    const unsigned ldsw = (unsigned)wid * 1024u;
    const int aoff = lds_byte(wr * 64 + fr, fq * 8), boff = lds_byte(wc * 32 + fr, fq * 8);
#define PG8_SA(b, h) (((b) * 2 + (h)) * HTB)
#define PG8_SB(b, h) ((4 + (b) * 2 + (h)) * HTB)
#define PG8_STAGE(bufoff, gbase, voff) do { _Pragma("unroll") for (int _i = 0; _i < 2; ++_i) \
        __builtin_amdgcn_global_load_lds((const unsigned*)((const char*)(gbase) + (voff)[_i]), (LAS unsigned*)(lds + (bufoff) + ldsw + _i * 8192), 16, 0, 0); } while (0)
#define PG8_LDA(dst, b, h) do { _Pragma("unroll") for (int m = 0; m < 4; ++m) _Pragma("unroll") for (int k = 0; k < 2; ++k) dst[m][k] = *(const LAS bf16x8*)(lds + PG8_SA(b, h) + aoff + m * 2048 + k * 1024); } while (0)
#define PG8_LDB(dst, b, h) do { _Pragma("unroll") for (int n = 0; n < 2; ++n) _Pragma("unroll") for (int k = 0; k < 2; ++k) dst[n][k] = *(const LAS bf16x8*)(lds + PG8_SB(b, h) + boff + n * 2048 + k * 1024); } while (0)
#define PG8_MMA(ai, bj, At, Bt) do { __builtin_amdgcn_s_setprio(1); _Pragma("unroll") for (int m = 0; m < 4; ++m) _Pragma("unroll") for (int n = 0; n < 2; ++n) _Pragma("unroll") for (int k = 0; k < 2; ++k) \
        acc[ai][bj][m][n] = __builtin_amdgcn_mfma_f32_16x16x32_bf16(Bt[n][k], At[m][k], acc[ai][bj][m][n], 0, 0, 0); __builtin_amdgcn_s_setprio(0); } while (0)
#define PG8_WAIT_V(n) asm volatile("s_waitcnt vmcnt(" #n ")" ::: "memory")
#define PG8_WAIT_L(n) asm volatile("s_waitcnt lgkmcnt(" #n ")" ::: "memory")
#define PG8_BAR __builtin_amdgcn_s_barrier()
#define PG8_SCHED __builtin_amdgcn_sched_barrier(0)
    auto unif = [](Unit u) { Unit r; r.A = (const char*)rfl64((unsigned long long)u.A); r.B = (const char*)rfl64((unsigned long long)u.B); r.src = (const int*)rfl64((unsigned long long)u.src);
        r.pm = __builtin_amdgcn_readfirstlane(u.pm); r.pn = __builtin_amdgcn_readfirstlane(u.pn); r.job = __builtin_amdgcn_readfirstlane(u.job); return r; };
    int ui = 0; bool ok0; Unit cur = unif(S.get(0, ok0));
    if (!ok0) return;
    f32x4 acc[2][2][4][2];
    E.prefetch(cur, wr, wc, fr, fq);
    bf16x8 At[4][2], B0[2][2], B1[2][2];
    const char* cA = cur.A; const char* cB = cur.B;
    a_rows(cur.src, vA0, vA1);
    {
        PG8_STAGE(PG8_SB(0, 0), cB, vB0); PG8_STAGE(PG8_SB(0, 1), cB + bhalf, vB0); PG8_STAGE(PG8_SA(0, 0), cA, vA0); PG8_STAGE(PG8_SA(0, 1), cA, vA1);
        if (wr == 1) PG8_BAR;
        PG8_WAIT_V(2); PG8_BAR;
        PG8_STAGE(PG8_SB(1, 0), cB + kstep, vB0); PG8_STAGE(PG8_SA(1, 0), cA + kstep, vA0); PG8_STAGE(PG8_SB(1, 1), cB + kstep + bhalf, vB0);
        PG8_WAIT_V(6); PG8_BAR;
    }
    for (;;) {
        E.init(acc);
        bool has_next; const Unit nxt = unif(S.get(ui + 1, has_next)); bool early_done = false;
        const char* nA = has_next ? nxt.A : cA; const char* nB = has_next ? nxt.B : cB;
        for (int t = 0; t < nt; t += 2) {
            const bool last = (t == nt - 2);
            const char* a1 = cA + (size_t)(t + 1) * kstep;
            const char* a2 = last ? nA : cA + (size_t)(t + 2) * kstep; const char* b2 = last ? nB : cB + (size_t)(t + 2) * kstep;
            const char* a3 = a2 + kstep; const char* b3 = b2 + kstep;
            PG8_LDB(B0, 0, 0); PG8_LDB(B1, 0, 1); PG8_SCHED; PG8_LDA(At, 0, 0); PG8_STAGE(PG8_SA(1, 1), a1, vA1);
            if (last && has_next) a_rows(nxt.src, vA0, vA1);
            PG8_WAIT_V(8); PG8_WAIT_L(0); PG8_BAR; PG8_MMA(0, 0, At, B0); PG8_MMA(0, 1, At, B1); PG8_BAR; PG8_SCHED;
            PG8_LDA(At, 0, 1); PG8_STAGE(PG8_SB(0, 0), b2, vB0); PG8_STAGE(PG8_SB(0, 1), b2 + bhalf, vB0); PG8_STAGE(PG8_SA(0, 0), a2, vA0);
            PG8_WAIT_V(8); PG8_WAIT_L(0); PG8_BAR; PG8_MMA(1, 0, At, B0); PG8_MMA(1, 1, At, B1); PG8_BAR; PG8_SCHED;
            PG8_LDB(B0, 1, 0); PG8_LDB(B1, 1, 1); PG8_SCHED; PG8_LDA(At, 1, 0); PG8_STAGE(PG8_SA(0, 1), a2, vA1);
            PG8_WAIT_V(8); PG8_WAIT_L(0); PG8_BAR; PG8_MMA(0, 0, At, B0); PG8_MMA(0, 1, At, B1); PG8_BAR; PG8_SCHED;
            if (last) { early_done = E.early(acc, cur, wr, wc, fr, fq); PG8_SCHED; }
            PG8_LDA(At, 1, 1); PG8_STAGE(PG8_SB(1, 0), b3, vB0); PG8_STAGE(PG8_SB(1, 1), b3 + bhalf, vB0); PG8_STAGE(PG8_SA(1, 0), a3, vA0);
            PG8_WAIT_V(8); PG8_WAIT_L(0); PG8_BAR; PG8_MMA(1, 0, At, B0); PG8_MMA(1, 1, At, B1); PG8_BAR; PG8_SCHED;
        }
        if constexpr (ALIGN_EPI) { if (wr == 0) PG8_BAR; }
        E.prefetch(nxt, wr, wc, fr, fq);
        if (!early_done) E.template half<0>(acc, cur, wr, wc, fr, fq);
        E.template half<1>(acc, cur, wr, wc, fr, fq);
        if (!has_next) break;
        cur = nxt; cA = nA; cB = nB; ++ui;
        if constexpr (ALIGN_EPI) { if (wr == 1) PG8_BAR; }
    }
    PG8_WAIT_V(0);
    if constexpr (!ALIGN_EPI) { if (wr == 0) PG8_BAR; }
    PG8_BAR;
#undef PG8_SA
#undef PG8_SB
#undef PG8_STAGE
#undef PG8_LDA
#undef PG8_LDB
#undef PG8_MMA
#undef PG8_WAIT_V
#undef PG8_WAIT_L
#undef PG8_BAR
#undef PG8_SCHED
}
}
enum { EM_PLAIN = 0, EM_GELU4 = 1, EM_SWIGLU = 2, EM_ROTARY = 3, EM_ROWBIAS = 4 };
struct EpiMulti {
    static constexpr bool PERM = true;
    const LAS pg8::JobDesc* jt;
    __device__ __forceinline__ void prefetch(const pg8::Unit&, int, int, int, int) const {}
    __device__ __forceinline__ void init(f32x4 (&acc)[2][2][4][2]) const {
#pragma unroll
        for (int a = 0; a < 2; ++a)
#pragma unroll
            for (int b = 0; b < 2; ++b)
#pragma unroll
                for (int m = 0; m < 4; ++m)
#pragma unroll
                    for (int n = 0; n < 2; ++n) acc[a][b][m][n] = (f32x4){0.f, 0.f, 0.f, 0.f};
    }
    __device__ __forceinline__ bool early(const f32x4 (&acc)[2][2][4][2], const pg8::Unit& u, int wr, int wc, int fr, int fq) const {
        const LAS pg8::JobDesc* jd = jt + u.job;
        if (__builtin_amdgcn_readfirstlane(jd->mode) != EM_PLAIN) return false;
        bf16_t* out = (bf16_t*)pg8::rfl64(jd->out); const int ldc = __builtin_amdgcn_readfirstlane(jd->ldc);
        bf16_t* rowp = out + (size_t)(u.pm * 256 + wr * 64 + fr) * ldc + u.pn * 256 + wc * 64 + 8 * fq;
#pragma unroll
        for (int m = 0; m < 4; ++m)
#pragma unroll
            for (int bj = 0; bj < 2; ++bj) { const f32x4 v0 = acc[0][bj][m][0], v1 = acc[0][bj][m][1];
                u32x4 w; w.x = pk2(v0[0], v0[1]); w.y = pk2(v0[2], v0[3]); w.z = pk2(v1[0], v1[1]); w.w = pk2(v1[2], v1[3]);
                *(u32x4*)(rowp + (size_t)m * 16 * ldc + bj * 32) = w; }
        return true;
    }
    template <int AI>
    __device__ __forceinline__ void half(const f32x4 (&acc)[2][2][4][2], const pg8::Unit& u, int wr, int wc, int fr, int fq) const {
        const LAS pg8::JobDesc* jd = jt + u.job;
        bf16_t* out = (bf16_t*)pg8::rfl64(jd->out);
        const int ldc = __builtin_amdgcn_readfirstlane(jd->ldc);
        const int mode = __builtin_amdgcn_readfirstlane(jd->mode);
        const float* bias = (const float*)pg8::rfl64(jd->bias);
        const int row0 = u.pm * 256 + wr * 64 + fr;
        const int colt = u.pn * 256 + wc * 64 + 8 * fq;
        if (mode == EM_PLAIN || mode == EM_ROWBIAS) {
#pragma unroll
            for (int ai = AI; ai < AI + 1; ++ai)
#pragma unroll
                for (int m = 0; m < 4; ++m) { const int row = row0 + ai * 128 + m * 16; const float rb = (mode == EM_ROWBIAS && bias) ? bias[row] : 0.f;
                    bf16_t* rowp = out + (size_t)row * ldc + colt;
#pragma unroll
                    for (int bj = 0; bj < 2; ++bj) { const f32x4 v0 = acc[ai][bj][m][0] + rb, v1 = acc[ai][bj][m][1] + rb;
                        u32x4 w; w.x = pk2(v0[0], v0[1]); w.y = pk2(v0[2], v0[3]); w.z = pk2(v1[0], v1[1]); w.w = pk2(v1[2], v1[3]);
                        *(u32x4*)(rowp + bj * 32) = w; } }
        } else if (mode == EM_GELU4) {
            const int arr = u.pn >> 1; bf16_t* base = out + (size_t)arr * NT * 512; const int col = colt - arr * 512; const bool act = arr < 2;
#pragma unroll
            for (int ai = AI; ai < AI + 1; ++ai)
#pragma unroll
                for (int m = 0; m < 4; ++m) { bf16_t* rowp = base + (size_t)(row0 + ai * 128 + m * 16) * 512 + col;
#pragma unroll
                    for (int bj = 0; bj < 2; ++bj) { f32x4 v0 = acc[ai][bj][m][0], v1 = acc[ai][bj][m][1];
                        if (act) {
#pragma unroll
                            for (int e = 0; e < 4; ++e) { v0[e] = gelu_tanh_f(v0[e]); v1[e] = gelu_tanh_f(v1[e]); } }
                        u32x4 w; w.x = pk2(v0[0], v0[1]); w.y = pk2(v0[2], v0[3]); w.z = pk2(v1[0], v1[1]); w.w = pk2(v1[2], v1[3]);
                        *(u32x4*)(rowp + bj * 32) = w; } }
        } else if (mode == EM_SWIGLU) {
#pragma unroll
            for (int ai = AI; ai < AI + 1; ++ai)
#pragma unroll
                for (int m = 0; m < 4; ++m) { bf16_t* rowp = out + (size_t)(row0 + ai * 128 + m * 16) * ldc + (colt >> 1);
#pragma unroll
                    for (int bj = 0; bj < 2; ++bj) { const f32x4 v0 = acc[ai][bj][m][0], v1 = acc[ai][bj][m][1];
                        u32x2 w; w.x = pk2(silu_f(v0[0]) * v0[1], silu_f(v0[2]) * v0[3]); w.y = pk2(silu_f(v1[0]) * v1[1], silu_f(v1[2]) * v1[3]);
                        *(u32x2*)(rowp + bj * 16) = w; } }
        } else {
            const float* rot = (const float*)pg8::rfl64(jd->rot);
            bf16_t* out2 = (bf16_t*)pg8::rfl64(jd->out2);
            const bool isk = u.pn >= 4; bf16_t* base = isk ? out2 : out; const int ld = isk ? 256 : 1024; const int colo = isk ? colt - 1024 : colt;
            float bv[2][8];
#pragma unroll
            for (int bj = 0; bj < 2; ++bj) { f32x4 b0 = (f32x4){0.f, 0.f, 0.f, 0.f}, b1 = b0; if (bias) { b0 = *(const f32x4*)(bias + colt + bj * 32); b1 = *(const f32x4*)(bias + colt + bj * 32 + 4); }
#pragma unroll
                for (int e = 0; e < 4; ++e) { bv[bj][e] = b0[e]; bv[bj][4 + e] = b1[e]; } }
            const int i0 = (colt & 63) >> 1;
#pragma unroll
            for (int ai = AI; ai < AI + 1; ++ai)
#pragma unroll
                for (int m = 0; m < 4; ++m) { const int row = row0 + ai * 128 + m * 16; const int pos = row & (SEQ - 1);
                    bf16_t* rowp = base + (size_t)row * ld + colo;
#pragma unroll
                    for (int bj = 0; bj < 2; ++bj) { f32x4 v0 = acc[ai][bj][m][0], v1 = acc[ai][bj][m][1];
                        const f32x4 cs0 = *(const f32x4*)(rot + ((size_t)pos * 32 + i0 + 16 * bj) * 2), cs1 = *(const f32x4*)(rot + ((size_t)pos * 32 + i0 + 16 * bj + 2) * 2);
#pragma unroll
                        for (int e = 0; e < 4; ++e) { v0[e] += bv[bj][e]; v1[e] += bv[bj][4 + e]; }
                        const float a0 = v0[0] * cs0[0] - v0[1] * cs0[1], b0 = v0[1] * cs0[0] + v0[0] * cs0[1];
                        const float a1 = v0[2] * cs0[2] - v0[3] * cs0[3], b1 = v0[3] * cs0[2] + v0[2] * cs0[3];
                        const float a2 = v1[0] * cs1[0] - v1[1] * cs1[1], b2 = v1[1] * cs1[0] + v1[0] * cs1[1];
                        const float a3 = v1[2] * cs1[2] - v1[3] * cs1[3], b3 = v1[3] * cs1[2] + v1[2] * cs1[3];
                        u32x4 w; w.x = pk2(a0, b0); w.y = pk2(a1, b1); w.z = pk2(a2, b2); w.w = pk2(a3, b3);
                        *(u32x4*)(rowp + bj * 32) = w; } }
        }
    }
};

#define GAS __attribute__((address_space(1)))
#define P_TMP_PROBE (194ull * 1048576ull)
constexpr int LNF_PART = pg8::JT_OFF + 1024;
constexpr int LNF_STAT = LNF_PART + 8192;
struct EpiLN {
    static constexpr bool PERM = true;
    LAS unsigned char* lds;
    mutable u32x4 pre[2][4][2];
    __device__ __forceinline__ void prefetch(const pg8::Unit& u, int, int, int, int) const {
        int tq = threadIdx.x; asm volatile("" : "+v"(tq)); const int wq = __builtin_amdgcn_readfirstlane(tq >> 6), wr = wq >> 2, wc = wq & 3, fr = tq & 15, fq = (tq & 63) >> 4;
        const unsigned long long xio = pg8::rfl64(((const LAS pg8::JobDesc*)(lds + pg8::JT_OFF))->out);
        const GAS unsigned char* tb = (const GAS unsigned char*)(xio + ((size_t)u.pm * 256 * 1024 + u.pn * 256) * 2);
        const unsigned loff = (unsigned)((wr * 64 + fr) * 1024 + wc * 64 + 8 * fq) * 2u;
#pragma unroll
        for (int ai = 0; ai < 2; ++ai)
#pragma unroll
            for (int m = 0; m < 4; ++m)
#pragma unroll
                for (int bj = 0; bj < 2; ++bj) pre[ai][m][bj] = *(const GAS u32x4*)(tb + (ai * 128 + m * 16) * 2048 + bj * 64 + loff);
    }
    __device__ __forceinline__ void init(f32x4 (&acc)[2][2][4][2]) const {
#pragma unroll
        for (int ai = 0; ai < 2; ++ai)
#pragma unroll
            for (int m = 0; m < 4; ++m)
#pragma unroll
                for (int bj = 0; bj < 2; ++bj) { const u32x4 w = pre[ai][m][bj];
                    acc[ai][bj][m][0] = (f32x4){ALPHA * bf_lo(w.x), ALPHA * bf_hi(w.x), ALPHA * bf_lo(w.y), ALPHA * bf_hi(w.y)};
                    acc[ai][bj][m][1] = (f32x4){ALPHA * bf_lo(w.z), ALPHA * bf_hi(w.z), ALPHA * bf_lo(w.w), ALPHA * bf_hi(w.w)};
                    __builtin_amdgcn_sched_barrier(0); }
    }
    __device__ __forceinline__ bool early(const f32x4 (&)[2][2][4][2], const pg8::Unit&, int, int, int, int) const { return false; }
    template <int AI>
    __device__ __forceinline__ void half(f32x4 (&acc)[2][2][4][2], const pg8::Unit& u, int, int, int, int) const {
        int tid_ = threadIdx.x; asm volatile("" : "+v"(tid_)); const int tid = tid_, lane = tid & 63;
        const int wq = __builtin_amdgcn_readfirstlane(tid >> 6), wr = wq >> 2, wc = wq & 3, fr = lane & 15, fq = lane >> 4;
        const int colt = u.pn * 256 + wc * 64 + 8 * fq;
        LAS f32x2* part = (LAS f32x2*)(lds + LNF_PART);
        LAS f32x2* stat = (LAS f32x2*)(lds + LNF_STAT);
#pragma unroll
        for (int m = 0; m < 4; ++m) { const int rl = AI * 128 + wr * 64 + m * 16 + fr;
            float s1 = 0.f, s2 = 0.f;
#pragma unroll
            for (int bj = 0; bj < 2; ++bj) { const f32x4 v0 = acc[AI][bj][m][0], v1 = acc[AI][bj][m][1];
#pragma unroll
                for (int e = 0; e < 4; ++e) { s1 += v0[e] + v1[e]; s2 += v0[e] * v0[e] + v1[e] * v1[e]; } }
            s1 += shx(s1, 16, lane); s2 += shx(s2, 16, lane); s1 += shx(s1, 32, lane); s2 += shx(s2, 32, lane);
            if (fq == 0) part[rl * 4 + wc] = (f32x2){s1, s2}; }
        if constexpr (AI == 1) {
            __syncthreads();
            if (tid < 256) {
                const f32x2 p0 = part[tid * 4], p1 = part[tid * 4 + 1], p2 = part[tid * 4 + 2], p3 = part[tid * 4 + 3];
                const float t1 = (p0[0] + p1[0]) + (p2[0] + p3[0]), t2 = (p0[1] + p1[1]) + (p2[1] + p3[1]);
                unsigned long long* sl = (unsigned long long*)pg8::rfl64(((const LAS pg8::JobDesc*)(lds + pg8::JT_OFF))->out2) + (size_t)u.pm * 1024 + tid;
#ifdef PROBE_LNV
                const bool dryp = __builtin_amdgcn_readfirstlane(((const LAS pg8::JobDesc*)(lds + pg8::JT_OFF))->mode) != 0;
#endif
                __hip_atomic_store(sl + u.pn * 256, ((unsigned long long)__float_as_uint(t2) << 32) | __float_as_uint(t1), __ATOMIC_RELAXED, __HIP_MEMORY_SCOPE_AGENT);
                unsigned long long x0, x1, x2, x3; unsigned sp = 0;
                for (;;) {
                    x0 = __hip_atomic_load(sl, __ATOMIC_RELAXED, __HIP_MEMORY_SCOPE_AGENT); x1 = __hip_atomic_load(sl + 256, __ATOMIC_RELAXED, __HIP_MEMORY_SCOPE_AGENT);
                    x2 = __hip_atomic_load(sl + 512, __ATOMIC_RELAXED, __HIP_MEMORY_SCOPE_AGENT); x3 = __hip_atomic_load(sl + 768, __ATOMIC_RELAXED, __HIP_MEMORY_SCOPE_AGENT);
                    if ((x0 != ~0ull && x1 != ~0ull && x2 != ~0ull && x3 != ~0ull) || ++sp > (1u << 22)) break;
#ifdef PROBE_LNV
                    if (dryp && ((PROBE_LNV) & 1)) break;
#endif
                    __builtin_amdgcn_s_sleep(1); }
#ifdef PROBE_LNX
                {   unsigned long long* sl2 = sl + 4 * 131072;
                    __hip_atomic_store(sl2 + u.pn * 256, ((unsigned long long)__float_as_uint(t2) << 32) | __float_as_uint(t1), __ATOMIC_RELAXED, __HIP_MEMORY_SCOPE_AGENT);
                    unsigned long long y0, y1, y2, y3; unsigned sq = 0;
                    for (;;) { y0 = __hip_atomic_load(sl2, __ATOMIC_RELAXED, __HIP_MEMORY_SCOPE_AGENT); y1 = __hip_atomic_load(sl2 + 256, __ATOMIC_RELAXED, __HIP_MEMORY_SCOPE_AGENT);
                        y2 = __hip_atomic_load(sl2 + 512, __ATOMIC_RELAXED, __HIP_MEMORY_SCOPE_AGENT); y3 = __hip_atomic_load(sl2 + 768, __ATOMIC_RELAXED, __HIP_MEMORY_SCOPE_AGENT);
                        if ((y0 != ~0ull && y1 != ~0ull && y2 != ~0ull && y3 != ~0ull) || ++sq > (1u << 22)) break;
                        __builtin_amdgcn_s_sleep(1); }
                    if (y0 == 0x123456789ull) x0 = y1; }
#endif
                const float S1 = (__uint_as_float((unsigned)x0) + __uint_as_float((unsigned)x1)) + (__uint_as_float((unsigned)x2) + __uint_as_float((unsigned)x3));
                const float S2 = (__uint_as_float((unsigned)(x0 >> 32)) + __uint_as_float((unsigned)(x1 >> 32))) + (__uint_as_float((unsigned)(x2 >> 32)) + __uint_as_float((unsigned)(x3 >> 32)));
                const float mean = S1 * (1.f / 1024.f); const float var = fmaxf(S2 * (1.f / 1024.f) - mean * mean, 0.f);
                stat[tid] = (f32x2){mean, __builtin_amdgcn_rsqf(var + LN_EPS)};
            }
            __syncthreads();
            const LAS pg8::JobDesc* jd = (const LAS pg8::JobDesc*)(lds + pg8::JT_OFF);
#ifdef PROBE_LNV
            const bool dryp2 = __builtin_amdgcn_readfirstlane(jd->mode) != 0;
#endif
            const unsigned long long xio = pg8::rfl64(jd->out); const float* g = (const float*)pg8::rfl64(jd->bias); const float* b = (const float*)pg8::rfl64(jd->rot);
            GAS unsigned char* tb = (GAS unsigned char*)(xio + ((size_t)u.pm * 256 * 1024 + u.pn * 256) * 2); const unsigned loff = (unsigned)((wr * 64 + fr) * 1024 + wc * 64 + 8 * fq) * 2u;
#pragma unroll
            for (int bj = 0; bj < 2; ++bj) {
                __builtin_amdgcn_sched_barrier(0);
                const f32x4 g0 = *(const GAS f32x4*)((const GAS float*)g + colt + bj * 32), g1 = *(const GAS f32x4*)((const GAS float*)g + colt + bj * 32 + 4), b0 = *(const GAS f32x4*)((const GAS float*)b + colt + bj * 32), b1 = *(const GAS f32x4*)((const GAS float*)b + colt + bj * 32 + 4);
                f32x2 stn = stat[wr * 64 + fr];
#pragma unroll
                for (int am = 0; am < 8; ++am) { const int ai = am >> 2, m = am & 3; const int rl = ai * 128 + wr * 64 + m * 16 + fr; const f32x2 st = stn;
                    if (am < 7) stn = stat[((am + 1) >> 2) * 128 + wr * 64 + ((am + 1) & 3) * 16 + fr];
                    const float sc = st[1], sh = -st[0] * st[1];
                    const f32x4 v0 = (acc[ai][bj][m][0] * sc + sh) * g0 + b0, v1 = (acc[ai][bj][m][1] * sc + sh) * g1 + b1;
                    u32x4 w; w.x = pk2(v0[0], v0[1]); w.y = pk2(v0[2], v0[3]); w.z = pk2(v1[0], v1[1]); w.w = pk2(v1[2], v1[3]);
#ifdef PROBE_LNV
                    if (!(dryp2 && ((PROBE_LNV) & 2)))
                    *(GAS u32x4*)(tb + (dryp2 ? (size_t)P_TMP_PROBE : (size_t)0) + (ai * 128 + m * 16) * 2048 + bj * 64 + loff) = w;
#else
                    *(GAS u32x4*)(tb + (ai * 128 + m * 16) * 2048 + bj * 64 + loff) = w;
#endif
#ifdef PROBE_LNS
                    *(GAS u32x4*)(tb + ((size_t)P_TMP_PROBE) + (ai * 128 + m * 16) * 2048 + bj * 64 + loff) = w;
#endif
                    __builtin_amdgcn_sched_barrier(0); }
            }
        }
    }
};
enum { RM_IDENT = 0, RM_ROT = 1, RM_PAIR0 = 2, RM_PAIR1 = 3 };
__device__ __forceinline__ int rowmap(int kind, int n) {
    if (kind == RM_ROT) { if (n >= 1280) return n; const int d = n & 63; return (n & ~63) + 2 * (d & 31) + (d >> 5); }
    if (kind == RM_PAIR0) return 2 * n;
    if (kind == RM_PAIR1) return 2 * n + 1;
    return n;
}
__device__ __forceinline__ void ti_load(const float* __restrict__ W, int ldw, int kb, int nb, int lane, f32x4 (&tv)[8]) {
    const int k0 = 64 * kb, n0 = 32 * nb;
#pragma unroll
    for (int i = 0; i < 8; ++i) { const int kk = 8 * i + (lane >> 3); tv[i] = *(const f32x4*)(W + (size_t)(k0 + kk) * ldw + n0 + 4 * (lane & 7)); }
}
__device__ __forceinline__ void ti_store(const f32x4 (&tv)[8], int K, bf16_t* __restrict__ WT, LAS float* scr, int kb, int nb, int lane, int kind, float scale, int nscale) {
    const int k0 = 64 * kb, n0 = 32 * nb;
#pragma unroll
    for (int i = 0; i < 8; ++i) { const int kk = 8 * i + (lane >> 3); LAS float* d = scr + kk * 33 + 4 * (lane & 7); d[0] = tv[i][0]; d[1] = tv[i][1]; d[2] = tv[i][2]; d[3] = tv[i][3]; }
    __builtin_amdgcn_s_waitcnt(0xc07f); asm volatile("" ::: "memory");
    const int c = lane & 7;
#pragma unroll
    for (int j = 0; j < 4; ++j) { const int n = (lane >> 3) + 8 * j; const LAS float* s = scr + (8 * c) * 33 + n; const float sc = (n0 + n) < nscale ? scale : 1.f;
        u32x4 o; o.x = pk2(s[0 * 33] * sc, s[1 * 33] * sc); o.y = pk2(s[2 * 33] * sc, s[3 * 33] * sc); o.z = pk2(s[4 * 33] * sc, s[5 * 33] * sc); o.w = pk2(s[6 * 33] * sc, s[7 * 33] * sc);
        *(u32x4*)(WT + (size_t)rowmap(kind, n0 + n) * K + k0 + 8 * c) = o; }
    __builtin_amdgcn_s_waitcnt(0xc07f); asm volatile("" ::: "memory");
}
__device__ __forceinline__ void convert_mats(const float* W, int K, int N, int nbat, size_t sstr, bf16_t* WT, size_t dstr, int kind, float scale, int nscale, LAS float* scr, int& gwr, int ngw, int lane) {
    const int nblk = N / 32, per = (K / 64) * nblk, total = per * nbat;
    const int gw = gwr; gwr = (gw + ngw - total % ngw) % ngw;
    if (gw >= total) return;
    f32x4 cur[8], nxt[8];
    { const int bt = gw / per, r = gw - bt * per; ti_load(W + (size_t)bt * sstr, N, r / nblk, r % nblk, lane, cur); }
    for (int it = gw; it < total; it += ngw) {
        const int in = it + ngw; const bool more = in < total;
        if (more) { const int bt = in / per, r = in - bt * per; ti_load(W + (size_t)bt * sstr, N, r / nblk, r % nblk, lane, nxt); }
        { const int bt = it / per, r = it - bt * per; ti_store(cur, K, WT + (size_t)bt * dstr, scr, r / nblk, r % nblk, lane, kind, scale, nscale); }
#pragma unroll
        for (int i = 0; i < 8; ++i) cur[i] = nxt[i];
    }
}
__device__ __forceinline__ void convert_rows(const float* __restrict__ src, bf16_t* __restrict__ dst, size_t n, int gt, int ngt) {
    const size_t step = (size_t)ngt * 8; size_t i = (size_t)gt * 8;
    for (; i + 3 * step < n; i += 4 * step) { f32x4 a[4], b[4];
#pragma unroll
        for (int j = 0; j < 4; ++j) { a[j] = *(const f32x4*)(src + i + j * step); b[j] = *(const f32x4*)(src + i + j * step + 4); }
#pragma unroll
        for (int j = 0; j < 4; ++j) { u32x4 o; o.x = pk2(a[j][0], a[j][1]); o.y = pk2(a[j][2], a[j][3]); o.z = pk2(b[j][0], b[j][1]); o.w = pk2(b[j][2], b[j][3]); *(u32x4*)(dst + i + j * step) = o; } }
    for (; i < n; i += step) { const f32x4 a = *(const f32x4*)(src + i), b = *(const f32x4*)(src + i + 4);
        u32x4 o; o.x = pk2(a[0], a[1]); o.y = pk2(a[2], a[3]); o.z = pk2(b[0], b[1]); o.w = pk2(b[2], b[3]); *(u32x4*)(dst + i) = o; }
}

struct LnArgs { const float* xin32; const bf16_t* xin; float* xout32; bf16_t* xbf; const bf16_t* y; const float* g; const float* b; const int* dest; const float* wts; };
template <int NR, bool XF32, bool OUTF32, bool MOE>
__device__ __forceinline__ void ln_rows(const LnArgs& a, int row0, int lane) {
    float v[NR][2][8];
    {
        int d0[NR], d1[NR]; float w0[NR], w1[NR];
        if (MOE) {
#pragma unroll
            for (int i = 0; i < NR; ++i) { d0[i] = a.dest[(row0 + i) * 2]; d1[i] = a.dest[(row0 + i) * 2 + 1]; w0[i] = a.wts[(row0 + i) * 2]; w1[i] = a.wts[(row0 + i) * 2 + 1]; }
        }
        f32x4 xf[XF32 ? NR : 1][2][2]; u32x4 xb[XF32 ? 1 : NR][2]; u32x4 p[NR][2], q[MOE ? NR : 1][2];
#pragma unroll
        for (int i = 0; i < NR; ++i) {
            const u32x4* y0 = (const u32x4*)(a.y + (size_t)(MOE ? d0[i] : row0 + i) * DM) + lane; const u32x4* y1 = (const u32x4*)(a.y + (size_t)(MOE ? d1[i] : 0) * DM) + lane;
#pragma unroll
            for (int j = 0; j < 2; ++j) {
                if (XF32) { const f32x4* xr = (const f32x4*)(a.xin32 + (size_t)(row0 + i) * DM) + 2 * lane + 128 * j; xf[XF32 ? i : 0][j][0] = xr[0]; xf[XF32 ? i : 0][j][1] = xr[1]; }
                else xb[XF32 ? 0 : i][j] = ((const u32x4*)(a.xin + (size_t)(row0 + i) * DM) + lane)[64 * j];
                p[i][j] = y0[64 * j]; if (MOE) q[MOE ? i : 0][j] = y1[64 * j]; } }
#pragma unroll
        for (int i = 0; i < NR; ++i)
#pragma unroll
            for (int j = 0; j < 2; ++j) {
                float x[8];
                if (XF32) {
#pragma unroll
                    for (int e = 0; e < 4; ++e) { x[e] = xf[XF32 ? i : 0][j][0][e]; x[4 + e] = xf[XF32 ? i : 0][j][1][e]; } }
                else { const u32x4 w = xb[XF32 ? 0 : i][j]; x[0] = bf_lo(w.x); x[1] = bf_hi(w.x); x[2] = bf_lo(w.y); x[3] = bf_hi(w.y); x[4] = bf_lo(w.z); x[5] = bf_hi(w.z); x[6] = bf_lo(w.w); x[7] = bf_hi(w.w); }
                const u32x4 pw = p[i][j]; const float py[8] = {bf_lo(pw.x), bf_hi(pw.x), bf_lo(pw.y), bf_hi(pw.y), bf_lo(pw.z), bf_hi(pw.z), bf_lo(pw.w), bf_hi(pw.w)};
                if (MOE) { const u32x4 qw = q[MOE ? i : 0][j]; const float qy[8] = {bf_lo(qw.x), bf_hi(qw.x), bf_lo(qw.y), bf_hi(qw.y), bf_lo(qw.z), bf_hi(qw.z), bf_lo(qw.w), bf_hi(qw.w)};
#pragma unroll
                    for (int e = 0; e < 8; ++e) v[i][j][e] = ALPHA * x[e] + w0[i] * py[e] + w1[i] * qy[e]; }
                else {
#pragma unroll
                    for (int e = 0; e < 8; ++e) v[i][j][e] = ALPHA * x[e] + py[e]; }
            }
    }
    float s[NR];
#pragma unroll
    for (int i = 0; i < NR; ++i) { s[i] = 0.f;
#pragma unroll
        for (int j = 0; j < 2; ++j)
#pragma unroll
            for (int e = 0; e < 8; ++e) s[i] += v[i][j][e]; }
#pragma unroll
    for (int o = 1; o < 64; o <<= 1)
#pragma unroll
        for (int i = 0; i < NR; ++i) s[i] += shx(s[i], o, lane);
    float q2[NR];
#pragma unroll
    for (int i = 0; i < NR; ++i) { const float mean = s[i] * (1.f / DM); q2[i] = 0.f;
#pragma unroll
        for (int j = 0; j < 2; ++j)
#pragma unroll
            for (int e = 0; e < 8; ++e) { v[i][j][e] -= mean; q2[i] += v[i][j][e] * v[i][j][e]; } }
#pragma unroll
    for (int o = 1; o < 64; o <<= 1)
#pragma unroll
        for (int i = 0; i < NR; ++i) q2[i] += shx(q2[i], o, lane);
    f32x4 gv[2][2], bv[2][2];
#pragma unroll
    for (int j = 0; j < 2; ++j) { const f32x4* gp = (const f32x4*)a.g + 2 * lane + 128 * j; const f32x4* bp = (const f32x4*)a.b + 2 * lane + 128 * j; gv[j][0] = gp[0]; gv[j][1] = gp[1]; bv[j][0] = bp[0]; bv[j][1] = bp[1]; }
#pragma unroll
    for (int i = 0; i < NR; ++i) { const float rstd = rsqrtf(q2[i] * (1.f / DM) + LN_EPS);
#pragma unroll
        for (int j = 0; j < 2; ++j) { float o[8];
#pragma unroll
            for (int e = 0; e < 8; ++e) o[e] = v[i][j][e] * rstd * gv[j][e >> 2][e & 3] + bv[j][e >> 2][e & 3];
            if (OUTF32) { f32x4* xo = (f32x4*)(a.xout32 + (size_t)(row0 + i) * DM) + 2 * lane + 128 * j; xo[0] = (f32x4){o[0], o[1], o[2], o[3]}; xo[1] = (f32x4){o[4], o[5], o[6], o[7]}; }
            else { u32x4 w; w.x = pk2(o[0], o[1]); w.y = pk2(o[2], o[3]); w.z = pk2(o[4], o[5]); w.w = pk2(o[6], o[7]); ((u32x4*)(a.xbf + (size_t)(row0 + i) * DM) + lane)[64 * j] = w; } } }
}
template <bool XF32, bool OUTF32, bool MOE>
__device__ __forceinline__ void ln_phase(const LnArgs& a, int blk, int G, int wave, int lane) {
    const int per = NT / G, r0 = blk * per, pw = per / NWAVE;
    for (int r = 0; r < pw; r += 4) ln_rows<4, XF32, OUTF32, MOE>(a, r0 + wave * pw + r, lane);
}
__device__ __forceinline__ void xattn_phase(LAS unsigned char* lds, const bf16_t* __restrict__ Q, const bf16_t* __restrict__ KC, const bf16_t* __restrict__ VT, bf16_t* __restrict__ O, int blk, int G) {
    const int tid0 = threadIdx.x, wave = __builtin_amdgcn_readfirstlane(tid0 >> 6);
#define XA_IDS int tid = tid0; asm volatile("" : "+v"(tid)); const int lane = tid & 63, r32 = lane & 31, hh = lane >> 5; const size_t qrow = (size_t)b * SEQ + qb * 256 + wave * 32 + r32; (void)lane; (void)hh; (void)qrow;
    for (int u = blk; u < 512; u += G) {
        int qb = u & 15, h = (u >> 4) & 3, b = u >> 6;
        if (G == 256) { const int x = blk & 7, j = blk >> 3, grp = x * 4 + (u >> 8) * 2 + (j >> 4); qb = j & 15; h = grp & 3; b = grp >> 2; }
        XA_IDS;
        bf16x8 qf[16];
#pragma unroll
        for (int ks = 0; ks < 16; ++ks) qf[ks] = *(const bf16x8*)(Q + qrow * 1024 + h * 256 + ks * 16 + hh * 8);
        __syncthreads();
#pragma unroll
        for (int bt = 0; bt < 2; ++bt) {
            u32x4 t[8];
#pragma unroll
            for (int i = 0; i < 8; ++i) { const int ch = tid + 512 * (bt * 8 + i), row = ch >> 5, c = ch & 31; t[i] = *(const u32x4*)(KC + (size_t)(b * 256 + row) * 1024 + h * 256 + c * 8); }
#pragma unroll
            for (int i = 0; i < 8; ++i) { const int ch = tid + 512 * (bt * 8 + i), row = ch >> 5, c = ch & 31; *(LAS u32x4*)(lds + row * 528 + c * 16) = t[i]; }
        }
        __syncthreads();
        f32x16 s[8];
#pragma unroll
        for (int mt = 0; mt < 8; ++mt)
#pragma unroll
            for (int r = 0; r < 16; ++r) s[mt][r] = 0.f;
        {   const LAS unsigned char* kbp = lds + r32 * 528 + hh * 16;
#pragma unroll
            for (int ks = 0; ks < 16; ++ks)
#pragma unroll
                for (int mt = 0; mt < 8; ++mt) { const bf16x8 a = *(const LAS bf16x8*)(kbp + mt * 32 * 528 + ks * 32); s[mt] = MFMA32(a, qf[ks], s[mt]); }
        }
        float mx = -INFINITY;
#pragma unroll
        for (int mt = 0; mt < 8; ++mt)
#pragma unroll
            for (int r = 0; r < 16; ++r) mx = fmaxf(mx, s[mt][r]);
        mx = xhalf_max(mx);
        float sm = 0.f; const float mxl = mx * LOG2E;
        u32x4 pf[8][2];
#pragma unroll
        for (int mt = 0; mt < 8; ++mt)
#pragma unroll
            for (int r = 0; r < 16; ++r) { const float p = __builtin_amdgcn_exp2f(s[mt][r] * LOG2E - mxl); s[mt][r] = p; sm += p; }
        sm = xhalf_sum(sm);
        {   const float inv = 1.f / sm;
#pragma unroll
            for (int mt = 0; mt < 8; ++mt)
#pragma unroll
                for (int sx = 0; sx < 2; ++sx) pf[mt][sx] = (u32x4){pk2(s[mt][8 * sx] * inv, s[mt][8 * sx + 1] * inv), pk2(s[mt][8 * sx + 2] * inv, s[mt][8 * sx + 3] * inv), pk2(s[mt][8 * sx + 4] * inv, s[mt][8 * sx + 5] * inv), pk2(s[mt][8 * sx + 6] * inv, s[mt][8 * sx + 7] * inv)};
        }
        __syncthreads();
        {   XA_IDS;
#pragma unroll
        for (int bt = 0; bt < 4; ++bt) {
            u32x4 t[4];
#pragma unroll
            for (int i = 0; i < 4; ++i) { const int ch = tid + 512 * (bt * 4 + i), row = ch >> 5, c = ch & 31; t[i] = *(const u32x4*)(VT + (size_t)(h * 256 + row) * 2048 + b * 256 + c * 8); }
#pragma unroll
            for (int i = 0; i < 4; ++i) { const int ch = tid + 512 * (bt * 4 + i), row = ch >> 5, c = ch & 31; LAS u32x2* d = (LAS u32x2*)(lds + row * 520 + c * 16); d[0] = (u32x2){t[i].x, t[i].y}; d[1] = (u32x2){t[i].z, t[i].w}; }
        }
        }
        __syncthreads();
        {   XA_IDS;
        bf16_t* otile = O + ((size_t)b * SEQ + qb * 256 + wave * 32) * 1024 + h * 256 + r32;
#pragma unroll 1
        for (int dh = 0; dh < 2; ++dh) {
            f32x16 o[4];
#pragma unroll
            for (int dt = 0; dt < 4; ++dt)
#pragma unroll
                for (int r = 0; r < 16; ++r) o[dt][r] = 0.f;
            const LAS unsigned char* vb = lds + (dh * 128 + r32) * 520 + 8 * hh;
#pragma unroll
            for (int mt = 0; mt < 8; ++mt)
#pragma unroll
                for (int sx = 0; sx < 2; ++sx) { const int kb = mt * 32 + 16 * sx; const bf16x8 pb = __builtin_bit_cast(bf16x8, pf[mt][sx]);
#pragma unroll
                    for (int dt = 0; dt < 4; ++dt) { const LAS unsigned char* q = vb + dt * 32 * 520 + kb * 2;
                        const s16x4 lo = *(const LAS s16x4*)q, hi = *(const LAS s16x4*)(q + 16);
                        const bf16x8 a = (bf16x8){lo[0], lo[1], lo[2], lo[3], hi[0], hi[1], hi[2], hi[3]}; o[dt] = MFMA32(pb, a, o[dt]); } }
#pragma unroll
            for (int dt = 0; dt < 4; ++dt)
#pragma unroll
                for (int r = 0; r < 16; ++r) otile[(size_t)crow(r, hh) * 1024 + dh * 128 + dt * 32] = f2bf(o[dt][r]);
        }
        }
    }
#undef XA_IDS
}

struct RouteBufs { int* e; float* w; int* rank; int* dest; int* hist; int* tstart; int* src; };
__device__ __forceinline__ void moe_router_phase(LAS unsigned char* lds, const bf16_t* __restrict__ XBF, const bf16_t* __restrict__ WRT, const float* __restrict__ brg, const float* __restrict__ bre, const RouteBufs rb, int blk) {
    int tid_ = threadIdx.x; asm volatile("" : "+v"(tid_)); const int tid = tid_, lane = tid & 63, wave = __builtin_amdgcn_readfirstlane(tid >> 6), r32 = lane & 31, hh = lane >> 5;
    LAS unsigned char* XT = lds; LAS unsigned char* WT = lds + 128 * 528;
    LAS float* LG = (LAS float*)lds;
    LAS int* hist = (LAS int*)(lds + 128 * 65 * 4);
    const int rbk = wave & 3, ct = wave >> 2;
    f32x16 acc;
#pragma unroll
    for (int r = 0; r < 16; ++r) acc[r] = 0.f;
#pragma unroll 1
    for (int kc = 0; kc < 4; ++kc) {
        __syncthreads();
        {   u32x4 tx[8], tw[8];
#pragma unroll
            for (int i = 0; i < 8; ++i) { const int ch = tid + 512 * i, row = ch >> 5, c = ch & 31; tx[i] = *(const u32x4*)(XBF + (size_t)(blk * 128 + row) * 1024 + kc * 256 + c * 8); tw[i] = *(const u32x4*)(WRT + (size_t)row * 1024 + kc * 256 + c * 8); }
#pragma unroll
            for (int i = 0; i < 8; ++i) { const int ch = tid + 512 * i, row = ch >> 5, c = ch & 31; *(LAS u32x4*)(XT + row * 528 + c * 16) = tx[i]; *(LAS u32x4*)(WT + row * 528 + c * 16) = tw[i]; } }
        __syncthreads();
        const LAS unsigned char* ap = XT + (rbk * 32 + r32) * 528 + hh * 16; const LAS unsigned char* bp = WT + (ct * 32 + r32) * 528 + hh * 16;
#pragma unroll
        for (int ks = 0; ks < 16; ++ks) { const bf16x8 a = *(const LAS bf16x8*)(ap + ks * 32), b0 = *(const LAS bf16x8*)(bp + ks * 32), b1 = *(const LAS bf16x8*)(bp + 64 * 528 + ks * 32);
            acc = MFMA32(a, b0, acc); acc = MFMA32(a, b1, acc); }
    }
    __syncthreads();
    if (tid < 32) hist[tid] = 0;
#pragma unroll
    for (int r = 0; r < 16; ++r) LG[(rbk * 32 + crow(r, hh)) * 65 + ct * 32 + r32] = acc[r];
    __syncthreads();
    if (tid < 128) {
        const LAS float* lg = LG + tid * 65; const int tok = blk * 128 + tid;
        float g4[4];
#pragma unroll
        for (int g = 0; g < 4; ++g) g4[g] = lg[32 + g] + brg[g];
        int gi = 0; float gm = g4[0];
#pragma unroll
        for (int g = 1; g < 4; ++g) if (g4[g] > gm) { gm = g4[g]; gi = g; }
        float gs = 0.f;
#pragma unroll
        for (int g = 0; g < 4; ++g) gs += fast_exp(g4[g] - gm);
        const float gate_g = 1.f / gs;
        float le[8];
#pragma unroll
        for (int e = 0; e < 8; ++e) le[e] = lg[gi * 8 + e] + bre[gi * 8 + e];
        int i0 = 0; float v0 = le[0];
#pragma unroll
        for (int e = 1; e < 8; ++e) if (le[e] > v0) { v0 = le[e]; i0 = e; }
        int i1 = 0; float v1 = -INFINITY;
#pragma unroll
        for (int e = 0; e < 8; ++e) if (e != i0 && le[e] > v1) { v1 = le[e]; i1 = e; }
        const float e1 = fast_exp(v1 - v0), p0 = 1.f / (1.f + e1), p1 = e1 * p0;
        const int ex0 = gi * 8 + i0, ex1 = gi * 8 + i1;
        rb.e[tok * 2] = ex0; rb.e[tok * 2 + 1] = ex1; rb.w[tok * 2] = gate_g * p0; rb.w[tok * 2 + 1] = gate_g * p1;
        rb.rank[tok * 2] = atomicAdd((int*)&hist[ex0], 1); rb.rank[tok * 2 + 1] = atomicAdd((int*)&hist[ex1], 1);
    }
    __syncthreads();
    if (tid < 32) rb.hist[blk * 32 + tid] = hist[tid];
}
__device__ __forceinline__ void moe_scatter_phase(LAS unsigned char* lds, const RouteBufs rb, int blk, int G) {
    int tid_ = threadIdx.x; asm volatile("" : "+v"(tid_)); const int tid = tid_, lane = tid & 63, wave = __builtin_amdgcn_readfirstlane(tid >> 6);
    LAS int* sb = (LAS int*)lds;
    __syncthreads();
    {
        const int e = tid & 31, part = tid >> 5; int c[16];
#pragma unroll
        for (int i = 0; i < 16; ++i) c[i] = rb.hist[(part * 16 + i) * 32 + e];
        int tot = 0, base = 0;
#pragma unroll
        for (int i = 0; i < 16; ++i) { tot += c[i]; if (part * 16 + i < blk) base += c[i]; }
        sb[128 + part * 32 + e] = base; sb[128 + 512 + part * 32 + e] = tot; }
    __syncthreads();
    if (tid < 32) { int tot = 0, base = 0;
#pragma unroll
        for (int i = 0; i < 16; ++i) { base += sb[128 + i * 32 + tid]; tot += sb[128 + 512 + i * 32 + tid]; }
        sb[tid] = base; sb[32 + tid] = tot; }
    __syncthreads();
    if (tid == 0) { int acc = 0; for (int e = 0; e < 32; ++e) { sb[64 + e] = acc; if (blk == 0) rb.tstart[e] = acc >> 8; acc += (sb[32 + e] + 255) & ~255; } sb[96] = acc; if (blk == 0) rb.tstart[32] = acc >> 8; }
    __syncthreads();
    if (tid < 256) { const int idx = blk * 256 + tid; const int e = rb.e[idx]; const int d = sb[64 + e] + sb[e] + rb.rank[idx]; rb.dest[idx] = d; rb.src[d] = idx >> 1; }
    if (blk < 32) { const int e = blk; const int lo = sb[64 + e] + sb[32 + e], hi = sb[64 + e] + ((sb[32 + e] + 255) & ~255); for (int r = lo + tid; r < hi; r += NTHR) rb.src[r] = 0; }
}
struct MoeSched {
    const char* A; const char* B; const int* tstart; int K, nN, G, c; size_t bexp;
    __device__ __forceinline__ pg8::Unit get(int i, bool& ok) const { pg8::Unit u; u.A = nullptr; u.B = nullptr; u.src = nullptr; u.pm = 0; u.pn = 0; u.job = 0; ok = next(i, u); return u; }
    __device__ __forceinline__ bool next(int i, pg8::Unit& u) const {
        const int vc = (c & 7) * (G >> 3) + (c >> 3);
        const long L = (long)i * G + vc; const int ntile = tstart[32];
        if (L >= (long)ntile * nN) return false;
        const int mt = (int)(L / nN), nt = (int)(L % nN);
        int e = 0;
        for (int k = 1; k < 32; ++k) if (tstart[k] <= mt) e = k;
        u.A = A + (size_t)mt * 256 * K * 2; u.B = B + (size_t)e * bexp + (size_t)nt * 256 * K * 2; u.src = nullptr; u.pm = mt; u.pn = nt; u.job = 0; return true;
    }
};
__device__ __forceinline__ void swa_phase(LAS unsigned char* lds, const bf16_t* __restrict__ Q1, const bf16_t* __restrict__ K1, const bf16_t* __restrict__ VT1, const float* __restrict__ sinks, bf16_t* __restrict__ O, int blk, int G) {
    int tid_ = threadIdx.x; asm volatile("" : "+v"(tid_)); const int tid = tid_, lane = tid & 63, wave = __builtin_amdgcn_readfirstlane(tid >> 6), r32 = lane & 31, hh = lane >> 5;
    LAS unsigned char* KL = lds;
    LAS unsigned char* VL = lds + 36864;
    for (int u = blk; u < 1024; u += G) {
        int n = u & 31, kvh = (u >> 5) & 3, b = u >> 7;
        if (G == 256) { const int grp = (u >> 8) * 8 + (blk & 7); n = blk >> 3; kvh = grp & 3; b = grp >> 2; }
        const int tokb = b * SEQ + (n - 1) * 128;
        bf16x8 qfa[2][4];
        {   const int g0 = wave >> 1, hq0 = kvh * 4 + g0;
#pragma unroll
            for (int sb = 0; sb < 2; ++sb)
#pragma unroll
                for (int ks = 0; ks < 4; ++ks) qfa[sb][ks] = *(const bf16x8*)(Q1 + ((size_t)b * SEQ + n * 128 + (wave & 1) * 64 + sb * 32 + r32) * 1024 + hq0 * 64 + ks * 16 + hh * 8); }
        __syncthreads();
#pragma unroll
        for (int i = 0; i < 4; ++i) { const int ch = tid + 512 * i; const int key = ch >> 3, c = ch & 7;
            u32x4 v = (u32x4){0u, 0u, 0u, 0u}; if (n > 0 || key >= 128) v = *(const u32x4*)(K1 + (size_t)(tokb + key) * 256 + kvh * 64 + c * 8);
            *(LAS u32x4*)(KL + key * 144 + c * 16) = v; }
#pragma unroll
        for (int i = 0; i < 4; ++i) { const int ch = tid + 512 * i; const int d = ch >> 5, c = ch & 31;
            u32x4 v = (u32x4){0u, 0u, 0u, 0u}; if (n > 0 || c >= 16) v = *(const u32x4*)(VT1 + (size_t)(kvh * 64 + d) * NT + tokb + c * 8);
            LAS u32x2* dp = (LAS u32x2*)(VL + d * 520 + c * 16); dp[0] = (u32x2){v.x, v.y}; dp[1] = (u32x2){v.z, v.w}; }
        __syncthreads();
        const int g = wave >> 1, hq = kvh * 4 + g; const float sink = sinks[hq];
#pragma unroll 1
        for (int sb = 0; sb < 2; ++sb) {
            bf16x8 qf[4];
#pragma unroll
            for (int ks = 0; ks < 4; ++ks) qf[ks] = sb ? qfa[1][ks] : qfa[0][ks];
            const int i0 = (wave & 1) * 64 + sb * 32, jt0 = i0 >> 5;
            const size_t qtok = (size_t)b * SEQ + n * 128 + i0 + r32;
            f32x16 s[5];
#pragma unroll
            for (int t = 0; t < 5; ++t) {
#pragma unroll
                for (int r = 0; r < 16; ++r) s[t][r] = 0.f;
                const LAS unsigned char* kp = KL + ((jt0 + t) * 32 + r32) * 144 + hh * 16;
#pragma unroll
                for (int ks = 0; ks < 4; ++ks) { const bf16x8 a = *(const LAS bf16x8*)(kp + ks * 32); s[t] = MFMA32(a, qf[ks], s[t]); }
            }
            const int qi = i0 + r32;
            float mx = sink;
#pragma unroll
            for (int t = 0; t < 5; ++t)
#pragma unroll
                for (int r = 0; r < 16; ++r) { const int kj = (jt0 + t) * 32 + crow(r, hh); const bool valid = (kj > qi) && (kj <= qi + 128) && (n > 0 || kj >= 128);
                    s[t][r] = valid ? s[t][r] : -INFINITY; mx = fmaxf(mx, s[t][r]); }
            mx = xhalf_max(mx);
            float sm = 0.f; const float mxl = mx * LOG2E;
            u32x4 pf[5][2];
#pragma unroll
            for (int t = 0; t < 5; ++t) {
#pragma unroll
                for (int r = 0; r < 16; ++r) { const float pv = __builtin_amdgcn_exp2f(s[t][r] * LOG2E - mxl); s[t][r] = pv; sm += pv; }
#pragma unroll
                for (int sx = 0; sx < 2; ++sx) pf[t][sx] = (u32x4){pk2(s[t][8 * sx], s[t][8 * sx + 1]), pk2(s[t][8 * sx + 2], s[t][8 * sx + 3]), pk2(s[t][8 * sx + 4], s[t][8 * sx + 5]), pk2(s[t][8 * sx + 6], s[t][8 * sx + 7])};
            }
            sm = xhalf_sum(sm) + __builtin_amdgcn_exp2f(sink * LOG2E - mxl);
            f32x16 o[2];
#pragma unroll
            for (int dt = 0; dt < 2; ++dt)
#pragma unroll
                for (int r = 0; r < 16; ++r) o[dt][r] = 0.f;
#pragma unroll
            for (int t = 0; t < 5; ++t)
#pragma unroll
                for (int sx = 0; sx < 2; ++sx) { const bf16x8 pb = __builtin_bit_cast(bf16x8, pf[t][sx]);
#pragma unroll
                    for (int dt = 0; dt < 2; ++dt) { const LAS unsigned char* q = VL + (dt * 32 + r32) * 520 + ((jt0 + t) * 32 + 16 * sx + 4 * hh) * 2;
                        const s16x4 lo = *(const LAS s16x4*)q, hi = *(const LAS s16x4*)(q + 16);
                        const bf16x8 a = (bf16x8){lo[0], lo[1], lo[2], lo[3], hi[0], hi[1], hi[2], hi[3]}; o[dt] = MFMA32(a, pb, o[dt]); } }
            const float inv = 1.f / sm;
            bf16_t* orow = O + qtok * 1024 + hq * 64 + 4 * hh;
#pragma unroll
            for (int dt = 0; dt < 2; ++dt)
#pragma unroll
                for (int gq = 0; gq < 4; ++gq) { u32x2 w; w.x = pk2(o[dt][4 * gq] * inv, o[dt][4 * gq + 1] * inv); w.y = pk2(o[dt][4 * gq + 2] * inv, o[dt][4 * gq + 3] * inv); *(u32x2*)(orow + dt * 32 + 8 * gq) = w; }
        }
    }
}
constexpr int TS = 272;
template <int STRIDE = TS>
__device__ __forceinline__ bf16x8 tr_frag(const LAS unsigned char* T, int k0, int c0, int lane, bool permuted) {
    const int hh = lane >> 5, blk = (lane >> 4) & 1, q = (lane & 15) >> 2, pp = lane & 3;
    const int r0 = k0 + (permuted ? 4 * hh : 8 * hh) + q, r1 = r0 + (permuted ? 8 : 4);
    const int cb = (c0 + 16 * blk + 4 * pp) * 2;
    const s16x4 lo = lds_tr(T + r0 * STRIDE + cb), hi = lds_tr(T + r1 * STRIDE + cb);
    return (bf16x8){lo[0], lo[1], lo[2], lo[3], hi[0], hi[1], hi[2], hi[3]};
}
__device__ __forceinline__ bf16x8 row_frag(const LAS unsigned char* T, int row, int k0, int hh) { return *(const LAS bf16x8*)(T + row * TS + (k0 + 8 * hh) * 2); }
__device__ __forceinline__ void load_tile128(LAS unsigned char* T, const bf16_t* __restrict__ g, int ld, int tid) {
#pragma unroll
    for (int i = 0; i < 4; ++i) { const int ch = tid + 512 * i, row = ch >> 4, c = ch & 15; *(LAS u32x4*)(T + row * TS + c * 16) = *(const u32x4*)(g + (size_t)row * ld + c * 8); }
}
struct L0Bufs {
    bf16_t *AU, *AV, *BX, *BZ, *V, *XC, *YM, *CS, *Q, *K, *U; float *GT, *UN, *NS, *SC;
    const bf16_t *WQT, *GMW, *MT; const float *gm_g, *gm_b, *gm_bs, *cw, *cb, *bif, *nw, *skip;
};

__device__ __forceinline__ void l0_mixA(LAS unsigned char* lds, const L0Bufs& B, int blk, int G) {
    const int tid0 = threadIdx.x, wave = __builtin_amdgcn_readfirstlane(tid0 >> 6);
#define OPQ_IDS int tid = tid0; asm volatile("" : "+v"(tid)); const int lane = tid & 63, r32 = lane & 31, hh = lane >> 5; (void)lane; (void)r32; (void)hh;
    LAS unsigned char* T0 = lds; LAS unsigned char* T1 = lds + 34816; LAS unsigned char* T2 = lds + 2 * 34816; LAS unsigned char* T3 = lds + 3 * 34816;
    LAS float* SF = (LAS float*)T2;
    LAS float* SG = (LAS float*)(lds + 3 * 34816 + 35632);
    for (int u = blk; u < 256; u += G) {
        const int tok0 = u * 128; const bool first = (u & 31) == 0;
        constexpr int VS = 1040;
        {   OPQ_IDS; const int trow = tid >> 2, q4 = tid & 3;
            const bf16_t* vr = B.AV + (size_t)(tok0 + trow) * 512 + q4 * 128; float s = 0.f, s2 = 0.f; u32x4 w[16];
#pragma unroll
            for (int i = 0; i < 16; ++i) w[i] = *(const u32x4*)(vr + i * 8);
#pragma unroll
            for (int i = 0; i < 16; ++i) { const float f[8] = {bf_lo(w[i].x), bf_hi(w[i].x), bf_lo(w[i].y), bf_hi(w[i].y), bf_lo(w[i].z), bf_hi(w[i].z), bf_lo(w[i].w), bf_hi(w[i].w)};
#pragma unroll
                for (int e = 0; e < 8; ++e) { s += f[e]; s2 += f[e] * f[e]; } }
            s += shx(s, 1, lane); s += shx(s, 2, lane); s2 += shx(s2, 1, lane); s2 += shx(s2, 2, lane);
            const float mean = s * (1.f / 512.f), rstd = rsqrtf(fmaxf(s2 * (1.f / 512.f) - mean * mean, 0.f) + LN_EPS);
            __syncthreads();
#pragma unroll
            for (int i = 0; i < 16; ++i) { const int cbase = q4 * 128 + i * 8; const f32x4 g0 = *(const f32x4*)(B.gm_g + cbase), g1 = *(const f32x4*)(B.gm_g + cbase + 4), b0 = *(const f32x4*)(B.gm_b + cbase), b1 = *(const f32x4*)(B.gm_b + cbase + 4);
                u32x4 o; o.x = pk2((bf_lo(w[i].x) - mean) * rstd * g0[0] + b0[0], (bf_hi(w[i].x) - mean) * rstd * g0[1] + b0[1]); o.y = pk2((bf_lo(w[i].y) - mean) * rstd * g0[2] + b0[2], (bf_hi(w[i].y) - mean) * rstd * g0[3] + b0[3]);
                o.z = pk2((bf_lo(w[i].z) - mean) * rstd * g1[0] + b1[0], (bf_hi(w[i].z) - mean) * rstd * g1[1] + b1[1]); o.w = pk2((bf_lo(w[i].w) - mean) * rstd * g1[2] + b1[2], (bf_hi(w[i].w) - mean) * rstd * g1[3] + b1[3]);
                *(LAS u32x4*)(lds + trow * VS + cbase * 2) = o; asm volatile("" ::: "memory"); }
            __syncthreads();
        }
        {   const int tb = wave & 3, dhf = wave >> 2;
#pragma unroll 1
            for (int g = 0; g < 4; ++g) {
                OPQ_IDS; const int t = 32 * tb + r32; const size_t tok = (size_t)tok0 + t;
                f32x16 acc[2];
#pragma unroll
                for (int dt = 0; dt < 2; ++dt)
#pragma unroll
                    for (int r = 0; r < 16; ++r) acc[dt][r] = 0.f;
                const bf16_t* wrow = B.GMW + ((size_t)g * 128 + t) * 128 + 8 * hh;
                bf16x8 bw[8];
#pragma unroll
                for (int ks = 0; ks < 8; ++ks) bw[ks] = *(const bf16x8*)(wrow + 16 * ks);
#pragma unroll
                for (int ks = 0; ks < 8; ++ks) if (ks <= 2 * tb + 1) {
#pragma unroll
                    for (int dt = 0; dt < 2; ++dt) { const bf16x8 a = tr_frag<VS>(lds, 16 * ks, g * 128 + 64 * dhf + 32 * dt, lane, false); acc[dt] = MFMA32(a, bw[ks], acc[dt]); } }
                const float bsv = B.gm_bs[g * 128 + t];
#pragma unroll
                for (int dt = 0; dt < 2; ++dt)
#pragma unroll
                    for (int gq = 0; gq < 4; ++gq) { const int col = g * 128 + 64 * dhf + 32 * dt + 8 * gq + 4 * hh; const u32x2 au = *(const u32x2*)(B.AU + tok * 512 + col);
                        u32x2 w; w.x = pk2(bf_lo(au.x) * (acc[dt][4 * gq] + bsv), bf_hi(au.x) * (acc[dt][4 * gq + 1] + bsv)); w.y = pk2(bf_lo(au.y) * (acc[dt][4 * gq + 2] + bsv), bf_hi(au.y) * (acc[dt][4 * gq + 3] + bsv));
                        *(u32x2*)(B.YM + tok * 1024 + col) = w; }
            }
        }
        f32x16 accg;
#pragma unroll
        for (int r = 0; r < 16; ++r) accg[r] = 0.f;
        LAS unsigned char* MTL = (LAS unsigned char*)SG;
#pragma unroll 1
        for (int h = 0; h < 4; ++h) {
            OPQ_IDS;
            __syncthreads();
            for (int ch = tid; ch < 131 * 16; ch += 512) { const int row = ch >> 4, c = ch & 15; u32x4 v = (u32x4){0u, 0u, 0u, 0u};
                if (!(first && row < 3)) v = *(const u32x4*)(B.BX + (size_t)(tok0 - 3 + row) * 512 + h * 128 + c * 8);
                *(LAS u32x4*)(T3 + row * TS + c * 16) = v; }
            load_tile128(T0, B.WQT + ((size_t)0 * 4 + h) * 128 * 128, 128, tid);
            load_tile128(T1, B.WQT + ((size_t)1 * 4 + h) * 128 * 128, 128, tid);
            if (tid < 256) { const int row = tid >> 5, c = tid & 31; *(LAS u32x4*)(MTL + row * 528 + c * 16) = *(const u32x4*)(B.MT + ((size_t)h * 8 + row) * 256 + c * 8); }
            __syncthreads();
            {   const int dc = tid & 15, chn = h * 128 + dc * 8; float w[4][8], cbv[8];
#pragma unroll
                for (int j = 0; j < 4; ++j)
#pragma unroll
                    for (int e = 0; e < 8; ++e) w[j][e] = B.cw[j * 512 + chn + e];
#pragma unroll
                for (int e = 0; e < 8; ++e) cbv[e] = B.cb[chn + e];
#pragma unroll 1
                for (int ps = 0; ps < 4; ++ps) { const int t = ps * 32 + (tid >> 4); float a[8];
#pragma unroll
                    for (int e = 0; e < 8; ++e) a[e] = cbv[e];
#pragma unroll
                    for (int j = 0; j < 4; ++j) { const u32x4 x = *(const LAS u32x4*)(T3 + (t + j) * TS + dc * 16);
                        a[0] += w[j][0] * bf_lo(x.x); a[1] += w[j][1] * bf_hi(x.x); a[2] += w[j][2] * bf_lo(x.y); a[3] += w[j][3] * bf_hi(x.y);
                        a[4] += w[j][4] * bf_lo(x.z); a[5] += w[j][5] * bf_hi(x.z); a[6] += w[j][6] * bf_lo(x.w); a[7] += w[j][7] * bf_hi(x.w); }
                    u32x4 o; o.x = pk2(silu_f(a[0]), silu_f(a[1])); o.y = pk2(silu_f(a[2]), silu_f(a[3])); o.z = pk2(silu_f(a[4]), silu_f(a[5])); o.w = pk2(silu_f(a[6]), silu_f(a[7]));
                    *(LAS u32x4*)(T2 + t * TS + dc * 16) = o; *(u32x4*)(B.XC + (size_t)(tok0 + t) * 512 + chn) = o; } }
            __syncthreads();
            {   const int tb = wave & 3, ehf = wave >> 2;
                {
                    OPQ_IDS; const LAS unsigned char* act = ehf ? T3 + 3 * TS : T2;
#pragma unroll
                    for (int ks = 0; ks < 8; ++ks) { const bf16x8 a = *(const LAS bf16x8*)(MTL + (r32 & 7) * 528 + (ehf * 128 + 16 * ks + 8 * hh) * 2); const bf16x8 bx = row_frag(act, 32 * tb + r32, 16 * ks, hh); accg = MFMA32(a, bx, accg); } }
#pragma unroll 1
                for (int mtx = 0; mtx < 2; ++mtx) {
                    OPQ_IDS;
                    const LAS unsigned char* wt = mtx ? T1 : T0;
                    f32x16 acc[2];
#pragma unroll
                    for (int et = 0; et < 2; ++et)
#pragma unroll
                        for (int r = 0; r < 16; ++r) acc[et][r] = 0.f;
#pragma unroll
                    for (int ks = 0; ks < 8; ++ks) { const bf16x8 bx = row_frag(T2, 32 * tb + r32, 16 * ks, hh);
#pragma unroll
                        for (int et = 0; et < 2; ++et) { const bf16x8 a = row_frag(wt, 64 * ehf + 32 * et + r32, 16 * ks, hh); acc[et] = MFMA32(a, bx, acc[et]); } }
                    bf16_t* dst = (mtx == 0 ? B.Q : B.K) + (size_t)(tok0 + 32 * tb + r32) * 512 + h * 128 + 64 * ehf + 4 * hh;
#pragma unroll
                    for (int et = 0; et < 2; ++et)
#pragma unroll
                        for (int gq = 0; gq < 4; ++gq) { u32x2 w; w.x = pk2(acc[et][4 * gq], acc[et][4 * gq + 1]); w.y = pk2(acc[et][4 * gq + 2], acc[et][4 * gq + 3]); *(u32x2*)(dst + 32 * et + 8 * gq) = w; }
                }
            }
            __syncthreads();
            load_tile128(T0, B.WQT + ((size_t)2 * 4 + h) * 128 * 128, 128, tid);
            __syncthreads();
            {   OPQ_IDS; const int tb = wave & 3, ehf = wave >> 2;
                f32x16 acc[2];
#pragma unroll
                for (int et = 0; et < 2; ++et)
#pragma unroll
                    for (int r = 0; r < 16; ++r) acc[et][r] = 0.f;
#pragma unroll
                for (int ks = 0; ks < 8; ++ks) { const bf16x8 bx = row_frag(T3 + 3 * TS, 32 * tb + r32, 16 * ks, hh);
#pragma unroll
                    for (int et = 0; et < 2; ++et) { const bf16x8 a = row_frag(T0, 64 * ehf + 32 * et + r32, 16 * ks, hh); acc[et] = MFMA32(a, bx, acc[et]); } }
                bf16_t* dst = B.V + (size_t)(tok0 + 32 * tb + r32) * 512 + h * 128 + 64 * ehf + 4 * hh;
#pragma unroll
                for (int et = 0; et < 2; ++et)
#pragma unroll
                    for (int gq = 0; gq < 4; ++gq) { u32x2 w; w.x = pk2(acc[et][4 * gq], acc[et][4 * gq + 1]); w.y = pk2(acc[et][4 * gq + 2], acc[et][4 * gq + 3]); *(u32x2*)(dst + 32 * et + 8 * gq) = w; }
            }
        }
        __syncthreads();
        {   OPQ_IDS; const int tb = wave & 3, kh = wave >> 2;
#pragma unroll
            for (int r = 0; r < 4; ++r) SF[(kh * 8 + r + 4 * hh) * 128 + 32 * tb + r32] = accg[r];
        }
        __syncthreads();
        LAS float* IG = SG; LAS float* BC = SG + 512; LAS float* WG = SG + 1024;
        if (wave < 4) {
            OPQ_IDS; const int h = wave; float lf[2], ig[2];
#pragma unroll
            for (int e = 0; e < 2; ++e) { const int t = 2 * lane + e; ig[e] = SF[h * 128 + t] + SF[(8 + h) * 128 + t] + B.bif[h];
                const float fx = SF[(4 + h) * 128 + t] + SF[(12 + h) * 128 + t] + B.bif[4 + h]; lf[e] = fminf(fx, 0.f) - log1pf(expf(-fabsf(fx))); }
            float run = lf[0] + lf[1];
#pragma unroll
            for (int o = 1; o < 64; o <<= 1) { const float v = shup(run, o, lane); if (lane >= o) run += v; }
            const float b1 = run, b0 = run - lf[1];
            IG[h * 128 + 2 * lane] = ig[0]; IG[h * 128 + 2 * lane + 1] = ig[1]; BC[h * 128 + 2 * lane] = b0; BC[h * 128 + 2 * lane + 1] = b1;
            float* gt = B.GT + ((size_t)u * 4 + h) * 256;
            gt[2 * lane] = ig[0]; gt[2 * lane + 1] = ig[1]; gt[128 + 2 * lane] = b0; gt[128 + 2 * lane + 1] = b1;
            const float bl = shidx(b1, 63);
            float g0 = bl - b0 + ig[0], g1 = bl - b1 + ig[1]; float mloc = fmaxf(g0, g1);
#pragma unroll
            for (int o = 1; o < 64; o <<= 1) mloc = fmaxf(mloc, shx(mloc, o, lane));
            WG[h * 128 + 2 * lane] = expf(g0 - mloc); WG[h * 128 + 2 * lane + 1] = expf(g1 - mloc);
            if (lane == 0) { B.SC[u * 4 + h] = bl; B.SC[1024 + u * 4 + h] = mloc; }
        }
#pragma unroll 1
        for (int h = 0; h < 4; ++h) {
            OPQ_IDS;
            __syncthreads();
#pragma unroll
            for (int i = 0; i < 4; ++i) { const int ch = tid + 512 * i, row = ch >> 4, c = ch & 15; const float wg = WG[h * 128 + row];
                const u32x4 v = *(const u32x4*)(B.V + (size_t)(tok0 + row) * 512 + h * 128 + c * 8), k = *(const u32x4*)(B.K + (size_t)(tok0 + row) * 512 + h * 128 + c * 8);
                u32x4 ov, ok; const float ksc = 0.08838834764831845f;
                ov.x = pk2(bf_lo(v.x) * wg, bf_hi(v.x) * wg); ov.y = pk2(bf_lo(v.y) * wg, bf_hi(v.y) * wg); ov.z = pk2(bf_lo(v.z) * wg, bf_hi(v.z) * wg); ov.w = pk2(bf_lo(v.w) * wg, bf_hi(v.w) * wg);
                ok.x = pk2(bf_lo(k.x) * ksc, bf_hi(k.x) * ksc); ok.y = pk2(bf_lo(k.y) * ksc, bf_hi(k.y) * ksc); ok.z = pk2(bf_lo(k.z) * ksc, bf_hi(k.z) * ksc); ok.w = pk2(bf_lo(k.w) * ksc, bf_hi(k.w) * ksc);
                *(LAS u32x4*)(T0 + row * TS + c * 16) = ov; *(LAS u32x4*)(T1 + row * TS + c * 16) = ok; }
            __syncthreads();
            const int vb = wave & 3, khf = wave >> 2;
            f32x16 acc[2];
#pragma unroll
            for (int kt = 0; kt < 2; ++kt)
#pragma unroll
                for (int r = 0; r < 16; ++r) acc[kt][r] = 0.f;
#pragma unroll
            for (int ks = 0; ks < 8; ++ks) { const bf16x8 a = tr_frag(T0, 16 * ks, 32 * vb, lane, false);
#pragma unroll
                for (int kt = 0; kt < 2; ++kt) { const bf16x8 bk = tr_frag(T1, 16 * ks, 64 * khf + 32 * kt, lane, false); acc[kt] = MFMA32(a, bk, acc[kt]); } }
            bf16_t* Uo = B.U + ((size_t)u * 4 + h) * 16384;
#pragma unroll
            for (int kt = 0; kt < 2; ++kt)
#pragma unroll
                for (int r = 0; r < 16; ++r) Uo[(32 * vb + crow(r, hh)) * 128 + 64 * khf + 32 * kt + r32] = f2bf(acc[kt][r]);
            {   const int kk = tid & 127, sq = tid >> 7; float a = 0.f;
                for (int s = sq * 32; s < sq * 32 + 32; ++s) a += WG[h * 128 + s] * bf2f(*(const LAS bf16_t*)(T1 + s * TS + kk * 2));
                SF[2048 + sq * 128 + kk] = a; }
            __syncthreads();
            if (tid < 128) B.UN[((size_t)u * 4 + h) * 128 + tid] = (SF[2048 + tid] + SF[2048 + 128 + tid]) + (SF[2048 + 256 + tid] + SF[2048 + 384 + tid]);
        }
    }
}
#undef OPQ_IDS
__device__ __forceinline__ void l0_scan(const L0Bufs& B, int blk, int tid) {
    const int bh = blk >> 3, part = blk & 7, b = bh >> 2, h = bh & 3, lane = tid & 63;
    const int e0 = part * 2048 + tid * 8;
    float zz = 0.f; asm volatile("" : "+v"(zz));
    f32x4 C0 = (f32x4){zz, zz, zz, zz}, C1 = C0; float nst = 0.f; float m = 0.f;
    const int unit0 = (b * 32) * 4 + h;
    const bool nrm = part == 0 && tid < 128;
    const float blv = lane < 32 ? B.SC[unit0 + 4 * lane] : 0.f, mlv = lane < 32 ? B.SC[1024 + unit0 + 4 * lane] : 0.f;
    u32x4 ub[8]; float un8[8];
#pragma unroll
    for (int j = 0; j < 8; ++j) { ub[j] = *(const u32x4*)(B.U + (size_t)(unit0 + 4 * j) * 16384 + e0); un8[j] = B.UN[(size_t)(unit0 + 4 * j) * 128 + (tid & 127)]; }
#pragma unroll
    for (int g = 0; g < 4; ++g) {
        u32x4 nb[8]; float nn[8];
#pragma unroll
        for (int j = 0; j < 8; ++j) { const int un1 = unit0 + 4 * (8 * (g < 3 ? g + 1 : 3) + j); nb[j] = *(const u32x4*)(B.U + (size_t)un1 * 16384 + e0); nn[j] = B.UN[(size_t)un1 * 128 + (tid & 127)]; }
#pragma unroll
        for (int j = 0; j < 8; ++j) { const int c = 8 * g + j, unit = unit0 + 4 * c; const u32x4 Unw = ub[j];
            const f32x4 U0 = (f32x4){bf_lo(Unw.x), bf_hi(Unw.x), bf_lo(Unw.y), bf_hi(Unw.y)}, U1 = (f32x4){bf_lo(Unw.z), bf_hi(Unw.z), bf_lo(Unw.w), bf_hi(Unw.w)};
            const float bl = __int_as_float(__builtin_amdgcn_readlane(__float_as_int(blv), c)), mloc = __int_as_float(__builtin_amdgcn_readlane(__float_as_int(mlv), c)), un = un8[j];
            u32x4 w; w.x = pk2(C0[0], C0[1]); w.y = pk2(C0[2], C0[3]); w.z = pk2(C1[0], C1[1]); w.w = pk2(C1[2], C1[3]); *(u32x4*)(B.CS + (size_t)unit * 16384 + e0) = w;
            if (nrm) B.NS[(size_t)unit * 128 + tid] = nst;
            if (part == 0 && tid == 0) B.SC[2048 + unit] = m;
            const float mn = fmaxf(bl + m, mloc), dec = expf(bl + m - mn), wu = expf(mloc - mn); m = mn;
            C0 = C0 * dec + U0 * wu; C1 = C1 * dec + U1 * wu;
            nst = nst * dec + wu * un; }
#pragma unroll
        for (int j = 0; j < 8; ++j) { ub[j] = nb[j]; un8[j] = nn[j]; }
    }
}
__device__ __forceinline__ void l0_mixC(LAS unsigned char* lds, const L0Bufs& B, int blk, int G) {
    const int tid0 = threadIdx.x, wave = __builtin_amdgcn_readfirstlane(tid0 >> 6);
    LAS unsigned char* TQ = lds; LAS unsigned char* TK = lds + 34816; LAS unsigned char* TV = lds + 2 * 34816; LAS unsigned char* TC = lds + 3 * 34816;
    LAS float* SF = (LAS float*)(lds + 4 * 34816);
    LAS float* AS = SF; LAS float* PM = SF + 128; LAS float* NP = SF + 256; LAS float* PS = SF + 384; LAS float* PQ = SF + 640; LAS float* NW = SF + 896;
    __syncthreads();
    { int tq = tid0; asm volatile("" : "+v"(tq)); if (tq < 256) ((LAS f32x4*)NW)[tq] = tq < 128 ? ((const f32x4*)B.nw)[tq] : ((const f32x4*)B.skip)[tq - 128]; }
    for (int uu = blk; uu < 256; uu += G) {
        const int tok0 = uu * 128;
#pragma unroll 1
        for (int h = 0; h < 4; ++h) {
            const int unit = uu * 4 + h;
            int tid = tid0; asm volatile("" : "+v"(tid));
            const int lane = tid & 63, r32 = lane & 31, hh = lane >> 5;
            __syncthreads();
            load_tile128(TQ, B.Q + (size_t)tok0 * 512 + h * 128, 512, tid);
            load_tile128(TV, B.V + (size_t)tok0 * 512 + h * 128, 512, tid);
            load_tile128(TC, B.CS + (size_t)unit * 16384, 128, tid);
#pragma unroll
            for (int i = 0; i < 4; ++i) { const int ch = tid + 512 * i, row = ch >> 4, c = ch & 15; const u32x4 k = *(const u32x4*)(B.K + (size_t)(tok0 + row) * 512 + h * 128 + c * 8); const float ksc = 0.08838834764831845f;
                u32x4 ok; ok.x = pk2(bf_lo(k.x) * ksc, bf_hi(k.x) * ksc); ok.y = pk2(bf_lo(k.y) * ksc, bf_hi(k.y) * ksc); ok.z = pk2(bf_lo(k.z) * ksc, bf_hi(k.z) * ksc); ok.w = pk2(bf_lo(k.w) * ksc, bf_hi(k.w) * ksc);
                *(LAS u32x4*)(TK + row * TS + c * 16) = ok; }
            const float mprev = B.SC[2048 + unit];
            if (wave == 0) {
                const float* gt = B.GT + (size_t)unit * 256;
                const float a0 = gt[2 * lane] - gt[128 + 2 * lane], a1 = gt[2 * lane + 1] - gt[128 + 2 * lane + 1];
                float run = fmaxf(a0, a1);
#pragma unroll
                for (int o = 1; o < 64; o <<= 1) { const float v = shup(run, o, lane); if (lane >= o) run = fmaxf(run, v); }
                const float prev = shup(run, 1, lane); const float p0 = fmaxf(lane > 0 ? fmaxf(prev, a0) : a0, mprev), p1 = fmaxf(run, mprev);
                AS[2 * lane] = a0; AS[2 * lane + 1] = a1; PM[2 * lane] = p0; PM[2 * lane + 1] = p1;
            }
            if (wave == 1) { NP[lane] = B.NS[(size_t)unit * 128 + lane]; NP[64 + lane] = B.NS[(size_t)unit * 128 + 64 + lane]; }
            __syncthreads();
            const int tb = wave & 3, vh = wave >> 2, t = 32 * tb + r32;
            const float pm = PM[t], bt = B.GT[(size_t)unit * 256 + 128 + t];
            f32x16 s[4];
#pragma unroll
            for (int st = 0; st < 4; ++st)
#pragma unroll
                for (int r = 0; r < 16; ++r) s[st][r] = 0.f;
            {   int lv = lane; asm volatile("" : "+v"(lv));
                const LAS unsigned char* qp = TQ + (32 * tb + (lv & 31)) * TS + (lv >> 5) * 16; const LAS unsigned char* kp = TK + (lv & 31) * TS + (lv >> 5) * 16;
#pragma unroll 2
                for (int ks = 0; ks < 8; ++ks) { const bf16x8 bq = *(const LAS bf16x8*)(qp + ks * 32);
#pragma unroll
                    for (int st = 0; st < 4; ++st) if (st <= tb) { const bf16x8 a = *(const LAS bf16x8*)(kp + st * 32 * TS + ks * 32); s[st] = MFMA32(a, bq, s[st]); } } }
            float nq = 0.f; u32x4 pf[4][2];
#pragma unroll
            for (int st = 0; st < 4; ++st) {
#pragma unroll
                for (int r = 0; r < 16; ++r) { const int sidx = 32 * st + crow(r, hh); const float wv = (sidx <= t) ? __builtin_amdgcn_exp2f((AS[sidx] - pm) * LOG2E) : 0.f; const float pv = s[st][r] * wv; s[st][r] = pv; nq += pv; }
#pragma unroll
                for (int sx = 0; sx < 2; ++sx) pf[st][sx] = (u32x4){pk2(s[st][8 * sx], s[st][8 * sx + 1]), pk2(s[st][8 * sx + 2], s[st][8 * sx + 3]), pk2(s[st][8 * sx + 4], s[st][8 * sx + 5]), pk2(s[st][8 * sx + 6], s[st][8 * sx + 7])};
            }
            nq = xhalf_sum(nq);
            float nqi = 0.f;
#pragma unroll
            for (int i = 0; i < 8; ++i) { const u32x4 qv = *(const LAS u32x4*)(TQ + t * TS + (64 * hh + 8 * i) * 2); const LAS float* np = NP + 64 * hh + 8 * i;
                nqi += bf_lo(qv.x) * np[0] + bf_hi(qv.x) * np[1] + bf_lo(qv.y) * np[2] + bf_hi(qv.y) * np[3] + bf_lo(qv.z) * np[4] + bf_hi(qv.z) * np[5] + bf_lo(qv.w) * np[6] + bf_hi(qv.w) * np[7]; }
            nqi = xhalf_sum(nqi);
            const float wst = __builtin_amdgcn_exp2f((mprev - pm) * LOG2E);
            const float den = fmaxf(fabsf(nq + wst * nqi), __builtin_amdgcn_exp2f(-(bt + pm) * LOG2E)), rden = 1.f / den;
            f32x16 ni[2], nx[2];
#pragma unroll
            for (int vt = 0; vt < 2; ++vt)
#pragma unroll
                for (int r = 0; r < 16; ++r) { ni[vt][r] = 0.f; nx[vt][r] = 0.f; }
            {   int lv = lane; asm volatile("" : "+v"(lv));
#pragma unroll
                for (int st = 0; st < 4; ++st) {
                    if (st <= tb) {
#pragma unroll
                        for (int sx = 0; sx < 2; ++sx) { const bf16x8 pb = __builtin_bit_cast(bf16x8, pf[st][sx]);
#pragma unroll
                            for (int vt = 0; vt < 2; ++vt) { const bf16x8 a = tr_frag(TV, 32 * st + 16 * sx, 64 * vh + 32 * vt, lv, true); ni[vt] = MFMA32(a, pb, ni[vt]); } }
                    }
                } }
            {   int lv = lane; asm volatile("" : "+v"(lv));
                const LAS unsigned char* qp = TQ + (32 * tb + (lv & 31)) * TS + (lv >> 5) * 16; const LAS unsigned char* cp = TC + (64 * vh + (lv & 31)) * TS + (lv >> 5) * 16;
#pragma unroll 2
                for (int ks = 0; ks < 8; ++ks) { const bf16x8 bq = *(const LAS bf16x8*)(qp + ks * 32);
#pragma unroll
                    for (int vt = 0; vt < 2; ++vt) { const bf16x8 a = *(const LAS bf16x8*)(cp + vt * 32 * TS + ks * 32); nx[vt] = MFMA32(a, bq, nx[vt]); } } }
            const size_t tok = (size_t)tok0 + t;
            u32x2 xcv[2][4], zv[2][4];
#pragma unroll
            for (int vt = 0; vt < 2; ++vt)
#pragma unroll
                for (int gq = 0; gq < 4; ++gq) { const int chn = h * 128 + 64 * vh + 32 * vt + 8 * gq + 4 * hh; xcv[vt][gq] = *(const u32x2*)(B.XC + tok * 512 + chn); zv[vt][gq] = *(const u32x2*)(B.BZ + tok * 512 + chn); }
            float hs = 0.f, hq = 0.f;
#pragma unroll
            for (int vt = 0; vt < 2; ++vt)
#pragma unroll
                for (int r = 0; r < 16; ++r) { const float hv = (ni[vt][r] + wst * nx[vt][r]) * rden; ni[vt][r] = hv; hs += hv; hq += hv * hv; }
            hs = xhalf_sum(hs); hq = xhalf_sum(hq);
            if (hh == 0) { PS[vh * 128 + t] = hs; PQ[vh * 128 + t] = hq; }
            __syncthreads();
            const float mean = (PS[t] + PS[128 + t]) * (1.f / 128.f);
            const float rstd = rsqrtf(fmaxf((PQ[t] + PQ[128 + t]) * (1.f / 128.f) - mean * mean, 0.f) + LN_EPS);
#pragma unroll
            for (int vt = 0; vt < 2; ++vt)
#pragma unroll
                for (int gq = 0; gq < 4; ++gq) { const int cl = 64 * vh + 32 * vt + 8 * gq + 4 * hh, chn = h * 128 + cl;
                    const f32x4 nw = *(const LAS f32x4*)(NW + chn), sk = *(const LAS f32x4*)(NW + 512 + chn); const u32x2 xc = xcv[vt][gq], z = zv[vt][gq];
                    const float y0 = ((ni[vt][4 * gq] - mean) * rstd * nw[0] + sk[0] * bf_lo(xc.x)) * silu_f(bf_lo(z.x)), y1 = ((ni[vt][4 * gq + 1] - mean) * rstd * nw[1] + sk[1] * bf_hi(xc.x)) * silu_f(bf_hi(z.x));
                    const float y2 = ((ni[vt][4 * gq + 2] - mean) * rstd * nw[2] + sk[2] * bf_lo(xc.y)) * silu_f(bf_lo(z.y)), y3 = ((ni[vt][4 * gq + 3] - mean) * rstd * nw[3] + sk[3] * bf_hi(xc.y)) * silu_f(bf_hi(z.y));
                    u32x2 w; w.x = pk2(y0, y1); w.y = pk2(y2, y3); *(u32x2*)(B.YM + tok * 1024 + 512 + chn) = w; }
        }
    }
}
constexpr size_t MB = 1048576ull;
constexpr size_t P_WIN_T = 0, P_WOUT_T = P_WIN_T + 4 * MB, P_WQKV_T = P_WOUT_T + 2 * MB, P_WO_T = P_WQKV_T + 3 * MB, P_XWQ_T = P_WO_T + 2 * MB, P_XWKV_T = P_XWQ_T + 4 * MB, P_XWO_T = P_XWKV_T + 8 * MB,
                 P_MLW_T = P_XWO_T + 4 * MB, P_WIFT = P_MLW_T + MB / 2, P_WRT = P_WIFT + MB / 8, P_ROT = P_WRT + MB / 2, P_BQK = P_ROT + MB, P_MEMB = P_BQK + MB / 8, P_KC = P_MEMB + 4 * MB, P_VT = P_KC + 8 * MB,
                 P_W13T = P_VT + 8 * MB, P_W2T = P_W13T + 64 * MB, P_XBF = P_W2T + 32 * MB, P_RT = P_XBF + 64 * MB, P_TMP = P_RT + 2 * MB;
constexpr size_t P_BAR = P_RT + 1572864;
constexpr size_t RT_SRC = 1638400;
constexpr size_t RT_E = 0, RT_W = 262144, RT_RANK = 2 * 262144, RT_DEST = 3 * 262144, RT_HIST = 4 * 262144, RT_TSTART = RT_HIST + 32768;
constexpr size_t T_QX = 0, T_OB = 64 * MB, T_YB = 128 * MB;
constexpr size_t T_K1 = 192 * MB, T_VT1 = 208 * MB;
constexpr size_t T_AU = 0, T_AV = 32 * MB, T_BX = 64 * MB, T_BZ = 96 * MB, T_V = 128 * MB, T_XC = 160 * MB, T_YM = 192 * MB, T_U = 256 * MB, T_CS = 320 * MB,
                 T_GT = 352 * MB, T_UN = 353 * MB, T_NS = 353 * MB + MB / 2, T_SC = 354 * MB, T_YB0 = 0;
constexpr size_t T_XG = 0, T_HM = 152 * MB, T_YG = 0;
constexpr size_t T_W13B = 228 * MB, T_W2B = 292 * MB;
constexpr size_t T_SLOT = 356 * MB;
constexpr size_t FAST_END = P_TMP + 360 * MB;
#if defined(PROBE_LNX) || defined(PROBE_LNV)
constexpr size_t SLOT_MB = 8;
#else
constexpr size_t SLOT_MB = 4;
#endif
constexpr int LDS_BYTES = 147456;

struct FP {
    const float* in[33]; float* X;
    unsigned char* ws;
};
typedef const float* const __attribute__((address_space(4)))* InTab;
struct PV { InTab in; float* X; unsigned char* ws; };
__device__ __forceinline__ PV make_pv(const FP& p0) {
    PV p; InTab kp = (InTab)__builtin_amdgcn_kernarg_segment_ptr(); asm volatile("" : "+s"(kp)); p.in = kp;
    p.X = p0.X; p.ws = p0.ws; asm volatile("" : "+s"(p.ws)); return p;
}
#define WSP(T, off) ((T*)(p.ws + (off)))

__device__ __forceinline__ RouteBufs route_bufs(const PV& p) {
    RouteBufs r; r.e = WSP(int, P_RT + RT_E); r.w = WSP(float, P_RT + RT_W); r.rank = WSP(int, P_RT + RT_RANK); r.dest = WSP(int, P_RT + RT_DEST); r.hist = WSP(int, P_RT + RT_HIST); r.tstart = WSP(int, P_RT + RT_TSTART); r.src = WSP(int, P_RT + RT_SRC); return r;
}
#define PH_ARGS const PV& p, LAS unsigned char* lds, int blk, int G
#define PH_IDS int tid_ = threadIdx.x; asm volatile("" : "+v"(tid_)); const int tid = tid_, lane = tid & 63, wave = __builtin_amdgcn_readfirstlane(tid >> 6); (void)lane; (void)wave;

__device__ __forceinline__ void ph_conv_xattn(PH_ARGS, int l, int& gw) {
    PH_IDS; LAS float* scr = (LAS float*)(lds + wave * 8448); const int ngw = G * NWAVE;
    convert_mats(p.in[23] + (size_t)l * 1024 * 1024, 1024, 1024, 1, 0, WSP(bf16_t, P_XWQ_T) + (size_t)l * 1024 * 1024, 0, RM_IDENT, 0.0625f, 1024, scr, gw, ngw, lane);
    convert_mats(p.in[24] + (size_t)l * 1024 * 2048, 1024, 2048, 1, 0, WSP(bf16_t, P_XWKV_T) + (size_t)l * 2048 * 1024, 0, RM_IDENT, 1.f, 0, scr, gw, ngw, lane);
    convert_mats(p.in[25] + (size_t)l * 1024 * 1024, 1024, 1024, 1, 0, WSP(bf16_t, P_XWO_T) + (size_t)l * 1024 * 1024, 0, RM_IDENT, 1.f, 0, scr, gw, ngw, lane);
    convert_rows(p.in[1], WSP(bf16_t, P_MEMB), (size_t)2048 * 1024, blk * NTHR + tid, G * NTHR);
}
__device__ __forceinline__ void conv_router_w(const PV& p, int l, int gt, int ngt) {
    bf16_t* wrt = WSP(bf16_t, P_WRT) + (size_t)l * 2 * 64 * 1024; const float* wre = p.in[28] + (size_t)l * 1024 * 32; const float* wrg = p.in[26] + (size_t)l * 1024 * 4;
    for (int i = gt; i < 64 * 1024; i += ngt) { const int r = i >> 10, k = i & 1023;
        const float v = r < 32 ? wre[k * 32 + r] : (r < 36 ? wrg[k * 4 + (r - 32)] : 0.f);
        const bf16_t h = f2bf(v); wrt[i] = h; wrt[64 * 1024 + i] = f2bf(v - bf2f(h)); }
}
__device__ __forceinline__ void conv_moe_waves(const PV& p, int l, LAS float* scr, int& gw, int ngw, int gt, int ngt, int lane) {
    const size_t wl = (size_t)l * 32 * 1024 * 512;
    convert_mats(p.in[30] + wl, 1024, 512, 32, (size_t)1024 * 512, WSP(bf16_t, P_W13T), (size_t)1024 * 1024, RM_PAIR0, 1.f, 0, scr, gw, ngw, lane);
    convert_mats(p.in[31] + wl, 1024, 512, 32, (size_t)1024 * 512, WSP(bf16_t, P_W13T), (size_t)1024 * 1024, RM_PAIR1, 1.f, 0, scr, gw, ngw, lane);
    convert_mats(p.in[32] + wl, 512, 1024, 32, (size_t)512 * 1024, WSP(bf16_t, P_W2T), (size_t)1024 * 512, RM_IDENT, 1.f, 0, scr, gw, ngw, lane);
    conv_router_w(p, l, gt, ngt);
}
#ifndef TAILQ_XA
#define TAILQ_XA 3
#endif
#ifndef TAILQ_G1
#define TAILQ_G1 4
#endif
#ifndef TAILQ_G2
#define TAILQ_G2 2
#endif
constexpr size_t P_CURSOR_OFF = 15360;
__device__ __forceinline__ void conv_moe1_item(const PV& p, unsigned it, LAS float* scr, int lane, f32x4 (&tv)[8], bool load) {
    const size_t wl = (size_t)32 * 1024 * 512;
    const int mat = it >> 13, r = it & 8191, bt = r >> 8, rr = r & 255;
    if (mat < 2) { const float* W = (mat == 0 ? p.in[30] : p.in[31]) + wl + (size_t)bt * 1024 * 512;
        if (load) ti_load(W, 512, rr >> 4, rr & 15, lane, tv); else ti_store(tv, 1024, WSP(bf16_t, P_TMP + T_W13B) + (size_t)bt * 1024 * 1024, scr, rr >> 4, rr & 15, lane, mat == 0 ? RM_PAIR0 : RM_PAIR1, 1.f, 0); }
    else { const float* W = p.in[32] + wl + (size_t)bt * 512 * 1024;
        if (load) ti_load(W, 1024, rr >> 5, rr & 31, lane, tv); else ti_store(tv, 512, WSP(bf16_t, P_TMP + T_W2B) + (size_t)bt * 1024 * 512, scr, rr >> 5, rr & 31, lane, RM_IDENT, 1.f, 0); }
}
__device__ __forceinline__ void conv_moe1_range(const PV& p, LAS float* scr, int lane, int first, int stride, int last) {
    if (last > 12288) last = 12288;
    if (first >= last) return;
    f32x4 ta[8], tb[8];
    conv_moe1_item(p, 2 * first, scr, lane, ta, true); conv_moe1_item(p, 2 * first + 1, scr, lane, tb, true);
    for (int it = first; it < last; it += stride) {
        const int nx = it + stride; f32x4 na[8], nb[8];
        const int nl = nx < last ? nx : it;
        conv_moe1_item(p, 2 * nl, scr, lane, na, true);
        conv_moe1_item(p, 2 * it, scr, lane, ta, false);
        conv_moe1_item(p, 2 * nl + 1, scr, lane, nb, true);
        conv_moe1_item(p, 2 * it + 1, scr, lane, tb, false);
#pragma unroll
        for (int i = 0; i < 8; ++i) { ta[i] = na[i]; tb[i] = nb[i]; }
    }
}
struct TailPlan { int t0, t1, t2, nidle, first_idle; };
__device__ __forceinline__ TailPlan tail_plan(int ntile, int G) {
    TailPlan t; const int U = ntile * 4, R = (U + G - 1) / G; t.first_idle = U - (R - 1) * G; t.nidle = G - t.first_idle;
    t.t0 = 128 * NWAVE * TAILQ_XA; t.t1 = t.nidle * NWAVE * TAILQ_G1; t.t2 = t.nidle * NWAVE * TAILQ_G2; return t;
}
__device__ __forceinline__ void ph_conv_moe(PH_ARGS, int l, int& gw) {
    PH_IDS; conv_moe_waves(p, l, (LAS float*)(lds + wave * 8448), gw, G * NWAVE, blk * NTHR + tid, G * NTHR, lane);
}
__device__ __forceinline__ void ph_x_to_bf(PH_ARGS) { PH_IDS; convert_rows(p.X, WSP(bf16_t, P_XBF), (size_t)NT * 1024, blk * NTHR + tid, G * NTHR); }

__device__ __forceinline__ void set_job(LAS pg8::JobDesc* jt, int j, const void* A, const void* B, int nM, int nN, void* out, int ldc, int mode, const void* bias = nullptr, const void* rot = nullptr, void* out2 = nullptr) {
    unsigned long long a = (unsigned long long)A, b = (unsigned long long)B, o = (unsigned long long)out, bi = (unsigned long long)bias, ro = (unsigned long long)rot, o2 = (unsigned long long)out2;
    asm volatile("" : "+s"(a), "+s"(b), "+s"(o), "+s"(bi), "+s"(ro), "+s"(o2), "+s"(nM), "+s"(nN), "+s"(ldc), "+s"(mode));
    LAS pg8::JobDesc* d = jt + j; d->A = a; d->B = b; d->out = o; d->bias = bi; d->rot = ro; d->out2 = o2;
    d->nM = nM; d->nN = nN; d->ldc = ldc; d->mode = mode;
}
#define JT_PTR ((LAS pg8::JobDesc*)(lds + pg8::JT_OFF))
__device__ __forceinline__ void run_jobs(LAS unsigned char* lds, int K, int n0, int n1, int n2, int blk, int G) {
    __syncthreads();
    pg8::Jobs3 S; S.jt = JT_PTR; S.n0 = n0; S.n1 = n1; S.n2 = n2; S.K = K; S.G = G; S.c = blk;
    EpiMulti E; E.jt = JT_PTR;
    pg8::gemm_phase<EpiMulti, pg8::Jobs3, true, true>(lds, K, S, E);
}
__device__ __forceinline__ void ph_xattn_g1(PH_ARGS, int l) {
    const bf16_t* wkv = WSP(bf16_t, P_XWKV_T) + (size_t)l * 2048 * 1024;
    __syncthreads();
    if (threadIdx.x == 0) {
        set_job(JT_PTR, 0, WSP(bf16_t, P_MEMB), wkv, 8, 4, WSP(bf16_t, P_KC) + (size_t)l * 2048 * 1024, 1024, EM_PLAIN);
        set_job(JT_PTR, 1, wkv + (size_t)1024 * 1024, WSP(bf16_t, P_MEMB), 4, 8, WSP(bf16_t, P_VT) + (size_t)l * 1024 * 2048, 2048, EM_PLAIN);
        set_job(JT_PTR, 2, WSP(bf16_t, P_XBF), WSP(bf16_t, P_XWQ_T) + (size_t)l * 1024 * 1024, 128, 4, WSP(bf16_t, P_TMP + T_QX), 1024, EM_PLAIN);
    }
    run_jobs(lds, 1024, 32, 32, 512, blk, G);
}
__device__ __forceinline__ void ph_xattn_attn(PH_ARGS, int l) {
    xattn_phase(lds, WSP(bf16_t, P_TMP + T_QX), WSP(bf16_t, P_KC) + (size_t)l * 2048 * 1024, WSP(bf16_t, P_VT) + (size_t)l * 1024 * 2048, WSP(bf16_t, P_TMP + T_OB), blk, G);
}
__device__ __forceinline__ void ph_gemm_plain(PH_ARGS, const bf16_t* A, const bf16_t* Bt, bf16_t* out) {
    __syncthreads();
    if (threadIdx.x == 0) set_job(JT_PTR, 0, A, Bt, 128, 4, out, 1024, EM_PLAIN);
    run_jobs(lds, 1024, 512, 0, 0, blk, G);
}
template <bool XF32, bool OUTF32, bool MOE>
__device__ __forceinline__ void ph_ln(PH_ARGS, const bf16_t* y, int lnidx, bool dry = false) {
    PH_IDS; LnArgs a; a.xin32 = p.in[0]; a.xin = WSP(bf16_t, P_XBF); a.xout32 = dry ? WSP(float, P_TMP + 200 * MB) : p.X; a.xbf = dry ? WSP(bf16_t, P_TMP + 288 * MB) : WSP(bf16_t, P_XBF); a.y = y; a.g = p.in[2] + lnidx * 1024; a.b = p.in[3] + lnidx * 1024;
    a.dest = WSP(int, P_RT + RT_DEST); a.wts = WSP(float, P_RT + RT_W);
    ln_phase<XF32, OUTF32, MOE>(a, blk, G, wave, lane);
}
__device__ __forceinline__ void ph_moe_route(PH_ARGS, int l) {
    moe_router_phase(lds, WSP(bf16_t, P_XBF), WSP(bf16_t, P_WRT) + (size_t)l * 2 * 64 * 1024, p.in[27] + l * 4, p.in[29] + l * 32, route_bufs(p), blk);
}
__device__ __forceinline__ void ph_moe_scatter(PH_ARGS) { moe_scatter_phase(lds, route_bufs(p), blk, G); }
__device__ __forceinline__ void ph_moe_g1(PH_ARGS) {
    __syncthreads();
    if (threadIdx.x == 0) set_job(JT_PTR, 0, nullptr, nullptr, 0, 0, WSP(bf16_t, P_TMP + T_HM), 512, EM_SWIGLU);
    __syncthreads();
    MoeSched S; S.A = (const char*)WSP(bf16_t, P_TMP + T_XG); S.B = (const char*)WSP(bf16_t, P_W13T); S.tstart = WSP(int, P_RT + RT_TSTART); S.K = 1024; S.nN = 4; S.G = G; S.c = blk; S.bexp = (size_t)1024 * 1024 * 2;
    EpiMulti E; E.jt = JT_PTR;
    pg8::gemm_phase<EpiMulti, MoeSched, true, true>(lds, 1024, S, E);
}
__device__ __forceinline__ void ph_moe_g2(PH_ARGS) {
    __syncthreads();
    if (threadIdx.x == 0) set_job(JT_PTR, 0, nullptr, nullptr, 0, 0, WSP(bf16_t, P_TMP + T_YG), 1024, EM_PLAIN);
    __syncthreads();
    MoeSched S; S.A = (const char*)WSP(bf16_t, P_TMP + T_HM); S.B = (const char*)WSP(bf16_t, P_W2T); S.tstart = WSP(int, P_RT + RT_TSTART); S.K = 512; S.nN = 4; S.G = G; S.c = blk; S.bexp = (size_t)1024 * 512 * 2;
    EpiMulti E; E.jt = JT_PTR;
    pg8::gemm_phase<EpiMulti, MoeSched, true, true>(lds, 512, S, E);
}

__device__ __forceinline__ void ph_conv_l1(PH_ARGS, int& gw) {
    PH_IDS; LAS float* scr = (LAS float*)(lds + wave * 8448); const int ngw = G * NWAVE;
    convert_mats(p.in[19], 1024, 1536, 1, 0, WSP(bf16_t, P_WQKV_T), 0, RM_ROT, 0.125f, 1024, scr, gw, ngw, lane);
    convert_mats(p.in[22], 1024, 1024, 1, 0, WSP(bf16_t, P_WO_T), 0, RM_IDENT, 1.f, 0, scr, gw, ngw, lane);
    const int gt = blk * NTHR + tid, ngt = G * NTHR;
    float* bqk = WSP(float, P_BQK);
    for (int n = gt; n < 1280; n += ngt) bqk[rowmap(RM_ROT, n)] = p.in[20][n] * (n < 1024 ? 0.125f : 1.f);
    float* rot = WSP(float, P_ROT);
    for (int i = gt; i < 4096 * 32; i += ngt) { const int pos = i >> 5, k = i & 31; const float inv = powf(10000.f, -(float)(2 * k) / 64.f); const float ang = (float)pos * inv; rot[2 * i] = cosf(ang); rot[2 * i + 1] = sinf(ang); }
}
__device__ __forceinline__ void ph_l1_g1(PH_ARGS) {
    __syncthreads();
    if (threadIdx.x == 0) {
        set_job(JT_PTR, 0, WSP(bf16_t, P_XBF), WSP(bf16_t, P_WQKV_T), 128, 5, WSP(bf16_t, P_TMP + T_QX), 1024, EM_ROTARY, WSP(float, P_BQK), WSP(float, P_ROT), WSP(bf16_t, P_TMP + T_K1));
        set_job(JT_PTR, 1, WSP(bf16_t, P_WQKV_T) + (size_t)1280 * 1024, WSP(bf16_t, P_XBF), 1, 128, WSP(bf16_t, P_TMP + T_VT1), NT, EM_ROWBIAS, p.in[20] + 1280);
    }
    run_jobs(lds, 1024, 640, 128, 0, blk, G);
}
__device__ __forceinline__ void ph_l1_swa(PH_ARGS) {
    swa_phase(lds, WSP(bf16_t, P_TMP + T_QX), WSP(bf16_t, P_TMP + T_K1), WSP(bf16_t, P_TMP + T_VT1), p.in[21], WSP(bf16_t, P_TMP + T_OB), blk, G);
}

__device__ __forceinline__ L0Bufs l0_bufs(const PV& p) {
    L0Bufs B; B.AU = WSP(bf16_t, P_TMP + T_AU); B.AV = WSP(bf16_t, P_TMP + T_AV); B.BX = WSP(bf16_t, P_TMP + T_BX); B.BZ = WSP(bf16_t, P_TMP + T_BZ); B.V = WSP(bf16_t, P_TMP + T_V); B.XC = WSP(bf16_t, P_TMP + T_XC);
    B.YM = WSP(bf16_t, P_TMP + T_YM); B.CS = WSP(bf16_t, P_TMP + T_CS); B.U = WSP(bf16_t, P_TMP + T_U); B.GT = WSP(float, P_TMP + T_GT); B.UN = WSP(float, P_TMP + T_UN); B.NS = WSP(float, P_TMP + T_NS); B.SC = WSP(float, P_TMP + T_SC);
    B.Q = B.AU; B.K = B.AV;
    B.WQT = WSP(bf16_t, P_MLW_T); B.GMW = WSP(bf16_t, P_MLW_T) + 12 * 16384; B.MT = WSP(bf16_t, P_WIFT);
    B.gm_g = p.in[5]; B.gm_b = p.in[6]; B.gm_bs = p.in[8]; B.cw = p.in[9]; B.cb = p.in[10]; B.bif = p.in[15]; B.nw = p.in[16]; B.skip = p.in[17]; return B;
}
__device__ __forceinline__ void ph_scan_conv(PH_ARGS) {
    PH_IDS;
    if (wave < 4) l0_scan(l0_bufs(p), blk, tid);
}
__device__ __forceinline__ void ph_conv_l0(PH_ARGS, int& gwr) {
    PH_IDS; LAS float* scr = (LAS float*)(lds + wave * 8448); const int gw = blk * NWAVE + wave, ngw = G * NWAVE;
    convert_mats(p.in[4], 1024, 2048, 1, 0, WSP(bf16_t, P_WIN_T), 0, RM_IDENT, 1.f, 0, scr, gwr, ngw, lane);
    convert_mats(p.in[18], 1024, 1024, 1, 0, WSP(bf16_t, P_WOUT_T), 0, RM_IDENT, 1.f, 0, scr, gwr, ngw, lane);
    convert_mats(p.in[11], 128, 128, 4, 16384, WSP(bf16_t, P_MLW_T), 16384, RM_IDENT, 1.f, 0, scr, gwr, ngw, lane);
    convert_mats(p.in[12], 128, 128, 4, 16384, WSP(bf16_t, P_MLW_T) + 4 * 16384, 16384, RM_IDENT, 1.f, 0, scr, gwr, ngw, lane);
    convert_mats(p.in[13], 128, 128, 4, 16384, WSP(bf16_t, P_MLW_T) + 8 * 16384, 16384, RM_IDENT, 1.f, 0, scr, gwr, ngw, lane);
    const int gt = blk * NTHR + tid, ngt = G * NTHR;
    bf16_t* gmw = WSP(bf16_t, P_MLW_T) + 12 * 16384;
    for (int i = gt; i < 4 * 16384; i += ngt) { const int t = (i >> 7) & 127, sidx = i & 127; gmw[i] = f2bf(sidx <= t ? p.in[7][i] : 0.f); }
    bf16_t* mt = WSP(bf16_t, P_WIFT);
    for (int i = gw; i < 4 * 8 * 256; i += ngw) { const int h = i >> 11, g = (i >> 8) & 7, j = i & 255, d = j & 127; float a = 0.f;
        for (int e = lane; e < 128; e += 64) {
            if (j < 128) a += p.in[11][((size_t)h * 128 + d) * 128 + e] * p.in[14][(h * 128 + e) * 8 + g] + p.in[12][((size_t)h * 128 + d) * 128 + e] * p.in[14][(512 + h * 128 + e) * 8 + g];
            else a += p.in[13][((size_t)h * 128 + d) * 128 + e] * p.in[14][(1024 + h * 128 + e) * 8 + g]; }
        a += shx(a, 32, lane); a += shx(a, 16, lane); a += shx(a, 8, lane); a += shx(a, 4, lane); a += shx(a, 2, lane); a += shx(a, 1, lane);
        if (lane == 0) mt[i] = f2bf(a); }
}
__device__ __forceinline__ void ph_xin_to_bf(PH_ARGS) { PH_IDS; convert_rows(p.in[0], WSP(bf16_t, P_XBF), (size_t)NT * 1024, blk * NTHR + tid, G * NTHR); }
__device__ __forceinline__ void ph_l0_g1(PH_ARGS) {
    __syncthreads();
    if (threadIdx.x == 0) set_job(JT_PTR, 0, WSP(bf16_t, P_XBF), WSP(bf16_t, P_WIN_T), 128, 8, WSP(bf16_t, P_TMP + T_AU), 512, EM_GELU4);
    run_jobs(lds, 1024, 1024, 0, 0, blk, G);
}

enum { K_CONV_XATTN = 0, K_CONV_MOE, K_X2BF, K_XATTN_G1, K_XATTN_ATTN, K_XATTN_G2, K_LN_Y, K_MOE_ROUTE, K_MOE_SCATTER, K_MOE_G1, K_MOE_G2, K_LN_MOE, K_CONV_L1, K_L1_G1, K_L1_SWA, K_L1_G2, K_CONV_L0, K_XIN2BF, K_L0_G1, K_L0_MIXA, K_L0_SCAN, K_L0_MIXC, K_L0_G2, K_LN_Y0 };
template <int PH>
__global__ void __launch_bounds__(NTHR, 2) k_phase(FP p0, int l, int lnidx) {
    const PV p = make_pv(p0);
    extern __shared__ __attribute__((aligned(16))) unsigned char smem[];
    LAS unsigned char* lds = (LAS unsigned char*)smem;
    const int blk = blockIdx.x, G = gridDim.x;
    if constexpr (PH == K_CONV_XATTN) { int gwr = blk * NWAVE + (threadIdx.x >> 6); ph_conv_xattn(p, lds, blk, G, l, gwr); }
    if constexpr (PH == K_CONV_MOE) { int gwr = blk * NWAVE + (threadIdx.x >> 6); ph_conv_moe(p, lds, blk, G, l, gwr); }
    if constexpr (PH == K_X2BF) ph_x_to_bf(p, lds, blk, G);
    if constexpr (PH == K_XATTN_G1) ph_xattn_g1(p, lds, blk, G, l);
    if constexpr (PH == K_XATTN_ATTN) ph_xattn_attn(p, lds, blk, G, l);
    if constexpr (PH == K_XATTN_G2) ph_gemm_plain(p, lds, blk, G, WSP(bf16_t, P_TMP + T_OB), WSP(bf16_t, P_XWO_T) + (size_t)l * 1024 * 1024, WSP(bf16_t, P_TMP + T_YB));
    if constexpr (PH == K_LN_Y) ph_ln<false, false, false>(p, lds, blk, G, WSP(bf16_t, P_TMP + T_YB), lnidx);
    if constexpr (PH == K_MOE_ROUTE) ph_moe_route(p, lds, blk, G, l);
    if constexpr (PH == K_MOE_SCATTER) ph_moe_scatter(p, lds, blk, G);
    if constexpr (PH == K_MOE_G1) ph_moe_g1(p, lds, blk, G);
    if constexpr (PH == K_MOE_G2) ph_moe_g2(p, lds, blk, G);
    if constexpr (PH == K_LN_MOE) ph_ln<false, false, true>(p, lds, blk, G, WSP(bf16_t, P_TMP + T_YG), lnidx);
    if constexpr (PH == K_CONV_L0) { int gwr = blk * NWAVE + (threadIdx.x >> 6); ph_conv_l0(p, lds, blk, G, gwr); }
    if constexpr (PH == K_XIN2BF) ph_xin_to_bf(p, lds, blk, G);
    if constexpr (PH == K_L0_G1) ph_l0_g1(p, lds, blk, G);
    if constexpr (PH == K_L0_MIXA) l0_mixA(lds, l0_bufs(p), blk, G);
    if constexpr (PH == K_L0_SCAN) ph_scan_conv(p, lds, blk, G);
    if constexpr (PH == K_L0_MIXC) l0_mixC(lds, l0_bufs(p), blk, G);
    if constexpr (PH == K_L0_G2) ph_gemm_plain(p, lds, blk, G, WSP(bf16_t, P_TMP + T_YM), WSP(bf16_t, P_WOUT_T), WSP(bf16_t, P_TMP + T_YB0));
    if constexpr (PH == K_LN_Y0) ph_ln<true, false, false>(p, lds, blk, G, WSP(bf16_t, P_TMP + T_YB0), 0);
    if constexpr (PH == K_CONV_L1) { int gwr = blk * NWAVE + (threadIdx.x >> 6); ph_conv_l1(p, lds, blk, G, gwr); }
    if constexpr (PH == K_L1_G1) ph_l1_g1(p, lds, blk, G);
    if constexpr (PH == K_L1_SWA) ph_l1_swa(p, lds, blk, G);
    if constexpr (PH == K_L1_G2) ph_gemm_plain(p, lds, blk, G, WSP(bf16_t, P_TMP + T_OB), WSP(bf16_t, P_WO_T), WSP(bf16_t, P_TMP + T_YB));
}

#define XB_TMO      128
#define XB_XCNT(j)  (256  + 64 * (j))
#define XB_XSUB(j)  (1280 + 64 * (j))
#define XB_XGEN(j)  (2304 + 64 * (j))
#define XB_TOP      3328
#define XB_TOPGEN   3392
#define XCD_BAR_WORDS 3456
#define XB_SPIN_CAP (1u << 22)
__device__ __forceinline__ unsigned xb_ld(unsigned* p)              { return __hip_atomic_load(p, __ATOMIC_RELAXED, __HIP_MEMORY_SCOPE_AGENT); }
__device__ __forceinline__ unsigned xb_add(unsigned* p, unsigned v) { return __hip_atomic_fetch_add(p, v, __ATOMIC_RELAXED, __HIP_MEMORY_SCOPE_AGENT); }
__device__ __forceinline__ unsigned xb_xcc_id() { return (unsigned)__builtin_amdgcn_s_getreg((3 << 11) | 20) & 0xFu; }
#define XB_SPIN(cond, bar) do { unsigned _sp = 0; while (cond) { __builtin_amdgcn_s_sleep(1); \
    if ((++_sp & 255u) == 0u) { if (xb_ld(&(bar)[XB_TMO])) break; if (_sp > XB_SPIN_CAP) { atomicAdd(&(bar)[XB_TMO], 1u); break; } } } } while (0)
struct XcdBarrier { unsigned* bar; unsigned x; volatile LAS unsigned* st; };
__device__ __forceinline__ XcdBarrier xcd_barrier_post(unsigned* bar, volatile LAS unsigned* st) {
    XcdBarrier b; b.bar = bar; b.x = xb_xcc_id(); b.st = st;
    if (threadIdx.x == 0) (void)xb_add(&bar[XB_XCNT(b.x)], 1u);
    return b;
}
__device__ __forceinline__ void xcd_barrier_complete(unsigned* bar, unsigned x, unsigned& nloc, unsigned& nx) {
    const unsigned G = gridDim.x * gridDim.y * gridDim.z;
    unsigned sum, cnt, mine, sp = 0u;
    for (;;) {
        sum = 0u; cnt = 0u; mine = 0u;
#pragma unroll
        for (unsigned j = 0; j < 16; ++j) { const unsigned c = xb_ld(&bar[XB_XCNT(j)]); sum += c; cnt += (c > 0u) ? 1u : 0u; mine = (j == x) ? c : mine; }
        if (sum == G) break;
        __builtin_amdgcn_s_sleep(1);
        if ((++sp & 255u) == 0u) { if (xb_ld(&bar[XB_TMO])) break; if (sp > XB_SPIN_CAP) { atomicAdd(&bar[XB_TMO], 1u); break; } }
    }
    nloc = mine > 0u ? mine : 1u; nx = cnt > 0u ? cnt : 1u;
}
__device__ __forceinline__ void xcd_barrier(const XcdBarrier& b) {
    asm volatile("s_waitcnt vmcnt(0)" ::: "memory");
    __syncthreads();
    if (threadIdx.x == 0) {
        unsigned* bar = b.bar; asm volatile("" : "+s"(bar));
        __builtin_amdgcn_s_waitcnt(0);
        unsigned nloc = b.st[0], nx = b.st[1];
        if (nloc == 0u) { xcd_barrier_complete(bar, b.x, nloc, nx); b.st[0] = nloc; b.st[1] = nx; }
        const unsigned old = xb_add(&bar[XB_XSUB(b.x)], 1u);
        const unsigned gen = old / nloc;
        if (old + 1u == (gen + 1u) * nloc) {
            __builtin_amdgcn_fence(__ATOMIC_RELEASE, "agent");
            asm volatile("s_waitcnt vmcnt(0)" ::: "memory");
            const unsigned og = xb_add(&bar[XB_TOP], 1u);
            const unsigned tg = og / nx;
            if (og + 1u == (tg + 1u) * nx) xb_add(&bar[XB_TOPGEN], 1u);
            else XB_SPIN(xb_ld(&bar[XB_TOPGEN]) == tg, bar);
            __builtin_amdgcn_fence(__ATOMIC_ACQUIRE, "agent");
            asm volatile("s_waitcnt vmcnt(0)" ::: "memory");
        } else {
            XB_SPIN(xb_ld(&bar[XB_TOPGEN]) == gen, bar);
            __builtin_amdgcn_fence(__ATOMIC_ACQUIRE, "agent");
            asm volatile("s_waitcnt vmcnt(0)" ::: "memory");
        }
    }
    __syncthreads();
}
constexpr int LDS_BARW = LDS_BYTES - 16;

struct SchedAll {
    const LAS pg8::JobDesc* jt; int n0, n1, n2, n3, n4; int K, G, c; int moe; const char* A; const char* B; const int* tstart; const int* src; int nN; size_t bexp;
    __device__ __forceinline__ pg8::Unit get(int i, bool& ok) const {
        const char* ua = nullptr; const char* ub = nullptr; const int* us = nullptr; int upm = 0, upn = 0, ujob = 0; bool good = false;
        if (moe) {
            const int vc = (c & 7) * (G >> 3) + (c >> 3);
            const long L = (long)i * G + vc; const int ntile = tstart[32];
            if (L < (long)ntile * nN) {
                const int mt = (int)(L / nN), nt = (int)(L % nN);
                int e = 0;
                for (int k = 1; k < 32; ++k) if (tstart[k] <= mt) e = k;
                ua = src ? A : A + (size_t)mt * 256 * K * 2; us = src ? src + mt * 256 : nullptr; ub = B + (size_t)e * bexp + (size_t)nt * 256 * K * 2; upm = mt; upn = nt; good = true;
            }
        } else {
            long L = (long)i * G + c;
            if (L < (long)n0 + n1 + n2 + n3 + n4) {
                int l = (int)L; int jb = 0;
                if (l >= n0) { l -= n0; jb = 1; if (l >= n1) { l -= n1; jb = 2; if (l >= n2) { l -= n2; jb = 3; if (l >= n3) { l -= n3; jb = 4; } } } }
                const int jM = __builtin_amdgcn_readfirstlane(jt[jb].nM), jN = __builtin_amdgcn_readfirstlane(jt[jb].nN);
                int pm, pn; pg8::tile_order(l, jM, jN, pm, pn);
                const size_t tstep = (size_t)pg8::BM * K * 2;
                ua = (const char*)pg8::rfl64(jt[jb].A) + (size_t)pm * tstep; ub = (const char*)pg8::rfl64(jt[jb].B) + (size_t)pn * tstep; upm = pm; upn = pn; ujob = jb; good = true;
            }
        }
        pg8::Unit u; u.A = ua; u.B = ub; u.src = us; u.pm = upm; u.pn = upn; u.job = ujob; ok = good; return u;
    }
};
enum { MP_CONV = 0, MP_L0_G1, MP_L0_MIXA, MP_L0_SCAN, MP_L0_MIXC, MP_L0_G2, MP_XA_G1, MP_XA_ATTN, MP_XA_G2, MP_ROUTE, MP_SCATTER, MP_MOE_G1, MP_MOE_G2, MP_LN_MOE, MP_L1_G1, MP_L1_SWA, MP_L1_G2 };
struct SchedLN {
    const char* A; const char* B; int G, c;
    __device__ __forceinline__ pg8::Unit get(int i, bool& ok) const {
        const int L = i * G + c; const bool good = L < 512; int pm = 0, pn = 0; if (good) pg8::tile_order(L, 128, 4, pm, pn);
        const size_t tstep = (size_t)pg8::BM * 1024 * 2;
        pg8::Unit u; u.A = A + (size_t)pm * tstep; u.B = B + (size_t)pn * tstep; u.src = nullptr; u.pm = pm; u.pn = pn; u.job = 0; ok = good; return u;
    }
};
__device__ __forceinline__ int prog_kind(int i) {
    switch (i) { case 0: return MP_CONV; case 1: return MP_L0_G1; case 2: return MP_L0_MIXA; case 3: return MP_L0_SCAN; case 4: return MP_L0_MIXC; case 5: return MP_L0_G2;
        case 6: case 17: return MP_XA_G1; case 7: case 18: return MP_XA_ATTN; case 8: case 19: return MP_XA_G2; case 9: case 20: return MP_ROUTE; case 10: case 21: return MP_SCATTER;
        case 11: case 22: return MP_MOE_G1; case 12: case 23: return MP_MOE_G2; case 13: case 24: return MP_LN_MOE; case 14: return MP_L1_G1; case 15: return MP_L1_SWA; default: return MP_L1_G2; }
}
constexpr int N_PROG = 25;
__global__ void __launch_bounds__(NTHR, 2) mega(FP p0) {
    extern __shared__ __attribute__((aligned(16))) unsigned char smem[];
    LAS unsigned char* lds = (LAS unsigned char*)smem;
    cooperative_groups::grid_group grid = cooperative_groups::this_grid();
    const int blk0 = blockIdx.x, G0 = gridDim.x;
    volatile LAS unsigned* bst = (volatile LAS unsigned*)(lds + LDS_BARW);
    if (threadIdx.x == 0) { bst[0] = 0u; bst[1] = 0u; }
    __syncthreads();
    const XcdBarrier xbar = xcd_barrier_post((unsigned*)(p0.ws + P_BAR), bst);
    int dup = 0; (void)dup;
#pragma unroll 1
    for (int pi = 0; pi < N_PROG; ++pi) {
        int blk = blk0, G = G0; asm volatile("" : "+s"(blk), "+s"(G));
        const PV p = make_pv(p0);
        const int kind = prog_kind(pi), l = pi >= 14 ? 1 : 0;
        const bool is_gemm = kind == MP_L0_G1 || kind == MP_XA_G1 || kind == MP_MOE_G1 || kind == MP_MOE_G2 || kind == MP_L1_G1;
        const bool is_lnf = kind == MP_L0_G2 || kind == MP_XA_G2 || kind == MP_L1_G2;
        if (is_lnf) {
            const int site = kind == MP_L0_G2 ? 0 : (kind == MP_L1_G2 ? 2 : 1 + 2 * l), lnidx = kind == MP_L0_G2 ? 0 : (kind == MP_L1_G2 ? 3 : 1 + 3 * l);
            SchedLN S; S.G = G; S.c = blk;
            S.A = (const char*)(kind == MP_L0_G2 ? WSP(bf16_t, P_TMP + T_YM) : WSP(bf16_t, P_TMP + T_OB));
            S.B = (const char*)(kind == MP_L0_G2 ? WSP(bf16_t, P_WOUT_T) : (kind == MP_L1_G2 ? WSP(bf16_t, P_WO_T) : WSP(bf16_t, P_XWO_T) + (size_t)l * 1024 * 1024));
            __syncthreads();
            #ifdef PROBE_LNV
            const int drym = __builtin_amdgcn_readfirstlane((dup == 0 && (((PROBE_MASK) >> kind) & 1)) ? 1 : 0);
#else
            const int drym = 0;
#endif
            unsigned long long* slp = WSP(unsigned long long, P_TMP + T_SLOT) + (size_t)(site + 4 * drym) * 131072;
            if (threadIdx.x == 0) set_job(JT_PTR, 0, nullptr, nullptr, 128, 4, WSP(bf16_t, P_XBF), 1024, 0, p.in[2] + lnidx * 1024, p.in[3] + lnidx * 1024, nullptr);
            if (threadIdx.x == 0) { JT_PTR->mode = drym; JT_PTR->out2 = (unsigned long long)slp; }
            EpiLN E; E.lds = lds;
            __syncthreads();
            pg8::gemm_phase<EpiLN, SchedLN, true, true>(lds, 1024, S, E);
        } else if (is_gemm) {
            SchedAll S; S.jt = JT_PTR; S.n0 = S.n1 = S.n2 = S.n3 = S.n4 = 0; S.K = 1024; S.G = G; S.c = blk; S.moe = 0; S.A = S.B = nullptr; S.tstart = WSP(int, P_RT + RT_TSTART); S.src = nullptr; S.nN = 4; S.bexp = 0;
            __syncthreads();
            if (threadIdx.x == 0) {
                if (kind == MP_L0_G1) set_job(JT_PTR, 0, WSP(bf16_t, P_XBF), WSP(bf16_t, P_WIN_T), 128, 8, WSP(bf16_t, P_TMP + T_AU), 512, EM_GELU4);
                if (kind == MP_XA_G1) {
                    set_job(JT_PTR, 0, WSP(bf16_t, P_XBF), WSP(bf16_t, P_XWQ_T) + (size_t)l * 1024 * 1024, 128, 4, WSP(bf16_t, P_TMP + T_QX), 1024, EM_PLAIN);
                    if (l == 0) { for (int ll = 0; ll < 2; ++ll) { const bf16_t* wkv = WSP(bf16_t, P_XWKV_T) + (size_t)ll * 2048 * 1024;
                        set_job(JT_PTR, 1 + 2 * ll, WSP(bf16_t, P_MEMB), wkv, 8, 4, WSP(bf16_t, P_KC) + (size_t)ll * 2048 * 1024, 1024, EM_PLAIN);
                        set_job(JT_PTR, 2 + 2 * ll, wkv + (size_t)1024 * 1024, WSP(bf16_t, P_MEMB), 4, 8, WSP(bf16_t, P_VT) + (size_t)ll * 1024 * 2048, 2048, EM_PLAIN); } } }
                if (kind == MP_MOE_G1) set_job(JT_PTR, 0, nullptr, nullptr, 0, 0, WSP(bf16_t, P_TMP + T_HM), 512, EM_SWIGLU);
                if (kind == MP_MOE_G2) set_job(JT_PTR, 0, nullptr, nullptr, 0, 0, WSP(bf16_t, P_TMP + T_YG), 1024, EM_PLAIN);
                if (kind == MP_L1_G1) { set_job(JT_PTR, 0, WSP(bf16_t, P_XBF), WSP(bf16_t, P_WQKV_T), 128, 5, WSP(bf16_t, P_TMP + T_QX), 1024, EM_ROTARY, WSP(float, P_BQK), WSP(float, P_ROT), WSP(bf16_t, P_TMP + T_K1));
                    set_job(JT_PTR, 1, WSP(bf16_t, P_WQKV_T) + (size_t)1280 * 1024, WSP(bf16_t, P_XBF), 1, 128, WSP(bf16_t, P_TMP + T_VT1), NT, EM_ROWBIAS, p.in[20] + 1280); }
#ifdef PROBE_L1PLAIN
                if (kind == MP_L1_G1 && dup == 0) JT_PTR[0].mode = EM_PLAIN;
#endif
            }
            if (kind == MP_L0_G1) S.n0 = 1024;
            if (kind == MP_XA_G1) { S.n0 = 512; if (l == 0) { S.n1 = 32; S.n2 = 32; S.n3 = 32; S.n4 = 32; } }
            if (kind == MP_L1_G1) { S.n0 = 640; S.n1 = 128; }
            if (kind == MP_MOE_G1) { S.moe = 1; S.A = (const char*)WSP(bf16_t, P_XBF); S.src = WSP(int, P_RT + RT_SRC); S.B = (const char*)(l ? WSP(bf16_t, P_TMP + T_W13B) : WSP(bf16_t, P_W13T)); S.bexp = (size_t)1024 * 1024 * 2; }
            if (kind == MP_MOE_G2) { S.moe = 1; S.K = 512; S.A = (const char*)WSP(bf16_t, P_TMP + T_HM); S.B = (const char*)(l ? WSP(bf16_t, P_TMP + T_W2B) : WSP(bf16_t, P_W2T)); S.bexp = (size_t)1024 * 512 * 2; }
            __syncthreads();
            EpiMulti E; E.jt = JT_PTR;
#ifdef PROBE_GEMM2
#pragma unroll 1
            for (int rep = 0; rep < 2; ++rep)
#endif
            pg8::gemm_phase<EpiMulti, SchedAll, true, true>(lds, S.K, S, E);
            if (l == 0 && (kind == MP_XA_G1 || kind == MP_MOE_G1 || kind == MP_MOE_G2)) {
                const TailPlan tp = tail_plan(S.tstart[32], G);
                const int vc = kind == MP_XA_G1 ? blk : (blk & 7) * (G >> 3) + (blk >> 3);
                const int fi = kind == MP_XA_G1 ? 128 : tp.first_idle, quota = kind == MP_MOE_G2 ? TAILQ_G2 : (kind == MP_XA_G1 ? TAILQ_XA : TAILQ_G1), base = kind == MP_XA_G1 ? 0 : (kind == MP_MOE_G1 ? tp.t0 : tp.t0 + tp.t1);
                if (vc >= fi) { const int wv = __builtin_amdgcn_readfirstlane((int)threadIdx.x >> 6); int lq = threadIdx.x & 63; asm volatile("" : "+v"(lq));
                    const int f0 = base + ((vc - fi) * NWAVE + wv) * quota;
                    conv_moe1_range(p, (LAS float*)(lds + wv * 8448), lq, f0, 1, f0 + quota); }
            }
        } else {
#ifdef PROBE_MASK
#define DRY (dup == 0 && (((PROBE_MASK) >> kind) & 1))
#else
#define DRY false
#endif
            switch (kind) {
                case MP_CONV: { int gwr = blk * NWAVE + __builtin_amdgcn_readfirstlane((int)threadIdx.x >> 6);
                    ph_conv_l0(p, lds, blk, G, gwr); ph_conv_l1(p, lds, blk, G, gwr); ph_conv_xattn(p, lds, blk, G, 0, gwr); ph_conv_xattn(p, lds, blk, G, 1, gwr); ph_conv_moe(p, lds, blk, G, 0, gwr); ph_xin_to_bf(p, lds, blk, G); } break;
                case MP_L0_MIXA: { L0Bufs Bx = l0_bufs(p); if (DRY) { Bx.Q = Bx.K = WSP(bf16_t, P_TMP + 288 * MB); } l0_mixA(lds, Bx, blk, G); } break;
                case MP_L0_SCAN: ph_scan_conv(p, lds, blk, G); break;
                case MP_L0_MIXC: l0_mixC(lds, l0_bufs(p), blk, G); break;
                case MP_XA_ATTN: ph_xattn_attn(p, lds, blk, G, l); break;
                case MP_ROUTE: ph_moe_route(p, lds, blk, G, l); break;
                case MP_SCATTER: ph_moe_scatter(p, lds, blk, G); break;
                case MP_LN_MOE: if (l == 0) { ph_ln<false, false, true>(p, lds, blk, G, WSP(bf16_t, P_TMP + T_YG), 2, DRY); if (!(DRY)) { const int wv = __builtin_amdgcn_readfirstlane((int)threadIdx.x >> 6); int lq = threadIdx.x & 63; asm volatile("" : "+v"(lq)); { const TailPlan tp = tail_plan(WSP(int, P_RT + RT_TSTART)[32], G); conv_moe1_range(p, (LAS float*)(lds + wv * 8448), lq, tp.t0 + tp.t1 + tp.t2 + blk * NWAVE + wv, G * NWAVE, 12288); } conv_router_w(p, 1, blk * NTHR + (int)threadIdx.x, G * NTHR); } } else ph_ln<false, true, true>(p, lds, blk, G, WSP(bf16_t, P_TMP + T_YG), 5, DRY); break;
                default: ph_l1_swa(p, lds, blk, G); break;
            }
        }
#ifdef PROBE_MASK
        if (((PROBE_MASK) >> kind) & 1) { if (dup == 0) { dup = 1; xcd_barrier(xbar); --pi; continue; } dup = 0; }
#endif
        if (pi + 1 < N_PROG) { if (p0.ws == nullptr) grid.sync(); else { xcd_barrier(xbar);
#ifdef PROBE_BAR2
            xcd_barrier(xbar);
#endif
        } }
    }
}
}
extern "C" void kernel_launch(void* const* d_in, const int* in_sizes, int n_in, void* d_out, int out_size, void* d_ws, size_t ws_size, hipStream_t stream) {
    static int ok = 0;
    if (ok == 0) {
        ok = -1;
        if (n_in != 33 || out_size != 32768 * 1024 || ws_size < fk::FAST_END + (fk::SLOT_MB - 4) * fk::MB) { fprintf(stderr, "kernel_launch: unexpected shapes/ws (%d, %d, %zu)\n", n_in, out_size, ws_size); return; }
        int dev = 0, cus = 0, per_cu = 0;
        if (hipGetDevice(&dev) != hipSuccess || hipDeviceGetAttribute(&cus, hipDeviceAttributeMultiprocessorCount, dev) != hipSuccess) return;
        if (hipFuncSetAttribute((const void*)fk::mega, hipFuncAttributeMaxDynamicSharedMemorySize, fk::LDS_BYTES) != hipSuccess) return;
        if (hipOccupancyMaxActiveBlocksPerMultiprocessor(&per_cu, (const void*)fk::mega, fk::NTHR, fk::LDS_BYTES) != hipSuccess || per_cu < 1 || cus * per_cu < 256) { fprintf(stderr, "kernel_launch: cannot co-reside 256 workgroups (%d CUs x %d)\n", cus, per_cu); return; }
        ok = 1;
    }
    if (ok < 0) return;
    fk::FP p{}; for (int i = 0; i < 33; ++i) p.in[i] = (const float*)d_in[i]; p.X = (float*)d_out; p.ws = (unsigned char*)d_ws;
    if (hipMemsetAsync((char*)d_ws + fk::P_BAR, 0, 16384, stream) != hipSuccess) return;
    if (hipMemsetAsync((char*)d_ws + fk::P_TMP + fk::T_SLOT, 0xFF, fk::SLOT_MB * fk::MB, stream) != hipSuccess) return;
    void* args[] = {&p};
    hipError_t e = hipLaunchCooperativeKernel((const void*)fk::mega, dim3(256), dim3(fk::NTHR), args, fk::LDS_BYTES, stream);
    if (e != hipSuccess) fprintf(stderr, "cooperative launch failed: %s\n", hipGetErrorString(e));
}
```

```cpp
#include <hip/hip_runtime.h>
#include <hip/hip_cooperative_groups.h>
#include <cstdio>
#include <cstdint>
#include <cmath>
namespace fk {
#define LAS __attribute__((address_space(3)))
typedef unsigned short bf16_t;
typedef short bf16x8 __attribute__((ext_vector_type(8)));
typedef short s16x4 __attribute__((ext_vector_type(4)));
typedef float f32x4 __attribute__((ext_vector_type(4)));
typedef float f32x16 __attribute__((ext_vector_type(16)));
typedef float f32x2 __attribute__((ext_vector_type(2)));
typedef unsigned u32x4 __attribute__((ext_vector_type(4)));
typedef unsigned u32x2 __attribute__((ext_vector_type(2)));
typedef __bf16 bf16x2_t __attribute__((ext_vector_type(2)));

constexpr int NT = 32768, DM = 1024, SEQ = 4096;
constexpr int NTHR = 512, NWAVE = 8;
constexpr float ALPHA = 1.4142135623730951f, LN_EPS = 1e-5f, LOG2E = 1.4426950408889634f;

__device__ __forceinline__ unsigned pk2(float lo, float hi) { f32x2 v = {lo, hi}; bf16x2_t b = __builtin_convertvector(v, bf16x2_t); return __builtin_bit_cast(unsigned, b); }
__device__ __forceinline__ float bf_lo(unsigned w) { return __uint_as_float(w << 16); }
__device__ __forceinline__ float bf_hi(unsigned w) { return __uint_as_float(w & 0xffff0000u); }
__device__ __forceinline__ float bf2f(bf16_t b) { return __uint_as_float(((unsigned)b) << 16); }
__device__ __forceinline__ bf16_t f2bf(float f) { return (bf16_t)(pk2(f, 0.f) & 0xffffu); }
__device__ __forceinline__ float fast_exp(float x) { return __builtin_amdgcn_exp2f(x * LOG2E); }
__device__ __forceinline__ float sigmoid_f(float x) { return __builtin_amdgcn_rcpf(1.f + fast_exp(-x)); }
__device__ __forceinline__ float silu_f(float x) { return x * sigmoid_f(x); }
__device__ __forceinline__ float gelu_tanh_f(float x) { const float u = 1.5957691216057308f * (x + 0.044715f * x * x * x); return x * sigmoid_f(u); }
__device__ __forceinline__ int crow(int r, int hi) { return (r & 3) + 8 * (r >> 2) + 4 * hi; }
__device__ __forceinline__ float xhalf_sum(float v) { auto rr = __builtin_amdgcn_permlane32_swap(__float_as_uint(v), __float_as_uint(v), false, false); return __uint_as_float(rr[0]) + __uint_as_float(rr[1]); }
__device__ __forceinline__ float xhalf_max(float v) { auto rr = __builtin_amdgcn_permlane32_swap(__float_as_uint(v), __float_as_uint(v), false, false); return fmaxf(__uint_as_float(rr[0]), __uint_as_float(rr[1])); }
__device__ __forceinline__ float shx(float v, int o, int lane) { return __int_as_float(__builtin_amdgcn_ds_bpermute((lane ^ o) << 2, __float_as_int(v))); }
__device__ __forceinline__ float shup(float v, int o, int lane) { return __int_as_float(__builtin_amdgcn_ds_bpermute(((lane - o) & 63) << 2, __float_as_int(v))); }
__device__ __forceinline__ float shidx(float v, int idx) { return __int_as_float(__builtin_amdgcn_ds_bpermute(idx << 2, __float_as_int(v))); }
__device__ __forceinline__ s16x4 lds_tr(const LAS void* p) { return __builtin_bit_cast(s16x4, __builtin_amdgcn_ds_read_tr16_b64_v4i16((LAS s16x4*)p)); }
#define MFMA32(a, b, c) __builtin_amdgcn_mfma_f32_32x32x16_bf16((a), (b), (c), 0, 0, 0)

namespace pg8 {
constexpr int BM = 256, BK = 64, HALF = 128, HTB = HALF * BK * 2, STAGE_BYTES = 8 * HTB, NXCD = 8, WGM = 8;
__host__ __device__ __forceinline__ int lds_byte(int r, int c) { const int st = (r >> 4) * 2 + (c >> 5), rr = r & 15, cc = c & 31, ob = rr * 64 + cc * 2; return st * 1024 + (ob ^ (((ob >> 9) & 1) << 5)); }
__host__ __device__ __forceinline__ void stage_rc(int b, int& R, int& C) { const int st = b / 1024, sb = b % 1024, swz = sb ^ (((sb >> 9) & 1) << 5); R = (st >> 1) * 16 + swz / 64; C = (st & 1) * 32 + (swz % 64) / 2; }
__host__ __device__ __forceinline__ int perm32(int rho) { const int n = rho >> 4, i = rho & 15; return 8 * (i >> 2) + 4 * n + (i & 3); }

struct Unit { const char* A; const char* B; const int* src; int pm, pn, job; };

__device__ __forceinline__ void tile_order(int l, int nM, int nN, int& pm, int& pn) {
    const int nwg = nM * nN; int wgid = l;
    { const int q = nwg / NXCD, r = nwg % NXCD, xcd = wgid % NXCD, off = wgid / NXCD; wgid = (xcd < r ? xcd * (q + 1) : r * (q + 1) + (xcd - r) * q) + off; }
    const int nig = WGM * nN, gid = wgid / nig, fm = gid * WGM, gsz = (nM - fm) < WGM ? (nM - fm) : WGM;
    pm = fm + ((wgid % nig) % gsz); pn = (wgid % nig) / gsz;
}
struct JobDesc { unsigned long long A, B, out, bias, rot, out2; int nM, nN, ldc, mode; };
__device__ __forceinline__ unsigned long long rfl64(unsigned long long v) { const unsigned lo = __builtin_amdgcn_readfirstlane((unsigned)v), hi = __builtin_amdgcn_readfirstlane((unsigned)(v >> 32)); return ((unsigned long long)hi << 32) | lo; }
constexpr int JT_OFF = STAGE_BYTES;
struct Jobs3 {
    const LAS JobDesc* jt; int n0, n1, n2; int K, G, c;
    __device__ __forceinline__ Unit get(int i, bool& ok) const { Unit u; u.A = nullptr; u.B = nullptr; u.src = nullptr; u.pm = 0; u.pn = 0; u.job = 0; ok = next(i, u); return u; }
    __device__ __forceinline__ bool next(int i, Unit& u) const {
        long L = (long)i * G + c;
        if (L >= (long)n0 + n1 + n2) return false;
        int l = (int)L; int jb = 0;
        if (l >= n0) { l -= n0; jb = 1; if (l >= n1) { l -= n1; jb = 2; } }
        const int jM = __builtin_amdgcn_readfirstlane(jt[jb].nM), jN = __builtin_amdgcn_readfirstlane(jt[jb].nN);
        int pm, pn; tile_order(l, jM, jN, pm, pn);
        const size_t tstep = (size_t)BM * K * 2;
        u.A = (const char*)rfl64(jt[jb].A) + (size_t)pm * tstep; u.B = (const char*)rfl64(jt[jb].B) + (size_t)pn * tstep; u.src = nullptr; u.pm = pm; u.pn = pn; u.job = jb; return true;
    }
};

template <class Epi, class Sched, bool ALIGN_EPI, bool SP2>
__device__ __forceinline__ void gemm_phase(LAS unsigned char* lds, const int K, const Sched& S, const Epi& E) {
    int tid_ = threadIdx.x; asm volatile("" : "+v"(tid_)); const int tid = tid_, wid = __builtin_amdgcn_readfirstlane(tid >> 6), lane = tid & 63, wr = wid >> 2, wc = wid & 3, fr = lane & 15, fq = lane >> 4;
    const int nt = K / BK;
    static_assert(SP2, "only the two-super-phase form is kept");
    unsigned vA0[2], vA1[2], vB0[2];
#pragma unroll
    for (int i = 0; i < 2; ++i) { int R, C; stage_rc(tid * 16 + i * 8192, R, C); const int Rb = 64 * (R >> 5) + perm32(R & 31); vB0[i] = (unsigned)(Rb * K + C) * 2u; }
    const size_t bhalf = (size_t)32 * K * 2;
    auto a_rows = [&](const int* src, unsigned (&o0)[2], unsigned (&o1)[2]) {
        int tq = threadIdx.x; asm volatile("" : "+v"(tq));
#pragma unroll
        for (int i = 0; i < 2; ++i) { int R, C; stage_rc(tq * 16 + i * 8192, R, C); int r0 = R, r1 = R + HALF; if (src) { r0 = src[R]; r1 = src[R + HALF]; }
            o0[i] = (unsigned)(r0 * K + C) * 2u; o1[i] = (unsigned)(r1 * K + C) * 2u; }
    };
    const size_t kstep = (size_t)(BK * 2);
    const size_t hstep = (size_t)HALF * K * 2;
    const unsigned ldsw = (unsigned)wid * 1024u;
    const int aoff = lds_byte(wr * 64 + fr, fq * 8), boff = lds_byte(wc * 32 + fr, fq * 8);
#define PG8_SA(b, h) (((b) * 2 + (h)) * HTB)
#define PG8_SB(b, h) ((4 + (b) * 2 + (h)) * HTB)
#define PG8_STAGE(bufoff, gbase, voff) do { _Pragma("unroll") for (int _i = 0; _i < 2; ++_i) \
        __builtin_amdgcn_global_load_lds((const unsigned*)((const char*)(gbase) + (voff)[_i]), (LAS unsigned*)(lds + (bufoff) + ldsw + _i * 8192), 16, 0, 0); } while (0)
#define PG8_LDA(dst, b, h) do { _Pragma("unroll") for (int m = 0; m < 4; ++m) _Pragma("unroll") for (int k = 0; k < 2; ++k) dst[m][k] = *(const LAS bf16x8*)(lds + PG8_SA(b, h) + aoff + m * 2048 + k * 1024); } while (0)
#define PG8_LDB(dst, b, h) do { _Pragma("unroll") for (int n = 0; n < 2; ++n) _Pragma("unroll") for (int k = 0; k < 2; ++k) dst[n][k] = *(const LAS bf16x8*)(lds + PG8_SB(b, h) + boff + n * 2048 + k * 1024); } while (0)
#define PG8_MMA(ai, bj, At, Bt) do { __builtin_amdgcn_s_setprio(1); _Pragma("unroll") for (int m = 0; m < 4; ++m) _Pragma("unroll") for (int n = 0; n < 2; ++n) _Pragma("unroll") for (int k = 0; k < 2; ++k) \
        acc[ai][bj][m][n] = __builtin_amdgcn_mfma_f32_16x16x32_bf16(Bt[n][k], At[m][k], acc[ai][bj][m][n], 0, 0, 0); __builtin_amdgcn_s_setprio(0); } while (0)
#define PG8_WAIT_V(n) asm volatile("s_waitcnt vmcnt(" #n ")" ::: "memory")
#define PG8_WAIT_L(n) asm volatile("s_waitcnt lgkmcnt(" #n ")" ::: "memory")
#define PG8_BAR __builtin_amdgcn_s_barrier()
#define PG8_SCHED __builtin_amdgcn_sched_barrier(0)
    auto unif = [](Unit u) { Unit r; r.A = (const char*)rfl64((unsigned long long)u.A); r.B = (const char*)rfl64((unsigned long long)u.B); r.src = (const int*)rfl64((unsigned long long)u.src);
        r.pm = __builtin_amdgcn_readfirstlane(u.pm); r.pn = __builtin_amdgcn_readfirstlane(u.pn); r.job = __builtin_amdgcn_readfirstlane(u.job); return r; };
    int ui = 0; bool ok0; Unit cur = unif(S.get(0, ok0));
    if (!ok0) return;
    f32x4 acc[2][2][4][2];
    E.prefetch(cur, wr, wc, fr, fq);
    bf16x8 At[4][2], B0[2][2], B1[2][2];
    const char* cA = cur.A; const char* cB = cur.B;
    a_rows(cur.src, vA0, vA1);
    {
        PG8_STAGE(PG8_SB(0, 0), cB, vB0); PG8_STAGE(PG8_SB(0, 1), cB + bhalf, vB0); PG8_STAGE(PG8_SA(0, 0), cA, vA0); PG8_STAGE(PG8_SA(0, 1), cA, vA1);
        if (wr == 1) PG8_BAR;
        PG8_WAIT_V(2); PG8_BAR;
        PG8_STAGE(PG8_SB(1, 0), cB + kstep, vB0); PG8_STAGE(PG8_SA(1, 0), cA + kstep, vA0); PG8_STAGE(PG8_SB(1, 1), cB + kstep + bhalf, vB0);
        PG8_WAIT_V(6); PG8_BAR;
    }
    for (;;) {
        E.init(acc);
        bool has_next; const Unit nxt = unif(S.get(ui + 1, has_next)); bool early_done = false;
        const char* nA = has_next ? nxt.A : cA; const char* nB = has_next ? nxt.B : cB;
        for (int t = 0; t < nt; t += 2) {
            const bool last = (t == nt - 2);
            const char* a1 = cA + (size_t)(t + 1) * kstep;
            const char* a2 = last ? nA : cA + (size_t)(t + 2) * kstep; const char* b2 = last ? nB : cB + (size_t)(t + 2) * kstep;
            const char* a3 = a2 + kstep; const char* b3 = b2 + kstep;
            PG8_LDB(B0, 0, 0); PG8_LDB(B1, 0, 1); PG8_SCHED; PG8_LDA(At, 0, 0); PG8_STAGE(PG8_SA(1, 1), a1, vA1);
            if (last && has_next) a_rows(nxt.src, vA0, vA1);
            PG8_WAIT_V(8); PG8_WAIT_L(0); PG8_BAR; PG8_MMA(0, 0, At, B0); PG8_MMA(0, 1, At, B1); PG8_BAR; PG8_SCHED;
            PG8_LDA(At, 0, 1); PG8_STAGE(PG8_SB(0, 0), b2, vB0); PG8_STAGE(PG8_SB(0, 1), b2 + bhalf, vB0); PG8_STAGE(PG8_SA(0, 0), a2, vA0);
            PG8_WAIT_V(8); PG8_WAIT_L(0); PG8_BAR; PG8_MMA(1, 0, At, B0); PG8_MMA(1, 1, At, B1); PG8_BAR; PG8_SCHED;
            PG8_LDB(B0, 1, 0); PG8_LDB(B1, 1, 1); PG8_SCHED; PG8_LDA(At, 1, 0); PG8_STAGE(PG8_SA(0, 1), a2, vA1);
            PG8_WAIT_V(8); PG8_WAIT_L(0); PG8_BAR; PG8_MMA(0, 0, At, B0); PG8_MMA(0, 1, At, B1); PG8_BAR; PG8_SCHED;
            if (last) { early_done = E.early(acc, cur, wr, wc, fr, fq); PG8_SCHED; }
            PG8_LDA(At, 1, 1); PG8_STAGE(PG8_SB(1, 0), b3, vB0); PG8_STAGE(PG8_SB(1, 1), b3 + bhalf, vB0); PG8_STAGE(PG8_SA(1, 0), a3, vA0);
            PG8_WAIT_V(8); PG8_WAIT_L(0); PG8_BAR; PG8_MMA(1, 0, At, B0); PG8_MMA(1, 1, At, B1); PG8_BAR; PG8_SCHED;
        }
        if constexpr (ALIGN_EPI) { if (wr == 0) PG8_BAR; }
        E.prefetch(nxt, wr, wc, fr, fq);
        if (!early_done) E.template half<0>(acc, cur, wr, wc, fr, fq);
        E.template half<1>(acc, cur, wr, wc, fr, fq);
        if (!has_next) break;
        cur = nxt; cA = nA; cB = nB; ++ui;
        if constexpr (ALIGN_EPI) { if (wr == 1) PG8_BAR; }
    }
    PG8_WAIT_V(0);
    if constexpr (!ALIGN_EPI) { if (wr == 0) PG8_BAR; }
    PG8_BAR;
#undef PG8_SA
#undef PG8_SB
#undef PG8_STAGE
#undef PG8_LDA
#undef PG8_LDB
#undef PG8_MMA
#undef PG8_WAIT_V
#undef PG8_WAIT_L
#undef PG8_BAR
#undef PG8_SCHED
}
}
enum { EM_PLAIN = 0, EM_GELU4 = 1, EM_SWIGLU = 2, EM_ROTARY = 3, EM_ROWBIAS = 4 };
struct EpiMulti {
    static constexpr bool PERM = true;
    const LAS pg8::JobDesc* jt;
    __device__ __forceinline__ void prefetch(const pg8::Unit&, int, int, int, int) const {}
    __device__ __forceinline__ void init(f32x4 (&acc)[2][2][4][2]) const {
#pragma unroll
        for (int a = 0; a < 2; ++a)
#pragma unroll
            for (int b = 0; b < 2; ++b)
#pragma unroll
                for (int m = 0; m < 4; ++m)
#pragma unroll
                    for (int n = 0; n < 2; ++n) acc[a][b][m][n] = (f32x4){0.f, 0.f, 0.f, 0.f};
    }
    __device__ __forceinline__ bool early(const f32x4 (&acc)[2][2][4][2], const pg8::Unit& u, int wr, int wc, int fr, int fq) const {
        const LAS pg8::JobDesc* jd = jt + u.job;
        if (__builtin_amdgcn_readfirstlane(jd->mode) != EM_PLAIN) return false;
        bf16_t* out = (bf16_t*)pg8::rfl64(jd->out); const int ldc = __builtin_amdgcn_readfirstlane(jd->ldc);
        bf16_t* rowp = out + (size_t)(u.pm * 256 + wr * 64 + fr) * ldc + u.pn * 256 + wc * 64 + 8 * fq;
#pragma unroll
        for (int m = 0; m < 4; ++m)
#pragma unroll
            for (int bj = 0; bj < 2; ++bj) { const f32x4 v0 = acc[0][bj][m][0], v1 = acc[0][bj][m][1];
                u32x4 w; w.x = pk2(v0[0], v0[1]); w.y = pk2(v0[2], v0[3]); w.z = pk2(v1[0], v1[1]); w.w = pk2(v1[2], v1[3]);
                *(u32x4*)(rowp + (size_t)m * 16 * ldc + bj * 32) = w; }
        return true;
    }
    template <int AI>
    __device__ __forceinline__ void half(const f32x4 (&acc)[2][2][4][2], const pg8::Unit& u, int wr, int wc, int fr, int fq) const {
        const LAS pg8::JobDesc* jd = jt + u.job;
        bf16_t* out = (bf16_t*)pg8::rfl64(jd->out);
        const int ldc = __builtin_amdgcn_readfirstlane(jd->ldc);
        const int mode = __builtin_amdgcn_readfirstlane(jd->mode);
        const float* bias = (const float*)pg8::rfl64(jd->bias);
        const int row0 = u.pm * 256 + wr * 64 + fr;
        const int colt = u.pn * 256 + wc * 64 + 8 * fq;
        if (mode == EM_PLAIN || mode == EM_ROWBIAS) {
#pragma unroll
            for (int ai = AI; ai < AI + 1; ++ai)
#pragma unroll
                for (int m = 0; m < 4; ++m) { const int row = row0 + ai * 128 + m * 16; const float rb = (mode == EM_ROWBIAS && bias) ? bias[row] : 0.f;
                    bf16_t* rowp = out + (size_t)row * ldc + colt;
#pragma unroll
                    for (int bj = 0; bj < 2; ++bj) { const f32x4 v0 = acc[ai][bj][m][0] + rb, v1 = acc[ai][bj][m][1] + rb;
                        u32x4 w; w.x = pk2(v0[0], v0[1]); w.y = pk2(v0[2], v0[3]); w.z = pk2(v1[0], v1[1]); w.w = pk2(v1[2], v1[3]);
                        *(u32x4*)(rowp + bj * 32) = w; } }
        } else if (mode == EM_GELU4) {
            const int arr = u.pn >> 1; bf16_t* base = out + (size_t)arr * NT * 512; const int col = colt - arr * 512; const bool act = arr < 2;
#pragma unroll
            for (int ai = AI; ai < AI + 1; ++ai)
#pragma unroll
                for (int m = 0; m < 4; ++m) { bf16_t* rowp = base + (size_t)(row0 + ai * 128 + m * 16) * 512 + col;
#pragma unroll
                    for (int bj = 0; bj < 2; ++bj) { f32x4 v0 = acc[ai][bj][m][0], v1 = acc[ai][bj][m][1];
                        if (act) {
#pragma unroll
                            for (int e = 0; e < 4; ++e) { v0[e] = gelu_tanh_f(v0[e]); v1[e] = gelu_tanh_f(v1[e]); } }
                        u32x4 w; w.x = pk2(v0[0], v0[1]); w.y = pk2(v0[2], v0[3]); w.z = pk2(v1[0], v1[1]); w.w = pk2(v1[2], v1[3]);
                        *(u32x4*)(rowp + bj * 32) = w; } }
        } else if (mode == EM_SWIGLU) {
#pragma unroll
            for (int ai = AI; ai < AI + 1; ++ai)
#pragma unroll
                for (int m = 0; m < 4; ++m) { bf16_t* rowp = out + (size_t)(row0 + ai * 128 + m * 16) * ldc + (colt >> 1);
#pragma unroll
                    for (int bj = 0; bj < 2; ++bj) { const f32x4 v0 = acc[ai][bj][m][0], v1 = acc[ai][bj][m][1];
                        u32x2 w; w.x = pk2(silu_f(v0[0]) * v0[1], silu_f(v0[2]) * v0[3]); w.y = pk2(silu_f(v1[0]) * v1[1], silu_f(v1[2]) * v1[3]);
                        *(u32x2*)(rowp + bj * 16) = w; } }
        } else {
            const float* rot = (const float*)pg8::rfl64(jd->rot);
            bf16_t* out2 = (bf16_t*)pg8::rfl64(jd->out2);
            const bool isk = u.pn >= 4; bf16_t* base = isk ? out2 : out; const int ld = isk ? 256 : 1024; const int colo = isk ? colt - 1024 : colt;
            float bv[2][8];
#pragma unroll
            for (int bj = 0; bj < 2; ++bj) { f32x4 b0 = (f32x4){0.f, 0.f, 0.f, 0.f}, b1 = b0; if (bias) { b0 = *(const f32x4*)(bias + colt + bj * 32); b1 = *(const f32x4*)(bias + colt + bj * 32 + 4); }
#pragma unroll
                for (int e = 0; e < 4; ++e) { bv[bj][e] = b0[e]; bv[bj][4 + e] = b1[e]; } }
            const int i0 = (colt & 63) >> 1;
#pragma unroll
            for (int ai = AI; ai < AI + 1; ++ai)
#pragma unroll
                for (int m = 0; m < 4; ++m) { const int row = row0 + ai * 128 + m * 16; const int pos = row & (SEQ - 1);
                    bf16_t* rowp = base + (size_t)row * ld + colo;
#pragma unroll
                    for (int bj = 0; bj < 2; ++bj) { f32x4 v0 = acc[ai][bj][m][0], v1 = acc[ai][bj][m][1];
                        const f32x4 cs0 = *(const f32x4*)(rot + ((size_t)pos * 32 + i0 + 16 * bj) * 2), cs1 = *(const f32x4*)(rot + ((size_t)pos * 32 + i0 + 16 * bj + 2) * 2);
#pragma unroll
                        for (int e = 0; e < 4; ++e) { v0[e] += bv[bj][e]; v1[e] += bv[bj][4 + e]; }
                        const float a0 = v0[0] * cs0[0] - v0[1] * cs0[1], b0 = v0[1] * cs0[0] + v0[0] * cs0[1];
                        const float a1 = v0[2] * cs0[2] - v0[3] * cs0[3], b1 = v0[3] * cs0[2] + v0[2] * cs0[3];
                        const float a2 = v1[0] * cs1[0] - v1[1] * cs1[1], b2 = v1[1] * cs1[0] + v1[0] * cs1[1];
                        const float a3 = v1[2] * cs1[2] - v1[3] * cs1[3], b3 = v1[3] * cs1[2] + v1[2] * cs1[3];
                        u32x4 w; w.x = pk2(a0, b0); w.y = pk2(a1, b1); w.z = pk2(a2, b2); w.w = pk2(a3, b3);
                        *(u32x4*)(rowp + bj * 32) = w; } }
        }
    }
};

#define GAS __attribute__((address_space(1)))
#define P_TMP_PROBE (194ull * 1048576ull)
constexpr int LNF_PART = pg8::JT_OFF + 1024;
constexpr int LNF_STAT = LNF_PART + 8192;
struct EpiLN {
    static constexpr bool PERM = true;
    LAS unsigned char* lds;
    mutable u32x4 pre[2][4][2];
    __device__ __forceinline__ void prefetch(const pg8::Unit& u, int, int, int, int) const {
        int tq = threadIdx.x; asm volatile("" : "+v"(tq)); const int wq = __builtin_amdgcn_readfirstlane(tq >> 6), wr = wq >> 2, wc = wq & 3, fr = tq & 15, fq = (tq & 63) >> 4;
        const unsigned long long xio = pg8::rfl64(((const LAS pg8::JobDesc*)(lds + pg8::JT_OFF))->out);
        const GAS unsigned char* tb = (const GAS unsigned char*)(xio + ((size_t)u.pm * 256 * 1024 + u.pn * 256) * 2);
        const unsigned loff = (unsigned)((wr * 64 + fr) * 1024 + wc * 64 + 8 * fq) * 2u;
#pragma unroll
        for (int ai = 0; ai < 2; ++ai)
#pragma unroll
            for (int m = 0; m < 4; ++m)
#pragma unroll
                for (int bj = 0; bj < 2; ++bj) pre[ai][m][bj] = *(const GAS u32x4*)(tb + (ai * 128 + m * 16) * 2048 + bj * 64 + loff);
    }
    __device__ __forceinline__ void init(f32x4 (&acc)[2][2][4][2]) const {
#pragma unroll
        for (int ai = 0; ai < 2; ++ai)
#pragma unroll
            for (int m = 0; m < 4; ++m)
#pragma unroll
                for (int bj = 0; bj < 2; ++bj) { const u32x4 w = pre[ai][m][bj];
                    acc[ai][bj][m][0] = (f32x4){ALPHA * bf_lo(w.x), ALPHA * bf_hi(w.x), ALPHA * bf_lo(w.y), ALPHA * bf_hi(w.y)};
                    acc[ai][bj][m][1] = (f32x4){ALPHA * bf_lo(w.z), ALPHA * bf_hi(w.z), ALPHA * bf_lo(w.w), ALPHA * bf_hi(w.w)};
                    __builtin_amdgcn_sched_barrier(0); }
    }
    __device__ __forceinline__ bool early(const f32x4 (&)[2][2][4][2], const pg8::Unit&, int, int, int, int) const { return false; }
    template <int AI>
    __device__ __forceinline__ void half(f32x4 (&acc)[2][2][4][2], const pg8::Unit& u, int, int, int, int) const {
        int tid_ = threadIdx.x; asm volatile("" : "+v"(tid_)); const int tid = tid_, lane = tid & 63;
        const int wq = __builtin_amdgcn_readfirstlane(tid >> 6), wr = wq >> 2, wc = wq & 3, fr = lane & 15, fq = lane >> 4;
        const int colt = u.pn * 256 + wc * 64 + 8 * fq;
        LAS f32x2* part = (LAS f32x2*)(lds + LNF_PART);
        LAS f32x2* stat = (LAS f32x2*)(lds + LNF_STAT);
#pragma unroll
        for (int m = 0; m < 4; ++m) { const int rl = AI * 128 + wr * 64 + m * 16 + fr;
            float s1 = 0.f, s2 = 0.f;
#pragma unroll
            for (int bj = 0; bj < 2; ++bj) { const f32x4 v0 = acc[AI][bj][m][0], v1 = acc[AI][bj][m][1];
#pragma unroll
                for (int e = 0; e < 4; ++e) { s1 += v0[e] + v1[e]; s2 += v0[e] * v0[e] + v1[e] * v1[e]; } }
            s1 += shx(s1, 16, lane); s2 += shx(s2, 16, lane); s1 += shx(s1, 32, lane); s2 += shx(s2, 32, lane);
            if (fq == 0) part[rl * 4 + wc] = (f32x2){s1, s2}; }
        if constexpr (AI == 1) {
            __syncthreads();
            if (tid < 256) {
                const f32x2 p0 = part[tid * 4], p1 = part[tid * 4 + 1], p2 = part[tid * 4 + 2], p3 = part[tid * 4 + 3];
                const float t1 = (p0[0] + p1[0]) + (p2[0] + p3[0]), t2 = (p0[1] + p1[1]) + (p2[1] + p3[1]);
                unsigned long long* sl = (unsigned long long*)pg8::rfl64(((const LAS pg8::JobDesc*)(lds + pg8::JT_OFF))->out2) + (size_t)u.pm * 1024 + tid;
#ifdef PROBE_LNV
                const bool dryp = __builtin_amdgcn_readfirstlane(((const LAS pg8::JobDesc*)(lds + pg8::JT_OFF))->mode) != 0;
#endif
                __hip_atomic_store(sl + u.pn * 256, ((unsigned long long)__float_as_uint(t2) << 32) | __float_as_uint(t1), __ATOMIC_RELAXED, __HIP_MEMORY_SCOPE_AGENT);
                unsigned long long x0, x1, x2, x3; unsigned sp = 0;
                for (;;) {
                    x0 = __hip_atomic_load(sl, __ATOMIC_RELAXED, __HIP_MEMORY_SCOPE_AGENT); x1 = __hip_atomic_load(sl + 256, __ATOMIC_RELAXED, __HIP_MEMORY_SCOPE_AGENT);
                    x2 = __hip_atomic_load(sl + 512, __ATOMIC_RELAXED, __HIP_MEMORY_SCOPE_AGENT); x3 = __hip_atomic_load(sl + 768, __ATOMIC_RELAXED, __HIP_MEMORY_SCOPE_AGENT);
                    if ((x0 != ~0ull && x1 != ~0ull && x2 != ~0ull && x3 != ~0ull) || ++sp > (1u << 22)) break;
#ifdef PROBE_LNV
                    if (dryp && ((PROBE_LNV) & 1)) break;
#endif
                    __builtin_amdgcn_s_sleep(1); }
#ifdef PROBE_LNX
                {   unsigned long long* sl2 = sl + 4 * 131072;
                    __hip_atomic_store(sl2 + u.pn * 256, ((unsigned long long)__float_as_uint(t2) << 32) | __float_as_uint(t1), __ATOMIC_RELAXED, __HIP_MEMORY_SCOPE_AGENT);
                    unsigned long long y0, y1, y2, y3; unsigned sq = 0;
                    for (;;) { y0 = __hip_atomic_load(sl2, __ATOMIC_RELAXED, __HIP_MEMORY_SCOPE_AGENT); y1 = __hip_atomic_load(sl2 + 256, __ATOMIC_RELAXED, __HIP_MEMORY_SCOPE_AGENT);
                        y2 = __hip_atomic_load(sl2 + 512, __ATOMIC_RELAXED, __HIP_MEMORY_SCOPE_AGENT); y3 = __hip_atomic_load(sl2 + 768, __ATOMIC_RELAXED, __HIP_MEMORY_SCOPE_AGENT);
                        if ((y0 != ~0ull && y1 != ~0ull && y2 != ~0ull && y3 != ~0ull) || ++sq > (1u << 22)) break;
                        __builtin_amdgcn_s_sleep(1); }
                    if (y0 == 0x123456789ull) x0 = y1; }
#endif
                const float S1 = (__uint_as_float((unsigned)x0) + __uint_as_float((unsigned)x1)) + (__uint_as_float((unsigned)x2) + __uint_as_float((unsigned)x3));
                const float S2 = (__uint_as_float((unsigned)(x0 >> 32)) + __uint_as_float((unsigned)(x1 >> 32))) + (__uint_as_float((unsigned)(x2 >> 32)) + __uint_as_float((unsigned)(x3 >> 32)));
                const float mean = S1 * (1.f / 1024.f); const float var = fmaxf(S2 * (1.f / 1024.f) - mean * mean, 0.f);
                stat[tid] = (f32x2){mean, __builtin_amdgcn_rsqf(var + LN_EPS)};
            }
            __syncthreads();
            const LAS pg8::JobDesc* jd = (const LAS pg8::JobDesc*)(lds + pg8::JT_OFF);
#ifdef PROBE_LNV
            const bool dryp2 = __builtin_amdgcn_readfirstlane(jd->mode) != 0;
#endif
            const unsigned long long xio = pg8::rfl64(jd->out); const float* g = (const float*)pg8::rfl64(jd->bias); const float* b = (const float*)pg8::rfl64(jd->rot);
            GAS unsigned char* tb = (GAS unsigned char*)(xio + ((size_t)u.pm * 256 * 1024 + u.pn * 256) * 2); const unsigned loff = (unsigned)((wr * 64 + fr) * 1024 + wc * 64 + 8 * fq) * 2u;
#pragma unroll
            for (int bj = 0; bj < 2; ++bj) {
                __builtin_amdgcn_sched_barrier(0);
                const f32x4 g0 = *(const GAS f32x4*)((const GAS float*)g + colt + bj * 32), g1 = *(const GAS f32x4*)((const GAS float*)g + colt + bj * 32 + 4), b0 = *(const GAS f32x4*)((const GAS float*)b + colt + bj * 32), b1 = *(const GAS f32x4*)((const GAS float*)b + colt + bj * 32 + 4);
                f32x2 stn = stat[wr * 64 + fr];
#pragma unroll
                for (int am = 0; am < 8; ++am) { const int ai = am >> 2, m = am & 3; const int rl = ai * 128 + wr * 64 + m * 16 + fr; const f32x2 st = stn;
                    if (am < 7) stn = stat[((am + 1) >> 2) * 128 + wr * 64 + ((am + 1) & 3) * 16 + fr];
                    const float sc = st[1], sh = -st[0] * st[1];
                    const f32x4 v0 = (acc[ai][bj][m][0] * sc + sh) * g0 + b0, v1 = (acc[ai][bj][m][1] * sc + sh) * g1 + b1;
                    u32x4 w; w.x = pk2(v0[0], v0[1]); w.y = pk2(v0[2], v0[3]); w.z = pk2(v1[0], v1[1]); w.w = pk2(v1[2], v1[3]);
#ifdef PROBE_LNV
                    if (!(dryp2 && ((PROBE_LNV) & 2)))
                    *(GAS u32x4*)(tb + (dryp2 ? (size_t)P_TMP_PROBE : (size_t)0) + (ai * 128 + m * 16) * 2048 + bj * 64 + loff) = w;
#else
                    *(GAS u32x4*)(tb + (ai * 128 + m * 16) * 2048 + bj * 64 + loff) = w;
#endif
#ifdef PROBE_LNS
                    *(GAS u32x4*)(tb + ((size_t)P_TMP_PROBE) + (ai * 128 + m * 16) * 2048 + bj * 64 + loff) = w;
#endif
                    __builtin_amdgcn_sched_barrier(0); }
            }
        }
    }
};
enum { RM_IDENT = 0, RM_ROT = 1, RM_PAIR0 = 2, RM_PAIR1 = 3 };
__device__ __forceinline__ int rowmap(int kind, int n) {
    if (kind == RM_ROT) { if (n >= 1280) return n; const int d = n & 63; return (n & ~63) + 2 * (d & 31) + (d >> 5); }
    if (kind == RM_PAIR0) return 2 * n;
    if (kind == RM_PAIR1) return 2 * n + 1;
    return n;
}
__device__ __forceinline__ void ti_load(const float* __restrict__ W, int ldw, int kb, int nb, int lane, f32x4 (&tv)[8]) {
    const int k0 = 64 * kb, n0 = 32 * nb;
#pragma unroll
    for (int i = 0; i < 8; ++i) { const int kk = 8 * i + (lane >> 3); tv[i] = *(const f32x4*)(W + (size_t)(k0 + kk) * ldw + n0 + 4 * (lane & 7)); }
}
__device__ __forceinline__ void ti_store(const f32x4 (&tv)[8], int K, bf16_t* __restrict__ WT, LAS float* scr, int kb, int nb, int lane, int kind, float scale, int nscale) {
    const int k0 = 64 * kb, n0 = 32 * nb;
#pragma unroll
    for (int i = 0; i < 8; ++i) { const int kk = 8 * i + (lane >> 3); LAS float* d = scr + kk * 33 + 4 * (lane & 7); d[0] = tv[i][0]; d[1] = tv[i][1]; d[2] = tv[i][2]; d[3] = tv[i][3]; }
    __builtin_amdgcn_s_waitcnt(0xc07f); asm volatile("" ::: "memory");
    const int c = lane & 7;
#pragma unroll
    for (int j = 0; j < 4; ++j) { const int n = (lane >> 3) + 8 * j; const LAS float* s = scr + (8 * c) * 33 + n; const float sc = (n0 + n) < nscale ? scale : 1.f;
        u32x4 o; o.x = pk2(s[0 * 33] * sc, s[1 * 33] * sc); o.y = pk2(s[2 * 33] * sc, s[3 * 33] * sc); o.z = pk2(s[4 * 33] * sc, s[5 * 33] * sc); o.w = pk2(s[6 * 33] * sc, s[7 * 33] * sc);
        *(u32x4*)(WT + (size_t)rowmap(kind, n0 + n) * K + k0 + 8 * c) = o; }
    __builtin_amdgcn_s_waitcnt(0xc07f); asm volatile("" ::: "memory");
}
__device__ __forceinline__ void convert_mats(const float* W, int K, int N, int nbat, size_t sstr, bf16_t* WT, size_t dstr, int kind, float scale, int nscale, LAS float* scr, int& gwr, int ngw, int lane) {
    const int nblk = N / 32, per = (K / 64) * nblk, total = per * nbat;
    const int gw = gwr; gwr = (gw + ngw - total % ngw) % ngw;
    if (gw >= total) return;
    f32x4 cur[8], nxt[8];
    { const int bt = gw / per, r = gw - bt * per; ti_load(W + (size_t)bt * sstr, N, r / nblk, r % nblk, lane, cur); }
    for (int it = gw; it < total; it += ngw) {
        const int in = it + ngw; const bool more = in < total;
        if (more) { const int bt = in / per, r = in - bt * per; ti_load(W + (size_t)bt * sstr, N, r / nblk, r % nblk, lane, nxt); }
        { const int bt = it / per, r = it - bt * per; ti_store(cur, K, WT + (size_t)bt * dstr, scr, r / nblk, r % nblk, lane, kind, scale, nscale); }
#pragma unroll
        for (int i = 0; i < 8; ++i) cur[i] = nxt[i];
    }
}
__device__ __forceinline__ void convert_rows(const float* __restrict__ src, bf16_t* __restrict__ dst, size_t n, int gt, int ngt) {
    const size_t step = (size_t)ngt * 8; size_t i = (size_t)gt * 8;
    for (; i + 3 * step < n; i += 4 * step) { f32x4 a[4], b[4];
#pragma unroll
        for (int j = 0; j < 4; ++j) { a[j] = *(const f32x4*)(src + i + j * step); b[j] = *(const f32x4*)(src + i + j * step + 4); }
#pragma unroll
        for (int j = 0; j < 4; ++j) { u32x4 o; o.x = pk2(a[j][0], a[j][1]); o.y = pk2(a[j][2], a[j][3]); o.z = pk2(b[j][0], b[j][1]); o.w = pk2(b[j][2], b[j][3]); *(u32x4*)(dst + i + j * step) = o; } }
    for (; i < n; i += step) { const f32x4 a = *(const f32x4*)(src + i), b = *(const f32x4*)(src + i + 4);
        u32x4 o; o.x = pk2(a[0], a[1]); o.y = pk2(a[2], a[3]); o.z = pk2(b[0], b[1]); o.w = pk2(b[2], b[3]); *(u32x4*)(dst + i) = o; }
}

struct LnArgs { const float* xin32; const bf16_t* xin; float* xout32; bf16_t* xbf; const bf16_t* y; const float* g; const float* b; const int* dest; const float* wts; };
template <int NR, bool XF32, bool OUTF32, bool MOE>
__device__ __forceinline__ void ln_rows(const LnArgs& a, int row0, int lane) {
    float v[NR][2][8];
    {
        int d0[NR], d1[NR]; float w0[NR], w1[NR];
        if (MOE) {
#pragma unroll
            for (int i = 0; i < NR; ++i) { d0[i] = a.dest[(row0 + i) * 2]; d1[i] = a.dest[(row0 + i) * 2 + 1]; w0[i] = a.wts[(row0 + i) * 2]; w1[i] = a.wts[(row0 + i) * 2 + 1]; }
        }
        f32x4 xf[XF32 ? NR : 1][2][2]; u32x4 xb[XF32 ? 1 : NR][2]; u32x4 p[NR][2], q[MOE ? NR : 1][2];
#pragma unroll
        for (int i = 0; i < NR; ++i) {
            const u32x4* y0 = (const u32x4*)(a.y + (size_t)(MOE ? d0[i] : row0 + i) * DM) + lane; const u32x4* y1 = (const u32x4*)(a.y + (size_t)(MOE ? d1[i] : 0) * DM) + lane;
#pragma unroll
            for (int j = 0; j < 2; ++j) {
                if (XF32) { const f32x4* xr = (const f32x4*)(a.xin32 + (size_t)(row0 + i) * DM) + 2 * lane + 128 * j; xf[XF32 ? i : 0][j][0] = xr[0]; xf[XF32 ? i : 0][j][1] = xr[1]; }
                else xb[XF32 ? 0 : i][j] = ((const u32x4*)(a.xin + (size_t)(row0 + i) * DM) + lane)[64 * j];
                p[i][j] = y0[64 * j]; if (MOE) q[MOE ? i : 0][j] = y1[64 * j]; } }
#pragma unroll
        for (int i = 0; i < NR; ++i)
#pragma unroll
            for (int j = 0; j < 2; ++j) {
                float x[8];
                if (XF32) {
#pragma unroll
                    for (int e = 0; e < 4; ++e) { x[e] = xf[XF32 ? i : 0][j][0][e]; x[4 + e] = xf[XF32 ? i : 0][j][1][e]; } }
                else { const u32x4 w = xb[XF32 ? 0 : i][j]; x[0] = bf_lo(w.x); x[1] = bf_hi(w.x); x[2] = bf_lo(w.y); x[3] = bf_hi(w.y); x[4] = bf_lo(w.z); x[5] = bf_hi(w.z); x[6] = bf_lo(w.w); x[7] = bf_hi(w.w); }
                const u32x4 pw = p[i][j]; const float py[8] = {bf_lo(pw.x), bf_hi(pw.x), bf_lo(pw.y), bf_hi(pw.y), bf_lo(pw.z), bf_hi(pw.z), bf_lo(pw.w), bf_hi(pw.w)};
                if (MOE) { const u32x4 qw = q[MOE ? i : 0][j]; const float qy[8] = {bf_lo(qw.x), bf_hi(qw.x), bf_lo(qw.y), bf_hi(qw.y), bf_lo(qw.z), bf_hi(qw.z), bf_lo(qw.w), bf_hi(qw.w)};
#pragma unroll
                    for (int e = 0; e < 8; ++e) v[i][j][e] = ALPHA * x[e] + w0[i] * py[e] + w1[i] * qy[e]; }
                else {
#pragma unroll
                    for (int e = 0; e < 8; ++e) v[i][j][e] = ALPHA * x[e] + py[e]; }
            }
    }
    float s[NR];
#pragma unroll
    for (int i = 0; i < NR; ++i) { s[i] = 0.f;
#pragma unroll
        for (int j = 0; j < 2; ++j)
#pragma unroll
            for (int e = 0; e < 8; ++e) s[i] += v[i][j][e]; }
#pragma unroll
    for (int o = 1; o < 64; o <<= 1)
#pragma unroll
        for (int i = 0; i < NR; ++i) s[i] += shx(s[i], o, lane);
    float q2[NR];
#pragma unroll
    for (int i = 0; i < NR; ++i) { const float mean = s[i] * (1.f / DM); q2[i] = 0.f;
#pragma unroll
        for (int j = 0; j < 2; ++j)
#pragma unroll
            for (int e = 0; e < 8; ++e) { v[i][j][e] -= mean; q2[i] += v[i][j][e] * v[i][j][e]; } }
#pragma unroll
    for (int o = 1; o < 64; o <<= 1)
#pragma unroll
        for (int i = 0; i < NR; ++i) q2[i] += shx(q2[i], o, lane);
    f32x4 gv[2][2], bv[2][2];
#pragma unroll
    for (int j = 0; j < 2; ++j) { const f32x4* gp = (const f32x4*)a.g + 2 * lane + 128 * j; const f32x4* bp = (const f32x4*)a.b + 2 * lane + 128 * j; gv[j][0] = gp[0]; gv[j][1] = gp[1]; bv[j][0] = bp[0]; bv[j][1] = bp[1]; }
#pragma unroll
    for (int i = 0; i < NR; ++i) { const float rstd = rsqrtf(q2[i] * (1.f / DM) + LN_EPS);
#pragma unroll
        for (int j = 0; j < 2; ++j) { float o[8];
#pragma unroll
            for (int e = 0; e < 8; ++e) o[e] = v[i][j][e] * rstd * gv[j][e >> 2][e & 3] + bv[j][e >> 2][e & 3];
            if (OUTF32) { f32x4* xo = (f32x4*)(a.xout32 + (size_t)(row0 + i) * DM) + 2 * lane + 128 * j; xo[0] = (f32x4){o[0], o[1], o[2], o[3]}; xo[1] = (f32x4){o[4], o[5], o[6], o[7]}; }
            else { u32x4 w; w.x = pk2(o[0], o[1]); w.y = pk2(o[2], o[3]); w.z = pk2(o[4], o[5]); w.w = pk2(o[6], o[7]); ((u32x4*)(a.xbf + (size_t)(row0 + i) * DM) + lane)[64 * j] = w; } } }
}
template <bool XF32, bool OUTF32, bool MOE>
__device__ __forceinline__ void ln_phase(const LnArgs& a, int blk, int G, int wave, int lane) {
    const int per = NT / G, r0 = blk * per, pw = per / NWAVE;
    for (int r = 0; r < pw; r += 4) ln_rows<4, XF32, OUTF32, MOE>(a, r0 + wave * pw + r, lane);
}
__device__ __forceinline__ void xattn_phase(LAS unsigned char* lds, const bf16_t* __restrict__ Q, const bf16_t* __restrict__ KC, const bf16_t* __restrict__ VT, bf16_t* __restrict__ O, int blk, int G) {
    const int tid0 = threadIdx.x, wave = __builtin_amdgcn_readfirstlane(tid0 >> 6);
#define XA_IDS int tid = tid0; asm volatile("" : "+v"(tid)); const int lane = tid & 63, r32 = lane & 31, hh = lane >> 5; const size_t qrow = (size_t)b * SEQ + qb * 256 + wave * 32 + r32; (void)lane; (void)hh; (void)qrow;
    for (int u = blk; u < 512; u += G) {
        int qb = u & 15, h = (u >> 4) & 3, b = u >> 6;
        if (G == 256) { const int x = blk & 7, j = blk >> 3, grp = x * 4 + (u >> 8) * 2 + (j >> 4); qb = j & 15; h = grp & 3; b = grp >> 2; }
        XA_IDS;
        bf16x8 qf[16];
#pragma unroll
        for (int ks = 0; ks < 16; ++ks) qf[ks] = *(const bf16x8*)(Q + qrow * 1024 + h * 256 + ks * 16 + hh * 8);
        __syncthreads();
#pragma unroll
        for (int bt = 0; bt < 2; ++bt) {
            u32x4 t[8];
#pragma unroll
            for (int i = 0; i < 8; ++i) { const int ch = tid + 512 * (bt * 8 + i), row = ch >> 5, c = ch & 31; t[i] = *(const u32x4*)(KC + (size_t)(b * 256 + row) * 1024 + h * 256 + c * 8); }
#pragma unroll
            for (int i = 0; i < 8; ++i) { const int ch = tid + 512 * (bt * 8 + i), row = ch >> 5, c = ch & 31; *(LAS u32x4*)(lds + row * 528 + c * 16) = t[i]; }
        }
        __syncthreads();
        f32x16 s[8];
#pragma unroll
        for (int mt = 0; mt < 8; ++mt)
#pragma unroll
            for (int r = 0; r < 16; ++r) s[mt][r] = 0.f;
        {   const LAS unsigned char* kbp = lds + r32 * 528 + hh * 16;
#pragma unroll
            for (int ks = 0; ks < 16; ++ks)
#pragma unroll
                for (int mt = 0; mt < 8; ++mt) { const bf16x8 a = *(const LAS bf16x8*)(kbp + mt * 32 * 528 + ks * 32); s[mt] = MFMA32(a, qf[ks], s[mt]); }
        }
        float mx = -INFINITY;
#pragma unroll
        for (int mt = 0; mt < 8; ++mt)
#pragma unroll
            for (int r = 0; r < 16; ++r) mx = fmaxf(mx, s[mt][r]);
        mx = xhalf_max(mx);
        float sm = 0.f; const float mxl = mx * LOG2E;
        u32x4 pf[8][2];
#pragma unroll
        for (int mt = 0; mt < 8; ++mt)
#pragma unroll
            for (int r = 0; r < 16; ++r) { const float p = __builtin_amdgcn_exp2f(s[mt][r] * LOG2E - mxl); s[mt][r] = p; sm += p; }
        sm = xhalf_sum(sm);
        {   const float inv = 1.f / sm;
#pragma unroll
            for (int mt = 0; mt < 8; ++mt)
#pragma unroll
                for (int sx = 0; sx < 2; ++sx) pf[mt][sx] = (u32x4){pk2(s[mt][8 * sx] * inv, s[mt][8 * sx + 1] * inv), pk2(s[mt][8 * sx + 2] * inv, s[mt][8 * sx + 3] * inv), pk2(s[mt][8 * sx + 4] * inv, s[mt][8 * sx + 5] * inv), pk2(s[mt][8 * sx + 6] * inv, s[mt][8 * sx + 7] * inv)};
        }
        __syncthreads();
        {   XA_IDS;
#pragma unroll
        for (int bt = 0; bt < 4; ++bt) {
            u32x4 t[4];
#pragma unroll
            for (int i = 0; i < 4; ++i) { const int ch = tid + 512 * (bt * 4 + i), row = ch >> 5, c = ch & 31; t[i] = *(const u32x4*)(VT + (size_t)(h * 256 + row) * 2048 + b * 256 + c * 8); }
#pragma unroll
            for (int i = 0; i < 4; ++i) { const int ch = tid + 512 * (bt * 4 + i), row = ch >> 5, c = ch & 31; LAS u32x2* d = (LAS u32x2*)(lds + row * 520 + c * 16); d[0] = (u32x2){t[i].x, t[i].y}; d[1] = (u32x2){t[i].z, t[i].w}; }
        }
        }
        __syncthreads();
        {   XA_IDS;
        bf16_t* otile = O + ((size_t)b * SEQ + qb * 256 + wave * 32) * 1024 + h * 256 + r32;
#pragma unroll 1
        for (int dh = 0; dh < 2; ++dh) {
            f32x16 o[4];
#pragma unroll
            for (int dt = 0; dt < 4; ++dt)
#pragma unroll
                for (int r = 0; r < 16; ++r) o[dt][r] = 0.f;
            const LAS unsigned char* vb = lds + (dh * 128 + r32) * 520 + 8 * hh;
#pragma unroll
            for (int mt = 0; mt < 8; ++mt)
#pragma unroll
                for (int sx = 0; sx < 2; ++sx) { const int kb = mt * 32 + 16 * sx; const bf16x8 pb = __builtin_bit_cast(bf16x8, pf[mt][sx]);
#pragma unroll
                    for (int dt = 0; dt < 4; ++dt) { const LAS unsigned char* q = vb + dt * 32 * 520 + kb * 2;
                        const s16x4 lo = *(const LAS s16x4*)q, hi = *(const LAS s16x4*)(q + 16);
                        const bf16x8 a = (bf16x8){lo[0], lo[1], lo[2], lo[3], hi[0], hi[1], hi[2], hi[3]}; o[dt] = MFMA32(pb, a, o[dt]); } }
#pragma unroll
            for (int dt = 0; dt < 4; ++dt)
#pragma unroll
                for (int r = 0; r < 16; ++r) otile[(size_t)crow(r, hh) * 1024 + dh * 128 + dt * 32] = f2bf(o[dt][r]);
        }
        }
    }
#undef XA_IDS
}

struct RouteBufs { int* e; float* w; int* rank; int* dest; int* hist; int* tstart; int* src; };
__device__ __forceinline__ void moe_router_phase(LAS unsigned char* lds, const bf16_t* __restrict__ XBF, const bf16_t* __restrict__ WRT, const float* __restrict__ brg, const float* __restrict__ bre, const RouteBufs rb, int blk) {
    int tid_ = threadIdx.x; asm volatile("" : "+v"(tid_)); const int tid = tid_, lane = tid & 63, wave = __builtin_amdgcn_readfirstlane(tid >> 6), r32 = lane & 31, hh = lane >> 5;
    LAS unsigned char* XT = lds; LAS unsigned char* WT = lds + 128 * 528;
    LAS float* LG = (LAS float*)lds;
    LAS int* hist = (LAS int*)(lds + 128 * 65 * 4);
    const int rbk = wave & 3, ct = wave >> 2;
    f32x16 acc;
#pragma unroll
    for (int r = 0; r < 16; ++r) acc[r] = 0.f;
#pragma unroll 1
    for (int kc = 0; kc < 4; ++kc) {
        __syncthreads();
        {   u32x4 tx[8], tw[8];
#pragma unroll
            for (int i = 0; i < 8; ++i) { const int ch = tid + 512 * i, row = ch >> 5, c = ch & 31; tx[i] = *(const u32x4*)(XBF + (size_t)(blk * 128 + row) * 1024 + kc * 256 + c * 8); tw[i] = *(const u32x4*)(WRT + (size_t)row * 1024 + kc * 256 + c * 8); }
#pragma unroll
            for (int i = 0; i < 8; ++i) { const int ch = tid + 512 * i, row = ch >> 5, c = ch & 31; *(LAS u32x4*)(XT + row * 528 + c * 16) = tx[i]; *(LAS u32x4*)(WT + row * 528 + c * 16) = tw[i]; } }
        __syncthreads();
        const LAS unsigned char* ap = XT + (rbk * 32 + r32) * 528 + hh * 16; const LAS unsigned char* bp = WT + (ct * 32 + r32) * 528 + hh * 16;
#pragma unroll
        for (int ks = 0; ks < 16; ++ks) { const bf16x8 a = *(const LAS bf16x8*)(ap + ks * 32), b0 = *(const LAS bf16x8*)(bp + ks * 32), b1 = *(const LAS bf16x8*)(bp + 64 * 528 + ks * 32);
            acc = MFMA32(a, b0, acc); acc = MFMA32(a, b1, acc); }
    }
    __syncthreads();
    if (tid < 32) hist[tid] = 0;
#pragma unroll
    for (int r = 0; r < 16; ++r) LG[(rbk * 32 + crow(r, hh)) * 65 + ct * 32 + r32] = acc[r];
    __syncthreads();
    if (tid < 128) {
        const LAS float* lg = LG + tid * 65; const int tok = blk * 128 + tid;
        float g4[4];
#pragma unroll
        for (int g = 0; g < 4; ++g) g4[g] = lg[32 + g] + brg[g];
        int gi = 0; float gm = g4[0];
#pragma unroll
        for (int g = 1; g < 4; ++g) if (g4[g] > gm) { gm = g4[g]; gi = g; }
        float gs = 0.f;
#pragma unroll
        for (int g = 0; g < 4; ++g) gs += fast_exp(g4[g] - gm);
        const float gate_g = 1.f / gs;
        float le[8];
#pragma unroll
        for (int e = 0; e < 8; ++e) le[e] = lg[gi * 8 + e] + bre[gi * 8 + e];
        int i0 = 0; float v0 = le[0];
#pragma unroll
        for (int e = 1; e < 8; ++e) if (le[e] > v0) { v0 = le[e]; i0 = e; }
        int i1 = 0; float v1 = -INFINITY;
#pragma unroll
        for (int e = 0; e < 8; ++e) if (e != i0 && le[e] > v1) { v1 = le[e]; i1 = e; }
        const float e1 = fast_exp(v1 - v0), p0 = 1.f / (1.f + e1), p1 = e1 * p0;
        const int ex0 = gi * 8 + i0, ex1 = gi * 8 + i1;
        rb.e[tok * 2] = ex0; rb.e[tok * 2 + 1] = ex1; rb.w[tok * 2] = gate_g * p0; rb.w[tok * 2 + 1] = gate_g * p1;
        rb.rank[tok * 2] = atomicAdd((int*)&hist[ex0], 1); rb.rank[tok * 2 + 1] = atomicAdd((int*)&hist[ex1], 1);
    }
    __syncthreads();
    if (tid < 32) rb.hist[blk * 32 + tid] = hist[tid];
}
__device__ __forceinline__ void moe_scatter_phase(LAS unsigned char* lds, const RouteBufs rb, int blk, int G) {
    int tid_ = threadIdx.x; asm volatile("" : "+v"(tid_)); const int tid = tid_, lane = tid & 63, wave = __builtin_amdgcn_readfirstlane(tid >> 6);
    LAS int* sb = (LAS int*)lds;
    __syncthreads();
    {
        const int e = tid & 31, part = tid >> 5; int c[16];
#pragma unroll
        for (int i = 0; i < 16; ++i) c[i] = rb.hist[(part * 16 + i) * 32 + e];
        int tot = 0, base = 0;
#pragma unroll
        for (int i = 0; i < 16; ++i) { tot += c[i]; if (part * 16 + i < blk) base += c[i]; }
        sb[128 + part * 32 + e] = base; sb[128 + 512 + part * 32 + e] = tot; }
    __syncthreads();
    if (tid < 32) { int tot = 0, base = 0;
#pragma unroll
        for (int i = 0; i < 16; ++i) { base += sb[128 + i * 32 + tid]; tot += sb[128 + 512 + i * 32 + tid]; }
        sb[tid] = base; sb[32 + tid] = tot; }
    __syncthreads();
    if (tid == 0) { int acc = 0; for (int e = 0; e < 32; ++e) { sb[64 + e] = acc; if (blk == 0) rb.tstart[e] = acc >> 8; acc += (sb[32 + e] + 255) & ~255; } sb[96] = acc; if (blk == 0) rb.tstart[32] = acc >> 8; }
    __syncthreads();
    if (tid < 256) { const int idx = blk * 256 + tid; const int e = rb.e[idx]; const int d = sb[64 + e] + sb[e] + rb.rank[idx]; rb.dest[idx] = d; rb.src[d] = idx >> 1; }
    if (blk < 32) { const int e = blk; const int lo = sb[64 + e] + sb[32 + e], hi = sb[64 + e] + ((sb[32 + e] + 255) & ~255); for (int r = lo + tid; r < hi; r += NTHR) rb.src[r] = 0; }
}
struct MoeSched {
    const char* A; const char* B; const int* tstart; int K, nN, G, c; size_t bexp;
    __device__ __forceinline__ pg8::Unit get(int i, bool& ok) const { pg8::Unit u; u.A = nullptr; u.B = nullptr; u.src = nullptr; u.pm = 0; u.pn = 0; u.job = 0; ok = next(i, u); return u; }
    __device__ __forceinline__ bool next(int i, pg8::Unit& u) const {
        const int vc = (c & 7) * (G >> 3) + (c >> 3);
        const long L = (long)i * G + vc; const int ntile = tstart[32];
        if (L >= (long)ntile * nN) return false;
        const int mt = (int)(L / nN), nt = (int)(L % nN);
        int e = 0;
        for (int k = 1; k < 32; ++k) if (tstart[k] <= mt) e = k;
        u.A = A + (size_t)mt * 256 * K * 2; u.B = B + (size_t)e * bexp + (size_t)nt * 256 * K * 2; u.src = nullptr; u.pm = mt; u.pn = nt; u.job = 0; return true;
    }
};
__device__ __forceinline__ void swa_phase(LAS unsigned char* lds, const bf16_t* __restrict__ Q1, const bf16_t* __restrict__ K1, const bf16_t* __restrict__ VT1, const float* __restrict__ sinks, bf16_t* __restrict__ O, int blk, int G) {
    int tid_ = threadIdx.x; asm volatile("" : "+v"(tid_)); const int tid = tid_, lane = tid & 63, wave = __builtin_amdgcn_readfirstlane(tid >> 6), r32 = lane & 31, hh = lane >> 5;
    LAS unsigned char* KL = lds;
    LAS unsigned char* VL = lds + 36864;
    for (int u = blk; u < 1024; u += G) {
        int n = u & 31, kvh = (u >> 5) & 3, b = u >> 7;
        if (G == 256) { const int grp = (u >> 8) * 8 + (blk & 7); n = blk >> 3; kvh = grp & 3; b = grp >> 2; }
        const int tokb = b * SEQ + (n - 1) * 128;
        bf16x8 qfa[2][4];
        {   const int g0 = wave >> 1, hq0 = kvh * 4 + g0;
#pragma unroll
            for (int sb = 0; sb < 2; ++sb)
#pragma unroll
                for (int ks = 0; ks < 4; ++ks) qfa[sb][ks] = *(const bf16x8*)(Q1 + ((size_t)b * SEQ + n * 128 + (wave & 1) * 64 + sb * 32 + r32) * 1024 + hq0 * 64 + ks * 16 + hh * 8); }
        __syncthreads();
#pragma unroll
        for (int i = 0; i < 4; ++i) { const int ch = tid + 512 * i; const int key = ch >> 3, c = ch & 7;
            u32x4 v = (u32x4){0u, 0u, 0u, 0u}; if (n > 0 || key >= 128) v = *(const u32x4*)(K1 + (size_t)(tokb + key) * 256 + kvh * 64 + c * 8);
            *(LAS u32x4*)(KL + key * 144 + c * 16) = v; }
#pragma unroll
        for (int i = 0; i < 4; ++i) { const int ch = tid + 512 * i; const int d = ch >> 5, c = ch & 31;
            u32x4 v = (u32x4){0u, 0u, 0u, 0u}; if (n > 0 || c >= 16) v = *(const u32x4*)(VT1 + (size_t)(kvh * 64 + d) * NT + tokb + c * 8);
            LAS u32x2* dp = (LAS u32x2*)(VL + d * 520 + c * 16); dp[0] = (u32x2){v.x, v.y}; dp[1] = (u32x2){v.z, v.w}; }
        __syncthreads();
        const int g = wave >> 1, hq = kvh * 4 + g; const float sink = sinks[hq];
#pragma unroll 1
        for (int sb = 0; sb < 2; ++sb) {
            bf16x8 qf[4];
#pragma unroll
            for (int ks = 0; ks < 4; ++ks) qf[ks] = sb ? qfa[1][ks] : qfa[0][ks];
            const int i0 = (wave & 1) * 64 + sb * 32, jt0 = i0 >> 5;
            const size_t qtok = (size_t)b * SEQ + n * 128 + i0 + r32;
            f32x16 s[5];
#pragma unroll
            for (int t = 0; t < 5; ++t) {
#pragma unroll
                for (int r = 0; r < 16; ++r) s[t][r] = 0.f;
                const LAS unsigned char* kp = KL + ((jt0 + t) * 32 + r32) * 144 + hh * 16;
#pragma unroll
                for (int ks = 0; ks < 4; ++ks) { const bf16x8 a = *(const LAS bf16x8*)(kp + ks * 32); s[t] = MFMA32(a, qf[ks], s[t]); }
            }
            const int qi = i0 + r32;
            float mx = sink;
#pragma unroll
            for (int t = 0; t < 5; ++t)
#pragma unroll
                for (int r = 0; r < 16; ++r) { const int kj = (jt0 + t) * 32 + crow(r, hh); const bool valid = (kj > qi) && (kj <= qi + 128) && (n > 0 || kj >= 128);
                    s[t][r] = valid ? s[t][r] : -INFINITY; mx = fmaxf(mx, s[t][r]); }
            mx = xhalf_max(mx);
            float sm = 0.f; const float mxl = mx * LOG2E;
            u32x4 pf[5][2];
#pragma unroll
            for (int t = 0; t < 5; ++t) {
#pragma unroll
                for (int r = 0; r < 16; ++r) { const float pv = __builtin_amdgcn_exp2f(s[t][r] * LOG2E - mxl); s[t][r] = pv; sm += pv; }
#pragma unroll
                for (int sx = 0; sx < 2; ++sx) pf[t][sx] = (u32x4){pk2(s[t][8 * sx], s[t][8 * sx + 1]), pk2(s[t][8 * sx + 2], s[t][8 * sx + 3]), pk2(s[t][8 * sx + 4], s[t][8 * sx + 5]), pk2(s[t][8 * sx + 6], s[t][8 * sx + 7])};
            }
            sm = xhalf_sum(sm) + __builtin_amdgcn_exp2f(sink * LOG2E - mxl);
            f32x16 o[2];
#pragma unroll
            for (int dt = 0; dt < 2; ++dt)
#pragma unroll
                for (int r = 0; r < 16; ++r) o[dt][r] = 0.f;
#pragma unroll
            for (int t = 0; t < 5; ++t)
#pragma unroll
                for (int sx = 0; sx < 2; ++sx) { const bf16x8 pb = __builtin_bit_cast(bf16x8, pf[t][sx]);
#pragma unroll
                    for (int dt = 0; dt < 2; ++dt) { const LAS unsigned char* q = VL + (dt * 32 + r32) * 520 + ((jt0 + t) * 32 + 16 * sx + 4 * hh) * 2;
                        const s16x4 lo = *(const LAS s16x4*)q, hi = *(const LAS s16x4*)(q + 16);
                        const bf16x8 a = (bf16x8){lo[0], lo[1], lo[2], lo[3], hi[0], hi[1], hi[2], hi[3]}; o[dt] = MFMA32(a, pb, o[dt]); } }
            const float inv = 1.f / sm;
            bf16_t* orow = O + qtok * 1024 + hq * 64 + 4 * hh;
#pragma unroll
            for (int dt = 0; dt < 2; ++dt)
#pragma unroll
                for (int gq = 0; gq < 4; ++gq) { u32x2 w; w.x = pk2(o[dt][4 * gq] * inv, o[dt][4 * gq + 1] * inv); w.y = pk2(o[dt][4 * gq + 2] * inv, o[dt][4 * gq + 3] * inv); *(u32x2*)(orow + dt * 32 + 8 * gq) = w; }
        }
    }
}
constexpr int TS = 272;
template <int STRIDE = TS>
__device__ __forceinline__ bf16x8 tr_frag(const LAS unsigned char* T, int k0, int c0, int lane, bool permuted) {
    const int hh = lane >> 5, blk = (lane >> 4) & 1, q = (lane & 15) >> 2, pp = lane & 3;
    const int r0 = k0 + (permuted ? 4 * hh : 8 * hh) + q, r1 = r0 + (permuted ? 8 : 4);
    const int cb = (c0 + 16 * blk + 4 * pp) * 2;
    const s16x4 lo = lds_tr(T + r0 * STRIDE + cb), hi = lds_tr(T + r1 * STRIDE + cb);
    return (bf16x8){lo[0], lo[1], lo[2], lo[3], hi[0], hi[1], hi[2], hi[3]};
}
__device__ __forceinline__ bf16x8 row_frag(const LAS unsigned char* T, int row, int k0, int hh) { return *(const LAS bf16x8*)(T + row * TS + (k0 + 8 * hh) * 2); }
__device__ __forceinline__ void load_tile128(LAS unsigned char* T, const bf16_t* __restrict__ g, int ld, int tid) {
#pragma unroll
    for (int i = 0; i < 4; ++i) { const int ch = tid + 512 * i, row = ch >> 4, c = ch & 15; *(LAS u32x4*)(T + row * TS + c * 16) = *(const u32x4*)(g + (size_t)row * ld + c * 8); }
}
struct L0Bufs {
    bf16_t *AU, *AV, *BX, *BZ, *V, *XC, *YM, *CS, *Q, *K, *U; float *GT, *UN, *NS, *SC;
    const bf16_t *WQT, *GMW, *MT; const float *gm_g, *gm_b, *gm_bs, *cw, *cb, *bif, *nw, *skip;
};

__device__ __forceinline__ void l0_mixA(LAS unsigned char* lds, const L0Bufs& B, int blk, int G, int skip = 0) {
    const int tid0 = threadIdx.x, wave = __builtin_amdgcn_readfirstlane(tid0 >> 6);
#define OPQ_IDS int tid = tid0; asm volatile("" : "+v"(tid)); const int lane = tid & 63, r32 = lane & 31, hh = lane >> 5; (void)lane; (void)r32; (void)hh;
    LAS unsigned char* T0 = lds; LAS unsigned char* T1 = lds + 34816; LAS unsigned char* T2 = lds + 2 * 34816; LAS unsigned char* T3 = lds + 3 * 34816;
    LAS float* SF = (LAS float*)T2;
    LAS float* SG = (LAS float*)(lds + 3 * 34816 + 35632);
    for (int u = blk; u < 256; u += G) {
        const int tok0 = u * 128; const bool first = (u & 31) == 0;
        if (!(skip & 1)) {
        constexpr int VS = 1040;
        {   OPQ_IDS; const int trow = tid >> 2, q4 = tid & 3;
            const bf16_t* vr = B.AV + (size_t)(tok0 + trow) * 512 + q4 * 128; float s = 0.f, s2 = 0.f; u32x4 w[16];
#pragma unroll
            for (int i = 0; i < 16; ++i) w[i] = *(const u32x4*)(vr + i * 8);
#pragma unroll
            for (int i = 0; i < 16; ++i) { const float f[8] = {bf_lo(w[i].x), bf_hi(w[i].x), bf_lo(w[i].y), bf_hi(w[i].y), bf_lo(w[i].z), bf_hi(w[i].z), bf_lo(w[i].w), bf_hi(w[i].w)};
#pragma unroll
                for (int e = 0; e < 8; ++e) { s += f[e]; s2 += f[e] * f[e]; } }
            s += shx(s, 1, lane); s += shx(s, 2, lane); s2 += shx(s2, 1, lane); s2 += shx(s2, 2, lane);
            const float mean = s * (1.f / 512.f), rstd = rsqrtf(fmaxf(s2 * (1.f / 512.f) - mean * mean, 0.f) + LN_EPS);
            __syncthreads();
#pragma unroll
            for (int i = 0; i < 16; ++i) { const int cbase = q4 * 128 + i * 8; const f32x4 g0 = *(const f32x4*)(B.gm_g + cbase), g1 = *(const f32x4*)(B.gm_g + cbase + 4), b0 = *(const f32x4*)(B.gm_b + cbase), b1 = *(const f32x4*)(B.gm_b + cbase + 4);
                u32x4 o; o.x = pk2((bf_lo(w[i].x) - mean) * rstd * g0[0] + b0[0], (bf_hi(w[i].x) - mean) * rstd * g0[1] + b0[1]); o.y = pk2((bf_lo(w[i].y) - mean) * rstd * g0[2] + b0[2], (bf_hi(w[i].y) - mean) * rstd * g0[3] + b0[3]);
                o.z = pk2((bf_lo(w[i].z) - mean) * rstd * g1[0] + b1[0], (bf_hi(w[i].z) - mean) * rstd * g1[1] + b1[1]); o.w = pk2((bf_lo(w[i].w) - mean) * rstd * g1[2] + b1[2], (bf_hi(w[i].w) - mean) * rstd * g1[3] + b1[3]);
                *(LAS u32x4*)(lds + trow * VS + cbase * 2) = o; asm volatile("" ::: "memory"); }
            __syncthreads();
        }
        {   const int tb = wave & 3, dhf = wave >> 2;
#pragma unroll 1
            for (int g = 0; g < 4; ++g) {
                OPQ_IDS; const int t = 32 * tb + r32; const size_t tok = (size_t)tok0 + t;
                f32x16 acc[2];
#pragma unroll
                for (int dt = 0; dt < 2; ++dt)
#pragma unroll
                    for (int r = 0; r < 16; ++r) acc[dt][r] = 0.f;
                const bf16_t* wrow = B.GMW + ((size_t)g * 128 + t) * 128 + 8 * hh;
                u32x2 aup[2][4];
#pragma unroll
                for (int dt = 0; dt < 2; ++dt)
#pragma unroll
                    for (int gq = 0; gq < 4; ++gq) aup[dt][gq] = *(const u32x2*)(B.AU + tok * 512 + g * 128 + 64 * dhf + 32 * dt + 8 * gq + 4 * hh);
                bf16x8 bw[8];
#pragma unroll
                for (int ks = 0; ks < 8; ++ks) bw[ks] = *(const bf16x8*)(wrow + 16 * ks);
#pragma unroll
                for (int ks = 0; ks < 8; ++ks) if (ks <= 2 * tb + 1) {
#pragma unroll
                    for (int dt = 0; dt < 2; ++dt) { const bf16x8 a = tr_frag<VS>(lds, 16 * ks, g * 128 + 64 * dhf + 32 * dt, lane, false); acc[dt] = MFMA32(a, bw[ks], acc[dt]); } }
                const float bsv = B.gm_bs[g * 128 + t];
#pragma unroll
                for (int dt = 0; dt < 2; ++dt)
#pragma unroll
                    for (int gq = 0; gq < 4; ++gq) { const int col = g * 128 + 64 * dhf + 32 * dt + 8 * gq + 4 * hh; const u32x2 au = aup[dt][gq];
                        u32x2 w; w.x = pk2(bf_lo(au.x) * (acc[dt][4 * gq] + bsv), bf_hi(au.x) * (acc[dt][4 * gq + 1] + bsv)); w.y = pk2(bf_lo(au.y) * (acc[dt][4 * gq + 2] + bsv), bf_hi(au.y) * (acc[dt][4 * gq + 3] + bsv));
                        *(u32x2*)(B.YM + tok * 1024 + col) = w; }
            }
        }
        }
        f32x16 accg;
#pragma unroll
        for (int r = 0; r < 16; ++r) accg[r] = 0.f;
        LAS unsigned char* MTL = (LAS unsigned char*)SG;
        u32x4 pxm[5], pwq[4], pwk[4], pwv[4], pmt;
#define P1_LOADS_A(HN) do { _Pragma("unroll") for (int i = 0; i < 5; ++i) { const int ch = tid + 512 * i, row = ch >> 4, c = ch & 15; u32x4 v = (u32x4){0u, 0u, 0u, 0u}; \
                if (ch < 131 * 16 && !(first && row < 3)) v = *(const u32x4*)(B.BX + (size_t)(tok0 - 3 + row) * 512 + (HN) * 128 + c * 8); pxm[i] = v; } \
            _Pragma("unroll") for (int i = 0; i < 4; ++i) { const int ch = tid + 512 * i, row = ch >> 4, c = ch & 15; pwq[i] = *(const u32x4*)(B.WQT + ((size_t)0 * 4 + (HN)) * 128 * 128 + (size_t)row * 128 + c * 8); pwk[i] = *(const u32x4*)(B.WQT + ((size_t)1 * 4 + (HN)) * 128 * 128 + (size_t)row * 128 + c * 8); } \
            pmt = *(const u32x4*)(B.MT + ((size_t)(HN) * 8 + ((tid & 255) >> 5)) * 256 + (tid & 31) * 8); } while (0)
#define P1_LOADS_V(HN) do { _Pragma("unroll") for (int i = 0; i < 4; ++i) { const int ch = tid + 512 * i, row = ch >> 4, c = ch & 15; pwv[i] = *(const u32x4*)(B.WQT + ((size_t)2 * 4 + (HN)) * 128 * 128 + (size_t)row * 128 + c * 8); } } while (0)
        {   OPQ_IDS; P1_LOADS_A(0); P1_LOADS_V(0); }
#pragma unroll 1
        for (int h = 0; h < ((skip & 2) ? 0 : 4); ++h) {
            OPQ_IDS;
            __syncthreads();
#pragma unroll
            for (int i = 0; i < 5; ++i) { const int ch = tid + 512 * i, row = ch >> 4, c = ch & 15; if (ch < 131 * 16) *(LAS u32x4*)(T3 + row * TS + c * 16) = pxm[i]; }
#pragma unroll
            for (int i = 0; i < 4; ++i) { const int ch = tid + 512 * i, row = ch >> 4, c = ch & 15; *(LAS u32x4*)(T0 + row * TS + c * 16) = pwq[i]; *(LAS u32x4*)(T1 + row * TS + c * 16) = pwk[i]; }
            if (tid < 256) { const int row = tid >> 5, c = tid & 31; *(LAS u32x4*)(MTL + row * 528 + c * 16) = pmt; }
            { const int hn = h < 3 ? h + 1 : 3; P1_LOADS_A(hn); }
            __syncthreads();
            {   const int dc = tid & 15, chn = h * 128 + dc * 8; float w[4][8], cbv[8];
#pragma unroll
                for (int j = 0; j < 4; ++j)
#pragma unroll
                    for (int e = 0; e < 8; ++e) w[j][e] = B.cw[j * 512 + chn + e];
#pragma unroll
                for (int e = 0; e < 8; ++e) cbv[e] = B.cb[chn + e];
#pragma unroll 1
                for (int ps = 0; ps < 4; ++ps) { const int t = ps * 32 + (tid >> 4); float a[8];
#pragma unroll
                    for (int e = 0; e < 8; ++e) a[e] = cbv[e];
#pragma unroll
                    for (int j = 0; j < 4; ++j) { const u32x4 x = *(const LAS u32x4*)(T3 + (t + j) * TS + dc * 16);
                        a[0] += w[j][0] * bf_lo(x.x); a[1] += w[j][1] * bf_hi(x.x); a[2] += w[j][2] * bf_lo(x.y); a[3] += w[j][3] * bf_hi(x.y);
                        a[4] += w[j][4] * bf_lo(x.z); a[5] += w[j][5] * bf_hi(x.z); a[6] += w[j][6] * bf_lo(x.w); a[7] += w[j][7] * bf_hi(x.w); }
                    u32x4 o; o.x = pk2(silu_f(a[0]), silu_f(a[1])); o.y = pk2(silu_f(a[2]), silu_f(a[3])); o.z = pk2(silu_f(a[4]), silu_f(a[5])); o.w = pk2(silu_f(a[6]), silu_f(a[7]));
                    *(LAS u32x4*)(T2 + t * TS + dc * 16) = o; *(u32x4*)(B.XC + (size_t)(tok0 + t) * 512 + chn) = o; } }
            __syncthreads();
            {   const int tb = wave & 3, ehf = wave >> 2;
                {
                    OPQ_IDS; const LAS unsigned char* act = ehf ? T3 + 3 * TS : T2;
#pragma unroll
                    for (int ks = 0; ks < 8; ++ks) { const bf16x8 a = *(const LAS bf16x8*)(MTL + (r32 & 7) * 528 + (ehf * 128 + 16 * ks + 8 * hh) * 2); const bf16x8 bx = row_frag(act, 32 * tb + r32, 16 * ks, hh); accg = MFMA32(a, bx, accg); } }
#pragma unroll 1
                for (int mtx = 0; mtx < 2; ++mtx) {
                    OPQ_IDS;
                    const LAS unsigned char* wt = mtx ? T1 : T0;
                    f32x16 acc[2];
#pragma unroll
                    for (int et = 0; et < 2; ++et)
#pragma unroll
                        for (int r = 0; r < 16; ++r) acc[et][r] = 0.f;
#pragma unroll
                    for (int ks = 0; ks < 8; ++ks) { const bf16x8 bx = row_frag(T2, 32 * tb + r32, 16 * ks, hh);
#pragma unroll
                        for (int et = 0; et < 2; ++et) { const bf16x8 a = row_frag(wt, 64 * ehf + 32 * et + r32, 16 * ks, hh); acc[et] = MFMA32(a, bx, acc[et]); } }
                    bf16_t* dst = (mtx == 0 ? B.Q : B.K) + (size_t)(tok0 + 32 * tb + r32) * 512 + h * 128 + 64 * ehf + 4 * hh;
#pragma unroll
                    for (int et = 0; et < 2; ++et)
#pragma unroll
                        for (int gq = 0; gq < 4; ++gq) { u32x2 w; w.x = pk2(acc[et][4 * gq], acc[et][4 * gq + 1]); w.y = pk2(acc[et][4 * gq + 2], acc[et][4 * gq + 3]); *(u32x2*)(dst + 32 * et + 8 * gq) = w; }
                }
            }
            __syncthreads();
            {   OPQ_IDS;
#pragma unroll
                for (int i = 0; i < 4; ++i) { const int ch = tid + 512 * i, row = ch >> 4, c = ch & 15; *(LAS u32x4*)(T0 + row * TS + c * 16) = pwv[i]; }
                const int hn = h < 3 ? h + 1 : 3; P1_LOADS_V(hn); }
            __syncthreads();
            {   OPQ_IDS; const int tb = wave & 3, ehf = wave >> 2;
                f32x16 acc[2];
#pragma unroll
                for (int et = 0; et < 2; ++et)
#pragma unroll
                    for (int r = 0; r < 16; ++r) acc[et][r] = 0.f;
#pragma unroll
                for (int ks = 0; ks < 8; ++ks) { const bf16x8 bx = row_frag(T3 + 3 * TS, 32 * tb + r32, 16 * ks, hh);
#pragma unroll
                    for (int et = 0; et < 2; ++et) { const bf16x8 a = row_frag(T0, 64 * ehf + 32 * et + r32, 16 * ks, hh); acc[et] = MFMA32(a, bx, acc[et]); } }
                bf16_t* dst = B.V + (size_t)(tok0 + 32 * tb + r32) * 512 + h * 128 + 64 * ehf + 4 * hh;
#pragma unroll
                for (int et = 0; et < 2; ++et)
#pragma unroll
                    for (int gq = 0; gq < 4; ++gq) { u32x2 w; w.x = pk2(acc[et][4 * gq], acc[et][4 * gq + 1]); w.y = pk2(acc[et][4 * gq + 2], acc[et][4 * gq + 3]); *(u32x2*)(dst + 32 * et + 8 * gq) = w; }
            }
        }
        __syncthreads();
        {   OPQ_IDS; const int tb = wave & 3, kh = wave >> 2;
#pragma unroll
            for (int r = 0; r < 4; ++r) SF[(kh * 8 + r + 4 * hh) * 128 + 32 * tb + r32] = accg[r];
        }
        __syncthreads();
        LAS float* IG = SG; LAS float* BC = SG + 512; LAS float* WG = SG + 1024;
        if (wave < 4) {
            OPQ_IDS; const int h = wave; float lf[2], ig[2];
#pragma unroll
            for (int e = 0; e < 2; ++e) { const int t = 2 * lane + e; ig[e] = SF[h * 128 + t] + SF[(8 + h) * 128 + t] + B.bif[h];
                const float fx = SF[(4 + h) * 128 + t] + SF[(12 + h) * 128 + t] + B.bif[4 + h]; lf[e] = fminf(fx, 0.f) - log1pf(expf(-fabsf(fx))); }
            float run = lf[0] + lf[1];
#pragma unroll
            for (int o = 1; o < 64; o <<= 1) { const float v = shup(run, o, lane); if (lane >= o) run += v; }
            const float b1 = run, b0 = run - lf[1];
            IG[h * 128 + 2 * lane] = ig[0]; IG[h * 128 + 2 * lane + 1] = ig[1]; BC[h * 128 + 2 * lane] = b0; BC[h * 128 + 2 * lane + 1] = b1;
            float* gt = B.GT + ((size_t)u * 4 + h) * 256;
            gt[2 * lane] = ig[0]; gt[2 * lane + 1] = ig[1]; gt[128 + 2 * lane] = b0; gt[128 + 2 * lane + 1] = b1;
            const float bl = shidx(b1, 63);
            float g0 = bl - b0 + ig[0], g1 = bl - b1 + ig[1]; float mloc = fmaxf(g0, g1);
#pragma unroll
            for (int o = 1; o < 64; o <<= 1) mloc = fmaxf(mloc, shx(mloc, o, lane));
            WG[h * 128 + 2 * lane] = expf(g0 - mloc); WG[h * 128 + 2 * lane + 1] = expf(g1 - mloc);
            if (lane == 0) { B.SC[u * 4 + h] = bl; B.SC[1024 + u * 4 + h] = mloc; }
        }
        u32x4 pfv[4], pfk[4];
        {   OPQ_IDS;
#pragma unroll
            for (int i = 0; i < 4; ++i) { const int ch = tid + 512 * i, row = ch >> 4, c = ch & 15; pfv[i] = *(const u32x4*)(B.V + (size_t)(tok0 + row) * 512 + c * 8); pfk[i] = *(const u32x4*)(B.K + (size_t)(tok0 + row) * 512 + c * 8); } }
#pragma unroll 1
        for (int h = 0; h < ((skip & 4) ? 0 : 4); ++h) {
            OPQ_IDS;
            __syncthreads();
#pragma unroll
            for (int i = 0; i < 4; ++i) { const int ch = tid + 512 * i, row = ch >> 4, c = ch & 15; const float wg = WG[h * 128 + row];
                const u32x4 v = pfv[i], k = pfk[i];
                u32x4 ov, ok; const float ksc = 0.08838834764831845f;
                ov.x = pk2(bf_lo(v.x) * wg, bf_hi(v.x) * wg); ov.y = pk2(bf_lo(v.y) * wg, bf_hi(v.y) * wg); ov.z = pk2(bf_lo(v.z) * wg, bf_hi(v.z) * wg); ov.w = pk2(bf_lo(v.w) * wg, bf_hi(v.w) * wg);
                ok.x = pk2(bf_lo(k.x) * ksc, bf_hi(k.x) * ksc); ok.y = pk2(bf_lo(k.y) * ksc, bf_hi(k.y) * ksc); ok.z = pk2(bf_lo(k.z) * ksc, bf_hi(k.z) * ksc); ok.w = pk2(bf_lo(k.w) * ksc, bf_hi(k.w) * ksc);
                *(LAS u32x4*)(T0 + row * TS + c * 16) = ov; *(LAS u32x4*)(T1 + row * TS + c * 16) = ok; }
            {   const int hn = h < 3 ? h + 1 : 3;
#pragma unroll
                for (int i = 0; i < 4; ++i) { const int ch = tid + 512 * i, row = ch >> 4, c = ch & 15; pfv[i] = *(const u32x4*)(B.V + (size_t)(tok0 + row) * 512 + hn * 128 + c * 8); pfk[i] = *(const u32x4*)(B.K + (size_t)(tok0 + row) * 512 + hn * 128 + c * 8); } }
            __syncthreads();
            const int vb = wave & 3, khf = wave >> 2;
            f32x16 acc[2];
#pragma unroll
            for (int kt = 0; kt < 2; ++kt)
#pragma unroll
                for (int r = 0; r < 16; ++r) acc[kt][r] = 0.f;
#pragma unroll
            for (int ks = 0; ks < 8; ++ks) { const bf16x8 a = tr_frag(T0, 16 * ks, 32 * vb, lane, false);
#pragma unroll
                for (int kt = 0; kt < 2; ++kt) { const bf16x8 bk = tr_frag(T1, 16 * ks, 64 * khf + 32 * kt, lane, false); acc[kt] = MFMA32(a, bk, acc[kt]); } }
            bf16_t* Uo = B.U + ((size_t)u * 4 + h) * 16384;
#pragma unroll
            for (int kt = 0; kt < 2; ++kt)
#pragma unroll
                for (int r = 0; r < 16; ++r) Uo[(32 * vb + crow(r, hh)) * 128 + 64 * khf + 32 * kt + r32] = f2bf(acc[kt][r]);
            {   const int kk = tid & 127, sq = tid >> 7; float a = 0.f;
                for (int s = sq * 32; s < sq * 32 + 32; ++s) a += WG[h * 128 + s] * bf2f(*(const LAS bf16_t*)(T1 + s * TS + kk * 2));
                SF[2048 + sq * 128 + kk] = a; }
            __syncthreads();
            if (tid < 128) B.UN[((size_t)u * 4 + h) * 128 + tid] = (SF[2048 + tid] + SF[2048 + 128 + tid]) + (SF[2048 + 256 + tid] + SF[2048 + 384 + tid]);
        }
    }
}
#undef OPQ_IDS
#undef P1_LOADS_A
#undef P1_LOADS_V
__device__ __forceinline__ void l0_scan(const L0Bufs& B, int blk, int tid) {
    const int bh = blk >> 3, part = blk & 7, b = bh >> 2, h = bh & 3, lane = tid & 63;
    const int e0 = part * 2048 + tid * 8;
    float zz = 0.f; asm volatile("" : "+v"(zz));
    f32x4 C0 = (f32x4){zz, zz, zz, zz}, C1 = C0; float nst = 0.f; float m = 0.f;
    const int unit0 = (b * 32) * 4 + h;
    const bool nrm = part == 0 && tid < 128;
    const float blv = lane < 32 ? B.SC[unit0 + 4 * lane] : 0.f, mlv = lane < 32 ? B.SC[1024 + unit0 + 4 * lane] : 0.f;
    u32x4 ub[8]; float un8[8];
#pragma unroll
    for (int j = 0; j < 8; ++j) { ub[j] = *(const u32x4*)(B.U + (size_t)(unit0 + 4 * j) * 16384 + e0); un8[j] = B.UN[(size_t)(unit0 + 4 * j) * 128 + (tid & 127)]; }
#pragma unroll
    for (int g = 0; g < 4; ++g) {
        u32x4 nb[8]; float nn[8];
#pragma unroll
        for (int j = 0; j < 8; ++j) { const int un1 = unit0 + 4 * (8 * (g < 3 ? g + 1 : 3) + j); nb[j] = *(const u32x4*)(B.U + (size_t)un1 * 16384 + e0); nn[j] = B.UN[(size_t)un1 * 128 + (tid & 127)]; }
#pragma unroll
        for (int j = 0; j < 8; ++j) { const int c = 8 * g + j, unit = unit0 + 4 * c; const u32x4 Unw = ub[j];
            const f32x4 U0 = (f32x4){bf_lo(Unw.x), bf_hi(Unw.x), bf_lo(Unw.y), bf_hi(Unw.y)}, U1 = (f32x4){bf_lo(Unw.z), bf_hi(Unw.z), bf_lo(Unw.w), bf_hi(Unw.w)};
            const float bl = __int_as_float(__builtin_amdgcn_readlane(__float_as_int(blv), c)), mloc = __int_as_float(__builtin_amdgcn_readlane(__float_as_int(mlv), c)), un = un8[j];
            u32x4 w; w.x = pk2(C0[0], C0[1]); w.y = pk2(C0[2], C0[3]); w.z = pk2(C1[0], C1[1]); w.w = pk2(C1[2], C1[3]); *(u32x4*)(B.CS + (size_t)unit * 16384 + e0) = w;
            if (nrm) B.NS[(size_t)unit * 128 + tid] = nst;
            if (part == 0 && tid == 0) B.SC[2048 + unit] = m;
            const float mn = fmaxf(bl + m, mloc), dec = expf(bl + m - mn), wu = expf(mloc - mn); m = mn;
            C0 = C0 * dec + U0 * wu; C1 = C1 * dec + U1 * wu;
            nst = nst * dec + wu * un; }
#pragma unroll
        for (int j = 0; j < 8; ++j) { ub[j] = nb[j]; un8[j] = nn[j]; }
    }
}
__device__ __forceinline__ void l0_mixC(LAS unsigned char* lds, const L0Bufs& B, int blk, int G) {
    const int tid0 = threadIdx.x, wave = __builtin_amdgcn_readfirstlane(tid0 >> 6);
    LAS unsigned char* TQ = lds; LAS unsigned char* TK = lds + 34816; LAS unsigned char* TV = lds + 2 * 34816; LAS unsigned char* TC = lds + 3 * 34816;
    LAS float* SF = (LAS float*)(lds + 4 * 34816);
    LAS float* AS = SF; LAS float* PM = SF + 128; LAS float* NP = SF + 256; LAS float* PS = SF + 384; LAS float* PQ = SF + 640; LAS float* NW = SF + 896;
    __syncthreads();
    { int tq = tid0; asm volatile("" : "+v"(tq)); if (tq < 256) ((LAS f32x4*)NW)[tq] = tq < 128 ? ((const f32x4*)B.nw)[tq] : ((const f32x4*)B.skip)[tq - 128]; }
    for (int uu = blk; uu < 256; uu += G) {
        const int tok0 = uu * 128;
#pragma unroll 1
        for (int h = 0; h < 4; ++h) {
            const int unit = uu * 4 + h;
            int tid = tid0; asm volatile("" : "+v"(tid));
            const int lane = tid & 63, r32 = lane & 31, hh = lane >> 5;
            __syncthreads();
            load_tile128(TQ, B.Q + (size_t)tok0 * 512 + h * 128, 512, tid);
            load_tile128(TV, B.V + (size_t)tok0 * 512 + h * 128, 512, tid);
            load_tile128(TC, B.CS + (size_t)unit * 16384, 128, tid);
#pragma unroll
            for (int i = 0; i < 4; ++i) { const int ch = tid + 512 * i, row = ch >> 4, c = ch & 15; const u32x4 k = *(const u32x4*)(B.K + (size_t)(tok0 + row) * 512 + h * 128 + c * 8); const float ksc = 0.08838834764831845f;
                u32x4 ok; ok.x = pk2(bf_lo(k.x) * ksc, bf_hi(k.x) * ksc); ok.y = pk2(bf_lo(k.y) * ksc, bf_hi(k.y) * ksc); ok.z = pk2(bf_lo(k.z) * ksc, bf_hi(k.z) * ksc); ok.w = pk2(bf_lo(k.w) * ksc, bf_hi(k.w) * ksc);
                *(LAS u32x4*)(TK + row * TS + c * 16) = ok; }
            const float mprev = B.SC[2048 + unit];
            if (wave == 0) {
                const float* gt = B.GT + (size_t)unit * 256;
                const float a0 = gt[2 * lane] - gt[128 + 2 * lane], a1 = gt[2 * lane + 1] - gt[128 + 2 * lane + 1];
                float run = fmaxf(a0, a1);
#pragma unroll
                for (int o = 1; o < 64; o <<= 1) { const float v = shup(run, o, lane); if (lane >= o) run = fmaxf(run, v); }
                const float prev = shup(run, 1, lane); const float p0 = fmaxf(lane > 0 ? fmaxf(prev, a0) : a0, mprev), p1 = fmaxf(run, mprev);
                AS[2 * lane] = a0; AS[2 * lane + 1] = a1; PM[2 * lane] = p0; PM[2 * lane + 1] = p1;
            }
            if (wave == 1) { NP[lane] = B.NS[(size_t)unit * 128 + lane]; NP[64 + lane] = B.NS[(size_t)unit * 128 + 64 + lane]; }
            __syncthreads();
            const int tb = wave & 3, vh = wave >> 2, t = 32 * tb + r32;
            const float pm = PM[t], bt = B.GT[(size_t)unit * 256 + 128 + t];
            f32x16 s[4];
#pragma unroll
            for (int st = 0; st < 4; ++st)
#pragma unroll
                for (int r = 0; r < 16; ++r) s[st][r] = 0.f;
            {   int lv = lane; asm volatile("" : "+v"(lv));
                const LAS unsigned char* qp = TQ + (32 * tb + (lv & 31)) * TS + (lv >> 5) * 16; const LAS unsigned char* kp = TK + (lv & 31) * TS + (lv >> 5) * 16;
#pragma unroll 2
                for (int ks = 0; ks < 8; ++ks) { const bf16x8 bq = *(const LAS bf16x8*)(qp + ks * 32);
#pragma unroll
                    for (int st = 0; st < 4; ++st) if (st <= tb) { const bf16x8 a = *(const LAS bf16x8*)(kp + st * 32 * TS + ks * 32); s[st] = MFMA32(a, bq, s[st]); } } }
            float nq = 0.f; u32x4 pf[4][2];
#pragma unroll
            for (int st = 0; st < 4; ++st) {
#pragma unroll
                for (int r = 0; r < 16; ++r) { const int sidx = 32 * st + crow(r, hh); const float wv = (sidx <= t) ? __builtin_amdgcn_exp2f((AS[sidx] - pm) * LOG2E) : 0.f; const float pv = s[st][r] * wv; s[st][r] = pv; nq += pv; }
#pragma unroll
                for (int sx = 0; sx < 2; ++sx) pf[st][sx] = (u32x4){pk2(s[st][8 * sx], s[st][8 * sx + 1]), pk2(s[st][8 * sx + 2], s[st][8 * sx + 3]), pk2(s[st][8 * sx + 4], s[st][8 * sx + 5]), pk2(s[st][8 * sx + 6], s[st][8 * sx + 7])};
            }
            nq = xhalf_sum(nq);
            float nqi = 0.f;
#pragma unroll
            for (int i = 0; i < 8; ++i) { const u32x4 qv = *(const LAS u32x4*)(TQ + t * TS + (64 * hh + 8 * i) * 2); const LAS float* np = NP + 64 * hh + 8 * i;
                nqi += bf_lo(qv.x) * np[0] + bf_hi(qv.x) * np[1] + bf_lo(qv.y) * np[2] + bf_hi(qv.y) * np[3] + bf_lo(qv.z) * np[4] + bf_hi(qv.z) * np[5] + bf_lo(qv.w) * np[6] + bf_hi(qv.w) * np[7]; }
            nqi = xhalf_sum(nqi);
            const float wst = __builtin_amdgcn_exp2f((mprev - pm) * LOG2E);
            const float den = fmaxf(fabsf(nq + wst * nqi), __builtin_amdgcn_exp2f(-(bt + pm) * LOG2E)), rden = 1.f / den;
            f32x16 ni[2], nx[2];
#pragma unroll
            for (int vt = 0; vt < 2; ++vt)
#pragma unroll
                for (int r = 0; r < 16; ++r) { ni[vt][r] = 0.f; nx[vt][r] = 0.f; }
            {   int lv = lane; asm volatile("" : "+v"(lv));
#pragma unroll
                for (int st = 0; st < 4; ++st) {
                    if (st <= tb) {
#pragma unroll
                        for (int sx = 0; sx < 2; ++sx) { const bf16x8 pb = __builtin_bit_cast(bf16x8, pf[st][sx]);
#pragma unroll
                            for (int vt = 0; vt < 2; ++vt) { const bf16x8 a = tr_frag(TV, 32 * st + 16 * sx, 64 * vh + 32 * vt, lv, true); ni[vt] = MFMA32(a, pb, ni[vt]); } }
                    }
                } }
            {   int lv = lane; asm volatile("" : "+v"(lv));
                const LAS unsigned char* qp = TQ + (32 * tb + (lv & 31)) * TS + (lv >> 5) * 16; const LAS unsigned char* cp = TC + (64 * vh + (lv & 31)) * TS + (lv >> 5) * 16;
#pragma unroll 2
                for (int ks = 0; ks < 8; ++ks) { const bf16x8 bq = *(const LAS bf16x8*)(qp + ks * 32);
#pragma unroll
                    for (int vt = 0; vt < 2; ++vt) { const bf16x8 a = *(const LAS bf16x8*)(cp + vt * 32 * TS + ks * 32); nx[vt] = MFMA32(a, bq, nx[vt]); } } }
            const size_t tok = (size_t)tok0 + t;
            u32x2 xcv[2][4], zv[2][4];
#pragma unroll
            for (int vt = 0; vt < 2; ++vt)
#pragma unroll
                for (int gq = 0; gq < 4; ++gq) { const int chn = h * 128 + 64 * vh + 32 * vt + 8 * gq + 4 * hh; xcv[vt][gq] = *(const u32x2*)(B.XC + tok * 512 + chn); zv[vt][gq] = *(const u32x2*)(B.BZ + tok * 512 + chn); }
            float hs = 0.f, hq = 0.f;
#pragma unroll
            for (int vt = 0; vt < 2; ++vt)
#pragma unroll
                for (int r = 0; r < 16; ++r) { const float hv = (ni[vt][r] + wst * nx[vt][r]) * rden; ni[vt][r] = hv; hs += hv; hq += hv * hv; }
            hs = xhalf_sum(hs); hq = xhalf_sum(hq);
            if (hh == 0) { PS[vh * 128 + t] = hs; PQ[vh * 128 + t] = hq; }
            __syncthreads();
            const float mean = (PS[t] + PS[128 + t]) * (1.f / 128.f);
            const float rstd = rsqrtf(fmaxf((PQ[t] + PQ[128 + t]) * (1.f / 128.f) - mean * mean, 0.f) + LN_EPS);
#pragma unroll
            for (int vt = 0; vt < 2; ++vt)
#pragma unroll
                for (int gq = 0; gq < 4; ++gq) { const int cl = 64 * vh + 32 * vt + 8 * gq + 4 * hh, chn = h * 128 + cl;
                    const f32x4 nw = *(const LAS f32x4*)(NW + chn), sk = *(const LAS f32x4*)(NW + 512 + chn); const u32x2 xc = xcv[vt][gq], z = zv[vt][gq];
                    const float y0 = ((ni[vt][4 * gq] - mean) * rstd * nw[0] + sk[0] * bf_lo(xc.x)) * silu_f(bf_lo(z.x)), y1 = ((ni[vt][4 * gq + 1] - mean) * rstd * nw[1] + sk[1] * bf_hi(xc.x)) * silu_f(bf_hi(z.x));
                    const float y2 = ((ni[vt][4 * gq + 2] - mean) * rstd * nw[2] + sk[2] * bf_lo(xc.y)) * silu_f(bf_lo(z.y)), y3 = ((ni[vt][4 * gq + 3] - mean) * rstd * nw[3] + sk[3] * bf_hi(xc.y)) * silu_f(bf_hi(z.y));
                    u32x2 w; w.x = pk2(y0, y1); w.y = pk2(y2, y3); *(u32x2*)(B.YM + tok * 1024 + 512 + chn) = w; }
        }
    }
}
constexpr size_t MB = 1048576ull;
constexpr size_t P_WIN_T = 0, P_WOUT_T = P_WIN_T + 4 * MB, P_WQKV_T = P_WOUT_T + 2 * MB, P_WO_T = P_WQKV_T + 3 * MB, P_XWQ_T = P_WO_T + 2 * MB, P_XWKV_T = P_XWQ_T + 4 * MB, P_XWO_T = P_XWKV_T + 8 * MB,
                 P_MLW_T = P_XWO_T + 4 * MB, P_WIFT = P_MLW_T + MB / 2, P_WRT = P_WIFT + MB / 8, P_ROT = P_WRT + MB / 2, P_BQK = P_ROT + MB, P_MEMB = P_BQK + MB / 8, P_KC = P_MEMB + 4 * MB, P_VT = P_KC + 8 * MB,
                 P_W13T = P_VT + 8 * MB, P_W2T = P_W13T + 64 * MB, P_XBF = P_W2T + 32 * MB, P_RT = P_XBF + 64 * MB, P_TMP = P_RT + 2 * MB;
constexpr size_t P_BAR = P_RT + 1572864;
constexpr size_t RT_SRC = 1638400;
constexpr size_t RT_E = 0, RT_W = 262144, RT_RANK = 2 * 262144, RT_DEST = 3 * 262144, RT_HIST = 4 * 262144, RT_TSTART = RT_HIST + 32768;
constexpr size_t T_QX = 0, T_OB = 64 * MB, T_YB = 128 * MB;
constexpr size_t T_K1 = 192 * MB, T_VT1 = 208 * MB;
constexpr size_t T_AU = 0, T_AV = 32 * MB, T_BX = 64 * MB, T_BZ = 96 * MB, T_V = 128 * MB, T_XC = 160 * MB, T_YM = 192 * MB, T_U = 256 * MB, T_CS = 320 * MB,
                 T_GT = 352 * MB, T_UN = 353 * MB, T_NS = 353 * MB + MB / 2, T_SC = 354 * MB, T_YB0 = 0;
constexpr size_t T_XG = 0, T_HM = 152 * MB, T_YG = 0;
constexpr size_t T_W13B = 228 * MB, T_W2B = 292 * MB;
constexpr size_t T_SLOT = 356 * MB;
constexpr size_t FAST_END = P_TMP + 360 * MB;
#if defined(PROBE_LNX) || defined(PROBE_LNV)
constexpr size_t SLOT_MB = 8;
#else
constexpr size_t SLOT_MB = 4;
#endif
constexpr int LDS_BYTES = 147456;

struct FP {
    const float* in[33]; float* X;
    unsigned char* ws;
};
typedef const float* const __attribute__((address_space(4)))* InTab;
struct PV { InTab in; float* X; unsigned char* ws; };
__device__ __forceinline__ PV make_pv(const FP& p0) {
    PV p; InTab kp = (InTab)__builtin_amdgcn_kernarg_segment_ptr(); asm volatile("" : "+s"(kp)); p.in = kp;
    p.X = p0.X; p.ws = p0.ws; asm volatile("" : "+s"(p.ws)); return p;
}
#define WSP(T, off) ((T*)(p.ws + (off)))

__device__ __forceinline__ RouteBufs route_bufs(const PV& p) {
    RouteBufs r; r.e = WSP(int, P_RT + RT_E); r.w = WSP(float, P_RT + RT_W); r.rank = WSP(int, P_RT + RT_RANK); r.dest = WSP(int, P_RT + RT_DEST); r.hist = WSP(int, P_RT + RT_HIST); r.tstart = WSP(int, P_RT + RT_TSTART); r.src = WSP(int, P_RT + RT_SRC); return r;
}
#define PH_ARGS const PV& p, LAS unsigned char* lds, int blk, int G
#define PH_IDS int tid_ = threadIdx.x; asm volatile("" : "+v"(tid_)); const int tid = tid_, lane = tid & 63, wave = __builtin_amdgcn_readfirstlane(tid >> 6); (void)lane; (void)wave;

__device__ __forceinline__ void ph_conv_xattn(PH_ARGS, int l, int& gw) {
    PH_IDS; LAS float* scr = (LAS float*)(lds + wave * 8448); const int ngw = G * NWAVE;
    convert_mats(p.in[23] + (size_t)l * 1024 * 1024, 1024, 1024, 1, 0, WSP(bf16_t, P_XWQ_T) + (size_t)l * 1024 * 1024, 0, RM_IDENT, 0.0625f, 1024, scr, gw, ngw, lane);
    convert_mats(p.in[24] + (size_t)l * 1024 * 2048, 1024, 2048, 1, 0, WSP(bf16_t, P_XWKV_T) + (size_t)l * 2048 * 1024, 0, RM_IDENT, 1.f, 0, scr, gw, ngw, lane);
    convert_mats(p.in[25] + (size_t)l * 1024 * 1024, 1024, 1024, 1, 0, WSP(bf16_t, P_XWO_T) + (size_t)l * 1024 * 1024, 0, RM_IDENT, 1.f, 0, scr, gw, ngw, lane);
    convert_rows(p.in[1], WSP(bf16_t, P_MEMB), (size_t)2048 * 1024, blk * NTHR + tid, G * NTHR);
}
__device__ __forceinline__ void conv_router_w(const PV& p, int l, int gt, int ngt) {
    bf16_t* wrt = WSP(bf16_t, P_WRT) + (size_t)l * 2 * 64 * 1024; const float* wre = p.in[28] + (size_t)l * 1024 * 32; const float* wrg = p.in[26] + (size_t)l * 1024 * 4;
    for (int i = gt; i < 64 * 1024; i += ngt) { const int r = i >> 10, k = i & 1023;
        const float v = r < 32 ? wre[k * 32 + r] : (r < 36 ? wrg[k * 4 + (r - 32)] : 0.f);
        const bf16_t h = f2bf(v); wrt[i] = h; wrt[64 * 1024 + i] = f2bf(v - bf2f(h)); }
}
__device__ __forceinline__ void conv_moe_waves(const PV& p, int l, LAS float* scr, int& gw, int ngw, int gt, int ngt, int lane) {
    const size_t wl = (size_t)l * 32 * 1024 * 512;
    convert_mats(p.in[30] + wl, 1024, 512, 32, (size_t)1024 * 512, WSP(bf16_t, P_W13T), (size_t)1024 * 1024, RM_PAIR0, 1.f, 0, scr, gw, ngw, lane);
    convert_mats(p.in[31] + wl, 1024, 512, 32, (size_t)1024 * 512, WSP(bf16_t, P_W13T), (size_t)1024 * 1024, RM_PAIR1, 1.f, 0, scr, gw, ngw, lane);
    convert_mats(p.in[32] + wl, 512, 1024, 32, (size_t)512 * 1024, WSP(bf16_t, P_W2T), (size_t)1024 * 512, RM_IDENT, 1.f, 0, scr, gw, ngw, lane);
    conv_router_w(p, l, gt, ngt);
}
#ifndef TAILQ_XA
#define TAILQ_XA 3
#endif
#ifndef TAILQ_G1
#define TAILQ_G1 4
#endif
#ifndef TAILQ_G2
#define TAILQ_G2 2
#endif
constexpr size_t P_CURSOR_OFF = 15360;
__device__ __forceinline__ void conv_moe1_item(const PV& p, unsigned it, LAS float* scr, int lane, f32x4 (&tv)[8], bool load) {
    const size_t wl = (size_t)32 * 1024 * 512;
    const int mat = it >> 13, r = it & 8191, bt = r >> 8, rr = r & 255;
    if (mat < 2) { const float* W = (mat == 0 ? p.in[30] : p.in[31]) + wl + (size_t)bt * 1024 * 512;
        if (load) ti_load(W, 512, rr >> 4, rr & 15, lane, tv); else ti_store(tv, 1024, WSP(bf16_t, P_TMP + T_W13B) + (size_t)bt * 1024 * 1024, scr, rr >> 4, rr & 15, lane, mat == 0 ? RM_PAIR0 : RM_PAIR1, 1.f, 0); }
    else { const float* W = p.in[32] + wl + (size_t)bt * 512 * 1024;
        if (load) ti_load(W, 1024, rr >> 5, rr & 31, lane, tv); else ti_store(tv, 512, WSP(bf16_t, P_TMP + T_W2B) + (size_t)bt * 1024 * 512, scr, rr >> 5, rr & 31, lane, RM_IDENT, 1.f, 0); }
}
__device__ __forceinline__ void conv_moe1_range(const PV& p, LAS float* scr, int lane, int first, int stride, int last) {
    if (last > 12288) last = 12288;
    if (first >= last) return;
    f32x4 ta[8], tb[8];
    conv_moe1_item(p, 2 * first, scr, lane, ta, true); conv_moe1_item(p, 2 * first + 1, scr, lane, tb, true);
    for (int it = first; it < last; it += stride) {
        const int nx = it + stride; f32x4 na[8], nb[8];
        const int nl = nx < last ? nx : it;
        conv_moe1_item(p, 2 * nl, scr, lane, na, true);
        conv_moe1_item(p, 2 * it, scr, lane, ta, false);
        conv_moe1_item(p, 2 * nl + 1, scr, lane, nb, true);
        conv_moe1_item(p, 2 * it + 1, scr, lane, tb, false);
#pragma unroll
        for (int i = 0; i < 8; ++i) { ta[i] = na[i]; tb[i] = nb[i]; }
    }
}
struct TailPlan { int t0, t1, t2, nidle, first_idle; };
__device__ __forceinline__ TailPlan tail_plan(int ntile, int G) {
    TailPlan t; const int U = ntile * 4, R = (U + G - 1) / G; t.first_idle = U - (R - 1) * G; t.nidle = G - t.first_idle;
    t.t0 = 128 * NWAVE * TAILQ_XA; t.t1 = t.nidle * NWAVE * TAILQ_G1; t.t2 = t.nidle * NWAVE * TAILQ_G2; return t;
}
__device__ __forceinline__ void ph_conv_moe(PH_ARGS, int l, int& gw) {
    PH_IDS; conv_moe_waves(p, l, (LAS float*)(lds + wave * 8448), gw, G * NWAVE, blk * NTHR + tid, G * NTHR, lane);
}
__device__ __forceinline__ void ph_x_to_bf(PH_ARGS) { PH_IDS; convert_rows(p.X, WSP(bf16_t, P_XBF), (size_t)NT * 1024, blk * NTHR + tid, G * NTHR); }

__device__ __forceinline__ void set_job(LAS pg8::JobDesc* jt, int j, const void* A, const void* B, int nM, int nN, void* out, int ldc, int mode, const void* bias = nullptr, const void* rot = nullptr, void* out2 = nullptr) {
    unsigned long long a = (unsigned long long)A, b = (unsigned long long)B, o = (unsigned long long)out, bi = (unsigned long long)bias, ro = (unsigned long long)rot, o2 = (unsigned long long)out2;
    asm volatile("" : "+s"(a), "+s"(b), "+s"(o), "+s"(bi), "+s"(ro), "+s"(o2), "+s"(nM), "+s"(nN), "+s"(ldc), "+s"(mode));
    LAS pg8::JobDesc* d = jt + j; d->A = a; d->B = b; d->out = o; d->bias = bi; d->rot = ro; d->out2 = o2;
    d->nM = nM; d->nN = nN; d->ldc = ldc; d->mode = mode;
}
#define JT_PTR ((LAS pg8::JobDesc*)(lds + pg8::JT_OFF))
__device__ __forceinline__ void run_jobs(LAS unsigned char* lds, int K, int n0, int n1, int n2, int blk, int G) {
    __syncthreads();
    pg8::Jobs3 S; S.jt = JT_PTR; S.n0 = n0; S.n1 = n1; S.n2 = n2; S.K = K; S.G = G; S.c = blk;
    EpiMulti E; E.jt = JT_PTR;
    pg8::gemm_phase<EpiMulti, pg8::Jobs3, true, true>(lds, K, S, E);
}
__device__ __forceinline__ void ph_xattn_g1(PH_ARGS, int l) {
    const bf16_t* wkv = WSP(bf16_t, P_XWKV_T) + (size_t)l * 2048 * 1024;
    __syncthreads();
    if (threadIdx.x == 0) {
        set_job(JT_PTR, 0, WSP(bf16_t, P_MEMB), wkv, 8, 4, WSP(bf16_t, P_KC) + (size_t)l * 2048 * 1024, 1024, EM_PLAIN);
        set_job(JT_PTR, 1, wkv + (size_t)1024 * 1024, WSP(bf16_t, P_MEMB), 4, 8, WSP(bf16_t, P_VT) + (size_t)l * 1024 * 2048, 2048, EM_PLAIN);
        set_job(JT_PTR, 2, WSP(bf16_t, P_XBF), WSP(bf16_t, P_XWQ_T) + (size_t)l * 1024 * 1024, 128, 4, WSP(bf16_t, P_TMP + T_QX), 1024, EM_PLAIN);
    }
    run_jobs(lds, 1024, 32, 32, 512, blk, G);
}
__device__ __forceinline__ void ph_xattn_attn(PH_ARGS, int l) {
    xattn_phase(lds, WSP(bf16_t, P_TMP + T_QX), WSP(bf16_t, P_KC) + (size_t)l * 2048 * 1024, WSP(bf16_t, P_VT) + (size_t)l * 1024 * 2048, WSP(bf16_t, P_TMP + T_OB), blk, G);
}
__device__ __forceinline__ void ph_gemm_plain(PH_ARGS, const bf16_t* A, const bf16_t* Bt, bf16_t* out) {
    __syncthreads();
    if (threadIdx.x == 0) set_job(JT_PTR, 0, A, Bt, 128, 4, out, 1024, EM_PLAIN);
    run_jobs(lds, 1024, 512, 0, 0, blk, G);
}
template <bool XF32, bool OUTF32, bool MOE>
__device__ __forceinline__ void ph_ln(PH_ARGS, const bf16_t* y, int lnidx, bool dry = false) {
    PH_IDS; LnArgs a; a.xin32 = p.in[0]; a.xin = WSP(bf16_t, P_XBF); a.xout32 = dry ? WSP(float, P_TMP + 200 * MB) : p.X; a.xbf = dry ? WSP(bf16_t, P_TMP + 288 * MB) : WSP(bf16_t, P_XBF); a.y = y; a.g = p.in[2] + lnidx * 1024; a.b = p.in[3] + lnidx * 1024;
    a.dest = WSP(int, P_RT + RT_DEST); a.wts = WSP(float, P_RT + RT_W);
    ln_phase<XF32, OUTF32, MOE>(a, blk, G, wave, lane);
}
__device__ __forceinline__ void ph_moe_route(PH_ARGS, int l) {
    moe_router_phase(lds, WSP(bf16_t, P_XBF), WSP(bf16_t, P_WRT) + (size_t)l * 2 * 64 * 1024, p.in[27] + l * 4, p.in[29] + l * 32, route_bufs(p), blk);
}
__device__ __forceinline__ void ph_moe_scatter(PH_ARGS) { moe_scatter_phase(lds, route_bufs(p), blk, G); }
__device__ __forceinline__ void ph_moe_g1(PH_ARGS) {
    __syncthreads();
    if (threadIdx.x == 0) set_job(JT_PTR, 0, nullptr, nullptr, 0, 0, WSP(bf16_t, P_TMP + T_HM), 512, EM_SWIGLU);
    __syncthreads();
    MoeSched S; S.A = (const char*)WSP(bf16_t, P_TMP + T_XG); S.B = (const char*)WSP(bf16_t, P_W13T); S.tstart = WSP(int, P_RT + RT_TSTART); S.K = 1024; S.nN = 4; S.G = G; S.c = blk; S.bexp = (size_t)1024 * 1024 * 2;
    EpiMulti E; E.jt = JT_PTR;
    pg8::gemm_phase<EpiMulti, MoeSched, true, true>(lds, 1024, S, E);
}
__device__ __forceinline__ void ph_moe_g2(PH_ARGS) {
    __syncthreads();
    if (threadIdx.x == 0) set_job(JT_PTR, 0, nullptr, nullptr, 0, 0, WSP(bf16_t, P_TMP + T_YG), 1024, EM_PLAIN);
    __syncthreads();
    MoeSched S; S.A = (const char*)WSP(bf16_t, P_TMP + T_HM); S.B = (const char*)WSP(bf16_t, P_W2T); S.tstart = WSP(int, P_RT + RT_TSTART); S.K = 512; S.nN = 4; S.G = G; S.c = blk; S.bexp = (size_t)1024 * 512 * 2;
    EpiMulti E; E.jt = JT_PTR;
    pg8::gemm_phase<EpiMulti, MoeSched, true, true>(lds, 512, S, E);
}

__device__ __forceinline__ void ph_conv_l1(PH_ARGS, int& gw) {
    PH_IDS; LAS float* scr = (LAS float*)(lds + wave * 8448); const int ngw = G * NWAVE;
    convert_mats(p.in[19], 1024, 1536, 1, 0, WSP(bf16_t, P_WQKV_T), 0, RM_ROT, 0.125f, 1024, scr, gw, ngw, lane);
    convert_mats(p.in[22], 1024, 1024, 1, 0, WSP(bf16_t, P_WO_T), 0, RM_IDENT, 1.f, 0, scr, gw, ngw, lane);
    const int gt = blk * NTHR + tid, ngt = G * NTHR;
    float* bqk = WSP(float, P_BQK);
    for (int n = gt; n < 1280; n += ngt) bqk[rowmap(RM_ROT, n)] = p.in[20][n] * (n < 1024 ? 0.125f : 1.f);
    float* rot = WSP(float, P_ROT);
    for (int i = gt; i < 4096 * 32; i += ngt) { const int pos = i >> 5, k = i & 31; const float inv = powf(10000.f, -(float)(2 * k) / 64.f); const float ang = (float)pos * inv; rot[2 * i] = cosf(ang); rot[2 * i + 1] = sinf(ang); }
}
__device__ __forceinline__ void ph_l1_g1(PH_ARGS) {
    __syncthreads();
    if (threadIdx.x == 0) {
        set_job(JT_PTR, 0, WSP(bf16_t, P_XBF), WSP(bf16_t, P_WQKV_T), 128, 5, WSP(bf16_t, P_TMP + T_QX), 1024, EM_ROTARY, WSP(float, P_BQK), WSP(float, P_ROT), WSP(bf16_t, P_TMP + T_K1));
        set_job(JT_PTR, 1, WSP(bf16_t, P_WQKV_T) + (size_t)1280 * 1024, WSP(bf16_t, P_XBF), 1, 128, WSP(bf16_t, P_TMP + T_VT1), NT, EM_ROWBIAS, p.in[20] + 1280);
    }
    run_jobs(lds, 1024, 640, 128, 0, blk, G);
}
__device__ __forceinline__ void ph_l1_swa(PH_ARGS) {
    swa_phase(lds, WSP(bf16_t, P_TMP + T_QX), WSP(bf16_t, P_TMP + T_K1), WSP(bf16_t, P_TMP + T_VT1), p.in[21], WSP(bf16_t, P_TMP + T_OB), blk, G);
}

__device__ __forceinline__ L0Bufs l0_bufs(const PV& p) {
    L0Bufs B; B.AU = WSP(bf16_t, P_TMP + T_AU); B.AV = WSP(bf16_t, P_TMP + T_AV); B.BX = WSP(bf16_t, P_TMP + T_BX); B.BZ = WSP(bf16_t, P_TMP + T_BZ); B.V = WSP(bf16_t, P_TMP + T_V); B.XC = WSP(bf16_t, P_TMP + T_XC);
    B.YM = WSP(bf16_t, P_TMP + T_YM); B.CS = WSP(bf16_t, P_TMP + T_CS); B.U = WSP(bf16_t, P_TMP + T_U); B.GT = WSP(float, P_TMP + T_GT); B.UN = WSP(float, P_TMP + T_UN); B.NS = WSP(float, P_TMP + T_NS); B.SC = WSP(float, P_TMP + T_SC);
    B.Q = B.AU; B.K = B.AV;
    B.WQT = WSP(bf16_t, P_MLW_T); B.GMW = WSP(bf16_t, P_MLW_T) + 12 * 16384; B.MT = WSP(bf16_t, P_WIFT);
    B.gm_g = p.in[5]; B.gm_b = p.in[6]; B.gm_bs = p.in[8]; B.cw = p.in[9]; B.cb = p.in[10]; B.bif = p.in[15]; B.nw = p.in[16]; B.skip = p.in[17]; return B;
}
__device__ __forceinline__ void ph_scan_conv(PH_ARGS) {
    PH_IDS;
    if (wave < 4) l0_scan(l0_bufs(p), blk, tid);
}
__device__ __forceinline__ void ph_conv_l0(PH_ARGS, int& gwr) {
    PH_IDS; LAS float* scr = (LAS float*)(lds + wave * 8448); const int gw = blk * NWAVE + wave, ngw = G * NWAVE;
    convert_mats(p.in[4], 1024, 2048, 1, 0, WSP(bf16_t, P_WIN_T), 0, RM_IDENT, 1.f, 0, scr, gwr, ngw, lane);
    convert_mats(p.in[18], 1024, 1024, 1, 0, WSP(bf16_t, P_WOUT_T), 0, RM_IDENT, 1.f, 0, scr, gwr, ngw, lane);
    convert_mats(p.in[11], 128, 128, 4, 16384, WSP(bf16_t, P_MLW_T), 16384, RM_IDENT, 1.f, 0, scr, gwr, ngw, lane);
    convert_mats(p.in[12], 128, 128, 4, 16384, WSP(bf16_t, P_MLW_T) + 4 * 16384, 16384, RM_IDENT, 1.f, 0, scr, gwr, ngw, lane);
    convert_mats(p.in[13], 128, 128, 4, 16384, WSP(bf16_t, P_MLW_T) + 8 * 16384, 16384, RM_IDENT, 1.f, 0, scr, gwr, ngw, lane);
    const int gt = blk * NTHR + tid, ngt = G * NTHR;
    bf16_t* gmw = WSP(bf16_t, P_MLW_T) + 12 * 16384;
    for (int i = gt; i < 4 * 16384; i += ngt) { const int t = (i >> 7) & 127, sidx = i & 127; gmw[i] = f2bf(sidx <= t ? p.in[7][i] : 0.f); }
    bf16_t* mt = WSP(bf16_t, P_WIFT);
    for (int i = gw; i < 4 * 8 * 256; i += ngw) { const int h = i >> 11, g = (i >> 8) & 7, j = i & 255, d = j & 127; float a = 0.f;
        for (int e = lane; e < 128; e += 64) {
            if (j < 128) a += p.in[11][((size_t)h * 128 + d) * 128 + e] * p.in[14][(h * 128 + e) * 8 + g] + p.in[12][((size_t)h * 128 + d) * 128 + e] * p.in[14][(512 + h * 128 + e) * 8 + g];
            else a += p.in[13][((size_t)h * 128 + d) * 128 + e] * p.in[14][(1024 + h * 128 + e) * 8 + g]; }
        a += shx(a, 32, lane); a += shx(a, 16, lane); a += shx(a, 8, lane); a += shx(a, 4, lane); a += shx(a, 2, lane); a += shx(a, 1, lane);
        if (lane == 0) mt[i] = f2bf(a); }
}
__device__ __forceinline__ void ph_xin_to_bf(PH_ARGS) { PH_IDS; convert_rows(p.in[0], WSP(bf16_t, P_XBF), (size_t)NT * 1024, blk * NTHR + tid, G * NTHR); }
__device__ __forceinline__ void ph_l0_g1(PH_ARGS) {
    __syncthreads();
    if (threadIdx.x == 0) set_job(JT_PTR, 0, WSP(bf16_t, P_XBF), WSP(bf16_t, P_WIN_T), 128, 8, WSP(bf16_t, P_TMP + T_AU), 512, EM_GELU4);
    run_jobs(lds, 1024, 1024, 0, 0, blk, G);
}

enum { K_CONV_XATTN = 0, K_CONV_MOE, K_X2BF, K_XATTN_G1, K_XATTN_ATTN, K_XATTN_G2, K_LN_Y, K_MOE_ROUTE, K_MOE_SCATTER, K_MOE_G1, K_MOE_G2, K_LN_MOE, K_CONV_L1, K_L1_G1, K_L1_SWA, K_L1_G2, K_CONV_L0, K_XIN2BF, K_L0_G1, K_L0_MIXA, K_L0_SCAN, K_L0_MIXC, K_L0_G2, K_LN_Y0 };
template <int PH>
__global__ void __launch_bounds__(NTHR, 2) k_phase(FP p0, int l, int lnidx) {
    const PV p = make_pv(p0);
    extern __shared__ __attribute__((aligned(16))) unsigned char smem[];
    LAS unsigned char* lds = (LAS unsigned char*)smem;
    const int blk = blockIdx.x, G = gridDim.x;
    if constexpr (PH == K_CONV_XATTN) { int gwr = blk * NWAVE + (threadIdx.x >> 6); ph_conv_xattn(p, lds, blk, G, l, gwr); }
    if constexpr (PH == K_CONV_MOE) { int gwr = blk * NWAVE + (threadIdx.x >> 6); ph_conv_moe(p, lds, blk, G, l, gwr); }
    if constexpr (PH == K_X2BF) ph_x_to_bf(p, lds, blk, G);
    if constexpr (PH == K_XATTN_G1) ph_xattn_g1(p, lds, blk, G, l);
    if constexpr (PH == K_XATTN_ATTN) ph_xattn_attn(p, lds, blk, G, l);
    if constexpr (PH == K_XATTN_G2) ph_gemm_plain(p, lds, blk, G, WSP(bf16_t, P_TMP + T_OB), WSP(bf16_t, P_XWO_T) + (size_t)l * 1024 * 1024, WSP(bf16_t, P_TMP + T_YB));
    if constexpr (PH == K_LN_Y) ph_ln<false, false, false>(p, lds, blk, G, WSP(bf16_t, P_TMP + T_YB), lnidx);
    if constexpr (PH == K_MOE_ROUTE) ph_moe_route(p, lds, blk, G, l);
    if constexpr (PH == K_MOE_SCATTER) ph_moe_scatter(p, lds, blk, G);
    if constexpr (PH == K_MOE_G1) ph_moe_g1(p, lds, blk, G);
    if constexpr (PH == K_MOE_G2) ph_moe_g2(p, lds, blk, G);
    if constexpr (PH == K_LN_MOE) ph_ln<false, false, true>(p, lds, blk, G, WSP(bf16_t, P_TMP + T_YG), lnidx);
    if constexpr (PH == K_CONV_L0) { int gwr = blk * NWAVE + (threadIdx.x >> 6); ph_conv_l0(p, lds, blk, G, gwr); }
    if constexpr (PH == K_XIN2BF) ph_xin_to_bf(p, lds, blk, G);
    if constexpr (PH == K_L0_G1) ph_l0_g1(p, lds, blk, G);
    if constexpr (PH == K_L0_MIXA) l0_mixA(lds, l0_bufs(p), blk, G);
    if constexpr (PH == K_L0_SCAN) ph_scan_conv(p, lds, blk, G);
    if constexpr (PH == K_L0_MIXC) l0_mixC(lds, l0_bufs(p), blk, G);
    if constexpr (PH == K_L0_G2) ph_gemm_plain(p, lds, blk, G, WSP(bf16_t, P_TMP + T_YM), WSP(bf16_t, P_WOUT_T), WSP(bf16_t, P_TMP + T_YB0));
    if constexpr (PH == K_LN_Y0) ph_ln<true, false, false>(p, lds, blk, G, WSP(bf16_t, P_TMP + T_YB0), 0);
    if constexpr (PH == K_CONV_L1) { int gwr = blk * NWAVE + (threadIdx.x >> 6); ph_conv_l1(p, lds, blk, G, gwr); }
    if constexpr (PH == K_L1_G1) ph_l1_g1(p, lds, blk, G);
    if constexpr (PH == K_L1_SWA) ph_l1_swa(p, lds, blk, G);
    if constexpr (PH == K_L1_G2) ph_gemm_plain(p, lds, blk, G, WSP(bf16_t, P_TMP + T_OB), WSP(bf16_t, P_WO_T), WSP(bf16_t, P_TMP + T_YB));
}

#define XB_TMO      128
#define XB_XCNT(j)  (256  + 64 * (j))
#define XB_XSUB(j)  (1280 + 64 * (j))
#define XB_XGEN(j)  (2304 + 64 * (j))
#define XB_TOP      3328
#define XB_TOPGEN   3392
#define XCD_BAR_WORDS 3456
#define XB_SPIN_CAP (1u << 22)
__device__ __forceinline__ unsigned xb_ld(unsigned* p)              { return __hip_atomic_load(p, __ATOMIC_RELAXED, __HIP_MEMORY_SCOPE_AGENT); }
__device__ __forceinline__ unsigned xb_add(unsigned* p, unsigned v) { return __hip_atomic_fetch_add(p, v, __ATOMIC_RELAXED, __HIP_MEMORY_SCOPE_AGENT); }
__device__ __forceinline__ unsigned xb_xcc_id() { return (unsigned)__builtin_amdgcn_s_getreg((3 << 11) | 20) & 0xFu; }
#define XB_SPIN(cond, bar) do { unsigned _sp = 0; while (cond) { __builtin_amdgcn_s_sleep(1); \
    if ((++_sp & 255u) == 0u) { if (xb_ld(&(bar)[XB_TMO])) break; if (_sp > XB_SPIN_CAP) { atomicAdd(&(bar)[XB_TMO], 1u); break; } } } } while (0)
struct XcdBarrier { unsigned* bar; unsigned x; volatile LAS unsigned* st; };
__device__ __forceinline__ XcdBarrier xcd_barrier_post(unsigned* bar, volatile LAS unsigned* st) {
    XcdBarrier b; b.bar = bar; b.x = xb_xcc_id(); b.st = st;
    if (threadIdx.x == 0) (void)xb_add(&bar[XB_XCNT(b.x)], 1u);
    return b;
}
__device__ __forceinline__ void xcd_barrier_complete(unsigned* bar, unsigned x, unsigned& nloc, unsigned& nx) {
    const unsigned G = gridDim.x * gridDim.y * gridDim.z;
    unsigned sum, cnt, mine, sp = 0u;
    for (;;) {
        sum = 0u; cnt = 0u; mine = 0u;
#pragma unroll
        for (unsigned j = 0; j < 16; ++j) { const unsigned c = xb_ld(&bar[XB_XCNT(j)]); sum += c; cnt += (c > 0u) ? 1u : 0u; mine = (j == x) ? c : mine; }
        if (sum == G) break;
        __builtin_amdgcn_s_sleep(1);
        if ((++sp & 255u) == 0u) { if (xb_ld(&bar[XB_TMO])) break; if (sp > XB_SPIN_CAP) { atomicAdd(&bar[XB_TMO], 1u); break; } }
    }
    nloc = mine > 0u ? mine : 1u; nx = cnt > 0u ? cnt : 1u;
}
__device__ __forceinline__ void xcd_barrier(const XcdBarrier& b) {
    asm volatile("s_waitcnt vmcnt(0)" ::: "memory");
    __syncthreads();
    if (threadIdx.x == 0) {
        unsigned* bar = b.bar; asm volatile("" : "+s"(bar));
        __builtin_amdgcn_s_waitcnt(0);
        unsigned nloc = b.st[0], nx = b.st[1];
        if (nloc == 0u) { xcd_barrier_complete(bar, b.x, nloc, nx); b.st[0] = nloc; b.st[1] = nx; }
        const unsigned old = xb_add(&bar[XB_XSUB(b.x)], 1u);
        const unsigned gen = old / nloc;
        if (old + 1u == (gen + 1u) * nloc) {
            __builtin_amdgcn_fence(__ATOMIC_RELEASE, "agent");
            asm volatile("s_waitcnt vmcnt(0)" ::: "memory");
            const unsigned og = xb_add(&bar[XB_TOP], 1u);
            const unsigned tg = og / nx;
            if (og + 1u == (tg + 1u) * nx) xb_add(&bar[XB_TOPGEN], 1u);
            else XB_SPIN(xb_ld(&bar[XB_TOPGEN]) == tg, bar);
            __builtin_amdgcn_fence(__ATOMIC_ACQUIRE, "agent");
            asm volatile("s_waitcnt vmcnt(0)" ::: "memory");
        } else {
            XB_SPIN(xb_ld(&bar[XB_TOPGEN]) == gen, bar);
            __builtin_amdgcn_fence(__ATOMIC_ACQUIRE, "agent");
            asm volatile("s_waitcnt vmcnt(0)" ::: "memory");
        }
    }
    __syncthreads();
}
constexpr int LDS_BARW = LDS_BYTES - 16;

struct SchedAll {
    const LAS pg8::JobDesc* jt; int n0, n1, n2, n3, n4; int K, G, c; int moe; const char* A; const char* B; const int* tstart; const int* src; int nN; size_t bexp;
    __device__ __forceinline__ pg8::Unit get(int i, bool& ok) const {
        const char* ua = nullptr; const char* ub = nullptr; const int* us = nullptr; int upm = 0, upn = 0, ujob = 0; bool good = false;
        if (moe) {
            const int vc = (c & 7) * (G >> 3) + (c >> 3);
            const long L = (long)i * G + vc; const int ntile = tstart[32];
            if (L < (long)ntile * nN) {
                const int mt = (int)(L / nN), nt = (int)(L % nN);
                int e = 0;
                for (int k = 1; k < 32; ++k) if (tstart[k] <= mt) e = k;
                ua = src ? A : A + (size_t)mt * 256 * K * 2; us = src ? src + mt * 256 : nullptr; ub = B + (size_t)e * bexp + (size_t)nt * 256 * K * 2; upm = mt; upn = nt; good = true;
            }
        } else {
            long L = (long)i * G + c;
            if (L < (long)n0 + n1 + n2 + n3 + n4) {
                int l = (int)L; int jb = 0;
                if (l >= n0) { l -= n0; jb = 1; if (l >= n1) { l -= n1; jb = 2; if (l >= n2) { l -= n2; jb = 3; if (l >= n3) { l -= n3; jb = 4; } } } }
                const int jM = __builtin_amdgcn_readfirstlane(jt[jb].nM), jN = __builtin_amdgcn_readfirstlane(jt[jb].nN);
                int pm, pn; pg8::tile_order(l, jM, jN, pm, pn);
                const size_t tstep = (size_t)pg8::BM * K * 2;
                ua = (const char*)pg8::rfl64(jt[jb].A) + (size_t)pm * tstep; ub = (const char*)pg8::rfl64(jt[jb].B) + (size_t)pn * tstep; upm = pm; upn = pn; ujob = jb; good = true;
            }
        }
        pg8::Unit u; u.A = ua; u.B = ub; u.src = us; u.pm = upm; u.pn = upn; u.job = ujob; ok = good; return u;
    }
};
enum { MP_CONV = 0, MP_L0_G1, MP_L0_MIXA, MP_L0_SCAN, MP_L0_MIXC, MP_L0_G2, MP_XA_G1, MP_XA_ATTN, MP_XA_G2, MP_ROUTE, MP_SCATTER, MP_MOE_G1, MP_MOE_G2, MP_LN_MOE, MP_L1_G1, MP_L1_SWA, MP_L1_G2 };
struct SchedLN {
    const char* A; const char* B; int G, c;
    __device__ __forceinline__ pg8::Unit get(int i, bool& ok) const {
        const int L = i * G + c; const bool good = L < 512; int pm = 0, pn = 0; if (good) pg8::tile_order(L, 128, 4, pm, pn);
        const size_t tstep = (size_t)pg8::BM * 1024 * 2;
        pg8::Unit u; u.A = A + (size_t)pm * tstep; u.B = B + (size_t)pn * tstep; u.src = nullptr; u.pm = pm; u.pn = pn; u.job = 0; ok = good; return u;
    }
};
__device__ __forceinline__ int prog_kind(int i) {
    switch (i) { case 0: return MP_CONV; case 1: return MP_L0_G1; case 2: return MP_L0_MIXA; case 3: return MP_L0_SCAN; case 4: return MP_L0_MIXC; case 5: return MP_L0_G2;
        case 6: case 17: return MP_XA_G1; case 7: case 18: return MP_XA_ATTN; case 8: case 19: return MP_XA_G2; case 9: case 20: return MP_ROUTE; case 10: case 21: return MP_SCATTER;
        case 11: case 22: return MP_MOE_G1; case 12: case 23: return MP_MOE_G2; case 13: case 24: return MP_LN_MOE; case 14: return MP_L1_G1; case 15: return MP_L1_SWA; default: return MP_L1_G2; }
}
constexpr int N_PROG = 25;
__global__ void __launch_bounds__(NTHR, 2) mega(FP p0) {
    extern __shared__ __attribute__((aligned(16))) unsigned char smem[];
    LAS unsigned char* lds = (LAS unsigned char*)smem;
    cooperative_groups::grid_group grid = cooperative_groups::this_grid();
    const int blk0 = blockIdx.x, G0 = gridDim.x;
    volatile LAS unsigned* bst = (volatile LAS unsigned*)(lds + LDS_BARW);
    if (threadIdx.x == 0) { bst[0] = 0u; bst[1] = 0u; }
    __syncthreads();
    const XcdBarrier xbar = xcd_barrier_post((unsigned*)(p0.ws + P_BAR), bst);
    int dup = 0; (void)dup;
#pragma unroll 1
    for (int pi = 0; pi < N_PROG; ++pi) {
        int blk = blk0, G = G0; asm volatile("" : "+s"(blk), "+s"(G));
        const PV p = make_pv(p0);
        const int kind = prog_kind(pi), l = pi >= 14 ? 1 : 0;
        const bool is_gemm = kind == MP_L0_G1 || kind == MP_XA_G1 || kind == MP_MOE_G1 || kind == MP_MOE_G2 || kind == MP_L1_G1;
        const bool is_lnf = kind == MP_L0_G2 || kind == MP_XA_G2 || kind == MP_L1_G2;
        if (is_lnf) {
            const int site = kind == MP_L0_G2 ? 0 : (kind == MP_L1_G2 ? 2 : 1 + 2 * l), lnidx = kind == MP_L0_G2 ? 0 : (kind == MP_L1_G2 ? 3 : 1 + 3 * l);
            SchedLN S; S.G = G; S.c = blk;
            S.A = (const char*)(kind == MP_L0_G2 ? WSP(bf16_t, P_TMP + T_YM) : WSP(bf16_t, P_TMP + T_OB));
            S.B = (const char*)(kind == MP_L0_G2 ? WSP(bf16_t, P_WOUT_T) : (kind == MP_L1_G2 ? WSP(bf16_t, P_WO_T) : WSP(bf16_t, P_XWO_T) + (size_t)l * 1024 * 1024));
            __syncthreads();
            #ifdef PROBE_LNV
            const int drym = __builtin_amdgcn_readfirstlane((dup == 0 && (((PROBE_MASK) >> kind) & 1)) ? 1 : 0);
#else
            const int drym = 0;
#endif
            unsigned long long* slp = WSP(unsigned long long, P_TMP + T_SLOT) + (size_t)(site + 4 * drym) * 131072;
            if (threadIdx.x == 0) set_job(JT_PTR, 0, nullptr, nullptr, 128, 4, WSP(bf16_t, P_XBF), 1024, 0, p.in[2] + lnidx * 1024, p.in[3] + lnidx * 1024, nullptr);
            if (threadIdx.x == 0) { JT_PTR->mode = drym; JT_PTR->out2 = (unsigned long long)slp; }
            EpiLN E; E.lds = lds;
            __syncthreads();
            pg8::gemm_phase<EpiLN, SchedLN, true, true>(lds, 1024, S, E);
        } else if (is_gemm) {
            SchedAll S; S.jt = JT_PTR; S.n0 = S.n1 = S.n2 = S.n3 = S.n4 = 0; S.K = 1024; S.G = G; S.c = blk; S.moe = 0; S.A = S.B = nullptr; S.tstart = WSP(int, P_RT + RT_TSTART); S.src = nullptr; S.nN = 4; S.bexp = 0;
            __syncthreads();
            if (threadIdx.x == 0) {
                if (kind == MP_L0_G1) set_job(JT_PTR, 0, WSP(bf16_t, P_XBF), WSP(bf16_t, P_WIN_T), 128, 8, WSP(bf16_t, P_TMP + T_AU), 512, EM_GELU4);
                if (kind == MP_XA_G1) {
                    set_job(JT_PTR, 0, WSP(bf16_t, P_XBF), WSP(bf16_t, P_XWQ_T) + (size_t)l * 1024 * 1024, 128, 4, WSP(bf16_t, P_TMP + T_QX), 1024, EM_PLAIN);
                    if (l == 0) { for (int ll = 0; ll < 2; ++ll) { const bf16_t* wkv = WSP(bf16_t, P_XWKV_T) + (size_t)ll * 2048 * 1024;
                        set_job(JT_PTR, 1 + 2 * ll, WSP(bf16_t, P_MEMB), wkv, 8, 4, WSP(bf16_t, P_KC) + (size_t)ll * 2048 * 1024, 1024, EM_PLAIN);
                        set_job(JT_PTR, 2 + 2 * ll, wkv + (size_t)1024 * 1024, WSP(bf16_t, P_MEMB), 4, 8, WSP(bf16_t, P_VT) + (size_t)ll * 1024 * 2048, 2048, EM_PLAIN); } } }
                if (kind == MP_MOE_G1) set_job(JT_PTR, 0, nullptr, nullptr, 0, 0, WSP(bf16_t, P_TMP + T_HM), 512, EM_SWIGLU);
                if (kind == MP_MOE_G2) set_job(JT_PTR, 0, nullptr, nullptr, 0, 0, WSP(bf16_t, P_TMP + T_YG), 1024, EM_PLAIN);
                if (kind == MP_L1_G1) { set_job(JT_PTR, 0, WSP(bf16_t, P_XBF), WSP(bf16_t, P_WQKV_T), 128, 5, WSP(bf16_t, P_TMP + T_QX), 1024, EM_ROTARY, WSP(float, P_BQK), WSP(float, P_ROT), WSP(bf16_t, P_TMP + T_K1));
                    set_job(JT_PTR, 1, WSP(bf16_t, P_WQKV_T) + (size_t)1280 * 1024, WSP(bf16_t, P_XBF), 1, 128, WSP(bf16_t, P_TMP + T_VT1), NT, EM_ROWBIAS, p.in[20] + 1280); }
#ifdef PROBE_L1PLAIN
                if (kind == MP_L1_G1 && dup == 0) JT_PTR[0].mode = EM_PLAIN;
#endif
            }
            if (kind == MP_L0_G1) S.n0 = 1024;
            if (kind == MP_XA_G1) { S.n0 = 512; if (l == 0) { S.n1 = 32; S.n2 = 32; S.n3 = 32; S.n4 = 32; } }
            if (kind == MP_L1_G1) { S.n0 = 640; S.n1 = 128; }
            if (kind == MP_MOE_G1) { S.moe = 1; S.A = (const char*)WSP(bf16_t, P_XBF); S.src = WSP(int, P_RT + RT_SRC); S.B = (const char*)(l ? WSP(bf16_t, P_TMP + T_W13B) : WSP(bf16_t, P_W13T)); S.bexp = (size_t)1024 * 1024 * 2; }
            if (kind == MP_MOE_G2) { S.moe = 1; S.K = 512; S.A = (const char*)WSP(bf16_t, P_TMP + T_HM); S.B = (const char*)(l ? WSP(bf16_t, P_TMP + T_W2B) : WSP(bf16_t, P_W2T)); S.bexp = (size_t)1024 * 512 * 2; }
            __syncthreads();
            EpiMulti E; E.jt = JT_PTR;
#ifdef PROBE_GEMM2
#pragma unroll 1
            for (int rep = 0; rep < 2; ++rep)
#endif
            pg8::gemm_phase<EpiMulti, SchedAll, true, true>(lds, S.K, S, E);
            if (l == 0 && (kind == MP_XA_G1 || kind == MP_MOE_G1 || kind == MP_MOE_G2)) {
                const TailPlan tp = tail_plan(S.tstart[32], G);
                const int vc = kind == MP_XA_G1 ? blk : (blk & 7) * (G >> 3) + (blk >> 3);
                const int fi = kind == MP_XA_G1 ? 128 : tp.first_idle, quota = kind == MP_MOE_G2 ? TAILQ_G2 : (kind == MP_XA_G1 ? TAILQ_XA : TAILQ_G1), base = kind == MP_XA_G1 ? 0 : (kind == MP_MOE_G1 ? tp.t0 : tp.t0 + tp.t1);
                if (vc >= fi) { const int wv = __builtin_amdgcn_readfirstlane((int)threadIdx.x >> 6); int lq = threadIdx.x & 63; asm volatile("" : "+v"(lq));
                    const int f0 = base + ((vc - fi) * NWAVE + wv) * quota;
                    conv_moe1_range(p, (LAS float*)(lds + wv * 8448), lq, f0, 1, f0 + quota); }
            }
        } else {
#ifdef PROBE_MIXA_SKIP
#define MIXA_SKIP_ARG ((dup == 0 && (((PROBE_MASK) >> kind) & 1)) ? (PROBE_MIXA_SKIP) : 0)
#else
#define MIXA_SKIP_ARG 0
#endif
#ifdef PROBE_MASK
#define DRY (dup == 0 && (((PROBE_MASK) >> kind) & 1))
#else
#define DRY false
#endif
            switch (kind) {
                case MP_CONV: { int gwr = blk * NWAVE + __builtin_amdgcn_readfirstlane((int)threadIdx.x >> 6);
                    ph_conv_l0(p, lds, blk, G, gwr); ph_conv_l1(p, lds, blk, G, gwr); ph_conv_xattn(p, lds, blk, G, 0, gwr); ph_conv_xattn(p, lds, blk, G, 1, gwr); ph_conv_moe(p, lds, blk, G, 0, gwr); ph_xin_to_bf(p, lds, blk, G); } break;
                case MP_L0_MIXA: { L0Bufs Bx = l0_bufs(p); if (DRY) { Bx.Q = Bx.K = WSP(bf16_t, P_TMP + 288 * MB); } l0_mixA(lds, Bx, blk, G, MIXA_SKIP_ARG); } break;
                case MP_L0_SCAN: ph_scan_conv(p, lds, blk, G); break;
                case MP_L0_MIXC: l0_mixC(lds, l0_bufs(p), blk, G); break;
                case MP_XA_ATTN: ph_xattn_attn(p, lds, blk, G, l); break;
                case MP_ROUTE: ph_moe_route(p, lds, blk, G, l); break;
                case MP_SCATTER: ph_moe_scatter(p, lds, blk, G); break;
                case MP_LN_MOE: if (l == 0) { ph_ln<false, false, true>(p, lds, blk, G, WSP(bf16_t, P_TMP + T_YG), 2, DRY); if (!(DRY)) { const int wv = __builtin_amdgcn_readfirstlane((int)threadIdx.x >> 6); int lq = threadIdx.x & 63; asm volatile("" : "+v"(lq)); { const TailPlan tp = tail_plan(WSP(int, P_RT + RT_TSTART)[32], G); conv_moe1_range(p, (LAS float*)(lds + wv * 8448), lq, tp.t0 + tp.t1 + tp.t2 + blk * NWAVE + wv, G * NWAVE, 12288); } conv_router_w(p, 1, blk * NTHR + (int)threadIdx.x, G * NTHR); } } else ph_ln<false, true, true>(p, lds, blk, G, WSP(bf16_t, P_TMP + T_YG), 5, DRY); break;
                default: ph_l1_swa(p, lds, blk, G); break;
            }
        }
#ifdef PROBE_MASK
        if (((PROBE_MASK) >> kind) & 1) { if (dup == 0) { dup = 1; xcd_barrier(xbar); --pi; continue; } dup = 0; }
#endif
        if (pi + 1 < N_PROG) { if (p0.ws == nullptr) grid.sync(); else { xcd_barrier(xbar);
#ifdef PROBE_BAR2
            xcd_barrier(xbar);
#endif
        } }
    }
}
}
extern "C" void kernel_launch(void* const* d_in, const int* in_sizes, int n_in, void* d_out, int out_size, void* d_ws, size_t ws_size, hipStream_t stream) {
    static int ok = 0;
    if (ok == 0) {
        ok = -1;
        if (n_in != 33 || out_size != 32768 * 1024 || ws_size < fk::FAST_END + (fk::SLOT_MB - 4) * fk::MB) { fprintf(stderr, "kernel_launch: unexpected shapes/ws (%d, %d, %zu)\n", n_in, out_size, ws_size); return; }
        int dev = 0, cus = 0, per_cu = 0;
        if (hipGetDevice(&dev) != hipSuccess || hipDeviceGetAttribute(&cus, hipDeviceAttributeMultiprocessorCount, dev) != hipSuccess) return;
        if (hipFuncSetAttribute((const void*)fk::mega, hipFuncAttributeMaxDynamicSharedMemorySize, fk::LDS_BYTES) != hipSuccess) return;
        if (hipOccupancyMaxActiveBlocksPerMultiprocessor(&per_cu, (const void*)fk::mega, fk::NTHR, fk::LDS_BYTES) != hipSuccess || per_cu < 1 || cus * per_cu < 256) { fprintf(stderr, "kernel_launch: cannot co-reside 256 workgroups (%d CUs x %d)\n", cus, per_cu); return; }
        ok = 1;
    }
    if (ok < 0) return;
    fk::FP p{}; for (int i = 0; i < 33; ++i) p.in[i] = (const float*)d_in[i]; p.X = (float*)d_out; p.ws = (unsigned char*)d_ws;
    if (hipMemsetAsync((char*)d_ws + fk::P_BAR, 0, 16384, stream) != hipSuccess) return;
    if (hipMemsetAsync((char*)d_ws + fk::P_TMP + fk::T_SLOT, 0xFF, fk::SLOT_MB * fk::MB, stream) != hipSuccess) return;
    void* args[] = {&p};
    hipError_t e = hipLaunchCooperativeKernel((const void*)fk::mega, dim3(256), dim3(fk::NTHR), args, fk::LDS_BYTES, stream);
    if (e != hipSuccess) fprintf(stderr, "cooperative launch failed: %s\n", hipGetErrorString(e));
}
```

```cpp
#include <hip/hip_runtime.h>
#include <hip/hip_cooperative_groups.h>
#include <cstdio>
#include <cstdint>
#include <cmath>
namespace fk {
#define LAS __attribute__((address_space(3)))
typedef unsigned short bf16_t;
typedef short bf16x8 __attribute__((ext_vector_type(8)));
typedef short s16x4 __attribute__((ext_vector_type(4)));
typedef float f32x4 __attribute__((ext_vector_type(4)));
typedef float f32x16 __attribute__((ext_vector_type(16)));
typedef float f32x2 __attribute__((ext_vector_type(2)));
typedef unsigned u32x4 __attribute__((ext_vector_type(4)));
typedef unsigned u32x2 __attribute__((ext_vector_type(2)));
typedef __bf16 bf16x2_t __attribute__((ext_vector_type(2)));

constexpr int NT = 32768, DM = 1024, SEQ = 4096;
constexpr int NTHR = 512, NWAVE = 8;
constexpr float ALPHA = 1.4142135623730951f, LN_EPS = 1e-5f, LOG2E = 1.4426950408889634f;

__device__ __forceinline__ unsigned pk2(float lo, float hi) { f32x2 v = {lo, hi}; bf16x2_t b = __builtin_convertvector(v, bf16x2_t); return __builtin_bit_cast(unsigned, b); }
__device__ __forceinline__ float bf_lo(unsigned w) { return __uint_as_float(w << 16); }
__device__ __forceinline__ float bf_hi(unsigned w) { return __uint_as_float(w & 0xffff0000u); }
__device__ __forceinline__ float bf2f(bf16_t b) { return __uint_as_float(((unsigned)b) << 16); }
__device__ __forceinline__ bf16_t f2bf(float f) { return (bf16_t)(pk2(f, 0.f) & 0xffffu); }
__device__ __forceinline__ float fast_exp(float x) { return __builtin_amdgcn_exp2f(x * LOG2E); }
__device__ __forceinline__ float sigmoid_f(float x) { return __builtin_amdgcn_rcpf(1.f + fast_exp(-x)); }
__device__ __forceinline__ float silu_f(float x) { return x * sigmoid_f(x); }
__device__ __forceinline__ float gelu_tanh_f(float x) { const float u = 1.5957691216057308f * (x + 0.044715f * x * x * x); return x * sigmoid_f(u); }
__device__ __forceinline__ int crow(int r, int hi) { return (r & 3) + 8 * (r >> 2) + 4 * hi; }
__device__ __forceinline__ float xhalf_sum(float v) { auto rr = __builtin_amdgcn_permlane32_swap(__float_as_uint(v), __float_as_uint(v), false, false); return __uint_as_float(rr[0]) + __uint_as_float(rr[1]); }
__device__ __forceinline__ float xhalf_max(float v) { auto rr = __builtin_amdgcn_permlane32_swap(__float_as_uint(v), __float_as_uint(v), false, false); return fmaxf(__uint_as_float(rr[0]), __uint_as_float(rr[1])); }
__device__ __forceinline__ float shx(float v, int o, int lane) { return __int_as_float(__builtin_amdgcn_ds_bpermute((lane ^ o) << 2, __float_as_int(v))); }
__device__ __forceinline__ float shup(float v, int o, int lane) { return __int_as_float(__builtin_amdgcn_ds_bpermute(((lane - o) & 63) << 2, __float_as_int(v))); }
__device__ __forceinline__ float shidx(float v, int idx) { return __int_as_float(__builtin_amdgcn_ds_bpermute(idx << 2, __float_as_int(v))); }
__device__ __forceinline__ s16x4 lds_tr(const LAS void* p) { return __builtin_bit_cast(s16x4, __builtin_amdgcn_ds_read_tr16_b64_v4i16((LAS s16x4*)p)); }
#define MFMA32(a, b, c) __builtin_amdgcn_mfma_f32_32x32x16_bf16((a), (b), (c), 0, 0, 0)

namespace pg8 {
constexpr int BM = 256, BK = 64, HALF = 128, HTB = HALF * BK * 2, STAGE_BYTES = 8 * HTB, NXCD = 8, WGM = 8;
__host__ __device__ __forceinline__ int lds_byte(int r, int c) { const int st = (r >> 4) * 2 + (c >> 5), rr = r & 15, cc = c & 31, ob = rr * 64 + cc * 2; return st * 1024 + (ob ^ (((ob >> 9) & 1) << 5)); }
__host__ __device__ __forceinline__ void stage_rc(int b, int& R, int& C) { const int st = b / 1024, sb = b % 1024, swz = sb ^ (((sb >> 9) & 1) << 5); R = (st >> 1) * 16 + swz / 64; C = (st & 1) * 32 + (swz % 64) / 2; }
__host__ __device__ __forceinline__ int perm32(int rho) { const int n = rho >> 4, i = rho & 15; return 8 * (i >> 2) + 4 * n + (i & 3); }

struct Unit { const char* A; const char* B; const int* src; int pm, pn, job; };

__device__ __forceinline__ void tile_order(int l, int nM, int nN, int& pm, int& pn) {
    const int nwg = nM * nN; int wgid = l;
    { const int q = nwg / NXCD, r = nwg % NXCD, xcd = wgid % NXCD, off = wgid / NXCD; wgid = (xcd < r ? xcd * (q + 1) : r * (q + 1) + (xcd - r) * q) + off; }
    const int nig = WGM * nN, gid = wgid / nig, fm = gid * WGM, gsz = (nM - fm) < WGM ? (nM - fm) : WGM;
    pm = fm + ((wgid % nig) % gsz); pn = (wgid % nig) / gsz;
}
struct JobDesc { unsigned long long A, B, out, bias, rot, out2; int nM, nN, ldc, mode; };
__device__ __forceinline__ unsigned long long rfl64(unsigned long long v) { const unsigned lo = __builtin_amdgcn_readfirstlane((unsigned)v), hi = __builtin_amdgcn_readfirstlane((unsigned)(v >> 32)); return ((unsigned long long)hi << 32) | lo; }
constexpr int JT_OFF = STAGE_BYTES;
struct Jobs3 {
    const LAS JobDesc* jt; int n0, n1, n2; int K, G, c;
    __device__ __forceinline__ Unit get(int i, bool& ok) const { Unit u; u.A = nullptr; u.B = nullptr; u.src = nullptr; u.pm = 0; u.pn = 0; u.job = 0; ok = next(i, u); return u; }
    __device__ __forceinline__ bool next(int i, Unit& u) const {
        long L = (long)i * G + c;
        if (L >= (long)n0 + n1 + n2) return false;
        int l = (int)L; int jb = 0;
        if (l >= n0) { l -= n0; jb = 1; if (l >= n1) { l -= n1; jb = 2; } }
        const int jM = __builtin_amdgcn_readfirstlane(jt[jb].nM), jN = __builtin_amdgcn_readfirstlane(jt[jb].nN);
        int pm, pn; tile_order(l, jM, jN, pm, pn);
        const size_t tstep = (size_t)BM * K * 2;
        u.A = (const char*)rfl64(jt[jb].A) + (size_t)pm * tstep; u.B = (const char*)rfl64(jt[jb].B) + (size_t)pn * tstep; u.src = nullptr; u.pm = pm; u.pn = pn; u.job = jb; return true;
    }
};

template <class Epi, class Sched, bool ALIGN_EPI, bool SP2>
__device__ __forceinline__ void gemm_phase(LAS unsigned char* lds, const int K, const Sched& S, const Epi& E) {
    int tid_ = threadIdx.x; asm volatile("" : "+v"(tid_)); const int tid = tid_, wid = __builtin_amdgcn_readfirstlane(tid >> 6), lane = tid & 63, wr = wid >> 2, wc = wid & 3, fr = lane & 15, fq = lane >> 4;
    const int nt = K / BK;
    static_assert(SP2, "only the two-super-phase form is kept");
    unsigned vA0[2], vA1[2], vB0[2];
#pragma unroll
    for (int i = 0; i < 2; ++i) { int R, C; stage_rc(tid * 16 + i * 8192, R, C); const int Rb = 64 * (R >> 5) + perm32(R & 31); vB0[i] = (unsigned)(Rb * K + C) * 2u; }
    const size_t bhalf = (size_t)32 * K * 2;
    auto a_rows = [&](const int* src, unsigned (&o0)[2], unsigned (&o1)[2]) {
        int tq = threadIdx.x; asm volatile("" : "+v"(tq));
#pragma unroll
        for (int i = 0; i < 2; ++i) { int R, C; stage_rc(tq * 16 + i * 8192, R, C); int r0 = R, r1 = R + HALF; if (src) { r0 = src[R]; r1 = src[R + HALF]; }
            o0[i] = (unsigned)(r0 * K + C) * 2u; o1[i] = (unsigned)(r1 * K + C) * 2u; }
    };
    const size_t kstep = (size_t)(BK * 2);
    const size_t hstep = (size_t)HALF * K * 2;
    const unsigned ldsw = (unsigned)wid * 1024u;
    const int aoff = lds_byte(wr * 64 + fr, fq * 8), boff = lds_byte(wc * 32 + fr, fq * 8);
#define PG8_SA(b, h) (((b) * 2 + (h)) * HTB)
#define PG8_SB(b, h) ((4 + (b) * 2 + (h)) * HTB)
#define PG8_STAGE(bufoff, gbase, voff) do { _Pragma("unroll") for (int _i = 0; _i < 2; ++_i) \
        __builtin_amdgcn_global_load_lds((const unsigned*)((const char*)(gbase) + (voff)[_i]), (LAS unsigned*)(lds + (bufoff) + ldsw + _i * 8192), 16, 0, 0); } while (0)
#define PG8_LDA(dst, b, h) do { _Pragma("unroll") for (int m = 0; m < 4; ++m) _Pragma("unroll") for (int k = 0; k < 2; ++k) dst[m][k] = *(const LAS bf16x8*)(lds + PG8_SA(b, h) + aoff + m * 2048 + k * 1024); } while (0)
#define PG8_LDB(dst, b, h) do { _Pragma("unroll") for (int n = 0; n < 2; ++n) _Pragma("unroll") for (int k = 0; k < 2; ++k) dst[n][k] = *(const LAS bf16x8*)(lds + PG8_SB(b, h) + boff + n * 2048 + k * 1024); } while (0)
#define PG8_MMA(ai, bj, At, Bt) do { __builtin_amdgcn_s_setprio(1); _Pragma("unroll") for (int m = 0; m < 4; ++m) _Pragma("unroll") for (int n = 0; n < 2; ++n) _Pragma("unroll") for (int k = 0; k < 2; ++k) \
        acc[ai][bj][m][n] = __builtin_amdgcn_mfma_f32_16x16x32_bf16(Bt[n][k], At[m][k], acc[ai][bj][m][n], 0, 0, 0); __builtin_amdgcn_s_setprio(0); } while (0)
#define PG8_WAIT_V(n) asm volatile("s_waitcnt vmcnt(" #n ")" ::: "memory")
#define PG8_WAIT_L(n) asm volatile("s_waitcnt lgkmcnt(" #n ")" ::: "memory")
#define PG8_BAR __builtin_amdgcn_s_barrier()
#define PG8_SCHED __builtin_amdgcn_sched_barrier(0)
    auto unif = [](Unit u) { Unit r; r.A = (const char*)rfl64((unsigned long long)u.A); r.B = (const char*)rfl64((unsigned long long)u.B); r.src = (const int*)rfl64((unsigned long long)u.src);
        r.pm = __builtin_amdgcn_readfirstlane(u.pm); r.pn = __builtin_amdgcn_readfirstlane(u.pn); r.job = __builtin_amdgcn_readfirstlane(u.job); return r; };
    int ui = 0; bool ok0; Unit cur = unif(S.get(0, ok0));
    if (!ok0) return;
    f32x4 acc[2][2][4][2];
    E.prefetch(cur, wr, wc, fr, fq);
    bf16x8 At[4][2], B0[2][2], B1[2][2];
    const char* cA = cur.A; const char* cB = cur.B;
    a_rows(cur.src, vA0, vA1);
    {
        PG8_STAGE(PG8_SB(0, 0), cB, vB0); PG8_STAGE(PG8_SB(0, 1), cB + bhalf, vB0); PG8_STAGE(PG8_SA(0, 0), cA, vA0); PG8_STAGE(PG8_SA(0, 1), cA, vA1);
        if (wr == 1) PG8_BAR;
        PG8_WAIT_V(2); PG8_BAR;
        PG8_STAGE(PG8_SB(1, 0), cB + kstep, vB0); PG8_STAGE(PG8_SA(1, 0), cA + kstep, vA0); PG8_STAGE(PG8_SB(1, 1), cB + kstep + bhalf, vB0);
        PG8_WAIT_V(6); PG8_BAR;
    }
    for (;;) {
        E.init(acc);
        bool has_next; const Unit nxt = unif(S.get(ui + 1, has_next)); bool early_done = false;
        const char* nA = has_next ? nxt.A : cA; const char* nB = has_next ? nxt.B : cB;
        for (int t = 0; t < nt; t += 2) {
            const bool last = (t == nt - 2);
            const char* a1 = cA + (size_t)(t + 1) * kstep;
            const char* a2 = last ? nA : cA + (size_t)(t + 2) * kstep; const char* b2 = last ? nB : cB + (size_t)(t + 2) * kstep;
            const char* a3 = a2 + kstep; const char* b3 = b2 + kstep;
            PG8_LDB(B0, 0, 0); PG8_LDB(B1, 0, 1); PG8_SCHED; PG8_LDA(At, 0, 0); PG8_STAGE(PG8_SA(1, 1), a1, vA1);
            if (last && has_next) a_rows(nxt.src, vA0, vA1);
            PG8_WAIT_V(8); PG8_WAIT_L(0); PG8_BAR; PG8_MMA(0, 0, At, B0); PG8_MMA(0, 1, At, B1); PG8_BAR; PG8_SCHED;
            PG8_LDA(At, 0, 1); PG8_STAGE(PG8_SB(0, 0), b2, vB0); PG8_STAGE(PG8_SB(0, 1), b2 + bhalf, vB0); PG8_STAGE(PG8_SA(0, 0), a2, vA0);
            PG8_WAIT_V(8); PG8_WAIT_L(0); PG8_BAR; PG8_MMA(1, 0, At, B0); PG8_MMA(1, 1, At, B1); PG8_BAR; PG8_SCHED;
            PG8_LDB(B0, 1, 0); PG8_LDB(B1, 1, 1); PG8_SCHED; PG8_LDA(At, 1, 0); PG8_STAGE(PG8_SA(0, 1), a2, vA1);
            PG8_WAIT_V(8); PG8_WAIT_L(0); PG8_BAR; PG8_MMA(0, 0, At, B0); PG8_MMA(0, 1, At, B1); PG8_BAR; PG8_SCHED;
            if (last) { early_done = E.early(acc, cur, wr, wc, fr, fq); PG8_SCHED; }
            PG8_LDA(At, 1, 1); PG8_STAGE(PG8_SB(1, 0), b3, vB0); PG8_STAGE(PG8_SB(1, 1), b3 + bhalf, vB0); PG8_STAGE(PG8_SA(1, 0), a3, vA0);
            PG8_WAIT_V(8); PG8_WAIT_L(0); PG8_BAR; PG8_MMA(1, 0, At, B0); PG8_MMA(1, 1, At, B1); PG8_BAR; PG8_SCHED;
        }
        if constexpr (ALIGN_EPI) { if (wr == 0) PG8_BAR; }
        E.prefetch(nxt, wr, wc, fr, fq);
        if (!early_done) E.template half<0>(acc, cur, wr, wc, fr, fq);
        E.template half<1>(acc, cur, wr, wc, fr, fq);
        if (!has_next) break;
        cur = nxt; cA = nA; cB = nB; ++ui;
        if constexpr (ALIGN_EPI) { if (wr == 1) PG8_BAR; }
    }
    PG8_WAIT_V(0);
    if constexpr (!ALIGN_EPI) { if (wr == 0) PG8_BAR; }
    PG8_BAR;
#undef PG8_SA
#undef PG8_SB
#undef PG8_STAGE
#undef PG8_LDA
#undef PG8_LDB
#undef PG8_MMA
#undef PG8_WAIT_V
#undef PG8_WAIT_L
#undef PG8_BAR
#undef PG8_SCHED
}
}
enum { EM_PLAIN = 0, EM_GELU4 = 1, EM_SWIGLU = 2, EM_ROTARY = 3, EM_ROWBIAS = 4 };
struct EpiMulti {
    static constexpr bool PERM = true;
    const LAS pg8::JobDesc* jt;
    __device__ __forceinline__ void prefetch(const pg8::Unit&, int, int, int, int) const {}
    __device__ __forceinline__ void init(f32x4 (&acc)[2][2][4][2]) const {
#pragma unroll
        for (int a = 0; a < 2; ++a)
#pragma unroll
            for (int b = 0; b < 2; ++b)
#pragma unroll
                for (int m = 0; m < 4; ++m)
#pragma unroll
                    for (int n = 0; n < 2; ++n) acc[a][b][m][n] = (f32x4){0.f, 0.f, 0.f, 0.f};
    }
    __device__ __forceinline__ bool early(const f32x4 (&acc)[2][2][4][2], const pg8::Unit& u, int wr, int wc, int fr, int fq) const {
        const LAS pg8::JobDesc* jd = jt + u.job;
        if (__builtin_amdgcn_readfirstlane(jd->mode) != EM_PLAIN) return false;
        bf16_t* out = (bf16_t*)pg8::rfl64(jd->out); const int ldc = __builtin_amdgcn_readfirstlane(jd->ldc);
        bf16_t* rowp = out + (size_t)(u.pm * 256 + wr * 64 + fr) * ldc + u.pn * 256 + wc * 64 + 8 * fq;
#pragma unroll
        for (int m = 0; m < 4; ++m)
#pragma unroll
            for (int bj = 0; bj < 2; ++bj) { const f32x4 v0 = acc[0][bj][m][0], v1 = acc[0][bj][m][1];
                u32x4 w; w.x = pk2(v0[0], v0[1]); w.y = pk2(v0[2], v0[3]); w.z = pk2(v1[0], v1[1]); w.w = pk2(v1[2], v1[3]);
                *(u32x4*)(rowp + (size_t)m * 16 * ldc + bj * 32) = w; }
        return true;
    }
    template <int AI>
    __device__ __forceinline__ void half(const f32x4 (&acc)[2][2][4][2], const pg8::Unit& u, int wr, int wc, int fr, int fq) const {
        const LAS pg8::JobDesc* jd = jt + u.job;
        bf16_t* out = (bf16_t*)pg8::rfl64(jd->out);
        const int ldc = __builtin_amdgcn_readfirstlane(jd->ldc);
        const int mode = __builtin_amdgcn_readfirstlane(jd->mode);
        const float* bias = (const float*)pg8::rfl64(jd->bias);
        const int row0 = u.pm * 256 + wr * 64 + fr;
        const int colt = u.pn * 256 + wc * 64 + 8 * fq;
        if (mode == EM_PLAIN || mode == EM_ROWBIAS) {
#pragma unroll
            for (int ai = AI; ai < AI + 1; ++ai)
#pragma unroll
                for (int m = 0; m < 4; ++m) { const int row = row0 + ai * 128 + m * 16; const float rb = (mode == EM_ROWBIAS && bias) ? bias[row] : 0.f;
                    bf16_t* rowp = out + (size_t)row * ldc + colt;
#pragma unroll
                    for (int bj = 0; bj < 2; ++bj) { const f32x4 v0 = acc[ai][bj][m][0] + rb, v1 = acc[ai][bj][m][1] + rb;
                        u32x4 w; w.x = pk2(v0[0], v0[1]); w.y = pk2(v0[2], v0[3]); w.z = pk2(v1[0], v1[1]); w.w = pk2(v1[2], v1[3]);
                        *(u32x4*)(rowp + bj * 32) = w; } }
        } else if (mode == EM_GELU4) {
            const int arr = u.pn >> 1; bf16_t* base = out + (size_t)arr * NT * 512; const int col = colt - arr * 512; const bool act = arr < 2;
#pragma unroll
            for (int ai = AI; ai < AI + 1; ++ai)
#pragma unroll
                for (int m = 0; m < 4; ++m) { bf16_t* rowp = base + (size_t)(row0 + ai * 128 + m * 16) * 512 + col;
#pragma unroll
                    for (int bj = 0; bj < 2; ++bj) { f32x4 v0 = acc[ai][bj][m][0], v1 = acc[ai][bj][m][1];
                        if (act) {
#pragma unroll
                            for (int e = 0; e < 4; ++e) { v0[e] = gelu_tanh_f(v0[e]); v1[e] = gelu_tanh_f(v1[e]); } }
                        u32x4 w; w.x = pk2(v0[0], v0[1]); w.y = pk2(v0[2], v0[3]); w.z = pk2(v1[0], v1[1]); w.w = pk2(v1[2], v1[3]);
                        *(u32x4*)(rowp + bj * 32) = w; } }
        } else if (mode == EM_SWIGLU) {
#pragma unroll
            for (int ai = AI; ai < AI + 1; ++ai)
#pragma unroll
                for (int m = 0; m < 4; ++m) { bf16_t* rowp = out + (size_t)(row0 + ai * 128 + m * 16) * ldc + (colt >> 1);
#pragma unroll
                    for (int bj = 0; bj < 2; ++bj) { const f32x4 v0 = acc[ai][bj][m][0], v1 = acc[ai][bj][m][1];
                        u32x2 w; w.x = pk2(silu_f(v0[0]) * v0[1], silu_f(v0[2]) * v0[3]); w.y = pk2(silu_f(v1[0]) * v1[1], silu_f(v1[2]) * v1[3]);
                        *(u32x2*)(rowp + bj * 16) = w; } }
        } else {
            const float* rot = (const float*)pg8::rfl64(jd->rot);
            bf16_t* out2 = (bf16_t*)pg8::rfl64(jd->out2);
            const bool isk = u.pn >= 4; bf16_t* base = isk ? out2 : out; const int ld = isk ? 256 : 1024; const int colo = isk ? colt - 1024 : colt;
            float bv[2][8];
#pragma unroll
            for (int bj = 0; bj < 2; ++bj) { f32x4 b0 = (f32x4){0.f, 0.f, 0.f, 0.f}, b1 = b0; if (bias) { b0 = *(const f32x4*)(bias + colt + bj * 32); b1 = *(const f32x4*)(bias + colt + bj * 32 + 4); }
#pragma unroll
                for (int e = 0; e < 4; ++e) { bv[bj][e] = b0[e]; bv[bj][4 + e] = b1[e]; } }
            const int i0 = (colt & 63) >> 1;
#pragma unroll
            for (int ai = AI; ai < AI + 1; ++ai)
#pragma unroll
                for (int m = 0; m < 4; ++m) { const int row = row0 + ai * 128 + m * 16; const int pos = row & (SEQ - 1);
                    bf16_t* rowp = base + (size_t)row * ld + colo;
#pragma unroll
                    for (int bj = 0; bj < 2; ++bj) { f32x4 v0 = acc[ai][bj][m][0], v1 = acc[ai][bj][m][1];
                        const f32x4 cs0 = *(const f32x4*)(rot + ((size_t)pos * 32 + i0 + 16 * bj) * 2), cs1 = *(const f32x4*)(rot + ((size_t)pos * 32 + i0 + 16 * bj + 2) * 2);
#pragma unroll
                        for (int e = 0; e < 4; ++e) { v0[e] += bv[bj][e]; v1[e] += bv[bj][4 + e]; }
                        const float a0 = v0[0] * cs0[0] - v0[1] * cs0[1], b0 = v0[1] * cs0[0] + v0[0] * cs0[1];
                        const float a1 = v0[2] * cs0[2] - v0[3] * cs0[3], b1 = v0[3] * cs0[2] + v0[2] * cs0[3];
                        const float a2 = v1[0] * cs1[0] - v1[1] * cs1[1], b2 = v1[1] * cs1[0] + v1[0] * cs1[1];
                        const float a3 = v1[2] * cs1[2] - v1[3] * cs1[3], b3 = v1[3] * cs1[2] + v1[2] * cs1[3];
                        u32x4 w; w.x = pk2(a0, b0); w.y = pk2(a1, b1); w.z = pk2(a2, b2); w.w = pk2(a3, b3);
                        *(u32x4*)(rowp + bj * 32) = w; } }
        }
    }
};

#define GAS __attribute__((address_space(1)))
#define P_TMP_PROBE (194ull * 1048576ull)
constexpr int LNF_PART = pg8::JT_OFF + 1024;
constexpr int LNF_STAT = LNF_PART + 8192;
struct EpiLN {
    static constexpr bool PERM = true;
    LAS unsigned char* lds;
    mutable u32x4 pre[2][4][2];
    __device__ __forceinline__ void prefetch(const pg8::Unit& u, int, int, int, int) const {
        int tq = threadIdx.x; asm volatile("" : "+v"(tq)); const int wq = __builtin_amdgcn_readfirstlane(tq >> 6), wr = wq >> 2, wc = wq & 3, fr = tq & 15, fq = (tq & 63) >> 4;
        const unsigned long long xio = pg8::rfl64(((const LAS pg8::JobDesc*)(lds + pg8::JT_OFF))->out);
        const GAS unsigned char* tb = (const GAS unsigned char*)(xio + ((size_t)u.pm * 256 * 1024 + u.pn * 256) * 2);
        const unsigned loff = (unsigned)((wr * 64 + fr) * 1024 + wc * 64 + 8 * fq) * 2u;
#pragma unroll
        for (int ai = 0; ai < 2; ++ai)
#pragma unroll
            for (int m = 0; m < 4; ++m)
#pragma unroll
                for (int bj = 0; bj < 2; ++bj) pre[ai][m][bj] = *(const GAS u32x4*)(tb + (ai * 128 + m * 16) * 2048 + bj * 64 + loff);
    }
    __device__ __forceinline__ void init(f32x4 (&acc)[2][2][4][2]) const {
#pragma unroll
        for (int ai = 0; ai < 2; ++ai)
#pragma unroll
            for (int m = 0; m < 4; ++m)
#pragma unroll
                for (int bj = 0; bj < 2; ++bj) { const u32x4 w = pre[ai][m][bj];
                    acc[ai][bj][m][0] = (f32x4){ALPHA * bf_lo(w.x), ALPHA * bf_hi(w.x), ALPHA * bf_lo(w.y), ALPHA * bf_hi(w.y)};
                    acc[ai][bj][m][1] = (f32x4){ALPHA * bf_lo(w.z), ALPHA * bf_hi(w.z), ALPHA * bf_lo(w.w), ALPHA * bf_hi(w.w)};
                    __builtin_amdgcn_sched_barrier(0); }
    }
    __device__ __forceinline__ bool early(const f32x4 (&)[2][2][4][2], const pg8::Unit&, int, int, int, int) const { return false; }
    template <int AI>
    __device__ __forceinline__ void half(f32x4 (&acc)[2][2][4][2], const pg8::Unit& u, int, int, int, int) const {
        int tid_ = threadIdx.x; asm volatile("" : "+v"(tid_)); const int tid = tid_, lane = tid & 63;
        const int wq = __builtin_amdgcn_readfirstlane(tid >> 6), wr = wq >> 2, wc = wq & 3, fr = lane & 15, fq = lane >> 4;
        const int colt = u.pn * 256 + wc * 64 + 8 * fq;
        LAS f32x2* part = (LAS f32x2*)(lds + LNF_PART);
        LAS f32x2* stat = (LAS f32x2*)(lds + LNF_STAT);
#pragma unroll
        for (int m = 0; m < 4; ++m) { const int rl = AI * 128 + wr * 64 + m * 16 + fr;
            float s1 = 0.f, s2 = 0.f;
#pragma unroll
            for (int bj = 0; bj < 2; ++bj) { const f32x4 v0 = acc[AI][bj][m][0], v1 = acc[AI][bj][m][1];
#pragma unroll
                for (int e = 0; e < 4; ++e) { s1 += v0[e] + v1[e]; s2 += v0[e] * v0[e] + v1[e] * v1[e]; } }
            s1 += shx(s1, 16, lane); s2 += shx(s2, 16, lane); s1 += shx(s1, 32, lane); s2 += shx(s2, 32, lane);
            if (fq == 0) part[rl * 4 + wc] = (f32x2){s1, s2}; }
        if constexpr (AI == 1) {
            __syncthreads();
            if (tid < 256) {
                const f32x2 p0 = part[tid * 4], p1 = part[tid * 4 + 1], p2 = part[tid * 4 + 2], p3 = part[tid * 4 + 3];
                const float t1 = (p0[0] + p1[0]) + (p2[0] + p3[0]), t2 = (p0[1] + p1[1]) + (p2[1] + p3[1]);
                unsigned long long* sl = (unsigned long long*)pg8::rfl64(((const LAS pg8::JobDesc*)(lds + pg8::JT_OFF))->out2) + (size_t)u.pm * 1024 + tid;
#ifdef PROBE_LNV
                const bool dryp = __builtin_amdgcn_readfirstlane(((const LAS pg8::JobDesc*)(lds + pg8::JT_OFF))->mode) != 0;
#endif
                __hip_atomic_store(sl + u.pn * 256, ((unsigned long long)__float_as_uint(t2) << 32) | __float_as_uint(t1), __ATOMIC_RELAXED, __HIP_MEMORY_SCOPE_AGENT);
                unsigned long long x0, x1, x2, x3; unsigned sp = 0;
                for (;;) {
                    x0 = __hip_atomic_load(sl, __ATOMIC_RELAXED, __HIP_MEMORY_SCOPE_AGENT); x1 = __hip_atomic_load(sl + 256, __ATOMIC_RELAXED, __HIP_MEMORY_SCOPE_AGENT);
                    x2 = __hip_atomic_load(sl + 512, __ATOMIC_RELAXED, __HIP_MEMORY_SCOPE_AGENT); x3 = __hip_atomic_load(sl + 768, __ATOMIC_RELAXED, __HIP_MEMORY_SCOPE_AGENT);
                    if ((x0 != ~0ull && x1 != ~0ull && x2 != ~0ull && x3 != ~0ull) || ++sp > (1u << 22)) break;
#ifdef PROBE_LNV
                    if (dryp && ((PROBE_LNV) & 1)) break;
#endif
                    __builtin_amdgcn_s_sleep(1); }
#ifdef PROBE_LNX
                {   unsigned long long* sl2 = sl + 4 * 131072;
                    __hip_atomic_store(sl2 + u.pn * 256, ((unsigned long long)__float_as_uint(t2) << 32) | __float_as_uint(t1), __ATOMIC_RELAXED, __HIP_MEMORY_SCOPE_AGENT);
                    unsigned long long y0, y1, y2, y3; unsigned sq = 0;
                    for (;;) { y0 = __hip_atomic_load(sl2, __ATOMIC_RELAXED, __HIP_MEMORY_SCOPE_AGENT); y1 = __hip_atomic_load(sl2 + 256, __ATOMIC_RELAXED, __HIP_MEMORY_SCOPE_AGENT);
                        y2 = __hip_atomic_load(sl2 + 512, __ATOMIC_RELAXED, __HIP_MEMORY_SCOPE_AGENT); y3 = __hip_atomic_load(sl2 + 768, __ATOMIC_RELAXED, __HIP_MEMORY_SCOPE_AGENT);
                        if ((y0 != ~0ull && y1 != ~0ull && y2 != ~0ull && y3 != ~0ull) || ++sq > (1u << 22)) break;
                        __builtin_amdgcn_s_sleep(1); }
                    if (y0 == 0x123456789ull) x0 = y1; }
#endif
                const float S1 = (__uint_as_float((unsigned)x0) + __uint_as_float((unsigned)x1)) + (__uint_as_float((unsigned)x2) + __uint_as_float((unsigned)x3));
                const float S2 = (__uint_as_float((unsigned)(x0 >> 32)) + __uint_as_float((unsigned)(x1 >> 32))) + (__uint_as_float((unsigned)(x2 >> 32)) + __uint_as_float((unsigned)(x3 >> 32)));
                const float mean = S1 * (1.f / 1024.f); const float var = fmaxf(S2 * (1.f / 1024.f) - mean * mean, 0.f);
                stat[tid] = (f32x2){mean, __builtin_amdgcn_rsqf(var + LN_EPS)};
            }
            __syncthreads();
            const LAS pg8::JobDesc* jd = (const LAS pg8::JobDesc*)(lds + pg8::JT_OFF);
#ifdef PROBE_LNV
            const bool dryp2 = __builtin_amdgcn_readfirstlane(jd->mode) != 0;
#endif
            const unsigned long long xio = pg8::rfl64(jd->out); const float* g = (const float*)pg8::rfl64(jd->bias); const float* b = (const float*)pg8::rfl64(jd->rot);
            GAS unsigned char* tb = (GAS unsigned char*)(xio + ((size_t)u.pm * 256 * 1024 + u.pn * 256) * 2); const unsigned loff = (unsigned)((wr * 64 + fr) * 1024 + wc * 64 + 8 * fq) * 2u;
#pragma unroll
            for (int bj = 0; bj < 2; ++bj) {
                __builtin_amdgcn_sched_barrier(0);
                const f32x4 g0 = *(const GAS f32x4*)((const GAS float*)g + colt + bj * 32), g1 = *(const GAS f32x4*)((const GAS float*)g + colt + bj * 32 + 4), b0 = *(const GAS f32x4*)((const GAS float*)b + colt + bj * 32), b1 = *(const GAS f32x4*)((const GAS float*)b + colt + bj * 32 + 4);
                f32x2 stn = stat[wr * 64 + fr];
#pragma unroll
                for (int am = 0; am < 8; ++am) { const int ai = am >> 2, m = am & 3; const int rl = ai * 128 + wr * 64 + m * 16 + fr; const f32x2 st = stn;
                    if (am < 7) stn = stat[((am + 1) >> 2) * 128 + wr * 64 + ((am + 1) & 3) * 16 + fr];
                    const float sc = st[1], sh = -st[0] * st[1];
                    const f32x4 v0 = (acc[ai][bj][m][0] * sc + sh) * g0 + b0, v1 = (acc[ai][bj][m][1] * sc + sh) * g1 + b1;
                    u32x4 w; w.x = pk2(v0[0], v0[1]); w.y = pk2(v0[2], v0[3]); w.z = pk2(v1[0], v1[1]); w.w = pk2(v1[2], v1[3]);
#ifdef PROBE_LNV
                    if (!(dryp2 && ((PROBE_LNV) & 2)))
                    *(GAS u32x4*)(tb + (dryp2 ? (size_t)P_TMP_PROBE : (size_t)0) + (ai * 128 + m * 16) * 2048 + bj * 64 + loff) = w;
#else
                    *(GAS u32x4*)(tb + (ai * 128 + m * 16) * 2048 + bj * 64 + loff) = w;
#endif
#ifdef PROBE_LNS
                    *(GAS u32x4*)(tb + ((size_t)P_TMP_PROBE) + (ai * 128 + m * 16) * 2048 + bj * 64 + loff) = w;
#endif
                    __builtin_amdgcn_sched_barrier(0); }
            }
        }
    }
};
enum { RM_IDENT = 0, RM_ROT = 1, RM_PAIR0 = 2, RM_PAIR1 = 3 };
__device__ __forceinline__ int rowmap(int kind, int n) {
    if (kind == RM_ROT) { if (n >= 1280) return n; const int d = n & 63; return (n & ~63) + 2 * (d & 31) + (d >> 5); }
    if (kind == RM_PAIR0) return 2 * n;
    if (kind == RM_PAIR1) return 2 * n + 1;
    return n;
}
__device__ __forceinline__ void ti_load(const float* __restrict__ W, int ldw, int kb, int nb, int lane, f32x4 (&tv)[8]) {
    const int k0 = 64 * kb, n0 = 32 * nb;
#pragma unroll
    for (int i = 0; i < 8; ++i) { const int kk = 8 * i + (lane >> 3); tv[i] = *(const f32x4*)(W + (size_t)(k0 + kk) * ldw + n0 + 4 * (lane & 7)); }
}
__device__ __forceinline__ void ti_store(const f32x4 (&tv)[8], int K, bf16_t* __restrict__ WT, LAS float* scr, int kb, int nb, int lane, int kind, float scale, int nscale) {
    const int k0 = 64 * kb, n0 = 32 * nb;
#pragma unroll
    for (int i = 0; i < 8; ++i) { const int kk = 8 * i + (lane >> 3); LAS float* d = scr + kk * 33 + 4 * (lane & 7); d[0] = tv[i][0]; d[1] = tv[i][1]; d[2] = tv[i][2]; d[3] = tv[i][3]; }
    __builtin_amdgcn_s_waitcnt(0xc07f); asm volatile("" ::: "memory");
    const int c = lane & 7;
#pragma unroll
    for (int j = 0; j < 4; ++j) { const int n = (lane >> 3) + 8 * j; const LAS float* s = scr + (8 * c) * 33 + n; const float sc = (n0 + n) < nscale ? scale : 1.f;
        u32x4 o; o.x = pk2(s[0 * 33] * sc, s[1 * 33] * sc); o.y = pk2(s[2 * 33] * sc, s[3 * 33] * sc); o.z = pk2(s[4 * 33] * sc, s[5 * 33] * sc); o.w = pk2(s[6 * 33] * sc, s[7 * 33] * sc);
        *(u32x4*)(WT + (size_t)rowmap(kind, n0 + n) * K + k0 + 8 * c) = o; }
    __builtin_amdgcn_s_waitcnt(0xc07f); asm volatile("" ::: "memory");
}
__device__ __forceinline__ void convert_mats(const float* W, int K, int N, int nbat, size_t sstr, bf16_t* WT, size_t dstr, int kind, float scale, int nscale, LAS float* scr, int& gwr, int ngw, int lane) {
    const int nblk = N / 32, per = (K / 64) * nblk, total = per * nbat;
    const int gw = gwr; gwr = (gw + ngw - total % ngw) % ngw;
    if (gw >= total) return;
    f32x4 cur[8], nxt[8];
    { const int bt = gw / per, r = gw - bt * per; ti_load(W + (size_t)bt * sstr, N, r / nblk, r % nblk, lane, cur); }
    for (int it = gw; it < total; it += ngw) {
        const int in = it + ngw; const bool more = in < total;
        if (more) { const int bt = in / per, r = in - bt * per; ti_load(W + (size_t)bt * sstr, N, r / nblk, r % nblk, lane, nxt); }
        { const int bt = it / per, r = it - bt * per; ti_store(cur, K, WT + (size_t)bt * dstr, scr, r / nblk, r % nblk, lane, kind, scale, nscale); }
#pragma unroll
        for (int i = 0; i < 8; ++i) cur[i] = nxt[i];
    }
}
__device__ __forceinline__ void convert_rows(const float* __restrict__ src, bf16_t* __restrict__ dst, size_t n, int gt, int ngt) {
    const size_t step = (size_t)ngt * 8; size_t i = (size_t)gt * 8;
    for (; i + 3 * step < n; i += 4 * step) { f32x4 a[4], b[4];
#pragma unroll
        for (int j = 0; j < 4; ++j) { a[j] = *(const f32x4*)(src + i + j * step); b[j] = *(const f32x4*)(src + i + j * step + 4); }
#pragma unroll
        for (int j = 0; j < 4; ++j) { u32x4 o; o.x = pk2(a[j][0], a[j][1]); o.y = pk2(a[j][2], a[j][3]); o.z = pk2(b[j][0], b[j][1]); o.w = pk2(b[j][2], b[j][3]); *(u32x4*)(dst + i + j * step) = o; } }
    for (; i < n; i += step) { const f32x4 a = *(const f32x4*)(src + i), b = *(const f32x4*)(src + i + 4);
        u32x4 o; o.x = pk2(a[0], a[1]); o.y = pk2(a[2], a[3]); o.z = pk2(b[0], b[1]); o.w = pk2(b[2], b[3]); *(u32x4*)(dst + i) = o; }
}

struct LnArgs { const float* xin32; const bf16_t* xin; float* xout32; bf16_t* xbf; const bf16_t* y; const float* g; const float* b; const int* dest; const float* wts; };
template <int NR, bool XF32, bool OUTF32, bool MOE>
__device__ __forceinline__ void ln_rows(const LnArgs& a, int row0, int lane) {
    float v[NR][2][8];
    {
        int d0[NR], d1[NR]; float w0[NR], w1[NR];
        if (MOE) {
#pragma unroll
            for (int i = 0; i < NR; ++i) { d0[i] = a.dest[(row0 + i) * 2]; d1[i] = a.dest[(row0 + i) * 2 + 1]; w0[i] = a.wts[(row0 + i) * 2]; w1[i] = a.wts[(row0 + i) * 2 + 1]; }
        }
        f32x4 xf[XF32 ? NR : 1][2][2]; u32x4 xb[XF32 ? 1 : NR][2]; u32x4 p[NR][2], q[MOE ? NR : 1][2];
#pragma unroll
        for (int i = 0; i < NR; ++i) {
            const u32x4* y0 = (const u32x4*)(a.y + (size_t)(MOE ? d0[i] : row0 + i) * DM) + lane; const u32x4* y1 = (const u32x4*)(a.y + (size_t)(MOE ? d1[i] : 0) * DM) + lane;
#pragma unroll
            for (int j = 0; j < 2; ++j) {
                if (XF32) { const f32x4* xr = (const f32x4*)(a.xin32 + (size_t)(row0 + i) * DM) + 2 * lane + 128 * j; xf[XF32 ? i : 0][j][0] = xr[0]; xf[XF32 ? i : 0][j][1] = xr[1]; }
                else xb[XF32 ? 0 : i][j] = ((const u32x4*)(a.xin + (size_t)(row0 + i) * DM) + lane)[64 * j];
                p[i][j] = y0[64 * j]; if (MOE) q[MOE ? i : 0][j] = y1[64 * j]; } }
#pragma unroll
        for (int i = 0; i < NR; ++i)
#pragma unroll
            for (int j = 0; j < 2; ++j) {
                float x[8];
                if (XF32) {
#pragma unroll
                    for (int e = 0; e < 4; ++e) { x[e] = xf[XF32 ? i : 0][j][0][e]; x[4 + e] = xf[XF32 ? i : 0][j][1][e]; } }
                else { const u32x4 w = xb[XF32 ? 0 : i][j]; x[0] = bf_lo(w.x); x[1] = bf_hi(w.x); x[2] = bf_lo(w.y); x[3] = bf_hi(w.y); x[4] = bf_lo(w.z); x[5] = bf_hi(w.z); x[6] = bf_lo(w.w); x[7] = bf_hi(w.w); }
                const u32x4 pw = p[i][j]; const float py[8] = {bf_lo(pw.x), bf_hi(pw.x), bf_lo(pw.y), bf_hi(pw.y), bf_lo(pw.z), bf_hi(pw.z), bf_lo(pw.w), bf_hi(pw.w)};
                if (MOE) { const u32x4 qw = q[MOE ? i : 0][j]; const float qy[8] = {bf_lo(qw.x), bf_hi(qw.x), bf_lo(qw.y), bf_hi(qw.y), bf_lo(qw.z), bf_hi(qw.z), bf_lo(qw.w), bf_hi(qw.w)};
#pragma unroll
                    for (int e = 0; e < 8; ++e) v[i][j][e] = ALPHA * x[e] + w0[i] * py[e] + w1[i] * qy[e]; }
                else {
#pragma unroll
                    for (int e = 0; e < 8; ++e) v[i][j][e] = ALPHA * x[e] + py[e]; }
            }
    }
    float s[NR];
#pragma unroll
    for (int i = 0; i < NR; ++i) { s[i] = 0.f;
#pragma unroll
        for (int j = 0; j < 2; ++j)
#pragma unroll
            for (int e = 0; e < 8; ++e) s[i] += v[i][j][e]; }
#pragma unroll
    for (int o = 1; o < 64; o <<= 1)
#pragma unroll
        for (int i = 0; i < NR; ++i) s[i] += shx(s[i], o, lane);
    float q2[NR];
#pragma unroll
    for (int i = 0; i < NR; ++i) { const float mean = s[i] * (1.f / DM); q2[i] = 0.f;
#pragma unroll
        for (int j = 0; j < 2; ++j)
#pragma unroll
            for (int e = 0; e < 8; ++e) { v[i][j][e] -= mean; q2[i] += v[i][j][e] * v[i][j][e]; } }
#pragma unroll
    for (int o = 1; o < 64; o <<= 1)
#pragma unroll
        for (int i = 0; i < NR; ++i) q2[i] += shx(q2[i], o, lane);
    f32x4 gv[2][2], bv[2][2];
#pragma unroll
    for (int j = 0; j < 2; ++j) { const f32x4* gp = (const f32x4*)a.g + 2 * lane + 128 * j; const f32x4* bp = (const f32x4*)a.b + 2 * lane + 128 * j; gv[j][0] = gp[0]; gv[j][1] = gp[1]; bv[j][0] = bp[0]; bv[j][1] = bp[1]; }
#pragma unroll
    for (int i = 0; i < NR; ++i) { const float rstd = rsqrtf(q2[i] * (1.f / DM) + LN_EPS);
#pragma unroll
        for (int j = 0; j < 2; ++j) { float o[8];
#pragma unroll
            for (int e = 0; e < 8; ++e) o[e] = v[i][j][e] * rstd * gv[j][e >> 2][e & 3] + bv[j][e >> 2][e & 3];
            if (OUTF32) { f32x4* xo = (f32x4*)(a.xout32 + (size_t)(row0 + i) * DM) + 2 * lane + 128 * j; xo[0] = (f32x4){o[0], o[1], o[2], o[3]}; xo[1] = (f32x4){o[4], o[5], o[6], o[7]}; }
            else { u32x4 w; w.x = pk2(o[0], o[1]); w.y = pk2(o[2], o[3]); w.z = pk2(o[4], o[5]); w.w = pk2(o[6], o[7]); ((u32x4*)(a.xbf + (size_t)(row0 + i) * DM) + lane)[64 * j] = w; } } }
}
template <bool XF32, bool OUTF32, bool MOE>
__device__ __forceinline__ void ln_phase(const LnArgs& a, int blk, int G, int wave, int lane) {
    const int per = NT / G, r0 = blk * per, pw = per / NWAVE;
    for (int r = 0; r < pw; r += 4) ln_rows<4, XF32, OUTF32, MOE>(a, r0 + wave * pw + r, lane);
}
__device__ __forceinline__ void xattn_phase(LAS unsigned char* lds, const bf16_t* __restrict__ Q, const bf16_t* __restrict__ KC, const bf16_t* __restrict__ VT, bf16_t* __restrict__ O, int blk, int G) {
    const int tid0 = threadIdx.x, wave = __builtin_amdgcn_readfirstlane(tid0 >> 6);
#define XA_IDS int tid = tid0; asm volatile("" : "+v"(tid)); const int lane = tid & 63, r32 = lane & 31, hh = lane >> 5; const size_t qrow = (size_t)b * SEQ + qb * 256 + wave * 32 + r32; (void)lane; (void)hh; (void)qrow;
    for (int u = blk; u < 512; u += G) {
        int qb = u & 15, h = (u >> 4) & 3, b = u >> 6;
        if (G == 256) { const int x = blk & 7, j = blk >> 3, grp = x * 4 + (u >> 8) * 2 + (j >> 4); qb = j & 15; h = grp & 3; b = grp >> 2; }
        XA_IDS;
        bf16x8 qf[16];
#pragma unroll
        for (int ks = 0; ks < 16; ++ks) qf[ks] = *(const bf16x8*)(Q + qrow * 1024 + h * 256 + ks * 16 + hh * 8);
        __syncthreads();
#pragma unroll
        for (int bt = 0; bt < 2; ++bt) {
            u32x4 t[8];
#pragma unroll
            for (int i = 0; i < 8; ++i) { const int ch = tid + 512 * (bt * 8 + i), row = ch >> 5, c = ch & 31; t[i] = *(const u32x4*)(KC + (size_t)(b * 256 + row) * 1024 + h * 256 + c * 8); }
#pragma unroll
            for (int i = 0; i < 8; ++i) { const int ch = tid + 512 * (bt * 8 + i), row = ch >> 5, c = ch & 31; *(LAS u32x4*)(lds + row * 528 + c * 16) = t[i]; }
        }
        __syncthreads();
        f32x16 s[8];
#pragma unroll
        for (int mt = 0; mt < 8; ++mt)
#pragma unroll
            for (int r = 0; r < 16; ++r) s[mt][r] = 0.f;
        {   const LAS unsigned char* kbp = lds + r32 * 528 + hh * 16;
#pragma unroll
            for (int ks = 0; ks < 16; ++ks)
#pragma unroll
                for (int mt = 0; mt < 8; ++mt) { const bf16x8 a = *(const LAS bf16x8*)(kbp + mt * 32 * 528 + ks * 32); s[mt] = MFMA32(a, qf[ks], s[mt]); }
        }
        float mx = -INFINITY;
#pragma unroll
        for (int mt = 0; mt < 8; ++mt)
#pragma unroll
            for (int r = 0; r < 16; ++r) mx = fmaxf(mx, s[mt][r]);
        mx = xhalf_max(mx);
        float sm = 0.f; const float mxl = mx * LOG2E;
        u32x4 pf[8][2];
#pragma unroll
        for (int mt = 0; mt < 8; ++mt)
#pragma unroll
            for (int r = 0; r < 16; ++r) { const float p = __builtin_amdgcn_exp2f(s[mt][r] * LOG2E - mxl); s[mt][r] = p; sm += p; }
        sm = xhalf_sum(sm);
        {   const float inv = 1.f / sm;
#pragma unroll
            for (int mt = 0; mt < 8; ++mt)
#pragma unroll
                for (int sx = 0; sx < 2; ++sx) pf[mt][sx] = (u32x4){pk2(s[mt][8 * sx] * inv, s[mt][8 * sx + 1] * inv), pk2(s[mt][8 * sx + 2] * inv, s[mt][8 * sx + 3] * inv), pk2(s[mt][8 * sx + 4] * inv, s[mt][8 * sx + 5] * inv), pk2(s[mt][8 * sx + 6] * inv, s[mt][8 * sx + 7] * inv)};
        }
        __syncthreads();
        {   XA_IDS;
#pragma unroll
        for (int bt = 0; bt < 4; ++bt) {
            u32x4 t[4];
#pragma unroll
            for (int i = 0; i < 4; ++i) { const int ch = tid + 512 * (bt * 4 + i), row = ch >> 5, c = ch & 31; t[i] = *(const u32x4*)(VT + (size_t)(h * 256 + row) * 2048 + b * 256 + c * 8); }
#pragma unroll
            for (int i = 0; i < 4; ++i) { const int ch = tid + 512 * (bt * 4 + i), row = ch >> 5, c = ch & 31; LAS u32x2* d = (LAS u32x2*)(lds + row * 520 + c * 16); d[0] = (u32x2){t[i].x, t[i].y}; d[1] = (u32x2){t[i].z, t[i].w}; }
        }
        }
        __syncthreads();
        {   XA_IDS;
        bf16_t* otile = O + ((size_t)b * SEQ + qb * 256 + wave * 32) * 1024 + h * 256 + r32;
#pragma unroll 1
        for (int dh = 0; dh < 2; ++dh) {
            f32x16 o[4];
#pragma unroll
            for (int dt = 0; dt < 4; ++dt)
#pragma unroll
                for (int r = 0; r < 16; ++r) o[dt][r] = 0.f;
            const LAS unsigned char* vb = lds + (dh * 128 + r32) * 520 + 8 * hh;
#pragma unroll
            for (int mt = 0; mt < 8; ++mt)
#pragma unroll
                for (int sx = 0; sx < 2; ++sx) { const int kb = mt * 32 + 16 * sx; const bf16x8 pb = __builtin_bit_cast(bf16x8, pf[mt][sx]);
#pragma unroll
                    for (int dt = 0; dt < 4; ++dt) { const LAS unsigned char* q = vb + dt * 32 * 520 + kb * 2;
                        const s16x4 lo = *(const LAS s16x4*)q, hi = *(const LAS s16x4*)(q + 16);
                        const bf16x8 a = (bf16x8){lo[0], lo[1], lo[2], lo[3], hi[0], hi[1], hi[2], hi[3]}; o[dt] = MFMA32(pb, a, o[dt]); } }
#pragma unroll
            for (int dt = 0; dt < 4; ++dt)
#pragma unroll
                for (int r = 0; r < 16; ++r) otile[(size_t)crow(r, hh) * 1024 + dh * 128 + dt * 32] = f2bf(o[dt][r]);
        }
        }
    }
#undef XA_IDS
}

struct RouteBufs { int* e; float* w; int* rank; int* dest; int* hist; int* tstart; int* src; };
__device__ __forceinline__ void moe_router_phase(LAS unsigned char* lds, const bf16_t* __restrict__ XBF, const bf16_t* __restrict__ WRT, const float* __restrict__ brg, const float* __restrict__ bre, const RouteBufs rb, int blk) {
    int tid_ = threadIdx.x; asm volatile("" : "+v"(tid_)); const int tid = tid_, lane = tid & 63, wave = __builtin_amdgcn_readfirstlane(tid >> 6), r32 = lane & 31, hh = lane >> 5;
    LAS unsigned char* XT = lds; LAS unsigned char* WT = lds + 128 * 528;
    LAS float* LG = (LAS float*)lds;
    LAS int* hist = (LAS int*)(lds + 128 * 65 * 4);
    const int rbk = wave & 3, ct = wave >> 2;
    f32x16 acc;
#pragma unroll
    for (int r = 0; r < 16; ++r) acc[r] = 0.f;
#pragma unroll 1
    for (int kc = 0; kc < 4; ++kc) {
        __syncthreads();
        {   u32x4 tx[8], tw[8];
#pragma unroll
            for (int i = 0; i < 8; ++i) { const int ch = tid + 512 * i, row = ch >> 5, c = ch & 31; tx[i] = *(const u32x4*)(XBF + (size_t)(blk * 128 + row) * 1024 + kc * 256 + c * 8); tw[i] = *(const u32x4*)(WRT + (size_t)row * 1024 + kc * 256 + c * 8); }
#pragma unroll
            for (int i = 0; i < 8; ++i) { const int ch = tid + 512 * i, row = ch >> 5, c = ch & 31; *(LAS u32x4*)(XT + row * 528 + c * 16) = tx[i]; *(LAS u32x4*)(WT + row * 528 + c * 16) = tw[i]; } }
        __syncthreads();
        const LAS unsigned char* ap = XT + (rbk * 32 + r32) * 528 + hh * 16; const LAS unsigned char* bp = WT + (ct * 32 + r32) * 528 + hh * 16;
#pragma unroll
        for (int ks = 0; ks < 16; ++ks) { const bf16x8 a = *(const LAS bf16x8*)(ap + ks * 32), b0 = *(const LAS bf16x8*)(bp + ks * 32), b1 = *(const LAS bf16x8*)(bp + 64 * 528 + ks * 32);
            acc = MFMA32(a, b0, acc); acc = MFMA32(a, b1, acc); }
    }
    __syncthreads();
    if (tid < 32) hist[tid] = 0;
#pragma unroll
    for (int r = 0; r < 16; ++r) LG[(rbk * 32 + crow(r, hh)) * 65 + ct * 32 + r32] = acc[r];
    __syncthreads();
    if (tid < 128) {
        const LAS float* lg = LG + tid * 65; const int tok = blk * 128 + tid;
        float g4[4];
#pragma unroll
        for (int g = 0; g < 4; ++g) g4[g] = lg[32 + g] + brg[g];
        int gi = 0; float gm = g4[0];
#pragma unroll
        for (int g = 1; g < 4; ++g) if (g4[g] > gm) { gm = g4[g]; gi = g; }
        float gs = 0.f;
#pragma unroll
        for (int g = 0; g < 4; ++g) gs += fast_exp(g4[g] - gm);
        const float gate_g = 1.f / gs;
        float le[8];
#pragma unroll
        for (int e = 0; e < 8; ++e) le[e] = lg[gi * 8 + e] + bre[gi * 8 + e];
        int i0 = 0; float v0 = le[0];
#pragma unroll
        for (int e = 1; e < 8; ++e) if (le[e] > v0) { v0 = le[e]; i0 = e; }
        int i1 = 0; float v1 = -INFINITY;
#pragma unroll
        for (int e = 0; e < 8; ++e) if (e != i0 && le[e] > v1) { v1 = le[e]; i1 = e; }
        const float e1 = fast_exp(v1 - v0), p0 = 1.f / (1.f + e1), p1 = e1 * p0;
        const int ex0 = gi * 8 + i0, ex1 = gi * 8 + i1;
        rb.e[tok * 2] = ex0; rb.e[tok * 2 + 1] = ex1; rb.w[tok * 2] = gate_g * p0; rb.w[tok * 2 + 1] = gate_g * p1;
        rb.rank[tok * 2] = atomicAdd((int*)&hist[ex0], 1); rb.rank[tok * 2 + 1] = atomicAdd((int*)&hist[ex1], 1);
    }
    __syncthreads();
    if (tid < 32) rb.hist[blk * 32 + tid] = hist[tid];
}
__device__ __forceinline__ void moe_scatter_phase(LAS unsigned char* lds, const RouteBufs rb, int blk, int G) {
    int tid_ = threadIdx.x; asm volatile("" : "+v"(tid_)); const int tid = tid_, lane = tid & 63, wave = __builtin_amdgcn_readfirstlane(tid >> 6);
    LAS int* sb = (LAS int*)lds;
    __syncthreads();
    {
        const int e = tid & 31, part = tid >> 5; int c[16];
#pragma unroll
        for (int i = 0; i < 16; ++i) c[i] = rb.hist[(part * 16 + i) * 32 + e];
        int tot = 0, base = 0;
#pragma unroll
        for (int i = 0; i < 16; ++i) { tot += c[i]; if (part * 16 + i < blk) base += c[i]; }
        sb[128 + part * 32 + e] = base; sb[128 + 512 + part * 32 + e] = tot; }
    __syncthreads();
    if (tid < 32) { int tot = 0, base = 0;
#pragma unroll
        for (int i = 0; i < 16; ++i) { base += sb[128 + i * 32 + tid]; tot += sb[128 + 512 + i * 32 + tid]; }
        sb[tid] = base; sb[32 + tid] = tot; }
    __syncthreads();
    if (tid == 0) { int acc = 0; for (int e = 0; e < 32; ++e) { sb[64 + e] = acc; if (blk == 0) rb.tstart[e] = acc >> 8; acc += (sb[32 + e] + 255) & ~255; } sb[96] = acc; if (blk == 0) rb.tstart[32] = acc >> 8; }
    __syncthreads();
    if (tid < 256) { const int idx = blk * 256 + tid; const int e = rb.e[idx]; const int d = sb[64 + e] + sb[e] + rb.rank[idx]; rb.dest[idx] = d; rb.src[d] = idx >> 1; }
    if (blk < 32) { const int e = blk; const int lo = sb[64 + e] + sb[32 + e], hi = sb[64 + e] + ((sb[32 + e] + 255) & ~255); for (int r = lo + tid; r < hi; r += NTHR) rb.src[r] = 0; }
}
struct MoeSched {
    const char* A; const char* B; const int* tstart; int K, nN, G, c; size_t bexp;
    __device__ __forceinline__ pg8::Unit get(int i, bool& ok) const { pg8::Unit u; u.A = nullptr; u.B = nullptr; u.src = nullptr; u.pm = 0; u.pn = 0; u.job = 0; ok = next(i, u); return u; }
    __device__ __forceinline__ bool next(int i, pg8::Unit& u) const {
        const int vc = (c & 7) * (G >> 3) + (c >> 3);
        const long L = (long)i * G + vc; const int ntile = tstart[32];
        if (L >= (long)ntile * nN) return false;
        const int mt = (int)(L / nN), nt = (int)(L % nN);
        int e = 0;
        for (int k = 1; k < 32; ++k) if (tstart[k] <= mt) e = k;
        u.A = A + (size_t)mt * 256 * K * 2; u.B = B + (size_t)e * bexp + (size_t)nt * 256 * K * 2; u.src = nullptr; u.pm = mt; u.pn = nt; u.job = 0; return true;
    }
};
__device__ __forceinline__ void swa_phase(LAS unsigned char* lds, const bf16_t* __restrict__ Q1, const bf16_t* __restrict__ K1, const bf16_t* __restrict__ VT1, const float* __restrict__ sinks, bf16_t* __restrict__ O, int blk, int G) {
    int tid_ = threadIdx.x; asm volatile("" : "+v"(tid_)); const int tid = tid_, lane = tid & 63, wave = __builtin_amdgcn_readfirstlane(tid >> 6), r32 = lane & 31, hh = lane >> 5;
    LAS unsigned char* KL = lds;
    LAS unsigned char* VL = lds + 36864;
    auto umap = [&](int u, int& n, int& kvh, int& b) { n = u & 31; kvh = (u >> 5) & 3; b = u >> 7;
        if (G == 256) { const int grp = (u >> 8) * 8 + (blk & 7); n = blk >> 3; kvh = grp & 3; b = grp >> 2; } };
    u32x4 pkb[4], pvb[4];
#define SWA_BAND_LOADS(UU) do { int n_, kvh_, b_; umap((UU), n_, kvh_, b_); const int tokb_ = b_ * SEQ + (n_ - 1) * 128; \
        _Pragma("unroll") for (int i = 0; i < 4; ++i) { const int ch = tid + 512 * i; const int key = ch >> 3, c = ch & 7; \
            u32x4 v = (u32x4){0u, 0u, 0u, 0u}; if (n_ > 0 || key >= 128) v = *(const u32x4*)(K1 + (size_t)(tokb_ + key) * 256 + kvh_ * 64 + c * 8); pkb[i] = v; } \
        _Pragma("unroll") for (int i = 0; i < 4; ++i) { const int ch = tid + 512 * i; const int d = ch >> 5, c = ch & 31; \
            u32x4 v = (u32x4){0u, 0u, 0u, 0u}; if (n_ > 0 || c >= 16) v = *(const u32x4*)(VT1 + (size_t)(kvh_ * 64 + d) * NT + tokb_ + c * 8); pvb[i] = v; } } while (0)
    if (blk < 1024) SWA_BAND_LOADS(blk);
    for (int u = blk; u < 1024; u += G) {
        int n, kvh, b; umap(u, n, kvh, b);
        bf16x8 qfa[2][4];
        {   const int g0 = wave >> 1, hq0 = kvh * 4 + g0;
#pragma unroll
            for (int sb = 0; sb < 2; ++sb)
#pragma unroll
                for (int ks = 0; ks < 4; ++ks) qfa[sb][ks] = *(const bf16x8*)(Q1 + ((size_t)b * SEQ + n * 128 + (wave & 1) * 64 + sb * 32 + r32) * 1024 + hq0 * 64 + ks * 16 + hh * 8); }
        __syncthreads();
#pragma unroll
        for (int i = 0; i < 4; ++i) { const int ch = tid + 512 * i; const int key = ch >> 3, c = ch & 7; *(LAS u32x4*)(KL + key * 144 + c * 16) = pkb[i]; }
#pragma unroll
        for (int i = 0; i < 4; ++i) { const int ch = tid + 512 * i; const int d = ch >> 5, c = ch & 31; const u32x4 v = pvb[i];
            LAS u32x2* dp = (LAS u32x2*)(VL + d * 520 + c * 16); dp[0] = (u32x2){v.x, v.y}; dp[1] = (u32x2){v.z, v.w}; }
        { const int un = u + G < 1024 ? u + G : u; SWA_BAND_LOADS(un); }
        __syncthreads();
        const int g = wave >> 1, hq = kvh * 4 + g; const float sink = sinks[hq];
#pragma unroll 1
        for (int sb = 0; sb < 2; ++sb) {
            bf16x8 qf[4];
#pragma unroll
            for (int ks = 0; ks < 4; ++ks) qf[ks] = sb ? qfa[1][ks] : qfa[0][ks];
            const int i0 = (wave & 1) * 64 + sb * 32, jt0 = i0 >> 5;
            const size_t qtok = (size_t)b * SEQ + n * 128 + i0 + r32;
            f32x16 s[5];
#pragma unroll
            for (int t = 0; t < 5; ++t) {
#pragma unroll
                for (int r = 0; r < 16; ++r) s[t][r] = 0.f;
                const LAS unsigned char* kp = KL + ((jt0 + t) * 32 + r32) * 144 + hh * 16;
#pragma unroll
                for (int ks = 0; ks < 4; ++ks) { const bf16x8 a = *(const LAS bf16x8*)(kp + ks * 32); s[t] = MFMA32(a, qf[ks], s[t]); }
            }
            const int qi = i0 + r32;
            float mx = sink;
#pragma unroll
            for (int t = 0; t < 5; ++t)
#pragma unroll
                for (int r = 0; r < 16; ++r) { const int kj = (jt0 + t) * 32 + crow(r, hh); const bool valid = (kj > qi) && (kj <= qi + 128) && (n > 0 || kj >= 128);
                    s[t][r] = valid ? s[t][r] : -INFINITY; mx = fmaxf(mx, s[t][r]); }
            mx = xhalf_max(mx);
            float sm = 0.f; const float mxl = mx * LOG2E;
            u32x4 pf[5][2];
#pragma unroll
            for (int t = 0; t < 5; ++t) {
#pragma unroll
                for (int r = 0; r < 16; ++r) { const float pv = __builtin_amdgcn_exp2f(s[t][r] * LOG2E - mxl); s[t][r] = pv; sm += pv; }
#pragma unroll
                for (int sx = 0; sx < 2; ++sx) pf[t][sx] = (u32x4){pk2(s[t][8 * sx], s[t][8 * sx + 1]), pk2(s[t][8 * sx + 2], s[t][8 * sx + 3]), pk2(s[t][8 * sx + 4], s[t][8 * sx + 5]), pk2(s[t][8 * sx + 6], s[t][8 * sx + 7])};
            }
            sm = xhalf_sum(sm) + __builtin_amdgcn_exp2f(sink * LOG2E - mxl);
            f32x16 o[2];
#pragma unroll
            for (int dt = 0; dt < 2; ++dt)
#pragma unroll
                for (int r = 0; r < 16; ++r) o[dt][r] = 0.f;
#pragma unroll
            for (int t = 0; t < 5; ++t)
#pragma unroll
                for (int sx = 0; sx < 2; ++sx) { const bf16x8 pb = __builtin_bit_cast(bf16x8, pf[t][sx]);
#pragma unroll
                    for (int dt = 0; dt < 2; ++dt) { const LAS unsigned char* q = VL + (dt * 32 + r32) * 520 + ((jt0 + t) * 32 + 16 * sx + 4 * hh) * 2;
                        const s16x4 lo = *(const LAS s16x4*)q, hi = *(const LAS s16x4*)(q + 16);
                        const bf16x8 a = (bf16x8){lo[0], lo[1], lo[2], lo[3], hi[0], hi[1], hi[2], hi[3]}; o[dt] = MFMA32(a, pb, o[dt]); } }
            const float inv = 1.f / sm;
            bf16_t* orow = O + qtok * 1024 + hq * 64 + 4 * hh;
#pragma unroll
            for (int dt = 0; dt < 2; ++dt)
#pragma unroll
                for (int gq = 0; gq < 4; ++gq) { u32x2 w; w.x = pk2(o[dt][4 * gq] * inv, o[dt][4 * gq + 1] * inv); w.y = pk2(o[dt][4 * gq + 2] * inv, o[dt][4 * gq + 3] * inv); *(u32x2*)(orow + dt * 32 + 8 * gq) = w; }
        }
    }
}
#undef SWA_BAND_LOADS
constexpr int TS = 272;
template <int STRIDE = TS>
__device__ __forceinline__ bf16x8 tr_frag(const LAS unsigned char* T, int k0, int c0, int lane, bool permuted) {
    const int hh = lane >> 5, blk = (lane >> 4) & 1, q = (lane & 15) >> 2, pp = lane & 3;
    const int r0 = k0 + (permuted ? 4 * hh : 8 * hh) + q, r1 = r0 + (permuted ? 8 : 4);
    const int cb = (c0 + 16 * blk + 4 * pp) * 2;
    const s16x4 lo = lds_tr(T + r0 * STRIDE + cb), hi = lds_tr(T + r1 * STRIDE + cb);
    return (bf16x8){lo[0], lo[1], lo[2], lo[3], hi[0], hi[1], hi[2], hi[3]};
}
__device__ __forceinline__ bf16x8 row_frag(const LAS unsigned char* T, int row, int k0, int hh) { return *(const LAS bf16x8*)(T + row * TS + (k0 + 8 * hh) * 2); }
__device__ __forceinline__ void load_tile128(LAS unsigned char* T, const bf16_t* __restrict__ g, int ld, int tid) {
#pragma unroll
    for (int i = 0; i < 4; ++i) { const int ch = tid + 512 * i, row = ch >> 4, c = ch & 15; *(LAS u32x4*)(T + row * TS + c * 16) = *(const u32x4*)(g + (size_t)row * ld + c * 8); }
}
struct L0Bufs {
    bf16_t *AU, *AV, *BX, *BZ, *V, *XC, *YM, *CS, *Q, *K, *U; float *GT, *UN, *NS, *SC;
    const bf16_t *WQT, *GMW, *MT; const float *gm_g, *gm_b, *gm_bs, *cw, *cb, *bif, *nw, *skip;
};

__device__ __forceinline__ void l0_mixA(LAS unsigned char* lds, const L0Bufs& B, int blk, int G, int skip = 0) {
    const int tid0 = threadIdx.x, wave = __builtin_amdgcn_readfirstlane(tid0 >> 6);
#define OPQ_IDS int tid = tid0; asm volatile("" : "+v"(tid)); const int lane = tid & 63, r32 = lane & 31, hh = lane >> 5; (void)lane; (void)r32; (void)hh;
    LAS unsigned char* T0 = lds; LAS unsigned char* T1 = lds + 34816; LAS unsigned char* T2 = lds + 2 * 34816; LAS unsigned char* T3 = lds + 3 * 34816;
    LAS float* SF = (LAS float*)T2;
    LAS float* SG = (LAS float*)(lds + 3 * 34816 + 35632);
    for (int u = blk; u < 256; u += G) {
        const int tok0 = u * 128; const bool first = (u & 31) == 0;
        if (!(skip & 1)) {
        constexpr int VS = 1040;
        {   OPQ_IDS; const int trow = tid >> 2, q4 = tid & 3;
            const bf16_t* vr = B.AV + (size_t)(tok0 + trow) * 512 + q4 * 128; float s = 0.f, s2 = 0.f; u32x4 w[16];
#pragma unroll
            for (int i = 0; i < 16; ++i) w[i] = *(const u32x4*)(vr + i * 8);
#pragma unroll
            for (int i = 0; i < 16; ++i) { const float f[8] = {bf_lo(w[i].x), bf_hi(w[i].x), bf_lo(w[i].y), bf_hi(w[i].y), bf_lo(w[i].z), bf_hi(w[i].z), bf_lo(w[i].w), bf_hi(w[i].w)};
#pragma unroll
                for (int e = 0; e < 8; ++e) { s += f[e]; s2 += f[e] * f[e]; } }
            s += shx(s, 1, lane); s += shx(s, 2, lane); s2 += shx(s2, 1, lane); s2 += shx(s2, 2, lane);
            const float mean = s * (1.f / 512.f), rstd = rsqrtf(fmaxf(s2 * (1.f / 512.f) - mean * mean, 0.f) + LN_EPS);
            __syncthreads();
#pragma unroll
            for (int i = 0; i < 16; ++i) { const int cbase = q4 * 128 + i * 8; const f32x4 g0 = *(const f32x4*)(B.gm_g + cbase), g1 = *(const f32x4*)(B.gm_g + cbase + 4), b0 = *(const f32x4*)(B.gm_b + cbase), b1 = *(const f32x4*)(B.gm_b + cbase + 4);
                u32x4 o; o.x = pk2((bf_lo(w[i].x) - mean) * rstd * g0[0] + b0[0], (bf_hi(w[i].x) - mean) * rstd * g0[1] + b0[1]); o.y = pk2((bf_lo(w[i].y) - mean) * rstd * g0[2] + b0[2], (bf_hi(w[i].y) - mean) * rstd * g0[3] + b0[3]);
                o.z = pk2((bf_lo(w[i].z) - mean) * rstd * g1[0] + b1[0], (bf_hi(w[i].z) - mean) * rstd * g1[1] + b1[1]); o.w = pk2((bf_lo(w[i].w) - mean) * rstd * g1[2] + b1[2], (bf_hi(w[i].w) - mean) * rstd * g1[3] + b1[3]);
                *(LAS u32x4*)(lds + trow * VS + cbase * 2) = o; asm volatile("" ::: "memory"); }
            __syncthreads();
        }
        {   const int tb = wave & 3, dhf = wave >> 2;
#pragma unroll 1
            for (int g = 0; g < 4; ++g) {
                OPQ_IDS; const int t = 32 * tb + r32; const size_t tok = (size_t)tok0 + t;
                f32x16 acc[2];
#pragma unroll
                for (int dt = 0; dt < 2; ++dt)
#pragma unroll
                    for (int r = 0; r < 16; ++r) acc[dt][r] = 0.f;
                const bf16_t* wrow = B.GMW + ((size_t)g * 128 + t) * 128 + 8 * hh;
                u32x2 aup[2][4];
#pragma unroll
                for (int dt = 0; dt < 2; ++dt)
#pragma unroll
                    for (int gq = 0; gq < 4; ++gq) aup[dt][gq] = *(const u32x2*)(B.AU + tok * 512 + g * 128 + 64 * dhf + 32 * dt + 8 * gq + 4 * hh);
                bf16x8 bw[8];
#pragma unroll
                for (int ks = 0; ks < 8; ++ks) bw[ks] = *(const bf16x8*)(wrow + 16 * ks);
#pragma unroll
                for (int ks = 0; ks < 8; ++ks) if (ks <= 2 * tb + 1) {
#pragma unroll
                    for (int dt = 0; dt < 2; ++dt) { const bf16x8 a = tr_frag<VS>(lds, 16 * ks, g * 128 + 64 * dhf + 32 * dt, lane, false); acc[dt] = MFMA32(a, bw[ks], acc[dt]); } }
                const float bsv = B.gm_bs[g * 128 + t];
#pragma unroll
                for (int dt = 0; dt < 2; ++dt)
#pragma unroll
                    for (int gq = 0; gq < 4; ++gq) { const int col = g * 128 + 64 * dhf + 32 * dt + 8 * gq + 4 * hh; const u32x2 au = aup[dt][gq];
                        u32x2 w; w.x = pk2(bf_lo(au.x) * (acc[dt][4 * gq] + bsv), bf_hi(au.x) * (acc[dt][4 * gq + 1] + bsv)); w.y = pk2(bf_lo(au.y) * (acc[dt][4 * gq + 2] + bsv), bf_hi(au.y) * (acc[dt][4 * gq + 3] + bsv));
                        *(u32x2*)(B.YM + tok * 1024 + col) = w; }
            }
        }
        }
        f32x16 accg;
#pragma unroll
        for (int r = 0; r < 16; ++r) accg[r] = 0.f;
        LAS unsigned char* MTL = (LAS unsigned char*)SG;
        u32x4 pxm[5], pwq[4], pwk[4], pwv[4], pmt;
#define P1_LOADS_A(HN) do { _Pragma("unroll") for (int i = 0; i < 5; ++i) { const int ch = tid + 512 * i, row = ch >> 4, c = ch & 15; u32x4 v = (u32x4){0u, 0u, 0u, 0u}; \
                if (ch < 131 * 16 && !(first && row < 3)) v = *(const u32x4*)(B.BX + (size_t)(tok0 - 3 + row) * 512 + (HN) * 128 + c * 8); pxm[i] = v; } \
            _Pragma("unroll") for (int i = 0; i < 4; ++i) { const int ch = tid + 512 * i, row = ch >> 4, c = ch & 15; pwq[i] = *(const u32x4*)(B.WQT + ((size_t)0 * 4 + (HN)) * 128 * 128 + (size_t)row * 128 + c * 8); pwk[i] = *(const u32x4*)(B.WQT + ((size_t)1 * 4 + (HN)) * 128 * 128 + (size_t)row * 128 + c * 8); } \
            pmt = *(const u32x4*)(B.MT + ((size_t)(HN) * 8 + ((tid & 255) >> 5)) * 256 + (tid & 31) * 8); } while (0)
#define P1_LOADS_V(HN) do { _Pragma("unroll") for (int i = 0; i < 4; ++i) { const int ch = tid + 512 * i, row = ch >> 4, c = ch & 15; pwv[i] = *(const u32x4*)(B.WQT + ((size_t)2 * 4 + (HN)) * 128 * 128 + (size_t)row * 128 + c * 8); } } while (0)
        {   OPQ_IDS; P1_LOADS_A(0); P1_LOADS_V(0); }
#pragma unroll 1
        for (int h = 0; h < ((skip & 2) ? 0 : 4); ++h) {
            OPQ_IDS;
            __syncthreads();
#pragma unroll
            for (int i = 0; i < 5; ++i) { const int ch = tid + 512 * i, row = ch >> 4, c = ch & 15; if (ch < 131 * 16) *(LAS u32x4*)(T3 + row * TS + c * 16) = pxm[i]; }
#pragma unroll
            for (int i = 0; i < 4; ++i) { const int ch = tid + 512 * i, row = ch >> 4, c = ch & 15; *(LAS u32x4*)(T0 + row * TS + c * 16) = pwq[i]; *(LAS u32x4*)(T1 + row * TS + c * 16) = pwk[i]; }
            if (tid < 256) { const int row = tid >> 5, c = tid & 31; *(LAS u32x4*)(MTL + row * 528 + c * 16) = pmt; }
            { const int hn = h < 3 ? h + 1 : 3; P1_LOADS_A(hn); }
            __syncthreads();
            {   const int dc = tid & 15, chn = h * 128 + dc * 8; float w[4][8], cbv[8];
#pragma unroll
                for (int j = 0; j < 4; ++j)
#pragma unroll
                    for (int e = 0; e < 8; ++e) w[j][e] = B.cw[j * 512 + chn + e];
#pragma unroll
                for (int e = 0; e < 8; ++e) cbv[e] = B.cb[chn + e];
#pragma unroll 1
                for (int ps = 0; ps < 4; ++ps) { const int t = ps * 32 + (tid >> 4); float a[8];
#pragma unroll
                    for (int e = 0; e < 8; ++e) a[e] = cbv[e];
#pragma unroll
                    for (int j = 0; j < 4; ++j) { const u32x4 x = *(const LAS u32x4*)(T3 + (t + j) * TS + dc * 16);
                        a[0] += w[j][0] * bf_lo(x.x); a[1] += w[j][1] * bf_hi(x.x); a[2] += w[j][2] * bf_lo(x.y); a[3] += w[j][3] * bf_hi(x.y);
                        a[4] += w[j][4] * bf_lo(x.z); a[5] += w[j][5] * bf_hi(x.z); a[6] += w[j][6] * bf_lo(x.w); a[7] += w[j][7] * bf_hi(x.w); }
                    u32x4 o; o.x = pk2(silu_f(a[0]), silu_f(a[1])); o.y = pk2(silu_f(a[2]), silu_f(a[3])); o.z = pk2(silu_f(a[4]), silu_f(a[5])); o.w = pk2(silu_f(a[6]), silu_f(a[7]));
                    *(LAS u32x4*)(T2 + t * TS + dc * 16) = o; *(u32x4*)(B.XC + (size_t)(tok0 + t) * 512 + chn) = o; } }
            __syncthreads();
            {   const int tb = wave & 3, ehf = wave >> 2;
                {
                    OPQ_IDS; const LAS unsigned char* act = ehf ? T3 + 3 * TS : T2;
#pragma unroll
                    for (int ks = 0; ks < 8; ++ks) { const bf16x8 a = *(const LAS bf16x8*)(MTL + (r32 & 7) * 528 + (ehf * 128 + 16 * ks + 8 * hh) * 2); const bf16x8 bx = row_frag(act, 32 * tb + r32, 16 * ks, hh); accg = MFMA32(a, bx, accg); } }
#pragma unroll 1
                for (int mtx = 0; mtx < 2; ++mtx) {
                    OPQ_IDS;
                    const LAS unsigned char* wt = mtx ? T1 : T0;
                    f32x16 acc[2];
#pragma unroll
                    for (int et = 0; et < 2; ++et)
#pragma unroll
                        for (int r = 0; r < 16; ++r) acc[et][r] = 0.f;
#pragma unroll
                    for (int ks = 0; ks < 8; ++ks) { const bf16x8 bx = row_frag(T2, 32 * tb + r32, 16 * ks, hh);
#pragma unroll
                        for (int et = 0; et < 2; ++et) { const bf16x8 a = row_frag(wt, 64 * ehf + 32 * et + r32, 16 * ks, hh); acc[et] = MFMA32(a, bx, acc[et]); } }
                    bf16_t* dst = (mtx == 0 ? B.Q : B.K) + (size_t)(tok0 + 32 * tb + r32) * 512 + h * 128 + 64 * ehf + 4 * hh;
#pragma unroll
                    for (int et = 0; et < 2; ++et)
#pragma unroll
                        for (int gq = 0; gq < 4; ++gq) { u32x2 w; w.x = pk2(acc[et][4 * gq], acc[et][4 * gq + 1]); w.y = pk2(acc[et][4 * gq + 2], acc[et][4 * gq + 3]); *(u32x2*)(dst + 32 * et + 8 * gq) = w; }
                }
            }
            __syncthreads();
            {   OPQ_IDS;
#pragma unroll
                for (int i = 0; i < 4; ++i) { const int ch = tid + 512 * i, row = ch >> 4, c = ch & 15; *(LAS u32x4*)(T0 + row * TS + c * 16) = pwv[i]; }
                const int hn = h < 3 ? h + 1 : 3; P1_LOADS_V(hn); }
            __syncthreads();
            {   OPQ_IDS; const int tb = wave & 3, ehf = wave >> 2;
                f32x16 acc[2];
#pragma unroll
                for (int et = 0; et < 2; ++et)
#pragma unroll
                    for (int r = 0; r < 16; ++r) acc[et][r] = 0.f;
#pragma unroll
                for (int ks = 0; ks < 8; ++ks) { const bf16x8 bx = row_frag(T3 + 3 * TS, 32 * tb + r32, 16 * ks, hh);
#pragma unroll
                    for (int et = 0; et < 2; ++et) { const bf16x8 a = row_frag(T0, 64 * ehf + 32 * et + r32, 16 * ks, hh); acc[et] = MFMA32(a, bx, acc[et]); } }
                bf16_t* dst = B.V + (size_t)(tok0 + 32 * tb + r32) * 512 + h * 128 + 64 * ehf + 4 * hh;
#pragma unroll
                for (int et = 0; et < 2; ++et)
#pragma unroll
                    for (int gq = 0; gq < 4; ++gq) { u32x2 w; w.x = pk2(acc[et][4 * gq], acc[et][4 * gq + 1]); w.y = pk2(acc[et][4 * gq + 2], acc[et][4 * gq + 3]); *(u32x2*)(dst + 32 * et + 8 * gq) = w; }
            }
        }
        __syncthreads();
        {   OPQ_IDS; const int tb = wave & 3, kh = wave >> 2;
#pragma unroll
            for (int r = 0; r < 4; ++r) SF[(kh * 8 + r + 4 * hh) * 128 + 32 * tb + r32] = accg[r];
        }
        __syncthreads();
        LAS float* IG = SG; LAS float* BC = SG + 512; LAS float* WG = SG + 1024;
        if (wave < 4) {
            OPQ_IDS; const int h = wave; float lf[2], ig[2];
#pragma unroll
            for (int e = 0; e < 2; ++e) { const int t = 2 * lane + e; ig[e] = SF[h * 128 + t] + SF[(8 + h) * 128 + t] + B.bif[h];
                const float fx = SF[(4 + h) * 128 + t] + SF[(12 + h) * 128 + t] + B.bif[4 + h]; lf[e] = fminf(fx, 0.f) - log1pf(expf(-fabsf(fx))); }
            float run = lf[0] + lf[1];
#pragma unroll
            for (int o = 1; o < 64; o <<= 1) { const float v = shup(run, o, lane); if (lane >= o) run += v; }
            const float b1 = run, b0 = run - lf[1];
            IG[h * 128 + 2 * lane] = ig[0]; IG[h * 128 + 2 * lane + 1] = ig[1]; BC[h * 128 + 2 * lane] = b0; BC[h * 128 + 2 * lane + 1] = b1;
            float* gt = B.GT + ((size_t)u * 4 + h) * 256;
            gt[2 * lane] = ig[0]; gt[2 * lane + 1] = ig[1]; gt[128 + 2 * lane] = b0; gt[128 + 2 * lane + 1] = b1;
            const float bl = shidx(b1, 63);
            float g0 = bl - b0 + ig[0], g1 = bl - b1 + ig[1]; float mloc = fmaxf(g0, g1);
#pragma unroll
            for (int o = 1; o < 64; o <<= 1) mloc = fmaxf(mloc, shx(mloc, o, lane));
            WG[h * 128 + 2 * lane] = expf(g0 - mloc); WG[h * 128 + 2 * lane + 1] = expf(g1 - mloc);
            if (lane == 0) { B.SC[u * 4 + h] = bl; B.SC[1024 + u * 4 + h] = mloc; }
        }
        u32x4 pfv[4], pfk[4];
        {   OPQ_IDS;
#pragma unroll
            for (int i = 0; i < 4; ++i) { const int ch = tid + 512 * i, row = ch >> 4, c = ch & 15; pfv[i] = *(const u32x4*)(B.V + (size_t)(tok0 + row) * 512 + c * 8); pfk[i] = *(const u32x4*)(B.K + (size_t)(tok0 + row) * 512 + c * 8); } }
#pragma unroll 1
        for (int h = 0; h < ((skip & 4) ? 0 : 4); ++h) {
            OPQ_IDS;
            __syncthreads();
#pragma unroll
            for (int i = 0; i < 4; ++i) { const int ch = tid + 512 * i, row = ch >> 4, c = ch & 15; const float wg = WG[h * 128 + row];
                const u32x4 v = pfv[i], k = pfk[i];
                u32x4 ov, ok; const float ksc = 0.08838834764831845f;
                ov.x = pk2(bf_lo(v.x) * wg, bf_hi(v.x) * wg); ov.y = pk2(bf_lo(v.y) * wg, bf_hi(v.y) * wg); ov.z = pk2(bf_lo(v.z) * wg, bf_hi(v.z) * wg); ov.w = pk2(bf_lo(v.w) * wg, bf_hi(v.w) * wg);
                ok.x = pk2(bf_lo(k.x) * ksc, bf_hi(k.x) * ksc); ok.y = pk2(bf_lo(k.y) * ksc, bf_hi(k.y) * ksc); ok.z = pk2(bf_lo(k.z) * ksc, bf_hi(k.z) * ksc); ok.w = pk2(bf_lo(k.w) * ksc, bf_hi(k.w) * ksc);
                *(LAS u32x4*)(T0 + row * TS + c * 16) = ov; *(LAS u32x4*)(T1 + row * TS + c * 16) = ok; }
            {   const int hn = h < 3 ? h + 1 : 3;
#pragma unroll
                for (int i = 0; i < 4; ++i) { const int ch = tid + 512 * i, row = ch >> 4, c = ch & 15; pfv[i] = *(const u32x4*)(B.V + (size_t)(tok0 + row) * 512 + hn * 128 + c * 8); pfk[i] = *(const u32x4*)(B.K + (size_t)(tok0 + row) * 512 + hn * 128 + c * 8); } }
            __syncthreads();
            const int vb = wave & 3, khf = wave >> 2;
            f32x16 acc[2];
#pragma unroll
            for (int kt = 0; kt < 2; ++kt)
#pragma unroll
                for (int r = 0; r < 16; ++r) acc[kt][r] = 0.f;
#pragma unroll
            for (int ks = 0; ks < 8; ++ks) { const bf16x8 a = tr_frag(T0, 16 * ks, 32 * vb, lane, false);
#pragma unroll
                for (int kt = 0; kt < 2; ++kt) { const bf16x8 bk = tr_frag(T1, 16 * ks, 64 * khf + 32 * kt, lane, false); acc[kt] = MFMA32(a, bk, acc[kt]); } }
            bf16_t* Uo = B.U + ((size_t)u * 4 + h) * 16384;
#pragma unroll
            for (int kt = 0; kt < 2; ++kt)
#pragma unroll
                for (int r = 0; r < 16; ++r) Uo[(32 * vb + crow(r, hh)) * 128 + 64 * khf + 32 * kt + r32] = f2bf(acc[kt][r]);
            {   const int kk = tid & 127, sq = tid >> 7; float a = 0.f;
                for (int s = sq * 32; s < sq * 32 + 32; ++s) a += WG[h * 128 + s] * bf2f(*(const LAS bf16_t*)(T1 + s * TS + kk * 2));
                SF[2048 + sq * 128 + kk] = a; }
            __syncthreads();
            if (tid < 128) B.UN[((size_t)u * 4 + h) * 128 + tid] = (SF[2048 + tid] + SF[2048 + 128 + tid]) + (SF[2048 + 256 + tid] + SF[2048 + 384 + tid]);
        }
    }
}
#undef OPQ_IDS
#undef P1_LOADS_A
#undef P1_LOADS_V
__device__ __forceinline__ void l0_scan(const L0Bufs& B, int blk, int tid) {
    const int bh = blk >> 3, part = blk & 7, b = bh >> 2, h = bh & 3, lane = tid & 63;
    const int e0 = part * 2048 + tid * 8;
    float zz = 0.f; asm volatile("" : "+v"(zz));
    f32x4 C0 = (f32x4){zz, zz, zz, zz}, C1 = C0; float nst = 0.f; float m = 0.f;
    const int unit0 = (b * 32) * 4 + h;
    const bool nrm = part == 0 && tid < 128;
    const float blv = lane < 32 ? B.SC[unit0 + 4 * lane] : 0.f, mlv = lane < 32 ? B.SC[1024 + unit0 + 4 * lane] : 0.f;
    u32x4 ub[8]; float un8[8];
#pragma unroll
    for (int j = 0; j < 8; ++j) { ub[j] = *(const u32x4*)(B.U + (size_t)(unit0 + 4 * j) * 16384 + e0); un8[j] = B.UN[(size_t)(unit0 + 4 * j) * 128 + (tid & 127)]; }
#pragma unroll
    for (int g = 0; g < 4; ++g) {
        u32x4 nb[8]; float nn[8];
#pragma unroll
        for (int j = 0; j < 8; ++j) { const int un1 = unit0 + 4 * (8 * (g < 3 ? g + 1 : 3) + j); nb[j] = *(const u32x4*)(B.U + (size_t)un1 * 16384 + e0); nn[j] = B.UN[(size_t)un1 * 128 + (tid & 127)]; }
#pragma unroll
        for (int j = 0; j < 8; ++j) { const int c = 8 * g + j, unit = unit0 + 4 * c; const u32x4 Unw = ub[j];
            const f32x4 U0 = (f32x4){bf_lo(Unw.x), bf_hi(Unw.x), bf_lo(Unw.y), bf_hi(Unw.y)}, U1 = (f32x4){bf_lo(Unw.z), bf_hi(Unw.z), bf_lo(Unw.w), bf_hi(Unw.w)};
            const float bl = __int_as_float(__builtin_amdgcn_readlane(__float_as_int(blv), c)), mloc = __int_as_float(__builtin_amdgcn_readlane(__float_as_int(mlv), c)), un = un8[j];
            u32x4 w; w.x = pk2(C0[0], C0[1]); w.y = pk2(C0[2], C0[3]); w.z = pk2(C1[0], C1[1]); w.w = pk2(C1[2], C1[3]); *(u32x4*)(B.CS + (size_t)unit * 16384 + e0) = w;
            if (nrm) B.NS[(size_t)unit * 128 + tid] = nst;
            if (part == 0 && tid == 0) B.SC[2048 + unit] = m;
            const float mn = fmaxf(bl + m, mloc), dec = expf(bl + m - mn), wu = expf(mloc - mn); m = mn;
            C0 = C0 * dec + U0 * wu; C1 = C1 * dec + U1 * wu;
            nst = nst * dec + wu * un; }
#pragma unroll
        for (int j = 0; j < 8; ++j) { ub[j] = nb[j]; un8[j] = nn[j]; }
    }
}
__device__ __forceinline__ void l0_mixC(LAS unsigned char* lds, const L0Bufs& B, int blk, int G) {
    const int tid0 = threadIdx.x, wave = __builtin_amdgcn_readfirstlane(tid0 >> 6);
    LAS unsigned char* TQ = lds; LAS unsigned char* TK = lds + 34816; LAS unsigned char* TV = lds + 2 * 34816; LAS unsigned char* TC = lds + 3 * 34816;
    LAS float* SF = (LAS float*)(lds + 4 * 34816);
    LAS float* AS = SF; LAS float* PM = SF + 128; LAS float* NP = SF + 256; LAS float* PS = SF + 384; LAS float* PQ = SF + 640; LAS float* NW = SF + 896;
    __syncthreads();
    { int tq = tid0; asm volatile("" : "+v"(tq)); if (tq < 256) ((LAS f32x4*)NW)[tq] = tq < 128 ? ((const f32x4*)B.nw)[tq] : ((const f32x4*)B.skip)[tq - 128]; }
    for (int uu = blk; uu < 256; uu += G) {
        const int tok0 = uu * 128;
        u32x4 pq[4], pk[4], pv[4], pc[4];
#define PC_LOADS(HN) do { _Pragma("unroll") for (int i = 0; i < 4; ++i) { const int ch = tid + 512 * i, row = ch >> 4, c = ch & 15; const size_t ro = (size_t)(tok0 + row) * 512 + (HN) * 128 + c * 8; \
            pq[i] = *(const u32x4*)(B.Q + ro); pk[i] = *(const u32x4*)(B.K + ro); pv[i] = *(const u32x4*)(B.V + ro); pc[i] = *(const u32x4*)(B.CS + (size_t)(uu * 4 + (HN)) * 16384 + (size_t)row * 128 + c * 8); } } while (0)
        { int tid = tid0; asm volatile("" : "+v"(tid)); PC_LOADS(0); }
#pragma unroll 1
        for (int h = 0; h < 4; ++h) {
            const int unit = uu * 4 + h;
            int tid = tid0; asm volatile("" : "+v"(tid));
            const int lane = tid & 63, r32 = lane & 31, hh = lane >> 5;
            __syncthreads();
#pragma unroll
            for (int i = 0; i < 4; ++i) { const int ch = tid + 512 * i, row = ch >> 4, c = ch & 15; *(LAS u32x4*)(TQ + row * TS + c * 16) = pq[i]; *(LAS u32x4*)(TV + row * TS + c * 16) = pv[i]; *(LAS u32x4*)(TC + row * TS + c * 16) = pc[i]; }
#pragma unroll
            for (int i = 0; i < 4; ++i) { const int ch = tid + 512 * i, row = ch >> 4, c = ch & 15; const u32x4 k = pk[i]; const float ksc = 0.08838834764831845f;
                u32x4 ok; ok.x = pk2(bf_lo(k.x) * ksc, bf_hi(k.x) * ksc); ok.y = pk2(bf_lo(k.y) * ksc, bf_hi(k.y) * ksc); ok.z = pk2(bf_lo(k.z) * ksc, bf_hi(k.z) * ksc); ok.w = pk2(bf_lo(k.w) * ksc, bf_hi(k.w) * ksc);
                *(LAS u32x4*)(TK + row * TS + c * 16) = ok; }
            { const int hn = h < 3 ? h + 1 : 3; PC_LOADS(hn); }
            const float mprev = B.SC[2048 + unit];
            if (wave == 0) {
                const float* gt = B.GT + (size_t)unit * 256;
                const float a0 = gt[2 * lane] - gt[128 + 2 * lane], a1 = gt[2 * lane + 1] - gt[128 + 2 * lane + 1];
                float run = fmaxf(a0, a1);
#pragma unroll
                for (int o = 1; o < 64; o <<= 1) { const float v = shup(run, o, lane); if (lane >= o) run = fmaxf(run, v); }
                const float prev = shup(run, 1, lane); const float p0 = fmaxf(lane > 0 ? fmaxf(prev, a0) : a0, mprev), p1 = fmaxf(run, mprev);
                AS[2 * lane] = a0; AS[2 * lane + 1] = a1; PM[2 * lane] = p0; PM[2 * lane + 1] = p1;
            }
            if (wave == 1) { NP[lane] = B.NS[(size_t)unit * 128 + lane]; NP[64 + lane] = B.NS[(size_t)unit * 128 + 64 + lane]; }
            __syncthreads();
            const int tb = wave & 3, vh = wave >> 2, t = 32 * tb + r32;
            const float pm = PM[t], bt = B.GT[(size_t)unit * 256 + 128 + t];
            f32x16 s[4];
#pragma unroll
            for (int st = 0; st < 4; ++st)
#pragma unroll
                for (int r = 0; r < 16; ++r) s[st][r] = 0.f;
            {   int lv = lane; asm volatile("" : "+v"(lv));
                const LAS unsigned char* qp = TQ + (32 * tb + (lv & 31)) * TS + (lv >> 5) * 16; const LAS unsigned char* kp = TK + (lv & 31) * TS + (lv >> 5) * 16;
#pragma unroll 2
                for (int ks = 0; ks < 8; ++ks) { const bf16x8 bq = *(const LAS bf16x8*)(qp + ks * 32);
#pragma unroll
                    for (int st = 0; st < 4; ++st) if (st <= tb) { const bf16x8 a = *(const LAS bf16x8*)(kp + st * 32 * TS + ks * 32); s[st] = MFMA32(a, bq, s[st]); } } }
            float nq = 0.f; u32x4 pf[4][2];
#pragma unroll
            for (int st = 0; st < 4; ++st) {
#pragma unroll
                for (int r = 0; r < 16; ++r) { const int sidx = 32 * st + crow(r, hh); const float wv = (sidx <= t) ? __builtin_amdgcn_exp2f((AS[sidx] - pm) * LOG2E) : 0.f; const float pv = s[st][r] * wv; s[st][r] = pv; nq += pv; }
#pragma unroll
                for (int sx = 0; sx < 2; ++sx) pf[st][sx] = (u32x4){pk2(s[st][8 * sx], s[st][8 * sx + 1]), pk2(s[st][8 * sx + 2], s[st][8 * sx + 3]), pk2(s[st][8 * sx + 4], s[st][8 * sx + 5]), pk2(s[st][8 * sx + 6], s[st][8 * sx + 7])};
            }
            nq = xhalf_sum(nq);
            float nqi = 0.f;
#pragma unroll
            for (int i = 0; i < 8; ++i) { const u32x4 qv = *(const LAS u32x4*)(TQ + t * TS + (64 * hh + 8 * i) * 2); const LAS float* np = NP + 64 * hh + 8 * i;
                nqi += bf_lo(qv.x) * np[0] + bf_hi(qv.x) * np[1] + bf_lo(qv.y) * np[2] + bf_hi(qv.y) * np[3] + bf_lo(qv.z) * np[4] + bf_hi(qv.z) * np[5] + bf_lo(qv.w) * np[6] + bf_hi(qv.w) * np[7]; }
            nqi = xhalf_sum(nqi);
            const float wst = __builtin_amdgcn_exp2f((mprev - pm) * LOG2E);
            const float den = fmaxf(fabsf(nq + wst * nqi), __builtin_amdgcn_exp2f(-(bt + pm) * LOG2E)), rden = 1.f / den;
            f32x16 ni[2], nx[2];
#pragma unroll
            for (int vt = 0; vt < 2; ++vt)
#pragma unroll
                for (int r = 0; r < 16; ++r) { ni[vt][r] = 0.f; nx[vt][r] = 0.f; }
            {   int lv = lane; asm volatile("" : "+v"(lv));
#pragma unroll
                for (int st = 0; st < 4; ++st) {
                    if (st <= tb) {
#pragma unroll
                        for (int sx = 0; sx < 2; ++sx) { const bf16x8 pb = __builtin_bit_cast(bf16x8, pf[st][sx]);
#pragma unroll
                            for (int vt = 0; vt < 2; ++vt) { const bf16x8 a = tr_frag(TV, 32 * st + 16 * sx, 64 * vh + 32 * vt, lv, true); ni[vt] = MFMA32(a, pb, ni[vt]); } }
                    }
                } }
            {   int lv = lane; asm volatile("" : "+v"(lv));
                const LAS unsigned char* qp = TQ + (32 * tb + (lv & 31)) * TS + (lv >> 5) * 16; const LAS unsigned char* cp = TC + (64 * vh + (lv & 31)) * TS + (lv >> 5) * 16;
#pragma unroll 2
                for (int ks = 0; ks < 8; ++ks) { const bf16x8 bq = *(const LAS bf16x8*)(qp + ks * 32);
#pragma unroll
                    for (int vt = 0; vt < 2; ++vt) { const bf16x8 a = *(const LAS bf16x8*)(cp + vt * 32 * TS + ks * 32); nx[vt] = MFMA32(a, bq, nx[vt]); } } }
            const size_t tok = (size_t)tok0 + t;
            u32x2 xcv[2][4], zv[2][4];
#pragma unroll
            for (int vt = 0; vt < 2; ++vt)
#pragma unroll
                for (int gq = 0; gq < 4; ++gq) { const int chn = h * 128 + 64 * vh + 32 * vt + 8 * gq + 4 * hh; xcv[vt][gq] = *(const u32x2*)(B.XC + tok * 512 + chn); zv[vt][gq] = *(const u32x2*)(B.BZ + tok * 512 + chn); }
            float hs = 0.f, hq = 0.f;
#pragma unroll
            for (int vt = 0; vt < 2; ++vt)
#pragma unroll
                for (int r = 0; r < 16; ++r) { const float hv = (ni[vt][r] + wst * nx[vt][r]) * rden; ni[vt][r] = hv; hs += hv; hq += hv * hv; }
            hs = xhalf_sum(hs); hq = xhalf_sum(hq);
            if (hh == 0) { PS[vh * 128 + t] = hs; PQ[vh * 128 + t] = hq; }
            __syncthreads();
            const float mean = (PS[t] + PS[128 + t]) * (1.f / 128.f);
            const float rstd = rsqrtf(fmaxf((PQ[t] + PQ[128 + t]) * (1.f / 128.f) - mean * mean, 0.f) + LN_EPS);
#pragma unroll
            for (int vt = 0; vt < 2; ++vt)
#pragma unroll
                for (int gq = 0; gq < 4; ++gq) { const int cl = 64 * vh + 32 * vt + 8 * gq + 4 * hh, chn = h * 128 + cl;
                    const f32x4 nw = *(const LAS f32x4*)(NW + chn), sk = *(const LAS f32x4*)(NW + 512 + chn); const u32x2 xc = xcv[vt][gq], z = zv[vt][gq];
                    const float y0 = ((ni[vt][4 * gq] - mean) * rstd * nw[0] + sk[0] * bf_lo(xc.x)) * silu_f(bf_lo(z.x)), y1 = ((ni[vt][4 * gq + 1] - mean) * rstd * nw[1] + sk[1] * bf_hi(xc.x)) * silu_f(bf_hi(z.x));
                    const float y2 = ((ni[vt][4 * gq + 2] - mean) * rstd * nw[2] + sk[2] * bf_lo(xc.y)) * silu_f(bf_lo(z.y)), y3 = ((ni[vt][4 * gq + 3] - mean) * rstd * nw[3] + sk[3] * bf_hi(xc.y)) * silu_f(bf_hi(z.y));
                    u32x2 w; w.x = pk2(y0, y1); w.y = pk2(y2, y3); *(u32x2*)(B.YM + tok * 1024 + 512 + chn) = w; }
        }
    }
}
constexpr size_t MB = 1048576ull;
constexpr size_t P_WIN_T = 0, P_WOUT_T = P_WIN_T + 4 * MB, P_WQKV_T = P_WOUT_T + 2 * MB, P_WO_T = P_WQKV_T + 3 * MB, P_XWQ_T = P_WO_T + 2 * MB, P_XWKV_T = P_XWQ_T + 4 * MB, P_XWO_T = P_XWKV_T + 8 * MB,
                 P_MLW_T = P_XWO_T + 4 * MB, P_WIFT = P_MLW_T + MB / 2, P_WRT = P_WIFT + MB / 8, P_ROT = P_WRT + MB / 2, P_BQK = P_ROT + MB, P_MEMB = P_BQK + MB / 8, P_KC = P_MEMB + 4 * MB, P_VT = P_KC + 8 * MB,
                 P_W13T = P_VT + 8 * MB, P_W2T = P_W13T + 64 * MB, P_XBF = P_W2T + 32 * MB, P_RT = P_XBF + 64 * MB, P_TMP = P_RT + 2 * MB;
constexpr size_t P_BAR = P_RT + 1572864;
constexpr size_t RT_SRC = 1638400;
constexpr size_t RT_E = 0, RT_W = 262144, RT_RANK = 2 * 262144, RT_DEST = 3 * 262144, RT_HIST = 4 * 262144, RT_TSTART = RT_HIST + 32768;
constexpr size_t T_QX = 0, T_OB = 64 * MB, T_YB = 128 * MB;
constexpr size_t T_K1 = 192 * MB, T_VT1 = 208 * MB;
constexpr size_t T_AU = 0, T_AV = 32 * MB, T_BX = 64 * MB, T_BZ = 96 * MB, T_V = 128 * MB, T_XC = 160 * MB, T_YM = 192 * MB, T_U = 256 * MB, T_CS = 320 * MB,
                 T_GT = 352 * MB, T_UN = 353 * MB, T_NS = 353 * MB + MB / 2, T_SC = 354 * MB, T_YB0 = 0;
constexpr size_t T_XG = 0, T_HM = 152 * MB, T_YG = 0;
constexpr size_t T_W13B = 228 * MB, T_W2B = 292 * MB;
constexpr size_t T_SLOT = 356 * MB;
constexpr size_t FAST_END = P_TMP + 360 * MB;
#if defined(PROBE_LNX) || defined(PROBE_LNV)
constexpr size_t SLOT_MB = 8;
#else
constexpr size_t SLOT_MB = 4;
#endif
constexpr int LDS_BYTES = 147456;

struct FP {
    const float* in[33]; float* X;
    unsigned char* ws;
};
typedef const float* const __attribute__((address_space(4)))* InTab;
struct PV { InTab in; float* X; unsigned char* ws; };
__device__ __forceinline__ PV make_pv(const FP& p0) {
    PV p; InTab kp = (InTab)__builtin_amdgcn_kernarg_segment_ptr(); asm volatile("" : "+s"(kp)); p.in = kp;
    p.X = p0.X; p.ws = p0.ws; asm volatile("" : "+s"(p.ws)); return p;
}
#define WSP(T, off) ((T*)(p.ws + (off)))

__device__ __forceinline__ RouteBufs route_bufs(const PV& p) {
    RouteBufs r; r.e = WSP(int, P_RT + RT_E); r.w = WSP(float, P_RT + RT_W); r.rank = WSP(int, P_RT + RT_RANK); r.dest = WSP(int, P_RT + RT_DEST); r.hist = WSP(int, P_RT + RT_HIST); r.tstart = WSP(int, P_RT + RT_TSTART); r.src = WSP(int, P_RT + RT_SRC); return r;
}
#define PH_ARGS const PV& p, LAS unsigned char* lds, int blk, int G
#define PH_IDS int tid_ = threadIdx.x; asm volatile("" : "+v"(tid_)); const int tid = tid_, lane = tid & 63, wave = __builtin_amdgcn_readfirstlane(tid >> 6); (void)lane; (void)wave;

__device__ __forceinline__ void ph_conv_xattn(PH_ARGS, int l, int& gw) {
    PH_IDS; LAS float* scr = (LAS float*)(lds + wave * 8448); const int ngw = G * NWAVE;
    convert_mats(p.in[23] + (size_t)l * 1024 * 1024, 1024, 1024, 1, 0, WSP(bf16_t, P_XWQ_T) + (size_t)l * 1024 * 1024, 0, RM_IDENT, 0.0625f, 1024, scr, gw, ngw, lane);
    convert_mats(p.in[24] + (size_t)l * 1024 * 2048, 1024, 2048, 1, 0, WSP(bf16_t, P_XWKV_T) + (size_t)l * 2048 * 1024, 0, RM_IDENT, 1.f, 0, scr, gw, ngw, lane);
    convert_mats(p.in[25] + (size_t)l * 1024 * 1024, 1024, 1024, 1, 0, WSP(bf16_t, P_XWO_T) + (size_t)l * 1024 * 1024, 0, RM_IDENT, 1.f, 0, scr, gw, ngw, lane);
    convert_rows(p.in[1], WSP(bf16_t, P_MEMB), (size_t)2048 * 1024, blk * NTHR + tid, G * NTHR);
}
__device__ __forceinline__ void conv_router_w(const PV& p, int l, int gt, int ngt) {
    bf16_t* wrt = WSP(bf16_t, P_WRT) + (size_t)l * 2 * 64 * 1024; const float* wre = p.in[28] + (size_t)l * 1024 * 32; const float* wrg = p.in[26] + (size_t)l * 1024 * 4;
    for (int i = gt; i < 64 * 1024; i += ngt) { const int r = i >> 10, k = i & 1023;
        const float v = r < 32 ? wre[k * 32 + r] : (r < 36 ? wrg[k * 4 + (r - 32)] : 0.f);
        const bf16_t h = f2bf(v); wrt[i] = h; wrt[64 * 1024 + i] = f2bf(v - bf2f(h)); }
}
__device__ __forceinline__ void conv_moe_waves(const PV& p, int l, LAS float* scr, int& gw, int ngw, int gt, int ngt, int lane) {
    const size_t wl = (size_t)l * 32 * 1024 * 512;
    convert_mats(p.in[30] + wl, 1024, 512, 32, (size_t)1024 * 512, WSP(bf16_t, P_W13T), (size_t)1024 * 1024, RM_PAIR0, 1.f, 0, scr, gw, ngw, lane);
    convert_mats(p.in[31] + wl, 1024, 512, 32, (size_t)1024 * 512, WSP(bf16_t, P_W13T), (size_t)1024 * 1024, RM_PAIR1, 1.f, 0, scr, gw, ngw, lane);
    convert_mats(p.in[32] + wl, 512, 1024, 32, (size_t)512 * 1024, WSP(bf16_t, P_W2T), (size_t)1024 * 512, RM_IDENT, 1.f, 0, scr, gw, ngw, lane);
    conv_router_w(p, l, gt, ngt);
}
#ifndef TAILQ_XA
#define TAILQ_XA 3
#endif
#ifndef TAILQ_G1
#define TAILQ_G1 4
#endif
#ifndef TAILQ_G2
#define TAILQ_G2 2
#endif
constexpr size_t P_CURSOR_OFF = 15360;
__device__ __forceinline__ void conv_moe1_item(const PV& p, unsigned it, LAS float* scr, int lane, f32x4 (&tv)[8], bool load) {
    const size_t wl = (size_t)32 * 1024 * 512;
    const int mat = it >> 13, r = it & 8191, bt = r >> 8, rr = r & 255;
    if (mat < 2) { const float* W = (mat == 0 ? p.in[30] : p.in[31]) + wl + (size_t)bt * 1024 * 512;
        if (load) ti_load(W, 512, rr >> 4, rr & 15, lane, tv); else ti_store(tv, 1024, WSP(bf16_t, P_TMP + T_W13B) + (size_t)bt * 1024 * 1024, scr, rr >> 4, rr & 15, lane, mat == 0 ? RM_PAIR0 : RM_PAIR1, 1.f, 0); }
    else { const float* W = p.in[32] + wl + (size_t)bt * 512 * 1024;
        if (load) ti_load(W, 1024, rr >> 5, rr & 31, lane, tv); else ti_store(tv, 512, WSP(bf16_t, P_TMP + T_W2B) + (size_t)bt * 1024 * 512, scr, rr >> 5, rr & 31, lane, RM_IDENT, 1.f, 0); }
}
__device__ __forceinline__ void conv_moe1_range(const PV& p, LAS float* scr, int lane, int first, int stride, int last) {
    if (last > 12288) last = 12288;
    if (first >= last) return;
    f32x4 ta[8], tb[8];
    conv_moe1_item(p, 2 * first, scr, lane, ta, true); conv_moe1_item(p, 2 * first + 1, scr, lane, tb, true);
    for (int it = first; it < last; it += stride) {
        const int nx = it + stride; f32x4 na[8], nb[8];
        const int nl = nx < last ? nx : it;
        conv_moe1_item(p, 2 * nl, scr, lane, na, true);
        conv_moe1_item(p, 2 * it, scr, lane, ta, false);
        conv_moe1_item(p, 2 * nl + 1, scr, lane, nb, true);
        conv_moe1_item(p, 2 * it + 1, scr, lane, tb, false);
#pragma unroll
        for (int i = 0; i < 8; ++i) { ta[i] = na[i]; tb[i] = nb[i]; }
    }
}
struct TailPlan { int t0, t1, t2, nidle, first_idle; };
__device__ __forceinline__ TailPlan tail_plan(int ntile, int G) {
    TailPlan t; const int U = ntile * 4, R = (U + G - 1) / G; t.first_idle = U - (R - 1) * G; t.nidle = G - t.first_idle;
    t.t0 = 128 * NWAVE * TAILQ_XA; t.t1 = t.nidle * NWAVE * TAILQ_G1; t.t2 = t.nidle * NWAVE * TAILQ_G2; return t;
}
__device__ __forceinline__ void ph_conv_moe(PH_ARGS, int l, int& gw) {
    PH_IDS; conv_moe_waves(p, l, (LAS float*)(lds + wave * 8448), gw, G * NWAVE, blk * NTHR + tid, G * NTHR, lane);
}
__device__ __forceinline__ void ph_x_to_bf(PH_ARGS) { PH_IDS; convert_rows(p.X, WSP(bf16_t, P_XBF), (size_t)NT * 1024, blk * NTHR + tid, G * NTHR); }

__device__ __forceinline__ void set_job(LAS pg8::JobDesc* jt, int j, const void* A, const void* B, int nM, int nN, void* out, int ldc, int mode, const void* bias = nullptr, const void* rot = nullptr, void* out2 = nullptr) {
    unsigned long long a = (unsigned long long)A, b = (unsigned long long)B, o = (unsigned long long)out, bi = (unsigned long long)bias, ro = (unsigned long long)rot, o2 = (unsigned long long)out2;
    asm volatile("" : "+s"(a), "+s"(b), "+s"(o), "+s"(bi), "+s"(ro), "+s"(o2), "+s"(nM), "+s"(nN), "+s"(ldc), "+s"(mode));
    LAS pg8::JobDesc* d = jt + j; d->A = a; d->B = b; d->out = o; d->bias = bi; d->rot = ro; d->out2 = o2;
    d->nM = nM; d->nN = nN; d->ldc = ldc; d->mode = mode;
}
#define JT_PTR ((LAS pg8::JobDesc*)(lds + pg8::JT_OFF))
__device__ __forceinline__ void run_jobs(LAS unsigned char* lds, int K, int n0, int n1, int n2, int blk, int G) {
    __syncthreads();
    pg8::Jobs3 S; S.jt = JT_PTR; S.n0 = n0; S.n1 = n1; S.n2 = n2; S.K = K; S.G = G; S.c = blk;
    EpiMulti E; E.jt = JT_PTR;
    pg8::gemm_phase<EpiMulti, pg8::Jobs3, true, true>(lds, K, S, E);
}
__device__ __forceinline__ void ph_xattn_g1(PH_ARGS, int l) {
    const bf16_t* wkv = WSP(bf16_t, P_XWKV_T) + (size_t)l * 2048 * 1024;
    __syncthreads();
    if (threadIdx.x == 0) {
        set_job(JT_PTR, 0, WSP(bf16_t, P_MEMB), wkv, 8, 4, WSP(bf16_t, P_KC) + (size_t)l * 2048 * 1024, 1024, EM_PLAIN);
        set_job(JT_PTR, 1, wkv + (size_t)1024 * 1024, WSP(bf16_t, P_MEMB), 4, 8, WSP(bf16_t, P_VT) + (size_t)l * 1024 * 2048, 2048, EM_PLAIN);
        set_job(JT_PTR, 2, WSP(bf16_t, P_XBF), WSP(bf16_t, P_XWQ_T) + (size_t)l * 1024 * 1024, 128, 4, WSP(bf16_t, P_TMP + T_QX), 1024, EM_PLAIN);
    }
    run_jobs(lds, 1024, 32, 32, 512, blk, G);
}
__device__ __forceinline__ void ph_xattn_attn(PH_ARGS, int l) {
    xattn_phase(lds, WSP(bf16_t, P_TMP + T_QX), WSP(bf16_t, P_KC) + (size_t)l * 2048 * 1024, WSP(bf16_t, P_VT) + (size_t)l * 1024 * 2048, WSP(bf16_t, P_TMP + T_OB), blk, G);
}
__device__ __forceinline__ void ph_gemm_plain(PH_ARGS, const bf16_t* A, const bf16_t* Bt, bf16_t* out) {
    __syncthreads();
    if (threadIdx.x == 0) set_job(JT_PTR, 0, A, Bt, 128, 4, out, 1024, EM_PLAIN);
    run_jobs(lds, 1024, 512, 0, 0, blk, G);
}
template <bool XF32, bool OUTF32, bool MOE>
__device__ __forceinline__ void ph_ln(PH_ARGS, const bf16_t* y, int lnidx, bool dry = false) {
    PH_IDS; LnArgs a; a.xin32 = p.in[0]; a.xin = WSP(bf16_t, P_XBF); a.xout32 = dry ? WSP(float, P_TMP + 200 * MB) : p.X; a.xbf = dry ? WSP(bf16_t, P_TMP + 288 * MB) : WSP(bf16_t, P_XBF); a.y = y; a.g = p.in[2] + lnidx * 1024; a.b = p.in[3] + lnidx * 1024;
    a.dest = WSP(int, P_RT + RT_DEST); a.wts = WSP(float, P_RT + RT_W);
    ln_phase<XF32, OUTF32, MOE>(a, blk, G, wave, lane);
}
__device__ __forceinline__ void ph_moe_route(PH_ARGS, int l) {
    moe_router_phase(lds, WSP(bf16_t, P_XBF), WSP(bf16_t, P_WRT) + (size_t)l * 2 * 64 * 1024, p.in[27] + l * 4, p.in[29] + l * 32, route_bufs(p), blk);
}
__device__ __forceinline__ void ph_moe_scatter(PH_ARGS) { moe_scatter_phase(lds, route_bufs(p), blk, G); }
__device__ __forceinline__ void ph_moe_g1(PH_ARGS) {
    __syncthreads();
    if (threadIdx.x == 0) set_job(JT_PTR, 0, nullptr, nullptr, 0, 0, WSP(bf16_t, P_TMP + T_HM), 512, EM_SWIGLU);
    __syncthreads();
    MoeSched S; S.A = (const char*)WSP(bf16_t, P_TMP + T_XG); S.B = (const char*)WSP(bf16_t, P_W13T); S.tstart = WSP(int, P_RT + RT_TSTART); S.K = 1024; S.nN = 4; S.G = G; S.c = blk; S.bexp = (size_t)1024 * 1024 * 2;
    EpiMulti E; E.jt = JT_PTR;
    pg8::gemm_phase<EpiMulti, MoeSched, true, true>(lds, 1024, S, E);
}
__device__ __forceinline__ void ph_moe_g2(PH_ARGS) {
    __syncthreads();
    if (threadIdx.x == 0) set_job(JT_PTR, 0, nullptr, nullptr, 0, 0, WSP(bf16_t, P_TMP + T_YG), 1024, EM_PLAIN);
    __syncthreads();
    MoeSched S; S.A = (const char*)WSP(bf16_t, P_TMP + T_HM); S.B = (const char*)WSP(bf16_t, P_W2T); S.tstart = WSP(int, P_RT + RT_TSTART); S.K = 512; S.nN = 4; S.G = G; S.c = blk; S.bexp = (size_t)1024 * 512 * 2;
    EpiMulti E; E.jt = JT_PTR;
    pg8::gemm_phase<EpiMulti, MoeSched, true, true>(lds, 512, S, E);
}

__device__ __forceinline__ void ph_conv_l1(PH_ARGS, int& gw) {
    PH_IDS; LAS float* scr = (LAS float*)(lds + wave * 8448); const int ngw = G * NWAVE;
    convert_mats(p.in[19], 1024, 1536, 1, 0, WSP(bf16_t, P_WQKV_T), 0, RM_ROT, 0.125f, 1024, scr, gw, ngw, lane);
    convert_mats(p.in[22], 1024, 1024, 1, 0, WSP(bf16_t, P_WO_T), 0, RM_IDENT, 1.f, 0, scr, gw, ngw, lane);
    const int gt = blk * NTHR + tid, ngt = G * NTHR;
    float* bqk = WSP(float, P_BQK);
    for (int n = gt; n < 1280; n += ngt) bqk[rowmap(RM_ROT, n)] = p.in[20][n] * (n < 1024 ? 0.125f : 1.f);
    float* rot = WSP(float, P_ROT);
    for (int i = gt; i < 4096 * 32; i += ngt) { const int pos = i >> 5, k = i & 31; const float inv = powf(10000.f, -(float)(2 * k) / 64.f); const float ang = (float)pos * inv; rot[2 * i] = cosf(ang); rot[2 * i + 1] = sinf(ang); }
}
__device__ __forceinline__ void ph_l1_g1(PH_ARGS) {
    __syncthreads();
    if (threadIdx.x == 0) {
        set_job(JT_PTR, 0, WSP(bf16_t, P_XBF), WSP(bf16_t, P_WQKV_T), 128, 5, WSP(bf16_t, P_TMP + T_QX), 1024, EM_ROTARY, WSP(float, P_BQK), WSP(float, P_ROT), WSP(bf16_t, P_TMP + T_K1));
        set_job(JT_PTR, 1, WSP(bf16_t, P_WQKV_T) + (size_t)1280 * 1024, WSP(bf16_t, P_XBF), 1, 128, WSP(bf16_t, P_TMP + T_VT1), NT, EM_ROWBIAS, p.in[20] + 1280);
    }
    run_jobs(lds, 1024, 640, 128, 0, blk, G);
}
__device__ __forceinline__ void ph_l1_swa(PH_ARGS) {
    swa_phase(lds, WSP(bf16_t, P_TMP + T_QX), WSP(bf16_t, P_TMP + T_K1), WSP(bf16_t, P_TMP + T_VT1), p.in[21], WSP(bf16_t, P_TMP + T_OB), blk, G);
}

__device__ __forceinline__ L0Bufs l0_bufs(const PV& p) {
    L0Bufs B; B.AU = WSP(bf16_t, P_TMP + T_AU); B.AV = WSP(bf16_t, P_TMP + T_AV); B.BX = WSP(bf16_t, P_TMP + T_BX); B.BZ = WSP(bf16_t, P_TMP + T_BZ); B.V = WSP(bf16_t, P_TMP + T_V); B.XC = WSP(bf16_t, P_TMP + T_XC);
    B.YM = WSP(bf16_t, P_TMP + T_YM); B.CS = WSP(bf16_t, P_TMP + T_CS); B.U = WSP(bf16_t, P_TMP + T_U); B.GT = WSP(float, P_TMP + T_GT); B.UN = WSP(float, P_TMP + T_UN); B.NS = WSP(float, P_TMP + T_NS); B.SC = WSP(float, P_TMP + T_SC);
    B.Q = B.AU; B.K = B.AV;
    B.WQT = WSP(bf16_t, P_MLW_T); B.GMW = WSP(bf16_t, P_MLW_T) + 12 * 16384; B.MT = WSP(bf16_t, P_WIFT);
    B.gm_g = p.in[5]; B.gm_b = p.in[6]; B.gm_bs = p.in[8]; B.cw = p.in[9]; B.cb = p.in[10]; B.bif = p.in[15]; B.nw = p.in[16]; B.skip = p.in[17]; return B;
}
__device__ __forceinline__ void ph_scan_conv(PH_ARGS) {
    PH_IDS;
    if (wave < 4) l0_scan(l0_bufs(p), blk, tid);
}
__device__ __forceinline__ void ph_conv_l0(PH_ARGS, int& gwr) {
    PH_IDS; LAS float* scr = (LAS float*)(lds + wave * 8448); const int gw = blk * NWAVE + wave, ngw = G * NWAVE;
    convert_mats(p.in[4], 1024, 2048, 1, 0, WSP(bf16_t, P_WIN_T), 0, RM_IDENT, 1.f, 0, scr, gwr, ngw, lane);
    convert_mats(p.in[18], 1024, 1024, 1, 0, WSP(bf16_t, P_WOUT_T), 0, RM_IDENT, 1.f, 0, scr, gwr, ngw, lane);
    convert_mats(p.in[11], 128, 128, 4, 16384, WSP(bf16_t, P_MLW_T), 16384, RM_IDENT, 1.f, 0, scr, gwr, ngw, lane);
    convert_mats(p.in[12], 128, 128, 4, 16384, WSP(bf16_t, P_MLW_T) + 4 * 16384, 16384, RM_IDENT, 1.f, 0, scr, gwr, ngw, lane);
    convert_mats(p.in[13], 128, 128, 4, 16384, WSP(bf16_t, P_MLW_T) + 8 * 16384, 16384, RM_IDENT, 1.f, 0, scr, gwr, ngw, lane);
    const int gt = blk * NTHR + tid, ngt = G * NTHR;
    bf16_t* gmw = WSP(bf16_t, P_MLW_T) + 12 * 16384;
    for (int i = gt; i < 4 * 16384; i += ngt) { const int t = (i >> 7) & 127, sidx = i & 127; gmw[i] = f2bf(sidx <= t ? p.in[7][i] : 0.f); }
    bf16_t* mt = WSP(bf16_t, P_WIFT);
    for (int i = gw; i < 4 * 8 * 256; i += ngw) { const int h = i >> 11, g = (i >> 8) & 7, j = i & 255, d = j & 127; float a = 0.f;
        for (int e = lane; e < 128; e += 64) {
            if (j < 128) a += p.in[11][((size_t)h * 128 + d) * 128 + e] * p.in[14][(h * 128 + e) * 8 + g] + p.in[12][((size_t)h * 128 + d) * 128 + e] * p.in[14][(512 + h * 128 + e) * 8 + g];
            else a += p.in[13][((size_t)h * 128 + d) * 128 + e] * p.in[14][(1024 + h * 128 + e) * 8 + g]; }
        a += shx(a, 32, lane); a += shx(a, 16, lane); a += shx(a, 8, lane); a += shx(a, 4, lane); a += shx(a, 2, lane); a += shx(a, 1, lane);
        if (lane == 0) mt[i] = f2bf(a); }
}
__device__ __forceinline__ void ph_xin_to_bf(PH_ARGS) { PH_IDS; convert_rows(p.in[0], WSP(bf16_t, P_XBF), (size_t)NT * 1024, blk * NTHR + tid, G * NTHR); }
__device__ __forceinline__ void ph_l0_g1(PH_ARGS) {
    __syncthreads();
    if (threadIdx.x == 0) set_job(JT_PTR, 0, WSP(bf16_t, P_XBF), WSP(bf16_t, P_WIN_T), 128, 8, WSP(bf16_t, P_TMP + T_AU), 512, EM_GELU4);
    run_jobs(lds, 1024, 1024, 0, 0, blk, G);
}

enum { K_CONV_XATTN = 0, K_CONV_MOE, K_X2BF, K_XATTN_G1, K_XATTN_ATTN, K_XATTN_G2, K_LN_Y, K_MOE_ROUTE, K_MOE_SCATTER, K_MOE_G1, K_MOE_G2, K_LN_MOE, K_CONV_L1, K_L1_G1, K_L1_SWA, K_L1_G2, K_CONV_L0, K_XIN2BF, K_L0_G1, K_L0_MIXA, K_L0_SCAN, K_L0_MIXC, K_L0_G2, K_LN_Y0 };
template <int PH>
__global__ void __launch_bounds__(NTHR, 2) k_phase(FP p0, int l, int lnidx) {
    const PV p = make_pv(p0);
    extern __shared__ __attribute__((aligned(16))) unsigned char smem[];
    LAS unsigned char* lds = (LAS unsigned char*)smem;
    const int blk = blockIdx.x, G = gridDim.x;
    if constexpr (PH == K_CONV_XATTN) { int gwr = blk * NWAVE + (threadIdx.x >> 6); ph_conv_xattn(p, lds, blk, G, l, gwr); }
    if constexpr (PH == K_CONV_MOE) { int gwr = blk * NWAVE + (threadIdx.x >> 6); ph_conv_moe(p, lds, blk, G, l, gwr); }
    if constexpr (PH == K_X2BF) ph_x_to_bf(p, lds, blk, G);
    if constexpr (PH == K_XATTN_G1) ph_xattn_g1(p, lds, blk, G, l);
    if constexpr (PH == K_XATTN_ATTN) ph_xattn_attn(p, lds, blk, G, l);
    if constexpr (PH == K_XATTN_G2) ph_gemm_plain(p, lds, blk, G, WSP(bf16_t, P_TMP + T_OB), WSP(bf16_t, P_XWO_T) + (size_t)l * 1024 * 1024, WSP(bf16_t, P_TMP + T_YB));
    if constexpr (PH == K_LN_Y) ph_ln<false, false, false>(p, lds, blk, G, WSP(bf16_t, P_TMP + T_YB), lnidx);
    if constexpr (PH == K_MOE_ROUTE) ph_moe_route(p, lds, blk, G, l);
    if constexpr (PH == K_MOE_SCATTER) ph_moe_scatter(p, lds, blk, G);
    if constexpr (PH == K_MOE_G1) ph_moe_g1(p, lds, blk, G);
    if constexpr (PH == K_MOE_G2) ph_moe_g2(p, lds, blk, G);
    if constexpr (PH == K_LN_MOE) ph_ln<false, false, true>(p, lds, blk, G, WSP(bf16_t, P_TMP + T_YG), lnidx);
    if constexpr (PH == K_CONV_L0) { int gwr = blk * NWAVE + (threadIdx.x >> 6); ph_conv_l0(p, lds, blk, G, gwr); }
    if constexpr (PH == K_XIN2BF) ph_xin_to_bf(p, lds, blk, G);
    if constexpr (PH == K_L0_G1) ph_l0_g1(p, lds, blk, G);
    if constexpr (PH == K_L0_MIXA) l0_mixA(lds, l0_bufs(p), blk, G);
    if constexpr (PH == K_L0_SCAN) ph_scan_conv(p, lds, blk, G);
    if constexpr (PH == K_L0_MIXC) l0_mixC(lds, l0_bufs(p), blk, G);
    if constexpr (PH == K_L0_G2) ph_gemm_plain(p, lds, blk, G, WSP(bf16_t, P_TMP + T_YM), WSP(bf16_t, P_WOUT_T), WSP(bf16_t, P_TMP + T_YB0));
    if constexpr (PH == K_LN_Y0) ph_ln<true, false, false>(p, lds, blk, G, WSP(bf16_t, P_TMP + T_YB0), 0);
    if constexpr (PH == K_CONV_L1) { int gwr = blk * NWAVE + (threadIdx.x >> 6); ph_conv_l1(p, lds, blk, G, gwr); }
    if constexpr (PH == K_L1_G1) ph_l1_g1(p, lds, blk, G);
    if constexpr (PH == K_L1_SWA) ph_l1_swa(p, lds, blk, G);
    if constexpr (PH == K_L1_G2) ph_gemm_plain(p, lds, blk, G, WSP(bf16_t, P_TMP + T_OB), WSP(bf16_t, P_WO_T), WSP(bf16_t, P_TMP + T_YB));
}

#define XB_TMO      128
#define XB_XCNT(j)  (256  + 64 * (j))
#define XB_XSUB(j)  (1280 + 64 * (j))
#define XB_XGEN(j)  (2304 + 64 * (j))
#define XB_TOP      3328
#define XB_TOPGEN   3392
#define XCD_BAR_WORDS 3456
#define XB_SPIN_CAP (1u << 22)
__device__ __forceinline__ unsigned xb_ld(unsigned* p)              { return __hip_atomic_load(p, __ATOMIC_RELAXED, __HIP_MEMORY_SCOPE_AGENT); }
__device__ __forceinline__ unsigned xb_add(unsigned* p, unsigned v) { return __hip_atomic_fetch_add(p, v, __ATOMIC_RELAXED, __HIP_MEMORY_SCOPE_AGENT); }
__device__ __forceinline__ unsigned xb_xcc_id() { return (unsigned)__builtin_amdgcn_s_getreg((3 << 11) | 20) & 0xFu; }
#define XB_SPIN(cond, bar) do { unsigned _sp = 0; while (cond) { __builtin_amdgcn_s_sleep(1); \
    if ((++_sp & 255u) == 0u) { if (xb_ld(&(bar)[XB_TMO])) break; if (_sp > XB_SPIN_CAP) { atomicAdd(&(bar)[XB_TMO], 1u); break; } } } } while (0)
struct XcdBarrier { unsigned* bar; unsigned x; volatile LAS unsigned* st; };
__device__ __forceinline__ XcdBarrier xcd_barrier_post(unsigned* bar, volatile LAS unsigned* st) {
    XcdBarrier b; b.bar = bar; b.x = xb_xcc_id(); b.st = st;
    if (threadIdx.x == 0) (void)xb_add(&bar[XB_XCNT(b.x)], 1u);
    return b;
}
__device__ __forceinline__ void xcd_barrier_complete(unsigned* bar, unsigned x, unsigned& nloc, unsigned& nx) {
    const unsigned G = gridDim.x * gridDim.y * gridDim.z;
    unsigned sum, cnt, mine, sp = 0u;
    for (;;) {
        sum = 0u; cnt = 0u; mine = 0u;
#pragma unroll
        for (unsigned j = 0; j < 16; ++j) { const unsigned c = xb_ld(&bar[XB_XCNT(j)]); sum += c; cnt += (c > 0u) ? 1u : 0u; mine = (j == x) ? c : mine; }
        if (sum == G) break;
        __builtin_amdgcn_s_sleep(1);
        if ((++sp & 255u) == 0u) { if (xb_ld(&bar[XB_TMO])) break; if (sp > XB_SPIN_CAP) { atomicAdd(&bar[XB_TMO], 1u); break; } }
    }
    nloc = mine > 0u ? mine : 1u; nx = cnt > 0u ? cnt : 1u;
}
__device__ __forceinline__ void xcd_barrier(const XcdBarrier& b) {
    asm volatile("s_waitcnt vmcnt(0)" ::: "memory");
    __syncthreads();
    if (threadIdx.x == 0) {
        unsigned* bar = b.bar; asm volatile("" : "+s"(bar));
        __builtin_amdgcn_s_waitcnt(0);
        unsigned nloc = b.st[0], nx = b.st[1];
        if (nloc == 0u) { xcd_barrier_complete(bar, b.x, nloc, nx); b.st[0] = nloc; b.st[1] = nx; }
        const unsigned old = xb_add(&bar[XB_XSUB(b.x)], 1u);
        const unsigned gen = old / nloc;
        if (old + 1u == (gen + 1u) * nloc) {
            __builtin_amdgcn_fence(__ATOMIC_RELEASE, "agent");
            asm volatile("s_waitcnt vmcnt(0)" ::: "memory");
            const unsigned og = xb_add(&bar[XB_TOP], 1u);
            const unsigned tg = og / nx;
            if (og + 1u == (tg + 1u) * nx) xb_add(&bar[XB_TOPGEN], 1u);
            else XB_SPIN(xb_ld(&bar[XB_TOPGEN]) == tg, bar);
            __builtin_amdgcn_fence(__ATOMIC_ACQUIRE, "agent");
            asm volatile("s_waitcnt vmcnt(0)" ::: "memory");
        } else {
            XB_SPIN(xb_ld(&bar[XB_TOPGEN]) == gen, bar);
            __builtin_amdgcn_fence(__ATOMIC_ACQUIRE, "agent");
            asm volatile("s_waitcnt vmcnt(0)" ::: "memory");
        }
    }
    __syncthreads();
}
constexpr int LDS_BARW = LDS_BYTES - 16;

struct SchedAll {
    const LAS pg8::JobDesc* jt; int n0, n1, n2, n3, n4; int K, G, c; int moe; const char* A; const char* B; const int* tstart; const int* src; int nN; size_t bexp;
    __device__ __forceinline__ pg8::Unit get(int i, bool& ok) const {
        const char* ua = nullptr; const char* ub = nullptr; const int* us = nullptr; int upm = 0, upn = 0, ujob = 0; bool good = false;
        if (moe) {
            const int vc = (c & 7) * (G >> 3) + (c >> 3);
            const long L = (long)i * G + vc; const int ntile = tstart[32];
            if (L < (long)ntile * nN) {
                const int mt = (int)(L / nN), nt = (int)(L % nN);
                int e = 0;
                for (int k = 1; k < 32; ++k) if (tstart[k] <= mt) e = k;
                ua = src ? A : A + (size_t)mt * 256 * K * 2; us = src ? src + mt * 256 : nullptr; ub = B + (size_t)e * bexp + (size_t)nt * 256 * K * 2; upm = mt; upn = nt; good = true;
            }
        } else {
            long L = (long)i * G + c;
            if (L < (long)n0 + n1 + n2 + n3 + n4) {
                int l = (int)L; int jb = 0;
                if (l >= n0) { l -= n0; jb = 1; if (l >= n1) { l -= n1; jb = 2; if (l >= n2) { l -= n2; jb = 3; if (l >= n3) { l -= n3; jb = 4; } } } }
                const int jM = __builtin_amdgcn_readfirstlane(jt[jb].nM), jN = __builtin_amdgcn_readfirstlane(jt[jb].nN);
                int pm, pn; pg8::tile_order(l, jM, jN, pm, pn);
                const size_t tstep = (size_t)pg8::BM * K * 2;
                ua = (const char*)pg8::rfl64(jt[jb].A) + (size_t)pm * tstep; ub = (const char*)pg8::rfl64(jt[jb].B) + (size_t)pn * tstep; upm = pm; upn = pn; ujob = jb; good = true;
            }
        }
        pg8::Unit u; u.A = ua; u.B = ub; u.src = us; u.pm = upm; u.pn = upn; u.job = ujob; ok = good; return u;
    }
};
enum { MP_CONV = 0, MP_L0_G1, MP_L0_MIXA, MP_L0_SCAN, MP_L0_MIXC, MP_L0_G2, MP_XA_G1, MP_XA_ATTN, MP_XA_G2, MP_ROUTE, MP_SCATTER, MP_MOE_G1, MP_MOE_G2, MP_LN_MOE, MP_L1_G1, MP_L1_SWA, MP_L1_G2 };
struct SchedLN {
    const char* A; const char* B; int G, c;
    __device__ __forceinline__ pg8::Unit get(int i, bool& ok) const {
        const int L = i * G + c; const bool good = L < 512; int pm = 0, pn = 0; if (good) pg8::tile_order(L, 128, 4, pm, pn);
        const size_t tstep = (size_t)pg8::BM * 1024 * 2;
        pg8::Unit u; u.A = A + (size_t)pm * tstep; u.B = B + (size_t)pn * tstep; u.src = nullptr; u.pm = pm; u.pn = pn; u.job = 0; ok = good; return u;
    }
};
__device__ __forceinline__ int prog_kind(int i) {
    switch (i) { case 0: return MP_CONV; case 1: return MP_L0_G1; case 2: return MP_L0_MIXA; case 3: return MP_L0_SCAN; case 4: return MP_L0_MIXC; case 5: return MP_L0_G2;
        case 6: case 17: return MP_XA_G1; case 7: case 18: return MP_XA_ATTN; case 8: case 19: return MP_XA_G2; case 9: case 20: return MP_ROUTE; case 10: case 21: return MP_SCATTER;
        case 11: case 22: return MP_MOE_G1; case 12: case 23: return MP_MOE_G2; case 13: case 24: return MP_LN_MOE; case 14: return MP_L1_G1; case 15: return MP_L1_SWA; default: return MP_L1_G2; }
}
constexpr int N_PROG = 25;
__global__ void __launch_bounds__(NTHR, 2) mega(FP p0) {
    extern __shared__ __attribute__((aligned(16))) unsigned char smem[];
    LAS unsigned char* lds = (LAS unsigned char*)smem;
    cooperative_groups::grid_group grid = cooperative_groups::this_grid();
    const int blk0 = blockIdx.x, G0 = gridDim.x;
    volatile LAS unsigned* bst = (volatile LAS unsigned*)(lds + LDS_BARW);
    if (threadIdx.x == 0) { bst[0] = 0u; bst[1] = 0u; }
    __syncthreads();
    const XcdBarrier xbar = xcd_barrier_post((unsigned*)(p0.ws + P_BAR), bst);
    int dup = 0; (void)dup;
#pragma unroll 1
    for (int pi = 0; pi < N_PROG; ++pi) {
        int blk = blk0, G = G0; asm volatile("" : "+s"(blk), "+s"(G));
        const PV p = make_pv(p0);
        const int kind = prog_kind(pi), l = pi >= 14 ? 1 : 0;
        const bool is_gemm = kind == MP_L0_G1 || kind == MP_XA_G1 || kind == MP_MOE_G1 || kind == MP_MOE_G2 || kind == MP_L1_G1;
        const bool is_lnf = kind == MP_L0_G2 || kind == MP_XA_G2 || kind == MP_L1_G2;
        if (is_lnf) {
            const int site = kind == MP_L0_G2 ? 0 : (kind == MP_L1_G2 ? 2 : 1 + 2 * l), lnidx = kind == MP_L0_G2 ? 0 : (kind == MP_L1_G2 ? 3 : 1 + 3 * l);
            SchedLN S; S.G = G; S.c = blk;
            S.A = (const char*)(kind == MP_L0_G2 ? WSP(bf16_t, P_TMP + T_YM) : WSP(bf16_t, P_TMP + T_OB));
            S.B = (const char*)(kind == MP_L0_G2 ? WSP(bf16_t, P_WOUT_T) : (kind == MP_L1_G2 ? WSP(bf16_t, P_WO_T) : WSP(bf16_t, P_XWO_T) + (size_t)l * 1024 * 1024));
            __syncthreads();
            #ifdef PROBE_LNV
            const int drym = __builtin_amdgcn_readfirstlane((dup == 0 && (((PROBE_MASK) >> kind) & 1)) ? 1 : 0);
#else
            const int drym = 0;
#endif
            unsigned long long* slp = WSP(unsigned long long, P_TMP + T_SLOT) + (size_t)(site + 4 * drym) * 131072;
            if (threadIdx.x == 0) set_job(JT_PTR, 0, nullptr, nullptr, 128, 4, WSP(bf16_t, P_XBF), 1024, 0, p.in[2] + lnidx * 1024, p.in[3] + lnidx * 1024, nullptr);
            if (threadIdx.x == 0) { JT_PTR->mode = drym; JT_PTR->out2 = (unsigned long long)slp; }
            EpiLN E; E.lds = lds;
            __syncthreads();
            pg8::gemm_phase<EpiLN, SchedLN, true, true>(lds, 1024, S, E);
        } else if (is_gemm) {
            SchedAll S; S.jt = JT_PTR; S.n0 = S.n1 = S.n2 = S.n3 = S.n4 = 0; S.K = 1024; S.G = G; S.c = blk; S.moe = 0; S.A = S.B = nullptr; S.tstart = WSP(int, P_RT + RT_TSTART); S.src = nullptr; S.nN = 4; S.bexp = 0;
            __syncthreads();
            if (threadIdx.x == 0) {
                if (kind == MP_L0_G1) set_job(JT_PTR, 0, WSP(bf16_t, P_XBF), WSP(bf16_t, P_WIN_T), 128, 8, WSP(bf16_t, P_TMP + T_AU), 512, EM_GELU4);
                if (kind == MP_XA_G1) {
                    set_job(JT_PTR, 0, WSP(bf16_t, P_XBF), WSP(bf16_t, P_XWQ_T) + (size_t)l * 1024 * 1024, 128, 4, WSP(bf16_t, P_TMP + T_QX), 1024, EM_PLAIN);
                    if (l == 0) { for (int ll = 0; ll < 2; ++ll) { const bf16_t* wkv = WSP(bf16_t, P_XWKV_T) + (size_t)ll * 2048 * 1024;
                        set_job(JT_PTR, 1 + 2 * ll, WSP(bf16_t, P_MEMB), wkv, 8, 4, WSP(bf16_t, P_KC) + (size_t)ll * 2048 * 1024, 1024, EM_PLAIN);
                        set_job(JT_PTR, 2 + 2 * ll, wkv + (size_t)1024 * 1024, WSP(bf16_t, P_MEMB), 4, 8, WSP(bf16_t, P_VT) + (size_t)ll * 1024 * 2048, 2048, EM_PLAIN); } } }
                if (kind == MP_MOE_G1) set_job(JT_PTR, 0, nullptr, nullptr, 0, 0, WSP(bf16_t, P_TMP + T_HM), 512, EM_SWIGLU);
                if (kind == MP_MOE_G2) set_job(JT_PTR, 0, nullptr, nullptr, 0, 0, WSP(bf16_t, P_TMP + T_YG), 1024, EM_PLAIN);
                if (kind == MP_L1_G1) { set_job(JT_PTR, 0, WSP(bf16_t, P_XBF), WSP(bf16_t, P_WQKV_T), 128, 5, WSP(bf16_t, P_TMP + T_QX), 1024, EM_ROTARY, WSP(float, P_BQK), WSP(float, P_ROT), WSP(bf16_t, P_TMP + T_K1));
                    set_job(JT_PTR, 1, WSP(bf16_t, P_WQKV_T) + (size_t)1280 * 1024, WSP(bf16_t, P_XBF), 1, 128, WSP(bf16_t, P_TMP + T_VT1), NT, EM_ROWBIAS, p.in[20] + 1280); }
#ifdef PROBE_L1PLAIN
                if (kind == MP_L1_G1 && dup == 0) JT_PTR[0].mode = EM_PLAIN;
#endif
            }
            if (kind == MP_L0_G1) S.n0 = 1024;
            if (kind == MP_XA_G1) { S.n0 = 512; if (l == 0) { S.n1 = 32; S.n2 = 32; S.n3 = 32; S.n4 = 32; } }
            if (kind == MP_L1_G1) { S.n0 = 640; S.n1 = 128; }
            if (kind == MP_MOE_G1) { S.moe = 1; S.A = (const char*)WSP(bf16_t, P_XBF); S.src = WSP(int, P_RT + RT_SRC); S.B = (const char*)(l ? WSP(bf16_t, P_TMP + T_W13B) : WSP(bf16_t, P_W13T)); S.bexp = (size_t)1024 * 1024 * 2; }
            if (kind == MP_MOE_G2) { S.moe = 1; S.K = 512; S.A = (const char*)WSP(bf16_t, P_TMP + T_HM); S.B = (const char*)(l ? WSP(bf16_t, P_TMP + T_W2B) : WSP(bf16_t, P_W2T)); S.bexp = (size_t)1024 * 512 * 2; }
            __syncthreads();
            EpiMulti E; E.jt = JT_PTR;
#ifdef PROBE_GEMM2
#pragma unroll 1
            for (int rep = 0; rep < 2; ++rep)
#endif
            pg8::gemm_phase<EpiMulti, SchedAll, true, true>(lds, S.K, S, E);
            if (l == 0 && (kind == MP_XA_G1 || kind == MP_MOE_G1 || kind == MP_MOE_G2)) {
                const TailPlan tp = tail_plan(S.tstart[32], G);
                const int vc = kind == MP_XA_G1 ? blk : (blk & 7) * (G >> 3) + (blk >> 3);
                const int fi = kind == MP_XA_G1 ? 128 : tp.first_idle, quota = kind == MP_MOE_G2 ? TAILQ_G2 : (kind == MP_XA_G1 ? TAILQ_XA : TAILQ_G1), base = kind == MP_XA_G1 ? 0 : (kind == MP_MOE_G1 ? tp.t0 : tp.t0 + tp.t1);
                if (vc >= fi) { const int wv = __builtin_amdgcn_readfirstlane((int)threadIdx.x >> 6); int lq = threadIdx.x & 63; asm volatile("" : "+v"(lq));
                    const int f0 = base + ((vc - fi) * NWAVE + wv) * quota;
                    conv_moe1_range(p, (LAS float*)(lds + wv * 8448), lq, f0, 1, f0 + quota); }
            }
        } else {
#ifdef PROBE_MIXA_SKIP
#define MIXA_SKIP_ARG ((dup == 0 && (((PROBE_MASK) >> kind) & 1)) ? (PROBE_MIXA_SKIP) : 0)
#else
#define MIXA_SKIP_ARG 0
#endif
#ifdef PROBE_MASK
#define DRY (dup == 0 && (((PROBE_MASK) >> kind) & 1))
#else
#define DRY false
#endif
            switch (kind) {
                case MP_CONV: { int gwr = blk * NWAVE + __builtin_amdgcn_readfirstlane((int)threadIdx.x >> 6);
                    ph_conv_l0(p, lds, blk, G, gwr); ph_conv_l1(p, lds, blk, G, gwr); ph_conv_xattn(p, lds, blk, G, 0, gwr); ph_conv_xattn(p, lds, blk, G, 1, gwr); ph_conv_moe(p, lds, blk, G, 0, gwr); ph_xin_to_bf(p, lds, blk, G); } break;
                case MP_L0_MIXA: { L0Bufs Bx = l0_bufs(p); if (DRY) { Bx.Q = Bx.K = WSP(bf16_t, P_TMP + 288 * MB); } l0_mixA(lds, Bx, blk, G, MIXA_SKIP_ARG); } break;
                case MP_L0_SCAN: ph_scan_conv(p, lds, blk, G); break;
                case MP_L0_MIXC: l0_mixC(lds, l0_bufs(p), blk, G); break;
                case MP_XA_ATTN: ph_xattn_attn(p, lds, blk, G, l); break;
                case MP_ROUTE: ph_moe_route(p, lds, blk, G, l); break;
                case MP_SCATTER: ph_moe_scatter(p, lds, blk, G); break;
                case MP_LN_MOE: if (l == 0) { ph_ln<false, false, true>(p, lds, blk, G, WSP(bf16_t, P_TMP + T_YG), 2, DRY); if (!(DRY)) { const int wv = __builtin_amdgcn_readfirstlane((int)threadIdx.x >> 6); int lq = threadIdx.x & 63; asm volatile("" : "+v"(lq)); { const TailPlan tp = tail_plan(WSP(int, P_RT + RT_TSTART)[32], G); conv_moe1_range(p, (LAS float*)(lds + wv * 8448), lq, tp.t0 + tp.t1 + tp.t2 + blk * NWAVE + wv, G * NWAVE, 12288); } conv_router_w(p, 1, blk * NTHR + (int)threadIdx.x, G * NTHR); } } else ph_ln<false, true, true>(p, lds, blk, G, WSP(bf16_t, P_TMP + T_YG), 5, DRY); break;
                default: ph_l1_swa(p, lds, blk, G); break;
            }
        }
#ifdef PROBE_MASK
        if (((PROBE_MASK) >> kind) & 1) { if (dup == 0) { dup = 1; xcd_barrier(xbar); --pi; continue; } dup = 0; }
#endif
        if (pi + 1 < N_PROG) { if (p0.ws == nullptr) grid.sync(); else { xcd_barrier(xbar);
#ifdef PROBE_BAR2
            xcd_barrier(xbar);
#endif
        } }
    }
}
}
extern "C" void kernel_launch(void* const* d_in, const int* in_sizes, int n_in, void* d_out, int out_size, void* d_ws, size_t ws_size, hipStream_t stream) {
    static int ok = 0;
    if (ok == 0) {
        ok = -1;
        if (n_in != 33 || out_size != 32768 * 1024 || ws_size < fk::FAST_END + (fk::SLOT_MB - 4) * fk::MB) { fprintf(stderr, "kernel_launch: unexpected shapes/ws (%d, %d, %zu)\n", n_in, out_size, ws_size); return; }
        int dev = 0, cus = 0, per_cu = 0;
        if (hipGetDevice(&dev) != hipSuccess || hipDeviceGetAttribute(&cus, hipDeviceAttributeMultiprocessorCount, dev) != hipSuccess) return;
        if (hipFuncSetAttribute((const void*)fk::mega, hipFuncAttributeMaxDynamicSharedMemorySize, fk::LDS_BYTES) != hipSuccess) return;
        if (hipOccupancyMaxActiveBlocksPerMultiprocessor(&per_cu, (const void*)fk::mega, fk::NTHR, fk::LDS_BYTES) != hipSuccess || per_cu < 1 || cus * per_cu < 256) { fprintf(stderr, "kernel_launch: cannot co-reside 256 workgroups (%d CUs x %d)\n", cus, per_cu); return; }
        ok = 1;
    }
    if (ok < 0) return;
    fk::FP p{}; for (int i = 0; i < 33; ++i) p.in[i] = (const float*)d_in[i]; p.X = (float*)d_out; p.ws = (unsigned char*)d_ws;
    if (hipMemsetAsync((char*)d_ws + fk::P_BAR, 0, 16384, stream) != hipSuccess) return;
    if (hipMemsetAsync((char*)d_ws + fk::P_TMP + fk::T_SLOT, 0xFF, fk::SLOT_MB * fk::MB, stream) != hipSuccess) return;
    void* args[] = {&p};
    hipError_t e = hipLaunchCooperativeKernel((const void*)fk::mega, dim3(256), dim3(fk::NTHR), args, fk::LDS_BYTES, stream);
    if (e != hipSuccess) fprintf(stderr, "cooperative launch failed: %s\n", hipGetErrorString(e));
}
```

```cpp
#include <hip/hip_runtime.h>
#include <hip/hip_cooperative_groups.h>
#include <cstdio>
#include <cstdint>
#include <cmath>
namespace fk {
#define LAS __attribute__((address_space(3)))
typedef unsigned short bf16_t;
typedef short bf16x8 __attribute__((ext_vector_type(8)));
typedef short s16x4 __attribute__((ext_vector_type(4)));
typedef float f32x4 __attribute__((ext_vector_type(4)));
typedef float f32x16 __attribute__((ext_vector_type(16)));
typedef float f32x2 __attribute__((ext_vector_type(2)));
typedef unsigned u32x4 __attribute__((ext_vector_type(4)));
typedef unsigned u32x2 __attribute__((ext_vector_type(2)));
typedef __bf16 bf16x2_t __attribute__((ext_vector_type(2)));

constexpr int NT = 32768, DM = 1024, SEQ = 4096;
constexpr int NTHR = 512, NWAVE = 8;
constexpr float ALPHA = 1.4142135623730951f, LN_EPS = 1e-5f, LOG2E = 1.4426950408889634f;

__device__ __forceinline__ unsigned pk2(float lo, float hi) { f32x2 v = {lo, hi}; bf16x2_t b = __builtin_convertvector(v, bf16x2_t); return __builtin_bit_cast(unsigned, b); }
__device__ __forceinline__ float bf_lo(unsigned w) { return __uint_as_float(w << 16); }
__device__ __forceinline__ float bf_hi(unsigned w) { return __uint_as_float(w & 0xffff0000u); }
__device__ __forceinline__ float bf2f(bf16_t b) { return __uint_as_float(((unsigned)b) << 16); }
__device__ __forceinline__ bf16_t f2bf(float f) { return (bf16_t)(pk2(f, 0.f) & 0xffffu); }
__device__ __forceinline__ float fast_exp(float x) { return __builtin_amdgcn_exp2f(x * LOG2E); }
__device__ __forceinline__ float sigmoid_f(float x) { return __builtin_amdgcn_rcpf(1.f + fast_exp(-x)); }
__device__ __forceinline__ float silu_f(float x) { return x * sigmoid_f(x); }
__device__ __forceinline__ float gelu_tanh_f(float x) { const float u = 1.5957691216057308f * (x + 0.044715f * x * x * x); return x * sigmoid_f(u); }
__device__ __forceinline__ int crow(int r, int hi) { return (r & 3) + 8 * (r >> 2) + 4 * hi; }
__device__ __forceinline__ float xhalf_sum(float v) { auto rr = __builtin_amdgcn_permlane32_swap(__float_as_uint(v), __float_as_uint(v), false, false); return __uint_as_float(rr[0]) + __uint_as_float(rr[1]); }
__device__ __forceinline__ float xhalf_max(float v) { auto rr = __builtin_amdgcn_permlane32_swap(__float_as_uint(v), __float_as_uint(v), false, false); return fmaxf(__uint_as_float(rr[0]), __uint_as_float(rr[1])); }
__device__ __forceinline__ float shx(float v, int o, int lane) { return __int_as_float(__builtin_amdgcn_ds_bpermute((lane ^ o) << 2, __float_as_int(v))); }
__device__ __forceinline__ float shup(float v, int o, int lane) { return __int_as_float(__builtin_amdgcn_ds_bpermute(((lane - o) & 63) << 2, __float_as_int(v))); }
__device__ __forceinline__ float shidx(float v, int idx) { return __int_as_float(__builtin_amdgcn_ds_bpermute(idx << 2, __float_as_int(v))); }
__device__ __forceinline__ s16x4 lds_tr(const LAS void* p) { return __builtin_bit_cast(s16x4, __builtin_amdgcn_ds_read_tr16_b64_v4i16((LAS s16x4*)p)); }
#define MFMA32(a, b, c) __builtin_amdgcn_mfma_f32_32x32x16_bf16((a), (b), (c), 0, 0, 0)

namespace pg8 {
constexpr int BM = 256, BK = 64, HALF = 128, HTB = HALF * BK * 2, STAGE_BYTES = 8 * HTB, NXCD = 8, WGM = 8;
__host__ __device__ __forceinline__ int lds_byte(int r, int c) { const int st = (r >> 4) * 2 + (c >> 5), rr = r & 15, cc = c & 31, ob = rr * 64 + cc * 2; return st * 1024 + (ob ^ (((ob >> 9) & 1) << 5)); }
__host__ __device__ __forceinline__ void stage_rc(int b, int& R, int& C) { const int st = b / 1024, sb = b % 1024, swz = sb ^ (((sb >> 9) & 1) << 5); R = (st >> 1) * 16 + swz / 64; C = (st & 1) * 32 + (swz % 64) / 2; }
__host__ __device__ __forceinline__ int perm32(int rho) { const int n = rho >> 4, i = rho & 15; return 8 * (i >> 2) + 4 * n + (i & 3); }

struct Unit { const char* A; const char* B; const int* src; int pm, pn, job; };

__device__ __forceinline__ void tile_order(int l, int nM, int nN, int& pm, int& pn) {
    const int nwg = nM * nN; int wgid = l;
    { const int q = nwg / NXCD, r = nwg % NXCD, xcd = wgid % NXCD, off = wgid / NXCD; wgid = (xcd < r ? xcd * (q + 1) : r * (q + 1) + (xcd - r) * q) + off; }
    const int nig = WGM * nN, gid = wgid / nig, fm = gid * WGM, gsz = (nM - fm) < WGM ? (nM - fm) : WGM;
    pm = fm + ((wgid % nig) % gsz); pn = (wgid % nig) / gsz;
}
struct JobDesc { unsigned long long A, B, out, bias, rot, out2; int nM, nN, ldc, mode; };
__device__ __forceinline__ unsigned long long rfl64(unsigned long long v) { const unsigned lo = __builtin_amdgcn_readfirstlane((unsigned)v), hi = __builtin_amdgcn_readfirstlane((unsigned)(v >> 32)); return ((unsigned long long)hi << 32) | lo; }
constexpr int JT_OFF = STAGE_BYTES;
struct Jobs3 {
    const LAS JobDesc* jt; int n0, n1, n2; int K, G, c;
    __device__ __forceinline__ Unit get(int i, bool& ok) const { Unit u; u.A = nullptr; u.B = nullptr; u.src = nullptr; u.pm = 0; u.pn = 0; u.job = 0; ok = next(i, u); return u; }
    __device__ __forceinline__ bool next(int i, Unit& u) const {
        long L = (long)i * G + c;
        if (L >= (long)n0 + n1 + n2) return false;
        int l = (int)L; int jb = 0;
        if (l >= n0) { l -= n0; jb = 1; if (l >= n1) { l -= n1; jb = 2; } }
        const int jM = __builtin_amdgcn_readfirstlane(jt[jb].nM), jN = __builtin_amdgcn_readfirstlane(jt[jb].nN);
        int pm, pn; tile_order(l, jM, jN, pm, pn);
        const size_t tstep = (size_t)BM * K * 2;
        u.A = (const char*)rfl64(jt[jb].A) + (size_t)pm * tstep; u.B = (const char*)rfl64(jt[jb].B) + (size_t)pn * tstep; u.src = nullptr; u.pm = pm; u.pn = pn; u.job = jb; return true;
    }
};

template <class Epi, class Sched, bool ALIGN_EPI, bool SP2>
__device__ __forceinline__ void gemm_phase(LAS unsigned char* lds, const int K, const Sched& S, const Epi& E) {
    int tid_ = threadIdx.x; asm volatile("" : "+v"(tid_)); const int tid = tid_, wid = __builtin_amdgcn_readfirstlane(tid >> 6), lane = tid & 63, wr = wid >> 2, wc = wid & 3, fr = lane & 15, fq = lane >> 4;
    const int nt = K / BK;
    static_assert(SP2, "only the two-super-phase form is kept");
    unsigned vA0[2], vA1[2], vB0[2];
#pragma unroll
    for (int i = 0; i < 2; ++i) { int R, C; stage_rc(tid * 16 + i * 8192, R, C); const int Rb = 64 * (R >> 5) + perm32(R & 31); vB0[i] = (unsigned)(Rb * K + C) * 2u; }
    const size_t bhalf = (size_t)32 * K * 2;
    auto a_rows = [&](const int* src, unsigned (&o0)[2], unsigned (&o1)[2]) {
        int tq = threadIdx.x; asm volatile("" : "+v"(tq));
#pragma unroll
        for (int i = 0; i < 2; ++i) { int R, C; stage_rc(tq * 16 + i * 8192, R, C); int r0 = R, r1 = R + HALF; if (src) { r0 = src[R]; r1 = src[R + HALF]; }
            o0[i] = (unsigned)(r0 * K + C) * 2u; o1[i] = (unsigned)(r1 * K + C) * 2u; }
    };
    const size_t kstep = (size_t)(BK * 2);
    const size_t hstep = (size_t)HALF * K * 2;
    const unsigned ldsw = (unsigned)wid * 1024u;
    const int aoff = lds_byte(wr * 64 + fr, fq * 8), boff = lds_byte(wc * 32 + fr, fq * 8);
#define PG8_SA(b, h) (((b) * 2 + (h)) * HTB)
#define PG8_SB(b, h) ((4 + (b) * 2 + (h)) * HTB)
#define PG8_STAGE(bufoff, gbase, voff) do { _Pragma("unroll") for (int _i = 0; _i < 2; ++_i) \
        __builtin_amdgcn_global_load_lds((const unsigned*)((const char*)(gbase) + (voff)[_i]), (LAS unsigned*)(lds + (bufoff) + ldsw + _i * 8192), 16, 0, 0); } while (0)
#define PG8_LDA(dst, b, h) do { _Pragma("unroll") for (int m = 0; m < 4; ++m) _Pragma("unroll") for (int k = 0; k < 2; ++k) dst[m][k] = *(const LAS bf16x8*)(lds + PG8_SA(b, h) + aoff + m * 2048 + k * 1024); } while (0)
#define PG8_LDB(dst, b, h) do { _Pragma("unroll") for (int n = 0; n < 2; ++n) _Pragma("unroll") for (int k = 0; k < 2; ++k) dst[n][k] = *(const LAS bf16x8*)(lds + PG8_SB(b, h) + boff + n * 2048 + k * 1024); } while (0)
#define PG8_MMA(ai, bj, At, Bt) do { __builtin_amdgcn_s_setprio(1); _Pragma("unroll") for (int m = 0; m < 4; ++m) _Pragma("unroll") for (int n = 0; n < 2; ++n) _Pragma("unroll") for (int k = 0; k < 2; ++k) \
        acc[ai][bj][m][n] = __builtin_amdgcn_mfma_f32_16x16x32_bf16(Bt[n][k], At[m][k], acc[ai][bj][m][n], 0, 0, 0); __builtin_amdgcn_s_setprio(0); } while (0)
#define PG8_WAIT_V(n) asm volatile("s_waitcnt vmcnt(" #n ")" ::: "memory")
#define PG8_WAIT_L(n) asm volatile("s_waitcnt lgkmcnt(" #n ")" ::: "memory")
#define PG8_BAR __builtin_amdgcn_s_barrier()
#define PG8_SCHED __builtin_amdgcn_sched_barrier(0)
    auto unif = [](Unit u) { Unit r; r.A = (const char*)rfl64((unsigned long long)u.A); r.B = (const char*)rfl64((unsigned long long)u.B); r.src = (const int*)rfl64((unsigned long long)u.src);
        r.pm = __builtin_amdgcn_readfirstlane(u.pm); r.pn = __builtin_amdgcn_readfirstlane(u.pn); r.job = __builtin_amdgcn_readfirstlane(u.job); return r; };
    int ui = 0; bool ok0; Unit cur = unif(S.get(0, ok0));
    if (!ok0) return;
    f32x4 acc[2][2][4][2];
    E.prefetch(cur, wr, wc, fr, fq);
    bf16x8 At[4][2], B0[2][2], B1[2][2];
    const char* cA = cur.A; const char* cB = cur.B;
    a_rows(cur.src, vA0, vA1);
    {
        PG8_STAGE(PG8_SB(0, 0), cB, vB0); PG8_STAGE(PG8_SB(0, 1), cB + bhalf, vB0); PG8_STAGE(PG8_SA(0, 0), cA, vA0); PG8_STAGE(PG8_SA(0, 1), cA, vA1);
        if (wr == 1) PG8_BAR;
        PG8_WAIT_V(2); PG8_BAR;
        PG8_STAGE(PG8_SB(1, 0), cB + kstep, vB0); PG8_STAGE(PG8_SA(1, 0), cA + kstep, vA0); PG8_STAGE(PG8_SB(1, 1), cB + kstep + bhalf, vB0);
        PG8_WAIT_V(6); PG8_BAR;
    }
    for (;;) {
        E.init(acc);
        bool has_next; const Unit nxt = unif(S.get(ui + 1, has_next)); bool early_done = false;
        const char* nA = has_next ? nxt.A : cA; const char* nB = has_next ? nxt.B : cB;
        for (int t = 0; t < nt; t += 2) {
            const bool last = (t == nt - 2);
            const char* a1 = cA + (size_t)(t + 1) * kstep;
            const char* a2 = last ? nA : cA + (size_t)(t + 2) * kstep; const char* b2 = last ? nB : cB + (size_t)(t + 2) * kstep;
            const char* a3 = a2 + kstep; const char* b3 = b2 + kstep;
            PG8_LDB(B0, 0, 0); PG8_LDB(B1, 0, 1); PG8_SCHED; PG8_LDA(At, 0, 0); PG8_STAGE(PG8_SA(1, 1), a1, vA1);
            if (last && has_next) a_rows(nxt.src, vA0, vA1);
            PG8_WAIT_V(8); PG8_WAIT_L(0); PG8_BAR; PG8_MMA(0, 0, At, B0); PG8_MMA(0, 1, At, B1); PG8_BAR; PG8_SCHED;
            PG8_LDA(At, 0, 1); PG8_STAGE(PG8_SB(0, 0), b2, vB0); PG8_STAGE(PG8_SB(0, 1), b2 + bhalf, vB0); PG8_STAGE(PG8_SA(0, 0), a2, vA0);
            PG8_WAIT_V(8); PG8_WAIT_L(0); PG8_BAR; PG8_MMA(1, 0, At, B0); PG8_MMA(1, 1, At, B1); PG8_BAR; PG8_SCHED;
            PG8_LDB(B0, 1, 0); PG8_LDB(B1, 1, 1); PG8_SCHED; PG8_LDA(At, 1, 0); PG8_STAGE(PG8_SA(0, 1), a2, vA1);
            PG8_WAIT_V(8); PG8_WAIT_L(0); PG8_BAR; PG8_MMA(0, 0, At, B0); PG8_MMA(0, 1, At, B1); PG8_BAR; PG8_SCHED;
            if (last) { early_done = E.early(acc, cur, wr, wc, fr, fq); PG8_SCHED; }
            PG8_LDA(At, 1, 1); PG8_STAGE(PG8_SB(1, 0), b3, vB0); PG8_STAGE(PG8_SB(1, 1), b3 + bhalf, vB0); PG8_STAGE(PG8_SA(1, 0), a3, vA0);
            PG8_WAIT_V(8); PG8_WAIT_L(0); PG8_BAR; PG8_MMA(1, 0, At, B0); PG8_MMA(1, 1, At, B1); PG8_BAR; PG8_SCHED;
        }
        if constexpr (ALIGN_EPI) { if (wr == 0) PG8_BAR; }
        E.prefetch(nxt, wr, wc, fr, fq);
        if (!early_done) E.template half<0>(acc, cur, wr, wc, fr, fq);
        E.template half<1>(acc, cur, wr, wc, fr, fq);
        if (!has_next) break;
        cur = nxt; cA = nA; cB = nB; ++ui;
        if constexpr (ALIGN_EPI) { if (wr == 1) PG8_BAR; }
    }
    PG8_WAIT_V(0);
    if constexpr (!ALIGN_EPI) { if (wr == 0) PG8_BAR; }
    PG8_BAR;
#undef PG8_SA
#undef PG8_SB
#undef PG8_STAGE
#undef PG8_LDA
#undef PG8_LDB
#undef PG8_MMA
#undef PG8_WAIT_V
#undef PG8_WAIT_L
#undef PG8_BAR
#undef PG8_SCHED
}
}
enum { EM_PLAIN = 0, EM_GELU4 = 1, EM_SWIGLU = 2, EM_ROTARY = 3, EM_ROWBIAS = 4 };
struct EpiMulti {
    static constexpr bool PERM = true;
    const LAS pg8::JobDesc* jt;
    __device__ __forceinline__ void prefetch(const pg8::Unit&, int, int, int, int) const {}
    __device__ __forceinline__ void init(f32x4 (&acc)[2][2][4][2]) const {
#pragma unroll
        for (int a = 0; a < 2; ++a)
#pragma unroll
            for (int b = 0; b < 2; ++b)
#pragma unroll
                for (int m = 0; m < 4; ++m)
#pragma unroll
                    for (int n = 0; n < 2; ++n) acc[a][b][m][n] = (f32x4){0.f, 0.f, 0.f, 0.f};
    }
    __device__ __forceinline__ bool early(const f32x4 (&acc)[2][2][4][2], const pg8::Unit& u, int wr, int wc, int fr, int fq) const {
        const LAS pg8::JobDesc* jd = jt + u.job;
        if (__builtin_amdgcn_readfirstlane(jd->mode) != EM_PLAIN) return false;
        bf16_t* out = (bf16_t*)pg8::rfl64(jd->out); const int ldc = __builtin_amdgcn_readfirstlane(jd->ldc);
        bf16_t* rowp = out + (size_t)(u.pm * 256 + wr * 64 + fr) * ldc + u.pn * 256 + wc * 64 + 8 * fq;
#pragma unroll
        for (int m = 0; m < 4; ++m)
#pragma unroll
            for (int bj = 0; bj < 2; ++bj) { const f32x4 v0 = acc[0][bj][m][0], v1 = acc[0][bj][m][1];
                u32x4 w; w.x = pk2(v0[0], v0[1]); w.y = pk2(v0[2], v0[3]); w.z = pk2(v1[0], v1[1]); w.w = pk2(v1[2], v1[3]);
                *(u32x4*)(rowp + (size_t)m * 16 * ldc + bj * 32) = w; }
        return true;
    }
    template <int AI>
    __device__ __forceinline__ void half(const f32x4 (&acc)[2][2][4][2], const pg8::Unit& u, int wr, int wc, int fr, int fq) const {
        const LAS pg8::JobDesc* jd = jt + u.job;
        bf16_t* out = (bf16_t*)pg8::rfl64(jd->out);
        const int ldc = __builtin_amdgcn_readfirstlane(jd->ldc);
        const int mode = __builtin_amdgcn_readfirstlane(jd->mode);
        const float* bias = (const float*)pg8::rfl64(jd->bias);
        const int row0 = u.pm * 256 + wr * 64 + fr;
        const int colt = u.pn * 256 + wc * 64 + 8 * fq;
        if (mode == EM_PLAIN || mode == EM_ROWBIAS) {
#pragma unroll
            for (int ai = AI; ai < AI + 1; ++ai)
#pragma unroll
                for (int m = 0; m < 4; ++m) { const int row = row0 + ai * 128 + m * 16; const float rb = (mode == EM_ROWBIAS && bias) ? bias[row] : 0.f;
                    bf16_t* rowp = out + (size_t)row * ldc + colt;
#pragma unroll
                    for (int bj = 0; bj < 2; ++bj) { const f32x4 v0 = acc[ai][bj][m][0] + rb, v1 = acc[ai][bj][m][1] + rb;
                        u32x4 w; w.x = pk2(v0[0], v0[1]); w.y = pk2(v0[2], v0[3]); w.z = pk2(v1[0], v1[1]); w.w = pk2(v1[2], v1[3]);
                        *(u32x4*)(rowp + bj * 32) = w; } }
        } else if (mode == EM_GELU4) {
            const int arr = u.pn >> 1; bf16_t* base = out + (size_t)arr * NT * 512; const int col = colt - arr * 512; const bool act = arr < 2;
#pragma unroll
            for (int ai = AI; ai < AI + 1; ++ai)
#pragma unroll
                for (int m = 0; m < 4; ++m) { bf16_t* rowp = base + (size_t)(row0 + ai * 128 + m * 16) * 512 + col;
#pragma unroll
                    for (int bj = 0; bj < 2; ++bj) { f32x4 v0 = acc[ai][bj][m][0], v1 = acc[ai][bj][m][1];
                        if (act) {
#pragma unroll
                            for (int e = 0; e < 4; ++e) { v0[e] = gelu_tanh_f(v0[e]); v1[e] = gelu_tanh_f(v1[e]); } }
                        u32x4 w; w.x = pk2(v0[0], v0[1]); w.y = pk2(v0[2], v0[3]); w.z = pk2(v1[0], v1[1]); w.w = pk2(v1[2], v1[3]);
                        *(u32x4*)(rowp + bj * 32) = w; } }
        } else if (mode == EM_SWIGLU) {
#pragma unroll
            for (int ai = AI; ai < AI + 1; ++ai)
#pragma unroll
                for (int m = 0; m < 4; ++m) { bf16_t* rowp = out + (size_t)(row0 + ai * 128 + m * 16) * ldc + (colt >> 1);
#pragma unroll
                    for (int bj = 0; bj < 2; ++bj) { const f32x4 v0 = acc[ai][bj][m][0], v1 = acc[ai][bj][m][1];
                        u32x2 w; w.x = pk2(silu_f(v0[0]) * v0[1], silu_f(v0[2]) * v0[3]); w.y = pk2(silu_f(v1[0]) * v1[1], silu_f(v1[2]) * v1[3]);
                        *(u32x2*)(rowp + bj * 16) = w; } }
        } else {
            const float* rot = (const float*)pg8::rfl64(jd->rot);
            bf16_t* out2 = (bf16_t*)pg8::rfl64(jd->out2);
            const bool isk = u.pn >= 4; bf16_t* base = isk ? out2 : out; const int ld = isk ? 256 : 1024; const int colo = isk ? colt - 1024 : colt;
            float bv[2][8];
#pragma unroll
            for (int bj = 0; bj < 2; ++bj) { f32x4 b0 = (f32x4){0.f, 0.f, 0.f, 0.f}, b1 = b0; if (bias) { b0 = *(const f32x4*)(bias + colt + bj * 32); b1 = *(const f32x4*)(bias + colt + bj * 32 + 4); }
#pragma unroll
                for (int e = 0; e < 4; ++e) { bv[bj][e] = b0[e]; bv[bj][4 + e] = b1[e]; } }
            const int i0 = (colt & 63) >> 1;
#pragma unroll
            for (int ai = AI; ai < AI + 1; ++ai)
#pragma unroll
                for (int m = 0; m < 4; ++m) { const int row = row0 + ai * 128 + m * 16; const int pos = row & (SEQ - 1);
                    bf16_t* rowp = base + (size_t)row * ld + colo;
#pragma unroll
                    for (int bj = 0; bj < 2; ++bj) { f32x4 v0 = acc[ai][bj][m][0], v1 = acc[ai][bj][m][1];
                        const f32x4 cs0 = *(const f32x4*)(rot + ((size_t)pos * 32 + i0 + 16 * bj) * 2), cs1 = *(const f32x4*)(rot + ((size_t)pos * 32 + i0 + 16 * bj + 2) * 2);
#pragma unroll
                        for (int e = 0; e < 4; ++e) { v0[e] += bv[bj][e]; v1[e] += bv[bj][4 + e]; }
                        const float a0 = v0[0] * cs0[0] - v0[1] * cs0[1], b0 = v0[1] * cs0[0] + v0[0] * cs0[1];
                        const float a1 = v0[2] * cs0[2] - v0[3] * cs0[3], b1 = v0[3] * cs0[2] + v0[2] * cs0[3];
                        const float a2 = v1[0] * cs1[0] - v1[1] * cs1[1], b2 = v1[1] * cs1[0] + v1[0] * cs1[1];
                        const float a3 = v1[2] * cs1[2] - v1[3] * cs1[3], b3 = v1[3] * cs1[2] + v1[2] * cs1[3];
                        u32x4 w; w.x = pk2(a0, b0); w.y = pk2(a1, b1); w.z = pk2(a2, b2); w.w = pk2(a3, b3);
                        *(u32x4*)(rowp + bj * 32) = w; } }
        }
    }
};

#define GAS __attribute__((address_space(1)))
#define P_TMP_PROBE (194ull * 1048576ull)
constexpr int LNF_PART = pg8::JT_OFF + 1024;
constexpr int LNF_STAT = LNF_PART + 8192;
struct EpiLN {
    static constexpr bool PERM = true;
    LAS unsigned char* lds;
    mutable u32x4 pre[2][4][2];
    __device__ __forceinline__ void prefetch(const pg8::Unit& u, int, int, int, int) const {
        int tq = threadIdx.x; asm volatile("" : "+v"(tq)); const int wq = __builtin_amdgcn_readfirstlane(tq >> 6), wr = wq >> 2, wc = wq & 3, fr = tq & 15, fq = (tq & 63) >> 4;
        const unsigned long long xio = pg8::rfl64(((const LAS pg8::JobDesc*)(lds + pg8::JT_OFF))->out);
        const GAS unsigned char* tb = (const GAS unsigned char*)(xio + ((size_t)u.pm * 256 * 1024 + u.pn * 256) * 2);
        const unsigned loff = (unsigned)((wr * 64 + fr) * 1024 + wc * 64 + 8 * fq) * 2u;
#pragma unroll
        for (int ai = 0; ai < 2; ++ai)
#pragma unroll
            for (int m = 0; m < 4; ++m)
#pragma unroll
                for (int bj = 0; bj < 2; ++bj) pre[ai][m][bj] = *(const GAS u32x4*)(tb + (ai * 128 + m * 16) * 2048 + bj * 64 + loff);
    }
    __device__ __forceinline__ void init(f32x4 (&acc)[2][2][4][2]) const {
#pragma unroll
        for (int ai = 0; ai < 2; ++ai)
#pragma unroll
            for (int m = 0; m < 4; ++m)
#pragma unroll
                for (int bj = 0; bj < 2; ++bj) { const u32x4 w = pre[ai][m][bj];
                    acc[ai][bj][m][0] = (f32x4){ALPHA * bf_lo(w.x), ALPHA * bf_hi(w.x), ALPHA * bf_lo(w.y), ALPHA * bf_hi(w.y)};
                    acc[ai][bj][m][1] = (f32x4){ALPHA * bf_lo(w.z), ALPHA * bf_hi(w.z), ALPHA * bf_lo(w.w), ALPHA * bf_hi(w.w)};
                    __builtin_amdgcn_sched_barrier(0); }
    }
    __device__ __forceinline__ bool early(const f32x4 (&)[2][2][4][2], const pg8::Unit&, int, int, int, int) const { return false; }
    template <int AI>
    __device__ __forceinline__ void half(f32x4 (&acc)[2][2][4][2], const pg8::Unit& u, int, int, int, int) const {
        int tid_ = threadIdx.x; asm volatile("" : "+v"(tid_)); const int tid = tid_, lane = tid & 63;
        const int wq = __builtin_amdgcn_readfirstlane(tid >> 6), wr = wq >> 2, wc = wq & 3, fr = lane & 15, fq = lane >> 4;
        const int colt = u.pn * 256 + wc * 64 + 8 * fq;
        LAS f32x2* part = (LAS f32x2*)(lds + LNF_PART);
        LAS f32x2* stat = (LAS f32x2*)(lds + LNF_STAT);
#pragma unroll
        for (int m = 0; m < 4; ++m) { const int rl = AI * 128 + wr * 64 + m * 16 + fr;
            float s1 = 0.f, s2 = 0.f;
#pragma unroll
            for (int bj = 0; bj < 2; ++bj) { const f32x4 v0 = acc[AI][bj][m][0], v1 = acc[AI][bj][m][1];
#pragma unroll
                for (int e = 0; e < 4; ++e) { s1 += v0[e] + v1[e]; s2 += v0[e] * v0[e] + v1[e] * v1[e]; } }
            s1 += shx(s1, 16, lane); s2 += shx(s2, 16, lane); s1 += shx(s1, 32, lane); s2 += shx(s2, 32, lane);
            if (fq == 0) part[rl * 4 + wc] = (f32x2){s1, s2}; }
        if constexpr (AI == 1) {
            __syncthreads();
            if (tid < 256) {
                const f32x2 p0 = part[tid * 4], p1 = part[tid * 4 + 1], p2 = part[tid * 4 + 2], p3 = part[tid * 4 + 3];
                const float t1 = (p0[0] + p1[0]) + (p2[0] + p3[0]), t2 = (p0[1] + p1[1]) + (p2[1] + p3[1]);
                unsigned long long* sl = (unsigned long long*)pg8::rfl64(((const LAS pg8::JobDesc*)(lds + pg8::JT_OFF))->out2) + (size_t)u.pm * 1024 + tid;
#ifdef PROBE_LNV
                const bool dryp = __builtin_amdgcn_readfirstlane(((const LAS pg8::JobDesc*)(lds + pg8::JT_OFF))->mode) != 0;
#endif
                __hip_atomic_store(sl + u.pn * 256, ((unsigned long long)__float_as_uint(t2) << 32) | __float_as_uint(t1), __ATOMIC_RELAXED, __HIP_MEMORY_SCOPE_AGENT);
                unsigned long long x0, x1, x2, x3; unsigned sp = 0;
                for (;;) {
                    x0 = __hip_atomic_load(sl, __ATOMIC_RELAXED, __HIP_MEMORY_SCOPE_AGENT); x1 = __hip_atomic_load(sl + 256, __ATOMIC_RELAXED, __HIP_MEMORY_SCOPE_AGENT);
                    x2 = __hip_atomic_load(sl + 512, __ATOMIC_RELAXED, __HIP_MEMORY_SCOPE_AGENT); x3 = __hip_atomic_load(sl + 768, __ATOMIC_RELAXED, __HIP_MEMORY_SCOPE_AGENT);
                    if ((x0 != ~0ull && x1 != ~0ull && x2 != ~0ull && x3 != ~0ull) || ++sp > (1u << 22)) break;
#ifdef PROBE_LNV
                    if (dryp && ((PROBE_LNV) & 1)) break;
#endif
                    __builtin_amdgcn_s_sleep(1); }
#ifdef PROBE_LNX
                {   unsigned long long* sl2 = sl + 4 * 131072;
                    __hip_atomic_store(sl2 + u.pn * 256, ((unsigned long long)__float_as_uint(t2) << 32) | __float_as_uint(t1), __ATOMIC_RELAXED, __HIP_MEMORY_SCOPE_AGENT);
                    unsigned long long y0, y1, y2, y3; unsigned sq = 0;
                    for (;;) { y0 = __hip_atomic_load(sl2, __ATOMIC_RELAXED, __HIP_MEMORY_SCOPE_AGENT); y1 = __hip_atomic_load(sl2 + 256, __ATOMIC_RELAXED, __HIP_MEMORY_SCOPE_AGENT);
                        y2 = __hip_atomic_load(sl2 + 512, __ATOMIC_RELAXED, __HIP_MEMORY_SCOPE_AGENT); y3 = __hip_atomic_load(sl2 + 768, __ATOMIC_RELAXED, __HIP_MEMORY_SCOPE_AGENT);
                        if ((y0 != ~0ull && y1 != ~0ull && y2 != ~0ull && y3 != ~0ull) || ++sq > (1u << 22)) break;
                        __builtin_amdgcn_s_sleep(1); }
                    if (y0 == 0x123456789ull) x0 = y1; }
#endif
                const float S1 = (__uint_as_float((unsigned)x0) + __uint_as_float((unsigned)x1)) + (__uint_as_float((unsigned)x2) + __uint_as_float((unsigned)x3));
                const float S2 = (__uint_as_float((unsigned)(x0 >> 32)) + __uint_as_float((unsigned)(x1 >> 32))) + (__uint_as_float((unsigned)(x2 >> 32)) + __uint_as_float((unsigned)(x3 >> 32)));
                const float mean = S1 * (1.f / 1024.f); const float var = fmaxf(S2 * (1.f / 1024.f) - mean * mean, 0.f);
                stat[tid] = (f32x2){mean, __builtin_amdgcn_rsqf(var + LN_EPS)};
            }
            __syncthreads();
            const LAS pg8::JobDesc* jd = (const LAS pg8::JobDesc*)(lds + pg8::JT_OFF);
#ifdef PROBE_LNV
            const bool dryp2 = __builtin_amdgcn_readfirstlane(jd->mode) != 0;
#endif
            const unsigned long long xio = pg8::rfl64(jd->out); const float* g = (const float*)pg8::rfl64(jd->bias); const float* b = (const float*)pg8::rfl64(jd->rot);
            GAS unsigned char* tb = (GAS unsigned char*)(xio + ((size_t)u.pm * 256 * 1024 + u.pn * 256) * 2); const unsigned loff = (unsigned)((wr * 64 + fr) * 1024 + wc * 64 + 8 * fq) * 2u;
#pragma unroll
            for (int bj = 0; bj < 2; ++bj) {
                __builtin_amdgcn_sched_barrier(0);
                const f32x4 g0 = *(const GAS f32x4*)((const GAS float*)g + colt + bj * 32), g1 = *(const GAS f32x4*)((const GAS float*)g + colt + bj * 32 + 4), b0 = *(const GAS f32x4*)((const GAS float*)b + colt + bj * 32), b1 = *(const GAS f32x4*)((const GAS float*)b + colt + bj * 32 + 4);
                f32x2 stn = stat[wr * 64 + fr];
#pragma unroll
                for (int am = 0; am < 8; ++am) { const int ai = am >> 2, m = am & 3; const int rl = ai * 128 + wr * 64 + m * 16 + fr; const f32x2 st = stn;
                    if (am < 7) stn = stat[((am + 1) >> 2) * 128 + wr * 64 + ((am + 1) & 3) * 16 + fr];
                    const float sc = st[1], sh = -st[0] * st[1];
                    const f32x4 v0 = (acc[ai][bj][m][0] * sc + sh) * g0 + b0, v1 = (acc[ai][bj][m][1] * sc + sh) * g1 + b1;
                    u32x4 w; w.x = pk2(v0[0], v0[1]); w.y = pk2(v0[2], v0[3]); w.z = pk2(v1[0], v1[1]); w.w = pk2(v1[2], v1[3]);
#ifdef PROBE_LNV
                    if (!(dryp2 && ((PROBE_LNV) & 2)))
                    *(GAS u32x4*)(tb + (dryp2 ? (size_t)P_TMP_PROBE : (size_t)0) + (ai * 128 + m * 16) * 2048 + bj * 64 + loff) = w;
#else
                    *(GAS u32x4*)(tb + (ai * 128 + m * 16) * 2048 + bj * 64 + loff) = w;
#endif
#ifdef PROBE_LNS
                    *(GAS u32x4*)(tb + ((size_t)P_TMP_PROBE) + (ai * 128 + m * 16) * 2048 + bj * 64 + loff) = w;
#endif
                    __builtin_amdgcn_sched_barrier(0); }
            }
        }
    }
};
enum { RM_IDENT = 0, RM_ROT = 1, RM_PAIR0 = 2, RM_PAIR1 = 3 };
__device__ __forceinline__ int rowmap(int kind, int n) {
    if (kind == RM_ROT) { if (n >= 1280) return n; const int d = n & 63; return (n & ~63) + 2 * (d & 31) + (d >> 5); }
    if (kind == RM_PAIR0) return 2 * n;
    if (kind == RM_PAIR1) return 2 * n + 1;
    return n;
}
__device__ __forceinline__ void ti_load(const float* __restrict__ W, int ldw, int kb, int nb, int lane, f32x4 (&tv)[8]) {
    const int k0 = 64 * kb, n0 = 32 * nb;
#pragma unroll
    for (int i = 0; i < 8; ++i) { const int kk = 8 * i + (lane >> 3); tv[i] = *(const f32x4*)(W + (size_t)(k0 + kk) * ldw + n0 + 4 * (lane & 7)); }
}
__device__ __forceinline__ void ti_store(const f32x4 (&tv)[8], int K, bf16_t* __restrict__ WT, LAS float* scr, int kb, int nb, int lane, int kind, float scale, int nscale) {
    const int k0 = 64 * kb, n0 = 32 * nb;
#pragma unroll
    for (int i = 0; i < 8; ++i) { const int kk = 8 * i + (lane >> 3); LAS float* d = scr + kk * 33 + 4 * (lane & 7); d[0] = tv[i][0]; d[1] = tv[i][1]; d[2] = tv[i][2]; d[3] = tv[i][3]; }
    __builtin_amdgcn_s_waitcnt(0xc07f); asm volatile("" ::: "memory");
    const int c = lane & 7;
#pragma unroll
    for (int j = 0; j < 4; ++j) { const int n = (lane >> 3) + 8 * j; const LAS float* s = scr + (8 * c) * 33 + n; const float sc = (n0 + n) < nscale ? scale : 1.f;
        u32x4 o; o.x = pk2(s[0 * 33] * sc, s[1 * 33] * sc); o.y = pk2(s[2 * 33] * sc, s[3 * 33] * sc); o.z = pk2(s[4 * 33] * sc, s[5 * 33] * sc); o.w = pk2(s[6 * 33] * sc, s[7 * 33] * sc);
        *(u32x4*)(WT + (size_t)rowmap(kind, n0 + n) * K + k0 + 8 * c) = o; }
    __builtin_amdgcn_s_waitcnt(0xc07f); asm volatile("" ::: "memory");
}
__device__ __forceinline__ void convert_mats(const float* W, int K, int N, int nbat, size_t sstr, bf16_t* WT, size_t dstr, int kind, float scale, int nscale, LAS float* scr, int& gwr, int ngw, int lane) {
    const int nblk = N / 32, per = (K / 64) * nblk, total = per * nbat;
    const int gw = gwr; gwr = (gw + ngw - total % ngw) % ngw;
    if (gw >= total) return;
    f32x4 cur[8], nxt[8];
    { const int bt = gw / per, r = gw - bt * per; ti_load(W + (size_t)bt * sstr, N, r / nblk, r % nblk, lane, cur); }
    for (int it = gw; it < total; it += ngw) {
        const int in = it + ngw; const bool more = in < total;
        if (more) { const int bt = in / per, r = in - bt * per; ti_load(W + (size_t)bt * sstr, N, r / nblk, r % nblk, lane, nxt); }
        { const int bt = it / per, r = it - bt * per; ti_store(cur, K, WT + (size_t)bt * dstr, scr, r / nblk, r % nblk, lane, kind, scale, nscale); }
#pragma unroll
        for (int i = 0; i < 8; ++i) cur[i] = nxt[i];
    }
}
__device__ __forceinline__ void convert_rows(const float* __restrict__ src, bf16_t* __restrict__ dst, size_t n, int gt, int ngt) {
    const size_t step = (size_t)ngt * 8; size_t i = (size_t)gt * 8;
    for (; i + 3 * step < n; i += 4 * step) { f32x4 a[4], b[4];
#pragma unroll
        for (int j = 0; j < 4; ++j) { a[j] = *(const f32x4*)(src + i + j * step); b[j] = *(const f32x4*)(src + i + j * step + 4); }
#pragma unroll
        for (int j = 0; j < 4; ++j) { u32x4 o; o.x = pk2(a[j][0], a[j][1]); o.y = pk2(a[j][2], a[j][3]); o.z = pk2(b[j][0], b[j][1]); o.w = pk2(b[j][2], b[j][3]); *(u32x4*)(dst + i + j * step) = o; } }
    for (; i < n; i += step) { const f32x4 a = *(const f32x4*)(src + i), b = *(const f32x4*)(src + i + 4);
        u32x4 o; o.x = pk2(a[0], a[1]); o.y = pk2(a[2], a[3]); o.z = pk2(b[0], b[1]); o.w = pk2(b[2], b[3]); *(u32x4*)(dst + i) = o; }
}

struct LnArgs { const float* xin32; const bf16_t* xin; float* xout32; bf16_t* xbf; const bf16_t* y; const float* g; const float* b; const int* dest; const float* wts; };
template <int NR, bool XF32, bool OUTF32, bool MOE>
__device__ __forceinline__ void ln_rows(const LnArgs& a, int row0, int lane) {
    float v[NR][2][8];
    {
        int d0[NR], d1[NR]; float w0[NR], w1[NR];
        if (MOE) {
#pragma unroll
            for (int i = 0; i < NR; ++i) { d0[i] = a.dest[(row0 + i) * 2]; d1[i] = a.dest[(row0 + i) * 2 + 1]; w0[i] = a.wts[(row0 + i) * 2]; w1[i] = a.wts[(row0 + i) * 2 + 1]; }
        }
        f32x4 xf[XF32 ? NR : 1][2][2]; u32x4 xb[XF32 ? 1 : NR][2]; u32x4 p[NR][2], q[MOE ? NR : 1][2];
#pragma unroll
        for (int i = 0; i < NR; ++i) {
            const u32x4* y0 = (const u32x4*)(a.y + (size_t)(MOE ? d0[i] : row0 + i) * DM) + lane; const u32x4* y1 = (const u32x4*)(a.y + (size_t)(MOE ? d1[i] : 0) * DM) + lane;
#pragma unroll
            for (int j = 0; j < 2; ++j) {
                if (XF32) { const f32x4* xr = (const f32x4*)(a.xin32 + (size_t)(row0 + i) * DM) + 2 * lane + 128 * j; xf[XF32 ? i : 0][j][0] = xr[0]; xf[XF32 ? i : 0][j][1] = xr[1]; }
                else xb[XF32 ? 0 : i][j] = ((const u32x4*)(a.xin + (size_t)(row0 + i) * DM) + lane)[64 * j];
                p[i][j] = y0[64 * j]; if (MOE) q[MOE ? i : 0][j] = y1[64 * j]; } }
#pragma unroll
        for (int i = 0; i < NR; ++i)
#pragma unroll
            for (int j = 0; j < 2; ++j) {
                float x[8];
                if (XF32) {
#pragma unroll
                    for (int e = 0; e < 4; ++e) { x[e] = xf[XF32 ? i : 0][j][0][e]; x[4 + e] = xf[XF32 ? i : 0][j][1][e]; } }
                else { const u32x4 w = xb[XF32 ? 0 : i][j]; x[0] = bf_lo(w.x); x[1] = bf_hi(w.x); x[2] = bf_lo(w.y); x[3] = bf_hi(w.y); x[4] = bf_lo(w.z); x[5] = bf_hi(w.z); x[6] = bf_lo(w.w); x[7] = bf_hi(w.w); }
                const u32x4 pw = p[i][j]; const float py[8] = {bf_lo(pw.x), bf_hi(pw.x), bf_lo(pw.y), bf_hi(pw.y), bf_lo(pw.z), bf_hi(pw.z), bf_lo(pw.w), bf_hi(pw.w)};
                if (MOE) { const u32x4 qw = q[MOE ? i : 0][j]; const float qy[8] = {bf_lo(qw.x), bf_hi(qw.x), bf_lo(qw.y), bf_hi(qw.y), bf_lo(qw.z), bf_hi(qw.z), bf_lo(qw.w), bf_hi(qw.w)};
#pragma unroll
                    for (int e = 0; e < 8; ++e) v[i][j][e] = ALPHA * x[e] + w0[i] * py[e] + w1[i] * qy[e]; }
                else {
#pragma unroll
                    for (int e = 0; e < 8; ++e) v[i][j][e] = ALPHA * x[e] + py[e]; }
            }
    }
    float s[NR];
#pragma unroll
    for (int i = 0; i < NR; ++i) { s[i] = 0.f;
#pragma unroll
        for (int j = 0; j < 2; ++j)
#pragma unroll
            for (int e = 0; e < 8; ++e) s[i] += v[i][j][e]; }
#pragma unroll
    for (int o = 1; o < 64; o <<= 1)
#pragma unroll
        for (int i = 0; i < NR; ++i) s[i] += shx(s[i], o, lane);
    float q2[NR];
#pragma unroll
    for (int i = 0; i < NR; ++i) { const float mean = s[i] * (1.f / DM); q2[i] = 0.f;
#pragma unroll
        for (int j = 0; j < 2; ++j)
#pragma unroll
            for (int e = 0; e < 8; ++e) { v[i][j][e] -= mean; q2[i] += v[i][j][e] * v[i][j][e]; } }
#pragma unroll
    for (int o = 1; o < 64; o <<= 1)
#pragma unroll
        for (int i = 0; i < NR; ++i) q2[i] += shx(q2[i], o, lane);
    f32x4 gv[2][2], bv[2][2];
#pragma unroll
    for (int j = 0; j < 2; ++j) { const f32x4* gp = (const f32x4*)a.g + 2 * lane + 128 * j; const f32x4* bp = (const f32x4*)a.b + 2 * lane + 128 * j; gv[j][0] = gp[0]; gv[j][1] = gp[1]; bv[j][0] = bp[0]; bv[j][1] = bp[1]; }
#pragma unroll
    for (int i = 0; i < NR; ++i) { const float rstd = rsqrtf(q2[i] * (1.f / DM) + LN_EPS);
#pragma unroll
        for (int j = 0; j < 2; ++j) { float o[8];
#pragma unroll
            for (int e = 0; e < 8; ++e) o[e] = v[i][j][e] * rstd * gv[j][e >> 2][e & 3] + bv[j][e >> 2][e & 3];
            if (OUTF32) { f32x4* xo = (f32x4*)(a.xout32 + (size_t)(row0 + i) * DM) + 2 * lane + 128 * j; xo[0] = (f32x4){o[0], o[1], o[2], o[3]}; xo[1] = (f32x4){o[4], o[5], o[6], o[7]}; }
            else { u32x4 w; w.x = pk2(o[0], o[1]); w.y = pk2(o[2], o[3]); w.z = pk2(o[4], o[5]); w.w = pk2(o[6], o[7]); ((u32x4*)(a.xbf + (size_t)(row0 + i) * DM) + lane)[64 * j] = w; } } }
}
template <bool XF32, bool OUTF32, bool MOE>
__device__ __forceinline__ void ln_phase(const LnArgs& a, int blk, int G, int wave, int lane) {
    const int per = NT / G, r0 = blk * per, pw = per / NWAVE;
    for (int r = 0; r < pw; r += 4) ln_rows<4, XF32, OUTF32, MOE>(a, r0 + wave * pw + r, lane);
}
__device__ __forceinline__ void xattn_phase(LAS unsigned char* lds, const bf16_t* __restrict__ Q, const bf16_t* __restrict__ KC, const bf16_t* __restrict__ VT, bf16_t* __restrict__ O, int blk, int G) {
    const int tid0 = threadIdx.x, wave = __builtin_amdgcn_readfirstlane(tid0 >> 6);
#define XA_IDS int tid = tid0; asm volatile("" : "+v"(tid)); const int lane = tid & 63, r32 = lane & 31, hh = lane >> 5; const size_t qrow = (size_t)b * SEQ + qb * 256 + wave * 32 + r32; (void)lane; (void)hh; (void)qrow;
    for (int u = blk; u < 512; u += G) {
        int qb = u & 15, h = (u >> 4) & 3, b = u >> 6;
        if (G == 256) { const int x = blk & 7, j = blk >> 3, grp = x * 4 + (u >> 8) * 2 + (j >> 4); qb = j & 15; h = grp & 3; b = grp >> 2; }
        XA_IDS;
        bf16x8 qf[16];
#pragma unroll
        for (int ks = 0; ks < 16; ++ks) qf[ks] = *(const bf16x8*)(Q + qrow * 1024 + h * 256 + ks * 16 + hh * 8);
        __syncthreads();
#pragma unroll
        for (int bt = 0; bt < 2; ++bt) {
            u32x4 t[8];
#pragma unroll
            for (int i = 0; i < 8; ++i) { const int ch = tid + 512 * (bt * 8 + i), row = ch >> 5, c = ch & 31; t[i] = *(const u32x4*)(KC + (size_t)(b * 256 + row) * 1024 + h * 256 + c * 8); }
#pragma unroll
            for (int i = 0; i < 8; ++i) { const int ch = tid + 512 * (bt * 8 + i), row = ch >> 5, c = ch & 31; *(LAS u32x4*)(lds + row * 528 + c * 16) = t[i]; }
        }
        __syncthreads();
        f32x16 s[8];
#pragma unroll
        for (int mt = 0; mt < 8; ++mt)
#pragma unroll
            for (int r = 0; r < 16; ++r) s[mt][r] = 0.f;
        {   const LAS unsigned char* kbp = lds + r32 * 528 + hh * 16;
#pragma unroll
            for (int ks = 0; ks < 16; ++ks)
#pragma unroll
                for (int mt = 0; mt < 8; ++mt) { const bf16x8 a = *(const LAS bf16x8*)(kbp + mt * 32 * 528 + ks * 32); s[mt] = MFMA32(a, qf[ks], s[mt]); }
        }
        float mx = -INFINITY;
#pragma unroll
        for (int mt = 0; mt < 8; ++mt)
#pragma unroll
            for (int r = 0; r < 16; ++r) mx = fmaxf(mx, s[mt][r]);
        mx = xhalf_max(mx);
        float sm = 0.f; const float mxl = mx * LOG2E;
        u32x4 pf[8][2];
#pragma unroll
        for (int mt = 0; mt < 8; ++mt)
#pragma unroll
            for (int r = 0; r < 16; ++r) { const float p = __builtin_amdgcn_exp2f(s[mt][r] * LOG2E - mxl); s[mt][r] = p; sm += p; }
        sm = xhalf_sum(sm);
        {   const float inv = 1.f / sm;
#pragma unroll
            for (int mt = 0; mt < 8; ++mt)
#pragma unroll
                for (int sx = 0; sx < 2; ++sx) pf[mt][sx] = (u32x4){pk2(s[mt][8 * sx] * inv, s[mt][8 * sx + 1] * inv), pk2(s[mt][8 * sx + 2] * inv, s[mt][8 * sx + 3] * inv), pk2(s[mt][8 * sx + 4] * inv, s[mt][8 * sx + 5] * inv), pk2(s[mt][8 * sx + 6] * inv, s[mt][8 * sx + 7] * inv)};
        }
        __syncthreads();
        {   XA_IDS;
#pragma unroll
        for (int bt = 0; bt < 4; ++bt) {
            u32x4 t[4];
#pragma unroll
            for (int i = 0; i < 4; ++i) { const int ch = tid + 512 * (bt * 4 + i), row = ch >> 5, c = ch & 31; t[i] = *(const u32x4*)(VT + (size_t)(h * 256 + row) * 2048 + b * 256 + c * 8); }
#pragma unroll
            for (int i = 0; i < 4; ++i) { const int ch = tid + 512 * (bt * 4 + i), row = ch >> 5, c = ch & 31; LAS u32x2* d = (LAS u32x2*)(lds + row * 520 + c * 16); d[0] = (u32x2){t[i].x, t[i].y}; d[1] = (u32x2){t[i].z, t[i].w}; }
        }
        }
        __syncthreads();
        {   XA_IDS;
        bf16_t* otile = O + ((size_t)b * SEQ + qb * 256 + wave * 32) * 1024 + h * 256 + r32;
#pragma unroll 1
        for (int dh = 0; dh < 2; ++dh) {
            f32x16 o[4];
#pragma unroll
            for (int dt = 0; dt < 4; ++dt)
#pragma unroll
                for (int r = 0; r < 16; ++r) o[dt][r] = 0.f;
            const LAS unsigned char* vb = lds + (dh * 128 + r32) * 520 + 8 * hh;
#pragma unroll
            for (int mt = 0; mt < 8; ++mt)
#pragma unroll
                for (int sx = 0; sx < 2; ++sx) { const int kb = mt * 32 + 16 * sx; const bf16x8 pb = __builtin_bit_cast(bf16x8, pf[mt][sx]);
#pragma unroll
                    for (int dt = 0; dt < 4; ++dt) { const LAS unsigned char* q = vb + dt * 32 * 520 + kb * 2;
                        const s16x4 lo = *(const LAS s16x4*)q, hi = *(const LAS s16x4*)(q + 16);
                        const bf16x8 a = (bf16x8){lo[0], lo[1], lo[2], lo[3], hi[0], hi[1], hi[2], hi[3]}; o[dt] = MFMA32(pb, a, o[dt]); } }
#pragma unroll
            for (int dt = 0; dt < 4; ++dt)
#pragma unroll
                for (int r = 0; r < 16; ++r) otile[(size_t)crow(r, hh) * 1024 + dh * 128 + dt * 32] = f2bf(o[dt][r]);
        }
        }
    }
#undef XA_IDS
}

struct RouteBufs { int* e; float* w; int* rank; int* dest; int* hist; int* tstart; int* src; };
__device__ __forceinline__ void moe_router_phase(LAS unsigned char* lds, const bf16_t* __restrict__ XBF, const bf16_t* __restrict__ WRT, const float* __restrict__ brg, const float* __restrict__ bre, const RouteBufs rb, int blk) {
    int tid_ = threadIdx.x; asm volatile("" : "+v"(tid_)); const int tid = tid_, lane = tid & 63, wave = __builtin_amdgcn_readfirstlane(tid >> 6), r32 = lane & 31, hh = lane >> 5;
    LAS unsigned char* XT = lds; LAS unsigned char* WT = lds + 128 * 528;
    LAS float* LG = (LAS float*)lds;
    LAS int* hist = (LAS int*)(lds + 128 * 65 * 4);
    const int rbk = wave & 3, ct = wave >> 2;
    f32x16 acc;
#pragma unroll
    for (int r = 0; r < 16; ++r) acc[r] = 0.f;
#pragma unroll 1
    for (int kc = 0; kc < 4; ++kc) {
        __syncthreads();
        {   u32x4 tx[8], tw[8];
#pragma unroll
            for (int i = 0; i < 8; ++i) { const int ch = tid + 512 * i, row = ch >> 5, c = ch & 31; tx[i] = *(const u32x4*)(XBF + (size_t)(blk * 128 + row) * 1024 + kc * 256 + c * 8); tw[i] = *(const u32x4*)(WRT + (size_t)row * 1024 + kc * 256 + c * 8); }
#pragma unroll
            for (int i = 0; i < 8; ++i) { const int ch = tid + 512 * i, row = ch >> 5, c = ch & 31; *(LAS u32x4*)(XT + row * 528 + c * 16) = tx[i]; *(LAS u32x4*)(WT + row * 528 + c * 16) = tw[i]; } }
        __syncthreads();
        const LAS unsigned char* ap = XT + (rbk * 32 + r32) * 528 + hh * 16; const LAS unsigned char* bp = WT + (ct * 32 + r32) * 528 + hh * 16;
#pragma unroll
        for (int ks = 0; ks < 16; ++ks) { const bf16x8 a = *(const LAS bf16x8*)(ap + ks * 32), b0 = *(const LAS bf16x8*)(bp + ks * 32), b1 = *(const LAS bf16x8*)(bp + 64 * 528 + ks * 32);
            acc = MFMA32(a, b0, acc); acc = MFMA32(a, b1, acc); }
    }
    __syncthreads();
    if (tid < 32) hist[tid] = 0;
#pragma unroll
    for (int r = 0; r < 16; ++r) LG[(rbk * 32 + crow(r, hh)) * 65 + ct * 32 + r32] = acc[r];
    __syncthreads();
    if (tid < 128) {
        const LAS float* lg = LG + tid * 65; const int tok = blk * 128 + tid;
        float g4[4];
#pragma unroll
        for (int g = 0; g < 4; ++g) g4[g] = lg[32 + g] + brg[g];
        int gi = 0; float gm = g4[0];
#pragma unroll
        for (int g = 1; g < 4; ++g) if (g4[g] > gm) { gm = g4[g]; gi = g; }
        float gs = 0.f;
#pragma unroll
        for (int g = 0; g < 4; ++g) gs += fast_exp(g4[g] - gm);
        const float gate_g = 1.f / gs;
        float le[8];
#pragma unroll
        for (int e = 0; e < 8; ++e) le[e] = lg[gi * 8 + e] + bre[gi * 8 + e];
        int i0 = 0; float v0 = le[0];
#pragma unroll
        for (int e = 1; e < 8; ++e) if (le[e] > v0) { v0 = le[e]; i0 = e; }
        int i1 = 0; float v1 = -INFINITY;
#pragma unroll
        for (int e = 0; e < 8; ++e) if (e != i0 && le[e] > v1) { v1 = le[e]; i1 = e; }
        const float e1 = fast_exp(v1 - v0), p0 = 1.f / (1.f + e1), p1 = e1 * p0;
        const int ex0 = gi * 8 + i0, ex1 = gi * 8 + i1;
        rb.e[tok * 2] = ex0; rb.e[tok * 2 + 1] = ex1; rb.w[tok * 2] = gate_g * p0; rb.w[tok * 2 + 1] = gate_g * p1;
        rb.rank[tok * 2] = atomicAdd((int*)&hist[ex0], 1); rb.rank[tok * 2 + 1] = atomicAdd((int*)&hist[ex1], 1);
    }
    __syncthreads();
    if (tid < 32) rb.hist[blk * 32 + tid] = hist[tid];
}
__device__ __forceinline__ void moe_scatter_phase(LAS unsigned char* lds, const RouteBufs rb, int blk, int G) {
    int tid_ = threadIdx.x; asm volatile("" : "+v"(tid_)); const int tid = tid_, lane = tid & 63, wave = __builtin_amdgcn_readfirstlane(tid >> 6);
    LAS int* sb = (LAS int*)lds;
    __syncthreads();
    {
        const int e = tid & 31, part = tid >> 5; int c[16];
#pragma unroll
        for (int i = 0; i < 16; ++i) c[i] = rb.hist[(part * 16 + i) * 32 + e];
        int tot = 0, base = 0;
#pragma unroll
        for (int i = 0; i < 16; ++i) { tot += c[i]; if (part * 16 + i < blk) base += c[i]; }
        sb[128 + part * 32 + e] = base; sb[128 + 512 + part * 32 + e] = tot; }
    __syncthreads();
    if (tid < 32) { int tot = 0, base = 0;
#pragma unroll
        for (int i = 0; i < 16; ++i) { base += sb[128 + i * 32 + tid]; tot += sb[128 + 512 + i * 32 + tid]; }
        sb[tid] = base; sb[32 + tid] = tot; }
    __syncthreads();
    if (tid == 0) { int acc = 0; for (int e = 0; e < 32; ++e) { sb[64 + e] = acc; if (blk == 0) rb.tstart[e] = acc >> 8; acc += (sb[32 + e] + 255) & ~255; } sb[96] = acc; if (blk == 0) rb.tstart[32] = acc >> 8; }
    __syncthreads();
    if (tid < 256) { const int idx = blk * 256 + tid; const int e = rb.e[idx]; const int d = sb[64 + e] + sb[e] + rb.rank[idx]; rb.dest[idx] = d; rb.src[d] = idx >> 1; }
    if (blk < 32) { const int e = blk; const int lo = sb[64 + e] + sb[32 + e], hi = sb[64 + e] + ((sb[32 + e] + 255) & ~255); for (int r = lo + tid; r < hi; r += NTHR) rb.src[r] = 0; }
}
struct MoeSched {
    const char* A; const char* B; const int* tstart; int K, nN, G, c; size_t bexp;
    __device__ __forceinline__ pg8::Unit get(int i, bool& ok) const { pg8::Unit u; u.A = nullptr; u.B = nullptr; u.src = nullptr; u.pm = 0; u.pn = 0; u.job = 0; ok = next(i, u); return u; }
    __device__ __forceinline__ bool next(int i, pg8::Unit& u) const {
        const int vc = (c & 7) * (G >> 3) + (c >> 3);
        const long L = (long)i * G + vc; const int ntile = tstart[32];
        if (L >= (long)ntile * nN) return false;
        const int mt = (int)(L / nN), nt = (int)(L % nN);
        int e = 0;
        for (int k = 1; k < 32; ++k) if (tstart[k] <= mt) e = k;
        u.A = A + (size_t)mt * 256 * K * 2; u.B = B + (size_t)e * bexp + (size_t)nt * 256 * K * 2; u.src = nullptr; u.pm = mt; u.pn = nt; u.job = 0; return true;
    }
};
__device__ __forceinline__ void swa_phase(LAS unsigned char* lds, const bf16_t* __restrict__ Q1, const bf16_t* __restrict__ K1, const bf16_t* __restrict__ VT1, const float* __restrict__ sinks, bf16_t* __restrict__ O, int blk, int G) {
    int tid_ = threadIdx.x; asm volatile("" : "+v"(tid_)); const int tid = tid_, lane = tid & 63, wave = __builtin_amdgcn_readfirstlane(tid >> 6), r32 = lane & 31, hh = lane >> 5;
    LAS unsigned char* KL = lds;
    LAS unsigned char* VL = lds + 36864;
    auto umap = [&](int u, int& n, int& kvh, int& b) { n = u & 31; kvh = (u >> 5) & 3; b = u >> 7;
        if (G == 256) { const int grp = (u >> 8) * 8 + (blk & 7); n = blk >> 3; kvh = grp & 3; b = grp >> 2; } };
    u32x4 pkb[4], pvb[4];
#define SWA_BAND_LOADS(UU) do { int n_, kvh_, b_; umap((UU), n_, kvh_, b_); const int tokb_ = b_ * SEQ + (n_ - 1) * 128; \
        _Pragma("unroll") for (int i = 0; i < 4; ++i) { const int ch = tid + 512 * i; const int key = ch >> 3, c = ch & 7; \
            u32x4 v = (u32x4){0u, 0u, 0u, 0u}; if (n_ > 0 || key >= 128) v = *(const u32x4*)(K1 + (size_t)(tokb_ + key) * 256 + kvh_ * 64 + c * 8); pkb[i] = v; } \
        _Pragma("unroll") for (int i = 0; i < 4; ++i) { const int ch = tid + 512 * i; const int d = ch >> 5, c = ch & 31; \
            u32x4 v = (u32x4){0u, 0u, 0u, 0u}; if (n_ > 0 || c >= 16) v = *(const u32x4*)(VT1 + (size_t)(kvh_ * 64 + d) * NT + tokb_ + c * 8); pvb[i] = v; } } while (0)
    if (blk < 1024) SWA_BAND_LOADS(blk);
    for (int u = blk; u < 1024; u += G) {
        int n, kvh, b; umap(u, n, kvh, b);
        bf16x8 qfa[2][4];
        {   const int g0 = wave >> 1, hq0 = kvh * 4 + g0;
#pragma unroll
            for (int sb = 0; sb < 2; ++sb)
#pragma unroll
                for (int ks = 0; ks < 4; ++ks) qfa[sb][ks] = *(const bf16x8*)(Q1 + ((size_t)b * SEQ + n * 128 + (wave & 1) * 64 + sb * 32 + r32) * 1024 + hq0 * 64 + ks * 16 + hh * 8); }
        __syncthreads();
#pragma unroll
        for (int i = 0; i < 4; ++i) { const int ch = tid + 512 * i; const int key = ch >> 3, c = ch & 7; *(LAS u32x4*)(KL + key * 144 + c * 16) = pkb[i]; }
#pragma unroll
        for (int i = 0; i < 4; ++i) { const int ch = tid + 512 * i; const int d = ch >> 5, c = ch & 31; const u32x4 v = pvb[i];
            LAS u32x2* dp = (LAS u32x2*)(VL + d * 520 + c * 16); dp[0] = (u32x2){v.x, v.y}; dp[1] = (u32x2){v.z, v.w}; }
        { const int un = u + G < 1024 ? u + G : u; SWA_BAND_LOADS(un); }
        __syncthreads();
        const int g = wave >> 1, hq = kvh * 4 + g; const float sink = sinks[hq];
#pragma unroll 1
        for (int sb = 0; sb < 2; ++sb) {
            bf16x8 qf[4];
#pragma unroll
            for (int ks = 0; ks < 4; ++ks) qf[ks] = sb ? qfa[1][ks] : qfa[0][ks];
            const int i0 = (wave & 1) * 64 + sb * 32, jt0 = i0 >> 5;
            const size_t qtok = (size_t)b * SEQ + n * 128 + i0 + r32;
            f32x16 s[5];
#pragma unroll
            for (int t = 0; t < 5; ++t) {
#pragma unroll
                for (int r = 0; r < 16; ++r) s[t][r] = 0.f;
                const LAS unsigned char* kp = KL + ((jt0 + t) * 32 + r32) * 144 + hh * 16;
#pragma unroll
                for (int ks = 0; ks < 4; ++ks) { const bf16x8 a = *(const LAS bf16x8*)(kp + ks * 32); s[t] = MFMA32(a, qf[ks], s[t]); }
            }
            const int qi = i0 + r32;
            float mx = sink;
#pragma unroll
            for (int t = 0; t < 5; ++t)
#pragma unroll
                for (int r = 0; r < 16; ++r) { const int kj = (jt0 + t) * 32 + crow(r, hh); const bool valid = (kj > qi) && (kj <= qi + 128) && (n > 0 || kj >= 128);
                    s[t][r] = valid ? s[t][r] : -INFINITY; mx = fmaxf(mx, s[t][r]); }
            mx = xhalf_max(mx);
            float sm = 0.f; const float mxl = mx * LOG2E;
            u32x4 pf[5][2];
#pragma unroll
            for (int t = 0; t < 5; ++t) {
#pragma unroll
                for (int r = 0; r < 16; ++r) { const float pv = __builtin_amdgcn_exp2f(s[t][r] * LOG2E - mxl); s[t][r] = pv; sm += pv; }
#pragma unroll
                for (int sx = 0; sx < 2; ++sx) pf[t][sx] = (u32x4){pk2(s[t][8 * sx], s[t][8 * sx + 1]), pk2(s[t][8 * sx + 2], s[t][8 * sx + 3]), pk2(s[t][8 * sx + 4], s[t][8 * sx + 5]), pk2(s[t][8 * sx + 6], s[t][8 * sx + 7])};
            }
            sm = xhalf_sum(sm) + __builtin_amdgcn_exp2f(sink * LOG2E - mxl);
            f32x16 o[2];
#pragma unroll
            for (int dt = 0; dt < 2; ++dt)
#pragma unroll
                for (int r = 0; r < 16; ++r) o[dt][r] = 0.f;
#pragma unroll
            for (int t = 0; t < 5; ++t)
#pragma unroll
                for (int sx = 0; sx < 2; ++sx) { const bf16x8 pb = __builtin_bit_cast(bf16x8, pf[t][sx]);
#pragma unroll
                    for (int dt = 0; dt < 2; ++dt) { const LAS unsigned char* q = VL + (dt * 32 + r32) * 520 + ((jt0 + t) * 32 + 16 * sx + 4 * hh) * 2;
                        const s16x4 lo = *(const LAS s16x4*)q, hi = *(const LAS s16x4*)(q + 16);
                        const bf16x8 a = (bf16x8){lo[0], lo[1], lo[2], lo[3], hi[0], hi[1], hi[2], hi[3]}; o[dt] = MFMA32(a, pb, o[dt]); } }
            const float inv = 1.f / sm;
            bf16_t* orow = O + qtok * 1024 + hq * 64 + 4 * hh;
#pragma unroll
            for (int dt = 0; dt < 2; ++dt)
#pragma unroll
                for (int gq = 0; gq < 4; ++gq) { u32x2 w; w.x = pk2(o[dt][4 * gq] * inv, o[dt][4 * gq + 1] * inv); w.y = pk2(o[dt][4 * gq + 2] * inv, o[dt][4 * gq + 3] * inv); *(u32x2*)(orow + dt * 32 + 8 * gq) = w; }
        }
    }
}
#undef SWA_BAND_LOADS
constexpr int TS = 272;
template <int STRIDE = TS>
__device__ __forceinline__ bf16x8 tr_frag(const LAS unsigned char* T, int k0, int c0, int lane, bool permuted) {
    const int hh = lane >> 5, blk = (lane >> 4) & 1, q = (lane & 15) >> 2, pp = lane & 3;
    const int r0 = k0 + (permuted ? 4 * hh : 8 * hh) + q, r1 = r0 + (permuted ? 8 : 4);
    const int cb = (c0 + 16 * blk + 4 * pp) * 2;
    const s16x4 lo = lds_tr(T + r0 * STRIDE + cb), hi = lds_tr(T + r1 * STRIDE + cb);
    return (bf16x8){lo[0], lo[1], lo[2], lo[3], hi[0], hi[1], hi[2], hi[3]};
}
__device__ __forceinline__ bf16x8 row_frag(const LAS unsigned char* T, int row, int k0, int hh) { return *(const LAS bf16x8*)(T + row * TS + (k0 + 8 * hh) * 2); }
__device__ __forceinline__ void load_tile128(LAS unsigned char* T, const bf16_t* __restrict__ g, int ld, int tid) {
#pragma unroll
    for (int i = 0; i < 4; ++i) { const int ch = tid + 512 * i, row = ch >> 4, c = ch & 15; *(LAS u32x4*)(T + row * TS + c * 16) = *(const u32x4*)(g + (size_t)row * ld + c * 8); }
}
struct L0Bufs {
    bf16_t *AU, *AV, *BX, *BZ, *V, *XC, *YM, *CS, *Q, *K, *U; float *GT, *UN, *NS, *SC;
    const bf16_t *WQT, *GMW, *MT; const float *gm_g, *gm_b, *gm_bs, *cw, *cb, *bif, *nw, *skip;
};

__device__ __forceinline__ void l0_mixA(LAS unsigned char* lds, const L0Bufs& B, int blk, int G, int skip = 0) {
    const int tid0 = threadIdx.x, wave = __builtin_amdgcn_readfirstlane(tid0 >> 6);
#define OPQ_IDS int tid = tid0; asm volatile("" : "+v"(tid)); const int lane = tid & 63, r32 = lane & 31, hh = lane >> 5; (void)lane; (void)r32; (void)hh;
    LAS unsigned char* T0 = lds; LAS unsigned char* T1 = lds + 34816; LAS unsigned char* T2 = lds + 2 * 34816; LAS unsigned char* T3 = lds + 3 * 34816;
    LAS float* SF = (LAS float*)T2;
    LAS float* SG = (LAS float*)(lds + 3 * 34816 + 35632);
    for (int u = blk; u < 256; u += G) {
        const int tok0 = u * 128; const bool first = (u & 31) == 0;
        if (!(skip & 1)) {
        constexpr int VS = 1040;
        {   OPQ_IDS; const int trow = tid >> 2, q4 = tid & 3;
            const bf16_t* vr = B.AV + (size_t)(tok0 + trow) * 512 + q4 * 128; float s = 0.f, s2 = 0.f; u32x4 w[16];
#pragma unroll
            for (int i = 0; i < 16; ++i) w[i] = *(const u32x4*)(vr + i * 8);
#pragma unroll
            for (int i = 0; i < 16; ++i) { const float f[8] = {bf_lo(w[i].x), bf_hi(w[i].x), bf_lo(w[i].y), bf_hi(w[i].y), bf_lo(w[i].z), bf_hi(w[i].z), bf_lo(w[i].w), bf_hi(w[i].w)};
#pragma unroll
                for (int e = 0; e < 8; ++e) { s += f[e]; s2 += f[e] * f[e]; } }
            s += shx(s, 1, lane); s += shx(s, 2, lane); s2 += shx(s2, 1, lane); s2 += shx(s2, 2, lane);
            const float mean = s * (1.f / 512.f), rstd = rsqrtf(fmaxf(s2 * (1.f / 512.f) - mean * mean, 0.f) + LN_EPS);
            __syncthreads();
#pragma unroll
            for (int i = 0; i < 16; ++i) { const int cbase = q4 * 128 + i * 8; const f32x4 g0 = *(const f32x4*)(B.gm_g + cbase), g1 = *(const f32x4*)(B.gm_g + cbase + 4), b0 = *(const f32x4*)(B.gm_b + cbase), b1 = *(const f32x4*)(B.gm_b + cbase + 4);
                u32x4 o; o.x = pk2((bf_lo(w[i].x) - mean) * rstd * g0[0] + b0[0], (bf_hi(w[i].x) - mean) * rstd * g0[1] + b0[1]); o.y = pk2((bf_lo(w[i].y) - mean) * rstd * g0[2] + b0[2], (bf_hi(w[i].y) - mean) * rstd * g0[3] + b0[3]);
                o.z = pk2((bf_lo(w[i].z) - mean) * rstd * g1[0] + b1[0], (bf_hi(w[i].z) - mean) * rstd * g1[1] + b1[1]); o.w = pk2((bf_lo(w[i].w) - mean) * rstd * g1[2] + b1[2], (bf_hi(w[i].w) - mean) * rstd * g1[3] + b1[3]);
                *(LAS u32x4*)(lds + trow * VS + cbase * 2) = o; asm volatile("" ::: "memory"); }
            __syncthreads();
        }
        {   const int tb = wave & 3, dhf = wave >> 2;
            bf16x8 nbw[8]; u32x2 naup[2][4]; float nbsv;
#define GM_LOADS(GN) do { const bf16_t* wrow_ = B.GMW + ((size_t)(GN) * 128 + t) * 128 + 8 * hh; \
                _Pragma("unroll") for (int ks = 0; ks < 8; ++ks) nbw[ks] = *(const bf16x8*)(wrow_ + 16 * ks); \
                _Pragma("unroll") for (int dt = 0; dt < 2; ++dt) _Pragma("unroll") for (int gq = 0; gq < 4; ++gq) naup[dt][gq] = *(const u32x2*)(B.AU + tok * 512 + (GN) * 128 + 64 * dhf + 32 * dt + 8 * gq + 4 * hh); \
                nbsv = B.gm_bs[(GN) * 128 + t]; } while (0)
            {   OPQ_IDS; const int t = 32 * tb + r32; const size_t tok = (size_t)tok0 + t; GM_LOADS(0); }
#pragma unroll 1
            for (int g = 0; g < 4; ++g) {
                OPQ_IDS; const int t = 32 * tb + r32; const size_t tok = (size_t)tok0 + t;
                f32x16 acc[2];
#pragma unroll
                for (int dt = 0; dt < 2; ++dt)
#pragma unroll
                    for (int r = 0; r < 16; ++r) acc[dt][r] = 0.f;
                bf16x8 bw[8]; u32x2 aup[2][4];
#pragma unroll
                for (int ks = 0; ks < 8; ++ks) bw[ks] = nbw[ks];
#pragma unroll
                for (int dt = 0; dt < 2; ++dt)
#pragma unroll
                    for (int gq = 0; gq < 4; ++gq) aup[dt][gq] = naup[dt][gq];
                const float bsv = nbsv;
                { const int gn = g < 3 ? g + 1 : 3; GM_LOADS(gn); }
#pragma unroll
                for (int ks = 0; ks < 8; ++ks) if (ks <= 2 * tb + 1) {
#pragma unroll
                    for (int dt = 0; dt < 2; ++dt) { const bf16x8 a = tr_frag<VS>(lds, 16 * ks, g * 128 + 64 * dhf + 32 * dt, lane, false); acc[dt] = MFMA32(a, bw[ks], acc[dt]); } }
#pragma unroll
                for (int dt = 0; dt < 2; ++dt)
#pragma unroll
                    for (int gq = 0; gq < 4; ++gq) { const int col = g * 128 + 64 * dhf + 32 * dt + 8 * gq + 4 * hh; const u32x2 au = aup[dt][gq];
                        u32x2 w; w.x = pk2(bf_lo(au.x) * (acc[dt][4 * gq] + bsv), bf_hi(au.x) * (acc[dt][4 * gq + 1] + bsv)); w.y = pk2(bf_lo(au.y) * (acc[dt][4 * gq + 2] + bsv), bf_hi(au.y) * (acc[dt][4 * gq + 3] + bsv));
                        *(u32x2*)(B.YM + tok * 1024 + col) = w; }
            }
        }
        }
        f32x16 accg;
#pragma unroll
        for (int r = 0; r < 16; ++r) accg[r] = 0.f;
        LAS unsigned char* MTL = (LAS unsigned char*)SG;
        u32x4 pxm[5], pwq[4], pwk[4], pwv[4], pmt;
#define P1_LOADS_A(HN) do { _Pragma("unroll") for (int i = 0; i < 5; ++i) { const int ch = tid + 512 * i, row = ch >> 4, c = ch & 15; u32x4 v = (u32x4){0u, 0u, 0u, 0u}; \
                if (ch < 131 * 16 && !(first && row < 3)) v = *(const u32x4*)(B.BX + (size_t)(tok0 - 3 + row) * 512 + (HN) * 128 + c * 8); pxm[i] = v; } \
            _Pragma("unroll") for (int i = 0; i < 4; ++i) { const int ch = tid + 512 * i, row = ch >> 4, c = ch & 15; pwq[i] = *(const u32x4*)(B.WQT + ((size_t)0 * 4 + (HN)) * 128 * 128 + (size_t)row * 128 + c * 8); pwk[i] = *(const u32x4*)(B.WQT + ((size_t)1 * 4 + (HN)) * 128 * 128 + (size_t)row * 128 + c * 8); } \
            pmt = *(const u32x4*)(B.MT + ((size_t)(HN) * 8 + ((tid & 255) >> 5)) * 256 + (tid & 31) * 8); } while (0)
#define P1_LOADS_V(HN) do { _Pragma("unroll") for (int i = 0; i < 4; ++i) { const int ch = tid + 512 * i, row = ch >> 4, c = ch & 15; pwv[i] = *(const u32x4*)(B.WQT + ((size_t)2 * 4 + (HN)) * 128 * 128 + (size_t)row * 128 + c * 8); } } while (0)
        {   OPQ_IDS; P1_LOADS_A(0); P1_LOADS_V(0); }
#pragma unroll 1
        for (int h = 0; h < ((skip & 2) ? 0 : 4); ++h) {
            OPQ_IDS;
            float w[4][8], cbv[8];
            {   const int chn = h * 128 + (tid & 15) * 8;
#pragma unroll
                for (int j = 0; j < 4; ++j) { const f32x4 w0 = *(const f32x4*)(B.cw + j * 512 + chn), w1 = *(const f32x4*)(B.cw + j * 512 + chn + 4);
#pragma unroll
                    for (int e = 0; e < 4; ++e) { w[j][e] = w0[e]; w[j][4 + e] = w1[e]; } }
                const f32x4 c0 = *(const f32x4*)(B.cb + chn), c1 = *(const f32x4*)(B.cb + chn + 4);
#pragma unroll
                for (int e = 0; e < 4; ++e) { cbv[e] = c0[e]; cbv[4 + e] = c1[e]; } }
            __syncthreads();
#pragma unroll
            for (int i = 0; i < 5; ++i) { const int ch = tid + 512 * i, row = ch >> 4, c = ch & 15; if (ch < 131 * 16) *(LAS u32x4*)(T3 + row * TS + c * 16) = pxm[i]; }
#pragma unroll
            for (int i = 0; i < 4; ++i) { const int ch = tid + 512 * i, row = ch >> 4, c = ch & 15; *(LAS u32x4*)(T0 + row * TS + c * 16) = pwq[i]; *(LAS u32x4*)(T1 + row * TS + c * 16) = pwk[i]; }
            if (tid < 256) { const int row = tid >> 5, c = tid & 31; *(LAS u32x4*)(MTL + row * 528 + c * 16) = pmt; }
            { const int hn = h < 3 ? h + 1 : 3; P1_LOADS_A(hn); }
            __syncthreads();
            {   const int dc = tid & 15, chn = h * 128 + dc * 8;
#pragma unroll 1
                for (int ps = 0; ps < 4; ++ps) { const int t = ps * 32 + (tid >> 4); float a[8];
#pragma unroll
                    for (int e = 0; e < 8; ++e) a[e] = cbv[e];
#pragma unroll
                    for (int j = 0; j < 4; ++j) { const u32x4 x = *(const LAS u32x4*)(T3 + (t + j) * TS + dc * 16);
                        a[0] += w[j][0] * bf_lo(x.x); a[1] += w[j][1] * bf_hi(x.x); a[2] += w[j][2] * bf_lo(x.y); a[3] += w[j][3] * bf_hi(x.y);
                        a[4] += w[j][4] * bf_lo(x.z); a[5] += w[j][5] * bf_hi(x.z); a[6] += w[j][6] * bf_lo(x.w); a[7] += w[j][7] * bf_hi(x.w); }
                    u32x4 o; o.x = pk2(silu_f(a[0]), silu_f(a[1])); o.y = pk2(silu_f(a[2]), silu_f(a[3])); o.z = pk2(silu_f(a[4]), silu_f(a[5])); o.w = pk2(silu_f(a[6]), silu_f(a[7]));
                    *(LAS u32x4*)(T2 + t * TS + dc * 16) = o; *(u32x4*)(B.XC + (size_t)(tok0 + t) * 512 + chn) = o; } }
            __syncthreads();
            {   const int tb = wave & 3, ehf = wave >> 2;
                {
                    OPQ_IDS; const LAS unsigned char* act = ehf ? T3 + 3 * TS : T2;
#pragma unroll
                    for (int ks = 0; ks < 8; ++ks) { const bf16x8 a = *(const LAS bf16x8*)(MTL + (r32 & 7) * 528 + (ehf * 128 + 16 * ks + 8 * hh) * 2); const bf16x8 bx = row_frag(act, 32 * tb + r32, 16 * ks, hh); accg = MFMA32(a, bx, accg); } }
#pragma unroll 1
                for (int mtx = 0; mtx < 2; ++mtx) {
                    OPQ_IDS;
                    const LAS unsigned char* wt = mtx ? T1 : T0;
                    f32x16 acc[2];
#pragma unroll
                    for (int et = 0; et < 2; ++et)
#pragma unroll
                        for (int r = 0; r < 16; ++r) acc[et][r] = 0.f;
#pragma unroll
                    for (int ks = 0; ks < 8; ++ks) { const bf16x8 bx = row_frag(T2, 32 * tb + r32, 16 * ks, hh);
#pragma unroll
                        for (int et = 0; et < 2; ++et) { const bf16x8 a = row_frag(wt, 64 * ehf + 32 * et + r32, 16 * ks, hh); acc[et] = MFMA32(a, bx, acc[et]); } }
                    bf16_t* dst = (mtx == 0 ? B.Q : B.K) + (size_t)(tok0 + 32 * tb + r32) * 512 + h * 128 + 64 * ehf + 4 * hh;
#pragma unroll
                    for (int et = 0; et < 2; ++et)
#pragma unroll
                        for (int gq = 0; gq < 4; ++gq) { u32x2 w; w.x = pk2(acc[et][4 * gq], acc[et][4 * gq + 1]); w.y = pk2(acc[et][4 * gq + 2], acc[et][4 * gq + 3]); *(u32x2*)(dst + 32 * et + 8 * gq) = w; }
                }
            }
            __syncthreads();
            {   OPQ_IDS;
#pragma unroll
                for (int i = 0; i < 4; ++i) { const int ch = tid + 512 * i, row = ch >> 4, c = ch & 15; *(LAS u32x4*)(T0 + row * TS + c * 16) = pwv[i]; }
                const int hn = h < 3 ? h + 1 : 3; P1_LOADS_V(hn); }
            __syncthreads();
            {   OPQ_IDS; const int tb = wave & 3, ehf = wave >> 2;
                f32x16 acc[2];
#pragma unroll
                for (int et = 0; et < 2; ++et)
#pragma unroll
                    for (int r = 0; r < 16; ++r) acc[et][r] = 0.f;
#pragma unroll
                for (int ks = 0; ks < 8; ++ks) { const bf16x8 bx = row_frag(T3 + 3 * TS, 32 * tb + r32, 16 * ks, hh);
#pragma unroll
                    for (int et = 0; et < 2; ++et) { const bf16x8 a = row_frag(T0, 64 * ehf + 32 * et + r32, 16 * ks, hh); acc[et] = MFMA32(a, bx, acc[et]); } }
                bf16_t* dst = B.V + (size_t)(tok0 + 32 * tb + r32) * 512 + h * 128 + 64 * ehf + 4 * hh;
#pragma unroll
                for (int et = 0; et < 2; ++et)
#pragma unroll
                    for (int gq = 0; gq < 4; ++gq) { u32x2 w; w.x = pk2(acc[et][4 * gq], acc[et][4 * gq + 1]); w.y = pk2(acc[et][4 * gq + 2], acc[et][4 * gq + 3]); *(u32x2*)(dst + 32 * et + 8 * gq) = w; }
            }
        }
        __syncthreads();
        {   OPQ_IDS; const int tb = wave & 3, kh = wave >> 2;
#pragma unroll
            for (int r = 0; r < 4; ++r) SF[(kh * 8 + r + 4 * hh) * 128 + 32 * tb + r32] = accg[r];
        }
        __syncthreads();
        LAS float* IG = SG; LAS float* BC = SG + 512; LAS float* WG = SG + 1024;
        if (wave < 4) {
            OPQ_IDS; const int h = wave; float lf[2], ig[2];
#pragma unroll
            for (int e = 0; e < 2; ++e) { const int t = 2 * lane + e; ig[e] = SF[h * 128 + t] + SF[(8 + h) * 128 + t] + B.bif[h];
                const float fx = SF[(4 + h) * 128 + t] + SF[(12 + h) * 128 + t] + B.bif[4 + h]; lf[e] = fminf(fx, 0.f) - log1pf(expf(-fabsf(fx))); }
            float run = lf[0] + lf[1];
#pragma unroll
            for (int o = 1; o < 64; o <<= 1) { const float v = shup(run, o, lane); if (lane >= o) run += v; }
            const float b1 = run, b0 = run - lf[1];
            IG[h * 128 + 2 * lane] = ig[0]; IG[h * 128 + 2 * lane + 1] = ig[1]; BC[h * 128 + 2 * lane] = b0; BC[h * 128 + 2 * lane + 1] = b1;
            float* gt = B.GT + ((size_t)u * 4 + h) * 256;
            gt[2 * lane] = ig[0]; gt[2 * lane + 1] = ig[1]; gt[128 + 2 * lane] = b0; gt[128 + 2 * lane + 1] = b1;
            const float bl = shidx(b1, 63);
            float g0 = bl - b0 + ig[0], g1 = bl - b1 + ig[1]; float mloc = fmaxf(g0, g1);
#pragma unroll
            for (int o = 1; o < 64; o <<= 1) mloc = fmaxf(mloc, shx(mloc, o, lane));
            WG[h * 128 + 2 * lane] = expf(g0 - mloc); WG[h * 128 + 2 * lane + 1] = expf(g1 - mloc);
            if (lane == 0) { B.SC[u * 4 + h] = bl; B.SC[1024 + u * 4 + h] = mloc; }
        }
        u32x4 pfv[4], pfk[4];
        {   OPQ_IDS;
#pragma unroll
            for (int i = 0; i < 4; ++i) { const int ch = tid + 512 * i, row = ch >> 4, c = ch & 15; pfv[i] = *(const u32x4*)(B.V + (size_t)(tok0 + row) * 512 + c * 8); pfk[i] = *(const u32x4*)(B.K + (size_t)(tok0 + row) * 512 + c * 8); } }
#pragma unroll 1
        for (int h = 0; h < ((skip & 4) ? 0 : 4); ++h) {
            OPQ_IDS;
            __syncthreads();
#pragma unroll
            for (int i = 0; i < 4; ++i) { const int ch = tid + 512 * i, row = ch >> 4, c = ch & 15; const float wg = WG[h * 128 + row];
                const u32x4 v = pfv[i], k = pfk[i];
                u32x4 ov, ok; const float ksc = 0.08838834764831845f;
                ov.x = pk2(bf_lo(v.x) * wg, bf_hi(v.x) * wg); ov.y = pk2(bf_lo(v.y) * wg, bf_hi(v.y) * wg); ov.z = pk2(bf_lo(v.z) * wg, bf_hi(v.z) * wg); ov.w = pk2(bf_lo(v.w) * wg, bf_hi(v.w) * wg);
                ok.x = pk2(bf_lo(k.x) * ksc, bf_hi(k.x) * ksc); ok.y = pk2(bf_lo(k.y) * ksc, bf_hi(k.y) * ksc); ok.z = pk2(bf_lo(k.z) * ksc, bf_hi(k.z) * ksc); ok.w = pk2(bf_lo(k.w) * ksc, bf_hi(k.w) * ksc);
                *(LAS u32x4*)(T0 + row * TS + c * 16) = ov; *(LAS u32x4*)(T1 + row * TS + c * 16) = ok; }
            {   const int hn = h < 3 ? h + 1 : 3;
#pragma unroll
                for (int i = 0; i < 4; ++i) { const int ch = tid + 512 * i, row = ch >> 4, c = ch & 15; pfv[i] = *(const u32x4*)(B.V + (size_t)(tok0 + row) * 512 + hn * 128 + c * 8); pfk[i] = *(const u32x4*)(B.K + (size_t)(tok0 + row) * 512 + hn * 128 + c * 8); } }
            __syncthreads();
            const int vb = wave & 3, khf = wave >> 2;
            f32x16 acc[2];
#pragma unroll
            for (int kt = 0; kt < 2; ++kt)
#pragma unroll
                for (int r = 0; r < 16; ++r) acc[kt][r] = 0.f;
#pragma unroll
            for (int ks = 0; ks < 8; ++ks) { const bf16x8 a = tr_frag(T0, 16 * ks, 32 * vb, lane, false);
#pragma unroll
                for (int kt = 0; kt < 2; ++kt) { const bf16x8 bk = tr_frag(T1, 16 * ks, 64 * khf + 32 * kt, lane, false); acc[kt] = MFMA32(a, bk, acc[kt]); } }
            bf16_t* Uo = B.U + ((size_t)u * 4 + h) * 16384;
#pragma unroll
            for (int kt = 0; kt < 2; ++kt)
#pragma unroll
                for (int r = 0; r < 16; ++r) Uo[(32 * vb + crow(r, hh)) * 128 + 64 * khf + 32 * kt + r32] = f2bf(acc[kt][r]);
            {   const int kk = tid & 127, sq = tid >> 7; float a = 0.f;
                for (int s = sq * 32; s < sq * 32 + 32; ++s) a += WG[h * 128 + s] * bf2f(*(const LAS bf16_t*)(T1 + s * TS + kk * 2));
                SF[2048 + sq * 128 + kk] = a; }
            __syncthreads();
            if (tid < 128) B.UN[((size_t)u * 4 + h) * 128 + tid] = (SF[2048 + tid] + SF[2048 + 128 + tid]) + (SF[2048 + 256 + tid] + SF[2048 + 384 + tid]);
        }
    }
}
#undef OPQ_IDS
#undef P1_LOADS_A
#undef GM_LOADS
#undef P1_LOADS_V
__device__ __forceinline__ void l0_scan(const L0Bufs& B, int blk, int tid) {
    const int bh = blk >> 3, part = blk & 7, b = bh >> 2, h = bh & 3, lane = tid & 63;
    const int e0 = part * 2048 + tid * 8;
    float zz = 0.f; asm volatile("" : "+v"(zz));
    f32x4 C0 = (f32x4){zz, zz, zz, zz}, C1 = C0; float nst = 0.f; float m = 0.f;
    const int unit0 = (b * 32) * 4 + h;
    const bool nrm = part == 0 && tid < 128;
    const float blv = lane < 32 ? B.SC[unit0 + 4 * lane] : 0.f, mlv = lane < 32 ? B.SC[1024 + unit0 + 4 * lane] : 0.f;
    u32x4 ub[8]; float un8[8];
#pragma unroll
    for (int j = 0; j < 8; ++j) { ub[j] = *(const u32x4*)(B.U + (size_t)(unit0 + 4 * j) * 16384 + e0); un8[j] = B.UN[(size_t)(unit0 + 4 * j) * 128 + (tid & 127)]; }
#pragma unroll
    for (int g = 0; g < 4; ++g) {
        u32x4 nb[8]; float nn[8];
#pragma unroll
        for (int j = 0; j < 8; ++j) { const int un1 = unit0 + 4 * (8 * (g < 3 ? g + 1 : 3) + j); nb[j] = *(const u32x4*)(B.U + (size_t)un1 * 16384 + e0); nn[j] = B.UN[(size_t)un1 * 128 + (tid & 127)]; }
#pragma unroll
        for (int j = 0; j < 8; ++j) { const int c = 8 * g + j, unit = unit0 + 4 * c; const u32x4 Unw = ub[j];
            const f32x4 U0 = (f32x4){bf_lo(Unw.x), bf_hi(Unw.x), bf_lo(Unw.y), bf_hi(Unw.y)}, U1 = (f32x4){bf_lo(Unw.z), bf_hi(Unw.z), bf_lo(Unw.w), bf_hi(Unw.w)};
            const float bl = __int_as_float(__builtin_amdgcn_readlane(__float_as_int(blv), c)), mloc = __int_as_float(__builtin_amdgcn_readlane(__float_as_int(mlv), c)), un = un8[j];
            u32x4 w; w.x = pk2(C0[0], C0[1]); w.y = pk2(C0[2], C0[3]); w.z = pk2(C1[0], C1[1]); w.w = pk2(C1[2], C1[3]); *(u32x4*)(B.CS + (size_t)unit * 16384 + e0) = w;
            if (nrm) B.NS[(size_t)unit * 128 + tid] = nst;
            if (part == 0 && tid == 0) B.SC[2048 + unit] = m;
            const float mn = fmaxf(bl + m, mloc), dec = expf(bl + m - mn), wu = expf(mloc - mn); m = mn;
            C0 = C0 * dec + U0 * wu; C1 = C1 * dec + U1 * wu;
            nst = nst * dec + wu * un; }
#pragma unroll
        for (int j = 0; j < 8; ++j) { ub[j] = nb[j]; un8[j] = nn[j]; }
    }
}
__device__ __forceinline__ void l0_mixC(LAS unsigned char* lds, const L0Bufs& B, int blk, int G) {
    const int tid0 = threadIdx.x, wave = __builtin_amdgcn_readfirstlane(tid0 >> 6);
    LAS unsigned char* TQ = lds; LAS unsigned char* TK = lds + 34816; LAS unsigned char* TV = lds + 2 * 34816; LAS unsigned char* TC = lds + 3 * 34816;
    LAS float* SF = (LAS float*)(lds + 4 * 34816);
    LAS float* AS = SF; LAS float* PM = SF + 128; LAS float* NP = SF + 256; LAS float* PS = SF + 384; LAS float* PQ = SF + 640; LAS float* NW = SF + 896;
    __syncthreads();
    { int tq = tid0; asm volatile("" : "+v"(tq)); if (tq < 256) ((LAS f32x4*)NW)[tq] = tq < 128 ? ((const f32x4*)B.nw)[tq] : ((const f32x4*)B.skip)[tq - 128]; }
    for (int uu = blk; uu < 256; uu += G) {
        const int tok0 = uu * 128;
        u32x4 pq[4], pk[4], pv[4], pc[4];
#define PC_LOADS(HN) do { _Pragma("unroll") for (int i = 0; i < 4; ++i) { const int ch = tid + 512 * i, row = ch >> 4, c = ch & 15; const size_t ro = (size_t)(tok0 + row) * 512 + (HN) * 128 + c * 8; \
            pq[i] = *(const u32x4*)(B.Q + ro); pk[i] = *(const u32x4*)(B.K + ro); pv[i] = *(const u32x4*)(B.V + ro); pc[i] = *(const u32x4*)(B.CS + (size_t)(uu * 4 + (HN)) * 16384 + (size_t)row * 128 + c * 8); } } while (0)
        { int tid = tid0; asm volatile("" : "+v"(tid)); PC_LOADS(0); }
#pragma unroll 1
        for (int h = 0; h < 4; ++h) {
            const int unit = uu * 4 + h;
            int tid = tid0; asm volatile("" : "+v"(tid));
            const int lane = tid & 63, r32 = lane & 31, hh = lane >> 5;
            const float mprev = B.SC[2048 + unit], btv = B.GT[(size_t)unit * 256 + 128 + 32 * (wave & 3) + r32];
            float gv0 = 0.f, gv1 = 0.f, gv2 = 0.f, gv3 = 0.f;
            if (wave == 0) { const float* gt = B.GT + (size_t)unit * 256; gv0 = gt[2 * lane]; gv1 = gt[128 + 2 * lane]; gv2 = gt[2 * lane + 1]; gv3 = gt[128 + 2 * lane + 1]; }
            if (wave == 1) { gv0 = B.NS[(size_t)unit * 128 + lane]; gv1 = B.NS[(size_t)unit * 128 + 64 + lane]; }
            __syncthreads();
#pragma unroll
            for (int i = 0; i < 4; ++i) { const int ch = tid + 512 * i, row = ch >> 4, c = ch & 15; *(LAS u32x4*)(TQ + row * TS + c * 16) = pq[i]; *(LAS u32x4*)(TV + row * TS + c * 16) = pv[i]; *(LAS u32x4*)(TC + row * TS + c * 16) = pc[i]; }
#pragma unroll
            for (int i = 0; i < 4; ++i) { const int ch = tid + 512 * i, row = ch >> 4, c = ch & 15; const u32x4 k = pk[i]; const float ksc = 0.08838834764831845f;
                u32x4 ok; ok.x = pk2(bf_lo(k.x) * ksc, bf_hi(k.x) * ksc); ok.y = pk2(bf_lo(k.y) * ksc, bf_hi(k.y) * ksc); ok.z = pk2(bf_lo(k.z) * ksc, bf_hi(k.z) * ksc); ok.w = pk2(bf_lo(k.w) * ksc, bf_hi(k.w) * ksc);
                *(LAS u32x4*)(TK + row * TS + c * 16) = ok; }
            { const int hn = h < 3 ? h + 1 : 3; PC_LOADS(hn); }
            if (wave == 0) {
                const float a0 = gv0 - gv1, a1 = gv2 - gv3;
                float run = fmaxf(a0, a1);
#pragma unroll
                for (int o = 1; o < 64; o <<= 1) { const float v = shup(run, o, lane); if (lane >= o) run = fmaxf(run, v); }
                const float prev = shup(run, 1, lane); const float p0 = fmaxf(lane > 0 ? fmaxf(prev, a0) : a0, mprev), p1 = fmaxf(run, mprev);
                AS[2 * lane] = a0; AS[2 * lane + 1] = a1; PM[2 * lane] = p0; PM[2 * lane + 1] = p1;
            }
            if (wave == 1) { NP[lane] = gv0; NP[64 + lane] = gv1; }
            __syncthreads();
            const int tb = wave & 3, vh = wave >> 2, t = 32 * tb + r32;
            const float pm = PM[t], bt = btv;
            f32x16 s[4];
#pragma unroll
            for (int st = 0; st < 4; ++st)
#pragma unroll
                for (int r = 0; r < 16; ++r) s[st][r] = 0.f;
            {   int lv = lane; asm volatile("" : "+v"(lv));
                const LAS unsigned char* qp = TQ + (32 * tb + (lv & 31)) * TS + (lv >> 5) * 16; const LAS unsigned char* kp = TK + (lv & 31) * TS + (lv >> 5) * 16;
#pragma unroll 2
                for (int ks = 0; ks < 8; ++ks) { const bf16x8 bq = *(const LAS bf16x8*)(qp + ks * 32);
#pragma unroll
                    for (int st = 0; st < 4; ++st) if (st <= tb) { const bf16x8 a = *(const LAS bf16x8*)(kp + st * 32 * TS + ks * 32); s[st] = MFMA32(a, bq, s[st]); } } }
            float nq = 0.f; u32x4 pf[4][2];
#pragma unroll
            for (int st = 0; st < 4; ++st) {
#pragma unroll
                for (int r = 0; r < 16; ++r) { const int sidx = 32 * st + crow(r, hh); const float wv = (sidx <= t) ? __builtin_amdgcn_exp2f((AS[sidx] - pm) * LOG2E) : 0.f; const float pv = s[st][r] * wv; s[st][r] = pv; nq += pv; }
#pragma unroll
                for (int sx = 0; sx < 2; ++sx) pf[st][sx] = (u32x4){pk2(s[st][8 * sx], s[st][8 * sx + 1]), pk2(s[st][8 * sx + 2], s[st][8 * sx + 3]), pk2(s[st][8 * sx + 4], s[st][8 * sx + 5]), pk2(s[st][8 * sx + 6], s[st][8 * sx + 7])};
            }
            nq = xhalf_sum(nq);
            float nqi = 0.f;
#pragma unroll
            for (int i = 0; i < 8; ++i) { const u32x4 qv = *(const LAS u32x4*)(TQ + t * TS + (64 * hh + 8 * i) * 2); const LAS float* np = NP + 64 * hh + 8 * i;
                nqi += bf_lo(qv.x) * np[0] + bf_hi(qv.x) * np[1] + bf_lo(qv.y) * np[2] + bf_hi(qv.y) * np[3] + bf_lo(qv.z) * np[4] + bf_hi(qv.z) * np[5] + bf_lo(qv.w) * np[6] + bf_hi(qv.w) * np[7]; }
            nqi = xhalf_sum(nqi);
            const float wst = __builtin_amdgcn_exp2f((mprev - pm) * LOG2E);
            const float den = fmaxf(fabsf(nq + wst * nqi), __builtin_amdgcn_exp2f(-(bt + pm) * LOG2E)), rden = 1.f / den;
            f32x16 ni[2], nx[2];
#pragma unroll
            for (int vt = 0; vt < 2; ++vt)
#pragma unroll
                for (int r = 0; r < 16; ++r) { ni[vt][r] = 0.f; nx[vt][r] = 0.f; }
            {   int lv = lane; asm volatile("" : "+v"(lv));
#pragma unroll
                for (int st = 0; st < 4; ++st) {
                    if (st <= tb) {
#pragma unroll
                        for (int sx = 0; sx < 2; ++sx) { const bf16x8 pb = __builtin_bit_cast(bf16x8, pf[st][sx]);
#pragma unroll
                            for (int vt = 0; vt < 2; ++vt) { const bf16x8 a = tr_frag(TV, 32 * st + 16 * sx, 64 * vh + 32 * vt, lv, true); ni[vt] = MFMA32(a, pb, ni[vt]); } }
                    }
                } }
            {   int lv = lane; asm volatile("" : "+v"(lv));
                const LAS unsigned char* qp = TQ + (32 * tb + (lv & 31)) * TS + (lv >> 5) * 16; const LAS unsigned char* cp = TC + (64 * vh + (lv & 31)) * TS + (lv >> 5) * 16;
#pragma unroll 2
                for (int ks = 0; ks < 8; ++ks) { const bf16x8 bq = *(const LAS bf16x8*)(qp + ks * 32);
#pragma unroll
                    for (int vt = 0; vt < 2; ++vt) { const bf16x8 a = *(const LAS bf16x8*)(cp + vt * 32 * TS + ks * 32); nx[vt] = MFMA32(a, bq, nx[vt]); } } }
            const size_t tok = (size_t)tok0 + t;
            u32x2 xcv[2][4], zv[2][4];
#pragma unroll
            for (int vt = 0; vt < 2; ++vt)
#pragma unroll
                for (int gq = 0; gq < 4; ++gq) { const int chn = h * 128 + 64 * vh + 32 * vt + 8 * gq + 4 * hh; xcv[vt][gq] = *(const u32x2*)(B.XC + tok * 512 + chn); zv[vt][gq] = *(const u32x2*)(B.BZ + tok * 512 + chn); }
            float hs = 0.f, hq = 0.f;
#pragma unroll
            for (int vt = 0; vt < 2; ++vt)
#pragma unroll
                for (int r = 0; r < 16; ++r) { const float hv = (ni[vt][r] + wst * nx[vt][r]) * rden; ni[vt][r] = hv; hs += hv; hq += hv * hv; }
            hs = xhalf_sum(hs); hq = xhalf_sum(hq);
            if (hh == 0) { PS[vh * 128 + t] = hs; PQ[vh * 128 + t] = hq; }
            __syncthreads();
            const float mean = (PS[t] + PS[128 + t]) * (1.f / 128.f);
            const float rstd = rsqrtf(fmaxf((PQ[t] + PQ[128 + t]) * (1.f / 128.f) - mean * mean, 0.f) + LN_EPS);
#pragma unroll
            for (int vt = 0; vt < 2; ++vt)
#pragma unroll
                for (int gq = 0; gq < 4; ++gq) { const int cl = 64 * vh + 32 * vt + 8 * gq + 4 * hh, chn = h * 128 + cl;
                    const f32x4 nw = *(const LAS f32x4*)(NW + chn), sk = *(const LAS f32x4*)(NW + 512 + chn); const u32x2 xc = xcv[vt][gq], z = zv[vt][gq];
                    const float y0 = ((ni[vt][4 * gq] - mean) * rstd * nw[0] + sk[0] * bf_lo(xc.x)) * silu_f(bf_lo(z.x)), y1 = ((ni[vt][4 * gq + 1] - mean) * rstd * nw[1] + sk[1] * bf_hi(xc.x)) * silu_f(bf_hi(z.x));
                    const float y2 = ((ni[vt][4 * gq + 2] - mean) * rstd * nw[2] + sk[2] * bf_lo(xc.y)) * silu_f(bf_lo(z.y)), y3 = ((ni[vt][4 * gq + 3] - mean) * rstd * nw[3] + sk[3] * bf_hi(xc.y)) * silu_f(bf_hi(z.y));
                    u32x2 w; w.x = pk2(y0, y1); w.y = pk2(y2, y3); *(u32x2*)(B.YM + tok * 1024 + 512 + chn) = w; }
        }
    }
}
constexpr size_t MB = 1048576ull;
constexpr size_t P_WIN_T = 0, P_WOUT_T = P_WIN_T + 4 * MB, P_WQKV_T = P_WOUT_T + 2 * MB, P_WO_T = P_WQKV_T + 3 * MB, P_XWQ_T = P_WO_T + 2 * MB, P_XWKV_T = P_XWQ_T + 4 * MB, P_XWO_T = P_XWKV_T + 8 * MB,
                 P_MLW_T = P_XWO_T + 4 * MB, P_WIFT = P_MLW_T + MB / 2, P_WRT = P_WIFT + MB / 8, P_ROT = P_WRT + MB / 2, P_BQK = P_ROT + MB, P_MEMB = P_BQK + MB / 8, P_KC = P_MEMB + 4 * MB, P_VT = P_KC + 8 * MB,
                 P_W13T = P_VT + 8 * MB, P_W2T = P_W13T + 64 * MB, P_XBF = P_W2T + 32 * MB, P_RT = P_XBF + 64 * MB, P_TMP = P_RT + 2 * MB;
constexpr size_t P_BAR = P_RT + 1572864;
constexpr size_t RT_SRC = 1638400;
constexpr size_t RT_E = 0, RT_W = 262144, RT_RANK = 2 * 262144, RT_DEST = 3 * 262144, RT_HIST = 4 * 262144, RT_TSTART = RT_HIST + 32768;
constexpr size_t T_QX = 0, T_OB = 64 * MB, T_YB = 128 * MB;
constexpr size_t T_K1 = 192 * MB, T_VT1 = 208 * MB;
constexpr size_t T_AU = 0, T_AV = 32 * MB, T_BX = 64 * MB, T_BZ = 96 * MB, T_V = 128 * MB, T_XC = 160 * MB, T_YM = 192 * MB, T_U = 256 * MB, T_CS = 320 * MB,
                 T_GT = 352 * MB, T_UN = 353 * MB, T_NS = 353 * MB + MB / 2, T_SC = 354 * MB, T_YB0 = 0;
constexpr size_t T_XG = 0, T_HM = 152 * MB, T_YG = 0;
constexpr size_t T_W13B = 228 * MB, T_W2B = 292 * MB;
constexpr size_t T_SLOT = 356 * MB;
constexpr size_t FAST_END = P_TMP + 360 * MB;
#if defined(PROBE_LNX) || defined(PROBE_LNV)
constexpr size_t SLOT_MB = 8;
#else
constexpr size_t SLOT_MB = 4;
#endif
constexpr int LDS_BYTES = 147456;

struct FP {
    const float* in[33]; float* X;
    unsigned char* ws;
};
typedef const float* const __attribute__((address_space(4)))* InTab;
struct PV { InTab in; float* X; unsigned char* ws; };
__device__ __forceinline__ PV make_pv(const FP& p0) {
    PV p; InTab kp = (InTab)__builtin_amdgcn_kernarg_segment_ptr(); asm volatile("" : "+s"(kp)); p.in = kp;
    p.X = p0.X; p.ws = p0.ws; asm volatile("" : "+s"(p.ws)); return p;
}
#define WSP(T, off) ((T*)(p.ws + (off)))

__device__ __forceinline__ RouteBufs route_bufs(const PV& p) {
    RouteBufs r; r.e = WSP(int, P_RT + RT_E); r.w = WSP(float, P_RT + RT_W); r.rank = WSP(int, P_RT + RT_RANK); r.dest = WSP(int, P_RT + RT_DEST); r.hist = WSP(int, P_RT + RT_HIST); r.tstart = WSP(int, P_RT + RT_TSTART); r.src = WSP(int, P_RT + RT_SRC); return r;
}
#define PH_ARGS const PV& p, LAS unsigned char* lds, int blk, int G
#define PH_IDS int tid_ = threadIdx.x; asm volatile("" : "+v"(tid_)); const int tid = tid_, lane = tid & 63, wave = __builtin_amdgcn_readfirstlane(tid >> 6); (void)lane; (void)wave;

__device__ __forceinline__ void ph_conv_xattn(PH_ARGS, int l, int& gw) {
    PH_IDS; LAS float* scr = (LAS float*)(lds + wave * 8448); const int ngw = G * NWAVE;
    convert_mats(p.in[23] + (size_t)l * 1024 * 1024, 1024, 1024, 1, 0, WSP(bf16_t, P_XWQ_T) + (size_t)l * 1024 * 1024, 0, RM_IDENT, 0.0625f, 1024, scr, gw, ngw, lane);
    convert_mats(p.in[24] + (size_t)l * 1024 * 2048, 1024, 2048, 1, 0, WSP(bf16_t, P_XWKV_T) + (size_t)l * 2048 * 1024, 0, RM_IDENT, 1.f, 0, scr, gw, ngw, lane);
    convert_mats(p.in[25] + (size_t)l * 1024 * 1024, 1024, 1024, 1, 0, WSP(bf16_t, P_XWO_T) + (size_t)l * 1024 * 1024, 0, RM_IDENT, 1.f, 0, scr, gw, ngw, lane);
    convert_rows(p.in[1], WSP(bf16_t, P_MEMB), (size_t)2048 * 1024, blk * NTHR + tid, G * NTHR);
}
__device__ __forceinline__ void conv_router_w(const PV& p, int l, int gt, int ngt) {
    bf16_t* wrt = WSP(bf16_t, P_WRT) + (size_t)l * 2 * 64 * 1024; const float* wre = p.in[28] + (size_t)l * 1024 * 32; const float* wrg = p.in[26] + (size_t)l * 1024 * 4;
    for (int i = gt; i < 64 * 1024; i += ngt) { const int r = i >> 10, k = i & 1023;
        const float v = r < 32 ? wre[k * 32 + r] : (r < 36 ? wrg[k * 4 + (r - 32)] : 0.f);
        const bf16_t h = f2bf(v); wrt[i] = h; wrt[64 * 1024 + i] = f2bf(v - bf2f(h)); }
}
__device__ __forceinline__ void conv_moe_waves(const PV& p, int l, LAS float* scr, int& gw, int ngw, int gt, int ngt, int lane) {
    const size_t wl = (size_t)l * 32 * 1024 * 512;
    convert_mats(p.in[30] + wl, 1024, 512, 32, (size_t)1024 * 512, WSP(bf16_t, P_W13T), (size_t)1024 * 1024, RM_PAIR0, 1.f, 0, scr, gw, ngw, lane);
    convert_mats(p.in[31] + wl, 1024, 512, 32, (size_t)1024 * 512, WSP(bf16_t, P_W13T), (size_t)1024 * 1024, RM_PAIR1, 1.f, 0, scr, gw, ngw, lane);
    convert_mats(p.in[32] + wl, 512, 1024, 32, (size_t)512 * 1024, WSP(bf16_t, P_W2T), (size_t)1024 * 512, RM_IDENT, 1.f, 0, scr, gw, ngw, lane);
    conv_router_w(p, l, gt, ngt);
}
#ifndef TAILQ_XA
#define TAILQ_XA 3
#endif
#ifndef TAILQ_G1
#define TAILQ_G1 4
#endif
#ifndef TAILQ_G2
#define TAILQ_G2 2
#endif
constexpr size_t P_CURSOR_OFF = 15360;
__device__ __forceinline__ void conv_moe1_item(const PV& p, unsigned it, LAS float* scr, int lane, f32x4 (&tv)[8], bool load) {
    const size_t wl = (size_t)32 * 1024 * 512;
    const int mat = it >> 13, r = it & 8191, bt = r >> 8, rr = r & 255;
    if (mat < 2) { const float* W = (mat == 0 ? p.in[30] : p.in[31]) + wl + (size_t)bt * 1024 * 512;
        if (load) ti_load(W, 512, rr >> 4, rr & 15, lane, tv); else ti_store(tv, 1024, WSP(bf16_t, P_TMP + T_W13B) + (size_t)bt * 1024 * 1024, scr, rr >> 4, rr & 15, lane, mat == 0 ? RM_PAIR0 : RM_PAIR1, 1.f, 0); }
    else { const float* W = p.in[32] + wl + (size_t)bt * 512 * 1024;
        if (load) ti_load(W, 1024, rr >> 5, rr & 31, lane, tv); else ti_store(tv, 512, WSP(bf16_t, P_TMP + T_W2B) + (size_t)bt * 1024 * 512, scr, rr >> 5, rr & 31, lane, RM_IDENT, 1.f, 0); }
}
__device__ __forceinline__ void conv_moe1_range(const PV& p, LAS float* scr, int lane, int first, int stride, int last) {
    if (last > 12288) last = 12288;
    if (first >= last) return;
    f32x4 ta[8], tb[8];
    conv_moe1_item(p, 2 * first, scr, lane, ta, true); conv_moe1_item(p, 2 * first + 1, scr, lane, tb, true);
    for (int it = first; it < last; it += stride) {
        const int nx = it + stride; f32x4 na[8], nb[8];
        const int nl = nx < last ? nx : it;
        conv_moe1_item(p, 2 * nl, scr, lane, na, true);
        conv_moe1_item(p, 2 * it, scr, lane, ta, false);
        conv_moe1_item(p, 2 * nl + 1, scr, lane, nb, true);
        conv_moe1_item(p, 2 * it + 1, scr, lane, tb, false);
#pragma unroll
        for (int i = 0; i < 8; ++i) { ta[i] = na[i]; tb[i] = nb[i]; }
    }
}
struct TailPlan { int t0, t1, t2, nidle, first_idle; };
__device__ __forceinline__ TailPlan tail_plan(int ntile, int G) {
    TailPlan t; const int U = ntile * 4, R = (U + G - 1) / G; t.first_idle = U - (R - 1) * G; t.nidle = G - t.first_idle;
    t.t0 = 128 * NWAVE * TAILQ_XA; t.t1 = t.nidle * NWAVE * TAILQ_G1; t.t2 = t.nidle * NWAVE * TAILQ_G2; return t;
}
__device__ __forceinline__ void ph_conv_moe(PH_ARGS, int l, int& gw) {
    PH_IDS; conv_moe_waves(p, l, (LAS float*)(lds + wave * 8448), gw, G * NWAVE, blk * NTHR + tid, G * NTHR, lane);
}
__device__ __forceinline__ void ph_x_to_bf(PH_ARGS) { PH_IDS; convert_rows(p.X, WSP(bf16_t, P_XBF), (size_t)NT * 1024, blk * NTHR + tid, G * NTHR); }

__device__ __forceinline__ void set_job(LAS pg8::JobDesc* jt, int j, const void* A, const void* B, int nM, int nN, void* out, int ldc, int mode, const void* bias = nullptr, const void* rot = nullptr, void* out2 = nullptr) {
    unsigned long long a = (unsigned long long)A, b = (unsigned long long)B, o = (unsigned long long)out, bi = (unsigned long long)bias, ro = (unsigned long long)rot, o2 = (unsigned long long)out2;
    asm volatile("" : "+s"(a), "+s"(b), "+s"(o), "+s"(bi), "+s"(ro), "+s"(o2), "+s"(nM), "+s"(nN), "+s"(ldc), "+s"(mode));
    LAS pg8::JobDesc* d = jt + j; d->A = a; d->B = b; d->out = o; d->bias = bi; d->rot = ro; d->out2 = o2;
    d->nM = nM; d->nN = nN; d->ldc = ldc; d->mode = mode;
}
#define JT_PTR ((LAS pg8::JobDesc*)(lds + pg8::JT_OFF))
__device__ __forceinline__ void run_jobs(LAS unsigned char* lds, int K, int n0, int n1, int n2, int blk, int G) {
    __syncthreads();
    pg8::Jobs3 S; S.jt = JT_PTR; S.n0 = n0; S.n1 = n1; S.n2 = n2; S.K = K; S.G = G; S.c = blk;
    EpiMulti E; E.jt = JT_PTR;
    pg8::gemm_phase<EpiMulti, pg8::Jobs3, true, true>(lds, K, S, E);
}
__device__ __forceinline__ void ph_xattn_g1(PH_ARGS, int l) {
    const bf16_t* wkv = WSP(bf16_t, P_XWKV_T) + (size_t)l * 2048 * 1024;
    __syncthreads();
    if (threadIdx.x == 0) {
        set_job(JT_PTR, 0, WSP(bf16_t, P_MEMB), wkv, 8, 4, WSP(bf16_t, P_KC) + (size_t)l * 2048 * 1024, 1024, EM_PLAIN);
        set_job(JT_PTR, 1, wkv + (size_t)1024 * 1024, WSP(bf16_t, P_MEMB), 4, 8, WSP(bf16_t, P_VT) + (size_t)l * 1024 * 2048, 2048, EM_PLAIN);
        set_job(JT_PTR, 2, WSP(bf16_t, P_XBF), WSP(bf16_t, P_XWQ_T) + (size_t)l * 1024 * 1024, 128, 4, WSP(bf16_t, P_TMP + T_QX), 1024, EM_PLAIN);
    }
    run_jobs(lds, 1024, 32, 32, 512, blk, G);
}
__device__ __forceinline__ void ph_xattn_attn(PH_ARGS, int l) {
    xattn_phase(lds, WSP(bf16_t, P_TMP + T_QX), WSP(bf16_t, P_KC) + (size_t)l * 2048 * 1024, WSP(bf16_t, P_VT) + (size_t)l * 1024 * 2048, WSP(bf16_t, P_TMP + T_OB), blk, G);
}
__device__ __forceinline__ void ph_gemm_plain(PH_ARGS, const bf16_t* A, const bf16_t* Bt, bf16_t* out) {
    __syncthreads();
    if (threadIdx.x == 0) set_job(JT_PTR, 0, A, Bt, 128, 4, out, 1024, EM_PLAIN);
    run_jobs(lds, 1024, 512, 0, 0, blk, G);
}
template <bool XF32, bool OUTF32, bool MOE>
__device__ __forceinline__ void ph_ln(PH_ARGS, const bf16_t* y, int lnidx, bool dry = false) {
    PH_IDS; LnArgs a; a.xin32 = p.in[0]; a.xin = WSP(bf16_t, P_XBF); a.xout32 = dry ? WSP(float, P_TMP + 200 * MB) : p.X; a.xbf = dry ? WSP(bf16_t, P_TMP + 288 * MB) : WSP(bf16_t, P_XBF); a.y = y; a.g = p.in[2] + lnidx * 1024; a.b = p.in[3] + lnidx * 1024;
    a.dest = WSP(int, P_RT + RT_DEST); a.wts = WSP(float, P_RT + RT_W);
    ln_phase<XF32, OUTF32, MOE>(a, blk, G, wave, lane);
}
__device__ __forceinline__ void ph_moe_route(PH_ARGS, int l) {
    moe_router_phase(lds, WSP(bf16_t, P_XBF), WSP(bf16_t, P_WRT) + (size_t)l * 2 * 64 * 1024, p.in[27] + l * 4, p.in[29] + l * 32, route_bufs(p), blk);
}
__device__ __forceinline__ void ph_moe_scatter(PH_ARGS) { moe_scatter_phase(lds, route_bufs(p), blk, G); }
__device__ __forceinline__ void ph_moe_g1(PH_ARGS) {
    __syncthreads();
    if (threadIdx.x == 0) set_job(JT_PTR, 0, nullptr, nullptr, 0, 0, WSP(bf16_t, P_TMP + T_HM), 512, EM_SWIGLU);
    __syncthreads();
    MoeSched S; S.A = (const char*)WSP(bf16_t, P_TMP + T_XG); S.B = (const char*)WSP(bf16_t, P_W13T); S.tstart = WSP(int, P_RT + RT_TSTART); S.K = 1024; S.nN = 4; S.G = G; S.c = blk; S.bexp = (size_t)1024 * 1024 * 2;
    EpiMulti E; E.jt = JT_PTR;
    pg8::gemm_phase<EpiMulti, MoeSched, true, true>(lds, 1024, S, E);
}
__device__ __forceinline__ void ph_moe_g2(PH_ARGS) {
    __syncthreads();
    if (threadIdx.x == 0) set_job(JT_PTR, 0, nullptr, nullptr, 0, 0, WSP(bf16_t, P_TMP + T_YG), 1024, EM_PLAIN);
    __syncthreads();
    MoeSched S; S.A = (const char*)WSP(bf16_t, P_TMP + T_HM); S.B = (const char*)WSP(bf16_t, P_W2T); S.tstart = WSP(int, P_RT + RT_TSTART); S.K = 512; S.nN = 4; S.G = G; S.c = blk; S.bexp = (size_t)1024 * 512 * 2;
    EpiMulti E; E.jt = JT_PTR;
    pg8::gemm_phase<EpiMulti, MoeSched, true, true>(lds, 512, S, E);
}

__device__ __forceinline__ void ph_conv_l1(PH_ARGS, int& gw) {
    PH_IDS; LAS float* scr = (LAS float*)(lds + wave * 8448); const int ngw = G * NWAVE;
    convert_mats(p.in[19], 1024, 1536, 1, 0, WSP(bf16_t, P_WQKV_T), 0, RM_ROT, 0.125f, 1024, scr, gw, ngw, lane);
    convert_mats(p.in[22], 1024, 1024, 1, 0, WSP(bf16_t, P_WO_T), 0, RM_IDENT, 1.f, 0, scr, gw, ngw, lane);
    const int gt = blk * NTHR + tid, ngt = G * NTHR;
    float* bqk = WSP(float, P_BQK);
    for (int n = gt; n < 1280; n += ngt) bqk[rowmap(RM_ROT, n)] = p.in[20][n] * (n < 1024 ? 0.125f : 1.f);
    float* rot = WSP(float, P_ROT);
    for (int i = gt; i < 4096 * 32; i += ngt) { const int pos = i >> 5, k = i & 31; const float inv = powf(10000.f, -(float)(2 * k) / 64.f); const float ang = (float)pos * inv; rot[2 * i] = cosf(ang); rot[2 * i + 1] = sinf(ang); }
}
__device__ __forceinline__ void ph_l1_g1(PH_ARGS) {
    __syncthreads();
    if (threadIdx.x == 0) {
        set_job(JT_PTR, 0, WSP(bf16_t, P_XBF), WSP(bf16_t, P_WQKV_T), 128, 5, WSP(bf16_t, P_TMP + T_QX), 1024, EM_ROTARY, WSP(float, P_BQK), WSP(float, P_ROT), WSP(bf16_t, P_TMP + T_K1));
        set_job(JT_PTR, 1, WSP(bf16_t, P_WQKV_T) + (size_t)1280 * 1024, WSP(bf16_t, P_XBF), 1, 128, WSP(bf16_t, P_TMP + T_VT1), NT, EM_ROWBIAS, p.in[20] + 1280);
    }
    run_jobs(lds, 1024, 640, 128, 0, blk, G);
}
__device__ __forceinline__ void ph_l1_swa(PH_ARGS) {
    swa_phase(lds, WSP(bf16_t, P_TMP + T_QX), WSP(bf16_t, P_TMP + T_K1), WSP(bf16_t, P_TMP + T_VT1), p.in[21], WSP(bf16_t, P_TMP + T_OB), blk, G);
}

__device__ __forceinline__ L0Bufs l0_bufs(const PV& p) {
    L0Bufs B; B.AU = WSP(bf16_t, P_TMP + T_AU); B.AV = WSP(bf16_t, P_TMP + T_AV); B.BX = WSP(bf16_t, P_TMP + T_BX); B.BZ = WSP(bf16_t, P_TMP + T_BZ); B.V = WSP(bf16_t, P_TMP + T_V); B.XC = WSP(bf16_t, P_TMP + T_XC);
    B.YM = WSP(bf16_t, P_TMP + T_YM); B.CS = WSP(bf16_t, P_TMP + T_CS); B.U = WSP(bf16_t, P_TMP + T_U); B.GT = WSP(float, P_TMP + T_GT); B.UN = WSP(float, P_TMP + T_UN); B.NS = WSP(float, P_TMP + T_NS); B.SC = WSP(float, P_TMP + T_SC);
    B.Q = B.AU; B.K = B.AV;
    B.WQT = WSP(bf16_t, P_MLW_T); B.GMW = WSP(bf16_t, P_MLW_T) + 12 * 16384; B.MT = WSP(bf16_t, P_WIFT);
    B.gm_g = p.in[5]; B.gm_b = p.in[6]; B.gm_bs = p.in[8]; B.cw = p.in[9]; B.cb = p.in[10]; B.bif = p.in[15]; B.nw = p.in[16]; B.skip = p.in[17]; return B;
}
__device__ __forceinline__ void ph_scan_conv(PH_ARGS) {
    PH_IDS;
    if (wave < 4) l0_scan(l0_bufs(p), blk, tid);
}
__device__ __forceinline__ void ph_conv_l0(PH_ARGS, int& gwr) {
    PH_IDS; LAS float* scr = (LAS float*)(lds + wave * 8448); const int gw = blk * NWAVE + wave, ngw = G * NWAVE;
    convert_mats(p.in[4], 1024, 2048, 1, 0, WSP(bf16_t, P_WIN_T), 0, RM_IDENT, 1.f, 0, scr, gwr, ngw, lane);
    convert_mats(p.in[18], 1024, 1024, 1, 0, WSP(bf16_t, P_WOUT_T), 0, RM_IDENT, 1.f, 0, scr, gwr, ngw, lane);
    convert_mats(p.in[11], 128, 128, 4, 16384, WSP(bf16_t, P_MLW_T), 16384, RM_IDENT, 1.f, 0, scr, gwr, ngw, lane);
    convert_mats(p.in[12], 128, 128, 4, 16384, WSP(bf16_t, P_MLW_T) + 4 * 16384, 16384, RM_IDENT, 1.f, 0, scr, gwr, ngw, lane);
    convert_mats(p.in[13], 128, 128, 4, 16384, WSP(bf16_t, P_MLW_T) + 8 * 16384, 16384, RM_IDENT, 1.f, 0, scr, gwr, ngw, lane);
    const int gt = blk * NTHR + tid, ngt = G * NTHR;
    bf16_t* gmw = WSP(bf16_t, P_MLW_T) + 12 * 16384;
    for (int i = gt; i < 4 * 16384; i += ngt) { const int t = (i >> 7) & 127, sidx = i & 127; gmw[i] = f2bf(sidx <= t ? p.in[7][i] : 0.f); }
    bf16_t* mt = WSP(bf16_t, P_WIFT);
    for (int i = gw; i < 4 * 8 * 256; i += ngw) { const int h = i >> 11, g = (i >> 8) & 7, j = i & 255, d = j & 127; float a = 0.f;
        for (int e = lane; e < 128; e += 64) {
            if (j < 128) a += p.in[11][((size_t)h * 128 + d) * 128 + e] * p.in[14][(h * 128 + e) * 8 + g] + p.in[12][((size_t)h * 128 + d) * 128 + e] * p.in[14][(512 + h * 128 + e) * 8 + g];
            else a += p.in[13][((size_t)h * 128 + d) * 128 + e] * p.in[14][(1024 + h * 128 + e) * 8 + g]; }
        a += shx(a, 32, lane); a += shx(a, 16, lane); a += shx(a, 8, lane); a += shx(a, 4, lane); a += shx(a, 2, lane); a += shx(a, 1, lane);
        if (lane == 0) mt[i] = f2bf(a); }
}
__device__ __forceinline__ void ph_xin_to_bf(PH_ARGS) { PH_IDS; convert_rows(p.in[0], WSP(bf16_t, P_XBF), (size_t)NT * 1024, blk * NTHR + tid, G * NTHR); }
__device__ __forceinline__ void ph_l0_g1(PH_ARGS) {
    __syncthreads();
    if (threadIdx.x == 0) set_job(JT_PTR, 0, WSP(bf16_t, P_XBF), WSP(bf16_t, P_WIN_T), 128, 8, WSP(bf16_t, P_TMP + T_AU), 512, EM_GELU4);
    run_jobs(lds, 1024, 1024, 0, 0, blk, G);
}

enum { K_CONV_XATTN = 0, K_CONV_MOE, K_X2BF, K_XATTN_G1, K_XATTN_ATTN, K_XATTN_G2, K_LN_Y, K_MOE_ROUTE, K_MOE_SCATTER, K_MOE_G1, K_MOE_G2, K_LN_MOE, K_CONV_L1, K_L1_G1, K_L1_SWA, K_L1_G2, K_CONV_L0, K_XIN2BF, K_L0_G1, K_L0_MIXA, K_L0_SCAN, K_L0_MIXC, K_L0_G2, K_LN_Y0 };
template <int PH>
__global__ void __launch_bounds__(NTHR, 2) k_phase(FP p0, int l, int lnidx) {
    const PV p = make_pv(p0);
    extern __shared__ __attribute__((aligned(16))) unsigned char smem[];
    LAS unsigned char* lds = (LAS unsigned char*)smem;
    const int blk = blockIdx.x, G = gridDim.x;
    if constexpr (PH == K_CONV_XATTN) { int gwr = blk * NWAVE + (threadIdx.x >> 6); ph_conv_xattn(p, lds, blk, G, l, gwr); }
    if constexpr (PH == K_CONV_MOE) { int gwr = blk * NWAVE + (threadIdx.x >> 6); ph_conv_moe(p, lds, blk, G, l, gwr); }
    if constexpr (PH == K_X2BF) ph_x_to_bf(p, lds, blk, G);
    if constexpr (PH == K_XATTN_G1) ph_xattn_g1(p, lds, blk, G, l);
    if constexpr (PH == K_XATTN_ATTN) ph_xattn_attn(p, lds, blk, G, l);
    if constexpr (PH == K_XATTN_G2) ph_gemm_plain(p, lds, blk, G, WSP(bf16_t, P_TMP + T_OB), WSP(bf16_t, P_XWO_T) + (size_t)l * 1024 * 1024, WSP(bf16_t, P_TMP + T_YB));
    if constexpr (PH == K_LN_Y) ph_ln<false, false, false>(p, lds, blk, G, WSP(bf16_t, P_TMP + T_YB), lnidx);
    if constexpr (PH == K_MOE_ROUTE) ph_moe_route(p, lds, blk, G, l);
    if constexpr (PH == K_MOE_SCATTER) ph_moe_scatter(p, lds, blk, G);
    if constexpr (PH == K_MOE_G1) ph_moe_g1(p, lds, blk, G);
    if constexpr (PH == K_MOE_G2) ph_moe_g2(p, lds, blk, G);
    if constexpr (PH == K_LN_MOE) ph_ln<false, false, true>(p, lds, blk, G, WSP(bf16_t, P_TMP + T_YG), lnidx);
    if constexpr (PH == K_CONV_L0) { int gwr = blk * NWAVE + (threadIdx.x >> 6); ph_conv_l0(p, lds, blk, G, gwr); }
    if constexpr (PH == K_XIN2BF) ph_xin_to_bf(p, lds, blk, G);
    if constexpr (PH == K_L0_G1) ph_l0_g1(p, lds, blk, G);
    if constexpr (PH == K_L0_MIXA) l0_mixA(lds, l0_bufs(p), blk, G);
    if constexpr (PH == K_L0_SCAN) ph_scan_conv(p, lds, blk, G);
    if constexpr (PH == K_L0_MIXC) l0_mixC(lds, l0_bufs(p), blk, G);
    if constexpr (PH == K_L0_G2) ph_gemm_plain(p, lds, blk, G, WSP(bf16_t, P_TMP + T_YM), WSP(bf16_t, P_WOUT_T), WSP(bf16_t, P_TMP + T_YB0));
    if constexpr (PH == K_LN_Y0) ph_ln<true, false, false>(p, lds, blk, G, WSP(bf16_t, P_TMP + T_YB0), 0);
    if constexpr (PH == K_CONV_L1) { int gwr = blk * NWAVE + (threadIdx.x >> 6); ph_conv_l1(p, lds, blk, G, gwr); }
    if constexpr (PH == K_L1_G1) ph_l1_g1(p, lds, blk, G);
    if constexpr (PH == K_L1_SWA) ph_l1_swa(p, lds, blk, G);
    if constexpr (PH == K_L1_G2) ph_gemm_plain(p, lds, blk, G, WSP(bf16_t, P_TMP + T_OB), WSP(bf16_t, P_WO_T), WSP(bf16_t, P_TMP + T_YB));
}

#define XB_TMO      128
#define XB_XCNT(j)  (256  + 64 * (j))
#define XB_XSUB(j)  (1280 + 64 * (j))
#define XB_XGEN(j)  (2304 + 64 * (j))
#define XB_TOP      3328
#define XB_TOPGEN   3392
#define XCD_BAR_WORDS 3456
#define XB_SPIN_CAP (1u << 22)
__device__ __forceinline__ unsigned xb_ld(unsigned* p)              { return __hip_atomic_load(p, __ATOMIC_RELAXED, __HIP_MEMORY_SCOPE_AGENT); }
__device__ __forceinline__ unsigned xb_add(unsigned* p, unsigned v) { return __hip_atomic_fetch_add(p, v, __ATOMIC_RELAXED, __HIP_MEMORY_SCOPE_AGENT); }
__device__ __forceinline__ unsigned xb_xcc_id() { return (unsigned)__builtin_amdgcn_s_getreg((3 << 11) | 20) & 0xFu; }
#define XB_SPIN(cond, bar) do { unsigned _sp = 0; while (cond) { __builtin_amdgcn_s_sleep(1); \
    if ((++_sp & 255u) == 0u) { if (xb_ld(&(bar)[XB_TMO])) break; if (_sp > XB_SPIN_CAP) { atomicAdd(&(bar)[XB_TMO], 1u); break; } } } } while (0)
struct XcdBarrier { unsigned* bar; unsigned x; volatile LAS unsigned* st; };
__device__ __forceinline__ XcdBarrier xcd_barrier_post(unsigned* bar, volatile LAS unsigned* st) {
    XcdBarrier b; b.bar = bar; b.x = xb_xcc_id(); b.st = st;
    if (threadIdx.x == 0) (void)xb_add(&bar[XB_XCNT(b.x)], 1u);
    return b;
}
__device__ __forceinline__ void xcd_barrier_complete(unsigned* bar, unsigned x, unsigned& nloc, unsigned& nx) {
    const unsigned G = gridDim.x * gridDim.y * gridDim.z;
    unsigned sum, cnt, mine, sp = 0u;
    for (;;) {
        sum = 0u; cnt = 0u; mine = 0u;
#pragma unroll
        for (unsigned j = 0; j < 16; ++j) { const unsigned c = xb_ld(&bar[XB_XCNT(j)]); sum += c; cnt += (c > 0u) ? 1u : 0u; mine = (j == x) ? c : mine; }
        if (sum == G) break;
        __builtin_amdgcn_s_sleep(1);
        if ((++sp & 255u) == 0u) { if (xb_ld(&bar[XB_TMO])) break; if (sp > XB_SPIN_CAP) { atomicAdd(&bar[XB_TMO], 1u); break; } }
    }
    nloc = mine > 0u ? mine : 1u; nx = cnt > 0u ? cnt : 1u;
}
__device__ __forceinline__ void xcd_barrier(const XcdBarrier& b) {
    asm volatile("s_waitcnt vmcnt(0)" ::: "memory");
    __syncthreads();
    if (threadIdx.x == 0) {
        unsigned* bar = b.bar; asm volatile("" : "+s"(bar));
        __builtin_amdgcn_s_waitcnt(0);
        unsigned nloc = b.st[0], nx = b.st[1];
        if (nloc == 0u) { xcd_barrier_complete(bar, b.x, nloc, nx); b.st[0] = nloc; b.st[1] = nx; }
        const unsigned old = xb_add(&bar[XB_XSUB(b.x)], 1u);
        const unsigned gen = old / nloc;
        if (old + 1u == (gen + 1u) * nloc) {
            __builtin_amdgcn_fence(__ATOMIC_RELEASE, "agent");
            asm volatile("s_waitcnt vmcnt(0)" ::: "memory");
            const unsigned og = xb_add(&bar[XB_TOP], 1u);
            const unsigned tg = og / nx;
            if (og + 1u == (tg + 1u) * nx) xb_add(&bar[XB_TOPGEN], 1u);
            else XB_SPIN(xb_ld(&bar[XB_TOPGEN]) == tg, bar);
            __builtin_amdgcn_fence(__ATOMIC_ACQUIRE, "agent");
            asm volatile("s_waitcnt vmcnt(0)" ::: "memory");
        } else {
            XB_SPIN(xb_ld(&bar[XB_TOPGEN]) == gen, bar);
            __builtin_amdgcn_fence(__ATOMIC_ACQUIRE, "agent");
            asm volatile("s_waitcnt vmcnt(0)" ::: "memory");
        }
    }
    __syncthreads();
}
constexpr int LDS_BARW = LDS_BYTES - 16;

struct SchedAll {
    const LAS pg8::JobDesc* jt; int n0, n1, n2, n3, n4; int K, G, c; int moe; const char* A; const char* B; const int* tstart; const int* src; int nN; size_t bexp;
    __device__ __forceinline__ pg8::Unit get(int i, bool& ok) const {
        const char* ua = nullptr; const char* ub = nullptr; const int* us = nullptr; int upm = 0, upn = 0, ujob = 0; bool good = false;
        if (moe) {
            const int vc = (c & 7) * (G >> 3) + (c >> 3);
            const long L = (long)i * G + vc; const int ntile = tstart[32];
            if (L < (long)ntile * nN) {
                const int mt = (int)(L / nN), nt = (int)(L % nN);
                int e = 0;
                for (int k = 1; k < 32; ++k) if (tstart[k] <= mt) e = k;
                ua = src ? A : A + (size_t)mt * 256 * K * 2; us = src ? src + mt * 256 : nullptr; ub = B + (size_t)e * bexp + (size_t)nt * 256 * K * 2; upm = mt; upn = nt; good = true;
            }
        } else {
            long L = (long)i * G + c;
            if (L < (long)n0 + n1 + n2 + n3 + n4) {
                int l = (int)L; int jb = 0;
                if (l >= n0) { l -= n0; jb = 1; if (l >= n1) { l -= n1; jb = 2; if (l >= n2) { l -= n2; jb = 3; if (l >= n3) { l -= n3; jb = 4; } } } }
                const int jM = __builtin_amdgcn_readfirstlane(jt[jb].nM), jN = __builtin_amdgcn_readfirstlane(jt[jb].nN);
                int pm, pn; pg8::tile_order(l, jM, jN, pm, pn);
                const size_t tstep = (size_t)pg8::BM * K * 2;
                ua = (const char*)pg8::rfl64(jt[jb].A) + (size_t)pm * tstep; ub = (const char*)pg8::rfl64(jt[jb].B) + (size_t)pn * tstep; upm = pm; upn = pn; ujob = jb; good = true;
            }
        }
        pg8::Unit u; u.A = ua; u.B = ub; u.src = us; u.pm = upm; u.pn = upn; u.job = ujob; ok = good; return u;
    }
};
enum { MP_CONV = 0, MP_L0_G1, MP_L0_MIXA, MP_L0_SCAN, MP_L0_MIXC, MP_L0_G2, MP_XA_G1, MP_XA_ATTN, MP_XA_G2, MP_ROUTE, MP_SCATTER, MP_MOE_G1, MP_MOE_G2, MP_LN_MOE, MP_L1_G1, MP_L1_SWA, MP_L1_G2 };
struct SchedLN {
    const char* A; const char* B; int G, c;
    __device__ __forceinline__ pg8::Unit get(int i, bool& ok) const {
        const int L = i * G + c; const bool good = L < 512; int pm = 0, pn = 0; if (good) pg8::tile_order(L, 128, 4, pm, pn);
        const size_t tstep = (size_t)pg8::BM * 1024 * 2;
        pg8::Unit u; u.A = A + (size_t)pm * tstep; u.B = B + (size_t)pn * tstep; u.src = nullptr; u.pm = pm; u.pn = pn; u.job = 0; ok = good; return u;
    }
};
__device__ __forceinline__ int prog_kind(int i) {
    switch (i) { case 0: return MP_CONV; case 1: return MP_L0_G1; case 2: return MP_L0_MIXA; case 3: return MP_L0_SCAN; case 4: return MP_L0_MIXC; case 5: return MP_L0_G2;
        case 6: case 17: return MP_XA_G1; case 7: case 18: return MP_XA_ATTN; case 8: case 19: return MP_XA_G2; case 9: case 20: return MP_ROUTE; case 10: case 21: return MP_SCATTER;
        case 11: case 22: return MP_MOE_G1; case 12: case 23: return MP_MOE_G2; case 13: case 24: return MP_LN_MOE; case 14: return MP_L1_G1; case 15: return MP_L1_SWA; default: return MP_L1_G2; }
}
constexpr int N_PROG = 25;
__global__ void __launch_bounds__(NTHR, 2) mega(FP p0) {
    extern __shared__ __attribute__((aligned(16))) unsigned char smem[];
    LAS unsigned char* lds = (LAS unsigned char*)smem;
    cooperative_groups::grid_group grid = cooperative_groups::this_grid();
    const int blk0 = blockIdx.x, G0 = gridDim.x;
    volatile LAS unsigned* bst = (volatile LAS unsigned*)(lds + LDS_BARW);
    if (threadIdx.x == 0) { bst[0] = 0u; bst[1] = 0u; }
    __syncthreads();
    const XcdBarrier xbar = xcd_barrier_post((unsigned*)(p0.ws + P_BAR), bst);
    int dup = 0; (void)dup;
#pragma unroll 1
    for (int pi = 0; pi < N_PROG; ++pi) {
        int blk = blk0, G = G0; asm volatile("" : "+s"(blk), "+s"(G));
        const PV p = make_pv(p0);
        const int kind = prog_kind(pi), l = pi >= 14 ? 1 : 0;
        const bool is_gemm = kind == MP_L0_G1 || kind == MP_XA_G1 || kind == MP_MOE_G1 || kind == MP_MOE_G2 || kind == MP_L1_G1;
        const bool is_lnf = kind == MP_L0_G2 || kind == MP_XA_G2 || kind == MP_L1_G2;
        if (is_lnf) {
            const int site = kind == MP_L0_G2 ? 0 : (kind == MP_L1_G2 ? 2 : 1 + 2 * l), lnidx = kind == MP_L0_G2 ? 0 : (kind == MP_L1_G2 ? 3 : 1 + 3 * l);
            SchedLN S; S.G = G; S.c = blk;
            S.A = (const char*)(kind == MP_L0_G2 ? WSP(bf16_t, P_TMP + T_YM) : WSP(bf16_t, P_TMP + T_OB));
            S.B = (const char*)(kind == MP_L0_G2 ? WSP(bf16_t, P_WOUT_T) : (kind == MP_L1_G2 ? WSP(bf16_t, P_WO_T) : WSP(bf16_t, P_XWO_T) + (size_t)l * 1024 * 1024));
            __syncthreads();
            #ifdef PROBE_LNV
            const int drym = __builtin_amdgcn_readfirstlane((dup == 0 && (((PROBE_MASK) >> kind) & 1)) ? 1 : 0);
#else
            const int drym = 0;
#endif
            unsigned long long* slp = WSP(unsigned long long, P_TMP + T_SLOT) + (size_t)(site + 4 * drym) * 131072;
            if (threadIdx.x == 0) set_job(JT_PTR, 0, nullptr, nullptr, 128, 4, WSP(bf16_t, P_XBF), 1024, 0, p.in[2] + lnidx * 1024, p.in[3] + lnidx * 1024, nullptr);
            if (threadIdx.x == 0) { JT_PTR->mode = drym; JT_PTR->out2 = (unsigned long long)slp; }
            EpiLN E; E.lds = lds;
            __syncthreads();
            pg8::gemm_phase<EpiLN, SchedLN, true, true>(lds, 1024, S, E);
        } else if (is_gemm) {
            SchedAll S; S.jt = JT_PTR; S.n0 = S.n1 = S.n2 = S.n3 = S.n4 = 0; S.K = 1024; S.G = G; S.c = blk; S.moe = 0; S.A = S.B = nullptr; S.tstart = WSP(int, P_RT + RT_TSTART); S.src = nullptr; S.nN = 4; S.bexp = 0;
            __syncthreads();
            if (threadIdx.x == 0) {
                if (kind == MP_L0_G1) set_job(JT_PTR, 0, WSP(bf16_t, P_XBF), WSP(bf16_t, P_WIN_T), 128, 8, WSP(bf16_t, P_TMP + T_AU), 512, EM_GELU4);
                if (kind == MP_XA_G1) {
                    set_job(JT_PTR, 0, WSP(bf16_t, P_XBF), WSP(bf16_t, P_XWQ_T) + (size_t)l * 1024 * 1024, 128, 4, WSP(bf16_t, P_TMP + T_QX), 1024, EM_PLAIN);
                    if (l == 0) { for (int ll = 0; ll < 2; ++ll) { const bf16_t* wkv = WSP(bf16_t, P_XWKV_T) + (size_t)ll * 2048 * 1024;
                        set_job(JT_PTR, 1 + 2 * ll, WSP(bf16_t, P_MEMB), wkv, 8, 4, WSP(bf16_t, P_KC) + (size_t)ll * 2048 * 1024, 1024, EM_PLAIN);
                        set_job(JT_PTR, 2 + 2 * ll, wkv + (size_t)1024 * 1024, WSP(bf16_t, P_MEMB), 4, 8, WSP(bf16_t, P_VT) + (size_t)ll * 1024 * 2048, 2048, EM_PLAIN); } } }
                if (kind == MP_MOE_G1) set_job(JT_PTR, 0, nullptr, nullptr, 0, 0, WSP(bf16_t, P_TMP + T_HM), 512, EM_SWIGLU);
                if (kind == MP_MOE_G2) set_job(JT_PTR, 0, nullptr, nullptr, 0, 0, WSP(bf16_t, P_TMP + T_YG), 1024, EM_PLAIN);
                if (kind == MP_L1_G1) { set_job(JT_PTR, 0, WSP(bf16_t, P_XBF), WSP(bf16_t, P_WQKV_T), 128, 5, WSP(bf16_t, P_TMP + T_QX), 1024, EM_ROTARY, WSP(float, P_BQK), WSP(float, P_ROT), WSP(bf16_t, P_TMP + T_K1));
                    set_job(JT_PTR, 1, WSP(bf16_t, P_WQKV_T) + (size_t)1280 * 1024, WSP(bf16_t, P_XBF), 1, 128, WSP(bf16_t, P_TMP + T_VT1), NT, EM_ROWBIAS, p.in[20] + 1280); }
#ifdef PROBE_L1PLAIN
                if (kind == MP_L1_G1 && dup == 0) JT_PTR[0].mode = EM_PLAIN;
#endif
            }
            if (kind == MP_L0_G1) S.n0 = 1024;
            if (kind == MP_XA_G1) { S.n0 = 512; if (l == 0) { S.n1 = 32; S.n2 = 32; S.n3 = 32; S.n4 = 32; } }
            if (kind == MP_L1_G1) { S.n0 = 640; S.n1 = 128; }
            if (kind == MP_MOE_G1) { S.moe = 1; S.A = (const char*)WSP(bf16_t, P_XBF); S.src = WSP(int, P_RT + RT_SRC); S.B = (const char*)(l ? WSP(bf16_t, P_TMP + T_W13B) : WSP(bf16_t, P_W13T)); S.bexp = (size_t)1024 * 1024 * 2; }
            if (kind == MP_MOE_G2) { S.moe = 1; S.K = 512; S.A = (const char*)WSP(bf16_t, P_TMP + T_HM); S.B = (const char*)(l ? WSP(bf16_t, P_TMP + T_W2B) : WSP(bf16_t, P_W2T)); S.bexp = (size_t)1024 * 512 * 2; }
            __syncthreads();
            EpiMulti E; E.jt = JT_PTR;
#ifdef PROBE_GEMM2
#pragma unroll 1
            for (int rep = 0; rep < 2; ++rep)
#endif
            pg8::gemm_phase<EpiMulti, SchedAll, true, true>(lds, S.K, S, E);
            if (l == 0 && (kind == MP_XA_G1 || kind == MP_MOE_G1 || kind == MP_MOE_G2)) {
                const TailPlan tp = tail_plan(S.tstart[32], G);
                const int vc = kind == MP_XA_G1 ? blk : (blk & 7) * (G >> 3) + (blk >> 3);
                const int fi = kind == MP_XA_G1 ? 128 : tp.first_idle, quota = kind == MP_MOE_G2 ? TAILQ_G2 : (kind == MP_XA_G1 ? TAILQ_XA : TAILQ_G1), base = kind == MP_XA_G1 ? 0 : (kind == MP_MOE_G1 ? tp.t0 : tp.t0 + tp.t1);
                if (vc >= fi) { const int wv = __builtin_amdgcn_readfirstlane((int)threadIdx.x >> 6); int lq = threadIdx.x & 63; asm volatile("" : "+v"(lq));
                    const int f0 = base + ((vc - fi) * NWAVE + wv) * quota;
                    conv_moe1_range(p, (LAS float*)(lds + wv * 8448), lq, f0, 1, f0 + quota); }
            }
        } else {
#ifdef PROBE_MIXA_SKIP
#define MIXA_SKIP_ARG ((dup == 0 && (((PROBE_MASK) >> kind) & 1)) ? (PROBE_MIXA_SKIP) : 0)
#else
#define MIXA_SKIP_ARG 0
#endif
#ifdef PROBE_MASK
#define DRY (dup == 0 && (((PROBE_MASK) >> kind) & 1))
#else
#define DRY false
#endif
            switch (kind) {
                case MP_CONV: { int gwr = blk * NWAVE + __builtin_amdgcn_readfirstlane((int)threadIdx.x >> 6);
                    ph_conv_l0(p, lds, blk, G, gwr); ph_conv_l1(p, lds, blk, G, gwr); ph_conv_xattn(p, lds, blk, G, 0, gwr); ph_conv_xattn(p, lds, blk, G, 1, gwr); ph_conv_moe(p, lds, blk, G, 0, gwr); ph_xin_to_bf(p, lds, blk, G); } break;
                case MP_L0_MIXA: { L0Bufs Bx = l0_bufs(p); if (DRY) { Bx.Q = Bx.K = WSP(bf16_t, P_TMP + 288 * MB); } l0_mixA(lds, Bx, blk, G, MIXA_SKIP_ARG); } break;
                case MP_L0_SCAN: ph_scan_conv(p, lds, blk, G); break;
                case MP_L0_MIXC: l0_mixC(lds, l0_bufs(p), blk, G); break;
                case MP_XA_ATTN: ph_xattn_attn(p, lds, blk, G, l); break;
                case MP_ROUTE: ph_moe_route(p, lds, blk, G, l); break;
                case MP_SCATTER: ph_moe_scatter(p, lds, blk, G); break;
                case MP_LN_MOE: if (l == 0) { ph_ln<false, false, true>(p, lds, blk, G, WSP(bf16_t, P_TMP + T_YG), 2, DRY); if (!(DRY)) { const int wv = __builtin_amdgcn_readfirstlane((int)threadIdx.x >> 6); int lq = threadIdx.x & 63; asm volatile("" : "+v"(lq)); { const TailPlan tp = tail_plan(WSP(int, P_RT + RT_TSTART)[32], G); conv_moe1_range(p, (LAS float*)(lds + wv * 8448), lq, tp.t0 + tp.t1 + tp.t2 + blk * NWAVE + wv, G * NWAVE, 12288); } conv_router_w(p, 1, blk * NTHR + (int)threadIdx.x, G * NTHR); } } else ph_ln<false, true, true>(p, lds, blk, G, WSP(bf16_t, P_TMP + T_YG), 5, DRY); break;
                default: ph_l1_swa(p, lds, blk, G); break;
            }
        }
#ifdef PROBE_MASK
        if (((PROBE_MASK) >> kind) & 1) { if (dup == 0) { dup = 1; xcd_barrier(xbar); --pi; continue; } dup = 0; }
#endif
        if (pi + 1 < N_PROG) { if (p0.ws == nullptr) grid.sync(); else { xcd_barrier(xbar);
#ifdef PROBE_BAR2
            xcd_barrier(xbar);
#endif
        } }
    }
}
}
extern "C" void kernel_launch(void* const* d_in, const int* in_sizes, int n_in, void* d_out, int out_size, void* d_ws, size_t ws_size, hipStream_t stream) {
    static int ok = 0;
    if (ok == 0) {
        ok = -1;
        if (n_in != 33 || out_size != 32768 * 1024 || ws_size < fk::FAST_END + (fk::SLOT_MB - 4) * fk::MB) { fprintf(stderr, "kernel_launch: unexpected shapes/ws (%d, %d, %zu)\n", n_in, out_size, ws_size); return; }
        int dev = 0, cus = 0, per_cu = 0;
        if (hipGetDevice(&dev) != hipSuccess || hipDeviceGetAttribute(&cus, hipDeviceAttributeMultiprocessorCount, dev) != hipSuccess) return;
        if (hipFuncSetAttribute((const void*)fk::mega, hipFuncAttributeMaxDynamicSharedMemorySize, fk::LDS_BYTES) != hipSuccess) return;
        if (hipOccupancyMaxActiveBlocksPerMultiprocessor(&per_cu, (const void*)fk::mega, fk::NTHR, fk::LDS_BYTES) != hipSuccess || per_cu < 1 || cus * per_cu < 256) { fprintf(stderr, "kernel_launch: cannot co-reside 256 workgroups (%d CUs x %d)\n", cus, per_cu); return; }
        ok = 1;
    }
    if (ok < 0) return;
    fk::FP p{}; for (int i = 0; i < 33; ++i) p.in[i] = (const float*)d_in[i]; p.X = (float*)d_out; p.ws = (unsigned char*)d_ws;
    if (hipMemsetAsync((char*)d_ws + fk::P_BAR, 0, 16384, stream) != hipSuccess) return;
    if (hipMemsetAsync((char*)d_ws + fk::P_TMP + fk::T_SLOT, 0xFF, fk::SLOT_MB * fk::MB, stream) != hipSuccess) return;
    void* args[] = {&p};
    hipError_t e = hipLaunchCooperativeKernel((const void*)fk::mega, dim3(256), dim3(fk::NTHR), args, fk::LDS_BYTES, stream);
    if (e != hipSuccess) fprintf(stderr, "cooperative launch failed: %s\n", hipGetErrorString(e));
}
```
